# Optimizing an MI355X kernel written in HIP

```python
import math
import jax, jax.numpy as jnp
from jax import lax
import numpy as np

D_MODEL = 1024
BATCH = 16
SEQ = 2048
DEPTH = 2

CTX_LEN = 256
GRID_W = 64
D_MIX = D_MODEL
HEAD_DIM = 64
S5_WIDTH = D_MIX // 4
S5_GROUP = 16
S5_GROUPS = S5_WIDTH // S5_GROUP
S5_STATE = 64
NA_WIDTH = (D_MIX - S5_WIDTH) // 2
NA_HEADS = NA_WIDTH // HEAD_DIM
NA_WIN_R = 8
NA_WIN_C = 16
NA_KEY_SPAN = 2 * NA_WIN_C
ROPE_BASE = 10000.0
RK_WIDTH = D_MIX - S5_WIDTH - NA_WIDTH
RK_HEADS = RK_WIDTH // HEAD_DIM
RK_DECAY_RANK = 64
RK_A_RANK = 64
RK_GATE_RANK = 128
RK_IN_WIDTH = 3 * RK_WIDTH + 2 * RK_DECAY_RANK + 2 * RK_A_RANK + RK_GATE_RANK
RK_GN_EPS = 64e-5
N_IN = S5_WIDTH + 3 * NA_WIDTH + RK_IN_WIDTH
N_EXPERTS = 16
EC_CAPACITY_FACTOR = 2
D_EXPERT = 2816
RMS_EPS = 1e-6
NEG_INF = -1e30

kernel_name = 'hybrid_s5_natten_rwkv7_ec_dit'


def rmsnorm(x, g):
    xf = x.astype(jnp.float32)
    y = xf * lax.rsqrt(jnp.mean(xf * xf, axis=-1, keepdims=True) + RMS_EPS)
    return (y * g.astype(jnp.float32)).astype(x.dtype)


def axial_rope(x):
    n = x.shape[1]
    t = jnp.arange(n)
    row = (t // GRID_W).astype(jnp.float32)
    col = (t % GRID_W).astype(jnp.float32)
    half = x.shape[-1] // 2
    nf = half // 2
    inv_freq = ROPE_BASE ** (-jnp.arange(nf, dtype=jnp.float32) / nf)

    def rot(xp, pos):
        ang = pos[:, None] * inv_freq
        cos = jnp.cos(ang)[None, :, None, :]
        sin = jnp.sin(ang)[None, :, None, :]
        x1, x2 = xp[..., :nf], xp[..., nf:]
        return jnp.concatenate([x1 * cos - x2 * sin, x1 * sin + x2 * cos], axis=-1)

    xf = x.astype(jnp.float32)
    return jnp.concatenate([rot(xf[..., :half], row), rot(xf[..., half:], col)], axis=-1).astype(x.dtype)


def s5_discretise(lam_re, lam_im, log_dt, b_re, b_im):
    lam = lax.complex(lam_re.astype(jnp.float32), lam_im.astype(jnp.float32))
    dt = jnp.exp(log_dt.astype(jnp.float32))[:, None]
    lam_bar = jnp.exp(lam * dt)
    b = lax.complex(b_re.astype(jnp.float32), b_im.astype(jnp.float32))
    b_bar = ((lam_bar - 1.0) / lam)[..., None] * b
    return lam_bar, b_bar


def _linear_recurrence_op(e1, e2):
    a1, b1 = e1
    a2, b2 = e2
    return a1 * a2, a2 * b1 + b2


def s5_scan(u, lam_bar, b_bar, s0, reverse):
    n = u.shape[1]
    bu = jnp.einsum('bngh,gph->nbgp', u, b_bar)
    if s0 is not None:
        bu = bu.at[-1 if reverse else 0].add(lam_bar * s0)
    a = jnp.broadcast_to(lam_bar, (n, 1) + lam_bar.shape)
    _, xs = lax.associative_scan(_linear_recurrence_op, (a, bu), reverse=reverse)
    return xs, (xs[0] if reverse else xs[-1])


def s5_readout(xs, c_re, c_im):
    c_re = c_re.astype(jnp.float32)
    c_im = c_im.astype(jnp.float32)
    return jnp.einsum('nbgp,ghp->bngh', xs.real, c_re) - jnp.einsum('nbgp,ghp->bngh', xs.imag, c_im)


def s5_mixer(u_lat, u_ctx, lam_re, lam_im, log_dt, b_re, b_im, c_re, c_im, d_skip, glu_w, glu_b, need_ctx):
    def groups(u):
        return u.astype(jnp.float32).reshape(u.shape[0], u.shape[1], S5_GROUPS, S5_GROUP)

    ul, uc = groups(u_lat), groups(u_ctx)
    dsk = d_skip.astype(jnp.float32).reshape(S5_GROUPS, S5_GROUP)
    y_lat = dsk * ul
    y_ctx = dsk * uc
    for d, rev in enumerate((False, True)):
        lam_bar, b_bar = s5_discretise(lam_re[d], lam_im[d], log_dt[d], b_re, b_im)
        xc, s_ctx = s5_scan(uc, lam_bar, b_bar, None, rev)
        xl, _ = s5_scan(ul, lam_bar, b_bar, s_ctx, rev)
        y_lat = y_lat + s5_readout(xl, c_re[d], c_im[d])
        if need_ctx:
            y_ctx = y_ctx + s5_readout(xc, c_re[d], c_im[d])

    def glu(y):
        y = jax.nn.gelu(y.reshape(y.shape[0], y.shape[1], S5_WIDTH))
        return y * jax.nn.sigmoid(y @ glu_w.astype(jnp.float32) + glu_b.astype(jnp.float32))

    out_lat = glu(y_lat).astype(u_lat.dtype)
    out_ctx = glu(y_ctx).astype(u_ctx.dtype) if need_ctx else None
    return out_lat, out_ctx


def na_geometry():
    n_blk = GRID_W // NA_WIN_C
    q_cols = np.arange(GRID_W).reshape(n_blk, NA_WIN_C)
    start = np.clip(np.arange(n_blk) * NA_WIN_C - NA_WIN_C // 2, 0, GRID_W - NA_KEY_SPAN)
    key_cols = start[:, None] + np.arange(NA_KEY_SPAN)[None, :]
    c0 = np.clip(q_cols - NA_WIN_C // 2, 0, GRID_W - NA_WIN_C)[..., None]
    kc = key_cols[:, None, :]
    valid = (kc >= c0) & (kc < c0 + NA_WIN_C)
    dc = np.clip(kc - q_cols[..., None], 1 - NA_WIN_C, NA_WIN_C - 1) + NA_WIN_C - 1
    return key_cols.astype(np.int32), valid, dc.astype(np.int32)


def na_mixer(q, k, v, qc, kc, vc, rpb, need_ctx):
    bsz, n, h, dh = q.shape
    rows = n // GRID_W
    win_r = min(NA_WIN_R, rows)
    scale = dh ** -0.5
    key_cols, valid, dc = na_geometry()
    n_blk = key_cols.shape[0]
    qg = q.reshape(bsz, rows, n_blk, NA_WIN_C, h, dh)
    kg = k.reshape(bsz, rows, GRID_W, h, dh)
    vg = v.reshape(bsz, rows, GRID_W, h, dh)
    bias_c = rpb.astype(jnp.float32)[:, :, dc]
    mask = jnp.asarray(valid)[:, :, None, :]
    n_lat = win_r * NA_KEY_SPAN

    def row_block(i):
        r0 = jnp.clip(i - win_r // 2, 0, rows - win_r)
        k_blk = lax.dynamic_slice_in_dim(kg, r0, win_r, axis=1)[:, :, key_cols]
        v_blk = lax.dynamic_slice_in_dim(vg, r0, win_r, axis=1)[:, :, key_cols]
        q_i = qg[:, i]
        s_lat = jnp.einsum('bnqhd,brnkhd->bhnqrk', q_i, k_blk).astype(jnp.float32) * scale
        dr = r0 + jnp.arange(win_r) - i + NA_WIN_R - 1
        bias = jnp.take(bias_c, dr, axis=1).transpose(0, 2, 3, 1, 4)
        s_lat = jnp.where(mask, s_lat + bias, NEG_INF)
        s_ctx = jnp.einsum('bnqhd,blhd->bhnql', q_i, kc).astype(jnp.float32) * scale
        s = jnp.concatenate([s_lat.reshape(bsz, h, n_blk, NA_WIN_C, n_lat), s_ctx], axis=-1)
        p = jax.nn.softmax(s, axis=-1).astype(v.dtype)
        p_lat = p[..., :n_lat].reshape(bsz, h, n_blk, NA_WIN_C, win_r, NA_KEY_SPAN)
        o = jnp.einsum('bhnqrk,brnkhd->bnqhd', p_lat, v_blk) + jnp.einsum('bhnql,blhd->bnqhd', p[..., n_lat:], vc)
        return o.reshape(bsz, GRID_W, h * dh)

    out = lax.map(row_block, jnp.arange(rows))
    out = jnp.swapaxes(out, 0, 1).reshape(bsz, n, h * dh)
    out_ctx = None
    if need_ctx:
        s = jnp.einsum('blhd,bmhd->bhlm', qc, kc).astype(jnp.float32) * scale
        p = jax.nn.softmax(s, axis=-1).astype(vc.dtype)
        out_ctx = jnp.einsum('bhlm,bmhd->blhd', p, vc).reshape(bsz, qc.shape[1], h * dh)
    return out, out_ctx


def centred_shift(x, mu):
    pad = jnp.pad(x, ((0, 0), (1, 1), (0, 0)))
    return x + (0.5 * (pad[:, :-2] + pad[:, 2:]) - x) * mu


def rwkv_prepare(z, w0, w2, a0, a2, g2, k_k, k_a):
    bsz, n, _ = z.shape
    zf = z.astype(jnp.float32)
    W, R, RA = RK_WIDTH, RK_DECAY_RANK, RK_A_RANK

    def heads(t):
        return t.reshape(bsz, n, RK_HEADS, HEAD_DIM)

    r, k, v = zf[..., :W], zf[..., W:2 * W], zf[..., 2 * W:3 * W]
    o = 3 * W
    zw = (zf[..., o:o + R], zf[..., o + R:o + 2 * R])
    o = o + 2 * R
    za = (zf[..., o:o + RA], zf[..., o + RA:o + 2 * RA])
    o = o + 2 * RA
    g = jax.nn.sigmoid(zf[..., o:o + RK_GATE_RANK]) @ g2.astype(jnp.float32)
    kk = heads(k * k_k.astype(jnp.float32))
    kk = kk / jnp.maximum(jnp.sqrt(jnp.sum(kk * kk, axis=-1, keepdims=True)), 1e-12)
    dirs = []
    for d in range(2):
        w = -jax.nn.softplus(-(w0[d].astype(jnp.float32) + jnp.tanh(zw[d]) @ w2[d].astype(jnp.float32))) - 0.5
        a = jax.nn.sigmoid(a0[d].astype(jnp.float32) + za[d] @ a2[d].astype(jnp.float32))
        kd = k * (1.0 + (a - 1.0) * k_a.astype(jnp.float32))
        dirs.append((heads(jnp.exp(-jnp.exp(w))), heads(kd), kk * heads(a)))
    return heads(r), heads(v), kk, g, dirs


def rwkv_scan(r, decay, k, v, a, b, s0, reverse):
    xs = tuple(jnp.moveaxis(t, 1, 0) for t in (r, decay, k, v, a, b))

    def step(S, inp):
        r_t, w_t, k_t, v_t, a_t, b_t = inp
        sa = jnp.einsum('bhij,bhj->bhi', S, a_t)
        S = S * w_t[:, :, None, :] + sa[..., None] * b_t[:, :, None, :] + v_t[..., None] * k_t[:, :, None, :]
        return S, jnp.einsum('bhij,bhj->bhi', S, r_t)

    S, ys = lax.scan(step, s0, xs, reverse=reverse)
    return jnp.moveaxis(ys, 0, 1), S


def rwkv_mixer(z_lat, z_ctx, mu, w0, w2, a0, a2, g2, k_k, k_a, r_k, ln_w, ln_b, need_ctx):
    mu = mu.astype(jnp.float32)
    lat = rwkv_prepare(centred_shift(z_lat.astype(jnp.float32), mu), w0, w2, a0, a2, g2, k_k, k_a)
    cx = rwkv_prepare(centred_shift(z_ctx.astype(jnp.float32), mu), w0, w2, a0, a2, g2, k_k, k_a)
    s_zero = jnp.zeros((z_ctx.shape[0], RK_HEADS, HEAD_DIM, HEAD_DIM), jnp.float32)
    ys_lat, ys_ctx = [], []
    for d, rev in enumerate((False, True)):
        dec, kd, b = cx[4][d]
        yc, s_ctx = rwkv_scan(cx[0], dec, kd, cx[1], -cx[2], b, s_zero, rev)
        dec, kd, b = lat[4][d]
        yl, _ = rwkv_scan(lat[0], dec, kd, lat[1], -lat[2], b, s_ctx, rev)
        ys_lat.append(yl)
        ys_ctx.append(yc)
    r_k = r_k.astype(jnp.float32)

    def finish(prep, y):
        r, v, _, g, dirs = prep
        bsz, n = y.shape[:2]
        mean = jnp.mean(y, axis=-1, keepdims=True)
        var = jnp.mean(jnp.square(y - mean), axis=-1, keepdims=True)
        yn = ((y - mean) * lax.rsqrt(var + RK_GN_EPS)).reshape(bsz, n, RK_WIDTH)
        yn = yn * ln_w.astype(jnp.float32) + ln_b.astype(jnp.float32)
        bonus = (jnp.sum(r * dirs[0][1] * r_k, axis=-1, keepdims=True)
                 + jnp.sum(r * dirs[1][1] * r_k, axis=-1, keepdims=True)) * v
        return (yn + bonus.reshape(bsz, n, RK_WIDTH)) * g

    out_lat = finish(lat, ys_lat[0] + ys_lat[1]).astype(z_lat.dtype)
    out_ctx = finish(cx, ys_ctx[0] + ys_ctx[1]).astype(z_ctx.dtype) if need_ctx else None
    return out_lat, out_ctx


def expert_choice_ffn(h, w_router, w_gate, w_up, w_down):
    bsz, n, d = h.shape
    cap = EC_CAPACITY_FACTOR * n // N_EXPERTS
    aff = jax.nn.softmax((h @ w_router).astype(jnp.float32), axis=-1)
    gate, idx = lax.top_k(jnp.swapaxes(aff, 1, 2), cap)
    xin = jax.vmap(lambda hb, ib: hb[ib])(h, idx)
    hid = jax.nn.silu(jnp.einsum('becd,edf->becf', xin, w_gate)) * jnp.einsum('becd,edf->becf', xin, w_up)
    y = jnp.einsum('becf,efd->becd', hid, w_down) * gate[..., None].astype(h.dtype)
    return jax.vmap(lambda ib, yb: jnp.zeros((n, d), yb.dtype).at[ib.reshape(-1)].add(yb.reshape(-1, d)))(idx, y)


def setup_inputs(seed: int = 0) -> dict:
    key = jax.random.key(seed)
    ks = list(jax.random.split(key, 40))
    ctr = [0]

    def nk():
        ctr[0] += 1
        return ks[ctr[0] - 1]

    def nrm(shape, s):
        return jax.random.normal(nk(), shape, jnp.float32) * s

    L, D, P, G, GH = DEPTH, D_MODEL, S5_STATE, S5_GROUPS, S5_GROUP
    x = nrm((BATCH, SEQ, D), 1.0)
    c = nrm((BATCH, D), 1.0)
    ctx = nrm((BATCH, CTX_LEN, D), 1.0)
    c_ctx = nrm((D,), 1.0)
    ada_w = nrm((L, D, 6 * D), 0.5 * D ** -0.5)
    ada_b = nrm((L, 6 * D), 0.02)
    norm_g = 1.0 + nrm((L, 4, D), 0.05)
    w_in = nrm((L, D, N_IN), D ** -0.5)
    w_out = nrm((L, D_MIX, D), D_MIX ** -0.5)
    s5_lam_re = -0.5 + nrm((L, 2, G, P), 0.01)
    s5_lam_im = jnp.pi * jnp.arange(P, dtype=jnp.float32) + nrm((L, 2, G, P), 0.01)
    s5_log_dt = jax.random.uniform(nk(), (L, 2, G), jnp.float32, math.log(1e-3), math.log(1e-1))
    s5_b_re = nrm((L, G, P, GH), (2 * GH) ** -0.5)
    s5_b_im = nrm((L, G, P, GH), (2 * GH) ** -0.5)
    s5_c_re = nrm((L, 2, G, GH, P), (2 * P) ** -0.5)
    s5_c_im = nrm((L, 2, G, GH, P), (2 * P) ** -0.5)
    s5_d = nrm((L, S5_WIDTH), 1.0)
    s5_glu_w = nrm((L, S5_WIDTH, S5_WIDTH), S5_WIDTH ** -0.5)
    s5_glu_b = nrm((L, S5_WIDTH), 0.02)
    na_rpb = nrm((L, NA_HEADS, 2 * NA_WIN_R - 1, 2 * NA_WIN_C - 1), 0.02)
    rk_mu = jax.random.uniform(nk(), (L, RK_IN_WIDTH), jnp.float32)
    ratio = jnp.arange(RK_WIDTH, dtype=jnp.float32) / (RK_WIDTH - 1)
    rk_w0 = -6.5 + 5.0 * ratio ** 0.85 + nrm((L, 2, RK_WIDTH), 0.1)
    rk_w2 = nrm((L, 2, RK_DECAY_RANK, RK_WIDTH), 0.1 * RK_DECAY_RANK ** -0.5)
    rk_a0 = nrm((L, 2, RK_WIDTH), 0.1)
    rk_a2 = nrm((L, 2, RK_A_RANK, RK_WIDTH), 0.1 * RK_A_RANK ** -0.5)
    rk_g2 = nrm((L, RK_GATE_RANK, RK_WIDTH), RK_GATE_RANK ** -0.5)
    rk_k_k = 0.85 + nrm((L, RK_WIDTH), 0.05)
    rk_k_a = 1.0 + nrm((L, RK_WIDTH), 0.05)
    rk_r_k = nrm((L, RK_HEADS, HEAD_DIM), 0.1)
    rk_ln_w = 1.0 + nrm((L, RK_WIDTH), 0.05)
    rk_ln_b = nrm((L, RK_WIDTH), 0.02)
    ec_router = nrm((L, D, N_EXPERTS), D ** -0.5)
    ec_w_gate = nrm((L, N_EXPERTS, D, D_EXPERT), D ** -0.5)
    ec_w_up = nrm((L, N_EXPERTS, D, D_EXPERT), D ** -0.5)
    ec_w_down = nrm((L, N_EXPERTS, D_EXPERT, D), D_EXPERT ** -0.5)
    return {'x': x, 'c': c, 'ctx': ctx, 'c_ctx': c_ctx, 'ada_w': ada_w, 'ada_b': ada_b, 'norm_g': norm_g,
            'w_in': w_in, 'w_out': w_out, 's5_lam_re': s5_lam_re, 's5_lam_im': s5_lam_im,
            's5_log_dt': s5_log_dt, 's5_b_re': s5_b_re, 's5_b_im': s5_b_im, 's5_c_re': s5_c_re,
            's5_c_im': s5_c_im, 's5_d': s5_d, 's5_glu_w': s5_glu_w, 's5_glu_b': s5_glu_b, 'na_rpb': na_rpb,
            'rk_mu': rk_mu, 'rk_w0': rk_w0, 'rk_w2': rk_w2, 'rk_a0': rk_a0, 'rk_a2': rk_a2, 'rk_g2': rk_g2,
            'rk_k_k': rk_k_k, 'rk_k_a': rk_k_a, 'rk_r_k': rk_r_k, 'rk_ln_w': rk_ln_w, 'rk_ln_b': rk_ln_b,
            'ec_router': ec_router, 'ec_w_gate': ec_w_gate, 'ec_w_up': ec_w_up, 'ec_w_down': ec_w_down}


def reference(x, c, ctx, c_ctx, ada_w, ada_b, norm_g, w_in, w_out, s5_lam_re, s5_lam_im, s5_log_dt, s5_b_re,
              s5_b_im, s5_c_re, s5_c_im, s5_d, s5_glu_w, s5_glu_b, na_rpb, rk_mu, rk_w0, rk_w2, rk_a0, rk_a2,
              rk_g2, rk_k_k, rk_k_a, rk_r_k, rk_ln_w, rk_ln_b, ec_router, ec_w_gate, ec_w_up, ec_w_down):
    o_na = S5_WIDTH
    o_rk = S5_WIDTH + 3 * NA_WIDTH

    def na_heads(p, i):
        t = p[..., o_na + i * NA_WIDTH:o_na + (i + 1) * NA_WIDTH]
        return t.reshape(t.shape[0], t.shape[1], NA_HEADS, HEAD_DIM)

    for l in range(DEPTH):
        need_ctx = l < DEPTH - 1
        mod = (jax.nn.silu(c) @ ada_w[l] + ada_b[l])[:, None, :]
        mod_c = jax.nn.silu(c_ctx) @ ada_w[l] + ada_b[l]
        sh1, sc1, gt1, sh2, sc2, gt2 = jnp.split(mod, 6, axis=-1)
        csh1, csc1, cgt1, csh2, csc2, cgt2 = jnp.split(mod_c, 6, axis=-1)

        h = rmsnorm(x, norm_g[l, 0]) * (1.0 + sc1) + sh1
        hc = rmsnorm(ctx, norm_g[l, 0]) * (1.0 + csc1) + csh1
        p_lat = h @ w_in[l]
        p_ctx = hc @ w_in[l]

        y_s5, yc_s5 = s5_mixer(p_lat[..., :S5_WIDTH], p_ctx[..., :S5_WIDTH], s5_lam_re[l], s5_lam_im[l],
                               s5_log_dt[l], s5_b_re[l], s5_b_im[l], s5_c_re[l], s5_c_im[l], s5_d[l],
                               s5_glu_w[l], s5_glu_b[l], need_ctx)
        q, k, v = (na_heads(p_lat, i) for i in range(3))
        qc, kc, vc = (na_heads(p_ctx, i) for i in range(3))
        y_na, yc_na = na_mixer(axial_rope(q), axial_rope(k), v, qc, kc, vc, na_rpb[l], need_ctx)
        y_rk, yc_rk = rwkv_mixer(p_lat[..., o_rk:], p_ctx[..., o_rk:], rk_mu[l], rk_w0[l], rk_w2[l], rk_a0[l],
                                 rk_a2[l], rk_g2[l], rk_k_k[l], rk_k_a[l], rk_r_k[l], rk_ln_w[l], rk_ln_b[l],
                                 need_ctx)

        y = jnp.concatenate([y_s5, y_na, y_rk], axis=-1) @ w_out[l]
        x = x + gt1 * rmsnorm(y, norm_g[l, 1])

        h2 = rmsnorm(x, norm_g[l, 2]) * (1.0 + sc2) + sh2
        f = expert_choice_ffn(h2, ec_router[l], ec_w_gate[l], ec_w_up[l], ec_w_down[l])
        x = x + gt2 * rmsnorm(f, norm_g[l, 3])

        if need_ctx:
            yc = jnp.concatenate([yc_s5, yc_na, yc_rk], axis=-1) @ w_out[l]
            ctx = ctx + cgt1 * rmsnorm(yc, norm_g[l, 1])
            hc2 = rmsnorm(ctx, norm_g[l, 2]) * (1.0 + csc2) + csh2
            fc = expert_choice_ffn(hc2, ec_router[l], ec_w_gate[l], ec_w_up[l], ec_w_down[l])
            ctx = ctx + cgt2 * rmsnorm(fc, norm_g[l, 3])
    return x
```

```cpp
#include <hip/hip_runtime.h>
#include <cstdio>
#include <cstdint>
namespace pg8 {
#define PG8_LAS __attribute__((address_space(3)))
typedef unsigned short bf16_t;
typedef short bf16x8 __attribute__((ext_vector_type(8)));
typedef float f32x4 __attribute__((ext_vector_type(4)));
typedef unsigned u32x4 __attribute__((ext_vector_type(4)));
constexpr int BM = 256, BK = 64, HALF = 128, HTB = HALF * BK * 2  , STAGE_BYTES = 8 * HTB, NXCD = 8, WGM = 8;

__host__ __device__ __forceinline__ int lds_byte(int r, int c) { const int st = (r >> 4) * 2 + (c >> 5), rr = r & 15, cc = c & 31, ob = rr * 64 + cc * 2; return st * 1024 + (ob ^ (((ob >> 9) & 1) << 5)); }
__host__ __device__ __forceinline__ void stage_rc(int b, int& R, int& C) { const int st = b / 1024, sb = b % 1024, swz = sb ^ (((sb >> 9) & 1) << 5); R = (st >> 1) * 16 + swz / 64; C = (st & 1) * 32 + (swz % 64) / 2; }
__host__ __device__ __forceinline__ int perm32(int rho) { const int n = rho >> 4, i = rho & 15; return 8 * (i >> 2) + 4 * n + (i & 3); }

struct Unit { int pm, pn; };
struct Gemm { const bf16_t* A; const bf16_t* Bt; int M, N, K; };

struct StaticOrder {
    int nM, nN, nwg, G, c;
    __host__ __device__ void init(int M, int N, int G_, int c_) { nM = M / BM; nN = N / BM; nwg = nM * nN; G = G_; c = c_; }
    __host__ __device__ bool next(int i, Unit& u) const {
        const long L = (long)i * G + c; if (L >= nwg) return false;
        int wgid = (int)L; { const int q = nwg / NXCD, r = nwg % NXCD, xcd = wgid % NXCD, off = wgid / NXCD; wgid = (xcd < r ? xcd * (q + 1) : r * (q + 1) + (xcd - r) * q) + off; }
        const int nig = WGM * nN, gid = wgid / nig, fm = gid * WGM, gsz = (nM - fm) < WGM ? (nM - fm) : WGM;
        u.pm = fm + ((wgid % nig) % gsz); u.pn = (wgid % nig) / gsz; return true;
    }
    __device__ __forceinline__ void a_ready(const Unit&) const {}
    __device__ __forceinline__ void done(const Unit&) const {}
};
struct CountedOrder : StaticOrder {
    const unsigned* ready; unsigned need; unsigned* tmo;
    __device__ __forceinline__ void a_ready(const Unit& u) const {
        if (threadIdx.x < 64) {
            const unsigned long long t0 = __builtin_amdgcn_s_memrealtime(); unsigned polls = 0;
            while ((unsigned)__builtin_amdgcn_readfirstlane(__hip_atomic_load(ready + 64 * u.pm, __ATOMIC_RELAXED, __HIP_MEMORY_SCOPE_AGENT)) < need) {
                if ((++polls & 255u) == 0u && __builtin_amdgcn_readfirstlane(__hip_atomic_load(tmo, __ATOMIC_RELAXED, __HIP_MEMORY_SCOPE_AGENT)) != 0u) break;
                if (__builtin_amdgcn_s_memrealtime() - t0 > 2000000ull) {
                    if (threadIdx.x == 0) { unsigned expect = 0u; __hip_atomic_compare_exchange_strong(tmo + 1, &expect, 0x600u | (unsigned)(u.pm & 0xff), __ATOMIC_RELAXED, __ATOMIC_RELAXED, __HIP_MEMORY_SCOPE_AGENT); __hip_atomic_store(tmo, 1u, __ATOMIC_RELAXED, __HIP_MEMORY_SCOPE_AGENT); }
                    break; }
                __builtin_amdgcn_s_sleep(2); }
            __builtin_amdgcn_fence(__ATOMIC_ACQUIRE, "agent");
            asm volatile("s_waitcnt vmcnt(0)" ::: "memory");
        }
#if !defined(BROKEN_HOOK_NO_BARRIER)
        asm volatile("" ::: "memory"); __builtin_amdgcn_s_barrier(); asm volatile("" ::: "memory");
#endif
    }
};

__device__ __forceinline__ unsigned cvt_pk_bf16(float lo, float hi) { unsigned r; asm volatile("v_cvt_pk_bf16_f32 %0, %1, %2" : "=v"(r) : "v"(lo), "v"(hi)); return r; }
typedef float f32x2 __attribute__((ext_vector_type(2)));
__device__ __forceinline__ f32x2 gelu_pk(f32x2 v) {
    const f32x2 av = __builtin_elementwise_abs(v), d = av * 0.2316418882f + 1.0f;
    f32x2 t; t.x = __builtin_amdgcn_rcpf(d.x); t.y = __builtin_amdgcn_rcpf(d.y);
    f32x2 q = t * 0.5307027145f + (-0.7265760135f); q = q * t + 0.7107068705f; q = q * t + (-0.142248368f); q = q * t + 0.127414796f; q = q * t;
    const f32x2 s = (v * v) * (-0.72134752044f);
    f32x2 e; e.x = __builtin_amdgcn_exp2f(s.x); e.y = __builtin_amdgcn_exp2f(s.y);
    const f32x2 m = v * (q * e), r = v - m;
    f32x2 o; o.x = v.x < 0.f ? m.x : r.x; o.y = v.y < 0.f ? m.y : r.y; return o;
}

struct EpiF32 {
    static constexpr bool PERM = false, AFTER_DRAIN = false;
    float* C; int ldc; const float* bias;
    __device__ __forceinline__ void operator()(const f32x4 (&acc)[2][2][4][2], const Unit& u, int wr, int wc, int fr, int fq) const {
        const int row0 = u.pm * BM + wr * 64 + fr, col0 = u.pn * BM + wc * 32 + 4 * fq;
        f32x4 bv[2][2];
#pragma unroll
        for (int bj = 0; bj < 2; ++bj)
#pragma unroll
            for (int n = 0; n < 2; ++n) bv[bj][n] = bias ? *(const f32x4*)(bias + col0 + bj * HALF + n * 16) : (f32x4){0.f, 0.f, 0.f, 0.f};
#pragma unroll
        for (int ai = 0; ai < 2; ++ai)
#pragma unroll
            for (int m = 0; m < 4; ++m) { float* rowp = C + (size_t)(row0 + ai * HALF + m * 16) * ldc + col0;
#pragma unroll
                for (int bj = 0; bj < 2; ++bj)
#pragma unroll
                    for (int n = 0; n < 2; ++n) *(f32x4*)(rowp + bj * HALF + n * 16) = acc[ai][bj][m][n] + bv[bj][n]; }
    }
};
template <int ACT  > struct EpiBf16 {
    static constexpr bool PERM = true, AFTER_DRAIN = false;
    bf16_t* O; int ldc; const float* bias; int split_cols; size_t split_stride;
    __device__ __forceinline__ void operator()(const f32x4 (&acc)[2][2][4][2], const Unit& u, int wr, int wc, int fr, int fq) const {
        const int row0 = u.pm * BM + wr * 64 + fr; int colt = u.pn * BM; bf16_t* base = O;
        if (split_cols) { const int t = colt / split_cols; base += (size_t)t * split_stride; colt -= t * split_cols; }
        const int col0 = colt + wc * 32 + 8 * fq, bcol0 = u.pn * BM + wc * 32 + 8 * fq;
        f32x4 bv[2][2];
#pragma unroll
        for (int bj = 0; bj < 2; ++bj)
#pragma unroll
            for (int n = 0; n < 2; ++n) bv[bj][n] = bias ? *(const f32x4*)(bias + bcol0 + bj * HALF + 4 * n) : (f32x4){0.f, 0.f, 0.f, 0.f};
#pragma unroll
        for (int ai = 0; ai < 2; ++ai)
#pragma unroll
            for (int m = 0; m < 4; ++m) { bf16_t* rowp = base + (size_t)(row0 + ai * HALF + m * 16) * ldc + col0;
#pragma unroll
                for (int bj = 0; bj < 2; ++bj) { f32x4 v0 = acc[ai][bj][m][0] + bv[bj][0], v1 = acc[ai][bj][m][1] + bv[bj][1];
                    if (ACT == 1) { f32x2 a = gelu_pk((f32x2){v0[0], v0[1]}), b = gelu_pk((f32x2){v0[2], v0[3]}), c = gelu_pk((f32x2){v1[0], v1[1]}), d = gelu_pk((f32x2){v1[2], v1[3]});
                        v0 = (f32x4){a.x, a.y, b.x, b.y}; v1 = (f32x4){c.x, c.y, d.x, d.y}; }
                    if (ACT == 2) {
#pragma unroll
                        for (int j = 0; j < 4; ++j) { v0[j] = 0.5f * v0[j] * (1.0f + erff(v0[j] * 0.70710678f)); v1[j] = 0.5f * v1[j] * (1.0f + erff(v1[j] * 0.70710678f)); } }
                    u32x4 w; w.x = cvt_pk_bf16(v0[0], v0[1]); w.y = cvt_pk_bf16(v0[2], v0[3]); w.z = cvt_pk_bf16(v1[0], v1[1]); w.w = cvt_pk_bf16(v1[2], v1[3]);
                    *(u32x4*)(rowp + bj * HALF) = w; } }
    }
};

template <class Epi, class Sched, bool STAMP = false>
__device__ __forceinline__ void gemm_phase(PG8_LAS unsigned char* lds, const Gemm g, const Sched& S, const Epi& E, unsigned long long* stamps) {
    const int tid = threadIdx.x, wid = __builtin_amdgcn_readfirstlane(tid >> 6), lane = tid & 63, wr = wid >> 2, wc = wid & 3, fr = lane & 15, fq = lane >> 4;
    const int K = g.K, nt = K / BK;
    int ts_lo = 0, ts_hi = 0, nts = 0; const unsigned long long rt_entry = STAMP ? (unsigned long long)wall_clock64() : 0ull;
#define PG8_STAMP() do { if (STAMP && wid == 0 && nts < 64) { const unsigned long long _c = (unsigned long long)clock64(); \
        ts_lo = (lane == nts) ? (int)(unsigned)_c : ts_lo; ts_hi = (lane == nts) ? (int)(unsigned)(_c >> 32) : ts_hi; ++nts; } } while (0)
    PG8_STAMP();
    unsigned voffA[2], voffB[2];
#pragma unroll
    for (int i = 0; i < 2; ++i) { int R, C; stage_rc(tid * 16 + i * 8192, R, C); const int Rb = Epi::PERM ? ((R & ~31) + perm32(R & 31)) : R;
        voffA[i] = (unsigned)(R * K + C) * 2u; voffB[i] = (unsigned)(Rb * K + C) * 2u; }
    const size_t kstep = (size_t)(BK * 2);
    const size_t hstep = (size_t)HALF * K * 2;
    const size_t tstep = 2 * hstep;
    const unsigned ldsw = (unsigned)wid * 1024u;
    const int aoff = lds_byte(wr * 64 + fr, fq * 8), boff = lds_byte(wc * 32 + fr, fq * 8);
#define PG8_SA(b, h) (((b) * 2 + (h)) * HTB)
#define PG8_SB(b, h) ((4 + (b) * 2 + (h)) * HTB)
#define PG8_STAGE(bufoff, gbase, voff) do { _Pragma("unroll") for (int _i = 0; _i < 2; ++_i) \
        __builtin_amdgcn_global_load_lds((const unsigned*)((const char*)(gbase) + (voff)[_i]), (PG8_LAS unsigned*)(lds + (bufoff) + ldsw + _i * 8192), 16, 0, 0); } while (0)
#define PG8_LDA(dst, b, h) do { _Pragma("unroll") for (int m = 0; m < 4; ++m) _Pragma("unroll") for (int k = 0; k < 2; ++k) dst[m][k] = *(const PG8_LAS bf16x8*)(lds + PG8_SA(b, h) + aoff + m * 2048 + k * 1024); } while (0)
#define PG8_LDB(dst, b, h) do { _Pragma("unroll") for (int n = 0; n < 2; ++n) _Pragma("unroll") for (int k = 0; k < 2; ++k) dst[n][k] = *(const PG8_LAS bf16x8*)(lds + PG8_SB(b, h) + boff + n * 2048 + k * 1024); } while (0)
#define PG8_MMA(ai, bj, At, Bt) do { __builtin_amdgcn_s_setprio(1); _Pragma("unroll") for (int m = 0; m < 4; ++m) _Pragma("unroll") for (int n = 0; n < 2; ++n) _Pragma("unroll") for (int k = 0; k < 2; ++k) \
        acc[ai][bj][m][n] = __builtin_amdgcn_mfma_f32_16x16x32_bf16(Bt[n][k], At[m][k], acc[ai][bj][m][n], 0, 0, 0); __builtin_amdgcn_s_setprio(0); } while (0)
#define PG8_WAIT_V(n) asm volatile("s_waitcnt vmcnt(" #n ")" ::: "memory")
#define PG8_WAIT_L(n) asm volatile("s_waitcnt lgkmcnt(" #n ")" ::: "memory")
#define PG8_BAR __builtin_amdgcn_s_barrier()
#define PG8_SCHED __builtin_amdgcn_sched_barrier(0)
    Unit cur, nxt; int ui = 0;
    if (!S.next(0, cur)) return;
    f32x4 acc[2][2][4][2];
#pragma unroll
    for (int a = 0; a < 2; ++a)
#pragma unroll
        for (int b = 0; b < 2; ++b)
#pragma unroll
            for (int m = 0; m < 4; ++m)
#pragma unroll
                for (int n = 0; n < 2; ++n) acc[a][b][m][n] = (f32x4){0.f, 0.f, 0.f, 0.f};
    bf16x8 At[4][2], B0[2][2], B1[2][2];
    const char* cA = (const char*)g.A + (size_t)cur.pm * tstep; const char* cB = (const char*)g.Bt + (size_t)cur.pn * tstep;
    S.a_ready(cur);
    PG8_STAGE(PG8_SB(0, 0), cB, voffB); PG8_STAGE(PG8_SA(0, 0), cA, voffA); PG8_STAGE(PG8_SB(0, 1), cB + hstep, voffB); PG8_STAGE(PG8_SA(0, 1), cA + hstep, voffA);
    if (wr == 1) PG8_BAR;
    PG8_WAIT_V(4); PG8_BAR;
    PG8_STAGE(PG8_SB(1, 0), cB + kstep, voffB); PG8_STAGE(PG8_SA(1, 0), cA + kstep, voffA); PG8_STAGE(PG8_SB(1, 1), cB + hstep + kstep, voffB);
    PG8_WAIT_V(6); PG8_BAR;
    PG8_STAMP();
    for (;;) {
        const bool has_next = S.next(ui + 1, nxt);
        const char* nA = has_next ? (const char*)g.A + (size_t)nxt.pm * tstep : cA; const char* nB = has_next ? (const char*)g.Bt + (size_t)nxt.pn * tstep : cB;
        for (int t = 0; t < nt; t += 2) {
            const bool last = (t == nt - 2);
            const char* a1 = cA + (size_t)(t + 1) * kstep;
            const char* a2 = last ? nA : cA + (size_t)(t + 2) * kstep; const char* b2 = last ? nB : cB + (size_t)(t + 2) * kstep;
            const char* a3 = a2 + kstep; const char* b3 = b2 + kstep;
            if (last && has_next) S.a_ready(nxt);
            PG8_LDB(B0, 0, 0); PG8_SCHED; PG8_LDA(At, 0, 0); PG8_STAGE(PG8_SA(1, 1), a1 + hstep, voffA);
            PG8_WAIT_L(8); PG8_BAR; PG8_WAIT_L(0); PG8_MMA(0, 0, At, B0); PG8_BAR; PG8_SCHED;
            PG8_LDB(B1, 0, 1); PG8_STAGE(PG8_SB(0, 0), b2, voffB);
            PG8_BAR; PG8_WAIT_L(0); PG8_MMA(0, 1, At, B1); PG8_BAR;
            PG8_LDA(At, 0, 1); PG8_STAGE(PG8_SA(0, 0), a2, voffA);
            PG8_BAR; PG8_WAIT_L(0); PG8_MMA(1, 0, At, B0); PG8_BAR; PG8_SCHED;
            PG8_STAGE(PG8_SB(0, 1), b2 + hstep, voffB);
            PG8_WAIT_V(6); PG8_BAR; PG8_MMA(1, 1, At, B1); PG8_BAR;
            PG8_LDB(B0, 1, 0); PG8_SCHED; PG8_LDA(At, 1, 0); PG8_STAGE(PG8_SA(0, 1), a2 + hstep, voffA);
            PG8_WAIT_L(8); PG8_BAR; PG8_WAIT_L(0); PG8_MMA(0, 0, At, B0); PG8_BAR; PG8_SCHED;
            PG8_LDB(B1, 1, 1); PG8_STAGE(PG8_SB(1, 0), b3, voffB);
            PG8_BAR; PG8_WAIT_L(0); PG8_MMA(0, 1, At, B1); PG8_BAR;
            PG8_LDA(At, 1, 1); PG8_STAGE(PG8_SA(1, 0), a3, voffA);
            PG8_BAR; PG8_WAIT_L(0); PG8_MMA(1, 0, At, B0); PG8_BAR; PG8_SCHED;
            PG8_STAGE(PG8_SB(1, 1), b3 + hstep, voffB);
            PG8_WAIT_V(6); PG8_BAR; PG8_MMA(1, 1, At, B1); PG8_BAR;
        }
        PG8_STAMP();
        if constexpr (!Epi::AFTER_DRAIN) { E(acc, cur, wr, wc, fr, fq); S.done(cur); }
        PG8_STAMP();
        if (!has_next) break;
#pragma unroll
        for (int a = 0; a < 2; ++a)
#pragma unroll
            for (int b = 0; b < 2; ++b)
#pragma unroll
                for (int m = 0; m < 4; ++m)
#pragma unroll
                    for (int n = 0; n < 2; ++n) acc[a][b][m][n] = (f32x4){0.f, 0.f, 0.f, 0.f};
        cur = nxt; cA = nA; cB = nB; ++ui;
    }
    PG8_WAIT_V(0);
    if (wr == 0) PG8_BAR;
    PG8_BAR;
    if constexpr (Epi::AFTER_DRAIN) { E.fused(acc, cur, wr, wc, fr, fq, lds, wid, lane); S.done(cur); }
    PG8_STAMP();
    if (STAMP && wid == 0) { stamps[lane] = lane < nts ? (((unsigned long long)(unsigned)ts_hi << 32) | (unsigned)ts_lo) : 0ull;
        if (lane == 62) stamps[62] = rt_entry; if (lane == 63) stamps[63] = (unsigned long long)wall_clock64(); }
#undef PG8_STAMP
#undef PG8_SA
#undef PG8_SB
#undef PG8_STAGE
#undef PG8_LDA
#undef PG8_LDB
#undef PG8_MMA
#undef PG8_WAIT_V
#undef PG8_WAIT_L
#undef PG8_BAR
#undef PG8_SCHED
}
}
#define XB_TMO      128
#define XB_XCNT(j)  (256  + 64 * (j))
#define XB_XSUB(j)  (1280 + 64 * (j))
#define XB_XGEN(j)  (2304 + 64 * (j))
#define XB_TOP      3328
#define XB_TOPGEN   3392
#define XCD_BAR_WORDS 3456
#define XB_SPIN_CAP (1u << 18)
#define LAS __attribute__((address_space(3)))

__device__ __forceinline__ unsigned xb_ld(unsigned* p)              { return __hip_atomic_load(p, __ATOMIC_RELAXED, __HIP_MEMORY_SCOPE_AGENT); }
__device__ __forceinline__ unsigned xb_add(unsigned* p, unsigned v) { return __hip_atomic_fetch_add(p, v, __ATOMIC_RELAXED, __HIP_MEMORY_SCOPE_AGENT); }
__device__ __forceinline__ unsigned xb_xcc_id() { return (unsigned)__builtin_amdgcn_s_getreg((3 << 11) | 20) & 0xFu; }
#define XB_SPIN(cond, bar) do { unsigned _sp = 0; while (cond) { __builtin_amdgcn_s_sleep(1); \
    if ((++_sp & 255u) == 0u) { if (xb_ld(&(bar)[XB_TMO])) break; if (_sp > XB_SPIN_CAP) { atomicAdd(&(bar)[XB_TMO], 1u); break; } } } } while (0)

struct XcdBarrier {
    unsigned* bar; unsigned x;
    volatile LAS unsigned* st;
};

__device__ __forceinline__ XcdBarrier xcd_barrier_post(unsigned* bar, volatile LAS unsigned* st) {
    XcdBarrier b; b.bar = bar; b.x = xb_xcc_id(); b.st = st;
    if (threadIdx.x == 0) (void)xb_add(&bar[XB_XCNT(b.x)], 1u);
    return b;
}
__device__ __forceinline__ void xcd_barrier_complete(unsigned* bar, unsigned x, unsigned& nloc, unsigned& nx) {
    const unsigned G = gridDim.x * gridDim.y * gridDim.z;
    unsigned sum, cnt, mine, sp = 0u;
    for (;;) {
        sum = 0u; cnt = 0u; mine = 0u;
#pragma unroll
        for (unsigned j = 0; j < 16; ++j) { const unsigned c = xb_ld(&bar[XB_XCNT(j)]); sum += c; cnt += (c > 0u) ? 1u : 0u; mine = (j == x) ? c : mine; }
        if (sum == G) break;
        __builtin_amdgcn_s_sleep(1);
        if ((++sp & 255u) == 0u) { if (xb_ld(&bar[XB_TMO])) break; if (sp > XB_SPIN_CAP) { atomicAdd(&bar[XB_TMO], 1u); break; } }
    }
    nloc = mine > 0u ? mine : 1u; nx = cnt > 0u ? cnt : 1u;
}

__device__ __forceinline__ void xcd_barrier(const XcdBarrier& b) {
    asm volatile("s_waitcnt vmcnt(0)" ::: "memory");
    __syncthreads();
    if (threadIdx.x == 0) {
        unsigned* bar = b.bar;
        __builtin_amdgcn_s_waitcnt(0);
        unsigned nloc = b.st[0], nx = b.st[1];
        if (nloc == 0u) { xcd_barrier_complete(bar, b.x, nloc, nx); b.st[0] = nloc; b.st[1] = nx; }
        const unsigned old = xb_add(&bar[XB_XSUB(b.x)], 1u);
        const unsigned gen = old / nloc;
        if (old + 1u == (gen + 1u) * nloc) {
            __builtin_amdgcn_fence(__ATOMIC_RELEASE, "agent");
            asm volatile("s_waitcnt vmcnt(0)" ::: "memory");
            const unsigned og = xb_add(&bar[XB_TOP], 1u);
            const unsigned tg = og / nx;
            if (og + 1u == (tg + 1u) * nx) xb_add(&bar[XB_TOPGEN], 1u);
            else XB_SPIN(xb_ld(&bar[XB_TOPGEN]) == tg, bar);
            __builtin_amdgcn_fence(__ATOMIC_ACQUIRE, "agent");
            xb_add(&bar[XB_XGEN(b.x)], 1u);
            asm volatile("s_waitcnt vmcnt(0)" ::: "memory");
        } else {
            XB_SPIN(xb_ld(&bar[XB_XGEN(b.x)]) == gen, bar);
            __builtin_amdgcn_fence(__ATOMIC_ACQUIRE, "agent");
            asm volatile("s_waitcnt vmcnt(0)" ::: "memory");
        }
    }
    __syncthreads();
}

namespace mk {
using pg8::bf16_t; using pg8::bf16x8; using pg8::f32x4; using pg8::u32x4;
typedef unsigned u32x2 __attribute__((ext_vector_type(2)));
typedef short bf16x4 __attribute__((ext_vector_type(4)));
typedef float lf2 __attribute__((ext_vector_type(2)));
typedef float lf4 __attribute__((ext_vector_type(4)));
typedef unsigned lu4 __attribute__((ext_vector_type(4)));

constexpr int D = 1024, NBATCH = 16, SEQ = 2048, CTXL = 256;
constexpr int NLAT = NBATCH * SEQ, NCTX = NBATCH * CTXL, NROW = NLAT + NCTX;
constexpr int NINP = 3072, NIN = 2944;
constexpr int C_Q = 256, C_K = 640, C_V = 1024, C_Z = 1408;
constexpr int DE = 2816;
constexpr int XROWS = 4608;
constexpr int NTHR = 512;
constexpr int LDS_MISC = 131072, LDS_BYTES = 131072 + 256;

constexpr size_t al256(size_t x) { return (x + 255) & ~(size_t)255; }
constexpr size_t WS_CTL = 0;
constexpr size_t WS_MOD = 65536;
constexpr size_t WS_SW = al256(WS_MOD + (size_t)2 * 17 * 6144 * 4);
constexpr size_t SW_W2T = 0, SW_A2T = 98304, SW_G2T = 196608, SW_GLUT = 294912, SW_S5E = 425984, SW_S5W2 = 2523136, SW_STRIDE = 6717440;
constexpr size_t WS_WIN = al256(WS_SW + 2 * SW_STRIDE);
constexpr size_t WS_WOUT = WS_WIN + (size_t)3072 * 1024 * 2;
constexpr size_t WS_WGU = WS_WOUT + (size_t)1024 * 1024 * 2;
constexpr size_t WS_WD = WS_WGU + (size_t)16 * 5632 * 1024 * 2;
constexpr size_t WS_XB = WS_WD + (size_t)16 * 1024 * 2816 * 2;
constexpr size_t WS_CTXA = WS_XB + (size_t)NLAT * D * 4;
constexpr size_t WS_CTXB = WS_CTXA + (size_t)NCTX * D * 4;
constexpr size_t WS_ABUF = WS_CTXB + (size_t)NCTX * D * 4;
constexpr size_t WS_AFF = WS_ABUF + (size_t)NROW * D * 2;
constexpr size_t WS_SLOT = WS_AFF + (size_t)NROW * 16 * 4;
constexpr size_t WS_SELG = WS_SLOT + (size_t)NROW * 16 * 4;
constexpr size_t WS_U = al256(WS_SELG + (size_t)16 * XROWS * 4);
constexpr size_t SZ384 = (size_t)NROW * 384 * 2;
constexpr size_t U_P = WS_U;
constexpr size_t U_QR = U_P + (size_t)NROW * NINP * 2;
constexpr size_t U_KR = U_QR + SZ384;
constexpr size_t U_VT = U_KR + SZ384;
constexpr size_t U_VTC = U_VT + (size_t)16 * 384 * 2048 * 2;
constexpr size_t U_RS = U_VT + SZ384;
constexpr size_t U_KS = U_RS + SZ384;
constexpr size_t U_VS = U_KS + SZ384;
constexpr size_t U_KK = U_VS + SZ384;
constexpr size_t U_ALR = U_KK + SZ384;
constexpr size_t U_LD = U_ALR + SZ384;
constexpr size_t U_AG = U_LD + 2 * SZ384;
constexpr size_t U_G = U_AG + 2 * SZ384;
constexpr size_t U_YRK = U_G + SZ384;
constexpr size_t U_SLOC = U_YRK + 2 * (size_t)NROW * 384 * 4;
constexpr size_t U_SPREV = U_SLOC + (size_t)2304 * 16 * 256 * 4;
constexpr size_t U_YG = U_SPREV + (size_t)2304 * 16 * 256 * 2;
constexpr size_t U_MIX_END = U_YG + (size_t)NROW * 256 * 2;
constexpr size_t U_Y = WS_U;
constexpr size_t U_XSEL = U_Y + (size_t)NROW * D * 4;
constexpr size_t U_HID = U_XSEL + (size_t)16 * XROWS * 1024 * 2;
constexpr size_t U_YEXP = U_HID + (size_t)16 * XROWS * DE * 2;
constexpr size_t U_FFN_END = U_YEXP + (size_t)16 * XROWS * 1024 * 2;
constexpr size_t WS_END = U_MIX_END > U_FFN_END ? U_MIX_END : U_FFN_END;

struct Params { const float* in[35]; float* out; unsigned char* ws; int ph_lo, ph_hi, use_bar, pad; };

__device__ __forceinline__ bf16_t f2bf(float f) { unsigned u = __float_as_uint(f); u += 0x7FFFu + ((u >> 16) & 1u); return (bf16_t)(u >> 16); }
__device__ __forceinline__ unsigned pack2(float lo, float hi) { return (unsigned)f2bf(lo) | ((unsigned)f2bf(hi) << 16); }
__device__ __forceinline__ float bflo(unsigned w) { return __uint_as_float(w << 16); }
__device__ __forceinline__ float bfhi(unsigned w) { return __uint_as_float(w & 0xffff0000u); }
__device__ __forceinline__ float bf2f(bf16_t b) { return __uint_as_float(((unsigned)b) << 16); }
__device__ __forceinline__ float sigm(float x) { return 1.0f / (1.0f + __expf(-x)); }
__device__ __forceinline__ float wave_sum(float v) {
#pragma unroll
    for (int o = 32; o >= 1; o >>= 1) v += __shfl_xor(v, o);
    return v; }
__device__ __forceinline__ void unpack8(const uint4 w, float (&f)[8]) { f[0] = bflo(w.x); f[1] = bfhi(w.x); f[2] = bflo(w.y); f[3] = bfhi(w.y); f[4] = bflo(w.z); f[5] = bfhi(w.z); f[6] = bflo(w.w); f[7] = bfhi(w.w); }
__device__ __forceinline__ uint4 pack8(const float (&f)[8]) { uint4 w; w.x = pack2(f[0], f[1]); w.y = pack2(f[2], f[3]); w.z = pack2(f[4], f[5]); w.w = pack2(f[6], f[7]); return w; }
__device__ __forceinline__ const float* xrow(const float* lat, const float* ctx, int r) { return r < NLAT ? lat + (size_t)r * D : ctx + (size_t)(r - NLAT) * D; }
__device__ __forceinline__ float* xrow_w(float* lat, float* ctx, int r) { return r < NLAT ? lat + (size_t)r * D : ctx + (size_t)(r - NLAT) * D; }
__device__ __forceinline__ f32x4 mfma16(bf16x8 a, bf16x8 b, f32x4 c) { return __builtin_amdgcn_mfma_f32_16x16x32_bf16(a, b, c, 0, 0, 0); }

__device__ __forceinline__ void tr_tile(const float* __restrict__ src, int ldsrc, int k0, int n0, bf16_t* __restrict__ dst, int lddst, int drow0, LAS unsigned* T) {
    const int tid = threadIdx.x, n4 = tid & 15, kq = tid >> 4;
    const float4 a = *(const float4*)(src + (size_t)(k0 + 2 * kq) * ldsrc + n0 + 4 * n4);
    const float4 b = *(const float4*)(src + (size_t)(k0 + 2 * kq + 1) * ldsrc + n0 + 4 * n4);
    T[(4 * n4 + 0) * 33 + kq] = pack2(a.x, b.x); T[(4 * n4 + 1) * 33 + kq] = pack2(a.y, b.y);
    T[(4 * n4 + 2) * 33 + kq] = pack2(a.z, b.z); T[(4 * n4 + 3) * 33 + kq] = pack2(a.w, b.w);
    __syncthreads();
    const int n = tid >> 3, pc = tid & 7;
    uint4 v; v.x = T[n * 33 + 4 * pc]; v.y = T[n * 33 + 4 * pc + 1]; v.z = T[n * 33 + 4 * pc + 2]; v.w = T[n * 33 + 4 * pc + 3];
    *(uint4*)(dst + (size_t)(drow0 + n) * lddst + k0 + 8 * pc) = v;
    __syncthreads();
}

constexpr int CV_WIN = 16 * 46, CV_PAD = 32, CV_WOUT = 256, CV_G = 16 * 704, CV_TOTAL = CV_WIN + CV_PAD + CV_WOUT + 3 * CV_G;
__device__ __forceinline__ void convert_weights(const Params& p, int l, LAS unsigned char* lds, int vb, int nvb) {
    LAS unsigned* T = (LAS unsigned*)lds;
    bf16_t* WIN = (bf16_t*)(p.ws + WS_WIN); bf16_t* WOUT = (bf16_t*)(p.ws + WS_WOUT); bf16_t* WGU = (bf16_t*)(p.ws + WS_WGU); bf16_t* WD = (bf16_t*)(p.ws + WS_WD);
    for (int it = vb; it < CV_TOTAL; it += nvb) {
        int j = it;
        if (j < CV_WIN) { const int kt = j / 46, nt = j % 46; tr_tile(p.in[7] + (size_t)l * 1024 * NIN, NIN, kt * 64, nt * 64, WIN, 1024, nt * 64, T); continue; }
        j -= CV_WIN;
        if (j < CV_PAD) { const size_t o = (size_t)NIN * 1024 + ((size_t)j * NTHR + threadIdx.x) * 8; *(uint4*)(WIN + o) = make_uint4(0u, 0u, 0u, 0u); continue; }
        j -= CV_PAD;
        if (j < CV_WOUT) { const int kt = j / 16, nt = j % 16; tr_tile(p.in[8] + (size_t)l * 1024 * 1024, 1024, kt * 64, nt * 64, WOUT, 1024, nt * 64, T); continue; }
        j -= CV_WOUT;
        if (j < 2 * CV_G) { const int up = j >= CV_G; if (up) j -= CV_G; const int e = j / 704, rem = j % 704, kt = rem / 44, nt = rem % 44, n0 = nt * 64;
            tr_tile(p.in[up ? 33 : 32] + (size_t)(l * 16 + e) * 1024 * DE, DE, kt * 64, n0, WGU + (size_t)e * 5632 * 1024, 1024, (n0 >> 7) * 256 + (n0 & 127) + (up ? 128 : 0), T); continue; }
        j -= 2 * CV_G;
        { const int e = j / 704, rem = j % 704, kt = rem / 16, nt = rem % 16;
            tr_tile(p.in[34] + (size_t)(l * 16 + e) * DE * 1024, 1024, kt * 64, nt * 64, WD + (size_t)e * 1024 * DE, DE, nt * 64, T); }
    }
}

__device__ __forceinline__ void mod_item(const Params& p, int item, LAS unsigned char* lds) {
    LAS float* sc = (LAS float*)lds;
    LAS float* red = (LAS float*)(lds + 69632);
    const int tid = threadIdx.x, l = item / 96, cg = item % 96;
    for (int i = tid; i < 17 * 1024; i += NTHR) { const int b = i >> 10, k = i & 1023; const float c = b < 16 ? p.in[1][b * 1024 + k] : p.in[3][k]; sc[k * 17 + b] = c * sigm(c); }
    __syncthreads();
    const int col = cg * 64 + (tid & 63), kg = tid >> 6;
    float acc[17];
#pragma unroll
    for (int b = 0; b < 17; ++b) acc[b] = 0.f;
    const float* w = p.in[4] + ((size_t)l * 1024 + kg * 128) * 6144 + col;
#pragma unroll 4
    for (int kk = 0; kk < 128; ++kk) { const float wv = w[(size_t)kk * 6144]; const LAS float* s = sc + (kg * 128 + kk) * 17;
#pragma unroll
        for (int b = 0; b < 17; ++b) acc[b] += s[b] * wv; }
#pragma unroll
    for (int b = 0; b < 17; ++b) red[(kg * 17 + b) * 64 + (tid & 63)] = acc[b];
    __syncthreads();
    for (int i = tid; i < 17 * 64; i += NTHR) { const int b = i >> 6, c = i & 63; float s = 0.f;
#pragma unroll
        for (int g = 0; g < 8; ++g) s += red[(g * 17 + b) * 64 + c];
        ((float*)(p.ws + WS_MOD))[((size_t)l * 17 + b) * 6144 + cg * 64 + c] = s + p.in[5][l * 6144 + cg * 64 + c]; }
    __syncthreads();
}

__device__ __forceinline__ void s5mat_item(const Params& p, int item, LAS unsigned char* lds) {
    LAS lf2* pw = (LAS lf2*)lds;
    LAS lf2* bb = (LAS lf2*)(lds + 17408);
    LAS lf2* cc = (LAS lf2*)(lds + 17408 + 16384);
    LAS float* KT = (LAS float*)(lds + 17408 + 32768);
    const int tid = threadIdx.x, l = item >> 4, g = item & 15;
    for (int i = tid; i < 2 * 17 * 64; i += NTHR) { const int pp = i & 63, n = (i >> 6) % 17, d = i / (17 * 64);
        const int li = ((l * 2 + d) * 16 + g) * 64 + pp; const float lr = p.in[9][li], lim = p.in[10][li], dt = expf(p.in[11][(l * 2 + d) * 16 + g]);
        const float mag = expf((float)n * dt * lr); float s, c; sincosf((float)n * dt * lim, &s, &c); pw[i] = (lf2){mag * c, mag * s}; }
    for (int i = tid; i < 2 * 64 * 16; i += NTHR) { const int h = i & 15, pp = (i >> 4) & 63, d = i >> 10;
        const int li = ((l * 2 + d) * 16 + g) * 64 + pp; const float lr = p.in[9][li], lim = p.in[10][li], dt = expf(p.in[11][(l * 2 + d) * 16 + g]);
        const float mag = expf(dt * lr); float s, c; sincosf(dt * lim, &s, &c); const float x = mag * c - 1.0f, y = mag * s;
        const float den = 1.0f / (lr * lr + lim * lim); const float cr = (x * lr + y * lim) * den, ci = (y * lr - x * lim) * den;
        const int bi = ((l * 16 + g) * 64 + pp) * 16 + h; const float br = p.in[12][bi], bim = p.in[13][bi];
        bb[i] = (lf2){cr * br - ci * bim, cr * bim + ci * br}; }
    for (int i = tid; i < 2 * 16 * 64; i += NTHR) { const int pp = i & 63, h = (i >> 6) & 15, d = i >> 10;
        const int ci = (((l * 2 + d) * 16 + g) * 16 + h) * 64 + pp; cc[i] = (lf2){p.in[14][ci], p.in[15][ci]}; }
    __syncthreads();
    for (int i = tid; i < 2 * 16 * 256; i += NTHR) { const int h2 = i & 15, h = (i >> 4) & 15, tau = (i >> 8) & 15, d = i >> 12; float s = 0.f;
        for (int pp = 0; pp < 64; ++pp) { const lf2 c = cc[(d * 16 + h) * 64 + pp], w = pw[(d * 17 + tau) * 64 + pp], b = bb[(d * 64 + pp) * 16 + h2];
            const float tr = c.x * w.x - c.y * w.y, ti = c.x * w.y + c.y * w.x; s += tr * b.x - ti * b.y; }
        KT[i] = s; }
    __syncthreads();
    bf16_t* E = (bf16_t*)(p.ws + WS_SW + (size_t)l * SW_STRIDE + SW_S5E) + (size_t)g * 256 * 256;
    bf16_t* W2 = (bf16_t*)(p.ws + WS_SW + (size_t)l * SW_STRIDE + SW_S5W2) + (size_t)g * 256 * 512;
    for (int i = tid; i < 256 * 256; i += NTHR) { const int k = i & 255, n = i >> 8; const int s = k >> 4, h = k & 15, d = n >> 7, part = (n >> 6) & 1, pp = n & 63;
        const int e = d == 0 ? 15 - s : s; const lf2 w = pw[(d * 17 + e) * 64 + pp], b = bb[(d * 64 + pp) * 16 + h];
        E[i] = f2bf(part ? (w.x * b.y + w.y * b.x) : (w.x * b.x - w.y * b.y)); }
    for (int i = tid; i < 256 * 512; i += NTHR) { const int k = i & 511, n = i >> 9; const int t = n >> 4, h = n & 15; float v;
        if (k < 256) { const int s = k >> 4, h2 = k & 15; v = 0.f;
            if (t >= s) v += KT[((0 * 16 + (t - s)) * 16 + h) * 16 + h2];
            if (s >= t) v += KT[((1 * 16 + (s - t)) * 16 + h) * 16 + h2];
            if (s == t && h == h2) v += p.in[16][l * 256 + g * 16 + h]; }
        else { const int q = k - 256, d = q >> 7, part = (q >> 6) & 1, pp = q & 63; const int e = d == 0 ? t + 1 : 16 - t;
            const lf2 c = cc[(d * 16 + h) * 64 + pp], w = pw[(d * 17 + e) * 64 + pp];
            v = part ? -(c.x * w.y + c.y * w.x) : (c.x * w.x - c.y * w.y); }
        W2[i] = f2bf(v); }
    __syncthreads();
}

__device__ __forceinline__ void smallw_item(const Params& p, int item) {
    int i = item * NTHR + threadIdx.x; const int l = i / 212992; i %= 212992;
    unsigned char* sw = p.ws + WS_SW + (size_t)l * SW_STRIDE;
    if (i < 49152) { const int k = i & 63, n = (i >> 6) % 384, d = i / 24576; ((bf16_t*)(sw + SW_W2T))[i] = f2bf(p.in[22][((size_t)(l * 2 + d) * 64 + k) * 384 + n]); return; }
    i -= 49152;
    if (i < 49152) { const int k = i & 63, n = (i >> 6) % 384, d = i / 24576; ((bf16_t*)(sw + SW_A2T))[i] = f2bf(p.in[24][((size_t)(l * 2 + d) * 64 + k) * 384 + n]); return; }
    i -= 49152;
    if (i < 49152) { const int k = i & 127, n = i >> 7; ((bf16_t*)(sw + SW_G2T))[i] = f2bf(p.in[25][((size_t)l * 128 + k) * 384 + n]); return; }
    i -= 49152;
    { const int k = i & 255, n = i >> 8; ((bf16_t*)(sw + SW_GLUT))[i] = f2bf(p.in[17][((size_t)l * 256 + k) * 256 + n]); }
}

constexpr int PRO_MOD = 192, PRO_S5 = 32, PRO_SW = 832;
__device__ __forceinline__ void phase_prologue(const Params& p, LAS unsigned char* lds) {
    for (int it = blockIdx.x; it < PRO_MOD + PRO_S5 + PRO_SW; it += gridDim.x) {
        if (it < PRO_MOD) mod_item(p, it, lds);
        else if (it < PRO_MOD + PRO_S5) s5mat_item(p, it - PRO_MOD, lds);
        else smallw_item(p, it - PRO_MOD - PRO_S5);
    }
    convert_weights(p, 0, lds, (int)blockIdx.x, (int)gridDim.x);
}

__device__ __forceinline__ void hnorm_row(const float* src, const float* g, const float* mb_sh, const float* mb_sc, bf16_t* dst, int lane, const float4 (&v)[4]) {
    float ss = 0.f;
#pragma unroll
    for (int i = 0; i < 4; ++i) ss += v[i].x * v[i].x + v[i].y * v[i].y + v[i].z * v[i].z + v[i].w * v[i].w;
    ss = wave_sum(ss); const float rs = rsqrtf(ss * (1.0f / 1024.0f) + 1e-6f);
#pragma unroll
    for (int i = 0; i < 4; ++i) { const int c = i * 256 + lane * 4; const float4 gg = *(const float4*)(g + c), sh = *(const float4*)(mb_sh + c), sc = *(const float4*)(mb_sc + c);
        u32x2 o; o.x = pack2(v[i].x * rs * gg.x * (1.f + sc.x) + sh.x, v[i].y * rs * gg.y * (1.f + sc.y) + sh.y);
        o.y = pack2(v[i].z * rs * gg.z * (1.f + sc.z) + sh.z, v[i].w * rs * gg.w * (1.f + sc.w) + sh.w);
        *(u32x2*)(dst + c) = o; }
    (void)src;
}
__device__ __forceinline__ void phase_hnorm(const Params& p, int l, const float* xl, const float* xc) {
    const int lane = threadIdx.x & 63, wv = threadIdx.x >> 6;
    const float* mod = (const float*)(p.ws + WS_MOD) + (size_t)l * 17 * 6144; const float* g = p.in[6] + (l * 4 + 0) * 1024;
    bf16_t* A = (bf16_t*)(p.ws + WS_ABUF);
    for (int r = blockIdx.x * 8 + wv; r < NROW; r += gridDim.x * 8) {
        const float* src = xrow(xl, xc, r); const int b = r < NLAT ? (r >> 11) : 16; const float* mb = mod + (size_t)b * 6144;
        float4 v[4];
#pragma unroll
        for (int i = 0; i < 4; ++i) v[i] = *(const float4*)(src + i * 256 + lane * 4);
        hnorm_row(src, g, mb, mb + 1024, A + (size_t)r * 1024, lane, v);
    }
}

__device__ __forceinline__ void phase_prep(const Params& p, int l, LAS unsigned char* lds) {
    LAS bf16_t* vt = (LAS bf16_t*)lds;
    LAS lf2* cs = (LAS lf2*)(lds + 50176);
    const int tid = threadIdx.x;
    for (int i = tid; i < 1024; i += NTHR) { const int pos = i >> 4, j = i & 15; const float invf = exp2f(-(float)j * (13.287712379549449f / 16.0f)); float s, c; sincosf((float)pos * invf, &s, &c); cs[i] = (lf2){c, s}; }
    __syncthreads();
    const bf16_t* P = (const bf16_t*)(p.ws + U_P);
    bf16_t* QR = (bf16_t*)(p.ws + U_QR); bf16_t* KR = (bf16_t*)(p.ws + U_KR);
    bf16_t* RS = (bf16_t*)(p.ws + U_RS); bf16_t* KS = (bf16_t*)(p.ws + U_KS); bf16_t* VS = (bf16_t*)(p.ws + U_VS); bf16_t* KK = (bf16_t*)(p.ws + U_KK); bf16_t* ALR = (bf16_t*)(p.ws + U_ALR);
    for (int ti = blockIdx.x; ti < NROW / 64; ti += gridDim.x) {
        const int r0 = ti * 64; const bool lat = r0 < NLAT; const int b = lat ? (r0 >> 11) : ((r0 - NLAT) >> 8), t0 = lat ? (r0 & 2047) : ((r0 - NLAT) & 255), slen = lat ? SEQ : CTXL;
#pragma unroll
        for (int i = 0; i < 6; ++i) { const int idx = tid + NTHR * i, tok = idx / 48, pc = idx % 48;
            *(LAS lu4*)(vt + tok * 392 + pc * 8) = *(const lu4*)(P + (size_t)(r0 + tok) * NINP + C_V + pc * 8); }
        __syncthreads();
        { bf16_t* vdst = lat ? (bf16_t*)(p.ws + U_VT) + (size_t)b * 384 * 2048 + t0 : (bf16_t*)(p.ws + U_VTC) + (size_t)b * 384 * 256 + t0;
#pragma unroll
          for (int i = 0; i < 6; ++i) { const int idx = tid + NTHR * i, hd = idx >> 3, pc = idx & 7; unsigned w[4];
#pragma unroll
              for (int j = 0; j < 4; ++j) w[j] = (unsigned)vt[(pc * 8 + 2 * j) * 392 + hd] | ((unsigned)vt[(pc * 8 + 2 * j + 1) * 392 + hd] << 16);
              *(uint4*)(vdst + (size_t)hd * slen + pc * 8) = make_uint4(w[0], w[1], w[2], w[3]); } }
#pragma unroll
        for (int i = 0; i < 6; ++i) { const int idx = tid + NTHR * i, tok = idx / 48, rem = idx % 48, qk = rem / 24, rem2 = rem % 24, h = rem2 >> 2, pp = rem2 & 3;
            const int d1 = (pp >> 1) * 32 + (pp & 1) * 8; const size_t so = (size_t)(r0 + tok) * NINP + (qk ? C_K : C_Q) + h * 64 + d1;
            float x1[8], x2[8], o1[8], o2[8]; unpack8(*(const uint4*)(P + so), x1); unpack8(*(const uint4*)(P + so + 16), x2);
            const int t = t0 + tok, pos = (pp < 2) ? (t >> 6) : (t & 63), j0 = (pp & 1) * 8; const float scl = qk ? 1.0f : 0.125f;
#pragma unroll
            for (int j = 0; j < 8; ++j) { lf2 c = cs[pos * 16 + j0 + j]; if (!lat) c = (lf2){1.f, 0.f}; o1[j] = (x1[j] * c.x - x2[j] * c.y) * scl; o2[j] = (x1[j] * c.y + x2[j] * c.x) * scl; }
            bf16_t* dq = (qk ? KR : QR) + (size_t)(r0 + tok) * 384 + h * 64 + d1; *(uint4*)dq = pack8(o1); *(uint4*)(dq + 16) = pack8(o2); }
        for (int i = 0; i < 24; ++i) { const int idx = tid + NTHR * i, tok = idx / 192, pc = idx % 192, c0 = pc * 8, r = r0 + tok, t = t0 + tok;
            const bf16_t* zp = P + (size_t)r * NINP + C_Z + c0; float x[8], pv[8], nx[8], zs[8];
            unpack8(*(const uint4*)zp, x);
            if (t > 0) unpack8(*(const uint4*)(zp - NINP), pv); else {
#pragma unroll
                for (int j = 0; j < 8; ++j) pv[j] = 0.f; }
            if (t < slen - 1) unpack8(*(const uint4*)(zp + NINP), nx); else {
#pragma unroll
                for (int j = 0; j < 8; ++j) nx[j] = 0.f; }
            const float4 mu0 = *(const float4*)(p.in[20] + l * 1536 + c0), mu1 = *(const float4*)(p.in[20] + l * 1536 + c0 + 4); const float mu[8] = {mu0.x, mu0.y, mu0.z, mu0.w, mu1.x, mu1.y, mu1.z, mu1.w};
#pragma unroll
            for (int j = 0; j < 8; ++j) zs[j] = x[j] + (0.5f * (pv[j] + nx[j]) - x[j]) * mu[j];
            const bool isk = c0 >= 384 && c0 < 768; float kv[8]; float ss = 0.f;
            { const int kc = isk ? c0 - 384 : 0; const float4 k0 = *(const float4*)(p.in[26] + l * 384 + kc), k1 = *(const float4*)(p.in[26] + l * 384 + kc + 4); const float kkw[8] = {k0.x, k0.y, k0.z, k0.w, k1.x, k1.y, k1.z, k1.w};
#pragma unroll
              for (int j = 0; j < 8; ++j) { kv[j] = zs[j] * kkw[j]; ss += kv[j] * kv[j]; } }
            ss += __shfl_xor(ss, 1); ss += __shfl_xor(ss, 2); ss += __shfl_xor(ss, 4);
            if (c0 < 384) *(uint4*)(RS + (size_t)r * 384 + c0) = pack8(zs);
            else if (c0 < 768) { *(uint4*)(KS + (size_t)r * 384 + c0 - 384) = pack8(zs); const float inv = 1.0f / fmaxf(sqrtf(ss), 1e-12f);
#pragma unroll
                for (int j = 0; j < 8; ++j) kv[j] *= inv;
                *(uint4*)(KK + (size_t)r * 384 + c0 - 384) = pack8(kv); }
            else if (c0 < 1152) *(uint4*)(VS + (size_t)r * 384 + c0 - 768) = pack8(zs);
            else { const int ac = c0 - 1152; float o[8];
#pragma unroll
                for (int j = 0; j < 8; ++j) o[j] = ac < 128 ? 1.0f - 2.0f / (1.0f + __expf(2.0f * zs[j])) : (ac < 256 ? zs[j] : sigm(zs[j]));
                *(uint4*)(ALR + (size_t)r * 384 + ac) = pack8(o); }
        }
        __syncthreads();
    }
}

template <int KS, int MODE> __device__ __forceinline__ void lr_wave(const Params& p, int l, int row0, int kofs, const bf16_t* Bt, int d) {
    const int lane = threadIdx.x & 63, m = lane & 15, q = lane >> 4;
    const bf16_t* Ap = (const bf16_t*)(p.ws + U_ALR) + (size_t)(row0 + m) * 384 + kofs + q * 8;
    bf16x8 a[KS];
#pragma unroll
    for (int ks = 0; ks < KS; ++ks) a[ks] = *(const bf16x8*)(Ap + ks * 32);
    bf16_t* O = (bf16_t*)(p.ws + (MODE == 0 ? U_LD + (size_t)d * SZ384 : (MODE == 1 ? U_AG + (size_t)d * SZ384 : U_G))) + (size_t)(row0 + m) * 384;
    const float* bias = MODE == 0 ? p.in[21] + (l * 2 + d) * 384 : p.in[23] + (l * 2 + d) * 384;
    for (int nt = 0; nt < 24; ++nt) {
        f32x4 acc = (f32x4){0.f, 0.f, 0.f, 0.f};
#pragma unroll
        for (int ks = 0; ks < KS; ++ks) { const bf16x8 bfr = *(const bf16x8*)(Bt + (size_t)(nt * 16 + m) * (KS * 32) + ks * 32 + q * 8); acc = mfma16(bfr, a[ks], acc); }
        const int n = nt * 16 + q * 4; float o[4];
        if (MODE == 2) {
#pragma unroll
            for (int j = 0; j < 4; ++j) o[j] = acc[j];
        } else { const float4 bv = *(const float4*)(bias + n); const float bb[4] = {bv.x, bv.y, bv.z, bv.w};
#pragma unroll
            for (int j = 0; j < 4; ++j) { const float s = sigm(bb[j] + acc[j]); o[j] = MODE == 0 ? -0.6065306597f * s : s; } }
        u32x2 w; w.x = pack2(o[0], o[1]); w.y = pack2(o[2], o[3]); *(u32x2*)(O + n) = w;
    }
}
__device__ __forceinline__ void lowrank_items(const Params& p, int l, int wid, int nw) {
    const unsigned char* sw = p.ws + WS_SW + (size_t)l * SW_STRIDE;
    for (int it = wid; it < 2304 * 5; it += nw) { const int rt = it / 5, m = it % 5, row0 = rt * 16;
        if (m < 2) lr_wave<2, 0>(p, l, row0, m * 64, (const bf16_t*)(sw + SW_W2T) + (size_t)m * 384 * 64, m);
        else if (m < 4) lr_wave<2, 1>(p, l, row0, m * 64, (const bf16_t*)(sw + SW_A2T) + (size_t)(m - 2) * 384 * 64, m - 2);
        else lr_wave<4, 2>(p, l, row0, 256, (const bf16_t*)(sw + SW_G2T), 0); }
}

__device__ __forceinline__ int s5_rowbase(int cr) { const int b = cr / 144, c = cr % 144; return c < 16 ? NLAT + b * 256 + c * 16 : b * 2048 + (c - 16) * 16; }
__device__ __forceinline__ void s5_pass1_items(const Params& p, int l, int wid, int nw) {
    const int lane = threadIdx.x & 63, m = lane & 15, q = lane >> 4;
    const bf16_t* P = (const bf16_t*)(p.ws + U_P); float* SLOC = (float*)(p.ws + U_SLOC);
    for (int it = wid; it < 144 * 16; it += nw) { const int ct = it >> 4, g = it & 15, cr = ct * 16 + m, rb = s5_rowbase(cr);
        const bf16_t* E = (const bf16_t*)(p.ws + WS_SW + (size_t)l * SW_STRIDE + SW_S5E) + (size_t)g * 256 * 256;
        bf16x8 a[8];
#pragma unroll
        for (int ks = 0; ks < 8; ++ks) a[ks] = *(const bf16x8*)(P + (size_t)(rb + 2 * ks + (q >> 1)) * NINP + g * 16 + (q & 1) * 8);
        float* o = SLOC + ((size_t)cr * 16 + g) * 256 + q * 4;
#pragma unroll 2
        for (int nt = 0; nt < 16; ++nt) { f32x4 acc = (f32x4){0.f, 0.f, 0.f, 0.f}; const bf16_t* ep = E + (size_t)(nt * 16 + m) * 256 + q * 8;
#pragma unroll
            for (int ks = 0; ks < 8; ++ks) acc = mfma16(*(const bf16x8*)(ep + ks * 32), a[ks], acc);
            *(f32x4*)(o + nt * 16) = acc; }
    }
}
__device__ __forceinline__ void s5_carry(const Params& p, int l) {
    const int gid = blockIdx.x * NTHR + threadIdx.x; if (gid >= 32768) return;
    const int pp = gid & 63, d = (gid >> 6) & 1, g = (gid >> 7) & 15, b = gid >> 11;
    const int li = ((l * 2 + d) * 16 + g) * 64 + pp; const float lr = p.in[9][li], lim = p.in[10][li], dt = expf(p.in[11][(l * 2 + d) * 16 + g]);
    const float mag = expf(16.0f * dt * lr); float sn, cn; sincosf(16.0f * dt * lim, &sn, &cn); const float ar = mag * cn, ai = mag * sn;
    const float* SLOC = (const float*)(p.ws + U_SLOC); bf16_t* SP = (bf16_t*)(p.ws + U_SPREV);
    float sr = 0.f, si = 0.f;
#pragma unroll 8
    for (int n = 0; n < 144; ++n) { const int c = d == 0 ? n : (n < 16 ? 15 - n : 159 - n); const size_t idx = ((size_t)(b * 144 + c) * 16 + g) * 256 + d * 128 + pp;
        SP[idx] = f2bf(sr); SP[idx + 64] = f2bf(si);
        const float xr = SLOC[idx], xi = SLOC[idx + 64]; const float nr = ar * sr - ai * si + xr, ni = ar * si + ai * sr + xi; sr = nr; si = ni; }
}
__device__ __forceinline__ void s5_pass2_items(const Params& p, int l, int wid, int nw) {
    const int lane = threadIdx.x & 63, m = lane & 15, q = lane >> 4;
    const bf16_t* P = (const bf16_t*)(p.ws + U_P); const bf16_t* SP = (const bf16_t*)(p.ws + U_SPREV); bf16_t* YG = (bf16_t*)(p.ws + U_YG);
    for (int it = wid; it < 144 * 16; it += nw) { const int ct = it >> 4, g = it & 15; if (l == 1 && ct % 9 == 0) continue;
        const int cr = ct * 16 + m, rb = s5_rowbase(cr);
        const bf16_t* W2 = (const bf16_t*)(p.ws + WS_SW + (size_t)l * SW_STRIDE + SW_S5W2) + (size_t)g * 256 * 512;
        bf16x8 a[16];
#pragma unroll
        for (int ks = 0; ks < 8; ++ks) a[ks] = *(const bf16x8*)(P + (size_t)(rb + 2 * ks + (q >> 1)) * NINP + g * 16 + (q & 1) * 8);
#pragma unroll
        for (int ks = 8; ks < 16; ++ks) a[ks] = *(const bf16x8*)(SP + ((size_t)cr * 16 + g) * 256 + (ks - 8) * 32 + q * 8);
#pragma unroll 2
        for (int nt = 0; nt < 16; ++nt) { f32x4 acc = (f32x4){0.f, 0.f, 0.f, 0.f}; const bf16_t* wp = W2 + (size_t)(nt * 16 + m) * 512 + q * 8;
#pragma unroll
            for (int ks = 0; ks < 16; ++ks) acc = mfma16(*(const bf16x8*)(wp + ks * 32), a[ks], acc);
            float o[4];
#pragma unroll
            for (int j = 0; j < 4; ++j) { const float x = acc[j]; const float u = 0.7978845608f * (x + 0.044715f * x * x * x); const float th = 1.0f - 2.0f / (1.0f + __expf(2.0f * u)); o[j] = 0.5f * x * (1.0f + th); }
            u32x2 w; w.x = pack2(o[0], o[1]); w.y = pack2(o[2], o[3]); *(u32x2*)(YG + (size_t)(rb + nt) * 256 + g * 16 + q * 4) = w; }
    }
}
__device__ __forceinline__ void s5_glu_items(const Params& p, int l, int wid, int nw) {
    const int lane = threadIdx.x & 63, m = lane & 15, q = lane >> 4;
    const bf16_t* YG = (const bf16_t*)(p.ws + U_YG); bf16_t* YC = (bf16_t*)(p.ws + WS_ABUF);
    const bf16_t* GT = (const bf16_t*)(p.ws + WS_SW + (size_t)l * SW_STRIDE + SW_GLUT);
    const int nrt = (l == 0 ? NROW : NLAT) / 16;
    for (int rt = wid; rt < nrt; rt += nw) { const int row = rt * 16 + m;
        bf16x8 a[8];
#pragma unroll
        for (int ks = 0; ks < 8; ++ks) a[ks] = *(const bf16x8*)(YG + (size_t)row * 256 + ks * 32 + q * 8);
#pragma unroll 2
        for (int nt = 0; nt < 16; ++nt) { f32x4 acc = (f32x4){0.f, 0.f, 0.f, 0.f}; const bf16_t* gp = GT + (size_t)(nt * 16 + m) * 256 + q * 8;
#pragma unroll
            for (int ks = 0; ks < 8; ++ks) acc = mfma16(*(const bf16x8*)(gp + ks * 32), a[ks], acc);
            const int n = nt * 16 + q * 4; const float4 bv = *(const float4*)(p.in[18] + l * 256 + n); const u32x2 yw = *(const u32x2*)(YG + (size_t)row * 256 + n);
            u32x2 w; w.x = pack2(bflo(yw.x) * sigm(acc[0] + bv.x), bfhi(yw.x) * sigm(acc[1] + bv.y)); w.y = pack2(bflo(yw.y) * sigm(acc[2] + bv.z), bfhi(yw.y) * sigm(acc[3] + bv.w));
            *(u32x2*)(YC + (size_t)row * 1024 + n) = w; }
    }
}

template <bool HASLAT> __device__ __forceinline__ void na_unit(const Params& p, int l, int b, int h, int i, int n) {
    const int lane = threadIdx.x & 63, m = lane & 15, q = lane >> 4;
    const bf16_t* QR = (const bf16_t*)(p.ws + U_QR); const bf16_t* KR = (const bf16_t*)(p.ws + U_KR);
    const bf16_t* VTL = (const bf16_t*)(p.ws + U_VT) + (size_t)(b * 6 + h) * 64 * 2048; const bf16_t* VTC = (const bf16_t*)(p.ws + U_VTC) + (size_t)(b * 6 + h) * 64 * 256;
    const int qrow = HASLAT ? b * 2048 + i * 64 + n * 16 + m : NLAT + b * 256 + n * 16 + m;
    bf16x8 qf[2];
#pragma unroll
    for (int ks = 0; ks < 2; ++ks) qf[ks] = *(const bf16x8*)(QR + (size_t)qrow * 384 + h * 64 + ks * 32 + q * 8);
    const int r0 = HASLAT ? min(max(i - 4, 0), 24) : 0, scol = HASLAT ? min(max(n * 16 - 8, 0), 32) : 0;
    f32x4 sl[HASLAT ? 16 : 1], sc[16];
    float mx = -3.0e38f;
    if (HASLAT) { const int qc = n * 16 + m, c0 = min(max(qc - 8, 0), 48); const float* rpb = p.in[19] + (size_t)(l * 6 + h) * 15 * 31;
#pragma unroll
        for (int t = 0; t < 16; ++t) { const int kr = t >> 1, ch = t & 1; const bf16_t* kp = KR + (size_t)(b * 2048 + (r0 + kr) * 64 + scol + ch * 16 + m) * 384 + h * 64 + q * 8;
            f32x4 acc = (f32x4){0.f, 0.f, 0.f, 0.f};
#pragma unroll
            for (int ks = 0; ks < 2; ++ks) acc = mfma16(*(const bf16x8*)(kp + ks * 32), qf[ks], acc);
            const int dr = r0 + kr - i + 7;
#pragma unroll
            for (int j = 0; j < 4; ++j) { const int kc = scol + ch * 16 + q * 4 + j; const bool valid = kc >= c0 && kc < c0 + 16; const int dc = min(max(kc - qc + 15, 0), 30);
                const float s = valid ? acc[j] + rpb[dr * 31 + dc] : -1.0e30f; acc[j] = s; mx = fmaxf(mx, s); }
            sl[t] = acc; } }
#pragma unroll
    for (int t = 0; t < 16; ++t) { const bf16_t* kp = KR + (size_t)(NLAT + b * 256 + t * 16 + m) * 384 + h * 64 + q * 8;
        f32x4 acc = (f32x4){0.f, 0.f, 0.f, 0.f};
#pragma unroll
        for (int ks = 0; ks < 2; ++ks) acc = mfma16(*(const bf16x8*)(kp + ks * 32), qf[ks], acc);
#pragma unroll
        for (int j = 0; j < 4; ++j) mx = fmaxf(mx, acc[j]);
        sc[t] = acc; }
    mx = fmaxf(mx, __shfl_xor(mx, 16)); mx = fmaxf(mx, __shfl_xor(mx, 32));
    float sum = 0.f;
    f32x4 o[4];
#pragma unroll
    for (int dt = 0; dt < 4; ++dt) o[dt] = (f32x4){0.f, 0.f, 0.f, 0.f};
    if (HASLAT) {
#pragma unroll
        for (int kr = 0; kr < 8; ++kr) { float e[8];
#pragma unroll
            for (int j = 0; j < 4; ++j) { e[j] = __expf(sl[2 * kr][j] - mx); e[4 + j] = __expf(sl[2 * kr + 1][j] - mx); }
#pragma unroll
            for (int j = 0; j < 8; ++j) sum += e[j];
            const uint4 pw = pack8(e); const bf16x8 pf = __builtin_bit_cast(bf16x8, pw);
            const int tok = (r0 + kr) * 64 + scol + q * 4;
#pragma unroll
            for (int dt = 0; dt < 4; ++dt) { const bf16_t* vp = VTL + (size_t)(dt * 16 + m) * 2048 + tok; const u32x2 v0 = *(const u32x2*)vp, v1 = *(const u32x2*)(vp + 16);
                const uint4 vw = make_uint4(v0.x, v0.y, v1.x, v1.y); o[dt] = mfma16(__builtin_bit_cast(bf16x8, vw), pf, o[dt]); } } }
#pragma unroll
    for (int t2 = 0; t2 < 8; ++t2) { float e[8];
#pragma unroll
        for (int j = 0; j < 4; ++j) { e[j] = __expf(sc[2 * t2][j] - mx); e[4 + j] = __expf(sc[2 * t2 + 1][j] - mx); }
#pragma unroll
        for (int j = 0; j < 8; ++j) sum += e[j];
        const uint4 pw = pack8(e); const bf16x8 pf = __builtin_bit_cast(bf16x8, pw);
        const int tok = t2 * 32 + q * 4;
#pragma unroll
        for (int dt = 0; dt < 4; ++dt) { const bf16_t* vp = VTC + (size_t)(dt * 16 + m) * 256 + tok; const u32x2 v0 = *(const u32x2*)vp, v1 = *(const u32x2*)(vp + 16);
            const uint4 vw = make_uint4(v0.x, v0.y, v1.x, v1.y); o[dt] = mfma16(__builtin_bit_cast(bf16x8, vw), pf, o[dt]); } }
    sum += __shfl_xor(sum, 16); sum += __shfl_xor(sum, 32);
    const float inv = 1.0f / sum;
    bf16_t* yo = (bf16_t*)(p.ws + WS_ABUF) + (size_t)qrow * 1024 + 256 + h * 64 + q * 4;
#pragma unroll
    for (int dt = 0; dt < 4; ++dt) { u32x2 w; w.x = pack2(o[dt][0] * inv, o[dt][1] * inv); w.y = pack2(o[dt][2] * inv, o[dt][3] * inv); *(u32x2*)(yo + dt * 16) = w; }
}
__device__ __forceinline__ void na_items(const Params& p, int l, int wid, int nw) {
    const int nlat = 16 * 6 * 32 * 4, nctx = (l == 0) ? 16 * 6 * 16 : 0;
    for (int it = wid; it < nlat + nctx; it += nw) {
        if (it < nlat) { const int n = it & 3, i = (it >> 2) & 31, bh = it >> 7; na_unit<true>(p, l, bh / 6, bh % 6, i, n); }
        else { const int j = it - nlat, n = j & 15, bh = j >> 4; na_unit<false>(p, l, bh / 6, bh % 6, 0, n); }
    }
}

__device__ __forceinline__ int rk_row(int b, int d, int n) { return n < 256 ? NLAT + b * 256 + (d ? 255 - n : n) : b * 2048 + (d ? 2047 - (n - 256) : (n - 256)); }
__device__ __forceinline__ void rwkv_scan_unit(const Params& p, int l, int unit, LAS unsigned char* lds) {
    const int tid = threadIdx.x, b = unit / 12, h = (unit % 12) >> 1, d = unit & 1;
    const int i = tid >> 3, q = tid & 7, j = tid & 63;
    LAS float* buf = (LAS float*)lds;
    const bf16_t* RS = (const bf16_t*)(p.ws + U_RS); const bf16_t* KS = (const bf16_t*)(p.ws + U_KS); const bf16_t* VS = (const bf16_t*)(p.ws + U_VS); const bf16_t* KK = (const bf16_t*)(p.ws + U_KK);
    const bf16_t* AG = (const bf16_t*)(p.ws + U_AG + (size_t)d * SZ384); const bf16_t* LD = (const bf16_t*)(p.ws + U_LD + (size_t)d * SZ384);
    float* Y = (float*)(p.ws + U_YRK) + (size_t)d * NROW * 384;
    const float ka = p.in[27][l * 384 + h * 64 + j];
    float S[8];
#pragma unroll
    for (int k = 0; k < 8; ++k) S[k] = 0.f;
    bf16_t st[4][6];
#define RK_LOAD(cn) do { _Pragma("unroll") for (int k = 0; k < 4; ++k) { const int sx = (tid >> 6) + 8 * k; const size_t o = (size_t)rk_row(b, d, (cn) * 32 + sx) * 384 + h * 64 + j; \
        st[k][0] = RS[o]; st[k][1] = KS[o]; st[k][2] = VS[o]; st[k][3] = KK[o]; st[k][4] = AG[o]; st[k][5] = LD[o]; } } while (0)
#define RK_STORE(nb) do { _Pragma("unroll") for (int k = 0; k < 4; ++k) { const int sx = (tid >> 6) + 8 * k; LAS float* o = buf + ((nb) * 32 + sx) * 384 + j; \
        const float r_ = bf2f(st[k][0]), k_ = bf2f(st[k][1]), v_ = bf2f(st[k][2]), kk_ = bf2f(st[k][3]), ag_ = bf2f(st[k][4]), ld_ = bf2f(st[k][5]); \
        o[0] = __expf(ld_); o[64] = k_ * (1.0f + (ag_ - 1.0f) * ka); o[128] = kk_ * ag_; o[192] = -kk_; o[256] = r_; o[320] = v_; } } while (0)
    __syncthreads();
    RK_LOAD(0); RK_STORE(0);
    __syncthreads();
    for (int cn = 0; cn < 72; ++cn) {
        if (cn + 1 < 72) RK_LOAD(cn + 1);
        const LAS float* cb = buf + (cn & 1) * 32 * 384;
        for (int s = 0; s < 32; ++s) { const LAS float* o = cb + s * 384 + q * 8;
            const lf4 w0 = *(const LAS lf4*)(o), w1 = *(const LAS lf4*)(o + 4), k0 = *(const LAS lf4*)(o + 64), k1 = *(const LAS lf4*)(o + 68), b0 = *(const LAS lf4*)(o + 128), b1 = *(const LAS lf4*)(o + 132);
            const lf4 a0 = *(const LAS lf4*)(o + 192), a1 = *(const LAS lf4*)(o + 196), r0 = *(const LAS lf4*)(o + 256), r1 = *(const LAS lf4*)(o + 260);
            const float vi = cb[s * 384 + 320 + i];
            float sa = S[0] * a0.x + S[1] * a0.y + S[2] * a0.z + S[3] * a0.w + S[4] * a1.x + S[5] * a1.y + S[6] * a1.z + S[7] * a1.w;
            sa += __shfl_xor(sa, 1); sa += __shfl_xor(sa, 2); sa += __shfl_xor(sa, 4);
            S[0] = S[0] * w0.x + (sa * b0.x + vi * k0.x); S[1] = S[1] * w0.y + (sa * b0.y + vi * k0.y); S[2] = S[2] * w0.z + (sa * b0.z + vi * k0.z); S[3] = S[3] * w0.w + (sa * b0.w + vi * k0.w);
            S[4] = S[4] * w1.x + (sa * b1.x + vi * k1.x); S[5] = S[5] * w1.y + (sa * b1.y + vi * k1.y); S[6] = S[6] * w1.z + (sa * b1.z + vi * k1.z); S[7] = S[7] * w1.w + (sa * b1.w + vi * k1.w);
            float y = S[0] * r0.x + S[1] * r0.y + S[2] * r0.z + S[3] * r0.w + S[4] * r1.x + S[5] * r1.y + S[6] * r1.z + S[7] * r1.w;
            y += __shfl_xor(y, 1); y += __shfl_xor(y, 2); y += __shfl_xor(y, 4);
            if (q == 0) Y[(size_t)rk_row(b, d, cn * 32 + s) * 384 + h * 64 + i] = y; }
        if (cn + 1 < 72) RK_STORE((cn + 1) & 1);
        __syncthreads();
    }
#undef RK_LOAD
#undef RK_STORE
}

__device__ __forceinline__ void rwkv_finish(const Params& p, int l) {
    const int sub = threadIdx.x & 7; const int npair = (l == 0 ? NROW : NLAT) * 6;
    const bf16_t* RS = (const bf16_t*)(p.ws + U_RS); const bf16_t* KS = (const bf16_t*)(p.ws + U_KS); const bf16_t* VS = (const bf16_t*)(p.ws + U_VS);
    const bf16_t* AG0 = (const bf16_t*)(p.ws + U_AG); const bf16_t* AG1 = (const bf16_t*)(p.ws + U_AG + SZ384); const bf16_t* G = (const bf16_t*)(p.ws + U_G);
    const float* Y0 = (const float*)(p.ws + U_YRK); const float* Y1 = Y0 + (size_t)NROW * 384; bf16_t* YC = (bf16_t*)(p.ws + WS_ABUF);
    for (int pr = (blockIdx.x * NTHR + threadIdx.x) >> 3; pr < npair; pr += (gridDim.x * NTHR) >> 3) { const int row = pr / 6, h = pr % 6, col = h * 64 + sub * 8; const size_t o = (size_t)row * 384 + col;
        float y[8]; { const float4 a0 = *(const float4*)(Y0 + o), a1 = *(const float4*)(Y0 + o + 4), c0 = *(const float4*)(Y1 + o), c1 = *(const float4*)(Y1 + o + 4);
            y[0] = a0.x + c0.x; y[1] = a0.y + c0.y; y[2] = a0.z + c0.z; y[3] = a0.w + c0.w; y[4] = a1.x + c1.x; y[5] = a1.y + c1.y; y[6] = a1.z + c1.z; y[7] = a1.w + c1.w; }
        float s = 0.f;
#pragma unroll
        for (int k = 0; k < 8; ++k) s += y[k];
        s += __shfl_xor(s, 1); s += __shfl_xor(s, 2); s += __shfl_xor(s, 4); const float mean = s * (1.0f / 64.0f);
        float v2 = 0.f;
#pragma unroll
        for (int k = 0; k < 8; ++k) { const float dd = y[k] - mean; v2 += dd * dd; }
        v2 += __shfl_xor(v2, 1); v2 += __shfl_xor(v2, 2); v2 += __shfl_xor(v2, 4); const float rstd = rsqrtf(v2 * (1.0f / 64.0f) + 64e-5f);
        float r[8], kx[8], vx[8], a0[8], a1[8], gx[8];
        unpack8(*(const uint4*)(RS + o), r); unpack8(*(const uint4*)(KS + o), kx); unpack8(*(const uint4*)(VS + o), vx); unpack8(*(const uint4*)(AG0 + o), a0); unpack8(*(const uint4*)(AG1 + o), a1); unpack8(*(const uint4*)(G + o), gx);
        const float* ka = p.in[27] + l * 384 + col; const float* rk = p.in[28] + l * 384 + col; const float* lw = p.in[29] + l * 384 + col; const float* lb = p.in[30] + l * 384 + col;
        float bs = 0.f;
#pragma unroll
        for (int k = 0; k < 8; ++k) { const float kd0 = kx[k] * (1.0f + (a0[k] - 1.0f) * ka[k]), kd1 = kx[k] * (1.0f + (a1[k] - 1.0f) * ka[k]); bs += r[k] * (kd0 + kd1) * rk[k]; }
        bs += __shfl_xor(bs, 1); bs += __shfl_xor(bs, 2); bs += __shfl_xor(bs, 4);
        float ov[8];
#pragma unroll
        for (int k = 0; k < 8; ++k) ov[k] = ((y[k] - mean) * rstd * lw[k] + lb[k] + bs * vx[k]) * gx[k];
        *(uint4*)(YC + (size_t)row * 1024 + 640 + col) = pack8(ov);
    }
}

__device__ __forceinline__ void phase_normrouter(const Params& p, int l, const float* xl, const float* xc, LAS unsigned char* lds) {
    LAS float* rt = (LAS float*)lds;
    for (int i = threadIdx.x; i < 1024 * 16 / 4; i += NTHR) *(LAS lf4*)(rt + i * 4) = *(const lf4*)(p.in[31] + (size_t)l * 1024 * 16 + i * 4);
    __syncthreads();
    const int lane = threadIdx.x & 63, wv = threadIdx.x >> 6; const int nrow = l == 0 ? NROW : NLAT;
    const float* mod = (const float*)(p.ws + WS_MOD) + (size_t)l * 17 * 6144; const float* g1 = p.in[6] + (l * 4 + 1) * 1024; const float* g2 = p.in[6] + (l * 4 + 2) * 1024;
    const float* Y = (const float*)(p.ws + U_Y); bf16_t* A = (bf16_t*)(p.ws + WS_ABUF); float* AFF = (float*)(p.ws + WS_AFF);
    for (int r = blockIdx.x * 8 + wv; r < nrow; r += gridDim.x * 8) { const int b = r < NLAT ? (r >> 11) : 16; const float* mb = mod + (size_t)b * 6144;
        const float* xs = xrow(xl, xc, r); float* xd = xrow_w(p.out, (float*)(p.ws + WS_CTXA), r);
        float4 y[4], x[4]; float ss = 0.f;
#pragma unroll
        for (int i = 0; i < 4; ++i) { y[i] = *(const float4*)(Y + (size_t)r * 1024 + i * 256 + lane * 4); x[i] = *(const float4*)(xs + i * 256 + lane * 4); ss += y[i].x * y[i].x + y[i].y * y[i].y + y[i].z * y[i].z + y[i].w * y[i].w; }
        ss = wave_sum(ss); const float rs = rsqrtf(ss * (1.0f / 1024.0f) + 1e-6f);
        float s2 = 0.f;
#pragma unroll
        for (int i = 0; i < 4; ++i) { const int c = i * 256 + lane * 4; const float4 gg = *(const float4*)(g1 + c), gt = *(const float4*)(mb + 2048 + c);
            x[i].x += gt.x * (y[i].x * rs * gg.x); x[i].y += gt.y * (y[i].y * rs * gg.y); x[i].z += gt.z * (y[i].z * rs * gg.z); x[i].w += gt.w * (y[i].w * rs * gg.w);
            *(float4*)(xd + c) = x[i]; s2 += x[i].x * x[i].x + x[i].y * x[i].y + x[i].z * x[i].z + x[i].w * x[i].w; }
        s2 = wave_sum(s2); const float rs2 = rsqrtf(s2 * (1.0f / 1024.0f) + 1e-6f);
        LAS float* hr = (LAS float*)(lds + 65536) + wv * 1024;
#pragma unroll
        for (int i = 0; i < 4; ++i) { const int c = i * 256 + lane * 4; const float4 gg = *(const float4*)(g2 + c), sh = *(const float4*)(mb + 3072 + c), sc = *(const float4*)(mb + 4096 + c);
            const float hv[4] = {x[i].x * rs2 * gg.x * (1.f + sc.x) + sh.x, x[i].y * rs2 * gg.y * (1.f + sc.y) + sh.y, x[i].z * rs2 * gg.z * (1.f + sc.z) + sh.z, x[i].w * rs2 * gg.w * (1.f + sc.w) + sh.w};
            u32x2 o; o.x = pack2(hv[0], hv[1]); o.y = pack2(hv[2], hv[3]); *(u32x2*)(A + (size_t)r * 1024 + c) = o;
            *(LAS lf4*)(hr + c) = (lf4){hv[0], hv[1], hv[2], hv[3]}; }
        const int e = lane & 15, cq = lane >> 4; float lgt = 0.f;
#pragma unroll 4
        for (int c4 = 0; c4 < 64; ++c4) { const int c = cq * 256 + c4 * 4; const lf4 hv4 = *(const LAS lf4*)(hr + c);
            lgt += hv4.x * rt[c * 16 + e] + hv4.y * rt[(c + 1) * 16 + e] + hv4.z * rt[(c + 2) * 16 + e] + hv4.w * rt[(c + 3) * 16 + e]; }
        lgt += __shfl_xor(lgt, 16); lgt += __shfl_xor(lgt, 32);
        float mxl = lgt;
#pragma unroll
        for (int o = 8; o >= 1; o >>= 1) mxl = fmaxf(mxl, __shfl_xor(mxl, o));
        const float ex = expf(lgt - mxl); float den = ex;
#pragma unroll
        for (int o = 8; o >= 1; o >>= 1) den += __shfl_xor(den, o);
        if (lane < 16) AFF[(size_t)r * 16 + lane] = ex / den;
    }
}

__device__ __forceinline__ void phase_topk(const Params& p, int l, LAS unsigned char* lds) {
    LAS float* vals = (LAS float*)lds; LAS int* toks = (LAS int*)(lds + 8192);
    const int tid = threadIdx.x, nitem = l == 0 ? 512 : 256;
    const float* AFF = (const float*)(p.ws + WS_AFF); int* SLOT = (int*)(p.ws + WS_SLOT); float* SELG = (float*)(p.ws + WS_SELG);
    const bf16_t* A = (const bf16_t*)(p.ws + WS_ABUF); bf16_t* XS = (bf16_t*)(p.ws + U_XSEL);
    for (int it = blockIdx.x; it < nitem; it += gridDim.x) { const bool lat = it < 256; const int be = it & 255, b = be >> 4, e = be & 15;
        const int n = lat ? SEQ : CTXL, cap = lat ? 256 : 32, rowbase = lat ? b * 2048 : NLAT + b * 256, xoff = lat ? b * 256 : 4096 + b * 32;
        __syncthreads();
        for (int t = tid; t < n; t += NTHR) vals[t] = AFF[(size_t)(rowbase + t) * 16 + e];
        __syncthreads();
        for (int t = tid; t < n; t += NTHR) { const float v = vals[t]; int cnt = 0;
            for (int t2 = 0; t2 < n; t2 += 4) { const lf4 w = *(const LAS lf4*)(vals + t2);
                cnt += (w.x > v || (w.x == v && t2 < t)) ? 1 : 0; cnt += (w.y > v || (w.y == v && t2 + 1 < t)) ? 1 : 0; cnt += (w.z > v || (w.z == v && t2 + 2 < t)) ? 1 : 0; cnt += (w.w > v || (w.w == v && t2 + 3 < t)) ? 1 : 0; }
            if (cnt < cap) { SELG[e * XROWS + xoff + cnt] = v; toks[cnt] = t; SLOT[(size_t)(rowbase + t) * 16 + e] = cnt; } else SLOT[(size_t)(rowbase + t) * 16 + e] = -1; }
        __syncthreads();
        for (int s = tid >> 6; s < cap; s += 8) { const uint4* src = (const uint4*)(A + (size_t)(rowbase + toks[s]) * 1024); uint4* dst = (uint4*)(XS + ((size_t)e * XROWS + xoff + s) * 1024); const int lane = tid & 63;
            dst[lane] = src[lane]; dst[lane + 64] = src[lane + 64]; }
    }
}

struct GroupedOrder { int nMl, nNl, G, c, total;
    __device__ void init(int nMl_, int nNl_, int G_, int c_) { nMl = nMl_; nNl = nNl_; G = G_; c = c_; total = 16 * nMl_ * nNl_; }
    __device__ bool next(int i, pg8::Unit& u) const { const long L = (long)i * G + c; if (L >= total) return false; const int per = nMl * nNl, e = (int)(L / per), rem = (int)(L % per), pnl = rem / nMl, pml = rem % nMl;
        u.pm = e * 18 + pml; u.pn = e * nNl + pnl; return true; }
    __device__ __forceinline__ void a_ready(const pg8::Unit&) const {}
    __device__ __forceinline__ void done(const pg8::Unit&) const {}
};
struct EpiSwiGLU { static constexpr bool PERM = true, AFTER_DRAIN = false; bf16_t* H;
    __device__ __forceinline__ void operator()(const f32x4 (&acc)[2][2][4][2], const pg8::Unit& u, int wr, int wc, int fr, int fq) const {
        const int e = u.pn / 22, pnl = u.pn - e * 22; const int row0 = u.pm * 256 + wr * 64 + fr, col0 = pnl * 128 + wc * 32 + 8 * fq;
#pragma unroll
        for (int ai = 0; ai < 2; ++ai)
#pragma unroll
            for (int m = 0; m < 4; ++m) { bf16_t* rowp = H + (size_t)(row0 + ai * 128 + m * 16) * DE + col0; float o[8];
#pragma unroll
                for (int n = 0; n < 2; ++n)
#pragma unroll
                    for (int j = 0; j < 4; ++j) { const float g = acc[ai][0][m][n][j], uu = acc[ai][1][m][n][j]; o[n * 4 + j] = g * sigm(g) * uu; }
                *(uint4*)rowp = pack8(o); }
    }
};
struct EpiGate { static constexpr bool PERM = true, AFTER_DRAIN = false; bf16_t* O; const float* gate;
    __device__ __forceinline__ void operator()(const f32x4 (&acc)[2][2][4][2], const pg8::Unit& u, int wr, int wc, int fr, int fq) const {
        const int pnl = u.pn & 3; const int row0 = u.pm * 256 + wr * 64 + fr, col0 = pnl * 256 + wc * 32 + 8 * fq;
#pragma unroll
        for (int ai = 0; ai < 2; ++ai)
#pragma unroll
            for (int m = 0; m < 4; ++m) { const int r = row0 + ai * 128 + m * 16; const float gt = gate[r]; bf16_t* rowp = O + (size_t)r * 1024 + col0;
#pragma unroll
                for (int bj = 0; bj < 2; ++bj) { float o[8];
#pragma unroll
                    for (int n = 0; n < 2; ++n)
#pragma unroll
                        for (int j = 0; j < 4; ++j) o[n * 4 + j] = acc[ai][bj][m][n][j] * gt;
                    *(uint4*)(rowp + bj * 128) = pack8(o); } }
    }
};

__device__ __forceinline__ void phase_combine(const Params& p, int l) {
    const int lane = threadIdx.x & 63, wv = threadIdx.x >> 6; const int nrow = l == 0 ? NROW : NLAT;
    const float* mod = (const float*)(p.ws + WS_MOD) + (size_t)l * 17 * 6144; const float* g3 = p.in[6] + (l * 4 + 3) * 1024;
    const int* SLOT = (const int*)(p.ws + WS_SLOT); const bf16_t* YE = (const bf16_t*)(p.ws + U_YEXP); bf16_t* A = (bf16_t*)(p.ws + WS_ABUF);
    for (int r = blockIdx.x * 8 + wv; r < nrow; r += gridDim.x * 8) { const bool lat = r < NLAT; const int b = lat ? (r >> 11) : ((r - NLAT) >> 8), mbi = lat ? b : 16, xoff = lat ? b * 256 : 4096 + b * 32;
        const float* mb = mod + (size_t)mbi * 6144;
        float f[16];
#pragma unroll
        for (int k = 0; k < 16; ++k) f[k] = 0.f;
        const int myslot = lane < 16 ? SLOT[(size_t)r * 16 + lane] : -1;
        for (int e = 0; e < 16; ++e) { const int s = __shfl(myslot, e); if (s >= 0) { const bf16_t* yr = YE + ((size_t)e * XROWS + xoff + s) * 1024 + lane * 4;
#pragma unroll
                for (int i = 0; i < 4; ++i) { const u32x2 w = *(const u32x2*)(yr + i * 256); f[i * 4] += bflo(w.x); f[i * 4 + 1] += bfhi(w.x); f[i * 4 + 2] += bflo(w.y); f[i * 4 + 3] += bfhi(w.y); } } }
        float ss = 0.f;
#pragma unroll
        for (int k = 0; k < 16; ++k) ss += f[k] * f[k];
        ss = wave_sum(ss); const float rs = rsqrtf(ss * (1.0f / 1024.0f) + 1e-6f);
        const float* x1 = xrow(p.out, (const float*)(p.ws + WS_CTXA), r);
        float* x2 = l == 0 ? xrow_w((float*)(p.ws + WS_XB), (float*)(p.ws + WS_CTXB), r) : p.out + (size_t)r * D;
        float4 xv[4];
#pragma unroll
        for (int i = 0; i < 4; ++i) { const int c = i * 256 + lane * 4; const float4 gg = *(const float4*)(g3 + c), gt = *(const float4*)(mb + 5120 + c); float4 x = *(const float4*)(x1 + c);
            x.x += gt.x * (f[i * 4] * rs * gg.x); x.y += gt.y * (f[i * 4 + 1] * rs * gg.y); x.z += gt.z * (f[i * 4 + 2] * rs * gg.z); x.w += gt.w * (f[i * 4 + 3] * rs * gg.w);
            *(float4*)(x2 + c) = x; xv[i] = x; }
        if (l == 0) { const float* mb1 = mod + (size_t)17 * 6144 + (size_t)mbi * 6144; hnorm_row(nullptr, p.in[6] + 4 * 1024, mb1, mb1 + 1024, A + (size_t)r * 1024, lane, xv); }
    }
}

#ifndef MK_ONLY
#define MK_ONLY -1
#endif
#define EN(k) (MK_ONLY < 0 || MK_ONLY == (k))
constexpr int PH_PER_LAYER = 13, N_PHASES = 1 + 2 * PH_PER_LAYER;
#define IN(k) (lo <= (k) && (k) < hi)
#define SEAM(k) do { if (p.use_bar && IN(k) && IN((k) + 1)) xcd_barrier(bar); } while (0)
template <int l> __device__ __forceinline__ void layer_phases(const Params& p, LAS unsigned char* lds, const XcdBarrier& bar, const int lo, const int hi) {
    const int wv = __builtin_amdgcn_readfirstlane(threadIdx.x >> 6), G = gridDim.x; const int wid = blockIdx.x * 8 + wv, nw = G * 8;
        const int pb = 1 + l * PH_PER_LAYER;
        const float* xl = l == 0 ? p.in[0] : (const float*)(p.ws + WS_XB);
        const float* xc = l == 0 ? p.in[2] : (const float*)(p.ws + WS_CTXB);
        if (EN(0) && IN(pb + 0)) { if (l == 0) phase_hnorm(p, 0, xl, xc); }
        SEAM(pb + 0);
        if (EN(1) && IN(pb + 1)) { pg8::Gemm g{(const bf16_t*)(p.ws + WS_ABUF), (const bf16_t*)(p.ws + WS_WIN), NROW, NINP, D}; pg8::StaticOrder S; S.init(NROW, NINP, G, (int)blockIdx.x);
            pg8::EpiBf16<0> E{(bf16_t*)(p.ws + U_P), NINP, nullptr, 0, 0}; pg8::gemm_phase<pg8::EpiBf16<0>, pg8::StaticOrder, false>(lds, g, S, E, nullptr); }
        SEAM(pb + 1);
        if (EN(2) && IN(pb + 2)) phase_prep(p, l, lds);
        SEAM(pb + 2);
        if (EN(3) && IN(pb + 3)) { lowrank_items(p, l, wid, nw); s5_pass1_items(p, l, wid, nw); }
        SEAM(pb + 3);
        if (EN(4) && IN(pb + 4)) { s5_carry(p, l); na_items(p, l, wid, nw); }
        SEAM(pb + 4);
        if (EN(5) && IN(pb + 5)) {
            if (G > 192) { if ((int)blockIdx.x < 192) rwkv_scan_unit(p, l, blockIdx.x, lds); else s5_pass2_items(p, l, ((int)blockIdx.x - 192) * 8 + wv, (G - 192) * 8); }
            else { for (int u = blockIdx.x; u < 192; u += G) rwkv_scan_unit(p, l, u, lds); s5_pass2_items(p, l, wid, nw); }
        }
        SEAM(pb + 5);
        if (EN(6) && IN(pb + 6)) { s5_glu_items(p, l, wid, nw); rwkv_finish(p, l); }
        SEAM(pb + 6);
        if (EN(7) && IN(pb + 7)) { const int M = l == 0 ? NROW : NLAT; pg8::Gemm g{(const bf16_t*)(p.ws + WS_ABUF), (const bf16_t*)(p.ws + WS_WOUT), M, D, D}; pg8::StaticOrder S; S.init(M, D, G, (int)blockIdx.x);
            pg8::EpiF32 E{(float*)(p.ws + U_Y), D, nullptr}; pg8::gemm_phase<pg8::EpiF32, pg8::StaticOrder, false>(lds, g, S, E, nullptr); }
        SEAM(pb + 7);
        if (EN(8) && IN(pb + 8)) phase_normrouter(p, l, xl, xc, lds);
        SEAM(pb + 8);
        if (EN(9) && IN(pb + 9)) phase_topk(p, l, lds);
        SEAM(pb + 9);
        if (EN(10) && IN(pb + 10)) { pg8::Gemm g{(const bf16_t*)(p.ws + U_XSEL), (const bf16_t*)(p.ws + WS_WGU), 16 * XROWS, 16 * 5632, D}; GroupedOrder S; S.init(l == 0 ? 18 : 16, 22, G, (int)blockIdx.x);
            EpiSwiGLU E{(bf16_t*)(p.ws + U_HID)}; pg8::gemm_phase<EpiSwiGLU, GroupedOrder, false>(lds, g, S, E, nullptr); }
        SEAM(pb + 10);
        if (EN(11) && IN(pb + 11)) { pg8::Gemm g{(const bf16_t*)(p.ws + U_HID), (const bf16_t*)(p.ws + WS_WD), 16 * XROWS, 16 * 1024, DE}; GroupedOrder S; S.init(l == 0 ? 18 : 16, 4, G, (int)blockIdx.x);
            EpiGate E{(bf16_t*)(p.ws + U_YEXP), (const float*)(p.ws + WS_SELG)}; pg8::gemm_phase<EpiGate, GroupedOrder, false>(lds, g, S, E, nullptr); }
        SEAM(pb + 11);
        if (EN(12) && IN(pb + 12)) { phase_combine(p, l); if (l == 0) convert_weights(p, 1, lds, (int)blockIdx.x, G); }
        SEAM(pb + 12);
}
__global__ void __launch_bounds__(NTHR, 2) fwd(Params p) {
    extern __shared__ __attribute__((aligned(16))) unsigned char lds_raw[];
    LAS unsigned char* lds = (LAS unsigned char*)lds_raw;
    const int tid = threadIdx.x;
    if (tid < 4) ((LAS unsigned*)(lds + LDS_MISC))[tid] = 0u;
    __syncthreads();
    XcdBarrier bar; bar.bar = (unsigned*)(p.ws + WS_CTL); bar.x = 0; bar.st = (volatile LAS unsigned*)(lds + LDS_MISC);
    if (p.use_bar) bar = xcd_barrier_post((unsigned*)(p.ws + WS_CTL), (volatile LAS unsigned*)(lds + LDS_MISC));
    const int lo = p.ph_lo, hi = p.ph_hi;

    if (EN(100) && IN(0)) { phase_prologue(p, lds); }
    SEAM(0);
    layer_phases<0>(p, lds, bar, lo, hi);
    layer_phases<1>(p, lds, bar, lo, hi);
#undef IN
#undef SEAM
}
}

#ifndef MK_ONE_LAUNCH
#define MK_ONE_LAUNCH 0
#endif
extern "C" void kernel_launch(void* const* d_in, const int* in_sizes, int n_in, void* d_out, int out_size, void* d_ws, size_t ws_size, hipStream_t stream) {
    static int grid = 0;
    if (grid == 0) {
        if (n_in != 35 || out_size != mk::NLAT * mk::D || ws_size < mk::WS_END) { fprintf(stderr, "kernel_launch: unexpected problem (n_in %d, out %d, ws %zu < %zu)\n", n_in, out_size, ws_size, (size_t)mk::WS_END); grid = -1; return; }
        int dev = 0, cus = 0, per_cu = 0;
        if (hipGetDevice(&dev) != hipSuccess || hipDeviceGetAttribute(&cus, hipDeviceAttributeMultiprocessorCount, dev) != hipSuccess) { grid = -1; return; }
        if (hipFuncSetAttribute((const void*)mk::fwd, hipFuncAttributeMaxDynamicSharedMemorySize, mk::LDS_BYTES) != hipSuccess) { fprintf(stderr, "kernel_launch: hipFuncSetAttribute failed\n"); grid = -1; return; }
        if (hipOccupancyMaxActiveBlocksPerMultiprocessor(&per_cu, (const void*)mk::fwd, mk::NTHR, mk::LDS_BYTES) != hipSuccess || per_cu < 1) { fprintf(stderr, "kernel_launch: occupancy query says %d\n", per_cu); per_cu = 1; }
        (void)hipGetLastError();
        grid = cus;
    }
    if (grid < 0) return;
    (void)in_sizes;
    if (hipMemsetAsync(d_ws, 0, 65536, stream) != hipSuccess) return;
    mk::Params a{};
    for (int i = 0; i < 35; ++i) a.in[i] = (const float*)d_in[i];
    a.out = (float*)d_out; a.ws = (unsigned char*)d_ws;
#if MK_ONE_LAUNCH
    a.ph_lo = 0; a.ph_hi = mk::N_PHASES; a.use_bar = 1;
    hipLaunchKernelGGL(mk::fwd, dim3(grid), dim3(mk::NTHR), mk::LDS_BYTES, stream, a);
#else
    for (int ph = 0; ph < mk::N_PHASES; ++ph) { a.ph_lo = ph; a.ph_hi = ph + 1; a.use_bar = 0; hipLaunchKernelGGL(mk::fwd, dim3(grid), dim3(mk::NTHR), mk::LDS_BYTES, stream, a); }
#endif
}
```

```cpp
#include <hip/hip_runtime.h>
#include <cstdio>
#include <cstdint>
namespace pg8 {
#define PG8_LAS __attribute__((address_space(3)))
typedef unsigned short bf16_t;
typedef short bf16x8 __attribute__((ext_vector_type(8)));
typedef float f32x4 __attribute__((ext_vector_type(4)));
typedef unsigned u32x4 __attribute__((ext_vector_type(4)));
constexpr int BM = 256, BK = 64, HALF = 128, HTB = HALF * BK * 2  , STAGE_BYTES = 8 * HTB, NXCD = 8, WGM = 8;

__host__ __device__ __forceinline__ int lds_byte(int r, int c) { const int st = (r >> 4) * 2 + (c >> 5), rr = r & 15, cc = c & 31, ob = rr * 64 + cc * 2; return st * 1024 + (ob ^ (((ob >> 9) & 1) << 5)); }
__host__ __device__ __forceinline__ void stage_rc(int b, int& R, int& C) { const int st = b / 1024, sb = b % 1024, swz = sb ^ (((sb >> 9) & 1) << 5); R = (st >> 1) * 16 + swz / 64; C = (st & 1) * 32 + (swz % 64) / 2; }
__host__ __device__ __forceinline__ int perm32(int rho) { const int n = rho >> 4, i = rho & 15; return 8 * (i >> 2) + 4 * n + (i & 3); }

struct Unit { int pm, pn; };
struct Gemm { const bf16_t* A; const bf16_t* Bt; int M, N, K; };

struct StaticOrder {
    int nM, nN, nwg, G, c;
    __host__ __device__ void init(int M, int N, int G_, int c_) { nM = M / BM; nN = N / BM; nwg = nM * nN; G = G_; c = c_; }
    __host__ __device__ bool next(int i, Unit& u) const {
        const long L = (long)i * G + c; if (L >= nwg) return false;
        int wgid = (int)L; { const int q = nwg / NXCD, r = nwg % NXCD, xcd = wgid % NXCD, off = wgid / NXCD; wgid = (xcd < r ? xcd * (q + 1) : r * (q + 1) + (xcd - r) * q) + off; }
        const int nig = WGM * nN, gid = wgid / nig, fm = gid * WGM, gsz = (nM - fm) < WGM ? (nM - fm) : WGM;
        u.pm = fm + ((wgid % nig) % gsz); u.pn = (wgid % nig) / gsz; return true;
    }
    __device__ __forceinline__ void a_ready(const Unit&) const {}
    __device__ __forceinline__ void done(const Unit&) const {}
};
struct CountedOrder : StaticOrder {
    const unsigned* ready; unsigned need; unsigned* tmo;
    __device__ __forceinline__ void a_ready(const Unit& u) const {
        if (threadIdx.x < 64) {
            const unsigned long long t0 = __builtin_amdgcn_s_memrealtime(); unsigned polls = 0;
            while ((unsigned)__builtin_amdgcn_readfirstlane(__hip_atomic_load(ready + 64 * u.pm, __ATOMIC_RELAXED, __HIP_MEMORY_SCOPE_AGENT)) < need) {
                if ((++polls & 255u) == 0u && __builtin_amdgcn_readfirstlane(__hip_atomic_load(tmo, __ATOMIC_RELAXED, __HIP_MEMORY_SCOPE_AGENT)) != 0u) break;
                if (__builtin_amdgcn_s_memrealtime() - t0 > 2000000ull) {
                    if (threadIdx.x == 0) { unsigned expect = 0u; __hip_atomic_compare_exchange_strong(tmo + 1, &expect, 0x600u | (unsigned)(u.pm & 0xff), __ATOMIC_RELAXED, __ATOMIC_RELAXED, __HIP_MEMORY_SCOPE_AGENT); __hip_atomic_store(tmo, 1u, __ATOMIC_RELAXED, __HIP_MEMORY_SCOPE_AGENT); }
                    break; }
                __builtin_amdgcn_s_sleep(2); }
            __builtin_amdgcn_fence(__ATOMIC_ACQUIRE, "agent");
            asm volatile("s_waitcnt vmcnt(0)" ::: "memory");
        }
#if !defined(BROKEN_HOOK_NO_BARRIER)
        asm volatile("" ::: "memory"); __builtin_amdgcn_s_barrier(); asm volatile("" ::: "memory");
#endif
    }
};

__device__ __forceinline__ unsigned cvt_pk_bf16(float lo, float hi) { unsigned r; asm volatile("v_cvt_pk_bf16_f32 %0, %1, %2" : "=v"(r) : "v"(lo), "v"(hi)); return r; }
typedef float f32x2 __attribute__((ext_vector_type(2)));
__device__ __forceinline__ f32x2 gelu_pk(f32x2 v) {
    const f32x2 av = __builtin_elementwise_abs(v), d = av * 0.2316418882f + 1.0f;
    f32x2 t; t.x = __builtin_amdgcn_rcpf(d.x); t.y = __builtin_amdgcn_rcpf(d.y);
    f32x2 q = t * 0.5307027145f + (-0.7265760135f); q = q * t + 0.7107068705f; q = q * t + (-0.142248368f); q = q * t + 0.127414796f; q = q * t;
    const f32x2 s = (v * v) * (-0.72134752044f);
    f32x2 e; e.x = __builtin_amdgcn_exp2f(s.x); e.y = __builtin_amdgcn_exp2f(s.y);
    const f32x2 m = v * (q * e), r = v - m;
    f32x2 o; o.x = v.x < 0.f ? m.x : r.x; o.y = v.y < 0.f ? m.y : r.y; return o;
}

struct EpiF32 {
    static constexpr bool PERM = false, AFTER_DRAIN = false;
    float* C; int ldc; const float* bias;
    __device__ __forceinline__ void operator()(const f32x4 (&acc)[2][2][4][2], const Unit& u, int wr, int wc, int fr, int fq) const {
        const int row0 = u.pm * BM + wr * 64 + fr, col0 = u.pn * BM + wc * 32 + 4 * fq;
        f32x4 bv[2][2];
#pragma unroll
        for (int bj = 0; bj < 2; ++bj)
#pragma unroll
            for (int n = 0; n < 2; ++n) bv[bj][n] = bias ? *(const f32x4*)(bias + col0 + bj * HALF + n * 16) : (f32x4){0.f, 0.f, 0.f, 0.f};
#pragma unroll
        for (int ai = 0; ai < 2; ++ai)
#pragma unroll
            for (int m = 0; m < 4; ++m) { float* rowp = C + (size_t)(row0 + ai * HALF + m * 16) * ldc + col0;
#pragma unroll
                for (int bj = 0; bj < 2; ++bj)
#pragma unroll
                    for (int n = 0; n < 2; ++n) *(f32x4*)(rowp + bj * HALF + n * 16) = acc[ai][bj][m][n] + bv[bj][n]; }
    }
};
template <int ACT  > struct EpiBf16 {
    static constexpr bool PERM = true, AFTER_DRAIN = false;
    bf16_t* O; int ldc; const float* bias; int split_cols; size_t split_stride;
    __device__ __forceinline__ void operator()(const f32x4 (&acc)[2][2][4][2], const Unit& u, int wr, int wc, int fr, int fq) const {
        const int row0 = u.pm * BM + wr * 64 + fr; int colt = u.pn * BM; bf16_t* base = O;
        if (split_cols) { const int t = colt / split_cols; base += (size_t)t * split_stride; colt -= t * split_cols; }
        const int col0 = colt + wc * 32 + 8 * fq, bcol0 = u.pn * BM + wc * 32 + 8 * fq;
        f32x4 bv[2][2];
#pragma unroll
        for (int bj = 0; bj < 2; ++bj)
#pragma unroll
            for (int n = 0; n < 2; ++n) bv[bj][n] = bias ? *(const f32x4*)(bias + bcol0 + bj * HALF + 4 * n) : (f32x4){0.f, 0.f, 0.f, 0.f};
#pragma unroll
        for (int ai = 0; ai < 2; ++ai)
#pragma unroll
            for (int m = 0; m < 4; ++m) { bf16_t* rowp = base + (size_t)(row0 + ai * HALF + m * 16) * ldc + col0;
#pragma unroll
                for (int bj = 0; bj < 2; ++bj) { f32x4 v0 = acc[ai][bj][m][0] + bv[bj][0], v1 = acc[ai][bj][m][1] + bv[bj][1];
                    if (ACT == 1) { f32x2 a = gelu_pk((f32x2){v0[0], v0[1]}), b = gelu_pk((f32x2){v0[2], v0[3]}), c = gelu_pk((f32x2){v1[0], v1[1]}), d = gelu_pk((f32x2){v1[2], v1[3]});
                        v0 = (f32x4){a.x, a.y, b.x, b.y}; v1 = (f32x4){c.x, c.y, d.x, d.y}; }
                    if (ACT == 2) {
#pragma unroll
                        for (int j = 0; j < 4; ++j) { v0[j] = 0.5f * v0[j] * (1.0f + erff(v0[j] * 0.70710678f)); v1[j] = 0.5f * v1[j] * (1.0f + erff(v1[j] * 0.70710678f)); } }
                    u32x4 w; w.x = cvt_pk_bf16(v0[0], v0[1]); w.y = cvt_pk_bf16(v0[2], v0[3]); w.z = cvt_pk_bf16(v1[0], v1[1]); w.w = cvt_pk_bf16(v1[2], v1[3]);
                    *(u32x4*)(rowp + bj * HALF) = w; } }
    }
};

template <class Epi, class Sched, bool STAMP = false>
__device__ __forceinline__ void gemm_phase(PG8_LAS unsigned char* lds, const Gemm g, const Sched& S, const Epi& E, unsigned long long* stamps) {
    const int tid = threadIdx.x, wid = __builtin_amdgcn_readfirstlane(tid >> 6), lane = tid & 63, wr = wid >> 2, wc = wid & 3, fr = lane & 15, fq = lane >> 4;
    const int K = g.K, nt = K / BK;
    int ts_lo = 0, ts_hi = 0, nts = 0; const unsigned long long rt_entry = STAMP ? (unsigned long long)wall_clock64() : 0ull;
#define PG8_STAMP() do { if (STAMP && wid == 0 && nts < 64) { const unsigned long long _c = (unsigned long long)clock64(); \
        ts_lo = (lane == nts) ? (int)(unsigned)_c : ts_lo; ts_hi = (lane == nts) ? (int)(unsigned)(_c >> 32) : ts_hi; ++nts; } } while (0)
    PG8_STAMP();
    unsigned voffA[2], voffB[2];
#pragma unroll
    for (int i = 0; i < 2; ++i) { int R, C; stage_rc(tid * 16 + i * 8192, R, C); const int Rb = Epi::PERM ? ((R & ~31) + perm32(R & 31)) : R;
        voffA[i] = (unsigned)(R * K + C) * 2u; voffB[i] = (unsigned)(Rb * K + C) * 2u; }
    const size_t kstep = (size_t)(BK * 2);
    const size_t hstep = (size_t)HALF * K * 2;
    const size_t tstep = 2 * hstep;
    const unsigned ldsw = (unsigned)wid * 1024u;
    const int aoff = lds_byte(wr * 64 + fr, fq * 8), boff = lds_byte(wc * 32 + fr, fq * 8);
#define PG8_SA(b, h) (((b) * 2 + (h)) * HTB)
#define PG8_SB(b, h) ((4 + (b) * 2 + (h)) * HTB)
#define PG8_STAGE(bufoff, gbase, voff) do { _Pragma("unroll") for (int _i = 0; _i < 2; ++_i) \
        __builtin_amdgcn_global_load_lds((const unsigned*)((const char*)(gbase) + (voff)[_i]), (PG8_LAS unsigned*)(lds + (bufoff) + ldsw + _i * 8192), 16, 0, 0); } while (0)
#define PG8_LDA(dst, b, h) do { _Pragma("unroll") for (int m = 0; m < 4; ++m) _Pragma("unroll") for (int k = 0; k < 2; ++k) dst[m][k] = *(const PG8_LAS bf16x8*)(lds + PG8_SA(b, h) + aoff + m * 2048 + k * 1024); } while (0)
#define PG8_LDB(dst, b, h) do { _Pragma("unroll") for (int n = 0; n < 2; ++n) _Pragma("unroll") for (int k = 0; k < 2; ++k) dst[n][k] = *(const PG8_LAS bf16x8*)(lds + PG8_SB(b, h) + boff + n * 2048 + k * 1024); } while (0)
#define PG8_MMA(ai, bj, At, Bt) do { __builtin_amdgcn_s_setprio(1); _Pragma("unroll") for (int m = 0; m < 4; ++m) _Pragma("unroll") for (int n = 0; n < 2; ++n) _Pragma("unroll") for (int k = 0; k < 2; ++k) \
        acc[ai][bj][m][n] = __builtin_amdgcn_mfma_f32_16x16x32_bf16(Bt[n][k], At[m][k], acc[ai][bj][m][n], 0, 0, 0); __builtin_amdgcn_s_setprio(0); } while (0)
#define PG8_WAIT_V(n) asm volatile("s_waitcnt vmcnt(" #n ")" ::: "memory")
#define PG8_WAIT_L(n) asm volatile("s_waitcnt lgkmcnt(" #n ")" ::: "memory")
#define PG8_BAR __builtin_amdgcn_s_barrier()
#define PG8_SCHED __builtin_amdgcn_sched_barrier(0)
    Unit cur, nxt; int ui = 0;
    if (!S.next(0, cur)) return;
    f32x4 acc[2][2][4][2];
#pragma unroll
    for (int a = 0; a < 2; ++a)
#pragma unroll
        for (int b = 0; b < 2; ++b)
#pragma unroll
            for (int m = 0; m < 4; ++m)
#pragma unroll
                for (int n = 0; n < 2; ++n) acc[a][b][m][n] = (f32x4){0.f, 0.f, 0.f, 0.f};
    bf16x8 At[4][2], B0[2][2], B1[2][2];
    const char* cA = (const char*)g.A + (size_t)cur.pm * tstep; const char* cB = (const char*)g.Bt + (size_t)cur.pn * tstep;
    S.a_ready(cur);
    PG8_STAGE(PG8_SB(0, 0), cB, voffB); PG8_STAGE(PG8_SA(0, 0), cA, voffA); PG8_STAGE(PG8_SB(0, 1), cB + hstep, voffB); PG8_STAGE(PG8_SA(0, 1), cA + hstep, voffA);
    if (wr == 1) PG8_BAR;
    PG8_WAIT_V(4); PG8_BAR;
    PG8_STAGE(PG8_SB(1, 0), cB + kstep, voffB); PG8_STAGE(PG8_SA(1, 0), cA + kstep, voffA); PG8_STAGE(PG8_SB(1, 1), cB + hstep + kstep, voffB);
    PG8_WAIT_V(6); PG8_BAR;
    PG8_STAMP();
    for (;;) {
        const bool has_next = S.next(ui + 1, nxt);
        const char* nA = has_next ? (const char*)g.A + (size_t)nxt.pm * tstep : cA; const char* nB = has_next ? (const char*)g.Bt + (size_t)nxt.pn * tstep : cB;
        for (int t = 0; t < nt; t += 2) {
            const bool last = (t == nt - 2);
            const char* a1 = cA + (size_t)(t + 1) * kstep;
            const char* a2 = last ? nA : cA + (size_t)(t + 2) * kstep; const char* b2 = last ? nB : cB + (size_t)(t + 2) * kstep;
            const char* a3 = a2 + kstep; const char* b3 = b2 + kstep;
            if (last && has_next) S.a_ready(nxt);
            PG8_LDB(B0, 0, 0); PG8_SCHED; PG8_LDA(At, 0, 0); PG8_STAGE(PG8_SA(1, 1), a1 + hstep, voffA);
            PG8_WAIT_L(8); PG8_BAR; PG8_WAIT_L(0); PG8_MMA(0, 0, At, B0); PG8_BAR; PG8_SCHED;
            PG8_LDB(B1, 0, 1); PG8_STAGE(PG8_SB(0, 0), b2, voffB);
            PG8_BAR; PG8_WAIT_L(0); PG8_MMA(0, 1, At, B1); PG8_BAR;
            PG8_LDA(At, 0, 1); PG8_STAGE(PG8_SA(0, 0), a2, voffA);
            PG8_BAR; PG8_WAIT_L(0); PG8_MMA(1, 0, At, B0); PG8_BAR; PG8_SCHED;
            PG8_STAGE(PG8_SB(0, 1), b2 + hstep, voffB);
            PG8_WAIT_V(6); PG8_BAR; PG8_MMA(1, 1, At, B1); PG8_BAR;
            PG8_LDB(B0, 1, 0); PG8_SCHED; PG8_LDA(At, 1, 0); PG8_STAGE(PG8_SA(0, 1), a2 + hstep, voffA);
            PG8_WAIT_L(8); PG8_BAR; PG8_WAIT_L(0); PG8_MMA(0, 0, At, B0); PG8_BAR; PG8_SCHED;
            PG8_LDB(B1, 1, 1); PG8_STAGE(PG8_SB(1, 0), b3, voffB);
            PG8_BAR; PG8_WAIT_L(0); PG8_MMA(0, 1, At, B1); PG8_BAR;
            PG8_LDA(At, 1, 1); PG8_STAGE(PG8_SA(1, 0), a3, voffA);
            PG8_BAR; PG8_WAIT_L(0); PG8_MMA(1, 0, At, B0); PG8_BAR; PG8_SCHED;
            PG8_STAGE(PG8_SB(1, 1), b3 + hstep, voffB);
            PG8_WAIT_V(6); PG8_BAR; PG8_MMA(1, 1, At, B1); PG8_BAR;
        }
        PG8_STAMP();
        if constexpr (!Epi::AFTER_DRAIN) { E(acc, cur, wr, wc, fr, fq); S.done(cur); }
        PG8_STAMP();
        if (!has_next) break;
#pragma unroll
        for (int a = 0; a < 2; ++a)
#pragma unroll
            for (int b = 0; b < 2; ++b)
#pragma unroll
                for (int m = 0; m < 4; ++m)
#pragma unroll
                    for (int n = 0; n < 2; ++n) acc[a][b][m][n] = (f32x4){0.f, 0.f, 0.f, 0.f};
        cur = nxt; cA = nA; cB = nB; ++ui;
    }
    PG8_WAIT_V(0);
    if (wr == 0) PG8_BAR;
    PG8_BAR;
    if constexpr (Epi::AFTER_DRAIN) { E.fused(acc, cur, wr, wc, fr, fq, lds, wid, lane); S.done(cur); }
    PG8_STAMP();
    if (STAMP && wid == 0) { stamps[lane] = lane < nts ? (((unsigned long long)(unsigned)ts_hi << 32) | (unsigned)ts_lo) : 0ull;
        if (lane == 62) stamps[62] = rt_entry; if (lane == 63) stamps[63] = (unsigned long long)wall_clock64(); }
#undef PG8_STAMP
#undef PG8_SA
#undef PG8_SB
#undef PG8_STAGE
#undef PG8_LDA
#undef PG8_LDB
#undef PG8_MMA
#undef PG8_WAIT_V
#undef PG8_WAIT_L
#undef PG8_BAR
#undef PG8_SCHED
}
}
#define XB_TMO      128
#define XB_XCNT(j)  (256  + 64 * (j))
#define XB_XSUB(j)  (1280 + 64 * (j))
#define XB_XGEN(j)  (2304 + 64 * (j))
#define XB_TOP      3328
#define XB_TOPGEN   3392
#define XCD_BAR_WORDS 3456
#define XB_SPIN_CAP (1u << 18)
#define LAS __attribute__((address_space(3)))

__device__ __forceinline__ unsigned xb_ld(unsigned* p)              { return __hip_atomic_load(p, __ATOMIC_RELAXED, __HIP_MEMORY_SCOPE_AGENT); }
__device__ __forceinline__ unsigned xb_add(unsigned* p, unsigned v) { return __hip_atomic_fetch_add(p, v, __ATOMIC_RELAXED, __HIP_MEMORY_SCOPE_AGENT); }
__device__ __forceinline__ unsigned xb_xcc_id() { return (unsigned)__builtin_amdgcn_s_getreg((3 << 11) | 20) & 0xFu; }
#define XB_SPIN(cond, bar) do { unsigned _sp = 0; while (cond) { __builtin_amdgcn_s_sleep(1); \
    if ((++_sp & 255u) == 0u) { if (xb_ld(&(bar)[XB_TMO])) break; if (_sp > XB_SPIN_CAP) { atomicAdd(&(bar)[XB_TMO], 1u); break; } } } } while (0)

struct XcdBarrier {
    unsigned* bar; unsigned x;
    volatile LAS unsigned* st;
};

__device__ __forceinline__ XcdBarrier xcd_barrier_post(unsigned* bar, volatile LAS unsigned* st) {
    XcdBarrier b; b.bar = bar; b.x = xb_xcc_id(); b.st = st;
    if (threadIdx.x == 0) (void)xb_add(&bar[XB_XCNT(b.x)], 1u);
    return b;
}
__device__ __forceinline__ void xcd_barrier_complete(unsigned* bar, unsigned x, unsigned& nloc, unsigned& nx) {
    const unsigned G = gridDim.x * gridDim.y * gridDim.z;
    unsigned sum, cnt, mine, sp = 0u;
    for (;;) {
        sum = 0u; cnt = 0u; mine = 0u;
#pragma unroll
        for (unsigned j = 0; j < 16; ++j) { const unsigned c = xb_ld(&bar[XB_XCNT(j)]); sum += c; cnt += (c > 0u) ? 1u : 0u; mine = (j == x) ? c : mine; }
        if (sum == G) break;
        __builtin_amdgcn_s_sleep(1);
        if ((++sp & 255u) == 0u) { if (xb_ld(&bar[XB_TMO])) break; if (sp > XB_SPIN_CAP) { atomicAdd(&bar[XB_TMO], 1u); break; } }
    }
    nloc = mine > 0u ? mine : 1u; nx = cnt > 0u ? cnt : 1u;
}

__device__ __forceinline__ void xcd_barrier(const XcdBarrier& b) {
    asm volatile("s_waitcnt vmcnt(0)" ::: "memory");
    __syncthreads();
    if (threadIdx.x == 0) {
        unsigned* bar = b.bar;
        __builtin_amdgcn_s_waitcnt(0);
        unsigned nloc = b.st[0], nx = b.st[1];
        if (nloc == 0u) { xcd_barrier_complete(bar, b.x, nloc, nx); b.st[0] = nloc; b.st[1] = nx; }
        const unsigned old = xb_add(&bar[XB_XSUB(b.x)], 1u);
        const unsigned gen = old / nloc;
        if (old + 1u == (gen + 1u) * nloc) {
            __builtin_amdgcn_fence(__ATOMIC_RELEASE, "agent");
            asm volatile("s_waitcnt vmcnt(0)" ::: "memory");
            const unsigned og = xb_add(&bar[XB_TOP], 1u);
            const unsigned tg = og / nx;
            if (og + 1u == (tg + 1u) * nx) xb_add(&bar[XB_TOPGEN], 1u);
            else XB_SPIN(xb_ld(&bar[XB_TOPGEN]) == tg, bar);
            __builtin_amdgcn_fence(__ATOMIC_ACQUIRE, "agent");
            xb_add(&bar[XB_XGEN(b.x)], 1u);
            asm volatile("s_waitcnt vmcnt(0)" ::: "memory");
        } else {
            XB_SPIN(xb_ld(&bar[XB_XGEN(b.x)]) == gen, bar);
            __builtin_amdgcn_fence(__ATOMIC_ACQUIRE, "agent");
            asm volatile("s_waitcnt vmcnt(0)" ::: "memory");
        }
    }
    __syncthreads();
}

namespace mk {
using pg8::bf16_t; using pg8::bf16x8; using pg8::f32x4; using pg8::u32x4;
typedef unsigned u32x2 __attribute__((ext_vector_type(2)));
typedef short bf16x4 __attribute__((ext_vector_type(4)));
typedef float lf2 __attribute__((ext_vector_type(2)));
typedef float lf4 __attribute__((ext_vector_type(4)));
typedef unsigned lu4 __attribute__((ext_vector_type(4)));

constexpr int D = 1024, NBATCH = 16, SEQ = 2048, CTXL = 256;
constexpr int NLAT = NBATCH * SEQ, NCTX = NBATCH * CTXL, NROW = NLAT + NCTX;
constexpr int NINP = 3072, NIN = 2944;
constexpr int C_Q = 256, C_K = 640, C_V = 1024, C_Z = 1408;
constexpr int DE = 2816;
constexpr int XROWS = 4608;
constexpr int NTHR = 512;
constexpr int LDS_MISC = 131072, LDS_BYTES = 131072 + 256;

constexpr size_t al256(size_t x) { return (x + 255) & ~(size_t)255; }
constexpr size_t WS_CTL = 0;
constexpr size_t WS_MOD = 65536;
constexpr size_t WS_SW = al256(WS_MOD + (size_t)2 * 17 * 6144 * 4);
constexpr size_t SW_W2T = 0, SW_A2T = 98304, SW_G2T = 196608, SW_GLUT = 294912, SW_S5E = 425984, SW_S5W2 = 2523136, SW_STRIDE = 6717440;
constexpr size_t WS_WIN = al256(WS_SW + 2 * SW_STRIDE);
constexpr size_t WS_WOUT = WS_WIN + (size_t)3072 * 1024 * 2;
constexpr size_t WS_WGU = WS_WOUT + (size_t)1024 * 1024 * 2;
constexpr size_t WS_WD = WS_WGU + (size_t)16 * 5632 * 1024 * 2;
constexpr size_t WS_XB = WS_WD + (size_t)16 * 1024 * 2816 * 2;
constexpr size_t WS_CTXA = WS_XB + (size_t)NLAT * D * 4;
constexpr size_t WS_CTXB = WS_CTXA + (size_t)NCTX * D * 4;
constexpr size_t WS_ABUF = WS_CTXB + (size_t)NCTX * D * 4;
constexpr size_t WS_AFF = WS_ABUF + (size_t)NROW * D * 2;
constexpr size_t WS_SLOT = WS_AFF + (size_t)NROW * 16 * 4;
constexpr size_t WS_SELG = WS_SLOT + (size_t)NROW * 16 * 4;
constexpr size_t WS_U = al256(WS_SELG + (size_t)16 * XROWS * 4);
constexpr size_t SZ384 = (size_t)NROW * 384 * 2;
constexpr size_t U_P = WS_U;
constexpr size_t U_QR = U_P + (size_t)NROW * NINP * 2;
constexpr size_t U_KR = U_QR + SZ384;
constexpr size_t U_VT = U_KR + SZ384;
constexpr size_t U_VTC = U_VT + (size_t)16 * 384 * 2048 * 2;
constexpr size_t U_RS = U_VT + SZ384;
constexpr size_t U_KS = U_RS + SZ384;
constexpr size_t U_VS = U_KS + SZ384;
constexpr size_t U_KK = U_VS + SZ384;
constexpr size_t U_ALR = U_KK + SZ384;
constexpr size_t U_LD = U_ALR + SZ384;
constexpr size_t U_AG = U_LD + 2 * SZ384;
constexpr size_t U_G = U_AG + 2 * SZ384;
constexpr size_t U_YRK = U_G + SZ384;
constexpr size_t U_SLOC = U_YRK + 2 * (size_t)NROW * 384 * 4;
constexpr size_t U_SPREV = U_SLOC + (size_t)2304 * 16 * 256 * 4;
constexpr size_t U_YG = U_SPREV + (size_t)2304 * 16 * 256 * 2;
constexpr size_t U_MIX_END = U_YG + (size_t)NROW * 256 * 2;
constexpr size_t U_Y = WS_U;
constexpr size_t U_XSEL = U_Y + (size_t)NROW * D * 4;
constexpr size_t U_HID = U_XSEL + (size_t)16 * XROWS * 1024 * 2;
constexpr size_t U_YEXP = U_HID + (size_t)16 * XROWS * DE * 2;
constexpr size_t U_FFN_END = U_YEXP + (size_t)16 * XROWS * 1024 * 2;
constexpr size_t WS_END = U_MIX_END > U_FFN_END ? U_MIX_END : U_FFN_END;

struct Params { const float* in[35]; float* out; unsigned char* ws; int ph_lo, ph_hi, use_bar, pad; };

__device__ __forceinline__ bf16_t f2bf(float f) { unsigned u = __float_as_uint(f); u += 0x7FFFu + ((u >> 16) & 1u); return (bf16_t)(u >> 16); }
__device__ __forceinline__ unsigned pack2(float lo, float hi) { return (unsigned)f2bf(lo) | ((unsigned)f2bf(hi) << 16); }
__device__ __forceinline__ float bflo(unsigned w) { return __uint_as_float(w << 16); }
__device__ __forceinline__ float bfhi(unsigned w) { return __uint_as_float(w & 0xffff0000u); }
__device__ __forceinline__ float bf2f(bf16_t b) { return __uint_as_float(((unsigned)b) << 16); }
__device__ __forceinline__ float sigm(float x) { return 1.0f / (1.0f + __expf(-x)); }
__device__ __forceinline__ float wave_sum(float v) {
#pragma unroll
    for (int o = 32; o >= 1; o >>= 1) v += __shfl_xor(v, o);
    return v; }
__device__ __forceinline__ void unpack8(const uint4 w, float (&f)[8]) { f[0] = bflo(w.x); f[1] = bfhi(w.x); f[2] = bflo(w.y); f[3] = bfhi(w.y); f[4] = bflo(w.z); f[5] = bfhi(w.z); f[6] = bflo(w.w); f[7] = bfhi(w.w); }
__device__ __forceinline__ uint4 pack8(const float (&f)[8]) { uint4 w; w.x = pack2(f[0], f[1]); w.y = pack2(f[2], f[3]); w.z = pack2(f[4], f[5]); w.w = pack2(f[6], f[7]); return w; }
__device__ __forceinline__ const float* xrow(const float* lat, const float* ctx, int r) { return r < NLAT ? lat + (size_t)r * D : ctx + (size_t)(r - NLAT) * D; }
__device__ __forceinline__ float* xrow_w(float* lat, float* ctx, int r) { return r < NLAT ? lat + (size_t)r * D : ctx + (size_t)(r - NLAT) * D; }
__device__ __forceinline__ f32x4 mfma16(bf16x8 a, bf16x8 b, f32x4 c) { return __builtin_amdgcn_mfma_f32_16x16x32_bf16(a, b, c, 0, 0, 0); }

__device__ __forceinline__ void tr_tile(const float* __restrict__ src, int ldsrc, int k0, int n0, bf16_t* __restrict__ dst, int lddst, int drow0, LAS unsigned* T) {
    const int tid = threadIdx.x, n4 = tid & 15, kq = tid >> 4;
    const float4 a = *(const float4*)(src + (size_t)(k0 + 2 * kq) * ldsrc + n0 + 4 * n4);
    const float4 b = *(const float4*)(src + (size_t)(k0 + 2 * kq + 1) * ldsrc + n0 + 4 * n4);
    T[(4 * n4 + 0) * 33 + kq] = pack2(a.x, b.x); T[(4 * n4 + 1) * 33 + kq] = pack2(a.y, b.y);
    T[(4 * n4 + 2) * 33 + kq] = pack2(a.z, b.z); T[(4 * n4 + 3) * 33 + kq] = pack2(a.w, b.w);
    __syncthreads();
    const int n = tid >> 3, pc = tid & 7;
    uint4 v; v.x = T[n * 33 + 4 * pc]; v.y = T[n * 33 + 4 * pc + 1]; v.z = T[n * 33 + 4 * pc + 2]; v.w = T[n * 33 + 4 * pc + 3];
    *(uint4*)(dst + (size_t)(drow0 + n) * lddst + k0 + 8 * pc) = v;
    __syncthreads();
}

constexpr int CV_WIN = 16 * 46, CV_PAD = 32, CV_WOUT = 256, CV_G = 16 * 704, CV_TOTAL = CV_WIN + CV_PAD + CV_WOUT + 3 * CV_G;
__device__ __forceinline__ void convert_weights(const Params& p, int l, LAS unsigned char* lds, int vb, int nvb) {
    LAS unsigned* T = (LAS unsigned*)lds;
    bf16_t* WIN = (bf16_t*)(p.ws + WS_WIN); bf16_t* WOUT = (bf16_t*)(p.ws + WS_WOUT); bf16_t* WGU = (bf16_t*)(p.ws + WS_WGU); bf16_t* WD = (bf16_t*)(p.ws + WS_WD);
    for (int it = vb; it < CV_TOTAL; it += nvb) {
        int j = it;
        if (j < CV_WIN) { const int kt = j / 46, nt = j % 46; tr_tile(p.in[7] + (size_t)l * 1024 * NIN, NIN, kt * 64, nt * 64, WIN, 1024, nt * 64, T); continue; }
        j -= CV_WIN;
        if (j < CV_PAD) { const size_t o = (size_t)NIN * 1024 + ((size_t)j * NTHR + threadIdx.x) * 8; *(uint4*)(WIN + o) = make_uint4(0u, 0u, 0u, 0u); continue; }
        j -= CV_PAD;
        if (j < CV_WOUT) { const int kt = j / 16, nt = j % 16; tr_tile(p.in[8] + (size_t)l * 1024 * 1024, 1024, kt * 64, nt * 64, WOUT, 1024, nt * 64, T); continue; }
        j -= CV_WOUT;
        if (j < 2 * CV_G) { const int up = j >= CV_G; if (up) j -= CV_G; const int e = j / 704, rem = j % 704, kt = rem / 44, nt = rem % 44, n0 = nt * 64;
            tr_tile(p.in[up ? 33 : 32] + (size_t)(l * 16 + e) * 1024 * DE, DE, kt * 64, n0, WGU + (size_t)e * 5632 * 1024, 1024, (n0 >> 7) * 256 + (n0 & 127) + (up ? 128 : 0), T); continue; }
        j -= 2 * CV_G;
        { const int e = j / 704, rem = j % 704, kt = rem / 16, nt = rem % 16;
            tr_tile(p.in[34] + (size_t)(l * 16 + e) * DE * 1024, 1024, kt * 64, nt * 64, WD + (size_t)e * 1024 * DE, DE, nt * 64, T); }
    }
}

__device__ __forceinline__ void mod_item(const Params& p, int item, LAS unsigned char* lds) {
    LAS float* sc = (LAS float*)lds;
    LAS float* red = (LAS float*)(lds + 69632);
    const int tid = threadIdx.x, l = item / 96, cg = item % 96;
    for (int i = tid; i < 17 * 1024; i += NTHR) { const int b = i >> 10, k = i & 1023; const float c = b < 16 ? p.in[1][b * 1024 + k] : p.in[3][k]; sc[k * 17 + b] = c * sigm(c); }
    __syncthreads();
    const int col = cg * 64 + (tid & 63), kg = tid >> 6;
    float acc[17];
#pragma unroll
    for (int b = 0; b < 17; ++b) acc[b] = 0.f;
    const float* w = p.in[4] + ((size_t)l * 1024 + kg * 128) * 6144 + col;
#pragma unroll 4
    for (int kk = 0; kk < 128; ++kk) { const float wv = w[(size_t)kk * 6144]; const LAS float* s = sc + (kg * 128 + kk) * 17;
#pragma unroll
        for (int b = 0; b < 17; ++b) acc[b] += s[b] * wv; }
#pragma unroll
    for (int b = 0; b < 17; ++b) red[(kg * 17 + b) * 64 + (tid & 63)] = acc[b];
    __syncthreads();
    for (int i = tid; i < 17 * 64; i += NTHR) { const int b = i >> 6, c = i & 63; float s = 0.f;
#pragma unroll
        for (int g = 0; g < 8; ++g) s += red[(g * 17 + b) * 64 + c];
        ((float*)(p.ws + WS_MOD))[((size_t)l * 17 + b) * 6144 + cg * 64 + c] = s + p.in[5][l * 6144 + cg * 64 + c]; }
    __syncthreads();
}

__device__ __forceinline__ void s5mat_item(const Params& p, int item, LAS unsigned char* lds) {
    LAS lf2* pw = (LAS lf2*)lds;
    LAS lf2* bb = (LAS lf2*)(lds + 17408);
    LAS lf2* cc = (LAS lf2*)(lds + 17408 + 16384);
    LAS float* KT = (LAS float*)(lds + 17408 + 32768);
    const int tid = threadIdx.x, l = item >> 4, g = item & 15;
    for (int i = tid; i < 2 * 17 * 64; i += NTHR) { const int pp = i & 63, n = (i >> 6) % 17, d = i / (17 * 64);
        const int li = ((l * 2 + d) * 16 + g) * 64 + pp; const float lr = p.in[9][li], lim = p.in[10][li], dt = expf(p.in[11][(l * 2 + d) * 16 + g]);
        const float mag = expf((float)n * dt * lr); float s, c; sincosf((float)n * dt * lim, &s, &c); pw[i] = (lf2){mag * c, mag * s}; }
    for (int i = tid; i < 2 * 64 * 16; i += NTHR) { const int h = i & 15, pp = (i >> 4) & 63, d = i >> 10;
        const int li = ((l * 2 + d) * 16 + g) * 64 + pp; const float lr = p.in[9][li], lim = p.in[10][li], dt = expf(p.in[11][(l * 2 + d) * 16 + g]);
        const float mag = expf(dt * lr); float s, c; sincosf(dt * lim, &s, &c); const float x = mag * c - 1.0f, y = mag * s;
        const float den = 1.0f / (lr * lr + lim * lim); const float cr = (x * lr + y * lim) * den, ci = (y * lr - x * lim) * den;
        const int bi = ((l * 16 + g) * 64 + pp) * 16 + h; const float br = p.in[12][bi], bim = p.in[13][bi];
        bb[i] = (lf2){cr * br - ci * bim, cr * bim + ci * br}; }
    for (int i = tid; i < 2 * 16 * 64; i += NTHR) { const int pp = i & 63, h = (i >> 6) & 15, d = i >> 10;
        const int ci = (((l * 2 + d) * 16 + g) * 16 + h) * 64 + pp; cc[i] = (lf2){p.in[14][ci], p.in[15][ci]}; }
    __syncthreads();
    for (int i = tid; i < 2 * 16 * 256; i += NTHR) { const int h2 = i & 15, h = (i >> 4) & 15, tau = (i >> 8) & 15, d = i >> 12; float s = 0.f;
        for (int pp = 0; pp < 64; ++pp) { const lf2 c = cc[(d * 16 + h) * 64 + pp], w = pw[(d * 17 + tau) * 64 + pp], b = bb[(d * 64 + pp) * 16 + h2];
            const float tr = c.x * w.x - c.y * w.y, ti = c.x * w.y + c.y * w.x; s += tr * b.x - ti * b.y; }
        KT[i] = s; }
    __syncthreads();
    bf16_t* E = (bf16_t*)(p.ws + WS_SW + (size_t)l * SW_STRIDE + SW_S5E) + (size_t)g * 256 * 256;
    bf16_t* W2 = (bf16_t*)(p.ws + WS_SW + (size_t)l * SW_STRIDE + SW_S5W2) + (size_t)g * 256 * 512;
    for (int i = tid; i < 256 * 256; i += NTHR) { const int k = i & 255, n = i >> 8; const int s = k >> 4, h = k & 15, d = n >> 7, part = (n >> 6) & 1, pp = n & 63;
        const int e = d == 0 ? 15 - s : s; const lf2 w = pw[(d * 17 + e) * 64 + pp], b = bb[(d * 64 + pp) * 16 + h];
        E[i] = f2bf(part ? (w.x * b.y + w.y * b.x) : (w.x * b.x - w.y * b.y)); }
    for (int i = tid; i < 256 * 512; i += NTHR) { const int k = i & 511, n = i >> 9; const int t = n >> 4, h = n & 15; float v;
        if (k < 256) { const int s = k >> 4, h2 = k & 15; v = 0.f;
            if (t >= s) v += KT[((0 * 16 + (t - s)) * 16 + h) * 16 + h2];
            if (s >= t) v += KT[((1 * 16 + (s - t)) * 16 + h) * 16 + h2];
            if (s == t && h == h2) v += p.in[16][l * 256 + g * 16 + h]; }
        else { const int q = k - 256, d = q >> 7, part = (q >> 6) & 1, pp = q & 63; const int e = d == 0 ? t + 1 : 16 - t;
            const lf2 c = cc[(d * 16 + h) * 64 + pp], w = pw[(d * 17 + e) * 64 + pp];
            v = part ? -(c.x * w.y + c.y * w.x) : (c.x * w.x - c.y * w.y); }
        W2[i] = f2bf(v); }
    __syncthreads();
}

__device__ __forceinline__ void smallw_item(const Params& p, int item) {
    int i = item * NTHR + threadIdx.x; const int l = i / 212992; i %= 212992;
    unsigned char* sw = p.ws + WS_SW + (size_t)l * SW_STRIDE;
    if (i < 49152) { const int k = i & 63, n = (i >> 6) % 384, d = i / 24576; ((bf16_t*)(sw + SW_W2T))[i] = f2bf(p.in[22][((size_t)(l * 2 + d) * 64 + k) * 384 + n]); return; }
    i -= 49152;
    if (i < 49152) { const int k = i & 63, n = (i >> 6) % 384, d = i / 24576; ((bf16_t*)(sw + SW_A2T))[i] = f2bf(p.in[24][((size_t)(l * 2 + d) * 64 + k) * 384 + n]); return; }
    i -= 49152;
    if (i < 49152) { const int k = i & 127, n = i >> 7; ((bf16_t*)(sw + SW_G2T))[i] = f2bf(p.in[25][((size_t)l * 128 + k) * 384 + n]); return; }
    i -= 49152;
    { const int k = i & 255, n = i >> 8; ((bf16_t*)(sw + SW_GLUT))[i] = f2bf(p.in[17][((size_t)l * 256 + k) * 256 + n]); }
}

constexpr int PRO_MOD = 192, PRO_S5 = 32, PRO_SW = 832;
__device__ __forceinline__ void phase_prologue(const Params& p, LAS unsigned char* lds) {
    for (int it = blockIdx.x; it < PRO_MOD + PRO_S5 + PRO_SW; it += gridDim.x) {
        if (it < PRO_MOD) mod_item(p, it, lds);
        else if (it < PRO_MOD + PRO_S5) s5mat_item(p, it - PRO_MOD, lds);
        else smallw_item(p, it - PRO_MOD - PRO_S5);
    }
    convert_weights(p, 0, lds, (int)blockIdx.x, (int)gridDim.x);
}

__device__ __forceinline__ void hnorm_row(const float* src, const float* g, const float* mb_sh, const float* mb_sc, bf16_t* dst, int lane, const float4 (&v)[4]) {
    float ss = 0.f;
#pragma unroll
    for (int i = 0; i < 4; ++i) ss += v[i].x * v[i].x + v[i].y * v[i].y + v[i].z * v[i].z + v[i].w * v[i].w;
    ss = wave_sum(ss); const float rs = rsqrtf(ss * (1.0f / 1024.0f) + 1e-6f);
#pragma unroll
    for (int i = 0; i < 4; ++i) { const int c = i * 256 + lane * 4; const float4 gg = *(const float4*)(g + c), sh = *(const float4*)(mb_sh + c), sc = *(const float4*)(mb_sc + c);
        u32x2 o; o.x = pack2(v[i].x * rs * gg.x * (1.f + sc.x) + sh.x, v[i].y * rs * gg.y * (1.f + sc.y) + sh.y);
        o.y = pack2(v[i].z * rs * gg.z * (1.f + sc.z) + sh.z, v[i].w * rs * gg.w * (1.f + sc.w) + sh.w);
        *(u32x2*)(dst + c) = o; }
    (void)src;
}
__device__ __forceinline__ void phase_hnorm(const Params& p, int l, const float* xl, const float* xc) {
    const int lane = threadIdx.x & 63, wv = threadIdx.x >> 6;
    const float* mod = (const float*)(p.ws + WS_MOD) + (size_t)l * 17 * 6144; const float* g = p.in[6] + (l * 4 + 0) * 1024;
    bf16_t* A = (bf16_t*)(p.ws + WS_ABUF);
    for (int r = blockIdx.x * 8 + wv; r < NROW; r += gridDim.x * 8) {
        const float* src = xrow(xl, xc, r); const int b = r < NLAT ? (r >> 11) : 16; const float* mb = mod + (size_t)b * 6144;
        float4 v[4];
#pragma unroll
        for (int i = 0; i < 4; ++i) v[i] = *(const float4*)(src + i * 256 + lane * 4);
        hnorm_row(src, g, mb, mb + 1024, A + (size_t)r * 1024, lane, v);
    }
}

__device__ __forceinline__ void phase_prep(const Params& p, int l, LAS unsigned char* lds) {
    LAS bf16_t* vt = (LAS bf16_t*)lds;
    LAS lf2* cs = (LAS lf2*)(lds + 50176);
    const int tid = threadIdx.x;
    for (int i = tid; i < 1024; i += NTHR) { const int pos = i >> 4, j = i & 15; const float invf = exp2f(-(float)j * (13.287712379549449f / 16.0f)); float s, c; sincosf((float)pos * invf, &s, &c); cs[i] = (lf2){c, s}; }
    __syncthreads();
    const bf16_t* P = (const bf16_t*)(p.ws + U_P);
    bf16_t* QR = (bf16_t*)(p.ws + U_QR); bf16_t* KR = (bf16_t*)(p.ws + U_KR);
    bf16_t* RS = (bf16_t*)(p.ws + U_RS); bf16_t* KS = (bf16_t*)(p.ws + U_KS); bf16_t* VS = (bf16_t*)(p.ws + U_VS); bf16_t* KK = (bf16_t*)(p.ws + U_KK); bf16_t* ALR = (bf16_t*)(p.ws + U_ALR);
    for (int ti = blockIdx.x; ti < NROW / 64; ti += gridDim.x) {
        const int r0 = ti * 64; const bool lat = r0 < NLAT; const int b = lat ? (r0 >> 11) : ((r0 - NLAT) >> 8), t0 = lat ? (r0 & 2047) : ((r0 - NLAT) & 255), slen = lat ? SEQ : CTXL;
#pragma unroll
        for (int i = 0; i < 6; ++i) { const int idx = tid + NTHR * i, tok = idx / 48, pc = idx % 48;
            *(LAS lu4*)(vt + tok * 392 + pc * 8) = *(const lu4*)(P + (size_t)(r0 + tok) * NINP + C_V + pc * 8); }
        __syncthreads();
        { bf16_t* vdst = lat ? (bf16_t*)(p.ws + U_VT) + (size_t)b * 384 * 2048 + t0 : (bf16_t*)(p.ws + U_VTC) + (size_t)b * 384 * 256 + t0;
#pragma unroll
          for (int i = 0; i < 6; ++i) { const int idx = tid + NTHR * i, hd = idx >> 3, pc = idx & 7; unsigned w[4];
#pragma unroll
              for (int j = 0; j < 4; ++j) w[j] = (unsigned)vt[(pc * 8 + 2 * j) * 392 + hd] | ((unsigned)vt[(pc * 8 + 2 * j + 1) * 392 + hd] << 16);
              *(uint4*)(vdst + (size_t)hd * slen + pc * 8) = make_uint4(w[0], w[1], w[2], w[3]); } }
#pragma unroll
        for (int i = 0; i < 6; ++i) { const int idx = tid + NTHR * i, tok = idx / 48, rem = idx % 48, qk = rem / 24, rem2 = rem % 24, h = rem2 >> 2, pp = rem2 & 3;
            const int d1 = (pp >> 1) * 32 + (pp & 1) * 8; const size_t so = (size_t)(r0 + tok) * NINP + (qk ? C_K : C_Q) + h * 64 + d1;
            float x1[8], x2[8], o1[8], o2[8]; unpack8(*(const uint4*)(P + so), x1); unpack8(*(const uint4*)(P + so + 16), x2);
            const int t = t0 + tok, pos = (pp < 2) ? (t >> 6) : (t & 63), j0 = (pp & 1) * 8; const float scl = qk ? 1.0f : 0.125f;
#pragma unroll
            for (int j = 0; j < 8; ++j) { lf2 c = cs[pos * 16 + j0 + j]; if (!lat) c = (lf2){1.f, 0.f}; o1[j] = (x1[j] * c.x - x2[j] * c.y) * scl; o2[j] = (x1[j] * c.y + x2[j] * c.x) * scl; }
            bf16_t* dq = (qk ? KR : QR) + (size_t)(r0 + tok) * 384 + h * 64 + d1; *(uint4*)dq = pack8(o1); *(uint4*)(dq + 16) = pack8(o2); }
        for (int i = 0; i < 24; ++i) { const int idx = tid + NTHR * i, tok = idx / 192, pc = idx % 192, c0 = pc * 8, r = r0 + tok, t = t0 + tok;
            const bf16_t* zp = P + (size_t)r * NINP + C_Z + c0; float x[8], pv[8], nx[8], zs[8];
            unpack8(*(const uint4*)zp, x);
            if (t > 0) unpack8(*(const uint4*)(zp - NINP), pv); else {
#pragma unroll
                for (int j = 0; j < 8; ++j) pv[j] = 0.f; }
            if (t < slen - 1) unpack8(*(const uint4*)(zp + NINP), nx); else {
#pragma unroll
                for (int j = 0; j < 8; ++j) nx[j] = 0.f; }
            const float4 mu0 = *(const float4*)(p.in[20] + l * 1536 + c0), mu1 = *(const float4*)(p.in[20] + l * 1536 + c0 + 4); const float mu[8] = {mu0.x, mu0.y, mu0.z, mu0.w, mu1.x, mu1.y, mu1.z, mu1.w};
#pragma unroll
            for (int j = 0; j < 8; ++j) zs[j] = x[j] + (0.5f * (pv[j] + nx[j]) - x[j]) * mu[j];
            const bool isk = c0 >= 384 && c0 < 768; float kv[8]; float ss = 0.f;
            { const int kc = isk ? c0 - 384 : 0; const float4 k0 = *(const float4*)(p.in[26] + l * 384 + kc), k1 = *(const float4*)(p.in[26] + l * 384 + kc + 4); const float kkw[8] = {k0.x, k0.y, k0.z, k0.w, k1.x, k1.y, k1.z, k1.w};
#pragma unroll
              for (int j = 0; j < 8; ++j) { kv[j] = zs[j] * kkw[j]; ss += kv[j] * kv[j]; } }
            ss += __shfl_xor(ss, 1); ss += __shfl_xor(ss, 2); ss += __shfl_xor(ss, 4);
            if (c0 < 384) *(uint4*)(RS + (size_t)r * 384 + c0) = pack8(zs);
            else if (c0 < 768) { *(uint4*)(KS + (size_t)r * 384 + c0 - 384) = pack8(zs); const float inv = 1.0f / fmaxf(sqrtf(ss), 1e-12f);
#pragma unroll
                for (int j = 0; j < 8; ++j) kv[j] *= inv;
                *(uint4*)(KK + (size_t)r * 384 + c0 - 384) = pack8(kv); }
            else if (c0 < 1152) *(uint4*)(VS + (size_t)r * 384 + c0 - 768) = pack8(zs);
            else { const int ac = c0 - 1152; float o[8];
#pragma unroll
                for (int j = 0; j < 8; ++j) o[j] = ac < 128 ? 1.0f - 2.0f / (1.0f + __expf(2.0f * zs[j])) : (ac < 256 ? zs[j] : sigm(zs[j]));
                *(uint4*)(ALR + (size_t)r * 384 + ac) = pack8(o); }
        }
        __syncthreads();
    }
}

template <int KS, int MODE> __device__ __forceinline__ void lr_wave(const Params& p, int l, int row0, int kofs, const bf16_t* Bt, int d) {
    const int lane = threadIdx.x & 63, m = lane & 15, q = lane >> 4;
    const bf16_t* Ap = (const bf16_t*)(p.ws + U_ALR) + (size_t)(row0 + m) * 384 + kofs + q * 8;
    bf16x8 a[KS];
#pragma unroll
    for (int ks = 0; ks < KS; ++ks) a[ks] = *(const bf16x8*)(Ap + ks * 32);
    bf16_t* O = (bf16_t*)(p.ws + (MODE == 0 ? U_LD + (size_t)d * SZ384 : (MODE == 1 ? U_AG + (size_t)d * SZ384 : U_G))) + (size_t)(row0 + m) * 384;
    const float* bias = MODE == 0 ? p.in[21] + (l * 2 + d) * 384 : p.in[23] + (l * 2 + d) * 384;
    for (int nt = 0; nt < 24; ++nt) {
        f32x4 acc = (f32x4){0.f, 0.f, 0.f, 0.f};
#pragma unroll
        for (int ks = 0; ks < KS; ++ks) { const bf16x8 bfr = *(const bf16x8*)(Bt + (size_t)(nt * 16 + m) * (KS * 32) + ks * 32 + q * 8); acc = mfma16(bfr, a[ks], acc); }
        const int n = nt * 16 + q * 4; float o[4];
        if (MODE == 2) {
#pragma unroll
            for (int j = 0; j < 4; ++j) o[j] = acc[j];
        } else { const float4 bv = *(const float4*)(bias + n); const float bb[4] = {bv.x, bv.y, bv.z, bv.w};
#pragma unroll
            for (int j = 0; j < 4; ++j) { const float s = sigm(bb[j] + acc[j]); o[j] = MODE == 0 ? -0.6065306597f * s : s; } }
        u32x2 w; w.x = pack2(o[0], o[1]); w.y = pack2(o[2], o[3]); *(u32x2*)(O + n) = w;
    }
}
__device__ __forceinline__ void lowrank_items(const Params& p, int l, int wid, int nw) {
    const unsigned char* sw = p.ws + WS_SW + (size_t)l * SW_STRIDE;
    for (int it = wid; it < 2304 * 5; it += nw) { const int rt = it / 5, m = it % 5, row0 = rt * 16;
        if (m < 2) lr_wave<2, 0>(p, l, row0, m * 64, (const bf16_t*)(sw + SW_W2T) + (size_t)m * 384 * 64, m);
        else if (m < 4) lr_wave<2, 1>(p, l, row0, m * 64, (const bf16_t*)(sw + SW_A2T) + (size_t)(m - 2) * 384 * 64, m - 2);
        else lr_wave<4, 2>(p, l, row0, 256, (const bf16_t*)(sw + SW_G2T), 0); }
}

__device__ __forceinline__ int s5_rowbase(int cr) { const int b = cr / 144, c = cr % 144; return c < 16 ? NLAT + b * 256 + c * 16 : b * 2048 + (c - 16) * 16; }
__device__ __forceinline__ void s5_pass1_items(const Params& p, int l, int wid, int nw) {
    const int lane = threadIdx.x & 63, m = lane & 15, q = lane >> 4;
    const bf16_t* P = (const bf16_t*)(p.ws + U_P); float* SLOC = (float*)(p.ws + U_SLOC);
    for (int it = wid; it < 144 * 16; it += nw) { const int ct = it >> 4, g = it & 15, cr = ct * 16 + m, rb = s5_rowbase(cr);
        const bf16_t* E = (const bf16_t*)(p.ws + WS_SW + (size_t)l * SW_STRIDE + SW_S5E) + (size_t)g * 256 * 256;
        bf16x8 a[8];
#pragma unroll
        for (int ks = 0; ks < 8; ++ks) a[ks] = *(const bf16x8*)(P + (size_t)(rb + 2 * ks + (q >> 1)) * NINP + g * 16 + (q & 1) * 8);
        float* o = SLOC + ((size_t)cr * 16 + g) * 256 + q * 4;
#pragma unroll 2
        for (int nt = 0; nt < 16; ++nt) { f32x4 acc = (f32x4){0.f, 0.f, 0.f, 0.f}; const bf16_t* ep = E + (size_t)(nt * 16 + m) * 256 + q * 8;
#pragma unroll
            for (int ks = 0; ks < 8; ++ks) acc = mfma16(*(const bf16x8*)(ep + ks * 32), a[ks], acc);
            *(f32x4*)(o + nt * 16) = acc; }
    }
}
__device__ __forceinline__ void s5_carry(const Params& p, int l) {
    const int gid = blockIdx.x * NTHR + threadIdx.x; if (gid >= 32768) return;
    const int pp = gid & 63, d = (gid >> 6) & 1, g = (gid >> 7) & 15, b = gid >> 11;
    const int li = ((l * 2 + d) * 16 + g) * 64 + pp; const float lr = p.in[9][li], lim = p.in[10][li], dt = expf(p.in[11][(l * 2 + d) * 16 + g]);
    const float mag = expf(16.0f * dt * lr); float sn, cn; sincosf(16.0f * dt * lim, &sn, &cn); const float ar = mag * cn, ai = mag * sn;
    const float* SLOC = (const float*)(p.ws + U_SLOC); bf16_t* SP = (bf16_t*)(p.ws + U_SPREV);
    float sr = 0.f, si = 0.f;
#pragma unroll 8
    for (int n = 0; n < 144; ++n) { const int c = d == 0 ? n : (n < 16 ? 15 - n : 159 - n); const size_t idx = ((size_t)(b * 144 + c) * 16 + g) * 256 + d * 128 + pp;
        SP[idx] = f2bf(sr); SP[idx + 64] = f2bf(si);
        const float xr = SLOC[idx], xi = SLOC[idx + 64]; const float nr = ar * sr - ai * si + xr, ni = ar * si + ai * sr + xi; sr = nr; si = ni; }
}
__device__ __forceinline__ void s5_pass2_items(const Params& p, int l, int wid, int nw) {
    const int lane = threadIdx.x & 63, m = lane & 15, q = lane >> 4;
    const bf16_t* P = (const bf16_t*)(p.ws + U_P); const bf16_t* SP = (const bf16_t*)(p.ws + U_SPREV); bf16_t* YG = (bf16_t*)(p.ws + U_YG);
    for (int it = wid; it < 144 * 16; it += nw) { const int ct = it >> 4, g = it & 15; if (l == 1 && ct % 9 == 0) continue;
        const int cr = ct * 16 + m, rb = s5_rowbase(cr);
        const bf16_t* W2 = (const bf16_t*)(p.ws + WS_SW + (size_t)l * SW_STRIDE + SW_S5W2) + (size_t)g * 256 * 512;
        bf16x8 a[16];
#pragma unroll
        for (int ks = 0; ks < 8; ++ks) a[ks] = *(const bf16x8*)(P + (size_t)(rb + 2 * ks + (q >> 1)) * NINP + g * 16 + (q & 1) * 8);
#pragma unroll
        for (int ks = 8; ks < 16; ++ks) a[ks] = *(const bf16x8*)(SP + ((size_t)cr * 16 + g) * 256 + (ks - 8) * 32 + q * 8);
#pragma unroll 2
        for (int nt = 0; nt < 16; ++nt) { f32x4 acc = (f32x4){0.f, 0.f, 0.f, 0.f}; const bf16_t* wp = W2 + (size_t)(nt * 16 + m) * 512 + q * 8;
#pragma unroll
            for (int ks = 0; ks < 16; ++ks) acc = mfma16(*(const bf16x8*)(wp + ks * 32), a[ks], acc);
            float o[4];
#pragma unroll
            for (int j = 0; j < 4; ++j) { const float x = acc[j]; const float u = 0.7978845608f * (x + 0.044715f * x * x * x); const float th = 1.0f - 2.0f / (1.0f + __expf(2.0f * u)); o[j] = 0.5f * x * (1.0f + th); }
            u32x2 w; w.x = pack2(o[0], o[1]); w.y = pack2(o[2], o[3]); *(u32x2*)(YG + (size_t)(rb + nt) * 256 + g * 16 + q * 4) = w; }
    }
}
__device__ __forceinline__ void s5_glu_items(const Params& p, int l, int wid, int nw) {
    const int lane = threadIdx.x & 63, m = lane & 15, q = lane >> 4;
    const bf16_t* YG = (const bf16_t*)(p.ws + U_YG); bf16_t* YC = (bf16_t*)(p.ws + WS_ABUF);
    const bf16_t* GT = (const bf16_t*)(p.ws + WS_SW + (size_t)l * SW_STRIDE + SW_GLUT);
    const int nrt = (l == 0 ? NROW : NLAT) / 16;
    for (int rt = wid; rt < nrt; rt += nw) { const int row = rt * 16 + m;
        bf16x8 a[8];
#pragma unroll
        for (int ks = 0; ks < 8; ++ks) a[ks] = *(const bf16x8*)(YG + (size_t)row * 256 + ks * 32 + q * 8);
#pragma unroll 2
        for (int nt = 0; nt < 16; ++nt) { f32x4 acc = (f32x4){0.f, 0.f, 0.f, 0.f}; const bf16_t* gp = GT + (size_t)(nt * 16 + m) * 256 + q * 8;
#pragma unroll
            for (int ks = 0; ks < 8; ++ks) acc = mfma16(*(const bf16x8*)(gp + ks * 32), a[ks], acc);
            const int n = nt * 16 + q * 4; const float4 bv = *(const float4*)(p.in[18] + l * 256 + n); const u32x2 yw = *(const u32x2*)(YG + (size_t)row * 256 + n);
            u32x2 w; w.x = pack2(bflo(yw.x) * sigm(acc[0] + bv.x), bfhi(yw.x) * sigm(acc[1] + bv.y)); w.y = pack2(bflo(yw.y) * sigm(acc[2] + bv.z), bfhi(yw.y) * sigm(acc[3] + bv.w));
            *(u32x2*)(YC + (size_t)row * 1024 + n) = w; }
    }
}

template <bool HASLAT> __device__ __forceinline__ void na_unit(const Params& p, int l, int b, int h, int i, int n) {
    const int lane = threadIdx.x & 63, m = lane & 15, q = lane >> 4;
    const bf16_t* QR = (const bf16_t*)(p.ws + U_QR); const bf16_t* KR = (const bf16_t*)(p.ws + U_KR);
    const bf16_t* VTL = (const bf16_t*)(p.ws + U_VT) + (size_t)(b * 6 + h) * 64 * 2048; const bf16_t* VTC = (const bf16_t*)(p.ws + U_VTC) + (size_t)(b * 6 + h) * 64 * 256;
    const int qrow = HASLAT ? b * 2048 + i * 64 + n * 16 + m : NLAT + b * 256 + n * 16 + m;
    bf16x8 qf[2];
#pragma unroll
    for (int ks = 0; ks < 2; ++ks) qf[ks] = *(const bf16x8*)(QR + (size_t)qrow * 384 + h * 64 + ks * 32 + q * 8);
    const int r0 = HASLAT ? min(max(i - 4, 0), 24) : 0, scol = HASLAT ? min(max(n * 16 - 8, 0), 32) : 0;
    f32x4 sl[HASLAT ? 16 : 1], sc[16];
    float mx = -3.0e38f;
    if (HASLAT) { const int qc = n * 16 + m, c0 = min(max(qc - 8, 0), 48); const float* rpb = p.in[19] + (size_t)(l * 6 + h) * 15 * 31;
#pragma unroll
        for (int t = 0; t < 16; ++t) { const int kr = t >> 1, ch = t & 1; const bf16_t* kp = KR + (size_t)(b * 2048 + (r0 + kr) * 64 + scol + ch * 16 + m) * 384 + h * 64 + q * 8;
            f32x4 acc = (f32x4){0.f, 0.f, 0.f, 0.f};
#pragma unroll
            for (int ks = 0; ks < 2; ++ks) acc = mfma16(*(const bf16x8*)(kp + ks * 32), qf[ks], acc);
            const int dr = r0 + kr - i + 7;
#pragma unroll
            for (int j = 0; j < 4; ++j) { const int kc = scol + ch * 16 + q * 4 + j; const bool valid = kc >= c0 && kc < c0 + 16; const int dc = min(max(kc - qc + 15, 0), 30);
                const float s = valid ? acc[j] + rpb[dr * 31 + dc] : -1.0e30f; acc[j] = s; mx = fmaxf(mx, s); }
            sl[t] = acc; } }
#pragma unroll
    for (int t = 0; t < 16; ++t) { const bf16_t* kp = KR + (size_t)(NLAT + b * 256 + t * 16 + m) * 384 + h * 64 + q * 8;
        f32x4 acc = (f32x4){0.f, 0.f, 0.f, 0.f};
#pragma unroll
        for (int ks = 0; ks < 2; ++ks) acc = mfma16(*(const bf16x8*)(kp + ks * 32), qf[ks], acc);
#pragma unroll
        for (int j = 0; j < 4; ++j) mx = fmaxf(mx, acc[j]);
        sc[t] = acc; }
    mx = fmaxf(mx, __shfl_xor(mx, 16)); mx = fmaxf(mx, __shfl_xor(mx, 32));
    float sum = 0.f;
    f32x4 o[4];
#pragma unroll
    for (int dt = 0; dt < 4; ++dt) o[dt] = (f32x4){0.f, 0.f, 0.f, 0.f};
    if (HASLAT) {
#pragma unroll
        for (int kr = 0; kr < 8; ++kr) { float e[8];
#pragma unroll
            for (int j = 0; j < 4; ++j) { e[j] = __expf(sl[2 * kr][j] - mx); e[4 + j] = __expf(sl[2 * kr + 1][j] - mx); }
#pragma unroll
            for (int j = 0; j < 8; ++j) sum += e[j];
            const uint4 pw = pack8(e); const bf16x8 pf = __builtin_bit_cast(bf16x8, pw);
            const int tok = (r0 + kr) * 64 + scol + q * 4;
#pragma unroll
            for (int dt = 0; dt < 4; ++dt) { const bf16_t* vp = VTL + (size_t)(dt * 16 + m) * 2048 + tok; const u32x2 v0 = *(const u32x2*)vp, v1 = *(const u32x2*)(vp + 16);
                const uint4 vw = make_uint4(v0.x, v0.y, v1.x, v1.y); o[dt] = mfma16(__builtin_bit_cast(bf16x8, vw), pf, o[dt]); } } }
#pragma unroll
    for (int t2 = 0; t2 < 8; ++t2) { float e[8];
#pragma unroll
        for (int j = 0; j < 4; ++j) { e[j] = __expf(sc[2 * t2][j] - mx); e[4 + j] = __expf(sc[2 * t2 + 1][j] - mx); }
#pragma unroll
        for (int j = 0; j < 8; ++j) sum += e[j];
        const uint4 pw = pack8(e); const bf16x8 pf = __builtin_bit_cast(bf16x8, pw);
        const int tok = t2 * 32 + q * 4;
#pragma unroll
        for (int dt = 0; dt < 4; ++dt) { const bf16_t* vp = VTC + (size_t)(dt * 16 + m) * 256 + tok; const u32x2 v0 = *(const u32x2*)vp, v1 = *(const u32x2*)(vp + 16);
            const uint4 vw = make_uint4(v0.x, v0.y, v1.x, v1.y); o[dt] = mfma16(__builtin_bit_cast(bf16x8, vw), pf, o[dt]); } }
    sum += __shfl_xor(sum, 16); sum += __shfl_xor(sum, 32);
    const float inv = 1.0f / sum;
    bf16_t* yo = (bf16_t*)(p.ws + WS_ABUF) + (size_t)qrow * 1024 + 256 + h * 64 + q * 4;
#pragma unroll
    for (int dt = 0; dt < 4; ++dt) { u32x2 w; w.x = pack2(o[dt][0] * inv, o[dt][1] * inv); w.y = pack2(o[dt][2] * inv, o[dt][3] * inv); *(u32x2*)(yo + dt * 16) = w; }
}
__device__ __forceinline__ void na_items(const Params& p, int l, int wid, int nw) {
    const int nlat = 16 * 6 * 32 * 4, nctx = (l == 0) ? 16 * 6 * 16 : 0;
    for (int it = wid; it < nlat + nctx; it += nw) {
        if (it < nlat) { const int n = it & 3, i = (it >> 2) & 31, bh = it >> 7; na_unit<true>(p, l, bh / 6, bh % 6, i, n); }
        else { const int j = it - nlat, n = j & 15, bh = j >> 4; na_unit<false>(p, l, bh / 6, bh % 6, 0, n); }
    }
}

__device__ __forceinline__ int rk_row(int b, int d, int n) { return n < 256 ? NLAT + b * 256 + (d ? 255 - n : n) : b * 2048 + (d ? 2047 - (n - 256) : (n - 256)); }
__device__ __forceinline__ void rwkv_scan_unit(const Params& p, int l, int unit, LAS unsigned char* lds) {
    const int tid = threadIdx.x, b = unit / 12, h = (unit % 12) >> 1, d = unit & 1;
    const int i = tid >> 3, q = tid & 7, j = tid & 63;
    LAS float* buf = (LAS float*)lds;
    const bf16_t* RS = (const bf16_t*)(p.ws + U_RS); const bf16_t* KS = (const bf16_t*)(p.ws + U_KS); const bf16_t* VS = (const bf16_t*)(p.ws + U_VS); const bf16_t* KK = (const bf16_t*)(p.ws + U_KK);
    const bf16_t* AG = (const bf16_t*)(p.ws + U_AG + (size_t)d * SZ384); const bf16_t* LD = (const bf16_t*)(p.ws + U_LD + (size_t)d * SZ384);
    float* Y = (float*)(p.ws + U_YRK) + (size_t)d * NROW * 384;
    const float ka = p.in[27][l * 384 + h * 64 + j];
    float S[8];
#pragma unroll
    for (int k = 0; k < 8; ++k) S[k] = 0.f;
    bf16_t st[4][6];
#define RK_LOAD(cn) do { _Pragma("unroll") for (int k = 0; k < 4; ++k) { const int sx = (tid >> 6) + 8 * k; const size_t o = (size_t)rk_row(b, d, (cn) * 32 + sx) * 384 + h * 64 + j; \
        st[k][0] = RS[o]; st[k][1] = KS[o]; st[k][2] = VS[o]; st[k][3] = KK[o]; st[k][4] = AG[o]; st[k][5] = LD[o]; } } while (0)
#define RK_STORE(nb) do { _Pragma("unroll") for (int k = 0; k < 4; ++k) { const int sx = (tid >> 6) + 8 * k; LAS float* o = buf + ((nb) * 32 + sx) * 384 + j; \
        const float r_ = bf2f(st[k][0]), k_ = bf2f(st[k][1]), v_ = bf2f(st[k][2]), kk_ = bf2f(st[k][3]), ag_ = bf2f(st[k][4]), ld_ = bf2f(st[k][5]); \
        o[0] = __expf(ld_); o[64] = k_ * (1.0f + (ag_ - 1.0f) * ka); o[128] = kk_ * ag_; o[192] = -kk_; o[256] = r_; o[320] = v_; } } while (0)
    __syncthreads();
    RK_LOAD(0); RK_STORE(0);
    __syncthreads();
    for (int cn = 0; cn < 72; ++cn) {
        if (cn + 1 < 72) RK_LOAD(cn + 1);
        const LAS float* cb = buf + (cn & 1) * 32 * 384;
        for (int s = 0; s < 32; ++s) { const LAS float* o = cb + s * 384 + q * 8;
            const lf4 w0 = *(const LAS lf4*)(o), w1 = *(const LAS lf4*)(o + 4), k0 = *(const LAS lf4*)(o + 64), k1 = *(const LAS lf4*)(o + 68), b0 = *(const LAS lf4*)(o + 128), b1 = *(const LAS lf4*)(o + 132);
            const lf4 a0 = *(const LAS lf4*)(o + 192), a1 = *(const LAS lf4*)(o + 196), r0 = *(const LAS lf4*)(o + 256), r1 = *(const LAS lf4*)(o + 260);
            const float vi = cb[s * 384 + 320 + i];
            float sa = S[0] * a0.x + S[1] * a0.y + S[2] * a0.z + S[3] * a0.w + S[4] * a1.x + S[5] * a1.y + S[6] * a1.z + S[7] * a1.w;
            sa += __shfl_xor(sa, 1); sa += __shfl_xor(sa, 2); sa += __shfl_xor(sa, 4);
            S[0] = S[0] * w0.x + (sa * b0.x + vi * k0.x); S[1] = S[1] * w0.y + (sa * b0.y + vi * k0.y); S[2] = S[2] * w0.z + (sa * b0.z + vi * k0.z); S[3] = S[3] * w0.w + (sa * b0.w + vi * k0.w);
            S[4] = S[4] * w1.x + (sa * b1.x + vi * k1.x); S[5] = S[5] * w1.y + (sa * b1.y + vi * k1.y); S[6] = S[6] * w1.z + (sa * b1.z + vi * k1.z); S[7] = S[7] * w1.w + (sa * b1.w + vi * k1.w);
            float y = S[0] * r0.x + S[1] * r0.y + S[2] * r0.z + S[3] * r0.w + S[4] * r1.x + S[5] * r1.y + S[6] * r1.z + S[7] * r1.w;
            y += __shfl_xor(y, 1); y += __shfl_xor(y, 2); y += __shfl_xor(y, 4);
            if (q == 0) Y[(size_t)rk_row(b, d, cn * 32 + s) * 384 + h * 64 + i] = y; }
        if (cn + 1 < 72) RK_STORE((cn + 1) & 1);
        __syncthreads();
    }
#undef RK_LOAD
#undef RK_STORE
}

__device__ __forceinline__ void rwkv_finish(const Params& p, int l) {
    const int sub = threadIdx.x & 7; const int npair = (l == 0 ? NROW : NLAT) * 6;
    const bf16_t* RS = (const bf16_t*)(p.ws + U_RS); const bf16_t* KS = (const bf16_t*)(p.ws + U_KS); const bf16_t* VS = (const bf16_t*)(p.ws + U_VS);
    const bf16_t* AG0 = (const bf16_t*)(p.ws + U_AG); const bf16_t* AG1 = (const bf16_t*)(p.ws + U_AG + SZ384); const bf16_t* G = (const bf16_t*)(p.ws + U_G);
    const float* Y0 = (const float*)(p.ws + U_YRK); const float* Y1 = Y0 + (size_t)NROW * 384; bf16_t* YC = (bf16_t*)(p.ws + WS_ABUF);
    for (int pr = (blockIdx.x * NTHR + threadIdx.x) >> 3; pr < npair; pr += (gridDim.x * NTHR) >> 3) { const int row = pr / 6, h = pr % 6, col = h * 64 + sub * 8; const size_t o = (size_t)row * 384 + col;
        float y[8]; { const float4 a0 = *(const float4*)(Y0 + o), a1 = *(const float4*)(Y0 + o + 4), c0 = *(const float4*)(Y1 + o), c1 = *(const float4*)(Y1 + o + 4);
            y[0] = a0.x + c0.x; y[1] = a0.y + c0.y; y[2] = a0.z + c0.z; y[3] = a0.w + c0.w; y[4] = a1.x + c1.x; y[5] = a1.y + c1.y; y[6] = a1.z + c1.z; y[7] = a1.w + c1.w; }
        float s = 0.f;
#pragma unroll
        for (int k = 0; k < 8; ++k) s += y[k];
        s += __shfl_xor(s, 1); s += __shfl_xor(s, 2); s += __shfl_xor(s, 4); const float mean = s * (1.0f / 64.0f);
        float v2 = 0.f;
#pragma unroll
        for (int k = 0; k < 8; ++k) { const float dd = y[k] - mean; v2 += dd * dd; }
        v2 += __shfl_xor(v2, 1); v2 += __shfl_xor(v2, 2); v2 += __shfl_xor(v2, 4); const float rstd = rsqrtf(v2 * (1.0f / 64.0f) + 64e-5f);
        float r[8], kx[8], vx[8], a0[8], a1[8], gx[8];
        unpack8(*(const uint4*)(RS + o), r); unpack8(*(const uint4*)(KS + o), kx); unpack8(*(const uint4*)(VS + o), vx); unpack8(*(const uint4*)(AG0 + o), a0); unpack8(*(const uint4*)(AG1 + o), a1); unpack8(*(const uint4*)(G + o), gx);
        const float* ka = p.in[27] + l * 384 + col; const float* rk = p.in[28] + l * 384 + col; const float* lw = p.in[29] + l * 384 + col; const float* lb = p.in[30] + l * 384 + col;
        float bs = 0.f;
#pragma unroll
        for (int k = 0; k < 8; ++k) { const float kd0 = kx[k] * (1.0f + (a0[k] - 1.0f) * ka[k]), kd1 = kx[k] * (1.0f + (a1[k] - 1.0f) * ka[k]); bs += r[k] * (kd0 + kd1) * rk[k]; }
        bs += __shfl_xor(bs, 1); bs += __shfl_xor(bs, 2); bs += __shfl_xor(bs, 4);
        float ov[8];
#pragma unroll
        for (int k = 0; k < 8; ++k) ov[k] = ((y[k] - mean) * rstd * lw[k] + lb[k] + bs * vx[k]) * gx[k];
        *(uint4*)(YC + (size_t)row * 1024 + 640 + col) = pack8(ov);
    }
}

__device__ __forceinline__ void phase_normrouter(const Params& p, int l, const float* xl, const float* xc, LAS unsigned char* lds) {
    LAS float* rt = (LAS float*)lds;
    for (int i = threadIdx.x; i < 1024 * 16 / 4; i += NTHR) *(LAS lf4*)(rt + i * 4) = *(const lf4*)(p.in[31] + (size_t)l * 1024 * 16 + i * 4);
    __syncthreads();
    const int lane = threadIdx.x & 63, wv = threadIdx.x >> 6; const int nrow = l == 0 ? NROW : NLAT;
    const float* mod = (const float*)(p.ws + WS_MOD) + (size_t)l * 17 * 6144; const float* g1 = p.in[6] + (l * 4 + 1) * 1024; const float* g2 = p.in[6] + (l * 4 + 2) * 1024;
    const float* Y = (const float*)(p.ws + U_Y); bf16_t* A = (bf16_t*)(p.ws + WS_ABUF); float* AFF = (float*)(p.ws + WS_AFF);
    for (int r = blockIdx.x * 8 + wv; r < nrow; r += gridDim.x * 8) { const int b = r < NLAT ? (r >> 11) : 16; const float* mb = mod + (size_t)b * 6144;
        const float* xs = xrow(xl, xc, r); float* xd = xrow_w(p.out, (float*)(p.ws + WS_CTXA), r);
        float4 y[4], x[4]; float ss = 0.f;
#pragma unroll
        for (int i = 0; i < 4; ++i) { y[i] = *(const float4*)(Y + (size_t)r * 1024 + i * 256 + lane * 4); x[i] = *(const float4*)(xs + i * 256 + lane * 4); ss += y[i].x * y[i].x + y[i].y * y[i].y + y[i].z * y[i].z + y[i].w * y[i].w; }
        ss = wave_sum(ss); const float rs = rsqrtf(ss * (1.0f / 1024.0f) + 1e-6f);
        float s2 = 0.f;
#pragma unroll
        for (int i = 0; i < 4; ++i) { const int c = i * 256 + lane * 4; const float4 gg = *(const float4*)(g1 + c), gt = *(const float4*)(mb + 2048 + c);
            x[i].x += gt.x * (y[i].x * rs * gg.x); x[i].y += gt.y * (y[i].y * rs * gg.y); x[i].z += gt.z * (y[i].z * rs * gg.z); x[i].w += gt.w * (y[i].w * rs * gg.w);
            *(float4*)(xd + c) = x[i]; s2 += x[i].x * x[i].x + x[i].y * x[i].y + x[i].z * x[i].z + x[i].w * x[i].w; }
        s2 = wave_sum(s2); const float rs2 = rsqrtf(s2 * (1.0f / 1024.0f) + 1e-6f);
        LAS float* hr = (LAS float*)(lds + 65536) + wv * 1024;
#pragma unroll
        for (int i = 0; i < 4; ++i) { const int c = i * 256 + lane * 4; const float4 gg = *(const float4*)(g2 + c), sh = *(const float4*)(mb + 3072 + c), sc = *(const float4*)(mb + 4096 + c);
            const float hv[4] = {x[i].x * rs2 * gg.x * (1.f + sc.x) + sh.x, x[i].y * rs2 * gg.y * (1.f + sc.y) + sh.y, x[i].z * rs2 * gg.z * (1.f + sc.z) + sh.z, x[i].w * rs2 * gg.w * (1.f + sc.w) + sh.w};
            u32x2 o; o.x = pack2(hv[0], hv[1]); o.y = pack2(hv[2], hv[3]); *(u32x2*)(A + (size_t)r * 1024 + c) = o;
            *(LAS lf4*)(hr + c) = (lf4){hv[0], hv[1], hv[2], hv[3]}; }
        const int e = lane & 15, cq = lane >> 4; float lgt = 0.f;
#pragma unroll 4
        for (int c4 = 0; c4 < 64; ++c4) { const int c = cq * 256 + c4 * 4; const lf4 hv4 = *(const LAS lf4*)(hr + c);
            lgt += hv4.x * rt[c * 16 + e] + hv4.y * rt[(c + 1) * 16 + e] + hv4.z * rt[(c + 2) * 16 + e] + hv4.w * rt[(c + 3) * 16 + e]; }
        lgt += __shfl_xor(lgt, 16); lgt += __shfl_xor(lgt, 32);
        float mxl = lgt;
#pragma unroll
        for (int o = 8; o >= 1; o >>= 1) mxl = fmaxf(mxl, __shfl_xor(mxl, o));
        const float ex = expf(lgt - mxl); float den = ex;
#pragma unroll
        for (int o = 8; o >= 1; o >>= 1) den += __shfl_xor(den, o);
        if (lane < 16) AFF[(size_t)r * 16 + lane] = ex / den;
    }
}

__device__ __forceinline__ void phase_topk(const Params& p, int l, LAS unsigned char* lds) {
    LAS float* vals = (LAS float*)lds; LAS int* toks = (LAS int*)(lds + 8192);
    const int tid = threadIdx.x, nitem = l == 0 ? 512 : 256;
    const float* AFF = (const float*)(p.ws + WS_AFF); int* SLOT = (int*)(p.ws + WS_SLOT); float* SELG = (float*)(p.ws + WS_SELG);
    const bf16_t* A = (const bf16_t*)(p.ws + WS_ABUF); bf16_t* XS = (bf16_t*)(p.ws + U_XSEL);
    for (int it = blockIdx.x; it < nitem; it += gridDim.x) { const bool lat = it < 256; const int be = it & 255, b = be >> 4, e = be & 15;
        const int n = lat ? SEQ : CTXL, cap = lat ? 256 : 32, rowbase = lat ? b * 2048 : NLAT + b * 256, xoff = lat ? b * 256 : 4096 + b * 32;
        __syncthreads();
        for (int t = tid; t < n; t += NTHR) vals[t] = AFF[(size_t)(rowbase + t) * 16 + e];
        __syncthreads();
        for (int t = tid; t < n; t += NTHR) { const float v = vals[t]; int cnt = 0;
            for (int t2 = 0; t2 < n; t2 += 4) { const lf4 w = *(const LAS lf4*)(vals + t2);
                cnt += (w.x > v || (w.x == v && t2 < t)) ? 1 : 0; cnt += (w.y > v || (w.y == v && t2 + 1 < t)) ? 1 : 0; cnt += (w.z > v || (w.z == v && t2 + 2 < t)) ? 1 : 0; cnt += (w.w > v || (w.w == v && t2 + 3 < t)) ? 1 : 0; }
            if (cnt < cap) { SELG[e * XROWS + xoff + cnt] = v; toks[cnt] = t; SLOT[(size_t)(rowbase + t) * 16 + e] = cnt; } else SLOT[(size_t)(rowbase + t) * 16 + e] = -1; }
        __syncthreads();
        for (int s = tid >> 6; s < cap; s += 8) { const uint4* src = (const uint4*)(A + (size_t)(rowbase + toks[s]) * 1024); uint4* dst = (uint4*)(XS + ((size_t)e * XROWS + xoff + s) * 1024); const int lane = tid & 63;
            dst[lane] = src[lane]; dst[lane + 64] = src[lane + 64]; }
    }
}

struct GroupedOrder { int nMl, nNl, G, c, total;
    __device__ void init(int nMl_, int nNl_, int G_, int c_) { nMl = nMl_; nNl = nNl_; G = G_; c = c_; total = 16 * nMl_ * nNl_; }
    __device__ bool next(int i, pg8::Unit& u) const { const long L = (long)i * G + c; if (L >= total) return false; const int per = nMl * nNl, e = (int)(L / per), rem = (int)(L % per), pnl = rem / nMl, pml = rem % nMl;
        u.pm = e * 18 + pml; u.pn = e * nNl + pnl; return true; }
    __device__ __forceinline__ void a_ready(const pg8::Unit&) const {}
    __device__ __forceinline__ void done(const pg8::Unit&) const {}
};
struct EpiSwiGLU { static constexpr bool PERM = true, AFTER_DRAIN = false; bf16_t* H;
    __device__ __forceinline__ void operator()(const f32x4 (&acc)[2][2][4][2], const pg8::Unit& u, int wr, int wc, int fr, int fq) const {
        const int e = u.pn / 22, pnl = u.pn - e * 22; const int row0 = u.pm * 256 + wr * 64 + fr, col0 = pnl * 128 + wc * 32 + 8 * fq;
#pragma unroll
        for (int ai = 0; ai < 2; ++ai)
#pragma unroll
            for (int m = 0; m < 4; ++m) { bf16_t* rowp = H + (size_t)(row0 + ai * 128 + m * 16) * DE + col0; float o[8];
#pragma unroll
                for (int n = 0; n < 2; ++n)
#pragma unroll
                    for (int j = 0; j < 4; ++j) { const float g = acc[ai][0][m][n][j], uu = acc[ai][1][m][n][j]; o[n * 4 + j] = g * sigm(g) * uu; }
                *(uint4*)rowp = pack8(o); }
    }
};
struct EpiGate { static constexpr bool PERM = true, AFTER_DRAIN = false; bf16_t* O; const float* gate;
    __device__ __forceinline__ void operator()(const f32x4 (&acc)[2][2][4][2], const pg8::Unit& u, int wr, int wc, int fr, int fq) const {
        const int pnl = u.pn & 3; const int row0 = u.pm * 256 + wr * 64 + fr, col0 = pnl * 256 + wc * 32 + 8 * fq;
#pragma unroll
        for (int ai = 0; ai < 2; ++ai)
#pragma unroll
            for (int m = 0; m < 4; ++m) { const int r = row0 + ai * 128 + m * 16; const float gt = gate[r]; bf16_t* rowp = O + (size_t)r * 1024 + col0;
#pragma unroll
                for (int bj = 0; bj < 2; ++bj) { float o[8];
#pragma unroll
                    for (int n = 0; n < 2; ++n)
#pragma unroll
                        for (int j = 0; j < 4; ++j) o[n * 4 + j] = acc[ai][bj][m][n][j] * gt;
                    *(uint4*)(rowp + bj * 128) = pack8(o); } }
    }
};

__device__ __forceinline__ void phase_combine(const Params& p, int l) {
    const int lane = threadIdx.x & 63, wv = threadIdx.x >> 6; const int nrow = l == 0 ? NROW : NLAT;
    const float* mod = (const float*)(p.ws + WS_MOD) + (size_t)l * 17 * 6144; const float* g3 = p.in[6] + (l * 4 + 3) * 1024;
    const int* SLOT = (const int*)(p.ws + WS_SLOT); const bf16_t* YE = (const bf16_t*)(p.ws + U_YEXP); bf16_t* A = (bf16_t*)(p.ws + WS_ABUF);
    for (int r = blockIdx.x * 8 + wv; r < nrow; r += gridDim.x * 8) { const bool lat = r < NLAT; const int b = lat ? (r >> 11) : ((r - NLAT) >> 8), mbi = lat ? b : 16, xoff = lat ? b * 256 : 4096 + b * 32;
        const float* mb = mod + (size_t)mbi * 6144;
        float f[16];
#pragma unroll
        for (int k = 0; k < 16; ++k) f[k] = 0.f;
        const int myslot = lane < 16 ? SLOT[(size_t)r * 16 + lane] : -1;
        for (int e = 0; e < 16; ++e) { const int s = __shfl(myslot, e); if (s >= 0) { const bf16_t* yr = YE + ((size_t)e * XROWS + xoff + s) * 1024 + lane * 4;
#pragma unroll
                for (int i = 0; i < 4; ++i) { const u32x2 w = *(const u32x2*)(yr + i * 256); f[i * 4] += bflo(w.x); f[i * 4 + 1] += bfhi(w.x); f[i * 4 + 2] += bflo(w.y); f[i * 4 + 3] += bfhi(w.y); } } }
        float ss = 0.f;
#pragma unroll
        for (int k = 0; k < 16; ++k) ss += f[k] * f[k];
        ss = wave_sum(ss); const float rs = rsqrtf(ss * (1.0f / 1024.0f) + 1e-6f);
        const float* x1 = xrow(p.out, (const float*)(p.ws + WS_CTXA), r);
        float* x2 = l == 0 ? xrow_w((float*)(p.ws + WS_XB), (float*)(p.ws + WS_CTXB), r) : p.out + (size_t)r * D;
        float4 xv[4];
#pragma unroll
        for (int i = 0; i < 4; ++i) { const int c = i * 256 + lane * 4; const float4 gg = *(const float4*)(g3 + c), gt = *(const float4*)(mb + 5120 + c); float4 x = *(const float4*)(x1 + c);
            x.x += gt.x * (f[i * 4] * rs * gg.x); x.y += gt.y * (f[i * 4 + 1] * rs * gg.y); x.z += gt.z * (f[i * 4 + 2] * rs * gg.z); x.w += gt.w * (f[i * 4 + 3] * rs * gg.w);
            *(float4*)(x2 + c) = x; xv[i] = x; }
        if (l == 0) { const float* mb1 = mod + (size_t)17 * 6144 + (size_t)mbi * 6144; hnorm_row(nullptr, p.in[6] + 4 * 1024, mb1, mb1 + 1024, A + (size_t)r * 1024, lane, xv); }
    }
}

#ifndef MK_ONLY
#define MK_ONLY -1
#endif
#define EN(k) (MK_ONLY < 0 || MK_ONLY == (k))
constexpr int PH_PER_LAYER = 13, N_PHASES = 1 + 2 * PH_PER_LAYER;
#define IN(k) (lo <= (k) && (k) < hi)
#define SEAM(k) do { if (p.use_bar && IN(k) && IN((k) + 1)) xcd_barrier(bar); } while (0)
template <int l> __device__ __forceinline__ void layer_phases(const Params& p, LAS unsigned char* lds, const XcdBarrier& bar, const int lo, const int hi) {
    const int wv = __builtin_amdgcn_readfirstlane(threadIdx.x >> 6), G = gridDim.x; const int wid = blockIdx.x * 8 + wv, nw = G * 8;
        const int pb = 1 + l * PH_PER_LAYER;
        const float* xl = l == 0 ? p.in[0] : (const float*)(p.ws + WS_XB);
        const float* xc = l == 0 ? p.in[2] : (const float*)(p.ws + WS_CTXB);
        if (EN(0) && IN(pb + 0)) { if (l == 0) phase_hnorm(p, 0, xl, xc); }
        SEAM(pb + 0);
        if (EN(1) && IN(pb + 1)) { pg8::Gemm g{(const bf16_t*)(p.ws + WS_ABUF), (const bf16_t*)(p.ws + WS_WIN), NROW, NINP, D}; pg8::StaticOrder S; S.init(NROW, NINP, G, (int)blockIdx.x);
            pg8::EpiBf16<0> E{(bf16_t*)(p.ws + U_P), NINP, nullptr, 0, 0}; pg8::gemm_phase<pg8::EpiBf16<0>, pg8::StaticOrder, false>(lds, g, S, E, nullptr); }
        SEAM(pb + 1);
        if (EN(2) && IN(pb + 2)) phase_prep(p, l, lds);
        SEAM(pb + 2);
        if (EN(3) && IN(pb + 3)) { lowrank_items(p, l, wid, nw); s5_pass1_items(p, l, wid, nw); }
        SEAM(pb + 3);
        if (EN(4) && IN(pb + 4)) { s5_carry(p, l); na_items(p, l, wid, nw); }
        SEAM(pb + 4);
        if (EN(5) && IN(pb + 5)) {
            if (G > 192) { if ((int)blockIdx.x < 192) rwkv_scan_unit(p, l, blockIdx.x, lds); else s5_pass2_items(p, l, ((int)blockIdx.x - 192) * 8 + wv, (G - 192) * 8); }
            else { for (int u = blockIdx.x; u < 192; u += G) rwkv_scan_unit(p, l, u, lds); s5_pass2_items(p, l, wid, nw); }
        }
        SEAM(pb + 5);
        if (EN(6) && IN(pb + 6)) { s5_glu_items(p, l, wid, nw); rwkv_finish(p, l); }
        SEAM(pb + 6);
        if (EN(7) && IN(pb + 7)) { const int M = l == 0 ? NROW : NLAT; pg8::Gemm g{(const bf16_t*)(p.ws + WS_ABUF), (const bf16_t*)(p.ws + WS_WOUT), M, D, D}; pg8::StaticOrder S; S.init(M, D, G, (int)blockIdx.x);
            pg8::EpiF32 E{(float*)(p.ws + U_Y), D, nullptr}; pg8::gemm_phase<pg8::EpiF32, pg8::StaticOrder, false>(lds, g, S, E, nullptr); }
        SEAM(pb + 7);
        if (EN(8) && IN(pb + 8)) phase_normrouter(p, l, xl, xc, lds);
        SEAM(pb + 8);
        if (EN(9) && IN(pb + 9)) phase_topk(p, l, lds);
        SEAM(pb + 9);
        if (EN(10) && IN(pb + 10)) { pg8::Gemm g{(const bf16_t*)(p.ws + U_XSEL), (const bf16_t*)(p.ws + WS_WGU), 16 * XROWS, 16 * 5632, D}; GroupedOrder S; S.init(l == 0 ? 18 : 16, 22, G, (int)blockIdx.x);
            EpiSwiGLU E{(bf16_t*)(p.ws + U_HID)}; pg8::gemm_phase<EpiSwiGLU, GroupedOrder, false>(lds, g, S, E, nullptr); }
        SEAM(pb + 10);
        if (EN(11) && IN(pb + 11)) { pg8::Gemm g{(const bf16_t*)(p.ws + U_HID), (const bf16_t*)(p.ws + WS_WD), 16 * XROWS, 16 * 1024, DE}; GroupedOrder S; S.init(l == 0 ? 18 : 16, 4, G, (int)blockIdx.x);
            EpiGate E{(bf16_t*)(p.ws + U_YEXP), (const float*)(p.ws + WS_SELG)}; pg8::gemm_phase<EpiGate, GroupedOrder, false>(lds, g, S, E, nullptr); }
        SEAM(pb + 11);
        if (EN(12) && IN(pb + 12)) { phase_combine(p, l); if (l == 0) convert_weights(p, 1, lds, (int)blockIdx.x, G); }
        SEAM(pb + 12);
}
__global__ void __launch_bounds__(NTHR, 2) fwd(Params p) {
    extern __shared__ __attribute__((aligned(16))) unsigned char lds_raw[];
    LAS unsigned char* lds = (LAS unsigned char*)lds_raw;
    const int tid = threadIdx.x;
    if (tid < 4) ((LAS unsigned*)(lds + LDS_MISC))[tid] = 0u;
    __syncthreads();
    XcdBarrier bar; bar.bar = (unsigned*)(p.ws + WS_CTL); bar.x = 0; bar.st = (volatile LAS unsigned*)(lds + LDS_MISC);
    if (p.use_bar) bar = xcd_barrier_post((unsigned*)(p.ws + WS_CTL), (volatile LAS unsigned*)(lds + LDS_MISC));
    const int lo = p.ph_lo, hi = p.ph_hi;

    if (EN(100) && IN(0)) { phase_prologue(p, lds); }
    SEAM(0);
    layer_phases<0>(p, lds, bar, lo, hi);
    layer_phases<1>(p, lds, bar, lo, hi);
#undef IN
#undef SEAM
}
}

#ifndef MK_ONE_LAUNCH
#define MK_ONE_LAUNCH 1
#endif
extern "C" void kernel_launch(void* const* d_in, const int* in_sizes, int n_in, void* d_out, int out_size, void* d_ws, size_t ws_size, hipStream_t stream) {
    static int grid = 0;
    if (grid == 0) {
        if (n_in != 35 || out_size != mk::NLAT * mk::D || ws_size < mk::WS_END) { fprintf(stderr, "kernel_launch: unexpected problem (n_in %d, out %d, ws %zu < %zu)\n", n_in, out_size, ws_size, (size_t)mk::WS_END); grid = -1; return; }
        int dev = 0, cus = 0, per_cu = 0;
        if (hipGetDevice(&dev) != hipSuccess || hipDeviceGetAttribute(&cus, hipDeviceAttributeMultiprocessorCount, dev) != hipSuccess) { grid = -1; return; }
        if (hipFuncSetAttribute((const void*)mk::fwd, hipFuncAttributeMaxDynamicSharedMemorySize, mk::LDS_BYTES) != hipSuccess) { fprintf(stderr, "kernel_launch: hipFuncSetAttribute failed\n"); grid = -1; return; }
        if (hipOccupancyMaxActiveBlocksPerMultiprocessor(&per_cu, (const void*)mk::fwd, mk::NTHR, mk::LDS_BYTES) != hipSuccess || per_cu < 1) { fprintf(stderr, "kernel_launch: occupancy query says %d\n", per_cu); per_cu = 1; }
        (void)hipGetLastError();
        grid = cus;
    }
    if (grid < 0) return;
    (void)in_sizes;
    if (hipMemsetAsync(d_ws, 0, 65536, stream) != hipSuccess) return;
    mk::Params a{};
    for (int i = 0; i < 35; ++i) a.in[i] = (const float*)d_in[i];
    a.out = (float*)d_out; a.ws = (unsigned char*)d_ws;
#if MK_ONE_LAUNCH
    a.ph_lo = 0; a.ph_hi = mk::N_PHASES; a.use_bar = 1;
    hipLaunchKernelGGL(mk::fwd, dim3(grid), dim3(mk::NTHR), mk::LDS_BYTES, stream, a);
#else
    for (int ph = 0; ph < mk::N_PHASES; ++ph) { a.ph_lo = ph; a.ph_hi = ph + 1; a.use_bar = 0; hipLaunchKernelGGL(mk::fwd, dim3(grid), dim3(mk::NTHR), mk::LDS_BYTES, stream, a); }
#endif
}
```

```cpp
#include <hip/hip_runtime.h>
#include <cstdio>
#include <cstdint>
namespace pg8 {
#define PG8_LAS __attribute__((address_space(3)))
typedef unsigned short bf16_t;
typedef short bf16x8 __attribute__((ext_vector_type(8)));
typedef float f32x4 __attribute__((ext_vector_type(4)));
typedef unsigned u32x4 __attribute__((ext_vector_type(4)));
constexpr int BM = 256, BK = 64, HALF = 128, HTB = HALF * BK * 2  , STAGE_BYTES = 8 * HTB, NXCD = 8, WGM = 8;

__host__ __device__ __forceinline__ int lds_byte(int r, int c) { const int st = (r >> 4) * 2 + (c >> 5), rr = r & 15, cc = c & 31, ob = rr * 64 + cc * 2; return st * 1024 + (ob ^ (((ob >> 9) & 1) << 5)); }
__host__ __device__ __forceinline__ void stage_rc(int b, int& R, int& C) { const int st = b / 1024, sb = b % 1024, swz = sb ^ (((sb >> 9) & 1) << 5); R = (st >> 1) * 16 + swz / 64; C = (st & 1) * 32 + (swz % 64) / 2; }
__host__ __device__ __forceinline__ int perm32(int rho) { const int n = rho >> 4, i = rho & 15; return 8 * (i >> 2) + 4 * n + (i & 3); }

struct Unit { int pm, pn; };
struct Gemm { const bf16_t* A; const bf16_t* Bt; int M, N, K; };

struct StaticOrder {
    int nM, nN, nwg, G, c;
    __host__ __device__ void init(int M, int N, int G_, int c_) { nM = M / BM; nN = N / BM; nwg = nM * nN; G = G_; c = c_; }
    __host__ __device__ bool next(int i, Unit& u) const {
        const long L = (long)i * G + c; if (L >= nwg) return false;
        int wgid = (int)L; { const int q = nwg / NXCD, r = nwg % NXCD, xcd = wgid % NXCD, off = wgid / NXCD; wgid = (xcd < r ? xcd * (q + 1) : r * (q + 1) + (xcd - r) * q) + off; }
        const int nig = WGM * nN, gid = wgid / nig, fm = gid * WGM, gsz = (nM - fm) < WGM ? (nM - fm) : WGM;
        u.pm = fm + ((wgid % nig) % gsz); u.pn = (wgid % nig) / gsz; return true;
    }
    __device__ __forceinline__ void a_ready(const Unit&) const {}
    __device__ __forceinline__ void done(const Unit&) const {}
};
struct CountedOrder : StaticOrder {
    const unsigned* ready; unsigned need; unsigned* tmo;
    __device__ __forceinline__ void a_ready(const Unit& u) const {
        if (threadIdx.x < 64) {
            const unsigned long long t0 = __builtin_amdgcn_s_memrealtime(); unsigned polls = 0;
            while ((unsigned)__builtin_amdgcn_readfirstlane(__hip_atomic_load(ready + 64 * u.pm, __ATOMIC_RELAXED, __HIP_MEMORY_SCOPE_AGENT)) < need) {
                if ((++polls & 255u) == 0u && __builtin_amdgcn_readfirstlane(__hip_atomic_load(tmo, __ATOMIC_RELAXED, __HIP_MEMORY_SCOPE_AGENT)) != 0u) break;
                if (__builtin_amdgcn_s_memrealtime() - t0 > 2000000ull) {
                    if (threadIdx.x == 0) { unsigned expect = 0u; __hip_atomic_compare_exchange_strong(tmo + 1, &expect, 0x600u | (unsigned)(u.pm & 0xff), __ATOMIC_RELAXED, __ATOMIC_RELAXED, __HIP_MEMORY_SCOPE_AGENT); __hip_atomic_store(tmo, 1u, __ATOMIC_RELAXED, __HIP_MEMORY_SCOPE_AGENT); }
                    break; }
                __builtin_amdgcn_s_sleep(2); }
            __builtin_amdgcn_fence(__ATOMIC_ACQUIRE, "agent");
            asm volatile("s_waitcnt vmcnt(0)" ::: "memory");
        }
#if !defined(BROKEN_HOOK_NO_BARRIER)
        asm volatile("" ::: "memory"); __builtin_amdgcn_s_barrier(); asm volatile("" ::: "memory");
#endif
    }
};

__device__ __forceinline__ unsigned cvt_pk_bf16(float lo, float hi) { unsigned r; asm volatile("v_cvt_pk_bf16_f32 %0, %1, %2" : "=v"(r) : "v"(lo), "v"(hi)); return r; }
typedef float f32x2 __attribute__((ext_vector_type(2)));
__device__ __forceinline__ f32x2 gelu_pk(f32x2 v) {
    const f32x2 av = __builtin_elementwise_abs(v), d = av * 0.2316418882f + 1.0f;
    f32x2 t; t.x = __builtin_amdgcn_rcpf(d.x); t.y = __builtin_amdgcn_rcpf(d.y);
    f32x2 q = t * 0.5307027145f + (-0.7265760135f); q = q * t + 0.7107068705f; q = q * t + (-0.142248368f); q = q * t + 0.127414796f; q = q * t;
    const f32x2 s = (v * v) * (-0.72134752044f);
    f32x2 e; e.x = __builtin_amdgcn_exp2f(s.x); e.y = __builtin_amdgcn_exp2f(s.y);
    const f32x2 m = v * (q * e), r = v - m;
    f32x2 o; o.x = v.x < 0.f ? m.x : r.x; o.y = v.y < 0.f ? m.y : r.y; return o;
}

struct EpiF32 {
    static constexpr bool PERM = false, AFTER_DRAIN = false;
    float* C; int ldc; const float* bias;
    __device__ __forceinline__ void operator()(const f32x4 (&acc)[2][2][4][2], const Unit& u, int wr, int wc, int fr, int fq) const {
        const int row0 = u.pm * BM + wr * 64 + fr, col0 = u.pn * BM + wc * 32 + 4 * fq;
        f32x4 bv[2][2];
#pragma unroll
        for (int bj = 0; bj < 2; ++bj)
#pragma unroll
            for (int n = 0; n < 2; ++n) bv[bj][n] = bias ? *(const f32x4*)(bias + col0 + bj * HALF + n * 16) : (f32x4){0.f, 0.f, 0.f, 0.f};
#pragma unroll
        for (int ai = 0; ai < 2; ++ai)
#pragma unroll
            for (int m = 0; m < 4; ++m) { float* rowp = C + (size_t)(row0 + ai * HALF + m * 16) * ldc + col0;
#pragma unroll
                for (int bj = 0; bj < 2; ++bj)
#pragma unroll
                    for (int n = 0; n < 2; ++n) *(f32x4*)(rowp + bj * HALF + n * 16) = acc[ai][bj][m][n] + bv[bj][n]; }
    }
};
template <int ACT  > struct EpiBf16 {
    static constexpr bool PERM = true, AFTER_DRAIN = false;
    bf16_t* O; int ldc; const float* bias; int split_cols; size_t split_stride;
    __device__ __forceinline__ void operator()(const f32x4 (&acc)[2][2][4][2], const Unit& u, int wr, int wc, int fr, int fq) const {
        const int row0 = u.pm * BM + wr * 64 + fr; int colt = u.pn * BM; bf16_t* base = O;
        if (split_cols) { const int t = colt / split_cols; base += (size_t)t * split_stride; colt -= t * split_cols; }
        const int col0 = colt + wc * 32 + 8 * fq, bcol0 = u.pn * BM + wc * 32 + 8 * fq;
        f32x4 bv[2][2];
#pragma unroll
        for (int bj = 0; bj < 2; ++bj)
#pragma unroll
            for (int n = 0; n < 2; ++n) bv[bj][n] = bias ? *(const f32x4*)(bias + bcol0 + bj * HALF + 4 * n) : (f32x4){0.f, 0.f, 0.f, 0.f};
#pragma unroll
        for (int ai = 0; ai < 2; ++ai)
#pragma unroll
            for (int m = 0; m < 4; ++m) { bf16_t* rowp = base + (size_t)(row0 + ai * HALF + m * 16) * ldc + col0;
#pragma unroll
                for (int bj = 0; bj < 2; ++bj) { f32x4 v0 = acc[ai][bj][m][0] + bv[bj][0], v1 = acc[ai][bj][m][1] + bv[bj][1];
                    if (ACT == 1) { f32x2 a = gelu_pk((f32x2){v0[0], v0[1]}), b = gelu_pk((f32x2){v0[2], v0[3]}), c = gelu_pk((f32x2){v1[0], v1[1]}), d = gelu_pk((f32x2){v1[2], v1[3]});
                        v0 = (f32x4){a.x, a.y, b.x, b.y}; v1 = (f32x4){c.x, c.y, d.x, d.y}; }
                    if (ACT == 2) {
#pragma unroll
                        for (int j = 0; j < 4; ++j) { v0[j] = 0.5f * v0[j] * (1.0f + erff(v0[j] * 0.70710678f)); v1[j] = 0.5f * v1[j] * (1.0f + erff(v1[j] * 0.70710678f)); } }
                    u32x4 w; w.x = cvt_pk_bf16(v0[0], v0[1]); w.y = cvt_pk_bf16(v0[2], v0[3]); w.z = cvt_pk_bf16(v1[0], v1[1]); w.w = cvt_pk_bf16(v1[2], v1[3]);
                    *(u32x4*)(rowp + bj * HALF) = w; } }
    }
};

template <class Epi, class Sched, bool STAMP = false>
__device__ __forceinline__ void gemm_phase(PG8_LAS unsigned char* lds, const Gemm g, const Sched& S, const Epi& E, unsigned long long* stamps) {
    const int tid = threadIdx.x, wid = __builtin_amdgcn_readfirstlane(tid >> 6), lane = tid & 63, wr = wid >> 2, wc = wid & 3, fr = lane & 15, fq = lane >> 4;
    const int K = g.K, nt = K / BK;
    int ts_lo = 0, ts_hi = 0, nts = 0; const unsigned long long rt_entry = STAMP ? (unsigned long long)wall_clock64() : 0ull;
#define PG8_STAMP() do { if (STAMP && wid == 0 && nts < 64) { const unsigned long long _c = (unsigned long long)clock64(); \
        ts_lo = (lane == nts) ? (int)(unsigned)_c : ts_lo; ts_hi = (lane == nts) ? (int)(unsigned)(_c >> 32) : ts_hi; ++nts; } } while (0)
    PG8_STAMP();
    unsigned voffA[2], voffB[2];
#pragma unroll
    for (int i = 0; i < 2; ++i) { int R, C; stage_rc(tid * 16 + i * 8192, R, C); const int Rb = Epi::PERM ? ((R & ~31) + perm32(R & 31)) : R;
        voffA[i] = (unsigned)(R * K + C) * 2u; voffB[i] = (unsigned)(Rb * K + C) * 2u; }
    const size_t kstep = (size_t)(BK * 2);
    const size_t hstep = (size_t)HALF * K * 2;
    const size_t tstep = 2 * hstep;
    const unsigned ldsw = (unsigned)wid * 1024u;
    const int aoff = lds_byte(wr * 64 + fr, fq * 8), boff = lds_byte(wc * 32 + fr, fq * 8);
#define PG8_SA(b, h) (((b) * 2 + (h)) * HTB)
#define PG8_SB(b, h) ((4 + (b) * 2 + (h)) * HTB)
#define PG8_STAGE(bufoff, gbase, voff) do { _Pragma("unroll") for (int _i = 0; _i < 2; ++_i) \
        __builtin_amdgcn_global_load_lds((const unsigned*)((const char*)(gbase) + (voff)[_i]), (PG8_LAS unsigned*)(lds + (bufoff) + ldsw + _i * 8192), 16, 0, 0); } while (0)
#define PG8_LDA(dst, b, h) do { _Pragma("unroll") for (int m = 0; m < 4; ++m) _Pragma("unroll") for (int k = 0; k < 2; ++k) dst[m][k] = *(const PG8_LAS bf16x8*)(lds + PG8_SA(b, h) + aoff + m * 2048 + k * 1024); } while (0)
#define PG8_LDB(dst, b, h) do { _Pragma("unroll") for (int n = 0; n < 2; ++n) _Pragma("unroll") for (int k = 0; k < 2; ++k) dst[n][k] = *(const PG8_LAS bf16x8*)(lds + PG8_SB(b, h) + boff + n * 2048 + k * 1024); } while (0)
#define PG8_MMA(ai, bj, At, Bt) do { __builtin_amdgcn_s_setprio(1); _Pragma("unroll") for (int m = 0; m < 4; ++m) _Pragma("unroll") for (int n = 0; n < 2; ++n) _Pragma("unroll") for (int k = 0; k < 2; ++k) \
        acc[ai][bj][m][n] = __builtin_amdgcn_mfma_f32_16x16x32_bf16(Bt[n][k], At[m][k], acc[ai][bj][m][n], 0, 0, 0); __builtin_amdgcn_s_setprio(0); } while (0)
#define PG8_WAIT_V(n) asm volatile("s_waitcnt vmcnt(" #n ")" ::: "memory")
#define PG8_WAIT_L(n) asm volatile("s_waitcnt lgkmcnt(" #n ")" ::: "memory")
#define PG8_BAR __builtin_amdgcn_s_barrier()
#define PG8_SCHED __builtin_amdgcn_sched_barrier(0)
    Unit cur, nxt; int ui = 0;
    if (!S.next(0, cur)) return;
    f32x4 acc[2][2][4][2];
#pragma unroll
    for (int a = 0; a < 2; ++a)
#pragma unroll
        for (int b = 0; b < 2; ++b)
#pragma unroll
            for (int m = 0; m < 4; ++m)
#pragma unroll
                for (int n = 0; n < 2; ++n) acc[a][b][m][n] = (f32x4){0.f, 0.f, 0.f, 0.f};
    bf16x8 At[4][2], B0[2][2], B1[2][2];
    const char* cA = (const char*)g.A + (size_t)cur.pm * tstep; const char* cB = (const char*)g.Bt + (size_t)cur.pn * tstep;
    S.a_ready(cur);
    PG8_STAGE(PG8_SB(0, 0), cB, voffB); PG8_STAGE(PG8_SA(0, 0), cA, voffA); PG8_STAGE(PG8_SB(0, 1), cB + hstep, voffB); PG8_STAGE(PG8_SA(0, 1), cA + hstep, voffA);
    if (wr == 1) PG8_BAR;
    PG8_WAIT_V(4); PG8_BAR;
    PG8_STAGE(PG8_SB(1, 0), cB + kstep, voffB); PG8_STAGE(PG8_SA(1, 0), cA + kstep, voffA); PG8_STAGE(PG8_SB(1, 1), cB + hstep + kstep, voffB);
    PG8_WAIT_V(6); PG8_BAR;
    PG8_STAMP();
    for (;;) {
        const bool has_next = S.next(ui + 1, nxt);
        const char* nA = has_next ? (const char*)g.A + (size_t)nxt.pm * tstep : cA; const char* nB = has_next ? (const char*)g.Bt + (size_t)nxt.pn * tstep : cB;
        for (int t = 0; t < nt; t += 2) {
            const bool last = (t == nt - 2);
            const char* a1 = cA + (size_t)(t + 1) * kstep;
            const char* a2 = last ? nA : cA + (size_t)(t + 2) * kstep; const char* b2 = last ? nB : cB + (size_t)(t + 2) * kstep;
            const char* a3 = a2 + kstep; const char* b3 = b2 + kstep;
            if (last && has_next) S.a_ready(nxt);
            PG8_LDB(B0, 0, 0); PG8_SCHED; PG8_LDA(At, 0, 0); PG8_STAGE(PG8_SA(1, 1), a1 + hstep, voffA);
            PG8_WAIT_L(8); PG8_BAR; PG8_WAIT_L(0); PG8_MMA(0, 0, At, B0); PG8_BAR; PG8_SCHED;
            PG8_LDB(B1, 0, 1); PG8_STAGE(PG8_SB(0, 0), b2, voffB);
            PG8_BAR; PG8_WAIT_L(0); PG8_MMA(0, 1, At, B1); PG8_BAR;
            PG8_LDA(At, 0, 1); PG8_STAGE(PG8_SA(0, 0), a2, voffA);
            PG8_BAR; PG8_WAIT_L(0); PG8_MMA(1, 0, At, B0); PG8_BAR; PG8_SCHED;
            PG8_STAGE(PG8_SB(0, 1), b2 + hstep, voffB);
            PG8_WAIT_V(6); PG8_BAR; PG8_MMA(1, 1, At, B1); PG8_BAR;
            PG8_LDB(B0, 1, 0); PG8_SCHED; PG8_LDA(At, 1, 0); PG8_STAGE(PG8_SA(0, 1), a2 + hstep, voffA);
            PG8_WAIT_L(8); PG8_BAR; PG8_WAIT_L(0); PG8_MMA(0, 0, At, B0); PG8_BAR; PG8_SCHED;
            PG8_LDB(B1, 1, 1); PG8_STAGE(PG8_SB(1, 0), b3, voffB);
            PG8_BAR; PG8_WAIT_L(0); PG8_MMA(0, 1, At, B1); PG8_BAR;
            PG8_LDA(At, 1, 1); PG8_STAGE(PG8_SA(1, 0), a3, voffA);
            PG8_BAR; PG8_WAIT_L(0); PG8_MMA(1, 0, At, B0); PG8_BAR; PG8_SCHED;
            PG8_STAGE(PG8_SB(1, 1), b3 + hstep, voffB);
            PG8_WAIT_V(6); PG8_BAR; PG8_MMA(1, 1, At, B1); PG8_BAR;
        }
        PG8_STAMP();
        if constexpr (!Epi::AFTER_DRAIN) { E(acc, cur, wr, wc, fr, fq); S.done(cur); }
        PG8_STAMP();
        if (!has_next) break;
#pragma unroll
        for (int a = 0; a < 2; ++a)
#pragma unroll
            for (int b = 0; b < 2; ++b)
#pragma unroll
                for (int m = 0; m < 4; ++m)
#pragma unroll
                    for (int n = 0; n < 2; ++n) acc[a][b][m][n] = (f32x4){0.f, 0.f, 0.f, 0.f};
        cur = nxt; cA = nA; cB = nB; ++ui;
    }
    PG8_WAIT_V(0);
    if (wr == 0) PG8_BAR;
    PG8_BAR;
    if constexpr (Epi::AFTER_DRAIN) { E.fused(acc, cur, wr, wc, fr, fq, lds, wid, lane); S.done(cur); }
    PG8_STAMP();
    if (STAMP && wid == 0) { stamps[lane] = lane < nts ? (((unsigned long long)(unsigned)ts_hi << 32) | (unsigned)ts_lo) : 0ull;
        if (lane == 62) stamps[62] = rt_entry; if (lane == 63) stamps[63] = (unsigned long long)wall_clock64(); }
#undef PG8_STAMP
#undef PG8_SA
#undef PG8_SB
#undef PG8_STAGE
#undef PG8_LDA
#undef PG8_LDB
#undef PG8_MMA
#undef PG8_WAIT_V
#undef PG8_WAIT_L
#undef PG8_BAR
#undef PG8_SCHED
}
}
#define XB_TMO      128
#define XB_XCNT(j)  (256  + 64 * (j))
#define XB_XSUB(j)  (1280 + 64 * (j))
#define XB_XGEN(j)  (2304 + 64 * (j))
#define XB_TOP      3328
#define XB_TOPGEN   3392
#define XCD_BAR_WORDS 3456
#define XB_SPIN_CAP (1u << 18)
#define LAS __attribute__((address_space(3)))

__device__ __forceinline__ unsigned xb_ld(unsigned* p)              { return __hip_atomic_load(p, __ATOMIC_RELAXED, __HIP_MEMORY_SCOPE_AGENT); }
__device__ __forceinline__ unsigned xb_add(unsigned* p, unsigned v) { return __hip_atomic_fetch_add(p, v, __ATOMIC_RELAXED, __HIP_MEMORY_SCOPE_AGENT); }
__device__ __forceinline__ unsigned xb_xcc_id() { return (unsigned)__builtin_amdgcn_s_getreg((3 << 11) | 20) & 0xFu; }
#define XB_SPIN(cond, bar) do { unsigned _sp = 0; while (cond) { __builtin_amdgcn_s_sleep(1); \
    if ((++_sp & 255u) == 0u) { if (xb_ld(&(bar)[XB_TMO])) break; if (_sp > XB_SPIN_CAP) { atomicAdd(&(bar)[XB_TMO], 1u); break; } } } } while (0)

struct XcdBarrier {
    unsigned* bar; unsigned x;
    volatile LAS unsigned* st;
};

__device__ __forceinline__ XcdBarrier xcd_barrier_post(unsigned* bar, volatile LAS unsigned* st) {
    XcdBarrier b; b.bar = bar; b.x = xb_xcc_id(); b.st = st;
    if (threadIdx.x == 0) (void)xb_add(&bar[XB_XCNT(b.x)], 1u);
    return b;
}
__device__ __forceinline__ void xcd_barrier_complete(unsigned* bar, unsigned x, unsigned& nloc, unsigned& nx) {
    const unsigned G = gridDim.x * gridDim.y * gridDim.z;
    unsigned sum, cnt, mine, sp = 0u;
    for (;;) {
        sum = 0u; cnt = 0u; mine = 0u;
#pragma unroll
        for (unsigned j = 0; j < 16; ++j) { const unsigned c = xb_ld(&bar[XB_XCNT(j)]); sum += c; cnt += (c > 0u) ? 1u : 0u; mine = (j == x) ? c : mine; }
        if (sum == G) break;
        __builtin_amdgcn_s_sleep(1);
        if ((++sp & 255u) == 0u) { if (xb_ld(&bar[XB_TMO])) break; if (sp > XB_SPIN_CAP) { atomicAdd(&bar[XB_TMO], 1u); break; } }
    }
    nloc = mine > 0u ? mine : 1u; nx = cnt > 0u ? cnt : 1u;
}

__device__ __forceinline__ void xcd_barrier(const XcdBarrier& b) {
    asm volatile("s_waitcnt vmcnt(0)" ::: "memory");
    __syncthreads();
    if (threadIdx.x == 0) {
        unsigned* bar = b.bar;
        __builtin_amdgcn_s_waitcnt(0);
        unsigned nloc = b.st[0], nx = b.st[1];
        if (nloc == 0u) { xcd_barrier_complete(bar, b.x, nloc, nx); b.st[0] = nloc; b.st[1] = nx; }
        const unsigned old = xb_add(&bar[XB_XSUB(b.x)], 1u);
        const unsigned gen = old / nloc;
        if (old + 1u == (gen + 1u) * nloc) {
            __builtin_amdgcn_fence(__ATOMIC_RELEASE, "agent");
            asm volatile("s_waitcnt vmcnt(0)" ::: "memory");
            const unsigned og = xb_add(&bar[XB_TOP], 1u);
            const unsigned tg = og / nx;
            if (og + 1u == (tg + 1u) * nx) xb_add(&bar[XB_TOPGEN], 1u);
            else XB_SPIN(xb_ld(&bar[XB_TOPGEN]) == tg, bar);
            __builtin_amdgcn_fence(__ATOMIC_ACQUIRE, "agent");
            xb_add(&bar[XB_XGEN(b.x)], 1u);
            asm volatile("s_waitcnt vmcnt(0)" ::: "memory");
        } else {
            XB_SPIN(xb_ld(&bar[XB_XGEN(b.x)]) == gen, bar);
            __builtin_amdgcn_fence(__ATOMIC_ACQUIRE, "agent");
            asm volatile("s_waitcnt vmcnt(0)" ::: "memory");
        }
    }
    __syncthreads();
}

namespace mk {
using pg8::bf16_t; using pg8::bf16x8; using pg8::f32x4; using pg8::u32x4;
typedef unsigned u32x2 __attribute__((ext_vector_type(2)));
typedef short bf16x4 __attribute__((ext_vector_type(4)));
typedef float lf2 __attribute__((ext_vector_type(2)));
typedef float lf4 __attribute__((ext_vector_type(4)));
typedef unsigned lu4 __attribute__((ext_vector_type(4)));

constexpr int D = 1024, NBATCH = 16, SEQ = 2048, CTXL = 256;
constexpr int NLAT = NBATCH * SEQ, NCTX = NBATCH * CTXL, NROW = NLAT + NCTX;
constexpr int NINP = 3072, NIN = 2944;
constexpr int C_Q = 256, C_K = 640, C_V = 1024, C_Z = 1408;
constexpr int DE = 2816;
constexpr int XROWS = 4608;
constexpr int NTHR = 512;
constexpr int LDS_MISC = 131072, LDS_BYTES = 131072 + 256;

constexpr size_t al256(size_t x) { return (x + 255) & ~(size_t)255; }
constexpr size_t WS_CTL = 0;
constexpr size_t WS_MOD = 65536;
constexpr size_t WS_SW = al256(WS_MOD + (size_t)2 * 17 * 6144 * 4);
constexpr size_t SW_W2T = 0, SW_A2T = 98304, SW_G2T = 196608, SW_GLUT = 294912, SW_S5E = 425984, SW_S5W2 = 2523136, SW_STRIDE = 6717440;
constexpr size_t WS_WIN = al256(WS_SW + 2 * SW_STRIDE);
constexpr size_t WS_WOUT = WS_WIN + (size_t)3072 * 1024 * 2;
constexpr size_t WS_WGU = WS_WOUT + (size_t)1024 * 1024 * 2;
constexpr size_t WS_WD = WS_WGU + (size_t)16 * 5632 * 1024 * 2;
constexpr size_t WS_XB = WS_WD + (size_t)16 * 1024 * 2816 * 2;
constexpr size_t WS_CTXA = WS_XB + (size_t)NLAT * D * 4;
constexpr size_t WS_CTXB = WS_CTXA + (size_t)NCTX * D * 4;
constexpr size_t WS_ABUF = WS_CTXB + (size_t)NCTX * D * 4;
constexpr size_t WS_AFF = WS_ABUF + (size_t)NROW * D * 2;
constexpr size_t WS_SLOT = WS_AFF + (size_t)NROW * 16 * 4;
constexpr size_t WS_SELG = WS_SLOT + (size_t)NROW * 16 * 4;
constexpr size_t WS_U = al256(WS_SELG + (size_t)16 * XROWS * 4);
constexpr size_t SZ384 = (size_t)NROW * 384 * 2;
constexpr size_t U_P = WS_U;
constexpr size_t U_QR = U_P + (size_t)NROW * NINP * 2;
constexpr size_t U_KR = U_QR + SZ384;
constexpr size_t U_VT = U_KR + SZ384;
constexpr size_t U_VTC = U_VT + (size_t)16 * 384 * 2048 * 2;
constexpr size_t U_RS = U_VT + SZ384;
constexpr size_t U_KS = U_RS + SZ384;
constexpr size_t U_VS = U_KS + SZ384;
constexpr size_t U_KK = U_VS + SZ384;
constexpr size_t U_ALR = U_KK + SZ384;
constexpr size_t U_LD = U_ALR + SZ384;
constexpr size_t U_AG = U_LD + 2 * SZ384;
constexpr size_t U_G = U_AG + 2 * SZ384;
constexpr size_t U_YRK = U_G + SZ384;
constexpr size_t U_SLOC = U_YRK + 2 * (size_t)NROW * 384 * 4;
constexpr size_t U_SPREV = U_SLOC + (size_t)2304 * 16 * 256 * 4;
constexpr size_t U_YG = U_SPREV + (size_t)2304 * 16 * 256 * 2;
constexpr size_t U_U16 = U_YG + (size_t)NROW * 256 * 2;
constexpr size_t U_MIX_END = U_U16 + (size_t)NROW * 256 * 2;
constexpr int NCHUNK = 192 * 144;
constexpr size_t CH_XP = U_P;
constexpr size_t CH_BK = CH_XP + (size_t)NCHUNK * 4096;
constexpr size_t CH_UL = CH_BK + (size_t)NCHUNK * 4096;
constexpr size_t CH_MM = U_SLOC;
constexpr size_t CH_GT = CH_MM + (size_t)NCHUNK * 1024;
static_assert(CH_UL + (size_t)NCHUNK * 2048 <= U_RS, "chunk buffers overlap live RWKV operands");
static_assert(CH_GT + (size_t)NCHUNK * 256 <= U_SPREV, "chunk buffers overlap S5 states");
constexpr size_t U_Y = WS_U;
constexpr size_t U_XSEL = U_Y + (size_t)NROW * D * 4;
constexpr size_t U_HID = U_XSEL + (size_t)16 * XROWS * 1024 * 2;
constexpr size_t U_YEXP = U_HID + (size_t)16 * XROWS * DE * 2;
constexpr size_t U_FFN_END = U_YEXP + (size_t)16 * XROWS * 1024 * 2;
constexpr size_t WS_END = U_MIX_END > U_FFN_END ? U_MIX_END : U_FFN_END;

struct Params { const float* in[35]; float* out; unsigned char* ws; int ph_lo, ph_hi, use_bar, pad; };

typedef __bf16 hwbf2 __attribute__((ext_vector_type(2)));
__device__ __forceinline__ unsigned pack2(float lo, float hi) { const lf2 v = {lo, hi}; return __builtin_bit_cast(unsigned, __builtin_convertvector(v, hwbf2)); }
__device__ __forceinline__ bf16_t f2bf(float f) { return (bf16_t)(pack2(f, 0.f) & 0xffffu); }
__device__ __forceinline__ float bflo(unsigned w) { return __uint_as_float(w << 16); }
__device__ __forceinline__ float bfhi(unsigned w) { return __uint_as_float(w & 0xffff0000u); }
__device__ __forceinline__ float bf2f(bf16_t b) { return __uint_as_float(((unsigned)b) << 16); }
__device__ __forceinline__ float sigm(float x) { return 1.0f / (1.0f + __expf(-x)); }
__device__ __forceinline__ float wave_sum(float v) {
#pragma unroll
    for (int o = 32; o >= 1; o >>= 1) v += __shfl_xor(v, o);
    return v; }
__device__ __forceinline__ void unpack8(const uint4 w, float (&f)[8]) { f[0] = bflo(w.x); f[1] = bfhi(w.x); f[2] = bflo(w.y); f[3] = bfhi(w.y); f[4] = bflo(w.z); f[5] = bfhi(w.z); f[6] = bflo(w.w); f[7] = bfhi(w.w); }
__device__ __forceinline__ uint4 pack8(const float (&f)[8]) { uint4 w; w.x = pack2(f[0], f[1]); w.y = pack2(f[2], f[3]); w.z = pack2(f[4], f[5]); w.w = pack2(f[6], f[7]); return w; }
__device__ __forceinline__ const float* xrow(const float* lat, const float* ctx, int r) { return r < NLAT ? lat + (size_t)r * D : ctx + (size_t)(r - NLAT) * D; }
__device__ __forceinline__ float* xrow_w(float* lat, float* ctx, int r) { return r < NLAT ? lat + (size_t)r * D : ctx + (size_t)(r - NLAT) * D; }
__device__ __forceinline__ f32x4 mfma16(bf16x8 a, bf16x8 b, f32x4 c) { return __builtin_amdgcn_mfma_f32_16x16x32_bf16(a, b, c, 0, 0, 0); }

__device__ __forceinline__ void tr_tile(const float* __restrict__ src, int ldsrc, int k0, int n0, bf16_t* __restrict__ dst, int lddst, int drow0, LAS unsigned* T) {
    const int tid = threadIdx.x, n4 = tid & 15, kq = tid >> 4;
    const float4 a = *(const float4*)(src + (size_t)(k0 + 2 * kq) * ldsrc + n0 + 4 * n4);
    const float4 b = *(const float4*)(src + (size_t)(k0 + 2 * kq + 1) * ldsrc + n0 + 4 * n4);
    T[(4 * n4 + 0) * 33 + kq] = pack2(a.x, b.x); T[(4 * n4 + 1) * 33 + kq] = pack2(a.y, b.y);
    T[(4 * n4 + 2) * 33 + kq] = pack2(a.z, b.z); T[(4 * n4 + 3) * 33 + kq] = pack2(a.w, b.w);
    __syncthreads();
    const int n = tid >> 3, pc = tid & 7;
    uint4 v; v.x = T[n * 33 + 4 * pc]; v.y = T[n * 33 + 4 * pc + 1]; v.z = T[n * 33 + 4 * pc + 2]; v.w = T[n * 33 + 4 * pc + 3];
    *(uint4*)(dst + (size_t)(drow0 + n) * lddst + k0 + 8 * pc) = v;
    __syncthreads();
}

constexpr int CV_WIN = 16 * 46, CV_PAD = 32, CV_WOUT = 256, CV_G = 16 * 704, CV_TOTAL = CV_WIN + CV_PAD + CV_WOUT + 3 * CV_G;
__device__ __forceinline__ void convert_weights(const Params& p, int l, LAS unsigned char* lds, int vb, int nvb) {
    LAS unsigned* T = (LAS unsigned*)lds;
    bf16_t* WIN = (bf16_t*)(p.ws + WS_WIN); bf16_t* WOUT = (bf16_t*)(p.ws + WS_WOUT); bf16_t* WGU = (bf16_t*)(p.ws + WS_WGU); bf16_t* WD = (bf16_t*)(p.ws + WS_WD);
    for (int it = vb; it < CV_TOTAL; it += nvb) {
        int j = it;
        if (j < CV_WIN) { const int kt = j / 46, nt = j % 46; tr_tile(p.in[7] + (size_t)l * 1024 * NIN, NIN, kt * 64, nt * 64, WIN, 1024, nt * 64, T); continue; }
        j -= CV_WIN;
        if (j < CV_PAD) { const size_t o = (size_t)NIN * 1024 + ((size_t)j * NTHR + threadIdx.x) * 8; *(uint4*)(WIN + o) = make_uint4(0u, 0u, 0u, 0u); continue; }
        j -= CV_PAD;
        if (j < CV_WOUT) { const int kt = j / 16, nt = j % 16; tr_tile(p.in[8] + (size_t)l * 1024 * 1024, 1024, kt * 64, nt * 64, WOUT, 1024, nt * 64, T); continue; }
        j -= CV_WOUT;
        if (j < 2 * CV_G) { const int up = j >= CV_G; if (up) j -= CV_G; const int e = j / 704, rem = j % 704, kt = rem / 44, nt = rem % 44, n0 = nt * 64;
            tr_tile(p.in[up ? 33 : 32] + (size_t)(l * 16 + e) * 1024 * DE, DE, kt * 64, n0, WGU + (size_t)e * 5632 * 1024, 1024, (n0 >> 7) * 256 + (n0 & 127) + (up ? 128 : 0), T); continue; }
        j -= 2 * CV_G;
        { const int e = j / 704, rem = j % 704, kt = rem / 16, nt = rem % 16;
            tr_tile(p.in[34] + (size_t)(l * 16 + e) * DE * 1024, 1024, kt * 64, nt * 64, WD + (size_t)e * 1024 * DE, DE, nt * 64, T); }
    }
}

__device__ __forceinline__ void mod_item(const Params& p, int item, LAS unsigned char* lds) {
    LAS float* sc = (LAS float*)lds;
    LAS float* red = (LAS float*)(lds + 69632);
    const int tid = threadIdx.x, l = item / 96, cg = item % 96;
    for (int i = tid; i < 17 * 1024; i += NTHR) { const int b = i >> 10, k = i & 1023; const float c = b < 16 ? p.in[1][b * 1024 + k] : p.in[3][k]; sc[k * 17 + b] = c * sigm(c); }
    __syncthreads();
    const int col = cg * 64 + (tid & 63), kg = tid >> 6;
    float acc[17];
#pragma unroll
    for (int b = 0; b < 17; ++b) acc[b] = 0.f;
    const float* w = p.in[4] + ((size_t)l * 1024 + kg * 128) * 6144 + col;
#pragma unroll 4
    for (int kk = 0; kk < 128; ++kk) { const float wv = w[(size_t)kk * 6144]; const LAS float* s = sc + (kg * 128 + kk) * 17;
#pragma unroll
        for (int b = 0; b < 17; ++b) acc[b] += s[b] * wv; }
#pragma unroll
    for (int b = 0; b < 17; ++b) red[(kg * 17 + b) * 64 + (tid & 63)] = acc[b];
    __syncthreads();
    for (int i = tid; i < 17 * 64; i += NTHR) { const int b = i >> 6, c = i & 63; float s = 0.f;
#pragma unroll
        for (int g = 0; g < 8; ++g) s += red[(g * 17 + b) * 64 + c];
        ((float*)(p.ws + WS_MOD))[((size_t)l * 17 + b) * 6144 + cg * 64 + c] = s + p.in[5][l * 6144 + cg * 64 + c]; }
    __syncthreads();
}

__device__ __forceinline__ void s5mat_item(const Params& p, int item, LAS unsigned char* lds) {
    LAS lf2* pw = (LAS lf2*)lds;
    LAS lf2* bb = (LAS lf2*)(lds + 17408);
    LAS lf2* cc = (LAS lf2*)(lds + 17408 + 16384);
    LAS float* KT = (LAS float*)(lds + 17408 + 32768);
    const int tid = threadIdx.x, l = item >> 4, g = item & 15;
    for (int i = tid; i < 2 * 17 * 64; i += NTHR) { const int pp = i & 63, n = (i >> 6) % 17, d = i / (17 * 64);
        const int li = ((l * 2 + d) * 16 + g) * 64 + pp; const float lr = p.in[9][li], lim = p.in[10][li], dt = expf(p.in[11][(l * 2 + d) * 16 + g]);
        const float mag = expf((float)n * dt * lr); float s, c; sincosf((float)n * dt * lim, &s, &c); pw[i] = (lf2){mag * c, mag * s}; }
    for (int i = tid; i < 2 * 64 * 16; i += NTHR) { const int h = i & 15, pp = (i >> 4) & 63, d = i >> 10;
        const int li = ((l * 2 + d) * 16 + g) * 64 + pp; const float lr = p.in[9][li], lim = p.in[10][li], dt = expf(p.in[11][(l * 2 + d) * 16 + g]);
        const float mag = expf(dt * lr); float s, c; sincosf(dt * lim, &s, &c); const float x = mag * c - 1.0f, y = mag * s;
        const float den = 1.0f / (lr * lr + lim * lim); const float cr = (x * lr + y * lim) * den, ci = (y * lr - x * lim) * den;
        const int bi = ((l * 16 + g) * 64 + pp) * 16 + h; const float br = p.in[12][bi], bim = p.in[13][bi];
        bb[i] = (lf2){cr * br - ci * bim, cr * bim + ci * br}; }
    for (int i = tid; i < 2 * 16 * 64; i += NTHR) { const int pp = i & 63, h = (i >> 6) & 15, d = i >> 10;
        const int ci = (((l * 2 + d) * 16 + g) * 16 + h) * 64 + pp; cc[i] = (lf2){p.in[14][ci], p.in[15][ci]}; }
    __syncthreads();
    for (int i = tid; i < 2 * 16 * 256; i += NTHR) { const int h2 = i & 15, h = (i >> 4) & 15, tau = (i >> 8) & 15, d = i >> 12; float s = 0.f;
        for (int pp = 0; pp < 64; ++pp) { const lf2 c = cc[(d * 16 + h) * 64 + pp], w = pw[(d * 17 + tau) * 64 + pp], b = bb[(d * 64 + pp) * 16 + h2];
            const float tr = c.x * w.x - c.y * w.y, ti = c.x * w.y + c.y * w.x; s += tr * b.x - ti * b.y; }
        KT[i] = s; }
    __syncthreads();
    bf16_t* E = (bf16_t*)(p.ws + WS_SW + (size_t)l * SW_STRIDE + SW_S5E) + (size_t)g * 256 * 256;
    bf16_t* W2 = (bf16_t*)(p.ws + WS_SW + (size_t)l * SW_STRIDE + SW_S5W2) + (size_t)g * 256 * 512;
    for (int i = tid; i < 256 * 256; i += NTHR) { const int k = i & 255, n = i >> 8; const int s = k >> 4, h = k & 15, d = n >> 7, part = (n >> 6) & 1, pp = n & 63;
        const int e = d == 0 ? 15 - s : s; const lf2 w = pw[(d * 17 + e) * 64 + pp], b = bb[(d * 64 + pp) * 16 + h];
        E[i] = f2bf(part ? (w.x * b.y + w.y * b.x) : (w.x * b.x - w.y * b.y)); }
    for (int i = tid; i < 256 * 512; i += NTHR) { const int k = i & 511, n = i >> 9; const int t = n >> 4, h = n & 15; float v;
        if (k < 256) { const int s = k >> 4, h2 = k & 15; v = 0.f;
            if (t >= s) v += KT[((0 * 16 + (t - s)) * 16 + h) * 16 + h2];
            if (s >= t) v += KT[((1 * 16 + (s - t)) * 16 + h) * 16 + h2];
            if (s == t && h == h2) v += p.in[16][l * 256 + g * 16 + h]; }
        else { const int q = k - 256, d = q >> 7, part = (q >> 6) & 1, pp = q & 63; const int e = d == 0 ? t + 1 : 16 - t;
            const lf2 c = cc[(d * 16 + h) * 64 + pp], w = pw[(d * 17 + e) * 64 + pp];
            v = part ? -(c.x * w.y + c.y * w.x) : (c.x * w.x - c.y * w.y); }
        W2[i] = f2bf(v); }
    __syncthreads();
}

__device__ __forceinline__ void smallw_item(const Params& p, int item) {
    int i = item * NTHR + threadIdx.x; const int l = i / 212992; i %= 212992;
    unsigned char* sw = p.ws + WS_SW + (size_t)l * SW_STRIDE;
    if (i < 49152) { const int k = i & 63, n = (i >> 6) % 384, d = i / 24576; ((bf16_t*)(sw + SW_W2T))[i] = f2bf(p.in[22][((size_t)(l * 2 + d) * 64 + k) * 384 + n]); return; }
    i -= 49152;
    if (i < 49152) { const int k = i & 63, n = (i >> 6) % 384, d = i / 24576; ((bf16_t*)(sw + SW_A2T))[i] = f2bf(p.in[24][((size_t)(l * 2 + d) * 64 + k) * 384 + n]); return; }
    i -= 49152;
    if (i < 49152) { const int k = i & 127, n = i >> 7; ((bf16_t*)(sw + SW_G2T))[i] = f2bf(p.in[25][((size_t)l * 128 + k) * 384 + n]); return; }
    i -= 49152;
    { const int k = i & 255, n = i >> 8; ((bf16_t*)(sw + SW_GLUT))[i] = f2bf(p.in[17][((size_t)l * 256 + k) * 256 + n]); }
}

constexpr int PRO_MOD = 192, PRO_S5 = 32, PRO_SW = 832;
__device__ __forceinline__ void phase_prologue(const Params& p, LAS unsigned char* lds) {
    for (int it = blockIdx.x; it < PRO_MOD + PRO_S5 + PRO_SW; it += gridDim.x) {
        if (it < PRO_MOD) mod_item(p, it, lds);
        else if (it < PRO_MOD + PRO_S5) s5mat_item(p, it - PRO_MOD, lds);
        else smallw_item(p, it - PRO_MOD - PRO_S5);
    }
    convert_weights(p, 0, lds, (int)blockIdx.x, (int)gridDim.x);
}

__device__ __forceinline__ void hnorm_row(const float* src, const float* g, const float* mb_sh, const float* mb_sc, bf16_t* dst, int lane, const float4 (&v)[4]) {
    float ss = 0.f;
#pragma unroll
    for (int i = 0; i < 4; ++i) ss += v[i].x * v[i].x + v[i].y * v[i].y + v[i].z * v[i].z + v[i].w * v[i].w;
    ss = wave_sum(ss); const float rs = rsqrtf(ss * (1.0f / 1024.0f) + 1e-6f);
#pragma unroll
    for (int i = 0; i < 4; ++i) { const int c = i * 256 + lane * 4; const float4 gg = *(const float4*)(g + c), sh = *(const float4*)(mb_sh + c), sc = *(const float4*)(mb_sc + c);
        u32x2 o; o.x = pack2(v[i].x * rs * gg.x * (1.f + sc.x) + sh.x, v[i].y * rs * gg.y * (1.f + sc.y) + sh.y);
        o.y = pack2(v[i].z * rs * gg.z * (1.f + sc.z) + sh.z, v[i].w * rs * gg.w * (1.f + sc.w) + sh.w);
        *(u32x2*)(dst + c) = o; }
    (void)src;
}
__device__ __forceinline__ void phase_hnorm(const Params& p, int l, const float* xl, const float* xc) {
    const int lane = threadIdx.x & 63, wv = threadIdx.x >> 6;
    const float* mod = (const float*)(p.ws + WS_MOD) + (size_t)l * 17 * 6144; const float* g = p.in[6] + (l * 4 + 0) * 1024;
    bf16_t* A = (bf16_t*)(p.ws + WS_ABUF);
    for (int r = blockIdx.x * 8 + wv; r < NROW; r += gridDim.x * 8) {
        const float* src = xrow(xl, xc, r); const int b = r < NLAT ? (r >> 11) : 16; const float* mb = mod + (size_t)b * 6144;
        float4 v[4];
#pragma unroll
        for (int i = 0; i < 4; ++i) v[i] = *(const float4*)(src + i * 256 + lane * 4);
        hnorm_row(src, g, mb, mb + 1024, A + (size_t)r * 1024, lane, v);
    }
}

__device__ __forceinline__ void phase_prep(const Params& p, int l, LAS unsigned char* lds) {
    LAS bf16_t* vt = (LAS bf16_t*)lds;
    LAS lf2* cs = (LAS lf2*)(lds + 50176);
    const int tid = threadIdx.x;
    for (int i = tid; i < 1024; i += NTHR) { const int pos = i >> 4, j = i & 15; const float invf = exp2f(-(float)j * (13.287712379549449f / 16.0f)); float s, c; sincosf((float)pos * invf, &s, &c); cs[i] = (lf2){c, s}; }
    __syncthreads();
    const bf16_t* P = (const bf16_t*)(p.ws + U_P);
    bf16_t* QR = (bf16_t*)(p.ws + U_QR); bf16_t* KR = (bf16_t*)(p.ws + U_KR);
    bf16_t* RS = (bf16_t*)(p.ws + U_RS); bf16_t* KS = (bf16_t*)(p.ws + U_KS); bf16_t* VS = (bf16_t*)(p.ws + U_VS); bf16_t* KK = (bf16_t*)(p.ws + U_KK); bf16_t* ALR = (bf16_t*)(p.ws + U_ALR);
    for (int ti = blockIdx.x; ti < NROW / 64; ti += gridDim.x) {
        const int r0 = ti * 64; const bool lat = r0 < NLAT; const int b = lat ? (r0 >> 11) : ((r0 - NLAT) >> 8), t0 = lat ? (r0 & 2047) : ((r0 - NLAT) & 255), slen = lat ? SEQ : CTXL;
#pragma unroll
        for (int i = 0; i < 6; ++i) { const int idx = tid + NTHR * i, tok = idx / 48, pc = idx % 48;
            *(LAS lu4*)(vt + tok * 392 + pc * 8) = *(const lu4*)(P + (size_t)(r0 + tok) * NINP + C_V + pc * 8); }
        __syncthreads();
        { bf16_t* vdst = lat ? (bf16_t*)(p.ws + U_VT) + (size_t)b * 384 * 2048 + t0 : (bf16_t*)(p.ws + U_VTC) + (size_t)b * 384 * 256 + t0;
#pragma unroll
          for (int i = 0; i < 6; ++i) { const int idx = tid + NTHR * i, hd = idx >> 3, pc = idx & 7; unsigned w[4];
#pragma unroll
              for (int j = 0; j < 4; ++j) w[j] = (unsigned)vt[(pc * 8 + 2 * j) * 392 + hd] | ((unsigned)vt[(pc * 8 + 2 * j + 1) * 392 + hd] << 16);
              *(uint4*)(vdst + (size_t)hd * slen + pc * 8) = make_uint4(w[0], w[1], w[2], w[3]); } }
#pragma unroll
        for (int i = 0; i < 4; ++i) { const int idx = tid + NTHR * i, tok = idx >> 5, pc = idx & 31;
            *(lu4*)((bf16_t*)(p.ws + U_U16) + (size_t)(r0 + tok) * 256 + pc * 8) = *(const lu4*)(P + (size_t)(r0 + tok) * NINP + pc * 8); }
#pragma unroll
        for (int i = 0; i < 6; ++i) { const int idx = tid + NTHR * i, tok = idx / 48, rem = idx % 48, qk = rem / 24, rem2 = rem % 24, h = rem2 >> 2, pp = rem2 & 3;
            const int d1 = (pp >> 1) * 32 + (pp & 1) * 8; const size_t so = (size_t)(r0 + tok) * NINP + (qk ? C_K : C_Q) + h * 64 + d1;
            float x1[8], x2[8], o1[8], o2[8]; unpack8(*(const uint4*)(P + so), x1); unpack8(*(const uint4*)(P + so + 16), x2);
            const int t = t0 + tok, pos = (pp < 2) ? (t >> 6) : (t & 63), j0 = (pp & 1) * 8; const float scl = qk ? 1.0f : 0.125f;
#pragma unroll
            for (int j = 0; j < 8; ++j) { lf2 c = cs[pos * 16 + j0 + j]; if (!lat) c = (lf2){1.f, 0.f}; o1[j] = (x1[j] * c.x - x2[j] * c.y) * scl; o2[j] = (x1[j] * c.y + x2[j] * c.x) * scl; }
            bf16_t* dq = (qk ? KR : QR) + (size_t)(r0 + tok) * 384 + h * 64 + d1; *(uint4*)dq = pack8(o1); *(uint4*)(dq + 16) = pack8(o2); }
        for (int i = 0; i < 24; ++i) { const int idx = tid + NTHR * i, tok = idx / 192, pc = idx % 192, c0 = pc * 8, r = r0 + tok, t = t0 + tok;
            const bf16_t* zp = P + (size_t)r * NINP + C_Z + c0; float x[8], pv[8], nx[8], zs[8];
            unpack8(*(const uint4*)zp, x);
            if (t > 0) unpack8(*(const uint4*)(zp - NINP), pv); else {
#pragma unroll
                for (int j = 0; j < 8; ++j) pv[j] = 0.f; }
            if (t < slen - 1) unpack8(*(const uint4*)(zp + NINP), nx); else {
#pragma unroll
                for (int j = 0; j < 8; ++j) nx[j] = 0.f; }
            const float4 mu0 = *(const float4*)(p.in[20] + l * 1536 + c0), mu1 = *(const float4*)(p.in[20] + l * 1536 + c0 + 4); const float mu[8] = {mu0.x, mu0.y, mu0.z, mu0.w, mu1.x, mu1.y, mu1.z, mu1.w};
#pragma unroll
            for (int j = 0; j < 8; ++j) zs[j] = x[j] + (0.5f * (pv[j] + nx[j]) - x[j]) * mu[j];
            const bool isk = c0 >= 384 && c0 < 768; float kv[8]; float ss = 0.f;
            { const int kc = isk ? c0 - 384 : 0; const float4 k0 = *(const float4*)(p.in[26] + l * 384 + kc), k1 = *(const float4*)(p.in[26] + l * 384 + kc + 4); const float kkw[8] = {k0.x, k0.y, k0.z, k0.w, k1.x, k1.y, k1.z, k1.w};
#pragma unroll
              for (int j = 0; j < 8; ++j) { kv[j] = zs[j] * kkw[j]; ss += kv[j] * kv[j]; } }
            ss += __shfl_xor(ss, 1); ss += __shfl_xor(ss, 2); ss += __shfl_xor(ss, 4);
            if (c0 < 384) *(uint4*)(RS + (size_t)r * 384 + c0) = pack8(zs);
            else if (c0 < 768) { *(uint4*)(KS + (size_t)r * 384 + c0 - 384) = pack8(zs); const float inv = 1.0f / fmaxf(sqrtf(ss), 1e-12f);
#pragma unroll
                for (int j = 0; j < 8; ++j) kv[j] *= inv;
                *(uint4*)(KK + (size_t)r * 384 + c0 - 384) = pack8(kv); }
            else if (c0 < 1152) *(uint4*)(VS + (size_t)r * 384 + c0 - 768) = pack8(zs);
            else { const int ac = c0 - 1152; float o[8];
#pragma unroll
                for (int j = 0; j < 8; ++j) o[j] = ac < 128 ? 1.0f - 2.0f / (1.0f + __expf(2.0f * zs[j])) : (ac < 256 ? zs[j] : sigm(zs[j]));
                *(uint4*)(ALR + (size_t)r * 384 + ac) = pack8(o); }
        }
        __syncthreads();
    }
}

template <int KS, int MODE> __device__ __forceinline__ void lr_wave(const Params& p, int l, int row0, int kofs, const bf16_t* Bt, int d) {
    const int lane = threadIdx.x & 63, m = lane & 15, q = lane >> 4;
    const bf16_t* Ap = (const bf16_t*)(p.ws + U_ALR) + (size_t)(row0 + m) * 384 + kofs + q * 8;
    bf16x8 a[KS];
#pragma unroll
    for (int ks = 0; ks < KS; ++ks) a[ks] = *(const bf16x8*)(Ap + ks * 32);
    bf16_t* O = (bf16_t*)(p.ws + (MODE == 0 ? U_LD + (size_t)d * SZ384 : (MODE == 1 ? U_AG + (size_t)d * SZ384 : U_G))) + (size_t)(row0 + m) * 384;
    const float* bias = MODE == 0 ? p.in[21] + (l * 2 + d) * 384 : p.in[23] + (l * 2 + d) * 384;
    for (int nt = 0; nt < 24; ++nt) {
        f32x4 acc = (f32x4){0.f, 0.f, 0.f, 0.f};
#pragma unroll
        for (int ks = 0; ks < KS; ++ks) { const bf16x8 bfr = *(const bf16x8*)(Bt + (size_t)(nt * 16 + m) * (KS * 32) + ks * 32 + q * 8); acc = mfma16(bfr, a[ks], acc); }
        const int n = nt * 16 + q * 4; float o[4];
        if (MODE == 2) {
#pragma unroll
            for (int j = 0; j < 4; ++j) o[j] = acc[j];
        } else { const float4 bv = *(const float4*)(bias + n); const float bb[4] = {bv.x, bv.y, bv.z, bv.w};
#pragma unroll
            for (int j = 0; j < 4; ++j) { const float s = sigm(bb[j] + acc[j]); o[j] = MODE == 0 ? -0.6065306597f * s : s; } }
        u32x2 w; w.x = pack2(o[0], o[1]); w.y = pack2(o[2], o[3]); *(u32x2*)(O + n) = w;
    }
}
__device__ __forceinline__ void lowrank_items(const Params& p, int l, int wid, int nw) {
    const unsigned char* sw = p.ws + WS_SW + (size_t)l * SW_STRIDE;
    for (int it = wid; it < 2304 * 5; it += nw) { const int rt = it / 5, m = it % 5, row0 = rt * 16;
        if (m < 2) lr_wave<2, 0>(p, l, row0, m * 64, (const bf16_t*)(sw + SW_W2T) + (size_t)m * 384 * 64, m);
        else if (m < 4) lr_wave<2, 1>(p, l, row0, m * 64, (const bf16_t*)(sw + SW_A2T) + (size_t)(m - 2) * 384 * 64, m - 2);
        else lr_wave<4, 2>(p, l, row0, 256, (const bf16_t*)(sw + SW_G2T), 0); }
}

__device__ __forceinline__ int s5_rowbase(int cr) { const int b = cr / 144, c = cr % 144; return c < 16 ? NLAT + b * 256 + c * 16 : b * 2048 + (c - 16) * 16; }
__device__ __forceinline__ void s5_pass1_items(const Params& p, int l, int wid, int nw) {
    const int lane = threadIdx.x & 63, m = lane & 15, q = lane >> 4;
    const bf16_t* P = (const bf16_t*)(p.ws + U_U16); float* SLOC = (float*)(p.ws + U_SLOC);
    for (int it = wid; it < 144 * 16; it += nw) { const int ct = it >> 4, g = it & 15, cr = ct * 16 + m, rb = s5_rowbase(cr);
        const bf16_t* E = (const bf16_t*)(p.ws + WS_SW + (size_t)l * SW_STRIDE + SW_S5E) + (size_t)g * 256 * 256;
        bf16x8 a[8];
#pragma unroll
        for (int ks = 0; ks < 8; ++ks) a[ks] = *(const bf16x8*)(P + (size_t)(rb + 2 * ks + (q >> 1)) * 256 + g * 16 + (q & 1) * 8);
        float* o = SLOC + ((size_t)cr * 16 + g) * 256 + q * 4;
#pragma unroll 2
        for (int nt = 0; nt < 16; ++nt) { f32x4 acc = (f32x4){0.f, 0.f, 0.f, 0.f}; const bf16_t* ep = E + (size_t)(nt * 16 + m) * 256 + q * 8;
#pragma unroll
            for (int ks = 0; ks < 8; ++ks) acc = mfma16(*(const bf16x8*)(ep + ks * 32), a[ks], acc);
            *(f32x4*)(o + nt * 16) = acc; }
    }
}
__device__ __forceinline__ void s5_carry(const Params& p, int l) {
    const int gid = blockIdx.x * NTHR + threadIdx.x; if (gid >= 32768) return;
    const int pp = gid & 63, d = (gid >> 6) & 1, g = (gid >> 7) & 15, b = gid >> 11;
    const int li = ((l * 2 + d) * 16 + g) * 64 + pp; const float lr = p.in[9][li], lim = p.in[10][li], dt = expf(p.in[11][(l * 2 + d) * 16 + g]);
    const float mag = expf(16.0f * dt * lr); float sn, cn; sincosf(16.0f * dt * lim, &sn, &cn); const float ar = mag * cn, ai = mag * sn;
    const float* SLOC = (const float*)(p.ws + U_SLOC); bf16_t* SP = (bf16_t*)(p.ws + U_SPREV);
    float sr = 0.f, si = 0.f;
#pragma unroll 8
    for (int n = 0; n < 144; ++n) { const int c = d == 0 ? n : (n < 16 ? 15 - n : 159 - n); const size_t idx = ((size_t)(b * 144 + c) * 16 + g) * 256 + d * 128 + pp;
        SP[idx] = f2bf(sr); SP[idx + 64] = f2bf(si);
        const float xr = SLOC[idx], xi = SLOC[idx + 64]; const float nr = ar * sr - ai * si + xr, ni = ar * si + ai * sr + xi; sr = nr; si = ni; }
}
__device__ __forceinline__ void s5_pass2_items(const Params& p, int l, int wid, int nw) {
    const int lane = threadIdx.x & 63, m = lane & 15, q = lane >> 4;
    const bf16_t* P = (const bf16_t*)(p.ws + U_U16); const bf16_t* SP = (const bf16_t*)(p.ws + U_SPREV); bf16_t* YG = (bf16_t*)(p.ws + U_YG);
    for (int it = wid; it < 144 * 16; it += nw) { const int ct = it >> 4, g = it & 15; if (l == 1 && ct % 9 == 0) continue;
        const int cr = ct * 16 + m, rb = s5_rowbase(cr);
        const bf16_t* W2 = (const bf16_t*)(p.ws + WS_SW + (size_t)l * SW_STRIDE + SW_S5W2) + (size_t)g * 256 * 512;
        bf16x8 a[16];
#pragma unroll
        for (int ks = 0; ks < 8; ++ks) a[ks] = *(const bf16x8*)(P + (size_t)(rb + 2 * ks + (q >> 1)) * 256 + g * 16 + (q & 1) * 8);
#pragma unroll
        for (int ks = 8; ks < 16; ++ks) a[ks] = *(const bf16x8*)(SP + ((size_t)cr * 16 + g) * 256 + (ks - 8) * 32 + q * 8);
#pragma unroll 2
        for (int nt = 0; nt < 16; ++nt) { f32x4 acc = (f32x4){0.f, 0.f, 0.f, 0.f}; const bf16_t* wp = W2 + (size_t)(nt * 16 + m) * 512 + q * 8;
#pragma unroll
            for (int ks = 0; ks < 16; ++ks) acc = mfma16(*(const bf16x8*)(wp + ks * 32), a[ks], acc);
            float o[4];
#pragma unroll
            for (int j = 0; j < 4; ++j) { const float x = acc[j]; const float u = 0.7978845608f * (x + 0.044715f * x * x * x); const float th = 1.0f - 2.0f / (1.0f + __expf(2.0f * u)); o[j] = 0.5f * x * (1.0f + th); }
            u32x2 w; w.x = pack2(o[0], o[1]); w.y = pack2(o[2], o[3]); *(u32x2*)(YG + (size_t)(rb + nt) * 256 + g * 16 + q * 4) = w; }
    }
}
__device__ __forceinline__ void s5_glu_items(const Params& p, int l, int wid, int nw) {
    const int lane = threadIdx.x & 63, m = lane & 15, q = lane >> 4;
    const bf16_t* YG = (const bf16_t*)(p.ws + U_YG); bf16_t* YC = (bf16_t*)(p.ws + WS_ABUF);
    const bf16_t* GT = (const bf16_t*)(p.ws + WS_SW + (size_t)l * SW_STRIDE + SW_GLUT);
    const int nrt = (l == 0 ? NROW : NLAT) / 16;
    for (int rt = wid; rt < nrt; rt += nw) { const int row = rt * 16 + m;
        bf16x8 a[8];
#pragma unroll
        for (int ks = 0; ks < 8; ++ks) a[ks] = *(const bf16x8*)(YG + (size_t)row * 256 + ks * 32 + q * 8);
#pragma unroll 2
        for (int nt = 0; nt < 16; ++nt) { f32x4 acc = (f32x4){0.f, 0.f, 0.f, 0.f}; const bf16_t* gp = GT + (size_t)(nt * 16 + m) * 256 + q * 8;
#pragma unroll
            for (int ks = 0; ks < 8; ++ks) acc = mfma16(*(const bf16x8*)(gp + ks * 32), a[ks], acc);
            const int n = nt * 16 + q * 4; const float4 bv = *(const float4*)(p.in[18] + l * 256 + n); const u32x2 yw = *(const u32x2*)(YG + (size_t)row * 256 + n);
            u32x2 w; w.x = pack2(bflo(yw.x) * sigm(acc[0] + bv.x), bfhi(yw.x) * sigm(acc[1] + bv.y)); w.y = pack2(bflo(yw.y) * sigm(acc[2] + bv.z), bfhi(yw.y) * sigm(acc[3] + bv.w));
            *(u32x2*)(YC + (size_t)row * 1024 + n) = w; }
    }
}

template <bool HASLAT> __device__ __forceinline__ void na_unit(const Params& p, int l, int b, int h, int i, int n) {
    const int lane = threadIdx.x & 63, m = lane & 15, q = lane >> 4;
    const bf16_t* QR = (const bf16_t*)(p.ws + U_QR); const bf16_t* KR = (const bf16_t*)(p.ws + U_KR);
    const bf16_t* VTL = (const bf16_t*)(p.ws + U_VT) + (size_t)(b * 6 + h) * 64 * 2048; const bf16_t* VTC = (const bf16_t*)(p.ws + U_VTC) + (size_t)(b * 6 + h) * 64 * 256;
    const int qrow = HASLAT ? b * 2048 + i * 64 + n * 16 + m : NLAT + b * 256 + n * 16 + m;
    bf16x8 qf[2];
#pragma unroll
    for (int ks = 0; ks < 2; ++ks) qf[ks] = *(const bf16x8*)(QR + (size_t)qrow * 384 + h * 64 + ks * 32 + q * 8);
    const int r0 = HASLAT ? min(max(i - 4, 0), 24) : 0, scol = HASLAT ? min(max(n * 16 - 8, 0), 32) : 0;
    f32x4 sl[HASLAT ? 16 : 1], sc[16];
    float mx = -3.0e38f;
    if (HASLAT) { const int qc = n * 16 + m, c0 = min(max(qc - 8, 0), 48); const float* rpb = p.in[19] + (size_t)(l * 6 + h) * 15 * 31;
#pragma unroll
        for (int t = 0; t < 16; ++t) { const int kr = t >> 1, ch = t & 1; const bf16_t* kp = KR + (size_t)(b * 2048 + (r0 + kr) * 64 + scol + ch * 16 + m) * 384 + h * 64 + q * 8;
            f32x4 acc = (f32x4){0.f, 0.f, 0.f, 0.f};
#pragma unroll
            for (int ks = 0; ks < 2; ++ks) acc = mfma16(*(const bf16x8*)(kp + ks * 32), qf[ks], acc);
            const int dr = r0 + kr - i + 7;
#pragma unroll
            for (int j = 0; j < 4; ++j) { const int kc = scol + ch * 16 + q * 4 + j; const bool valid = kc >= c0 && kc < c0 + 16; const int dc = min(max(kc - qc + 15, 0), 30);
                const float s = valid ? acc[j] + rpb[dr * 31 + dc] : -1.0e30f; acc[j] = s; mx = fmaxf(mx, s); }
            sl[t] = acc; } }
#pragma unroll
    for (int t = 0; t < 16; ++t) { const bf16_t* kp = KR + (size_t)(NLAT + b * 256 + t * 16 + m) * 384 + h * 64 + q * 8;
        f32x4 acc = (f32x4){0.f, 0.f, 0.f, 0.f};
#pragma unroll
        for (int ks = 0; ks < 2; ++ks) acc = mfma16(*(const bf16x8*)(kp + ks * 32), qf[ks], acc);
#pragma unroll
        for (int j = 0; j < 4; ++j) mx = fmaxf(mx, acc[j]);
        sc[t] = acc; }
    mx = fmaxf(mx, __shfl_xor(mx, 16)); mx = fmaxf(mx, __shfl_xor(mx, 32));
    float sum = 0.f;
    f32x4 o[4];
#pragma unroll
    for (int dt = 0; dt < 4; ++dt) o[dt] = (f32x4){0.f, 0.f, 0.f, 0.f};
    if (HASLAT) {
#pragma unroll
        for (int kr = 0; kr < 8; ++kr) { float e[8];
#pragma unroll
            for (int j = 0; j < 4; ++j) { e[j] = __expf(sl[2 * kr][j] - mx); e[4 + j] = __expf(sl[2 * kr + 1][j] - mx); }
#pragma unroll
            for (int j = 0; j < 8; ++j) sum += e[j];
            const uint4 pw = pack8(e); const bf16x8 pf = __builtin_bit_cast(bf16x8, pw);
            const int tok = (r0 + kr) * 64 + scol + q * 4;
#pragma unroll
            for (int dt = 0; dt < 4; ++dt) { const bf16_t* vp = VTL + (size_t)(dt * 16 + m) * 2048 + tok; const u32x2 v0 = *(const u32x2*)vp, v1 = *(const u32x2*)(vp + 16);
                const uint4 vw = make_uint4(v0.x, v0.y, v1.x, v1.y); o[dt] = mfma16(__builtin_bit_cast(bf16x8, vw), pf, o[dt]); } } }
#pragma unroll
    for (int t2 = 0; t2 < 8; ++t2) { float e[8];
#pragma unroll
        for (int j = 0; j < 4; ++j) { e[j] = __expf(sc[2 * t2][j] - mx); e[4 + j] = __expf(sc[2 * t2 + 1][j] - mx); }
#pragma unroll
        for (int j = 0; j < 8; ++j) sum += e[j];
        const uint4 pw = pack8(e); const bf16x8 pf = __builtin_bit_cast(bf16x8, pw);
        const int tok = t2 * 32 + q * 4;
#pragma unroll
        for (int dt = 0; dt < 4; ++dt) { const bf16_t* vp = VTC + (size_t)(dt * 16 + m) * 256 + tok; const u32x2 v0 = *(const u32x2*)vp, v1 = *(const u32x2*)(vp + 16);
            const uint4 vw = make_uint4(v0.x, v0.y, v1.x, v1.y); o[dt] = mfma16(__builtin_bit_cast(bf16x8, vw), pf, o[dt]); } }
    sum += __shfl_xor(sum, 16); sum += __shfl_xor(sum, 32);
    const float inv = 1.0f / sum;
    bf16_t* yo = (bf16_t*)(p.ws + WS_ABUF) + (size_t)qrow * 1024 + 256 + h * 64 + q * 4;
#pragma unroll
    for (int dt = 0; dt < 4; ++dt) { u32x2 w; w.x = pack2(o[dt][0] * inv, o[dt][1] * inv); w.y = pack2(o[dt][2] * inv, o[dt][3] * inv); *(u32x2*)(yo + dt * 16) = w; }
}
__device__ __forceinline__ void na_items(const Params& p, int l, int wid, int nw) {
    const int nlat = 16 * 6 * 32 * 4, nctx = (l == 0) ? 16 * 6 * 16 : 0;
    for (int it = wid; it < nlat + nctx; it += nw) {
        if (it < nlat) { const int n = it & 3, i = (it >> 2) & 31, bh = it >> 7; na_unit<true>(p, l, bh / 6, bh % 6, i, n); }
        else { const int j = it - nlat, n = j & 15, bh = j >> 4; na_unit<false>(p, l, bh / 6, bh % 6, 0, n); }
    }
}

typedef float f32x2 __attribute__((ext_vector_type(2)));
__device__ __forceinline__ int rk_row(int b, int d, int n) { return n < 256 ? NLAT + b * 256 + (d ? 255 - n : n) : b * 2048 + (d ? 2047 - (n - 256) : (n - 256)); }
template <int CTRL> __device__ __forceinline__ float dpp_f(float v) { return __builtin_bit_cast(float, __builtin_amdgcn_update_dpp(0, __builtin_bit_cast(int, v), CTRL, 0xF, 0xF, true)); }
constexpr int RKP_PITCH = 72, RKP_MAT = 16 * RKP_PITCH * 2, RKP_WAVE = 5 * RKP_MAT + 4 * 16 * 17 * 4;
__device__ __forceinline__ bf16x8 pack_frag(const float (&lo)[4], const float (&hi)[4]) { u32x4 w; w.x = pack2(lo[0], lo[1]); w.y = pack2(lo[2], lo[3]); w.z = pack2(hi[0], hi[1]); w.w = pack2(hi[2], hi[3]); return __builtin_bit_cast(bf16x8, w); }
__device__ __forceinline__ void rwkv_pre_items(const Params& p, int l, int wid, int nw, LAS unsigned char* lds) {
    const int lane = threadIdx.x & 63, m = lane & 15, q = lane >> 4, wv = threadIdx.x >> 6;
    LAS bf16_t* sAt = (LAS bf16_t*)(lds + wv * RKP_WAVE); LAS bf16_t* sBh = sAt + 16 * RKP_PITCH; LAS bf16_t* sKh = sBh + 16 * RKP_PITCH; LAS bf16_t* sRt = sKh + 16 * RKP_PITCH; LAS bf16_t* sV = sRt + 16 * RKP_PITCH;
    LAS float* sM = (LAS float*)(lds + wv * RKP_WAVE + 5 * RKP_MAT);
    const bf16_t* RS = (const bf16_t*)(p.ws + U_RS); const bf16_t* KS = (const bf16_t*)(p.ws + U_KS); const bf16_t* VS = (const bf16_t*)(p.ws + U_VS); const bf16_t* KK = (const bf16_t*)(p.ws + U_KK);
    for (int it = wid; it < NCHUNK; it += nw) { const int u = it / 144, c = it % 144, b = u / 12, h = (u % 12) >> 1, d = u & 1;
        const bf16_t* AG = (const bf16_t*)(p.ws + U_AG + (size_t)d * SZ384); const bf16_t* LD = (const bf16_t*)(p.ws + U_LD + (size_t)d * SZ384);
        const int rb = rk_row(b, d, c * 16), sgn = d ? -1 : 1;
        { LAS bf16_t* sLd = (LAS bf16_t*)sM;
#pragma unroll
          for (int k = 0; k < 12; ++k) { const int idx = lane + 64 * k, pair = idx >> 3, arr = pair >> 4, t = pair & 15, pc = idx & 7;
              const bf16_t* src = arr == 0 ? KK : arr == 1 ? AG : arr == 2 ? KS : arr == 3 ? RS : arr == 4 ? VS : LD;
              LAS bf16_t* dst = arr == 0 ? sAt : arr == 1 ? sBh : arr == 2 ? sKh : arr == 3 ? sRt : arr == 4 ? sV : sLd;
              *(LAS lu4*)(dst + t * RKP_PITCH + pc * 8) = *(const lu4*)(src + (size_t)(rb + sgn * t) * 384 + h * 64 + pc * 8); }
          const float ka = p.in[27][l * 384 + h * 64 + lane]; float L = 0.f;
#pragma unroll 4
          for (int t = 0; t < 16; ++t) { const int o = t * RKP_PITCH + lane;
              const float r_ = bf2f(sRt[o]), k_ = bf2f(sKh[o]), kk_ = bf2f(sAt[o]), ag_ = bf2f(sBh[o]), ld_ = bf2f(sLd[o]);
              const float e0 = __expf(L); L += ld_; const float e1 = __expf(L), ei = __expf(-L);
              sAt[o] = f2bf(-kk_ * e0); sBh[o] = f2bf(kk_ * ag_ * ei); sKh[o] = f2bf(k_ * (1.0f + (ag_ - 1.0f) * ka) * ei); sRt[o] = f2bf(r_ * e1); }
          ((bf16_t*)(p.ws + CH_GT))[(size_t)it * 64 + lane] = f2bf(L); }
        { bf16x8 atf[2], rtf[2], bhf[2], khf[2];
#pragma unroll
          for (int ks = 0; ks < 2; ++ks) { atf[ks] = *(const LAS bf16x8*)(sAt + m * RKP_PITCH + ks * 32 + q * 8); rtf[ks] = *(const LAS bf16x8*)(sRt + m * RKP_PITCH + ks * 32 + q * 8);
              bhf[ks] = *(const LAS bf16x8*)(sBh + m * RKP_PITCH + ks * 32 + q * 8); khf[ks] = *(const LAS bf16x8*)(sKh + m * RKP_PITCH + ks * 32 + q * 8); }
          f32x4 mab = (f32x4){0.f, 0.f, 0.f, 0.f}, mak = mab, mrb = mab, mrk = mab;
#pragma unroll
          for (int ks = 0; ks < 2; ++ks) { mab = mfma16(atf[ks], bhf[ks], mab); mak = mfma16(atf[ks], khf[ks], mak); mrb = mfma16(rtf[ks], bhf[ks], mrb); mrk = mfma16(rtf[ks], khf[ks], mrk); }
#pragma unroll
          for (int r = 0; r < 4; ++r) { const int t = 4 * q + r; sM[(0 * 16 + t) * 17 + m] = m < t ? mab[r] : 0.f; sM[(1 * 16 + t) * 17 + m] = m < t ? mak[r] : 0.f;
              sM[(2 * 16 + t) * 17 + m] = m <= t ? mrb[r] : 0.f; sM[(3 * 16 + t) * 17 + m] = m <= t ? mrk[r] : 0.f; } }
        { float tv[16];
#pragma unroll
          for (int t = 0; t < 16; ++t) { float acc = (m == t) ? 1.0f : 0.0f;
#pragma unroll
              for (int s2 = 0; s2 < t; ++s2) acc += sM[t * 17 + s2] * tv[s2];
              tv[t] = acc; }
#pragma unroll
          for (int t = 0; t < 16; ++t) if (q == 0) sM[t * 17 + m] = tv[t]; }
        bf16x8 tinvf, mrbf;
        { float lo[4], hi[4] = {0.f, 0.f, 0.f, 0.f};
#pragma unroll
          for (int j = 0; j < 4; ++j) lo[j] = sM[(0 * 16 + m) * 17 + 4 * q + j];
          tinvf = pack_frag(lo, hi);
#pragma unroll
          for (int j = 0; j < 4; ++j) lo[j] = sM[(2 * 16 + m) * 17 + 4 * q + j];
          mrbf = pack_frag(lo, hi);
#pragma unroll
          for (int j = 0; j < 4; ++j) hi[j] = sM[(3 * 16 + m) * 17 + 4 * q + j];
          *(bf16x8*)((bf16_t*)(p.ws + CH_MM) + ((size_t)it * 64 + lane) * 8) = pack_frag(lo, hi); }
        { bf16x8 makf; { float lo[4], hi[4];
#pragma unroll
            for (int j = 0; j < 4; ++j) { lo[j] = q < 2 ? sM[(1 * 16 + m) * 17 + 8 * q + j] : 0.f; hi[j] = q < 2 ? sM[(1 * 16 + m) * 17 + 8 * q + 4 + j] : 0.f; }
            makf = pack_frag(lo, hi); }
#pragma unroll
          for (int itile = 0; itile < 4; ++itile) { unsigned vw[4];
#pragma unroll
              for (int j = 0; j < 4; ++j) vw[j] = q < 2 ? ((unsigned)sV[(8 * q + 2 * j) * RKP_PITCH + 16 * itile + m] | ((unsigned)sV[(8 * q + 2 * j + 1) * RKP_PITCH + 16 * itile + m] << 16)) : 0u;
              const u32x4 vq = {vw[0], vw[1], vw[2], vw[3]};
              const f32x4 w1 = mfma16(makf, __builtin_bit_cast(bf16x8, vq), (f32x4){0.f, 0.f, 0.f, 0.f});
              const float lo[4] = {w1[0], w1[1], w1[2], w1[3]}, hi[4] = {0.f, 0.f, 0.f, 0.f};
              const f32x4 uu = mfma16(tinvf, pack_frag(lo, hi), (f32x4){0.f, 0.f, 0.f, 0.f});
              u32x2 o; o.x = pack2(uu[0], uu[1]); o.y = pack2(uu[2], uu[3]);
              *(u32x2*)((bf16_t*)(p.ws + CH_UL) + (((size_t)it * 4 + itile) * 64 + lane) * 4) = o; } }
        f32x4 ap[4], rp[4];
#pragma unroll
        for (int jt = 0; jt < 4; ++jt) { float lo[4], hi[4] = {0.f, 0.f, 0.f, 0.f};
#pragma unroll
            for (int j = 0; j < 4; ++j) lo[j] = bf2f(sAt[(4 * q + j) * RKP_PITCH + 16 * jt + m]);
            ap[jt] = mfma16(tinvf, pack_frag(lo, hi), (f32x4){0.f, 0.f, 0.f, 0.f});
            const float al[4] = {ap[jt][0], ap[jt][1], ap[jt][2], ap[jt][3]};
            f32x4 rr = mfma16(mrbf, pack_frag(al, hi), (f32x4){0.f, 0.f, 0.f, 0.f});
#pragma unroll
            for (int r = 0; r < 4; ++r) rr[r] += bf2f(sRt[(4 * q + r) * RKP_PITCH + 16 * jt + m]);
            rp[jt] = rr;
            float bl[4], kl[4];
#pragma unroll
            for (int j = 0; j < 4; ++j) { bl[j] = bf2f(sBh[(4 * q + j) * RKP_PITCH + 16 * jt + m]); kl[j] = bf2f(sKh[(4 * q + j) * RKP_PITCH + 16 * jt + m]); }
            *(bf16x8*)((bf16_t*)(p.ws + CH_BK) + (((size_t)it * 4 + jt) * 64 + lane) * 8) = pack_frag(bl, kl); }
#pragma unroll
        for (int jt = 0; jt < 4; ++jt)
#pragma unroll
            for (int r = 0; r < 4; ++r) { sAt[(4 * q + r) * RKP_PITCH + 16 * jt + m] = f2bf(ap[jt][r]); sRt[(4 * q + r) * RKP_PITCH + 16 * jt + m] = f2bf(rp[jt][r]); }
#pragma unroll
        for (int x = 0; x < 2; ++x)
#pragma unroll
            for (int ks = 0; ks < 2; ++ks) { const LAS bf16_t* src = (x ? sRt : sAt) + m * RKP_PITCH + 32 * ks + 4 * q;
                const u32x2 a0 = *(const LAS u32x2*)src, a1 = *(const LAS u32x2*)(src + 16); const u32x4 w = {a0.x, a0.y, a1.x, a1.y};
                *(u32x4*)((bf16_t*)(p.ws + CH_XP) + ((((size_t)it * 2 + x) * 2 + ks) * 64 + lane) * 8) = w; }
    }
}
__device__ __forceinline__ void rwkv_seq_task(const Params& p, int l, int task, LAS unsigned char* lds) {
    const int lane = threadIdx.x & 63, m = lane & 15, q = lane >> 4;
    const int u = task >> 2, iw = task & 3, b = u / 12, h = (u % 12) >> 1, d = u & 1, sgn = d ? -1 : 1;
    const bf16_t* XP = (const bf16_t*)(p.ws + CH_XP); const bf16_t* BK = (const bf16_t*)(p.ws + CH_BK); const bf16_t* UL = (const bf16_t*)(p.ws + CH_UL); const bf16_t* MM = (const bf16_t*)(p.ws + CH_MM);
    const bf16_t* GT = (const bf16_t*)(p.ws + CH_GT); const bf16_t* VS = (const bf16_t*)(p.ws + U_VS) + h * 64 + 16 * iw + m;
    float* Yw = (float*)(p.ws + U_YRK) + (size_t)d * NROW * 384 + h * 64 + 16 * iw;
    LAS float* ybuf = (LAS float*)(lds + (threadIdx.x >> 6) * 12288);
    const int rc0 = NLAT + b * 256 + (d ? 255 : 0) + sgn * 4 * q, rdel = (b * 2048 + (d ? 2047 : 0)) - (NLAT + b * 256 + (d ? 255 : 0)) - sgn * 256;
    f32x4 acc[4];
#pragma unroll
    for (int jt = 0; jt < 4; ++jt) acc[jt] = (f32x4){0.f, 0.f, 0.f, 0.f};
    struct OpSet { bf16x8 apf[2], rpf[2], bkf[4], mmf; u32x2 gl[4]; u32x2 uw; bf16_t vr[4]; };
#define RKS_LOAD(X, c_) do { const size_t it_ = (size_t)u * 144 + (c_); const int rb_ = rc0 + sgn * 16 * (c_) + (int)((c_) >= 16) * rdel; \
        _Pragma("unroll") for (int ks = 0; ks < 2; ++ks) { X.apf[ks] = *(const bf16x8*)(XP + (((it_ * 2 + 0) * 2 + ks) * 64 + lane) * 8); X.rpf[ks] = *(const bf16x8*)(XP + (((it_ * 2 + 1) * 2 + ks) * 64 + lane) * 8); } \
        _Pragma("unroll") for (int jt = 0; jt < 4; ++jt) { X.bkf[jt] = *(const bf16x8*)(BK + ((it_ * 4 + jt) * 64 + lane) * 8); X.gl[jt] = *(const u32x2*)(GT + it_ * 64 + 16 * jt + 4 * q); } \
        X.mmf = *(const bf16x8*)(MM + (it_ * 64 + lane) * 8); X.uw = *(const u32x2*)(UL + ((it_ * 4 + iw) * 64 + lane) * 4); \
        _Pragma("unroll") for (int r = 0; r < 4; ++r) X.vr[r] = VS[(size_t)(rb_ + sgn * r) * 384]; } while (0)
#define RKS_COMPUTE(X, c_) do { const int rb_ = rc0 + sgn * 16 * (c_) + (int)((c_) >= 16) * rdel; \
        const float ul[4] = {bflo(X.uw.x), bfhi(X.uw.x), bflo(X.uw.y), bfhi(X.uw.y)}; const float vl[4] = {bf2f(X.vr[0]), bf2f(X.vr[1]), bf2f(X.vr[2]), bf2f(X.vr[3])}; \
        f32x4 zp = (f32x4){0.f, 0.f, 0.f, 0.f}, yp = zp; \
        _Pragma("unroll") for (int ks = 0; ks < 2; ++ks) { const float lo[4] = {acc[2 * ks][0], acc[2 * ks][1], acc[2 * ks][2], acc[2 * ks][3]}, hi[4] = {acc[2 * ks + 1][0], acc[2 * ks + 1][1], acc[2 * ks + 1][2], acc[2 * ks + 1][3]}; \
            const bf16x8 sf = pack_frag(lo, hi); zp = mfma16(X.apf[ks], sf, zp); yp = mfma16(X.rpf[ks], sf, yp); } \
        const float z[4] = {zp[0] + ul[0], zp[1] + ul[1], zp[2] + ul[2], zp[3] + ul[3]}; \
        yp = mfma16(X.mmf, pack_frag(ul, vl), yp); \
        const bf16x8 zvf = pack_frag(z, vl); \
        _Pragma("unroll") for (int jt = 0; jt < 4; ++jt) { acc[jt] = mfma16(X.bkf[jt], zvf, acc[jt]); const f32x4 g4 = {__expf(bflo(X.gl[jt].x)), __expf(bfhi(X.gl[jt].x)), __expf(bflo(X.gl[jt].y)), __expf(bfhi(X.gl[jt].y))}; acc[jt] *= g4; } \
        _Pragma("unroll") for (int r = 0; r < 4; ++r) ybuf[((((c_) % 12) * 16) + 4 * q + r) * 16 + m] = yp[r]; (void)rb_; } while (0)
    asm volatile("; SEQ_BEGIN");
    OpSet A, B, C;
    RKS_LOAD(A, 0); RKS_LOAD(B, 1);
    for (int c0 = 0; c0 < 144; c0 += 12) {
#pragma unroll
        for (int cc = 0; cc < 12; cc += 3) { const int c = c0 + cc;
            RKS_LOAD(C, c + 2); __builtin_amdgcn_sched_barrier(0);
            RKS_COMPUTE(A, c); __builtin_amdgcn_sched_barrier(0);
            { const int cn = c + 3 < 144 ? c + 3 : 143; RKS_LOAD(A, cn); } __builtin_amdgcn_sched_barrier(0);
            RKS_COMPUTE(B, c + 1); __builtin_amdgcn_sched_barrier(0);
            { const int cn = c + 4 < 144 ? c + 4 : 143; RKS_LOAD(B, cn); } __builtin_amdgcn_sched_barrier(0);
            RKS_COMPUTE(C, c + 2); __builtin_amdgcn_sched_barrier(0); }
#pragma unroll
        for (int k = 0; k < 12; ++k) { const int rr = (lane >> 2) + 16 * k, n = c0 * 16 + rr; const int grow = (rc0 - sgn * 4 * q) + sgn * n + (int)(n >= 256) * rdel;
            *(f32x4*)(Yw + (size_t)grow * 384 + (lane & 3) * 4) = *(const LAS f32x4*)(ybuf + rr * 16 + (lane & 3) * 4); }
    }
    asm volatile("; SEQ_END");
#undef RKS_LOAD
#undef RKS_COMPUTE
}

__device__ __forceinline__ void rwkv_finish(const Params& p, int l) {
    const int sub = threadIdx.x & 7; const int npair = (l == 0 ? NROW : NLAT) * 6;
    const bf16_t* RS = (const bf16_t*)(p.ws + U_RS); const bf16_t* KS = (const bf16_t*)(p.ws + U_KS); const bf16_t* VS = (const bf16_t*)(p.ws + U_VS);
    const bf16_t* AG0 = (const bf16_t*)(p.ws + U_AG); const bf16_t* AG1 = (const bf16_t*)(p.ws + U_AG + SZ384); const bf16_t* G = (const bf16_t*)(p.ws + U_G);
    const float* Y0 = (const float*)(p.ws + U_YRK); const float* Y1 = Y0 + (size_t)NROW * 384; bf16_t* YC = (bf16_t*)(p.ws + WS_ABUF);
    for (int pr = (blockIdx.x * NTHR + threadIdx.x) >> 3; pr < npair; pr += (gridDim.x * NTHR) >> 3) { const int row = pr / 6, h = pr % 6, col = h * 64 + sub * 8; const size_t o = (size_t)row * 384 + col;
        float y[8]; { const float4 a0 = *(const float4*)(Y0 + o), a1 = *(const float4*)(Y0 + o + 4), c0 = *(const float4*)(Y1 + o), c1 = *(const float4*)(Y1 + o + 4);
            y[0] = a0.x + c0.x; y[1] = a0.y + c0.y; y[2] = a0.z + c0.z; y[3] = a0.w + c0.w; y[4] = a1.x + c1.x; y[5] = a1.y + c1.y; y[6] = a1.z + c1.z; y[7] = a1.w + c1.w; }
        float s = 0.f;
#pragma unroll
        for (int k = 0; k < 8; ++k) s += y[k];
        s += __shfl_xor(s, 1); s += __shfl_xor(s, 2); s += __shfl_xor(s, 4); const float mean = s * (1.0f / 64.0f);
        float v2 = 0.f;
#pragma unroll
        for (int k = 0; k < 8; ++k) { const float dd = y[k] - mean; v2 += dd * dd; }
        v2 += __shfl_xor(v2, 1); v2 += __shfl_xor(v2, 2); v2 += __shfl_xor(v2, 4); const float rstd = rsqrtf(v2 * (1.0f / 64.0f) + 64e-5f);
        float r[8], kx[8], vx[8], a0[8], a1[8], gx[8];
        unpack8(*(const uint4*)(RS + o), r); unpack8(*(const uint4*)(KS + o), kx); unpack8(*(const uint4*)(VS + o), vx); unpack8(*(const uint4*)(AG0 + o), a0); unpack8(*(const uint4*)(AG1 + o), a1); unpack8(*(const uint4*)(G + o), gx);
        const float* ka = p.in[27] + l * 384 + col; const float* rk = p.in[28] + l * 384 + col; const float* lw = p.in[29] + l * 384 + col; const float* lb = p.in[30] + l * 384 + col;
        float bs = 0.f;
#pragma unroll
        for (int k = 0; k < 8; ++k) { const float kd0 = kx[k] * (1.0f + (a0[k] - 1.0f) * ka[k]), kd1 = kx[k] * (1.0f + (a1[k] - 1.0f) * ka[k]); bs += r[k] * (kd0 + kd1) * rk[k]; }
        bs += __shfl_xor(bs, 1); bs += __shfl_xor(bs, 2); bs += __shfl_xor(bs, 4);
        float ov[8];
#pragma unroll
        for (int k = 0; k < 8; ++k) ov[k] = ((y[k] - mean) * rstd * lw[k] + lb[k] + bs * vx[k]) * gx[k];
        *(uint4*)(YC + (size_t)row * 1024 + 640 + col) = pack8(ov);
    }
}

__device__ __forceinline__ void phase_normrouter(const Params& p, int l, const float* xl, const float* xc, LAS unsigned char* lds) {
    LAS float* rt = (LAS float*)lds;
    for (int i = threadIdx.x; i < 1024 * 16 / 4; i += NTHR) *(LAS lf4*)(rt + i * 4) = *(const lf4*)(p.in[31] + (size_t)l * 1024 * 16 + i * 4);
    __syncthreads();
    const int lane = threadIdx.x & 63, wv = threadIdx.x >> 6; const int nrow = l == 0 ? NROW : NLAT;
    const float* mod = (const float*)(p.ws + WS_MOD) + (size_t)l * 17 * 6144; const float* g1 = p.in[6] + (l * 4 + 1) * 1024; const float* g2 = p.in[6] + (l * 4 + 2) * 1024;
    const float* Y = (const float*)(p.ws + U_Y); bf16_t* A = (bf16_t*)(p.ws + WS_ABUF); float* AFF = (float*)(p.ws + WS_AFF);
    for (int r = blockIdx.x * 8 + wv; r < nrow; r += gridDim.x * 8) { const int b = r < NLAT ? (r >> 11) : 16; const float* mb = mod + (size_t)b * 6144;
        const float* xs = xrow(xl, xc, r); float* xd = xrow_w(p.out, (float*)(p.ws + WS_CTXA), r);
        float4 y[4], x[4]; float ss = 0.f;
#pragma unroll
        for (int i = 0; i < 4; ++i) { y[i] = *(const float4*)(Y + (size_t)r * 1024 + i * 256 + lane * 4); x[i] = *(const float4*)(xs + i * 256 + lane * 4); ss += y[i].x * y[i].x + y[i].y * y[i].y + y[i].z * y[i].z + y[i].w * y[i].w; }
        ss = wave_sum(ss); const float rs = rsqrtf(ss * (1.0f / 1024.0f) + 1e-6f);
        float s2 = 0.f;
#pragma unroll
        for (int i = 0; i < 4; ++i) { const int c = i * 256 + lane * 4; const float4 gg = *(const float4*)(g1 + c), gt = *(const float4*)(mb + 2048 + c);
            x[i].x += gt.x * (y[i].x * rs * gg.x); x[i].y += gt.y * (y[i].y * rs * gg.y); x[i].z += gt.z * (y[i].z * rs * gg.z); x[i].w += gt.w * (y[i].w * rs * gg.w);
            *(float4*)(xd + c) = x[i]; s2 += x[i].x * x[i].x + x[i].y * x[i].y + x[i].z * x[i].z + x[i].w * x[i].w; }
        s2 = wave_sum(s2); const float rs2 = rsqrtf(s2 * (1.0f / 1024.0f) + 1e-6f);
        LAS float* hr = (LAS float*)(lds + 65536) + wv * 1024;
#pragma unroll
        for (int i = 0; i < 4; ++i) { const int c = i * 256 + lane * 4; const float4 gg = *(const float4*)(g2 + c), sh = *(const float4*)(mb + 3072 + c), sc = *(const float4*)(mb + 4096 + c);
            const float hv[4] = {x[i].x * rs2 * gg.x * (1.f + sc.x) + sh.x, x[i].y * rs2 * gg.y * (1.f + sc.y) + sh.y, x[i].z * rs2 * gg.z * (1.f + sc.z) + sh.z, x[i].w * rs2 * gg.w * (1.f + sc.w) + sh.w};
            u32x2 o; o.x = pack2(hv[0], hv[1]); o.y = pack2(hv[2], hv[3]); *(u32x2*)(A + (size_t)r * 1024 + c) = o;
            *(LAS lf4*)(hr + c) = (lf4){hv[0], hv[1], hv[2], hv[3]}; }
        const int e = lane & 15, cq = lane >> 4; float lgt = 0.f;
#pragma unroll 4
        for (int c4 = 0; c4 < 64; ++c4) { const int c = cq * 256 + c4 * 4; const lf4 hv4 = *(const LAS lf4*)(hr + c);
            lgt += hv4.x * rt[c * 16 + e] + hv4.y * rt[(c + 1) * 16 + e] + hv4.z * rt[(c + 2) * 16 + e] + hv4.w * rt[(c + 3) * 16 + e]; }
        lgt += __shfl_xor(lgt, 16); lgt += __shfl_xor(lgt, 32);
        float mxl = lgt;
#pragma unroll
        for (int o = 8; o >= 1; o >>= 1) mxl = fmaxf(mxl, __shfl_xor(mxl, o));
        const float ex = expf(lgt - mxl); float den = ex;
#pragma unroll
        for (int o = 8; o >= 1; o >>= 1) den += __shfl_xor(den, o);
        if (lane < 16) AFF[(size_t)r * 16 + lane] = ex / den;
    }
}

__device__ __forceinline__ void phase_topk(const Params& p, int l, LAS unsigned char* lds) {
    LAS unsigned* keys = (LAS unsigned*)lds;
    LAS int* toks = (LAS int*)(lds + 8192);
    LAS unsigned* hist = (LAS unsigned*)(lds + 9216);
    LAS unsigned* wtot = (LAS unsigned*)(lds + 10240);
    LAS unsigned* sel = (LAS unsigned*)(lds + 10304);
    const int tid = threadIdx.x, lane = tid & 63, wv = tid >> 6, nitem = l == 0 ? 512 : 256;
    const float* AFF = (const float*)(p.ws + WS_AFF); int* SLOT = (int*)(p.ws + WS_SLOT); float* SELG = (float*)(p.ws + WS_SELG);
    const bf16_t* A = (const bf16_t*)(p.ws + WS_ABUF); bf16_t* XS = (bf16_t*)(p.ws + U_XSEL);
    for (int it = blockIdx.x; it < nitem; it += gridDim.x) { const bool lat = it < 256; const int be = it & 255, b = be >> 4, e = be & 15;
        const int n = lat ? SEQ : CTXL, cap = lat ? 256 : 32, rowbase = lat ? b * 2048 : NLAT + b * 256, xoff = lat ? b * 256 : 4096 + b * 32;
        const int per = n / NTHR > 0 ? n / NTHR : 1;
        const int t0 = tid * per; const bool act = t0 < n;
        unsigned kx[4];
        __syncthreads();
#pragma unroll
        for (int j = 0; j < 4; ++j) { kx[j] = 0u; if (act && j < per) { kx[j] = __float_as_uint(AFF[(size_t)(rowbase + t0 + j) * 16 + e]); keys[t0 + j] = kx[j]; } }
        unsigned prefix = 0u; int krem = cap;
        for (int pass = 0; pass < 4; ++pass) { const int shift = 24 - 8 * pass;
            if (tid < 256) hist[tid] = 0u;
            __syncthreads();
#pragma unroll
            for (int j = 0; j < 4; ++j) if (act && j < per) { const bool match = pass == 0 || (kx[j] >> (shift + 8)) == (prefix >> (shift + 8)); if (match) atomicAdd((unsigned*)&hist[(kx[j] >> shift) & 255u], 1u); }
            __syncthreads();
            if (tid < 256) { unsigned above = 0u; for (int bb = tid + 1; bb < 256; ++bb) above += hist[bb]; const unsigned mine = hist[tid];
                if (above < (unsigned)krem && above + mine >= (unsigned)krem) { sel[0] = (unsigned)tid; sel[1] = (unsigned)krem - above; } }
            __syncthreads();
            prefix |= sel[0] << shift; krem = (int)sel[1];
            __syncthreads();
        }
        unsigned loc = 0u, pre[4];
#pragma unroll
        for (int j = 0; j < 4; ++j) { pre[j] = loc; if (act && j < per) loc += (kx[j] > prefix ? 1u : 0u) + (kx[j] == prefix ? 65536u : 0u); }
        unsigned inc = loc;
#pragma unroll
        for (int o = 1; o < 64; o <<= 1) { const unsigned t = __shfl_up(inc, o); if (lane >= o) inc += t; }
        if (lane == 63) wtot[wv] = inc;
        __syncthreads();
        unsigned base = inc - loc;
        for (int w = 0; w < wv; ++w) base += wtot[w];
#pragma unroll
        for (int j = 0; j < 4; ++j) if (act && j < per) { const unsigned c = base + pre[j]; const int gtb = (int)(c & 0xffffu), eqb = (int)(c >> 16);
            const bool s = kx[j] > prefix || (kx[j] == prefix && eqb < krem); const int slot = gtb + (eqb < krem ? eqb : krem);
            if (s) { SELG[e * XROWS + xoff + slot] = __uint_as_float(kx[j]); toks[slot] = t0 + j; }
            SLOT[(size_t)(rowbase + t0 + j) * 16 + e] = s ? slot : -1; }
        __syncthreads();
        for (int s = wv; s < cap; s += 8) { const lu4* src = (const lu4*)(A + (size_t)(rowbase + toks[s]) * 1024); lu4* dst = (lu4*)(XS + ((size_t)e * XROWS + xoff + s) * 1024);
            dst[lane] = src[lane]; dst[lane + 64] = src[lane + 64]; }
    }
}

struct GroupedOrder { int nMl, nNl, pnb, G, c, total;
    __device__ void init(int nMl_, int nNl_, int pnb_, int G_, int c_) { nMl = nMl_; nNl = nNl_; pnb = pnb_; G = G_; c = c_; total = 16 * nMl_ * nNl_; }
    __device__ bool next(int i, pg8::Unit& u) const {
        int L;
        if ((G & 7) == 0 && (total & 7) == 0) { const int W = G >> 3, x = c & 7, r = c >> 3, t8 = total >> 3, k = i * W + r; if (k >= t8) return false; L = x * t8 + k; }
        else { const long LL = (long)i * G + c; if (LL >= total) return false; L = (int)LL; }
        const int per = nMl * nNl, e = L / per, idx = L % per, blk = idx / (pnb * nMl), rem = idx % (pnb * nMl), pml = rem / pnb, pnl = blk * pnb + rem % pnb;
        u.pm = e * 18 + pml; u.pn = e * nNl + pnl; return true; }
    __device__ __forceinline__ void a_ready(const pg8::Unit&) const {}
    __device__ __forceinline__ void done(const pg8::Unit&) const {}
};
struct EpiSwiGLU { static constexpr bool PERM = true, AFTER_DRAIN = false; bf16_t* H;
    __device__ __forceinline__ void operator()(const f32x4 (&acc)[2][2][4][2], const pg8::Unit& u, int wr, int wc, int fr, int fq) const {
        const int e = u.pn / 22, pnl = u.pn - e * 22; const int row0 = u.pm * 256 + wr * 64 + fr, col0 = pnl * 128 + wc * 32 + 8 * fq;
#pragma unroll
        for (int ai = 0; ai < 2; ++ai)
#pragma unroll
            for (int m = 0; m < 4; ++m) { bf16_t* rowp = H + (size_t)(row0 + ai * 128 + m * 16) * DE + col0; float o[8];
#pragma unroll
                for (int n = 0; n < 2; ++n)
#pragma unroll
                    for (int j = 0; j < 4; ++j) { const float g = acc[ai][0][m][n][j], uu = acc[ai][1][m][n][j]; o[n * 4 + j] = g * sigm(g) * uu; }
                *(uint4*)rowp = pack8(o); }
    }
};
struct EpiGate { static constexpr bool PERM = true, AFTER_DRAIN = false; bf16_t* O; const float* gate;
    __device__ __forceinline__ void operator()(const f32x4 (&acc)[2][2][4][2], const pg8::Unit& u, int wr, int wc, int fr, int fq) const {
        const int pnl = u.pn & 3; const int row0 = u.pm * 256 + wr * 64 + fr, col0 = pnl * 256 + wc * 32 + 8 * fq;
#pragma unroll
        for (int ai = 0; ai < 2; ++ai)
#pragma unroll
            for (int m = 0; m < 4; ++m) { const int r = row0 + ai * 128 + m * 16; const float gt = gate[r]; bf16_t* rowp = O + (size_t)r * 1024 + col0;
#pragma unroll
                for (int bj = 0; bj < 2; ++bj) { float o[8];
#pragma unroll
                    for (int n = 0; n < 2; ++n)
#pragma unroll
                        for (int j = 0; j < 4; ++j) o[n * 4 + j] = acc[ai][bj][m][n][j] * gt;
                    *(uint4*)(rowp + bj * 128) = pack8(o); } }
    }
};

__device__ __forceinline__ void phase_combine(const Params& p, int l) {
    const int lane = threadIdx.x & 63, wv = threadIdx.x >> 6; const int nrow = l == 0 ? NROW : NLAT;
    const float* mod = (const float*)(p.ws + WS_MOD) + (size_t)l * 17 * 6144; const float* g3 = p.in[6] + (l * 4 + 3) * 1024;
    const int* SLOT = (const int*)(p.ws + WS_SLOT); const bf16_t* YE = (const bf16_t*)(p.ws + U_YEXP); bf16_t* A = (bf16_t*)(p.ws + WS_ABUF);
    for (int r = blockIdx.x * 8 + wv; r < nrow; r += gridDim.x * 8) { const bool lat = r < NLAT; const int b = lat ? (r >> 11) : ((r - NLAT) >> 8), mbi = lat ? b : 16, xoff = lat ? b * 256 : 4096 + b * 32;
        const float* mb = mod + (size_t)mbi * 6144;
        float f[16];
#pragma unroll
        for (int k = 0; k < 16; ++k) f[k] = 0.f;
        const int myslot = lane < 16 ? SLOT[(size_t)r * 16 + lane] : -1;
        for (int e = 0; e < 16; ++e) { const int s = __shfl(myslot, e); if (s >= 0) { const bf16_t* yr = YE + ((size_t)e * XROWS + xoff + s) * 1024 + lane * 4;
#pragma unroll
                for (int i = 0; i < 4; ++i) { const u32x2 w = *(const u32x2*)(yr + i * 256); f[i * 4] += bflo(w.x); f[i * 4 + 1] += bfhi(w.x); f[i * 4 + 2] += bflo(w.y); f[i * 4 + 3] += bfhi(w.y); } } }
        float ss = 0.f;
#pragma unroll
        for (int k = 0; k < 16; ++k) ss += f[k] * f[k];
        ss = wave_sum(ss); const float rs = rsqrtf(ss * (1.0f / 1024.0f) + 1e-6f);
        const float* x1 = xrow(p.out, (const float*)(p.ws + WS_CTXA), r);
        float* x2 = l == 0 ? xrow_w((float*)(p.ws + WS_XB), (float*)(p.ws + WS_CTXB), r) : p.out + (size_t)r * D;
        float4 xv[4];
#pragma unroll
        for (int i = 0; i < 4; ++i) { const int c = i * 256 + lane * 4; const float4 gg = *(const float4*)(g3 + c), gt = *(const float4*)(mb + 5120 + c); float4 x = *(const float4*)(x1 + c);
            x.x += gt.x * (f[i * 4] * rs * gg.x); x.y += gt.y * (f[i * 4 + 1] * rs * gg.y); x.z += gt.z * (f[i * 4 + 2] * rs * gg.z); x.w += gt.w * (f[i * 4 + 3] * rs * gg.w);
            *(float4*)(x2 + c) = x; xv[i] = x; }
        if (l == 0) { const float* mb1 = mod + (size_t)17 * 6144 + (size_t)mbi * 6144; hnorm_row(nullptr, p.in[6] + 4 * 1024, mb1, mb1 + 1024, A + (size_t)r * 1024, lane, xv); }
    }
}

#ifndef MK_ONLY
#define MK_ONLY -1
#endif
#define EN(k) (MK_ONLY < 0 || MK_ONLY == (k))
#ifndef MK_DUP
#define MK_DUP 0
#endif
#define NREP(k) ((((MK_DUP) >> (k)) & 1) ? 2 : 1)
constexpr int PH_PER_LAYER = 14, N_PHASES = 1 + 2 * PH_PER_LAYER;
#define IN(k) (lo <= (k) && (k) < hi)
#define SEAM(k) do { if (p.use_bar && IN(k) && IN((k) + 1)) xcd_barrier(bar); } while (0)
template <int l> __device__ __forceinline__ void layer_phases(const Params& p, LAS unsigned char* lds, const XcdBarrier& bar, const int lo, const int hi) {
    const int wv = __builtin_amdgcn_readfirstlane(threadIdx.x >> 6), G = gridDim.x; const int wid = blockIdx.x * 8 + wv, nw = G * 8;
        const int pb = 1 + l * PH_PER_LAYER;
        const float* xl = l == 0 ? p.in[0] : (const float*)(p.ws + WS_XB);
        const float* xc = l == 0 ? p.in[2] : (const float*)(p.ws + WS_CTXB);
        if (EN(0) && IN(pb + 0)) { { if (l == 0) phase_hnorm(p, 0, xl, xc); }
            if ((NREP(0)) == 2) { if (l == 0) phase_hnorm(p, 0, xl, xc); } }
        SEAM(pb + 0);
        if (EN(1) && IN(pb + 1)) { { pg8::Gemm g{(const bf16_t*)(p.ws + WS_ABUF), (const bf16_t*)(p.ws + WS_WIN), NROW, NINP, D}; pg8::StaticOrder S; S.init(NROW, NINP, G, (int)blockIdx.x);
            pg8::EpiBf16<0> E{(bf16_t*)(p.ws + U_P), NINP, nullptr, 0, 0}; pg8::gemm_phase<pg8::EpiBf16<0>, pg8::StaticOrder, false>(lds, g, S, E, nullptr); }
            if ((NREP(1)) == 2) { pg8::Gemm g{(const bf16_t*)(p.ws + WS_ABUF), (const bf16_t*)(p.ws + WS_WIN), NROW, NINP, D}; pg8::StaticOrder S; S.init(NROW, NINP, G, (int)blockIdx.x);
            pg8::EpiBf16<0> E{(bf16_t*)(p.ws + U_P), NINP, nullptr, 0, 0}; pg8::gemm_phase<pg8::EpiBf16<0>, pg8::StaticOrder, false>(lds, g, S, E, nullptr); } }
        SEAM(pb + 1);
        if (EN(2) && IN(pb + 2)) { phase_prep(p, l, lds);
            if ((NREP(2)) == 2) phase_prep(p, l, lds); }
        SEAM(pb + 2);
        if (EN(3) && IN(pb + 3)) { { lowrank_items(p, l, wid, nw); s5_pass1_items(p, l, wid, nw); }
            if ((NREP(3)) == 2) { lowrank_items(p, l, wid, nw); s5_pass1_items(p, l, wid, nw); } }
        SEAM(pb + 3);
        if (EN(4) && IN(pb + 4)) { { s5_carry(p, l); na_items(p, l, wid, nw); }
            if ((NREP(4)) == 2) { s5_carry(p, l); na_items(p, l, wid, nw); } }
        SEAM(pb + 4);
        if (EN(5) && IN(pb + 5)) { { s5_pass2_items(p, l, wid, nw); rwkv_pre_items(p, l, wid, nw, lds); }
            if ((NREP(5)) == 2) { s5_pass2_items(p, l, wid, nw); rwkv_pre_items(p, l, wid, nw, lds); } }
        SEAM(pb + 5);
        if (EN(6) && IN(pb + 6)) { { if (G * 3 >= 768) { if (wv < 3) { for (int task = wv * G + (int)blockIdx.x; task < 768; task += 3 * G) rwkv_seq_task(p, l, task, lds); } else s5_glu_items(p, l, (int)blockIdx.x * 5 + (wv - 3), G * 5); } else { for (int task = wv * G + (int)blockIdx.x; task < 768; task += nw) rwkv_seq_task(p, l, task, lds); s5_glu_items(p, l, wid, nw); } }
            if ((NREP(6)) == 2) { if (G * 3 >= 768) { if (wv < 3) { for (int task = wv * G + (int)blockIdx.x; task < 768; task += 3 * G) rwkv_seq_task(p, l, task, lds); } else s5_glu_items(p, l, (int)blockIdx.x * 5 + (wv - 3), G * 5); } else { for (int task = wv * G + (int)blockIdx.x; task < 768; task += nw) rwkv_seq_task(p, l, task, lds); s5_glu_items(p, l, wid, nw); } } }
        SEAM(pb + 6);
        if (EN(7) && IN(pb + 7)) { rwkv_finish(p, l);
            if ((NREP(7)) == 2) rwkv_finish(p, l); }
        SEAM(pb + 7);
        if (EN(8) && IN(pb + 8)) { { const int M = l == 0 ? NROW : NLAT; pg8::Gemm g{(const bf16_t*)(p.ws + WS_ABUF), (const bf16_t*)(p.ws + WS_WOUT), M, D, D}; pg8::StaticOrder S; S.init(M, D, G, (int)blockIdx.x);
            pg8::EpiF32 E{(float*)(p.ws + U_Y), D, nullptr}; pg8::gemm_phase<pg8::EpiF32, pg8::StaticOrder, false>(lds, g, S, E, nullptr); }
            if ((NREP(8)) == 2) { const int M = l == 0 ? NROW : NLAT; pg8::Gemm g{(const bf16_t*)(p.ws + WS_ABUF), (const bf16_t*)(p.ws + WS_WOUT), M, D, D}; pg8::StaticOrder S; S.init(M, D, G, (int)blockIdx.x);
            pg8::EpiF32 E{(float*)(p.ws + U_Y), D, nullptr}; pg8::gemm_phase<pg8::EpiF32, pg8::StaticOrder, false>(lds, g, S, E, nullptr); } }
        SEAM(pb + 8);
        if (EN(9) && IN(pb + 9)) { phase_normrouter(p, l, xl, xc, lds);
            if ((NREP(9)) == 2) phase_normrouter(p, l, xl, xc, lds); }
        SEAM(pb + 9);
        if (EN(10) && IN(pb + 10)) { phase_topk(p, l, lds);
            if ((NREP(10)) == 2) phase_topk(p, l, lds); }
        SEAM(pb + 10);
        if (EN(11) && IN(pb + 11)) { { pg8::Gemm g{(const bf16_t*)(p.ws + U_XSEL), (const bf16_t*)(p.ws + WS_WGU), 16 * XROWS, 16 * 5632, D}; GroupedOrder S; S.init(l == 0 ? 18 : 16, 22, 2, G, (int)blockIdx.x);
            EpiSwiGLU E{(bf16_t*)(p.ws + U_HID)}; pg8::gemm_phase<EpiSwiGLU, GroupedOrder, false>(lds, g, S, E, nullptr); }
            if ((NREP(11)) == 2) { pg8::Gemm g{(const bf16_t*)(p.ws + U_XSEL), (const bf16_t*)(p.ws + WS_WGU), 16 * XROWS, 16 * 5632, D}; GroupedOrder S; S.init(l == 0 ? 18 : 16, 22, 2, G, (int)blockIdx.x);
            EpiSwiGLU E{(bf16_t*)(p.ws + U_HID)}; pg8::gemm_phase<EpiSwiGLU, GroupedOrder, false>(lds, g, S, E, nullptr); } }
        SEAM(pb + 11);
        if (EN(12) && IN(pb + 12)) { { pg8::Gemm g{(const bf16_t*)(p.ws + U_HID), (const bf16_t*)(p.ws + WS_WD), 16 * XROWS, 16 * 1024, DE}; GroupedOrder S; S.init(l == 0 ? 18 : 16, 4, 4, G, (int)blockIdx.x);
            EpiGate E{(bf16_t*)(p.ws + U_YEXP), (const float*)(p.ws + WS_SELG)}; pg8::gemm_phase<EpiGate, GroupedOrder, false>(lds, g, S, E, nullptr); }
            if ((NREP(12)) == 2) { pg8::Gemm g{(const bf16_t*)(p.ws + U_HID), (const bf16_t*)(p.ws + WS_WD), 16 * XROWS, 16 * 1024, DE}; GroupedOrder S; S.init(l == 0 ? 18 : 16, 4, 4, G, (int)blockIdx.x);
            EpiGate E{(bf16_t*)(p.ws + U_YEXP), (const float*)(p.ws + WS_SELG)}; pg8::gemm_phase<EpiGate, GroupedOrder, false>(lds, g, S, E, nullptr); } }
        SEAM(pb + 12);
        if (EN(13) && IN(pb + 13)) { { phase_combine(p, l); if (l == 0) convert_weights(p, 1, lds, (int)blockIdx.x, G); }
            if (((l == 0 ? NREP(13) : 1)) == 2) { phase_combine(p, l); if (l == 0) convert_weights(p, 1, lds, (int)blockIdx.x, G); } }
        SEAM(pb + 13);
}
__global__ void __launch_bounds__(NTHR, 2) fwd(Params p) {
    extern __shared__ __attribute__((aligned(16))) unsigned char lds_raw[];
    LAS unsigned char* lds = (LAS unsigned char*)lds_raw;
    const int tid = threadIdx.x;
    if (tid < 4) ((LAS unsigned*)(lds + LDS_MISC))[tid] = 0u;
    __syncthreads();
    XcdBarrier bar; bar.bar = (unsigned*)(p.ws + WS_CTL); bar.x = 0; bar.st = (volatile LAS unsigned*)(lds + LDS_MISC);
    if (p.use_bar) bar = xcd_barrier_post((unsigned*)(p.ws + WS_CTL), (volatile LAS unsigned*)(lds + LDS_MISC));
    const int lo = p.ph_lo, hi = p.ph_hi;

    if (EN(100) && IN(0)) { { phase_prologue(p, lds); }
        if ((NREP(14)) == 2) { phase_prologue(p, lds); } }
    SEAM(0);
    layer_phases<0>(p, lds, bar, lo, hi);
    layer_phases<1>(p, lds, bar, lo, hi);
#undef IN
#undef SEAM
}
}

#ifndef MK_ONE_LAUNCH
#define MK_ONE_LAUNCH 1
#endif
extern "C" void kernel_launch(void* const* d_in, const int* in_sizes, int n_in, void* d_out, int out_size, void* d_ws, size_t ws_size, hipStream_t stream) {
    static int grid = 0;
    if (grid == 0) {
        if (n_in != 35 || out_size != mk::NLAT * mk::D || ws_size < mk::WS_END) { fprintf(stderr, "kernel_launch: unexpected problem (n_in %d, out %d, ws %zu < %zu)\n", n_in, out_size, ws_size, (size_t)mk::WS_END); grid = -1; return; }
        int dev = 0, cus = 0, per_cu = 0;
        if (hipGetDevice(&dev) != hipSuccess || hipDeviceGetAttribute(&cus, hipDeviceAttributeMultiprocessorCount, dev) != hipSuccess) { grid = -1; return; }
        if (hipFuncSetAttribute((const void*)mk::fwd, hipFuncAttributeMaxDynamicSharedMemorySize, mk::LDS_BYTES) != hipSuccess) { fprintf(stderr, "kernel_launch: hipFuncSetAttribute failed\n"); grid = -1; return; }
        if (hipOccupancyMaxActiveBlocksPerMultiprocessor(&per_cu, (const void*)mk::fwd, mk::NTHR, mk::LDS_BYTES) != hipSuccess || per_cu < 1) { fprintf(stderr, "kernel_launch: occupancy query says %d\n", per_cu); per_cu = 1; }
        (void)hipGetLastError();
        grid = cus;
    }
    if (grid < 0) return;
    (void)in_sizes;
    if (hipMemsetAsync(d_ws, 0, 65536, stream) != hipSuccess) return;
    mk::Params a{};
    for (int i = 0; i < 35; ++i) a.in[i] = (const float*)d_in[i];
    a.out = (float*)d_out; a.ws = (unsigned char*)d_ws;
#if MK_ONE_LAUNCH
    a.ph_lo = 0; a.ph_hi = mk::N_PHASES; a.use_bar = 1;
    hipLaunchKernelGGL(mk::fwd, dim3(grid), dim3(mk::NTHR), mk::LDS_BYTES, stream, a);
#else
    for (int ph = 0; ph < mk::N_PHASES; ++ph) { a.ph_lo = ph; a.ph_hi = ph + 1; a.use_bar = 0; hipLaunchKernelGGL(mk::fwd, dim3(grid), dim3(mk::NTHR), mk::LDS_BYTES, stream, a); }
#endif
}
```

```cpp
#include <hip/hip_runtime.h>
#include <cstdio>
#include <cstdint>
namespace pg8 {
#define PG8_LAS __attribute__((address_space(3)))
typedef unsigned short bf16_t;
typedef short bf16x8 __attribute__((ext_vector_type(8)));
typedef float f32x4 __attribute__((ext_vector_type(4)));
typedef unsigned u32x4 __attribute__((ext_vector_type(4)));
constexpr int BM = 256, BK = 64, HALF = 128, HTB = HALF * BK * 2  , STAGE_BYTES = 8 * HTB, NXCD = 8, WGM = 8;

__host__ __device__ __forceinline__ int lds_byte(int r, int c) { const int st = (r >> 4) * 2 + (c >> 5), rr = r & 15, cc = c & 31, ob = rr * 64 + cc * 2; return st * 1024 + (ob ^ (((ob >> 9) & 1) << 5)); }
__host__ __device__ __forceinline__ void stage_rc(int b, int& R, int& C) { const int st = b / 1024, sb = b % 1024, swz = sb ^ (((sb >> 9) & 1) << 5); R = (st >> 1) * 16 + swz / 64; C = (st & 1) * 32 + (swz % 64) / 2; }
__host__ __device__ __forceinline__ int perm32(int rho) { const int n = rho >> 4, i = rho & 15; return 8 * (i >> 2) + 4 * n + (i & 3); }

struct Unit { int pm, pn; };
struct Gemm { const bf16_t* A; const bf16_t* Bt; int M, N, K; };

struct StaticOrder {
    int nM, nN, nwg, G, c;
    __host__ __device__ void init(int M, int N, int G_, int c_) { nM = M / BM; nN = N / BM; nwg = nM * nN; G = G_; c = c_; }
    __host__ __device__ bool next(int i, Unit& u) const {
        const long L = (long)i * G + c; if (L >= nwg) return false;
        int wgid = (int)L; { const int q = nwg / NXCD, r = nwg % NXCD, xcd = wgid % NXCD, off = wgid / NXCD; wgid = (xcd < r ? xcd * (q + 1) : r * (q + 1) + (xcd - r) * q) + off; }
        const int nig = WGM * nN, gid = wgid / nig, fm = gid * WGM, gsz = (nM - fm) < WGM ? (nM - fm) : WGM;
        u.pm = fm + ((wgid % nig) % gsz); u.pn = (wgid % nig) / gsz; return true;
    }
    __device__ __forceinline__ void a_ready(const Unit&) const {}
    __device__ __forceinline__ void done(const Unit&) const {}
};
struct CountedOrder : StaticOrder {
    const unsigned* ready; unsigned need; unsigned* tmo;
    __device__ __forceinline__ void a_ready(const Unit& u) const {
        if (threadIdx.x < 64) {
            const unsigned long long t0 = __builtin_amdgcn_s_memrealtime(); unsigned polls = 0;
            while ((unsigned)__builtin_amdgcn_readfirstlane(__hip_atomic_load(ready + 64 * u.pm, __ATOMIC_RELAXED, __HIP_MEMORY_SCOPE_AGENT)) < need) {
                if ((++polls & 255u) == 0u && __builtin_amdgcn_readfirstlane(__hip_atomic_load(tmo, __ATOMIC_RELAXED, __HIP_MEMORY_SCOPE_AGENT)) != 0u) break;
                if (__builtin_amdgcn_s_memrealtime() - t0 > 2000000ull) {
                    if (threadIdx.x == 0) { unsigned expect = 0u; __hip_atomic_compare_exchange_strong(tmo + 1, &expect, 0x600u | (unsigned)(u.pm & 0xff), __ATOMIC_RELAXED, __ATOMIC_RELAXED, __HIP_MEMORY_SCOPE_AGENT); __hip_atomic_store(tmo, 1u, __ATOMIC_RELAXED, __HIP_MEMORY_SCOPE_AGENT); }
                    break; }
                __builtin_amdgcn_s_sleep(2); }
            __builtin_amdgcn_fence(__ATOMIC_ACQUIRE, "agent");
            asm volatile("s_waitcnt vmcnt(0)" ::: "memory");
        }
#if !defined(BROKEN_HOOK_NO_BARRIER)
        asm volatile("" ::: "memory"); __builtin_amdgcn_s_barrier(); asm volatile("" ::: "memory");
#endif
    }
};

__device__ __forceinline__ unsigned cvt_pk_bf16(float lo, float hi) { unsigned r; asm volatile("v_cvt_pk_bf16_f32 %0, %1, %2" : "=v"(r) : "v"(lo), "v"(hi)); return r; }
typedef float f32x2 __attribute__((ext_vector_type(2)));
__device__ __forceinline__ f32x2 gelu_pk(f32x2 v) {
    const f32x2 av = __builtin_elementwise_abs(v), d = av * 0.2316418882f + 1.0f;
    f32x2 t; t.x = __builtin_amdgcn_rcpf(d.x); t.y = __builtin_amdgcn_rcpf(d.y);
    f32x2 q = t * 0.5307027145f + (-0.7265760135f); q = q * t + 0.7107068705f; q = q * t + (-0.142248368f); q = q * t + 0.127414796f; q = q * t;
    const f32x2 s = (v * v) * (-0.72134752044f);
    f32x2 e; e.x = __builtin_amdgcn_exp2f(s.x); e.y = __builtin_amdgcn_exp2f(s.y);
    const f32x2 m = v * (q * e), r = v - m;
    f32x2 o; o.x = v.x < 0.f ? m.x : r.x; o.y = v.y < 0.f ? m.y : r.y; return o;
}

struct EpiF32 {
    static constexpr bool PERM = false, AFTER_DRAIN = false;
    float* C; int ldc; const float* bias;
    __device__ __forceinline__ void operator()(const f32x4 (&acc)[2][2][4][2], const Unit& u, int wr, int wc, int fr, int fq) const {
        const int row0 = u.pm * BM + wr * 64 + fr, col0 = u.pn * BM + wc * 32 + 4 * fq;
        f32x4 bv[2][2];
#pragma unroll
        for (int bj = 0; bj < 2; ++bj)
#pragma unroll
            for (int n = 0; n < 2; ++n) bv[bj][n] = bias ? *(const f32x4*)(bias + col0 + bj * HALF + n * 16) : (f32x4){0.f, 0.f, 0.f, 0.f};
#pragma unroll
        for (int ai = 0; ai < 2; ++ai)
#pragma unroll
            for (int m = 0; m < 4; ++m) { float* rowp = C + (size_t)(row0 + ai * HALF + m * 16) * ldc + col0;
#pragma unroll
                for (int bj = 0; bj < 2; ++bj)
#pragma unroll
                    for (int n = 0; n < 2; ++n) *(f32x4*)(rowp + bj * HALF + n * 16) = acc[ai][bj][m][n] + bv[bj][n]; }
    }
};
template <int ACT  > struct EpiBf16 {
    static constexpr bool PERM = true, AFTER_DRAIN = false;
    bf16_t* O; int ldc; const float* bias; int split_cols; size_t split_stride;
    __device__ __forceinline__ void operator()(const f32x4 (&acc)[2][2][4][2], const Unit& u, int wr, int wc, int fr, int fq) const {
        const int row0 = u.pm * BM + wr * 64 + fr; int colt = u.pn * BM; bf16_t* base = O;
        if (split_cols) { const int t = colt / split_cols; base += (size_t)t * split_stride; colt -= t * split_cols; }
        const int col0 = colt + wc * 32 + 8 * fq, bcol0 = u.pn * BM + wc * 32 + 8 * fq;
        f32x4 bv[2][2];
#pragma unroll
        for (int bj = 0; bj < 2; ++bj)
#pragma unroll
            for (int n = 0; n < 2; ++n) bv[bj][n] = bias ? *(const f32x4*)(bias + bcol0 + bj * HALF + 4 * n) : (f32x4){0.f, 0.f, 0.f, 0.f};
#pragma unroll
        for (int ai = 0; ai < 2; ++ai)
#pragma unroll
            for (int m = 0; m < 4; ++m) { bf16_t* rowp = base + (size_t)(row0 + ai * HALF + m * 16) * ldc + col0;
#pragma unroll
                for (int bj = 0; bj < 2; ++bj) { f32x4 v0 = acc[ai][bj][m][0] + bv[bj][0], v1 = acc[ai][bj][m][1] + bv[bj][1];
                    if (ACT == 1) { f32x2 a = gelu_pk((f32x2){v0[0], v0[1]}), b = gelu_pk((f32x2){v0[2], v0[3]}), c = gelu_pk((f32x2){v1[0], v1[1]}), d = gelu_pk((f32x2){v1[2], v1[3]});
                        v0 = (f32x4){a.x, a.y, b.x, b.y}; v1 = (f32x4){c.x, c.y, d.x, d.y}; }
                    if (ACT == 2) {
#pragma unroll
                        for (int j = 0; j < 4; ++j) { v0[j] = 0.5f * v0[j] * (1.0f + erff(v0[j] * 0.70710678f)); v1[j] = 0.5f * v1[j] * (1.0f + erff(v1[j] * 0.70710678f)); } }
                    u32x4 w; w.x = cvt_pk_bf16(v0[0], v0[1]); w.y = cvt_pk_bf16(v0[2], v0[3]); w.z = cvt_pk_bf16(v1[0], v1[1]); w.w = cvt_pk_bf16(v1[2], v1[3]);
                    *(u32x4*)(rowp + bj * HALF) = w; } }
    }
};

template <bool I8> __device__ __forceinline__ f32x4 pg8_mma(bf16x8 a, bf16x8 b, f32x4 c) {
    if constexpr (I8) { typedef int i32x4_ __attribute__((ext_vector_type(4))); return __builtin_bit_cast(f32x4, __builtin_amdgcn_mfma_i32_16x16x64_i8(__builtin_bit_cast(i32x4_, a), __builtin_bit_cast(i32x4_, b), __builtin_bit_cast(i32x4_, c), 0, 0, 0)); }
    else return __builtin_amdgcn_mfma_f32_16x16x32_bf16(a, b, c, 0, 0, 0); }
template <class Epi, class Sched, bool STAMP = false, bool I8 = false>
__device__ __forceinline__ void gemm_phase(PG8_LAS unsigned char* lds, const Gemm g, const Sched& S, const Epi& E, unsigned long long* stamps) {
    const int tid = threadIdx.x, wid = __builtin_amdgcn_readfirstlane(tid >> 6), lane = tid & 63, wr = wid >> 2, wc = wid & 3, fr = lane & 15, fq = lane >> 4;
    const int K = g.K, nt = K / BK;
    int ts_lo = 0, ts_hi = 0, nts = 0; const unsigned long long rt_entry = STAMP ? (unsigned long long)wall_clock64() : 0ull;
#define PG8_STAMP() do { if (STAMP && wid == 0 && nts < 64) { const unsigned long long _c = (unsigned long long)clock64(); \
        ts_lo = (lane == nts) ? (int)(unsigned)_c : ts_lo; ts_hi = (lane == nts) ? (int)(unsigned)(_c >> 32) : ts_hi; ++nts; } } while (0)
    PG8_STAMP();
    unsigned voffA[2], voffB[2];
#pragma unroll
    for (int i = 0; i < 2; ++i) { int R, C; stage_rc(tid * 16 + i * 8192, R, C); const int Rb = Epi::PERM ? ((R & ~31) + perm32(R & 31)) : R;
        voffA[i] = (unsigned)(R * K + C) * 2u; voffB[i] = (unsigned)(Rb * K + C) * 2u; }
    const size_t kstep = (size_t)(BK * 2);
    const size_t hstep = (size_t)HALF * K * 2;
    const size_t tstep = 2 * hstep;
    const unsigned ldsw = (unsigned)wid * 1024u;
    const int aoff = lds_byte(wr * 64 + fr, fq * 8), boff = lds_byte(wc * 32 + fr, fq * 8);
#define PG8_SA(b, h) (((b) * 2 + (h)) * HTB)
#define PG8_SB(b, h) ((4 + (b) * 2 + (h)) * HTB)
#define PG8_STAGE(bufoff, gbase, voff) do { _Pragma("unroll") for (int _i = 0; _i < 2; ++_i) \
        __builtin_amdgcn_global_load_lds((const unsigned*)((const char*)(gbase) + (voff)[_i]), (PG8_LAS unsigned*)(lds + (bufoff) + ldsw + _i * 8192), 16, 0, 0); } while (0)
#define PG8_LDA(dst, b, h) do { _Pragma("unroll") for (int m = 0; m < 4; ++m) _Pragma("unroll") for (int k = 0; k < 2; ++k) dst[m][k] = *(const PG8_LAS bf16x8*)(lds + PG8_SA(b, h) + aoff + m * 2048 + k * 1024); } while (0)
#define PG8_LDB(dst, b, h) do { _Pragma("unroll") for (int n = 0; n < 2; ++n) _Pragma("unroll") for (int k = 0; k < 2; ++k) dst[n][k] = *(const PG8_LAS bf16x8*)(lds + PG8_SB(b, h) + boff + n * 2048 + k * 1024); } while (0)
#define PG8_MMA(ai, bj, At, Bt) do { __builtin_amdgcn_s_setprio(1); _Pragma("unroll") for (int m = 0; m < 4; ++m) _Pragma("unroll") for (int n = 0; n < 2; ++n) _Pragma("unroll") for (int k = 0; k < 2; ++k) \
        acc[ai][bj][m][n] = pg8_mma<I8>(Bt[n][k], At[m][k], acc[ai][bj][m][n]); __builtin_amdgcn_s_setprio(0); } while (0)
#define PG8_WAIT_V(n) asm volatile("s_waitcnt vmcnt(" #n ")" ::: "memory")
#define PG8_WAIT_L(n) asm volatile("s_waitcnt lgkmcnt(" #n ")" ::: "memory")
#define PG8_BAR __builtin_amdgcn_s_barrier()
#define PG8_SCHED __builtin_amdgcn_sched_barrier(0)
    Unit cur, nxt; int ui = 0;
    if (!S.next(0, cur)) return;
    f32x4 acc[2][2][4][2];
#pragma unroll
    for (int a = 0; a < 2; ++a)
#pragma unroll
        for (int b = 0; b < 2; ++b)
#pragma unroll
            for (int m = 0; m < 4; ++m)
#pragma unroll
                for (int n = 0; n < 2; ++n) acc[a][b][m][n] = (f32x4){0.f, 0.f, 0.f, 0.f};
    bf16x8 At[4][2], B0[2][2], B1[2][2];
    const char* cA = (const char*)g.A + (size_t)cur.pm * tstep; const char* cB = (const char*)g.Bt + (size_t)cur.pn * tstep;
    S.a_ready(cur);
    PG8_STAGE(PG8_SB(0, 0), cB, voffB); PG8_STAGE(PG8_SA(0, 0), cA, voffA); PG8_STAGE(PG8_SB(0, 1), cB + hstep, voffB); PG8_STAGE(PG8_SA(0, 1), cA + hstep, voffA);
    if (wr == 1) PG8_BAR;
    PG8_WAIT_V(4); PG8_BAR;
    PG8_STAGE(PG8_SB(1, 0), cB + kstep, voffB); PG8_STAGE(PG8_SA(1, 0), cA + kstep, voffA); PG8_STAGE(PG8_SB(1, 1), cB + hstep + kstep, voffB);
    PG8_WAIT_V(6); PG8_BAR;
    PG8_STAMP();
    for (;;) {
        const bool has_next = S.next(ui + 1, nxt);
        const char* nA = has_next ? (const char*)g.A + (size_t)nxt.pm * tstep : cA; const char* nB = has_next ? (const char*)g.Bt + (size_t)nxt.pn * tstep : cB;
        for (int t = 0; t < nt; t += 2) {
            const bool last = (t == nt - 2);
            const char* a1 = cA + (size_t)(t + 1) * kstep;
            const char* a2 = last ? nA : cA + (size_t)(t + 2) * kstep; const char* b2 = last ? nB : cB + (size_t)(t + 2) * kstep;
            const char* a3 = a2 + kstep; const char* b3 = b2 + kstep;
            if (last && has_next) S.a_ready(nxt);
            PG8_LDB(B0, 0, 0); PG8_SCHED; PG8_LDA(At, 0, 0); PG8_STAGE(PG8_SA(1, 1), a1 + hstep, voffA);
            PG8_WAIT_L(8); PG8_BAR; PG8_WAIT_L(0); PG8_MMA(0, 0, At, B0); PG8_BAR; PG8_SCHED;
            PG8_LDB(B1, 0, 1); PG8_STAGE(PG8_SB(0, 0), b2, voffB);
            PG8_BAR; PG8_WAIT_L(0); PG8_MMA(0, 1, At, B1); PG8_BAR;
            PG8_LDA(At, 0, 1); PG8_STAGE(PG8_SA(0, 0), a2, voffA);
            PG8_BAR; PG8_WAIT_L(0); PG8_MMA(1, 0, At, B0); PG8_BAR; PG8_SCHED;
            PG8_STAGE(PG8_SB(0, 1), b2 + hstep, voffB);
            PG8_WAIT_V(6); PG8_BAR; PG8_MMA(1, 1, At, B1); PG8_BAR;
            PG8_LDB(B0, 1, 0); PG8_SCHED; PG8_LDA(At, 1, 0); PG8_STAGE(PG8_SA(0, 1), a2 + hstep, voffA);
            PG8_WAIT_L(8); PG8_BAR; PG8_WAIT_L(0); PG8_MMA(0, 0, At, B0); PG8_BAR; PG8_SCHED;
            PG8_LDB(B1, 1, 1); PG8_STAGE(PG8_SB(1, 0), b3, voffB);
            PG8_BAR; PG8_WAIT_L(0); PG8_MMA(0, 1, At, B1); PG8_BAR;
            PG8_LDA(At, 1, 1); PG8_STAGE(PG8_SA(1, 0), a3, voffA);
            PG8_BAR; PG8_WAIT_L(0); PG8_MMA(1, 0, At, B0); PG8_BAR; PG8_SCHED;
            PG8_STAGE(PG8_SB(1, 1), b3 + hstep, voffB);
            PG8_WAIT_V(6); PG8_BAR; PG8_MMA(1, 1, At, B1); PG8_BAR;
        }
        PG8_STAMP();
        if constexpr (!Epi::AFTER_DRAIN) { E(acc, cur, wr, wc, fr, fq); S.done(cur); }
        PG8_STAMP();
        if (!has_next) break;
#pragma unroll
        for (int a = 0; a < 2; ++a)
#pragma unroll
            for (int b = 0; b < 2; ++b)
#pragma unroll
                for (int m = 0; m < 4; ++m)
#pragma unroll
                    for (int n = 0; n < 2; ++n) acc[a][b][m][n] = (f32x4){0.f, 0.f, 0.f, 0.f};
        cur = nxt; cA = nA; cB = nB; ++ui;
    }
    PG8_WAIT_V(0);
    if (wr == 0) PG8_BAR;
    PG8_BAR;
    if constexpr (Epi::AFTER_DRAIN) { E.fused(acc, cur, wr, wc, fr, fq, lds, wid, lane); S.done(cur); }
    PG8_STAMP();
    if (STAMP && wid == 0) { stamps[lane] = lane < nts ? (((unsigned long long)(unsigned)ts_hi << 32) | (unsigned)ts_lo) : 0ull;
        if (lane == 62) stamps[62] = rt_entry; if (lane == 63) stamps[63] = (unsigned long long)wall_clock64(); }
#undef PG8_STAMP
#undef PG8_SA
#undef PG8_SB
#undef PG8_STAGE
#undef PG8_LDA
#undef PG8_LDB
#undef PG8_MMA
#undef PG8_WAIT_V
#undef PG8_WAIT_L
#undef PG8_BAR
#undef PG8_SCHED
}
}
#define XB_TMO      128
#define XB_XCNT(j)  (256  + 64 * (j))
#define XB_XSUB(j)  (1280 + 64 * (j))
#define XB_XGEN(j)  (2304 + 64 * (j))
#define XB_TOP      3328
#define XB_TOPGEN   3392
#define XCD_BAR_WORDS 3456
#define XB_SPIN_CAP (1u << 18)
#define LAS __attribute__((address_space(3)))

__device__ __forceinline__ unsigned xb_ld(unsigned* p)              { return __hip_atomic_load(p, __ATOMIC_RELAXED, __HIP_MEMORY_SCOPE_AGENT); }
__device__ __forceinline__ unsigned xb_add(unsigned* p, unsigned v) { return __hip_atomic_fetch_add(p, v, __ATOMIC_RELAXED, __HIP_MEMORY_SCOPE_AGENT); }
__device__ __forceinline__ unsigned xb_xcc_id() { return (unsigned)__builtin_amdgcn_s_getreg((3 << 11) | 20) & 0xFu; }
#define XB_SPIN(cond, bar) do { unsigned _sp = 0; while (cond) { __builtin_amdgcn_s_sleep(1); \
    if ((++_sp & 255u) == 0u) { if (xb_ld(&(bar)[XB_TMO])) break; if (_sp > XB_SPIN_CAP) { atomicAdd(&(bar)[XB_TMO], 1u); break; } } } } while (0)

struct XcdBarrier {
    unsigned* bar; unsigned x;
    volatile LAS unsigned* st;
};

__device__ __forceinline__ XcdBarrier xcd_barrier_post(unsigned* bar, volatile LAS unsigned* st) {
    XcdBarrier b; b.bar = bar; b.x = xb_xcc_id(); b.st = st;
    if (threadIdx.x == 0) (void)xb_add(&bar[XB_XCNT(b.x)], 1u);
    return b;
}
__device__ __forceinline__ void xcd_barrier_complete(unsigned* bar, unsigned x, unsigned& nloc, unsigned& nx) {
    const unsigned G = gridDim.x * gridDim.y * gridDim.z;
    unsigned sum, cnt, mine, sp = 0u;
    for (;;) {
        sum = 0u; cnt = 0u; mine = 0u;
#pragma unroll
        for (unsigned j = 0; j < 16; ++j) { const unsigned c = xb_ld(&bar[XB_XCNT(j)]); sum += c; cnt += (c > 0u) ? 1u : 0u; mine = (j == x) ? c : mine; }
        if (sum == G) break;
        __builtin_amdgcn_s_sleep(1);
        if ((++sp & 255u) == 0u) { if (xb_ld(&bar[XB_TMO])) break; if (sp > XB_SPIN_CAP) { atomicAdd(&bar[XB_TMO], 1u); break; } }
    }
    nloc = mine > 0u ? mine : 1u; nx = cnt > 0u ? cnt : 1u;
}

__device__ __forceinline__ void xcd_barrier(const XcdBarrier& b) {
    asm volatile("s_waitcnt vmcnt(0)" ::: "memory");
    __syncthreads();
    if (threadIdx.x == 0) {
        unsigned* bar = b.bar;
        __builtin_amdgcn_s_waitcnt(0);
        unsigned nloc = b.st[0], nx = b.st[1];
        if (nloc == 0u) { xcd_barrier_complete(bar, b.x, nloc, nx); b.st[0] = nloc; b.st[1] = nx; }
        const unsigned old = xb_add(&bar[XB_XSUB(b.x)], 1u);
        const unsigned gen = old / nloc;
        if (old + 1u == (gen + 1u) * nloc) {
            __builtin_amdgcn_fence(__ATOMIC_RELEASE, "agent");
            asm volatile("s_waitcnt vmcnt(0)" ::: "memory");
            const unsigned og = xb_add(&bar[XB_TOP], 1u);
            const unsigned tg = og / nx;
            if (og + 1u == (tg + 1u) * nx) xb_add(&bar[XB_TOPGEN], 1u);
            else XB_SPIN(xb_ld(&bar[XB_TOPGEN]) == tg, bar);
            __builtin_amdgcn_fence(__ATOMIC_ACQUIRE, "agent");
            xb_add(&bar[XB_XGEN(b.x)], 1u);
            asm volatile("s_waitcnt vmcnt(0)" ::: "memory");
        } else {
            XB_SPIN(xb_ld(&bar[XB_XGEN(b.x)]) == gen, bar);
            __builtin_amdgcn_fence(__ATOMIC_ACQUIRE, "agent");
            asm volatile("s_waitcnt vmcnt(0)" ::: "memory");
        }
    }
    __syncthreads();
}

namespace mk {
using pg8::bf16_t; using pg8::bf16x8; using pg8::f32x4; using pg8::u32x4;
typedef unsigned u32x2 __attribute__((ext_vector_type(2)));
typedef short bf16x4 __attribute__((ext_vector_type(4)));
typedef float lf2 __attribute__((ext_vector_type(2)));
typedef float lf4 __attribute__((ext_vector_type(4)));
typedef unsigned lu4 __attribute__((ext_vector_type(4)));

constexpr int D = 1024, NBATCH = 16, SEQ = 2048, CTXL = 256;
constexpr int NLAT = NBATCH * SEQ, NCTX = NBATCH * CTXL, NROW = NLAT + NCTX;
constexpr int NINP = 3072, NIN = 2944;
constexpr int C_Q = 256, C_K = 640, C_V = 1024, C_Z = 1408;
constexpr int DE = 2816;
constexpr int XROWS = 4608;
constexpr int NTHR = 512;
constexpr int LDS_MISC = 131072, LDS_BYTES = 131072 + 256;

constexpr size_t al256(size_t x) { return (x + 255) & ~(size_t)255; }
constexpr size_t WS_CTL = 0;
constexpr size_t WS_MOD = 65536;
constexpr size_t WS_SW = al256(WS_MOD + (size_t)2 * 17 * 6144 * 4);
constexpr size_t SW_W2T = 0, SW_A2T = 98304, SW_G2T = 196608, SW_GLUT = 294912, SW_S5E = 425984, SW_S5W2 = 2523136, SW_STRIDE = 6717440;
constexpr size_t WS_WIN = al256(WS_SW + 2 * SW_STRIDE);
constexpr size_t WS_WOUT = WS_WIN + (size_t)3072 * 1024 * 2;
constexpr size_t WS_WGU = WS_WOUT + (size_t)1024 * 1024 * 2;
constexpr size_t WS_WD = WS_WGU + (size_t)16 * 5632 * 1024 * 2;
constexpr size_t WS_XB = WS_WD + (size_t)16 * 1024 * 2816 * 2;
constexpr size_t WS_CTXA = WS_XB + (size_t)NLAT * D * 4;
constexpr size_t WS_CTXB = WS_CTXA + (size_t)NCTX * D * 4;
constexpr size_t WS_ABUF = WS_CTXB + (size_t)NCTX * D * 4;
constexpr size_t WS_AFF = WS_ABUF + (size_t)NROW * D * 2;
constexpr size_t WS_SLOT = WS_AFF + (size_t)NROW * 16 * 4;
constexpr size_t WS_SELG = WS_SLOT + (size_t)NROW * 16 * 4;
constexpr size_t WS_SW8 = al256(WS_SELG + (size_t)16 * XROWS * 4);
constexpr size_t WS_SX = WS_SW8 + (size_t)16 * 5632 * 4;
constexpr size_t WS_SXS = WS_SX + (size_t)NROW * 4;
constexpr size_t WS_SWIN = WS_SXS + (size_t)16 * XROWS * 4;
constexpr size_t WS_SH = WS_SWIN + (size_t)3072 * 4;
constexpr size_t WS_U = al256(WS_SH + (size_t)NROW * 4);
constexpr size_t SZ384 = (size_t)NROW * 384 * 2;
constexpr size_t U_P = WS_U;
constexpr size_t U_QR = U_P + (size_t)NROW * NINP * 2;
constexpr size_t U_KR = U_QR + SZ384;
constexpr size_t U_VT = U_KR + SZ384;
constexpr size_t U_VTC = U_VT + (size_t)16 * 384 * 2048 * 2;
constexpr size_t U_RS = U_VT + SZ384;
constexpr size_t U_KS = U_RS + SZ384;
constexpr size_t U_VS = U_KS + SZ384;
constexpr size_t U_KK = U_VS + SZ384;
constexpr size_t U_ALR = U_KK + SZ384;
constexpr size_t U_LD = U_ALR + SZ384;
constexpr size_t U_AG = U_LD + 2 * SZ384;
constexpr size_t U_G = U_AG + 2 * SZ384;
constexpr size_t U_YRK = U_G + SZ384;
constexpr size_t U_SLOC = U_YRK + 2 * (size_t)NROW * 384 * 4;
constexpr size_t U_SPREV = U_SLOC + (size_t)2304 * 16 * 256 * 4;
constexpr size_t U_YG = U_SPREV + (size_t)2304 * 16 * 256 * 2;
constexpr size_t U_U16 = U_YG + (size_t)NROW * 256 * 2;
constexpr size_t U_MIX_END = U_U16 + (size_t)NROW * 256 * 2;
constexpr int NCHUNK = 192 * 144;
constexpr size_t CH_XP = U_P;
constexpr size_t CH_BK = CH_XP + (size_t)NCHUNK * 4096;
constexpr size_t CH_UL = CH_BK + (size_t)NCHUNK * 4096;
constexpr size_t CH_MM = U_SLOC;
constexpr size_t CH_GT = CH_MM + (size_t)NCHUNK * 1024;
static_assert(CH_UL + (size_t)NCHUNK * 2048 <= U_RS, "chunk buffers overlap live RWKV operands");
static_assert(CH_GT + (size_t)NCHUNK * 256 <= U_SPREV, "chunk buffers overlap S5 states");
constexpr size_t U_Y = WS_U;
constexpr size_t U_XSEL = U_Y + (size_t)NROW * D * 4;
constexpr size_t U_HID = U_XSEL + (size_t)16 * XROWS * 1024 * 2;
constexpr size_t U_YEXP = U_HID + (size_t)16 * XROWS * DE * 2;
constexpr size_t U_FFN_END = U_YEXP + (size_t)16 * XROWS * 1024 * 2;
constexpr size_t WS_END = U_MIX_END > U_FFN_END ? U_MIX_END : U_FFN_END;

struct Params { const float* in[35]; float* out; unsigned char* ws; int ph_lo, ph_hi, use_bar, pad; };

typedef __bf16 hwbf2 __attribute__((ext_vector_type(2)));
__device__ __forceinline__ unsigned pack2(float lo, float hi) { const lf2 v = {lo, hi}; return __builtin_bit_cast(unsigned, __builtin_convertvector(v, hwbf2)); }
__device__ __forceinline__ bf16_t f2bf(float f) { return (bf16_t)(pack2(f, 0.f) & 0xffffu); }
__device__ __forceinline__ float bflo(unsigned w) { return __uint_as_float(w << 16); }
__device__ __forceinline__ float bfhi(unsigned w) { return __uint_as_float(w & 0xffff0000u); }
__device__ __forceinline__ float bf2f(bf16_t b) { return __uint_as_float(((unsigned)b) << 16); }
__device__ __forceinline__ float sigm(float x) { return 1.0f / (1.0f + __expf(-x)); }
__device__ __forceinline__ float wave_sum(float v) {
#pragma unroll
    for (int o = 32; o >= 1; o >>= 1) v += __shfl_xor(v, o);
    return v; }
__device__ __forceinline__ void unpack8(const uint4 w, float (&f)[8]) { f[0] = bflo(w.x); f[1] = bfhi(w.x); f[2] = bflo(w.y); f[3] = bfhi(w.y); f[4] = bflo(w.z); f[5] = bfhi(w.z); f[6] = bflo(w.w); f[7] = bfhi(w.w); }
__device__ __forceinline__ uint4 pack8(const float (&f)[8]) { uint4 w; w.x = pack2(f[0], f[1]); w.y = pack2(f[2], f[3]); w.z = pack2(f[4], f[5]); w.w = pack2(f[6], f[7]); return w; }
__device__ __forceinline__ const float* xrow(const float* lat, const float* ctx, int r) { return r < NLAT ? lat + (size_t)r * D : ctx + (size_t)(r - NLAT) * D; }
__device__ __forceinline__ float* xrow_w(float* lat, float* ctx, int r) { return r < NLAT ? lat + (size_t)r * D : ctx + (size_t)(r - NLAT) * D; }
__device__ __forceinline__ f32x4 mfma16(bf16x8 a, bf16x8 b, f32x4 c) { return __builtin_amdgcn_mfma_f32_16x16x32_bf16(a, b, c, 0, 0, 0); }

__device__ __forceinline__ void tr_tile(const float* __restrict__ src, int ldsrc, int k0, int n0, bf16_t* __restrict__ dst, int lddst, int drow0, LAS unsigned* T) {
    const int tid = threadIdx.x, n4 = tid & 15, kq = tid >> 4;
    const float4 a = *(const float4*)(src + (size_t)(k0 + 2 * kq) * ldsrc + n0 + 4 * n4);
    const float4 b = *(const float4*)(src + (size_t)(k0 + 2 * kq + 1) * ldsrc + n0 + 4 * n4);
    T[(4 * n4 + 0) * 33 + kq] = pack2(a.x, b.x); T[(4 * n4 + 1) * 33 + kq] = pack2(a.y, b.y);
    T[(4 * n4 + 2) * 33 + kq] = pack2(a.z, b.z); T[(4 * n4 + 3) * 33 + kq] = pack2(a.w, b.w);
    __syncthreads();
    const int n = tid >> 3, pc = tid & 7;
    uint4 v; v.x = T[n * 33 + 4 * pc]; v.y = T[n * 33 + 4 * pc + 1]; v.z = T[n * 33 + 4 * pc + 2]; v.w = T[n * 33 + 4 * pc + 3];
    *(uint4*)(dst + (size_t)(drow0 + n) * lddst + k0 + 8 * pc) = v;
    __syncthreads();
}

__device__ __forceinline__ void tr_tile4(const float* __restrict__ src, int ldsrc, int k0, int n0, bf16_t* __restrict__ dst, int lddst, int drow0, LAS unsigned* T) {
    const int tid = threadIdx.x, n4 = tid & 15, kq = tid >> 4;
    float4 a[4], b[4];
#pragma unroll
    for (int t = 0; t < 4; ++t) { a[t] = *(const float4*)(src + (size_t)(k0 + 2 * kq) * ldsrc + n0 + 64 * t + 4 * n4); b[t] = *(const float4*)(src + (size_t)(k0 + 2 * kq + 1) * ldsrc + n0 + 64 * t + 4 * n4); }
#pragma unroll
    for (int t = 0; t < 4; ++t) { LAS unsigned* Tt = T + t * 64 * 33;
        Tt[(4 * n4 + 0) * 33 + kq] = pack2(a[t].x, b[t].x); Tt[(4 * n4 + 1) * 33 + kq] = pack2(a[t].y, b[t].y); Tt[(4 * n4 + 2) * 33 + kq] = pack2(a[t].z, b[t].z); Tt[(4 * n4 + 3) * 33 + kq] = pack2(a[t].w, b[t].w); }
    __syncthreads();
#pragma unroll
    for (int i = 0; i < 4; ++i) { const int idx = tid + NTHR * i, n = idx >> 3, pc = idx & 7;
        uint4 v; v.x = T[n * 33 + 4 * pc]; v.y = T[n * 33 + 4 * pc + 1]; v.z = T[n * 33 + 4 * pc + 2]; v.w = T[n * 33 + 4 * pc + 3];
        *(uint4*)(dst + (size_t)(drow0 + n) * lddst + k0 + 8 * pc) = v; }
    __syncthreads();
}
__device__ __forceinline__ void q8_strip(const float* __restrict__ src, int ldsrc, unsigned char* __restrict__ dst, float* __restrict__ scl, LAS unsigned char* lds) {
    LAS float* cmax = (LAS float*)lds;
    LAS unsigned char* T = lds + 8704;
    const int tid = threadIdx.x, n4 = tid & 15, kq = tid >> 4;
    float mx[4] = {0.f, 0.f, 0.f, 0.f};
#pragma unroll 8
    for (int i = 0; i < 32; ++i) { const float4 v = *(const float4*)(src + (size_t)(kq + 32 * i) * ldsrc + 4 * n4); mx[0] = fmaxf(mx[0], fabsf(v.x)); mx[1] = fmaxf(mx[1], fabsf(v.y)); mx[2] = fmaxf(mx[2], fabsf(v.z)); mx[3] = fmaxf(mx[3], fabsf(v.w)); }
    __syncthreads();
#pragma unroll
    for (int j = 0; j < 4; ++j) cmax[kq * 64 + 4 * n4 + j] = mx[j];
    __syncthreads();
    if (tid < 64) { float m = 0.f; for (int g = 0; g < 32; ++g) m = fmaxf(m, cmax[g * 64 + tid]); m = fmaxf(m, 1e-20f); scl[tid] = m * (1.0f / 127.0f); cmax[32 * 64 + tid] = 127.0f / m; }
    __syncthreads();
    float inv[4];
#pragma unroll
    for (int j = 0; j < 4; ++j) inv[j] = cmax[32 * 64 + 4 * n4 + j];
    for (int kg = 0; kg < 4; ++kg) {
        float4 a[4], b[4];
#pragma unroll
        for (int t = 0; t < 4; ++t) { const int kb = (kg * 4 + t) * 64 + 2 * kq; a[t] = *(const float4*)(src + (size_t)kb * ldsrc + 4 * n4); b[t] = *(const float4*)(src + (size_t)(kb + 1) * ldsrc + 4 * n4); }
#pragma unroll
        for (int t = 0; t < 4; ++t) { const float av[4] = {a[t].x, a[t].y, a[t].z, a[t].w}, bv[4] = {b[t].x, b[t].y, b[t].z, b[t].w};
#pragma unroll
            for (int j = 0; j < 4; ++j) { const int q0 = __float2int_rn(av[j] * inv[j]), q1 = __float2int_rn(bv[j] * inv[j]);
                *(LAS unsigned short*)(T + (4 * n4 + j) * 272 + t * 64 + 2 * kq) = (unsigned short)((q0 & 255) | ((q1 & 255) << 8)); } }
        __syncthreads();
#pragma unroll
        for (int i = 0; i < 2; ++i) { const int idx = tid + NTHR * i, n = idx >> 4, pc = idx & 15; *(lu4*)(dst + (size_t)n * 1024 + kg * 256 + 16 * pc) = *(const LAS lu4*)(T + n * 272 + 16 * pc); }
        __syncthreads();
    }
}
__device__ __forceinline__ void gu_strip(const Params& p, int l, int item, LAS unsigned char* lds) {
    const int e = item / 88, rem = item % 88, up = rem / 44, nt = rem % 44, n0 = nt * 64, drow0 = (n0 >> 7) * 256 + (n0 & 127) + (up ? 128 : 0);
    q8_strip(p.in[up ? 33 : 32] + (size_t)(l * 16 + e) * 1024 * DE + n0, DE, p.ws + WS_WGU + ((size_t)e * 5632 + drow0) * 1024, (float*)(p.ws + WS_SW8) + (size_t)e * 5632 + drow0, lds);
}
constexpr int CV_GU = 16 * 88, CV_D4 = 16 * 44 * 4, CV_WIN = 46, CV_PAD = 16, CV_WOUT4 = 16 * 4, CV_TOTAL = CV_GU + CV_D4 + CV_WIN + CV_PAD + CV_WOUT4;
__device__ __forceinline__ void convert_weights(const Params& p, int l, LAS unsigned char* lds, int vb, int nvb) {
    LAS unsigned* T = (LAS unsigned*)lds; bf16_t* WD = (bf16_t*)(p.ws + WS_WD); bf16_t* WOUT = (bf16_t*)(p.ws + WS_WOUT);
    for (int it = vb; it < CV_TOTAL; it += nvb) {
        int j = it;
        if (j < CV_GU) { gu_strip(p, l, j, lds); continue; }
        j -= CV_GU;
        if (j < CV_D4) { const int e = j / 176, rem = j % 176, kt = rem >> 2, ng = rem & 3;
            tr_tile4(p.in[34] + (size_t)(l * 16 + e) * DE * 1024, 1024, kt * 64, ng * 256, WD + (size_t)e * 1024 * DE, DE, ng * 256, T); continue; }
        j -= CV_D4;
        if (j < CV_WIN) { q8_strip(p.in[7] + (size_t)l * 1024 * NIN + j * 64, NIN, p.ws + WS_WIN + (size_t)j * 64 * 1024, (float*)(p.ws + WS_SWIN) + j * 64, lds); continue; }
        j -= CV_WIN;
        if (j < CV_PAD) { const size_t o = (size_t)NIN * 1024 + ((size_t)j * NTHR + threadIdx.x) * 16; *(uint4*)(p.ws + WS_WIN + o) = make_uint4(0u, 0u, 0u, 0u);
            if (j == 0 && threadIdx.x < 128) ((float*)(p.ws + WS_SWIN))[NIN + threadIdx.x] = 0.f; continue; }
        j -= CV_PAD;
        { const int kt = j >> 2, ng = j & 3; tr_tile4(p.in[8] + (size_t)l * 1024 * 1024, 1024, kt * 64, ng * 256, WOUT, 1024, ng * 256, T); }
    }
}

__device__ __forceinline__ void mod_item(const Params& p, int item, LAS unsigned char* lds) {
    LAS float* sc = (LAS float*)lds;
    LAS float* red = (LAS float*)(lds + 69632);
    const int tid = threadIdx.x, l = item / 96, cg = item % 96;
    for (int i = tid; i < 17 * 1024; i += NTHR) { const int b = i >> 10, k = i & 1023; const float c = b < 16 ? p.in[1][b * 1024 + k] : p.in[3][k]; sc[k * 17 + b] = c * sigm(c); }
    __syncthreads();
    const int col = cg * 64 + (tid & 63), kg = tid >> 6;
    float acc[17];
#pragma unroll
    for (int b = 0; b < 17; ++b) acc[b] = 0.f;
    const float* w = p.in[4] + ((size_t)l * 1024 + kg * 128) * 6144 + col;
#pragma unroll 4
    for (int kk = 0; kk < 128; ++kk) { const float wv = w[(size_t)kk * 6144]; const LAS float* s = sc + (kg * 128 + kk) * 17;
#pragma unroll
        for (int b = 0; b < 17; ++b) acc[b] += s[b] * wv; }
#pragma unroll
    for (int b = 0; b < 17; ++b) red[(kg * 17 + b) * 64 + (tid & 63)] = acc[b];
    __syncthreads();
    for (int i = tid; i < 17 * 64; i += NTHR) { const int b = i >> 6, c = i & 63; float s = 0.f;
#pragma unroll
        for (int g = 0; g < 8; ++g) s += red[(g * 17 + b) * 64 + c];
        ((float*)(p.ws + WS_MOD))[((size_t)l * 17 + b) * 6144 + cg * 64 + c] = s + p.in[5][l * 6144 + cg * 64 + c]; }
    __syncthreads();
}

__device__ __forceinline__ void s5mat_item(const Params& p, int item, LAS unsigned char* lds) {
    LAS lf2* pw = (LAS lf2*)lds;
    LAS lf2* bb = (LAS lf2*)(lds + 17408);
    LAS lf2* cc = (LAS lf2*)(lds + 17408 + 16384);
    LAS float* KT = (LAS float*)(lds + 17408 + 32768);
    const int tid = threadIdx.x, l = item >> 4, g = item & 15;
    for (int i = tid; i < 2 * 17 * 64; i += NTHR) { const int pp = i & 63, n = (i >> 6) % 17, d = i / (17 * 64);
        const int li = ((l * 2 + d) * 16 + g) * 64 + pp; const float lr = p.in[9][li], lim = p.in[10][li], dt = expf(p.in[11][(l * 2 + d) * 16 + g]);
        const float mag = expf((float)n * dt * lr); float s, c; sincosf((float)n * dt * lim, &s, &c); pw[i] = (lf2){mag * c, mag * s}; }
    for (int i = tid; i < 2 * 64 * 16; i += NTHR) { const int h = i & 15, pp = (i >> 4) & 63, d = i >> 10;
        const int li = ((l * 2 + d) * 16 + g) * 64 + pp; const float lr = p.in[9][li], lim = p.in[10][li], dt = expf(p.in[11][(l * 2 + d) * 16 + g]);
        const float mag = expf(dt * lr); float s, c; sincosf(dt * lim, &s, &c); const float x = mag * c - 1.0f, y = mag * s;
        const float den = 1.0f / (lr * lr + lim * lim); const float cr = (x * lr + y * lim) * den, ci = (y * lr - x * lim) * den;
        const int bi = ((l * 16 + g) * 64 + pp) * 16 + h; const float br = p.in[12][bi], bim = p.in[13][bi];
        bb[i] = (lf2){cr * br - ci * bim, cr * bim + ci * br}; }
    for (int i = tid; i < 2 * 16 * 64; i += NTHR) { const int pp = i & 63, h = (i >> 6) & 15, d = i >> 10;
        const int ci = (((l * 2 + d) * 16 + g) * 16 + h) * 64 + pp; cc[i] = (lf2){p.in[14][ci], p.in[15][ci]}; }
    __syncthreads();
    for (int i = tid; i < 2 * 16 * 256; i += NTHR) { const int h2 = i & 15, h = (i >> 4) & 15, tau = (i >> 8) & 15, d = i >> 12; float s = 0.f;
        for (int pp = 0; pp < 64; ++pp) { const lf2 c = cc[(d * 16 + h) * 64 + pp], w = pw[(d * 17 + tau) * 64 + pp], b = bb[(d * 64 + pp) * 16 + h2];
            const float tr = c.x * w.x - c.y * w.y, ti = c.x * w.y + c.y * w.x; s += tr * b.x - ti * b.y; }
        KT[i] = s; }
    __syncthreads();
    bf16_t* E = (bf16_t*)(p.ws + WS_SW + (size_t)l * SW_STRIDE + SW_S5E) + (size_t)g * 256 * 256;
    bf16_t* W2 = (bf16_t*)(p.ws + WS_SW + (size_t)l * SW_STRIDE + SW_S5W2) + (size_t)g * 256 * 512;
    for (int i = tid; i < 256 * 256; i += NTHR) { const int k = i & 255, n = i >> 8; const int s = k >> 4, h = k & 15, d = n >> 7, part = (n >> 6) & 1, pp = n & 63;
        const int e = d == 0 ? 15 - s : s; const lf2 w = pw[(d * 17 + e) * 64 + pp], b = bb[(d * 64 + pp) * 16 + h];
        E[i] = f2bf(part ? (w.x * b.y + w.y * b.x) : (w.x * b.x - w.y * b.y)); }
    for (int i = tid; i < 256 * 512; i += NTHR) { const int k = i & 511, n = i >> 9; const int t = n >> 4, h = n & 15; float v;
        if (k < 256) { const int s = k >> 4, h2 = k & 15; v = 0.f;
            if (t >= s) v += KT[((0 * 16 + (t - s)) * 16 + h) * 16 + h2];
            if (s >= t) v += KT[((1 * 16 + (s - t)) * 16 + h) * 16 + h2];
            if (s == t && h == h2) v += p.in[16][l * 256 + g * 16 + h]; }
        else { const int q = k - 256, d = q >> 7, part = (q >> 6) & 1, pp = q & 63; const int e = d == 0 ? t + 1 : 16 - t;
            const lf2 c = cc[(d * 16 + h) * 64 + pp], w = pw[(d * 17 + e) * 64 + pp];
            v = part ? -(c.x * w.y + c.y * w.x) : (c.x * w.x - c.y * w.y); }
        W2[i] = f2bf(v); }
    __syncthreads();
}

__device__ __forceinline__ void smallw_item(const Params& p, int item) {
    int i = item * NTHR + threadIdx.x; const int l = i / 212992; i %= 212992;
    unsigned char* sw = p.ws + WS_SW + (size_t)l * SW_STRIDE;
    if (i < 49152) { const int k = i & 63, n = (i >> 6) % 384, d = i / 24576; ((bf16_t*)(sw + SW_W2T))[i] = f2bf(p.in[22][((size_t)(l * 2 + d) * 64 + k) * 384 + n]); return; }
    i -= 49152;
    if (i < 49152) { const int k = i & 63, n = (i >> 6) % 384, d = i / 24576; ((bf16_t*)(sw + SW_A2T))[i] = f2bf(p.in[24][((size_t)(l * 2 + d) * 64 + k) * 384 + n]); return; }
    i -= 49152;
    if (i < 49152) { const int k = i & 127, n = i >> 7; ((bf16_t*)(sw + SW_G2T))[i] = f2bf(p.in[25][((size_t)l * 128 + k) * 384 + n]); return; }
    i -= 49152;
    { const int k = i & 255, n = i >> 8; ((bf16_t*)(sw + SW_GLUT))[i] = f2bf(p.in[17][((size_t)l * 256 + k) * 256 + n]); }
}

constexpr int PRO_MOD = 192, PRO_S5 = 32, PRO_SW = 832;
__device__ __forceinline__ void phase_prologue(const Params& p, LAS unsigned char* lds) {
    for (int it = blockIdx.x; it < PRO_MOD + PRO_S5 + PRO_SW; it += gridDim.x) {
        if (it < PRO_MOD) mod_item(p, it, lds);
        else if (it < PRO_MOD + PRO_S5) s5mat_item(p, it - PRO_MOD, lds);
        else smallw_item(p, it - PRO_MOD - PRO_S5);
    }
    convert_weights(p, 0, lds, (int)blockIdx.x, (int)gridDim.x);
}

__device__ __forceinline__ void hnorm_row(const float* g, const float* mb_sh, const float* mb_sc, unsigned char* dst, float* sdst, int lane, const float4 (&v)[4]) {
    float ss = 0.f;
#pragma unroll
    for (int i = 0; i < 4; ++i) ss += v[i].x * v[i].x + v[i].y * v[i].y + v[i].z * v[i].z + v[i].w * v[i].w;
    ss = wave_sum(ss); const float rs = rsqrtf(ss * (1.0f / 1024.0f) + 1e-6f);
    float hv[4][4]; float amax = 0.f;
#pragma unroll
    for (int i = 0; i < 4; ++i) { const int c = i * 256 + lane * 4; const float4 gg = *(const float4*)(g + c), sh = *(const float4*)(mb_sh + c), sc = *(const float4*)(mb_sc + c);
        hv[i][0] = v[i].x * rs * gg.x * (1.f + sc.x) + sh.x; hv[i][1] = v[i].y * rs * gg.y * (1.f + sc.y) + sh.y; hv[i][2] = v[i].z * rs * gg.z * (1.f + sc.z) + sh.z; hv[i][3] = v[i].w * rs * gg.w * (1.f + sc.w) + sh.w;
        amax = fmaxf(amax, fmaxf(fmaxf(fabsf(hv[i][0]), fabsf(hv[i][1])), fmaxf(fabsf(hv[i][2]), fabsf(hv[i][3])))); }
#pragma unroll
    for (int o = 32; o >= 1; o >>= 1) amax = fmaxf(amax, __shfl_xor(amax, o));
    amax = fmaxf(amax, 1e-20f); const float qs = 127.0f / amax;
    if (lane == 0) *sdst = amax * (1.0f / 127.0f);
#pragma unroll
    for (int i = 0; i < 4; ++i) { unsigned w = 0u;
#pragma unroll
        for (int k = 0; k < 4; ++k) w |= ((unsigned)__float2int_rn(hv[i][k] * qs) & 255u) << (8 * k);
        *(unsigned*)(dst + i * 256 + lane * 4) = w; }
}
__device__ __forceinline__ void phase_hnorm(const Params& p, int l, const float* xl, const float* xc) {
    const int lane = threadIdx.x & 63, wv = threadIdx.x >> 6;
    const float* mod = (const float*)(p.ws + WS_MOD) + (size_t)l * 17 * 6144; const float* g = p.in[6] + (l * 4 + 0) * 1024;
    unsigned char* A = p.ws + WS_ABUF; float* SH = (float*)(p.ws + WS_SH);
    for (int r = blockIdx.x * 8 + wv; r < NROW; r += gridDim.x * 8) {
        const float* src = xrow(xl, xc, r); const int b = r < NLAT ? (r >> 11) : 16; const float* mb = mod + (size_t)b * 6144;
        float4 v[4];
#pragma unroll
        for (int i = 0; i < 4; ++i) v[i] = *(const float4*)(src + i * 256 + lane * 4);
        hnorm_row(g, mb, mb + 1024, A + (size_t)r * 1024, SH + r, lane, v);
    }
}

__device__ __forceinline__ void phase_prep(const Params& p, int l, LAS unsigned char* lds) {
    LAS bf16_t* vt = (LAS bf16_t*)lds;
    LAS lf2* cs = (LAS lf2*)(lds + 50176);
    const int tid = threadIdx.x;
    for (int i = tid; i < 1024; i += NTHR) { const int pos = i >> 4, j = i & 15; const float invf = exp2f(-(float)j * (13.287712379549449f / 16.0f)); float s, c; sincosf((float)pos * invf, &s, &c); cs[i] = (lf2){c, s}; }
    __syncthreads();
    const bf16_t* P = (const bf16_t*)(p.ws + U_P);
    bf16_t* QR = (bf16_t*)(p.ws + U_QR); bf16_t* KR = (bf16_t*)(p.ws + U_KR);
    bf16_t* RS = (bf16_t*)(p.ws + U_RS); bf16_t* KS = (bf16_t*)(p.ws + U_KS); bf16_t* VS = (bf16_t*)(p.ws + U_VS); bf16_t* KK = (bf16_t*)(p.ws + U_KK); bf16_t* ALR = (bf16_t*)(p.ws + U_ALR);
    for (int ti = blockIdx.x; ti < NROW / 64; ti += gridDim.x) {
        const int r0 = ti * 64; const bool lat = r0 < NLAT; const int b = lat ? (r0 >> 11) : ((r0 - NLAT) >> 8), t0 = lat ? (r0 & 2047) : ((r0 - NLAT) & 255), slen = lat ? SEQ : CTXL;
#pragma unroll
        for (int i = 0; i < 6; ++i) { const int idx = tid + NTHR * i, tok = idx / 48, pc = idx % 48;
            *(LAS lu4*)(vt + tok * 392 + pc * 8) = *(const lu4*)(P + (size_t)(r0 + tok) * NINP + C_V + pc * 8); }
        __syncthreads();
        { bf16_t* vdst = lat ? (bf16_t*)(p.ws + U_VT) + (size_t)b * 384 * 2048 + t0 : (bf16_t*)(p.ws + U_VTC) + (size_t)b * 384 * 256 + t0;
#pragma unroll
          for (int i = 0; i < 6; ++i) { const int idx = tid + NTHR * i, hd = idx >> 3, pc = idx & 7; unsigned w[4];
#pragma unroll
              for (int j = 0; j < 4; ++j) w[j] = (unsigned)vt[(pc * 8 + 2 * j) * 392 + hd] | ((unsigned)vt[(pc * 8 + 2 * j + 1) * 392 + hd] << 16);
              *(uint4*)(vdst + (size_t)hd * slen + pc * 8) = make_uint4(w[0], w[1], w[2], w[3]); } }
#pragma unroll
        for (int i = 0; i < 4; ++i) { const int idx = tid + NTHR * i, tok = idx >> 5, pc = idx & 31;
            *(lu4*)((bf16_t*)(p.ws + U_U16) + (size_t)(r0 + tok) * 256 + pc * 8) = *(const lu4*)(P + (size_t)(r0 + tok) * NINP + pc * 8); }
#pragma unroll
        for (int i = 0; i < 6; ++i) { const int idx = tid + NTHR * i, tok = idx / 48, rem = idx % 48, qk = rem / 24, rem2 = rem % 24, h = rem2 >> 2, pp = rem2 & 3;
            const int d1 = (pp >> 1) * 32 + (pp & 1) * 8; const size_t so = (size_t)(r0 + tok) * NINP + (qk ? C_K : C_Q) + h * 64 + d1;
            float x1[8], x2[8], o1[8], o2[8]; unpack8(*(const uint4*)(P + so), x1); unpack8(*(const uint4*)(P + so + 16), x2);
            const int t = t0 + tok, pos = (pp < 2) ? (t >> 6) : (t & 63), j0 = (pp & 1) * 8; const float scl = qk ? 1.0f : 0.125f;
#pragma unroll
            for (int j = 0; j < 8; ++j) { lf2 c = cs[pos * 16 + j0 + j]; if (!lat) c = (lf2){1.f, 0.f}; o1[j] = (x1[j] * c.x - x2[j] * c.y) * scl; o2[j] = (x1[j] * c.y + x2[j] * c.x) * scl; }
            bf16_t* dq = (qk ? KR : QR) + (size_t)(r0 + tok) * 384 + h * 64 + d1; *(uint4*)dq = pack8(o1); *(uint4*)(dq + 16) = pack8(o2); }
        for (int i = 0; i < 24; ++i) { const int idx = tid + NTHR * i, tok = idx / 192, pc = idx % 192, c0 = pc * 8, r = r0 + tok, t = t0 + tok;
            const bf16_t* zp = P + (size_t)r * NINP + C_Z + c0; float x[8], pv[8], nx[8], zs[8];
            unpack8(*(const uint4*)zp, x);
            if (t > 0) unpack8(*(const uint4*)(zp - NINP), pv); else {
#pragma unroll
                for (int j = 0; j < 8; ++j) pv[j] = 0.f; }
            if (t < slen - 1) unpack8(*(const uint4*)(zp + NINP), nx); else {
#pragma unroll
                for (int j = 0; j < 8; ++j) nx[j] = 0.f; }
            const float4 mu0 = *(const float4*)(p.in[20] + l * 1536 + c0), mu1 = *(const float4*)(p.in[20] + l * 1536 + c0 + 4); const float mu[8] = {mu0.x, mu0.y, mu0.z, mu0.w, mu1.x, mu1.y, mu1.z, mu1.w};
#pragma unroll
            for (int j = 0; j < 8; ++j) zs[j] = x[j] + (0.5f * (pv[j] + nx[j]) - x[j]) * mu[j];
            const bool isk = c0 >= 384 && c0 < 768; float kv[8]; float ss = 0.f;
            { const int kc = isk ? c0 - 384 : 0; const float4 k0 = *(const float4*)(p.in[26] + l * 384 + kc), k1 = *(const float4*)(p.in[26] + l * 384 + kc + 4); const float kkw[8] = {k0.x, k0.y, k0.z, k0.w, k1.x, k1.y, k1.z, k1.w};
#pragma unroll
              for (int j = 0; j < 8; ++j) { kv[j] = zs[j] * kkw[j]; ss += kv[j] * kv[j]; } }
            ss += __shfl_xor(ss, 1); ss += __shfl_xor(ss, 2); ss += __shfl_xor(ss, 4);
            if (c0 < 384) *(uint4*)(RS + (size_t)r * 384 + c0) = pack8(zs);
            else if (c0 < 768) { *(uint4*)(KS + (size_t)r * 384 + c0 - 384) = pack8(zs); const float inv = 1.0f / fmaxf(sqrtf(ss), 1e-12f);
#pragma unroll
                for (int j = 0; j < 8; ++j) kv[j] *= inv;
                *(uint4*)(KK + (size_t)r * 384 + c0 - 384) = pack8(kv); }
            else if (c0 < 1152) *(uint4*)(VS + (size_t)r * 384 + c0 - 768) = pack8(zs);
            else { const int ac = c0 - 1152; float o[8];
#pragma unroll
                for (int j = 0; j < 8; ++j) o[j] = ac < 128 ? 1.0f - 2.0f / (1.0f + __expf(2.0f * zs[j])) : (ac < 256 ? zs[j] : sigm(zs[j]));
                *(uint4*)(ALR + (size_t)r * 384 + ac) = pack8(o); }
        }
        __syncthreads();
    }
}

template <int KS, int MODE> __device__ __forceinline__ void lr_wave(const Params& p, int l, int row0, int kofs, const bf16_t* Bt, int d) {
    const int lane = threadIdx.x & 63, m = lane & 15, q = lane >> 4;
    const bf16_t* Ap = (const bf16_t*)(p.ws + U_ALR) + (size_t)(row0 + m) * 384 + kofs + q * 8;
    bf16x8 a[KS];
#pragma unroll
    for (int ks = 0; ks < KS; ++ks) a[ks] = *(const bf16x8*)(Ap + ks * 32);
    bf16_t* O = (bf16_t*)(p.ws + (MODE == 0 ? U_LD + (size_t)d * SZ384 : (MODE == 1 ? U_AG + (size_t)d * SZ384 : U_G))) + (size_t)(row0 + m) * 384;
    const float* bias = MODE == 0 ? p.in[21] + (l * 2 + d) * 384 : p.in[23] + (l * 2 + d) * 384;
    for (int nt = 0; nt < 24; ++nt) {
        f32x4 acc = (f32x4){0.f, 0.f, 0.f, 0.f};
#pragma unroll
        for (int ks = 0; ks < KS; ++ks) { const bf16x8 bfr = *(const bf16x8*)(Bt + (size_t)(nt * 16 + m) * (KS * 32) + ks * 32 + q * 8); acc = mfma16(bfr, a[ks], acc); }
        const int n = nt * 16 + q * 4; float o[4];
        if (MODE == 2) {
#pragma unroll
            for (int j = 0; j < 4; ++j) o[j] = acc[j];
        } else { const float4 bv = *(const float4*)(bias + n); const float bb[4] = {bv.x, bv.y, bv.z, bv.w};
#pragma unroll
            for (int j = 0; j < 4; ++j) { const float s = sigm(bb[j] + acc[j]); o[j] = MODE == 0 ? -0.6065306597f * s : s; } }
        u32x2 w; w.x = pack2(o[0], o[1]); w.y = pack2(o[2], o[3]); *(u32x2*)(O + n) = w;
    }
}
__device__ __forceinline__ void lowrank_items(const Params& p, int l, int wid, int nw) {
    const unsigned char* sw = p.ws + WS_SW + (size_t)l * SW_STRIDE;
    for (int it = wid; it < 2304 * 5; it += nw) { const int rt = it / 5, m = it % 5, row0 = rt * 16;
        if (m < 2) lr_wave<2, 0>(p, l, row0, m * 64, (const bf16_t*)(sw + SW_W2T) + (size_t)m * 384 * 64, m);
        else if (m < 4) lr_wave<2, 1>(p, l, row0, m * 64, (const bf16_t*)(sw + SW_A2T) + (size_t)(m - 2) * 384 * 64, m - 2);
        else lr_wave<4, 2>(p, l, row0, 256, (const bf16_t*)(sw + SW_G2T), 0); }
}

__device__ __forceinline__ int s5_rowbase(int cr) { const int b = cr / 144, c = cr % 144; return c < 16 ? NLAT + b * 256 + c * 16 : b * 2048 + (c - 16) * 16; }
__device__ __forceinline__ void s5_pass1_items(const Params& p, int l, int wid, int nw) {
    const int lane = threadIdx.x & 63, m = lane & 15, q = lane >> 4;
    const bf16_t* P = (const bf16_t*)(p.ws + U_U16); float* SLOC = (float*)(p.ws + U_SLOC);
    for (int it = wid; it < 144 * 16; it += nw) { const int ct = it >> 4, g = it & 15, cr = ct * 16 + m, rb = s5_rowbase(cr);
        const bf16_t* E = (const bf16_t*)(p.ws + WS_SW + (size_t)l * SW_STRIDE + SW_S5E) + (size_t)g * 256 * 256;
        bf16x8 a[8];
#pragma unroll
        for (int ks = 0; ks < 8; ++ks) a[ks] = *(const bf16x8*)(P + (size_t)(rb + 2 * ks + (q >> 1)) * 256 + g * 16 + (q & 1) * 8);
        float* o = SLOC + ((size_t)cr * 16 + g) * 256 + q * 4;
#pragma unroll 2
        for (int nt = 0; nt < 16; ++nt) { f32x4 acc = (f32x4){0.f, 0.f, 0.f, 0.f}; const bf16_t* ep = E + (size_t)(nt * 16 + m) * 256 + q * 8;
#pragma unroll
            for (int ks = 0; ks < 8; ++ks) acc = mfma16(*(const bf16x8*)(ep + ks * 32), a[ks], acc);
            *(f32x4*)(o + nt * 16) = acc; }
    }
}
__device__ __forceinline__ void s5_carry(const Params& p, int l) {
    const int gid = blockIdx.x * NTHR + threadIdx.x; if (gid >= 32768) return;
    const int pp = gid & 63, d = (gid >> 6) & 1, g = (gid >> 7) & 15, b = gid >> 11;
    const int li = ((l * 2 + d) * 16 + g) * 64 + pp; const float lr = p.in[9][li], lim = p.in[10][li], dt = expf(p.in[11][(l * 2 + d) * 16 + g]);
    const float mag = expf(16.0f * dt * lr); float sn, cn; sincosf(16.0f * dt * lim, &sn, &cn); const float ar = mag * cn, ai = mag * sn;
    const float* SLOC = (const float*)(p.ws + U_SLOC); bf16_t* SP = (bf16_t*)(p.ws + U_SPREV);
    float sr = 0.f, si = 0.f;
#pragma unroll 8
    for (int n = 0; n < 144; ++n) { const int c = d == 0 ? n : (n < 16 ? 15 - n : 159 - n); const size_t idx = ((size_t)(b * 144 + c) * 16 + g) * 256 + d * 128 + pp;
        SP[idx] = f2bf(sr); SP[idx + 64] = f2bf(si);
        const float xr = SLOC[idx], xi = SLOC[idx + 64]; const float nr = ar * sr - ai * si + xr, ni = ar * si + ai * sr + xi; sr = nr; si = ni; }
}
__device__ __forceinline__ void s5_pass2_items(const Params& p, int l, int wid, int nw) {
    const int lane = threadIdx.x & 63, m = lane & 15, q = lane >> 4;
    const bf16_t* P = (const bf16_t*)(p.ws + U_U16); const bf16_t* SP = (const bf16_t*)(p.ws + U_SPREV); bf16_t* YG = (bf16_t*)(p.ws + U_YG);
    for (int it = wid; it < 144 * 16; it += nw) { const int ct = it >> 4, g = it & 15; if (l == 1 && ct % 9 == 0) continue;
        const int cr = ct * 16 + m, rb = s5_rowbase(cr);
        const bf16_t* W2 = (const bf16_t*)(p.ws + WS_SW + (size_t)l * SW_STRIDE + SW_S5W2) + (size_t)g * 256 * 512;
        bf16x8 a[16];
#pragma unroll
        for (int ks = 0; ks < 8; ++ks) a[ks] = *(const bf16x8*)(P + (size_t)(rb + 2 * ks + (q >> 1)) * 256 + g * 16 + (q & 1) * 8);
#pragma unroll
        for (int ks = 8; ks < 16; ++ks) a[ks] = *(const bf16x8*)(SP + ((size_t)cr * 16 + g) * 256 + (ks - 8) * 32 + q * 8);
#pragma unroll 2
        for (int nt = 0; nt < 16; ++nt) { f32x4 acc = (f32x4){0.f, 0.f, 0.f, 0.f}; const bf16_t* wp = W2 + (size_t)(nt * 16 + m) * 512 + q * 8;
#pragma unroll
            for (int ks = 0; ks < 16; ++ks) acc = mfma16(*(const bf16x8*)(wp + ks * 32), a[ks], acc);
            float o[4];
#pragma unroll
            for (int j = 0; j < 4; ++j) { const float x = acc[j]; const float u = 0.7978845608f * (x + 0.044715f * x * x * x); const float th = 1.0f - 2.0f / (1.0f + __expf(2.0f * u)); o[j] = 0.5f * x * (1.0f + th); }
            u32x2 w; w.x = pack2(o[0], o[1]); w.y = pack2(o[2], o[3]); *(u32x2*)(YG + (size_t)(rb + nt) * 256 + g * 16 + q * 4) = w; }
    }
}
__device__ __forceinline__ void s5_glu_items(const Params& p, int l, int wid, int nw) {
    const int lane = threadIdx.x & 63, m = lane & 15, q = lane >> 4;
    const bf16_t* YG = (const bf16_t*)(p.ws + U_YG); bf16_t* YC = (bf16_t*)(p.ws + WS_ABUF);
    const bf16_t* GT = (const bf16_t*)(p.ws + WS_SW + (size_t)l * SW_STRIDE + SW_GLUT);
    const int nrt = (l == 0 ? NROW : NLAT) / 16;
    for (int rt = wid; rt < nrt; rt += nw) { const int row = rt * 16 + m;
        bf16x8 a[8];
#pragma unroll
        for (int ks = 0; ks < 8; ++ks) a[ks] = *(const bf16x8*)(YG + (size_t)row * 256 + ks * 32 + q * 8);
#pragma unroll 2
        for (int nt = 0; nt < 16; ++nt) { f32x4 acc = (f32x4){0.f, 0.f, 0.f, 0.f}; const bf16_t* gp = GT + (size_t)(nt * 16 + m) * 256 + q * 8;
#pragma unroll
            for (int ks = 0; ks < 8; ++ks) acc = mfma16(*(const bf16x8*)(gp + ks * 32), a[ks], acc);
            const int n = nt * 16 + q * 4; const float4 bv = *(const float4*)(p.in[18] + l * 256 + n); const u32x2 yw = *(const u32x2*)(YG + (size_t)row * 256 + n);
            u32x2 w; w.x = pack2(bflo(yw.x) * sigm(acc[0] + bv.x), bfhi(yw.x) * sigm(acc[1] + bv.y)); w.y = pack2(bflo(yw.y) * sigm(acc[2] + bv.z), bfhi(yw.y) * sigm(acc[3] + bv.w));
            *(u32x2*)(YC + (size_t)row * 1024 + n) = w; }
    }
}

template <bool HASLAT> __device__ __forceinline__ void na_unit(const Params& p, const LAS float* rpb_l, int b, int h, int i, int n) {
    const int lane = threadIdx.x & 63, m = lane & 15, q = lane >> 4, kin = 8 * (m >> 2) + (m & 3);
    const bf16_t* QR = (const bf16_t*)(p.ws + U_QR); const bf16_t* KR = (const bf16_t*)(p.ws + U_KR);
    const bf16_t* VTL = (const bf16_t*)(p.ws + U_VT) + (size_t)(b * 6 + h) * 64 * 2048; const bf16_t* VTC = (const bf16_t*)(p.ws + U_VTC) + (size_t)(b * 6 + h) * 64 * 256;
    const int qrow = HASLAT ? b * 2048 + i * 64 + n * 16 + m : NLAT + b * 256 + n * 16 + m;
    bf16x8 qf[2];
#pragma unroll
    for (int ks = 0; ks < 2; ++ks) qf[ks] = *(const bf16x8*)(QR + (size_t)qrow * 384 + h * 64 + ks * 32 + q * 8);
    const int r0 = HASLAT ? min(max(i - 4, 0), 24) : 0, scol = HASLAT ? min(max(n * 16 - 8, 0), 32) : 0;
    f32x4 sl[HASLAT ? 16 : 1], sc[16];
    float mx = -3.0e38f;
    if (HASLAT) { const int qc = n * 16 + m, c0 = min(max(qc - 8, 0), 48); const LAS float* rpb = rpb_l + h * 15 * 31;
#pragma unroll
        for (int t = 0; t < 16; ++t) { const int kr = t >> 1, ch = t & 1; const bf16_t* kp = KR + (size_t)(b * 2048 + (r0 + kr) * 64 + scol + kin + 4 * ch) * 384 + h * 64 + q * 8;
            f32x4 acc = (f32x4){0.f, 0.f, 0.f, 0.f};
#pragma unroll
            for (int ks = 0; ks < 2; ++ks) acc = mfma16(*(const bf16x8*)(kp + ks * 32), qf[ks], acc);
            const int dr = r0 + kr - i + 7;
#pragma unroll
            for (int j = 0; j < 4; ++j) { const int kc = scol + 8 * q + 4 * ch + j; const bool valid = kc >= c0 && kc < c0 + 16; const int dc = min(max(kc - qc + 15, 0), 30);
                const float s = valid ? acc[j] + rpb[dr * 31 + dc] : -1.0e30f; acc[j] = s; mx = fmaxf(mx, s); }
            sl[t] = acc; if ((t & 3) == 3) __builtin_amdgcn_sched_barrier(0); } }
#pragma unroll
    for (int t = 0; t < 16; ++t) { const bf16_t* kp = KR + (size_t)(NLAT + b * 256 + (t >> 1) * 32 + kin + 4 * (t & 1)) * 384 + h * 64 + q * 8;
        f32x4 acc = (f32x4){0.f, 0.f, 0.f, 0.f};
#pragma unroll
        for (int ks = 0; ks < 2; ++ks) acc = mfma16(*(const bf16x8*)(kp + ks * 32), qf[ks], acc);
#pragma unroll
        for (int j = 0; j < 4; ++j) mx = fmaxf(mx, acc[j]);
        sc[t] = acc; }
    mx = fmaxf(mx, __shfl_xor(mx, 16)); mx = fmaxf(mx, __shfl_xor(mx, 32));
    float sum = 0.f;
    f32x4 o[4];
#pragma unroll
    for (int dt = 0; dt < 4; ++dt) o[dt] = (f32x4){0.f, 0.f, 0.f, 0.f};
    if (HASLAT) {
#pragma unroll
        for (int kr = 0; kr < 8; ++kr) { float e[8];
#pragma unroll
            for (int j = 0; j < 4; ++j) { e[j] = __expf(sl[2 * kr][j] - mx); e[4 + j] = __expf(sl[2 * kr + 1][j] - mx); }
#pragma unroll
            for (int j = 0; j < 8; ++j) sum += e[j];
            const uint4 pw = pack8(e); const bf16x8 pf = __builtin_bit_cast(bf16x8, pw);
            const int tok = (r0 + kr) * 64 + scol + q * 8;
#pragma unroll
            for (int dt = 0; dt < 4; ++dt) o[dt] = mfma16(*(const bf16x8*)(VTL + (size_t)(dt * 16 + m) * 2048 + tok), pf, o[dt]);
            if (kr & 1) __builtin_amdgcn_sched_barrier(0); } }
#pragma unroll
    for (int t2 = 0; t2 < 8; ++t2) { float e[8];
#pragma unroll
        for (int j = 0; j < 4; ++j) { e[j] = __expf(sc[2 * t2][j] - mx); e[4 + j] = __expf(sc[2 * t2 + 1][j] - mx); }
#pragma unroll
        for (int j = 0; j < 8; ++j) sum += e[j];
        const uint4 pw = pack8(e); const bf16x8 pf = __builtin_bit_cast(bf16x8, pw);
        const int tok = t2 * 32 + q * 8;
#pragma unroll
        for (int dt = 0; dt < 4; ++dt) o[dt] = mfma16(*(const bf16x8*)(VTC + (size_t)(dt * 16 + m) * 256 + tok), pf, o[dt]);
        if (t2 & 1) __builtin_amdgcn_sched_barrier(0); }
    sum += __shfl_xor(sum, 16); sum += __shfl_xor(sum, 32);
    const float inv = 1.0f / sum;
    bf16_t* yo = (bf16_t*)(p.ws + WS_ABUF) + (size_t)qrow * 1024 + 256 + h * 64 + q * 4;
#pragma unroll
    for (int dt = 0; dt < 4; ++dt) { u32x2 w; w.x = pack2(o[dt][0] * inv, o[dt][1] * inv); w.y = pack2(o[dt][2] * inv, o[dt][3] * inv); *(u32x2*)(yo + dt * 16) = w; }
}
__device__ __forceinline__ void na_items(const Params& p, int l, int wid, int nw, LAS unsigned char* lds) {
    LAS float* rpb_l = (LAS float*)lds;
    __syncthreads();
    for (int i = threadIdx.x; i < 6 * 465; i += NTHR) rpb_l[i] = p.in[19][(size_t)l * 6 * 465 + i];
    __syncthreads();
    const int nlat = 16 * 6 * 32 * 4, nctx = (l == 0) ? 16 * 6 * 16 : 0, per = (nlat + nw - 1) / nw;
    for (int k = 0; k < per; ++k) { const int it = wid * per + k; if (it < nlat) { const int n = it & 3, i = (it >> 2) & 31, bh = it >> 7; na_unit<true>(p, rpb_l, bh / 6, bh % 6, i, n); } }
    for (int j = wid; j < nctx; j += nw) { const int n = j & 15, bh = j >> 4; na_unit<false>(p, rpb_l, bh / 6, bh % 6, 0, n); }
}

typedef float f32x2 __attribute__((ext_vector_type(2)));
__device__ __forceinline__ int rk_row(int b, int d, int n) { return n < 256 ? NLAT + b * 256 + (d ? 255 - n : n) : b * 2048 + (d ? 2047 - (n - 256) : (n - 256)); }
template <int CTRL> __device__ __forceinline__ float dpp_f(float v) { return __builtin_bit_cast(float, __builtin_amdgcn_update_dpp(0, __builtin_bit_cast(int, v), CTRL, 0xF, 0xF, true)); }
constexpr int RKP_PITCH = 72, RKP_MAT = 16 * RKP_PITCH * 2, RKP_WAVE = 5 * RKP_MAT + 4 * 16 * 17 * 4;
__device__ __forceinline__ bf16x8 pack_frag(const float (&lo)[4], const float (&hi)[4]) { u32x4 w; w.x = pack2(lo[0], lo[1]); w.y = pack2(lo[2], lo[3]); w.z = pack2(hi[0], hi[1]); w.w = pack2(hi[2], hi[3]); return __builtin_bit_cast(bf16x8, w); }
__device__ __forceinline__ void rwkv_pre_items(const Params& p, int l, int wid, int nw, LAS unsigned char* lds) {
    const int lane = threadIdx.x & 63, m = lane & 15, q = lane >> 4, wv = threadIdx.x >> 6;
    LAS bf16_t* sAt = (LAS bf16_t*)(lds + wv * RKP_WAVE); LAS bf16_t* sBh = sAt + 16 * RKP_PITCH; LAS bf16_t* sKh = sBh + 16 * RKP_PITCH; LAS bf16_t* sRt = sKh + 16 * RKP_PITCH; LAS bf16_t* sV = sRt + 16 * RKP_PITCH;
    LAS float* sM = (LAS float*)(lds + wv * RKP_WAVE + 5 * RKP_MAT);
    const bf16_t* RS = (const bf16_t*)(p.ws + U_RS); const bf16_t* KS = (const bf16_t*)(p.ws + U_KS); const bf16_t* VS = (const bf16_t*)(p.ws + U_VS); const bf16_t* KK = (const bf16_t*)(p.ws + U_KK);
    for (int it = wid; it < NCHUNK; it += nw) { const int u = it / 144, c = it % 144, b = u / 12, h = (u % 12) >> 1, d = u & 1;
        const bf16_t* AG = (const bf16_t*)(p.ws + U_AG + (size_t)d * SZ384); const bf16_t* LD = (const bf16_t*)(p.ws + U_LD + (size_t)d * SZ384);
        const int rb = rk_row(b, d, c * 16), sgn = d ? -1 : 1;
        { LAS bf16_t* sLd = (LAS bf16_t*)sM;
#pragma unroll
          for (int k = 0; k < 12; ++k) { const int idx = lane + 64 * k, pair = idx >> 3, arr = pair >> 4, t = pair & 15, pc = idx & 7;
              const bf16_t* src = arr == 0 ? KK : arr == 1 ? AG : arr == 2 ? KS : arr == 3 ? RS : arr == 4 ? VS : LD;
              LAS bf16_t* dst = arr == 0 ? sAt : arr == 1 ? sBh : arr == 2 ? sKh : arr == 3 ? sRt : arr == 4 ? sV : sLd;
              *(LAS lu4*)(dst + t * RKP_PITCH + pc * 8) = *(const lu4*)(src + (size_t)(rb + sgn * t) * 384 + h * 64 + pc * 8); }
          const float ka = p.in[27][l * 384 + h * 64 + lane]; float L = 0.f;
#pragma unroll 4
          for (int t = 0; t < 16; ++t) { const int o = t * RKP_PITCH + lane;
              const float r_ = bf2f(sRt[o]), k_ = bf2f(sKh[o]), kk_ = bf2f(sAt[o]), ag_ = bf2f(sBh[o]), ld_ = bf2f(sLd[o]);
              const float e0 = __expf(L); L += ld_; const float e1 = __expf(L), ei = __expf(-L);
              sAt[o] = f2bf(-kk_ * e0); sBh[o] = f2bf(kk_ * ag_ * ei); sKh[o] = f2bf(k_ * (1.0f + (ag_ - 1.0f) * ka) * ei); sRt[o] = f2bf(r_ * e1); }
          ((bf16_t*)(p.ws + CH_GT))[(size_t)it * 64 + lane] = f2bf(L); }
        { bf16x8 atf[2], rtf[2], bhf[2], khf[2];
#pragma unroll
          for (int ks = 0; ks < 2; ++ks) { atf[ks] = *(const LAS bf16x8*)(sAt + m * RKP_PITCH + ks * 32 + q * 8); rtf[ks] = *(const LAS bf16x8*)(sRt + m * RKP_PITCH + ks * 32 + q * 8);
              bhf[ks] = *(const LAS bf16x8*)(sBh + m * RKP_PITCH + ks * 32 + q * 8); khf[ks] = *(const LAS bf16x8*)(sKh + m * RKP_PITCH + ks * 32 + q * 8); }
          f32x4 mab = (f32x4){0.f, 0.f, 0.f, 0.f}, mak = mab, mrb = mab, mrk = mab;
#pragma unroll
          for (int ks = 0; ks < 2; ++ks) { mab = mfma16(atf[ks], bhf[ks], mab); mak = mfma16(atf[ks], khf[ks], mak); mrb = mfma16(rtf[ks], bhf[ks], mrb); mrk = mfma16(rtf[ks], khf[ks], mrk); }
#pragma unroll
          for (int r = 0; r < 4; ++r) { const int t = 4 * q + r; sM[(0 * 16 + t) * 17 + m] = m < t ? mab[r] : 0.f; sM[(1 * 16 + t) * 17 + m] = m < t ? mak[r] : 0.f;
              sM[(2 * 16 + t) * 17 + m] = m <= t ? mrb[r] : 0.f; sM[(3 * 16 + t) * 17 + m] = m <= t ? mrk[r] : 0.f; } }
        { float tv[16];
#pragma unroll
          for (int t = 0; t < 16; ++t) { float acc = (m == t) ? 1.0f : 0.0f;
#pragma unroll
              for (int s2 = 0; s2 < t; ++s2) acc += sM[t * 17 + s2] * tv[s2];
              tv[t] = acc; }
#pragma unroll
          for (int t = 0; t < 16; ++t) if (q == 0) sM[t * 17 + m] = tv[t]; }
        bf16x8 tinvf, mrbf;
        { float lo[4], hi[4] = {0.f, 0.f, 0.f, 0.f};
#pragma unroll
          for (int j = 0; j < 4; ++j) lo[j] = sM[(0 * 16 + m) * 17 + 4 * q + j];
          tinvf = pack_frag(lo, hi);
#pragma unroll
          for (int j = 0; j < 4; ++j) lo[j] = sM[(2 * 16 + m) * 17 + 4 * q + j];
          mrbf = pack_frag(lo, hi);
#pragma unroll
          for (int j = 0; j < 4; ++j) hi[j] = sM[(3 * 16 + m) * 17 + 4 * q + j];
          *(bf16x8*)((bf16_t*)(p.ws + CH_MM) + ((size_t)it * 64 + lane) * 8) = pack_frag(lo, hi); }
        { bf16x8 makf; { float lo[4], hi[4];
#pragma unroll
            for (int j = 0; j < 4; ++j) { lo[j] = q < 2 ? sM[(1 * 16 + m) * 17 + 8 * q + j] : 0.f; hi[j] = q < 2 ? sM[(1 * 16 + m) * 17 + 8 * q + 4 + j] : 0.f; }
            makf = pack_frag(lo, hi); }
#pragma unroll
          for (int itile = 0; itile < 4; ++itile) { unsigned vw[4];
#pragma unroll
              for (int j = 0; j < 4; ++j) vw[j] = q < 2 ? ((unsigned)sV[(8 * q + 2 * j) * RKP_PITCH + 16 * itile + m] | ((unsigned)sV[(8 * q + 2 * j + 1) * RKP_PITCH + 16 * itile + m] << 16)) : 0u;
              const u32x4 vq = {vw[0], vw[1], vw[2], vw[3]};
              const f32x4 w1 = mfma16(makf, __builtin_bit_cast(bf16x8, vq), (f32x4){0.f, 0.f, 0.f, 0.f});
              const float lo[4] = {w1[0], w1[1], w1[2], w1[3]}, hi[4] = {0.f, 0.f, 0.f, 0.f};
              const f32x4 uu = mfma16(tinvf, pack_frag(lo, hi), (f32x4){0.f, 0.f, 0.f, 0.f});
              u32x2 o; o.x = pack2(uu[0], uu[1]); o.y = pack2(uu[2], uu[3]);
              *(u32x2*)((bf16_t*)(p.ws + CH_UL) + (((size_t)it * 4 + itile) * 64 + lane) * 4) = o; } }
        f32x4 ap[4], rp[4];
#pragma unroll
        for (int jt = 0; jt < 4; ++jt) { float lo[4], hi[4] = {0.f, 0.f, 0.f, 0.f};
#pragma unroll
            for (int j = 0; j < 4; ++j) lo[j] = bf2f(sAt[(4 * q + j) * RKP_PITCH + 16 * jt + m]);
            ap[jt] = mfma16(tinvf, pack_frag(lo, hi), (f32x4){0.f, 0.f, 0.f, 0.f});
            const float al[4] = {ap[jt][0], ap[jt][1], ap[jt][2], ap[jt][3]};
            f32x4 rr = mfma16(mrbf, pack_frag(al, hi), (f32x4){0.f, 0.f, 0.f, 0.f});
#pragma unroll
            for (int r = 0; r < 4; ++r) rr[r] += bf2f(sRt[(4 * q + r) * RKP_PITCH + 16 * jt + m]);
            rp[jt] = rr;
            float bl[4], kl[4];
#pragma unroll
            for (int j = 0; j < 4; ++j) { bl[j] = bf2f(sBh[(4 * q + j) * RKP_PITCH + 16 * jt + m]); kl[j] = bf2f(sKh[(4 * q + j) * RKP_PITCH + 16 * jt + m]); }
            *(bf16x8*)((bf16_t*)(p.ws + CH_BK) + (((size_t)it * 4 + jt) * 64 + lane) * 8) = pack_frag(bl, kl); }
#pragma unroll
        for (int jt = 0; jt < 4; ++jt)
#pragma unroll
            for (int r = 0; r < 4; ++r) { sAt[(4 * q + r) * RKP_PITCH + 16 * jt + m] = f2bf(ap[jt][r]); sRt[(4 * q + r) * RKP_PITCH + 16 * jt + m] = f2bf(rp[jt][r]); }
#pragma unroll
        for (int x = 0; x < 2; ++x)
#pragma unroll
            for (int ks = 0; ks < 2; ++ks) { const LAS bf16_t* src = (x ? sRt : sAt) + m * RKP_PITCH + 32 * ks + 4 * q;
                const u32x2 a0 = *(const LAS u32x2*)src, a1 = *(const LAS u32x2*)(src + 16); const u32x4 w = {a0.x, a0.y, a1.x, a1.y};
                *(u32x4*)((bf16_t*)(p.ws + CH_XP) + ((((size_t)it * 2 + x) * 2 + ks) * 64 + lane) * 8) = w; }
    }
}
__device__ __forceinline__ void rwkv_seq_task(const Params& p, int l, int task, LAS unsigned char* lds) {
    const int lane = threadIdx.x & 63, m = lane & 15, q = lane >> 4;
    const int u = task >> 2, iw = task & 3, b = u / 12, h = (u % 12) >> 1, d = u & 1, sgn = d ? -1 : 1;
    const bf16_t* XP = (const bf16_t*)(p.ws + CH_XP); const bf16_t* BK = (const bf16_t*)(p.ws + CH_BK); const bf16_t* UL = (const bf16_t*)(p.ws + CH_UL); const bf16_t* MM = (const bf16_t*)(p.ws + CH_MM);
    const bf16_t* GT = (const bf16_t*)(p.ws + CH_GT); const bf16_t* VS = (const bf16_t*)(p.ws + U_VS) + h * 64 + 16 * iw;
    float* Yw = (float*)(p.ws + U_YRK) + (size_t)d * NROW * 384 + h * 64 + 16 * iw;
    LAS float* ybuf = (LAS float*)(lds + (threadIdx.x >> 6) * 12288);
    const int rc0 = NLAT + b * 256 + (d ? 255 : 0) + sgn * 4 * q, rdel = (b * 2048 + (d ? 2047 : 0)) - (NLAT + b * 256 + (d ? 255 : 0)) - sgn * 256;
    f32x4 acc[4];
#pragma unroll
    for (int jt = 0; jt < 4; ++jt) acc[jt] = (f32x4){0.f, 0.f, 0.f, 0.f};
    const unsigned vo16 = (unsigned)lane * 16u, vo8 = (unsigned)lane * 8u, vo8q = (unsigned)q * 8u;
    struct OpSet { u32x4 apf0, apf1, rpf0, rpf1, bkf0, bkf1, bkf2, bkf3, mmf; u32x2 gl0, gl1, gl2, gl3, uw; unsigned vr0, vr1, vr2, vr3; };
#define GLDS16(dst, voff, sbase, imm) asm volatile("global_load_dwordx4 %0, %1, %2 offset:" #imm : "=&v"(dst) : "v"(voff), "s"(sbase) : "memory")
#define GLDS8(dst, voff, sbase, imm) asm volatile("global_load_dwordx2 %0, %1, %2 offset:" #imm : "=&v"(dst) : "v"(voff), "s"(sbase) : "memory")
#define GLDS2(dst, voff, sbase) asm volatile("global_load_ushort %0, %1, %2" : "=&v"(dst) : "v"(voff), "s"(sbase) : "memory")
#define RKS_LOAD(X, c_) do { const size_t it_ = (size_t)u * 144 + (c_); const int rb_ = rc0 + sgn * 16 * (c_) + (int)((c_) >= 16) * rdel; \
        const bf16_t* xpb = XP + it_ * 2048; const bf16_t* bkb = BK + it_ * 2048; const bf16_t* mmb = MM + it_ * 512; const bf16_t* gtb = GT + it_ * 64; const bf16_t* ulb = UL + (it_ * 4 + iw) * 256; \
        GLDS16(X.apf0, vo16, xpb, 0); GLDS16(X.apf1, vo16, xpb, 1024); GLDS16(X.rpf0, vo16, xpb, 2048); GLDS16(X.rpf1, vo16, xpb, 3072); \
        GLDS16(X.bkf0, vo16, bkb, 0); GLDS16(X.bkf1, vo16, bkb, 1024); GLDS16(X.bkf2, vo16, bkb, 2048); GLDS16(X.bkf3, vo16, bkb, 3072); \
        GLDS8(X.gl0, vo8q, gtb, 0); GLDS8(X.gl1, vo8q, gtb, 32); GLDS8(X.gl2, vo8q, gtb, 64); GLDS8(X.gl3, vo8q, gtb, 96); \
        GLDS16(X.mmf, vo16, mmb, 0); GLDS8(X.uw, vo8, ulb, 0); \
        { const unsigned v0_ = (unsigned)(rb_) * 768u + 2u * m, v1_ = (unsigned)(rb_ + sgn) * 768u + 2u * m, v2_ = (unsigned)(rb_ + 2 * sgn) * 768u + 2u * m, v3_ = (unsigned)(rb_ + 3 * sgn) * 768u + 2u * m; \
          GLDS2(X.vr0, v0_, VS); GLDS2(X.vr1, v1_, VS); GLDS2(X.vr2, v2_, VS); GLDS2(X.vr3, v3_, VS); } } while (0)
#define RKS_WAIT(X) asm volatile("s_waitcnt vmcnt(36)" : "+v"(X.apf0), "+v"(X.apf1), "+v"(X.rpf0), "+v"(X.rpf1), "+v"(X.bkf0), "+v"(X.bkf1), "+v"(X.bkf2), "+v"(X.bkf3), "+v"(X.mmf), \
        "+v"(X.gl0), "+v"(X.gl1), "+v"(X.gl2), "+v"(X.gl3), "+v"(X.uw), "+v"(X.vr0), "+v"(X.vr1), "+v"(X.vr2), "+v"(X.vr3) :: "memory")
#define BF8(x) __builtin_bit_cast(bf16x8, x)
#define RKS_COMPUTE(X, c_) do { RKS_WAIT(X); \
        const float ul[4] = {bflo(X.uw.x), bfhi(X.uw.x), bflo(X.uw.y), bfhi(X.uw.y)}; const float vl[4] = {bflo(X.vr0), bflo(X.vr1), bflo(X.vr2), bflo(X.vr3)}; \
        f32x4 zp = (f32x4){0.f, 0.f, 0.f, 0.f}, yp = zp; \
        { const float lo[4] = {acc[0][0], acc[0][1], acc[0][2], acc[0][3]}, hi[4] = {acc[1][0], acc[1][1], acc[1][2], acc[1][3]}; const bf16x8 sf = pack_frag(lo, hi); zp = mfma16(BF8(X.apf0), sf, zp); yp = mfma16(BF8(X.rpf0), sf, yp); } \
        { const float lo[4] = {acc[2][0], acc[2][1], acc[2][2], acc[2][3]}, hi[4] = {acc[3][0], acc[3][1], acc[3][2], acc[3][3]}; const bf16x8 sf = pack_frag(lo, hi); zp = mfma16(BF8(X.apf1), sf, zp); yp = mfma16(BF8(X.rpf1), sf, yp); } \
        const float z[4] = {zp[0] + ul[0], zp[1] + ul[1], zp[2] + ul[2], zp[3] + ul[3]}; \
        yp = mfma16(BF8(X.mmf), pack_frag(ul, vl), yp); \
        const bf16x8 zvf = pack_frag(z, vl); \
        acc[0] = mfma16(BF8(X.bkf0), zvf, acc[0]); acc[1] = mfma16(BF8(X.bkf1), zvf, acc[1]); acc[2] = mfma16(BF8(X.bkf2), zvf, acc[2]); acc[3] = mfma16(BF8(X.bkf3), zvf, acc[3]); \
        { const f32x4 g4 = {__expf(bflo(X.gl0.x)), __expf(bfhi(X.gl0.x)), __expf(bflo(X.gl0.y)), __expf(bfhi(X.gl0.y))}; acc[0] *= g4; } \
        { const f32x4 g4 = {__expf(bflo(X.gl1.x)), __expf(bfhi(X.gl1.x)), __expf(bflo(X.gl1.y)), __expf(bfhi(X.gl1.y))}; acc[1] *= g4; } \
        { const f32x4 g4 = {__expf(bflo(X.gl2.x)), __expf(bfhi(X.gl2.x)), __expf(bflo(X.gl2.y)), __expf(bfhi(X.gl2.y))}; acc[2] *= g4; } \
        { const f32x4 g4 = {__expf(bflo(X.gl3.x)), __expf(bfhi(X.gl3.x)), __expf(bflo(X.gl3.y)), __expf(bfhi(X.gl3.y))}; acc[3] *= g4; } \
        _Pragma("unroll") for (int r = 0; r < 4; ++r) ybuf[((((c_) % 12) * 16) + 4 * q + r) * 16 + m] = yp[r]; } while (0)
    asm volatile("; SEQ_BEGIN");
    OpSet A, B, C;
    RKS_LOAD(A, 0); RKS_LOAD(B, 1);
    for (int c0 = 0; c0 < 144; c0 += 12) {
#pragma unroll
        for (int cc = 0; cc < 12; cc += 3) { const int c = c0 + cc;
            RKS_LOAD(C, c + 2); __builtin_amdgcn_sched_barrier(0);
            RKS_COMPUTE(A, c); __builtin_amdgcn_sched_barrier(0);
            { const int cn = c + 3 < 144 ? c + 3 : 143; RKS_LOAD(A, cn); } __builtin_amdgcn_sched_barrier(0);
            RKS_COMPUTE(B, c + 1); __builtin_amdgcn_sched_barrier(0);
            { const int cn = c + 4 < 144 ? c + 4 : 143; RKS_LOAD(B, cn); } __builtin_amdgcn_sched_barrier(0);
            RKS_COMPUTE(C, c + 2); __builtin_amdgcn_sched_barrier(0); }
#pragma unroll
        for (int k = 0; k < 12; ++k) { const int rr = (lane >> 2) + 16 * k, n = c0 * 16 + rr; const int grow = (rc0 - sgn * 4 * q) + sgn * n + (int)(n >= 256) * rdel;
            *(f32x4*)(Yw + (size_t)grow * 384 + (lane & 3) * 4) = *(const LAS f32x4*)(ybuf + rr * 16 + (lane & 3) * 4); }
    }
    asm volatile("; SEQ_END");
#undef RKS_LOAD
#undef RKS_COMPUTE
#undef RKS_WAIT
#undef GLDS16
#undef GLDS8
#undef GLDS2
#undef BF8
}

__device__ __forceinline__ void rwkv_finish(const Params& p, int l) {
    const int sub = threadIdx.x & 7; const int npair = (l == 0 ? NROW : NLAT) * 6;
    const bf16_t* RS = (const bf16_t*)(p.ws + U_RS); const bf16_t* KS = (const bf16_t*)(p.ws + U_KS); const bf16_t* VS = (const bf16_t*)(p.ws + U_VS);
    const bf16_t* AG0 = (const bf16_t*)(p.ws + U_AG); const bf16_t* AG1 = (const bf16_t*)(p.ws + U_AG + SZ384); const bf16_t* G = (const bf16_t*)(p.ws + U_G);
    const float* Y0 = (const float*)(p.ws + U_YRK); const float* Y1 = Y0 + (size_t)NROW * 384; bf16_t* YC = (bf16_t*)(p.ws + WS_ABUF);
    for (int pr = (blockIdx.x * NTHR + threadIdx.x) >> 3; pr < npair; pr += (gridDim.x * NTHR) >> 3) { const int row = pr / 6, h = pr % 6, col = h * 64 + sub * 8; const size_t o = (size_t)row * 384 + col;
        float y[8]; { const float4 a0 = *(const float4*)(Y0 + o), a1 = *(const float4*)(Y0 + o + 4), c0 = *(const float4*)(Y1 + o), c1 = *(const float4*)(Y1 + o + 4);
            y[0] = a0.x + c0.x; y[1] = a0.y + c0.y; y[2] = a0.z + c0.z; y[3] = a0.w + c0.w; y[4] = a1.x + c1.x; y[5] = a1.y + c1.y; y[6] = a1.z + c1.z; y[7] = a1.w + c1.w; }
        float s = 0.f;
#pragma unroll
        for (int k = 0; k < 8; ++k) s += y[k];
        s += __shfl_xor(s, 1); s += __shfl_xor(s, 2); s += __shfl_xor(s, 4); const float mean = s * (1.0f / 64.0f);
        float v2 = 0.f;
#pragma unroll
        for (int k = 0; k < 8; ++k) { const float dd = y[k] - mean; v2 += dd * dd; }
        v2 += __shfl_xor(v2, 1); v2 += __shfl_xor(v2, 2); v2 += __shfl_xor(v2, 4); const float rstd = rsqrtf(v2 * (1.0f / 64.0f) + 64e-5f);
        float r[8], kx[8], vx[8], a0[8], a1[8], gx[8];
        unpack8(*(const uint4*)(RS + o), r); unpack8(*(const uint4*)(KS + o), kx); unpack8(*(const uint4*)(VS + o), vx); unpack8(*(const uint4*)(AG0 + o), a0); unpack8(*(const uint4*)(AG1 + o), a1); unpack8(*(const uint4*)(G + o), gx);
        const float* ka = p.in[27] + l * 384 + col; const float* rk = p.in[28] + l * 384 + col; const float* lw = p.in[29] + l * 384 + col; const float* lb = p.in[30] + l * 384 + col;
        float bs = 0.f;
#pragma unroll
        for (int k = 0; k < 8; ++k) { const float kd0 = kx[k] * (1.0f + (a0[k] - 1.0f) * ka[k]), kd1 = kx[k] * (1.0f + (a1[k] - 1.0f) * ka[k]); bs += r[k] * (kd0 + kd1) * rk[k]; }
        bs += __shfl_xor(bs, 1); bs += __shfl_xor(bs, 2); bs += __shfl_xor(bs, 4);
        float ov[8];
#pragma unroll
        for (int k = 0; k < 8; ++k) ov[k] = ((y[k] - mean) * rstd * lw[k] + lb[k] + bs * vx[k]) * gx[k];
        *(uint4*)(YC + (size_t)row * 1024 + 640 + col) = pack8(ov);
    }
}

__device__ __forceinline__ void phase_normrouter(const Params& p, int l, const float* xl, const float* xc, LAS unsigned char* lds) {
    LAS float* hrow = (LAS float*)lds;
    LAS float* part = (LAS float*)(lds + 32768);
    const int lane = threadIdx.x & 63, wv = threadIdx.x >> 6, e = lane & 15, cq = lane >> 4; const int ngrp = (l == 0 ? NROW : NLAT) / 8;
    const float* mod = (const float*)(p.ws + WS_MOD) + (size_t)l * 17 * 6144; const float* g1 = p.in[6] + (l * 4 + 1) * 1024; const float* g2 = p.in[6] + (l * 4 + 2) * 1024;
    const bf16_t* Y = (const bf16_t*)(p.ws + U_Y); unsigned char* A8 = p.ws + WS_ABUF; float* AFF = (float*)(p.ws + WS_AFF);
    float wr[32];
#pragma unroll
    for (int j = 0; j < 32; ++j) wr[j] = p.in[31][((size_t)l * 1024 + 128 * wv + 32 * cq + j) * 16 + e];
    for (int gi = blockIdx.x; gi < ngrp; gi += gridDim.x) { const int r = gi * 8 + wv; const int b = r < NLAT ? (r >> 11) : 16; const float* mb = mod + (size_t)b * 6144;
        const float* xs = xrow(xl, xc, r); float* xd = xrow_w(p.out, (float*)(p.ws + WS_CTXA), r);
        float4 y[4], x[4]; float ss = 0.f;
#pragma unroll
        for (int i = 0; i < 4; ++i) { { const u32x2 yw = *(const u32x2*)(Y + (size_t)r * 1024 + i * 256 + lane * 4); y[i] = make_float4(bflo(yw.x), bfhi(yw.x), bflo(yw.y), bfhi(yw.y)); } x[i] = *(const float4*)(xs + i * 256 + lane * 4); ss += y[i].x * y[i].x + y[i].y * y[i].y + y[i].z * y[i].z + y[i].w * y[i].w; }
        ss = wave_sum(ss); const float rs = rsqrtf(ss * (1.0f / 1024.0f) + 1e-6f);
        float s2 = 0.f;
#pragma unroll
        for (int i = 0; i < 4; ++i) { const int c = i * 256 + lane * 4; const float4 gg = *(const float4*)(g1 + c), gt = *(const float4*)(mb + 2048 + c);
            x[i].x += gt.x * (y[i].x * rs * gg.x); x[i].y += gt.y * (y[i].y * rs * gg.y); x[i].z += gt.z * (y[i].z * rs * gg.z); x[i].w += gt.w * (y[i].w * rs * gg.w);
            *(float4*)(xd + c) = x[i]; s2 += x[i].x * x[i].x + x[i].y * x[i].y + x[i].z * x[i].z + x[i].w * x[i].w; }
        s2 = wave_sum(s2); const float rs2 = rsqrtf(s2 * (1.0f / 1024.0f) + 1e-6f);
        float hv[4][4]; float amax = 0.f;
        __syncthreads();
#pragma unroll
        for (int i = 0; i < 4; ++i) { const int c = i * 256 + lane * 4; const float4 gg = *(const float4*)(g2 + c), sh = *(const float4*)(mb + 3072 + c), sc = *(const float4*)(mb + 4096 + c);
            hv[i][0] = x[i].x * rs2 * gg.x * (1.f + sc.x) + sh.x; hv[i][1] = x[i].y * rs2 * gg.y * (1.f + sc.y) + sh.y; hv[i][2] = x[i].z * rs2 * gg.z * (1.f + sc.z) + sh.z; hv[i][3] = x[i].w * rs2 * gg.w * (1.f + sc.w) + sh.w;
            *(LAS lf4*)(hrow + wv * 1024 + c) = (lf4){hv[i][0], hv[i][1], hv[i][2], hv[i][3]};
            amax = fmaxf(amax, fmaxf(fmaxf(fabsf(hv[i][0]), fabsf(hv[i][1])), fmaxf(fabsf(hv[i][2]), fabsf(hv[i][3])))); }
#pragma unroll
        for (int o = 32; o >= 1; o >>= 1) amax = fmaxf(amax, __shfl_xor(amax, o));
        amax = fmaxf(amax, 1e-20f); const float qs = 127.0f / amax;
        if (lane == 0) ((float*)(p.ws + WS_SX))[r] = amax * (1.0f / 127.0f);
#pragma unroll
        for (int i = 0; i < 4; ++i) { unsigned w = 0u;
#pragma unroll
            for (int k = 0; k < 4; ++k) w |= ((unsigned)__float2int_rn(hv[i][k] * qs) & 255u) << (8 * k);
            *(unsigned*)(A8 + (size_t)r * 1024 + i * 256 + lane * 4) = w; }
        __syncthreads();
#pragma unroll 2
        for (int rr = 0; rr < 8; ++rr) { const LAS float* hp = hrow + rr * 1024 + 128 * wv + 32 * cq; float acc = 0.f;
#pragma unroll
            for (int j4 = 0; j4 < 8; ++j4) { const lf4 h4 = *(const LAS lf4*)(hp + 4 * j4); acc += h4.x * wr[4 * j4] + h4.y * wr[4 * j4 + 1] + h4.z * wr[4 * j4 + 2] + h4.w * wr[4 * j4 + 3]; }
            acc += __shfl_xor(acc, 16); acc += __shfl_xor(acc, 32);
            if (cq == 0) part[(rr * 8 + wv) * 16 + e] = acc; }
        __syncthreads();
        if (lane < 16) { float lgt = 0.f;
#pragma unroll
            for (int w = 0; w < 8; ++w) lgt += part[(wv * 8 + w) * 16 + lane];
            float mxl = lgt;
#pragma unroll
            for (int o = 8; o >= 1; o >>= 1) mxl = fmaxf(mxl, __shfl_xor(mxl, o));
            const float ex = expf(lgt - mxl); float den = ex;
#pragma unroll
            for (int o = 8; o >= 1; o >>= 1) den += __shfl_xor(den, o);
            AFF[(size_t)r * 16 + lane] = ex / den; }
    }
}

__device__ __forceinline__ void phase_topk(const Params& p, int l, LAS unsigned char* lds) {
    LAS unsigned* keys = (LAS unsigned*)lds;
    LAS int* toks = (LAS int*)(lds + 8192);
    LAS unsigned* hist = (LAS unsigned*)(lds + 9216);
    LAS unsigned* wtot = (LAS unsigned*)(lds + 10240);
    LAS unsigned* sel = (LAS unsigned*)(lds + 10304);
    const int tid = threadIdx.x, lane = tid & 63, wv = tid >> 6, nitem = l == 0 ? 512 : 256;
    const float* AFF = (const float*)(p.ws + WS_AFF); int* SLOT = (int*)(p.ws + WS_SLOT); float* SELG = (float*)(p.ws + WS_SELG);
    const bf16_t* A = (const bf16_t*)(p.ws + WS_ABUF); bf16_t* XS = (bf16_t*)(p.ws + U_XSEL);
    for (int it = blockIdx.x; it < nitem; it += gridDim.x) { const bool lat = it < 256; const int be = it & 255, b = be >> 4, e = be & 15;
        const int n = lat ? SEQ : CTXL, cap = lat ? 256 : 32, rowbase = lat ? b * 2048 : NLAT + b * 256, xoff = lat ? b * 256 : 4096 + b * 32;
        const int per = n / NTHR > 0 ? n / NTHR : 1;
        const int t0 = tid * per; const bool act = t0 < n;
        unsigned kx[4];
        __syncthreads();
#pragma unroll
        for (int j = 0; j < 4; ++j) { kx[j] = 0u; if (act && j < per) { kx[j] = __float_as_uint(AFF[(size_t)(rowbase + t0 + j) * 16 + e]); keys[t0 + j] = kx[j]; } }
        unsigned prefix = 0u; int krem = cap;
        for (int pass = 0; pass < 4; ++pass) { const int shift = 24 - 8 * pass;
            if (tid < 256) hist[tid] = 0u;
            __syncthreads();
#pragma unroll
            for (int j = 0; j < 4; ++j) if (act && j < per) { const bool match = pass == 0 || (kx[j] >> (shift + 8)) == (prefix >> (shift + 8)); if (match) atomicAdd((unsigned*)&hist[(kx[j] >> shift) & 255u], 1u); }
            __syncthreads();
            if (tid < 256) { unsigned above = 0u; for (int bb = tid + 1; bb < 256; ++bb) above += hist[bb]; const unsigned mine = hist[tid];
                if (above < (unsigned)krem && above + mine >= (unsigned)krem) { sel[0] = (unsigned)tid; sel[1] = (unsigned)krem - above; } }
            __syncthreads();
            prefix |= sel[0] << shift; krem = (int)sel[1];
            __syncthreads();
        }
        unsigned loc = 0u, pre[4];
#pragma unroll
        for (int j = 0; j < 4; ++j) { pre[j] = loc; if (act && j < per) loc += (kx[j] > prefix ? 1u : 0u) + (kx[j] == prefix ? 65536u : 0u); }
        unsigned inc = loc;
#pragma unroll
        for (int o = 1; o < 64; o <<= 1) { const unsigned t = __shfl_up(inc, o); if (lane >= o) inc += t; }
        if (lane == 63) wtot[wv] = inc;
        __syncthreads();
        unsigned base = inc - loc;
        for (int w = 0; w < wv; ++w) base += wtot[w];
#pragma unroll
        for (int j = 0; j < 4; ++j) if (act && j < per) { const unsigned c = base + pre[j]; const int gtb = (int)(c & 0xffffu), eqb = (int)(c >> 16);
            const bool s = kx[j] > prefix || (kx[j] == prefix && eqb < krem); const int slot = gtb + (eqb < krem ? eqb : krem);
            if (s) { SELG[e * XROWS + xoff + slot] = __uint_as_float(kx[j]); toks[slot] = t0 + j; }
            SLOT[(size_t)(rowbase + t0 + j) * 16 + e] = s ? slot : -1; }
        __syncthreads();
        for (int s = wv; s < cap; s += 8) { const int row = rowbase + toks[s]; const lu4* src = (const lu4*)((const unsigned char*)A + (size_t)row * 1024); lu4* dst = (lu4*)((unsigned char*)XS + ((size_t)e * XROWS + xoff + s) * 1024);
            dst[lane] = src[lane]; if (lane == 0) ((float*)(p.ws + WS_SXS))[e * XROWS + xoff + s] = ((const float*)(p.ws + WS_SX))[row]; }
    }
}

struct GroupedOrder { int nMl, nNl, pnb, G, c, total;
    __device__ void init(int nMl_, int nNl_, int pnb_, int G_, int c_) { nMl = nMl_; nNl = nNl_; pnb = pnb_; G = G_; c = c_; total = 16 * nMl_ * nNl_; }
    __device__ bool next(int i, pg8::Unit& u) const {
        int L;
        if ((G & 7) == 0 && (total & 7) == 0) { const int W = G >> 3, x = c & 7, r = c >> 3, t8 = total >> 3, k = i * W + r; if (k >= t8) return false; L = x * t8 + k; }
        else { const long LL = (long)i * G + c; if (LL >= total) return false; L = (int)LL; }
        const int per = nMl * nNl, e = L / per, idx = L % per, blk = idx / (pnb * nMl), rem = idx % (pnb * nMl), pml = rem / pnb, pnl = blk * pnb + rem % pnb;
        u.pm = e * 18 + pml; u.pn = e * nNl + pnl; return true; }
    __device__ __forceinline__ void a_ready(const pg8::Unit&) const {}
    __device__ __forceinline__ void done(const pg8::Unit&) const {}
};
struct EpiSwiGLU { static constexpr bool PERM = true, AFTER_DRAIN = false; bf16_t* H; const float* sx; const float* sw;
    __device__ __forceinline__ void operator()(const f32x4 (&acc)[2][2][4][2], const pg8::Unit& u, int wr, int wc, int fr, int fq) const {
        typedef int i32x4_ __attribute__((ext_vector_type(4)));
        const int e = u.pn / 22, pnl = u.pn - e * 22; const int row0 = u.pm * 256 + wr * 64 + fr, col0 = pnl * 128 + wc * 32 + 8 * fq;
        const float* swp = sw + (size_t)u.pn * 256 + wc * 32 + 8 * fq; const float4 g0 = *(const float4*)swp, g1 = *(const float4*)(swp + 4), u0 = *(const float4*)(swp + 128), u1 = *(const float4*)(swp + 132);
        const float swg[8] = {g0.x, g0.y, g0.z, g0.w, g1.x, g1.y, g1.z, g1.w}, swu[8] = {u0.x, u0.y, u0.z, u0.w, u1.x, u1.y, u1.z, u1.w};
#pragma unroll
        for (int ai = 0; ai < 2; ++ai)
#pragma unroll
            for (int m = 0; m < 4; ++m) { const int r = row0 + ai * 128 + m * 16; const float sr = sx[r]; bf16_t* rowp = H + (size_t)r * DE + col0; float o[8];
#pragma unroll
                for (int n = 0; n < 2; ++n) { const i32x4_ ig = __builtin_bit_cast(i32x4_, acc[ai][0][m][n]), iu = __builtin_bit_cast(i32x4_, acc[ai][1][m][n]);
#pragma unroll
                    for (int j = 0; j < 4; ++j) { const float g = (float)ig[j] * (sr * swg[n * 4 + j]), uu = (float)iu[j] * (sr * swu[n * 4 + j]); o[n * 4 + j] = g * sigm(g) * uu; } }
                *(uint4*)rowp = pack8(o); }
    }
};
struct EpiScaleBf16 { static constexpr bool PERM = true, AFTER_DRAIN = false; bf16_t* O; int ldc; const float* sx; const float* sw;
    __device__ __forceinline__ void operator()(const f32x4 (&acc)[2][2][4][2], const pg8::Unit& u, int wr, int wc, int fr, int fq) const {
        typedef int i32x4_ __attribute__((ext_vector_type(4)));
        const int row0 = u.pm * 256 + wr * 64 + fr, col0 = u.pn * 256 + wc * 32 + 8 * fq;
        float swv[2][8];
#pragma unroll
        for (int bj = 0; bj < 2; ++bj) { const float4 a = *(const float4*)(sw + col0 + bj * 128), b = *(const float4*)(sw + col0 + bj * 128 + 4); swv[bj][0] = a.x; swv[bj][1] = a.y; swv[bj][2] = a.z; swv[bj][3] = a.w; swv[bj][4] = b.x; swv[bj][5] = b.y; swv[bj][6] = b.z; swv[bj][7] = b.w; }
#pragma unroll
        for (int ai = 0; ai < 2; ++ai)
#pragma unroll
            for (int m = 0; m < 4; ++m) { const int r = row0 + ai * 128 + m * 16; const float sr = sx[r]; bf16_t* rowp = O + (size_t)r * ldc + col0;
#pragma unroll
                for (int bj = 0; bj < 2; ++bj) { float o[8];
#pragma unroll
                    for (int n = 0; n < 2; ++n) { const i32x4_ iv = __builtin_bit_cast(i32x4_, acc[ai][bj][m][n]);
#pragma unroll
                        for (int j = 0; j < 4; ++j) o[n * 4 + j] = (float)iv[j] * (sr * swv[bj][n * 4 + j]); }
                    *(uint4*)(rowp + bj * 128) = pack8(o); } }
    }
};
struct EpiGate { static constexpr bool PERM = true, AFTER_DRAIN = false; bf16_t* O; const float* gate;
    __device__ __forceinline__ void operator()(const f32x4 (&acc)[2][2][4][2], const pg8::Unit& u, int wr, int wc, int fr, int fq) const {
        const int pnl = u.pn & 3; const int row0 = u.pm * 256 + wr * 64 + fr, col0 = pnl * 256 + wc * 32 + 8 * fq;
#pragma unroll
        for (int ai = 0; ai < 2; ++ai)
#pragma unroll
            for (int m = 0; m < 4; ++m) { const int r = row0 + ai * 128 + m * 16; const float gt = gate[r]; bf16_t* rowp = O + (size_t)r * 1024 + col0;
#pragma unroll
                for (int bj = 0; bj < 2; ++bj) { float o[8];
#pragma unroll
                    for (int n = 0; n < 2; ++n)
#pragma unroll
                        for (int j = 0; j < 4; ++j) o[n * 4 + j] = acc[ai][bj][m][n][j] * gt;
                    *(uint4*)(rowp + bj * 128) = pack8(o); } }
    }
};

__device__ __forceinline__ void phase_combine(const Params& p, int l) {
    const int lane = threadIdx.x & 63, wv = threadIdx.x >> 6; const int nrow = l == 0 ? NROW : NLAT;
    const float* mod = (const float*)(p.ws + WS_MOD) + (size_t)l * 17 * 6144; const float* g3 = p.in[6] + (l * 4 + 3) * 1024;
    const int* SLOT = (const int*)(p.ws + WS_SLOT); const bf16_t* YE = (const bf16_t*)(p.ws + U_YEXP); bf16_t* A = (bf16_t*)(p.ws + WS_ABUF);
    for (int r = blockIdx.x * 8 + wv; r < nrow; r += gridDim.x * 8) { const bool lat = r < NLAT; const int b = lat ? (r >> 11) : ((r - NLAT) >> 8), mbi = lat ? b : 16, xoff = lat ? b * 256 : 4096 + b * 32;
        const float* mb = mod + (size_t)mbi * 6144;
        float f[16];
#pragma unroll
        for (int k = 0; k < 16; ++k) f[k] = 0.f;
        const int myslot = lane < 16 ? SLOT[(size_t)r * 16 + lane] : -1;
        for (int e = 0; e < 16; ++e) { const int s = __shfl(myslot, e); if (s >= 0) { const bf16_t* yr = YE + ((size_t)e * XROWS + xoff + s) * 1024 + lane * 4;
#pragma unroll
                for (int i = 0; i < 4; ++i) { const u32x2 w = *(const u32x2*)(yr + i * 256); f[i * 4] += bflo(w.x); f[i * 4 + 1] += bfhi(w.x); f[i * 4 + 2] += bflo(w.y); f[i * 4 + 3] += bfhi(w.y); } } }
        float ss = 0.f;
#pragma unroll
        for (int k = 0; k < 16; ++k) ss += f[k] * f[k];
        ss = wave_sum(ss); const float rs = rsqrtf(ss * (1.0f / 1024.0f) + 1e-6f);
        const float* x1 = xrow(p.out, (const float*)(p.ws + WS_CTXA), r);
        float* x2 = l == 0 ? xrow_w((float*)(p.ws + WS_XB), (float*)(p.ws + WS_CTXB), r) : p.out + (size_t)r * D;
        float4 xv[4];
#pragma unroll
        for (int i = 0; i < 4; ++i) { const int c = i * 256 + lane * 4; const float4 gg = *(const float4*)(g3 + c), gt = *(const float4*)(mb + 5120 + c); float4 x = *(const float4*)(x1 + c);
            x.x += gt.x * (f[i * 4] * rs * gg.x); x.y += gt.y * (f[i * 4 + 1] * rs * gg.y); x.z += gt.z * (f[i * 4 + 2] * rs * gg.z); x.w += gt.w * (f[i * 4 + 3] * rs * gg.w);
            *(float4*)(x2 + c) = x; xv[i] = x; }
        if (l == 0) { const float* mb1 = mod + (size_t)17 * 6144 + (size_t)mbi * 6144; hnorm_row(p.in[6] + 4 * 1024, mb1, mb1 + 1024, p.ws + WS_ABUF + (size_t)r * 1024, (float*)(p.ws + WS_SH) + r, lane, xv); }
    }
}

#ifndef MK_ONLY
#define MK_ONLY -1
#endif
#define EN(k) (MK_ONLY < 0 || MK_ONLY == (k))
#ifndef MK_DUP
#define MK_DUP 0
#endif
#define NREP(k) ((((MK_DUP) >> (k)) & 1) ? 2 : 1)
constexpr int PH_PER_LAYER = 14, N_PHASES = 1 + 2 * PH_PER_LAYER;
#define IN(k) (lo <= (k) && (k) < hi)
#define SEAM(k) do { if (p.use_bar && IN(k) && IN((k) + 1)) xcd_barrier(bar); } while (0)
template <int l> __device__ __forceinline__ void layer_phases(const Params& p, LAS unsigned char* lds, const XcdBarrier& bar, const int lo, const int hi) {
    const int wv = __builtin_amdgcn_readfirstlane(threadIdx.x >> 6), G = gridDim.x; const int wid = blockIdx.x * 8 + wv, nw = G * 8;
        const int pb = 1 + l * PH_PER_LAYER;
        const float* xl = l == 0 ? p.in[0] : (const float*)(p.ws + WS_XB);
        const float* xc = l == 0 ? p.in[2] : (const float*)(p.ws + WS_CTXB);
        if (EN(0) && IN(pb + 0)) { { if (l == 0) phase_hnorm(p, 0, xl, xc); }
            if ((NREP(0)) == 2) { if (l == 0) phase_hnorm(p, 0, xl, xc); } }
        SEAM(pb + 0);
        if (EN(1) && IN(pb + 1)) { { pg8::Gemm g{(const bf16_t*)(p.ws + WS_ABUF), (const bf16_t*)(p.ws + WS_WIN), NROW, NINP, D / 2}; pg8::StaticOrder S; S.init(NROW, NINP, G, (int)blockIdx.x);
            EpiScaleBf16 E{(bf16_t*)(p.ws + U_P), NINP, (const float*)(p.ws + WS_SH), (const float*)(p.ws + WS_SWIN)}; pg8::gemm_phase<EpiScaleBf16, pg8::StaticOrder, false, true>(lds, g, S, E, nullptr); }
            if ((NREP(1)) == 2) { pg8::Gemm g{(const bf16_t*)(p.ws + WS_ABUF), (const bf16_t*)(p.ws + WS_WIN), NROW, NINP, D / 2}; pg8::StaticOrder S; S.init(NROW, NINP, G, (int)blockIdx.x);
            EpiScaleBf16 E{(bf16_t*)(p.ws + U_P), NINP, (const float*)(p.ws + WS_SH), (const float*)(p.ws + WS_SWIN)}; pg8::gemm_phase<EpiScaleBf16, pg8::StaticOrder, false, true>(lds, g, S, E, nullptr); } }
        SEAM(pb + 1);
        if (EN(2) && IN(pb + 2)) { phase_prep(p, l, lds);
            if ((NREP(2)) == 2) phase_prep(p, l, lds); }
        SEAM(pb + 2);
        if (EN(3) && IN(pb + 3)) { { lowrank_items(p, l, wid, nw); s5_pass1_items(p, l, wid, nw); }
            if ((NREP(3)) == 2) { lowrank_items(p, l, wid, nw); s5_pass1_items(p, l, wid, nw); } }
        SEAM(pb + 3);
        if (EN(4) && IN(pb + 4)) { { s5_carry(p, l); na_items(p, l, wid, nw, lds); }
            if ((NREP(4)) == 2) { s5_carry(p, l); na_items(p, l, wid, nw, lds); } }
        SEAM(pb + 4);
        if (EN(5) && IN(pb + 5)) { { s5_pass2_items(p, l, wid, nw); rwkv_pre_items(p, l, wid, nw, lds); }
            if ((NREP(5)) == 2) { s5_pass2_items(p, l, wid, nw); rwkv_pre_items(p, l, wid, nw, lds); } }
        SEAM(pb + 5);
        if (EN(6) && IN(pb + 6)) {
            if (G > 192) { const int bx = (int)blockIdx.x;
                if (bx < 192) { if (wv < 4) rwkv_seq_task(p, l, bx * 4 + wv, lds); } else s5_glu_items(p, l, (bx - 192) * 8 + wv, (G - 192) * 8);
                if ((NREP(6)) == 2) { if (bx < 192) { if (wv < 4) rwkv_seq_task(p, l, bx * 4 + wv, lds); } else s5_glu_items(p, l, (bx - 192) * 8 + wv, (G - 192) * 8); } }
            else { for (int task = wid; task < 768; task += nw) rwkv_seq_task(p, l, task, lds); s5_glu_items(p, l, wid, nw); } }
        SEAM(pb + 6);
        if (EN(7) && IN(pb + 7)) { rwkv_finish(p, l);
            if ((NREP(7)) == 2) rwkv_finish(p, l); }
        SEAM(pb + 7);
        if (EN(8) && IN(pb + 8)) { { const int M = l == 0 ? NROW : NLAT; pg8::Gemm g{(const bf16_t*)(p.ws + WS_ABUF), (const bf16_t*)(p.ws + WS_WOUT), M, D, D}; pg8::StaticOrder S; S.init(M, D, G, (int)blockIdx.x);
            pg8::EpiBf16<0> E{(bf16_t*)(p.ws + U_Y), D, nullptr, 0, 0}; pg8::gemm_phase<pg8::EpiBf16<0>, pg8::StaticOrder, false>(lds, g, S, E, nullptr); }
            if ((NREP(8)) == 2) { const int M = l == 0 ? NROW : NLAT; pg8::Gemm g{(const bf16_t*)(p.ws + WS_ABUF), (const bf16_t*)(p.ws + WS_WOUT), M, D, D}; pg8::StaticOrder S; S.init(M, D, G, (int)blockIdx.x);
            pg8::EpiBf16<0> E{(bf16_t*)(p.ws + U_Y), D, nullptr, 0, 0}; pg8::gemm_phase<pg8::EpiBf16<0>, pg8::StaticOrder, false>(lds, g, S, E, nullptr); } }
        SEAM(pb + 8);
        if (EN(9) && IN(pb + 9)) { phase_normrouter(p, l, xl, xc, lds);
            if ((NREP(9)) == 2) phase_normrouter(p, l, xl, xc, lds); }
        SEAM(pb + 9);
        if (EN(10) && IN(pb + 10)) { phase_topk(p, l, lds);
            if ((NREP(10)) == 2) phase_topk(p, l, lds); }
        SEAM(pb + 10);
        if (EN(11) && IN(pb + 11)) { { pg8::Gemm g{(const bf16_t*)(p.ws + U_XSEL), (const bf16_t*)(p.ws + WS_WGU), 16 * XROWS, 16 * 5632, D / 2}; GroupedOrder S; S.init(l == 0 ? 18 : 16, 22, 2, G, (int)blockIdx.x);
            EpiSwiGLU E{(bf16_t*)(p.ws + U_HID), (const float*)(p.ws + WS_SXS), (const float*)(p.ws + WS_SW8)}; pg8::gemm_phase<EpiSwiGLU, GroupedOrder, false, true>(lds, g, S, E, nullptr); }
            if ((NREP(11)) == 2) { pg8::Gemm g{(const bf16_t*)(p.ws + U_XSEL), (const bf16_t*)(p.ws + WS_WGU), 16 * XROWS, 16 * 5632, D / 2}; GroupedOrder S; S.init(l == 0 ? 18 : 16, 22, 2, G, (int)blockIdx.x);
            EpiSwiGLU E{(bf16_t*)(p.ws + U_HID), (const float*)(p.ws + WS_SXS), (const float*)(p.ws + WS_SW8)}; pg8::gemm_phase<EpiSwiGLU, GroupedOrder, false, true>(lds, g, S, E, nullptr); } }
        SEAM(pb + 11);
        if (EN(12) && IN(pb + 12)) { { pg8::Gemm g{(const bf16_t*)(p.ws + U_HID), (const bf16_t*)(p.ws + WS_WD), 16 * XROWS, 16 * 1024, DE}; GroupedOrder S; S.init(l == 0 ? 18 : 16, 4, 4, G, (int)blockIdx.x);
            EpiGate E{(bf16_t*)(p.ws + U_YEXP), (const float*)(p.ws + WS_SELG)}; pg8::gemm_phase<EpiGate, GroupedOrder, false>(lds, g, S, E, nullptr); }
            if ((NREP(12)) == 2) { pg8::Gemm g{(const bf16_t*)(p.ws + U_HID), (const bf16_t*)(p.ws + WS_WD), 16 * XROWS, 16 * 1024, DE}; GroupedOrder S; S.init(l == 0 ? 18 : 16, 4, 4, G, (int)blockIdx.x);
            EpiGate E{(bf16_t*)(p.ws + U_YEXP), (const float*)(p.ws + WS_SELG)}; pg8::gemm_phase<EpiGate, GroupedOrder, false>(lds, g, S, E, nullptr); } }
        SEAM(pb + 12);
        if (EN(13) && IN(pb + 13)) { { phase_combine(p, l); if (l == 0) convert_weights(p, 1, lds, (int)blockIdx.x, G); }
            if (((l == 0 ? NREP(13) : 1)) == 2) { phase_combine(p, l); if (l == 0) convert_weights(p, 1, lds, (int)blockIdx.x, G); } }
        SEAM(pb + 13);
}
__global__ void __launch_bounds__(NTHR, 2) fwd(Params p) {
    extern __shared__ __attribute__((aligned(16))) unsigned char lds_raw[];
    LAS unsigned char* lds = (LAS unsigned char*)lds_raw;
    const int tid = threadIdx.x;
    if (tid < 4) ((LAS unsigned*)(lds + LDS_MISC))[tid] = 0u;
    __syncthreads();
    XcdBarrier bar; bar.bar = (unsigned*)(p.ws + WS_CTL); bar.x = 0; bar.st = (volatile LAS unsigned*)(lds + LDS_MISC);
    if (p.use_bar) bar = xcd_barrier_post((unsigned*)(p.ws + WS_CTL), (volatile LAS unsigned*)(lds + LDS_MISC));
    const int lo = p.ph_lo, hi = p.ph_hi;

    if (EN(100) && IN(0)) { { phase_prologue(p, lds); }
        if ((NREP(14)) == 2) { phase_prologue(p, lds); } }
    SEAM(0);
    layer_phases<0>(p, lds, bar, lo, hi);
    layer_phases<1>(p, lds, bar, lo, hi);
#undef IN
#undef SEAM
}
}

#ifndef MK_ONE_LAUNCH
#define MK_ONE_LAUNCH 1
#endif
extern "C" void kernel_launch(void* const* d_in, const int* in_sizes, int n_in, void* d_out, int out_size, void* d_ws, size_t ws_size, hipStream_t stream) {
    static int grid = 0;
    if (grid == 0) {
        if (n_in != 35 || out_size != mk::NLAT * mk::D || ws_size < mk::WS_END) { fprintf(stderr, "kernel_launch: unexpected problem (n_in %d, out %d, ws %zu < %zu)\n", n_in, out_size, ws_size, (size_t)mk::WS_END); grid = -1; return; }
        int dev = 0, cus = 0, per_cu = 0;
        if (hipGetDevice(&dev) != hipSuccess || hipDeviceGetAttribute(&cus, hipDeviceAttributeMultiprocessorCount, dev) != hipSuccess) { grid = -1; return; }
        if (hipFuncSetAttribute((const void*)mk::fwd, hipFuncAttributeMaxDynamicSharedMemorySize, mk::LDS_BYTES) != hipSuccess) { fprintf(stderr, "kernel_launch: hipFuncSetAttribute failed\n"); grid = -1; return; }
        if (hipOccupancyMaxActiveBlocksPerMultiprocessor(&per_cu, (const void*)mk::fwd, mk::NTHR, mk::LDS_BYTES) != hipSuccess || per_cu < 1) { fprintf(stderr, "kernel_launch: occupancy query says %d\n", per_cu); per_cu = 1; }
        (void)hipGetLastError();
        grid = cus;
    }
    if (grid < 0) return;
    (void)in_sizes;
    if (hipMemsetAsync(d_ws, 0, 65536, stream) != hipSuccess) return;
    mk::Params a{};
    for (int i = 0; i < 35; ++i) a.in[i] = (const float*)d_in[i];
    a.out = (float*)d_out; a.ws = (unsigned char*)d_ws;
#if MK_ONE_LAUNCH
    a.ph_lo = 0; a.ph_hi = mk::N_PHASES; a.use_bar = 1;
    hipLaunchKernelGGL(mk::fwd, dim3(grid), dim3(mk::NTHR), mk::LDS_BYTES, stream, a);
#else
    for (int ph = 0; ph < mk::N_PHASES; ++ph) { a.ph_lo = ph; a.ph_hi = ph + 1; a.use_bar = 0; hipLaunchKernelGGL(mk::fwd, dim3(grid), dim3(mk::NTHR), mk::LDS_BYTES, stream, a); }
#endif
}
```

```cpp
#include <hip/hip_runtime.h>
#include <cstdio>
#include <cstdint>
namespace pg8 {
#define PG8_LAS __attribute__((address_space(3)))
typedef unsigned short bf16_t;
typedef short bf16x8 __attribute__((ext_vector_type(8)));
typedef float f32x4 __attribute__((ext_vector_type(4)));
typedef unsigned u32x4 __attribute__((ext_vector_type(4)));
constexpr int BM = 256, BK = 64, HALF = 128, HTB = HALF * BK * 2  , STAGE_BYTES = 8 * HTB, NXCD = 8, WGM = 8;

__host__ __device__ __forceinline__ int lds_byte(int r, int c) { const int st = (r >> 4) * 2 + (c >> 5), rr = r & 15, cc = c & 31, ob = rr * 64 + cc * 2; return st * 1024 + (ob ^ (((ob >> 9) & 1) << 5)); }
__host__ __device__ __forceinline__ void stage_rc(int b, int& R, int& C) { const int st = b / 1024, sb = b % 1024, swz = sb ^ (((sb >> 9) & 1) << 5); R = (st >> 1) * 16 + swz / 64; C = (st & 1) * 32 + (swz % 64) / 2; }
__host__ __device__ __forceinline__ int perm32(int rho) { const int n = rho >> 4, i = rho & 15; return 8 * (i >> 2) + 4 * n + (i & 3); }

struct Unit { int pm, pn; };
struct Gemm { const bf16_t* A; const bf16_t* Bt; int M, N, K; };

struct StaticOrder {
    int nM, nN, nwg, G, c;
    __host__ __device__ void init(int M, int N, int G_, int c_) { nM = M / BM; nN = N / BM; nwg = nM * nN; G = G_; c = c_; }
    __host__ __device__ bool next(int i, Unit& u) const {
        const long L = (long)i * G + c; if (L >= nwg) return false;
        int wgid = (int)L; { const int q = nwg / NXCD, r = nwg % NXCD, xcd = wgid % NXCD, off = wgid / NXCD; wgid = (xcd < r ? xcd * (q + 1) : r * (q + 1) + (xcd - r) * q) + off; }
        const int nig = WGM * nN, gid = wgid / nig, fm = gid * WGM, gsz = (nM - fm) < WGM ? (nM - fm) : WGM;
        u.pm = fm + ((wgid % nig) % gsz); u.pn = (wgid % nig) / gsz; return true;
    }
    __device__ __forceinline__ void a_ready(const Unit&) const {}
    __device__ __forceinline__ void done(const Unit&) const {}
};
struct CountedOrder : StaticOrder {
    const unsigned* ready; unsigned need; unsigned* tmo;
    __device__ __forceinline__ void a_ready(const Unit& u) const {
        if (threadIdx.x < 64) {
            const unsigned long long t0 = __builtin_amdgcn_s_memrealtime(); unsigned polls = 0;
            while ((unsigned)__builtin_amdgcn_readfirstlane(__hip_atomic_load(ready + 64 * u.pm, __ATOMIC_RELAXED, __HIP_MEMORY_SCOPE_AGENT)) < need) {
                if ((++polls & 255u) == 0u && __builtin_amdgcn_readfirstlane(__hip_atomic_load(tmo, __ATOMIC_RELAXED, __HIP_MEMORY_SCOPE_AGENT)) != 0u) break;
                if (__builtin_amdgcn_s_memrealtime() - t0 > 2000000ull) {
                    if (threadIdx.x == 0) { unsigned expect = 0u; __hip_atomic_compare_exchange_strong(tmo + 1, &expect, 0x600u | (unsigned)(u.pm & 0xff), __ATOMIC_RELAXED, __ATOMIC_RELAXED, __HIP_MEMORY_SCOPE_AGENT); __hip_atomic_store(tmo, 1u, __ATOMIC_RELAXED, __HIP_MEMORY_SCOPE_AGENT); }
                    break; }
                __builtin_amdgcn_s_sleep(2); }
            __builtin_amdgcn_fence(__ATOMIC_ACQUIRE, "agent");
            asm volatile("s_waitcnt vmcnt(0)" ::: "memory");
        }
#if !defined(BROKEN_HOOK_NO_BARRIER)
        asm volatile("" ::: "memory"); __builtin_amdgcn_s_barrier(); asm volatile("" ::: "memory");
#endif
    }
};

__device__ __forceinline__ unsigned cvt_pk_bf16(float lo, float hi) { unsigned r; asm volatile("v_cvt_pk_bf16_f32 %0, %1, %2" : "=v"(r) : "v"(lo), "v"(hi)); return r; }
typedef float f32x2 __attribute__((ext_vector_type(2)));
__device__ __forceinline__ f32x2 gelu_pk(f32x2 v) {
    const f32x2 av = __builtin_elementwise_abs(v), d = av * 0.2316418882f + 1.0f;
    f32x2 t; t.x = __builtin_amdgcn_rcpf(d.x); t.y = __builtin_amdgcn_rcpf(d.y);
    f32x2 q = t * 0.5307027145f + (-0.7265760135f); q = q * t + 0.7107068705f; q = q * t + (-0.142248368f); q = q * t + 0.127414796f; q = q * t;
    const f32x2 s = (v * v) * (-0.72134752044f);
    f32x2 e; e.x = __builtin_amdgcn_exp2f(s.x); e.y = __builtin_amdgcn_exp2f(s.y);
    const f32x2 m = v * (q * e), r = v - m;
    f32x2 o; o.x = v.x < 0.f ? m.x : r.x; o.y = v.y < 0.f ? m.y : r.y; return o;
}

struct EpiF32 {
    static constexpr bool PERM = false, AFTER_DRAIN = false;
    float* C; int ldc; const float* bias;
    __device__ __forceinline__ void operator()(const f32x4 (&acc)[2][2][4][2], const Unit& u, int wr, int wc, int fr, int fq) const {
        const int row0 = u.pm * BM + wr * 64 + fr, col0 = u.pn * BM + wc * 32 + 4 * fq;
        f32x4 bv[2][2];
#pragma unroll
        for (int bj = 0; bj < 2; ++bj)
#pragma unroll
            for (int n = 0; n < 2; ++n) bv[bj][n] = bias ? *(const f32x4*)(bias + col0 + bj * HALF + n * 16) : (f32x4){0.f, 0.f, 0.f, 0.f};
#pragma unroll
        for (int ai = 0; ai < 2; ++ai)
#pragma unroll
            for (int m = 0; m < 4; ++m) { float* rowp = C + (size_t)(row0 + ai * HALF + m * 16) * ldc + col0;
#pragma unroll
                for (int bj = 0; bj < 2; ++bj)
#pragma unroll
                    for (int n = 0; n < 2; ++n) *(f32x4*)(rowp + bj * HALF + n * 16) = acc[ai][bj][m][n] + bv[bj][n]; }
    }
};
template <int ACT  > struct EpiBf16 {
    static constexpr bool PERM = true, AFTER_DRAIN = false;
    bf16_t* O; int ldc; const float* bias; int split_cols; size_t split_stride;
    __device__ __forceinline__ void operator()(const f32x4 (&acc)[2][2][4][2], const Unit& u, int wr, int wc, int fr, int fq) const {
        const int row0 = u.pm * BM + wr * 64 + fr; int colt = u.pn * BM; bf16_t* base = O;
        if (split_cols) { const int t = colt / split_cols; base += (size_t)t * split_stride; colt -= t * split_cols; }
        const int col0 = colt + wc * 32 + 8 * fq, bcol0 = u.pn * BM + wc * 32 + 8 * fq;
        f32x4 bv[2][2];
#pragma unroll
        for (int bj = 0; bj < 2; ++bj)
#pragma unroll
            for (int n = 0; n < 2; ++n) bv[bj][n] = bias ? *(const f32x4*)(bias + bcol0 + bj * HALF + 4 * n) : (f32x4){0.f, 0.f, 0.f, 0.f};
#pragma unroll
        for (int ai = 0; ai < 2; ++ai)
#pragma unroll
            for (int m = 0; m < 4; ++m) { bf16_t* rowp = base + (size_t)(row0 + ai * HALF + m * 16) * ldc + col0;
#pragma unroll
                for (int bj = 0; bj < 2; ++bj) { f32x4 v0 = acc[ai][bj][m][0] + bv[bj][0], v1 = acc[ai][bj][m][1] + bv[bj][1];
                    if (ACT == 1) { f32x2 a = gelu_pk((f32x2){v0[0], v0[1]}), b = gelu_pk((f32x2){v0[2], v0[3]}), c = gelu_pk((f32x2){v1[0], v1[1]}), d = gelu_pk((f32x2){v1[2], v1[3]});
                        v0 = (f32x4){a.x, a.y, b.x, b.y}; v1 = (f32x4){c.x, c.y, d.x, d.y}; }
                    if (ACT == 2) {
#pragma unroll
                        for (int j = 0; j < 4; ++j) { v0[j] = 0.5f * v0[j] * (1.0f + erff(v0[j] * 0.70710678f)); v1[j] = 0.5f * v1[j] * (1.0f + erff(v1[j] * 0.70710678f)); } }
                    u32x4 w; w.x = cvt_pk_bf16(v0[0], v0[1]); w.y = cvt_pk_bf16(v0[2], v0[3]); w.z = cvt_pk_bf16(v1[0], v1[1]); w.w = cvt_pk_bf16(v1[2], v1[3]);
                    *(u32x4*)(rowp + bj * HALF) = w; } }
    }
};

template <int MODE> __device__ __forceinline__ f32x4 pg8_mma(bf16x8 a, bf16x8 b, f32x4 c) {
    if constexpr (MODE == 1) { typedef int i32x4_ __attribute__((ext_vector_type(4))); return __builtin_bit_cast(f32x4, __builtin_amdgcn_mfma_i32_16x16x64_i8(__builtin_bit_cast(i32x4_, a), __builtin_bit_cast(i32x4_, b), __builtin_bit_cast(i32x4_, c), 0, 0, 0)); }
    else return __builtin_amdgcn_mfma_f32_16x16x32_bf16(a, b, c, 0, 0, 0); }
__device__ __forceinline__ f32x4 pg8_mma8(bf16x8 a0, bf16x8 a1, bf16x8 b0, bf16x8 b1, f32x4 c) {
    typedef int i32x4_ __attribute__((ext_vector_type(4))); typedef int i32x8_ __attribute__((ext_vector_type(8)));
    const i32x8_ A = __builtin_shufflevector(__builtin_bit_cast(i32x4_, a0), __builtin_bit_cast(i32x4_, a1), 0, 1, 2, 3, 4, 5, 6, 7), B = __builtin_shufflevector(__builtin_bit_cast(i32x4_, b0), __builtin_bit_cast(i32x4_, b1), 0, 1, 2, 3, 4, 5, 6, 7);
    const int one = 0x7f7f7f7f;
    asm volatile("v_mfma_scale_f32_16x16x128_f8f6f4 %0, %1, %2, %0, %3, %3 op_sel_hi:[0,0,0]" : "+v"(c) : "v"(A), "v"(B), "v"(one));
    return c; }
__device__ __forceinline__ void fp8_acc_settle() { asm volatile("s_nop 7\n\ts_nop 7\n\ts_nop 7" ::: "memory"); }
template <class Epi, class Sched, bool STAMP = false, int MODE = 0>
__device__ __forceinline__ void gemm_phase(PG8_LAS unsigned char* lds, const Gemm g, const Sched& S, const Epi& E, unsigned long long* stamps) {
    const int tid = threadIdx.x, wid = __builtin_amdgcn_readfirstlane(tid >> 6), lane = tid & 63, wr = wid >> 2, wc = wid & 3, fr = lane & 15, fq = lane >> 4;
    const int K = g.K, nt = K / BK;
    int ts_lo = 0, ts_hi = 0, nts = 0; const unsigned long long rt_entry = STAMP ? (unsigned long long)wall_clock64() : 0ull;
#define PG8_STAMP() do { if (STAMP && wid == 0 && nts < 64) { const unsigned long long _c = (unsigned long long)clock64(); \
        ts_lo = (lane == nts) ? (int)(unsigned)_c : ts_lo; ts_hi = (lane == nts) ? (int)(unsigned)(_c >> 32) : ts_hi; ++nts; } } while (0)
    PG8_STAMP();
    unsigned voffA[2], voffB[2];
#pragma unroll
    for (int i = 0; i < 2; ++i) { int R, C; stage_rc(tid * 16 + i * 8192, R, C); const int Rb = Epi::PERM ? ((R & ~31) + perm32(R & 31)) : R;
        voffA[i] = (unsigned)(R * K + C) * 2u; voffB[i] = (unsigned)(Rb * K + C) * 2u; }
    const size_t kstep = (size_t)(BK * 2);
    const size_t hstep = (size_t)HALF * K * 2;
    const size_t tstep = 2 * hstep;
    const unsigned ldsw = (unsigned)wid * 1024u;
    const int aoff = lds_byte(wr * 64 + fr, fq * 8), boff = lds_byte(wc * 32 + fr, fq * 8);
#define PG8_SA(b, h) (((b) * 2 + (h)) * HTB)
#define PG8_SB(b, h) ((4 + (b) * 2 + (h)) * HTB)
#define PG8_STAGE(bufoff, gbase, voff) do { _Pragma("unroll") for (int _i = 0; _i < 2; ++_i) \
        __builtin_amdgcn_global_load_lds((const unsigned*)((const char*)(gbase) + (voff)[_i]), (PG8_LAS unsigned*)(lds + (bufoff) + ldsw + _i * 8192), 16, 0, 0); } while (0)
#define PG8_LDA(dst, b, h) do { _Pragma("unroll") for (int m = 0; m < 4; ++m) _Pragma("unroll") for (int k = 0; k < 2; ++k) dst[m][k] = *(const PG8_LAS bf16x8*)(lds + PG8_SA(b, h) + aoff + m * 2048 + k * 1024); } while (0)
#define PG8_LDB(dst, b, h) do { _Pragma("unroll") for (int n = 0; n < 2; ++n) _Pragma("unroll") for (int k = 0; k < 2; ++k) dst[n][k] = *(const PG8_LAS bf16x8*)(lds + PG8_SB(b, h) + boff + n * 2048 + k * 1024); } while (0)
#define PG8_MMA(ai, bj, At, Bt) do { __builtin_amdgcn_s_setprio(1); _Pragma("unroll") for (int m = 0; m < 4; ++m) _Pragma("unroll") for (int n = 0; n < 2; ++n) { if constexpr (MODE == 2) acc[ai][bj][m][n] = pg8_mma8(Bt[n][0], Bt[n][1], At[m][0], At[m][1], acc[ai][bj][m][n]); else { _Pragma("unroll") for (int k = 0; k < 2; ++k) \
        acc[ai][bj][m][n] = pg8_mma<MODE>(Bt[n][k], At[m][k], acc[ai][bj][m][n]); } } __builtin_amdgcn_s_setprio(0); } while (0)
#define PG8_WAIT_V(n) asm volatile("s_waitcnt vmcnt(" #n ")" ::: "memory")
#define PG8_WAIT_L(n) asm volatile("s_waitcnt lgkmcnt(" #n ")" ::: "memory")
#define PG8_BAR __builtin_amdgcn_s_barrier()
#define PG8_SCHED __builtin_amdgcn_sched_barrier(0)
    Unit cur, nxt; int ui = 0;
    if (!S.next(0, cur)) return;
    f32x4 acc[2][2][4][2];
#pragma unroll
    for (int a = 0; a < 2; ++a)
#pragma unroll
        for (int b = 0; b < 2; ++b)
#pragma unroll
            for (int m = 0; m < 4; ++m)
#pragma unroll
                for (int n = 0; n < 2; ++n) acc[a][b][m][n] = (f32x4){0.f, 0.f, 0.f, 0.f};
    bf16x8 At[4][2], B0[2][2], B1[2][2];
    const char* cA = (const char*)g.A + (size_t)cur.pm * tstep; const char* cB = (const char*)g.Bt + (size_t)cur.pn * tstep;
    S.a_ready(cur);
    PG8_STAGE(PG8_SB(0, 0), cB, voffB); PG8_STAGE(PG8_SA(0, 0), cA, voffA); PG8_STAGE(PG8_SB(0, 1), cB + hstep, voffB); PG8_STAGE(PG8_SA(0, 1), cA + hstep, voffA);
    if (wr == 1) PG8_BAR;
    PG8_WAIT_V(4); PG8_BAR;
    PG8_STAGE(PG8_SB(1, 0), cB + kstep, voffB); PG8_STAGE(PG8_SA(1, 0), cA + kstep, voffA); PG8_STAGE(PG8_SB(1, 1), cB + hstep + kstep, voffB);
    PG8_WAIT_V(6); PG8_BAR;
    PG8_STAMP();
    for (;;) {
        const bool has_next = S.next(ui + 1, nxt);
        const char* nA = has_next ? (const char*)g.A + (size_t)nxt.pm * tstep : cA; const char* nB = has_next ? (const char*)g.Bt + (size_t)nxt.pn * tstep : cB;
        for (int t = 0; t < nt; t += 2) {
            const bool last = (t == nt - 2);
            const char* a1 = cA + (size_t)(t + 1) * kstep;
            const char* a2 = last ? nA : cA + (size_t)(t + 2) * kstep; const char* b2 = last ? nB : cB + (size_t)(t + 2) * kstep;
            const char* a3 = a2 + kstep; const char* b3 = b2 + kstep;
            if (last && has_next) S.a_ready(nxt);
            PG8_LDB(B0, 0, 0); PG8_SCHED; PG8_LDA(At, 0, 0); PG8_STAGE(PG8_SA(1, 1), a1 + hstep, voffA);
            PG8_WAIT_L(8); PG8_BAR; PG8_WAIT_L(0); PG8_MMA(0, 0, At, B0); PG8_BAR; PG8_SCHED;
            PG8_LDB(B1, 0, 1); PG8_STAGE(PG8_SB(0, 0), b2, voffB);
            PG8_BAR; PG8_WAIT_L(0); PG8_MMA(0, 1, At, B1); PG8_BAR;
            PG8_LDA(At, 0, 1); PG8_STAGE(PG8_SA(0, 0), a2, voffA);
            PG8_BAR; PG8_WAIT_L(0); PG8_MMA(1, 0, At, B0); PG8_BAR; PG8_SCHED;
            PG8_STAGE(PG8_SB(0, 1), b2 + hstep, voffB);
            PG8_WAIT_V(6); PG8_BAR; PG8_MMA(1, 1, At, B1); PG8_BAR;
            PG8_LDB(B0, 1, 0); PG8_SCHED; PG8_LDA(At, 1, 0); PG8_STAGE(PG8_SA(0, 1), a2 + hstep, voffA);
            PG8_WAIT_L(8); PG8_BAR; PG8_WAIT_L(0); PG8_MMA(0, 0, At, B0); PG8_BAR; PG8_SCHED;
            PG8_LDB(B1, 1, 1); PG8_STAGE(PG8_SB(1, 0), b3, voffB);
            PG8_BAR; PG8_WAIT_L(0); PG8_MMA(0, 1, At, B1); PG8_BAR;
            PG8_LDA(At, 1, 1); PG8_STAGE(PG8_SA(1, 0), a3, voffA);
            PG8_BAR; PG8_WAIT_L(0); PG8_MMA(1, 0, At, B0); PG8_BAR; PG8_SCHED;
            PG8_STAGE(PG8_SB(1, 1), b3 + hstep, voffB);
            PG8_WAIT_V(6); PG8_BAR; PG8_MMA(1, 1, At, B1); PG8_BAR;
        }
        PG8_STAMP();
        if constexpr (!Epi::AFTER_DRAIN) { E(acc, cur, wr, wc, fr, fq); S.done(cur); }
        PG8_STAMP();
        if (!has_next) break;
#pragma unroll
        for (int a = 0; a < 2; ++a)
#pragma unroll
            for (int b = 0; b < 2; ++b)
#pragma unroll
                for (int m = 0; m < 4; ++m)
#pragma unroll
                    for (int n = 0; n < 2; ++n) acc[a][b][m][n] = (f32x4){0.f, 0.f, 0.f, 0.f};
        cur = nxt; cA = nA; cB = nB; ++ui;
    }
    PG8_WAIT_V(0);
    if (wr == 0) PG8_BAR;
    PG8_BAR;
    if constexpr (Epi::AFTER_DRAIN) { E.fused(acc, cur, wr, wc, fr, fq, lds, wid, lane); S.done(cur); }
    PG8_STAMP();
    if (STAMP && wid == 0) { stamps[lane] = lane < nts ? (((unsigned long long)(unsigned)ts_hi << 32) | (unsigned)ts_lo) : 0ull;
        if (lane == 62) stamps[62] = rt_entry; if (lane == 63) stamps[63] = (unsigned long long)wall_clock64(); }
#undef PG8_STAMP
#undef PG8_SA
#undef PG8_SB
#undef PG8_STAGE
#undef PG8_LDA
#undef PG8_LDB
#undef PG8_MMA
#undef PG8_WAIT_V
#undef PG8_WAIT_L
#undef PG8_BAR
#undef PG8_SCHED
}
}
#define XB_TMO      128
#define XB_XCNT(j)  (256  + 64 * (j))
#define XB_XSUB(j)  (1280 + 64 * (j))
#define XB_XGEN(j)  (2304 + 64 * (j))
#define XB_TOP      3328
#define XB_TOPGEN   3392
#define XCD_BAR_WORDS 3456
#define XB_SPIN_CAP (1u << 18)
#define LAS __attribute__((address_space(3)))

__device__ __forceinline__ unsigned xb_ld(unsigned* p)              { return __hip_atomic_load(p, __ATOMIC_RELAXED, __HIP_MEMORY_SCOPE_AGENT); }
__device__ __forceinline__ unsigned xb_add(unsigned* p, unsigned v) { return __hip_atomic_fetch_add(p, v, __ATOMIC_RELAXED, __HIP_MEMORY_SCOPE_AGENT); }
__device__ __forceinline__ unsigned xb_xcc_id() { return (unsigned)__builtin_amdgcn_s_getreg((3 << 11) | 20) & 0xFu; }
#define XB_SPIN(cond, bar) do { unsigned _sp = 0; while (cond) { __builtin_amdgcn_s_sleep(1); \
    if ((++_sp & 255u) == 0u) { if (xb_ld(&(bar)[XB_TMO])) break; if (_sp > XB_SPIN_CAP) { atomicAdd(&(bar)[XB_TMO], 1u); break; } } } } while (0)

struct XcdBarrier {
    unsigned* bar; unsigned x;
    volatile LAS unsigned* st;
};

__device__ __forceinline__ XcdBarrier xcd_barrier_post(unsigned* bar, volatile LAS unsigned* st) {
    XcdBarrier b; b.bar = bar; b.x = xb_xcc_id(); b.st = st;
    if (threadIdx.x == 0) (void)xb_add(&bar[XB_XCNT(b.x)], 1u);
    return b;
}
__device__ __forceinline__ void xcd_barrier_complete(unsigned* bar, unsigned x, unsigned& nloc, unsigned& nx) {
    const unsigned G = gridDim.x * gridDim.y * gridDim.z;
    unsigned sum, cnt, mine, sp = 0u;
    for (;;) {
        sum = 0u; cnt = 0u; mine = 0u;
#pragma unroll
        for (unsigned j = 0; j < 16; ++j) { const unsigned c = xb_ld(&bar[XB_XCNT(j)]); sum += c; cnt += (c > 0u) ? 1u : 0u; mine = (j == x) ? c : mine; }
        if (sum == G) break;
        __builtin_amdgcn_s_sleep(1);
        if ((++sp & 255u) == 0u) { if (xb_ld(&bar[XB_TMO])) break; if (sp > XB_SPIN_CAP) { atomicAdd(&bar[XB_TMO], 1u); break; } }
    }
    nloc = mine > 0u ? mine : 1u; nx = cnt > 0u ? cnt : 1u;
}

__device__ __forceinline__ void xcd_barrier(const XcdBarrier& b) {
    asm volatile("s_waitcnt vmcnt(0)" ::: "memory");
    __syncthreads();
    if (threadIdx.x == 0) {
        unsigned* bar = b.bar;
        __builtin_amdgcn_s_waitcnt(0);
        unsigned nloc = b.st[0], nx = b.st[1];
        if (nloc == 0u) { xcd_barrier_complete(bar, b.x, nloc, nx); b.st[0] = nloc; b.st[1] = nx; }
        const unsigned old = xb_add(&bar[XB_XSUB(b.x)], 1u);
        const unsigned gen = old / nloc;
        if (old + 1u == (gen + 1u) * nloc) {
            __builtin_amdgcn_fence(__ATOMIC_RELEASE, "agent");
            asm volatile("s_waitcnt vmcnt(0)" ::: "memory");
            const unsigned og = xb_add(&bar[XB_TOP], 1u);
            const unsigned tg = og / nx;
            if (og + 1u == (tg + 1u) * nx) xb_add(&bar[XB_TOPGEN], 1u);
            else XB_SPIN(xb_ld(&bar[XB_TOPGEN]) == tg, bar);
            __builtin_amdgcn_fence(__ATOMIC_ACQUIRE, "agent");
            xb_add(&bar[XB_XGEN(b.x)], 1u);
            asm volatile("s_waitcnt vmcnt(0)" ::: "memory");
        } else {
            XB_SPIN(xb_ld(&bar[XB_XGEN(b.x)]) == gen, bar);
            __builtin_amdgcn_fence(__ATOMIC_ACQUIRE, "agent");
            asm volatile("s_waitcnt vmcnt(0)" ::: "memory");
        }
    }
    __syncthreads();
}

namespace mk {
using pg8::bf16_t; using pg8::bf16x8; using pg8::f32x4; using pg8::u32x4;
typedef unsigned u32x2 __attribute__((ext_vector_type(2)));
typedef short bf16x4 __attribute__((ext_vector_type(4)));
typedef float lf2 __attribute__((ext_vector_type(2)));
typedef float lf4 __attribute__((ext_vector_type(4)));
typedef unsigned lu4 __attribute__((ext_vector_type(4)));

constexpr int D = 1024, NBATCH = 16, SEQ = 2048, CTXL = 256;
constexpr int NLAT = NBATCH * SEQ, NCTX = NBATCH * CTXL, NROW = NLAT + NCTX;
constexpr int NINP = 3072, NIN = 2944;
constexpr int C_Q = 256, C_K = 640, C_V = 1024, C_Z = 1408;
constexpr int DE = 2816;
constexpr int XROWS = 4608;
constexpr int NTHR = 512;
constexpr int LDS_MISC = 131072, LDS_BYTES = 131072 + 256;

constexpr size_t al256(size_t x) { return (x + 255) & ~(size_t)255; }
constexpr size_t WS_CTL = 0;
constexpr size_t WS_MOD = 65536;
constexpr size_t WS_SW = al256(WS_MOD + (size_t)2 * 17 * 6144 * 4);
constexpr size_t SW_W2T = 0, SW_A2T = 98304, SW_G2T = 196608, SW_GLUT = 294912, SW_S5E = 425984, SW_S5W2 = 2523136, SW_STRIDE = 6717440;
constexpr size_t WS_WIN = al256(WS_SW + 2 * SW_STRIDE);
constexpr size_t WS_WOUT = WS_WIN + (size_t)3072 * 1024 * 2;
constexpr size_t WS_WGU = WS_WOUT + (size_t)1024 * 1024 * 2;
constexpr size_t WS_WD = WS_WGU + (size_t)16 * 5632 * 1024 * 2;
constexpr size_t WS_XB = WS_WD + (size_t)16 * 1024 * 2816 * 2;
constexpr size_t WS_CTXA = WS_XB + (size_t)NLAT * D * 4;
constexpr size_t WS_CTXB = WS_CTXA + (size_t)NCTX * D * 4;
constexpr size_t WS_ABUF = WS_CTXB + (size_t)NCTX * D * 4;
constexpr size_t WS_AFF = WS_ABUF + (size_t)NROW * D * 2;
constexpr size_t WS_SLOT = WS_AFF + (size_t)NROW * 16 * 4;
constexpr size_t WS_SELG = WS_SLOT + (size_t)NROW * 16 * 4;
constexpr size_t WS_SW8 = al256(WS_SELG + (size_t)16 * XROWS * 4);
constexpr size_t WS_SX = WS_SW8 + (size_t)16 * 5632 * 4;
constexpr size_t WS_SXS = WS_SX + (size_t)NROW * 4;
constexpr size_t WS_SWIN = WS_SXS + (size_t)16 * XROWS * 4;
constexpr size_t WS_SH = WS_SWIN + (size_t)3072 * 4;
constexpr size_t WS_SWD = WS_SH + (size_t)NROW * 4;
constexpr size_t WS_U = al256(WS_SWD + (size_t)16 * 1024 * 4);
constexpr size_t SZ384 = (size_t)NROW * 384 * 2;
constexpr size_t U_P = WS_U;
constexpr size_t U_QR = U_P + (size_t)NROW * NINP * 2;
constexpr size_t U_KR = U_QR + SZ384;
constexpr size_t U_VT = U_KR + SZ384;
constexpr size_t U_VTC = U_VT + (size_t)16 * 384 * 2048 * 2;
constexpr size_t U_RS = U_VT + SZ384;
constexpr size_t U_KS = U_RS + SZ384;
constexpr size_t U_VS = U_KS + SZ384;
constexpr size_t U_KK = U_VS + SZ384;
constexpr size_t U_ALR = U_KK + SZ384;
constexpr size_t U_LD = U_ALR + SZ384;
constexpr size_t U_AG = U_LD + 2 * SZ384;
constexpr size_t U_G = U_AG + 2 * SZ384;
constexpr size_t U_YRK = U_G + SZ384;
constexpr size_t U_SLOC = U_YRK + 2 * (size_t)NROW * 384 * 4;
constexpr size_t U_SPREV = U_SLOC + (size_t)2304 * 16 * 256 * 4;
constexpr size_t U_YG = U_SPREV + (size_t)2304 * 16 * 256 * 2;
constexpr size_t U_U16 = U_YG + (size_t)NROW * 256 * 2;
constexpr size_t U_MIX_END = U_U16 + (size_t)NROW * 256 * 2;
constexpr int NCHUNK = 192 * 144;
constexpr size_t CH_XP = U_P;
constexpr size_t CH_BK = CH_XP + (size_t)NCHUNK * 4096;
constexpr size_t CH_UL = CH_BK + (size_t)NCHUNK * 4096;
constexpr size_t CH_MM = U_SLOC;
constexpr size_t CH_GT = CH_MM + (size_t)NCHUNK * 1024;
static_assert(CH_UL + (size_t)NCHUNK * 2048 <= U_RS, "chunk buffers overlap live RWKV operands");
static_assert(CH_GT + (size_t)NCHUNK * 256 <= U_SPREV, "chunk buffers overlap S5 states");
constexpr size_t U_Y = WS_U;
constexpr size_t U_XSEL = U_Y + (size_t)NROW * D * 4;
constexpr size_t U_HID = U_XSEL + (size_t)16 * XROWS * 1024 * 2;
constexpr size_t U_YEXP = U_HID + (size_t)16 * XROWS * DE * 2;
constexpr size_t U_FFN_END = U_YEXP + (size_t)16 * XROWS * 1024 * 2;
constexpr size_t WS_END = U_MIX_END > U_FFN_END ? U_MIX_END : U_FFN_END;

struct Params { const float* in[35]; float* out; unsigned char* ws; int ph_lo, ph_hi, use_bar, pad; };

typedef __bf16 hwbf2 __attribute__((ext_vector_type(2)));
__device__ __forceinline__ unsigned pack2(float lo, float hi) { const lf2 v = {lo, hi}; return __builtin_bit_cast(unsigned, __builtin_convertvector(v, hwbf2)); }
__device__ __forceinline__ bf16_t f2bf(float f) { return (bf16_t)(pack2(f, 0.f) & 0xffffu); }
__device__ __forceinline__ float bflo(unsigned w) { return __uint_as_float(w << 16); }
__device__ __forceinline__ float bfhi(unsigned w) { return __uint_as_float(w & 0xffff0000u); }
__device__ __forceinline__ float bf2f(bf16_t b) { return __uint_as_float(((unsigned)b) << 16); }
__device__ __forceinline__ float sigm(float x) { return 1.0f / (1.0f + __expf(-x)); }
__device__ __forceinline__ float wave_sum(float v) {
#pragma unroll
    for (int o = 32; o >= 1; o >>= 1) v += __shfl_xor(v, o);
    return v; }
__device__ __forceinline__ void unpack8(const uint4 w, float (&f)[8]) { f[0] = bflo(w.x); f[1] = bfhi(w.x); f[2] = bflo(w.y); f[3] = bfhi(w.y); f[4] = bflo(w.z); f[5] = bfhi(w.z); f[6] = bflo(w.w); f[7] = bfhi(w.w); }
__device__ __forceinline__ uint4 pack8(const float (&f)[8]) { uint4 w; w.x = pack2(f[0], f[1]); w.y = pack2(f[2], f[3]); w.z = pack2(f[4], f[5]); w.w = pack2(f[6], f[7]); return w; }
__device__ __forceinline__ const float* xrow(const float* lat, const float* ctx, int r) { return r < NLAT ? lat + (size_t)r * D : ctx + (size_t)(r - NLAT) * D; }
__device__ __forceinline__ float* xrow_w(float* lat, float* ctx, int r) { return r < NLAT ? lat + (size_t)r * D : ctx + (size_t)(r - NLAT) * D; }
__device__ __forceinline__ f32x4 mfma16(bf16x8 a, bf16x8 b, f32x4 c) { return __builtin_amdgcn_mfma_f32_16x16x32_bf16(a, b, c, 0, 0, 0); }

__device__ __forceinline__ void tr_tile(const float* __restrict__ src, int ldsrc, int k0, int n0, bf16_t* __restrict__ dst, int lddst, int drow0, LAS unsigned* T) {
    const int tid = threadIdx.x, n4 = tid & 15, kq = tid >> 4;
    const float4 a = *(const float4*)(src + (size_t)(k0 + 2 * kq) * ldsrc + n0 + 4 * n4);
    const float4 b = *(const float4*)(src + (size_t)(k0 + 2 * kq + 1) * ldsrc + n0 + 4 * n4);
    T[(4 * n4 + 0) * 33 + kq] = pack2(a.x, b.x); T[(4 * n4 + 1) * 33 + kq] = pack2(a.y, b.y);
    T[(4 * n4 + 2) * 33 + kq] = pack2(a.z, b.z); T[(4 * n4 + 3) * 33 + kq] = pack2(a.w, b.w);
    __syncthreads();
    const int n = tid >> 3, pc = tid & 7;
    uint4 v; v.x = T[n * 33 + 4 * pc]; v.y = T[n * 33 + 4 * pc + 1]; v.z = T[n * 33 + 4 * pc + 2]; v.w = T[n * 33 + 4 * pc + 3];
    *(uint4*)(dst + (size_t)(drow0 + n) * lddst + k0 + 8 * pc) = v;
    __syncthreads();
}

__device__ __forceinline__ void tr_tile4(const float* __restrict__ src, int ldsrc, int k0, int n0, bf16_t* __restrict__ dst, int lddst, int drow0, LAS unsigned* T) {
    const int tid = threadIdx.x, n4 = tid & 15, kq = tid >> 4;
    float4 a[4], b[4];
#pragma unroll
    for (int t = 0; t < 4; ++t) { a[t] = *(const float4*)(src + (size_t)(k0 + 2 * kq) * ldsrc + n0 + 64 * t + 4 * n4); b[t] = *(const float4*)(src + (size_t)(k0 + 2 * kq + 1) * ldsrc + n0 + 64 * t + 4 * n4); }
#pragma unroll
    for (int t = 0; t < 4; ++t) { LAS unsigned* Tt = T + t * 64 * 33;
        Tt[(4 * n4 + 0) * 33 + kq] = pack2(a[t].x, b[t].x); Tt[(4 * n4 + 1) * 33 + kq] = pack2(a[t].y, b[t].y); Tt[(4 * n4 + 2) * 33 + kq] = pack2(a[t].z, b[t].z); Tt[(4 * n4 + 3) * 33 + kq] = pack2(a[t].w, b[t].w); }
    __syncthreads();
#pragma unroll
    for (int i = 0; i < 4; ++i) { const int idx = tid + NTHR * i, n = idx >> 3, pc = idx & 7;
        uint4 v; v.x = T[n * 33 + 4 * pc]; v.y = T[n * 33 + 4 * pc + 1]; v.z = T[n * 33 + 4 * pc + 2]; v.w = T[n * 33 + 4 * pc + 3];
        *(uint4*)(dst + (size_t)(drow0 + n) * lddst + k0 + 8 * pc) = v; }
    __syncthreads();
}
template <int NK, int DP, bool FP8> __device__ __forceinline__ void q8_strip(const float* __restrict__ src, int ldsrc, unsigned char* __restrict__ dst, float* __restrict__ scl, LAS unsigned char* lds) {
    LAS float* cmax = (LAS float*)lds;
    LAS unsigned char* T = lds + 8704;
    const int tid = threadIdx.x, n4 = tid & 15, kq = tid >> 4; constexpr float QMAX = FP8 ? 256.0f : 127.0f;
    float mx[4] = {0.f, 0.f, 0.f, 0.f};
#pragma unroll 8
    for (int i = 0; i < 2 * NK; ++i) { const float4 v = *(const float4*)(src + (size_t)(kq + 32 * i) * ldsrc + 4 * n4); mx[0] = fmaxf(mx[0], fabsf(v.x)); mx[1] = fmaxf(mx[1], fabsf(v.y)); mx[2] = fmaxf(mx[2], fabsf(v.z)); mx[3] = fmaxf(mx[3], fabsf(v.w)); }
    __syncthreads();
#pragma unroll
    for (int j = 0; j < 4; ++j) cmax[kq * 64 + 4 * n4 + j] = mx[j];
    __syncthreads();
    if (tid < 64) { float m = 0.f; for (int g = 0; g < 32; ++g) m = fmaxf(m, cmax[g * 64 + tid]); m = fmaxf(m, 1e-20f); scl[tid] = m * (1.0f / QMAX); cmax[32 * 64 + tid] = QMAX / m; }
    __syncthreads();
    float inv[4];
#pragma unroll
    for (int j = 0; j < 4; ++j) inv[j] = cmax[32 * 64 + 4 * n4 + j];
    for (int kg = 0; kg < NK / 4; ++kg) {
        float4 a[4], b[4];
#pragma unroll
        for (int t = 0; t < 4; ++t) { const int kb = (kg * 4 + t) * 64 + 2 * kq; a[t] = *(const float4*)(src + (size_t)kb * ldsrc + 4 * n4); b[t] = *(const float4*)(src + (size_t)(kb + 1) * ldsrc + 4 * n4); }
#pragma unroll
        for (int t = 0; t < 4; ++t) { const float av[4] = {a[t].x, a[t].y, a[t].z, a[t].w}, bv[4] = {b[t].x, b[t].y, b[t].z, b[t].w};
#pragma unroll
            for (int j = 0; j < 4; ++j) { unsigned short w;
                if (FP8) w = (unsigned short)(__builtin_amdgcn_cvt_pk_fp8_f32(av[j] * inv[j], bv[j] * inv[j], 0, false) & 0xffff);
                else { const int q0 = __float2int_rn(av[j] * inv[j]), q1 = __float2int_rn(bv[j] * inv[j]); w = (unsigned short)((q0 & 255) | ((q1 & 255) << 8)); }
                *(LAS unsigned short*)(T + (4 * n4 + j) * 272 + t * 64 + 2 * kq) = w; } }
        __syncthreads();
#pragma unroll
        for (int i = 0; i < 2; ++i) { const int idx = tid + NTHR * i, n = idx >> 4, pc = idx & 15; *(lu4*)(dst + (size_t)n * DP + kg * 256 + 16 * pc) = *(const LAS lu4*)(T + n * 272 + 16 * pc); }
        __syncthreads();
    }
}
__device__ __forceinline__ void gu_strip(const Params& p, int l, int item, LAS unsigned char* lds) {
    const int e = item / 88, rem = item % 88, up = rem / 44, nt = rem % 44, n0 = nt * 64, drow0 = (n0 >> 7) * 256 + (n0 & 127) + (up ? 128 : 0);
    q8_strip<16, 1024, false>(p.in[up ? 33 : 32] + (size_t)(l * 16 + e) * 1024 * DE + n0, DE, p.ws + WS_WGU + ((size_t)e * 5632 + drow0) * 1024, (float*)(p.ws + WS_SW8) + (size_t)e * 5632 + drow0, lds);
}
constexpr int CV_GU = 16 * 88, CV_D4 = 16 * 16, CV_WIN = 46, CV_PAD = 16, CV_WOUT4 = 16 * 4, CV_TOTAL = CV_GU + CV_D4 + CV_WIN + CV_PAD + CV_WOUT4;
__device__ __forceinline__ void convert_weights(const Params& p, int l, LAS unsigned char* lds, int vb, int nvb) {
    LAS unsigned* T = (LAS unsigned*)lds; bf16_t* WOUT = (bf16_t*)(p.ws + WS_WOUT);
    for (int it = vb; it < CV_TOTAL; it += nvb) {
        int j = it;
        if (j < CV_GU) { gu_strip(p, l, j, lds); continue; }
        j -= CV_GU;
        if (j < CV_D4) { const int e = j >> 4, nt = j & 15;
            q8_strip<44, DE, true>(p.in[34] + (size_t)(l * 16 + e) * DE * 1024 + nt * 64, 1024, p.ws + WS_WD + ((size_t)e * 1024 + nt * 64) * DE, (float*)(p.ws + WS_SWD) + e * 1024 + nt * 64, lds); continue; }
        j -= CV_D4;
        if (j < CV_WIN) { q8_strip<16, 1024, false>(p.in[7] + (size_t)l * 1024 * NIN + j * 64, NIN, p.ws + WS_WIN + (size_t)j * 64 * 1024, (float*)(p.ws + WS_SWIN) + j * 64, lds); continue; }
        j -= CV_WIN;
        if (j < CV_PAD) { const size_t o = (size_t)NIN * 1024 + ((size_t)j * NTHR + threadIdx.x) * 16; *(uint4*)(p.ws + WS_WIN + o) = make_uint4(0u, 0u, 0u, 0u);
            if (j == 0 && threadIdx.x < 128) ((float*)(p.ws + WS_SWIN))[NIN + threadIdx.x] = 0.f; continue; }
        j -= CV_PAD;
        { const int kt = j >> 2, ng = j & 3; tr_tile4(p.in[8] + (size_t)l * 1024 * 1024, 1024, kt * 64, ng * 256, WOUT, 1024, ng * 256, T); }
    }
}

__device__ __forceinline__ void mod_item(const Params& p, int item, LAS unsigned char* lds) {
    LAS float* sc = (LAS float*)lds;
    LAS float* red = (LAS float*)(lds + 69632);
    const int tid = threadIdx.x, l = item / 96, cg = item % 96;
    for (int i = tid; i < 17 * 1024; i += NTHR) { const int b = i >> 10, k = i & 1023; const float c = b < 16 ? p.in[1][b * 1024 + k] : p.in[3][k]; sc[k * 17 + b] = c * sigm(c); }
    __syncthreads();
    const int col = cg * 64 + (tid & 63), kg = tid >> 6;
    float acc[17];
#pragma unroll
    for (int b = 0; b < 17; ++b) acc[b] = 0.f;
    const float* w = p.in[4] + ((size_t)l * 1024 + kg * 128) * 6144 + col;
#pragma unroll 4
    for (int kk = 0; kk < 128; ++kk) { const float wv = w[(size_t)kk * 6144]; const LAS float* s = sc + (kg * 128 + kk) * 17;
#pragma unroll
        for (int b = 0; b < 17; ++b) acc[b] += s[b] * wv; }
#pragma unroll
    for (int b = 0; b < 17; ++b) red[(kg * 17 + b) * 64 + (tid & 63)] = acc[b];
    __syncthreads();
    for (int i = tid; i < 17 * 64; i += NTHR) { const int b = i >> 6, c = i & 63; float s = 0.f;
#pragma unroll
        for (int g = 0; g < 8; ++g) s += red[(g * 17 + b) * 64 + c];
        ((float*)(p.ws + WS_MOD))[((size_t)l * 17 + b) * 6144 + cg * 64 + c] = s + p.in[5][l * 6144 + cg * 64 + c]; }
    __syncthreads();
}

__device__ __forceinline__ void s5mat_item(const Params& p, int item, LAS unsigned char* lds) {
    LAS lf2* pw = (LAS lf2*)lds;
    LAS lf2* bb = (LAS lf2*)(lds + 17408);
    LAS lf2* cc = (LAS lf2*)(lds + 17408 + 16384);
    LAS float* KT = (LAS float*)(lds + 17408 + 32768);
    const int tid = threadIdx.x, l = item >> 4, g = item & 15;
    for (int i = tid; i < 2 * 17 * 64; i += NTHR) { const int pp = i & 63, n = (i >> 6) % 17, d = i / (17 * 64);
        const int li = ((l * 2 + d) * 16 + g) * 64 + pp; const float lr = p.in[9][li], lim = p.in[10][li], dt = expf(p.in[11][(l * 2 + d) * 16 + g]);
        const float mag = expf((float)n * dt * lr); float s, c; sincosf((float)n * dt * lim, &s, &c); pw[i] = (lf2){mag * c, mag * s}; }
    for (int i = tid; i < 2 * 64 * 16; i += NTHR) { const int h = i & 15, pp = (i >> 4) & 63, d = i >> 10;
        const int li = ((l * 2 + d) * 16 + g) * 64 + pp; const float lr = p.in[9][li], lim = p.in[10][li], dt = expf(p.in[11][(l * 2 + d) * 16 + g]);
        const float mag = expf(dt * lr); float s, c; sincosf(dt * lim, &s, &c); const float x = mag * c - 1.0f, y = mag * s;
        const float den = 1.0f / (lr * lr + lim * lim); const float cr = (x * lr + y * lim) * den, ci = (y * lr - x * lim) * den;
        const int bi = ((l * 16 + g) * 64 + pp) * 16 + h; const float br = p.in[12][bi], bim = p.in[13][bi];
        bb[i] = (lf2){cr * br - ci * bim, cr * bim + ci * br}; }
    for (int i = tid; i < 2 * 16 * 64; i += NTHR) { const int pp = i & 63, h = (i >> 6) & 15, d = i >> 10;
        const int ci = (((l * 2 + d) * 16 + g) * 16 + h) * 64 + pp; cc[i] = (lf2){p.in[14][ci], p.in[15][ci]}; }
    __syncthreads();
    for (int i = tid; i < 2 * 16 * 256; i += NTHR) { const int h2 = i & 15, h = (i >> 4) & 15, tau = (i >> 8) & 15, d = i >> 12; float s = 0.f;
        for (int pp = 0; pp < 64; ++pp) { const lf2 c = cc[(d * 16 + h) * 64 + pp], w = pw[(d * 17 + tau) * 64 + pp], b = bb[(d * 64 + pp) * 16 + h2];
            const float tr = c.x * w.x - c.y * w.y, ti = c.x * w.y + c.y * w.x; s += tr * b.x - ti * b.y; }
        KT[i] = s; }
    __syncthreads();
    bf16_t* E = (bf16_t*)(p.ws + WS_SW + (size_t)l * SW_STRIDE + SW_S5E) + (size_t)g * 256 * 256;
    bf16_t* W2 = (bf16_t*)(p.ws + WS_SW + (size_t)l * SW_STRIDE + SW_S5W2) + (size_t)g * 256 * 512;
    for (int i = tid; i < 256 * 256; i += NTHR) { const int k = i & 255, n = i >> 8; const int s = k >> 4, h = k & 15, d = n >> 7, part = (n >> 6) & 1, pp = n & 63;
        const int e = d == 0 ? 15 - s : s; const lf2 w = pw[(d * 17 + e) * 64 + pp], b = bb[(d * 64 + pp) * 16 + h];
        E[i] = f2bf(part ? (w.x * b.y + w.y * b.x) : (w.x * b.x - w.y * b.y)); }
    for (int i = tid; i < 256 * 512; i += NTHR) { const int k = i & 511, n = i >> 9; const int t = n >> 4, h = n & 15; float v;
        if (k < 256) { const int s = k >> 4, h2 = k & 15; v = 0.f;
            if (t >= s) v += KT[((0 * 16 + (t - s)) * 16 + h) * 16 + h2];
            if (s >= t) v += KT[((1 * 16 + (s - t)) * 16 + h) * 16 + h2];
            if (s == t && h == h2) v += p.in[16][l * 256 + g * 16 + h]; }
        else { const int q = k - 256, d = q >> 7, part = (q >> 6) & 1, pp = q & 63; const int e = d == 0 ? t + 1 : 16 - t;
            const lf2 c = cc[(d * 16 + h) * 64 + pp], w = pw[(d * 17 + e) * 64 + pp];
            v = part ? -(c.x * w.y + c.y * w.x) : (c.x * w.x - c.y * w.y); }
        W2[i] = f2bf(v); }
    __syncthreads();
}

__device__ __forceinline__ void smallw_item(const Params& p, int item) {
    int i = item * NTHR + threadIdx.x; const int l = i / 212992; i %= 212992;
    unsigned char* sw = p.ws + WS_SW + (size_t)l * SW_STRIDE;
    if (i < 49152) { const int k = i & 63, n = (i >> 6) % 384, d = i / 24576; ((bf16_t*)(sw + SW_W2T))[i] = f2bf(p.in[22][((size_t)(l * 2 + d) * 64 + k) * 384 + n]); return; }
    i -= 49152;
    if (i < 49152) { const int k = i & 63, n = (i >> 6) % 384, d = i / 24576; ((bf16_t*)(sw + SW_A2T))[i] = f2bf(p.in[24][((size_t)(l * 2 + d) * 64 + k) * 384 + n]); return; }
    i -= 49152;
    if (i < 49152) { const int k = i & 127, n = i >> 7; ((bf16_t*)(sw + SW_G2T))[i] = f2bf(p.in[25][((size_t)l * 128 + k) * 384 + n]); return; }
    i -= 49152;
    { const int k = i & 255, n = i >> 8; ((bf16_t*)(sw + SW_GLUT))[i] = f2bf(p.in[17][((size_t)l * 256 + k) * 256 + n]); }
}

constexpr int PRO_MOD = 192, PRO_S5 = 32, PRO_SW = 832;
__device__ __forceinline__ void phase_prologue(const Params& p, LAS unsigned char* lds) {
    for (int it = blockIdx.x; it < PRO_MOD + PRO_S5 + PRO_SW; it += gridDim.x) {
        if (it < PRO_MOD) mod_item(p, it, lds);
        else if (it < PRO_MOD + PRO_S5) s5mat_item(p, it - PRO_MOD, lds);
        else smallw_item(p, it - PRO_MOD - PRO_S5);
    }
    convert_weights(p, 0, lds, (int)blockIdx.x, (int)gridDim.x);
}

__device__ __forceinline__ void hnorm_row(const float* g, const float* mb_sh, const float* mb_sc, unsigned char* dst, float* sdst, int lane, const float4 (&v)[4]) {
    float ss = 0.f;
#pragma unroll
    for (int i = 0; i < 4; ++i) ss += v[i].x * v[i].x + v[i].y * v[i].y + v[i].z * v[i].z + v[i].w * v[i].w;
    ss = wave_sum(ss); const float rs = rsqrtf(ss * (1.0f / 1024.0f) + 1e-6f);
    float hv[4][4]; float amax = 0.f;
#pragma unroll
    for (int i = 0; i < 4; ++i) { const int c = i * 256 + lane * 4; const float4 gg = *(const float4*)(g + c), sh = *(const float4*)(mb_sh + c), sc = *(const float4*)(mb_sc + c);
        hv[i][0] = v[i].x * rs * gg.x * (1.f + sc.x) + sh.x; hv[i][1] = v[i].y * rs * gg.y * (1.f + sc.y) + sh.y; hv[i][2] = v[i].z * rs * gg.z * (1.f + sc.z) + sh.z; hv[i][3] = v[i].w * rs * gg.w * (1.f + sc.w) + sh.w;
        amax = fmaxf(amax, fmaxf(fmaxf(fabsf(hv[i][0]), fabsf(hv[i][1])), fmaxf(fabsf(hv[i][2]), fabsf(hv[i][3])))); }
#pragma unroll
    for (int o = 32; o >= 1; o >>= 1) amax = fmaxf(amax, __shfl_xor(amax, o));
    amax = fmaxf(amax, 1e-20f); const float qs = 127.0f / amax;
    if (lane == 0) *sdst = amax * (1.0f / 127.0f);
#pragma unroll
    for (int i = 0; i < 4; ++i) { unsigned w = 0u;
#pragma unroll
        for (int k = 0; k < 4; ++k) w |= ((unsigned)__float2int_rn(hv[i][k] * qs) & 255u) << (8 * k);
        *(unsigned*)(dst + i * 256 + lane * 4) = w; }
}
__device__ __forceinline__ void phase_hnorm(const Params& p, int l, const float* xl, const float* xc) {
    const int lane = threadIdx.x & 63, wv = threadIdx.x >> 6;
    const float* mod = (const float*)(p.ws + WS_MOD) + (size_t)l * 17 * 6144; const float* g = p.in[6] + (l * 4 + 0) * 1024;
    unsigned char* A = p.ws + WS_ABUF; float* SH = (float*)(p.ws + WS_SH);
    for (int r = blockIdx.x * 8 + wv; r < NROW; r += gridDim.x * 8) {
        const float* src = xrow(xl, xc, r); const int b = r < NLAT ? (r >> 11) : 16; const float* mb = mod + (size_t)b * 6144;
        float4 v[4];
#pragma unroll
        for (int i = 0; i < 4; ++i) v[i] = *(const float4*)(src + i * 256 + lane * 4);
        hnorm_row(g, mb, mb + 1024, A + (size_t)r * 1024, SH + r, lane, v);
    }
}

__device__ __forceinline__ void phase_prep(const Params& p, int l, LAS unsigned char* lds) {
    LAS bf16_t* vt = (LAS bf16_t*)lds;
    LAS lf2* cs = (LAS lf2*)(lds + 50176);
    const int tid = threadIdx.x;
    for (int i = tid; i < 1024; i += NTHR) { const int pos = i >> 4, j = i & 15; const float invf = exp2f(-(float)j * (13.287712379549449f / 16.0f)); float s, c; sincosf((float)pos * invf, &s, &c); cs[i] = (lf2){c, s}; }
    __syncthreads();
    const bf16_t* P = (const bf16_t*)(p.ws + U_P);
    bf16_t* QR = (bf16_t*)(p.ws + U_QR); bf16_t* KR = (bf16_t*)(p.ws + U_KR);
    bf16_t* RS = (bf16_t*)(p.ws + U_RS); bf16_t* KS = (bf16_t*)(p.ws + U_KS); bf16_t* VS = (bf16_t*)(p.ws + U_VS); bf16_t* KK = (bf16_t*)(p.ws + U_KK); bf16_t* ALR = (bf16_t*)(p.ws + U_ALR);
    for (int ti = blockIdx.x; ti < NROW / 64; ti += gridDim.x) {
        const int r0 = ti * 64; const bool lat = r0 < NLAT; const int b = lat ? (r0 >> 11) : ((r0 - NLAT) >> 8), t0 = lat ? (r0 & 2047) : ((r0 - NLAT) & 255), slen = lat ? SEQ : CTXL;
#pragma unroll
        for (int i = 0; i < 6; ++i) { const int idx = tid + NTHR * i, tok = idx / 48, pc = idx % 48;
            *(LAS lu4*)(vt + tok * 392 + pc * 8) = *(const lu4*)(P + (size_t)(r0 + tok) * NINP + C_V + pc * 8); }
        __syncthreads();
        { bf16_t* vdst = lat ? (bf16_t*)(p.ws + U_VT) + (size_t)b * 384 * 2048 + t0 : (bf16_t*)(p.ws + U_VTC) + (size_t)b * 384 * 256 + t0;
#pragma unroll
          for (int i = 0; i < 6; ++i) { const int idx = tid + NTHR * i, hd = idx >> 3, pc = idx & 7; unsigned w[4];
#pragma unroll
              for (int j = 0; j < 4; ++j) w[j] = (unsigned)vt[(pc * 8 + 2 * j) * 392 + hd] | ((unsigned)vt[(pc * 8 + 2 * j + 1) * 392 + hd] << 16);
              *(uint4*)(vdst + (size_t)hd * slen + pc * 8) = make_uint4(w[0], w[1], w[2], w[3]); } }
#pragma unroll
        for (int i = 0; i < 4; ++i) { const int idx = tid + NTHR * i, tok = idx >> 5, pc = idx & 31;
            *(lu4*)((bf16_t*)(p.ws + U_U16) + (size_t)(r0 + tok) * 256 + pc * 8) = *(const lu4*)(P + (size_t)(r0 + tok) * NINP + pc * 8); }
#pragma unroll
        for (int i = 0; i < 6; ++i) { const int idx = tid + NTHR * i, tok = idx / 48, rem = idx % 48, qk = rem / 24, rem2 = rem % 24, h = rem2 >> 2, pp = rem2 & 3;
            const int d1 = (pp >> 1) * 32 + (pp & 1) * 8; const size_t so = (size_t)(r0 + tok) * NINP + (qk ? C_K : C_Q) + h * 64 + d1;
            float x1[8], x2[8], o1[8], o2[8]; unpack8(*(const uint4*)(P + so), x1); unpack8(*(const uint4*)(P + so + 16), x2);
            const int t = t0 + tok, pos = (pp < 2) ? (t >> 6) : (t & 63), j0 = (pp & 1) * 8; const float scl = qk ? 1.0f : 0.125f;
#pragma unroll
            for (int j = 0; j < 8; ++j) { lf2 c = cs[pos * 16 + j0 + j]; if (!lat) c = (lf2){1.f, 0.f}; o1[j] = (x1[j] * c.x - x2[j] * c.y) * scl; o2[j] = (x1[j] * c.y + x2[j] * c.x) * scl; }
            bf16_t* dq = (qk ? KR : QR) + (size_t)(r0 + tok) * 384 + h * 64 + d1; *(uint4*)dq = pack8(o1); *(uint4*)(dq + 16) = pack8(o2); }
        for (int i = 0; i < 24; ++i) { const int idx = tid + NTHR * i, tok = idx / 192, pc = idx % 192, c0 = pc * 8, r = r0 + tok, t = t0 + tok;
            const bf16_t* zp = P + (size_t)r * NINP + C_Z + c0; float x[8], pv[8], nx[8], zs[8];
            unpack8(*(const uint4*)zp, x);
            if (t > 0) unpack8(*(const uint4*)(zp - NINP), pv); else {
#pragma unroll
                for (int j = 0; j < 8; ++j) pv[j] = 0.f; }
            if (t < slen - 1) unpack8(*(const uint4*)(zp + NINP), nx); else {
#pragma unroll
                for (int j = 0; j < 8; ++j) nx[j] = 0.f; }
            const float4 mu0 = *(const float4*)(p.in[20] + l * 1536 + c0), mu1 = *(const float4*)(p.in[20] + l * 1536 + c0 + 4); const float mu[8] = {mu0.x, mu0.y, mu0.z, mu0.w, mu1.x, mu1.y, mu1.z, mu1.w};
#pragma unroll
            for (int j = 0; j < 8; ++j) zs[j] = x[j] + (0.5f * (pv[j] + nx[j]) - x[j]) * mu[j];
            const bool isk = c0 >= 384 && c0 < 768; float kv[8]; float ss = 0.f;
            { const int kc = isk ? c0 - 384 : 0; const float4 k0 = *(const float4*)(p.in[26] + l * 384 + kc), k1 = *(const float4*)(p.in[26] + l * 384 + kc + 4); const float kkw[8] = {k0.x, k0.y, k0.z, k0.w, k1.x, k1.y, k1.z, k1.w};
#pragma unroll
              for (int j = 0; j < 8; ++j) { kv[j] = zs[j] * kkw[j]; ss += kv[j] * kv[j]; } }
            ss += __shfl_xor(ss, 1); ss += __shfl_xor(ss, 2); ss += __shfl_xor(ss, 4);
            if (c0 < 384) *(uint4*)(RS + (size_t)r * 384 + c0) = pack8(zs);
            else if (c0 < 768) { *(uint4*)(KS + (size_t)r * 384 + c0 - 384) = pack8(zs); const float inv = 1.0f / fmaxf(sqrtf(ss), 1e-12f);
#pragma unroll
                for (int j = 0; j < 8; ++j) kv[j] *= inv;
                *(uint4*)(KK + (size_t)r * 384 + c0 - 384) = pack8(kv); }
            else if (c0 < 1152) *(uint4*)(VS + (size_t)r * 384 + c0 - 768) = pack8(zs);
            else { const int ac = c0 - 1152; float o[8];
#pragma unroll
                for (int j = 0; j < 8; ++j) o[j] = ac < 128 ? 1.0f - 2.0f / (1.0f + __expf(2.0f * zs[j])) : (ac < 256 ? zs[j] : sigm(zs[j]));
                *(uint4*)(ALR + (size_t)r * 384 + ac) = pack8(o); }
        }
        __syncthreads();
    }
}

template <int KS, int MODE> __device__ __forceinline__ void lr_wave(const Params& p, int l, int row0, int kofs, const bf16_t* Bt, int d) {
    const int lane = threadIdx.x & 63, m = lane & 15, q = lane >> 4;
    const bf16_t* Ap = (const bf16_t*)(p.ws + U_ALR) + (size_t)(row0 + m) * 384 + kofs + q * 8;
    bf16x8 a[KS];
#pragma unroll
    for (int ks = 0; ks < KS; ++ks) a[ks] = *(const bf16x8*)(Ap + ks * 32);
    bf16_t* O = (bf16_t*)(p.ws + (MODE == 0 ? U_LD + (size_t)d * SZ384 : (MODE == 1 ? U_AG + (size_t)d * SZ384 : U_G))) + (size_t)(row0 + m) * 384;
    const float* bias = MODE == 0 ? p.in[21] + (l * 2 + d) * 384 : p.in[23] + (l * 2 + d) * 384;
    for (int nt = 0; nt < 24; ++nt) {
        f32x4 acc = (f32x4){0.f, 0.f, 0.f, 0.f};
#pragma unroll
        for (int ks = 0; ks < KS; ++ks) { const bf16x8 bfr = *(const bf16x8*)(Bt + (size_t)(nt * 16 + m) * (KS * 32) + ks * 32 + q * 8); acc = mfma16(bfr, a[ks], acc); }
        const int n = nt * 16 + q * 4; float o[4];
        if (MODE == 2) {
#pragma unroll
            for (int j = 0; j < 4; ++j) o[j] = acc[j];
        } else { const float4 bv = *(const float4*)(bias + n); const float bb[4] = {bv.x, bv.y, bv.z, bv.w};
#pragma unroll
            for (int j = 0; j < 4; ++j) { const float s = sigm(bb[j] + acc[j]); o[j] = MODE == 0 ? -0.6065306597f * s : s; } }
        u32x2 w; w.x = pack2(o[0], o[1]); w.y = pack2(o[2], o[3]); *(u32x2*)(O + n) = w;
    }
}
__device__ __forceinline__ void lowrank_items(const Params& p, int l, int wid, int nw) {
    const unsigned char* sw = p.ws + WS_SW + (size_t)l * SW_STRIDE;
    for (int it = wid; it < 2304 * 5; it += nw) { const int rt = it / 5, m = it % 5, row0 = rt * 16;
        if (m < 2) lr_wave<2, 0>(p, l, row0, m * 64, (const bf16_t*)(sw + SW_W2T) + (size_t)m * 384 * 64, m);
        else if (m < 4) lr_wave<2, 1>(p, l, row0, m * 64, (const bf16_t*)(sw + SW_A2T) + (size_t)(m - 2) * 384 * 64, m - 2);
        else lr_wave<4, 2>(p, l, row0, 256, (const bf16_t*)(sw + SW_G2T), 0); }
}

__device__ __forceinline__ int s5_rowbase(int cr) { const int b = cr / 144, c = cr % 144; return c < 16 ? NLAT + b * 256 + c * 16 : b * 2048 + (c - 16) * 16; }
__device__ __forceinline__ void s5_pass1_items(const Params& p, int l, int wid, int nw) {
    const int lane = threadIdx.x & 63, m = lane & 15, q = lane >> 4;
    const bf16_t* P = (const bf16_t*)(p.ws + U_U16); float* SLOC = (float*)(p.ws + U_SLOC);
    for (int it = wid; it < 144 * 16; it += nw) { const int ct = it >> 4, g = it & 15, cr = ct * 16 + m, rb = s5_rowbase(cr);
        const bf16_t* E = (const bf16_t*)(p.ws + WS_SW + (size_t)l * SW_STRIDE + SW_S5E) + (size_t)g * 256 * 256;
        bf16x8 a[8];
#pragma unroll
        for (int ks = 0; ks < 8; ++ks) a[ks] = *(const bf16x8*)(P + (size_t)(rb + 2 * ks + (q >> 1)) * 256 + g * 16 + (q & 1) * 8);
        float* o = SLOC + ((size_t)cr * 16 + g) * 256 + q * 4;
#pragma unroll 2
        for (int nt = 0; nt < 16; ++nt) { f32x4 acc = (f32x4){0.f, 0.f, 0.f, 0.f}; const bf16_t* ep = E + (size_t)(nt * 16 + m) * 256 + q * 8;
#pragma unroll
            for (int ks = 0; ks < 8; ++ks) acc = mfma16(*(const bf16x8*)(ep + ks * 32), a[ks], acc);
            *(f32x4*)(o + nt * 16) = acc; }
    }
}
__device__ __forceinline__ void s5_carry(const Params& p, int l) {
    const int gid = blockIdx.x * NTHR + threadIdx.x; if (gid >= 32768) return;
    const int pp = gid & 63, d = (gid >> 6) & 1, g = (gid >> 7) & 15, b = gid >> 11;
    const int li = ((l * 2 + d) * 16 + g) * 64 + pp; const float lr = p.in[9][li], lim = p.in[10][li], dt = expf(p.in[11][(l * 2 + d) * 16 + g]);
    const float mag = expf(16.0f * dt * lr); float sn, cn; sincosf(16.0f * dt * lim, &sn, &cn); const float ar = mag * cn, ai = mag * sn;
    const float* SLOC = (const float*)(p.ws + U_SLOC); bf16_t* SP = (bf16_t*)(p.ws + U_SPREV);
    float sr = 0.f, si = 0.f;
#pragma unroll 8
    for (int n = 0; n < 144; ++n) { const int c = d == 0 ? n : (n < 16 ? 15 - n : 159 - n); const size_t idx = ((size_t)(b * 144 + c) * 16 + g) * 256 + d * 128 + pp;
        SP[idx] = f2bf(sr); SP[idx + 64] = f2bf(si);
        const float xr = SLOC[idx], xi = SLOC[idx + 64]; const float nr = ar * sr - ai * si + xr, ni = ar * si + ai * sr + xi; sr = nr; si = ni; }
}
__device__ __forceinline__ void s5_pass2_items(const Params& p, int l, int wid, int nw) {
    const int lane = threadIdx.x & 63, m = lane & 15, q = lane >> 4;
    const bf16_t* P = (const bf16_t*)(p.ws + U_U16); const bf16_t* SP = (const bf16_t*)(p.ws + U_SPREV); bf16_t* YG = (bf16_t*)(p.ws + U_YG);
    for (int it = wid; it < 144 * 16; it += nw) { const int ct = it >> 4, g = it & 15; if (l == 1 && ct % 9 == 0) continue;
        const int cr = ct * 16 + m, rb = s5_rowbase(cr);
        const bf16_t* W2 = (const bf16_t*)(p.ws + WS_SW + (size_t)l * SW_STRIDE + SW_S5W2) + (size_t)g * 256 * 512;
        bf16x8 a[16];
#pragma unroll
        for (int ks = 0; ks < 8; ++ks) a[ks] = *(const bf16x8*)(P + (size_t)(rb + 2 * ks + (q >> 1)) * 256 + g * 16 + (q & 1) * 8);
#pragma unroll
        for (int ks = 8; ks < 16; ++ks) a[ks] = *(const bf16x8*)(SP + ((size_t)cr * 16 + g) * 256 + (ks - 8) * 32 + q * 8);
#pragma unroll 2
        for (int nt = 0; nt < 16; ++nt) { f32x4 acc = (f32x4){0.f, 0.f, 0.f, 0.f}; const bf16_t* wp = W2 + (size_t)(nt * 16 + m) * 512 + q * 8;
#pragma unroll
            for (int ks = 0; ks < 16; ++ks) acc = mfma16(*(const bf16x8*)(wp + ks * 32), a[ks], acc);
            float o[4];
#pragma unroll
            for (int j = 0; j < 4; ++j) { const float x = acc[j]; const float u = 0.7978845608f * (x + 0.044715f * x * x * x); const float th = 1.0f - 2.0f / (1.0f + __expf(2.0f * u)); o[j] = 0.5f * x * (1.0f + th); }
            u32x2 w; w.x = pack2(o[0], o[1]); w.y = pack2(o[2], o[3]); *(u32x2*)(YG + (size_t)(rb + nt) * 256 + g * 16 + q * 4) = w; }
    }
}
__device__ __forceinline__ void s5_glu_items(const Params& p, int l, int wid, int nw) {
    const int lane = threadIdx.x & 63, m = lane & 15, q = lane >> 4;
    const bf16_t* YG = (const bf16_t*)(p.ws + U_YG); bf16_t* YC = (bf16_t*)(p.ws + WS_ABUF);
    const bf16_t* GT = (const bf16_t*)(p.ws + WS_SW + (size_t)l * SW_STRIDE + SW_GLUT);
    const int nrt = (l == 0 ? NROW : NLAT) / 16;
    for (int rt = wid; rt < nrt; rt += nw) { const int row = rt * 16 + m;
        bf16x8 a[8];
#pragma unroll
        for (int ks = 0; ks < 8; ++ks) a[ks] = *(const bf16x8*)(YG + (size_t)row * 256 + ks * 32 + q * 8);
#pragma unroll 2
        for (int nt = 0; nt < 16; ++nt) { f32x4 acc = (f32x4){0.f, 0.f, 0.f, 0.f}; const bf16_t* gp = GT + (size_t)(nt * 16 + m) * 256 + q * 8;
#pragma unroll
            for (int ks = 0; ks < 8; ++ks) acc = mfma16(*(const bf16x8*)(gp + ks * 32), a[ks], acc);
            const int n = nt * 16 + q * 4; const float4 bv = *(const float4*)(p.in[18] + l * 256 + n); const u32x2 yw = *(const u32x2*)(YG + (size_t)row * 256 + n);
            u32x2 w; w.x = pack2(bflo(yw.x) * sigm(acc[0] + bv.x), bfhi(yw.x) * sigm(acc[1] + bv.y)); w.y = pack2(bflo(yw.y) * sigm(acc[2] + bv.z), bfhi(yw.y) * sigm(acc[3] + bv.w));
            *(u32x2*)(YC + (size_t)row * 1024 + n) = w; }
    }
}

template <bool HASLAT> __device__ __forceinline__ void na_unit(const Params& p, const LAS float* rpb_l, int b, int h, int i, int n) {
    const int lane = threadIdx.x & 63, m = lane & 15, q = lane >> 4, kin = 8 * (m >> 2) + (m & 3);
    const bf16_t* QR = (const bf16_t*)(p.ws + U_QR); const bf16_t* KR = (const bf16_t*)(p.ws + U_KR);
    const bf16_t* VTL = (const bf16_t*)(p.ws + U_VT) + (size_t)(b * 6 + h) * 64 * 2048; const bf16_t* VTC = (const bf16_t*)(p.ws + U_VTC) + (size_t)(b * 6 + h) * 64 * 256;
    const int qrow = HASLAT ? b * 2048 + i * 64 + n * 16 + m : NLAT + b * 256 + n * 16 + m;
    bf16x8 qf[2];
#pragma unroll
    for (int ks = 0; ks < 2; ++ks) qf[ks] = *(const bf16x8*)(QR + (size_t)qrow * 384 + h * 64 + ks * 32 + q * 8);
    const int r0 = HASLAT ? min(max(i - 4, 0), 24) : 0, scol = HASLAT ? min(max(n * 16 - 8, 0), 32) : 0;
    f32x4 sl[HASLAT ? 16 : 1], sc[16];
    float mx = -3.0e38f;
    if (HASLAT) { const int qc = n * 16 + m, c0 = min(max(qc - 8, 0), 48); const LAS float* rpb = rpb_l + h * 15 * 31;
#pragma unroll
        for (int t = 0; t < 16; ++t) { const int kr = t >> 1, ch = t & 1; const bf16_t* kp = KR + (size_t)(b * 2048 + (r0 + kr) * 64 + scol + kin + 4 * ch) * 384 + h * 64 + q * 8;
            f32x4 acc = (f32x4){0.f, 0.f, 0.f, 0.f};
#pragma unroll
            for (int ks = 0; ks < 2; ++ks) acc = mfma16(*(const bf16x8*)(kp + ks * 32), qf[ks], acc);
            const int dr = r0 + kr - i + 7;
#pragma unroll
            for (int j = 0; j < 4; ++j) { const int kc = scol + 8 * q + 4 * ch + j; const bool valid = kc >= c0 && kc < c0 + 16; const int dc = min(max(kc - qc + 15, 0), 30);
                const float s = valid ? acc[j] + rpb[dr * 31 + dc] : -1.0e30f; acc[j] = s; mx = fmaxf(mx, s); }
            sl[t] = acc; if ((t & 3) == 3) __builtin_amdgcn_sched_barrier(0); } }
#pragma unroll
    for (int t = 0; t < 16; ++t) { const bf16_t* kp = KR + (size_t)(NLAT + b * 256 + (t >> 1) * 32 + kin + 4 * (t & 1)) * 384 + h * 64 + q * 8;
        f32x4 acc = (f32x4){0.f, 0.f, 0.f, 0.f};
#pragma unroll
        for (int ks = 0; ks < 2; ++ks) acc = mfma16(*(const bf16x8*)(kp + ks * 32), qf[ks], acc);
#pragma unroll
        for (int j = 0; j < 4; ++j) mx = fmaxf(mx, acc[j]);
        sc[t] = acc; }
    mx = fmaxf(mx, __shfl_xor(mx, 16)); mx = fmaxf(mx, __shfl_xor(mx, 32));
    float sum = 0.f;
    f32x4 o[4];
#pragma unroll
    for (int dt = 0; dt < 4; ++dt) o[dt] = (f32x4){0.f, 0.f, 0.f, 0.f};
    if (HASLAT) {
#pragma unroll
        for (int kr = 0; kr < 8; ++kr) { float e[8];
#pragma unroll
            for (int j = 0; j < 4; ++j) { e[j] = __expf(sl[2 * kr][j] - mx); e[4 + j] = __expf(sl[2 * kr + 1][j] - mx); }
#pragma unroll
            for (int j = 0; j < 8; ++j) sum += e[j];
            const uint4 pw = pack8(e); const bf16x8 pf = __builtin_bit_cast(bf16x8, pw);
            const int tok = (r0 + kr) * 64 + scol + q * 8;
#pragma unroll
            for (int dt = 0; dt < 4; ++dt) o[dt] = mfma16(*(const bf16x8*)(VTL + (size_t)(dt * 16 + m) * 2048 + tok), pf, o[dt]);
            if (kr & 1) __builtin_amdgcn_sched_barrier(0); } }
#pragma unroll
    for (int t2 = 0; t2 < 8; ++t2) { float e[8];
#pragma unroll
        for (int j = 0; j < 4; ++j) { e[j] = __expf(sc[2 * t2][j] - mx); e[4 + j] = __expf(sc[2 * t2 + 1][j] - mx); }
#pragma unroll
        for (int j = 0; j < 8; ++j) sum += e[j];
        const uint4 pw = pack8(e); const bf16x8 pf = __builtin_bit_cast(bf16x8, pw);
        const int tok = t2 * 32 + q * 8;
#pragma unroll
        for (int dt = 0; dt < 4; ++dt) o[dt] = mfma16(*(const bf16x8*)(VTC + (size_t)(dt * 16 + m) * 256 + tok), pf, o[dt]);
        if (t2 & 1) __builtin_amdgcn_sched_barrier(0); }
    sum += __shfl_xor(sum, 16); sum += __shfl_xor(sum, 32);
    const float inv = 1.0f / sum;
    bf16_t* yo = (bf16_t*)(p.ws + WS_ABUF) + (size_t)qrow * 1024 + 256 + h * 64 + q * 4;
#pragma unroll
    for (int dt = 0; dt < 4; ++dt) { u32x2 w; w.x = pack2(o[dt][0] * inv, o[dt][1] * inv); w.y = pack2(o[dt][2] * inv, o[dt][3] * inv); *(u32x2*)(yo + dt * 16) = w; }
}
__device__ __forceinline__ void na_items(const Params& p, int l, int wid, int nw, LAS unsigned char* lds) {
    LAS float* rpb_l = (LAS float*)lds;
    __syncthreads();
    for (int i = threadIdx.x; i < 6 * 465; i += NTHR) rpb_l[i] = p.in[19][(size_t)l * 6 * 465 + i];
    __syncthreads();
    const int nlat = 16 * 6 * 32 * 4, nctx = (l == 0) ? 16 * 6 * 16 : 0, per = (nlat + nw - 1) / nw;
    for (int k = 0; k < per; ++k) { const int it = wid * per + k; if (it < nlat) { const int n = it & 3, i = (it >> 2) & 31, bh = it >> 7; na_unit<true>(p, rpb_l, bh / 6, bh % 6, i, n); } }
    for (int j = wid; j < nctx; j += nw) { const int n = j & 15, bh = j >> 4; na_unit<false>(p, rpb_l, bh / 6, bh % 6, 0, n); }
}

typedef float f32x2 __attribute__((ext_vector_type(2)));
__device__ __forceinline__ int rk_row(int b, int d, int n) { return n < 256 ? NLAT + b * 256 + (d ? 255 - n : n) : b * 2048 + (d ? 2047 - (n - 256) : (n - 256)); }
template <int CTRL> __device__ __forceinline__ float dpp_f(float v) { return __builtin_bit_cast(float, __builtin_amdgcn_update_dpp(0, __builtin_bit_cast(int, v), CTRL, 0xF, 0xF, true)); }
constexpr int RKP_PITCH = 72, RKP_MAT = 16 * RKP_PITCH * 2, RKP_WAVE = 5 * RKP_MAT + 4 * 16 * 17 * 4;
__device__ __forceinline__ bf16x8 pack_frag(const float (&lo)[4], const float (&hi)[4]) { u32x4 w; w.x = pack2(lo[0], lo[1]); w.y = pack2(lo[2], lo[3]); w.z = pack2(hi[0], hi[1]); w.w = pack2(hi[2], hi[3]); return __builtin_bit_cast(bf16x8, w); }
__device__ __forceinline__ void rwkv_pre_items(const Params& p, int l, int wid, int nw, LAS unsigned char* lds) {
    const int lane = threadIdx.x & 63, m = lane & 15, q = lane >> 4, wv = threadIdx.x >> 6;
    LAS bf16_t* sAt = (LAS bf16_t*)(lds + wv * RKP_WAVE); LAS bf16_t* sBh = sAt + 16 * RKP_PITCH; LAS bf16_t* sKh = sBh + 16 * RKP_PITCH; LAS bf16_t* sRt = sKh + 16 * RKP_PITCH; LAS bf16_t* sV = sRt + 16 * RKP_PITCH;
    LAS float* sM = (LAS float*)(lds + wv * RKP_WAVE + 5 * RKP_MAT);
    const bf16_t* RS = (const bf16_t*)(p.ws + U_RS); const bf16_t* KS = (const bf16_t*)(p.ws + U_KS); const bf16_t* VS = (const bf16_t*)(p.ws + U_VS); const bf16_t* KK = (const bf16_t*)(p.ws + U_KK);
    for (int it = wid; it < NCHUNK; it += nw) { const int u = it / 144, c = it % 144, b = u / 12, h = (u % 12) >> 1, d = u & 1;
        const bf16_t* AG = (const bf16_t*)(p.ws + U_AG + (size_t)d * SZ384); const bf16_t* LD = (const bf16_t*)(p.ws + U_LD + (size_t)d * SZ384);
        const int rb = rk_row(b, d, c * 16), sgn = d ? -1 : 1;
        { LAS bf16_t* sLd = (LAS bf16_t*)sM;
#pragma unroll
          for (int k = 0; k < 12; ++k) { const int idx = lane + 64 * k, pair = idx >> 3, arr = pair >> 4, t = pair & 15, pc = idx & 7;
              const bf16_t* src = arr == 0 ? KK : arr == 1 ? AG : arr == 2 ? KS : arr == 3 ? RS : arr == 4 ? VS : LD;
              LAS bf16_t* dst = arr == 0 ? sAt : arr == 1 ? sBh : arr == 2 ? sKh : arr == 3 ? sRt : arr == 4 ? sV : sLd;
              *(LAS lu4*)(dst + t * RKP_PITCH + pc * 8) = *(const lu4*)(src + (size_t)(rb + sgn * t) * 384 + h * 64 + pc * 8); }
          const float ka = p.in[27][l * 384 + h * 64 + lane]; float L = 0.f;
#pragma unroll 4
          for (int t = 0; t < 16; ++t) { const int o = t * RKP_PITCH + lane;
              const float r_ = bf2f(sRt[o]), k_ = bf2f(sKh[o]), kk_ = bf2f(sAt[o]), ag_ = bf2f(sBh[o]), ld_ = bf2f(sLd[o]);
              const float e0 = __expf(L); L += ld_; const float e1 = __expf(L), ei = __expf(-L);
              sAt[o] = f2bf(-kk_ * e0); sBh[o] = f2bf(kk_ * ag_ * ei); sKh[o] = f2bf(k_ * (1.0f + (ag_ - 1.0f) * ka) * ei); sRt[o] = f2bf(r_ * e1); }
          ((bf16_t*)(p.ws + CH_GT))[(size_t)it * 64 + lane] = f2bf(L); }
        { bf16x8 atf[2], rtf[2], bhf[2], khf[2];
#pragma unroll
          for (int ks = 0; ks < 2; ++ks) { atf[ks] = *(const LAS bf16x8*)(sAt + m * RKP_PITCH + ks * 32 + q * 8); rtf[ks] = *(const LAS bf16x8*)(sRt + m * RKP_PITCH + ks * 32 + q * 8);
              bhf[ks] = *(const LAS bf16x8*)(sBh + m * RKP_PITCH + ks * 32 + q * 8); khf[ks] = *(const LAS bf16x8*)(sKh + m * RKP_PITCH + ks * 32 + q * 8); }
          f32x4 mab = (f32x4){0.f, 0.f, 0.f, 0.f}, mak = mab, mrb = mab, mrk = mab;
#pragma unroll
          for (int ks = 0; ks < 2; ++ks) { mab = mfma16(atf[ks], bhf[ks], mab); mak = mfma16(atf[ks], khf[ks], mak); mrb = mfma16(rtf[ks], bhf[ks], mrb); mrk = mfma16(rtf[ks], khf[ks], mrk); }
#pragma unroll
          for (int r = 0; r < 4; ++r) { const int t = 4 * q + r; sM[(0 * 16 + t) * 17 + m] = m < t ? mab[r] : 0.f; sM[(1 * 16 + t) * 17 + m] = m < t ? mak[r] : 0.f;
              sM[(2 * 16 + t) * 17 + m] = m <= t ? mrb[r] : 0.f; sM[(3 * 16 + t) * 17 + m] = m <= t ? mrk[r] : 0.f; } }
        { float tv[16];
#pragma unroll
          for (int t = 0; t < 16; ++t) { float acc = (m == t) ? 1.0f : 0.0f;
#pragma unroll
              for (int s2 = 0; s2 < t; ++s2) acc += sM[t * 17 + s2] * tv[s2];
              tv[t] = acc; }
#pragma unroll
          for (int t = 0; t < 16; ++t) if (q == 0) sM[t * 17 + m] = tv[t]; }
        bf16x8 tinvf, mrbf;
        { float lo[4], hi[4] = {0.f, 0.f, 0.f, 0.f};
#pragma unroll
          for (int j = 0; j < 4; ++j) lo[j] = sM[(0 * 16 + m) * 17 + 4 * q + j];
          tinvf = pack_frag(lo, hi);
#pragma unroll
          for (int j = 0; j < 4; ++j) lo[j] = sM[(2 * 16 + m) * 17 + 4 * q + j];
          mrbf = pack_frag(lo, hi);
#pragma unroll
          for (int j = 0; j < 4; ++j) hi[j] = sM[(3 * 16 + m) * 17 + 4 * q + j];
          *(bf16x8*)((bf16_t*)(p.ws + CH_MM) + ((size_t)it * 64 + lane) * 8) = pack_frag(lo, hi); }
        { bf16x8 makf; { float lo[4], hi[4];
#pragma unroll
            for (int j = 0; j < 4; ++j) { lo[j] = q < 2 ? sM[(1 * 16 + m) * 17 + 8 * q + j] : 0.f; hi[j] = q < 2 ? sM[(1 * 16 + m) * 17 + 8 * q + 4 + j] : 0.f; }
            makf = pack_frag(lo, hi); }
#pragma unroll
          for (int itile = 0; itile < 4; ++itile) { unsigned vw[4];
#pragma unroll
              for (int j = 0; j < 4; ++j) vw[j] = q < 2 ? ((unsigned)sV[(8 * q + 2 * j) * RKP_PITCH + 16 * itile + m] | ((unsigned)sV[(8 * q + 2 * j + 1) * RKP_PITCH + 16 * itile + m] << 16)) : 0u;
              const u32x4 vq = {vw[0], vw[1], vw[2], vw[3]};
              const f32x4 w1 = mfma16(makf, __builtin_bit_cast(bf16x8, vq), (f32x4){0.f, 0.f, 0.f, 0.f});
              const float lo[4] = {w1[0], w1[1], w1[2], w1[3]}, hi[4] = {0.f, 0.f, 0.f, 0.f};
              const f32x4 uu = mfma16(tinvf, pack_frag(lo, hi), (f32x4){0.f, 0.f, 0.f, 0.f});
              u32x2 o; o.x = pack2(uu[0], uu[1]); o.y = pack2(uu[2], uu[3]);
              *(u32x2*)((bf16_t*)(p.ws + CH_UL) + (((size_t)it * 4 + itile) * 64 + lane) * 4) = o; } }
        f32x4 ap[4], rp[4];
#pragma unroll
        for (int jt = 0; jt < 4; ++jt) { float lo[4], hi[4] = {0.f, 0.f, 0.f, 0.f};
#pragma unroll
            for (int j = 0; j < 4; ++j) lo[j] = bf2f(sAt[(4 * q + j) * RKP_PITCH + 16 * jt + m]);
            ap[jt] = mfma16(tinvf, pack_frag(lo, hi), (f32x4){0.f, 0.f, 0.f, 0.f});
            const float al[4] = {ap[jt][0], ap[jt][1], ap[jt][2], ap[jt][3]};
            f32x4 rr = mfma16(mrbf, pack_frag(al, hi), (f32x4){0.f, 0.f, 0.f, 0.f});
#pragma unroll
            for (int r = 0; r < 4; ++r) rr[r] += bf2f(sRt[(4 * q + r) * RKP_PITCH + 16 * jt + m]);
            rp[jt] = rr;
            float bl[4], kl[4];
#pragma unroll
            for (int j = 0; j < 4; ++j) { bl[j] = bf2f(sBh[(4 * q + j) * RKP_PITCH + 16 * jt + m]); kl[j] = bf2f(sKh[(4 * q + j) * RKP_PITCH + 16 * jt + m]); }
            *(bf16x8*)((bf16_t*)(p.ws + CH_BK) + (((size_t)it * 4 + jt) * 64 + lane) * 8) = pack_frag(bl, kl); }
#pragma unroll
        for (int jt = 0; jt < 4; ++jt)
#pragma unroll
            for (int r = 0; r < 4; ++r) { sAt[(4 * q + r) * RKP_PITCH + 16 * jt + m] = f2bf(ap[jt][r]); sRt[(4 * q + r) * RKP_PITCH + 16 * jt + m] = f2bf(rp[jt][r]); }
#pragma unroll
        for (int x = 0; x < 2; ++x)
#pragma unroll
            for (int ks = 0; ks < 2; ++ks) { const LAS bf16_t* src = (x ? sRt : sAt) + m * RKP_PITCH + 32 * ks + 4 * q;
                const u32x2 a0 = *(const LAS u32x2*)src, a1 = *(const LAS u32x2*)(src + 16); const u32x4 w = {a0.x, a0.y, a1.x, a1.y};
                *(u32x4*)((bf16_t*)(p.ws + CH_XP) + ((((size_t)it * 2 + x) * 2 + ks) * 64 + lane) * 8) = w; }
    }
}
__device__ __forceinline__ void rwkv_seq_task(const Params& p, int l, int task, LAS unsigned char* lds) {
    const int lane = threadIdx.x & 63, m = lane & 15, q = lane >> 4;
    const int u = task >> 2, iw = task & 3, b = u / 12, h = (u % 12) >> 1, d = u & 1, sgn = d ? -1 : 1;
    const bf16_t* XP = (const bf16_t*)(p.ws + CH_XP); const bf16_t* BK = (const bf16_t*)(p.ws + CH_BK); const bf16_t* UL = (const bf16_t*)(p.ws + CH_UL); const bf16_t* MM = (const bf16_t*)(p.ws + CH_MM);
    const bf16_t* GT = (const bf16_t*)(p.ws + CH_GT); const bf16_t* VS = (const bf16_t*)(p.ws + U_VS) + h * 64 + 16 * iw;
    float* Yw = (float*)(p.ws + U_YRK) + (size_t)d * NROW * 384 + h * 64 + 16 * iw;
    LAS float* ybuf = (LAS float*)(lds + (threadIdx.x >> 6) * 12288);
    const int rc0 = NLAT + b * 256 + (d ? 255 : 0) + sgn * 4 * q, rdel = (b * 2048 + (d ? 2047 : 0)) - (NLAT + b * 256 + (d ? 255 : 0)) - sgn * 256;
    f32x4 acc[4];
#pragma unroll
    for (int jt = 0; jt < 4; ++jt) acc[jt] = (f32x4){0.f, 0.f, 0.f, 0.f};
    const unsigned vo16 = (unsigned)lane * 16u, vo8 = (unsigned)lane * 8u, vo8q = (unsigned)q * 8u;
    struct OpSet { u32x4 apf0, apf1, rpf0, rpf1, bkf0, bkf1, bkf2, bkf3, mmf; u32x2 gl0, gl1, gl2, gl3, uw; unsigned vr0, vr1, vr2, vr3; };
#define GLDS16(dst, voff, sbase, imm) asm volatile("global_load_dwordx4 %0, %1, %2 offset:" #imm : "=&v"(dst) : "v"(voff), "s"(sbase) : "memory")
#define GLDS8(dst, voff, sbase, imm) asm volatile("global_load_dwordx2 %0, %1, %2 offset:" #imm : "=&v"(dst) : "v"(voff), "s"(sbase) : "memory")
#define GLDS2(dst, voff, sbase) asm volatile("global_load_ushort %0, %1, %2" : "=&v"(dst) : "v"(voff), "s"(sbase) : "memory")
#define RKS_LOAD(X, c_) do { const size_t it_ = (size_t)u * 144 + (c_); const int rb_ = rc0 + sgn * 16 * (c_) + (int)((c_) >= 16) * rdel; \
        const bf16_t* xpb = XP + it_ * 2048; const bf16_t* bkb = BK + it_ * 2048; const bf16_t* mmb = MM + it_ * 512; const bf16_t* gtb = GT + it_ * 64; const bf16_t* ulb = UL + (it_ * 4 + iw) * 256; \
        GLDS16(X.apf0, vo16, xpb, 0); GLDS16(X.apf1, vo16, xpb, 1024); GLDS16(X.rpf0, vo16, xpb, 2048); GLDS16(X.rpf1, vo16, xpb, 3072); \
        GLDS16(X.bkf0, vo16, bkb, 0); GLDS16(X.bkf1, vo16, bkb, 1024); GLDS16(X.bkf2, vo16, bkb, 2048); GLDS16(X.bkf3, vo16, bkb, 3072); \
        GLDS8(X.gl0, vo8q, gtb, 0); GLDS8(X.gl1, vo8q, gtb, 32); GLDS8(X.gl2, vo8q, gtb, 64); GLDS8(X.gl3, vo8q, gtb, 96); \
        GLDS16(X.mmf, vo16, mmb, 0); GLDS8(X.uw, vo8, ulb, 0); \
        { const unsigned v0_ = (unsigned)(rb_) * 768u + 2u * m, v1_ = (unsigned)(rb_ + sgn) * 768u + 2u * m, v2_ = (unsigned)(rb_ + 2 * sgn) * 768u + 2u * m, v3_ = (unsigned)(rb_ + 3 * sgn) * 768u + 2u * m; \
          GLDS2(X.vr0, v0_, VS); GLDS2(X.vr1, v1_, VS); GLDS2(X.vr2, v2_, VS); GLDS2(X.vr3, v3_, VS); } } while (0)
#define RKS_WAIT(X) asm volatile("s_waitcnt vmcnt(36)" : "+v"(X.apf0), "+v"(X.apf1), "+v"(X.rpf0), "+v"(X.rpf1), "+v"(X.bkf0), "+v"(X.bkf1), "+v"(X.bkf2), "+v"(X.bkf3), "+v"(X.mmf), \
        "+v"(X.gl0), "+v"(X.gl1), "+v"(X.gl2), "+v"(X.gl3), "+v"(X.uw), "+v"(X.vr0), "+v"(X.vr1), "+v"(X.vr2), "+v"(X.vr3) :: "memory")
#define BF8(x) __builtin_bit_cast(bf16x8, x)
#define RKS_COMPUTE(X, c_) do { RKS_WAIT(X); \
        const float ul[4] = {bflo(X.uw.x), bfhi(X.uw.x), bflo(X.uw.y), bfhi(X.uw.y)}; const float vl[4] = {bflo(X.vr0), bflo(X.vr1), bflo(X.vr2), bflo(X.vr3)}; \
        f32x4 zp = (f32x4){0.f, 0.f, 0.f, 0.f}, yp = zp; \
        { const float lo[4] = {acc[0][0], acc[0][1], acc[0][2], acc[0][3]}, hi[4] = {acc[1][0], acc[1][1], acc[1][2], acc[1][3]}; const bf16x8 sf = pack_frag(lo, hi); zp = mfma16(BF8(X.apf0), sf, zp); yp = mfma16(BF8(X.rpf0), sf, yp); } \
        { const float lo[4] = {acc[2][0], acc[2][1], acc[2][2], acc[2][3]}, hi[4] = {acc[3][0], acc[3][1], acc[3][2], acc[3][3]}; const bf16x8 sf = pack_frag(lo, hi); zp = mfma16(BF8(X.apf1), sf, zp); yp = mfma16(BF8(X.rpf1), sf, yp); } \
        const float z[4] = {zp[0] + ul[0], zp[1] + ul[1], zp[2] + ul[2], zp[3] + ul[3]}; \
        yp = mfma16(BF8(X.mmf), pack_frag(ul, vl), yp); \
        const bf16x8 zvf = pack_frag(z, vl); \
        acc[0] = mfma16(BF8(X.bkf0), zvf, acc[0]); acc[1] = mfma16(BF8(X.bkf1), zvf, acc[1]); acc[2] = mfma16(BF8(X.bkf2), zvf, acc[2]); acc[3] = mfma16(BF8(X.bkf3), zvf, acc[3]); \
        { const f32x4 g4 = {__expf(bflo(X.gl0.x)), __expf(bfhi(X.gl0.x)), __expf(bflo(X.gl0.y)), __expf(bfhi(X.gl0.y))}; acc[0] *= g4; } \
        { const f32x4 g4 = {__expf(bflo(X.gl1.x)), __expf(bfhi(X.gl1.x)), __expf(bflo(X.gl1.y)), __expf(bfhi(X.gl1.y))}; acc[1] *= g4; } \
        { const f32x4 g4 = {__expf(bflo(X.gl2.x)), __expf(bfhi(X.gl2.x)), __expf(bflo(X.gl2.y)), __expf(bfhi(X.gl2.y))}; acc[2] *= g4; } \
        { const f32x4 g4 = {__expf(bflo(X.gl3.x)), __expf(bfhi(X.gl3.x)), __expf(bflo(X.gl3.y)), __expf(bfhi(X.gl3.y))}; acc[3] *= g4; } \
        _Pragma("unroll") for (int r = 0; r < 4; ++r) ybuf[((((c_) % 12) * 16) + 4 * q + r) * 16 + m] = yp[r]; } while (0)
    asm volatile("; SEQ_BEGIN");
    OpSet A, B, C;
    RKS_LOAD(A, 0); RKS_LOAD(B, 1);
    for (int c0 = 0; c0 < 144; c0 += 12) {
#pragma unroll
        for (int cc = 0; cc < 12; cc += 3) { const int c = c0 + cc;
            RKS_LOAD(C, c + 2); __builtin_amdgcn_sched_barrier(0);
            RKS_COMPUTE(A, c); __builtin_amdgcn_sched_barrier(0);
            { const int cn = c + 3 < 144 ? c + 3 : 143; RKS_LOAD(A, cn); } __builtin_amdgcn_sched_barrier(0);
            RKS_COMPUTE(B, c + 1); __builtin_amdgcn_sched_barrier(0);
            { const int cn = c + 4 < 144 ? c + 4 : 143; RKS_LOAD(B, cn); } __builtin_amdgcn_sched_barrier(0);
            RKS_COMPUTE(C, c + 2); __builtin_amdgcn_sched_barrier(0); }
#pragma unroll
        for (int k = 0; k < 12; ++k) { const int rr = (lane >> 2) + 16 * k, n = c0 * 16 + rr; const int grow = (rc0 - sgn * 4 * q) + sgn * n + (int)(n >= 256) * rdel;
            *(f32x4*)(Yw + (size_t)grow * 384 + (lane & 3) * 4) = *(const LAS f32x4*)(ybuf + rr * 16 + (lane & 3) * 4); }
    }
    asm volatile("; SEQ_END");
#undef RKS_LOAD
#undef RKS_COMPUTE
#undef RKS_WAIT
#undef GLDS16
#undef GLDS8
#undef GLDS2
#undef BF8
}

__device__ __forceinline__ void rwkv_finish(const Params& p, int l) {
    const int sub = threadIdx.x & 7; const int npair = (l == 0 ? NROW : NLAT) * 6;
    const bf16_t* RS = (const bf16_t*)(p.ws + U_RS); const bf16_t* KS = (const bf16_t*)(p.ws + U_KS); const bf16_t* VS = (const bf16_t*)(p.ws + U_VS);
    const bf16_t* AG0 = (const bf16_t*)(p.ws + U_AG); const bf16_t* AG1 = (const bf16_t*)(p.ws + U_AG + SZ384); const bf16_t* G = (const bf16_t*)(p.ws + U_G);
    const float* Y0 = (const float*)(p.ws + U_YRK); const float* Y1 = Y0 + (size_t)NROW * 384; bf16_t* YC = (bf16_t*)(p.ws + WS_ABUF);
    for (int pr = (blockIdx.x * NTHR + threadIdx.x) >> 3; pr < npair; pr += (gridDim.x * NTHR) >> 3) { const int row = pr / 6, h = pr % 6, col = h * 64 + sub * 8; const size_t o = (size_t)row * 384 + col;
        float y[8]; { const float4 a0 = *(const float4*)(Y0 + o), a1 = *(const float4*)(Y0 + o + 4), c0 = *(const float4*)(Y1 + o), c1 = *(const float4*)(Y1 + o + 4);
            y[0] = a0.x + c0.x; y[1] = a0.y + c0.y; y[2] = a0.z + c0.z; y[3] = a0.w + c0.w; y[4] = a1.x + c1.x; y[5] = a1.y + c1.y; y[6] = a1.z + c1.z; y[7] = a1.w + c1.w; }
        float s = 0.f;
#pragma unroll
        for (int k = 0; k < 8; ++k) s += y[k];
        s += __shfl_xor(s, 1); s += __shfl_xor(s, 2); s += __shfl_xor(s, 4); const float mean = s * (1.0f / 64.0f);
        float v2 = 0.f;
#pragma unroll
        for (int k = 0; k < 8; ++k) { const float dd = y[k] - mean; v2 += dd * dd; }
        v2 += __shfl_xor(v2, 1); v2 += __shfl_xor(v2, 2); v2 += __shfl_xor(v2, 4); const float rstd = rsqrtf(v2 * (1.0f / 64.0f) + 64e-5f);
        float r[8], kx[8], vx[8], a0[8], a1[8], gx[8];
        unpack8(*(const uint4*)(RS + o), r); unpack8(*(const uint4*)(KS + o), kx); unpack8(*(const uint4*)(VS + o), vx); unpack8(*(const uint4*)(AG0 + o), a0); unpack8(*(const uint4*)(AG1 + o), a1); unpack8(*(const uint4*)(G + o), gx);
        const float* ka = p.in[27] + l * 384 + col; const float* rk = p.in[28] + l * 384 + col; const float* lw = p.in[29] + l * 384 + col; const float* lb = p.in[30] + l * 384 + col;
        float bs = 0.f;
#pragma unroll
        for (int k = 0; k < 8; ++k) { const float kd0 = kx[k] * (1.0f + (a0[k] - 1.0f) * ka[k]), kd1 = kx[k] * (1.0f + (a1[k] - 1.0f) * ka[k]); bs += r[k] * (kd0 + kd1) * rk[k]; }
        bs += __shfl_xor(bs, 1); bs += __shfl_xor(bs, 2); bs += __shfl_xor(bs, 4);
        float ov[8];
#pragma unroll
        for (int k = 0; k < 8; ++k) ov[k] = ((y[k] - mean) * rstd * lw[k] + lb[k] + bs * vx[k]) * gx[k];
        *(uint4*)(YC + (size_t)row * 1024 + 640 + col) = pack8(ov);
    }
}

__device__ __forceinline__ void phase_normrouter(const Params& p, int l, const float* xl, const float* xc, LAS unsigned char* lds) {
    LAS float* hrow = (LAS float*)lds;
    LAS float* part = (LAS float*)(lds + 32768);
    const int lane = threadIdx.x & 63, wv = threadIdx.x >> 6, e = lane & 15, cq = lane >> 4; const int ngrp = (l == 0 ? NROW : NLAT) / 8;
    const float* mod = (const float*)(p.ws + WS_MOD) + (size_t)l * 17 * 6144; const float* g1 = p.in[6] + (l * 4 + 1) * 1024; const float* g2 = p.in[6] + (l * 4 + 2) * 1024;
    const bf16_t* Y = (const bf16_t*)(p.ws + U_Y); unsigned char* A8 = p.ws + WS_ABUF; float* AFF = (float*)(p.ws + WS_AFF);
    float wr[32];
#pragma unroll
    for (int j = 0; j < 32; ++j) wr[j] = p.in[31][((size_t)l * 1024 + 128 * wv + 32 * cq + j) * 16 + e];
    for (int gi = blockIdx.x; gi < ngrp; gi += gridDim.x) { const int r = gi * 8 + wv; const int b = r < NLAT ? (r >> 11) : 16; const float* mb = mod + (size_t)b * 6144;
        const float* xs = xrow(xl, xc, r); float* xd = xrow_w(p.out, (float*)(p.ws + WS_CTXA), r);
        float4 y[4], x[4]; float ss = 0.f;
#pragma unroll
        for (int i = 0; i < 4; ++i) { { const u32x2 yw = *(const u32x2*)(Y + (size_t)r * 1024 + i * 256 + lane * 4); y[i] = make_float4(bflo(yw.x), bfhi(yw.x), bflo(yw.y), bfhi(yw.y)); } x[i] = *(const float4*)(xs + i * 256 + lane * 4); ss += y[i].x * y[i].x + y[i].y * y[i].y + y[i].z * y[i].z + y[i].w * y[i].w; }
        ss = wave_sum(ss); const float rs = rsqrtf(ss * (1.0f / 1024.0f) + 1e-6f);
        float s2 = 0.f;
#pragma unroll
        for (int i = 0; i < 4; ++i) { const int c = i * 256 + lane * 4; const float4 gg = *(const float4*)(g1 + c), gt = *(const float4*)(mb + 2048 + c);
            x[i].x += gt.x * (y[i].x * rs * gg.x); x[i].y += gt.y * (y[i].y * rs * gg.y); x[i].z += gt.z * (y[i].z * rs * gg.z); x[i].w += gt.w * (y[i].w * rs * gg.w);
            *(float4*)(xd + c) = x[i]; s2 += x[i].x * x[i].x + x[i].y * x[i].y + x[i].z * x[i].z + x[i].w * x[i].w; }
        s2 = wave_sum(s2); const float rs2 = rsqrtf(s2 * (1.0f / 1024.0f) + 1e-6f);
        float hv[4][4]; float amax = 0.f;
        __syncthreads();
#pragma unroll
        for (int i = 0; i < 4; ++i) { const int c = i * 256 + lane * 4; const float4 gg = *(const float4*)(g2 + c), sh = *(const float4*)(mb + 3072 + c), sc = *(const float4*)(mb + 4096 + c);
            hv[i][0] = x[i].x * rs2 * gg.x * (1.f + sc.x) + sh.x; hv[i][1] = x[i].y * rs2 * gg.y * (1.f + sc.y) + sh.y; hv[i][2] = x[i].z * rs2 * gg.z * (1.f + sc.z) + sh.z; hv[i][3] = x[i].w * rs2 * gg.w * (1.f + sc.w) + sh.w;
            *(LAS lf4*)(hrow + wv * 1024 + c) = (lf4){hv[i][0], hv[i][1], hv[i][2], hv[i][3]};
            amax = fmaxf(amax, fmaxf(fmaxf(fabsf(hv[i][0]), fabsf(hv[i][1])), fmaxf(fabsf(hv[i][2]), fabsf(hv[i][3])))); }
#pragma unroll
        for (int o = 32; o >= 1; o >>= 1) amax = fmaxf(amax, __shfl_xor(amax, o));
        amax = fmaxf(amax, 1e-20f); const float qs = 127.0f / amax;
        if (lane == 0) ((float*)(p.ws + WS_SX))[r] = amax * (1.0f / 127.0f);
#pragma unroll
        for (int i = 0; i < 4; ++i) { unsigned w = 0u;
#pragma unroll
            for (int k = 0; k < 4; ++k) w |= ((unsigned)__float2int_rn(hv[i][k] * qs) & 255u) << (8 * k);
            *(unsigned*)(A8 + (size_t)r * 1024 + i * 256 + lane * 4) = w; }
        __syncthreads();
#pragma unroll 2
        for (int rr = 0; rr < 8; ++rr) { const LAS float* hp = hrow + rr * 1024 + 128 * wv + 32 * cq; float acc = 0.f;
#pragma unroll
            for (int j4 = 0; j4 < 8; ++j4) { const lf4 h4 = *(const LAS lf4*)(hp + 4 * j4); acc += h4.x * wr[4 * j4] + h4.y * wr[4 * j4 + 1] + h4.z * wr[4 * j4 + 2] + h4.w * wr[4 * j4 + 3]; }
            acc += __shfl_xor(acc, 16); acc += __shfl_xor(acc, 32);
            if (cq == 0) part[(rr * 8 + wv) * 16 + e] = acc; }
        __syncthreads();
        if (lane < 16) { float lgt = 0.f;
#pragma unroll
            for (int w = 0; w < 8; ++w) lgt += part[(wv * 8 + w) * 16 + lane];
            float mxl = lgt;
#pragma unroll
            for (int o = 8; o >= 1; o >>= 1) mxl = fmaxf(mxl, __shfl_xor(mxl, o));
            const float ex = expf(lgt - mxl); float den = ex;
#pragma unroll
            for (int o = 8; o >= 1; o >>= 1) den += __shfl_xor(den, o);
            AFF[(size_t)r * 16 + lane] = ex / den; }
    }
}

__device__ __forceinline__ void phase_topk(const Params& p, int l, LAS unsigned char* lds) {
    LAS unsigned* keys = (LAS unsigned*)lds;
    LAS int* toks = (LAS int*)(lds + 8192);
    LAS unsigned* hist = (LAS unsigned*)(lds + 9216);
    LAS unsigned* wtot = (LAS unsigned*)(lds + 10240);
    LAS unsigned* sel = (LAS unsigned*)(lds + 10304);
    const int tid = threadIdx.x, lane = tid & 63, wv = tid >> 6, nitem = l == 0 ? 512 : 256;
    const float* AFF = (const float*)(p.ws + WS_AFF); int* SLOT = (int*)(p.ws + WS_SLOT); float* SELG = (float*)(p.ws + WS_SELG);
    const bf16_t* A = (const bf16_t*)(p.ws + WS_ABUF); bf16_t* XS = (bf16_t*)(p.ws + U_XSEL);
    for (int it = blockIdx.x; it < nitem; it += gridDim.x) { const bool lat = it < 256; const int be = it & 255, b = be >> 4, e = be & 15;
        const int n = lat ? SEQ : CTXL, cap = lat ? 256 : 32, rowbase = lat ? b * 2048 : NLAT + b * 256, xoff = lat ? b * 256 : 4096 + b * 32;
        const int per = n / NTHR > 0 ? n / NTHR : 1;
        const int t0 = tid * per; const bool act = t0 < n;
        unsigned kx[4];
        __syncthreads();
#pragma unroll
        for (int j = 0; j < 4; ++j) { kx[j] = 0u; if (act && j < per) { kx[j] = __float_as_uint(AFF[(size_t)(rowbase + t0 + j) * 16 + e]); keys[t0 + j] = kx[j]; } }
        unsigned prefix = 0u; int krem = cap;
        for (int pass = 0; pass < 4; ++pass) { const int shift = 24 - 8 * pass;
            if (tid < 256) hist[tid] = 0u;
            __syncthreads();
#pragma unroll
            for (int j = 0; j < 4; ++j) if (act && j < per) { const bool match = pass == 0 || (kx[j] >> (shift + 8)) == (prefix >> (shift + 8)); if (match) atomicAdd((unsigned*)&hist[(kx[j] >> shift) & 255u], 1u); }
            __syncthreads();
            if (tid < 256) { unsigned above = 0u; for (int bb = tid + 1; bb < 256; ++bb) above += hist[bb]; const unsigned mine = hist[tid];
                if (above < (unsigned)krem && above + mine >= (unsigned)krem) { sel[0] = (unsigned)tid; sel[1] = (unsigned)krem - above; } }
            __syncthreads();
            prefix |= sel[0] << shift; krem = (int)sel[1];
            __syncthreads();
        }
        unsigned loc = 0u, pre[4];
#pragma unroll
        for (int j = 0; j < 4; ++j) { pre[j] = loc; if (act && j < per) loc += (kx[j] > prefix ? 1u : 0u) + (kx[j] == prefix ? 65536u : 0u); }
        unsigned inc = loc;
#pragma unroll
        for (int o = 1; o < 64; o <<= 1) { const unsigned t = __shfl_up(inc, o); if (lane >= o) inc += t; }
        if (lane == 63) wtot[wv] = inc;
        __syncthreads();
        unsigned base = inc - loc;
        for (int w = 0; w < wv; ++w) base += wtot[w];
#pragma unroll
        for (int j = 0; j < 4; ++j) if (act && j < per) { const unsigned c = base + pre[j]; const int gtb = (int)(c & 0xffffu), eqb = (int)(c >> 16);
            const bool s = kx[j] > prefix || (kx[j] == prefix && eqb < krem); const int slot = gtb + (eqb < krem ? eqb : krem);
            if (s) { SELG[e * XROWS + xoff + slot] = __uint_as_float(kx[j]); toks[slot] = t0 + j; }
            SLOT[(size_t)(rowbase + t0 + j) * 16 + e] = s ? slot : -1; }
        __syncthreads();
        for (int s = wv; s < cap; s += 8) { const int row = rowbase + toks[s]; const lu4* src = (const lu4*)((const unsigned char*)A + (size_t)row * 1024); lu4* dst = (lu4*)((unsigned char*)XS + ((size_t)e * XROWS + xoff + s) * 1024);
            dst[lane] = src[lane]; if (lane == 0) ((float*)(p.ws + WS_SXS))[e * XROWS + xoff + s] = ((const float*)(p.ws + WS_SX))[row]; }
    }
}

struct GroupedOrder { int nMl, nNl, pnb, G, c, total;
    __device__ void init(int nMl_, int nNl_, int pnb_, int G_, int c_) { nMl = nMl_; nNl = nNl_; pnb = pnb_; G = G_; c = c_; total = 16 * nMl_ * nNl_; }
    __device__ bool next(int i, pg8::Unit& u) const {
        int L;
        if ((G & 7) == 0 && (total & 7) == 0) { const int W = G >> 3, x = c & 7, r = c >> 3, t8 = total >> 3, k = i * W + r; if (k >= t8) return false; L = x * t8 + k; }
        else { const long LL = (long)i * G + c; if (LL >= total) return false; L = (int)LL; }
        const int per = nMl * nNl, e = L / per, idx = L % per, blk = idx / (pnb * nMl), rem = idx % (pnb * nMl), pml = rem / pnb, pnl = blk * pnb + rem % pnb;
        u.pm = e * 18 + pml; u.pn = e * nNl + pnl; return true; }
    __device__ __forceinline__ void a_ready(const pg8::Unit&) const {}
    __device__ __forceinline__ void done(const pg8::Unit&) const {}
};
struct EpiSwiGLU { static constexpr bool PERM = true, AFTER_DRAIN = false; unsigned char* H; const float* sx; const float* sw;
    __device__ __forceinline__ void operator()(const f32x4 (&acc)[2][2][4][2], const pg8::Unit& u, int wr, int wc, int fr, int fq) const {
        typedef int i32x4_ __attribute__((ext_vector_type(4)));
        const int e = u.pn / 22, pnl = u.pn - e * 22; const int row0 = u.pm * 256 + wr * 64 + fr, col0 = pnl * 128 + wc * 32 + 8 * fq;
        const float* swp = sw + (size_t)u.pn * 256 + wc * 32 + 8 * fq; const float4 g0 = *(const float4*)swp, g1 = *(const float4*)(swp + 4), u0 = *(const float4*)(swp + 128), u1 = *(const float4*)(swp + 132);
        const float swg[8] = {g0.x, g0.y, g0.z, g0.w, g1.x, g1.y, g1.z, g1.w}, swu[8] = {u0.x, u0.y, u0.z, u0.w, u1.x, u1.y, u1.z, u1.w};
#pragma unroll
        for (int ai = 0; ai < 2; ++ai)
#pragma unroll
            for (int m = 0; m < 4; ++m) { const int r = row0 + ai * 128 + m * 16; const float sr = sx[r]; unsigned char* rowp = H + (size_t)r * DE + col0; float o[8];
#pragma unroll
                for (int n = 0; n < 2; ++n) { const i32x4_ ig = __builtin_bit_cast(i32x4_, acc[ai][0][m][n]), iu = __builtin_bit_cast(i32x4_, acc[ai][1][m][n]);
#pragma unroll
                    for (int j = 0; j < 4; ++j) { const float g = (float)ig[j] * (sr * swg[n * 4 + j]), uu = (float)iu[j] * (sr * swu[n * 4 + j]); o[n * 4 + j] = g * sigm(g) * uu; } }
                u32x2 w8; { int t0 = 0, t1 = 0; t0 = __builtin_amdgcn_cvt_pk_fp8_f32(o[0], o[1], t0, false); t0 = __builtin_amdgcn_cvt_pk_fp8_f32(o[2], o[3], t0, true); t1 = __builtin_amdgcn_cvt_pk_fp8_f32(o[4], o[5], t1, false); t1 = __builtin_amdgcn_cvt_pk_fp8_f32(o[6], o[7], t1, true); w8.x = (unsigned)t0; w8.y = (unsigned)t1; }
                *(u32x2*)rowp = w8; }
    }
};
struct EpiScaleBf16 { static constexpr bool PERM = true, AFTER_DRAIN = false; bf16_t* O; int ldc; const float* sx; const float* sw;
    __device__ __forceinline__ void operator()(const f32x4 (&acc)[2][2][4][2], const pg8::Unit& u, int wr, int wc, int fr, int fq) const {
        typedef int i32x4_ __attribute__((ext_vector_type(4)));
        const int row0 = u.pm * 256 + wr * 64 + fr, col0 = u.pn * 256 + wc * 32 + 8 * fq;
        float swv[2][8];
#pragma unroll
        for (int bj = 0; bj < 2; ++bj) { const float4 a = *(const float4*)(sw + col0 + bj * 128), b = *(const float4*)(sw + col0 + bj * 128 + 4); swv[bj][0] = a.x; swv[bj][1] = a.y; swv[bj][2] = a.z; swv[bj][3] = a.w; swv[bj][4] = b.x; swv[bj][5] = b.y; swv[bj][6] = b.z; swv[bj][7] = b.w; }
#pragma unroll
        for (int ai = 0; ai < 2; ++ai)
#pragma unroll
            for (int m = 0; m < 4; ++m) { const int r = row0 + ai * 128 + m * 16; const float sr = sx[r]; bf16_t* rowp = O + (size_t)r * ldc + col0;
#pragma unroll
                for (int bj = 0; bj < 2; ++bj) { float o[8];
#pragma unroll
                    for (int n = 0; n < 2; ++n) { const i32x4_ iv = __builtin_bit_cast(i32x4_, acc[ai][bj][m][n]);
#pragma unroll
                        for (int j = 0; j < 4; ++j) o[n * 4 + j] = (float)iv[j] * (sr * swv[bj][n * 4 + j]); }
                    *(uint4*)(rowp + bj * 128) = pack8(o); } }
    }
};
struct EpiGate { static constexpr bool PERM = true, AFTER_DRAIN = false; bf16_t* O; const float* gate; const float* sw;
    __device__ __forceinline__ void operator()(const f32x4 (&acc)[2][2][4][2], const pg8::Unit& u, int wr, int wc, int fr, int fq) const {
        pg8::fp8_acc_settle();
        const int pnl = u.pn & 3; const int row0 = u.pm * 256 + wr * 64 + fr, col0 = pnl * 256 + wc * 32 + 8 * fq;
#pragma unroll
        for (int bj = 0; bj < 2; ++bj) { const float* sp = sw + (size_t)u.pn * 256 + wc * 32 + 8 * fq + bj * 128; const float4 sa = *(const float4*)sp, sb = *(const float4*)(sp + 4);
#pragma unroll
            for (int ai = 0; ai < 2; ++ai)
#pragma unroll
                for (int m = 0; m < 4; ++m) { const int r = row0 + ai * 128 + m * 16; const float gt = gate[r]; const f32x4 v0 = acc[ai][bj][m][0], v1 = acc[ai][bj][m][1];
                    u32x4 w; w.x = pack2(v0[0] * (gt * sa.x), v0[1] * (gt * sa.y)); w.y = pack2(v0[2] * (gt * sa.z), v0[3] * (gt * sa.w)); w.z = pack2(v1[0] * (gt * sb.x), v1[1] * (gt * sb.y)); w.w = pack2(v1[2] * (gt * sb.z), v1[3] * (gt * sb.w));
                    *(u32x4*)(O + (size_t)r * 1024 + col0 + bj * 128) = w; } }
    }
};

__device__ __forceinline__ void phase_combine(const Params& p, int l) {
    const int lane = threadIdx.x & 63, wv = threadIdx.x >> 6; const int nrow = l == 0 ? NROW : NLAT;
    const float* mod = (const float*)(p.ws + WS_MOD) + (size_t)l * 17 * 6144; const float* g3 = p.in[6] + (l * 4 + 3) * 1024;
    const int* SLOT = (const int*)(p.ws + WS_SLOT); const bf16_t* YE = (const bf16_t*)(p.ws + U_YEXP); bf16_t* A = (bf16_t*)(p.ws + WS_ABUF);
    for (int r = blockIdx.x * 8 + wv; r < nrow; r += gridDim.x * 8) { const bool lat = r < NLAT; const int b = lat ? (r >> 11) : ((r - NLAT) >> 8), mbi = lat ? b : 16, xoff = lat ? b * 256 : 4096 + b * 32;
        const float* mb = mod + (size_t)mbi * 6144;
        float f[16];
#pragma unroll
        for (int k = 0; k < 16; ++k) f[k] = 0.f;
        const int myslot = lane < 16 ? SLOT[(size_t)r * 16 + lane] : -1;
        for (int e = 0; e < 16; ++e) { const int s = __shfl(myslot, e); if (s >= 0) { const bf16_t* yr = YE + ((size_t)e * XROWS + xoff + s) * 1024 + lane * 4;
#pragma unroll
                for (int i = 0; i < 4; ++i) { const u32x2 w = *(const u32x2*)(yr + i * 256); f[i * 4] += bflo(w.x); f[i * 4 + 1] += bfhi(w.x); f[i * 4 + 2] += bflo(w.y); f[i * 4 + 3] += bfhi(w.y); } } }
        float ss = 0.f;
#pragma unroll
        for (int k = 0; k < 16; ++k) ss += f[k] * f[k];
        ss = wave_sum(ss); const float rs = rsqrtf(ss * (1.0f / 1024.0f) + 1e-6f);
        const float* x1 = xrow(p.out, (const float*)(p.ws + WS_CTXA), r);
        float* x2 = l == 0 ? xrow_w((float*)(p.ws + WS_XB), (float*)(p.ws + WS_CTXB), r) : p.out + (size_t)r * D;
        float4 xv[4];
#pragma unroll
        for (int i = 0; i < 4; ++i) { const int c = i * 256 + lane * 4; const float4 gg = *(const float4*)(g3 + c), gt = *(const float4*)(mb + 5120 + c); float4 x = *(const float4*)(x1 + c);
            x.x += gt.x * (f[i * 4] * rs * gg.x); x.y += gt.y * (f[i * 4 + 1] * rs * gg.y); x.z += gt.z * (f[i * 4 + 2] * rs * gg.z); x.w += gt.w * (f[i * 4 + 3] * rs * gg.w);
            *(float4*)(x2 + c) = x; xv[i] = x; }
        if (l == 0) { const float* mb1 = mod + (size_t)17 * 6144 + (size_t)mbi * 6144; hnorm_row(p.in[6] + 4 * 1024, mb1, mb1 + 1024, p.ws + WS_ABUF + (size_t)r * 1024, (float*)(p.ws + WS_SH) + r, lane, xv); }
    }
}

#ifndef MK_ONLY
#define MK_ONLY -1
#endif
#define EN(k) (MK_ONLY < 0 || MK_ONLY == (k))
#ifndef MK_DUP
#define MK_DUP 0
#endif
#define NREP(k) ((((MK_DUP) >> (k)) & 1) ? 2 : 1)
constexpr int PH_PER_LAYER = 14, N_PHASES = 1 + 2 * PH_PER_LAYER;
#define IN(k) (lo <= (k) && (k) < hi)
#define SEAM(k) do { if (p.use_bar && IN(k) && IN((k) + 1)) xcd_barrier(bar); } while (0)
template <int l> __device__ __forceinline__ void layer_phases(const Params& p, LAS unsigned char* lds, const XcdBarrier& bar, const int lo, const int hi) {
    const int wv = __builtin_amdgcn_readfirstlane(threadIdx.x >> 6), G = gridDim.x; const int wid = blockIdx.x * 8 + wv, nw = G * 8;
        const int pb = 1 + l * PH_PER_LAYER;
        const float* xl = l == 0 ? p.in[0] : (const float*)(p.ws + WS_XB);
        const float* xc = l == 0 ? p.in[2] : (const float*)(p.ws + WS_CTXB);
        if (EN(0) && IN(pb + 0)) { { if (l == 0) phase_hnorm(p, 0, xl, xc); }
            if ((NREP(0)) == 2) { if (l == 0) phase_hnorm(p, 0, xl, xc); } }
        SEAM(pb + 0);
        if (EN(1) && IN(pb + 1)) { { pg8::Gemm g{(const bf16_t*)(p.ws + WS_ABUF), (const bf16_t*)(p.ws + WS_WIN), NROW, NINP, D / 2}; pg8::StaticOrder S; S.init(NROW, NINP, G, (int)blockIdx.x);
            EpiScaleBf16 E{(bf16_t*)(p.ws + U_P), NINP, (const float*)(p.ws + WS_SH), (const float*)(p.ws + WS_SWIN)}; pg8::gemm_phase<EpiScaleBf16, pg8::StaticOrder, false, 1>(lds, g, S, E, nullptr); }
            if ((NREP(1)) == 2) { pg8::Gemm g{(const bf16_t*)(p.ws + WS_ABUF), (const bf16_t*)(p.ws + WS_WIN), NROW, NINP, D / 2}; pg8::StaticOrder S; S.init(NROW, NINP, G, (int)blockIdx.x);
            EpiScaleBf16 E{(bf16_t*)(p.ws + U_P), NINP, (const float*)(p.ws + WS_SH), (const float*)(p.ws + WS_SWIN)}; pg8::gemm_phase<EpiScaleBf16, pg8::StaticOrder, false, 1>(lds, g, S, E, nullptr); } }
        SEAM(pb + 1);
        if (EN(2) && IN(pb + 2)) { phase_prep(p, l, lds);
            if ((NREP(2)) == 2) phase_prep(p, l, lds); }
        SEAM(pb + 2);
        if (EN(3) && IN(pb + 3)) { { lowrank_items(p, l, wid, nw); s5_pass1_items(p, l, wid, nw); }
            if ((NREP(3)) == 2) { lowrank_items(p, l, wid, nw); s5_pass1_items(p, l, wid, nw); } }
        SEAM(pb + 3);
        if (EN(4) && IN(pb + 4)) { { s5_carry(p, l); na_items(p, l, wid, nw, lds); }
            if ((NREP(4)) == 2) { s5_carry(p, l); na_items(p, l, wid, nw, lds); } }
        SEAM(pb + 4);
        if (EN(5) && IN(pb + 5)) { { s5_pass2_items(p, l, wid, nw); rwkv_pre_items(p, l, wid, nw, lds); }
            if ((NREP(5)) == 2) { s5_pass2_items(p, l, wid, nw); rwkv_pre_items(p, l, wid, nw, lds); } }
        SEAM(pb + 5);
        if (EN(6) && IN(pb + 6)) {
            if (G > 192) { const int bx = (int)blockIdx.x;
                if (bx < 192) { if (wv < 4) rwkv_seq_task(p, l, bx * 4 + wv, lds); } else s5_glu_items(p, l, (bx - 192) * 8 + wv, (G - 192) * 8);
                if ((NREP(6)) == 2) { if (bx < 192) { if (wv < 4) rwkv_seq_task(p, l, bx * 4 + wv, lds); } else s5_glu_items(p, l, (bx - 192) * 8 + wv, (G - 192) * 8); } }
            else { for (int task = wid; task < 768; task += nw) rwkv_seq_task(p, l, task, lds); s5_glu_items(p, l, wid, nw); } }
        SEAM(pb + 6);
        if (EN(7) && IN(pb + 7)) { rwkv_finish(p, l);
            if ((NREP(7)) == 2) rwkv_finish(p, l); }
        SEAM(pb + 7);
        if (EN(8) && IN(pb + 8)) { { const int M = l == 0 ? NROW : NLAT; pg8::Gemm g{(const bf16_t*)(p.ws + WS_ABUF), (const bf16_t*)(p.ws + WS_WOUT), M, D, D}; pg8::StaticOrder S; S.init(M, D, G, (int)blockIdx.x);
            pg8::EpiBf16<0> E{(bf16_t*)(p.ws + U_Y), D, nullptr, 0, 0}; pg8::gemm_phase<pg8::EpiBf16<0>, pg8::StaticOrder, false>(lds, g, S, E, nullptr); }
            if ((NREP(8)) == 2) { const int M = l == 0 ? NROW : NLAT; pg8::Gemm g{(const bf16_t*)(p.ws + WS_ABUF), (const bf16_t*)(p.ws + WS_WOUT), M, D, D}; pg8::StaticOrder S; S.init(M, D, G, (int)blockIdx.x);
            pg8::EpiBf16<0> E{(bf16_t*)(p.ws + U_Y), D, nullptr, 0, 0}; pg8::gemm_phase<pg8::EpiBf16<0>, pg8::StaticOrder, false>(lds, g, S, E, nullptr); } }
        SEAM(pb + 8);
        if (EN(9) && IN(pb + 9)) { phase_normrouter(p, l, xl, xc, lds);
            if ((NREP(9)) == 2) phase_normrouter(p, l, xl, xc, lds); }
        SEAM(pb + 9);
        if (EN(10) && IN(pb + 10)) { phase_topk(p, l, lds);
            if ((NREP(10)) == 2) phase_topk(p, l, lds); }
        SEAM(pb + 10);
        if (EN(11) && IN(pb + 11)) { { pg8::Gemm g{(const bf16_t*)(p.ws + U_XSEL), (const bf16_t*)(p.ws + WS_WGU), 16 * XROWS, 16 * 5632, D / 2}; GroupedOrder S; S.init(l == 0 ? 18 : 16, 22, 2, G, (int)blockIdx.x);
            EpiSwiGLU E{p.ws + U_HID, (const float*)(p.ws + WS_SXS), (const float*)(p.ws + WS_SW8)}; pg8::gemm_phase<EpiSwiGLU, GroupedOrder, false, 1>(lds, g, S, E, nullptr); }
            if ((NREP(11)) == 2) { pg8::Gemm g{(const bf16_t*)(p.ws + U_XSEL), (const bf16_t*)(p.ws + WS_WGU), 16 * XROWS, 16 * 5632, D / 2}; GroupedOrder S; S.init(l == 0 ? 18 : 16, 22, 2, G, (int)blockIdx.x);
            EpiSwiGLU E{p.ws + U_HID, (const float*)(p.ws + WS_SXS), (const float*)(p.ws + WS_SW8)}; pg8::gemm_phase<EpiSwiGLU, GroupedOrder, false, 1>(lds, g, S, E, nullptr); } }
        SEAM(pb + 11);
        if (EN(12) && IN(pb + 12)) { { pg8::Gemm g{(const bf16_t*)(p.ws + U_HID), (const bf16_t*)(p.ws + WS_WD), 16 * XROWS, 16 * 1024, DE / 2}; GroupedOrder S; S.init(l == 0 ? 18 : 16, 4, 4, G, (int)blockIdx.x);
            EpiGate E{(bf16_t*)(p.ws + U_YEXP), (const float*)(p.ws + WS_SELG), (const float*)(p.ws + WS_SWD)}; pg8::gemm_phase<EpiGate, GroupedOrder, false, 2>(lds, g, S, E, nullptr); }
            if ((NREP(12)) == 2) { pg8::Gemm g{(const bf16_t*)(p.ws + U_HID), (const bf16_t*)(p.ws + WS_WD), 16 * XROWS, 16 * 1024, DE / 2}; GroupedOrder S; S.init(l == 0 ? 18 : 16, 4, 4, G, (int)blockIdx.x);
            EpiGate E{(bf16_t*)(p.ws + U_YEXP), (const float*)(p.ws + WS_SELG), (const float*)(p.ws + WS_SWD)}; pg8::gemm_phase<EpiGate, GroupedOrder, false, 2>(lds, g, S, E, nullptr); } }
        SEAM(pb + 12);
        if (EN(13) && IN(pb + 13)) { { phase_combine(p, l); if (l == 0) convert_weights(p, 1, lds, (int)blockIdx.x, G); }
            if (((l == 0 ? NREP(13) : 1)) == 2) { phase_combine(p, l); if (l == 0) convert_weights(p, 1, lds, (int)blockIdx.x, G); } }
        SEAM(pb + 13);
}
__global__ void __launch_bounds__(NTHR, 2) fwd(Params p) {
    extern __shared__ __attribute__((aligned(16))) unsigned char lds_raw[];
    LAS unsigned char* lds = (LAS unsigned char*)lds_raw;
    const int tid = threadIdx.x;
    if (tid < 4) ((LAS unsigned*)(lds + LDS_MISC))[tid] = 0u;
    __syncthreads();
    XcdBarrier bar; bar.bar = (unsigned*)(p.ws + WS_CTL); bar.x = 0; bar.st = (volatile LAS unsigned*)(lds + LDS_MISC);
    if (p.use_bar) bar = xcd_barrier_post((unsigned*)(p.ws + WS_CTL), (volatile LAS unsigned*)(lds + LDS_MISC));
    const int lo = p.ph_lo, hi = p.ph_hi;

    if (EN(100) && IN(0)) { { phase_prologue(p, lds); }
        if ((NREP(14)) == 2) { phase_prologue(p, lds); } }
    SEAM(0);
    layer_phases<0>(p, lds, bar, lo, hi);
    layer_phases<1>(p, lds, bar, lo, hi);
#undef IN
#undef SEAM
}
}

#ifndef MK_ONE_LAUNCH
#define MK_ONE_LAUNCH 1
#endif
extern "C" void kernel_launch(void* const* d_in, const int* in_sizes, int n_in, void* d_out, int out_size, void* d_ws, size_t ws_size, hipStream_t stream) {
    static int grid = 0;
    if (grid == 0) {
        if (n_in != 35 || out_size != mk::NLAT * mk::D || ws_size < mk::WS_END) { fprintf(stderr, "kernel_launch: unexpected problem (n_in %d, out %d, ws %zu < %zu)\n", n_in, out_size, ws_size, (size_t)mk::WS_END); grid = -1; return; }
        int dev = 0, cus = 0, per_cu = 0;
        if (hipGetDevice(&dev) != hipSuccess || hipDeviceGetAttribute(&cus, hipDeviceAttributeMultiprocessorCount, dev) != hipSuccess) { grid = -1; return; }
        if (hipFuncSetAttribute((const void*)mk::fwd, hipFuncAttributeMaxDynamicSharedMemorySize, mk::LDS_BYTES) != hipSuccess) { fprintf(stderr, "kernel_launch: hipFuncSetAttribute failed\n"); grid = -1; return; }
        if (hipOccupancyMaxActiveBlocksPerMultiprocessor(&per_cu, (const void*)mk::fwd, mk::NTHR, mk::LDS_BYTES) != hipSuccess || per_cu < 1) { fprintf(stderr, "kernel_launch: occupancy query says %d\n", per_cu); per_cu = 1; }
        (void)hipGetLastError();
        grid = cus;
    }
    if (grid < 0) return;
    (void)in_sizes;
    if (hipMemsetAsync(d_ws, 0, 65536, stream) != hipSuccess) return;
    mk::Params a{};
    for (int i = 0; i < 35; ++i) a.in[i] = (const float*)d_in[i];
    a.out = (float*)d_out; a.ws = (unsigned char*)d_ws;
#if MK_ONE_LAUNCH
    a.ph_lo = 0; a.ph_hi = mk::N_PHASES; a.use_bar = 1;
    hipLaunchKernelGGL(mk::fwd, dim3(grid), dim3(mk::NTHR), mk::LDS_BYTES, stream, a);
#else
    for (int ph = 0; ph < mk::N_PHASES; ++ph) { a.ph_lo = ph; a.ph_hi = ph + 1; a.use_bar = 0; hipLaunchKernelGGL(mk::fwd, dim3(grid), dim3(mk::NTHR), mk::LDS_BYTES, stream, a); }
#endif
}
```

```cpp
#include <hip/hip_runtime.h>
#include <cstdio>
#include <cstdint>
namespace pg8 {
#define PG8_LAS __attribute__((address_space(3)))
typedef unsigned short bf16_t;
typedef short bf16x8 __attribute__((ext_vector_type(8)));
typedef float f32x4 __attribute__((ext_vector_type(4)));
typedef unsigned u32x4 __attribute__((ext_vector_type(4)));
constexpr int BM = 256, BK = 64, HALF = 128, HTB = HALF * BK * 2  , STAGE_BYTES = 8 * HTB, NXCD = 8, WGM = 8;

__host__ __device__ __forceinline__ int lds_byte(int r, int c) { const int st = (r >> 4) * 2 + (c >> 5), rr = r & 15, cc = c & 31, ob = rr * 64 + cc * 2; return st * 1024 + (ob ^ (((ob >> 9) & 1) << 5)); }
__host__ __device__ __forceinline__ void stage_rc(int b, int& R, int& C) { const int st = b / 1024, sb = b % 1024, swz = sb ^ (((sb >> 9) & 1) << 5); R = (st >> 1) * 16 + swz / 64; C = (st & 1) * 32 + (swz % 64) / 2; }
__host__ __device__ __forceinline__ int perm32(int rho) { const int n = rho >> 4, i = rho & 15; return 8 * (i >> 2) + 4 * n + (i & 3); }

struct Unit { int pm, pn; };
struct Gemm { const bf16_t* A; const bf16_t* Bt; int M, N, K; };

struct StaticOrder {
    int nM, nN, nwg, G, c;
    __host__ __device__ void init(int M, int N, int G_, int c_) { nM = M / BM; nN = N / BM; nwg = nM * nN; G = G_; c = c_; }
    __host__ __device__ bool next(int i, Unit& u) const {
        const long L = (long)i * G + c; if (L >= nwg) return false;
        int wgid = (int)L; { const int q = nwg / NXCD, r = nwg % NXCD, xcd = wgid % NXCD, off = wgid / NXCD; wgid = (xcd < r ? xcd * (q + 1) : r * (q + 1) + (xcd - r) * q) + off; }
        const int nig = WGM * nN, gid = wgid / nig, fm = gid * WGM, gsz = (nM - fm) < WGM ? (nM - fm) : WGM;
        u.pm = fm + ((wgid % nig) % gsz); u.pn = (wgid % nig) / gsz; return true;
    }
    __device__ __forceinline__ void a_ready(const Unit&) const {}
    __device__ __forceinline__ void done(const Unit&) const {}
};
struct CountedOrder : StaticOrder {
    const unsigned* ready; unsigned need; unsigned* tmo;
    __device__ __forceinline__ void a_ready(const Unit& u) const {
        if (threadIdx.x < 64) {
            const unsigned long long t0 = __builtin_amdgcn_s_memrealtime(); unsigned polls = 0;
            while ((unsigned)__builtin_amdgcn_readfirstlane(__hip_atomic_load(ready + 64 * u.pm, __ATOMIC_RELAXED, __HIP_MEMORY_SCOPE_AGENT)) < need) {
                if ((++polls & 255u) == 0u && __builtin_amdgcn_readfirstlane(__hip_atomic_load(tmo, __ATOMIC_RELAXED, __HIP_MEMORY_SCOPE_AGENT)) != 0u) break;
                if (__builtin_amdgcn_s_memrealtime() - t0 > 2000000ull) {
                    if (threadIdx.x == 0) { unsigned expect = 0u; __hip_atomic_compare_exchange_strong(tmo + 1, &expect, 0x600u | (unsigned)(u.pm & 0xff), __ATOMIC_RELAXED, __ATOMIC_RELAXED, __HIP_MEMORY_SCOPE_AGENT); __hip_atomic_store(tmo, 1u, __ATOMIC_RELAXED, __HIP_MEMORY_SCOPE_AGENT); }
                    break; }
                __builtin_amdgcn_s_sleep(2); }
            __builtin_amdgcn_fence(__ATOMIC_ACQUIRE, "agent");
            asm volatile("s_waitcnt vmcnt(0)" ::: "memory");
        }
#if !defined(BROKEN_HOOK_NO_BARRIER)
        asm volatile("" ::: "memory"); __builtin_amdgcn_s_barrier(); asm volatile("" ::: "memory");
#endif
    }
};

__device__ __forceinline__ unsigned cvt_pk_bf16(float lo, float hi) { unsigned r; asm volatile("v_cvt_pk_bf16_f32 %0, %1, %2" : "=v"(r) : "v"(lo), "v"(hi)); return r; }
typedef float f32x2 __attribute__((ext_vector_type(2)));
__device__ __forceinline__ f32x2 gelu_pk(f32x2 v) {
    const f32x2 av = __builtin_elementwise_abs(v), d = av * 0.2316418882f + 1.0f;
    f32x2 t; t.x = __builtin_amdgcn_rcpf(d.x); t.y = __builtin_amdgcn_rcpf(d.y);
    f32x2 q = t * 0.5307027145f + (-0.7265760135f); q = q * t + 0.7107068705f; q = q * t + (-0.142248368f); q = q * t + 0.127414796f; q = q * t;
    const f32x2 s = (v * v) * (-0.72134752044f);
    f32x2 e; e.x = __builtin_amdgcn_exp2f(s.x); e.y = __builtin_amdgcn_exp2f(s.y);
    const f32x2 m = v * (q * e), r = v - m;
    f32x2 o; o.x = v.x < 0.f ? m.x : r.x; o.y = v.y < 0.f ? m.y : r.y; return o;
}

struct EpiF32 {
    static constexpr bool PERM = false, AFTER_DRAIN = false;
    float* C; int ldc; const float* bias;
    __device__ __forceinline__ void operator()(const f32x4 (&acc)[2][2][4][2], const Unit& u, int wr, int wc, int fr, int fq) const {
        const int row0 = u.pm * BM + wr * 64 + fr, col0 = u.pn * BM + wc * 32 + 4 * fq;
        f32x4 bv[2][2];
#pragma unroll
        for (int bj = 0; bj < 2; ++bj)
#pragma unroll
            for (int n = 0; n < 2; ++n) bv[bj][n] = bias ? *(const f32x4*)(bias + col0 + bj * HALF + n * 16) : (f32x4){0.f, 0.f, 0.f, 0.f};
#pragma unroll
        for (int ai = 0; ai < 2; ++ai)
#pragma unroll
            for (int m = 0; m < 4; ++m) { float* rowp = C + (size_t)(row0 + ai * HALF + m * 16) * ldc + col0;
#pragma unroll
                for (int bj = 0; bj < 2; ++bj)
#pragma unroll
                    for (int n = 0; n < 2; ++n) *(f32x4*)(rowp + bj * HALF + n * 16) = acc[ai][bj][m][n] + bv[bj][n]; }
    }
};
template <int ACT  > struct EpiBf16 {
    static constexpr bool PERM = true, AFTER_DRAIN = false;
    bf16_t* O; int ldc; const float* bias; int split_cols; size_t split_stride;
    __device__ __forceinline__ void operator()(const f32x4 (&acc)[2][2][4][2], const Unit& u, int wr, int wc, int fr, int fq) const {
        const int row0 = u.pm * BM + wr * 64 + fr; int colt = u.pn * BM; bf16_t* base = O;
        if (split_cols) { const int t = colt / split_cols; base += (size_t)t * split_stride; colt -= t * split_cols; }
        const int col0 = colt + wc * 32 + 8 * fq, bcol0 = u.pn * BM + wc * 32 + 8 * fq;
        f32x4 bv[2][2];
#pragma unroll
        for (int bj = 0; bj < 2; ++bj)
#pragma unroll
            for (int n = 0; n < 2; ++n) bv[bj][n] = bias ? *(const f32x4*)(bias + bcol0 + bj * HALF + 4 * n) : (f32x4){0.f, 0.f, 0.f, 0.f};
#pragma unroll
        for (int ai = 0; ai < 2; ++ai)
#pragma unroll
            for (int m = 0; m < 4; ++m) { bf16_t* rowp = base + (size_t)(row0 + ai * HALF + m * 16) * ldc + col0;
#pragma unroll
                for (int bj = 0; bj < 2; ++bj) { f32x4 v0 = acc[ai][bj][m][0] + bv[bj][0], v1 = acc[ai][bj][m][1] + bv[bj][1];
                    if (ACT == 1) { f32x2 a = gelu_pk((f32x2){v0[0], v0[1]}), b = gelu_pk((f32x2){v0[2], v0[3]}), c = gelu_pk((f32x2){v1[0], v1[1]}), d = gelu_pk((f32x2){v1[2], v1[3]});
                        v0 = (f32x4){a.x, a.y, b.x, b.y}; v1 = (f32x4){c.x, c.y, d.x, d.y}; }
                    if (ACT == 2) {
#pragma unroll
                        for (int j = 0; j < 4; ++j) { v0[j] = 0.5f * v0[j] * (1.0f + erff(v0[j] * 0.70710678f)); v1[j] = 0.5f * v1[j] * (1.0f + erff(v1[j] * 0.70710678f)); } }
                    u32x4 w; w.x = cvt_pk_bf16(v0[0], v0[1]); w.y = cvt_pk_bf16(v0[2], v0[3]); w.z = cvt_pk_bf16(v1[0], v1[1]); w.w = cvt_pk_bf16(v1[2], v1[3]);
                    *(u32x4*)(rowp + bj * HALF) = w; } }
    }
};

template <int MODE> __device__ __forceinline__ f32x4 pg8_mma(bf16x8 a, bf16x8 b, f32x4 c) {
    if constexpr (MODE == 1) { typedef int i32x4_ __attribute__((ext_vector_type(4))); return __builtin_bit_cast(f32x4, __builtin_amdgcn_mfma_i32_16x16x64_i8(__builtin_bit_cast(i32x4_, a), __builtin_bit_cast(i32x4_, b), __builtin_bit_cast(i32x4_, c), 0, 0, 0)); }
    else return __builtin_amdgcn_mfma_f32_16x16x32_bf16(a, b, c, 0, 0, 0); }
__device__ __forceinline__ f32x4 pg8_mma8(bf16x8 a0, bf16x8 a1, bf16x8 b0, bf16x8 b1, f32x4 c) {
    typedef int i32x4_ __attribute__((ext_vector_type(4))); typedef int i32x8_ __attribute__((ext_vector_type(8)));
    const i32x8_ A = __builtin_shufflevector(__builtin_bit_cast(i32x4_, a0), __builtin_bit_cast(i32x4_, a1), 0, 1, 2, 3, 4, 5, 6, 7), B = __builtin_shufflevector(__builtin_bit_cast(i32x4_, b0), __builtin_bit_cast(i32x4_, b1), 0, 1, 2, 3, 4, 5, 6, 7);
    const int one = 0x7f7f7f7f;
    asm volatile("v_mfma_scale_f32_16x16x128_f8f6f4 %0, %1, %2, %0, %3, %3 op_sel_hi:[0,0,0]" : "+v"(c) : "v"(A), "v"(B), "v"(one));
    return c; }
__device__ __forceinline__ void fp8_acc_settle() { asm volatile("s_nop 7\n\ts_nop 7\n\ts_nop 7" ::: "memory"); }
template <class Epi, class Sched, bool STAMP = false, int MODE = 0>
__device__ __forceinline__ void gemm_phase(PG8_LAS unsigned char* lds, const Gemm g, const Sched& S, const Epi& E, unsigned long long* stamps) {
    const int tid = threadIdx.x, wid = __builtin_amdgcn_readfirstlane(tid >> 6), lane = tid & 63, wr = wid >> 2, wc = wid & 3, fr = lane & 15, fq = lane >> 4;
    const int K = g.K, nt = K / BK;
    int ts_lo = 0, ts_hi = 0, nts = 0; const unsigned long long rt_entry = STAMP ? (unsigned long long)wall_clock64() : 0ull;
#define PG8_STAMP() do { if (STAMP && wid == 0 && nts < 64) { const unsigned long long _c = (unsigned long long)clock64(); \
        ts_lo = (lane == nts) ? (int)(unsigned)_c : ts_lo; ts_hi = (lane == nts) ? (int)(unsigned)(_c >> 32) : ts_hi; ++nts; } } while (0)
    PG8_STAMP();
    unsigned voffA[2], voffB[2];
#pragma unroll
    for (int i = 0; i < 2; ++i) { int R, C; stage_rc(tid * 16 + i * 8192, R, C); const int Rb = Epi::PERM ? ((R & ~31) + perm32(R & 31)) : R;
        voffA[i] = (unsigned)(R * K + C) * 2u; voffB[i] = (unsigned)(Rb * K + C) * 2u; }
    const size_t kstep = (size_t)(BK * 2);
    const size_t hstep = (size_t)HALF * K * 2;
    const size_t tstep = 2 * hstep;
    const unsigned ldsw = (unsigned)wid * 1024u;
    const int aoff = lds_byte(wr * 64 + fr, fq * 8), boff = lds_byte(wc * 32 + fr, fq * 8);
#define PG8_SA(b, h) (((b) * 2 + (h)) * HTB)
#define PG8_SB(b, h) ((4 + (b) * 2 + (h)) * HTB)
#define PG8_STAGE(bufoff, gbase, voff) do { _Pragma("unroll") for (int _i = 0; _i < 2; ++_i) \
        __builtin_amdgcn_global_load_lds((const unsigned*)((const char*)(gbase) + (voff)[_i]), (PG8_LAS unsigned*)(lds + (bufoff) + ldsw + _i * 8192), 16, 0, 0); } while (0)
#define PG8_LDA(dst, b, h) do { _Pragma("unroll") for (int m = 0; m < 4; ++m) _Pragma("unroll") for (int k = 0; k < 2; ++k) dst[m][k] = *(const PG8_LAS bf16x8*)(lds + PG8_SA(b, h) + aoff + m * 2048 + k * 1024); } while (0)
#define PG8_LDB(dst, b, h) do { _Pragma("unroll") for (int n = 0; n < 2; ++n) _Pragma("unroll") for (int k = 0; k < 2; ++k) dst[n][k] = *(const PG8_LAS bf16x8*)(lds + PG8_SB(b, h) + boff + n * 2048 + k * 1024); } while (0)
#define PG8_MMA(ai, bj, At, Bt) do { __builtin_amdgcn_s_setprio(1); _Pragma("unroll") for (int m = 0; m < 4; ++m) _Pragma("unroll") for (int n = 0; n < 2; ++n) { if constexpr (MODE == 2) acc[ai][bj][m][n] = pg8_mma8(Bt[n][0], Bt[n][1], At[m][0], At[m][1], acc[ai][bj][m][n]); else { _Pragma("unroll") for (int k = 0; k < 2; ++k) \
        acc[ai][bj][m][n] = pg8_mma<MODE>(Bt[n][k], At[m][k], acc[ai][bj][m][n]); } } __builtin_amdgcn_s_setprio(0); } while (0)
#define PG8_WAIT_V(n) asm volatile("s_waitcnt vmcnt(" #n ")" ::: "memory")
#define PG8_WAIT_L(n) asm volatile("s_waitcnt lgkmcnt(" #n ")" ::: "memory")
#define PG8_BAR __builtin_amdgcn_s_barrier()
#define PG8_SCHED __builtin_amdgcn_sched_barrier(0)
    Unit cur, nxt; int ui = 0;
    if (!S.next(0, cur)) return;
    f32x4 acc[2][2][4][2];
#pragma unroll
    for (int a = 0; a < 2; ++a)
#pragma unroll
        for (int b = 0; b < 2; ++b)
#pragma unroll
            for (int m = 0; m < 4; ++m)
#pragma unroll
                for (int n = 0; n < 2; ++n) acc[a][b][m][n] = (f32x4){0.f, 0.f, 0.f, 0.f};
    bf16x8 At[4][2], B0[2][2], B1[2][2];
    const char* cA = (const char*)g.A + (size_t)cur.pm * tstep; const char* cB = (const char*)g.Bt + (size_t)cur.pn * tstep;
    S.a_ready(cur);
    PG8_STAGE(PG8_SB(0, 0), cB, voffB); PG8_STAGE(PG8_SA(0, 0), cA, voffA); PG8_STAGE(PG8_SB(0, 1), cB + hstep, voffB); PG8_STAGE(PG8_SA(0, 1), cA + hstep, voffA);
    if (wr == 1) PG8_BAR;
    PG8_WAIT_V(4); PG8_BAR;
    PG8_STAGE(PG8_SB(1, 0), cB + kstep, voffB); PG8_STAGE(PG8_SA(1, 0), cA + kstep, voffA); PG8_STAGE(PG8_SB(1, 1), cB + hstep + kstep, voffB);
    PG8_WAIT_V(6); PG8_BAR;
    PG8_STAMP();
    for (;;) {
        const bool has_next = S.next(ui + 1, nxt);
        const char* nA = has_next ? (const char*)g.A + (size_t)nxt.pm * tstep : cA; const char* nB = has_next ? (const char*)g.Bt + (size_t)nxt.pn * tstep : cB;
        for (int t = 0; t < nt; t += 2) {
            const bool last = (t == nt - 2);
            const char* a1 = cA + (size_t)(t + 1) * kstep;
            const char* a2 = last ? nA : cA + (size_t)(t + 2) * kstep; const char* b2 = last ? nB : cB + (size_t)(t + 2) * kstep;
            const char* a3 = a2 + kstep; const char* b3 = b2 + kstep;
            if (last && has_next) S.a_ready(nxt);
            PG8_LDB(B0, 0, 0); PG8_SCHED; PG8_LDA(At, 0, 0); PG8_STAGE(PG8_SA(1, 1), a1 + hstep, voffA);
            PG8_WAIT_L(8); PG8_BAR; PG8_WAIT_L(0); PG8_MMA(0, 0, At, B0); PG8_BAR; PG8_SCHED;
            PG8_LDB(B1, 0, 1); PG8_STAGE(PG8_SB(0, 0), b2, voffB);
            PG8_BAR; PG8_WAIT_L(0); PG8_MMA(0, 1, At, B1); PG8_BAR;
            PG8_LDA(At, 0, 1); PG8_STAGE(PG8_SA(0, 0), a2, voffA);
            PG8_BAR; PG8_WAIT_L(0); PG8_MMA(1, 0, At, B0); PG8_BAR; PG8_SCHED;
            PG8_STAGE(PG8_SB(0, 1), b2 + hstep, voffB);
            PG8_WAIT_V(6); PG8_BAR; PG8_MMA(1, 1, At, B1); PG8_BAR;
            PG8_LDB(B0, 1, 0); PG8_SCHED; PG8_LDA(At, 1, 0); PG8_STAGE(PG8_SA(0, 1), a2 + hstep, voffA);
            PG8_WAIT_L(8); PG8_BAR; PG8_WAIT_L(0); PG8_MMA(0, 0, At, B0); PG8_BAR; PG8_SCHED;
            PG8_LDB(B1, 1, 1); PG8_STAGE(PG8_SB(1, 0), b3, voffB);
            PG8_BAR; PG8_WAIT_L(0); PG8_MMA(0, 1, At, B1); PG8_BAR;
            PG8_LDA(At, 1, 1); PG8_STAGE(PG8_SA(1, 0), a3, voffA);
            PG8_BAR; PG8_WAIT_L(0); PG8_MMA(1, 0, At, B0); PG8_BAR; PG8_SCHED;
            PG8_STAGE(PG8_SB(1, 1), b3 + hstep, voffB);
            PG8_WAIT_V(6); PG8_BAR; PG8_MMA(1, 1, At, B1); PG8_BAR;
        }
        PG8_STAMP();
        if constexpr (!Epi::AFTER_DRAIN) { E(acc, cur, wr, wc, fr, fq); S.done(cur); }
        PG8_STAMP();
        if (!has_next) break;
#pragma unroll
        for (int a = 0; a < 2; ++a)
#pragma unroll
            for (int b = 0; b < 2; ++b)
#pragma unroll
                for (int m = 0; m < 4; ++m)
#pragma unroll
                    for (int n = 0; n < 2; ++n) acc[a][b][m][n] = (f32x4){0.f, 0.f, 0.f, 0.f};
        cur = nxt; cA = nA; cB = nB; ++ui;
    }
    PG8_WAIT_V(0);
    if (wr == 0) PG8_BAR;
    PG8_BAR;
    if constexpr (Epi::AFTER_DRAIN) { E.fused(acc, cur, wr, wc, fr, fq, lds, wid, lane); S.done(cur); }
    PG8_STAMP();
    if (STAMP && wid == 0) { stamps[lane] = lane < nts ? (((unsigned long long)(unsigned)ts_hi << 32) | (unsigned)ts_lo) : 0ull;
        if (lane == 62) stamps[62] = rt_entry; if (lane == 63) stamps[63] = (unsigned long long)wall_clock64(); }
#undef PG8_STAMP
#undef PG8_SA
#undef PG8_SB
#undef PG8_STAGE
#undef PG8_LDA
#undef PG8_LDB
#undef PG8_MMA
#undef PG8_WAIT_V
#undef PG8_WAIT_L
#undef PG8_BAR
#undef PG8_SCHED
}
}
#define XB_TMO      128
#define XB_XCNT(j)  (256  + 64 * (j))
#define XB_XSUB(j)  (1280 + 64 * (j))
#define XB_XGEN(j)  (2304 + 64 * (j))
#define XB_TOP      3328
#define XB_TOPGEN   3392
#define XCD_BAR_WORDS 3456
#define XB_SPIN_CAP (1u << 18)
#define LAS __attribute__((address_space(3)))

__device__ __forceinline__ unsigned xb_ld(unsigned* p)              { return __hip_atomic_load(p, __ATOMIC_RELAXED, __HIP_MEMORY_SCOPE_AGENT); }
__device__ __forceinline__ unsigned xb_add(unsigned* p, unsigned v) { return __hip_atomic_fetch_add(p, v, __ATOMIC_RELAXED, __HIP_MEMORY_SCOPE_AGENT); }
__device__ __forceinline__ unsigned xb_xcc_id() { return (unsigned)__builtin_amdgcn_s_getreg((3 << 11) | 20) & 0xFu; }
#define XB_SPIN(cond, bar) do { unsigned _sp = 0; while (cond) { __builtin_amdgcn_s_sleep(1); \
    if ((++_sp & 255u) == 0u) { if (xb_ld(&(bar)[XB_TMO])) break; if (_sp > XB_SPIN_CAP) { atomicAdd(&(bar)[XB_TMO], 1u); break; } } } } while (0)

struct XcdBarrier {
    unsigned* bar; unsigned x;
    volatile LAS unsigned* st;
};

__device__ __forceinline__ XcdBarrier xcd_barrier_post(unsigned* bar, volatile LAS unsigned* st) {
    XcdBarrier b; b.bar = bar; b.x = xb_xcc_id(); b.st = st;
    if (threadIdx.x == 0) (void)xb_add(&bar[XB_XCNT(b.x)], 1u);
    return b;
}
__device__ __forceinline__ void xcd_barrier_complete(unsigned* bar, unsigned x, unsigned& nloc, unsigned& nx) {
    const unsigned G = gridDim.x * gridDim.y * gridDim.z;
    unsigned sum, cnt, mine, sp = 0u;
    for (;;) {
        sum = 0u; cnt = 0u; mine = 0u;
#pragma unroll
        for (unsigned j = 0; j < 16; ++j) { const unsigned c = xb_ld(&bar[XB_XCNT(j)]); sum += c; cnt += (c > 0u) ? 1u : 0u; mine = (j == x) ? c : mine; }
        if (sum == G) break;
        __builtin_amdgcn_s_sleep(1);
        if ((++sp & 255u) == 0u) { if (xb_ld(&bar[XB_TMO])) break; if (sp > XB_SPIN_CAP) { atomicAdd(&bar[XB_TMO], 1u); break; } }
    }
    nloc = mine > 0u ? mine : 1u; nx = cnt > 0u ? cnt : 1u;
}

__device__ __forceinline__ void xcd_barrier(const XcdBarrier& b) {
    asm volatile("s_waitcnt vmcnt(0)" ::: "memory");
    __syncthreads();
    if (threadIdx.x == 0) {
        unsigned* bar = b.bar;
        __builtin_amdgcn_s_waitcnt(0);
        unsigned nloc = b.st[0], nx = b.st[1];
        if (nloc == 0u) { xcd_barrier_complete(bar, b.x, nloc, nx); b.st[0] = nloc; b.st[1] = nx; }
        const unsigned old = xb_add(&bar[XB_XSUB(b.x)], 1u);
        const unsigned gen = old / nloc;
        if (old + 1u == (gen + 1u) * nloc) {
            __builtin_amdgcn_fence(__ATOMIC_RELEASE, "agent");
            asm volatile("s_waitcnt vmcnt(0)" ::: "memory");
            const unsigned og = xb_add(&bar[XB_TOP], 1u);
            const unsigned tg = og / nx;
            if (og + 1u == (tg + 1u) * nx) xb_add(&bar[XB_TOPGEN], 1u);
            else XB_SPIN(xb_ld(&bar[XB_TOPGEN]) == tg, bar);
            __builtin_amdgcn_fence(__ATOMIC_ACQUIRE, "agent");
            xb_add(&bar[XB_XGEN(b.x)], 1u);
            asm volatile("s_waitcnt vmcnt(0)" ::: "memory");
        } else {
            XB_SPIN(xb_ld(&bar[XB_XGEN(b.x)]) == gen, bar);
            __builtin_amdgcn_fence(__ATOMIC_ACQUIRE, "agent");
            asm volatile("s_waitcnt vmcnt(0)" ::: "memory");
        }
    }
    __syncthreads();
}

namespace mk {
using pg8::bf16_t; using pg8::bf16x8; using pg8::f32x4; using pg8::u32x4;
typedef unsigned u32x2 __attribute__((ext_vector_type(2)));
typedef short bf16x4 __attribute__((ext_vector_type(4)));
typedef float lf2 __attribute__((ext_vector_type(2)));
typedef float lf4 __attribute__((ext_vector_type(4)));
typedef unsigned lu4 __attribute__((ext_vector_type(4)));

constexpr int D = 1024, NBATCH = 16, SEQ = 2048, CTXL = 256;
constexpr int NLAT = NBATCH * SEQ, NCTX = NBATCH * CTXL, NROW = NLAT + NCTX;
constexpr int NINP = 3072, NIN = 2944;
constexpr int C_Q = 256, C_K = 640, C_V = 1024, C_Z = 1408;
constexpr int DE = 2816;
constexpr int XROWS = 4608;
constexpr int NTHR = 512;
constexpr int LDS_MISC = 131072, LDS_BYTES = 131072 + 256;

constexpr size_t al256(size_t x) { return (x + 255) & ~(size_t)255; }
constexpr size_t WS_CTL = 0;
constexpr size_t WS_MOD = 65536;
constexpr size_t WS_SW = al256(WS_MOD + (size_t)2 * 17 * 6144 * 4);
constexpr size_t SW_W2T = 0, SW_A2T = 98304, SW_G2T = 196608, SW_GLUT = 294912, SW_S5E = 425984, SW_S5W2 = 2523136, SW_STRIDE = 6717440;
constexpr size_t WS_WIN = al256(WS_SW + 2 * SW_STRIDE);
constexpr size_t WS_WOUT = WS_WIN + (size_t)3072 * 1024 * 2;
constexpr size_t WS_WGU = WS_WOUT + (size_t)1024 * 1024 * 2;
constexpr size_t WS_WD = WS_WGU + (size_t)16 * 5632 * 1024 * 2;
constexpr size_t WS_XB = WS_WD + (size_t)16 * 1024 * 2816 * 2;
constexpr size_t WS_CTXA = WS_XB + (size_t)NLAT * D * 4;
constexpr size_t WS_CTXB = WS_CTXA + (size_t)NCTX * D * 4;
constexpr size_t WS_ABUF = WS_CTXB + (size_t)NCTX * D * 4;
constexpr size_t WS_AFF = WS_ABUF + (size_t)NROW * D * 2;
constexpr size_t WS_SLOT = WS_AFF + (size_t)NROW * 16 * 4;
constexpr size_t WS_SELG = WS_SLOT + (size_t)NROW * 16 * 4;
constexpr size_t WS_SW8 = al256(WS_SELG + (size_t)16 * XROWS * 4);
constexpr size_t WS_SX = WS_SW8 + (size_t)16 * 5632 * 4;
constexpr size_t WS_SXS = WS_SX + (size_t)NROW * 4;
constexpr size_t WS_SWIN = WS_SXS + (size_t)16 * XROWS * 4;
constexpr size_t WS_SH = WS_SWIN + (size_t)3072 * 4;
constexpr size_t WS_SWD = WS_SH + (size_t)NROW * 4;
constexpr size_t WS_U = al256(WS_SWD + (size_t)16 * 1024 * 4);
constexpr size_t SZ384 = (size_t)NROW * 384 * 2;
constexpr size_t U_P = WS_U;
constexpr size_t U_QR = U_P + (size_t)NROW * NINP * 2;
constexpr size_t U_KR = U_QR + SZ384;
constexpr size_t U_VT = U_KR + SZ384;
constexpr size_t U_VTC = U_VT + (size_t)16 * 384 * 2048 * 2;
constexpr size_t U_RS = U_VT + SZ384;
constexpr size_t U_KS = U_RS + SZ384;
constexpr size_t U_VS = U_KS + SZ384;
constexpr size_t U_KK = U_VS + SZ384;
constexpr size_t U_ALR = U_KK + SZ384;
constexpr size_t U_LD = U_ALR + SZ384;
constexpr size_t U_AG = U_LD + 2 * SZ384;
constexpr size_t U_G = U_AG + 2 * SZ384;
constexpr size_t U_YRK = U_G + SZ384;
constexpr size_t U_SLOC = U_YRK + 2 * (size_t)NROW * 384 * 4;
constexpr size_t U_SPREV = U_SLOC + (size_t)2304 * 16 * 256 * 4;
constexpr size_t U_YG = U_SPREV + (size_t)2304 * 16 * 256 * 2;
constexpr size_t U_U16 = U_YG + (size_t)NROW * 256 * 2;
constexpr size_t U_MIX_END = U_U16 + (size_t)NROW * 256 * 2;
constexpr int NCHUNK = 192 * 144;
constexpr size_t CH_XP = U_P;
constexpr size_t CH_BK = CH_XP + (size_t)NCHUNK * 4096;
constexpr size_t CH_UL = CH_BK + (size_t)NCHUNK * 4096;
constexpr size_t CH_MM = U_SLOC;
constexpr size_t CH_GT = CH_MM + (size_t)NCHUNK * 1024;
static_assert(CH_UL + (size_t)NCHUNK * 2048 <= U_RS, "chunk buffers overlap live RWKV operands");
static_assert(CH_GT + (size_t)NCHUNK * 256 <= U_SPREV, "chunk buffers overlap S5 states");
constexpr size_t U_Y = WS_U;
constexpr size_t U_XSEL = U_Y + (size_t)NROW * D * 4;
constexpr size_t U_HID = U_XSEL + (size_t)16 * XROWS * 1024 * 2;
constexpr size_t U_YEXP = U_HID + (size_t)16 * XROWS * DE * 2;
constexpr size_t U_FFN_END = U_YEXP + (size_t)16 * XROWS * 1024 * 2;
constexpr size_t WS_END = U_MIX_END > U_FFN_END ? U_MIX_END : U_FFN_END;

struct Params { const float* in[35]; float* out; unsigned char* ws; int ph_lo, ph_hi, use_bar, pad; };

typedef __bf16 hwbf2 __attribute__((ext_vector_type(2)));
__device__ __forceinline__ unsigned pack2(float lo, float hi) { const lf2 v = {lo, hi}; return __builtin_bit_cast(unsigned, __builtin_convertvector(v, hwbf2)); }
__device__ __forceinline__ bf16_t f2bf(float f) { return (bf16_t)(pack2(f, 0.f) & 0xffffu); }
__device__ __forceinline__ float bflo(unsigned w) { return __uint_as_float(w << 16); }
__device__ __forceinline__ float bfhi(unsigned w) { return __uint_as_float(w & 0xffff0000u); }
__device__ __forceinline__ float bf2f(bf16_t b) { return __uint_as_float(((unsigned)b) << 16); }
__device__ __forceinline__ float sigm(float x) { return 1.0f / (1.0f + __expf(-x)); }
__device__ __forceinline__ float wave_sum(float v) {
#pragma unroll
    for (int o = 32; o >= 1; o >>= 1) v += __shfl_xor(v, o);
    return v; }
__device__ __forceinline__ void unpack8(const uint4 w, float (&f)[8]) { f[0] = bflo(w.x); f[1] = bfhi(w.x); f[2] = bflo(w.y); f[3] = bfhi(w.y); f[4] = bflo(w.z); f[5] = bfhi(w.z); f[6] = bflo(w.w); f[7] = bfhi(w.w); }
__device__ __forceinline__ uint4 pack8(const float (&f)[8]) { uint4 w; w.x = pack2(f[0], f[1]); w.y = pack2(f[2], f[3]); w.z = pack2(f[4], f[5]); w.w = pack2(f[6], f[7]); return w; }
__device__ __forceinline__ const float* xrow(const float* lat, const float* ctx, int r) { return r < NLAT ? lat + (size_t)r * D : ctx + (size_t)(r - NLAT) * D; }
__device__ __forceinline__ float* xrow_w(float* lat, float* ctx, int r) { return r < NLAT ? lat + (size_t)r * D : ctx + (size_t)(r - NLAT) * D; }
__device__ __forceinline__ f32x4 mfma16(bf16x8 a, bf16x8 b, f32x4 c) { return __builtin_amdgcn_mfma_f32_16x16x32_bf16(a, b, c, 0, 0, 0); }

__device__ __forceinline__ void tr_tile(const float* __restrict__ src, int ldsrc, int k0, int n0, bf16_t* __restrict__ dst, int lddst, int drow0, LAS unsigned* T) {
    const int tid = threadIdx.x, n4 = tid & 15, kq = tid >> 4;
    const float4 a = *(const float4*)(src + (size_t)(k0 + 2 * kq) * ldsrc + n0 + 4 * n4);
    const float4 b = *(const float4*)(src + (size_t)(k0 + 2 * kq + 1) * ldsrc + n0 + 4 * n4);
    T[(4 * n4 + 0) * 33 + kq] = pack2(a.x, b.x); T[(4 * n4 + 1) * 33 + kq] = pack2(a.y, b.y);
    T[(4 * n4 + 2) * 33 + kq] = pack2(a.z, b.z); T[(4 * n4 + 3) * 33 + kq] = pack2(a.w, b.w);
    __syncthreads();
    const int n = tid >> 3, pc = tid & 7;
    uint4 v; v.x = T[n * 33 + 4 * pc]; v.y = T[n * 33 + 4 * pc + 1]; v.z = T[n * 33 + 4 * pc + 2]; v.w = T[n * 33 + 4 * pc + 3];
    *(uint4*)(dst + (size_t)(drow0 + n) * lddst + k0 + 8 * pc) = v;
    __syncthreads();
}

__device__ __forceinline__ void tr_tile4(const float* __restrict__ src, int ldsrc, int k0, int n0, bf16_t* __restrict__ dst, int lddst, int drow0, LAS unsigned* T) {
    const int tid = threadIdx.x, n4 = tid & 15, kq = tid >> 4;
    float4 a[4], b[4];
#pragma unroll
    for (int t = 0; t < 4; ++t) { a[t] = *(const float4*)(src + (size_t)(k0 + 2 * kq) * ldsrc + n0 + 64 * t + 4 * n4); b[t] = *(const float4*)(src + (size_t)(k0 + 2 * kq + 1) * ldsrc + n0 + 64 * t + 4 * n4); }
#pragma unroll
    for (int t = 0; t < 4; ++t) { LAS unsigned* Tt = T + t * 64 * 33;
        Tt[(4 * n4 + 0) * 33 + kq] = pack2(a[t].x, b[t].x); Tt[(4 * n4 + 1) * 33 + kq] = pack2(a[t].y, b[t].y); Tt[(4 * n4 + 2) * 33 + kq] = pack2(a[t].z, b[t].z); Tt[(4 * n4 + 3) * 33 + kq] = pack2(a[t].w, b[t].w); }
    __syncthreads();
#pragma unroll
    for (int i = 0; i < 4; ++i) { const int idx = tid + NTHR * i, n = idx >> 3, pc = idx & 7;
        uint4 v; v.x = T[n * 33 + 4 * pc]; v.y = T[n * 33 + 4 * pc + 1]; v.z = T[n * 33 + 4 * pc + 2]; v.w = T[n * 33 + 4 * pc + 3];
        *(uint4*)(dst + (size_t)(drow0 + n) * lddst + k0 + 8 * pc) = v; }
    __syncthreads();
}
template <int NK, int DP, bool FP8> __device__ __forceinline__ void q8_strip(const float* __restrict__ src, int ldsrc, unsigned char* __restrict__ dst, float* __restrict__ scl, LAS unsigned char* lds) {
    LAS float* cmax = (LAS float*)lds;
    LAS unsigned char* T = lds + 8704;
    const int tid = threadIdx.x, n4 = tid & 15, kq = tid >> 4; constexpr float QMAX = FP8 ? 256.0f : 127.0f;
    float mx[4] = {0.f, 0.f, 0.f, 0.f};
#pragma unroll 8
    for (int i = 0; i < 2 * NK; ++i) { const float4 v = *(const float4*)(src + (size_t)(kq + 32 * i) * ldsrc + 4 * n4); mx[0] = fmaxf(mx[0], fabsf(v.x)); mx[1] = fmaxf(mx[1], fabsf(v.y)); mx[2] = fmaxf(mx[2], fabsf(v.z)); mx[3] = fmaxf(mx[3], fabsf(v.w)); }
    __syncthreads();
#pragma unroll
    for (int j = 0; j < 4; ++j) cmax[kq * 64 + 4 * n4 + j] = mx[j];
    __syncthreads();
    if (tid < 64) { float m = 0.f; for (int g = 0; g < 32; ++g) m = fmaxf(m, cmax[g * 64 + tid]); m = fmaxf(m, 1e-20f); scl[tid] = m * (1.0f / QMAX); cmax[32 * 64 + tid] = QMAX / m; }
    __syncthreads();
    float inv[4];
#pragma unroll
    for (int j = 0; j < 4; ++j) inv[j] = cmax[32 * 64 + 4 * n4 + j];
    for (int kg = 0; kg < NK / 4; ++kg) {
        float4 a[4], b[4];
#pragma unroll
        for (int t = 0; t < 4; ++t) { const int kb = (kg * 4 + t) * 64 + 2 * kq; a[t] = *(const float4*)(src + (size_t)kb * ldsrc + 4 * n4); b[t] = *(const float4*)(src + (size_t)(kb + 1) * ldsrc + 4 * n4); }
#pragma unroll
        for (int t = 0; t < 4; ++t) { const float av[4] = {a[t].x, a[t].y, a[t].z, a[t].w}, bv[4] = {b[t].x, b[t].y, b[t].z, b[t].w};
#pragma unroll
            for (int j = 0; j < 4; ++j) { unsigned short w;
                if (FP8) w = (unsigned short)(__builtin_amdgcn_cvt_pk_fp8_f32(av[j] * inv[j], bv[j] * inv[j], 0, false) & 0xffff);
                else { const int q0 = __float2int_rn(av[j] * inv[j]), q1 = __float2int_rn(bv[j] * inv[j]); w = (unsigned short)((q0 & 255) | ((q1 & 255) << 8)); }
                *(LAS unsigned short*)(T + (4 * n4 + j) * 272 + t * 64 + 2 * kq) = w; } }
        __syncthreads();
#pragma unroll
        for (int i = 0; i < 2; ++i) { const int idx = tid + NTHR * i, n = idx >> 4, pc = idx & 15; *(lu4*)(dst + (size_t)n * DP + kg * 256 + 16 * pc) = *(const LAS lu4*)(T + n * 272 + 16 * pc); }
        __syncthreads();
    }
}
__device__ __forceinline__ void gu_strip(const Params& p, int l, int item, LAS unsigned char* lds) {
    const int e = item / 88, rem = item % 88, up = rem / 44, nt = rem % 44, n0 = nt * 64, drow0 = (n0 >> 7) * 256 + (n0 & 127) + (up ? 128 : 0);
    q8_strip<16, 1024, false>(p.in[up ? 33 : 32] + (size_t)(l * 16 + e) * 1024 * DE + n0, DE, p.ws + WS_WGU + ((size_t)e * 5632 + drow0) * 1024, (float*)(p.ws + WS_SW8) + (size_t)e * 5632 + drow0, lds);
}
constexpr int CV_GU = 16 * 88, CV_D4 = 16 * 16, CV_WIN = 46, CV_PAD = 16, CV_WOUT4 = 16 * 4, CV_TOTAL = CV_GU + CV_D4 + CV_WIN + CV_PAD + CV_WOUT4;
__device__ __forceinline__ void convert_weights(const Params& p, int l, LAS unsigned char* lds, int vb, int nvb) {
    LAS unsigned* T = (LAS unsigned*)lds; bf16_t* WOUT = (bf16_t*)(p.ws + WS_WOUT);
    for (int it = vb; it < CV_TOTAL; it += nvb) {
        int j = it;
        if (j < CV_GU) { gu_strip(p, l, j, lds); continue; }
        j -= CV_GU;
        if (j < CV_D4) { const int e = j >> 4, nt = j & 15;
            q8_strip<44, DE, true>(p.in[34] + (size_t)(l * 16 + e) * DE * 1024 + nt * 64, 1024, p.ws + WS_WD + ((size_t)e * 1024 + nt * 64) * DE, (float*)(p.ws + WS_SWD) + e * 1024 + nt * 64, lds); continue; }
        j -= CV_D4;
        if (j < CV_WIN) { q8_strip<16, 1024, false>(p.in[7] + (size_t)l * 1024 * NIN + j * 64, NIN, p.ws + WS_WIN + (size_t)j * 64 * 1024, (float*)(p.ws + WS_SWIN) + j * 64, lds); continue; }
        j -= CV_WIN;
        if (j < CV_PAD) { const size_t o = (size_t)NIN * 1024 + ((size_t)j * NTHR + threadIdx.x) * 16; *(uint4*)(p.ws + WS_WIN + o) = make_uint4(0u, 0u, 0u, 0u);
            if (j == 0 && threadIdx.x < 128) ((float*)(p.ws + WS_SWIN))[NIN + threadIdx.x] = 0.f; continue; }
        j -= CV_PAD;
        { const int kt = j >> 2, ng = j & 3; tr_tile4(p.in[8] + (size_t)l * 1024 * 1024, 1024, kt * 64, ng * 256, WOUT, 1024, ng * 256, T); }
    }
}

__device__ __forceinline__ void mod_item(const Params& p, int item, LAS unsigned char* lds) {
    LAS float* sc = (LAS float*)lds;
    LAS float* red = (LAS float*)(lds + 69632);
    const int tid = threadIdx.x, l = item / 96, cg = item % 96;
    for (int i = tid; i < 17 * 1024; i += NTHR) { const int b = i >> 10, k = i & 1023; const float c = b < 16 ? p.in[1][b * 1024 + k] : p.in[3][k]; sc[k * 17 + b] = c * sigm(c); }
    __syncthreads();
    const int col = cg * 64 + (tid & 63), kg = tid >> 6;
    float acc[17];
#pragma unroll
    for (int b = 0; b < 17; ++b) acc[b] = 0.f;
    const float* w = p.in[4] + ((size_t)l * 1024 + kg * 128) * 6144 + col;
#pragma unroll 4
    for (int kk = 0; kk < 128; ++kk) { const float wv = w[(size_t)kk * 6144]; const LAS float* s = sc + (kg * 128 + kk) * 17;
#pragma unroll
        for (int b = 0; b < 17; ++b) acc[b] += s[b] * wv; }
#pragma unroll
    for (int b = 0; b < 17; ++b) red[(kg * 17 + b) * 64 + (tid & 63)] = acc[b];
    __syncthreads();
    for (int i = tid; i < 17 * 64; i += NTHR) { const int b = i >> 6, c = i & 63; float s = 0.f;
#pragma unroll
        for (int g = 0; g < 8; ++g) s += red[(g * 17 + b) * 64 + c];
        ((float*)(p.ws + WS_MOD))[((size_t)l * 17 + b) * 6144 + cg * 64 + c] = s + p.in[5][l * 6144 + cg * 64 + c]; }
    __syncthreads();
}

__device__ __forceinline__ void s5mat_item(const Params& p, int item, LAS unsigned char* lds) {
    LAS lf2* pw = (LAS lf2*)lds;
    LAS lf2* bb = (LAS lf2*)(lds + 17408);
    LAS lf2* cc = (LAS lf2*)(lds + 17408 + 16384);
    LAS float* KT = (LAS float*)(lds + 17408 + 32768);
    const int tid = threadIdx.x, l = item >> 4, g = item & 15;
    for (int i = tid; i < 2 * 17 * 64; i += NTHR) { const int pp = i & 63, n = (i >> 6) % 17, d = i / (17 * 64);
        const int li = ((l * 2 + d) * 16 + g) * 64 + pp; const float lr = p.in[9][li], lim = p.in[10][li], dt = expf(p.in[11][(l * 2 + d) * 16 + g]);
        const float mag = expf((float)n * dt * lr); float s, c; sincosf((float)n * dt * lim, &s, &c); pw[i] = (lf2){mag * c, mag * s}; }
    for (int i = tid; i < 2 * 64 * 16; i += NTHR) { const int h = i & 15, pp = (i >> 4) & 63, d = i >> 10;
        const int li = ((l * 2 + d) * 16 + g) * 64 + pp; const float lr = p.in[9][li], lim = p.in[10][li], dt = expf(p.in[11][(l * 2 + d) * 16 + g]);
        const float mag = expf(dt * lr); float s, c; sincosf(dt * lim, &s, &c); const float x = mag * c - 1.0f, y = mag * s;
        const float den = 1.0f / (lr * lr + lim * lim); const float cr = (x * lr + y * lim) * den, ci = (y * lr - x * lim) * den;
        const int bi = ((l * 16 + g) * 64 + pp) * 16 + h; const float br = p.in[12][bi], bim = p.in[13][bi];
        bb[i] = (lf2){cr * br - ci * bim, cr * bim + ci * br}; }
    for (int i = tid; i < 2 * 16 * 64; i += NTHR) { const int pp = i & 63, h = (i >> 6) & 15, d = i >> 10;
        const int ci = (((l * 2 + d) * 16 + g) * 16 + h) * 64 + pp; cc[i] = (lf2){p.in[14][ci], p.in[15][ci]}; }
    __syncthreads();
    for (int i = tid; i < 2 * 16 * 256; i += NTHR) { const int h2 = i & 15, h = (i >> 4) & 15, tau = (i >> 8) & 15, d = i >> 12; float s = 0.f;
        for (int pp = 0; pp < 64; ++pp) { const lf2 c = cc[(d * 16 + h) * 64 + pp], w = pw[(d * 17 + tau) * 64 + pp], b = bb[(d * 64 + pp) * 16 + h2];
            const float tr = c.x * w.x - c.y * w.y, ti = c.x * w.y + c.y * w.x; s += tr * b.x - ti * b.y; }
        KT[i] = s; }
    __syncthreads();
    bf16_t* E = (bf16_t*)(p.ws + WS_SW + (size_t)l * SW_STRIDE + SW_S5E) + (size_t)g * 256 * 256;
    bf16_t* W2 = (bf16_t*)(p.ws + WS_SW + (size_t)l * SW_STRIDE + SW_S5W2) + (size_t)g * 256 * 512;
    for (int i = tid; i < 256 * 256; i += NTHR) { const int k = i & 255, n = i >> 8; const int s = k >> 4, h = k & 15, d = n >> 7, part = (n >> 6) & 1, pp = n & 63;
        const int e = d == 0 ? 15 - s : s; const lf2 w = pw[(d * 17 + e) * 64 + pp], b = bb[(d * 64 + pp) * 16 + h];
        E[i] = f2bf(part ? (w.x * b.y + w.y * b.x) : (w.x * b.x - w.y * b.y)); }
    for (int i = tid; i < 256 * 512; i += NTHR) { const int k = i & 511, n = i >> 9; const int t = n >> 4, h = n & 15; float v;
        if (k < 256) { const int s = k >> 4, h2 = k & 15; v = 0.f;
            if (t >= s) v += KT[((0 * 16 + (t - s)) * 16 + h) * 16 + h2];
            if (s >= t) v += KT[((1 * 16 + (s - t)) * 16 + h) * 16 + h2];
            if (s == t && h == h2) v += p.in[16][l * 256 + g * 16 + h]; }
        else { const int q = k - 256, d = q >> 7, part = (q >> 6) & 1, pp = q & 63; const int e = d == 0 ? t + 1 : 16 - t;
            const lf2 c = cc[(d * 16 + h) * 64 + pp], w = pw[(d * 17 + e) * 64 + pp];
            v = part ? -(c.x * w.y + c.y * w.x) : (c.x * w.x - c.y * w.y); }
        W2[i] = f2bf(v); }
    __syncthreads();
}

__device__ __forceinline__ void smallw_item(const Params& p, int item) {
    int i = item * NTHR + threadIdx.x; const int l = i / 212992; i %= 212992;
    unsigned char* sw = p.ws + WS_SW + (size_t)l * SW_STRIDE;
    if (i < 49152) { const int k = i & 63, n = (i >> 6) % 384, d = i / 24576; ((bf16_t*)(sw + SW_W2T))[i] = f2bf(p.in[22][((size_t)(l * 2 + d) * 64 + k) * 384 + n]); return; }
    i -= 49152;
    if (i < 49152) { const int k = i & 63, n = (i >> 6) % 384, d = i / 24576; ((bf16_t*)(sw + SW_A2T))[i] = f2bf(p.in[24][((size_t)(l * 2 + d) * 64 + k) * 384 + n]); return; }
    i -= 49152;
    if (i < 49152) { const int k = i & 127, n = i >> 7; ((bf16_t*)(sw + SW_G2T))[i] = f2bf(p.in[25][((size_t)l * 128 + k) * 384 + n]); return; }
    i -= 49152;
    { const int k = i & 255, n = i >> 8; ((bf16_t*)(sw + SW_GLUT))[i] = f2bf(p.in[17][((size_t)l * 256 + k) * 256 + n]); }
}

constexpr int PRO_MOD = 192, PRO_S5 = 32, PRO_SW = 832;
__device__ __forceinline__ void phase_prologue(const Params& p, LAS unsigned char* lds) {
    for (int it = blockIdx.x; it < PRO_MOD + PRO_S5 + PRO_SW; it += gridDim.x) {
        if (it < PRO_MOD) mod_item(p, it, lds);
        else if (it < PRO_MOD + PRO_S5) s5mat_item(p, it - PRO_MOD, lds);
        else smallw_item(p, it - PRO_MOD - PRO_S5);
    }
    convert_weights(p, 0, lds, (int)blockIdx.x, (int)gridDim.x);
}

__device__ __forceinline__ void hnorm_row(const float* g, const float* mb_sh, const float* mb_sc, unsigned char* dst, float* sdst, int lane, const float4 (&v)[4]) {
    float ss = 0.f;
#pragma unroll
    for (int i = 0; i < 4; ++i) ss += v[i].x * v[i].x + v[i].y * v[i].y + v[i].z * v[i].z + v[i].w * v[i].w;
    ss = wave_sum(ss); const float rs = rsqrtf(ss * (1.0f / 1024.0f) + 1e-6f);
    float hv[4][4]; float amax = 0.f;
#pragma unroll
    for (int i = 0; i < 4; ++i) { const int c = i * 256 + lane * 4; const float4 gg = *(const float4*)(g + c), sh = *(const float4*)(mb_sh + c), sc = *(const float4*)(mb_sc + c);
        hv[i][0] = v[i].x * rs * gg.x * (1.f + sc.x) + sh.x; hv[i][1] = v[i].y * rs * gg.y * (1.f + sc.y) + sh.y; hv[i][2] = v[i].z * rs * gg.z * (1.f + sc.z) + sh.z; hv[i][3] = v[i].w * rs * gg.w * (1.f + sc.w) + sh.w;
        amax = fmaxf(amax, fmaxf(fmaxf(fabsf(hv[i][0]), fabsf(hv[i][1])), fmaxf(fabsf(hv[i][2]), fabsf(hv[i][3])))); }
#pragma unroll
    for (int o = 32; o >= 1; o >>= 1) amax = fmaxf(amax, __shfl_xor(amax, o));
    amax = fmaxf(amax, 1e-20f); const float qs = 127.0f / amax;
    if (lane == 0) *sdst = amax * (1.0f / 127.0f);
#pragma unroll
    for (int i = 0; i < 4; ++i) { unsigned w = 0u;
#pragma unroll
        for (int k = 0; k < 4; ++k) w |= ((unsigned)__float2int_rn(hv[i][k] * qs) & 255u) << (8 * k);
        *(unsigned*)(dst + i * 256 + lane * 4) = w; }
}
__device__ __forceinline__ void phase_hnorm(const Params& p, int l, const float* xl, const float* xc) {
    const int lane = threadIdx.x & 63, wv = threadIdx.x >> 6;
    const float* mod = (const float*)(p.ws + WS_MOD) + (size_t)l * 17 * 6144; const float* g = p.in[6] + (l * 4 + 0) * 1024;
    unsigned char* A = p.ws + WS_ABUF; float* SH = (float*)(p.ws + WS_SH);
    for (int r = blockIdx.x * 8 + wv; r < NROW; r += gridDim.x * 8) {
        const float* src = xrow(xl, xc, r); const int b = r < NLAT ? (r >> 11) : 16; const float* mb = mod + (size_t)b * 6144;
        float4 v[4];
#pragma unroll
        for (int i = 0; i < 4; ++i) v[i] = *(const float4*)(src + i * 256 + lane * 4);
        hnorm_row(g, mb, mb + 1024, A + (size_t)r * 1024, SH + r, lane, v);
    }
}


__device__ __forceinline__ void phase_prep(const Params& p, int l, LAS unsigned char* lds) {
    LAS bf16_t* vt = (LAS bf16_t*)lds;
    LAS lf2* cs = (LAS lf2*)(lds + 50176);
    const int tid = threadIdx.x;
    for (int i = tid; i < 1024; i += NTHR) { const int pos = i >> 4, j = i & 15; const float invf = exp2f(-(float)j * (13.287712379549449f / 16.0f)); float s, c; sincosf((float)pos * invf, &s, &c); cs[i] = (lf2){c, s}; }
    __syncthreads();
    const bf16_t* P = (const bf16_t*)(p.ws + U_P);
    bf16_t* QR = (bf16_t*)(p.ws + U_QR); bf16_t* KR = (bf16_t*)(p.ws + U_KR);
    bf16_t* RS = (bf16_t*)(p.ws + U_RS); bf16_t* KS = (bf16_t*)(p.ws + U_KS); bf16_t* VS = (bf16_t*)(p.ws + U_VS); bf16_t* KK = (bf16_t*)(p.ws + U_KK); bf16_t* ALR = (bf16_t*)(p.ws + U_ALR);
    for (int ti = blockIdx.x; ti < NROW / 64; ti += gridDim.x) {
        const int r0 = ti * 64; const bool lat = r0 < NLAT; const int b = lat ? (r0 >> 11) : ((r0 - NLAT) >> 8), t0 = lat ? (r0 & 2047) : ((r0 - NLAT) & 255), slen = lat ? SEQ : CTXL;
#pragma unroll
        for (int i = 0; i < 6; ++i) { const int idx = tid + NTHR * i, tok = idx / 48, pc = idx % 48;
            *(LAS lu4*)(vt + tok * 392 + pc * 8) = *(const lu4*)(P + (size_t)(r0 + tok) * NINP + C_V + pc * 8); }
        __syncthreads();
        { bf16_t* vdst = lat ? (bf16_t*)(p.ws + U_VT) + (size_t)b * 384 * 2048 + t0 : (bf16_t*)(p.ws + U_VTC) + (size_t)b * 384 * 256 + t0;
#pragma unroll
          for (int i = 0; i < 6; ++i) { const int idx = tid + NTHR * i, hd = idx >> 3, pc = idx & 7; unsigned w[4];
#pragma unroll
              for (int j = 0; j < 4; ++j) w[j] = (unsigned)vt[(pc * 8 + 2 * j) * 392 + hd] | ((unsigned)vt[(pc * 8 + 2 * j + 1) * 392 + hd] << 16);
              *(uint4*)(vdst + (size_t)hd * slen + pc * 8) = make_uint4(w[0], w[1], w[2], w[3]); } }
#pragma unroll
        for (int i = 0; i < 4; ++i) { const int idx = tid + NTHR * i, tok = idx >> 5, pc = idx & 31;
            *(lu4*)((bf16_t*)(p.ws + U_U16) + (size_t)(r0 + tok) * 256 + pc * 8) = *(const lu4*)(P + (size_t)(r0 + tok) * NINP + pc * 8); }
#pragma unroll
        for (int i = 0; i < 6; ++i) { const int idx = tid + NTHR * i, tok = idx / 48, rem = idx % 48, qk = rem / 24, rem2 = rem % 24, h = rem2 >> 2, pp = rem2 & 3;
            const int d1 = (pp >> 1) * 32 + (pp & 1) * 8; const size_t so = (size_t)(r0 + tok) * NINP + (qk ? C_K : C_Q) + h * 64 + d1;
            float x1[8], x2[8], o1[8], o2[8]; unpack8(*(const uint4*)(P + so), x1); unpack8(*(const uint4*)(P + so + 16), x2);
            const int t = t0 + tok, pos = (pp < 2) ? (t >> 6) : (t & 63), j0 = (pp & 1) * 8; const float scl = qk ? 1.0f : 0.125f;
#pragma unroll
            for (int j = 0; j < 8; ++j) { lf2 c = cs[pos * 16 + j0 + j]; if (!lat) c = (lf2){1.f, 0.f}; o1[j] = (x1[j] * c.x - x2[j] * c.y) * scl; o2[j] = (x1[j] * c.y + x2[j] * c.x) * scl; }
            bf16_t* dq = (qk ? KR : QR) + (size_t)(r0 + tok) * 384 + h * 64 + d1; *(uint4*)dq = pack8(o1); *(uint4*)(dq + 16) = pack8(o2); }
#pragma unroll 4
        for (int i = 0; i < 24; ++i) { const int idx = tid + NTHR * i, tok = idx / 192, pc = idx % 192, c0 = pc * 8, r = r0 + tok, t = t0 + tok;
            const bf16_t* zp = P + (size_t)r * NINP + C_Z + c0; float x[8], pv[8], nx[8], zs[8];
            unpack8(*(const uint4*)zp, x);
            if (t > 0) unpack8(*(const uint4*)(zp - NINP), pv); else {
#pragma unroll
                for (int j = 0; j < 8; ++j) pv[j] = 0.f; }
            if (t < slen - 1) unpack8(*(const uint4*)(zp + NINP), nx); else {
#pragma unroll
                for (int j = 0; j < 8; ++j) nx[j] = 0.f; }
            const float4 mu0 = *(const float4*)(p.in[20] + l * 1536 + c0), mu1 = *(const float4*)(p.in[20] + l * 1536 + c0 + 4); const float mu[8] = {mu0.x, mu0.y, mu0.z, mu0.w, mu1.x, mu1.y, mu1.z, mu1.w};
#pragma unroll
            for (int j = 0; j < 8; ++j) zs[j] = x[j] + (0.5f * (pv[j] + nx[j]) - x[j]) * mu[j];
            const bool isk = c0 >= 384 && c0 < 768; float kv[8]; float ss = 0.f;
            { const int kc = isk ? c0 - 384 : 0; const float4 k0 = *(const float4*)(p.in[26] + l * 384 + kc), k1 = *(const float4*)(p.in[26] + l * 384 + kc + 4); const float kkw[8] = {k0.x, k0.y, k0.z, k0.w, k1.x, k1.y, k1.z, k1.w};
#pragma unroll
              for (int j = 0; j < 8; ++j) { kv[j] = zs[j] * kkw[j]; ss += kv[j] * kv[j]; } }
            ss += __shfl_xor(ss, 1); ss += __shfl_xor(ss, 2); ss += __shfl_xor(ss, 4);
            if (c0 < 384) *(uint4*)(RS + (size_t)r * 384 + c0) = pack8(zs);
            else if (c0 < 768) { *(uint4*)(KS + (size_t)r * 384 + c0 - 384) = pack8(zs); const float inv = 1.0f / fmaxf(sqrtf(ss), 1e-12f);
#pragma unroll
                for (int j = 0; j < 8; ++j) kv[j] *= inv;
                *(uint4*)(KK + (size_t)r * 384 + c0 - 384) = pack8(kv); }
            else if (c0 < 1152) *(uint4*)(VS + (size_t)r * 384 + c0 - 768) = pack8(zs);
            else { const int ac = c0 - 1152; float o[8];
#pragma unroll
                for (int j = 0; j < 8; ++j) o[j] = ac < 128 ? 1.0f - 2.0f / (1.0f + __expf(2.0f * zs[j])) : (ac < 256 ? zs[j] : sigm(zs[j]));
                *(uint4*)(ALR + (size_t)r * 384 + ac) = pack8(o); }
        }
        __syncthreads();
    }
}

template <int KS, int MODE> __device__ __forceinline__ void lr_wave(const Params& p, int l, int row0, int kofs, const bf16_t* Bt, int d) {
    const int lane = threadIdx.x & 63, m = lane & 15, q = lane >> 4;
    const bf16_t* Ap = (const bf16_t*)(p.ws + U_ALR) + (size_t)(row0 + m) * 384 + kofs + q * 8;
    bf16x8 a[KS];
#pragma unroll
    for (int ks = 0; ks < KS; ++ks) a[ks] = *(const bf16x8*)(Ap + ks * 32);
    bf16_t* O = (bf16_t*)(p.ws + (MODE == 0 ? U_LD + (size_t)d * SZ384 : (MODE == 1 ? U_AG + (size_t)d * SZ384 : U_G))) + (size_t)(row0 + m) * 384;
    const float* bias = MODE == 0 ? p.in[21] + (l * 2 + d) * 384 : p.in[23] + (l * 2 + d) * 384;
    for (int nt = 0; nt < 24; ++nt) {
        f32x4 acc = (f32x4){0.f, 0.f, 0.f, 0.f};
#pragma unroll
        for (int ks = 0; ks < KS; ++ks) { const bf16x8 bfr = *(const bf16x8*)(Bt + (size_t)(nt * 16 + m) * (KS * 32) + ks * 32 + q * 8); acc = mfma16(bfr, a[ks], acc); }
        const int n = nt * 16 + q * 4; float o[4];
        if (MODE == 2) {
#pragma unroll
            for (int j = 0; j < 4; ++j) o[j] = acc[j];
        } else { const float4 bv = *(const float4*)(bias + n); const float bb[4] = {bv.x, bv.y, bv.z, bv.w};
#pragma unroll
            for (int j = 0; j < 4; ++j) { const float s = sigm(bb[j] + acc[j]); o[j] = MODE == 0 ? -0.6065306597f * s : s; } }
        u32x2 w; w.x = pack2(o[0], o[1]); w.y = pack2(o[2], o[3]); *(u32x2*)(O + n) = w;
    }
}
__device__ __forceinline__ void lowrank_items(const Params& p, int l, int wid, int nw) {
    const unsigned char* sw = p.ws + WS_SW + (size_t)l * SW_STRIDE;
    for (int it = wid; it < 2304 * 5; it += nw) { const int rt = it / 5, m = it % 5, row0 = rt * 16;
        if (m < 2) lr_wave<2, 0>(p, l, row0, m * 64, (const bf16_t*)(sw + SW_W2T) + (size_t)m * 384 * 64, m);
        else if (m < 4) lr_wave<2, 1>(p, l, row0, m * 64, (const bf16_t*)(sw + SW_A2T) + (size_t)(m - 2) * 384 * 64, m - 2);
        else lr_wave<4, 2>(p, l, row0, 256, (const bf16_t*)(sw + SW_G2T), 0); }
}

__device__ __forceinline__ int s5_rowbase(int cr) { const int b = cr / 144, c = cr % 144; return c < 16 ? NLAT + b * 256 + c * 16 : b * 2048 + (c - 16) * 16; }
__device__ __forceinline__ void s5_pass1_items(const Params& p, int l, int wid, int nw) {
    const int lane = threadIdx.x & 63, m = lane & 15, q = lane >> 4;
    const bf16_t* P = (const bf16_t*)(p.ws + U_U16); float* SLOC = (float*)(p.ws + U_SLOC);
    for (int it = wid; it < 144 * 16; it += nw) { const int ct = it >> 4, g = it & 15, cr = ct * 16 + m, rb = s5_rowbase(cr);
        const bf16_t* E = (const bf16_t*)(p.ws + WS_SW + (size_t)l * SW_STRIDE + SW_S5E) + (size_t)g * 256 * 256;
        bf16x8 a[8];
#pragma unroll
        for (int ks = 0; ks < 8; ++ks) a[ks] = *(const bf16x8*)(P + (size_t)(rb + 2 * ks + (q >> 1)) * 256 + g * 16 + (q & 1) * 8);
        float* o = SLOC + ((size_t)cr * 16 + g) * 256 + q * 4;
#pragma unroll 2
        for (int nt = 0; nt < 16; ++nt) { f32x4 acc = (f32x4){0.f, 0.f, 0.f, 0.f}; const bf16_t* ep = E + (size_t)(nt * 16 + m) * 256 + q * 8;
#pragma unroll
            for (int ks = 0; ks < 8; ++ks) acc = mfma16(*(const bf16x8*)(ep + ks * 32), a[ks], acc);
            *(f32x4*)(o + nt * 16) = acc; }
    }
}
__device__ __forceinline__ void s5_carry(const Params& p, int l) {
    const int gid = blockIdx.x * NTHR + threadIdx.x; if (gid >= 32768) return;
    const int pp = gid & 63, d = (gid >> 6) & 1, g = (gid >> 7) & 15, b = gid >> 11;
    const int li = ((l * 2 + d) * 16 + g) * 64 + pp; const float lr = p.in[9][li], lim = p.in[10][li], dt = expf(p.in[11][(l * 2 + d) * 16 + g]);
    const float mag = expf(16.0f * dt * lr); float sn, cn; sincosf(16.0f * dt * lim, &sn, &cn); const float ar = mag * cn, ai = mag * sn;
    const float* SLOC = (const float*)(p.ws + U_SLOC); bf16_t* SP = (bf16_t*)(p.ws + U_SPREV);
    float sr = 0.f, si = 0.f;
#pragma unroll 8
    for (int n = 0; n < 144; ++n) { const int c = d == 0 ? n : (n < 16 ? 15 - n : 159 - n); const size_t idx = ((size_t)(b * 144 + c) * 16 + g) * 256 + d * 128 + pp;
        SP[idx] = f2bf(sr); SP[idx + 64] = f2bf(si);
        const float xr = SLOC[idx], xi = SLOC[idx + 64]; const float nr = ar * sr - ai * si + xr, ni = ar * si + ai * sr + xi; sr = nr; si = ni; }
}
__device__ __forceinline__ void s5_pass2_items(const Params& p, int l, int wid, int nw) {
    const int lane = threadIdx.x & 63, m = lane & 15, q = lane >> 4;
    const bf16_t* P = (const bf16_t*)(p.ws + U_U16); const bf16_t* SP = (const bf16_t*)(p.ws + U_SPREV); bf16_t* YG = (bf16_t*)(p.ws + U_YG);
    for (int it = wid; it < 144 * 16; it += nw) { const int ct = it >> 4, g = it & 15; if (l == 1 && ct % 9 == 0) continue;
        const int cr = ct * 16 + m, rb = s5_rowbase(cr);
        const bf16_t* W2 = (const bf16_t*)(p.ws + WS_SW + (size_t)l * SW_STRIDE + SW_S5W2) + (size_t)g * 256 * 512;
        bf16x8 a[16];
#pragma unroll
        for (int ks = 0; ks < 8; ++ks) a[ks] = *(const bf16x8*)(P + (size_t)(rb + 2 * ks + (q >> 1)) * 256 + g * 16 + (q & 1) * 8);
#pragma unroll
        for (int ks = 8; ks < 16; ++ks) a[ks] = *(const bf16x8*)(SP + ((size_t)cr * 16 + g) * 256 + (ks - 8) * 32 + q * 8);
#pragma unroll 2
        for (int nt = 0; nt < 16; ++nt) { f32x4 acc = (f32x4){0.f, 0.f, 0.f, 0.f}; const bf16_t* wp = W2 + (size_t)(nt * 16 + m) * 512 + q * 8;
#pragma unroll
            for (int ks = 0; ks < 16; ++ks) acc = mfma16(*(const bf16x8*)(wp + ks * 32), a[ks], acc);
            float o[4];
#pragma unroll
            for (int j = 0; j < 4; ++j) { const float x = acc[j]; const float u = 0.7978845608f * (x + 0.044715f * x * x * x); const float th = 1.0f - 2.0f / (1.0f + __expf(2.0f * u)); o[j] = 0.5f * x * (1.0f + th); }
            u32x2 w; w.x = pack2(o[0], o[1]); w.y = pack2(o[2], o[3]); *(u32x2*)(YG + (size_t)(rb + nt) * 256 + g * 16 + q * 4) = w; }
    }
}
__device__ __forceinline__ void s5_glu_items(const Params& p, int l, int wid, int nw) {
    const int lane = threadIdx.x & 63, m = lane & 15, q = lane >> 4;
    const bf16_t* YG = (const bf16_t*)(p.ws + U_YG); bf16_t* YC = (bf16_t*)(p.ws + WS_ABUF);
    const bf16_t* GT = (const bf16_t*)(p.ws + WS_SW + (size_t)l * SW_STRIDE + SW_GLUT);
    const int nrt = (l == 0 ? NROW : NLAT) / 16;
    for (int rt = wid; rt < nrt; rt += nw) { const int row = rt * 16 + m;
        bf16x8 a[8];
#pragma unroll
        for (int ks = 0; ks < 8; ++ks) a[ks] = *(const bf16x8*)(YG + (size_t)row * 256 + ks * 32 + q * 8);
#pragma unroll 2
        for (int nt = 0; nt < 16; ++nt) { f32x4 acc = (f32x4){0.f, 0.f, 0.f, 0.f}; const bf16_t* gp = GT + (size_t)(nt * 16 + m) * 256 + q * 8;
#pragma unroll
            for (int ks = 0; ks < 8; ++ks) acc = mfma16(*(const bf16x8*)(gp + ks * 32), a[ks], acc);
            const int n = nt * 16 + q * 4; const float4 bv = *(const float4*)(p.in[18] + l * 256 + n); const u32x2 yw = *(const u32x2*)(YG + (size_t)row * 256 + n);
            u32x2 w; w.x = pack2(bflo(yw.x) * sigm(acc[0] + bv.x), bfhi(yw.x) * sigm(acc[1] + bv.y)); w.y = pack2(bflo(yw.y) * sigm(acc[2] + bv.z), bfhi(yw.y) * sigm(acc[3] + bv.w));
            *(u32x2*)(YC + (size_t)row * 1024 + n) = w; }
    }
}

template <bool HASLAT> __device__ __forceinline__ void na_unit(const Params& p, const LAS float* rpb_l, int b, int h, int i, int n) {
    const int lane = threadIdx.x & 63, m = lane & 15, q = lane >> 4, kin = 8 * (m >> 2) + (m & 3);
    const bf16_t* QR = (const bf16_t*)(p.ws + U_QR); const bf16_t* KR = (const bf16_t*)(p.ws + U_KR);
    const bf16_t* VTL = (const bf16_t*)(p.ws + U_VT) + (size_t)(b * 6 + h) * 64 * 2048; const bf16_t* VTC = (const bf16_t*)(p.ws + U_VTC) + (size_t)(b * 6 + h) * 64 * 256;
    const int qrow = HASLAT ? b * 2048 + i * 64 + n * 16 + m : NLAT + b * 256 + n * 16 + m;
    bf16x8 qf[2];
#pragma unroll
    for (int ks = 0; ks < 2; ++ks) qf[ks] = *(const bf16x8*)(QR + (size_t)qrow * 384 + h * 64 + ks * 32 + q * 8);
    const int r0 = HASLAT ? min(max(i - 4, 0), 24) : 0, scol = HASLAT ? min(max(n * 16 - 8, 0), 32) : 0;
    f32x4 sl[HASLAT ? 16 : 1], sc[16];
    float mx = -3.0e38f;
    if (HASLAT) { const int qc = n * 16 + m, c0 = min(max(qc - 8, 0), 48); const LAS float* rpb = rpb_l + h * 15 * 31;
#pragma unroll
        for (int t = 0; t < 16; ++t) { const int kr = t >> 1, ch = t & 1; const bf16_t* kp = KR + (size_t)(b * 2048 + (r0 + kr) * 64 + scol + kin + 4 * ch) * 384 + h * 64 + q * 8;
            f32x4 acc = (f32x4){0.f, 0.f, 0.f, 0.f};
#pragma unroll
            for (int ks = 0; ks < 2; ++ks) acc = mfma16(*(const bf16x8*)(kp + ks * 32), qf[ks], acc);
            const int dr = r0 + kr - i + 7;
#pragma unroll
            for (int j = 0; j < 4; ++j) { const int kc = scol + 8 * q + 4 * ch + j; const bool valid = kc >= c0 && kc < c0 + 16; const int dc = min(max(kc - qc + 15, 0), 30);
                const float s = valid ? acc[j] + rpb[dr * 31 + dc] : -1.0e30f; acc[j] = s; mx = fmaxf(mx, s); }
            sl[t] = acc; if ((t & 7) == 7) __builtin_amdgcn_sched_barrier(0); } }
#pragma unroll
    for (int t = 0; t < 16; ++t) { const bf16_t* kp = KR + (size_t)(NLAT + b * 256 + (t >> 1) * 32 + kin + 4 * (t & 1)) * 384 + h * 64 + q * 8;
        f32x4 acc = (f32x4){0.f, 0.f, 0.f, 0.f};
#pragma unroll
        for (int ks = 0; ks < 2; ++ks) acc = mfma16(*(const bf16x8*)(kp + ks * 32), qf[ks], acc);
#pragma unroll
        for (int j = 0; j < 4; ++j) mx = fmaxf(mx, acc[j]);
        sc[t] = acc; }
    mx = fmaxf(mx, __shfl_xor(mx, 16)); mx = fmaxf(mx, __shfl_xor(mx, 32));
    float sum = 0.f;
    f32x4 o[4];
#pragma unroll
    for (int dt = 0; dt < 4; ++dt) o[dt] = (f32x4){0.f, 0.f, 0.f, 0.f};
    if (HASLAT) {
#pragma unroll
        for (int kr = 0; kr < 8; ++kr) { float e[8];
#pragma unroll
            for (int j = 0; j < 4; ++j) { e[j] = __expf(sl[2 * kr][j] - mx); e[4 + j] = __expf(sl[2 * kr + 1][j] - mx); }
#pragma unroll
            for (int j = 0; j < 8; ++j) sum += e[j];
            const uint4 pw = pack8(e); const bf16x8 pf = __builtin_bit_cast(bf16x8, pw);
            const int tok = (r0 + kr) * 64 + scol + q * 8;
#pragma unroll
            for (int dt = 0; dt < 4; ++dt) o[dt] = mfma16(*(const bf16x8*)(VTL + (size_t)(dt * 16 + m) * 2048 + tok), pf, o[dt]);
            if (kr & 1) __builtin_amdgcn_sched_barrier(0); } }
#pragma unroll
    for (int t2 = 0; t2 < 8; ++t2) { float e[8];
#pragma unroll
        for (int j = 0; j < 4; ++j) { e[j] = __expf(sc[2 * t2][j] - mx); e[4 + j] = __expf(sc[2 * t2 + 1][j] - mx); }
#pragma unroll
        for (int j = 0; j < 8; ++j) sum += e[j];
        const uint4 pw = pack8(e); const bf16x8 pf = __builtin_bit_cast(bf16x8, pw);
        const int tok = t2 * 32 + q * 8;
#pragma unroll
        for (int dt = 0; dt < 4; ++dt) o[dt] = mfma16(*(const bf16x8*)(VTC + (size_t)(dt * 16 + m) * 256 + tok), pf, o[dt]);
        if (t2 & 1) __builtin_amdgcn_sched_barrier(0); }
    sum += __shfl_xor(sum, 16); sum += __shfl_xor(sum, 32);
    const float inv = 1.0f / sum;
    bf16_t* yo = (bf16_t*)(p.ws + WS_ABUF) + (size_t)qrow * 1024 + 256 + h * 64 + q * 4;
#pragma unroll
    for (int dt = 0; dt < 4; ++dt) { u32x2 w; w.x = pack2(o[dt][0] * inv, o[dt][1] * inv); w.y = pack2(o[dt][2] * inv, o[dt][3] * inv); *(u32x2*)(yo + dt * 16) = w; }
}
template <bool HASLAT> __device__ __forceinline__ void na_block(const Params& p, int l, int b, int h, int sel, LAS unsigned char* lds) {
    LAS bf16_t* Ks = (LAS bf16_t*)lds;
    LAS bf16_t* Vs = (LAS bf16_t*)lds;
    LAS float* rp = (LAS float*)(lds + 120064);
    const int tid = threadIdx.x, lane = tid & 63, m = lane & 15, q = lane >> 4, w = tid >> 6, kin = 8 * (m >> 2) + (m & 3);
    const bf16_t* QR = (const bf16_t*)(p.ws + U_QR); const bf16_t* KR = (const bf16_t*)(p.ws + U_KR);
    const bf16_t* VTL = (const bf16_t*)(p.ws + U_VT) + (size_t)(b * 6 + h) * 64 * 2048; const bf16_t* VTC = (const bf16_t*)(p.ws + U_VTC) + (size_t)(b * 6 + h) * 64 * 256;
    const int i0 = HASLAT ? 2 * sel : 0, rlo = HASLAT ? min(max(i0 - 4, 0), 24) : 0;
    __syncthreads();
    int tk = threadIdx.x; asm volatile("" : "+v"(tk));
    if (HASLAT) {
#pragma unroll
        for (int j = 0; j < 9; ++j) { const int idx = tk + NTHR * j, key = idx >> 3, pc = idx & 7, tok = rlo * 64 + key;
            if (tok < 2048) *(LAS lu4*)(Ks + key * 72 + pc * 8) = *(const lu4*)(KR + (size_t)(b * 2048 + tok) * 384 + h * 64 + pc * 8); }
        for (int j = tk; j < 465; j += NTHR) rp[j] = p.in[19][(size_t)(l * 6 + h) * 465 + j]; }
#pragma unroll
    for (int j = 0; j < 4; ++j) { const int idx = tk + NTHR * j, key = idx >> 3, pc = idx & 7;
        *(LAS lu4*)(Ks + (576 + key) * 72 + pc * 8) = *(const lu4*)(KR + (size_t)(NLAT + b * 256 + key) * 384 + h * 64 + pc * 8); }
    const int i = HASLAT ? i0 + (w >> 2) : 0, n = HASLAT ? (w & 3) : sel * 8 + w;
    const int qrow = HASLAT ? b * 2048 + i * 64 + n * 16 + m : NLAT + b * 256 + n * 16 + m;
    bf16x8 qf[2];
#pragma unroll
    for (int ks = 0; ks < 2; ++ks) qf[ks] = *(const bf16x8*)(QR + (size_t)qrow * 384 + h * 64 + ks * 32 + q * 8);
    const int r0 = HASLAT ? min(max(i - 4, 0), 24) : 0, scol = HASLAT ? min(max(n * 16 - 8, 0), 32) : 0, kb = (r0 - rlo) * 64 + scol;
    LAS unsigned char* kbl = (LAS unsigned char*)(Ks + (kb + kin) * 72 + q * 8); LAS unsigned char* kbc = (LAS unsigned char*)(Ks + (576 + kin) * 72 + q * 8);
    LAS unsigned char* vb0 = (LAS unsigned char*)(Vs + (0 * 16 + m) * 840 + q * 8); LAS unsigned char* vb1 = (LAS unsigned char*)(Vs + (1 * 16 + m) * 840 + q * 8);
    LAS unsigned char* vb2 = (LAS unsigned char*)(Vs + (2 * 16 + m) * 840 + q * 8); LAS unsigned char* vb3 = (LAS unsigned char*)(Vs + (3 * 16 + m) * 840 + q * 8);
    asm volatile("" : "+v"(kbl), "+v"(kbc), "+v"(vb0), "+v"(vb1), "+v"(vb2), "+v"(vb3));
    __syncthreads();
    float mx1 = -3.0e38f, mx2 = -3.0e38f, sum1 = 0.f, sum2 = 0.f;
    bf16x8 pl[HASLAT ? 8 : 1], pcx[8];
    if (HASLAT) { const int qc = n * 16 + m, c0 = min(max(qc - 8, 0), 48); f32x4 sl[16];
#pragma unroll
        for (int t = 0; t < 16; ++t) { const int kr = t >> 1, ch = t & 1; const LAS bf16_t* kp = (const LAS bf16_t*)(kbl + (kr * 64 + 4 * ch) * 144);
            f32x4 acc = (f32x4){0.f, 0.f, 0.f, 0.f};
#pragma unroll
            for (int ks = 0; ks < 2; ++ks) acc = mfma16(*(const LAS bf16x8*)(kp + ks * 32), qf[ks], acc);
            const int dr = r0 + kr - i + 7;
#pragma unroll
            for (int j = 0; j < 4; ++j) { const int kc = scol + 8 * q + 4 * ch + j; const bool valid = kc >= c0 && kc < c0 + 16; const int dc = min(max(kc - qc + 15, 0), 30);
                const float sv = valid ? acc[j] + rp[dr * 31 + dc] : -1.0e30f; acc[j] = sv; mx1 = fmaxf(mx1, sv); }
            sl[t] = acc; if ((t & 3) == 3) __builtin_amdgcn_sched_barrier(0); }
        mx1 = fmaxf(mx1, __shfl_xor(mx1, 16)); mx1 = fmaxf(mx1, __shfl_xor(mx1, 32));
#pragma unroll
        for (int kr = 0; kr < 8; ++kr) { float e[8];
#pragma unroll
            for (int j = 0; j < 4; ++j) { e[j] = __expf(sl[2 * kr][j] - mx1); e[4 + j] = __expf(sl[2 * kr + 1][j] - mx1); }
#pragma unroll
            for (int j = 0; j < 8; ++j) sum1 += e[j];
            const uint4 pw = pack8(e); pl[kr] = __builtin_bit_cast(bf16x8, pw); }
        __builtin_amdgcn_sched_barrier(0); }
    { f32x4 sc[16];
#pragma unroll
      for (int t = 0; t < 16; ++t) { const LAS bf16_t* kp = (const LAS bf16_t*)(kbc + ((t >> 1) * 32 + 4 * (t & 1)) * 144);
          f32x4 acc = (f32x4){0.f, 0.f, 0.f, 0.f};
#pragma unroll
          for (int ks = 0; ks < 2; ++ks) acc = mfma16(*(const LAS bf16x8*)(kp + ks * 32), qf[ks], acc);
#pragma unroll
          for (int j = 0; j < 4; ++j) mx2 = fmaxf(mx2, acc[j]);
          sc[t] = acc; if ((t & 3) == 3) __builtin_amdgcn_sched_barrier(0); }
      mx2 = fmaxf(mx2, __shfl_xor(mx2, 16)); mx2 = fmaxf(mx2, __shfl_xor(mx2, 32));
#pragma unroll
      for (int t2 = 0; t2 < 8; ++t2) { float e[8];
#pragma unroll
          for (int j = 0; j < 4; ++j) { e[j] = __expf(sc[2 * t2][j] - mx2); e[4 + j] = __expf(sc[2 * t2 + 1][j] - mx2); }
#pragma unroll
          for (int j = 0; j < 8; ++j) sum2 += e[j];
          const uint4 pw = pack8(e); pcx[t2] = __builtin_bit_cast(bf16x8, pw); } }
    sum1 += __shfl_xor(sum1, 16); sum1 += __shfl_xor(sum1, 32); sum2 += __shfl_xor(sum2, 16); sum2 += __shfl_xor(sum2, 32);
    __builtin_amdgcn_sched_barrier(0);
    __syncthreads();
    int tv = threadIdx.x; asm volatile("" : "+v"(tv));
    if (HASLAT) {
#pragma unroll
        for (int j = 0; j < 9; ++j) { const int idx = tv + NTHR * j, dim = idx / 72, pc = idx % 72, tok = rlo * 64 + pc * 8;
            if (tok < 2048) *(LAS lu4*)(Vs + dim * 840 + pc * 8) = *(const lu4*)(VTL + (size_t)dim * 2048 + tok); } }
#pragma unroll
    for (int j = 0; j < 4; ++j) { const int idx = tv + NTHR * j, dim = idx >> 5, pc = idx & 31; *(LAS lu4*)(Vs + dim * 840 + 576 + pc * 8) = *(const lu4*)(VTC + (size_t)dim * 256 + pc * 8); }
    __syncthreads();
    const int kbv = kb * 2;
    f32x4 o1[4], o2[4];
#pragma unroll
    for (int dt = 0; dt < 4; ++dt) { o1[dt] = (f32x4){0.f, 0.f, 0.f, 0.f}; o2[dt] = (f32x4){0.f, 0.f, 0.f, 0.f}; }
    if (HASLAT) {
#pragma unroll
        for (int kr = 0; kr < 8; ++kr) {
#pragma unroll
            for (int dt = 0; dt < 4; ++dt) { LAS unsigned char* vb = dt == 0 ? vb0 : dt == 1 ? vb1 : dt == 2 ? vb2 : vb3; o1[dt] = mfma16(*(const LAS bf16x8*)(vb + kbv + kr * 128), pl[kr], o1[dt]); }
            if (kr & 1) __builtin_amdgcn_sched_barrier(0); } }
#pragma unroll
    for (int t2 = 0; t2 < 8; ++t2) {
#pragma unroll
        for (int dt = 0; dt < 4; ++dt) { LAS unsigned char* vb = dt == 0 ? vb0 : dt == 1 ? vb1 : dt == 2 ? vb2 : vb3; o2[dt] = mfma16(*(const LAS bf16x8*)(vb + 1152 + t2 * 64), pcx[t2], o2[dt]); }
        if (t2 & 1) __builtin_amdgcn_sched_barrier(0); }
    const float mxm = fmaxf(mx1, mx2), a1 = HASLAT ? __expf(mx1 - mxm) : 0.f, a2 = __expf(mx2 - mxm), inv = 1.0f / (a1 * sum1 + a2 * sum2), c1 = a1 * inv, c2 = a2 * inv;
    bf16_t* yo = (bf16_t*)(p.ws + WS_ABUF) + (size_t)qrow * 1024 + 256 + h * 64 + q * 4;
#pragma unroll
    for (int dt = 0; dt < 4; ++dt) { u32x2 wv2; wv2.x = pack2(o1[dt][0] * c1 + o2[dt][0] * c2, o1[dt][1] * c1 + o2[dt][1] * c2); wv2.y = pack2(o1[dt][2] * c1 + o2[dt][2] * c2, o1[dt][3] * c1 + o2[dt][3] * c2); *(u32x2*)(yo + dt * 16) = wv2; }
}
__device__ __forceinline__ void na_items(const Params& p, int l, int wid, int nw, LAS unsigned char* lds) {
    (void)wid; (void)nw;
    const int nlat = 16 * 6 * 16, nctx = (l == 0) ? 16 * 6 * 2 : 0;
    for (int it = blockIdx.x; it < nlat + nctx; it += gridDim.x) {
        if (it < nlat) { const int ip = it & 15, bh = it >> 4; na_block<true>(p, l, bh / 6, bh % 6, ip, lds); }
        else { const int j = it - nlat, half = j & 1, bh = j >> 1; na_block<false>(p, l, bh / 6, bh % 6, half, lds); }
    }
    __syncthreads();
}

typedef float f32x2 __attribute__((ext_vector_type(2)));
__device__ __forceinline__ int rk_row(int b, int d, int n) { return n < 256 ? NLAT + b * 256 + (d ? 255 - n : n) : b * 2048 + (d ? 2047 - (n - 256) : (n - 256)); }
template <int CTRL> __device__ __forceinline__ float dpp_f(float v) { return __builtin_bit_cast(float, __builtin_amdgcn_update_dpp(0, __builtin_bit_cast(int, v), CTRL, 0xF, 0xF, true)); }
constexpr int RKP_PITCH = 72, RKP_MAT = 16 * RKP_PITCH * 2, RKP_WAVE = 5 * RKP_MAT + 4 * 16 * 17 * 4;
__device__ __forceinline__ bf16x8 pack_frag(const float (&lo)[4], const float (&hi)[4]) { u32x4 w; w.x = pack2(lo[0], lo[1]); w.y = pack2(lo[2], lo[3]); w.z = pack2(hi[0], hi[1]); w.w = pack2(hi[2], hi[3]); return __builtin_bit_cast(bf16x8, w); }
__device__ __forceinline__ void rwkv_pre_items(const Params& p, int l, int wid, int nw, LAS unsigned char* lds) {
    const int lane = threadIdx.x & 63, m = lane & 15, q = lane >> 4, wv = threadIdx.x >> 6;
    LAS bf16_t* sAt = (LAS bf16_t*)(lds + wv * RKP_WAVE); LAS bf16_t* sBh = sAt + 16 * RKP_PITCH; LAS bf16_t* sKh = sBh + 16 * RKP_PITCH; LAS bf16_t* sRt = sKh + 16 * RKP_PITCH; LAS bf16_t* sV = sRt + 16 * RKP_PITCH;
    LAS float* sM = (LAS float*)(lds + wv * RKP_WAVE + 5 * RKP_MAT);
    const bf16_t* RS = (const bf16_t*)(p.ws + U_RS); const bf16_t* KS = (const bf16_t*)(p.ws + U_KS); const bf16_t* VS = (const bf16_t*)(p.ws + U_VS); const bf16_t* KK = (const bf16_t*)(p.ws + U_KK);
    for (int it = wid; it < NCHUNK; it += nw) { const int u = it / 144, c = it % 144, b = u / 12, h = (u % 12) >> 1, d = u & 1;
        const bf16_t* AG = (const bf16_t*)(p.ws + U_AG + (size_t)d * SZ384); const bf16_t* LD = (const bf16_t*)(p.ws + U_LD + (size_t)d * SZ384);
        const int rb = rk_row(b, d, c * 16), sgn = d ? -1 : 1;
        { LAS bf16_t* sLd = (LAS bf16_t*)sM;
#pragma unroll
          for (int k = 0; k < 12; ++k) { const int idx = lane + 64 * k, pair = idx >> 3, arr = pair >> 4, t = pair & 15, pc = idx & 7;
              const bf16_t* src = arr == 0 ? KK : arr == 1 ? AG : arr == 2 ? KS : arr == 3 ? RS : arr == 4 ? VS : LD;
              LAS bf16_t* dst = arr == 0 ? sAt : arr == 1 ? sBh : arr == 2 ? sKh : arr == 3 ? sRt : arr == 4 ? sV : sLd;
              *(LAS lu4*)(dst + t * RKP_PITCH + pc * 8) = *(const lu4*)(src + (size_t)(rb + sgn * t) * 384 + h * 64 + pc * 8); }
          const float ka = p.in[27][l * 384 + h * 64 + lane]; float L = 0.f;
#pragma unroll 4
          for (int t = 0; t < 16; ++t) { const int o = t * RKP_PITCH + lane;
              const float r_ = bf2f(sRt[o]), k_ = bf2f(sKh[o]), kk_ = bf2f(sAt[o]), ag_ = bf2f(sBh[o]), ld_ = bf2f(sLd[o]);
              const float e0 = __expf(L); L += ld_; const float e1 = __expf(L), ei = __expf(-L);
              sAt[o] = f2bf(-kk_ * e0); sBh[o] = f2bf(kk_ * ag_ * ei); sKh[o] = f2bf(k_ * (1.0f + (ag_ - 1.0f) * ka) * ei); sRt[o] = f2bf(r_ * e1); }
          ((bf16_t*)(p.ws + CH_GT))[(size_t)it * 64 + lane] = f2bf(L); }
        { bf16x8 atf[2], rtf[2], bhf[2], khf[2];
#pragma unroll
          for (int ks = 0; ks < 2; ++ks) { atf[ks] = *(const LAS bf16x8*)(sAt + m * RKP_PITCH + ks * 32 + q * 8); rtf[ks] = *(const LAS bf16x8*)(sRt + m * RKP_PITCH + ks * 32 + q * 8);
              bhf[ks] = *(const LAS bf16x8*)(sBh + m * RKP_PITCH + ks * 32 + q * 8); khf[ks] = *(const LAS bf16x8*)(sKh + m * RKP_PITCH + ks * 32 + q * 8); }
          f32x4 mab = (f32x4){0.f, 0.f, 0.f, 0.f}, mak = mab, mrb = mab, mrk = mab;
#pragma unroll
          for (int ks = 0; ks < 2; ++ks) { mab = mfma16(atf[ks], bhf[ks], mab); mak = mfma16(atf[ks], khf[ks], mak); mrb = mfma16(rtf[ks], bhf[ks], mrb); mrk = mfma16(rtf[ks], khf[ks], mrk); }
#pragma unroll
          for (int r = 0; r < 4; ++r) { const int t = 4 * q + r; sM[(0 * 16 + t) * 17 + m] = m < t ? mab[r] : 0.f; sM[(1 * 16 + t) * 17 + m] = m < t ? mak[r] : 0.f;
              sM[(2 * 16 + t) * 17 + m] = m <= t ? mrb[r] : 0.f; sM[(3 * 16 + t) * 17 + m] = m <= t ? mrk[r] : 0.f; } }
        { float tv[16];
#pragma unroll
          for (int t = 0; t < 16; ++t) { float acc = (m == t) ? 1.0f : 0.0f;
#pragma unroll
              for (int s2 = 0; s2 < t; ++s2) acc += sM[t * 17 + s2] * tv[s2];
              tv[t] = acc; }
#pragma unroll
          for (int t = 0; t < 16; ++t) if (q == 0) sM[t * 17 + m] = tv[t]; }
        bf16x8 tinvf, mrbf;
        { float lo[4], hi[4] = {0.f, 0.f, 0.f, 0.f};
#pragma unroll
          for (int j = 0; j < 4; ++j) lo[j] = sM[(0 * 16 + m) * 17 + 4 * q + j];
          tinvf = pack_frag(lo, hi);
#pragma unroll
          for (int j = 0; j < 4; ++j) lo[j] = sM[(2 * 16 + m) * 17 + 4 * q + j];
          mrbf = pack_frag(lo, hi);
#pragma unroll
          for (int j = 0; j < 4; ++j) hi[j] = sM[(3 * 16 + m) * 17 + 4 * q + j];
          *(bf16x8*)((bf16_t*)(p.ws + CH_MM) + ((size_t)it * 64 + lane) * 8) = pack_frag(lo, hi); }
        { bf16x8 makf; { float lo[4], hi[4];
#pragma unroll
            for (int j = 0; j < 4; ++j) { lo[j] = q < 2 ? sM[(1 * 16 + m) * 17 + 8 * q + j] : 0.f; hi[j] = q < 2 ? sM[(1 * 16 + m) * 17 + 8 * q + 4 + j] : 0.f; }
            makf = pack_frag(lo, hi); }
#pragma unroll
          for (int itile = 0; itile < 4; ++itile) { unsigned vw[4];
#pragma unroll
              for (int j = 0; j < 4; ++j) vw[j] = q < 2 ? ((unsigned)sV[(8 * q + 2 * j) * RKP_PITCH + 16 * itile + m] | ((unsigned)sV[(8 * q + 2 * j + 1) * RKP_PITCH + 16 * itile + m] << 16)) : 0u;
              const u32x4 vq = {vw[0], vw[1], vw[2], vw[3]};
              const f32x4 w1 = mfma16(makf, __builtin_bit_cast(bf16x8, vq), (f32x4){0.f, 0.f, 0.f, 0.f});
              const float lo[4] = {w1[0], w1[1], w1[2], w1[3]}, hi[4] = {0.f, 0.f, 0.f, 0.f};
              const f32x4 uu = mfma16(tinvf, pack_frag(lo, hi), (f32x4){0.f, 0.f, 0.f, 0.f});
              u32x2 o; o.x = pack2(uu[0], uu[1]); o.y = pack2(uu[2], uu[3]);
              *(u32x2*)((bf16_t*)(p.ws + CH_UL) + (((size_t)it * 4 + itile) * 64 + lane) * 4) = o; } }
        f32x4 ap[4], rp[4];
#pragma unroll
        for (int jt = 0; jt < 4; ++jt) { float lo[4], hi[4] = {0.f, 0.f, 0.f, 0.f};
#pragma unroll
            for (int j = 0; j < 4; ++j) lo[j] = bf2f(sAt[(4 * q + j) * RKP_PITCH + 16 * jt + m]);
            ap[jt] = mfma16(tinvf, pack_frag(lo, hi), (f32x4){0.f, 0.f, 0.f, 0.f});
            const float al[4] = {ap[jt][0], ap[jt][1], ap[jt][2], ap[jt][3]};
            f32x4 rr = mfma16(mrbf, pack_frag(al, hi), (f32x4){0.f, 0.f, 0.f, 0.f});
#pragma unroll
            for (int r = 0; r < 4; ++r) rr[r] += bf2f(sRt[(4 * q + r) * RKP_PITCH + 16 * jt + m]);
            rp[jt] = rr;
            float bl[4], kl[4];
#pragma unroll
            for (int j = 0; j < 4; ++j) { bl[j] = bf2f(sBh[(4 * q + j) * RKP_PITCH + 16 * jt + m]); kl[j] = bf2f(sKh[(4 * q + j) * RKP_PITCH + 16 * jt + m]); }
            *(bf16x8*)((bf16_t*)(p.ws + CH_BK) + (((size_t)it * 4 + jt) * 64 + lane) * 8) = pack_frag(bl, kl); }
#pragma unroll
        for (int jt = 0; jt < 4; ++jt)
#pragma unroll
            for (int r = 0; r < 4; ++r) { sAt[(4 * q + r) * RKP_PITCH + 16 * jt + m] = f2bf(ap[jt][r]); sRt[(4 * q + r) * RKP_PITCH + 16 * jt + m] = f2bf(rp[jt][r]); }
#pragma unroll
        for (int x = 0; x < 2; ++x)
#pragma unroll
            for (int ks = 0; ks < 2; ++ks) { const LAS bf16_t* src = (x ? sRt : sAt) + m * RKP_PITCH + 32 * ks + 4 * q;
                const u32x2 a0 = *(const LAS u32x2*)src, a1 = *(const LAS u32x2*)(src + 16); const u32x4 w = {a0.x, a0.y, a1.x, a1.y};
                *(u32x4*)((bf16_t*)(p.ws + CH_XP) + ((((size_t)it * 2 + x) * 2 + ks) * 64 + lane) * 8) = w; }
    }
}
__device__ __forceinline__ void rwkv_seq_task(const Params& p, int l, int task, LAS unsigned char* lds) {
    const int lane = threadIdx.x & 63, m = lane & 15, q = lane >> 4;
    const int u = task >> 2, iw = task & 3, b = u / 12, h = (u % 12) >> 1, d = u & 1, sgn = d ? -1 : 1;
    const bf16_t* XP = (const bf16_t*)(p.ws + CH_XP); const bf16_t* BK = (const bf16_t*)(p.ws + CH_BK); const bf16_t* UL = (const bf16_t*)(p.ws + CH_UL); const bf16_t* MM = (const bf16_t*)(p.ws + CH_MM);
    const bf16_t* GT = (const bf16_t*)(p.ws + CH_GT); const bf16_t* VS = (const bf16_t*)(p.ws + U_VS) + h * 64 + 16 * iw;
    float* Yw = (float*)(p.ws + U_YRK) + (size_t)d * NROW * 384 + h * 64 + 16 * iw;
    LAS float* ybuf = (LAS float*)(lds + (threadIdx.x >> 6) * 12288);
    const int rc0 = NLAT + b * 256 + (d ? 255 : 0) + sgn * 4 * q, rdel = (b * 2048 + (d ? 2047 : 0)) - (NLAT + b * 256 + (d ? 255 : 0)) - sgn * 256;
    f32x4 acc[4];
#pragma unroll
    for (int jt = 0; jt < 4; ++jt) acc[jt] = (f32x4){0.f, 0.f, 0.f, 0.f};
    const unsigned vo16 = (unsigned)lane * 16u, vo8 = (unsigned)lane * 8u, vo8q = (unsigned)q * 8u;
    struct OpSet { u32x4 apf0, apf1, rpf0, rpf1, bkf0, bkf1, bkf2, bkf3, mmf; u32x2 gl0, gl1, gl2, gl3, uw; unsigned vr0, vr1, vr2, vr3; };
#define GLDS16(dst, voff, sbase, imm) asm volatile("global_load_dwordx4 %0, %1, %2 offset:" #imm : "=&v"(dst) : "v"(voff), "s"(sbase) : "memory")
#define GLDS8(dst, voff, sbase, imm) asm volatile("global_load_dwordx2 %0, %1, %2 offset:" #imm : "=&v"(dst) : "v"(voff), "s"(sbase) : "memory")
#define GLDS2(dst, voff, sbase) asm volatile("global_load_ushort %0, %1, %2" : "=&v"(dst) : "v"(voff), "s"(sbase) : "memory")
#define RKS_LOAD(X, c_) do { const size_t it_ = (size_t)u * 144 + (c_); const int rb_ = rc0 + sgn * 16 * (c_) + (int)((c_) >= 16) * rdel; \
        const bf16_t* xpb = XP + it_ * 2048; const bf16_t* bkb = BK + it_ * 2048; const bf16_t* mmb = MM + it_ * 512; const bf16_t* gtb = GT + it_ * 64; const bf16_t* ulb = UL + (it_ * 4 + iw) * 256; \
        GLDS16(X.apf0, vo16, xpb, 0); GLDS16(X.apf1, vo16, xpb, 1024); GLDS16(X.rpf0, vo16, xpb, 2048); GLDS16(X.rpf1, vo16, xpb, 3072); \
        GLDS16(X.bkf0, vo16, bkb, 0); GLDS16(X.bkf1, vo16, bkb, 1024); GLDS16(X.bkf2, vo16, bkb, 2048); GLDS16(X.bkf3, vo16, bkb, 3072); \
        GLDS8(X.gl0, vo8q, gtb, 0); GLDS8(X.gl1, vo8q, gtb, 32); GLDS8(X.gl2, vo8q, gtb, 64); GLDS8(X.gl3, vo8q, gtb, 96); \
        GLDS16(X.mmf, vo16, mmb, 0); GLDS8(X.uw, vo8, ulb, 0); \
        { const unsigned v0_ = (unsigned)(rb_) * 768u + 2u * m, v1_ = (unsigned)(rb_ + sgn) * 768u + 2u * m, v2_ = (unsigned)(rb_ + 2 * sgn) * 768u + 2u * m, v3_ = (unsigned)(rb_ + 3 * sgn) * 768u + 2u * m; \
          GLDS2(X.vr0, v0_, VS); GLDS2(X.vr1, v1_, VS); GLDS2(X.vr2, v2_, VS); GLDS2(X.vr3, v3_, VS); } } while (0)
#define RKS_WAIT(X) asm volatile("s_waitcnt vmcnt(36)" : "+v"(X.apf0), "+v"(X.apf1), "+v"(X.rpf0), "+v"(X.rpf1), "+v"(X.bkf0), "+v"(X.bkf1), "+v"(X.bkf2), "+v"(X.bkf3), "+v"(X.mmf), \
        "+v"(X.gl0), "+v"(X.gl1), "+v"(X.gl2), "+v"(X.gl3), "+v"(X.uw), "+v"(X.vr0), "+v"(X.vr1), "+v"(X.vr2), "+v"(X.vr3) :: "memory")
#define BF8(x) __builtin_bit_cast(bf16x8, x)
#define RKS_COMPUTE(X, c_) do { RKS_WAIT(X); \
        const float ul[4] = {bflo(X.uw.x), bfhi(X.uw.x), bflo(X.uw.y), bfhi(X.uw.y)}; const float vl[4] = {bflo(X.vr0), bflo(X.vr1), bflo(X.vr2), bflo(X.vr3)}; \
        f32x4 zp = (f32x4){0.f, 0.f, 0.f, 0.f}, yp = zp; \
        { const float lo[4] = {acc[0][0], acc[0][1], acc[0][2], acc[0][3]}, hi[4] = {acc[1][0], acc[1][1], acc[1][2], acc[1][3]}; const bf16x8 sf = pack_frag(lo, hi); zp = mfma16(BF8(X.apf0), sf, zp); yp = mfma16(BF8(X.rpf0), sf, yp); } \
        { const float lo[4] = {acc[2][0], acc[2][1], acc[2][2], acc[2][3]}, hi[4] = {acc[3][0], acc[3][1], acc[3][2], acc[3][3]}; const bf16x8 sf = pack_frag(lo, hi); zp = mfma16(BF8(X.apf1), sf, zp); yp = mfma16(BF8(X.rpf1), sf, yp); } \
        const float z[4] = {zp[0] + ul[0], zp[1] + ul[1], zp[2] + ul[2], zp[3] + ul[3]}; \
        yp = mfma16(BF8(X.mmf), pack_frag(ul, vl), yp); \
        const bf16x8 zvf = pack_frag(z, vl); \
        acc[0] = mfma16(BF8(X.bkf0), zvf, acc[0]); acc[1] = mfma16(BF8(X.bkf1), zvf, acc[1]); acc[2] = mfma16(BF8(X.bkf2), zvf, acc[2]); acc[3] = mfma16(BF8(X.bkf3), zvf, acc[3]); \
        { const f32x4 g4 = {__expf(bflo(X.gl0.x)), __expf(bfhi(X.gl0.x)), __expf(bflo(X.gl0.y)), __expf(bfhi(X.gl0.y))}; acc[0] *= g4; } \
        { const f32x4 g4 = {__expf(bflo(X.gl1.x)), __expf(bfhi(X.gl1.x)), __expf(bflo(X.gl1.y)), __expf(bfhi(X.gl1.y))}; acc[1] *= g4; } \
        { const f32x4 g4 = {__expf(bflo(X.gl2.x)), __expf(bfhi(X.gl2.x)), __expf(bflo(X.gl2.y)), __expf(bfhi(X.gl2.y))}; acc[2] *= g4; } \
        { const f32x4 g4 = {__expf(bflo(X.gl3.x)), __expf(bfhi(X.gl3.x)), __expf(bflo(X.gl3.y)), __expf(bfhi(X.gl3.y))}; acc[3] *= g4; } \
        _Pragma("unroll") for (int r = 0; r < 4; ++r) ybuf[((((c_) % 12) * 16) + 4 * q + r) * 16 + m] = yp[r]; } while (0)
    asm volatile("; SEQ_BEGIN");
    OpSet A, B, C;
    RKS_LOAD(A, 0); RKS_LOAD(B, 1);
    for (int c0 = 0; c0 < 144; c0 += 12) {
#pragma unroll
        for (int cc = 0; cc < 12; cc += 3) { const int c = c0 + cc;
            RKS_LOAD(C, c + 2); __builtin_amdgcn_sched_barrier(0);
            RKS_COMPUTE(A, c); __builtin_amdgcn_sched_barrier(0);
            { const int cn = c + 3 < 144 ? c + 3 : 143; RKS_LOAD(A, cn); } __builtin_amdgcn_sched_barrier(0);
            RKS_COMPUTE(B, c + 1); __builtin_amdgcn_sched_barrier(0);
            { const int cn = c + 4 < 144 ? c + 4 : 143; RKS_LOAD(B, cn); } __builtin_amdgcn_sched_barrier(0);
            RKS_COMPUTE(C, c + 2); __builtin_amdgcn_sched_barrier(0); }
#pragma unroll
        for (int k = 0; k < 12; ++k) { const int rr = (lane >> 2) + 16 * k, n = c0 * 16 + rr; const int grow = (rc0 - sgn * 4 * q) + sgn * n + (int)(n >= 256) * rdel;
            *(f32x4*)(Yw + (size_t)grow * 384 + (lane & 3) * 4) = *(const LAS f32x4*)(ybuf + rr * 16 + (lane & 3) * 4); }
    }
    asm volatile("; SEQ_END");
#undef RKS_LOAD
#undef RKS_COMPUTE
#undef RKS_WAIT
#undef GLDS16
#undef GLDS8
#undef GLDS2
#undef BF8
}

__device__ __forceinline__ void rwkv_finish(const Params& p, int l) {
    const int sub = threadIdx.x & 7; const int npair = (l == 0 ? NROW : NLAT) * 6;
    const bf16_t* RS = (const bf16_t*)(p.ws + U_RS); const bf16_t* KS = (const bf16_t*)(p.ws + U_KS); const bf16_t* VS = (const bf16_t*)(p.ws + U_VS);
    const bf16_t* AG0 = (const bf16_t*)(p.ws + U_AG); const bf16_t* AG1 = (const bf16_t*)(p.ws + U_AG + SZ384); const bf16_t* G = (const bf16_t*)(p.ws + U_G);
    const float* Y0 = (const float*)(p.ws + U_YRK); const float* Y1 = Y0 + (size_t)NROW * 384; bf16_t* YC = (bf16_t*)(p.ws + WS_ABUF);
    for (int pr = (blockIdx.x * NTHR + threadIdx.x) >> 3; pr < npair; pr += (gridDim.x * NTHR) >> 3) { const int row = pr / 6, h = pr % 6, col = h * 64 + sub * 8; const size_t o = (size_t)row * 384 + col;
        float y[8]; { const float4 a0 = *(const float4*)(Y0 + o), a1 = *(const float4*)(Y0 + o + 4), c0 = *(const float4*)(Y1 + o), c1 = *(const float4*)(Y1 + o + 4);
            y[0] = a0.x + c0.x; y[1] = a0.y + c0.y; y[2] = a0.z + c0.z; y[3] = a0.w + c0.w; y[4] = a1.x + c1.x; y[5] = a1.y + c1.y; y[6] = a1.z + c1.z; y[7] = a1.w + c1.w; }
        float s = 0.f;
#pragma unroll
        for (int k = 0; k < 8; ++k) s += y[k];
        s += __shfl_xor(s, 1); s += __shfl_xor(s, 2); s += __shfl_xor(s, 4); const float mean = s * (1.0f / 64.0f);
        float v2 = 0.f;
#pragma unroll
        for (int k = 0; k < 8; ++k) { const float dd = y[k] - mean; v2 += dd * dd; }
        v2 += __shfl_xor(v2, 1); v2 += __shfl_xor(v2, 2); v2 += __shfl_xor(v2, 4); const float rstd = rsqrtf(v2 * (1.0f / 64.0f) + 64e-5f);
        float r[8], kx[8], vx[8], a0[8], a1[8], gx[8];
        unpack8(*(const uint4*)(RS + o), r); unpack8(*(const uint4*)(KS + o), kx); unpack8(*(const uint4*)(VS + o), vx); unpack8(*(const uint4*)(AG0 + o), a0); unpack8(*(const uint4*)(AG1 + o), a1); unpack8(*(const uint4*)(G + o), gx);
        const float* ka = p.in[27] + l * 384 + col; const float* rk = p.in[28] + l * 384 + col; const float* lw = p.in[29] + l * 384 + col; const float* lb = p.in[30] + l * 384 + col;
        float bs = 0.f;
#pragma unroll
        for (int k = 0; k < 8; ++k) { const float kd0 = kx[k] * (1.0f + (a0[k] - 1.0f) * ka[k]), kd1 = kx[k] * (1.0f + (a1[k] - 1.0f) * ka[k]); bs += r[k] * (kd0 + kd1) * rk[k]; }
        bs += __shfl_xor(bs, 1); bs += __shfl_xor(bs, 2); bs += __shfl_xor(bs, 4);
        float ov[8];
#pragma unroll
        for (int k = 0; k < 8; ++k) ov[k] = ((y[k] - mean) * rstd * lw[k] + lb[k] + bs * vx[k]) * gx[k];
        *(uint4*)(YC + (size_t)row * 1024 + 640 + col) = pack8(ov);
    }
}

__device__ __forceinline__ void phase_normrouter(const Params& p, int l, const float* xl, const float* xc, LAS unsigned char* lds) {
    LAS float* hrow = (LAS float*)lds;
    LAS float* part = (LAS float*)(lds + 32768);
    const int lane = threadIdx.x & 63, wv = threadIdx.x >> 6, e = lane & 15, cq = lane >> 4; const int ngrp = (l == 0 ? NROW : NLAT) / 8;
    const float* mod = (const float*)(p.ws + WS_MOD) + (size_t)l * 17 * 6144; const float* g1 = p.in[6] + (l * 4 + 1) * 1024; const float* g2 = p.in[6] + (l * 4 + 2) * 1024;
    const bf16_t* Y = (const bf16_t*)(p.ws + U_Y); unsigned char* A8 = p.ws + WS_ABUF; float* AFF = (float*)(p.ws + WS_AFF);
    float wr[32];
#pragma unroll
    for (int j = 0; j < 32; ++j) wr[j] = p.in[31][((size_t)l * 1024 + 128 * wv + 32 * cq + j) * 16 + e];
    for (int gi = blockIdx.x; gi < ngrp; gi += gridDim.x) { const int r = gi * 8 + wv; const int b = r < NLAT ? (r >> 11) : 16; const float* mb = mod + (size_t)b * 6144;
        const float* xs = xrow(xl, xc, r); float* xd = xrow_w(p.out, (float*)(p.ws + WS_CTXA), r);
        float4 y[4], x[4]; float ss = 0.f;
#pragma unroll
        for (int i = 0; i < 4; ++i) { { const u32x2 yw = *(const u32x2*)(Y + (size_t)r * 1024 + i * 256 + lane * 4); y[i] = make_float4(bflo(yw.x), bfhi(yw.x), bflo(yw.y), bfhi(yw.y)); } x[i] = *(const float4*)(xs + i * 256 + lane * 4); ss += y[i].x * y[i].x + y[i].y * y[i].y + y[i].z * y[i].z + y[i].w * y[i].w; }
        ss = wave_sum(ss); const float rs = rsqrtf(ss * (1.0f / 1024.0f) + 1e-6f);
        float s2 = 0.f;
#pragma unroll
        for (int i = 0; i < 4; ++i) { const int c = i * 256 + lane * 4; const float4 gg = *(const float4*)(g1 + c), gt = *(const float4*)(mb + 2048 + c);
            x[i].x += gt.x * (y[i].x * rs * gg.x); x[i].y += gt.y * (y[i].y * rs * gg.y); x[i].z += gt.z * (y[i].z * rs * gg.z); x[i].w += gt.w * (y[i].w * rs * gg.w);
            *(float4*)(xd + c) = x[i]; s2 += x[i].x * x[i].x + x[i].y * x[i].y + x[i].z * x[i].z + x[i].w * x[i].w; }
        s2 = wave_sum(s2); const float rs2 = rsqrtf(s2 * (1.0f / 1024.0f) + 1e-6f);
        float hv[4][4]; float amax = 0.f;
        __syncthreads();
#pragma unroll
        for (int i = 0; i < 4; ++i) { const int c = i * 256 + lane * 4; const float4 gg = *(const float4*)(g2 + c), sh = *(const float4*)(mb + 3072 + c), sc = *(const float4*)(mb + 4096 + c);
            hv[i][0] = x[i].x * rs2 * gg.x * (1.f + sc.x) + sh.x; hv[i][1] = x[i].y * rs2 * gg.y * (1.f + sc.y) + sh.y; hv[i][2] = x[i].z * rs2 * gg.z * (1.f + sc.z) + sh.z; hv[i][3] = x[i].w * rs2 * gg.w * (1.f + sc.w) + sh.w;
            *(LAS lf4*)(hrow + wv * 1024 + c) = (lf4){hv[i][0], hv[i][1], hv[i][2], hv[i][3]};
            amax = fmaxf(amax, fmaxf(fmaxf(fabsf(hv[i][0]), fabsf(hv[i][1])), fmaxf(fabsf(hv[i][2]), fabsf(hv[i][3])))); }
#pragma unroll
        for (int o = 32; o >= 1; o >>= 1) amax = fmaxf(amax, __shfl_xor(amax, o));
        amax = fmaxf(amax, 1e-20f); const float qs = 127.0f / amax;
        if (lane == 0) ((float*)(p.ws + WS_SX))[r] = amax * (1.0f / 127.0f);
#pragma unroll
        for (int i = 0; i < 4; ++i) { unsigned w = 0u;
#pragma unroll
            for (int k = 0; k < 4; ++k) w |= ((unsigned)__float2int_rn(hv[i][k] * qs) & 255u) << (8 * k);
            *(unsigned*)(A8 + (size_t)r * 1024 + i * 256 + lane * 4) = w; }
        __syncthreads();
#pragma unroll 2
        for (int rr = 0; rr < 8; ++rr) { const LAS float* hp = hrow + rr * 1024 + 128 * wv + 32 * cq; float acc = 0.f;
#pragma unroll
            for (int j4 = 0; j4 < 8; ++j4) { const lf4 h4 = *(const LAS lf4*)(hp + 4 * j4); acc += h4.x * wr[4 * j4] + h4.y * wr[4 * j4 + 1] + h4.z * wr[4 * j4 + 2] + h4.w * wr[4 * j4 + 3]; }
            acc += __shfl_xor(acc, 16); acc += __shfl_xor(acc, 32);
            if (cq == 0) part[(rr * 8 + wv) * 16 + e] = acc; }
        __syncthreads();
        if (lane < 16) { float lgt = 0.f;
#pragma unroll
            for (int w = 0; w < 8; ++w) lgt += part[(wv * 8 + w) * 16 + lane];
            float mxl = lgt;
#pragma unroll
            for (int o = 8; o >= 1; o >>= 1) mxl = fmaxf(mxl, __shfl_xor(mxl, o));
            const float ex = expf(lgt - mxl); float den = ex;
#pragma unroll
            for (int o = 8; o >= 1; o >>= 1) den += __shfl_xor(den, o);
            AFF[(size_t)r * 16 + lane] = ex / den; }
    }
}

__device__ __forceinline__ void phase_topk(const Params& p, int l, LAS unsigned char* lds) {
    LAS unsigned* keys = (LAS unsigned*)lds;
    LAS int* toks = (LAS int*)(lds + 8192);
    LAS unsigned* hist = (LAS unsigned*)(lds + 9216);
    LAS unsigned* wtot = (LAS unsigned*)(lds + 10240);
    LAS unsigned* sel = (LAS unsigned*)(lds + 10304);
    const int tid = threadIdx.x, lane = tid & 63, wv = tid >> 6, nitem = l == 0 ? 512 : 256;
    const float* AFF = (const float*)(p.ws + WS_AFF); int* SLOT = (int*)(p.ws + WS_SLOT); float* SELG = (float*)(p.ws + WS_SELG);
    const bf16_t* A = (const bf16_t*)(p.ws + WS_ABUF); bf16_t* XS = (bf16_t*)(p.ws + U_XSEL);
    for (int it = blockIdx.x; it < nitem; it += gridDim.x) { const bool lat = it < 256; const int be = it & 255, b = be >> 4, e = be & 15;
        const int n = lat ? SEQ : CTXL, cap = lat ? 256 : 32, rowbase = lat ? b * 2048 : NLAT + b * 256, xoff = lat ? b * 256 : 4096 + b * 32;
        const int per = n / NTHR > 0 ? n / NTHR : 1;
        const int t0 = tid * per; const bool act = t0 < n;
        unsigned kx[4];
        __syncthreads();
#pragma unroll
        for (int j = 0; j < 4; ++j) { kx[j] = 0u; if (act && j < per) { kx[j] = __float_as_uint(AFF[(size_t)(rowbase + t0 + j) * 16 + e]); keys[t0 + j] = kx[j]; } }
        unsigned prefix = 0u; int krem = cap;
        for (int pass = 0; pass < 4; ++pass) { const int shift = 24 - 8 * pass;
            if (tid < 256) hist[tid] = 0u;
            __syncthreads();
#pragma unroll
            for (int j = 0; j < 4; ++j) if (act && j < per) { const bool match = pass == 0 || (kx[j] >> (shift + 8)) == (prefix >> (shift + 8)); if (match) atomicAdd((unsigned*)&hist[(kx[j] >> shift) & 255u], 1u); }
            __syncthreads();
            if (tid < 256) { unsigned above = 0u; for (int bb = tid + 1; bb < 256; ++bb) above += hist[bb]; const unsigned mine = hist[tid];
                if (above < (unsigned)krem && above + mine >= (unsigned)krem) { sel[0] = (unsigned)tid; sel[1] = (unsigned)krem - above; } }
            __syncthreads();
            prefix |= sel[0] << shift; krem = (int)sel[1];
            __syncthreads();
        }
        unsigned loc = 0u, pre[4];
#pragma unroll
        for (int j = 0; j < 4; ++j) { pre[j] = loc; if (act && j < per) loc += (kx[j] > prefix ? 1u : 0u) + (kx[j] == prefix ? 65536u : 0u); }
        unsigned inc = loc;
#pragma unroll
        for (int o = 1; o < 64; o <<= 1) { const unsigned t = __shfl_up(inc, o); if (lane >= o) inc += t; }
        if (lane == 63) wtot[wv] = inc;
        __syncthreads();
        unsigned base = inc - loc;
        for (int w = 0; w < wv; ++w) base += wtot[w];
#pragma unroll
        for (int j = 0; j < 4; ++j) if (act && j < per) { const unsigned c = base + pre[j]; const int gtb = (int)(c & 0xffffu), eqb = (int)(c >> 16);
            const bool s = kx[j] > prefix || (kx[j] == prefix && eqb < krem); const int slot = gtb + (eqb < krem ? eqb : krem);
            if (s) { SELG[e * XROWS + xoff + slot] = __uint_as_float(kx[j]); toks[slot] = t0 + j; }
            SLOT[(size_t)(rowbase + t0 + j) * 16 + e] = s ? slot : -1; }
        __syncthreads();
        for (int s = wv; s < cap; s += 8) { const int row = rowbase + toks[s]; const lu4* src = (const lu4*)((const unsigned char*)A + (size_t)row * 1024); lu4* dst = (lu4*)((unsigned char*)XS + ((size_t)e * XROWS + xoff + s) * 1024);
            dst[lane] = src[lane]; if (lane == 0) ((float*)(p.ws + WS_SXS))[e * XROWS + xoff + s] = ((const float*)(p.ws + WS_SX))[row]; }
    }
}

struct GroupedOrder { int nMl, nNl, G, c, total;
    __device__ void init(int nMl_, int nNl_, int, int G_, int c_) { nMl = nMl_; nNl = nNl_; G = G_; c = c_; total = 16 * nMl_ * nNl_; }
    __device__ bool next(int i, pg8::Unit& u) const {
        int L;
        if ((G & 7) == 0 && (total & 7) == 0) { const int W = G >> 3, x = c & 7, r = c >> 3, t8 = total >> 3, k = i * W + r; if (k >= t8) return false; L = x * t8 + k; }
        else { const long LL = (long)i * G + c; if (LL >= total) return false; L = (int)LL; }
        const int per = nMl * nNl, e = L / per; int idx = L % per;
        const int mg = idx / (8 * nNl) < nMl / 8 ? idx / (8 * nNl) : nMl / 8, gm = (mg + 1) * 8 <= nMl ? 8 : nMl - mg * 8; idx -= mg * 8 * nNl;
        const int ng = idx / (gm * 4) < nNl / 4 ? idx / (gm * 4) : nNl / 4, gn = (ng + 1) * 4 <= nNl ? 4 : nNl - ng * 4; idx -= ng * gm * 4;
        u.pm = e * 18 + mg * 8 + idx / gn; u.pn = e * nNl + ng * 4 + idx % gn; return true; }
    __device__ __forceinline__ void a_ready(const pg8::Unit&) const {}
    __device__ __forceinline__ void done(const pg8::Unit&) const {}
};
struct EpiSwiGLU { static constexpr bool PERM = true, AFTER_DRAIN = false; unsigned char* H; const float* sx; const float* sw;
    __device__ __forceinline__ void operator()(const f32x4 (&acc)[2][2][4][2], const pg8::Unit& u, int wr, int wc, int fr, int fq) const {
        typedef int i32x4_ __attribute__((ext_vector_type(4)));
        const int e = u.pn / 22, pnl = u.pn - e * 22; const int row0 = u.pm * 256 + wr * 64 + fr, col0 = pnl * 128 + wc * 32 + 8 * fq;
        const float* swp = sw + (size_t)u.pn * 256 + wc * 32 + 8 * fq; const float4 g0 = *(const float4*)swp, g1 = *(const float4*)(swp + 4), u0 = *(const float4*)(swp + 128), u1 = *(const float4*)(swp + 132);
        const float swg[8] = {g0.x, g0.y, g0.z, g0.w, g1.x, g1.y, g1.z, g1.w}, swu[8] = {u0.x, u0.y, u0.z, u0.w, u1.x, u1.y, u1.z, u1.w};
#pragma unroll
        for (int ai = 0; ai < 2; ++ai)
#pragma unroll
            for (int m = 0; m < 4; ++m) { const int r = row0 + ai * 128 + m * 16; const float sr = sx[r]; unsigned char* rowp = H + (size_t)r * DE + col0; float o[8];
#pragma unroll
                for (int n = 0; n < 2; ++n) { const i32x4_ ig = __builtin_bit_cast(i32x4_, acc[ai][0][m][n]), iu = __builtin_bit_cast(i32x4_, acc[ai][1][m][n]);
#pragma unroll
                    for (int j = 0; j < 4; ++j) { const float g = (float)ig[j] * (sr * swg[n * 4 + j]), uu = (float)iu[j] * (sr * swu[n * 4 + j]); o[n * 4 + j] = g * sigm(g) * uu; } }
                u32x2 w8; { int t0 = 0, t1 = 0; t0 = __builtin_amdgcn_cvt_pk_fp8_f32(o[0], o[1], t0, false); t0 = __builtin_amdgcn_cvt_pk_fp8_f32(o[2], o[3], t0, true); t1 = __builtin_amdgcn_cvt_pk_fp8_f32(o[4], o[5], t1, false); t1 = __builtin_amdgcn_cvt_pk_fp8_f32(o[6], o[7], t1, true); w8.x = (unsigned)t0; w8.y = (unsigned)t1; }
                *(u32x2*)rowp = w8; }
    }
};
struct EpiScaleBf16 { static constexpr bool PERM = true, AFTER_DRAIN = false; bf16_t* O; int ldc; const float* sx; const float* sw;
    __device__ __forceinline__ void operator()(const f32x4 (&acc)[2][2][4][2], const pg8::Unit& u, int wr, int wc, int fr, int fq) const {
        typedef int i32x4_ __attribute__((ext_vector_type(4)));
        const int row0 = u.pm * 256 + wr * 64 + fr, col0 = u.pn * 256 + wc * 32 + 8 * fq;
        float swv[2][8];
#pragma unroll
        for (int bj = 0; bj < 2; ++bj) { const float4 a = *(const float4*)(sw + col0 + bj * 128), b = *(const float4*)(sw + col0 + bj * 128 + 4); swv[bj][0] = a.x; swv[bj][1] = a.y; swv[bj][2] = a.z; swv[bj][3] = a.w; swv[bj][4] = b.x; swv[bj][5] = b.y; swv[bj][6] = b.z; swv[bj][7] = b.w; }
#pragma unroll
        for (int ai = 0; ai < 2; ++ai)
#pragma unroll
            for (int m = 0; m < 4; ++m) { const int r = row0 + ai * 128 + m * 16; const float sr = sx[r]; bf16_t* rowp = O + (size_t)r * ldc + col0;
#pragma unroll
                for (int bj = 0; bj < 2; ++bj) { float o[8];
#pragma unroll
                    for (int n = 0; n < 2; ++n) { const i32x4_ iv = __builtin_bit_cast(i32x4_, acc[ai][bj][m][n]);
#pragma unroll
                        for (int j = 0; j < 4; ++j) o[n * 4 + j] = (float)iv[j] * (sr * swv[bj][n * 4 + j]); }
                    *(uint4*)(rowp + bj * 128) = pack8(o); } }
    }
};
struct EpiGate { static constexpr bool PERM = true, AFTER_DRAIN = false; bf16_t* O; const float* gate; const float* sw;
    __device__ __forceinline__ void operator()(const f32x4 (&acc)[2][2][4][2], const pg8::Unit& u, int wr, int wc, int fr, int fq) const {
        pg8::fp8_acc_settle();
        const int pnl = u.pn & 3; const int row0 = u.pm * 256 + wr * 64 + fr, col0 = pnl * 256 + wc * 32 + 8 * fq;
#pragma unroll
        for (int bj = 0; bj < 2; ++bj) { const float* sp = sw + (size_t)u.pn * 256 + wc * 32 + 8 * fq + bj * 128; const float4 sa = *(const float4*)sp, sb = *(const float4*)(sp + 4);
#pragma unroll
            for (int ai = 0; ai < 2; ++ai)
#pragma unroll
                for (int m = 0; m < 4; ++m) { const int r = row0 + ai * 128 + m * 16; const float gt = gate[r]; const f32x4 v0 = acc[ai][bj][m][0], v1 = acc[ai][bj][m][1];
                    u32x4 w; w.x = pack2(v0[0] * (gt * sa.x), v0[1] * (gt * sa.y)); w.y = pack2(v0[2] * (gt * sa.z), v0[3] * (gt * sa.w)); w.z = pack2(v1[0] * (gt * sb.x), v1[1] * (gt * sb.y)); w.w = pack2(v1[2] * (gt * sb.z), v1[3] * (gt * sb.w));
                    *(u32x4*)(O + (size_t)r * 1024 + col0 + bj * 128) = w; } }
    }
};

__device__ __forceinline__ void phase_combine(const Params& p, int l) {
    const int lane = threadIdx.x & 63, wv = threadIdx.x >> 6; const int nrow = l == 0 ? NROW : NLAT;
    const float* mod = (const float*)(p.ws + WS_MOD) + (size_t)l * 17 * 6144; const float* g3 = p.in[6] + (l * 4 + 3) * 1024;
    const int* SLOT = (const int*)(p.ws + WS_SLOT); const bf16_t* YE = (const bf16_t*)(p.ws + U_YEXP); bf16_t* A = (bf16_t*)(p.ws + WS_ABUF);
    for (int r = blockIdx.x * 8 + wv; r < nrow; r += gridDim.x * 8) { const bool lat = r < NLAT; const int b = lat ? (r >> 11) : ((r - NLAT) >> 8), mbi = lat ? b : 16, xoff = lat ? b * 256 : 4096 + b * 32;
        const float* mb = mod + (size_t)mbi * 6144;
        float f[16];
#pragma unroll
        for (int k = 0; k < 16; ++k) f[k] = 0.f;
        const int myslot = lane < 16 ? SLOT[(size_t)r * 16 + lane] : -1;
        for (int e = 0; e < 16; ++e) { const int s = __shfl(myslot, e); if (s >= 0) { const bf16_t* yr = YE + ((size_t)e * XROWS + xoff + s) * 1024 + lane * 4;
#pragma unroll
                for (int i = 0; i < 4; ++i) { const u32x2 w = *(const u32x2*)(yr + i * 256); f[i * 4] += bflo(w.x); f[i * 4 + 1] += bfhi(w.x); f[i * 4 + 2] += bflo(w.y); f[i * 4 + 3] += bfhi(w.y); } } }
        float ss = 0.f;
#pragma unroll
        for (int k = 0; k < 16; ++k) ss += f[k] * f[k];
        ss = wave_sum(ss); const float rs = rsqrtf(ss * (1.0f / 1024.0f) + 1e-6f);
        const float* x1 = xrow(p.out, (const float*)(p.ws + WS_CTXA), r);
        float* x2 = l == 0 ? xrow_w((float*)(p.ws + WS_XB), (float*)(p.ws + WS_CTXB), r) : p.out + (size_t)r * D;
        float4 xv[4];
#pragma unroll
        for (int i = 0; i < 4; ++i) { const int c = i * 256 + lane * 4; const float4 gg = *(const float4*)(g3 + c), gt = *(const float4*)(mb + 5120 + c); float4 x = *(const float4*)(x1 + c);
            x.x += gt.x * (f[i * 4] * rs * gg.x); x.y += gt.y * (f[i * 4 + 1] * rs * gg.y); x.z += gt.z * (f[i * 4 + 2] * rs * gg.z); x.w += gt.w * (f[i * 4 + 3] * rs * gg.w);
            *(float4*)(x2 + c) = x; xv[i] = x; }
        if (l == 0) { const float* mb1 = mod + (size_t)17 * 6144 + (size_t)mbi * 6144; hnorm_row(p.in[6] + 4 * 1024, mb1, mb1 + 1024, p.ws + WS_ABUF + (size_t)r * 1024, (float*)(p.ws + WS_SH) + r, lane, xv); }
    }
}


#ifndef MK_ONLY
#define MK_ONLY -1
#endif
#define EN(k) (MK_ONLY < 0 || MK_ONLY == (k))
#ifndef MK_DUP
#define MK_DUP 0
#endif
#define NREP(k) ((((MK_DUP) >> (k)) & 1) ? 2 : 1)
constexpr int PH_PER_LAYER = 14, N_PHASES = 1 + 2 * PH_PER_LAYER;
#define IN(k) (lo <= (k) && (k) < hi)
#define SEAM(k) do { if (p.use_bar && IN(k) && IN((k) + 1)) xcd_barrier(bar); } while (0)
template <int l> __device__ __forceinline__ void layer_phases(const Params& p, LAS unsigned char* lds, const XcdBarrier& bar, const int lo, const int hi) {
    const int wv = __builtin_amdgcn_readfirstlane(threadIdx.x >> 6), G = gridDim.x; const int wid = blockIdx.x * 8 + wv, nw = G * 8;
        const int pb = 1 + l * PH_PER_LAYER;
        const float* xl = l == 0 ? p.in[0] : (const float*)(p.ws + WS_XB);
        const float* xc = l == 0 ? p.in[2] : (const float*)(p.ws + WS_CTXB);
        if (EN(0) && IN(pb + 0)) { { if (l == 0) phase_hnorm(p, 0, xl, xc); }
            if ((NREP(0)) == 2) { if (l == 0) phase_hnorm(p, 0, xl, xc); } }
        SEAM(pb + 0);
        if (EN(1) && IN(pb + 1)) { { pg8::Gemm g{(const bf16_t*)(p.ws + WS_ABUF), (const bf16_t*)(p.ws + WS_WIN), NROW, NINP, D / 2}; pg8::StaticOrder S; S.init(NROW, NINP, G, (int)blockIdx.x);
            EpiScaleBf16 E{(bf16_t*)(p.ws + U_P), NINP, (const float*)(p.ws + WS_SH), (const float*)(p.ws + WS_SWIN)}; pg8::gemm_phase<EpiScaleBf16, pg8::StaticOrder, false, 1>(lds, g, S, E, nullptr); }
            if ((NREP(1)) == 2) { pg8::Gemm g{(const bf16_t*)(p.ws + WS_ABUF), (const bf16_t*)(p.ws + WS_WIN), NROW, NINP, D / 2}; pg8::StaticOrder S; S.init(NROW, NINP, G, (int)blockIdx.x);
            EpiScaleBf16 E{(bf16_t*)(p.ws + U_P), NINP, (const float*)(p.ws + WS_SH), (const float*)(p.ws + WS_SWIN)}; pg8::gemm_phase<EpiScaleBf16, pg8::StaticOrder, false, 1>(lds, g, S, E, nullptr); } }
        SEAM(pb + 1);
        if (EN(2) && IN(pb + 2)) { phase_prep(p, l, lds);
            if ((NREP(2)) == 2) phase_prep(p, l, lds); }
        SEAM(pb + 2);
        if (EN(3) && IN(pb + 3)) { { lowrank_items(p, l, wid, nw); s5_pass1_items(p, l, wid, nw); }
            if ((NREP(3)) == 2) { lowrank_items(p, l, wid, nw); s5_pass1_items(p, l, wid, nw); } }
        SEAM(pb + 3);
        if (EN(4) && IN(pb + 4)) { { s5_carry(p, l); na_items(p, l, wid, nw, lds); }
            if ((NREP(4)) == 2) { s5_carry(p, l); na_items(p, l, wid, nw, lds); } }
        SEAM(pb + 4);
        if (EN(5) && IN(pb + 5)) { { s5_pass2_items(p, l, wid, nw); rwkv_pre_items(p, l, wid, nw, lds); }
            if ((NREP(5)) == 2) { s5_pass2_items(p, l, wid, nw); rwkv_pre_items(p, l, wid, nw, lds); } }
        SEAM(pb + 5);
        if (EN(6) && IN(pb + 6)) {
            if (G > 192) { const int bx = (int)blockIdx.x;
                if (bx < 192) { if (wv < 4) rwkv_seq_task(p, l, bx * 4 + wv, lds); } else s5_glu_items(p, l, (bx - 192) * 8 + wv, (G - 192) * 8);
                if ((NREP(6)) == 2) { if (bx < 192) { if (wv < 4) rwkv_seq_task(p, l, bx * 4 + wv, lds); } else s5_glu_items(p, l, (bx - 192) * 8 + wv, (G - 192) * 8); } }
            else { for (int task = wid; task < 768; task += nw) rwkv_seq_task(p, l, task, lds); s5_glu_items(p, l, wid, nw); } }
        SEAM(pb + 6);
        if (EN(7) && IN(pb + 7)) { rwkv_finish(p, l);
            if ((NREP(7)) == 2) rwkv_finish(p, l); }
        SEAM(pb + 7);
        if (EN(8) && IN(pb + 8)) { { const int M = l == 0 ? NROW : NLAT; pg8::Gemm g{(const bf16_t*)(p.ws + WS_ABUF), (const bf16_t*)(p.ws + WS_WOUT), M, D, D}; pg8::StaticOrder S; S.init(M, D, G, (int)blockIdx.x);
            pg8::EpiBf16<0> E{(bf16_t*)(p.ws + U_Y), D, nullptr, 0, 0}; pg8::gemm_phase<pg8::EpiBf16<0>, pg8::StaticOrder, false>(lds, g, S, E, nullptr); }
            if ((NREP(8)) == 2) { const int M = l == 0 ? NROW : NLAT; pg8::Gemm g{(const bf16_t*)(p.ws + WS_ABUF), (const bf16_t*)(p.ws + WS_WOUT), M, D, D}; pg8::StaticOrder S; S.init(M, D, G, (int)blockIdx.x);
            pg8::EpiBf16<0> E{(bf16_t*)(p.ws + U_Y), D, nullptr, 0, 0}; pg8::gemm_phase<pg8::EpiBf16<0>, pg8::StaticOrder, false>(lds, g, S, E, nullptr); } }
        SEAM(pb + 8);
        if (EN(9) && IN(pb + 9)) { phase_normrouter(p, l, xl, xc, lds);
            if ((NREP(9)) == 2) phase_normrouter(p, l, xl, xc, lds); }
        SEAM(pb + 9);
        if (EN(10) && IN(pb + 10)) { phase_topk(p, l, lds);
            if ((NREP(10)) == 2) phase_topk(p, l, lds); }
        SEAM(pb + 10);
        if (EN(11) && IN(pb + 11)) { { pg8::Gemm g{(const bf16_t*)(p.ws + U_XSEL), (const bf16_t*)(p.ws + WS_WGU), 16 * XROWS, 16 * 5632, D / 2}; GroupedOrder S; S.init(l == 0 ? 18 : 16, 22, 2, G, (int)blockIdx.x);
            EpiSwiGLU E{p.ws + U_HID, (const float*)(p.ws + WS_SXS), (const float*)(p.ws + WS_SW8)}; pg8::gemm_phase<EpiSwiGLU, GroupedOrder, false, 1>(lds, g, S, E, nullptr); }
            if ((NREP(11)) == 2) { pg8::Gemm g{(const bf16_t*)(p.ws + U_XSEL), (const bf16_t*)(p.ws + WS_WGU), 16 * XROWS, 16 * 5632, D / 2}; GroupedOrder S; S.init(l == 0 ? 18 : 16, 22, 2, G, (int)blockIdx.x);
            EpiSwiGLU E{p.ws + U_HID, (const float*)(p.ws + WS_SXS), (const float*)(p.ws + WS_SW8)}; pg8::gemm_phase<EpiSwiGLU, GroupedOrder, false, 1>(lds, g, S, E, nullptr); } }
        SEAM(pb + 11);
        if (EN(12) && IN(pb + 12)) { { pg8::Gemm g{(const bf16_t*)(p.ws + U_HID), (const bf16_t*)(p.ws + WS_WD), 16 * XROWS, 16 * 1024, DE / 2}; GroupedOrder S; S.init(l == 0 ? 18 : 16, 4, 4, G, (int)blockIdx.x);
            EpiGate E{(bf16_t*)(p.ws + U_YEXP), (const float*)(p.ws + WS_SELG), (const float*)(p.ws + WS_SWD)}; pg8::gemm_phase<EpiGate, GroupedOrder, false, 2>(lds, g, S, E, nullptr); }
            if ((NREP(12)) == 2) { pg8::Gemm g{(const bf16_t*)(p.ws + U_HID), (const bf16_t*)(p.ws + WS_WD), 16 * XROWS, 16 * 1024, DE / 2}; GroupedOrder S; S.init(l == 0 ? 18 : 16, 4, 4, G, (int)blockIdx.x);
            EpiGate E{(bf16_t*)(p.ws + U_YEXP), (const float*)(p.ws + WS_SELG), (const float*)(p.ws + WS_SWD)}; pg8::gemm_phase<EpiGate, GroupedOrder, false, 2>(lds, g, S, E, nullptr); } }
        SEAM(pb + 12);
        if (EN(13) && IN(pb + 13)) { { phase_combine(p, l); if (l == 0) convert_weights(p, 1, lds, (int)blockIdx.x, G); }
            if (((l == 0 ? NREP(13) : 1)) == 2) { phase_combine(p, l); if (l == 0) convert_weights(p, 1, lds, (int)blockIdx.x, G); } }
        SEAM(pb + 13);
}
__global__ void __launch_bounds__(NTHR, 2) fwd(Params p) {
    extern __shared__ __attribute__((aligned(16))) unsigned char lds_raw[];
    LAS unsigned char* lds = (LAS unsigned char*)lds_raw;
    const int tid = threadIdx.x;
    if (tid < 4) ((LAS unsigned*)(lds + LDS_MISC))[tid] = 0u;
    __syncthreads();
    XcdBarrier bar; bar.bar = (unsigned*)(p.ws + WS_CTL); bar.x = 0; bar.st = (volatile LAS unsigned*)(lds + LDS_MISC);
    if (p.use_bar) bar = xcd_barrier_post((unsigned*)(p.ws + WS_CTL), (volatile LAS unsigned*)(lds + LDS_MISC));
    if (p.use_bar && tid == 0) { unsigned* xr = (unsigned*)(p.ws + WS_CTL + 32768); ((LAS unsigned*)(lds + LDS_MISC))[2] = xb_xcc_id(); ((LAS unsigned*)(lds + LDS_MISC))[3] = atomicAdd(xr + 64 * xb_xcc_id(), 1u); }
    __syncthreads();
    const int lo = p.ph_lo, hi = p.ph_hi;

    if (EN(100) && IN(0)) { { phase_prologue(p, lds); }
        if ((NREP(14)) == 2) { phase_prologue(p, lds); } }
    SEAM(0);
    layer_phases<0>(p, lds, bar, lo, hi);
    layer_phases<1>(p, lds, bar, lo, hi);
#undef IN
#undef SEAM
}
}

#ifndef MK_ONE_LAUNCH
#define MK_ONE_LAUNCH 1
#endif
extern "C" void kernel_launch(void* const* d_in, const int* in_sizes, int n_in, void* d_out, int out_size, void* d_ws, size_t ws_size, hipStream_t stream) {
    static int grid = 0;
    if (grid == 0) {
        if (n_in != 35 || out_size != mk::NLAT * mk::D || ws_size < mk::WS_END) { fprintf(stderr, "kernel_launch: unexpected problem (n_in %d, out %d, ws %zu < %zu)\n", n_in, out_size, ws_size, (size_t)mk::WS_END); grid = -1; return; }
        int dev = 0, cus = 0, per_cu = 0;
        if (hipGetDevice(&dev) != hipSuccess || hipDeviceGetAttribute(&cus, hipDeviceAttributeMultiprocessorCount, dev) != hipSuccess) { grid = -1; return; }
        if (hipFuncSetAttribute((const void*)mk::fwd, hipFuncAttributeMaxDynamicSharedMemorySize, mk::LDS_BYTES) != hipSuccess) { fprintf(stderr, "kernel_launch: hipFuncSetAttribute failed\n"); grid = -1; return; }
        if (hipOccupancyMaxActiveBlocksPerMultiprocessor(&per_cu, (const void*)mk::fwd, mk::NTHR, mk::LDS_BYTES) != hipSuccess || per_cu < 1) { fprintf(stderr, "kernel_launch: occupancy query says %d\n", per_cu); per_cu = 1; }
        (void)hipGetLastError();
        grid = cus;
    }
    if (grid < 0) return;
    (void)in_sizes;
    if (hipMemsetAsync(d_ws, 0, 65536, stream) != hipSuccess) return;
    mk::Params a{};
    for (int i = 0; i < 35; ++i) a.in[i] = (const float*)d_in[i];
    a.out = (float*)d_out; a.ws = (unsigned char*)d_ws;
#if MK_ONE_LAUNCH
    a.ph_lo = 0; a.ph_hi = mk::N_PHASES; a.use_bar = 1;
    hipLaunchKernelGGL(mk::fwd, dim3(grid), dim3(mk::NTHR), mk::LDS_BYTES, stream, a);
#else
    for (int ph = 0; ph < mk::N_PHASES; ++ph) { a.ph_lo = ph; a.ph_hi = ph + 1; a.use_bar = 0; hipLaunchKernelGGL(mk::fwd, dim3(grid), dim3(mk::NTHR), mk::LDS_BYTES, stream, a); }
#endif
}
```

```cpp
#include <hip/hip_runtime.h>
#include <cstdio>
#include <cstdint>
namespace pg8 {
#define PG8_LAS __attribute__((address_space(3)))
typedef unsigned short bf16_t;
typedef short bf16x8 __attribute__((ext_vector_type(8)));
typedef float f32x4 __attribute__((ext_vector_type(4)));
typedef unsigned u32x4 __attribute__((ext_vector_type(4)));
constexpr int BM = 256, BK = 64, HALF = 128, HTB = HALF * BK * 2  , STAGE_BYTES = 8 * HTB, NXCD = 8, WGM = 8;

__host__ __device__ __forceinline__ int lds_byte(int r, int c) { const int st = (r >> 4) * 2 + (c >> 5), rr = r & 15, cc = c & 31, ob = rr * 64 + cc * 2; return st * 1024 + (ob ^ (((ob >> 9) & 1) << 5)); }
__host__ __device__ __forceinline__ void stage_rc(int b, int& R, int& C) { const int st = b / 1024, sb = b % 1024, swz = sb ^ (((sb >> 9) & 1) << 5); R = (st >> 1) * 16 + swz / 64; C = (st & 1) * 32 + (swz % 64) / 2; }
__host__ __device__ __forceinline__ int perm32(int rho) { const int n = rho >> 4, i = rho & 15; return 8 * (i >> 2) + 4 * n + (i & 3); }

struct Unit { int pm, pn; };
struct Gemm { const bf16_t* A; const bf16_t* Bt; int M, N, K; };

struct StaticOrder {
    int nM, nN, nwg, G, c;
    __host__ __device__ void init(int M, int N, int G_, int c_) { nM = M / BM; nN = N / BM; nwg = nM * nN; G = G_; c = c_; }
    __host__ __device__ bool next(int i, Unit& u) const {
        const long L = (long)i * G + c; if (L >= nwg) return false;
        int wgid = (int)L; { const int q = nwg / NXCD, r = nwg % NXCD, xcd = wgid % NXCD, off = wgid / NXCD; wgid = (xcd < r ? xcd * (q + 1) : r * (q + 1) + (xcd - r) * q) + off; }
        const int nig = WGM * nN, gid = wgid / nig, fm = gid * WGM, gsz = (nM - fm) < WGM ? (nM - fm) : WGM;
        u.pm = fm + ((wgid % nig) % gsz); u.pn = (wgid % nig) / gsz; return true;
    }
    __device__ __forceinline__ void a_ready(const Unit&) const {}
    __device__ __forceinline__ void done(const Unit&) const {}
};
struct CountedOrder : StaticOrder {
    const unsigned* ready; unsigned need; unsigned* tmo;
    __device__ __forceinline__ void a_ready(const Unit& u) const {
        if (threadIdx.x < 64) {
            const unsigned long long t0 = __builtin_amdgcn_s_memrealtime(); unsigned polls = 0;
            while ((unsigned)__builtin_amdgcn_readfirstlane(__hip_atomic_load(ready + 64 * u.pm, __ATOMIC_RELAXED, __HIP_MEMORY_SCOPE_AGENT)) < need) {
                if ((++polls & 255u) == 0u && __builtin_amdgcn_readfirstlane(__hip_atomic_load(tmo, __ATOMIC_RELAXED, __HIP_MEMORY_SCOPE_AGENT)) != 0u) break;
                if (__builtin_amdgcn_s_memrealtime() - t0 > 2000000ull) {
                    if (threadIdx.x == 0) { unsigned expect = 0u; __hip_atomic_compare_exchange_strong(tmo + 1, &expect, 0x600u | (unsigned)(u.pm & 0xff), __ATOMIC_RELAXED, __ATOMIC_RELAXED, __HIP_MEMORY_SCOPE_AGENT); __hip_atomic_store(tmo, 1u, __ATOMIC_RELAXED, __HIP_MEMORY_SCOPE_AGENT); }
                    break; }
                __builtin_amdgcn_s_sleep(2); }
            __builtin_amdgcn_fence(__ATOMIC_ACQUIRE, "agent");
            asm volatile("s_waitcnt vmcnt(0)" ::: "memory");
        }
#if !defined(BROKEN_HOOK_NO_BARRIER)
        asm volatile("" ::: "memory"); __builtin_amdgcn_s_barrier(); asm volatile("" ::: "memory");
#endif
    }
};

__device__ __forceinline__ unsigned cvt_pk_bf16(float lo, float hi) { unsigned r; asm volatile("v_cvt_pk_bf16_f32 %0, %1, %2" : "=v"(r) : "v"(lo), "v"(hi)); return r; }
typedef float f32x2 __attribute__((ext_vector_type(2)));
__device__ __forceinline__ f32x2 gelu_pk(f32x2 v) {
    const f32x2 av = __builtin_elementwise_abs(v), d = av * 0.2316418882f + 1.0f;
    f32x2 t; t.x = __builtin_amdgcn_rcpf(d.x); t.y = __builtin_amdgcn_rcpf(d.y);
    f32x2 q = t * 0.5307027145f + (-0.7265760135f); q = q * t + 0.7107068705f; q = q * t + (-0.142248368f); q = q * t + 0.127414796f; q = q * t;
    const f32x2 s = (v * v) * (-0.72134752044f);
    f32x2 e; e.x = __builtin_amdgcn_exp2f(s.x); e.y = __builtin_amdgcn_exp2f(s.y);
    const f32x2 m = v * (q * e), r = v - m;
    f32x2 o; o.x = v.x < 0.f ? m.x : r.x; o.y = v.y < 0.f ? m.y : r.y; return o;
}

struct EpiF32 {
    static constexpr bool PERM = false, AFTER_DRAIN = false;
    float* C; int ldc; const float* bias;
    __device__ __forceinline__ void operator()(const f32x4 (&acc)[2][2][4][2], const Unit& u, int wr, int wc, int fr, int fq) const {
        const int row0 = u.pm * BM + wr * 64 + fr, col0 = u.pn * BM + wc * 32 + 4 * fq;
        f32x4 bv[2][2];
#pragma unroll
        for (int bj = 0; bj < 2; ++bj)
#pragma unroll
            for (int n = 0; n < 2; ++n) bv[bj][n] = bias ? *(const f32x4*)(bias + col0 + bj * HALF + n * 16) : (f32x4){0.f, 0.f, 0.f, 0.f};
#pragma unroll
        for (int ai = 0; ai < 2; ++ai)
#pragma unroll
            for (int m = 0; m < 4; ++m) { float* rowp = C + (size_t)(row0 + ai * HALF + m * 16) * ldc + col0;
#pragma unroll
                for (int bj = 0; bj < 2; ++bj)
#pragma unroll
                    for (int n = 0; n < 2; ++n) *(f32x4*)(rowp + bj * HALF + n * 16) = acc[ai][bj][m][n] + bv[bj][n]; }
    }
};
template <int ACT  > struct EpiBf16 {
    static constexpr bool PERM = true, AFTER_DRAIN = false;
    bf16_t* O; int ldc; const float* bias; int split_cols; size_t split_stride;
    __device__ __forceinline__ void operator()(const f32x4 (&acc)[2][2][4][2], const Unit& u, int wr, int wc, int fr, int fq) const {
        const int row0 = u.pm * BM + wr * 64 + fr; int colt = u.pn * BM; bf16_t* base = O;
        if (split_cols) { const int t = colt / split_cols; base += (size_t)t * split_stride; colt -= t * split_cols; }
        const int col0 = colt + wc * 32 + 8 * fq, bcol0 = u.pn * BM + wc * 32 + 8 * fq;
        f32x4 bv[2][2];
#pragma unroll
        for (int bj = 0; bj < 2; ++bj)
#pragma unroll
            for (int n = 0; n < 2; ++n) bv[bj][n] = bias ? *(const f32x4*)(bias + bcol0 + bj * HALF + 4 * n) : (f32x4){0.f, 0.f, 0.f, 0.f};
#pragma unroll
        for (int ai = 0; ai < 2; ++ai)
#pragma unroll
            for (int m = 0; m < 4; ++m) { bf16_t* rowp = base + (size_t)(row0 + ai * HALF + m * 16) * ldc + col0;
#pragma unroll
                for (int bj = 0; bj < 2; ++bj) { f32x4 v0 = acc[ai][bj][m][0] + bv[bj][0], v1 = acc[ai][bj][m][1] + bv[bj][1];
                    if (ACT == 1) { f32x2 a = gelu_pk((f32x2){v0[0], v0[1]}), b = gelu_pk((f32x2){v0[2], v0[3]}), c = gelu_pk((f32x2){v1[0], v1[1]}), d = gelu_pk((f32x2){v1[2], v1[3]});
                        v0 = (f32x4){a.x, a.y, b.x, b.y}; v1 = (f32x4){c.x, c.y, d.x, d.y}; }
                    if (ACT == 2) {
#pragma unroll
                        for (int j = 0; j < 4; ++j) { v0[j] = 0.5f * v0[j] * (1.0f + erff(v0[j] * 0.70710678f)); v1[j] = 0.5f * v1[j] * (1.0f + erff(v1[j] * 0.70710678f)); } }
                    u32x4 w; w.x = cvt_pk_bf16(v0[0], v0[1]); w.y = cvt_pk_bf16(v0[2], v0[3]); w.z = cvt_pk_bf16(v1[0], v1[1]); w.w = cvt_pk_bf16(v1[2], v1[3]);
                    *(u32x4*)(rowp + bj * HALF) = w; } }
    }
};

template <int MODE> __device__ __forceinline__ f32x4 pg8_mma(bf16x8 a, bf16x8 b, f32x4 c) {
    if constexpr (MODE == 1) { typedef int i32x4_ __attribute__((ext_vector_type(4))); return __builtin_bit_cast(f32x4, __builtin_amdgcn_mfma_i32_16x16x64_i8(__builtin_bit_cast(i32x4_, a), __builtin_bit_cast(i32x4_, b), __builtin_bit_cast(i32x4_, c), 0, 0, 0)); }
    else return __builtin_amdgcn_mfma_f32_16x16x32_bf16(a, b, c, 0, 0, 0); }
__device__ __forceinline__ f32x4 pg8_mma8(bf16x8 a0, bf16x8 a1, bf16x8 b0, bf16x8 b1, f32x4 c) {
    typedef int i32x4_ __attribute__((ext_vector_type(4))); typedef int i32x8_ __attribute__((ext_vector_type(8)));
    const i32x8_ A = __builtin_shufflevector(__builtin_bit_cast(i32x4_, a0), __builtin_bit_cast(i32x4_, a1), 0, 1, 2, 3, 4, 5, 6, 7), B = __builtin_shufflevector(__builtin_bit_cast(i32x4_, b0), __builtin_bit_cast(i32x4_, b1), 0, 1, 2, 3, 4, 5, 6, 7);
    const int one = 0x7f7f7f7f;
    asm volatile("v_mfma_scale_f32_16x16x128_f8f6f4 %0, %1, %2, %0, %3, %3 op_sel_hi:[0,0,0]" : "+v"(c) : "v"(A), "v"(B), "v"(one));
    return c; }
__device__ __forceinline__ void fp8_acc_settle() { asm volatile("s_nop 7\n\ts_nop 7\n\ts_nop 7" ::: "memory"); }
template <class Epi, class Sched, bool STAMP = false, int MODE = 0>
__device__ __forceinline__ void gemm_phase(PG8_LAS unsigned char* lds, const Gemm g, const Sched& S, const Epi& E, unsigned long long* stamps) {
    const int tid = threadIdx.x, wid = __builtin_amdgcn_readfirstlane(tid >> 6), lane = tid & 63, wr = wid >> 2, wc = wid & 3, fr = lane & 15, fq = lane >> 4;
    const int K = g.K, nt = K / BK;
    int ts_lo = 0, ts_hi = 0, nts = 0; const unsigned long long rt_entry = STAMP ? (unsigned long long)wall_clock64() : 0ull;
#define PG8_STAMP() do { if (STAMP && wid == 0 && nts < 64) { const unsigned long long _c = (unsigned long long)clock64(); \
        ts_lo = (lane == nts) ? (int)(unsigned)_c : ts_lo; ts_hi = (lane == nts) ? (int)(unsigned)(_c >> 32) : ts_hi; ++nts; } } while (0)
    PG8_STAMP();
    unsigned voffA[2], voffB[2];
#pragma unroll
    for (int i = 0; i < 2; ++i) { int R, C; stage_rc(tid * 16 + i * 8192, R, C); const int Rb = Epi::PERM ? ((R & ~31) + perm32(R & 31)) : R;
        voffA[i] = (unsigned)(R * K + C) * 2u; voffB[i] = (unsigned)(Rb * K + C) * 2u; }
    const size_t kstep = (size_t)(BK * 2);
    const size_t hstep = (size_t)HALF * K * 2;
    const size_t tstep = 2 * hstep;
    const unsigned ldsw = (unsigned)wid * 1024u;
    const int aoff = lds_byte(wr * 64 + fr, fq * 8), boff = lds_byte(wc * 32 + fr, fq * 8);
#define PG8_SA(b, h) (((b) * 2 + (h)) * HTB)
#define PG8_SB(b, h) ((4 + (b) * 2 + (h)) * HTB)
#define PG8_STAGE(bufoff, gbase, voff) do { _Pragma("unroll") for (int _i = 0; _i < 2; ++_i) \
        __builtin_amdgcn_global_load_lds((const unsigned*)((const char*)(gbase) + (voff)[_i]), (PG8_LAS unsigned*)(lds + (bufoff) + ldsw + _i * 8192), 16, 0, 0); } while (0)
#define PG8_LDA(dst, b, h) do { _Pragma("unroll") for (int m = 0; m < 4; ++m) _Pragma("unroll") for (int k = 0; k < 2; ++k) dst[m][k] = *(const PG8_LAS bf16x8*)(lds + PG8_SA(b, h) + aoff + m * 2048 + k * 1024); } while (0)
#define PG8_LDB(dst, b, h) do { _Pragma("unroll") for (int n = 0; n < 2; ++n) _Pragma("unroll") for (int k = 0; k < 2; ++k) dst[n][k] = *(const PG8_LAS bf16x8*)(lds + PG8_SB(b, h) + boff + n * 2048 + k * 1024); } while (0)
#define PG8_MMA(ai, bj, At, Bt) do { __builtin_amdgcn_s_setprio(1); _Pragma("unroll") for (int m = 0; m < 4; ++m) _Pragma("unroll") for (int n = 0; n < 2; ++n) { if constexpr (MODE == 2) acc[ai][bj][m][n] = pg8_mma8(Bt[n][0], Bt[n][1], At[m][0], At[m][1], acc[ai][bj][m][n]); else { _Pragma("unroll") for (int k = 0; k < 2; ++k) \
        acc[ai][bj][m][n] = pg8_mma<MODE>(Bt[n][k], At[m][k], acc[ai][bj][m][n]); } } __builtin_amdgcn_s_setprio(0); } while (0)
#define PG8_WAIT_V(n) asm volatile("s_waitcnt vmcnt(" #n ")" ::: "memory")
#define PG8_WAIT_L(n) asm volatile("s_waitcnt lgkmcnt(" #n ")" ::: "memory")
#define PG8_BAR __builtin_amdgcn_s_barrier()
#define PG8_SCHED __builtin_amdgcn_sched_barrier(0)
    Unit cur, nxt; int ui = 0;
    if (!S.next(0, cur)) return;
    f32x4 acc[2][2][4][2];
#pragma unroll
    for (int a = 0; a < 2; ++a)
#pragma unroll
        for (int b = 0; b < 2; ++b)
#pragma unroll
            for (int m = 0; m < 4; ++m)
#pragma unroll
                for (int n = 0; n < 2; ++n) acc[a][b][m][n] = (f32x4){0.f, 0.f, 0.f, 0.f};
    bf16x8 At[4][2], B0[2][2], B1[2][2];
    const char* cA = (const char*)g.A + (size_t)cur.pm * tstep; const char* cB = (const char*)g.Bt + (size_t)cur.pn * tstep;
    S.a_ready(cur);
    PG8_STAGE(PG8_SB(0, 0), cB, voffB); PG8_STAGE(PG8_SA(0, 0), cA, voffA); PG8_STAGE(PG8_SB(0, 1), cB + hstep, voffB); PG8_STAGE(PG8_SA(0, 1), cA + hstep, voffA);
    if (wr == 1) PG8_BAR;
    PG8_WAIT_V(4); PG8_BAR;
    PG8_STAGE(PG8_SB(1, 0), cB + kstep, voffB); PG8_STAGE(PG8_SA(1, 0), cA + kstep, voffA); PG8_STAGE(PG8_SB(1, 1), cB + hstep + kstep, voffB);
    PG8_WAIT_V(6); PG8_BAR;
    PG8_STAMP();
    for (;;) {
        const bool has_next = S.next(ui + 1, nxt);
        const char* nA = has_next ? (const char*)g.A + (size_t)nxt.pm * tstep : cA; const char* nB = has_next ? (const char*)g.Bt + (size_t)nxt.pn * tstep : cB;
        for (int t = 0; t < nt; t += 2) {
            const bool last = (t == nt - 2);
            const char* a1 = cA + (size_t)(t + 1) * kstep;
            const char* a2 = last ? nA : cA + (size_t)(t + 2) * kstep; const char* b2 = last ? nB : cB + (size_t)(t + 2) * kstep;
            const char* a3 = a2 + kstep; const char* b3 = b2 + kstep;
            if (last && has_next) S.a_ready(nxt);
            PG8_LDB(B0, 0, 0); PG8_SCHED; PG8_LDA(At, 0, 0); PG8_STAGE(PG8_SA(1, 1), a1 + hstep, voffA);
            PG8_WAIT_L(8); PG8_BAR; PG8_WAIT_L(0); PG8_MMA(0, 0, At, B0); PG8_BAR; PG8_SCHED;
            PG8_LDB(B1, 0, 1); PG8_STAGE(PG8_SB(0, 0), b2, voffB);
            PG8_BAR; PG8_WAIT_L(0); PG8_MMA(0, 1, At, B1); PG8_BAR;
            PG8_LDA(At, 0, 1); PG8_STAGE(PG8_SA(0, 0), a2, voffA);
            PG8_BAR; PG8_WAIT_L(0); PG8_MMA(1, 0, At, B0); PG8_BAR; PG8_SCHED;
            PG8_STAGE(PG8_SB(0, 1), b2 + hstep, voffB);
            PG8_WAIT_V(6); PG8_BAR; PG8_MMA(1, 1, At, B1); PG8_BAR;
            PG8_LDB(B0, 1, 0); PG8_SCHED; PG8_LDA(At, 1, 0); PG8_STAGE(PG8_SA(0, 1), a2 + hstep, voffA);
            PG8_WAIT_L(8); PG8_BAR; PG8_WAIT_L(0); PG8_MMA(0, 0, At, B0); PG8_BAR; PG8_SCHED;
            PG8_LDB(B1, 1, 1); PG8_STAGE(PG8_SB(1, 0), b3, voffB);
            PG8_BAR; PG8_WAIT_L(0); PG8_MMA(0, 1, At, B1); PG8_BAR;
            PG8_LDA(At, 1, 1); PG8_STAGE(PG8_SA(1, 0), a3, voffA);
            PG8_BAR; PG8_WAIT_L(0); PG8_MMA(1, 0, At, B0); PG8_BAR; PG8_SCHED;
            PG8_STAGE(PG8_SB(1, 1), b3 + hstep, voffB);
            PG8_WAIT_V(6); PG8_BAR; PG8_MMA(1, 1, At, B1); PG8_BAR;
        }
        PG8_STAMP();
        if constexpr (!Epi::AFTER_DRAIN) { E(acc, cur, wr, wc, fr, fq); S.done(cur); }
        PG8_STAMP();
        if (!has_next) break;
#pragma unroll
        for (int a = 0; a < 2; ++a)
#pragma unroll
            for (int b = 0; b < 2; ++b)
#pragma unroll
                for (int m = 0; m < 4; ++m)
#pragma unroll
                    for (int n = 0; n < 2; ++n) acc[a][b][m][n] = (f32x4){0.f, 0.f, 0.f, 0.f};
        cur = nxt; cA = nA; cB = nB; ++ui;
    }
    PG8_WAIT_V(0);
    if (wr == 0) PG8_BAR;
    PG8_BAR;
    if constexpr (Epi::AFTER_DRAIN) { E.fused(acc, cur, wr, wc, fr, fq, lds, wid, lane); S.done(cur); }
    PG8_STAMP();
    if (STAMP && wid == 0) { stamps[lane] = lane < nts ? (((unsigned long long)(unsigned)ts_hi << 32) | (unsigned)ts_lo) : 0ull;
        if (lane == 62) stamps[62] = rt_entry; if (lane == 63) stamps[63] = (unsigned long long)wall_clock64(); }
#undef PG8_STAMP
#undef PG8_SA
#undef PG8_SB
#undef PG8_STAGE
#undef PG8_LDA
#undef PG8_LDB
#undef PG8_MMA
#undef PG8_WAIT_V
#undef PG8_WAIT_L
#undef PG8_BAR
#undef PG8_SCHED
}
}
#define XB_TMO      128
#define XB_XCNT(j)  (256  + 64 * (j))
#define XB_XSUB(j)  (1280 + 64 * (j))
#define XB_XGEN(j)  (2304 + 64 * (j))
#define XB_TOP      3328
#define XB_TOPGEN   3392
#define XCD_BAR_WORDS 3456
#define XB_SPIN_CAP (1u << 18)
#define LAS __attribute__((address_space(3)))

__device__ __forceinline__ unsigned xb_ld(unsigned* p)              { return __hip_atomic_load(p, __ATOMIC_RELAXED, __HIP_MEMORY_SCOPE_AGENT); }
__device__ __forceinline__ unsigned xb_add(unsigned* p, unsigned v) { return __hip_atomic_fetch_add(p, v, __ATOMIC_RELAXED, __HIP_MEMORY_SCOPE_AGENT); }
__device__ __forceinline__ unsigned xb_xcc_id() { return (unsigned)__builtin_amdgcn_s_getreg((3 << 11) | 20) & 0xFu; }
#define XB_SPIN(cond, bar) do { unsigned _sp = 0; while (cond) { __builtin_amdgcn_s_sleep(1); \
    if ((++_sp & 255u) == 0u) { if (xb_ld(&(bar)[XB_TMO])) break; if (_sp > XB_SPIN_CAP) { atomicAdd(&(bar)[XB_TMO], 1u); break; } } } } while (0)

struct XcdBarrier {
    unsigned* bar; unsigned x;
    volatile LAS unsigned* st;
};

__device__ __forceinline__ XcdBarrier xcd_barrier_post(unsigned* bar, volatile LAS unsigned* st) {
    XcdBarrier b; b.bar = bar; b.x = xb_xcc_id(); b.st = st;
    if (threadIdx.x == 0) (void)xb_add(&bar[XB_XCNT(b.x)], 1u);
    return b;
}
__device__ __forceinline__ void xcd_barrier_complete(unsigned* bar, unsigned x, unsigned& nloc, unsigned& nx) {
    const unsigned G = gridDim.x * gridDim.y * gridDim.z;
    unsigned sum, cnt, mine, sp = 0u;
    for (;;) {
        sum = 0u; cnt = 0u; mine = 0u;
#pragma unroll
        for (unsigned j = 0; j < 16; ++j) { const unsigned c = xb_ld(&bar[XB_XCNT(j)]); sum += c; cnt += (c > 0u) ? 1u : 0u; mine = (j == x) ? c : mine; }
        if (sum == G) break;
        __builtin_amdgcn_s_sleep(1);
        if ((++sp & 255u) == 0u) { if (xb_ld(&bar[XB_TMO])) break; if (sp > XB_SPIN_CAP) { atomicAdd(&bar[XB_TMO], 1u); break; } }
    }
    nloc = mine > 0u ? mine : 1u; nx = cnt > 0u ? cnt : 1u;
}

__device__ __forceinline__ void xcd_barrier(const XcdBarrier& b) {
    asm volatile("s_waitcnt vmcnt(0)" ::: "memory");
    __syncthreads();
    if (threadIdx.x == 0) {
        unsigned* bar = b.bar;
        __builtin_amdgcn_s_waitcnt(0);
        unsigned nloc = b.st[0], nx = b.st[1];
        if (nloc == 0u) { xcd_barrier_complete(bar, b.x, nloc, nx); b.st[0] = nloc; b.st[1] = nx; }
        const unsigned old = xb_add(&bar[XB_XSUB(b.x)], 1u);
        const unsigned gen = old / nloc;
        if (old + 1u == (gen + 1u) * nloc) {
            __builtin_amdgcn_fence(__ATOMIC_RELEASE, "agent");
            asm volatile("s_waitcnt vmcnt(0)" ::: "memory");
            const unsigned og = xb_add(&bar[XB_TOP], 1u);
            const unsigned tg = og / nx;
            if (og + 1u == (tg + 1u) * nx) xb_add(&bar[XB_TOPGEN], 1u);
            else XB_SPIN(xb_ld(&bar[XB_TOPGEN]) == tg, bar);
            __builtin_amdgcn_fence(__ATOMIC_ACQUIRE, "agent");
            xb_add(&bar[XB_XGEN(b.x)], 1u);
            asm volatile("s_waitcnt vmcnt(0)" ::: "memory");
        } else {
            XB_SPIN(xb_ld(&bar[XB_XGEN(b.x)]) == gen, bar);
            __builtin_amdgcn_fence(__ATOMIC_ACQUIRE, "agent");
            asm volatile("s_waitcnt vmcnt(0)" ::: "memory");
        }
    }
    __syncthreads();
}

namespace mk {
using pg8::bf16_t; using pg8::bf16x8; using pg8::f32x4; using pg8::u32x4;
typedef unsigned u32x2 __attribute__((ext_vector_type(2)));
typedef short bf16x4 __attribute__((ext_vector_type(4)));
typedef float lf2 __attribute__((ext_vector_type(2)));
typedef float lf4 __attribute__((ext_vector_type(4)));
typedef unsigned lu4 __attribute__((ext_vector_type(4)));

constexpr int D = 1024, NBATCH = 16, SEQ = 2048, CTXL = 256;
constexpr int NLAT = NBATCH * SEQ, NCTX = NBATCH * CTXL, NROW = NLAT + NCTX;
constexpr int NINP = 3072, NIN = 2944;
constexpr int C_Q = 256, C_K = 640, C_V = 1024, C_Z = 1408;
constexpr int DE = 2816;
constexpr int XROWS = 4608;
constexpr int NTHR = 512;
constexpr int LDS_MISC = 131072, LDS_BYTES = 131072 + 256;

constexpr size_t al256(size_t x) { return (x + 255) & ~(size_t)255; }
constexpr size_t WS_CTL = 0;
constexpr size_t WS_MOD = 65536;
constexpr size_t WS_SW = al256(WS_MOD + (size_t)2 * 17 * 6144 * 4);
constexpr size_t SW_W2T = 0, SW_A2T = 98304, SW_G2T = 196608, SW_GLUT = 294912, SW_S5E = 425984, SW_S5W2 = 2523136, SW_STRIDE = 6717440;
constexpr size_t WS_WIN = al256(WS_SW + 2 * SW_STRIDE);
constexpr size_t WS_WOUT = WS_WIN + (size_t)3072 * 1024 * 2;
constexpr size_t WS_WGU = WS_WOUT + (size_t)1024 * 1024 * 2;
constexpr size_t WS_WD = WS_WGU + (size_t)16 * 5632 * 1024 * 2;
constexpr size_t WS_XB = WS_WD + (size_t)16 * 1024 * 2816 * 2;
constexpr size_t WS_CTXA = WS_XB + (size_t)NLAT * D * 4;
constexpr size_t WS_CTXB = WS_CTXA + (size_t)NCTX * D * 4;
constexpr size_t WS_ABUF = WS_CTXB + (size_t)NCTX * D * 4;
constexpr size_t WS_AFF = WS_ABUF + (size_t)NROW * D * 2;
constexpr size_t WS_SLOT = WS_AFF + (size_t)NROW * 16 * 4;
constexpr size_t WS_SELG = WS_SLOT + (size_t)NROW * 16 * 4;
constexpr size_t WS_SW8 = al256(WS_SELG + (size_t)16 * XROWS * 4);
constexpr size_t WS_SX = WS_SW8 + (size_t)16 * 5632 * 4;
constexpr size_t WS_SXS = WS_SX + (size_t)NROW * 4;
constexpr size_t WS_SWIN = WS_SXS + (size_t)16 * XROWS * 4;
constexpr size_t WS_SH = WS_SWIN + (size_t)3072 * 4;
constexpr size_t WS_SWD = WS_SH + (size_t)NROW * 4;
constexpr size_t WS_U = al256(WS_SWD + (size_t)16 * 1024 * 4);
constexpr size_t SZ384 = (size_t)NROW * 384 * 2;
constexpr size_t U_P = WS_U;
constexpr size_t U_QR = U_P + (size_t)NROW * NINP * 2;
constexpr size_t U_KR = U_QR + SZ384;
constexpr size_t U_VT = U_KR + SZ384;
constexpr size_t U_VTC = U_VT + (size_t)16 * 384 * 2048 * 2;
constexpr size_t U_RS = U_VT + SZ384;
constexpr size_t U_KS = U_RS + SZ384;
constexpr size_t U_VS = U_KS + SZ384;
constexpr size_t U_KK = U_VS + SZ384;
constexpr size_t U_ALR = U_KK + SZ384;
constexpr size_t U_LD = U_ALR + SZ384;
constexpr size_t U_AG = U_LD + 2 * SZ384;
constexpr size_t U_G = U_AG + 2 * SZ384;
constexpr size_t U_YRK = U_G + SZ384;
constexpr size_t U_SLOC = U_YRK + 2 * (size_t)NROW * 384 * 4;
constexpr size_t U_SPREV = U_SLOC + (size_t)2304 * 16 * 256 * 4;
constexpr size_t U_YG = U_SPREV + (size_t)2304 * 16 * 256 * 2;
constexpr size_t U_U16 = U_YG + (size_t)NROW * 256 * 2;
constexpr size_t U_MIX_END = U_U16 + (size_t)NROW * 256 * 2;
constexpr int NCHUNK = 192 * 144;
constexpr size_t CH_XP = U_P;
constexpr size_t CH_BK = CH_XP + (size_t)NCHUNK * 4096;
constexpr size_t CH_UL = CH_BK + (size_t)NCHUNK * 4096;
constexpr size_t CH_MM = U_SLOC;
constexpr size_t CH_GT = CH_MM + (size_t)NCHUNK * 1024;
static_assert(CH_UL + (size_t)NCHUNK * 2048 <= U_RS, "chunk buffers overlap live RWKV operands");
static_assert(CH_GT + (size_t)NCHUNK * 256 <= U_SPREV, "chunk buffers overlap S5 states");
constexpr size_t U_Y = WS_U;
constexpr size_t U_XSEL = U_Y + (size_t)NROW * D * 4;
constexpr size_t U_HID = U_XSEL + (size_t)16 * XROWS * 1024 * 2;
constexpr size_t U_YEXP = U_HID + (size_t)16 * XROWS * DE * 2;
constexpr size_t U_FFN_END = U_YEXP + (size_t)16 * XROWS * 1024 * 2;
constexpr size_t WS_END = U_MIX_END > U_FFN_END ? U_MIX_END : U_FFN_END;

struct Params { const float* in[35]; float* out; unsigned char* ws; int ph_lo, ph_hi, use_bar, pad; };

typedef __bf16 hwbf2 __attribute__((ext_vector_type(2)));
__device__ __forceinline__ unsigned pack2(float lo, float hi) { const lf2 v = {lo, hi}; return __builtin_bit_cast(unsigned, __builtin_convertvector(v, hwbf2)); }
__device__ __forceinline__ bf16_t f2bf(float f) { return (bf16_t)(pack2(f, 0.f) & 0xffffu); }
__device__ __forceinline__ float bflo(unsigned w) { return __uint_as_float(w << 16); }
__device__ __forceinline__ float bfhi(unsigned w) { return __uint_as_float(w & 0xffff0000u); }
__device__ __forceinline__ float bf2f(bf16_t b) { return __uint_as_float(((unsigned)b) << 16); }
__device__ __forceinline__ float sigm(float x) { return 1.0f / (1.0f + __expf(-x)); }
__device__ __forceinline__ float wave_sum(float v) {
#pragma unroll
    for (int o = 32; o >= 1; o >>= 1) v += __shfl_xor(v, o);
    return v; }
__device__ __forceinline__ void unpack8(const uint4 w, float (&f)[8]) { f[0] = bflo(w.x); f[1] = bfhi(w.x); f[2] = bflo(w.y); f[3] = bfhi(w.y); f[4] = bflo(w.z); f[5] = bfhi(w.z); f[6] = bflo(w.w); f[7] = bfhi(w.w); }
__device__ __forceinline__ uint4 pack8(const float (&f)[8]) { uint4 w; w.x = pack2(f[0], f[1]); w.y = pack2(f[2], f[3]); w.z = pack2(f[4], f[5]); w.w = pack2(f[6], f[7]); return w; }
__device__ __forceinline__ const float* xrow(const float* lat, const float* ctx, int r) { return r < NLAT ? lat + (size_t)r * D : ctx + (size_t)(r - NLAT) * D; }
__device__ __forceinline__ float* xrow_w(float* lat, float* ctx, int r) { return r < NLAT ? lat + (size_t)r * D : ctx + (size_t)(r - NLAT) * D; }
__device__ __forceinline__ f32x4 mfma16(bf16x8 a, bf16x8 b, f32x4 c) { return __builtin_amdgcn_mfma_f32_16x16x32_bf16(a, b, c, 0, 0, 0); }

__device__ __forceinline__ void tr_tile(const float* __restrict__ src, int ldsrc, int k0, int n0, bf16_t* __restrict__ dst, int lddst, int drow0, LAS unsigned* T) {
    const int tid = threadIdx.x, n4 = tid & 15, kq = tid >> 4;
    const float4 a = *(const float4*)(src + (size_t)(k0 + 2 * kq) * ldsrc + n0 + 4 * n4);
    const float4 b = *(const float4*)(src + (size_t)(k0 + 2 * kq + 1) * ldsrc + n0 + 4 * n4);
    T[(4 * n4 + 0) * 33 + kq] = pack2(a.x, b.x); T[(4 * n4 + 1) * 33 + kq] = pack2(a.y, b.y);
    T[(4 * n4 + 2) * 33 + kq] = pack2(a.z, b.z); T[(4 * n4 + 3) * 33 + kq] = pack2(a.w, b.w);
    __syncthreads();
    const int n = tid >> 3, pc = tid & 7;
    uint4 v; v.x = T[n * 33 + 4 * pc]; v.y = T[n * 33 + 4 * pc + 1]; v.z = T[n * 33 + 4 * pc + 2]; v.w = T[n * 33 + 4 * pc + 3];
    *(uint4*)(dst + (size_t)(drow0 + n) * lddst + k0 + 8 * pc) = v;
    __syncthreads();
}

__device__ __forceinline__ void tr_tile4(const float* __restrict__ src, int ldsrc, int k0, int n0, bf16_t* __restrict__ dst, int lddst, int drow0, LAS unsigned* T) {
    const int tid = threadIdx.x, n4 = tid & 15, kq = tid >> 4;
    float4 a[4], b[4];
#pragma unroll
    for (int t = 0; t < 4; ++t) { a[t] = *(const float4*)(src + (size_t)(k0 + 2 * kq) * ldsrc + n0 + 64 * t + 4 * n4); b[t] = *(const float4*)(src + (size_t)(k0 + 2 * kq + 1) * ldsrc + n0 + 64 * t + 4 * n4); }
#pragma unroll
    for (int t = 0; t < 4; ++t) { LAS unsigned* Tt = T + t * 64 * 33;
        Tt[(4 * n4 + 0) * 33 + kq] = pack2(a[t].x, b[t].x); Tt[(4 * n4 + 1) * 33 + kq] = pack2(a[t].y, b[t].y); Tt[(4 * n4 + 2) * 33 + kq] = pack2(a[t].z, b[t].z); Tt[(4 * n4 + 3) * 33 + kq] = pack2(a[t].w, b[t].w); }
    __syncthreads();
#pragma unroll
    for (int i = 0; i < 4; ++i) { const int idx = tid + NTHR * i, n = idx >> 3, pc = idx & 7;
        uint4 v; v.x = T[n * 33 + 4 * pc]; v.y = T[n * 33 + 4 * pc + 1]; v.z = T[n * 33 + 4 * pc + 2]; v.w = T[n * 33 + 4 * pc + 3];
        *(uint4*)(dst + (size_t)(drow0 + n) * lddst + k0 + 8 * pc) = v; }
    __syncthreads();
}
template <int NK, int DP, bool FP8> __device__ __forceinline__ void q8_strip(const float* __restrict__ src, int ldsrc, unsigned char* __restrict__ dst, float* __restrict__ scl, LAS unsigned char* lds) {
    LAS float* cmax = (LAS float*)lds;
    LAS unsigned char* T = lds + 8704;
    const int tid = threadIdx.x, n4 = tid & 15, kq = tid >> 4; constexpr float QMAX = FP8 ? 256.0f : 127.0f;
    float mx[4] = {0.f, 0.f, 0.f, 0.f};
#pragma unroll 8
    for (int i = 0; i < 2 * NK; ++i) { const float4 v = *(const float4*)(src + (size_t)(kq + 32 * i) * ldsrc + 4 * n4); mx[0] = fmaxf(mx[0], fabsf(v.x)); mx[1] = fmaxf(mx[1], fabsf(v.y)); mx[2] = fmaxf(mx[2], fabsf(v.z)); mx[3] = fmaxf(mx[3], fabsf(v.w)); }
    __syncthreads();
#pragma unroll
    for (int j = 0; j < 4; ++j) cmax[kq * 64 + 4 * n4 + j] = mx[j];
    __syncthreads();
    if (tid < 64) { float m = 0.f; for (int g = 0; g < 32; ++g) m = fmaxf(m, cmax[g * 64 + tid]); m = fmaxf(m, 1e-20f); scl[tid] = m * (1.0f / QMAX); cmax[32 * 64 + tid] = QMAX / m; }
    __syncthreads();
    float inv[4];
#pragma unroll
    for (int j = 0; j < 4; ++j) inv[j] = cmax[32 * 64 + 4 * n4 + j];
    for (int kg = 0; kg < NK / 4; ++kg) {
        float4 a[4], b[4];
#pragma unroll
        for (int t = 0; t < 4; ++t) { const int kb = (kg * 4 + t) * 64 + 2 * kq; a[t] = *(const float4*)(src + (size_t)kb * ldsrc + 4 * n4); b[t] = *(const float4*)(src + (size_t)(kb + 1) * ldsrc + 4 * n4); }
#pragma unroll
        for (int t = 0; t < 4; ++t) { const float av[4] = {a[t].x, a[t].y, a[t].z, a[t].w}, bv[4] = {b[t].x, b[t].y, b[t].z, b[t].w};
#pragma unroll
            for (int j = 0; j < 4; ++j) { unsigned short w;
                if (FP8) w = (unsigned short)(__builtin_amdgcn_cvt_pk_fp8_f32(av[j] * inv[j], bv[j] * inv[j], 0, false) & 0xffff);
                else { const int q0 = __float2int_rn(av[j] * inv[j]), q1 = __float2int_rn(bv[j] * inv[j]); w = (unsigned short)((q0 & 255) | ((q1 & 255) << 8)); }
                *(LAS unsigned short*)(T + (4 * n4 + j) * 272 + t * 64 + 2 * kq) = w; } }
        __syncthreads();
#pragma unroll
        for (int i = 0; i < 2; ++i) { const int idx = tid + NTHR * i, n = idx >> 4, pc = idx & 15; *(lu4*)(dst + (size_t)n * DP + kg * 256 + 16 * pc) = *(const LAS lu4*)(T + n * 272 + 16 * pc); }
        __syncthreads();
    }
}
__device__ __forceinline__ void gu_strip(const Params& p, int l, int item, LAS unsigned char* lds) {
    const int e = item / 88, rem = item % 88, up = rem / 44, nt = rem % 44, n0 = nt * 64, drow0 = (n0 >> 7) * 256 + (n0 & 127) + (up ? 128 : 0);
    q8_strip<16, 1024, false>(p.in[up ? 33 : 32] + (size_t)(l * 16 + e) * 1024 * DE + n0, DE, p.ws + WS_WGU + ((size_t)e * 5632 + drow0) * 1024, (float*)(p.ws + WS_SW8) + (size_t)e * 5632 + drow0, lds);
}
constexpr int CV_GU = 16 * 88, CV_D4 = 16 * 16, CV_WIN = 46, CV_PAD = 16, CV_WOUT4 = 16 * 4, CV_TOTAL = CV_GU + CV_D4 + CV_WIN + CV_PAD + CV_WOUT4;
__device__ __forceinline__ void convert_weights(const Params& p, int l, LAS unsigned char* lds, int vb, int nvb) {
    LAS unsigned* T = (LAS unsigned*)lds; bf16_t* WOUT = (bf16_t*)(p.ws + WS_WOUT);
    for (int it = vb; it < CV_TOTAL; it += nvb) {
        int j = it;
        if (j < CV_GU) { gu_strip(p, l, j, lds); continue; }
        j -= CV_GU;
        if (j < CV_D4) { const int e = j >> 4, nt = j & 15;
            q8_strip<44, DE, true>(p.in[34] + (size_t)(l * 16 + e) * DE * 1024 + nt * 64, 1024, p.ws + WS_WD + ((size_t)e * 1024 + nt * 64) * DE, (float*)(p.ws + WS_SWD) + e * 1024 + nt * 64, lds); continue; }
        j -= CV_D4;
        if (j < CV_WIN) { q8_strip<16, 1024, false>(p.in[7] + (size_t)l * 1024 * NIN + j * 64, NIN, p.ws + WS_WIN + (size_t)j * 64 * 1024, (float*)(p.ws + WS_SWIN) + j * 64, lds); continue; }
        j -= CV_WIN;
        if (j < CV_PAD) { const size_t o = (size_t)NIN * 1024 + ((size_t)j * NTHR + threadIdx.x) * 16; *(uint4*)(p.ws + WS_WIN + o) = make_uint4(0u, 0u, 0u, 0u);
            if (j == 0 && threadIdx.x < 128) ((float*)(p.ws + WS_SWIN))[NIN + threadIdx.x] = 0.f; continue; }
        j -= CV_PAD;
        { const int kt = j >> 2, ng = j & 3; tr_tile4(p.in[8] + (size_t)l * 1024 * 1024, 1024, kt * 64, ng * 256, WOUT, 1024, ng * 256, T); }
    }
}

__device__ __forceinline__ void mod_item(const Params& p, int item, LAS unsigned char* lds) {
    LAS float* sc = (LAS float*)lds;
    LAS float* red = (LAS float*)(lds + 69632);
    const int tid = threadIdx.x, l = item / 96, cg = item % 96;
    for (int i = tid; i < 17 * 1024; i += NTHR) { const int b = i >> 10, k = i & 1023; const float c = b < 16 ? p.in[1][b * 1024 + k] : p.in[3][k]; sc[k * 17 + b] = c * sigm(c); }
    __syncthreads();
    const int col = cg * 64 + (tid & 63), kg = tid >> 6;
    float acc[17];
#pragma unroll
    for (int b = 0; b < 17; ++b) acc[b] = 0.f;
    const float* w = p.in[4] + ((size_t)l * 1024 + kg * 128) * 6144 + col;
#pragma unroll 4
    for (int kk = 0; kk < 128; ++kk) { const float wv = w[(size_t)kk * 6144]; const LAS float* s = sc + (kg * 128 + kk) * 17;
#pragma unroll
        for (int b = 0; b < 17; ++b) acc[b] += s[b] * wv; }
#pragma unroll
    for (int b = 0; b < 17; ++b) red[(kg * 17 + b) * 64 + (tid & 63)] = acc[b];
    __syncthreads();
    for (int i = tid; i < 17 * 64; i += NTHR) { const int b = i >> 6, c = i & 63; float s = 0.f;
#pragma unroll
        for (int g = 0; g < 8; ++g) s += red[(g * 17 + b) * 64 + c];
        ((float*)(p.ws + WS_MOD))[((size_t)l * 17 + b) * 6144 + cg * 64 + c] = s + p.in[5][l * 6144 + cg * 64 + c]; }
    __syncthreads();
}

__device__ __forceinline__ void s5mat_item(const Params& p, int item, LAS unsigned char* lds) {
    LAS lf2* pw = (LAS lf2*)lds;
    LAS lf2* bb = (LAS lf2*)(lds + 17408);
    LAS lf2* cc = (LAS lf2*)(lds + 17408 + 16384);
    LAS float* KT = (LAS float*)(lds + 17408 + 32768);
    const int tid = threadIdx.x, l = item >> 4, g = item & 15;
    for (int i = tid; i < 2 * 17 * 64; i += NTHR) { const int pp = i & 63, n = (i >> 6) % 17, d = i / (17 * 64);
        const int li = ((l * 2 + d) * 16 + g) * 64 + pp; const float lr = p.in[9][li], lim = p.in[10][li], dt = expf(p.in[11][(l * 2 + d) * 16 + g]);
        const float mag = expf((float)n * dt * lr); float s, c; sincosf((float)n * dt * lim, &s, &c); pw[i] = (lf2){mag * c, mag * s}; }
    for (int i = tid; i < 2 * 64 * 16; i += NTHR) { const int h = i & 15, pp = (i >> 4) & 63, d = i >> 10;
        const int li = ((l * 2 + d) * 16 + g) * 64 + pp; const float lr = p.in[9][li], lim = p.in[10][li], dt = expf(p.in[11][(l * 2 + d) * 16 + g]);
        const float mag = expf(dt * lr); float s, c; sincosf(dt * lim, &s, &c); const float x = mag * c - 1.0f, y = mag * s;
        const float den = 1.0f / (lr * lr + lim * lim); const float cr = (x * lr + y * lim) * den, ci = (y * lr - x * lim) * den;
        const int bi = ((l * 16 + g) * 64 + pp) * 16 + h; const float br = p.in[12][bi], bim = p.in[13][bi];
        bb[i] = (lf2){cr * br - ci * bim, cr * bim + ci * br}; }
    for (int i = tid; i < 2 * 16 * 64; i += NTHR) { const int pp = i & 63, h = (i >> 6) & 15, d = i >> 10;
        const int ci = (((l * 2 + d) * 16 + g) * 16 + h) * 64 + pp; cc[i] = (lf2){p.in[14][ci], p.in[15][ci]}; }
    __syncthreads();
    for (int i = tid; i < 2 * 16 * 256; i += NTHR) { const int h2 = i & 15, h = (i >> 4) & 15, tau = (i >> 8) & 15, d = i >> 12; float s = 0.f;
        for (int pp = 0; pp < 64; ++pp) { const lf2 c = cc[(d * 16 + h) * 64 + pp], w = pw[(d * 17 + tau) * 64 + pp], b = bb[(d * 64 + pp) * 16 + h2];
            const float tr = c.x * w.x - c.y * w.y, ti = c.x * w.y + c.y * w.x; s += tr * b.x - ti * b.y; }
        KT[i] = s; }
    __syncthreads();
    bf16_t* E = (bf16_t*)(p.ws + WS_SW + (size_t)l * SW_STRIDE + SW_S5E) + (size_t)g * 256 * 256;
    bf16_t* W2 = (bf16_t*)(p.ws + WS_SW + (size_t)l * SW_STRIDE + SW_S5W2) + (size_t)g * 256 * 512;
    for (int i = tid; i < 256 * 256; i += NTHR) { const int k = i & 255, n = i >> 8; const int s = k >> 4, h = k & 15, d = n >> 7, part = (n >> 6) & 1, pp = n & 63;
        const int e = d == 0 ? 15 - s : s; const lf2 w = pw[(d * 17 + e) * 64 + pp], b = bb[(d * 64 + pp) * 16 + h];
        E[i] = f2bf(part ? (w.x * b.y + w.y * b.x) : (w.x * b.x - w.y * b.y)); }
    for (int i = tid; i < 256 * 512; i += NTHR) { const int k = i & 511, n = i >> 9; const int t = n >> 4, h = n & 15; float v;
        if (k < 256) { const int s = k >> 4, h2 = k & 15; v = 0.f;
            if (t >= s) v += KT[((0 * 16 + (t - s)) * 16 + h) * 16 + h2];
            if (s >= t) v += KT[((1 * 16 + (s - t)) * 16 + h) * 16 + h2];
            if (s == t && h == h2) v += p.in[16][l * 256 + g * 16 + h]; }
        else { const int q = k - 256, d = q >> 7, part = (q >> 6) & 1, pp = q & 63; const int e = d == 0 ? t + 1 : 16 - t;
            const lf2 c = cc[(d * 16 + h) * 64 + pp], w = pw[(d * 17 + e) * 64 + pp];
            v = part ? -(c.x * w.y + c.y * w.x) : (c.x * w.x - c.y * w.y); }
        W2[i] = f2bf(v); }
    __syncthreads();
}

__device__ __forceinline__ void smallw_item(const Params& p, int item) {
    int i = item * NTHR + threadIdx.x; const int l = i / 212992; i %= 212992;
    unsigned char* sw = p.ws + WS_SW + (size_t)l * SW_STRIDE;
    if (i < 49152) { const int k = i & 63, n = (i >> 6) % 384, d = i / 24576; ((bf16_t*)(sw + SW_W2T))[i] = f2bf(p.in[22][((size_t)(l * 2 + d) * 64 + k) * 384 + n]); return; }
    i -= 49152;
    if (i < 49152) { const int k = i & 63, n = (i >> 6) % 384, d = i / 24576; ((bf16_t*)(sw + SW_A2T))[i] = f2bf(p.in[24][((size_t)(l * 2 + d) * 64 + k) * 384 + n]); return; }
    i -= 49152;
    if (i < 49152) { const int k = i & 127, n = i >> 7; ((bf16_t*)(sw + SW_G2T))[i] = f2bf(p.in[25][((size_t)l * 128 + k) * 384 + n]); return; }
    i -= 49152;
    { const int k = i & 255, n = i >> 8; ((bf16_t*)(sw + SW_GLUT))[i] = f2bf(p.in[17][((size_t)l * 256 + k) * 256 + n]); }
}

constexpr int PRO_MOD = 192, PRO_S5 = 32, PRO_SW = 832;
__device__ __forceinline__ void phase_prologue(const Params& p, LAS unsigned char* lds) {
    for (int it = blockIdx.x; it < PRO_MOD + PRO_S5 + PRO_SW; it += gridDim.x) {
        if (it < PRO_MOD) mod_item(p, it, lds);
        else if (it < PRO_MOD + PRO_S5) s5mat_item(p, it - PRO_MOD, lds);
        else smallw_item(p, it - PRO_MOD - PRO_S5);
    }
    convert_weights(p, 0, lds, (int)blockIdx.x, (int)gridDim.x);
}

__device__ __forceinline__ void hnorm_row(const float* g, const float* mb_sh, const float* mb_sc, unsigned char* dst, float* sdst, int lane, const float4 (&v)[4]) {
    float ss = 0.f;
#pragma unroll
    for (int i = 0; i < 4; ++i) ss += v[i].x * v[i].x + v[i].y * v[i].y + v[i].z * v[i].z + v[i].w * v[i].w;
    ss = wave_sum(ss); const float rs = rsqrtf(ss * (1.0f / 1024.0f) + 1e-6f);
    float hv[4][4]; float amax = 0.f;
#pragma unroll
    for (int i = 0; i < 4; ++i) { const int c = i * 256 + lane * 4; const float4 gg = *(const float4*)(g + c), sh = *(const float4*)(mb_sh + c), sc = *(const float4*)(mb_sc + c);
        hv[i][0] = v[i].x * rs * gg.x * (1.f + sc.x) + sh.x; hv[i][1] = v[i].y * rs * gg.y * (1.f + sc.y) + sh.y; hv[i][2] = v[i].z * rs * gg.z * (1.f + sc.z) + sh.z; hv[i][3] = v[i].w * rs * gg.w * (1.f + sc.w) + sh.w;
        amax = fmaxf(amax, fmaxf(fmaxf(fabsf(hv[i][0]), fabsf(hv[i][1])), fmaxf(fabsf(hv[i][2]), fabsf(hv[i][3])))); }
#pragma unroll
    for (int o = 32; o >= 1; o >>= 1) amax = fmaxf(amax, __shfl_xor(amax, o));
    amax = fmaxf(amax, 1e-20f); const float qs = 127.0f / amax;
    if (lane == 0) *sdst = amax * (1.0f / 127.0f);
#pragma unroll
    for (int i = 0; i < 4; ++i) { unsigned w = 0u;
#pragma unroll
        for (int k = 0; k < 4; ++k) w |= ((unsigned)__float2int_rn(hv[i][k] * qs) & 255u) << (8 * k);
        *(unsigned*)(dst + i * 256 + lane * 4) = w; }
}
__device__ __forceinline__ void phase_hnorm(const Params& p, int l, const float* xl, const float* xc) {
    const int lane = threadIdx.x & 63, wv = threadIdx.x >> 6;
    const float* mod = (const float*)(p.ws + WS_MOD) + (size_t)l * 17 * 6144; const float* g = p.in[6] + (l * 4 + 0) * 1024;
    unsigned char* A = p.ws + WS_ABUF; float* SH = (float*)(p.ws + WS_SH);
    for (int r = blockIdx.x * 8 + wv; r < NROW; r += gridDim.x * 8) {
        const float* src = xrow(xl, xc, r); const int b = r < NLAT ? (r >> 11) : 16; const float* mb = mod + (size_t)b * 6144;
        float4 v[4];
#pragma unroll
        for (int i = 0; i < 4; ++i) v[i] = *(const float4*)(src + i * 256 + lane * 4);
        hnorm_row(g, mb, mb + 1024, A + (size_t)r * 1024, SH + r, lane, v);
    }
}


__device__ __forceinline__ void phase_prep(const Params& p, int l, LAS unsigned char* lds) {
    LAS bf16_t* vt = (LAS bf16_t*)lds;
    LAS lf2* cs = (LAS lf2*)(lds + 50176);
    const int tid = threadIdx.x;
    for (int i = tid; i < 1024; i += NTHR) { const int pos = i >> 4, j = i & 15; const float invf = exp2f(-(float)j * (13.287712379549449f / 16.0f)); float s, c; sincosf((float)pos * invf, &s, &c); cs[i] = (lf2){c, s}; }
    __syncthreads();
    const bf16_t* P = (const bf16_t*)(p.ws + U_P);
    bf16_t* QR = (bf16_t*)(p.ws + U_QR); bf16_t* KR = (bf16_t*)(p.ws + U_KR);
    bf16_t* RS = (bf16_t*)(p.ws + U_RS); bf16_t* KS = (bf16_t*)(p.ws + U_KS); bf16_t* VS = (bf16_t*)(p.ws + U_VS); bf16_t* KK = (bf16_t*)(p.ws + U_KK); bf16_t* ALR = (bf16_t*)(p.ws + U_ALR);
    for (int ti = blockIdx.x; ti < NROW / 64; ti += gridDim.x) {
        const int r0 = ti * 64; const bool lat = r0 < NLAT; const int b = lat ? (r0 >> 11) : ((r0 - NLAT) >> 8), t0 = lat ? (r0 & 2047) : ((r0 - NLAT) & 255), slen = lat ? SEQ : CTXL;
#pragma unroll
        for (int i = 0; i < 6; ++i) { const int idx = tid + NTHR * i, tok = idx / 48, pc = idx % 48;
            *(LAS lu4*)(vt + tok * 392 + pc * 8) = *(const lu4*)(P + (size_t)(r0 + tok) * NINP + C_V + pc * 8); }
        __syncthreads();
        { bf16_t* vdst = lat ? (bf16_t*)(p.ws + U_VT) + (size_t)b * 384 * 2048 + t0 : (bf16_t*)(p.ws + U_VTC) + (size_t)b * 384 * 256 + t0;
#pragma unroll
          for (int i = 0; i < 6; ++i) { const int idx = tid + NTHR * i, hd = idx >> 3, pc = idx & 7; unsigned w[4];
#pragma unroll
              for (int j = 0; j < 4; ++j) w[j] = (unsigned)vt[(pc * 8 + 2 * j) * 392 + hd] | ((unsigned)vt[(pc * 8 + 2 * j + 1) * 392 + hd] << 16);
              *(uint4*)(vdst + (size_t)hd * slen + pc * 8) = make_uint4(w[0], w[1], w[2], w[3]); } }
#pragma unroll
        for (int i = 0; i < 4; ++i) { const int idx = tid + NTHR * i, tok = idx >> 5, pc = idx & 31;
            *(lu4*)((bf16_t*)(p.ws + U_U16) + (size_t)(r0 + tok) * 256 + pc * 8) = *(const lu4*)(P + (size_t)(r0 + tok) * NINP + pc * 8); }
        { lu4 rx[6][2]; int tq = threadIdx.x; asm volatile("" : "+v"(tq));
#pragma unroll
          for (int i = 0; i < 6; ++i) { const int idx = tq + NTHR * i, tok = idx / 48, rem = idx % 48, qk = rem / 24, rem2 = rem % 24, h = rem2 >> 2, pp = rem2 & 3;
              const int d1 = (pp >> 1) * 32 + (pp & 1) * 8; const size_t so = (size_t)(r0 + tok) * NINP + (qk ? C_K : C_Q) + h * 64 + d1;
              rx[i][0] = *(const lu4*)(P + so); rx[i][1] = *(const lu4*)(P + so + 16); }
#pragma unroll
          for (int i = 0; i < 6; ++i) { const int idx = tq + NTHR * i, tok = idx / 48, rem = idx % 48, qk = rem / 24, rem2 = rem % 24, h = rem2 >> 2, pp = rem2 & 3;
              const int d1 = (pp >> 1) * 32 + (pp & 1) * 8;
              float x1[8], x2[8], o1[8], o2[8]; unpack8(make_uint4(rx[i][0].x, rx[i][0].y, rx[i][0].z, rx[i][0].w), x1); unpack8(make_uint4(rx[i][1].x, rx[i][1].y, rx[i][1].z, rx[i][1].w), x2);
              const int t = t0 + tok, pos = (pp < 2) ? (t >> 6) : (t & 63), j0 = (pp & 1) * 8; const float scl = qk ? 1.0f : 0.125f;
#pragma unroll
              for (int j = 0; j < 8; ++j) { lf2 c = cs[pos * 16 + j0 + j]; if (!lat) c = (lf2){1.f, 0.f}; o1[j] = (x1[j] * c.x - x2[j] * c.y) * scl; o2[j] = (x1[j] * c.y + x2[j] * c.x) * scl; }
              bf16_t* dq = (qk ? KR : QR) + (size_t)(r0 + tok) * 384 + h * 64 + d1; *(uint4*)dq = pack8(o1); *(uint4*)(dq + 16) = pack8(o2); } }
#pragma unroll 1
        for (int ig = 0; ig < 6; ++ig) { lu4 zc[4], zq[4], zn[4]; int ts = threadIdx.x; asm volatile("" : "+v"(ts));
#pragma unroll
            for (int u = 0; u < 4; ++u) { const int idx = ts + NTHR * (ig * 4 + u), tok = idx / 192, pc = idx % 192, t = t0 + tok; const bf16_t* zp = P + (size_t)(r0 + tok) * NINP + C_Z + pc * 8;
                zc[u] = *(const lu4*)zp; zq[u] = t > 0 ? *(const lu4*)(zp - NINP) : (lu4){0u, 0u, 0u, 0u}; zn[u] = t < slen - 1 ? *(const lu4*)(zp + NINP) : (lu4){0u, 0u, 0u, 0u}; }
#pragma unroll
            for (int u = 0; u < 4; ++u) { const int idx = ts + NTHR * (ig * 4 + u), tok = idx / 192, pc = idx % 192, c0 = pc * 8, r = r0 + tok;
                float x[8], pv[8], nx[8], zs[8];
                unpack8(make_uint4(zc[u].x, zc[u].y, zc[u].z, zc[u].w), x); unpack8(make_uint4(zq[u].x, zq[u].y, zq[u].z, zq[u].w), pv); unpack8(make_uint4(zn[u].x, zn[u].y, zn[u].z, zn[u].w), nx);
                const float4 mu0 = *(const float4*)(p.in[20] + l * 1536 + c0), mu1 = *(const float4*)(p.in[20] + l * 1536 + c0 + 4); const float mu[8] = {mu0.x, mu0.y, mu0.z, mu0.w, mu1.x, mu1.y, mu1.z, mu1.w};
#pragma unroll
                for (int j = 0; j < 8; ++j) zs[j] = x[j] + (0.5f * (pv[j] + nx[j]) - x[j]) * mu[j];
                const bool isk = c0 >= 384 && c0 < 768; float kv[8]; float ss = 0.f;
                { const int kc = isk ? c0 - 384 : 0; const float4 k0 = *(const float4*)(p.in[26] + l * 384 + kc), k1 = *(const float4*)(p.in[26] + l * 384 + kc + 4); const float kkw[8] = {k0.x, k0.y, k0.z, k0.w, k1.x, k1.y, k1.z, k1.w};
#pragma unroll
                  for (int j = 0; j < 8; ++j) { kv[j] = zs[j] * kkw[j]; ss += kv[j] * kv[j]; } }
                ss += __shfl_xor(ss, 1); ss += __shfl_xor(ss, 2); ss += __shfl_xor(ss, 4);
                if (c0 < 384) *(uint4*)(RS + (size_t)r * 384 + c0) = pack8(zs);
                else if (c0 < 768) { *(uint4*)(KS + (size_t)r * 384 + c0 - 384) = pack8(zs); const float inv = 1.0f / fmaxf(sqrtf(ss), 1e-12f);
#pragma unroll
                    for (int j = 0; j < 8; ++j) kv[j] *= inv;
                    *(uint4*)(KK + (size_t)r * 384 + c0 - 384) = pack8(kv); }
                else if (c0 < 1152) *(uint4*)(VS + (size_t)r * 384 + c0 - 768) = pack8(zs);
                else { const int ac = c0 - 1152; float o[8];
#pragma unroll
                    for (int j = 0; j < 8; ++j) o[j] = ac < 128 ? 1.0f - 2.0f / (1.0f + __expf(2.0f * zs[j])) : (ac < 256 ? zs[j] : sigm(zs[j]));
                    *(uint4*)(ALR + (size_t)r * 384 + ac) = pack8(o); } }
        }
        __syncthreads();
    }
}

template <int KS, int MODE> __device__ __forceinline__ void lr_wave(const Params& p, int l, int row0, int kofs, const bf16_t* Bt, int d) {
    const int lane = threadIdx.x & 63, m = lane & 15, q = lane >> 4;
    const bf16_t* Ap = (const bf16_t*)(p.ws + U_ALR) + (size_t)(row0 + m) * 384 + kofs + q * 8;
    bf16x8 a[KS];
#pragma unroll
    for (int ks = 0; ks < KS; ++ks) a[ks] = *(const bf16x8*)(Ap + ks * 32);
    bf16_t* O = (bf16_t*)(p.ws + (MODE == 0 ? U_LD + (size_t)d * SZ384 : (MODE == 1 ? U_AG + (size_t)d * SZ384 : U_G))) + (size_t)(row0 + m) * 384;
    const float* bias = MODE == 0 ? p.in[21] + (l * 2 + d) * 384 : p.in[23] + (l * 2 + d) * 384;
    for (int nt = 0; nt < 24; ++nt) {
        f32x4 acc = (f32x4){0.f, 0.f, 0.f, 0.f};
#pragma unroll
        for (int ks = 0; ks < KS; ++ks) { const bf16x8 bfr = *(const bf16x8*)(Bt + (size_t)(nt * 16 + m) * (KS * 32) + ks * 32 + q * 8); acc = mfma16(bfr, a[ks], acc); }
        const int n = nt * 16 + q * 4; float o[4];
        if (MODE == 2) {
#pragma unroll
            for (int j = 0; j < 4; ++j) o[j] = acc[j];
        } else { const float4 bv = *(const float4*)(bias + n); const float bb[4] = {bv.x, bv.y, bv.z, bv.w};
#pragma unroll
            for (int j = 0; j < 4; ++j) { const float s = sigm(bb[j] + acc[j]); o[j] = MODE == 0 ? -0.6065306597f * s : s; } }
        u32x2 w; w.x = pack2(o[0], o[1]); w.y = pack2(o[2], o[3]); *(u32x2*)(O + n) = w;
    }
}
template <int KS, int MODE> __device__ __forceinline__ void lr_block(const Params& p, int l, const bf16_t* Bt, int kofs, int d, int bi, int nb, LAS unsigned char* lds) {
    constexpr int PITCH = KS * 32 + 8;
    LAS bf16_t* sB = (LAS bf16_t*)lds; LAS float* sbias = (LAS float*)(lds + 384 * PITCH * 2);
    const int tid = threadIdx.x, lane = tid & 63, m = lane & 15, q = lane >> 4, wv = tid >> 6;
    const float* bias = MODE == 0 ? p.in[21] + (l * 2 + d) * 384 : p.in[23] + (l * 2 + d) * 384;
    __syncthreads();
    for (int i = tid; i < 384 * KS * 4; i += NTHR) { const int n = i / (KS * 4), pc = i % (KS * 4); *(LAS lu4*)(sB + n * PITCH + pc * 8) = *(const lu4*)(Bt + (size_t)n * (KS * 32) + pc * 8); }
    if (MODE != 2) for (int i = tid; i < 384; i += NTHR) sbias[i] = bias[i];
    __syncthreads();
    bf16_t* Ob = (bf16_t*)(p.ws + (MODE == 0 ? U_LD + (size_t)d * SZ384 : (MODE == 1 ? U_AG + (size_t)d * SZ384 : U_G)));
    for (int rt = bi * 8 + wv; rt < 2304; rt += nb * 8) { const int row0 = rt * 16;
        const bf16_t* Ap = (const bf16_t*)(p.ws + U_ALR) + (size_t)(row0 + m) * 384 + kofs + q * 8;
        bf16x8 a[KS];
#pragma unroll
        for (int ks = 0; ks < KS; ++ks) a[ks] = *(const bf16x8*)(Ap + ks * 32);
        bf16_t* O = Ob + (size_t)(row0 + m) * 384;
#pragma unroll 4
        for (int nt = 0; nt < 24; ++nt) {
            f32x4 acc = (f32x4){0.f, 0.f, 0.f, 0.f};
#pragma unroll
            for (int ks = 0; ks < KS; ++ks) acc = mfma16(*(const LAS bf16x8*)(sB + (nt * 16 + m) * PITCH + ks * 32 + q * 8), a[ks], acc);
            const int n = nt * 16 + q * 4; float o[4];
            if (MODE == 2) {
#pragma unroll
                for (int j = 0; j < 4; ++j) o[j] = acc[j];
            } else { const lf4 bv = *(const LAS lf4*)(sbias + n); const float bb[4] = {bv.x, bv.y, bv.z, bv.w};
#pragma unroll
                for (int j = 0; j < 4; ++j) { const float sg = sigm(bb[j] + acc[j]); o[j] = MODE == 0 ? -0.6065306597f * sg : sg; } }
            u32x2 w; w.x = pack2(o[0], o[1]); w.y = pack2(o[2], o[3]); *(u32x2*)(O + n) = w;
        }
    }
    __syncthreads();
}
__device__ __forceinline__ void lowrank_items(const Params& p, int l, int wid, int nw, LAS unsigned char* lds) {
    const unsigned char* sw = p.ws + WS_SW + (size_t)l * SW_STRIDE; const int G = gridDim.x, bx = blockIdx.x;
    if (G >= 12) {
        const int sh = bx * 6 / G, mm = sh < 4 ? sh : 4; const int lo = (mm * G + 5) / 6, hi = mm < 4 ? ((mm + 1) * G + 5) / 6 : G, bi = bx - lo, nb = hi - lo;
        if (mm < 2) lr_block<2, 0>(p, l, (const bf16_t*)(sw + SW_W2T) + (size_t)mm * 384 * 64, mm * 64, mm, bi, nb, lds);
        else if (mm < 4) lr_block<2, 1>(p, l, (const bf16_t*)(sw + SW_A2T) + (size_t)(mm - 2) * 384 * 64, mm * 64, mm - 2, bi, nb, lds);
        else lr_block<4, 2>(p, l, (const bf16_t*)(sw + SW_G2T), 256, 0, bi, nb, lds);
        return; }
    for (int it = wid; it < 2304 * 5; it += nw) { const int rt = it / 5, m = it % 5, row0 = rt * 16;
        if (m < 2) lr_wave<2, 0>(p, l, row0, m * 64, (const bf16_t*)(sw + SW_W2T) + (size_t)m * 384 * 64, m);
        else if (m < 4) lr_wave<2, 1>(p, l, row0, m * 64, (const bf16_t*)(sw + SW_A2T) + (size_t)(m - 2) * 384 * 64, m - 2);
        else lr_wave<4, 2>(p, l, row0, 256, (const bf16_t*)(sw + SW_G2T), 0); }
}

__device__ __forceinline__ int s5_rowbase(int cr) { const int b = cr / 144, c = cr % 144; return c < 16 ? NLAT + b * 256 + c * 16 : b * 2048 + (c - 16) * 16; }
__device__ __forceinline__ void s5_pass1_items(const Params& p, int l, int wid, int nw) {
    const int lane = threadIdx.x & 63, m = lane & 15, q = lane >> 4;
    const bf16_t* P = (const bf16_t*)(p.ws + U_U16); float* SLOC = (float*)(p.ws + U_SLOC);
    for (int it = wid; it < 144 * 16; it += nw) { const int ct = it >> 4, g = it & 15, cr = ct * 16 + m, rb = s5_rowbase(cr);
        const bf16_t* E = (const bf16_t*)(p.ws + WS_SW + (size_t)l * SW_STRIDE + SW_S5E) + (size_t)g * 256 * 256;
        bf16x8 a[8];
#pragma unroll
        for (int ks = 0; ks < 8; ++ks) a[ks] = *(const bf16x8*)(P + (size_t)(rb + 2 * ks + (q >> 1)) * 256 + g * 16 + (q & 1) * 8);
        float* o = SLOC + ((size_t)cr * 16 + g) * 256 + q * 4;
#pragma unroll 2
        for (int nt = 0; nt < 16; ++nt) { f32x4 acc = (f32x4){0.f, 0.f, 0.f, 0.f}; const bf16_t* ep = E + (size_t)(nt * 16 + m) * 256 + q * 8;
#pragma unroll
            for (int ks = 0; ks < 8; ++ks) acc = mfma16(*(const bf16x8*)(ep + ks * 32), a[ks], acc);
            *(f32x4*)(o + nt * 16) = acc; }
    }
}
__device__ __forceinline__ void s5_carry(const Params& p, int l) {
    const int gid = blockIdx.x * NTHR + threadIdx.x; if (gid >= 32768) return;
    const int pp = gid & 63, d = (gid >> 6) & 1, g = (gid >> 7) & 15, b = gid >> 11;
    const int li = ((l * 2 + d) * 16 + g) * 64 + pp; const float lr = p.in[9][li], lim = p.in[10][li], dt = expf(p.in[11][(l * 2 + d) * 16 + g]);
    const float mag = expf(16.0f * dt * lr); float sn, cn; sincosf(16.0f * dt * lim, &sn, &cn); const float ar = mag * cn, ai = mag * sn;
    const float* SLOC = (const float*)(p.ws + U_SLOC); bf16_t* SP = (bf16_t*)(p.ws + U_SPREV);
    float sr = 0.f, si = 0.f;
#pragma unroll 8
    for (int n = 0; n < 144; ++n) { const int c = d == 0 ? n : (n < 16 ? 15 - n : 159 - n); const size_t idx = ((size_t)(b * 144 + c) * 16 + g) * 256 + d * 128 + pp;
        SP[idx] = f2bf(sr); SP[idx + 64] = f2bf(si);
        const float xr = SLOC[idx], xi = SLOC[idx + 64]; const float nr = ar * sr - ai * si + xr, ni = ar * si + ai * sr + xi; sr = nr; si = ni; }
}
__device__ __forceinline__ void s5_pass2_items(const Params& p, int l, int wid, int nw) {
    const int lane = threadIdx.x & 63, m = lane & 15, q = lane >> 4;
    const bf16_t* P = (const bf16_t*)(p.ws + U_U16); const bf16_t* SP = (const bf16_t*)(p.ws + U_SPREV); bf16_t* YG = (bf16_t*)(p.ws + U_YG);
    for (int it = wid; it < 144 * 16; it += nw) { const int ct = it >> 4, g = it & 15; if (l == 1 && ct % 9 == 0) continue;
        const int cr = ct * 16 + m, rb = s5_rowbase(cr);
        const bf16_t* W2 = (const bf16_t*)(p.ws + WS_SW + (size_t)l * SW_STRIDE + SW_S5W2) + (size_t)g * 256 * 512;
        bf16x8 a[16];
#pragma unroll
        for (int ks = 0; ks < 8; ++ks) a[ks] = *(const bf16x8*)(P + (size_t)(rb + 2 * ks + (q >> 1)) * 256 + g * 16 + (q & 1) * 8);
#pragma unroll
        for (int ks = 8; ks < 16; ++ks) a[ks] = *(const bf16x8*)(SP + ((size_t)cr * 16 + g) * 256 + (ks - 8) * 32 + q * 8);
#pragma unroll 2
        for (int nt = 0; nt < 16; ++nt) { f32x4 acc = (f32x4){0.f, 0.f, 0.f, 0.f}; const bf16_t* wp = W2 + (size_t)(nt * 16 + m) * 512 + q * 8;
#pragma unroll
            for (int ks = 0; ks < 16; ++ks) acc = mfma16(*(const bf16x8*)(wp + ks * 32), a[ks], acc);
            float o[4];
#pragma unroll
            for (int j = 0; j < 4; ++j) { const float x = acc[j]; const float u = 0.7978845608f * (x + 0.044715f * x * x * x); const float th = 1.0f - 2.0f / (1.0f + __expf(2.0f * u)); o[j] = 0.5f * x * (1.0f + th); }
            u32x2 w; w.x = pack2(o[0], o[1]); w.y = pack2(o[2], o[3]); *(u32x2*)(YG + (size_t)(rb + nt) * 256 + g * 16 + q * 4) = w; }
    }
}
__device__ __forceinline__ void s5_glu_items(const Params& p, int l, int wid, int nw) {
    const int lane = threadIdx.x & 63, m = lane & 15, q = lane >> 4;
    const bf16_t* YG = (const bf16_t*)(p.ws + U_YG); bf16_t* YC = (bf16_t*)(p.ws + WS_ABUF);
    const bf16_t* GT = (const bf16_t*)(p.ws + WS_SW + (size_t)l * SW_STRIDE + SW_GLUT);
    const int nrt = (l == 0 ? NROW : NLAT) / 16;
    for (int rt = wid; rt < nrt; rt += nw) { const int row = rt * 16 + m;
        bf16x8 a[8];
#pragma unroll
        for (int ks = 0; ks < 8; ++ks) a[ks] = *(const bf16x8*)(YG + (size_t)row * 256 + ks * 32 + q * 8);
#pragma unroll 2
        for (int nt = 0; nt < 16; ++nt) { f32x4 acc = (f32x4){0.f, 0.f, 0.f, 0.f}; const bf16_t* gp = GT + (size_t)(nt * 16 + m) * 256 + q * 8;
#pragma unroll
            for (int ks = 0; ks < 8; ++ks) acc = mfma16(*(const bf16x8*)(gp + ks * 32), a[ks], acc);
            const int n = nt * 16 + q * 4; const float4 bv = *(const float4*)(p.in[18] + l * 256 + n); const u32x2 yw = *(const u32x2*)(YG + (size_t)row * 256 + n);
            u32x2 w; w.x = pack2(bflo(yw.x) * sigm(acc[0] + bv.x), bfhi(yw.x) * sigm(acc[1] + bv.y)); w.y = pack2(bflo(yw.y) * sigm(acc[2] + bv.z), bfhi(yw.y) * sigm(acc[3] + bv.w));
            *(u32x2*)(YC + (size_t)row * 1024 + n) = w; }
    }
}

template <bool HASLAT> __device__ __forceinline__ void na_unit(const Params& p, const LAS float* rpb_l, int b, int h, int i, int n) {
    const int lane = threadIdx.x & 63, m = lane & 15, q = lane >> 4, kin = 8 * (m >> 2) + (m & 3);
    const bf16_t* QR = (const bf16_t*)(p.ws + U_QR); const bf16_t* KR = (const bf16_t*)(p.ws + U_KR);
    const bf16_t* VTL = (const bf16_t*)(p.ws + U_VT) + (size_t)(b * 6 + h) * 64 * 2048; const bf16_t* VTC = (const bf16_t*)(p.ws + U_VTC) + (size_t)(b * 6 + h) * 64 * 256;
    const int qrow = HASLAT ? b * 2048 + i * 64 + n * 16 + m : NLAT + b * 256 + n * 16 + m;
    bf16x8 qf[2];
#pragma unroll
    for (int ks = 0; ks < 2; ++ks) qf[ks] = *(const bf16x8*)(QR + (size_t)qrow * 384 + h * 64 + ks * 32 + q * 8);
    const int r0 = HASLAT ? min(max(i - 4, 0), 24) : 0, scol = HASLAT ? min(max(n * 16 - 8, 0), 32) : 0;
    f32x4 sl[HASLAT ? 16 : 1], sc[16];
    float mx = -3.0e38f;
    if (HASLAT) { const int qc = n * 16 + m, c0 = min(max(qc - 8, 0), 48); const LAS float* rpb = rpb_l + h * 15 * 31;
#pragma unroll
        for (int t = 0; t < 16; ++t) { const int kr = t >> 1, ch = t & 1; const bf16_t* kp = KR + (size_t)(b * 2048 + (r0 + kr) * 64 + scol + kin + 4 * ch) * 384 + h * 64 + q * 8;
            f32x4 acc = (f32x4){0.f, 0.f, 0.f, 0.f};
#pragma unroll
            for (int ks = 0; ks < 2; ++ks) acc = mfma16(*(const bf16x8*)(kp + ks * 32), qf[ks], acc);
            const int dr = r0 + kr - i + 7;
#pragma unroll
            for (int j = 0; j < 4; ++j) { const int kc = scol + 8 * q + 4 * ch + j; const bool valid = kc >= c0 && kc < c0 + 16; const int dc = min(max(kc - qc + 15, 0), 30);
                const float s = valid ? acc[j] + rpb[dr * 31 + dc] : -1.0e30f; acc[j] = s; mx = fmaxf(mx, s); }
            sl[t] = acc; if ((t & 7) == 7) __builtin_amdgcn_sched_barrier(0); } }
#pragma unroll
    for (int t = 0; t < 16; ++t) { const bf16_t* kp = KR + (size_t)(NLAT + b * 256 + (t >> 1) * 32 + kin + 4 * (t & 1)) * 384 + h * 64 + q * 8;
        f32x4 acc = (f32x4){0.f, 0.f, 0.f, 0.f};
#pragma unroll
        for (int ks = 0; ks < 2; ++ks) acc = mfma16(*(const bf16x8*)(kp + ks * 32), qf[ks], acc);
#pragma unroll
        for (int j = 0; j < 4; ++j) mx = fmaxf(mx, acc[j]);
        sc[t] = acc; }
    mx = fmaxf(mx, __shfl_xor(mx, 16)); mx = fmaxf(mx, __shfl_xor(mx, 32));
    float sum = 0.f;
    f32x4 o[4];
#pragma unroll
    for (int dt = 0; dt < 4; ++dt) o[dt] = (f32x4){0.f, 0.f, 0.f, 0.f};
    if (HASLAT) {
#pragma unroll
        for (int kr = 0; kr < 8; ++kr) { float e[8];
#pragma unroll
            for (int j = 0; j < 4; ++j) { e[j] = __expf(sl[2 * kr][j] - mx); e[4 + j] = __expf(sl[2 * kr + 1][j] - mx); }
#pragma unroll
            for (int j = 0; j < 8; ++j) sum += e[j];
            const uint4 pw = pack8(e); const bf16x8 pf = __builtin_bit_cast(bf16x8, pw);
            const int tok = (r0 + kr) * 64 + scol + q * 8;
#pragma unroll
            for (int dt = 0; dt < 4; ++dt) o[dt] = mfma16(*(const bf16x8*)(VTL + (size_t)(dt * 16 + m) * 2048 + tok), pf, o[dt]);
            if (kr & 1) __builtin_amdgcn_sched_barrier(0); } }
#pragma unroll
    for (int t2 = 0; t2 < 8; ++t2) { float e[8];
#pragma unroll
        for (int j = 0; j < 4; ++j) { e[j] = __expf(sc[2 * t2][j] - mx); e[4 + j] = __expf(sc[2 * t2 + 1][j] - mx); }
#pragma unroll
        for (int j = 0; j < 8; ++j) sum += e[j];
        const uint4 pw = pack8(e); const bf16x8 pf = __builtin_bit_cast(bf16x8, pw);
        const int tok = t2 * 32 + q * 8;
#pragma unroll
        for (int dt = 0; dt < 4; ++dt) o[dt] = mfma16(*(const bf16x8*)(VTC + (size_t)(dt * 16 + m) * 256 + tok), pf, o[dt]);
        if (t2 & 1) __builtin_amdgcn_sched_barrier(0); }
    sum += __shfl_xor(sum, 16); sum += __shfl_xor(sum, 32);
    const float inv = 1.0f / sum;
    bf16_t* yo = (bf16_t*)(p.ws + WS_ABUF) + (size_t)qrow * 1024 + 256 + h * 64 + q * 4;
#pragma unroll
    for (int dt = 0; dt < 4; ++dt) { u32x2 w; w.x = pack2(o[dt][0] * inv, o[dt][1] * inv); w.y = pack2(o[dt][2] * inv, o[dt][3] * inv); *(u32x2*)(yo + dt * 16) = w; }
}
template <bool HASLAT> __device__ __forceinline__ void na_block(const Params& p, int l, int b, int h, int sel, LAS unsigned char* lds) {
    LAS bf16_t* Ks = (LAS bf16_t*)lds;
    LAS bf16_t* Vs = (LAS bf16_t*)lds;
    LAS float* rp = (LAS float*)(lds + 120064);
    const int tid = threadIdx.x, lane = tid & 63, m = lane & 15, q = lane >> 4, w = tid >> 6, kin = 8 * (m >> 2) + (m & 3);
    const bf16_t* QR = (const bf16_t*)(p.ws + U_QR); const bf16_t* KR = (const bf16_t*)(p.ws + U_KR);
    const bf16_t* VTL = (const bf16_t*)(p.ws + U_VT) + (size_t)(b * 6 + h) * 64 * 2048; const bf16_t* VTC = (const bf16_t*)(p.ws + U_VTC) + (size_t)(b * 6 + h) * 64 * 256;
    const int i0 = HASLAT ? 2 * sel : 0, rlo = HASLAT ? min(max(i0 - 4, 0), 24) : 0;
    __syncthreads();
    int tk = threadIdx.x; asm volatile("" : "+v"(tk));
    if (HASLAT) {
#pragma unroll
        for (int j = 0; j < 9; ++j) { const int idx = tk + NTHR * j, key = idx >> 3, pc = idx & 7, tok = rlo * 64 + key;
            if (tok < 2048) *(LAS lu4*)(Ks + key * 72 + pc * 8) = *(const lu4*)(KR + (size_t)(b * 2048 + tok) * 384 + h * 64 + pc * 8); }
        for (int j = tk; j < 465; j += NTHR) rp[j] = p.in[19][(size_t)(l * 6 + h) * 465 + j]; }
#pragma unroll
    for (int j = 0; j < 4; ++j) { const int idx = tk + NTHR * j, key = idx >> 3, pc = idx & 7;
        *(LAS lu4*)(Ks + (576 + key) * 72 + pc * 8) = *(const lu4*)(KR + (size_t)(NLAT + b * 256 + key) * 384 + h * 64 + pc * 8); }
    const int i = HASLAT ? i0 + (w >> 2) : 0, n = HASLAT ? (w & 3) : sel * 8 + w;
    const int qrow = HASLAT ? b * 2048 + i * 64 + n * 16 + m : NLAT + b * 256 + n * 16 + m;
    bf16x8 qf[2];
#pragma unroll
    for (int ks = 0; ks < 2; ++ks) qf[ks] = *(const bf16x8*)(QR + (size_t)qrow * 384 + h * 64 + ks * 32 + q * 8);
    const int r0 = HASLAT ? min(max(i - 4, 0), 24) : 0, scol = HASLAT ? min(max(n * 16 - 8, 0), 32) : 0, kb = (r0 - rlo) * 64 + scol;
    LAS unsigned char* kbl = (LAS unsigned char*)(Ks + (kb + kin) * 72 + q * 8); LAS unsigned char* kbc = (LAS unsigned char*)(Ks + (576 + kin) * 72 + q * 8);
    LAS unsigned char* vb0 = (LAS unsigned char*)(Vs + (0 * 16 + m) * 840 + q * 8); LAS unsigned char* vb1 = (LAS unsigned char*)(Vs + (1 * 16 + m) * 840 + q * 8);
    LAS unsigned char* vb2 = (LAS unsigned char*)(Vs + (2 * 16 + m) * 840 + q * 8); LAS unsigned char* vb3 = (LAS unsigned char*)(Vs + (3 * 16 + m) * 840 + q * 8);
    asm volatile("" : "+v"(kbl), "+v"(kbc), "+v"(vb0), "+v"(vb1), "+v"(vb2), "+v"(vb3));
    __syncthreads();
    float mx1 = -3.0e38f, mx2 = -3.0e38f, sum1 = 0.f, sum2 = 0.f;
    bf16x8 pl[HASLAT ? 8 : 1], pcx[8];
    if (HASLAT) { const int qc = n * 16 + m, c0 = min(max(qc - 8, 0), 48); f32x4 sl[16];
#pragma unroll
        for (int t = 0; t < 16; ++t) { const int kr = t >> 1, ch = t & 1; const LAS bf16_t* kp = (const LAS bf16_t*)(kbl + (kr * 64 + 4 * ch) * 144);
            f32x4 acc = (f32x4){0.f, 0.f, 0.f, 0.f};
#pragma unroll
            for (int ks = 0; ks < 2; ++ks) acc = mfma16(*(const LAS bf16x8*)(kp + ks * 32), qf[ks], acc);
            const int dr = r0 + kr - i + 7;
#pragma unroll
            for (int j = 0; j < 4; ++j) { const int kc = scol + 8 * q + 4 * ch + j; const bool valid = kc >= c0 && kc < c0 + 16; const int dc = min(max(kc - qc + 15, 0), 30);
                const float sv = valid ? acc[j] + rp[dr * 31 + dc] : -1.0e30f; acc[j] = sv; mx1 = fmaxf(mx1, sv); }
            sl[t] = acc; if ((t & 3) == 3) __builtin_amdgcn_sched_barrier(0); }
        mx1 = fmaxf(mx1, __shfl_xor(mx1, 16)); mx1 = fmaxf(mx1, __shfl_xor(mx1, 32));
#pragma unroll
        for (int kr = 0; kr < 8; ++kr) { float e[8];
#pragma unroll
            for (int j = 0; j < 4; ++j) { e[j] = __expf(sl[2 * kr][j] - mx1); e[4 + j] = __expf(sl[2 * kr + 1][j] - mx1); }
#pragma unroll
            for (int j = 0; j < 8; ++j) sum1 += e[j];
            const uint4 pw = pack8(e); pl[kr] = __builtin_bit_cast(bf16x8, pw); }
        __builtin_amdgcn_sched_barrier(0); }
    { f32x4 sc[16];
#pragma unroll
      for (int t = 0; t < 16; ++t) { const LAS bf16_t* kp = (const LAS bf16_t*)(kbc + ((t >> 1) * 32 + 4 * (t & 1)) * 144);
          f32x4 acc = (f32x4){0.f, 0.f, 0.f, 0.f};
#pragma unroll
          for (int ks = 0; ks < 2; ++ks) acc = mfma16(*(const LAS bf16x8*)(kp + ks * 32), qf[ks], acc);
#pragma unroll
          for (int j = 0; j < 4; ++j) mx2 = fmaxf(mx2, acc[j]);
          sc[t] = acc; if ((t & 3) == 3) __builtin_amdgcn_sched_barrier(0); }
      mx2 = fmaxf(mx2, __shfl_xor(mx2, 16)); mx2 = fmaxf(mx2, __shfl_xor(mx2, 32));
#pragma unroll
      for (int t2 = 0; t2 < 8; ++t2) { float e[8];
#pragma unroll
          for (int j = 0; j < 4; ++j) { e[j] = __expf(sc[2 * t2][j] - mx2); e[4 + j] = __expf(sc[2 * t2 + 1][j] - mx2); }
#pragma unroll
          for (int j = 0; j < 8; ++j) sum2 += e[j];
          const uint4 pw = pack8(e); pcx[t2] = __builtin_bit_cast(bf16x8, pw); } }
    sum1 += __shfl_xor(sum1, 16); sum1 += __shfl_xor(sum1, 32); sum2 += __shfl_xor(sum2, 16); sum2 += __shfl_xor(sum2, 32);
    __builtin_amdgcn_sched_barrier(0);
    __syncthreads();
    int tv = threadIdx.x; asm volatile("" : "+v"(tv));
    if (HASLAT) {
#pragma unroll
        for (int j = 0; j < 9; ++j) { const int idx = tv + NTHR * j, dim = idx / 72, pc = idx % 72, tok = rlo * 64 + pc * 8;
            if (tok < 2048) *(LAS lu4*)(Vs + dim * 840 + pc * 8) = *(const lu4*)(VTL + (size_t)dim * 2048 + tok); } }
#pragma unroll
    for (int j = 0; j < 4; ++j) { const int idx = tv + NTHR * j, dim = idx >> 5, pc = idx & 31; *(LAS lu4*)(Vs + dim * 840 + 576 + pc * 8) = *(const lu4*)(VTC + (size_t)dim * 256 + pc * 8); }
    __syncthreads();
    const int kbv = kb * 2;
    f32x4 o1[4], o2[4];
#pragma unroll
    for (int dt = 0; dt < 4; ++dt) { o1[dt] = (f32x4){0.f, 0.f, 0.f, 0.f}; o2[dt] = (f32x4){0.f, 0.f, 0.f, 0.f}; }
    if (HASLAT) {
#pragma unroll
        for (int kr = 0; kr < 8; ++kr) {
#pragma unroll
            for (int dt = 0; dt < 4; ++dt) { LAS unsigned char* vb = dt == 0 ? vb0 : dt == 1 ? vb1 : dt == 2 ? vb2 : vb3; o1[dt] = mfma16(*(const LAS bf16x8*)(vb + kbv + kr * 128), pl[kr], o1[dt]); }
            if (kr & 1) __builtin_amdgcn_sched_barrier(0); } }
#pragma unroll
    for (int t2 = 0; t2 < 8; ++t2) {
#pragma unroll
        for (int dt = 0; dt < 4; ++dt) { LAS unsigned char* vb = dt == 0 ? vb0 : dt == 1 ? vb1 : dt == 2 ? vb2 : vb3; o2[dt] = mfma16(*(const LAS bf16x8*)(vb + 1152 + t2 * 64), pcx[t2], o2[dt]); }
        if (t2 & 1) __builtin_amdgcn_sched_barrier(0); }
    const float mxm = fmaxf(mx1, mx2), a1 = HASLAT ? __expf(mx1 - mxm) : 0.f, a2 = __expf(mx2 - mxm), inv = 1.0f / (a1 * sum1 + a2 * sum2), c1 = a1 * inv, c2 = a2 * inv;
    bf16_t* yo = (bf16_t*)(p.ws + WS_ABUF) + (size_t)qrow * 1024 + 256 + h * 64 + q * 4;
#pragma unroll
    for (int dt = 0; dt < 4; ++dt) { u32x2 wv2; wv2.x = pack2(o1[dt][0] * c1 + o2[dt][0] * c2, o1[dt][1] * c1 + o2[dt][1] * c2); wv2.y = pack2(o1[dt][2] * c1 + o2[dt][2] * c2, o1[dt][3] * c1 + o2[dt][3] * c2); *(u32x2*)(yo + dt * 16) = wv2; }
}
__device__ __forceinline__ void na_items(const Params& p, int l, int wid, int nw, LAS unsigned char* lds) {
    (void)wid; (void)nw;
    const int nlat = 16 * 6 * 16, nctx = (l == 0) ? 16 * 6 * 2 : 0;
    for (int it = blockIdx.x; it < nlat + nctx; it += gridDim.x) {
        if (it < nlat) { const int ip = it & 15, bh = it >> 4; na_block<true>(p, l, bh / 6, bh % 6, ip, lds); }
        else { const int j = it - nlat, half = j & 1, bh = j >> 1; na_block<false>(p, l, bh / 6, bh % 6, half, lds); }
    }
    __syncthreads();
}

typedef float f32x2 __attribute__((ext_vector_type(2)));
__device__ __forceinline__ int rk_row(int b, int d, int n) { return n < 256 ? NLAT + b * 256 + (d ? 255 - n : n) : b * 2048 + (d ? 2047 - (n - 256) : (n - 256)); }
template <int CTRL> __device__ __forceinline__ float dpp_f(float v) { return __builtin_bit_cast(float, __builtin_amdgcn_update_dpp(0, __builtin_bit_cast(int, v), CTRL, 0xF, 0xF, true)); }
constexpr int RKP_PITCH = 72, RKP_MAT = 16 * RKP_PITCH * 2, RKP_WAVE = 5 * RKP_MAT + 4 * 16 * 17 * 4;
__device__ __forceinline__ bf16x8 pack_frag(const float (&lo)[4], const float (&hi)[4]) { u32x4 w; w.x = pack2(lo[0], lo[1]); w.y = pack2(lo[2], lo[3]); w.z = pack2(hi[0], hi[1]); w.w = pack2(hi[2], hi[3]); return __builtin_bit_cast(bf16x8, w); }
__device__ __forceinline__ void rwkv_pre_items(const Params& p, int l, int wid, int nw, LAS unsigned char* lds) {
    const int lane = threadIdx.x & 63, m = lane & 15, q = lane >> 4, wv = threadIdx.x >> 6;
    LAS bf16_t* sAt = (LAS bf16_t*)(lds + wv * RKP_WAVE); LAS bf16_t* sBh = sAt + 16 * RKP_PITCH; LAS bf16_t* sKh = sBh + 16 * RKP_PITCH; LAS bf16_t* sRt = sKh + 16 * RKP_PITCH; LAS bf16_t* sV = sRt + 16 * RKP_PITCH;
    LAS float* sM = (LAS float*)(lds + wv * RKP_WAVE + 5 * RKP_MAT);
    const bf16_t* RS = (const bf16_t*)(p.ws + U_RS); const bf16_t* KS = (const bf16_t*)(p.ws + U_KS); const bf16_t* VS = (const bf16_t*)(p.ws + U_VS); const bf16_t* KK = (const bf16_t*)(p.ws + U_KK);
    for (int it = wid; it < NCHUNK; it += nw) { const int u = it / 144, c = it % 144, b = u / 12, h = (u % 12) >> 1, d = u & 1;
        const bf16_t* AG = (const bf16_t*)(p.ws + U_AG + (size_t)d * SZ384); const bf16_t* LD = (const bf16_t*)(p.ws + U_LD + (size_t)d * SZ384);
        const int rb = rk_row(b, d, c * 16), sgn = d ? -1 : 1;
        { LAS bf16_t* sLd = (LAS bf16_t*)sM;
#pragma unroll
          for (int k = 0; k < 12; ++k) { const int idx = lane + 64 * k, pair = idx >> 3, arr = pair >> 4, t = pair & 15, pc = idx & 7;
              const bf16_t* src = arr == 0 ? KK : arr == 1 ? AG : arr == 2 ? KS : arr == 3 ? RS : arr == 4 ? VS : LD;
              LAS bf16_t* dst = arr == 0 ? sAt : arr == 1 ? sBh : arr == 2 ? sKh : arr == 3 ? sRt : arr == 4 ? sV : sLd;
              *(LAS lu4*)(dst + t * RKP_PITCH + pc * 8) = *(const lu4*)(src + (size_t)(rb + sgn * t) * 384 + h * 64 + pc * 8); }
          const float ka = p.in[27][l * 384 + h * 64 + lane]; float L = 0.f;
#pragma unroll 4
          for (int t = 0; t < 16; ++t) { const int o = t * RKP_PITCH + lane;
              const float r_ = bf2f(sRt[o]), k_ = bf2f(sKh[o]), kk_ = bf2f(sAt[o]), ag_ = bf2f(sBh[o]), ld_ = bf2f(sLd[o]);
              const float e0 = __expf(L); L += ld_; const float e1 = __expf(L), ei = __expf(-L);
              sAt[o] = f2bf(-kk_ * e0); sBh[o] = f2bf(kk_ * ag_ * ei); sKh[o] = f2bf(k_ * (1.0f + (ag_ - 1.0f) * ka) * ei); sRt[o] = f2bf(r_ * e1); }
          ((bf16_t*)(p.ws + CH_GT))[(size_t)it * 64 + lane] = f2bf(L); }
        { bf16x8 atf[2], rtf[2], bhf[2], khf[2];
#pragma unroll
          for (int ks = 0; ks < 2; ++ks) { atf[ks] = *(const LAS bf16x8*)(sAt + m * RKP_PITCH + ks * 32 + q * 8); rtf[ks] = *(const LAS bf16x8*)(sRt + m * RKP_PITCH + ks * 32 + q * 8);
              bhf[ks] = *(const LAS bf16x8*)(sBh + m * RKP_PITCH + ks * 32 + q * 8); khf[ks] = *(const LAS bf16x8*)(sKh + m * RKP_PITCH + ks * 32 + q * 8); }
          f32x4 mab = (f32x4){0.f, 0.f, 0.f, 0.f}, mak = mab, mrb = mab, mrk = mab;
#pragma unroll
          for (int ks = 0; ks < 2; ++ks) { mab = mfma16(atf[ks], bhf[ks], mab); mak = mfma16(atf[ks], khf[ks], mak); mrb = mfma16(rtf[ks], bhf[ks], mrb); mrk = mfma16(rtf[ks], khf[ks], mrk); }
#pragma unroll
          for (int r = 0; r < 4; ++r) { const int t = 4 * q + r; sM[(0 * 16 + t) * 17 + m] = m < t ? mab[r] : 0.f; sM[(1 * 16 + t) * 17 + m] = m < t ? mak[r] : 0.f;
              sM[(2 * 16 + t) * 17 + m] = m <= t ? mrb[r] : 0.f; sM[(3 * 16 + t) * 17 + m] = m <= t ? mrk[r] : 0.f; } }
        { float tv[16];
#pragma unroll
          for (int t = 0; t < 16; ++t) { float acc = (m == t) ? 1.0f : 0.0f;
#pragma unroll
              for (int s2 = 0; s2 < t; ++s2) acc += sM[t * 17 + s2] * tv[s2];
              tv[t] = acc; }
#pragma unroll
          for (int t = 0; t < 16; ++t) if (q == 0) sM[t * 17 + m] = tv[t]; }
        bf16x8 tinvf, mrbf;
        { float lo[4], hi[4] = {0.f, 0.f, 0.f, 0.f};
#pragma unroll
          for (int j = 0; j < 4; ++j) lo[j] = sM[(0 * 16 + m) * 17 + 4 * q + j];
          tinvf = pack_frag(lo, hi);
#pragma unroll
          for (int j = 0; j < 4; ++j) lo[j] = sM[(2 * 16 + m) * 17 + 4 * q + j];
          mrbf = pack_frag(lo, hi);
#pragma unroll
          for (int j = 0; j < 4; ++j) hi[j] = sM[(3 * 16 + m) * 17 + 4 * q + j];
          *(bf16x8*)((bf16_t*)(p.ws + CH_MM) + ((size_t)it * 64 + lane) * 8) = pack_frag(lo, hi); }
        { bf16x8 makf; { float lo[4], hi[4];
#pragma unroll
            for (int j = 0; j < 4; ++j) { lo[j] = q < 2 ? sM[(1 * 16 + m) * 17 + 8 * q + j] : 0.f; hi[j] = q < 2 ? sM[(1 * 16 + m) * 17 + 8 * q + 4 + j] : 0.f; }
            makf = pack_frag(lo, hi); }
#pragma unroll
          for (int itile = 0; itile < 4; ++itile) { unsigned vw[4];
#pragma unroll
              for (int j = 0; j < 4; ++j) vw[j] = q < 2 ? ((unsigned)sV[(8 * q + 2 * j) * RKP_PITCH + 16 * itile + m] | ((unsigned)sV[(8 * q + 2 * j + 1) * RKP_PITCH + 16 * itile + m] << 16)) : 0u;
              const u32x4 vq = {vw[0], vw[1], vw[2], vw[3]};
              const f32x4 w1 = mfma16(makf, __builtin_bit_cast(bf16x8, vq), (f32x4){0.f, 0.f, 0.f, 0.f});
              const float lo[4] = {w1[0], w1[1], w1[2], w1[3]}, hi[4] = {0.f, 0.f, 0.f, 0.f};
              const f32x4 uu = mfma16(tinvf, pack_frag(lo, hi), (f32x4){0.f, 0.f, 0.f, 0.f});
              u32x2 o; o.x = pack2(uu[0], uu[1]); o.y = pack2(uu[2], uu[3]);
              *(u32x2*)((bf16_t*)(p.ws + CH_UL) + (((size_t)it * 4 + itile) * 64 + lane) * 4) = o; } }
        f32x4 ap[4], rp[4];
#pragma unroll
        for (int jt = 0; jt < 4; ++jt) { float lo[4], hi[4] = {0.f, 0.f, 0.f, 0.f};
#pragma unroll
            for (int j = 0; j < 4; ++j) lo[j] = bf2f(sAt[(4 * q + j) * RKP_PITCH + 16 * jt + m]);
            ap[jt] = mfma16(tinvf, pack_frag(lo, hi), (f32x4){0.f, 0.f, 0.f, 0.f});
            const float al[4] = {ap[jt][0], ap[jt][1], ap[jt][2], ap[jt][3]};
            f32x4 rr = mfma16(mrbf, pack_frag(al, hi), (f32x4){0.f, 0.f, 0.f, 0.f});
#pragma unroll
            for (int r = 0; r < 4; ++r) rr[r] += bf2f(sRt[(4 * q + r) * RKP_PITCH + 16 * jt + m]);
            rp[jt] = rr;
            float bl[4], kl[4];
#pragma unroll
            for (int j = 0; j < 4; ++j) { bl[j] = bf2f(sBh[(4 * q + j) * RKP_PITCH + 16 * jt + m]); kl[j] = bf2f(sKh[(4 * q + j) * RKP_PITCH + 16 * jt + m]); }
            *(bf16x8*)((bf16_t*)(p.ws + CH_BK) + (((size_t)it * 4 + jt) * 64 + lane) * 8) = pack_frag(bl, kl); }
#pragma unroll
        for (int jt = 0; jt < 4; ++jt)
#pragma unroll
            for (int r = 0; r < 4; ++r) { sAt[(4 * q + r) * RKP_PITCH + 16 * jt + m] = f2bf(ap[jt][r]); sRt[(4 * q + r) * RKP_PITCH + 16 * jt + m] = f2bf(rp[jt][r]); }
#pragma unroll
        for (int x = 0; x < 2; ++x)
#pragma unroll
            for (int ks = 0; ks < 2; ++ks) { const LAS bf16_t* src = (x ? sRt : sAt) + m * RKP_PITCH + 32 * ks + 4 * q;
                const u32x2 a0 = *(const LAS u32x2*)src, a1 = *(const LAS u32x2*)(src + 16); const u32x4 w = {a0.x, a0.y, a1.x, a1.y};
                *(u32x4*)((bf16_t*)(p.ws + CH_XP) + ((((size_t)it * 2 + x) * 2 + ks) * 64 + lane) * 8) = w; }
    }
}
__device__ __forceinline__ void rwkv_seq_task(const Params& p, int l, int task, LAS unsigned char* lds) {
    const int lane = threadIdx.x & 63, m = lane & 15, q = lane >> 4;
    const int u = task >> 2, iw = task & 3, b = u / 12, h = (u % 12) >> 1, d = u & 1, sgn = d ? -1 : 1;
    const bf16_t* XP = (const bf16_t*)(p.ws + CH_XP); const bf16_t* BK = (const bf16_t*)(p.ws + CH_BK); const bf16_t* UL = (const bf16_t*)(p.ws + CH_UL); const bf16_t* MM = (const bf16_t*)(p.ws + CH_MM);
    const bf16_t* GT = (const bf16_t*)(p.ws + CH_GT); const bf16_t* VS = (const bf16_t*)(p.ws + U_VS) + h * 64 + 16 * iw;
    float* Yw = (float*)(p.ws + U_YRK) + (size_t)d * NROW * 384 + h * 64 + 16 * iw;
    LAS float* ybuf = (LAS float*)(lds + (threadIdx.x >> 6) * 12288);
    const int rc0 = NLAT + b * 256 + (d ? 255 : 0) + sgn * 4 * q, rdel = (b * 2048 + (d ? 2047 : 0)) - (NLAT + b * 256 + (d ? 255 : 0)) - sgn * 256;
    f32x4 acc[4];
#pragma unroll
    for (int jt = 0; jt < 4; ++jt) acc[jt] = (f32x4){0.f, 0.f, 0.f, 0.f};
    const unsigned vo16 = (unsigned)lane * 16u, vo8 = (unsigned)lane * 8u, vo8q = (unsigned)q * 8u;
    struct OpSet { u32x4 apf0, apf1, rpf0, rpf1, bkf0, bkf1, bkf2, bkf3, mmf; u32x2 gl0, gl1, gl2, gl3, uw; unsigned vr0, vr1, vr2, vr3; };
#define GLDS16(dst, voff, sbase, imm) asm volatile("global_load_dwordx4 %0, %1, %2 offset:" #imm : "=&v"(dst) : "v"(voff), "s"(sbase) : "memory")
#define GLDS8(dst, voff, sbase, imm) asm volatile("global_load_dwordx2 %0, %1, %2 offset:" #imm : "=&v"(dst) : "v"(voff), "s"(sbase) : "memory")
#define GLDS2(dst, voff, sbase) asm volatile("global_load_ushort %0, %1, %2" : "=&v"(dst) : "v"(voff), "s"(sbase) : "memory")
#define RKS_LOAD(X, c_) do { const size_t it_ = (size_t)u * 144 + (c_); const int rb_ = rc0 + sgn * 16 * (c_) + (int)((c_) >= 16) * rdel; \
        const bf16_t* xpb = XP + it_ * 2048; const bf16_t* bkb = BK + it_ * 2048; const bf16_t* mmb = MM + it_ * 512; const bf16_t* gtb = GT + it_ * 64; const bf16_t* ulb = UL + (it_ * 4 + iw) * 256; \
        GLDS16(X.apf0, vo16, xpb, 0); GLDS16(X.apf1, vo16, xpb, 1024); GLDS16(X.rpf0, vo16, xpb, 2048); GLDS16(X.rpf1, vo16, xpb, 3072); \
        GLDS16(X.bkf0, vo16, bkb, 0); GLDS16(X.bkf1, vo16, bkb, 1024); GLDS16(X.bkf2, vo16, bkb, 2048); GLDS16(X.bkf3, vo16, bkb, 3072); \
        GLDS8(X.gl0, vo8q, gtb, 0); GLDS8(X.gl1, vo8q, gtb, 32); GLDS8(X.gl2, vo8q, gtb, 64); GLDS8(X.gl3, vo8q, gtb, 96); \
        GLDS16(X.mmf, vo16, mmb, 0); GLDS8(X.uw, vo8, ulb, 0); \
        { const unsigned v0_ = (unsigned)(rb_) * 768u + 2u * m, v1_ = (unsigned)(rb_ + sgn) * 768u + 2u * m, v2_ = (unsigned)(rb_ + 2 * sgn) * 768u + 2u * m, v3_ = (unsigned)(rb_ + 3 * sgn) * 768u + 2u * m; \
          GLDS2(X.vr0, v0_, VS); GLDS2(X.vr1, v1_, VS); GLDS2(X.vr2, v2_, VS); GLDS2(X.vr3, v3_, VS); } } while (0)
#define RKS_WAIT(X) asm volatile("s_waitcnt vmcnt(36)" : "+v"(X.apf0), "+v"(X.apf1), "+v"(X.rpf0), "+v"(X.rpf1), "+v"(X.bkf0), "+v"(X.bkf1), "+v"(X.bkf2), "+v"(X.bkf3), "+v"(X.mmf), \
        "+v"(X.gl0), "+v"(X.gl1), "+v"(X.gl2), "+v"(X.gl3), "+v"(X.uw), "+v"(X.vr0), "+v"(X.vr1), "+v"(X.vr2), "+v"(X.vr3) :: "memory")
#define BF8(x) __builtin_bit_cast(bf16x8, x)
#define RKS_COMPUTE(X, c_) do { RKS_WAIT(X); \
        const float ul[4] = {bflo(X.uw.x), bfhi(X.uw.x), bflo(X.uw.y), bfhi(X.uw.y)}; const float vl[4] = {bflo(X.vr0), bflo(X.vr1), bflo(X.vr2), bflo(X.vr3)}; \
        f32x4 zp = (f32x4){0.f, 0.f, 0.f, 0.f}, yp = zp; \
        { const float lo[4] = {acc[0][0], acc[0][1], acc[0][2], acc[0][3]}, hi[4] = {acc[1][0], acc[1][1], acc[1][2], acc[1][3]}; const bf16x8 sf = pack_frag(lo, hi); zp = mfma16(BF8(X.apf0), sf, zp); yp = mfma16(BF8(X.rpf0), sf, yp); } \
        { const float lo[4] = {acc[2][0], acc[2][1], acc[2][2], acc[2][3]}, hi[4] = {acc[3][0], acc[3][1], acc[3][2], acc[3][3]}; const bf16x8 sf = pack_frag(lo, hi); zp = mfma16(BF8(X.apf1), sf, zp); yp = mfma16(BF8(X.rpf1), sf, yp); } \
        const float z[4] = {zp[0] + ul[0], zp[1] + ul[1], zp[2] + ul[2], zp[3] + ul[3]}; \
        yp = mfma16(BF8(X.mmf), pack_frag(ul, vl), yp); \
        const bf16x8 zvf = pack_frag(z, vl); \
        acc[0] = mfma16(BF8(X.bkf0), zvf, acc[0]); acc[1] = mfma16(BF8(X.bkf1), zvf, acc[1]); acc[2] = mfma16(BF8(X.bkf2), zvf, acc[2]); acc[3] = mfma16(BF8(X.bkf3), zvf, acc[3]); \
        { const f32x4 g4 = {__expf(bflo(X.gl0.x)), __expf(bfhi(X.gl0.x)), __expf(bflo(X.gl0.y)), __expf(bfhi(X.gl0.y))}; acc[0] *= g4; } \
        { const f32x4 g4 = {__expf(bflo(X.gl1.x)), __expf(bfhi(X.gl1.x)), __expf(bflo(X.gl1.y)), __expf(bfhi(X.gl1.y))}; acc[1] *= g4; } \
        { const f32x4 g4 = {__expf(bflo(X.gl2.x)), __expf(bfhi(X.gl2.x)), __expf(bflo(X.gl2.y)), __expf(bfhi(X.gl2.y))}; acc[2] *= g4; } \
        { const f32x4 g4 = {__expf(bflo(X.gl3.x)), __expf(bfhi(X.gl3.x)), __expf(bflo(X.gl3.y)), __expf(bfhi(X.gl3.y))}; acc[3] *= g4; } \
        _Pragma("unroll") for (int r = 0; r < 4; ++r) ybuf[((((c_) % 12) * 16) + 4 * q + r) * 16 + m] = yp[r]; } while (0)
    asm volatile("; SEQ_BEGIN");
    OpSet A, B, C;
    RKS_LOAD(A, 0); RKS_LOAD(B, 1);
    for (int c0 = 0; c0 < 144; c0 += 12) {
#pragma unroll
        for (int cc = 0; cc < 12; cc += 3) { const int c = c0 + cc;
            RKS_LOAD(C, c + 2); __builtin_amdgcn_sched_barrier(0);
            RKS_COMPUTE(A, c); __builtin_amdgcn_sched_barrier(0);
            { const int cn = c + 3 < 144 ? c + 3 : 143; RKS_LOAD(A, cn); } __builtin_amdgcn_sched_barrier(0);
            RKS_COMPUTE(B, c + 1); __builtin_amdgcn_sched_barrier(0);
            { const int cn = c + 4 < 144 ? c + 4 : 143; RKS_LOAD(B, cn); } __builtin_amdgcn_sched_barrier(0);
            RKS_COMPUTE(C, c + 2); __builtin_amdgcn_sched_barrier(0); }
#pragma unroll
        for (int k = 0; k < 12; ++k) { const int rr = (lane >> 2) + 16 * k, n = c0 * 16 + rr; const int grow = (rc0 - sgn * 4 * q) + sgn * n + (int)(n >= 256) * rdel;
            *(f32x4*)(Yw + (size_t)grow * 384 + (lane & 3) * 4) = *(const LAS f32x4*)(ybuf + rr * 16 + (lane & 3) * 4); }
    }
    asm volatile("; SEQ_END");
#undef RKS_LOAD
#undef RKS_COMPUTE
#undef RKS_WAIT
#undef GLDS16
#undef GLDS8
#undef GLDS2
#undef BF8
}

__device__ __forceinline__ void rwkv_finish(const Params& p, int l) {
    const int sub = threadIdx.x & 7; const int npair = (l == 0 ? NROW : NLAT) * 6;
    const bf16_t* RS = (const bf16_t*)(p.ws + U_RS); const bf16_t* KS = (const bf16_t*)(p.ws + U_KS); const bf16_t* VS = (const bf16_t*)(p.ws + U_VS);
    const bf16_t* AG0 = (const bf16_t*)(p.ws + U_AG); const bf16_t* AG1 = (const bf16_t*)(p.ws + U_AG + SZ384); const bf16_t* G = (const bf16_t*)(p.ws + U_G);
    const float* Y0 = (const float*)(p.ws + U_YRK); const float* Y1 = Y0 + (size_t)NROW * 384; bf16_t* YC = (bf16_t*)(p.ws + WS_ABUF);
    for (int pr = (blockIdx.x * NTHR + threadIdx.x) >> 3; pr < npair; pr += (gridDim.x * NTHR) >> 3) { const int row = pr / 6, h = pr % 6, col = h * 64 + sub * 8; const size_t o = (size_t)row * 384 + col;
        float y[8]; { const float4 a0 = *(const float4*)(Y0 + o), a1 = *(const float4*)(Y0 + o + 4), c0 = *(const float4*)(Y1 + o), c1 = *(const float4*)(Y1 + o + 4);
            y[0] = a0.x + c0.x; y[1] = a0.y + c0.y; y[2] = a0.z + c0.z; y[3] = a0.w + c0.w; y[4] = a1.x + c1.x; y[5] = a1.y + c1.y; y[6] = a1.z + c1.z; y[7] = a1.w + c1.w; }
        float s = 0.f;
#pragma unroll
        for (int k = 0; k < 8; ++k) s += y[k];
        s += __shfl_xor(s, 1); s += __shfl_xor(s, 2); s += __shfl_xor(s, 4); const float mean = s * (1.0f / 64.0f);
        float v2 = 0.f;
#pragma unroll
        for (int k = 0; k < 8; ++k) { const float dd = y[k] - mean; v2 += dd * dd; }
        v2 += __shfl_xor(v2, 1); v2 += __shfl_xor(v2, 2); v2 += __shfl_xor(v2, 4); const float rstd = rsqrtf(v2 * (1.0f / 64.0f) + 64e-5f);
        float r[8], kx[8], vx[8], a0[8], a1[8], gx[8];
        unpack8(*(const uint4*)(RS + o), r); unpack8(*(const uint4*)(KS + o), kx); unpack8(*(const uint4*)(VS + o), vx); unpack8(*(const uint4*)(AG0 + o), a0); unpack8(*(const uint4*)(AG1 + o), a1); unpack8(*(const uint4*)(G + o), gx);
        const float* ka = p.in[27] + l * 384 + col; const float* rk = p.in[28] + l * 384 + col; const float* lw = p.in[29] + l * 384 + col; const float* lb = p.in[30] + l * 384 + col;
        float bs = 0.f;
#pragma unroll
        for (int k = 0; k < 8; ++k) { const float kd0 = kx[k] * (1.0f + (a0[k] - 1.0f) * ka[k]), kd1 = kx[k] * (1.0f + (a1[k] - 1.0f) * ka[k]); bs += r[k] * (kd0 + kd1) * rk[k]; }
        bs += __shfl_xor(bs, 1); bs += __shfl_xor(bs, 2); bs += __shfl_xor(bs, 4);
        float ov[8];
#pragma unroll
        for (int k = 0; k < 8; ++k) ov[k] = ((y[k] - mean) * rstd * lw[k] + lb[k] + bs * vx[k]) * gx[k];
        *(uint4*)(YC + (size_t)row * 1024 + 640 + col) = pack8(ov);
    }
}

__device__ __forceinline__ void phase_normrouter(const Params& p, int l, const float* xl, const float* xc, LAS unsigned char* lds) {
    LAS float* hrow = (LAS float*)lds;
    LAS float* part = (LAS float*)(lds + 32768);
    const int lane = threadIdx.x & 63, wv = threadIdx.x >> 6, e = lane & 15, cq = lane >> 4; const int ngrp = (l == 0 ? NROW : NLAT) / 8;
    const float* mod = (const float*)(p.ws + WS_MOD) + (size_t)l * 17 * 6144; const float* g1 = p.in[6] + (l * 4 + 1) * 1024; const float* g2 = p.in[6] + (l * 4 + 2) * 1024;
    const bf16_t* Y = (const bf16_t*)(p.ws + U_Y); unsigned char* A8 = p.ws + WS_ABUF; float* AFF = (float*)(p.ws + WS_AFF);
    float wr[32];
#pragma unroll
    for (int j = 0; j < 32; ++j) wr[j] = p.in[31][((size_t)l * 1024 + 128 * wv + 32 * cq + j) * 16 + e];
    for (int gi = blockIdx.x; gi < ngrp; gi += gridDim.x) { const int r = gi * 8 + wv; const int b = r < NLAT ? (r >> 11) : 16; const float* mb = mod + (size_t)b * 6144;
        const float* xs = xrow(xl, xc, r); float* xd = xrow_w(p.out, (float*)(p.ws + WS_CTXA), r);
        float4 y[4], x[4]; float ss = 0.f;
#pragma unroll
        for (int i = 0; i < 4; ++i) { { const u32x2 yw = *(const u32x2*)(Y + (size_t)r * 1024 + i * 256 + lane * 4); y[i] = make_float4(bflo(yw.x), bfhi(yw.x), bflo(yw.y), bfhi(yw.y)); } x[i] = *(const float4*)(xs + i * 256 + lane * 4); ss += y[i].x * y[i].x + y[i].y * y[i].y + y[i].z * y[i].z + y[i].w * y[i].w; }
        ss = wave_sum(ss); const float rs = rsqrtf(ss * (1.0f / 1024.0f) + 1e-6f);
        float s2 = 0.f;
#pragma unroll
        for (int i = 0; i < 4; ++i) { const int c = i * 256 + lane * 4; const float4 gg = *(const float4*)(g1 + c), gt = *(const float4*)(mb + 2048 + c);
            x[i].x += gt.x * (y[i].x * rs * gg.x); x[i].y += gt.y * (y[i].y * rs * gg.y); x[i].z += gt.z * (y[i].z * rs * gg.z); x[i].w += gt.w * (y[i].w * rs * gg.w);
            *(float4*)(xd + c) = x[i]; s2 += x[i].x * x[i].x + x[i].y * x[i].y + x[i].z * x[i].z + x[i].w * x[i].w; }
        s2 = wave_sum(s2); const float rs2 = rsqrtf(s2 * (1.0f / 1024.0f) + 1e-6f);
        float hv[4][4]; float amax = 0.f;
        __syncthreads();
#pragma unroll
        for (int i = 0; i < 4; ++i) { const int c = i * 256 + lane * 4; const float4 gg = *(const float4*)(g2 + c), sh = *(const float4*)(mb + 3072 + c), sc = *(const float4*)(mb + 4096 + c);
            hv[i][0] = x[i].x * rs2 * gg.x * (1.f + sc.x) + sh.x; hv[i][1] = x[i].y * rs2 * gg.y * (1.f + sc.y) + sh.y; hv[i][2] = x[i].z * rs2 * gg.z * (1.f + sc.z) + sh.z; hv[i][3] = x[i].w * rs2 * gg.w * (1.f + sc.w) + sh.w;
            *(LAS lf4*)(hrow + wv * 1024 + c) = (lf4){hv[i][0], hv[i][1], hv[i][2], hv[i][3]};
            amax = fmaxf(amax, fmaxf(fmaxf(fabsf(hv[i][0]), fabsf(hv[i][1])), fmaxf(fabsf(hv[i][2]), fabsf(hv[i][3])))); }
#pragma unroll
        for (int o = 32; o >= 1; o >>= 1) amax = fmaxf(amax, __shfl_xor(amax, o));
        amax = fmaxf(amax, 1e-20f); const float qs = 127.0f / amax;
        if (lane == 0) ((float*)(p.ws + WS_SX))[r] = amax * (1.0f / 127.0f);
#pragma unroll
        for (int i = 0; i < 4; ++i) { unsigned w = 0u;
#pragma unroll
            for (int k = 0; k < 4; ++k) w |= ((unsigned)__float2int_rn(hv[i][k] * qs) & 255u) << (8 * k);
            *(unsigned*)(A8 + (size_t)r * 1024 + i * 256 + lane * 4) = w; }
        __syncthreads();
#pragma unroll 2
        for (int rr = 0; rr < 8; ++rr) { const LAS float* hp = hrow + rr * 1024 + 128 * wv + 32 * cq; float acc = 0.f;
#pragma unroll
            for (int j4 = 0; j4 < 8; ++j4) { const lf4 h4 = *(const LAS lf4*)(hp + 4 * j4); acc += h4.x * wr[4 * j4] + h4.y * wr[4 * j4 + 1] + h4.z * wr[4 * j4 + 2] + h4.w * wr[4 * j4 + 3]; }
            acc += __shfl_xor(acc, 16); acc += __shfl_xor(acc, 32);
            if (cq == 0) part[(rr * 8 + wv) * 16 + e] = acc; }
        __syncthreads();
        if (lane < 16) { float lgt = 0.f;
#pragma unroll
            for (int w = 0; w < 8; ++w) lgt += part[(wv * 8 + w) * 16 + lane];
            float mxl = lgt;
#pragma unroll
            for (int o = 8; o >= 1; o >>= 1) mxl = fmaxf(mxl, __shfl_xor(mxl, o));
            const float ex = expf(lgt - mxl); float den = ex;
#pragma unroll
            for (int o = 8; o >= 1; o >>= 1) den += __shfl_xor(den, o);
            AFF[(size_t)r * 16 + lane] = ex / den; }
    }
}

__device__ __forceinline__ void phase_topk(const Params& p, int l, LAS unsigned char* lds) {
    LAS unsigned* keys = (LAS unsigned*)lds;
    LAS int* toks = (LAS int*)(lds + 8192);
    LAS unsigned* hist = (LAS unsigned*)(lds + 9216);
    LAS unsigned* wtot = (LAS unsigned*)(lds + 10240);
    LAS unsigned* sel = (LAS unsigned*)(lds + 10304);
    const int tid = threadIdx.x, lane = tid & 63, wv = tid >> 6, nitem = l == 0 ? 512 : 256;
    const float* AFF = (const float*)(p.ws + WS_AFF); int* SLOT = (int*)(p.ws + WS_SLOT); float* SELG = (float*)(p.ws + WS_SELG);
    const bf16_t* A = (const bf16_t*)(p.ws + WS_ABUF); bf16_t* XS = (bf16_t*)(p.ws + U_XSEL);
    for (int it = blockIdx.x; it < nitem; it += gridDim.x) { const bool lat = it < 256; const int be = it & 255, b = be >> 4, e = be & 15;
        const int n = lat ? SEQ : CTXL, cap = lat ? 256 : 32, rowbase = lat ? b * 2048 : NLAT + b * 256, xoff = lat ? b * 256 : 4096 + b * 32;
        const int per = n / NTHR > 0 ? n / NTHR : 1;
        const int t0 = tid * per; const bool act = t0 < n;
        unsigned kx[4];
        __syncthreads();
#pragma unroll
        for (int j = 0; j < 4; ++j) { kx[j] = 0u; if (act && j < per) { kx[j] = __float_as_uint(AFF[(size_t)(rowbase + t0 + j) * 16 + e]); keys[t0 + j] = kx[j]; } }
        unsigned prefix = 0u; int krem = cap;
        for (int pass = 0; pass < 4; ++pass) { const int shift = 24 - 8 * pass;
            if (tid < 256) hist[tid] = 0u;
            __syncthreads();
#pragma unroll
            for (int j = 0; j < 4; ++j) if (act && j < per) { const bool match = pass == 0 || (kx[j] >> (shift + 8)) == (prefix >> (shift + 8)); if (match) atomicAdd((unsigned*)&hist[(kx[j] >> shift) & 255u], 1u); }
            __syncthreads();
            if (tid < 256) { unsigned above = 0u; for (int bb = tid + 1; bb < 256; ++bb) above += hist[bb]; const unsigned mine = hist[tid];
                if (above < (unsigned)krem && above + mine >= (unsigned)krem) { sel[0] = (unsigned)tid; sel[1] = (unsigned)krem - above; } }
            __syncthreads();
            prefix |= sel[0] << shift; krem = (int)sel[1];
            __syncthreads();
        }
        unsigned loc = 0u, pre[4];
#pragma unroll
        for (int j = 0; j < 4; ++j) { pre[j] = loc; if (act && j < per) loc += (kx[j] > prefix ? 1u : 0u) + (kx[j] == prefix ? 65536u : 0u); }
        unsigned inc = loc;
#pragma unroll
        for (int o = 1; o < 64; o <<= 1) { const unsigned t = __shfl_up(inc, o); if (lane >= o) inc += t; }
        if (lane == 63) wtot[wv] = inc;
        __syncthreads();
        unsigned base = inc - loc;
        for (int w = 0; w < wv; ++w) base += wtot[w];
#pragma unroll
        for (int j = 0; j < 4; ++j) if (act && j < per) { const unsigned c = base + pre[j]; const int gtb = (int)(c & 0xffffu), eqb = (int)(c >> 16);
            const bool s = kx[j] > prefix || (kx[j] == prefix && eqb < krem); const int slot = gtb + (eqb < krem ? eqb : krem);
            if (s) { SELG[e * XROWS + xoff + slot] = __uint_as_float(kx[j]); toks[slot] = t0 + j; }
            SLOT[(size_t)(rowbase + t0 + j) * 16 + e] = s ? slot : -1; }
        __syncthreads();
        for (int s = wv; s < cap; s += 8) { const int row = rowbase + toks[s]; const lu4* src = (const lu4*)((const unsigned char*)A + (size_t)row * 1024); lu4* dst = (lu4*)((unsigned char*)XS + ((size_t)e * XROWS + xoff + s) * 1024);
            dst[lane] = src[lane]; if (lane == 0) ((float*)(p.ws + WS_SXS))[e * XROWS + xoff + s] = ((const float*)(p.ws + WS_SX))[row]; }
    }
}

struct GroupedOrder { int nMl, nNl, G, c, total;
    __device__ void init(int nMl_, int nNl_, int, int G_, int c_) { nMl = nMl_; nNl = nNl_; G = G_; c = c_; total = 16 * nMl_ * nNl_; }
    __device__ bool next(int i, pg8::Unit& u) const {
        int L;
        if ((G & 7) == 0 && (total & 7) == 0) { const int W = G >> 3, x = c & 7, r = c >> 3, t8 = total >> 3, k = i * W + r; if (k >= t8) return false; L = x * t8 + k; }
        else { const long LL = (long)i * G + c; if (LL >= total) return false; L = (int)LL; }
        const int per = nMl * nNl, e = L / per; int idx = L % per;
        const int mg = idx / (8 * nNl) < nMl / 8 ? idx / (8 * nNl) : nMl / 8, gm = (mg + 1) * 8 <= nMl ? 8 : nMl - mg * 8; idx -= mg * 8 * nNl;
        const int ng = idx / (gm * 4) < nNl / 4 ? idx / (gm * 4) : nNl / 4, gn = (ng + 1) * 4 <= nNl ? 4 : nNl - ng * 4; idx -= ng * gm * 4;
        u.pm = e * 18 + mg * 8 + idx / gn; u.pn = e * nNl + ng * 4 + idx % gn; return true; }
    __device__ __forceinline__ void a_ready(const pg8::Unit&) const {}
    __device__ __forceinline__ void done(const pg8::Unit&) const {}
};
struct EpiSwiGLU { static constexpr bool PERM = true, AFTER_DRAIN = false; unsigned char* H; const float* sx; const float* sw;
    __device__ __forceinline__ void operator()(const f32x4 (&acc)[2][2][4][2], const pg8::Unit& u, int wr, int wc, int fr, int fq) const {
        typedef int i32x4_ __attribute__((ext_vector_type(4)));
        const int e = u.pn / 22, pnl = u.pn - e * 22; const int row0 = u.pm * 256 + wr * 64 + fr, col0 = pnl * 128 + wc * 32 + 8 * fq;
        const float* swp = sw + (size_t)u.pn * 256 + wc * 32 + 8 * fq; const float4 g0 = *(const float4*)swp, g1 = *(const float4*)(swp + 4), u0 = *(const float4*)(swp + 128), u1 = *(const float4*)(swp + 132);
        const float swg[8] = {g0.x, g0.y, g0.z, g0.w, g1.x, g1.y, g1.z, g1.w}, swu[8] = {u0.x, u0.y, u0.z, u0.w, u1.x, u1.y, u1.z, u1.w};
#pragma unroll
        for (int ai = 0; ai < 2; ++ai)
#pragma unroll
            for (int m = 0; m < 4; ++m) { const int r = row0 + ai * 128 + m * 16; const float sr = sx[r]; unsigned char* rowp = H + (size_t)r * DE + col0; float o[8];
#pragma unroll
                for (int n = 0; n < 2; ++n) { const i32x4_ ig = __builtin_bit_cast(i32x4_, acc[ai][0][m][n]), iu = __builtin_bit_cast(i32x4_, acc[ai][1][m][n]);
#pragma unroll
                    for (int j = 0; j < 4; ++j) { const float g = (float)ig[j] * (sr * swg[n * 4 + j]), uu = (float)iu[j] * (sr * swu[n * 4 + j]); o[n * 4 + j] = g * sigm(g) * uu; } }
                u32x2 w8; { int t0 = 0, t1 = 0; t0 = __builtin_amdgcn_cvt_pk_fp8_f32(o[0], o[1], t0, false); t0 = __builtin_amdgcn_cvt_pk_fp8_f32(o[2], o[3], t0, true); t1 = __builtin_amdgcn_cvt_pk_fp8_f32(o[4], o[5], t1, false); t1 = __builtin_amdgcn_cvt_pk_fp8_f32(o[6], o[7], t1, true); w8.x = (unsigned)t0; w8.y = (unsigned)t1; }
                *(u32x2*)rowp = w8; }
    }
};
struct EpiScaleBf16 { static constexpr bool PERM = true, AFTER_DRAIN = false; bf16_t* O; int ldc; const float* sx; const float* sw;
    __device__ __forceinline__ void operator()(const f32x4 (&acc)[2][2][4][2], const pg8::Unit& u, int wr, int wc, int fr, int fq) const {
        typedef int i32x4_ __attribute__((ext_vector_type(4)));
        const int row0 = u.pm * 256 + wr * 64 + fr, col0 = u.pn * 256 + wc * 32 + 8 * fq;
        float swv[2][8];
#pragma unroll
        for (int bj = 0; bj < 2; ++bj) { const float4 a = *(const float4*)(sw + col0 + bj * 128), b = *(const float4*)(sw + col0 + bj * 128 + 4); swv[bj][0] = a.x; swv[bj][1] = a.y; swv[bj][2] = a.z; swv[bj][3] = a.w; swv[bj][4] = b.x; swv[bj][5] = b.y; swv[bj][6] = b.z; swv[bj][7] = b.w; }
#pragma unroll
        for (int ai = 0; ai < 2; ++ai)
#pragma unroll
            for (int m = 0; m < 4; ++m) { const int r = row0 + ai * 128 + m * 16; const float sr = sx[r]; bf16_t* rowp = O + (size_t)r * ldc + col0;
#pragma unroll
                for (int bj = 0; bj < 2; ++bj) { float o[8];
#pragma unroll
                    for (int n = 0; n < 2; ++n) { const i32x4_ iv = __builtin_bit_cast(i32x4_, acc[ai][bj][m][n]);
#pragma unroll
                        for (int j = 0; j < 4; ++j) o[n * 4 + j] = (float)iv[j] * (sr * swv[bj][n * 4 + j]); }
                    *(uint4*)(rowp + bj * 128) = pack8(o); } }
    }
};
struct EpiGate { static constexpr bool PERM = true, AFTER_DRAIN = false; bf16_t* O; const float* gate; const float* sw;
    __device__ __forceinline__ void operator()(const f32x4 (&acc)[2][2][4][2], const pg8::Unit& u, int wr, int wc, int fr, int fq) const {
        pg8::fp8_acc_settle();
        const int pnl = u.pn & 3; const int row0 = u.pm * 256 + wr * 64 + fr, col0 = pnl * 256 + wc * 32 + 8 * fq;
#pragma unroll
        for (int bj = 0; bj < 2; ++bj) { const float* sp = sw + (size_t)u.pn * 256 + wc * 32 + 8 * fq + bj * 128; const float4 sa = *(const float4*)sp, sb = *(const float4*)(sp + 4);
#pragma unroll
            for (int ai = 0; ai < 2; ++ai)
#pragma unroll
                for (int m = 0; m < 4; ++m) { const int r = row0 + ai * 128 + m * 16; const float gt = gate[r]; const f32x4 v0 = acc[ai][bj][m][0], v1 = acc[ai][bj][m][1];
                    u32x4 w; w.x = pack2(v0[0] * (gt * sa.x), v0[1] * (gt * sa.y)); w.y = pack2(v0[2] * (gt * sa.z), v0[3] * (gt * sa.w)); w.z = pack2(v1[0] * (gt * sb.x), v1[1] * (gt * sb.y)); w.w = pack2(v1[2] * (gt * sb.z), v1[3] * (gt * sb.w));
                    *(u32x4*)(O + (size_t)r * 1024 + col0 + bj * 128) = w; } }
    }
};

__device__ __forceinline__ void phase_combine(const Params& p, int l) {
    const int lane = threadIdx.x & 63, wv = threadIdx.x >> 6; const int nrow = l == 0 ? NROW : NLAT;
    const float* mod = (const float*)(p.ws + WS_MOD) + (size_t)l * 17 * 6144; const float* g3 = p.in[6] + (l * 4 + 3) * 1024;
    const int* SLOT = (const int*)(p.ws + WS_SLOT); const bf16_t* YE = (const bf16_t*)(p.ws + U_YEXP); bf16_t* A = (bf16_t*)(p.ws + WS_ABUF);
    const int rstep = gridDim.x * 8; int r = blockIdx.x * 8 + wv;
    int nslot = (r < nrow && lane < 16) ? SLOT[(size_t)r * 16 + lane] : -1; float4 nx1[4];
    if (r < nrow) { const float* x1p = xrow(p.out, (const float*)(p.ws + WS_CTXA), r);
#pragma unroll
        for (int i = 0; i < 4; ++i) nx1[i] = *(const float4*)(x1p + i * 256 + lane * 4); }
    for (; r < nrow; r += rstep) { const bool lat = r < NLAT; const int b = lat ? (r >> 11) : ((r - NLAT) >> 8), mbi = lat ? b : 16, xoff = lat ? b * 256 : 4096 + b * 32;
        const float* mb = mod + (size_t)mbi * 6144;
        const int myslot = nslot; float4 xc[4];
#pragma unroll
        for (int i = 0; i < 4; ++i) xc[i] = nx1[i];
        float f[16];
#pragma unroll
        for (int k = 0; k < 16; ++k) f[k] = 0.f;
        unsigned long long mask = __ballot(myslot >= 0);
        while (mask) { int ee[4], sl4[4]; u32x2 w[4][4];
#pragma unroll
            for (int k = 0; k < 4; ++k) { if (mask) { ee[k] = __builtin_ctzll(mask); mask &= mask - 1; sl4[k] = __shfl(myslot, ee[k]); } else { ee[k] = -1; sl4[k] = 0; } }
#pragma unroll
            for (int k = 0; k < 4; ++k) if (ee[k] >= 0) { const bf16_t* yr = YE + ((size_t)ee[k] * XROWS + xoff + sl4[k]) * 1024 + lane * 4;
#pragma unroll
                for (int i = 0; i < 4; ++i) w[k][i] = *(const u32x2*)(yr + i * 256); }
#pragma unroll
            for (int k = 0; k < 4; ++k) if (ee[k] >= 0) {
#pragma unroll
                for (int i = 0; i < 4; ++i) { f[i * 4] += bflo(w[k][i].x); f[i * 4 + 1] += bfhi(w[k][i].x); f[i * 4 + 2] += bflo(w[k][i].y); f[i * 4 + 3] += bfhi(w[k][i].y); } } }
        { const int rn = r + rstep; nslot = (rn < nrow && lane < 16) ? SLOT[(size_t)rn * 16 + lane] : -1;
          if (rn < nrow) { const float* x1p = xrow(p.out, (const float*)(p.ws + WS_CTXA), rn);
#pragma unroll
              for (int i = 0; i < 4; ++i) nx1[i] = *(const float4*)(x1p + i * 256 + lane * 4); } }
        float ss = 0.f;
#pragma unroll
        for (int k = 0; k < 16; ++k) ss += f[k] * f[k];
        ss = wave_sum(ss); const float rs = rsqrtf(ss * (1.0f / 1024.0f) + 1e-6f);
        float* x2 = l == 0 ? xrow_w((float*)(p.ws + WS_XB), (float*)(p.ws + WS_CTXB), r) : p.out + (size_t)r * D;
        float4 xv[4];
#pragma unroll
        for (int i = 0; i < 4; ++i) { const int c = i * 256 + lane * 4; const float4 gg = *(const float4*)(g3 + c), gt = *(const float4*)(mb + 5120 + c); float4 x = xc[i];
            x.x += gt.x * (f[i * 4] * rs * gg.x); x.y += gt.y * (f[i * 4 + 1] * rs * gg.y); x.z += gt.z * (f[i * 4 + 2] * rs * gg.z); x.w += gt.w * (f[i * 4 + 3] * rs * gg.w);
            *(float4*)(x2 + c) = x; xv[i] = x; }
        if (l == 0) { const float* mb1 = mod + (size_t)17 * 6144 + (size_t)mbi * 6144; hnorm_row(p.in[6] + 4 * 1024, mb1, mb1 + 1024, p.ws + WS_ABUF + (size_t)r * 1024, (float*)(p.ws + WS_SH) + r, lane, xv); }
    }
}


#ifndef MK_ONLY
#define MK_ONLY -1
#endif
#define EN(k) (MK_ONLY < 0 || MK_ONLY == (k))
#ifndef MK_DUP
#define MK_DUP 0
#endif
#define NREP(k) ((((MK_DUP) >> (k)) & 1) ? 2 : 1)
constexpr int PH_PER_LAYER = 14, N_PHASES = 1 + 2 * PH_PER_LAYER;
#define IN(k) (lo <= (k) && (k) < hi)
#define SEAM(k) do { if (p.use_bar && IN(k) && IN((k) + 1)) xcd_barrier(bar); } while (0)
template <int l> __device__ __forceinline__ void layer_phases(const Params& p, LAS unsigned char* lds, const XcdBarrier& bar, const int lo, const int hi) {
    const int wv = __builtin_amdgcn_readfirstlane(threadIdx.x >> 6), G = gridDim.x; const int wid = blockIdx.x * 8 + wv, nw = G * 8;
        const int pb = 1 + l * PH_PER_LAYER;
        const float* xl = l == 0 ? p.in[0] : (const float*)(p.ws + WS_XB);
        const float* xc = l == 0 ? p.in[2] : (const float*)(p.ws + WS_CTXB);
        if (EN(0) && IN(pb + 0)) { { if (l == 0) phase_hnorm(p, 0, xl, xc); }
            if ((NREP(0)) == 2) { if (l == 0) phase_hnorm(p, 0, xl, xc); } }
        SEAM(pb + 0);
        if (EN(1) && IN(pb + 1)) { { pg8::Gemm g{(const bf16_t*)(p.ws + WS_ABUF), (const bf16_t*)(p.ws + WS_WIN), NROW, NINP, D / 2}; pg8::StaticOrder S; S.init(NROW, NINP, G, (int)blockIdx.x);
            EpiScaleBf16 E{(bf16_t*)(p.ws + U_P), NINP, (const float*)(p.ws + WS_SH), (const float*)(p.ws + WS_SWIN)}; pg8::gemm_phase<EpiScaleBf16, pg8::StaticOrder, false, 1>(lds, g, S, E, nullptr); }
            if ((NREP(1)) == 2) { pg8::Gemm g{(const bf16_t*)(p.ws + WS_ABUF), (const bf16_t*)(p.ws + WS_WIN), NROW, NINP, D / 2}; pg8::StaticOrder S; S.init(NROW, NINP, G, (int)blockIdx.x);
            EpiScaleBf16 E{(bf16_t*)(p.ws + U_P), NINP, (const float*)(p.ws + WS_SH), (const float*)(p.ws + WS_SWIN)}; pg8::gemm_phase<EpiScaleBf16, pg8::StaticOrder, false, 1>(lds, g, S, E, nullptr); } }
        SEAM(pb + 1);
        if (EN(2) && IN(pb + 2)) { phase_prep(p, l, lds);
            if ((NREP(2)) == 2) phase_prep(p, l, lds); }
        SEAM(pb + 2);
        if (EN(3) && IN(pb + 3)) { { lowrank_items(p, l, wid, nw, lds); s5_pass1_items(p, l, wid, nw); }
            if ((NREP(3)) == 2) { lowrank_items(p, l, wid, nw, lds); s5_pass1_items(p, l, wid, nw); } }
        SEAM(pb + 3);
        if (EN(4) && IN(pb + 4)) { { s5_carry(p, l); na_items(p, l, wid, nw, lds); }
            if ((NREP(4)) == 2) { s5_carry(p, l); na_items(p, l, wid, nw, lds); } }
        SEAM(pb + 4);
        if (EN(5) && IN(pb + 5)) { { s5_pass2_items(p, l, wid, nw); rwkv_pre_items(p, l, wid, nw, lds); }
            if ((NREP(5)) == 2) { s5_pass2_items(p, l, wid, nw); rwkv_pre_items(p, l, wid, nw, lds); } }
        SEAM(pb + 5);
        if (EN(6) && IN(pb + 6)) {
            if (G > 192) { const int bx = (int)blockIdx.x;
                if (bx < 192) { if (wv < 4) rwkv_seq_task(p, l, bx * 4 + wv, lds); } else s5_glu_items(p, l, (bx - 192) * 8 + wv, (G - 192) * 8);
                if ((NREP(6)) == 2) { if (bx < 192) { if (wv < 4) rwkv_seq_task(p, l, bx * 4 + wv, lds); } else s5_glu_items(p, l, (bx - 192) * 8 + wv, (G - 192) * 8); } }
            else { for (int task = wid; task < 768; task += nw) rwkv_seq_task(p, l, task, lds); s5_glu_items(p, l, wid, nw); } }
        SEAM(pb + 6);
        if (EN(7) && IN(pb + 7)) { rwkv_finish(p, l);
            if ((NREP(7)) == 2) rwkv_finish(p, l); }
        SEAM(pb + 7);
        if (EN(8) && IN(pb + 8)) { { const int M = l == 0 ? NROW : NLAT; pg8::Gemm g{(const bf16_t*)(p.ws + WS_ABUF), (const bf16_t*)(p.ws + WS_WOUT), M, D, D}; pg8::StaticOrder S; S.init(M, D, G, (int)blockIdx.x);
            pg8::EpiBf16<0> E{(bf16_t*)(p.ws + U_Y), D, nullptr, 0, 0}; pg8::gemm_phase<pg8::EpiBf16<0>, pg8::StaticOrder, false>(lds, g, S, E, nullptr); }
            if ((NREP(8)) == 2) { const int M = l == 0 ? NROW : NLAT; pg8::Gemm g{(const bf16_t*)(p.ws + WS_ABUF), (const bf16_t*)(p.ws + WS_WOUT), M, D, D}; pg8::StaticOrder S; S.init(M, D, G, (int)blockIdx.x);
            pg8::EpiBf16<0> E{(bf16_t*)(p.ws + U_Y), D, nullptr, 0, 0}; pg8::gemm_phase<pg8::EpiBf16<0>, pg8::StaticOrder, false>(lds, g, S, E, nullptr); } }
        SEAM(pb + 8);
        if (EN(9) && IN(pb + 9)) { phase_normrouter(p, l, xl, xc, lds);
            if ((NREP(9)) == 2) phase_normrouter(p, l, xl, xc, lds); }
        SEAM(pb + 9);
        if (EN(10) && IN(pb + 10)) { phase_topk(p, l, lds);
            if ((NREP(10)) == 2) phase_topk(p, l, lds); }
        SEAM(pb + 10);
        if (EN(11) && IN(pb + 11)) { { pg8::Gemm g{(const bf16_t*)(p.ws + U_XSEL), (const bf16_t*)(p.ws + WS_WGU), 16 * XROWS, 16 * 5632, D / 2}; GroupedOrder S; S.init(l == 0 ? 18 : 16, 22, 2, G, (int)blockIdx.x);
            EpiSwiGLU E{p.ws + U_HID, (const float*)(p.ws + WS_SXS), (const float*)(p.ws + WS_SW8)}; pg8::gemm_phase<EpiSwiGLU, GroupedOrder, false, 1>(lds, g, S, E, nullptr); }
            if ((NREP(11)) == 2) { pg8::Gemm g{(const bf16_t*)(p.ws + U_XSEL), (const bf16_t*)(p.ws + WS_WGU), 16 * XROWS, 16 * 5632, D / 2}; GroupedOrder S; S.init(l == 0 ? 18 : 16, 22, 2, G, (int)blockIdx.x);
            EpiSwiGLU E{p.ws + U_HID, (const float*)(p.ws + WS_SXS), (const float*)(p.ws + WS_SW8)}; pg8::gemm_phase<EpiSwiGLU, GroupedOrder, false, 1>(lds, g, S, E, nullptr); } }
        SEAM(pb + 11);
        if (EN(12) && IN(pb + 12)) { { pg8::Gemm g{(const bf16_t*)(p.ws + U_HID), (const bf16_t*)(p.ws + WS_WD), 16 * XROWS, 16 * 1024, DE / 2}; GroupedOrder S; S.init(l == 0 ? 18 : 16, 4, 4, G, (int)blockIdx.x);
            EpiGate E{(bf16_t*)(p.ws + U_YEXP), (const float*)(p.ws + WS_SELG), (const float*)(p.ws + WS_SWD)}; pg8::gemm_phase<EpiGate, GroupedOrder, false, 2>(lds, g, S, E, nullptr); }
            if ((NREP(12)) == 2) { pg8::Gemm g{(const bf16_t*)(p.ws + U_HID), (const bf16_t*)(p.ws + WS_WD), 16 * XROWS, 16 * 1024, DE / 2}; GroupedOrder S; S.init(l == 0 ? 18 : 16, 4, 4, G, (int)blockIdx.x);
            EpiGate E{(bf16_t*)(p.ws + U_YEXP), (const float*)(p.ws + WS_SELG), (const float*)(p.ws + WS_SWD)}; pg8::gemm_phase<EpiGate, GroupedOrder, false, 2>(lds, g, S, E, nullptr); } }
        SEAM(pb + 12);
        if (EN(13) && IN(pb + 13)) { { phase_combine(p, l); if (l == 0) convert_weights(p, 1, lds, (int)blockIdx.x, G); }
            if (((l == 0 ? NREP(13) : 1)) == 2) { phase_combine(p, l); if (l == 0) convert_weights(p, 1, lds, (int)blockIdx.x, G); } }
        SEAM(pb + 13);
}
__global__ void __launch_bounds__(NTHR, 2) fwd(Params p) {
    extern __shared__ __attribute__((aligned(16))) unsigned char lds_raw[];
    LAS unsigned char* lds = (LAS unsigned char*)lds_raw;
    const int tid = threadIdx.x;
    if (tid < 4) ((LAS unsigned*)(lds + LDS_MISC))[tid] = 0u;
    __syncthreads();
    XcdBarrier bar; bar.bar = (unsigned*)(p.ws + WS_CTL); bar.x = 0; bar.st = (volatile LAS unsigned*)(lds + LDS_MISC);
    if (p.use_bar) bar = xcd_barrier_post((unsigned*)(p.ws + WS_CTL), (volatile LAS unsigned*)(lds + LDS_MISC));
    if (p.use_bar && tid == 0) { unsigned* xr = (unsigned*)(p.ws + WS_CTL + 32768); ((LAS unsigned*)(lds + LDS_MISC))[2] = xb_xcc_id(); ((LAS unsigned*)(lds + LDS_MISC))[3] = atomicAdd(xr + 64 * xb_xcc_id(), 1u); }
    __syncthreads();
    const int lo = p.ph_lo, hi = p.ph_hi;

    if (EN(100) && IN(0)) { { phase_prologue(p, lds); }
        if ((NREP(14)) == 2) { phase_prologue(p, lds); } }
    SEAM(0);
    layer_phases<0>(p, lds, bar, lo, hi);
    layer_phases<1>(p, lds, bar, lo, hi);
#undef IN
#undef SEAM
}
}

#ifndef MK_ONE_LAUNCH
#define MK_ONE_LAUNCH 1
#endif
extern "C" void kernel_launch(void* const* d_in, const int* in_sizes, int n_in, void* d_out, int out_size, void* d_ws, size_t ws_size, hipStream_t stream) {
    static int grid = 0;
    if (grid == 0) {
        if (n_in != 35 || out_size != mk::NLAT * mk::D || ws_size < mk::WS_END) { fprintf(stderr, "kernel_launch: unexpected problem (n_in %d, out %d, ws %zu < %zu)\n", n_in, out_size, ws_size, (size_t)mk::WS_END); grid = -1; return; }
        int dev = 0, cus = 0, per_cu = 0;
        if (hipGetDevice(&dev) != hipSuccess || hipDeviceGetAttribute(&cus, hipDeviceAttributeMultiprocessorCount, dev) != hipSuccess) { grid = -1; return; }
        if (hipFuncSetAttribute((const void*)mk::fwd, hipFuncAttributeMaxDynamicSharedMemorySize, mk::LDS_BYTES) != hipSuccess) { fprintf(stderr, "kernel_launch: hipFuncSetAttribute failed\n"); grid = -1; return; }
        if (hipOccupancyMaxActiveBlocksPerMultiprocessor(&per_cu, (const void*)mk::fwd, mk::NTHR, mk::LDS_BYTES) != hipSuccess || per_cu < 1) { fprintf(stderr, "kernel_launch: occupancy query says %d\n", per_cu); per_cu = 1; }
        (void)hipGetLastError();
        grid = cus;
    }
    if (grid < 0) return;
    (void)in_sizes;
    if (hipMemsetAsync(d_ws, 0, 65536, stream) != hipSuccess) return;
    mk::Params a{};
    for (int i = 0; i < 35; ++i) a.in[i] = (const float*)d_in[i];
    a.out = (float*)d_out; a.ws = (unsigned char*)d_ws;
#if MK_ONE_LAUNCH
    a.ph_lo = 0; a.ph_hi = mk::N_PHASES; a.use_bar = 1;
    hipLaunchKernelGGL(mk::fwd, dim3(grid), dim3(mk::NTHR), mk::LDS_BYTES, stream, a);
#else
    for (int ph = 0; ph < mk::N_PHASES; ++ph) { a.ph_lo = ph; a.ph_hi = ph + 1; a.use_bar = 0; hipLaunchKernelGGL(mk::fwd, dim3(grid), dim3(mk::NTHR), mk::LDS_BYTES, stream, a); }
#endif
}
```

```cpp
#include <hip/hip_runtime.h>
#include <cstdio>
#include <cstdint>
namespace pg8 {
#define PG8_LAS __attribute__((address_space(3)))
typedef unsigned short bf16_t;
typedef short bf16x8 __attribute__((ext_vector_type(8)));
typedef float f32x4 __attribute__((ext_vector_type(4)));
typedef unsigned u32x4 __attribute__((ext_vector_type(4)));
constexpr int BM = 256, BK = 64, HALF = 128, HTB = HALF * BK * 2  , STAGE_BYTES = 8 * HTB, NXCD = 8, WGM = 8;

__host__ __device__ __forceinline__ int lds_byte(int r, int c) { const int st = (r >> 4) * 2 + (c >> 5), rr = r & 15, cc = c & 31, ob = rr * 64 + cc * 2; return st * 1024 + (ob ^ (((ob >> 9) & 1) << 5)); }
__host__ __device__ __forceinline__ void stage_rc(int b, int& R, int& C) { const int st = b / 1024, sb = b % 1024, swz = sb ^ (((sb >> 9) & 1) << 5); R = (st >> 1) * 16 + swz / 64; C = (st & 1) * 32 + (swz % 64) / 2; }
__host__ __device__ __forceinline__ int perm32(int rho) { const int n = rho >> 4, i = rho & 15; return 8 * (i >> 2) + 4 * n + (i & 3); }

struct Unit { int pm, pn; };
struct Gemm { const bf16_t* A; const bf16_t* Bt; int M, N, K; };

struct StaticOrder {
    int nM, nN, nwg, G, c;
    __host__ __device__ void init(int M, int N, int G_, int c_) { nM = M / BM; nN = N / BM; nwg = nM * nN; G = G_; c = c_; }
    __host__ __device__ bool next(int i, Unit& u) const {
        const long L = (long)i * G + c; if (L >= nwg) return false;
        int wgid = (int)L; { const int q = nwg / NXCD, r = nwg % NXCD, xcd = wgid % NXCD, off = wgid / NXCD; wgid = (xcd < r ? xcd * (q + 1) : r * (q + 1) + (xcd - r) * q) + off; }
        const int nig = WGM * nN, gid = wgid / nig, fm = gid * WGM, gsz = (nM - fm) < WGM ? (nM - fm) : WGM;
        u.pm = fm + ((wgid % nig) % gsz); u.pn = (wgid % nig) / gsz; return true;
    }
    __device__ __forceinline__ void a_ready(const Unit&) const {}
    __device__ __forceinline__ void done(const Unit&) const {}
};
struct CountedOrder : StaticOrder {
    const unsigned* ready; unsigned need; unsigned* tmo;
    __device__ __forceinline__ void a_ready(const Unit& u) const {
        if (threadIdx.x < 64) {
            const unsigned long long t0 = __builtin_amdgcn_s_memrealtime(); unsigned polls = 0;
            while ((unsigned)__builtin_amdgcn_readfirstlane(__hip_atomic_load(ready + 64 * u.pm, __ATOMIC_RELAXED, __HIP_MEMORY_SCOPE_AGENT)) < need) {
                if ((++polls & 255u) == 0u && __builtin_amdgcn_readfirstlane(__hip_atomic_load(tmo, __ATOMIC_RELAXED, __HIP_MEMORY_SCOPE_AGENT)) != 0u) break;
                if (__builtin_amdgcn_s_memrealtime() - t0 > 2000000ull) {
                    if (threadIdx.x == 0) { unsigned expect = 0u; __hip_atomic_compare_exchange_strong(tmo + 1, &expect, 0x600u | (unsigned)(u.pm & 0xff), __ATOMIC_RELAXED, __ATOMIC_RELAXED, __HIP_MEMORY_SCOPE_AGENT); __hip_atomic_store(tmo, 1u, __ATOMIC_RELAXED, __HIP_MEMORY_SCOPE_AGENT); }
                    break; }
                __builtin_amdgcn_s_sleep(2); }
            __builtin_amdgcn_fence(__ATOMIC_ACQUIRE, "agent");
            asm volatile("s_waitcnt vmcnt(0)" ::: "memory");
        }
#if !defined(BROKEN_HOOK_NO_BARRIER)
        asm volatile("" ::: "memory"); __builtin_amdgcn_s_barrier(); asm volatile("" ::: "memory");
#endif
    }
};

__device__ __forceinline__ unsigned cvt_pk_bf16(float lo, float hi) { unsigned r; asm volatile("v_cvt_pk_bf16_f32 %0, %1, %2" : "=v"(r) : "v"(lo), "v"(hi)); return r; }
typedef float f32x2 __attribute__((ext_vector_type(2)));
__device__ __forceinline__ f32x2 gelu_pk(f32x2 v) {
    const f32x2 av = __builtin_elementwise_abs(v), d = av * 0.2316418882f + 1.0f;
    f32x2 t; t.x = __builtin_amdgcn_rcpf(d.x); t.y = __builtin_amdgcn_rcpf(d.y);
    f32x2 q = t * 0.5307027145f + (-0.7265760135f); q = q * t + 0.7107068705f; q = q * t + (-0.142248368f); q = q * t + 0.127414796f; q = q * t;
    const f32x2 s = (v * v) * (-0.72134752044f);
    f32x2 e; e.x = __builtin_amdgcn_exp2f(s.x); e.y = __builtin_amdgcn_exp2f(s.y);
    const f32x2 m = v * (q * e), r = v - m;
    f32x2 o; o.x = v.x < 0.f ? m.x : r.x; o.y = v.y < 0.f ? m.y : r.y; return o;
}

struct EpiF32 {
    static constexpr bool PERM = false, AFTER_DRAIN = false;
    float* C; int ldc; const float* bias;
    __device__ __forceinline__ void operator()(const f32x4 (&acc)[2][2][4][2], const Unit& u, int wr, int wc, int fr, int fq) const {
        const int row0 = u.pm * BM + wr * 64 + fr, col0 = u.pn * BM + wc * 32 + 4 * fq;
        f32x4 bv[2][2];
#pragma unroll
        for (int bj = 0; bj < 2; ++bj)
#pragma unroll
            for (int n = 0; n < 2; ++n) bv[bj][n] = bias ? *(const f32x4*)(bias + col0 + bj * HALF + n * 16) : (f32x4){0.f, 0.f, 0.f, 0.f};
#pragma unroll
        for (int ai = 0; ai < 2; ++ai)
#pragma unroll
            for (int m = 0; m < 4; ++m) { float* rowp = C + (size_t)(row0 + ai * HALF + m * 16) * ldc + col0;
#pragma unroll
                for (int bj = 0; bj < 2; ++bj)
#pragma unroll
                    for (int n = 0; n < 2; ++n) *(f32x4*)(rowp + bj * HALF + n * 16) = acc[ai][bj][m][n] + bv[bj][n]; }
    }
};
template <int ACT  > struct EpiBf16 {
    static constexpr bool PERM = true, AFTER_DRAIN = false;
    bf16_t* O; int ldc; const float* bias; int split_cols; size_t split_stride;
    __device__ __forceinline__ void operator()(const f32x4 (&acc)[2][2][4][2], const Unit& u, int wr, int wc, int fr, int fq) const {
        const int row0 = u.pm * BM + wr * 64 + fr; int colt = u.pn * BM; bf16_t* base = O;
        if (split_cols) { const int t = colt / split_cols; base += (size_t)t * split_stride; colt -= t * split_cols; }
        const int col0 = colt + wc * 32 + 8 * fq, bcol0 = u.pn * BM + wc * 32 + 8 * fq;
        f32x4 bv[2][2];
#pragma unroll
        for (int bj = 0; bj < 2; ++bj)
#pragma unroll
            for (int n = 0; n < 2; ++n) bv[bj][n] = bias ? *(const f32x4*)(bias + bcol0 + bj * HALF + 4 * n) : (f32x4){0.f, 0.f, 0.f, 0.f};
#pragma unroll
        for (int ai = 0; ai < 2; ++ai)
#pragma unroll
            for (int m = 0; m < 4; ++m) { bf16_t* rowp = base + (size_t)(row0 + ai * HALF + m * 16) * ldc + col0;
#pragma unroll
                for (int bj = 0; bj < 2; ++bj) { f32x4 v0 = acc[ai][bj][m][0] + bv[bj][0], v1 = acc[ai][bj][m][1] + bv[bj][1];
                    if (ACT == 1) { f32x2 a = gelu_pk((f32x2){v0[0], v0[1]}), b = gelu_pk((f32x2){v0[2], v0[3]}), c = gelu_pk((f32x2){v1[0], v1[1]}), d = gelu_pk((f32x2){v1[2], v1[3]});
                        v0 = (f32x4){a.x, a.y, b.x, b.y}; v1 = (f32x4){c.x, c.y, d.x, d.y}; }
                    if (ACT == 2) {
#pragma unroll
                        for (int j = 0; j < 4; ++j) { v0[j] = 0.5f * v0[j] * (1.0f + erff(v0[j] * 0.70710678f)); v1[j] = 0.5f * v1[j] * (1.0f + erff(v1[j] * 0.70710678f)); } }
                    u32x4 w; w.x = cvt_pk_bf16(v0[0], v0[1]); w.y = cvt_pk_bf16(v0[2], v0[3]); w.z = cvt_pk_bf16(v1[0], v1[1]); w.w = cvt_pk_bf16(v1[2], v1[3]);
                    *(u32x4*)(rowp + bj * HALF) = w; } }
    }
};

template <int MODE> __device__ __forceinline__ f32x4 pg8_mma(bf16x8 a, bf16x8 b, f32x4 c) {
    if constexpr (MODE == 1) { typedef int i32x4_ __attribute__((ext_vector_type(4))); return __builtin_bit_cast(f32x4, __builtin_amdgcn_mfma_i32_16x16x64_i8(__builtin_bit_cast(i32x4_, a), __builtin_bit_cast(i32x4_, b), __builtin_bit_cast(i32x4_, c), 0, 0, 0)); }
    else return __builtin_amdgcn_mfma_f32_16x16x32_bf16(a, b, c, 0, 0, 0); }
__device__ __forceinline__ f32x4 pg8_mma8(bf16x8 a0, bf16x8 a1, bf16x8 b0, bf16x8 b1, f32x4 c) {
    typedef int i32x4_ __attribute__((ext_vector_type(4))); typedef int i32x8_ __attribute__((ext_vector_type(8)));
    const i32x8_ A = __builtin_shufflevector(__builtin_bit_cast(i32x4_, a0), __builtin_bit_cast(i32x4_, a1), 0, 1, 2, 3, 4, 5, 6, 7), B = __builtin_shufflevector(__builtin_bit_cast(i32x4_, b0), __builtin_bit_cast(i32x4_, b1), 0, 1, 2, 3, 4, 5, 6, 7);
    const int one = 0x7f7f7f7f;
    asm volatile("v_mfma_scale_f32_16x16x128_f8f6f4 %0, %1, %2, %0, %3, %3 op_sel_hi:[0,0,0]" : "+v"(c) : "v"(A), "v"(B), "v"(one));
    return c; }
__device__ __forceinline__ void fp8_acc_settle() { asm volatile("s_nop 7\n\ts_nop 7\n\ts_nop 7" ::: "memory"); }
template <class Epi, class Sched, bool STAMP = false, int MODE = 0>
__device__ __forceinline__ void gemm_phase(PG8_LAS unsigned char* lds, const Gemm g, const Sched& S, const Epi& E, unsigned long long* stamps) {
    const int tid = threadIdx.x, wid = __builtin_amdgcn_readfirstlane(tid >> 6), lane = tid & 63, wr = wid >> 2, wc = wid & 3, fr = lane & 15, fq = lane >> 4;
    const int K = g.K, nt = K / BK;
    int ts_lo = 0, ts_hi = 0, nts = 0; const unsigned long long rt_entry = STAMP ? (unsigned long long)wall_clock64() : 0ull;
#define PG8_STAMP() do { if (STAMP && wid == 0 && nts < 64) { const unsigned long long _c = (unsigned long long)clock64(); \
        ts_lo = (lane == nts) ? (int)(unsigned)_c : ts_lo; ts_hi = (lane == nts) ? (int)(unsigned)(_c >> 32) : ts_hi; ++nts; } } while (0)
    PG8_STAMP();
    unsigned voffA[2], voffB[2];
#pragma unroll
    for (int i = 0; i < 2; ++i) { int R, C; stage_rc(tid * 16 + i * 8192, R, C); const int Rb = Epi::PERM ? ((R & ~31) + perm32(R & 31)) : R;
        voffA[i] = (unsigned)(R * K + C) * 2u; voffB[i] = (unsigned)(Rb * K + C) * 2u; }
    const size_t kstep = (size_t)(BK * 2);
    const size_t hstep = (size_t)HALF * K * 2;
    const size_t tstep = 2 * hstep;
    const unsigned ldsw = (unsigned)wid * 1024u;
    const int aoff = lds_byte(wr * 64 + fr, fq * 8), boff = lds_byte(wc * 32 + fr, fq * 8);
#define PG8_SA(b, h) (((b) * 2 + (h)) * HTB)
#define PG8_SB(b, h) ((4 + (b) * 2 + (h)) * HTB)
#define PG8_STAGE(bufoff, gbase, voff) do { _Pragma("unroll") for (int _i = 0; _i < 2; ++_i) \
        __builtin_amdgcn_global_load_lds((const unsigned*)((const char*)(gbase) + (voff)[_i]), (PG8_LAS unsigned*)(lds + (bufoff) + ldsw + _i * 8192), 16, 0, 0); } while (0)
#define PG8_LDA(dst, b, h) do { _Pragma("unroll") for (int m = 0; m < 4; ++m) _Pragma("unroll") for (int k = 0; k < 2; ++k) dst[m][k] = *(const PG8_LAS bf16x8*)(lds + PG8_SA(b, h) + aoff + m * 2048 + k * 1024); } while (0)
#define PG8_LDB(dst, b, h) do { _Pragma("unroll") for (int n = 0; n < 2; ++n) _Pragma("unroll") for (int k = 0; k < 2; ++k) dst[n][k] = *(const PG8_LAS bf16x8*)(lds + PG8_SB(b, h) + boff + n * 2048 + k * 1024); } while (0)
#define PG8_MMA(ai, bj, At, Bt) do { __builtin_amdgcn_s_setprio(1); _Pragma("unroll") for (int m = 0; m < 4; ++m) _Pragma("unroll") for (int n = 0; n < 2; ++n) { if constexpr (MODE == 2) acc[ai][bj][m][n] = pg8_mma8(Bt[n][0], Bt[n][1], At[m][0], At[m][1], acc[ai][bj][m][n]); else { _Pragma("unroll") for (int k = 0; k < 2; ++k) \
        acc[ai][bj][m][n] = pg8_mma<MODE>(Bt[n][k], At[m][k], acc[ai][bj][m][n]); } } __builtin_amdgcn_s_setprio(0); } while (0)
#define PG8_WAIT_V(n) asm volatile("s_waitcnt vmcnt(" #n ")" ::: "memory")
#define PG8_WAIT_L(n) asm volatile("s_waitcnt lgkmcnt(" #n ")" ::: "memory")
#define PG8_BAR __builtin_amdgcn_s_barrier()
#define PG8_SCHED __builtin_amdgcn_sched_barrier(0)
    Unit cur, nxt; int ui = 0;
    if (!S.next(0, cur)) return;
    f32x4 acc[2][2][4][2];
#pragma unroll
    for (int a = 0; a < 2; ++a)
#pragma unroll
        for (int b = 0; b < 2; ++b)
#pragma unroll
            for (int m = 0; m < 4; ++m)
#pragma unroll
                for (int n = 0; n < 2; ++n) acc[a][b][m][n] = (f32x4){0.f, 0.f, 0.f, 0.f};
    bf16x8 At[4][2], B0[2][2], B1[2][2];
    const char* cA = (const char*)g.A + (size_t)cur.pm * tstep; const char* cB = (const char*)g.Bt + (size_t)cur.pn * tstep;
    S.a_ready(cur);
    PG8_STAGE(PG8_SB(0, 0), cB, voffB); PG8_STAGE(PG8_SA(0, 0), cA, voffA); PG8_STAGE(PG8_SB(0, 1), cB + hstep, voffB); PG8_STAGE(PG8_SA(0, 1), cA + hstep, voffA);
    if (wr == 1) PG8_BAR;
    PG8_WAIT_V(4); PG8_BAR;
    PG8_STAGE(PG8_SB(1, 0), cB + kstep, voffB); PG8_STAGE(PG8_SA(1, 0), cA + kstep, voffA); PG8_STAGE(PG8_SB(1, 1), cB + hstep + kstep, voffB);
    PG8_WAIT_V(6); PG8_BAR;
    PG8_STAMP();
    for (;;) {
        const bool has_next = S.next(ui + 1, nxt);
        const char* nA = has_next ? (const char*)g.A + (size_t)nxt.pm * tstep : cA; const char* nB = has_next ? (const char*)g.Bt + (size_t)nxt.pn * tstep : cB;
        for (int t = 0; t < nt; t += 2) {
            const bool last = (t == nt - 2);
            const char* a1 = cA + (size_t)(t + 1) * kstep;
            const char* a2 = last ? nA : cA + (size_t)(t + 2) * kstep; const char* b2 = last ? nB : cB + (size_t)(t + 2) * kstep;
            const char* a3 = a2 + kstep; const char* b3 = b2 + kstep;
            if (last && has_next) S.a_ready(nxt);
            PG8_LDB(B0, 0, 0); PG8_SCHED; PG8_LDA(At, 0, 0); PG8_STAGE(PG8_SA(1, 1), a1 + hstep, voffA);
            PG8_WAIT_L(8); PG8_BAR; PG8_WAIT_L(0); PG8_MMA(0, 0, At, B0); PG8_BAR; PG8_SCHED;
            PG8_LDB(B1, 0, 1); PG8_STAGE(PG8_SB(0, 0), b2, voffB);
            PG8_BAR; PG8_WAIT_L(0); PG8_MMA(0, 1, At, B1); PG8_BAR;
            PG8_LDA(At, 0, 1); PG8_STAGE(PG8_SA(0, 0), a2, voffA);
            PG8_BAR; PG8_WAIT_L(0); PG8_MMA(1, 0, At, B0); PG8_BAR; PG8_SCHED;
            PG8_STAGE(PG8_SB(0, 1), b2 + hstep, voffB);
            PG8_WAIT_V(6); PG8_BAR; PG8_MMA(1, 1, At, B1); PG8_BAR;
            PG8_LDB(B0, 1, 0); PG8_SCHED; PG8_LDA(At, 1, 0); PG8_STAGE(PG8_SA(0, 1), a2 + hstep, voffA);
            PG8_WAIT_L(8); PG8_BAR; PG8_WAIT_L(0); PG8_MMA(0, 0, At, B0); PG8_BAR; PG8_SCHED;
            PG8_LDB(B1, 1, 1); PG8_STAGE(PG8_SB(1, 0), b3, voffB);
            PG8_BAR; PG8_WAIT_L(0); PG8_MMA(0, 1, At, B1); PG8_BAR;
            PG8_LDA(At, 1, 1); PG8_STAGE(PG8_SA(1, 0), a3, voffA);
            PG8_BAR; PG8_WAIT_L(0); PG8_MMA(1, 0, At, B0); PG8_BAR; PG8_SCHED;
            PG8_STAGE(PG8_SB(1, 1), b3 + hstep, voffB);
            PG8_WAIT_V(6); PG8_BAR; PG8_MMA(1, 1, At, B1); PG8_BAR;
        }
        PG8_STAMP();
        if constexpr (!Epi::AFTER_DRAIN) { E(acc, cur, wr, wc, fr, fq); S.done(cur); }
        PG8_STAMP();
        if (!has_next) break;
#pragma unroll
        for (int a = 0; a < 2; ++a)
#pragma unroll
            for (int b = 0; b < 2; ++b)
#pragma unroll
                for (int m = 0; m < 4; ++m)
#pragma unroll
                    for (int n = 0; n < 2; ++n) acc[a][b][m][n] = (f32x4){0.f, 0.f, 0.f, 0.f};
        cur = nxt; cA = nA; cB = nB; ++ui;
    }
    PG8_WAIT_V(0);
    if (wr == 0) PG8_BAR;
    PG8_BAR;
    if constexpr (Epi::AFTER_DRAIN) { E.fused(acc, cur, wr, wc, fr, fq, lds, wid, lane); S.done(cur); }
    PG8_STAMP();
    if (STAMP && wid == 0) { stamps[lane] = lane < nts ? (((unsigned long long)(unsigned)ts_hi << 32) | (unsigned)ts_lo) : 0ull;
        if (lane == 62) stamps[62] = rt_entry; if (lane == 63) stamps[63] = (unsigned long long)wall_clock64(); }
#undef PG8_STAMP
#undef PG8_SA
#undef PG8_SB
#undef PG8_STAGE
#undef PG8_LDA
#undef PG8_LDB
#undef PG8_MMA
#undef PG8_WAIT_V
#undef PG8_WAIT_L
#undef PG8_BAR
#undef PG8_SCHED
}
}
#define XB_TMO      128
#define XB_XCNT(j)  (256  + 64 * (j))
#define XB_XSUB(j)  (1280 + 64 * (j))
#define XB_XGEN(j)  (2304 + 64 * (j))
#define XB_TOP      3328
#define XB_TOPGEN   3392
#define XCD_BAR_WORDS 3456
#define XB_SPIN_CAP (1u << 18)
#define LAS __attribute__((address_space(3)))

__device__ __forceinline__ unsigned xb_ld(unsigned* p)              { return __hip_atomic_load(p, __ATOMIC_RELAXED, __HIP_MEMORY_SCOPE_AGENT); }
__device__ __forceinline__ unsigned xb_add(unsigned* p, unsigned v) { return __hip_atomic_fetch_add(p, v, __ATOMIC_RELAXED, __HIP_MEMORY_SCOPE_AGENT); }
__device__ __forceinline__ unsigned xb_xcc_id() { return (unsigned)__builtin_amdgcn_s_getreg((3 << 11) | 20) & 0xFu; }
#define XB_SPIN(cond, bar) do { unsigned _sp = 0; while (cond) { __builtin_amdgcn_s_sleep(1); \
    if ((++_sp & 255u) == 0u) { if (xb_ld(&(bar)[XB_TMO])) break; if (_sp > XB_SPIN_CAP) { atomicAdd(&(bar)[XB_TMO], 1u); break; } } } } while (0)

struct XcdBarrier {
    unsigned* bar; unsigned x;
    volatile LAS unsigned* st;
};

__device__ __forceinline__ XcdBarrier xcd_barrier_post(unsigned* bar, volatile LAS unsigned* st) {
    XcdBarrier b; b.bar = bar; b.x = xb_xcc_id(); b.st = st;
    if (threadIdx.x == 0) (void)xb_add(&bar[XB_XCNT(b.x)], 1u);
    return b;
}
__device__ __forceinline__ void xcd_barrier_complete(unsigned* bar, unsigned x, unsigned& nloc, unsigned& nx) {
    const unsigned G = gridDim.x * gridDim.y * gridDim.z;
    unsigned sum, cnt, mine, sp = 0u;
    for (;;) {
        sum = 0u; cnt = 0u; mine = 0u;
#pragma unroll
        for (unsigned j = 0; j < 16; ++j) { const unsigned c = xb_ld(&bar[XB_XCNT(j)]); sum += c; cnt += (c > 0u) ? 1u : 0u; mine = (j == x) ? c : mine; }
        if (sum == G) break;
        __builtin_amdgcn_s_sleep(1);
        if ((++sp & 255u) == 0u) { if (xb_ld(&bar[XB_TMO])) break; if (sp > XB_SPIN_CAP) { atomicAdd(&bar[XB_TMO], 1u); break; } }
    }
    nloc = mine > 0u ? mine : 1u; nx = cnt > 0u ? cnt : 1u;
}

__device__ __forceinline__ void xcd_barrier(const XcdBarrier& b) {
    asm volatile("s_waitcnt vmcnt(0)" ::: "memory");
    __syncthreads();
    if (threadIdx.x == 0) {
        unsigned* bar = b.bar;
        __builtin_amdgcn_s_waitcnt(0);
        unsigned nloc = b.st[0], nx = b.st[1];
        if (nloc == 0u) { xcd_barrier_complete(bar, b.x, nloc, nx); b.st[0] = nloc; b.st[1] = nx; }
        const unsigned old = xb_add(&bar[XB_XSUB(b.x)], 1u);
        const unsigned gen = old / nloc;
        if (old + 1u == (gen + 1u) * nloc) {
            __builtin_amdgcn_fence(__ATOMIC_RELEASE, "agent");
            asm volatile("s_waitcnt vmcnt(0)" ::: "memory");
            const unsigned og = xb_add(&bar[XB_TOP], 1u);
            const unsigned tg = og / nx;
            if (og + 1u == (tg + 1u) * nx) xb_add(&bar[XB_TOPGEN], 1u);
            else XB_SPIN(xb_ld(&bar[XB_TOPGEN]) == tg, bar);
            __builtin_amdgcn_fence(__ATOMIC_ACQUIRE, "agent");
            xb_add(&bar[XB_XGEN(b.x)], 1u);
            asm volatile("s_waitcnt vmcnt(0)" ::: "memory");
        } else {
            XB_SPIN(xb_ld(&bar[XB_XGEN(b.x)]) == gen, bar);
            __builtin_amdgcn_fence(__ATOMIC_ACQUIRE, "agent");
            asm volatile("s_waitcnt vmcnt(0)" ::: "memory");
        }
    }
    __syncthreads();
}

namespace mk {
using pg8::bf16_t; using pg8::bf16x8; using pg8::f32x4; using pg8::u32x4;
typedef unsigned u32x2 __attribute__((ext_vector_type(2)));
typedef short bf16x4 __attribute__((ext_vector_type(4)));
typedef float lf2 __attribute__((ext_vector_type(2)));
typedef float lf4 __attribute__((ext_vector_type(4)));
typedef unsigned lu4 __attribute__((ext_vector_type(4)));

constexpr int D = 1024, NBATCH = 16, SEQ = 2048, CTXL = 256;
constexpr int NLAT = NBATCH * SEQ, NCTX = NBATCH * CTXL, NROW = NLAT + NCTX;
constexpr int NINP = 3072, NIN = 2944;
constexpr int C_Q = 256, C_K = 640, C_V = 1024, C_Z = 1408;
constexpr int DE = 2816;
constexpr int XROWS = 4608;
constexpr int NTHR = 512;
constexpr int LDS_MISC = 131072, LDS_BYTES = 131072 + 256;

constexpr size_t al256(size_t x) { return (x + 255) & ~(size_t)255; }
constexpr size_t WS_CTL = 0;
constexpr size_t WS_MOD = 65536;
constexpr size_t WS_SW = al256(WS_MOD + (size_t)2 * 17 * 6144 * 4);
constexpr size_t SW_W2T = 0, SW_A2T = 98304, SW_G2T = 196608, SW_GLUT = 294912, SW_S5E = 425984, SW_S5W2 = 2523136, SW_STRIDE = 6717440;
constexpr size_t WS_WIN = al256(WS_SW + 2 * SW_STRIDE);
constexpr size_t WS_WOUT = WS_WIN + (size_t)3072 * 1024 * 2;
constexpr size_t WS_WGU = WS_WOUT + (size_t)1024 * 1024 * 2;
constexpr size_t WS_WD = WS_WGU + (size_t)16 * 5632 * 1024 * 2;
constexpr size_t WS_XB = WS_WD + (size_t)16 * 1024 * 2816 * 2;
constexpr size_t WS_CTXA = WS_XB + (size_t)NLAT * D * 4;
constexpr size_t WS_CTXB = WS_CTXA + (size_t)NCTX * D * 4;
constexpr size_t WS_ABUF = WS_CTXB + (size_t)NCTX * D * 4;
constexpr size_t WS_AFF = WS_ABUF + (size_t)NROW * D * 2;
constexpr size_t WS_SLOT = WS_AFF + (size_t)NROW * 16 * 4;
constexpr size_t WS_SELG = WS_SLOT + (size_t)NROW * 16 * 4;
constexpr size_t WS_SW8 = al256(WS_SELG + (size_t)16 * XROWS * 4);
constexpr size_t WS_SX = WS_SW8 + (size_t)16 * 5632 * 4;
constexpr size_t WS_SXS = WS_SX + (size_t)NROW * 4;
constexpr size_t WS_SWIN = WS_SXS + (size_t)16 * XROWS * 4;
constexpr size_t WS_SH = WS_SWIN + (size_t)3072 * 4;
constexpr size_t WS_SWD = WS_SH + (size_t)NROW * 4;
constexpr size_t WS_U = al256(WS_SWD + (size_t)16 * 1024 * 4);
constexpr size_t SZ384 = (size_t)NROW * 384 * 2;
constexpr size_t U_P = WS_U;
constexpr size_t U_QR = U_P + (size_t)NROW * NINP * 2;
constexpr size_t U_KR = U_QR + SZ384;
constexpr size_t U_VT = U_KR + SZ384;
constexpr size_t U_VTC = U_VT + (size_t)16 * 384 * 2048 * 2;
constexpr size_t U_RS = U_VT + SZ384;
constexpr size_t U_KS = U_RS + SZ384;
constexpr size_t U_VS = U_KS + SZ384;
constexpr size_t U_KK = U_VS + SZ384;
constexpr size_t U_ALR = U_KK + SZ384;
constexpr size_t U_LD = U_ALR + SZ384;
constexpr size_t U_AG = U_LD + 2 * SZ384;
constexpr size_t U_G = U_AG + 2 * SZ384;
constexpr size_t U_YRK = U_G + SZ384;
constexpr size_t U_SLOC = U_YRK + 2 * (size_t)NROW * 384 * 4;
constexpr size_t U_SPREV = U_SLOC + (size_t)2304 * 16 * 256 * 4;
constexpr size_t U_YG = U_SPREV + (size_t)2304 * 16 * 256 * 2;
constexpr size_t U_U16 = U_YG + (size_t)NROW * 256 * 2;
constexpr size_t U_MIX_END = U_U16 + (size_t)NROW * 256 * 2;
constexpr int NCHUNK = 192 * 144;
constexpr size_t CH_XP = U_P;
constexpr size_t CH_BK = CH_XP + (size_t)NCHUNK * 4096;
constexpr size_t CH_UL = CH_BK + (size_t)NCHUNK * 4096;
constexpr size_t CH_MM = U_SLOC;
constexpr size_t CH_GT = CH_MM + (size_t)NCHUNK * 1024;
static_assert(CH_UL + (size_t)NCHUNK * 2048 <= U_RS, "chunk buffers overlap live RWKV operands");
static_assert(CH_GT + (size_t)NCHUNK * 256 <= U_SPREV, "chunk buffers overlap S5 states");
constexpr size_t U_Y = WS_U;
constexpr size_t U_XSEL = U_Y + (size_t)NROW * D * 4;
constexpr size_t U_HID = U_XSEL + (size_t)16 * XROWS * 1024 * 2;
constexpr size_t U_YEXP = U_HID + (size_t)16 * XROWS * DE * 2;
constexpr size_t U_FFN_END = U_YEXP + (size_t)16 * XROWS * 1024 * 2;
constexpr size_t WS_END = U_MIX_END > U_FFN_END ? U_MIX_END : U_FFN_END;

struct Params { const float* in[35]; float* out; unsigned char* ws; int ph_lo, ph_hi, use_bar, pad; };

typedef __bf16 hwbf2 __attribute__((ext_vector_type(2)));
__device__ __forceinline__ unsigned pack2(float lo, float hi) { const lf2 v = {lo, hi}; return __builtin_bit_cast(unsigned, __builtin_convertvector(v, hwbf2)); }
__device__ __forceinline__ bf16_t f2bf(float f) { return (bf16_t)(pack2(f, 0.f) & 0xffffu); }
__device__ __forceinline__ float bflo(unsigned w) { return __uint_as_float(w << 16); }
__device__ __forceinline__ float bfhi(unsigned w) { return __uint_as_float(w & 0xffff0000u); }
__device__ __forceinline__ float bf2f(bf16_t b) { return __uint_as_float(((unsigned)b) << 16); }
__device__ __forceinline__ float sigm(float x) { return 1.0f / (1.0f + __expf(-x)); }
__device__ __forceinline__ float wave_sum(float v) {
#pragma unroll
    for (int o = 32; o >= 1; o >>= 1) v += __shfl_xor(v, o);
    return v; }
__device__ __forceinline__ void unpack8(const uint4 w, float (&f)[8]) { f[0] = bflo(w.x); f[1] = bfhi(w.x); f[2] = bflo(w.y); f[3] = bfhi(w.y); f[4] = bflo(w.z); f[5] = bfhi(w.z); f[6] = bflo(w.w); f[7] = bfhi(w.w); }
__device__ __forceinline__ uint4 pack8(const float (&f)[8]) { uint4 w; w.x = pack2(f[0], f[1]); w.y = pack2(f[2], f[3]); w.z = pack2(f[4], f[5]); w.w = pack2(f[6], f[7]); return w; }
__device__ __forceinline__ const float* xrow(const float* lat, const float* ctx, int r) { return r < NLAT ? lat + (size_t)r * D : ctx + (size_t)(r - NLAT) * D; }
__device__ __forceinline__ float* xrow_w(float* lat, float* ctx, int r) { return r < NLAT ? lat + (size_t)r * D : ctx + (size_t)(r - NLAT) * D; }
__device__ __forceinline__ f32x4 mfma16(bf16x8 a, bf16x8 b, f32x4 c) { return __builtin_amdgcn_mfma_f32_16x16x32_bf16(a, b, c, 0, 0, 0); }

__device__ __forceinline__ void tr_tile(const float* __restrict__ src, int ldsrc, int k0, int n0, bf16_t* __restrict__ dst, int lddst, int drow0, LAS unsigned* T) {
    const int tid = threadIdx.x, n4 = tid & 15, kq = tid >> 4;
    const float4 a = *(const float4*)(src + (size_t)(k0 + 2 * kq) * ldsrc + n0 + 4 * n4);
    const float4 b = *(const float4*)(src + (size_t)(k0 + 2 * kq + 1) * ldsrc + n0 + 4 * n4);
    T[(4 * n4 + 0) * 33 + kq] = pack2(a.x, b.x); T[(4 * n4 + 1) * 33 + kq] = pack2(a.y, b.y);
    T[(4 * n4 + 2) * 33 + kq] = pack2(a.z, b.z); T[(4 * n4 + 3) * 33 + kq] = pack2(a.w, b.w);
    __syncthreads();
    const int n = tid >> 3, pc = tid & 7;
    uint4 v; v.x = T[n * 33 + 4 * pc]; v.y = T[n * 33 + 4 * pc + 1]; v.z = T[n * 33 + 4 * pc + 2]; v.w = T[n * 33 + 4 * pc + 3];
    *(uint4*)(dst + (size_t)(drow0 + n) * lddst + k0 + 8 * pc) = v;
    __syncthreads();
}

__device__ __forceinline__ void tr_tile4(const float* __restrict__ src, int ldsrc, int k0, int n0, bf16_t* __restrict__ dst, int lddst, int drow0, LAS unsigned* T) {
    const int tid = threadIdx.x, n4 = tid & 15, kq = tid >> 4;
    float4 a[4], b[4];
#pragma unroll
    for (int t = 0; t < 4; ++t) { a[t] = *(const float4*)(src + (size_t)(k0 + 2 * kq) * ldsrc + n0 + 64 * t + 4 * n4); b[t] = *(const float4*)(src + (size_t)(k0 + 2 * kq + 1) * ldsrc + n0 + 64 * t + 4 * n4); }
#pragma unroll
    for (int t = 0; t < 4; ++t) { LAS unsigned* Tt = T + t * 64 * 33;
        Tt[(4 * n4 + 0) * 33 + kq] = pack2(a[t].x, b[t].x); Tt[(4 * n4 + 1) * 33 + kq] = pack2(a[t].y, b[t].y); Tt[(4 * n4 + 2) * 33 + kq] = pack2(a[t].z, b[t].z); Tt[(4 * n4 + 3) * 33 + kq] = pack2(a[t].w, b[t].w); }
    __syncthreads();
#pragma unroll
    for (int i = 0; i < 4; ++i) { const int idx = tid + NTHR * i, n = idx >> 3, pc = idx & 7;
        uint4 v; v.x = T[n * 33 + 4 * pc]; v.y = T[n * 33 + 4 * pc + 1]; v.z = T[n * 33 + 4 * pc + 2]; v.w = T[n * 33 + 4 * pc + 3];
        *(uint4*)(dst + (size_t)(drow0 + n) * lddst + k0 + 8 * pc) = v; }
    __syncthreads();
}
template <int NK, int DP, bool FP8> __device__ __forceinline__ void q8_strip(const float* __restrict__ src, int ldsrc, unsigned char* __restrict__ dst, float* __restrict__ scl, LAS unsigned char* lds) {
    LAS float* cmax = (LAS float*)lds;
    LAS unsigned char* T = lds + 8704;
    const int tid = threadIdx.x, n4 = tid & 15, kq = tid >> 4; constexpr float QMAX = FP8 ? 256.0f : 127.0f;
    float mx[4] = {0.f, 0.f, 0.f, 0.f};
#pragma unroll 8
    for (int i = 0; i < 2 * NK; ++i) { const float4 v = *(const float4*)(src + (size_t)(kq + 32 * i) * ldsrc + 4 * n4); mx[0] = fmaxf(mx[0], fabsf(v.x)); mx[1] = fmaxf(mx[1], fabsf(v.y)); mx[2] = fmaxf(mx[2], fabsf(v.z)); mx[3] = fmaxf(mx[3], fabsf(v.w)); }
    __syncthreads();
#pragma unroll
    for (int j = 0; j < 4; ++j) cmax[kq * 64 + 4 * n4 + j] = mx[j];
    __syncthreads();
    if (tid < 64) { float m = 0.f; for (int g = 0; g < 32; ++g) m = fmaxf(m, cmax[g * 64 + tid]); m = fmaxf(m, 1e-20f); scl[tid] = m * (1.0f / QMAX); cmax[32 * 64 + tid] = QMAX / m; }
    __syncthreads();
    float inv[4];
#pragma unroll
    for (int j = 0; j < 4; ++j) inv[j] = cmax[32 * 64 + 4 * n4 + j];
    for (int kg = 0; kg < NK / 4; ++kg) {
        float4 a[4], b[4];
#pragma unroll
        for (int t = 0; t < 4; ++t) { const int kb = (kg * 4 + t) * 64 + 2 * kq; a[t] = *(const float4*)(src + (size_t)kb * ldsrc + 4 * n4); b[t] = *(const float4*)(src + (size_t)(kb + 1) * ldsrc + 4 * n4); }
#pragma unroll
        for (int t = 0; t < 4; ++t) { const float av[4] = {a[t].x, a[t].y, a[t].z, a[t].w}, bv[4] = {b[t].x, b[t].y, b[t].z, b[t].w};
#pragma unroll
            for (int j = 0; j < 4; ++j) { unsigned short w;
                if (FP8) w = (unsigned short)(__builtin_amdgcn_cvt_pk_fp8_f32(av[j] * inv[j], bv[j] * inv[j], 0, false) & 0xffff);
                else { const int q0 = __float2int_rn(av[j] * inv[j]), q1 = __float2int_rn(bv[j] * inv[j]); w = (unsigned short)((q0 & 255) | ((q1 & 255) << 8)); }
                *(LAS unsigned short*)(T + (4 * n4 + j) * 272 + t * 64 + 2 * kq) = w; } }
        __syncthreads();
#pragma unroll
        for (int i = 0; i < 2; ++i) { const int idx = tid + NTHR * i, n = idx >> 4, pc = idx & 15; *(lu4*)(dst + (size_t)n * DP + kg * 256 + 16 * pc) = *(const LAS lu4*)(T + n * 272 + 16 * pc); }
        __syncthreads();
    }
}
__device__ __forceinline__ void gu_strip(const Params& p, int l, int item, LAS unsigned char* lds) {
    const int e = item / 88, rem = item % 88, up = rem / 44, nt = rem % 44, n0 = nt * 64, drow0 = (n0 >> 7) * 256 + (n0 & 127) + (up ? 128 : 0);
    q8_strip<16, 1024, false>(p.in[up ? 33 : 32] + (size_t)(l * 16 + e) * 1024 * DE + n0, DE, p.ws + WS_WGU + ((size_t)e * 5632 + drow0) * 1024, (float*)(p.ws + WS_SW8) + (size_t)e * 5632 + drow0, lds);
}
constexpr int CV_GU = 16 * 88, CV_D4 = 16 * 16, CV_WIN = 46, CV_PAD = 16, CV_WOUT4 = 16 * 4, CV_TOTAL = CV_GU + CV_D4 + CV_WIN + CV_PAD + CV_WOUT4;
__device__ __forceinline__ void convert_weights(const Params& p, int l, LAS unsigned char* lds, int vb, int nvb) {
    LAS unsigned* T = (LAS unsigned*)lds; bf16_t* WOUT = (bf16_t*)(p.ws + WS_WOUT);
    for (int it = vb; it < CV_TOTAL; it += nvb) {
        int j = it;
        if (j < CV_GU) { gu_strip(p, l, j, lds); continue; }
        j -= CV_GU;
        if (j < CV_D4) { const int e = j >> 4, nt = j & 15;
            q8_strip<44, DE, true>(p.in[34] + (size_t)(l * 16 + e) * DE * 1024 + nt * 64, 1024, p.ws + WS_WD + ((size_t)e * 1024 + nt * 64) * DE, (float*)(p.ws + WS_SWD) + e * 1024 + nt * 64, lds); continue; }
        j -= CV_D4;
        if (j < CV_WIN) { q8_strip<16, 1024, false>(p.in[7] + (size_t)l * 1024 * NIN + j * 64, NIN, p.ws + WS_WIN + (size_t)j * 64 * 1024, (float*)(p.ws + WS_SWIN) + j * 64, lds); continue; }
        j -= CV_WIN;
        if (j < CV_PAD) { const size_t o = (size_t)NIN * 1024 + ((size_t)j * NTHR + threadIdx.x) * 16; *(uint4*)(p.ws + WS_WIN + o) = make_uint4(0u, 0u, 0u, 0u);
            if (j == 0 && threadIdx.x < 128) ((float*)(p.ws + WS_SWIN))[NIN + threadIdx.x] = 0.f; continue; }
        j -= CV_PAD;
        { const int kt = j >> 2, ng = j & 3; tr_tile4(p.in[8] + (size_t)l * 1024 * 1024, 1024, kt * 64, ng * 256, WOUT, 1024, ng * 256, T); }
    }
}

__device__ __forceinline__ void mod_item(const Params& p, int item, LAS unsigned char* lds) {
    LAS float* sc = (LAS float*)lds;
    LAS float* red = (LAS float*)(lds + 69632);
    const int tid = threadIdx.x, l = item / 96, cg = item % 96;
    for (int i = tid; i < 17 * 1024; i += NTHR) { const int b = i >> 10, k = i & 1023; const float c = b < 16 ? p.in[1][b * 1024 + k] : p.in[3][k]; sc[k * 17 + b] = c * sigm(c); }
    __syncthreads();
    const int col = cg * 64 + (tid & 63), kg = tid >> 6;
    float acc[17];
#pragma unroll
    for (int b = 0; b < 17; ++b) acc[b] = 0.f;
    const float* w = p.in[4] + ((size_t)l * 1024 + kg * 128) * 6144 + col;
#pragma unroll 4
    for (int kk = 0; kk < 128; ++kk) { const float wv = w[(size_t)kk * 6144]; const LAS float* s = sc + (kg * 128 + kk) * 17;
#pragma unroll
        for (int b = 0; b < 17; ++b) acc[b] += s[b] * wv; }
#pragma unroll
    for (int b = 0; b < 17; ++b) red[(kg * 17 + b) * 64 + (tid & 63)] = acc[b];
    __syncthreads();
    for (int i = tid; i < 17 * 64; i += NTHR) { const int b = i >> 6, c = i & 63; float s = 0.f;
#pragma unroll
        for (int g = 0; g < 8; ++g) s += red[(g * 17 + b) * 64 + c];
        ((float*)(p.ws + WS_MOD))[((size_t)l * 17 + b) * 6144 + cg * 64 + c] = s + p.in[5][l * 6144 + cg * 64 + c]; }
    __syncthreads();
}

__device__ __forceinline__ void s5mat_item(const Params& p, int item, LAS unsigned char* lds) {
    LAS lf2* pw = (LAS lf2*)lds;
    LAS lf2* bb = (LAS lf2*)(lds + 17408);
    LAS lf2* cc = (LAS lf2*)(lds + 17408 + 16384);
    LAS float* KT = (LAS float*)(lds + 17408 + 32768);
    const int tid = threadIdx.x, l = item >> 4, g = item & 15;
    for (int i = tid; i < 2 * 17 * 64; i += NTHR) { const int pp = i & 63, n = (i >> 6) % 17, d = i / (17 * 64);
        const int li = ((l * 2 + d) * 16 + g) * 64 + pp; const float lr = p.in[9][li], lim = p.in[10][li], dt = expf(p.in[11][(l * 2 + d) * 16 + g]);
        const float mag = expf((float)n * dt * lr); float s, c; sincosf((float)n * dt * lim, &s, &c); pw[i] = (lf2){mag * c, mag * s}; }
    for (int i = tid; i < 2 * 64 * 16; i += NTHR) { const int h = i & 15, pp = (i >> 4) & 63, d = i >> 10;
        const int li = ((l * 2 + d) * 16 + g) * 64 + pp; const float lr = p.in[9][li], lim = p.in[10][li], dt = expf(p.in[11][(l * 2 + d) * 16 + g]);
        const float mag = expf(dt * lr); float s, c; sincosf(dt * lim, &s, &c); const float x = mag * c - 1.0f, y = mag * s;
        const float den = 1.0f / (lr * lr + lim * lim); const float cr = (x * lr + y * lim) * den, ci = (y * lr - x * lim) * den;
        const int bi = ((l * 16 + g) * 64 + pp) * 16 + h; const float br = p.in[12][bi], bim = p.in[13][bi];
        bb[i] = (lf2){cr * br - ci * bim, cr * bim + ci * br}; }
    for (int i = tid; i < 2 * 16 * 64; i += NTHR) { const int pp = i & 63, h = (i >> 6) & 15, d = i >> 10;
        const int ci = (((l * 2 + d) * 16 + g) * 16 + h) * 64 + pp; cc[i] = (lf2){p.in[14][ci], p.in[15][ci]}; }
    __syncthreads();
    for (int i = tid; i < 2 * 16 * 256; i += NTHR) { const int h2 = i & 15, h = (i >> 4) & 15, tau = (i >> 8) & 15, d = i >> 12; float s = 0.f;
        for (int pp = 0; pp < 64; ++pp) { const lf2 c = cc[(d * 16 + h) * 64 + pp], w = pw[(d * 17 + tau) * 64 + pp], b = bb[(d * 64 + pp) * 16 + h2];
            const float tr = c.x * w.x - c.y * w.y, ti = c.x * w.y + c.y * w.x; s += tr * b.x - ti * b.y; }
        KT[i] = s; }
    __syncthreads();
    bf16_t* E = (bf16_t*)(p.ws + WS_SW + (size_t)l * SW_STRIDE + SW_S5E) + (size_t)g * 256 * 256;
    bf16_t* W2 = (bf16_t*)(p.ws + WS_SW + (size_t)l * SW_STRIDE + SW_S5W2) + (size_t)g * 256 * 512;
    for (int i = tid; i < 256 * 256; i += NTHR) { const int k = i & 255, n = i >> 8; const int s = k >> 4, h = k & 15, d = n >> 7, part = (n >> 6) & 1, pp = n & 63;
        const int e = d == 0 ? 15 - s : s; const lf2 w = pw[(d * 17 + e) * 64 + pp], b = bb[(d * 64 + pp) * 16 + h];
        E[i] = f2bf(part ? (w.x * b.y + w.y * b.x) : (w.x * b.x - w.y * b.y)); }
    for (int i = tid; i < 256 * 512; i += NTHR) { const int k = i & 511, n = i >> 9; const int t = n >> 4, h = n & 15; float v;
        if (k < 256) { const int s = k >> 4, h2 = k & 15; v = 0.f;
            if (t >= s) v += KT[((0 * 16 + (t - s)) * 16 + h) * 16 + h2];
            if (s >= t) v += KT[((1 * 16 + (s - t)) * 16 + h) * 16 + h2];
            if (s == t && h == h2) v += p.in[16][l * 256 + g * 16 + h]; }
        else { const int q = k - 256, d = q >> 7, part = (q >> 6) & 1, pp = q & 63; const int e = d == 0 ? t + 1 : 16 - t;
            const lf2 c = cc[(d * 16 + h) * 64 + pp], w = pw[(d * 17 + e) * 64 + pp];
            v = part ? -(c.x * w.y + c.y * w.x) : (c.x * w.x - c.y * w.y); }
        W2[i] = f2bf(v); }
    __syncthreads();
}

__device__ __forceinline__ void smallw_item(const Params& p, int item) {
    int i = item * NTHR + threadIdx.x; const int l = i / 212992; i %= 212992;
    unsigned char* sw = p.ws + WS_SW + (size_t)l * SW_STRIDE;
    if (i < 49152) { const int k = i & 63, n = (i >> 6) % 384, d = i / 24576; ((bf16_t*)(sw + SW_W2T))[i] = f2bf(p.in[22][((size_t)(l * 2 + d) * 64 + k) * 384 + n]); return; }
    i -= 49152;
    if (i < 49152) { const int k = i & 63, n = (i >> 6) % 384, d = i / 24576; ((bf16_t*)(sw + SW_A2T))[i] = f2bf(p.in[24][((size_t)(l * 2 + d) * 64 + k) * 384 + n]); return; }
    i -= 49152;
    if (i < 49152) { const int k = i & 127, n = i >> 7; ((bf16_t*)(sw + SW_G2T))[i] = f2bf(p.in[25][((size_t)l * 128 + k) * 384 + n]); return; }
    i -= 49152;
    { const int k = i & 255, n = i >> 8; ((bf16_t*)(sw + SW_GLUT))[i] = f2bf(p.in[17][((size_t)l * 256 + k) * 256 + n]); }
}

constexpr int PRO_MOD = 192, PRO_S5 = 32, PRO_SW = 832;
__device__ __forceinline__ void phase_prologue(const Params& p, LAS unsigned char* lds) {
    for (int it = blockIdx.x; it < PRO_MOD + PRO_S5 + PRO_SW; it += gridDim.x) {
        if (it < PRO_MOD) mod_item(p, it, lds);
        else if (it < PRO_MOD + PRO_S5) s5mat_item(p, it - PRO_MOD, lds);
        else smallw_item(p, it - PRO_MOD - PRO_S5);
    }
    convert_weights(p, 0, lds, (int)blockIdx.x, (int)gridDim.x);
}

__device__ __forceinline__ void hnorm_row(const float* g, const float* mb_sh, const float* mb_sc, unsigned char* dst, float* sdst, int lane, const float4 (&v)[4]) {
    float ss = 0.f;
#pragma unroll
    for (int i = 0; i < 4; ++i) ss += v[i].x * v[i].x + v[i].y * v[i].y + v[i].z * v[i].z + v[i].w * v[i].w;
    ss = wave_sum(ss); const float rs = rsqrtf(ss * (1.0f / 1024.0f) + 1e-6f);
    float hv[4][4]; float amax = 0.f;
#pragma unroll
    for (int i = 0; i < 4; ++i) { const int c = i * 256 + lane * 4; const float4 gg = *(const float4*)(g + c), sh = *(const float4*)(mb_sh + c), sc = *(const float4*)(mb_sc + c);
        hv[i][0] = v[i].x * rs * gg.x * (1.f + sc.x) + sh.x; hv[i][1] = v[i].y * rs * gg.y * (1.f + sc.y) + sh.y; hv[i][2] = v[i].z * rs * gg.z * (1.f + sc.z) + sh.z; hv[i][3] = v[i].w * rs * gg.w * (1.f + sc.w) + sh.w;
        amax = fmaxf(amax, fmaxf(fmaxf(fabsf(hv[i][0]), fabsf(hv[i][1])), fmaxf(fabsf(hv[i][2]), fabsf(hv[i][3])))); }
#pragma unroll
    for (int o = 32; o >= 1; o >>= 1) amax = fmaxf(amax, __shfl_xor(amax, o));
    amax = fmaxf(amax, 1e-20f); const float qs = 127.0f / amax;
    if (lane == 0) *sdst = amax * (1.0f / 127.0f);
#pragma unroll
    for (int i = 0; i < 4; ++i) { unsigned w = 0u;
#pragma unroll
        for (int k = 0; k < 4; ++k) w |= ((unsigned)__float2int_rn(hv[i][k] * qs) & 255u) << (8 * k);
        *(unsigned*)(dst + i * 256 + lane * 4) = w; }
}
__device__ __forceinline__ void phase_hnorm(const Params& p, int l, const float* xl, const float* xc) {
    const int lane = threadIdx.x & 63, wv = threadIdx.x >> 6;
    const float* mod = (const float*)(p.ws + WS_MOD) + (size_t)l * 17 * 6144; const float* g = p.in[6] + (l * 4 + 0) * 1024;
    unsigned char* A = p.ws + WS_ABUF; float* SH = (float*)(p.ws + WS_SH);
    for (int r = blockIdx.x * 8 + wv; r < NROW; r += gridDim.x * 8) {
        const float* src = xrow(xl, xc, r); const int b = r < NLAT ? (r >> 11) : 16; const float* mb = mod + (size_t)b * 6144;
        float4 v[4];
#pragma unroll
        for (int i = 0; i < 4; ++i) v[i] = *(const float4*)(src + i * 256 + lane * 4);
        hnorm_row(g, mb, mb + 1024, A + (size_t)r * 1024, SH + r, lane, v);
    }
}


__device__ __forceinline__ void phase_prep(const Params& p, int l, LAS unsigned char* lds) {
    LAS bf16_t* vt = (LAS bf16_t*)lds;
    LAS lf2* cs = (LAS lf2*)(lds + 50176);
    const int tid = threadIdx.x;
    for (int i = tid; i < 1024; i += NTHR) { const int pos = i >> 4, j = i & 15; const float invf = exp2f(-(float)j * (13.287712379549449f / 16.0f)); float s, c; sincosf((float)pos * invf, &s, &c); cs[i] = (lf2){c, s}; }
    __syncthreads();
    const bf16_t* P = (const bf16_t*)(p.ws + U_P);
    bf16_t* QR = (bf16_t*)(p.ws + U_QR); bf16_t* KR = (bf16_t*)(p.ws + U_KR);
    bf16_t* RS = (bf16_t*)(p.ws + U_RS); bf16_t* KS = (bf16_t*)(p.ws + U_KS); bf16_t* VS = (bf16_t*)(p.ws + U_VS); bf16_t* KK = (bf16_t*)(p.ws + U_KK); bf16_t* ALR = (bf16_t*)(p.ws + U_ALR);
    for (int ti = blockIdx.x; ti < NROW / 64; ti += gridDim.x) {
        const int r0 = ti * 64; const bool lat = r0 < NLAT; const int b = lat ? (r0 >> 11) : ((r0 - NLAT) >> 8), t0 = lat ? (r0 & 2047) : ((r0 - NLAT) & 255), slen = lat ? SEQ : CTXL;
#pragma unroll
        for (int i = 0; i < 6; ++i) { const int idx = tid + NTHR * i, tok = idx / 48, pc = idx % 48;
            *(LAS lu4*)(vt + tok * 392 + pc * 8) = *(const lu4*)(P + (size_t)(r0 + tok) * NINP + C_V + pc * 8); }
        __syncthreads();
        { bf16_t* vdst = lat ? (bf16_t*)(p.ws + U_VT) + (size_t)b * 384 * 2048 + t0 : (bf16_t*)(p.ws + U_VTC) + (size_t)b * 384 * 256 + t0;
#pragma unroll
          for (int i = 0; i < 6; ++i) { const int idx = tid + NTHR * i, hd = idx >> 3, pc = idx & 7; unsigned w[4];
#pragma unroll
              for (int j = 0; j < 4; ++j) w[j] = (unsigned)vt[(pc * 8 + 2 * j) * 392 + hd] | ((unsigned)vt[(pc * 8 + 2 * j + 1) * 392 + hd] << 16);
              *(uint4*)(vdst + (size_t)hd * slen + pc * 8) = make_uint4(w[0], w[1], w[2], w[3]); } }
#pragma unroll
        for (int i = 0; i < 4; ++i) { const int idx = tid + NTHR * i, tok = idx >> 5, pc = idx & 31;
            *(lu4*)((bf16_t*)(p.ws + U_U16) + (size_t)(r0 + tok) * 256 + pc * 8) = *(const lu4*)(P + (size_t)(r0 + tok) * NINP + pc * 8); }
        { lu4 rx[6][2]; int tq = threadIdx.x; asm volatile("" : "+v"(tq));
#pragma unroll
          for (int i = 0; i < 6; ++i) { const int idx = tq + NTHR * i, tok = idx / 48, rem = idx % 48, qk = rem / 24, rem2 = rem % 24, h = rem2 >> 2, pp = rem2 & 3;
              const int d1 = (pp >> 1) * 32 + (pp & 1) * 8; const size_t so = (size_t)(r0 + tok) * NINP + (qk ? C_K : C_Q) + h * 64 + d1;
              rx[i][0] = *(const lu4*)(P + so); rx[i][1] = *(const lu4*)(P + so + 16); }
#pragma unroll
          for (int i = 0; i < 6; ++i) { const int idx = tq + NTHR * i, tok = idx / 48, rem = idx % 48, qk = rem / 24, rem2 = rem % 24, h = rem2 >> 2, pp = rem2 & 3;
              const int d1 = (pp >> 1) * 32 + (pp & 1) * 8;
              float x1[8], x2[8], o1[8], o2[8]; unpack8(make_uint4(rx[i][0].x, rx[i][0].y, rx[i][0].z, rx[i][0].w), x1); unpack8(make_uint4(rx[i][1].x, rx[i][1].y, rx[i][1].z, rx[i][1].w), x2);
              const int t = t0 + tok, pos = (pp < 2) ? (t >> 6) : (t & 63), j0 = (pp & 1) * 8; const float scl = qk ? 1.0f : 0.125f;
#pragma unroll
              for (int j = 0; j < 8; ++j) { lf2 c = cs[pos * 16 + j0 + j]; if (!lat) c = (lf2){1.f, 0.f}; o1[j] = (x1[j] * c.x - x2[j] * c.y) * scl; o2[j] = (x1[j] * c.y + x2[j] * c.x) * scl; }
              bf16_t* dq = (qk ? KR : QR) + (size_t)(r0 + tok) * 384 + h * 64 + d1; *(uint4*)dq = pack8(o1); *(uint4*)(dq + 16) = pack8(o2); } }
#pragma unroll 1
        for (int ig = 0; ig < 6; ++ig) { lu4 zc[4], zq[4], zn[4]; int ts = threadIdx.x; asm volatile("" : "+v"(ts));
#pragma unroll
            for (int u = 0; u < 4; ++u) { const int idx = ts + NTHR * (ig * 4 + u), tok = idx / 192, pc = idx % 192, t = t0 + tok; const bf16_t* zp = P + (size_t)(r0 + tok) * NINP + C_Z + pc * 8;
                zc[u] = *(const lu4*)zp; zq[u] = t > 0 ? *(const lu4*)(zp - NINP) : (lu4){0u, 0u, 0u, 0u}; zn[u] = t < slen - 1 ? *(const lu4*)(zp + NINP) : (lu4){0u, 0u, 0u, 0u}; }
#pragma unroll
            for (int u = 0; u < 4; ++u) { const int idx = ts + NTHR * (ig * 4 + u), tok = idx / 192, pc = idx % 192, c0 = pc * 8, r = r0 + tok;
                float x[8], pv[8], nx[8], zs[8];
                unpack8(make_uint4(zc[u].x, zc[u].y, zc[u].z, zc[u].w), x); unpack8(make_uint4(zq[u].x, zq[u].y, zq[u].z, zq[u].w), pv); unpack8(make_uint4(zn[u].x, zn[u].y, zn[u].z, zn[u].w), nx);
                const float4 mu0 = *(const float4*)(p.in[20] + l * 1536 + c0), mu1 = *(const float4*)(p.in[20] + l * 1536 + c0 + 4); const float mu[8] = {mu0.x, mu0.y, mu0.z, mu0.w, mu1.x, mu1.y, mu1.z, mu1.w};
#pragma unroll
                for (int j = 0; j < 8; ++j) zs[j] = x[j] + (0.5f * (pv[j] + nx[j]) - x[j]) * mu[j];
                const bool isk = c0 >= 384 && c0 < 768; float kv[8]; float ss = 0.f;
                { const int kc = isk ? c0 - 384 : 0; const float4 k0 = *(const float4*)(p.in[26] + l * 384 + kc), k1 = *(const float4*)(p.in[26] + l * 384 + kc + 4); const float kkw[8] = {k0.x, k0.y, k0.z, k0.w, k1.x, k1.y, k1.z, k1.w};
#pragma unroll
                  for (int j = 0; j < 8; ++j) { kv[j] = zs[j] * kkw[j]; ss += kv[j] * kv[j]; } }
                ss += __shfl_xor(ss, 1); ss += __shfl_xor(ss, 2); ss += __shfl_xor(ss, 4);
                if (c0 < 384) *(uint4*)(RS + (size_t)r * 384 + c0) = pack8(zs);
                else if (c0 < 768) { *(uint4*)(KS + (size_t)r * 384 + c0 - 384) = pack8(zs); const float inv = 1.0f / fmaxf(sqrtf(ss), 1e-12f);
#pragma unroll
                    for (int j = 0; j < 8; ++j) kv[j] *= inv;
                    *(uint4*)(KK + (size_t)r * 384 + c0 - 384) = pack8(kv); }
                else if (c0 < 1152) *(uint4*)(VS + (size_t)r * 384 + c0 - 768) = pack8(zs);
                else { const int ac = c0 - 1152; float o[8];
#pragma unroll
                    for (int j = 0; j < 8; ++j) o[j] = ac < 128 ? 1.0f - 2.0f / (1.0f + __expf(2.0f * zs[j])) : (ac < 256 ? zs[j] : sigm(zs[j]));
                    *(uint4*)(ALR + (size_t)r * 384 + ac) = pack8(o); } }
        }
        __syncthreads();
    }
}

template <int KS, int MODE> __device__ __forceinline__ void lr_wave(const Params& p, int l, int row0, int kofs, const bf16_t* Bt, int d) {
    const int lane = threadIdx.x & 63, m = lane & 15, q = lane >> 4;
    const bf16_t* Ap = (const bf16_t*)(p.ws + U_ALR) + (size_t)(row0 + m) * 384 + kofs + q * 8;
    bf16x8 a[KS];
#pragma unroll
    for (int ks = 0; ks < KS; ++ks) a[ks] = *(const bf16x8*)(Ap + ks * 32);
    bf16_t* O = (bf16_t*)(p.ws + (MODE == 0 ? U_LD + (size_t)d * SZ384 : (MODE == 1 ? U_AG + (size_t)d * SZ384 : U_G))) + (size_t)(row0 + m) * 384;
    const float* bias = MODE == 0 ? p.in[21] + (l * 2 + d) * 384 : p.in[23] + (l * 2 + d) * 384;
    for (int nt = 0; nt < 24; ++nt) {
        f32x4 acc = (f32x4){0.f, 0.f, 0.f, 0.f};
#pragma unroll
        for (int ks = 0; ks < KS; ++ks) { const bf16x8 bfr = *(const bf16x8*)(Bt + (size_t)(nt * 16 + m) * (KS * 32) + ks * 32 + q * 8); acc = mfma16(bfr, a[ks], acc); }
        const int n = nt * 16 + q * 4; float o[4];
        if (MODE == 2) {
#pragma unroll
            for (int j = 0; j < 4; ++j) o[j] = acc[j];
        } else { const float4 bv = *(const float4*)(bias + n); const float bb[4] = {bv.x, bv.y, bv.z, bv.w};
#pragma unroll
            for (int j = 0; j < 4; ++j) { const float s = sigm(bb[j] + acc[j]); o[j] = MODE == 0 ? -0.6065306597f * s : s; } }
        u32x2 w; w.x = pack2(o[0], o[1]); w.y = pack2(o[2], o[3]); *(u32x2*)(O + n) = w;
    }
}
template <int KS, int MODE> __device__ __forceinline__ void lr_block(const Params& p, int l, const bf16_t* Bt, int kofs, int d, int bi, int nb, LAS unsigned char* lds) {
    constexpr int PITCH = KS * 32 + 8;
    LAS bf16_t* sB = (LAS bf16_t*)lds; LAS float* sbias = (LAS float*)(lds + 384 * PITCH * 2);
    const int tid = threadIdx.x, lane = tid & 63, m = lane & 15, q = lane >> 4, wv = tid >> 6;
    const float* bias = MODE == 0 ? p.in[21] + (l * 2 + d) * 384 : p.in[23] + (l * 2 + d) * 384;
    __syncthreads();
    for (int i = tid; i < 384 * KS * 4; i += NTHR) { const int n = i / (KS * 4), pc = i % (KS * 4); *(LAS lu4*)(sB + n * PITCH + pc * 8) = *(const lu4*)(Bt + (size_t)n * (KS * 32) + pc * 8); }
    if (MODE != 2) for (int i = tid; i < 384; i += NTHR) sbias[i] = bias[i];
    __syncthreads();
    bf16_t* Ob = (bf16_t*)(p.ws + (MODE == 0 ? U_LD + (size_t)d * SZ384 : (MODE == 1 ? U_AG + (size_t)d * SZ384 : U_G)));
    for (int rt = bi * 8 + wv; rt < 2304; rt += nb * 8) { const int row0 = rt * 16;
        const bf16_t* Ap = (const bf16_t*)(p.ws + U_ALR) + (size_t)(row0 + m) * 384 + kofs + q * 8;
        bf16x8 a[KS];
#pragma unroll
        for (int ks = 0; ks < KS; ++ks) a[ks] = *(const bf16x8*)(Ap + ks * 32);
        bf16_t* O = Ob + (size_t)(row0 + m) * 384;
#pragma unroll 4
        for (int nt = 0; nt < 24; ++nt) {
            f32x4 acc = (f32x4){0.f, 0.f, 0.f, 0.f};
#pragma unroll
            for (int ks = 0; ks < KS; ++ks) acc = mfma16(*(const LAS bf16x8*)(sB + (nt * 16 + m) * PITCH + ks * 32 + q * 8), a[ks], acc);
            const int n = nt * 16 + q * 4; float o[4];
            if (MODE == 2) {
#pragma unroll
                for (int j = 0; j < 4; ++j) o[j] = acc[j];
            } else { const lf4 bv = *(const LAS lf4*)(sbias + n); const float bb[4] = {bv.x, bv.y, bv.z, bv.w};
#pragma unroll
                for (int j = 0; j < 4; ++j) { const float sg = sigm(bb[j] + acc[j]); o[j] = MODE == 0 ? -0.6065306597f * sg : sg; } }
            u32x2 w; w.x = pack2(o[0], o[1]); w.y = pack2(o[2], o[3]); *(u32x2*)(O + n) = w;
        }
    }
    __syncthreads();
}
__device__ __forceinline__ void lowrank_items(const Params& p, int l, int wid, int nw, LAS unsigned char* lds) {
    const unsigned char* sw = p.ws + WS_SW + (size_t)l * SW_STRIDE; const int G = gridDim.x, bx = blockIdx.x;
    if (G >= 12) {
        const int sh = bx * 6 / G, mm = sh < 4 ? sh : 4; const int lo = (mm * G + 5) / 6, hi = mm < 4 ? ((mm + 1) * G + 5) / 6 : G, bi = bx - lo, nb = hi - lo;
        if (mm < 2) lr_block<2, 0>(p, l, (const bf16_t*)(sw + SW_W2T) + (size_t)mm * 384 * 64, mm * 64, mm, bi, nb, lds);
        else if (mm < 4) lr_block<2, 1>(p, l, (const bf16_t*)(sw + SW_A2T) + (size_t)(mm - 2) * 384 * 64, mm * 64, mm - 2, bi, nb, lds);
        else lr_block<4, 2>(p, l, (const bf16_t*)(sw + SW_G2T), 256, 0, bi, nb, lds);
        return; }
    for (int it = wid; it < 2304 * 5; it += nw) { const int rt = it / 5, m = it % 5, row0 = rt * 16;
        if (m < 2) lr_wave<2, 0>(p, l, row0, m * 64, (const bf16_t*)(sw + SW_W2T) + (size_t)m * 384 * 64, m);
        else if (m < 4) lr_wave<2, 1>(p, l, row0, m * 64, (const bf16_t*)(sw + SW_A2T) + (size_t)(m - 2) * 384 * 64, m - 2);
        else lr_wave<4, 2>(p, l, row0, 256, (const bf16_t*)(sw + SW_G2T), 0); }
}

__device__ __forceinline__ int s5_rowbase(int cr) { const int b = cr / 144, c = cr % 144; return c < 16 ? NLAT + b * 256 + c * 16 : b * 2048 + (c - 16) * 16; }
__device__ __forceinline__ void s5_pass1_items(const Params& p, int l, int wid, int nw) {
    const int lane = threadIdx.x & 63, m = lane & 15, q = lane >> 4;
    const bf16_t* P = (const bf16_t*)(p.ws + U_U16); float* SLOC = (float*)(p.ws + U_SLOC);
    for (int it = wid; it < 144 * 16; it += nw) { const int ct = it >> 4, g = it & 15, cr = ct * 16 + m, rb = s5_rowbase(cr);
        const bf16_t* E = (const bf16_t*)(p.ws + WS_SW + (size_t)l * SW_STRIDE + SW_S5E) + (size_t)g * 256 * 256;
        bf16x8 a[8];
#pragma unroll
        for (int ks = 0; ks < 8; ++ks) a[ks] = *(const bf16x8*)(P + (size_t)(rb + 2 * ks + (q >> 1)) * 256 + g * 16 + (q & 1) * 8);
        float* o = SLOC + ((size_t)cr * 16 + g) * 256 + q * 4;
#pragma unroll 2
        for (int nt = 0; nt < 16; ++nt) { f32x4 acc = (f32x4){0.f, 0.f, 0.f, 0.f}; const bf16_t* ep = E + (size_t)(nt * 16 + m) * 256 + q * 8;
#pragma unroll
            for (int ks = 0; ks < 8; ++ks) acc = mfma16(*(const bf16x8*)(ep + ks * 32), a[ks], acc);
            *(f32x4*)(o + nt * 16) = acc; }
    }
}
__device__ __forceinline__ void s5_pass1_block(const Params& p, int l, LAS unsigned char* lds) {
    constexpr int PITCH = 264;
    LAS bf16_t* sE = (LAS bf16_t*)lds;
    const int tid = threadIdx.x, lane = tid & 63, m = lane & 15, q = lane >> 4, wv = tid >> 6, G = gridDim.x, bx = blockIdx.x;
    const int combo = bx & 31, g = combo >> 1, half = combo & 1, bi = bx >> 5, nb = G >> 5;
    const bf16_t* E = (const bf16_t*)(p.ws + WS_SW + (size_t)l * SW_STRIDE + SW_S5E) + ((size_t)g * 256 + half * 128) * 256;
    const bf16_t* P = (const bf16_t*)(p.ws + U_U16); float* SLOC = (float*)(p.ws + U_SLOC);
    __syncthreads();
    for (int i = tid; i < 128 * 32; i += NTHR) { const int n = i >> 5, pc = i & 31; *(LAS lu4*)(sE + n * PITCH + pc * 8) = *(const lu4*)(E + (size_t)n * 256 + pc * 8); }
    __syncthreads();
    LAS unsigned char* eb = (LAS unsigned char*)(sE + m * PITCH + q * 8); asm volatile("" : "+v"(eb));
    for (int ct = bi * 8 + wv; ct < 144; ct += nb * 8) { const int cr = ct * 16 + m, rb = s5_rowbase(cr);
        bf16x8 a[8];
#pragma unroll
        for (int ks = 0; ks < 8; ++ks) a[ks] = *(const bf16x8*)(P + (size_t)(rb + 2 * ks + (q >> 1)) * 256 + g * 16 + (q & 1) * 8);
        float* o = SLOC + ((size_t)cr * 16 + g) * 256 + half * 128 + q * 4;
#pragma unroll 2
        for (int nt = 0; nt < 8; ++nt) { f32x4 acc = (f32x4){0.f, 0.f, 0.f, 0.f};
#pragma unroll
            for (int ks = 0; ks < 8; ++ks) acc = mfma16(*(const LAS bf16x8*)(eb + nt * 16 * PITCH * 2 + ks * 64), a[ks], acc);
            *(f32x4*)(o + nt * 16) = acc; } }
    __syncthreads();
}
__device__ __forceinline__ void s5_carry(const Params& p, int l) {
    const int gid = blockIdx.x * NTHR + threadIdx.x; if (gid >= 32768) return;
    const int pp = gid & 63, d = (gid >> 6) & 1, g = (gid >> 7) & 15, b = gid >> 11;
    const int li = ((l * 2 + d) * 16 + g) * 64 + pp; const float lr = p.in[9][li], lim = p.in[10][li], dt = expf(p.in[11][(l * 2 + d) * 16 + g]);
    const float mag = expf(16.0f * dt * lr); float sn, cn; sincosf(16.0f * dt * lim, &sn, &cn); const float ar = mag * cn, ai = mag * sn;
    const float* SLOC = (const float*)(p.ws + U_SLOC); bf16_t* SP = (bf16_t*)(p.ws + U_SPREV);
    float sr = 0.f, si = 0.f;
#pragma unroll 8
    for (int n = 0; n < 144; ++n) { const int c = d == 0 ? n : (n < 16 ? 15 - n : 159 - n); const size_t idx = ((size_t)(b * 144 + c) * 16 + g) * 256 + d * 128 + pp;
        SP[idx] = f2bf(sr); SP[idx + 64] = f2bf(si);
        const float xr = SLOC[idx], xi = SLOC[idx + 64]; const float nr = ar * sr - ai * si + xr, ni = ar * si + ai * sr + xi; sr = nr; si = ni; }
}
__device__ __forceinline__ void s5_pass2_items(const Params& p, int l, int wid, int nw) {
    const int lane = threadIdx.x & 63, m = lane & 15, q = lane >> 4;
    const bf16_t* P = (const bf16_t*)(p.ws + U_U16); const bf16_t* SP = (const bf16_t*)(p.ws + U_SPREV); bf16_t* YG = (bf16_t*)(p.ws + U_YG);
    for (int it = wid; it < 144 * 16; it += nw) { const int ct = it >> 4, g = it & 15; if (l == 1 && ct % 9 == 0) continue;
        const int cr = ct * 16 + m, rb = s5_rowbase(cr);
        const bf16_t* W2 = (const bf16_t*)(p.ws + WS_SW + (size_t)l * SW_STRIDE + SW_S5W2) + (size_t)g * 256 * 512;
        bf16x8 a[16];
#pragma unroll
        for (int ks = 0; ks < 8; ++ks) a[ks] = *(const bf16x8*)(P + (size_t)(rb + 2 * ks + (q >> 1)) * 256 + g * 16 + (q & 1) * 8);
#pragma unroll
        for (int ks = 8; ks < 16; ++ks) a[ks] = *(const bf16x8*)(SP + ((size_t)cr * 16 + g) * 256 + (ks - 8) * 32 + q * 8);
#pragma unroll 2
        for (int nt = 0; nt < 16; ++nt) { f32x4 acc = (f32x4){0.f, 0.f, 0.f, 0.f}; const bf16_t* wp = W2 + (size_t)(nt * 16 + m) * 512 + q * 8;
#pragma unroll
            for (int ks = 0; ks < 16; ++ks) acc = mfma16(*(const bf16x8*)(wp + ks * 32), a[ks], acc);
            float o[4];
#pragma unroll
            for (int j = 0; j < 4; ++j) { const float x = acc[j]; const float u = 0.7978845608f * (x + 0.044715f * x * x * x); const float th = 1.0f - 2.0f / (1.0f + __expf(2.0f * u)); o[j] = 0.5f * x * (1.0f + th); }
            u32x2 w; w.x = pack2(o[0], o[1]); w.y = pack2(o[2], o[3]); *(u32x2*)(YG + (size_t)(rb + nt) * 256 + g * 16 + q * 4) = w; }
    }
}
__device__ __forceinline__ void s5_pass2_block(const Params& p, int l, int vb, int nvb, LAS unsigned char* lds) {
    constexpr int PITCH = 520;
    LAS bf16_t* sW = (LAS bf16_t*)lds;
    const int tid = threadIdx.x, lane = tid & 63, m = lane & 15, q = lane >> 4, wv = tid >> 6;
    const bf16_t* P = (const bf16_t*)(p.ws + U_U16); const bf16_t* SP = (const bf16_t*)(p.ws + U_SPREV); bf16_t* YG = (bf16_t*)(p.ws + U_YG);
    if ((nvb & 63) != 0) { s5_pass2_items(p, l, vb * 8 + wv, nvb * 8); return; }
    { const int combo = vb & 63, g = combo >> 2, qd = combo & 3, bi = vb >> 6, nb = nvb >> 6;
        const bf16_t* W2 = (const bf16_t*)(p.ws + WS_SW + (size_t)l * SW_STRIDE + SW_S5W2) + ((size_t)g * 256 + qd * 64) * 512;
        __syncthreads();
        for (int i = tid; i < 64 * 64; i += NTHR) { const int n = i >> 6, pc = i & 63; *(LAS lu4*)(sW + n * PITCH + pc * 8) = *(const lu4*)(W2 + (size_t)n * 512 + pc * 8); }
        __syncthreads();
        LAS unsigned char* wb = (LAS unsigned char*)(sW + m * PITCH + q * 8); asm volatile("" : "+v"(wb));
        for (int ct = bi * 8 + wv; ct < 144; ct += nb * 8) { if (l == 1 && ct % 9 == 0) continue;
            const int cr = ct * 16 + m, rb = s5_rowbase(cr);
            bf16x8 a[16];
#pragma unroll
            for (int ks = 0; ks < 8; ++ks) a[ks] = *(const bf16x8*)(P + (size_t)(rb + 2 * ks + (q >> 1)) * 256 + g * 16 + (q & 1) * 8);
#pragma unroll
            for (int ks = 8; ks < 16; ++ks) a[ks] = *(const bf16x8*)(SP + ((size_t)cr * 16 + g) * 256 + (ks - 8) * 32 + q * 8);
#pragma unroll 1
            for (int nt = 0; nt < 4; ++nt) { f32x4 acc = (f32x4){0.f, 0.f, 0.f, 0.f};
#pragma unroll
                for (int ks = 0; ks < 16; ++ks) acc = mfma16(*(const LAS bf16x8*)(wb + nt * 16 * PITCH * 2 + ks * 64), a[ks], acc);
                float o[4];
#pragma unroll
                for (int j = 0; j < 4; ++j) { const float x = acc[j]; const float u = 0.7978845608f * (x + 0.044715f * x * x * x); const float th = 1.0f - 2.0f / (1.0f + __expf(2.0f * u)); o[j] = 0.5f * x * (1.0f + th); }
                u32x2 w; w.x = pack2(o[0], o[1]); w.y = pack2(o[2], o[3]); *(u32x2*)(YG + (size_t)(rb + qd * 4 + nt) * 256 + g * 16 + q * 4) = w; } }
    }
    __syncthreads();
}
__device__ __forceinline__ void s5_glu_items(const Params& p, int l, int wid, int nw) {
    const int lane = threadIdx.x & 63, m = lane & 15, q = lane >> 4;
    const bf16_t* YG = (const bf16_t*)(p.ws + U_YG); bf16_t* YC = (bf16_t*)(p.ws + WS_ABUF);
    const bf16_t* GT = (const bf16_t*)(p.ws + WS_SW + (size_t)l * SW_STRIDE + SW_GLUT);
    const int nrt = (l == 0 ? NROW : NLAT) / 16;
    for (int rt = wid; rt < nrt; rt += nw) { const int row = rt * 16 + m;
        bf16x8 a[8];
#pragma unroll
        for (int ks = 0; ks < 8; ++ks) a[ks] = *(const bf16x8*)(YG + (size_t)row * 256 + ks * 32 + q * 8);
#pragma unroll 2
        for (int nt = 0; nt < 16; ++nt) { f32x4 acc = (f32x4){0.f, 0.f, 0.f, 0.f}; const bf16_t* gp = GT + (size_t)(nt * 16 + m) * 256 + q * 8;
#pragma unroll
            for (int ks = 0; ks < 8; ++ks) acc = mfma16(*(const bf16x8*)(gp + ks * 32), a[ks], acc);
            const int n = nt * 16 + q * 4; const float4 bv = *(const float4*)(p.in[18] + l * 256 + n); const u32x2 yw = *(const u32x2*)(YG + (size_t)row * 256 + n);
            u32x2 w; w.x = pack2(bflo(yw.x) * sigm(acc[0] + bv.x), bfhi(yw.x) * sigm(acc[1] + bv.y)); w.y = pack2(bflo(yw.y) * sigm(acc[2] + bv.z), bfhi(yw.y) * sigm(acc[3] + bv.w));
            *(u32x2*)(YC + (size_t)row * 1024 + n) = w; }
    }
}

__device__ __forceinline__ void s5_glu_block(const Params& p, int l, int vb, int nvb, LAS unsigned char* lds) {
    constexpr int PITCH = 264;
    LAS bf16_t* sG = (LAS bf16_t*)lds;
    const int tid = threadIdx.x, lane = tid & 63, m = lane & 15, q = lane >> 4, wv = tid >> 6;
    if (nvb < 2 || (nvb & 1)) { s5_glu_items(p, l, vb * 8 + wv, nvb * 8); return; }
    const int half = vb & 1, bi = vb >> 1, nb = nvb >> 1;
    const bf16_t* YG = (const bf16_t*)(p.ws + U_YG); bf16_t* YC = (bf16_t*)(p.ws + WS_ABUF);
    const bf16_t* GT = (const bf16_t*)(p.ws + WS_SW + (size_t)l * SW_STRIDE + SW_GLUT) + (size_t)half * 128 * 256;
    __syncthreads();
    for (int i = tid; i < 128 * 32; i += NTHR) { const int n = i >> 5, pc = i & 31; *(LAS lu4*)(sG + n * PITCH + pc * 8) = *(const lu4*)(GT + (size_t)n * 256 + pc * 8); }
    __syncthreads();
    LAS unsigned char* gb = (LAS unsigned char*)(sG + m * PITCH + q * 8); asm volatile("" : "+v"(gb));
    const int nrt = (l == 0 ? NROW : NLAT) / 16;
    for (int rt = bi * 8 + wv; rt < nrt; rt += nb * 8) { const int row = rt * 16 + m;
        bf16x8 a[8];
#pragma unroll
        for (int ks = 0; ks < 8; ++ks) a[ks] = *(const bf16x8*)(YG + (size_t)row * 256 + ks * 32 + q * 8);
#pragma unroll 2
        for (int nt = 0; nt < 8; ++nt) { f32x4 acc = (f32x4){0.f, 0.f, 0.f, 0.f};
#pragma unroll
            for (int ks = 0; ks < 8; ++ks) acc = mfma16(*(const LAS bf16x8*)(gb + nt * 16 * PITCH * 2 + ks * 64), a[ks], acc);
            const int n = half * 128 + nt * 16 + q * 4; const float4 bv = *(const float4*)(p.in[18] + l * 256 + n); const u32x2 yw = *(const u32x2*)(YG + (size_t)row * 256 + n);
            u32x2 w; w.x = pack2(bflo(yw.x) * sigm(acc[0] + bv.x), bfhi(yw.x) * sigm(acc[1] + bv.y)); w.y = pack2(bflo(yw.y) * sigm(acc[2] + bv.z), bfhi(yw.y) * sigm(acc[3] + bv.w));
            *(u32x2*)(YC + (size_t)row * 1024 + n) = w; } }
    __syncthreads();
}

template <bool HASLAT> __device__ __forceinline__ void na_unit(const Params& p, const LAS float* rpb_l, int b, int h, int i, int n) {
    const int lane = threadIdx.x & 63, m = lane & 15, q = lane >> 4, kin = 8 * (m >> 2) + (m & 3);
    const bf16_t* QR = (const bf16_t*)(p.ws + U_QR); const bf16_t* KR = (const bf16_t*)(p.ws + U_KR);
    const bf16_t* VTL = (const bf16_t*)(p.ws + U_VT) + (size_t)(b * 6 + h) * 64 * 2048; const bf16_t* VTC = (const bf16_t*)(p.ws + U_VTC) + (size_t)(b * 6 + h) * 64 * 256;
    const int qrow = HASLAT ? b * 2048 + i * 64 + n * 16 + m : NLAT + b * 256 + n * 16 + m;
    bf16x8 qf[2];
#pragma unroll
    for (int ks = 0; ks < 2; ++ks) qf[ks] = *(const bf16x8*)(QR + (size_t)qrow * 384 + h * 64 + ks * 32 + q * 8);
    const int r0 = HASLAT ? min(max(i - 4, 0), 24) : 0, scol = HASLAT ? min(max(n * 16 - 8, 0), 32) : 0;
    f32x4 sl[HASLAT ? 16 : 1], sc[16];
    float mx = -3.0e38f;
    if (HASLAT) { const int qc = n * 16 + m, c0 = min(max(qc - 8, 0), 48); const LAS float* rpb = rpb_l + h * 15 * 31;
#pragma unroll
        for (int t = 0; t < 16; ++t) { const int kr = t >> 1, ch = t & 1; const bf16_t* kp = KR + (size_t)(b * 2048 + (r0 + kr) * 64 + scol + kin + 4 * ch) * 384 + h * 64 + q * 8;
            f32x4 acc = (f32x4){0.f, 0.f, 0.f, 0.f};
#pragma unroll
            for (int ks = 0; ks < 2; ++ks) acc = mfma16(*(const bf16x8*)(kp + ks * 32), qf[ks], acc);
            const int dr = r0 + kr - i + 7;
#pragma unroll
            for (int j = 0; j < 4; ++j) { const int kc = scol + 8 * q + 4 * ch + j; const bool valid = kc >= c0 && kc < c0 + 16; const int dc = min(max(kc - qc + 15, 0), 30);
                const float s = valid ? acc[j] + rpb[dr * 31 + dc] : -1.0e30f; acc[j] = s; mx = fmaxf(mx, s); }
            sl[t] = acc; if ((t & 7) == 7) __builtin_amdgcn_sched_barrier(0); } }
#pragma unroll
    for (int t = 0; t < 16; ++t) { const bf16_t* kp = KR + (size_t)(NLAT + b * 256 + (t >> 1) * 32 + kin + 4 * (t & 1)) * 384 + h * 64 + q * 8;
        f32x4 acc = (f32x4){0.f, 0.f, 0.f, 0.f};
#pragma unroll
        for (int ks = 0; ks < 2; ++ks) acc = mfma16(*(const bf16x8*)(kp + ks * 32), qf[ks], acc);
#pragma unroll
        for (int j = 0; j < 4; ++j) mx = fmaxf(mx, acc[j]);
        sc[t] = acc; }
    mx = fmaxf(mx, __shfl_xor(mx, 16)); mx = fmaxf(mx, __shfl_xor(mx, 32));
    float sum = 0.f;
    f32x4 o[4];
#pragma unroll
    for (int dt = 0; dt < 4; ++dt) o[dt] = (f32x4){0.f, 0.f, 0.f, 0.f};
    if (HASLAT) {
#pragma unroll
        for (int kr = 0; kr < 8; ++kr) { float e[8];
#pragma unroll
            for (int j = 0; j < 4; ++j) { e[j] = __expf(sl[2 * kr][j] - mx); e[4 + j] = __expf(sl[2 * kr + 1][j] - mx); }
#pragma unroll
            for (int j = 0; j < 8; ++j) sum += e[j];
            const uint4 pw = pack8(e); const bf16x8 pf = __builtin_bit_cast(bf16x8, pw);
            const int tok = (r0 + kr) * 64 + scol + q * 8;
#pragma unroll
            for (int dt = 0; dt < 4; ++dt) o[dt] = mfma16(*(const bf16x8*)(VTL + (size_t)(dt * 16 + m) * 2048 + tok), pf, o[dt]);
            if (kr & 1) __builtin_amdgcn_sched_barrier(0); } }
#pragma unroll
    for (int t2 = 0; t2 < 8; ++t2) { float e[8];
#pragma unroll
        for (int j = 0; j < 4; ++j) { e[j] = __expf(sc[2 * t2][j] - mx); e[4 + j] = __expf(sc[2 * t2 + 1][j] - mx); }
#pragma unroll
        for (int j = 0; j < 8; ++j) sum += e[j];
        const uint4 pw = pack8(e); const bf16x8 pf = __builtin_bit_cast(bf16x8, pw);
        const int tok = t2 * 32 + q * 8;
#pragma unroll
        for (int dt = 0; dt < 4; ++dt) o[dt] = mfma16(*(const bf16x8*)(VTC + (size_t)(dt * 16 + m) * 256 + tok), pf, o[dt]);
        if (t2 & 1) __builtin_amdgcn_sched_barrier(0); }
    sum += __shfl_xor(sum, 16); sum += __shfl_xor(sum, 32);
    const float inv = 1.0f / sum;
    bf16_t* yo = (bf16_t*)(p.ws + WS_ABUF) + (size_t)qrow * 1024 + 256 + h * 64 + q * 4;
#pragma unroll
    for (int dt = 0; dt < 4; ++dt) { u32x2 w; w.x = pack2(o[dt][0] * inv, o[dt][1] * inv); w.y = pack2(o[dt][2] * inv, o[dt][3] * inv); *(u32x2*)(yo + dt * 16) = w; }
}
template <bool HASLAT> __device__ __forceinline__ void na_block(const Params& p, int l, int b, int h, int sel, LAS unsigned char* lds) {
    LAS bf16_t* Ks = (LAS bf16_t*)lds;
    LAS bf16_t* Vs = (LAS bf16_t*)lds;
    LAS float* rp = (LAS float*)(lds + 120064);
    const int tid = threadIdx.x, lane = tid & 63, m = lane & 15, q = lane >> 4, w = tid >> 6, kin = 8 * (m >> 2) + (m & 3);
    const bf16_t* QR = (const bf16_t*)(p.ws + U_QR); const bf16_t* KR = (const bf16_t*)(p.ws + U_KR);
    const bf16_t* VTL = (const bf16_t*)(p.ws + U_VT) + (size_t)(b * 6 + h) * 64 * 2048; const bf16_t* VTC = (const bf16_t*)(p.ws + U_VTC) + (size_t)(b * 6 + h) * 64 * 256;
    const int i0 = HASLAT ? 2 * sel : 0, rlo = HASLAT ? min(max(i0 - 4, 0), 24) : 0;
    __syncthreads();
    int tk = threadIdx.x; asm volatile("" : "+v"(tk));
    if (HASLAT) {
#pragma unroll
        for (int j = 0; j < 9; ++j) { const int idx = tk + NTHR * j, key = idx >> 3, pc = idx & 7, tok = rlo * 64 + key;
            if (tok < 2048) *(LAS lu4*)(Ks + key * 72 + pc * 8) = *(const lu4*)(KR + (size_t)(b * 2048 + tok) * 384 + h * 64 + pc * 8); }
        for (int j = tk; j < 465; j += NTHR) rp[j] = p.in[19][(size_t)(l * 6 + h) * 465 + j]; }
#pragma unroll
    for (int j = 0; j < 4; ++j) { const int idx = tk + NTHR * j, key = idx >> 3, pc = idx & 7;
        *(LAS lu4*)(Ks + (576 + key) * 72 + pc * 8) = *(const lu4*)(KR + (size_t)(NLAT + b * 256 + key) * 384 + h * 64 + pc * 8); }
    const int i = HASLAT ? i0 + (w >> 2) : 0, n = HASLAT ? (w & 3) : sel * 8 + w;
    const int qrow = HASLAT ? b * 2048 + i * 64 + n * 16 + m : NLAT + b * 256 + n * 16 + m;
    bf16x8 qf[2];
#pragma unroll
    for (int ks = 0; ks < 2; ++ks) qf[ks] = *(const bf16x8*)(QR + (size_t)qrow * 384 + h * 64 + ks * 32 + q * 8);
    const int r0 = HASLAT ? min(max(i - 4, 0), 24) : 0, scol = HASLAT ? min(max(n * 16 - 8, 0), 32) : 0, kb = (r0 - rlo) * 64 + scol;
    LAS unsigned char* kbl = (LAS unsigned char*)(Ks + (kb + kin) * 72 + q * 8); LAS unsigned char* kbc = (LAS unsigned char*)(Ks + (576 + kin) * 72 + q * 8);
    LAS unsigned char* vb0 = (LAS unsigned char*)(Vs + (0 * 16 + m) * 840 + q * 8); LAS unsigned char* vb1 = (LAS unsigned char*)(Vs + (1 * 16 + m) * 840 + q * 8);
    LAS unsigned char* vb2 = (LAS unsigned char*)(Vs + (2 * 16 + m) * 840 + q * 8); LAS unsigned char* vb3 = (LAS unsigned char*)(Vs + (3 * 16 + m) * 840 + q * 8);
    asm volatile("" : "+v"(kbl), "+v"(kbc), "+v"(vb0), "+v"(vb1), "+v"(vb2), "+v"(vb3));
    __syncthreads();
    float mx1 = -3.0e38f, mx2 = -3.0e38f, sum1 = 0.f, sum2 = 0.f;
    bf16x8 pl[HASLAT ? 8 : 1], pcx[8];
    if (HASLAT) { const int qc = n * 16 + m, c0 = min(max(qc - 8, 0), 48); f32x4 sl[16];
#pragma unroll
        for (int t = 0; t < 16; ++t) { const int kr = t >> 1, ch = t & 1; const LAS bf16_t* kp = (const LAS bf16_t*)(kbl + (kr * 64 + 4 * ch) * 144);
            f32x4 acc = (f32x4){0.f, 0.f, 0.f, 0.f};
#pragma unroll
            for (int ks = 0; ks < 2; ++ks) acc = mfma16(*(const LAS bf16x8*)(kp + ks * 32), qf[ks], acc);
            const int dr = r0 + kr - i + 7;
#pragma unroll
            for (int j = 0; j < 4; ++j) { const int kc = scol + 8 * q + 4 * ch + j; const bool valid = kc >= c0 && kc < c0 + 16; const int dc = min(max(kc - qc + 15, 0), 30);
                const float sv = valid ? acc[j] + rp[dr * 31 + dc] : -1.0e30f; acc[j] = sv; mx1 = fmaxf(mx1, sv); }
            sl[t] = acc; if ((t & 3) == 3) __builtin_amdgcn_sched_barrier(0); }
        mx1 = fmaxf(mx1, __shfl_xor(mx1, 16)); mx1 = fmaxf(mx1, __shfl_xor(mx1, 32));
#pragma unroll
        for (int kr = 0; kr < 8; ++kr) { float e[8];
#pragma unroll
            for (int j = 0; j < 4; ++j) { e[j] = __expf(sl[2 * kr][j] - mx1); e[4 + j] = __expf(sl[2 * kr + 1][j] - mx1); }
#pragma unroll
            for (int j = 0; j < 8; ++j) sum1 += e[j];
            const uint4 pw = pack8(e); pl[kr] = __builtin_bit_cast(bf16x8, pw); }
        __builtin_amdgcn_sched_barrier(0); }
    { f32x4 sc[16];
#pragma unroll
      for (int t = 0; t < 16; ++t) { const LAS bf16_t* kp = (const LAS bf16_t*)(kbc + ((t >> 1) * 32 + 4 * (t & 1)) * 144);
          f32x4 acc = (f32x4){0.f, 0.f, 0.f, 0.f};
#pragma unroll
          for (int ks = 0; ks < 2; ++ks) acc = mfma16(*(const LAS bf16x8*)(kp + ks * 32), qf[ks], acc);
#pragma unroll
          for (int j = 0; j < 4; ++j) mx2 = fmaxf(mx2, acc[j]);
          sc[t] = acc; if ((t & 3) == 3) __builtin_amdgcn_sched_barrier(0); }
      mx2 = fmaxf(mx2, __shfl_xor(mx2, 16)); mx2 = fmaxf(mx2, __shfl_xor(mx2, 32));
#pragma unroll
      for (int t2 = 0; t2 < 8; ++t2) { float e[8];
#pragma unroll
          for (int j = 0; j < 4; ++j) { e[j] = __expf(sc[2 * t2][j] - mx2); e[4 + j] = __expf(sc[2 * t2 + 1][j] - mx2); }
#pragma unroll
          for (int j = 0; j < 8; ++j) sum2 += e[j];
          const uint4 pw = pack8(e); pcx[t2] = __builtin_bit_cast(bf16x8, pw); } }
    sum1 += __shfl_xor(sum1, 16); sum1 += __shfl_xor(sum1, 32); sum2 += __shfl_xor(sum2, 16); sum2 += __shfl_xor(sum2, 32);
    __builtin_amdgcn_sched_barrier(0);
    __syncthreads();
    int tv = threadIdx.x; asm volatile("" : "+v"(tv));
    if (HASLAT) {
#pragma unroll
        for (int j = 0; j < 9; ++j) { const int idx = tv + NTHR * j, dim = idx / 72, pc = idx % 72, tok = rlo * 64 + pc * 8;
            if (tok < 2048) *(LAS lu4*)(Vs + dim * 840 + pc * 8) = *(const lu4*)(VTL + (size_t)dim * 2048 + tok); } }
#pragma unroll
    for (int j = 0; j < 4; ++j) { const int idx = tv + NTHR * j, dim = idx >> 5, pc = idx & 31; *(LAS lu4*)(Vs + dim * 840 + 576 + pc * 8) = *(const lu4*)(VTC + (size_t)dim * 256 + pc * 8); }
    __syncthreads();
    const int kbv = kb * 2;
    f32x4 o1[4], o2[4];
#pragma unroll
    for (int dt = 0; dt < 4; ++dt) { o1[dt] = (f32x4){0.f, 0.f, 0.f, 0.f}; o2[dt] = (f32x4){0.f, 0.f, 0.f, 0.f}; }
    if (HASLAT) {
#pragma unroll
        for (int kr = 0; kr < 8; ++kr) {
#pragma unroll
            for (int dt = 0; dt < 4; ++dt) { LAS unsigned char* vb = dt == 0 ? vb0 : dt == 1 ? vb1 : dt == 2 ? vb2 : vb3; o1[dt] = mfma16(*(const LAS bf16x8*)(vb + kbv + kr * 128), pl[kr], o1[dt]); }
            if (kr & 1) __builtin_amdgcn_sched_barrier(0); } }
#pragma unroll
    for (int t2 = 0; t2 < 8; ++t2) {
#pragma unroll
        for (int dt = 0; dt < 4; ++dt) { LAS unsigned char* vb = dt == 0 ? vb0 : dt == 1 ? vb1 : dt == 2 ? vb2 : vb3; o2[dt] = mfma16(*(const LAS bf16x8*)(vb + 1152 + t2 * 64), pcx[t2], o2[dt]); }
        if (t2 & 1) __builtin_amdgcn_sched_barrier(0); }
    const float mxm = fmaxf(mx1, mx2), a1 = HASLAT ? __expf(mx1 - mxm) : 0.f, a2 = __expf(mx2 - mxm), inv = 1.0f / (a1 * sum1 + a2 * sum2), c1 = a1 * inv, c2 = a2 * inv;
    bf16_t* yo = (bf16_t*)(p.ws + WS_ABUF) + (size_t)qrow * 1024 + 256 + h * 64 + q * 4;
#pragma unroll
    for (int dt = 0; dt < 4; ++dt) { u32x2 wv2; wv2.x = pack2(o1[dt][0] * c1 + o2[dt][0] * c2, o1[dt][1] * c1 + o2[dt][1] * c2); wv2.y = pack2(o1[dt][2] * c1 + o2[dt][2] * c2, o1[dt][3] * c1 + o2[dt][3] * c2); *(u32x2*)(yo + dt * 16) = wv2; }
}
__device__ __forceinline__ void na_items(const Params& p, int l, int wid, int nw, LAS unsigned char* lds) {
    (void)wid; (void)nw;
    const int nlat = 16 * 6 * 16, nctx = (l == 0) ? 16 * 6 * 2 : 0;
    for (int it = blockIdx.x; it < nlat + nctx; it += gridDim.x) {
        if (it < nlat) { const int ip = it & 15, bh = it >> 4; na_block<true>(p, l, bh / 6, bh % 6, ip, lds); }
        else { const int j = it - nlat, half = j & 1, bh = j >> 1; na_block<false>(p, l, bh / 6, bh % 6, half, lds); }
    }
    __syncthreads();
}

typedef float f32x2 __attribute__((ext_vector_type(2)));
__device__ __forceinline__ int rk_row(int b, int d, int n) { return n < 256 ? NLAT + b * 256 + (d ? 255 - n : n) : b * 2048 + (d ? 2047 - (n - 256) : (n - 256)); }
template <int CTRL> __device__ __forceinline__ float dpp_f(float v) { return __builtin_bit_cast(float, __builtin_amdgcn_update_dpp(0, __builtin_bit_cast(int, v), CTRL, 0xF, 0xF, true)); }
constexpr int RKP_PITCH = 72, RKP_MAT = 16 * RKP_PITCH * 2, RKP_WAVE = 5 * RKP_MAT + 4 * 16 * 17 * 4;
__device__ __forceinline__ bf16x8 pack_frag(const float (&lo)[4], const float (&hi)[4]) { u32x4 w; w.x = pack2(lo[0], lo[1]); w.y = pack2(lo[2], lo[3]); w.z = pack2(hi[0], hi[1]); w.w = pack2(hi[2], hi[3]); return __builtin_bit_cast(bf16x8, w); }
__device__ __forceinline__ void rwkv_pre_items(const Params& p, int l, int wid, int nw, LAS unsigned char* lds) {
    const int lane = threadIdx.x & 63, m = lane & 15, q = lane >> 4, wv = threadIdx.x >> 6;
    LAS bf16_t* sAt = (LAS bf16_t*)(lds + wv * RKP_WAVE); LAS bf16_t* sBh = sAt + 16 * RKP_PITCH; LAS bf16_t* sKh = sBh + 16 * RKP_PITCH; LAS bf16_t* sRt = sKh + 16 * RKP_PITCH; LAS bf16_t* sV = sRt + 16 * RKP_PITCH;
    LAS float* sM = (LAS float*)(lds + wv * RKP_WAVE + 5 * RKP_MAT);
    const bf16_t* RS = (const bf16_t*)(p.ws + U_RS); const bf16_t* KS = (const bf16_t*)(p.ws + U_KS); const bf16_t* VS = (const bf16_t*)(p.ws + U_VS); const bf16_t* KK = (const bf16_t*)(p.ws + U_KK);
    for (int it = wid; it < NCHUNK; it += nw) { const int u = it / 144, c = it % 144, b = u / 12, h = (u % 12) >> 1, d = u & 1;
        const bf16_t* AG = (const bf16_t*)(p.ws + U_AG + (size_t)d * SZ384); const bf16_t* LD = (const bf16_t*)(p.ws + U_LD + (size_t)d * SZ384);
        const int rb = rk_row(b, d, c * 16), sgn = d ? -1 : 1;
        { LAS bf16_t* sLd = (LAS bf16_t*)sM;
#pragma unroll
          for (int k = 0; k < 12; ++k) { const int idx = lane + 64 * k, pair = idx >> 3, arr = pair >> 4, t = pair & 15, pc = idx & 7;
              const bf16_t* src = arr == 0 ? KK : arr == 1 ? AG : arr == 2 ? KS : arr == 3 ? RS : arr == 4 ? VS : LD;
              LAS bf16_t* dst = arr == 0 ? sAt : arr == 1 ? sBh : arr == 2 ? sKh : arr == 3 ? sRt : arr == 4 ? sV : sLd;
              *(LAS lu4*)(dst + t * RKP_PITCH + pc * 8) = *(const lu4*)(src + (size_t)(rb + sgn * t) * 384 + h * 64 + pc * 8); }
          const float ka = p.in[27][l * 384 + h * 64 + lane]; float L = 0.f;
#pragma unroll 4
          for (int t = 0; t < 16; ++t) { const int o = t * RKP_PITCH + lane;
              const float r_ = bf2f(sRt[o]), k_ = bf2f(sKh[o]), kk_ = bf2f(sAt[o]), ag_ = bf2f(sBh[o]), ld_ = bf2f(sLd[o]);
              const float e0 = __expf(L); L += ld_; const float e1 = __expf(L), ei = __expf(-L);
              sAt[o] = f2bf(-kk_ * e0); sBh[o] = f2bf(kk_ * ag_ * ei); sKh[o] = f2bf(k_ * (1.0f + (ag_ - 1.0f) * ka) * ei); sRt[o] = f2bf(r_ * e1); }
          ((bf16_t*)(p.ws + CH_GT))[(size_t)it * 64 + lane] = f2bf(L); }
        { bf16x8 atf[2], rtf[2], bhf[2], khf[2];
#pragma unroll
          for (int ks = 0; ks < 2; ++ks) { atf[ks] = *(const LAS bf16x8*)(sAt + m * RKP_PITCH + ks * 32 + q * 8); rtf[ks] = *(const LAS bf16x8*)(sRt + m * RKP_PITCH + ks * 32 + q * 8);
              bhf[ks] = *(const LAS bf16x8*)(sBh + m * RKP_PITCH + ks * 32 + q * 8); khf[ks] = *(const LAS bf16x8*)(sKh + m * RKP_PITCH + ks * 32 + q * 8); }
          f32x4 mab = (f32x4){0.f, 0.f, 0.f, 0.f}, mak = mab, mrb = mab, mrk = mab;
#pragma unroll
          for (int ks = 0; ks < 2; ++ks) { mab = mfma16(atf[ks], bhf[ks], mab); mak = mfma16(atf[ks], khf[ks], mak); mrb = mfma16(rtf[ks], bhf[ks], mrb); mrk = mfma16(rtf[ks], khf[ks], mrk); }
#pragma unroll
          for (int r = 0; r < 4; ++r) { const int t = 4 * q + r; sM[(0 * 16 + t) * 17 + m] = m < t ? mab[r] : 0.f; sM[(1 * 16 + t) * 17 + m] = m < t ? mak[r] : 0.f;
              sM[(2 * 16 + t) * 17 + m] = m <= t ? mrb[r] : 0.f; sM[(3 * 16 + t) * 17 + m] = m <= t ? mrk[r] : 0.f; } }
        { float tv[16];
#pragma unroll
          for (int t = 0; t < 16; ++t) { float acc = (m == t) ? 1.0f : 0.0f;
#pragma unroll
              for (int s2 = 0; s2 < t; ++s2) acc += sM[t * 17 + s2] * tv[s2];
              tv[t] = acc; }
#pragma unroll
          for (int t = 0; t < 16; ++t) if (q == 0) sM[t * 17 + m] = tv[t]; }
        bf16x8 tinvf, mrbf;
        { float lo[4], hi[4] = {0.f, 0.f, 0.f, 0.f};
#pragma unroll
          for (int j = 0; j < 4; ++j) lo[j] = sM[(0 * 16 + m) * 17 + 4 * q + j];
          tinvf = pack_frag(lo, hi);
#pragma unroll
          for (int j = 0; j < 4; ++j) lo[j] = sM[(2 * 16 + m) * 17 + 4 * q + j];
          mrbf = pack_frag(lo, hi);
#pragma unroll
          for (int j = 0; j < 4; ++j) hi[j] = sM[(3 * 16 + m) * 17 + 4 * q + j];
          *(bf16x8*)((bf16_t*)(p.ws + CH_MM) + ((size_t)it * 64 + lane) * 8) = pack_frag(lo, hi); }
        { bf16x8 makf; { float lo[4], hi[4];
#pragma unroll
            for (int j = 0; j < 4; ++j) { lo[j] = q < 2 ? sM[(1 * 16 + m) * 17 + 8 * q + j] : 0.f; hi[j] = q < 2 ? sM[(1 * 16 + m) * 17 + 8 * q + 4 + j] : 0.f; }
            makf = pack_frag(lo, hi); }
#pragma unroll
          for (int itile = 0; itile < 4; ++itile) { unsigned vw[4];
#pragma unroll
              for (int j = 0; j < 4; ++j) vw[j] = q < 2 ? ((unsigned)sV[(8 * q + 2 * j) * RKP_PITCH + 16 * itile + m] | ((unsigned)sV[(8 * q + 2 * j + 1) * RKP_PITCH + 16 * itile + m] << 16)) : 0u;
              const u32x4 vq = {vw[0], vw[1], vw[2], vw[3]};
              const f32x4 w1 = mfma16(makf, __builtin_bit_cast(bf16x8, vq), (f32x4){0.f, 0.f, 0.f, 0.f});
              const float lo[4] = {w1[0], w1[1], w1[2], w1[3]}, hi[4] = {0.f, 0.f, 0.f, 0.f};
              const f32x4 uu = mfma16(tinvf, pack_frag(lo, hi), (f32x4){0.f, 0.f, 0.f, 0.f});
              u32x2 o; o.x = pack2(uu[0], uu[1]); o.y = pack2(uu[2], uu[3]);
              *(u32x2*)((bf16_t*)(p.ws + CH_UL) + (((size_t)it * 4 + itile) * 64 + lane) * 4) = o; } }
        f32x4 ap[4], rp[4];
#pragma unroll
        for (int jt = 0; jt < 4; ++jt) { float lo[4], hi[4] = {0.f, 0.f, 0.f, 0.f};
#pragma unroll
            for (int j = 0; j < 4; ++j) lo[j] = bf2f(sAt[(4 * q + j) * RKP_PITCH + 16 * jt + m]);
            ap[jt] = mfma16(tinvf, pack_frag(lo, hi), (f32x4){0.f, 0.f, 0.f, 0.f});
            const float al[4] = {ap[jt][0], ap[jt][1], ap[jt][2], ap[jt][3]};
            f32x4 rr = mfma16(mrbf, pack_frag(al, hi), (f32x4){0.f, 0.f, 0.f, 0.f});
#pragma unroll
            for (int r = 0; r < 4; ++r) rr[r] += bf2f(sRt[(4 * q + r) * RKP_PITCH + 16 * jt + m]);
            rp[jt] = rr;
            float bl[4], kl[4];
#pragma unroll
            for (int j = 0; j < 4; ++j) { bl[j] = bf2f(sBh[(4 * q + j) * RKP_PITCH + 16 * jt + m]); kl[j] = bf2f(sKh[(4 * q + j) * RKP_PITCH + 16 * jt + m]); }
            *(bf16x8*)((bf16_t*)(p.ws + CH_BK) + (((size_t)it * 4 + jt) * 64 + lane) * 8) = pack_frag(bl, kl); }
#pragma unroll
        for (int jt = 0; jt < 4; ++jt)
#pragma unroll
            for (int r = 0; r < 4; ++r) { sAt[(4 * q + r) * RKP_PITCH + 16 * jt + m] = f2bf(ap[jt][r]); sRt[(4 * q + r) * RKP_PITCH + 16 * jt + m] = f2bf(rp[jt][r]); }
#pragma unroll
        for (int x = 0; x < 2; ++x)
#pragma unroll
            for (int ks = 0; ks < 2; ++ks) { const LAS bf16_t* src = (x ? sRt : sAt) + m * RKP_PITCH + 32 * ks + 4 * q;
                const u32x2 a0 = *(const LAS u32x2*)src, a1 = *(const LAS u32x2*)(src + 16); const u32x4 w = {a0.x, a0.y, a1.x, a1.y};
                *(u32x4*)((bf16_t*)(p.ws + CH_XP) + ((((size_t)it * 2 + x) * 2 + ks) * 64 + lane) * 8) = w; }
    }
}
__device__ __forceinline__ void rwkv_seq_task(const Params& p, int l, int task, LAS unsigned char* lds) {
    const int lane = threadIdx.x & 63, m = lane & 15, q = lane >> 4;
    const int u = task >> 2, iw = task & 3, b = u / 12, h = (u % 12) >> 1, d = u & 1, sgn = d ? -1 : 1;
    const bf16_t* XP = (const bf16_t*)(p.ws + CH_XP); const bf16_t* BK = (const bf16_t*)(p.ws + CH_BK); const bf16_t* UL = (const bf16_t*)(p.ws + CH_UL); const bf16_t* MM = (const bf16_t*)(p.ws + CH_MM);
    const bf16_t* GT = (const bf16_t*)(p.ws + CH_GT); const bf16_t* VS = (const bf16_t*)(p.ws + U_VS) + h * 64 + 16 * iw;
    float* Yw = (float*)(p.ws + U_YRK) + (size_t)d * NROW * 384 + h * 64 + 16 * iw;
    LAS float* ybuf = (LAS float*)(lds + (threadIdx.x >> 6) * 12288);
    const int rc0 = NLAT + b * 256 + (d ? 255 : 0) + sgn * 4 * q, rdel = (b * 2048 + (d ? 2047 : 0)) - (NLAT + b * 256 + (d ? 255 : 0)) - sgn * 256;
    f32x4 acc[4];
#pragma unroll
    for (int jt = 0; jt < 4; ++jt) acc[jt] = (f32x4){0.f, 0.f, 0.f, 0.f};
    const unsigned vo16 = (unsigned)lane * 16u, vo8 = (unsigned)lane * 8u, vo8q = (unsigned)q * 8u;
    struct OpSet { u32x4 apf0, apf1, rpf0, rpf1, bkf0, bkf1, bkf2, bkf3, mmf; u32x2 gl0, gl1, gl2, gl3, uw; unsigned vr0, vr1, vr2, vr3; };
#define GLDS16(dst, voff, sbase, imm) asm volatile("global_load_dwordx4 %0, %1, %2 offset:" #imm : "=&v"(dst) : "v"(voff), "s"(sbase) : "memory")
#define GLDS8(dst, voff, sbase, imm) asm volatile("global_load_dwordx2 %0, %1, %2 offset:" #imm : "=&v"(dst) : "v"(voff), "s"(sbase) : "memory")
#define GLDS2(dst, voff, sbase) asm volatile("global_load_ushort %0, %1, %2" : "=&v"(dst) : "v"(voff), "s"(sbase) : "memory")
#define RKS_LOAD(X, c_) do { const size_t it_ = (size_t)u * 144 + (c_); const int rb_ = rc0 + sgn * 16 * (c_) + (int)((c_) >= 16) * rdel; \
        const bf16_t* xpb = XP + it_ * 2048; const bf16_t* bkb = BK + it_ * 2048; const bf16_t* mmb = MM + it_ * 512; const bf16_t* gtb = GT + it_ * 64; const bf16_t* ulb = UL + (it_ * 4 + iw) * 256; \
        GLDS16(X.apf0, vo16, xpb, 0); GLDS16(X.apf1, vo16, xpb, 1024); GLDS16(X.rpf0, vo16, xpb, 2048); GLDS16(X.rpf1, vo16, xpb, 3072); \
        GLDS16(X.bkf0, vo16, bkb, 0); GLDS16(X.bkf1, vo16, bkb, 1024); GLDS16(X.bkf2, vo16, bkb, 2048); GLDS16(X.bkf3, vo16, bkb, 3072); \
        GLDS8(X.gl0, vo8q, gtb, 0); GLDS8(X.gl1, vo8q, gtb, 32); GLDS8(X.gl2, vo8q, gtb, 64); GLDS8(X.gl3, vo8q, gtb, 96); \
        GLDS16(X.mmf, vo16, mmb, 0); GLDS8(X.uw, vo8, ulb, 0); \
        { const unsigned v0_ = (unsigned)(rb_) * 768u + 2u * m, v1_ = (unsigned)(rb_ + sgn) * 768u + 2u * m, v2_ = (unsigned)(rb_ + 2 * sgn) * 768u + 2u * m, v3_ = (unsigned)(rb_ + 3 * sgn) * 768u + 2u * m; \
          GLDS2(X.vr0, v0_, VS); GLDS2(X.vr1, v1_, VS); GLDS2(X.vr2, v2_, VS); GLDS2(X.vr3, v3_, VS); } } while (0)
#define RKS_WAIT(X) asm volatile("s_waitcnt vmcnt(36)" : "+v"(X.apf0), "+v"(X.apf1), "+v"(X.rpf0), "+v"(X.rpf1), "+v"(X.bkf0), "+v"(X.bkf1), "+v"(X.bkf2), "+v"(X.bkf3), "+v"(X.mmf), \
        "+v"(X.gl0), "+v"(X.gl1), "+v"(X.gl2), "+v"(X.gl3), "+v"(X.uw), "+v"(X.vr0), "+v"(X.vr1), "+v"(X.vr2), "+v"(X.vr3) :: "memory")
#define BF8(x) __builtin_bit_cast(bf16x8, x)
#define RKS_COMPUTE(X, c_) do { RKS_WAIT(X); \
        const float ul[4] = {bflo(X.uw.x), bfhi(X.uw.x), bflo(X.uw.y), bfhi(X.uw.y)}; const float vl[4] = {bflo(X.vr0), bflo(X.vr1), bflo(X.vr2), bflo(X.vr3)}; \
        f32x4 zp = (f32x4){0.f, 0.f, 0.f, 0.f}, yp = zp; \
        { const float lo[4] = {acc[0][0], acc[0][1], acc[0][2], acc[0][3]}, hi[4] = {acc[1][0], acc[1][1], acc[1][2], acc[1][3]}; const bf16x8 sf = pack_frag(lo, hi); zp = mfma16(BF8(X.apf0), sf, zp); yp = mfma16(BF8(X.rpf0), sf, yp); } \
        { const float lo[4] = {acc[2][0], acc[2][1], acc[2][2], acc[2][3]}, hi[4] = {acc[3][0], acc[3][1], acc[3][2], acc[3][3]}; const bf16x8 sf = pack_frag(lo, hi); zp = mfma16(BF8(X.apf1), sf, zp); yp = mfma16(BF8(X.rpf1), sf, yp); } \
        const float z[4] = {zp[0] + ul[0], zp[1] + ul[1], zp[2] + ul[2], zp[3] + ul[3]}; \
        yp = mfma16(BF8(X.mmf), pack_frag(ul, vl), yp); \
        const bf16x8 zvf = pack_frag(z, vl); \
        acc[0] = mfma16(BF8(X.bkf0), zvf, acc[0]); acc[1] = mfma16(BF8(X.bkf1), zvf, acc[1]); acc[2] = mfma16(BF8(X.bkf2), zvf, acc[2]); acc[3] = mfma16(BF8(X.bkf3), zvf, acc[3]); \
        { const f32x4 g4 = {__expf(bflo(X.gl0.x)), __expf(bfhi(X.gl0.x)), __expf(bflo(X.gl0.y)), __expf(bfhi(X.gl0.y))}; acc[0] *= g4; } \
        { const f32x4 g4 = {__expf(bflo(X.gl1.x)), __expf(bfhi(X.gl1.x)), __expf(bflo(X.gl1.y)), __expf(bfhi(X.gl1.y))}; acc[1] *= g4; } \
        { const f32x4 g4 = {__expf(bflo(X.gl2.x)), __expf(bfhi(X.gl2.x)), __expf(bflo(X.gl2.y)), __expf(bfhi(X.gl2.y))}; acc[2] *= g4; } \
        { const f32x4 g4 = {__expf(bflo(X.gl3.x)), __expf(bfhi(X.gl3.x)), __expf(bflo(X.gl3.y)), __expf(bfhi(X.gl3.y))}; acc[3] *= g4; } \
        _Pragma("unroll") for (int r = 0; r < 4; ++r) ybuf[((((c_) % 12) * 16) + 4 * q + r) * 16 + m] = yp[r]; } while (0)
    asm volatile("; SEQ_BEGIN");
    OpSet A, B, C;
    RKS_LOAD(A, 0); RKS_LOAD(B, 1);
    for (int c0 = 0; c0 < 144; c0 += 12) {
#pragma unroll
        for (int cc = 0; cc < 12; cc += 3) { const int c = c0 + cc;
            RKS_LOAD(C, c + 2); __builtin_amdgcn_sched_barrier(0);
            RKS_COMPUTE(A, c); __builtin_amdgcn_sched_barrier(0);
            { const int cn = c + 3 < 144 ? c + 3 : 143; RKS_LOAD(A, cn); } __builtin_amdgcn_sched_barrier(0);
            RKS_COMPUTE(B, c + 1); __builtin_amdgcn_sched_barrier(0);
            { const int cn = c + 4 < 144 ? c + 4 : 143; RKS_LOAD(B, cn); } __builtin_amdgcn_sched_barrier(0);
            RKS_COMPUTE(C, c + 2); __builtin_amdgcn_sched_barrier(0); }
#pragma unroll
        for (int k = 0; k < 12; ++k) { const int rr = (lane >> 2) + 16 * k, n = c0 * 16 + rr; const int grow = (rc0 - sgn * 4 * q) + sgn * n + (int)(n >= 256) * rdel;
            *(f32x4*)(Yw + (size_t)grow * 384 + (lane & 3) * 4) = *(const LAS f32x4*)(ybuf + rr * 16 + (lane & 3) * 4); }
    }
    asm volatile("; SEQ_END");
#undef RKS_LOAD
#undef RKS_COMPUTE
#undef RKS_WAIT
#undef GLDS16
#undef GLDS8
#undef GLDS2
#undef BF8
}

__device__ __forceinline__ void rwkv_seq_block(const Params& p, int l, int u, LAS unsigned char* lds) {
    (void)l;
    const int tid = threadIdx.x, lane = tid & 63, wv = __builtin_amdgcn_readfirstlane(tid >> 6), m = lane & 15, q = lane >> 4;
    const int b = u / 12, h = (u % 12) >> 1, d = u & 1, sgn = d ? -1 : 1;
    const unsigned char* XPb = p.ws + CH_XP + (size_t)u * 144 * 4096; const unsigned char* BKb = p.ws + CH_BK + (size_t)u * 144 * 4096;
    const unsigned char* MMb = p.ws + CH_MM + (size_t)u * 144 * 1024; const unsigned char* GTb = p.ws + CH_GT + (size_t)u * 144 * 128;
    LAS unsigned char* ring = lds + 49152;
#define SEQ_BAR() asm volatile("s_waitcnt lgkmcnt(0)\n\ts_barrier" ::: "memory")
    __syncthreads();
    if (wv >= 4) {
        const int lw = wv - 4; const bool hasmm = lw == 0, hasgt = (lw == 1) && lane < 8;
        lu4 xp[3], bk[3], mm[3], gt[3];
#define LDR_LOAD(k, c_) do { const int cc_ = (c_) < 144 ? (c_) : 143; xp[k] = *(const lu4*)(XPb + (size_t)cc_ * 4096 + lw * 1024 + lane * 16); bk[k] = *(const lu4*)(BKb + (size_t)cc_ * 4096 + lw * 1024 + lane * 16); \
            if (hasmm) mm[k] = *(const lu4*)(MMb + (size_t)cc_ * 1024 + lane * 16); if (hasgt) gt[k] = *(const lu4*)(GTb + (size_t)cc_ * 128 + lane * 16); } while (0)
#define LDR_STORE(k, c_) do { if ((c_) < 144) { LAS unsigned char* sl_ = ring + ((c_) % 3) * 9728; *(LAS lu4*)(sl_ + lw * 1024 + lane * 16) = xp[k]; *(LAS lu4*)(sl_ + 4096 + lw * 1024 + lane * 16) = bk[k]; \
            if (hasmm) *(LAS lu4*)(sl_ + 8192 + lane * 16) = mm[k]; if (hasgt) *(LAS lu4*)(sl_ + 9216 + lane * 16) = gt[k]; } } while (0)
        LDR_LOAD(0, 0); LDR_LOAD(1, 1); LDR_LOAD(2, 2);
        LDR_STORE(0, 0); LDR_LOAD(0, 3); LDR_STORE(1, 1); LDR_LOAD(1, 4);
        SEQ_BAR();
        for (int i0 = 0; i0 < 144; i0 += 3) {
            LDR_STORE(2, i0 + 2); LDR_LOAD(2, i0 + 5); SEQ_BAR();
            LDR_STORE(0, i0 + 3); LDR_LOAD(0, i0 + 6); SEQ_BAR();
            LDR_STORE(1, i0 + 4); LDR_LOAD(1, i0 + 7); SEQ_BAR(); }
#undef LDR_LOAD
#undef LDR_STORE
    } else {
        const int iw = wv;
        const bf16_t* UL = (const bf16_t*)(p.ws + CH_UL) + (size_t)u * 144 * 1024; const bf16_t* VS = (const bf16_t*)(p.ws + U_VS) + h * 64 + 16 * iw;
        float* Yw = (float*)(p.ws + U_YRK) + (size_t)d * NROW * 384 + h * 64 + 16 * iw;
        LAS float* ybuf = (LAS float*)(lds + wv * 12288);
        const int rc0 = NLAT + b * 256 + (d ? 255 : 0) + sgn * 4 * q, rdel = (b * 2048 + (d ? 2047 : 0)) - (NLAT + b * 256 + (d ? 255 : 0)) - sgn * 256;
        const unsigned vo8 = (unsigned)lane * 8u;
        f32x4 acc[4];
#pragma unroll
        for (int jt = 0; jt < 4; ++jt) acc[jt] = (f32x4){0.f, 0.f, 0.f, 0.f};
        struct Shared { bf16x8 apf0, apf1, rpf0, rpf1, bkf0, bkf1, bkf2, bkf3, mmf; u32x2 gl0, gl1, gl2, gl3; };
        struct Own { u32x2 uw; unsigned vr0, vr1, vr2, vr3; };
#define GLDS8(dst, voff, sbase) asm volatile("global_load_dwordx2 %0, %1, %2" : "=&v"(dst) : "v"(voff), "s"(sbase) : "memory")
#define GLDS2(dst, voff, sbase) asm volatile("global_load_ushort %0, %1, %2" : "=&v"(dst) : "v"(voff), "s"(sbase) : "memory")
#define OWN_LOAD(X, c_) do { const int cc_ = (c_) < 144 ? (c_) : 143; const int rb_ = rc0 + sgn * 16 * cc_ + (int)(cc_ >= 16) * rdel; const bf16_t* ulb = UL + ((size_t)cc_ * 4 + iw) * 256; \
            GLDS8(X.uw, vo8, ulb); const unsigned v0_ = (unsigned)(rb_) * 768u + 2u * m, v1_ = (unsigned)(rb_ + sgn) * 768u + 2u * m, v2_ = (unsigned)(rb_ + 2 * sgn) * 768u + 2u * m, v3_ = (unsigned)(rb_ + 3 * sgn) * 768u + 2u * m; \
            GLDS2(X.vr0, v0_, VS); GLDS2(X.vr1, v1_, VS); GLDS2(X.vr2, v2_, VS); GLDS2(X.vr3, v3_, VS); } while (0)
#define OWN_WAIT(X) asm volatile("s_waitcnt vmcnt(10)" : "+v"(X.uw), "+v"(X.vr0), "+v"(X.vr1), "+v"(X.vr2), "+v"(X.vr3) :: "memory")
#define SH_READ(S, c_) do { const int cc_ = (c_) < 144 ? (c_) : 143; const LAS unsigned char* sl_ = ring + (cc_ % 3) * 9728 + lane * 16; \
            S.apf0 = *(const LAS bf16x8*)(sl_); S.apf1 = *(const LAS bf16x8*)(sl_ + 1024); S.rpf0 = *(const LAS bf16x8*)(sl_ + 2048); S.rpf1 = *(const LAS bf16x8*)(sl_ + 3072); \
            S.bkf0 = *(const LAS bf16x8*)(sl_ + 4096); S.bkf1 = *(const LAS bf16x8*)(sl_ + 5120); S.bkf2 = *(const LAS bf16x8*)(sl_ + 6144); S.bkf3 = *(const LAS bf16x8*)(sl_ + 7168); S.mmf = *(const LAS bf16x8*)(sl_ + 8192); \
            const LAS unsigned char* gp_ = ring + (cc_ % 3) * 9728 + 9216 + q * 8; S.gl0 = *(const LAS u32x2*)(gp_); S.gl1 = *(const LAS u32x2*)(gp_ + 32); S.gl2 = *(const LAS u32x2*)(gp_ + 64); S.gl3 = *(const LAS u32x2*)(gp_ + 96); } while (0)
#define SEQ_COMPUTE(S, X, c_) do { OWN_WAIT(X); \
            const float ul[4] = {bflo(X.uw.x), bfhi(X.uw.x), bflo(X.uw.y), bfhi(X.uw.y)}; const float vl[4] = {bflo(X.vr0), bflo(X.vr1), bflo(X.vr2), bflo(X.vr3)}; \
            f32x4 zp = (f32x4){0.f, 0.f, 0.f, 0.f}, yp = zp; \
            { const float lo[4] = {acc[0][0], acc[0][1], acc[0][2], acc[0][3]}, hi[4] = {acc[1][0], acc[1][1], acc[1][2], acc[1][3]}; const bf16x8 sf = pack_frag(lo, hi); zp = mfma16(S.apf0, sf, zp); yp = mfma16(S.rpf0, sf, yp); } \
            { const float lo[4] = {acc[2][0], acc[2][1], acc[2][2], acc[2][3]}, hi[4] = {acc[3][0], acc[3][1], acc[3][2], acc[3][3]}; const bf16x8 sf = pack_frag(lo, hi); zp = mfma16(S.apf1, sf, zp); yp = mfma16(S.rpf1, sf, yp); } \
            const float z[4] = {zp[0] + ul[0], zp[1] + ul[1], zp[2] + ul[2], zp[3] + ul[3]}; \
            yp = mfma16(S.mmf, pack_frag(ul, vl), yp); \
            const bf16x8 zvf = pack_frag(z, vl); \
            acc[0] = mfma16(S.bkf0, zvf, acc[0]); acc[1] = mfma16(S.bkf1, zvf, acc[1]); acc[2] = mfma16(S.bkf2, zvf, acc[2]); acc[3] = mfma16(S.bkf3, zvf, acc[3]); \
            { const f32x4 g4 = {__expf(bflo(S.gl0.x)), __expf(bfhi(S.gl0.x)), __expf(bflo(S.gl0.y)), __expf(bfhi(S.gl0.y))}; acc[0] *= g4; } \
            { const f32x4 g4 = {__expf(bflo(S.gl1.x)), __expf(bfhi(S.gl1.x)), __expf(bflo(S.gl1.y)), __expf(bfhi(S.gl1.y))}; acc[1] *= g4; } \
            { const f32x4 g4 = {__expf(bflo(S.gl2.x)), __expf(bfhi(S.gl2.x)), __expf(bflo(S.gl2.y)), __expf(bfhi(S.gl2.y))}; acc[2] *= g4; } \
            { const f32x4 g4 = {__expf(bflo(S.gl3.x)), __expf(bfhi(S.gl3.x)), __expf(bflo(S.gl3.y)), __expf(bfhi(S.gl3.y))}; acc[3] *= g4; } \
            _Pragma("unroll") for (int r = 0; r < 4; ++r) ybuf[((((c_) % 12) * 16) + 4 * q + r) * 16 + m] = yp[r]; } while (0)
#define SEQ_STEP(SC, SN, XC, XN2, c_) do { SH_READ(SN, (c_) + 1); OWN_LOAD(XN2, (c_) + 2); __builtin_amdgcn_sched_barrier(0); SEQ_COMPUTE(SC, XC, c_); __builtin_amdgcn_sched_barrier(0); SEQ_BAR(); } while (0)
        Shared S0, S1; Own A, B, C;
        OWN_LOAD(A, 0); OWN_LOAD(B, 1);
        SEQ_BAR();
        SH_READ(S0, 0);
        for (int c0 = 0; c0 < 144; c0 += 12) {
#pragma unroll
            for (int cc = 0; cc < 12; cc += 6) { const int c = c0 + cc;
                SEQ_STEP(S0, S1, A, C, c); SEQ_STEP(S1, S0, B, A, c + 1); SEQ_STEP(S0, S1, C, B, c + 2);
                SEQ_STEP(S1, S0, A, C, c + 3); SEQ_STEP(S0, S1, B, A, c + 4); SEQ_STEP(S1, S0, C, B, c + 5); }
#pragma unroll
            for (int k = 0; k < 12; ++k) { const int rr = (lane >> 2) + 16 * k, n = c0 * 16 + rr; const int grow = (rc0 - sgn * 4 * q) + sgn * n + (int)(n >= 256) * rdel;
                *(f32x4*)(Yw + (size_t)grow * 384 + (lane & 3) * 4) = *(const LAS f32x4*)(ybuf + rr * 16 + (lane & 3) * 4); }
        }
#undef GLDS8
#undef GLDS2
#undef OWN_LOAD
#undef OWN_WAIT
#undef SH_READ
#undef SEQ_COMPUTE
#undef SEQ_STEP
    }
#undef SEQ_BAR
    __syncthreads();
}

__device__ __forceinline__ void rwkv_finish(const Params& p, int l) {
    const int sub = threadIdx.x & 7; const int npair = (l == 0 ? NROW : NLAT) * 6;
    const bf16_t* RS = (const bf16_t*)(p.ws + U_RS); const bf16_t* KS = (const bf16_t*)(p.ws + U_KS); const bf16_t* VS = (const bf16_t*)(p.ws + U_VS);
    const bf16_t* AG0 = (const bf16_t*)(p.ws + U_AG); const bf16_t* AG1 = (const bf16_t*)(p.ws + U_AG + SZ384); const bf16_t* G = (const bf16_t*)(p.ws + U_G);
    const float* Y0 = (const float*)(p.ws + U_YRK); const float* Y1 = Y0 + (size_t)NROW * 384; bf16_t* YC = (bf16_t*)(p.ws + WS_ABUF);
    for (int pr = (blockIdx.x * NTHR + threadIdx.x) >> 3; pr < npair; pr += (gridDim.x * NTHR) >> 3) { const int row = pr / 6, h = pr % 6, col = h * 64 + sub * 8; const size_t o = (size_t)row * 384 + col;
        float y[8]; { const float4 a0 = *(const float4*)(Y0 + o), a1 = *(const float4*)(Y0 + o + 4), c0 = *(const float4*)(Y1 + o), c1 = *(const float4*)(Y1 + o + 4);
            y[0] = a0.x + c0.x; y[1] = a0.y + c0.y; y[2] = a0.z + c0.z; y[3] = a0.w + c0.w; y[4] = a1.x + c1.x; y[5] = a1.y + c1.y; y[6] = a1.z + c1.z; y[7] = a1.w + c1.w; }
        float s = 0.f;
#pragma unroll
        for (int k = 0; k < 8; ++k) s += y[k];
        s += __shfl_xor(s, 1); s += __shfl_xor(s, 2); s += __shfl_xor(s, 4); const float mean = s * (1.0f / 64.0f);
        float v2 = 0.f;
#pragma unroll
        for (int k = 0; k < 8; ++k) { const float dd = y[k] - mean; v2 += dd * dd; }
        v2 += __shfl_xor(v2, 1); v2 += __shfl_xor(v2, 2); v2 += __shfl_xor(v2, 4); const float rstd = rsqrtf(v2 * (1.0f / 64.0f) + 64e-5f);
        float r[8], kx[8], vx[8], a0[8], a1[8], gx[8];
        unpack8(*(const uint4*)(RS + o), r); unpack8(*(const uint4*)(KS + o), kx); unpack8(*(const uint4*)(VS + o), vx); unpack8(*(const uint4*)(AG0 + o), a0); unpack8(*(const uint4*)(AG1 + o), a1); unpack8(*(const uint4*)(G + o), gx);
        const float* ka = p.in[27] + l * 384 + col; const float* rk = p.in[28] + l * 384 + col; const float* lw = p.in[29] + l * 384 + col; const float* lb = p.in[30] + l * 384 + col;
        float bs = 0.f;
#pragma unroll
        for (int k = 0; k < 8; ++k) { const float kd0 = kx[k] * (1.0f + (a0[k] - 1.0f) * ka[k]), kd1 = kx[k] * (1.0f + (a1[k] - 1.0f) * ka[k]); bs += r[k] * (kd0 + kd1) * rk[k]; }
        bs += __shfl_xor(bs, 1); bs += __shfl_xor(bs, 2); bs += __shfl_xor(bs, 4);
        float ov[8];
#pragma unroll
        for (int k = 0; k < 8; ++k) ov[k] = ((y[k] - mean) * rstd * lw[k] + lb[k] + bs * vx[k]) * gx[k];
        *(uint4*)(YC + (size_t)row * 1024 + 640 + col) = pack8(ov);
    }
}

__device__ __forceinline__ void phase_normrouter(const Params& p, int l, const float* xl, const float* xc, LAS unsigned char* lds) {
    LAS float* hrow = (LAS float*)lds;
    LAS float* part = (LAS float*)(lds + 32768);
    const int lane = threadIdx.x & 63, wv = threadIdx.x >> 6, e = lane & 15, cq = lane >> 4; const int ngrp = (l == 0 ? NROW : NLAT) / 8;
    const float* mod = (const float*)(p.ws + WS_MOD) + (size_t)l * 17 * 6144; const float* g1 = p.in[6] + (l * 4 + 1) * 1024; const float* g2 = p.in[6] + (l * 4 + 2) * 1024;
    const bf16_t* Y = (const bf16_t*)(p.ws + U_Y); unsigned char* A8 = p.ws + WS_ABUF; float* AFF = (float*)(p.ws + WS_AFF);
    float wr[32];
#pragma unroll
    for (int j = 0; j < 32; ++j) wr[j] = p.in[31][((size_t)l * 1024 + 128 * wv + 32 * cq + j) * 16 + e];
    for (int gi = blockIdx.x; gi < ngrp; gi += gridDim.x) { const int r = gi * 8 + wv; const int b = r < NLAT ? (r >> 11) : 16; const float* mb = mod + (size_t)b * 6144;
        const float* xs = xrow(xl, xc, r); float* xd = xrow_w(p.out, (float*)(p.ws + WS_CTXA), r);
        float4 y[4], x[4]; float ss = 0.f;
#pragma unroll
        for (int i = 0; i < 4; ++i) { { const u32x2 yw = *(const u32x2*)(Y + (size_t)r * 1024 + i * 256 + lane * 4); y[i] = make_float4(bflo(yw.x), bfhi(yw.x), bflo(yw.y), bfhi(yw.y)); } x[i] = *(const float4*)(xs + i * 256 + lane * 4); ss += y[i].x * y[i].x + y[i].y * y[i].y + y[i].z * y[i].z + y[i].w * y[i].w; }
        ss = wave_sum(ss); const float rs = rsqrtf(ss * (1.0f / 1024.0f) + 1e-6f);
        float s2 = 0.f;
#pragma unroll
        for (int i = 0; i < 4; ++i) { const int c = i * 256 + lane * 4; const float4 gg = *(const float4*)(g1 + c), gt = *(const float4*)(mb + 2048 + c);
            x[i].x += gt.x * (y[i].x * rs * gg.x); x[i].y += gt.y * (y[i].y * rs * gg.y); x[i].z += gt.z * (y[i].z * rs * gg.z); x[i].w += gt.w * (y[i].w * rs * gg.w);
            *(float4*)(xd + c) = x[i]; s2 += x[i].x * x[i].x + x[i].y * x[i].y + x[i].z * x[i].z + x[i].w * x[i].w; }
        s2 = wave_sum(s2); const float rs2 = rsqrtf(s2 * (1.0f / 1024.0f) + 1e-6f);
        float hv[4][4]; float amax = 0.f;
        __syncthreads();
#pragma unroll
        for (int i = 0; i < 4; ++i) { const int c = i * 256 + lane * 4; const float4 gg = *(const float4*)(g2 + c), sh = *(const float4*)(mb + 3072 + c), sc = *(const float4*)(mb + 4096 + c);
            hv[i][0] = x[i].x * rs2 * gg.x * (1.f + sc.x) + sh.x; hv[i][1] = x[i].y * rs2 * gg.y * (1.f + sc.y) + sh.y; hv[i][2] = x[i].z * rs2 * gg.z * (1.f + sc.z) + sh.z; hv[i][3] = x[i].w * rs2 * gg.w * (1.f + sc.w) + sh.w;
            *(LAS lf4*)(hrow + wv * 1024 + c) = (lf4){hv[i][0], hv[i][1], hv[i][2], hv[i][3]};
            amax = fmaxf(amax, fmaxf(fmaxf(fabsf(hv[i][0]), fabsf(hv[i][1])), fmaxf(fabsf(hv[i][2]), fabsf(hv[i][3])))); }
#pragma unroll
        for (int o = 32; o >= 1; o >>= 1) amax = fmaxf(amax, __shfl_xor(amax, o));
        amax = fmaxf(amax, 1e-20f); const float qs = 127.0f / amax;
        if (lane == 0) ((float*)(p.ws + WS_SX))[r] = amax * (1.0f / 127.0f);
#pragma unroll
        for (int i = 0; i < 4; ++i) { unsigned w = 0u;
#pragma unroll
            for (int k = 0; k < 4; ++k) w |= ((unsigned)__float2int_rn(hv[i][k] * qs) & 255u) << (8 * k);
            *(unsigned*)(A8 + (size_t)r * 1024 + i * 256 + lane * 4) = w; }
        __syncthreads();
#pragma unroll 2
        for (int rr = 0; rr < 8; ++rr) { const LAS float* hp = hrow + rr * 1024 + 128 * wv + 32 * cq; float acc = 0.f;
#pragma unroll
            for (int j4 = 0; j4 < 8; ++j4) { const lf4 h4 = *(const LAS lf4*)(hp + 4 * j4); acc += h4.x * wr[4 * j4] + h4.y * wr[4 * j4 + 1] + h4.z * wr[4 * j4 + 2] + h4.w * wr[4 * j4 + 3]; }
            acc += __shfl_xor(acc, 16); acc += __shfl_xor(acc, 32);
            if (cq == 0) part[(rr * 8 + wv) * 16 + e] = acc; }
        __syncthreads();
        if (lane < 16) { float lgt = 0.f;
#pragma unroll
            for (int w = 0; w < 8; ++w) lgt += part[(wv * 8 + w) * 16 + lane];
            float mxl = lgt;
#pragma unroll
            for (int o = 8; o >= 1; o >>= 1) mxl = fmaxf(mxl, __shfl_xor(mxl, o));
            const float ex = expf(lgt - mxl); float den = ex;
#pragma unroll
            for (int o = 8; o >= 1; o >>= 1) den += __shfl_xor(den, o);
            AFF[(size_t)r * 16 + lane] = ex / den; }
    }
}

__device__ __forceinline__ void phase_topk(const Params& p, int l, LAS unsigned char* lds) {
    LAS unsigned* keys = (LAS unsigned*)lds;
    LAS int* toks = (LAS int*)(lds + 8192);
    LAS unsigned* hist = (LAS unsigned*)(lds + 9216);
    LAS unsigned* wtot = (LAS unsigned*)(lds + 10240);
    LAS unsigned* sel = (LAS unsigned*)(lds + 10304);
    const int tid = threadIdx.x, lane = tid & 63, wv = tid >> 6, nitem = l == 0 ? 512 : 256;
    const float* AFF = (const float*)(p.ws + WS_AFF); int* SLOT = (int*)(p.ws + WS_SLOT); float* SELG = (float*)(p.ws + WS_SELG);
    const bf16_t* A = (const bf16_t*)(p.ws + WS_ABUF); bf16_t* XS = (bf16_t*)(p.ws + U_XSEL);
    for (int it = blockIdx.x; it < nitem; it += gridDim.x) { const bool lat = it < 256; const int be = it & 255, b = be >> 4, e = be & 15;
        const int n = lat ? SEQ : CTXL, cap = lat ? 256 : 32, rowbase = lat ? b * 2048 : NLAT + b * 256, xoff = lat ? b * 256 : 4096 + b * 32;
        const int per = n / NTHR > 0 ? n / NTHR : 1;
        const int t0 = tid * per; const bool act = t0 < n;
        unsigned kx[4];
        __syncthreads();
#pragma unroll
        for (int j = 0; j < 4; ++j) { kx[j] = 0u; if (act && j < per) { kx[j] = __float_as_uint(AFF[(size_t)(rowbase + t0 + j) * 16 + e]); keys[t0 + j] = kx[j]; } }
        unsigned prefix = 0u; int krem = cap;
        for (int pass = 0; pass < 4; ++pass) { const int shift = 24 - 8 * pass;
            if (tid < 256) hist[tid] = 0u;
            __syncthreads();
#pragma unroll
            for (int j = 0; j < 4; ++j) if (act && j < per) { const bool match = pass == 0 || (kx[j] >> (shift + 8)) == (prefix >> (shift + 8)); if (match) atomicAdd((unsigned*)&hist[(kx[j] >> shift) & 255u], 1u); }
            __syncthreads();
            if (tid < 256) { unsigned above = 0u; for (int bb = tid + 1; bb < 256; ++bb) above += hist[bb]; const unsigned mine = hist[tid];
                if (above < (unsigned)krem && above + mine >= (unsigned)krem) { sel[0] = (unsigned)tid; sel[1] = (unsigned)krem - above; } }
            __syncthreads();
            prefix |= sel[0] << shift; krem = (int)sel[1];
            __syncthreads();
        }
        unsigned loc = 0u, pre[4];
#pragma unroll
        for (int j = 0; j < 4; ++j) { pre[j] = loc; if (act && j < per) loc += (kx[j] > prefix ? 1u : 0u) + (kx[j] == prefix ? 65536u : 0u); }
        unsigned inc = loc;
#pragma unroll
        for (int o = 1; o < 64; o <<= 1) { const unsigned t = __shfl_up(inc, o); if (lane >= o) inc += t; }
        if (lane == 63) wtot[wv] = inc;
        __syncthreads();
        unsigned base = inc - loc;
        for (int w = 0; w < wv; ++w) base += wtot[w];
#pragma unroll
        for (int j = 0; j < 4; ++j) if (act && j < per) { const unsigned c = base + pre[j]; const int gtb = (int)(c & 0xffffu), eqb = (int)(c >> 16);
            const bool s = kx[j] > prefix || (kx[j] == prefix && eqb < krem); const int slot = gtb + (eqb < krem ? eqb : krem);
            if (s) { SELG[e * XROWS + xoff + slot] = __uint_as_float(kx[j]); toks[slot] = t0 + j; }
            SLOT[(size_t)(rowbase + t0 + j) * 16 + e] = s ? slot : -1; }
        __syncthreads();
        for (int s = wv; s < cap; s += 8) { const int row = rowbase + toks[s]; const lu4* src = (const lu4*)((const unsigned char*)A + (size_t)row * 1024); lu4* dst = (lu4*)((unsigned char*)XS + ((size_t)e * XROWS + xoff + s) * 1024);
            dst[lane] = src[lane]; if (lane == 0) ((float*)(p.ws + WS_SXS))[e * XROWS + xoff + s] = ((const float*)(p.ws + WS_SX))[row]; }
    }
}

struct GroupedOrder { int nMl, nNl, G, c, total;
    __device__ void init(int nMl_, int nNl_, int, int G_, int c_) { nMl = nMl_; nNl = nNl_; G = G_; c = c_; total = 16 * nMl_ * nNl_; }
    __device__ bool next(int i, pg8::Unit& u) const {
        int L;
        if ((G & 7) == 0 && (total & 7) == 0) { const int W = G >> 3, x = c & 7, r = c >> 3, t8 = total >> 3, k = i * W + r; if (k >= t8) return false; L = x * t8 + k; }
        else { const long LL = (long)i * G + c; if (LL >= total) return false; L = (int)LL; }
        const int per = nMl * nNl, e = L / per; int idx = L % per;
        const int mg = idx / (8 * nNl) < nMl / 8 ? idx / (8 * nNl) : nMl / 8, gm = (mg + 1) * 8 <= nMl ? 8 : nMl - mg * 8; idx -= mg * 8 * nNl;
        const int ng = idx / (gm * 4) < nNl / 4 ? idx / (gm * 4) : nNl / 4, gn = (ng + 1) * 4 <= nNl ? 4 : nNl - ng * 4; idx -= ng * gm * 4;
        u.pm = e * 18 + mg * 8 + idx / gn; u.pn = e * nNl + ng * 4 + idx % gn; return true; }
    __device__ __forceinline__ void a_ready(const pg8::Unit&) const {}
    __device__ __forceinline__ void done(const pg8::Unit&) const {}
};
struct EpiSwiGLU { static constexpr bool PERM = true, AFTER_DRAIN = false; unsigned char* H; const float* sx; const float* sw;
    __device__ __forceinline__ void operator()(const f32x4 (&acc)[2][2][4][2], const pg8::Unit& u, int wr, int wc, int fr, int fq) const {
        typedef int i32x4_ __attribute__((ext_vector_type(4)));
        const int e = u.pn / 22, pnl = u.pn - e * 22; const int row0 = u.pm * 256 + wr * 64 + fr, col0 = pnl * 128 + wc * 32 + 8 * fq;
        const float* swp = sw + (size_t)u.pn * 256 + wc * 32 + 8 * fq; const float4 g0 = *(const float4*)swp, g1 = *(const float4*)(swp + 4), u0 = *(const float4*)(swp + 128), u1 = *(const float4*)(swp + 132);
        const float swg[8] = {g0.x, g0.y, g0.z, g0.w, g1.x, g1.y, g1.z, g1.w}, swu[8] = {u0.x, u0.y, u0.z, u0.w, u1.x, u1.y, u1.z, u1.w};
#pragma unroll
        for (int ai = 0; ai < 2; ++ai)
#pragma unroll
            for (int m = 0; m < 4; ++m) { const int r = row0 + ai * 128 + m * 16; const float sr = sx[r]; unsigned char* rowp = H + (size_t)r * DE + col0; float o[8];
#pragma unroll
                for (int n = 0; n < 2; ++n) { const i32x4_ ig = __builtin_bit_cast(i32x4_, acc[ai][0][m][n]), iu = __builtin_bit_cast(i32x4_, acc[ai][1][m][n]);
#pragma unroll
                    for (int j = 0; j < 4; ++j) { const float g = (float)ig[j] * (sr * swg[n * 4 + j]), uu = (float)iu[j] * (sr * swu[n * 4 + j]); o[n * 4 + j] = g * sigm(g) * uu; } }
                u32x2 w8; { int t0 = 0, t1 = 0; t0 = __builtin_amdgcn_cvt_pk_fp8_f32(o[0], o[1], t0, false); t0 = __builtin_amdgcn_cvt_pk_fp8_f32(o[2], o[3], t0, true); t1 = __builtin_amdgcn_cvt_pk_fp8_f32(o[4], o[5], t1, false); t1 = __builtin_amdgcn_cvt_pk_fp8_f32(o[6], o[7], t1, true); w8.x = (unsigned)t0; w8.y = (unsigned)t1; }
                *(u32x2*)rowp = w8; }
    }
};
struct EpiScaleBf16 { static constexpr bool PERM = true, AFTER_DRAIN = false; bf16_t* O; int ldc; const float* sx; const float* sw;
    __device__ __forceinline__ void operator()(const f32x4 (&acc)[2][2][4][2], const pg8::Unit& u, int wr, int wc, int fr, int fq) const {
        typedef int i32x4_ __attribute__((ext_vector_type(4)));
        const int row0 = u.pm * 256 + wr * 64 + fr, col0 = u.pn * 256 + wc * 32 + 8 * fq;
        float swv[2][8];
#pragma unroll
        for (int bj = 0; bj < 2; ++bj) { const float4 a = *(const float4*)(sw + col0 + bj * 128), b = *(const float4*)(sw + col0 + bj * 128 + 4); swv[bj][0] = a.x; swv[bj][1] = a.y; swv[bj][2] = a.z; swv[bj][3] = a.w; swv[bj][4] = b.x; swv[bj][5] = b.y; swv[bj][6] = b.z; swv[bj][7] = b.w; }
#pragma unroll
        for (int ai = 0; ai < 2; ++ai)
#pragma unroll
            for (int m = 0; m < 4; ++m) { const int r = row0 + ai * 128 + m * 16; const float sr = sx[r]; bf16_t* rowp = O + (size_t)r * ldc + col0;
#pragma unroll
                for (int bj = 0; bj < 2; ++bj) { float o[8];
#pragma unroll
                    for (int n = 0; n < 2; ++n) { const i32x4_ iv = __builtin_bit_cast(i32x4_, acc[ai][bj][m][n]);
#pragma unroll
                        for (int j = 0; j < 4; ++j) o[n * 4 + j] = (float)iv[j] * (sr * swv[bj][n * 4 + j]); }
                    *(uint4*)(rowp + bj * 128) = pack8(o); } }
    }
};
struct EpiGate { static constexpr bool PERM = true, AFTER_DRAIN = false; bf16_t* O; const float* gate; const float* sw;
    __device__ __forceinline__ void operator()(const f32x4 (&acc)[2][2][4][2], const pg8::Unit& u, int wr, int wc, int fr, int fq) const {
        pg8::fp8_acc_settle();
        const int pnl = u.pn & 3; const int row0 = u.pm * 256 + wr * 64 + fr, col0 = pnl * 256 + wc * 32 + 8 * fq;
#pragma unroll
        for (int bj = 0; bj < 2; ++bj) { const float* sp = sw + (size_t)u.pn * 256 + wc * 32 + 8 * fq + bj * 128; const float4 sa = *(const float4*)sp, sb = *(const float4*)(sp + 4);
#pragma unroll
            for (int ai = 0; ai < 2; ++ai)
#pragma unroll
                for (int m = 0; m < 4; ++m) { const int r = row0 + ai * 128 + m * 16; const float gt = gate[r]; const f32x4 v0 = acc[ai][bj][m][0], v1 = acc[ai][bj][m][1];
                    u32x4 w; w.x = pack2(v0[0] * (gt * sa.x), v0[1] * (gt * sa.y)); w.y = pack2(v0[2] * (gt * sa.z), v0[3] * (gt * sa.w)); w.z = pack2(v1[0] * (gt * sb.x), v1[1] * (gt * sb.y)); w.w = pack2(v1[2] * (gt * sb.z), v1[3] * (gt * sb.w));
                    *(u32x4*)(O + (size_t)r * 1024 + col0 + bj * 128) = w; } }
    }
};

__device__ __forceinline__ void phase_combine(const Params& p, int l) {
    const int lane = threadIdx.x & 63, wv = threadIdx.x >> 6; const int nrow = l == 0 ? NROW : NLAT;
    const float* mod = (const float*)(p.ws + WS_MOD) + (size_t)l * 17 * 6144; const float* g3 = p.in[6] + (l * 4 + 3) * 1024;
    const int* SLOT = (const int*)(p.ws + WS_SLOT); const bf16_t* YE = (const bf16_t*)(p.ws + U_YEXP); bf16_t* A = (bf16_t*)(p.ws + WS_ABUF);
    const int rstep = gridDim.x * 8; int r = blockIdx.x * 8 + wv;
    int nslot = (r < nrow && lane < 16) ? SLOT[(size_t)r * 16 + lane] : -1; float4 nx1[4];
    if (r < nrow) { const float* x1p = xrow(p.out, (const float*)(p.ws + WS_CTXA), r);
#pragma unroll
        for (int i = 0; i < 4; ++i) nx1[i] = *(const float4*)(x1p + i * 256 + lane * 4); }
    for (; r < nrow; r += rstep) { const bool lat = r < NLAT; const int b = lat ? (r >> 11) : ((r - NLAT) >> 8), mbi = lat ? b : 16, xoff = lat ? b * 256 : 4096 + b * 32;
        const float* mb = mod + (size_t)mbi * 6144;
        const int myslot = nslot; float4 xc[4];
#pragma unroll
        for (int i = 0; i < 4; ++i) xc[i] = nx1[i];
        float f[16];
#pragma unroll
        for (int k = 0; k < 16; ++k) f[k] = 0.f;
        unsigned long long mask = __ballot(myslot >= 0);
        while (mask) { int ee[4], sl4[4]; u32x2 w[4][4];
#pragma unroll
            for (int k = 0; k < 4; ++k) { if (mask) { ee[k] = __builtin_ctzll(mask); mask &= mask - 1; sl4[k] = __shfl(myslot, ee[k]); } else { ee[k] = -1; sl4[k] = 0; } }
#pragma unroll
            for (int k = 0; k < 4; ++k) if (ee[k] >= 0) { const bf16_t* yr = YE + ((size_t)ee[k] * XROWS + xoff + sl4[k]) * 1024 + lane * 4;
#pragma unroll
                for (int i = 0; i < 4; ++i) w[k][i] = *(const u32x2*)(yr + i * 256); }
#pragma unroll
            for (int k = 0; k < 4; ++k) if (ee[k] >= 0) {
#pragma unroll
                for (int i = 0; i < 4; ++i) { f[i * 4] += bflo(w[k][i].x); f[i * 4 + 1] += bfhi(w[k][i].x); f[i * 4 + 2] += bflo(w[k][i].y); f[i * 4 + 3] += bfhi(w[k][i].y); } } }
        { const int rn = r + rstep; nslot = (rn < nrow && lane < 16) ? SLOT[(size_t)rn * 16 + lane] : -1;
          if (rn < nrow) { const float* x1p = xrow(p.out, (const float*)(p.ws + WS_CTXA), rn);
#pragma unroll
              for (int i = 0; i < 4; ++i) nx1[i] = *(const float4*)(x1p + i * 256 + lane * 4); } }
        float ss = 0.f;
#pragma unroll
        for (int k = 0; k < 16; ++k) ss += f[k] * f[k];
        ss = wave_sum(ss); const float rs = rsqrtf(ss * (1.0f / 1024.0f) + 1e-6f);
        float* x2 = l == 0 ? xrow_w((float*)(p.ws + WS_XB), (float*)(p.ws + WS_CTXB), r) : p.out + (size_t)r * D;
        float4 xv[4];
#pragma unroll
        for (int i = 0; i < 4; ++i) { const int c = i * 256 + lane * 4; const float4 gg = *(const float4*)(g3 + c), gt = *(const float4*)(mb + 5120 + c); float4 x = xc[i];
            x.x += gt.x * (f[i * 4] * rs * gg.x); x.y += gt.y * (f[i * 4 + 1] * rs * gg.y); x.z += gt.z * (f[i * 4 + 2] * rs * gg.z); x.w += gt.w * (f[i * 4 + 3] * rs * gg.w);
            *(float4*)(x2 + c) = x; xv[i] = x; }
        if (l == 0) { const float* mb1 = mod + (size_t)17 * 6144 + (size_t)mbi * 6144; hnorm_row(p.in[6] + 4 * 1024, mb1, mb1 + 1024, p.ws + WS_ABUF + (size_t)r * 1024, (float*)(p.ws + WS_SH) + r, lane, xv); }
    }
}


#ifndef MK_ONLY
#define MK_ONLY -1
#endif
#define EN(k) (MK_ONLY < 0 || MK_ONLY == (k))
#ifndef MK_DUP
#define MK_DUP 0
#endif
#define NREP(k) ((((MK_DUP) >> (k)) & 1) ? 2 : 1)
constexpr int PH_PER_LAYER = 14, N_PHASES = 1 + 2 * PH_PER_LAYER;
#define IN(k) (lo <= (k) && (k) < hi)
#define SEAM(k) do { if (p.use_bar && IN(k) && IN((k) + 1)) xcd_barrier(bar); } while (0)
template <int l> __device__ __forceinline__ void layer_phases(const Params& p, LAS unsigned char* lds, const XcdBarrier& bar, const int lo, const int hi) {
    const int wv = __builtin_amdgcn_readfirstlane(threadIdx.x >> 6), G = gridDim.x; const int wid = blockIdx.x * 8 + wv, nw = G * 8;
        const int pb = 1 + l * PH_PER_LAYER;
        const float* xl = l == 0 ? p.in[0] : (const float*)(p.ws + WS_XB);
        const float* xc = l == 0 ? p.in[2] : (const float*)(p.ws + WS_CTXB);
        if (EN(0) && IN(pb + 0)) { { if (l == 0) phase_hnorm(p, 0, xl, xc); }
            if ((NREP(0)) == 2) { if (l == 0) phase_hnorm(p, 0, xl, xc); } }
        SEAM(pb + 0);
        if (EN(1) && IN(pb + 1)) { { pg8::Gemm g{(const bf16_t*)(p.ws + WS_ABUF), (const bf16_t*)(p.ws + WS_WIN), NROW, NINP, D / 2}; pg8::StaticOrder S; S.init(NROW, NINP, G, (int)blockIdx.x);
            EpiScaleBf16 E{(bf16_t*)(p.ws + U_P), NINP, (const float*)(p.ws + WS_SH), (const float*)(p.ws + WS_SWIN)}; pg8::gemm_phase<EpiScaleBf16, pg8::StaticOrder, false, 1>(lds, g, S, E, nullptr); }
            if ((NREP(1)) == 2) { pg8::Gemm g{(const bf16_t*)(p.ws + WS_ABUF), (const bf16_t*)(p.ws + WS_WIN), NROW, NINP, D / 2}; pg8::StaticOrder S; S.init(NROW, NINP, G, (int)blockIdx.x);
            EpiScaleBf16 E{(bf16_t*)(p.ws + U_P), NINP, (const float*)(p.ws + WS_SH), (const float*)(p.ws + WS_SWIN)}; pg8::gemm_phase<EpiScaleBf16, pg8::StaticOrder, false, 1>(lds, g, S, E, nullptr); } }
        SEAM(pb + 1);
        if (EN(2) && IN(pb + 2)) { phase_prep(p, l, lds);
            if ((NREP(2)) == 2) phase_prep(p, l, lds); }
        SEAM(pb + 2);
        if (EN(3) && IN(pb + 3)) { { lowrank_items(p, l, wid, nw, lds); if ((G & 31) == 0) s5_pass1_block(p, l, lds); else s5_pass1_items(p, l, wid, nw); }
            if ((NREP(3)) == 2) { lowrank_items(p, l, wid, nw, lds); if ((G & 31) == 0) s5_pass1_block(p, l, lds); else s5_pass1_items(p, l, wid, nw); } }
        SEAM(pb + 3);
        if (EN(4) && IN(pb + 4)) { { s5_carry(p, l); na_items(p, l, wid, nw, lds); }
            if ((NREP(4)) == 2) { s5_carry(p, l); na_items(p, l, wid, nw, lds); } }
        SEAM(pb + 4);
        if (EN(5) && IN(pb + 5)) { { s5_pass2_block(p, l, (int)blockIdx.x, G, lds); rwkv_pre_items(p, l, wid, nw, lds); }
            if ((NREP(5)) == 2) { s5_pass2_block(p, l, (int)blockIdx.x, G, lds); rwkv_pre_items(p, l, wid, nw, lds); } }
        SEAM(pb + 5);
        if (EN(6) && IN(pb + 6)) {
            if (G > 192) { const int bx = (int)blockIdx.x;
                if (bx < 192) rwkv_seq_block(p, l, bx, lds); else s5_glu_block(p, l, bx - 192, G - 192, lds);
                if ((NREP(6)) == 2) { if (bx < 192) rwkv_seq_block(p, l, bx, lds); else s5_glu_block(p, l, bx - 192, G - 192, lds); } }
            else { for (int task = wid; task < 768; task += nw) rwkv_seq_task(p, l, task, lds); s5_glu_items(p, l, wid, nw); } }
        SEAM(pb + 6);
        if (EN(7) && IN(pb + 7)) { rwkv_finish(p, l);
            if ((NREP(7)) == 2) rwkv_finish(p, l); }
        SEAM(pb + 7);
        if (EN(8) && IN(pb + 8)) { { const int M = l == 0 ? NROW : NLAT; pg8::Gemm g{(const bf16_t*)(p.ws + WS_ABUF), (const bf16_t*)(p.ws + WS_WOUT), M, D, D}; pg8::StaticOrder S; S.init(M, D, G, (int)blockIdx.x);
            pg8::EpiBf16<0> E{(bf16_t*)(p.ws + U_Y), D, nullptr, 0, 0}; pg8::gemm_phase<pg8::EpiBf16<0>, pg8::StaticOrder, false>(lds, g, S, E, nullptr); }
            if ((NREP(8)) == 2) { const int M = l == 0 ? NROW : NLAT; pg8::Gemm g{(const bf16_t*)(p.ws + WS_ABUF), (const bf16_t*)(p.ws + WS_WOUT), M, D, D}; pg8::StaticOrder S; S.init(M, D, G, (int)blockIdx.x);
            pg8::EpiBf16<0> E{(bf16_t*)(p.ws + U_Y), D, nullptr, 0, 0}; pg8::gemm_phase<pg8::EpiBf16<0>, pg8::StaticOrder, false>(lds, g, S, E, nullptr); } }
        SEAM(pb + 8);
        if (EN(9) && IN(pb + 9)) { phase_normrouter(p, l, xl, xc, lds);
            if ((NREP(9)) == 2) phase_normrouter(p, l, xl, xc, lds); }
        SEAM(pb + 9);
        if (EN(10) && IN(pb + 10)) { phase_topk(p, l, lds);
            if ((NREP(10)) == 2) phase_topk(p, l, lds); }
        SEAM(pb + 10);
        if (EN(11) && IN(pb + 11)) { { pg8::Gemm g{(const bf16_t*)(p.ws + U_XSEL), (const bf16_t*)(p.ws + WS_WGU), 16 * XROWS, 16 * 5632, D / 2}; GroupedOrder S; S.init(l == 0 ? 18 : 16, 22, 2, G, (int)blockIdx.x);
            EpiSwiGLU E{p.ws + U_HID, (const float*)(p.ws + WS_SXS), (const float*)(p.ws + WS_SW8)}; pg8::gemm_phase<EpiSwiGLU, GroupedOrder, false, 1>(lds, g, S, E, nullptr); }
            if ((NREP(11)) == 2) { pg8::Gemm g{(const bf16_t*)(p.ws + U_XSEL), (const bf16_t*)(p.ws + WS_WGU), 16 * XROWS, 16 * 5632, D / 2}; GroupedOrder S; S.init(l == 0 ? 18 : 16, 22, 2, G, (int)blockIdx.x);
            EpiSwiGLU E{p.ws + U_HID, (const float*)(p.ws + WS_SXS), (const float*)(p.ws + WS_SW8)}; pg8::gemm_phase<EpiSwiGLU, GroupedOrder, false, 1>(lds, g, S, E, nullptr); } }
        SEAM(pb + 11);
        if (EN(12) && IN(pb + 12)) { { pg8::Gemm g{(const bf16_t*)(p.ws + U_HID), (const bf16_t*)(p.ws + WS_WD), 16 * XROWS, 16 * 1024, DE / 2}; GroupedOrder S; S.init(l == 0 ? 18 : 16, 4, 4, G, (int)blockIdx.x);
            EpiGate E{(bf16_t*)(p.ws + U_YEXP), (const float*)(p.ws + WS_SELG), (const float*)(p.ws + WS_SWD)}; pg8::gemm_phase<EpiGate, GroupedOrder, false, 2>(lds, g, S, E, nullptr); }
            if ((NREP(12)) == 2) { pg8::Gemm g{(const bf16_t*)(p.ws + U_HID), (const bf16_t*)(p.ws + WS_WD), 16 * XROWS, 16 * 1024, DE / 2}; GroupedOrder S; S.init(l == 0 ? 18 : 16, 4, 4, G, (int)blockIdx.x);
            EpiGate E{(bf16_t*)(p.ws + U_YEXP), (const float*)(p.ws + WS_SELG), (const float*)(p.ws + WS_SWD)}; pg8::gemm_phase<EpiGate, GroupedOrder, false, 2>(lds, g, S, E, nullptr); } }
        SEAM(pb + 12);
        if (EN(13) && IN(pb + 13)) { { phase_combine(p, l); if (l == 0) convert_weights(p, 1, lds, (int)blockIdx.x, G); }
            if (((l == 0 ? NREP(13) : 1)) == 2) { phase_combine(p, l); if (l == 0) convert_weights(p, 1, lds, (int)blockIdx.x, G); } }
        SEAM(pb + 13);
}
__global__ void __launch_bounds__(NTHR, 2) fwd(Params p) {
    extern __shared__ __attribute__((aligned(16))) unsigned char lds_raw[];
    LAS unsigned char* lds = (LAS unsigned char*)lds_raw;
    const int tid = threadIdx.x;
    if (tid < 4) ((LAS unsigned*)(lds + LDS_MISC))[tid] = 0u;
    __syncthreads();
    XcdBarrier bar; bar.bar = (unsigned*)(p.ws + WS_CTL); bar.x = 0; bar.st = (volatile LAS unsigned*)(lds + LDS_MISC);
    if (p.use_bar) bar = xcd_barrier_post((unsigned*)(p.ws + WS_CTL), (volatile LAS unsigned*)(lds + LDS_MISC));
    if (p.use_bar && tid == 0) { unsigned* xr = (unsigned*)(p.ws + WS_CTL + 32768); ((LAS unsigned*)(lds + LDS_MISC))[2] = xb_xcc_id(); ((LAS unsigned*)(lds + LDS_MISC))[3] = atomicAdd(xr + 64 * xb_xcc_id(), 1u); }
    __syncthreads();
    const int lo = p.ph_lo, hi = p.ph_hi;

    if (EN(100) && IN(0)) { { phase_prologue(p, lds); }
        if ((NREP(14)) == 2) { phase_prologue(p, lds); } }
    SEAM(0);
    layer_phases<0>(p, lds, bar, lo, hi);
    layer_phases<1>(p, lds, bar, lo, hi);
#undef IN
#undef SEAM
}
}

#ifndef MK_ONE_LAUNCH
#define MK_ONE_LAUNCH 1
#endif
extern "C" void kernel_launch(void* const* d_in, const int* in_sizes, int n_in, void* d_out, int out_size, void* d_ws, size_t ws_size, hipStream_t stream) {
    static int grid = 0;
    if (grid == 0) {
        if (n_in != 35 || out_size != mk::NLAT * mk::D || ws_size < mk::WS_END) { fprintf(stderr, "kernel_launch: unexpected problem (n_in %d, out %d, ws %zu < %zu)\n", n_in, out_size, ws_size, (size_t)mk::WS_END); grid = -1; return; }
        int dev = 0, cus = 0, per_cu = 0;
        if (hipGetDevice(&dev) != hipSuccess || hipDeviceGetAttribute(&cus, hipDeviceAttributeMultiprocessorCount, dev) != hipSuccess) { grid = -1; return; }
        if (hipFuncSetAttribute((const void*)mk::fwd, hipFuncAttributeMaxDynamicSharedMemorySize, mk::LDS_BYTES) != hipSuccess) { fprintf(stderr, "kernel_launch: hipFuncSetAttribute failed\n"); grid = -1; return; }
        if (hipOccupancyMaxActiveBlocksPerMultiprocessor(&per_cu, (const void*)mk::fwd, mk::NTHR, mk::LDS_BYTES) != hipSuccess || per_cu < 1) { fprintf(stderr, "kernel_launch: occupancy query says %d\n", per_cu); per_cu = 1; }
        (void)hipGetLastError();
        grid = cus;
    }
    if (grid < 0) return;
    (void)in_sizes;
    if (hipMemsetAsync(d_ws, 0, 65536, stream) != hipSuccess) return;
    mk::Params a{};
    for (int i = 0; i < 35; ++i) a.in[i] = (const float*)d_in[i];
    a.out = (float*)d_out; a.ws = (unsigned char*)d_ws;
#if MK_ONE_LAUNCH
    a.ph_lo = 0; a.ph_hi = mk::N_PHASES; a.use_bar = 1;
    hipLaunchKernelGGL(mk::fwd, dim3(grid), dim3(mk::NTHR), mk::LDS_BYTES, stream, a);
#else
    for (int ph = 0; ph < mk::N_PHASES; ++ph) { a.ph_lo = ph; a.ph_hi = ph + 1; a.use_bar = 0; hipLaunchKernelGGL(mk::fwd, dim3(grid), dim3(mk::NTHR), mk::LDS_BYTES, stream, a); }
#endif
}
```

```cpp
#include <hip/hip_runtime.h>
#include <cstdio>
#include <cstdint>
#define PRE_DUP 0
namespace pg8 {
#define PG8_LAS __attribute__((address_space(3)))
typedef unsigned short bf16_t;
typedef short bf16x8 __attribute__((ext_vector_type(8)));
typedef float f32x4 __attribute__((ext_vector_type(4)));
typedef unsigned u32x4 __attribute__((ext_vector_type(4)));
constexpr int BM = 256, BK = 64, HALF = 128, HTB = HALF * BK * 2  , STAGE_BYTES = 8 * HTB, NXCD = 8, WGM = 8;

__host__ __device__ __forceinline__ int lds_byte(int r, int c) { const int st = (r >> 4) * 2 + (c >> 5), rr = r & 15, cc = c & 31, ob = rr * 64 + cc * 2; return st * 1024 + (ob ^ (((ob >> 9) & 1) << 5)); }
__host__ __device__ __forceinline__ void stage_rc(int b, int& R, int& C) { const int st = b / 1024, sb = b % 1024, swz = sb ^ (((sb >> 9) & 1) << 5); R = (st >> 1) * 16 + swz / 64; C = (st & 1) * 32 + (swz % 64) / 2; }
__host__ __device__ __forceinline__ int perm32(int rho) { const int n = rho >> 4, i = rho & 15; return 8 * (i >> 2) + 4 * n + (i & 3); }

struct Unit { int pm, pn; };
struct Gemm { const bf16_t* A; const bf16_t* Bt; int M, N, K; };

struct StaticOrder {
    int nM, nN, nwg, G, c;
    __host__ __device__ void init(int M, int N, int G_, int c_) { nM = M / BM; nN = N / BM; nwg = nM * nN; G = G_; c = c_; }
    __host__ __device__ bool next(int i, Unit& u) const {
        const long L = (long)i * G + c; if (L >= nwg) return false;
        int wgid = (int)L; { const int q = nwg / NXCD, r = nwg % NXCD, xcd = wgid % NXCD, off = wgid / NXCD; wgid = (xcd < r ? xcd * (q + 1) : r * (q + 1) + (xcd - r) * q) + off; }
        const int nig = WGM * nN, gid = wgid / nig, fm = gid * WGM, gsz = (nM - fm) < WGM ? (nM - fm) : WGM;
        u.pm = fm + ((wgid % nig) % gsz); u.pn = (wgid % nig) / gsz; return true;
    }
    __device__ __forceinline__ void a_ready(const Unit&) const {}
    __device__ __forceinline__ void done(const Unit&) const {}
};
struct CountedOrder : StaticOrder {
    const unsigned* ready; unsigned need; unsigned* tmo;
    __device__ __forceinline__ void a_ready(const Unit& u) const {
        if (threadIdx.x < 64) {
            const unsigned long long t0 = __builtin_amdgcn_s_memrealtime(); unsigned polls = 0;
            while ((unsigned)__builtin_amdgcn_readfirstlane(__hip_atomic_load(ready + 64 * u.pm, __ATOMIC_RELAXED, __HIP_MEMORY_SCOPE_AGENT)) < need) {
                if ((++polls & 255u) == 0u && __builtin_amdgcn_readfirstlane(__hip_atomic_load(tmo, __ATOMIC_RELAXED, __HIP_MEMORY_SCOPE_AGENT)) != 0u) break;
                if (__builtin_amdgcn_s_memrealtime() - t0 > 2000000ull) {
                    if (threadIdx.x == 0) { unsigned expect = 0u; __hip_atomic_compare_exchange_strong(tmo + 1, &expect, 0x600u | (unsigned)(u.pm & 0xff), __ATOMIC_RELAXED, __ATOMIC_RELAXED, __HIP_MEMORY_SCOPE_AGENT); __hip_atomic_store(tmo, 1u, __ATOMIC_RELAXED, __HIP_MEMORY_SCOPE_AGENT); }
                    break; }
                __builtin_amdgcn_s_sleep(2); }
            __builtin_amdgcn_fence(__ATOMIC_ACQUIRE, "agent");
            asm volatile("s_waitcnt vmcnt(0)" ::: "memory");
        }
#if !defined(BROKEN_HOOK_NO_BARRIER)
        asm volatile("" ::: "memory"); __builtin_amdgcn_s_barrier(); asm volatile("" ::: "memory");
#endif
    }
};

__device__ __forceinline__ unsigned cvt_pk_bf16(float lo, float hi) { unsigned r; asm volatile("v_cvt_pk_bf16_f32 %0, %1, %2" : "=v"(r) : "v"(lo), "v"(hi)); return r; }
typedef float f32x2 __attribute__((ext_vector_type(2)));
__device__ __forceinline__ f32x2 gelu_pk(f32x2 v) {
    const f32x2 av = __builtin_elementwise_abs(v), d = av * 0.2316418882f + 1.0f;
    f32x2 t; t.x = __builtin_amdgcn_rcpf(d.x); t.y = __builtin_amdgcn_rcpf(d.y);
    f32x2 q = t * 0.5307027145f + (-0.7265760135f); q = q * t + 0.7107068705f; q = q * t + (-0.142248368f); q = q * t + 0.127414796f; q = q * t;
    const f32x2 s = (v * v) * (-0.72134752044f);
    f32x2 e; e.x = __builtin_amdgcn_exp2f(s.x); e.y = __builtin_amdgcn_exp2f(s.y);
    const f32x2 m = v * (q * e), r = v - m;
    f32x2 o; o.x = v.x < 0.f ? m.x : r.x; o.y = v.y < 0.f ? m.y : r.y; return o;
}

struct EpiF32 {
    static constexpr bool PERM = false, AFTER_DRAIN = false;
    float* C; int ldc; const float* bias;
    __device__ __forceinline__ void operator()(const f32x4 (&acc)[2][2][4][2], const Unit& u, int wr, int wc, int fr, int fq) const {
        const int row0 = u.pm * BM + wr * 64 + fr, col0 = u.pn * BM + wc * 32 + 4 * fq;
        f32x4 bv[2][2];
#pragma unroll
        for (int bj = 0; bj < 2; ++bj)
#pragma unroll
            for (int n = 0; n < 2; ++n) bv[bj][n] = bias ? *(const f32x4*)(bias + col0 + bj * HALF + n * 16) : (f32x4){0.f, 0.f, 0.f, 0.f};
#pragma unroll
        for (int ai = 0; ai < 2; ++ai)
#pragma unroll
            for (int m = 0; m < 4; ++m) { float* rowp = C + (size_t)(row0 + ai * HALF + m * 16) * ldc + col0;
#pragma unroll
                for (int bj = 0; bj < 2; ++bj)
#pragma unroll
                    for (int n = 0; n < 2; ++n) *(f32x4*)(rowp + bj * HALF + n * 16) = acc[ai][bj][m][n] + bv[bj][n]; }
    }
};
template <int ACT  > struct EpiBf16 {
    static constexpr bool PERM = true, AFTER_DRAIN = false;
    bf16_t* O; int ldc; const float* bias; int split_cols; size_t split_stride;
    __device__ __forceinline__ void operator()(const f32x4 (&acc)[2][2][4][2], const Unit& u, int wr, int wc, int fr, int fq) const {
        const int row0 = u.pm * BM + wr * 64 + fr; int colt = u.pn * BM; bf16_t* base = O;
        if (split_cols) { const int t = colt / split_cols; base += (size_t)t * split_stride; colt -= t * split_cols; }
        const int col0 = colt + wc * 32 + 8 * fq, bcol0 = u.pn * BM + wc * 32 + 8 * fq;
        f32x4 bv[2][2];
#pragma unroll
        for (int bj = 0; bj < 2; ++bj)
#pragma unroll
            for (int n = 0; n < 2; ++n) bv[bj][n] = bias ? *(const f32x4*)(bias + bcol0 + bj * HALF + 4 * n) : (f32x4){0.f, 0.f, 0.f, 0.f};
#pragma unroll
        for (int ai = 0; ai < 2; ++ai)
#pragma unroll
            for (int m = 0; m < 4; ++m) { bf16_t* rowp = base + (size_t)(row0 + ai * HALF + m * 16) * ldc + col0;
#pragma unroll
                for (int bj = 0; bj < 2; ++bj) { f32x4 v0 = acc[ai][bj][m][0] + bv[bj][0], v1 = acc[ai][bj][m][1] + bv[bj][1];
                    if (ACT == 1) { f32x2 a = gelu_pk((f32x2){v0[0], v0[1]}), b = gelu_pk((f32x2){v0[2], v0[3]}), c = gelu_pk((f32x2){v1[0], v1[1]}), d = gelu_pk((f32x2){v1[2], v1[3]});
                        v0 = (f32x4){a.x, a.y, b.x, b.y}; v1 = (f32x4){c.x, c.y, d.x, d.y}; }
                    if (ACT == 2) {
#pragma unroll
                        for (int j = 0; j < 4; ++j) { v0[j] = 0.5f * v0[j] * (1.0f + erff(v0[j] * 0.70710678f)); v1[j] = 0.5f * v1[j] * (1.0f + erff(v1[j] * 0.70710678f)); } }
                    u32x4 w; w.x = cvt_pk_bf16(v0[0], v0[1]); w.y = cvt_pk_bf16(v0[2], v0[3]); w.z = cvt_pk_bf16(v1[0], v1[1]); w.w = cvt_pk_bf16(v1[2], v1[3]);
                    *(u32x4*)(rowp + bj * HALF) = w; } }
    }
};

template <int MODE> __device__ __forceinline__ f32x4 pg8_mma(bf16x8 a, bf16x8 b, f32x4 c) {
    if constexpr (MODE == 1) { typedef int i32x4_ __attribute__((ext_vector_type(4))); return __builtin_bit_cast(f32x4, __builtin_amdgcn_mfma_i32_16x16x64_i8(__builtin_bit_cast(i32x4_, a), __builtin_bit_cast(i32x4_, b), __builtin_bit_cast(i32x4_, c), 0, 0, 0)); }
    else return __builtin_amdgcn_mfma_f32_16x16x32_bf16(a, b, c, 0, 0, 0); }
__device__ __forceinline__ f32x4 pg8_mma8(bf16x8 a0, bf16x8 a1, bf16x8 b0, bf16x8 b1, f32x4 c) {
    typedef int i32x4_ __attribute__((ext_vector_type(4))); typedef int i32x8_ __attribute__((ext_vector_type(8)));
    const i32x8_ A = __builtin_shufflevector(__builtin_bit_cast(i32x4_, a0), __builtin_bit_cast(i32x4_, a1), 0, 1, 2, 3, 4, 5, 6, 7), B = __builtin_shufflevector(__builtin_bit_cast(i32x4_, b0), __builtin_bit_cast(i32x4_, b1), 0, 1, 2, 3, 4, 5, 6, 7);
    const int one = 0x7f7f7f7f;
    asm volatile("v_mfma_scale_f32_16x16x128_f8f6f4 %0, %1, %2, %0, %3, %3 op_sel_hi:[0,0,0]" : "+v"(c) : "v"(A), "v"(B), "v"(one));
    return c; }
__device__ __forceinline__ void fp8_acc_settle() { asm volatile("s_nop 7\n\ts_nop 7\n\ts_nop 7" ::: "memory"); }
template <class Epi, class Sched, bool STAMP = false, int MODE = 0>
__device__ __forceinline__ void gemm_phase(PG8_LAS unsigned char* lds, const Gemm g, const Sched& S, const Epi& E, unsigned long long* stamps) {
    const int tid = threadIdx.x, wid = __builtin_amdgcn_readfirstlane(tid >> 6), lane = tid & 63, wr = wid >> 2, wc = wid & 3, fr = lane & 15, fq = lane >> 4;
    const int K = g.K, nt = K / BK;
    int ts_lo = 0, ts_hi = 0, nts = 0; const unsigned long long rt_entry = STAMP ? (unsigned long long)wall_clock64() : 0ull;
#define PG8_STAMP() do { if (STAMP && wid == 0 && nts < 64) { const unsigned long long _c = (unsigned long long)clock64(); \
        ts_lo = (lane == nts) ? (int)(unsigned)_c : ts_lo; ts_hi = (lane == nts) ? (int)(unsigned)(_c >> 32) : ts_hi; ++nts; } } while (0)
    PG8_STAMP();
    unsigned voffA[2], voffB[2];
#pragma unroll
    for (int i = 0; i < 2; ++i) { int R, C; stage_rc(tid * 16 + i * 8192, R, C); const int Rb = Epi::PERM ? ((R & ~31) + perm32(R & 31)) : R;
        voffA[i] = (unsigned)(R * K + C) * 2u; voffB[i] = (unsigned)(Rb * K + C) * 2u; }
    const size_t kstep = (size_t)(BK * 2);
    const size_t hstep = (size_t)HALF * K * 2;
    const size_t tstep = 2 * hstep;
    const unsigned ldsw = (unsigned)wid * 1024u;
    const int aoff = lds_byte(wr * 64 + fr, fq * 8), boff = lds_byte(wc * 32 + fr, fq * 8);
#define PG8_SA(b, h) (((b) * 2 + (h)) * HTB)
#define PG8_SB(b, h) ((4 + (b) * 2 + (h)) * HTB)
#define PG8_STAGE(bufoff, gbase, voff) do { _Pragma("unroll") for (int _i = 0; _i < 2; ++_i) \
        __builtin_amdgcn_global_load_lds((const unsigned*)((const char*)(gbase) + (voff)[_i]), (PG8_LAS unsigned*)(lds + (bufoff) + ldsw + _i * 8192), 16, 0, 0); } while (0)
#define PG8_LDA(dst, b, h) do { _Pragma("unroll") for (int m = 0; m < 4; ++m) _Pragma("unroll") for (int k = 0; k < 2; ++k) dst[m][k] = *(const PG8_LAS bf16x8*)(lds + PG8_SA(b, h) + aoff + m * 2048 + k * 1024); } while (0)
#define PG8_LDB(dst, b, h) do { _Pragma("unroll") for (int n = 0; n < 2; ++n) _Pragma("unroll") for (int k = 0; k < 2; ++k) dst[n][k] = *(const PG8_LAS bf16x8*)(lds + PG8_SB(b, h) + boff + n * 2048 + k * 1024); } while (0)
#define PG8_MMA(ai, bj, At, Bt) do { __builtin_amdgcn_s_setprio(1); _Pragma("unroll") for (int m = 0; m < 4; ++m) _Pragma("unroll") for (int n = 0; n < 2; ++n) { if constexpr (MODE == 2) acc[ai][bj][m][n] = pg8_mma8(Bt[n][0], Bt[n][1], At[m][0], At[m][1], acc[ai][bj][m][n]); else { _Pragma("unroll") for (int k = 0; k < 2; ++k) \
        acc[ai][bj][m][n] = pg8_mma<MODE>(Bt[n][k], At[m][k], acc[ai][bj][m][n]); } } __builtin_amdgcn_s_setprio(0); } while (0)
#define PG8_WAIT_V(n) asm volatile("s_waitcnt vmcnt(" #n ")" ::: "memory")
#define PG8_WAIT_L(n) asm volatile("s_waitcnt lgkmcnt(" #n ")" ::: "memory")
#define PG8_BAR __builtin_amdgcn_s_barrier()
#define PG8_SCHED __builtin_amdgcn_sched_barrier(0)
    Unit cur, nxt; int ui = 0;
    if (!S.next(0, cur)) return;
    f32x4 acc[2][2][4][2];
#pragma unroll
    for (int a = 0; a < 2; ++a)
#pragma unroll
        for (int b = 0; b < 2; ++b)
#pragma unroll
            for (int m = 0; m < 4; ++m)
#pragma unroll
                for (int n = 0; n < 2; ++n) acc[a][b][m][n] = (f32x4){0.f, 0.f, 0.f, 0.f};
    bf16x8 At[4][2], B0[2][2], B1[2][2];
    const char* cA = (const char*)g.A + (size_t)cur.pm * tstep; const char* cB = (const char*)g.Bt + (size_t)cur.pn * tstep;
    S.a_ready(cur);
    PG8_STAGE(PG8_SB(0, 0), cB, voffB); PG8_STAGE(PG8_SA(0, 0), cA, voffA); PG8_STAGE(PG8_SB(0, 1), cB + hstep, voffB); PG8_STAGE(PG8_SA(0, 1), cA + hstep, voffA);
    if (wr == 1) PG8_BAR;
    PG8_WAIT_V(4); PG8_BAR;
    PG8_STAGE(PG8_SB(1, 0), cB + kstep, voffB); PG8_STAGE(PG8_SA(1, 0), cA + kstep, voffA); PG8_STAGE(PG8_SB(1, 1), cB + hstep + kstep, voffB);
    PG8_WAIT_V(6); PG8_BAR;
    PG8_STAMP();
    for (;;) {
        const bool has_next = S.next(ui + 1, nxt);
        const char* nA = has_next ? (const char*)g.A + (size_t)nxt.pm * tstep : cA; const char* nB = has_next ? (const char*)g.Bt + (size_t)nxt.pn * tstep : cB;
        for (int t = 0; t < nt; t += 2) {
            const bool last = (t == nt - 2);
            const char* a1 = cA + (size_t)(t + 1) * kstep;
            const char* a2 = last ? nA : cA + (size_t)(t + 2) * kstep; const char* b2 = last ? nB : cB + (size_t)(t + 2) * kstep;
            const char* a3 = a2 + kstep; const char* b3 = b2 + kstep;
            if (last && has_next) S.a_ready(nxt);
            PG8_LDB(B0, 0, 0); PG8_SCHED; PG8_LDA(At, 0, 0); PG8_STAGE(PG8_SA(1, 1), a1 + hstep, voffA);
            PG8_WAIT_L(8); PG8_BAR; PG8_WAIT_L(0); PG8_MMA(0, 0, At, B0); PG8_BAR; PG8_SCHED;
            PG8_LDB(B1, 0, 1); PG8_STAGE(PG8_SB(0, 0), b2, voffB);
            PG8_BAR; PG8_WAIT_L(0); PG8_MMA(0, 1, At, B1); PG8_BAR;
            PG8_LDA(At, 0, 1); PG8_STAGE(PG8_SA(0, 0), a2, voffA);
            PG8_BAR; PG8_WAIT_L(0); PG8_MMA(1, 0, At, B0); PG8_BAR; PG8_SCHED;
            PG8_STAGE(PG8_SB(0, 1), b2 + hstep, voffB);
            PG8_WAIT_V(6); PG8_BAR; PG8_MMA(1, 1, At, B1); PG8_BAR;
            PG8_LDB(B0, 1, 0); PG8_SCHED; PG8_LDA(At, 1, 0); PG8_STAGE(PG8_SA(0, 1), a2 + hstep, voffA);
            PG8_WAIT_L(8); PG8_BAR; PG8_WAIT_L(0); PG8_MMA(0, 0, At, B0); PG8_BAR; PG8_SCHED;
            PG8_LDB(B1, 1, 1); PG8_STAGE(PG8_SB(1, 0), b3, voffB);
            PG8_BAR; PG8_WAIT_L(0); PG8_MMA(0, 1, At, B1); PG8_BAR;
            PG8_LDA(At, 1, 1); PG8_STAGE(PG8_SA(1, 0), a3, voffA);
            PG8_BAR; PG8_WAIT_L(0); PG8_MMA(1, 0, At, B0); PG8_BAR; PG8_SCHED;
            PG8_STAGE(PG8_SB(1, 1), b3 + hstep, voffB);
            PG8_WAIT_V(6); PG8_BAR; PG8_MMA(1, 1, At, B1); PG8_BAR;
        }
        PG8_STAMP();
        if constexpr (!Epi::AFTER_DRAIN) { E(acc, cur, wr, wc, fr, fq); S.done(cur); }
        PG8_STAMP();
        if (!has_next) break;
#pragma unroll
        for (int a = 0; a < 2; ++a)
#pragma unroll
            for (int b = 0; b < 2; ++b)
#pragma unroll
                for (int m = 0; m < 4; ++m)
#pragma unroll
                    for (int n = 0; n < 2; ++n) acc[a][b][m][n] = (f32x4){0.f, 0.f, 0.f, 0.f};
        cur = nxt; cA = nA; cB = nB; ++ui;
    }
    PG8_WAIT_V(0);
    if (wr == 0) PG8_BAR;
    PG8_BAR;
    if constexpr (Epi::AFTER_DRAIN) { E.fused(acc, cur, wr, wc, fr, fq, lds, wid, lane); S.done(cur); }
    PG8_STAMP();
    if (STAMP && wid == 0) { stamps[lane] = lane < nts ? (((unsigned long long)(unsigned)ts_hi << 32) | (unsigned)ts_lo) : 0ull;
        if (lane == 62) stamps[62] = rt_entry; if (lane == 63) stamps[63] = (unsigned long long)wall_clock64(); }
#undef PG8_STAMP
#undef PG8_SA
#undef PG8_SB
#undef PG8_STAGE
#undef PG8_LDA
#undef PG8_LDB
#undef PG8_MMA
#undef PG8_WAIT_V
#undef PG8_WAIT_L
#undef PG8_BAR
#undef PG8_SCHED
}
}
#define XB_TMO      128
#define XB_XCNT(j)  (256  + 64 * (j))
#define XB_XSUB(j)  (1280 + 64 * (j))
#define XB_XGEN(j)  (2304 + 64 * (j))
#define XB_TOP      3328
#define XB_TOPGEN   3392
#define XCD_BAR_WORDS 3456
#define XB_SPIN_CAP (1u << 18)
#define LAS __attribute__((address_space(3)))

__device__ __forceinline__ unsigned xb_ld(unsigned* p)              { return __hip_atomic_load(p, __ATOMIC_RELAXED, __HIP_MEMORY_SCOPE_AGENT); }
__device__ __forceinline__ unsigned xb_add(unsigned* p, unsigned v) { return __hip_atomic_fetch_add(p, v, __ATOMIC_RELAXED, __HIP_MEMORY_SCOPE_AGENT); }
__device__ __forceinline__ unsigned xb_xcc_id() { return (unsigned)__builtin_amdgcn_s_getreg((3 << 11) | 20) & 0xFu; }
#define XB_SPIN(cond, bar) do { unsigned _sp = 0; while (cond) { __builtin_amdgcn_s_sleep(1); \
    if ((++_sp & 255u) == 0u) { if (xb_ld(&(bar)[XB_TMO])) break; if (_sp > XB_SPIN_CAP) { atomicAdd(&(bar)[XB_TMO], 1u); break; } } } } while (0)

struct XcdBarrier {
    unsigned* bar; unsigned x;
    volatile LAS unsigned* st;
};

__device__ __forceinline__ XcdBarrier xcd_barrier_post(unsigned* bar, volatile LAS unsigned* st) {
    XcdBarrier b; b.bar = bar; b.x = xb_xcc_id(); b.st = st;
    if (threadIdx.x == 0) (void)xb_add(&bar[XB_XCNT(b.x)], 1u);
    return b;
}
__device__ __forceinline__ void xcd_barrier_complete(unsigned* bar, unsigned x, unsigned& nloc, unsigned& nx) {
    const unsigned G = gridDim.x * gridDim.y * gridDim.z;
    unsigned sum, cnt, mine, sp = 0u;
    for (;;) {
        sum = 0u; cnt = 0u; mine = 0u;
#pragma unroll
        for (unsigned j = 0; j < 16; ++j) { const unsigned c = xb_ld(&bar[XB_XCNT(j)]); sum += c; cnt += (c > 0u) ? 1u : 0u; mine = (j == x) ? c : mine; }
        if (sum == G) break;
        __builtin_amdgcn_s_sleep(1);
        if ((++sp & 255u) == 0u) { if (xb_ld(&bar[XB_TMO])) break; if (sp > XB_SPIN_CAP) { atomicAdd(&bar[XB_TMO], 1u); break; } }
    }
    nloc = mine > 0u ? mine : 1u; nx = cnt > 0u ? cnt : 1u;
}

__device__ __forceinline__ void xcd_barrier(const XcdBarrier& b) {
    asm volatile("s_waitcnt vmcnt(0)" ::: "memory");
    __syncthreads();
    if (threadIdx.x == 0) {
        unsigned* bar = b.bar;
        __builtin_amdgcn_s_waitcnt(0);
        unsigned nloc = b.st[0], nx = b.st[1];
        if (nloc == 0u) { xcd_barrier_complete(bar, b.x, nloc, nx); b.st[0] = nloc; b.st[1] = nx; }
        const unsigned old = xb_add(&bar[XB_XSUB(b.x)], 1u);
        const unsigned gen = old / nloc;
        if (old + 1u == (gen + 1u) * nloc) {
            __builtin_amdgcn_fence(__ATOMIC_RELEASE, "agent");
            asm volatile("s_waitcnt vmcnt(0)" ::: "memory");
            const unsigned og = xb_add(&bar[XB_TOP], 1u);
            const unsigned tg = og / nx;
            if (og + 1u == (tg + 1u) * nx) xb_add(&bar[XB_TOPGEN], 1u);
            else XB_SPIN(xb_ld(&bar[XB_TOPGEN]) == tg, bar);
            __builtin_amdgcn_fence(__ATOMIC_ACQUIRE, "agent");
            xb_add(&bar[XB_XGEN(b.x)], 1u);
            asm volatile("s_waitcnt vmcnt(0)" ::: "memory");
        } else {
            XB_SPIN(xb_ld(&bar[XB_XGEN(b.x)]) == gen, bar);
            __builtin_amdgcn_fence(__ATOMIC_ACQUIRE, "agent");
            asm volatile("s_waitcnt vmcnt(0)" ::: "memory");
        }
    }
    __syncthreads();
}

namespace mk {
using pg8::bf16_t; using pg8::bf16x8; using pg8::f32x4; using pg8::u32x4;
typedef unsigned u32x2 __attribute__((ext_vector_type(2)));
typedef short bf16x4 __attribute__((ext_vector_type(4)));
typedef float lf2 __attribute__((ext_vector_type(2)));
typedef float lf4 __attribute__((ext_vector_type(4)));
typedef unsigned lu4 __attribute__((ext_vector_type(4)));

constexpr int D = 1024, NBATCH = 16, SEQ = 2048, CTXL = 256;
constexpr int NLAT = NBATCH * SEQ, NCTX = NBATCH * CTXL, NROW = NLAT + NCTX;
constexpr int NINP = 3072, NIN = 2944;
constexpr int C_Q = 256, C_K = 640, C_V = 1024, C_Z = 1408;
constexpr int DE = 2816;
constexpr int XROWS = 4608;
constexpr int NTHR = 512;
constexpr int LDS_MISC = 131072, LDS_BYTES = 131072 + 256;

constexpr size_t al256(size_t x) { return (x + 255) & ~(size_t)255; }
constexpr size_t WS_CTL = 0;
constexpr size_t WS_MOD = 65536;
constexpr size_t WS_SW = al256(WS_MOD + (size_t)2 * 17 * 6144 * 4);
constexpr size_t SW_W2T = 0, SW_A2T = 98304, SW_G2T = 196608, SW_GLUT = 294912, SW_S5E = 425984, SW_S5W2 = 2523136, SW_STRIDE = 6717440;
constexpr size_t WS_WIN = al256(WS_SW + 2 * SW_STRIDE);
constexpr size_t WS_WOUT = WS_WIN + (size_t)3072 * 1024 * 2;
constexpr size_t WS_WGU = WS_WOUT + (size_t)1024 * 1024 * 2;
constexpr size_t WS_WD = WS_WGU + (size_t)16 * 5632 * 1024 * 2;
constexpr size_t WS_XB = WS_WD + (size_t)16 * 1024 * 2816 * 2;
constexpr size_t WS_CTXA = WS_XB + (size_t)NLAT * D * 4;
constexpr size_t WS_CTXB = WS_CTXA + (size_t)NCTX * D * 4;
constexpr size_t WS_ABUF = WS_CTXB + (size_t)NCTX * D * 4;
constexpr size_t WS_AFF = WS_ABUF + (size_t)NROW * D * 2;
constexpr size_t WS_SLOT = WS_AFF + (size_t)NROW * 16 * 4;
constexpr size_t WS_SELG = WS_SLOT + (size_t)NROW * 16 * 4;
constexpr size_t WS_SW8 = al256(WS_SELG + (size_t)16 * XROWS * 4);
constexpr size_t WS_SX = WS_SW8 + (size_t)16 * 5632 * 4;
constexpr size_t WS_SXS = WS_SX + (size_t)NROW * 4;
constexpr size_t WS_SWIN = WS_SXS + (size_t)16 * XROWS * 4;
constexpr size_t WS_SH = WS_SWIN + (size_t)3072 * 4;
constexpr size_t WS_SWD = WS_SH + (size_t)NROW * 4;
constexpr size_t WS_U = al256(WS_SWD + (size_t)16 * 1024 * 4);
constexpr size_t SZ384 = (size_t)NROW * 384 * 2;
constexpr size_t U_P = WS_U;
constexpr size_t U_QR = U_P + (size_t)NROW * NINP * 2;
constexpr size_t U_KR = U_QR + SZ384;
constexpr size_t U_VT = U_KR + SZ384;
constexpr size_t U_VTC = U_VT + (size_t)16 * 384 * 2048 * 2;
constexpr size_t U_RS = U_VT + SZ384;
constexpr size_t U_KS = U_RS + SZ384;
constexpr size_t U_VS = U_KS + SZ384;
constexpr size_t U_KK = U_VS + SZ384;
constexpr size_t U_ALR = U_KK + SZ384;
constexpr size_t U_LD = U_ALR + SZ384;
constexpr size_t U_AG = U_LD + 2 * SZ384;
constexpr size_t U_G = U_AG + 2 * SZ384;
constexpr size_t U_YRK = U_G + SZ384;
constexpr size_t U_SLOC = U_YRK + 2 * (size_t)NROW * 384 * 4;
constexpr size_t U_SPREV = U_SLOC + (size_t)2304 * 16 * 256 * 4;
constexpr size_t U_YG = U_SPREV + (size_t)2304 * 16 * 256 * 2;
constexpr size_t U_U16 = U_YG + (size_t)NROW * 256 * 2;
constexpr size_t U_MIX_END = U_U16 + (size_t)NROW * 256 * 2;
constexpr int NCHUNK = 192 * 144;
constexpr size_t CH_XP = U_P;
constexpr size_t CH_BK = CH_XP + (size_t)NCHUNK * 4096;
constexpr size_t CH_UL = CH_BK + (size_t)NCHUNK * 4096;
constexpr size_t CH_MM = U_SLOC;
constexpr size_t CH_GT = CH_MM + (size_t)NCHUNK * 1024;
static_assert(CH_UL + (size_t)NCHUNK * 2048 <= U_RS, "chunk buffers overlap live RWKV operands");
static_assert(CH_GT + (size_t)NCHUNK * 256 <= U_SPREV, "chunk buffers overlap S5 states");
constexpr size_t U_Y = WS_U;
constexpr size_t U_XSEL = U_Y + (size_t)NROW * D * 4;
constexpr size_t U_HID = U_XSEL + (size_t)16 * XROWS * 1024 * 2;
constexpr size_t U_YEXP = U_HID + (size_t)16 * XROWS * DE * 2;
constexpr size_t U_FFN_END = U_YEXP + (size_t)16 * XROWS * 1024 * 2;
constexpr size_t WS_END = U_MIX_END > U_FFN_END ? U_MIX_END : U_FFN_END;

struct Params { const float* in[35]; float* out; unsigned char* ws; int ph_lo, ph_hi, use_bar, pad; };

typedef __bf16 hwbf2 __attribute__((ext_vector_type(2)));
__device__ __forceinline__ unsigned pack2(float lo, float hi) { const lf2 v = {lo, hi}; return __builtin_bit_cast(unsigned, __builtin_convertvector(v, hwbf2)); }
__device__ __forceinline__ bf16_t f2bf(float f) { return (bf16_t)(pack2(f, 0.f) & 0xffffu); }
__device__ __forceinline__ float bflo(unsigned w) { return __uint_as_float(w << 16); }
__device__ __forceinline__ float bfhi(unsigned w) { return __uint_as_float(w & 0xffff0000u); }
__device__ __forceinline__ float bf2f(bf16_t b) { return __uint_as_float(((unsigned)b) << 16); }
__device__ __forceinline__ float sigm(float x) { return 1.0f / (1.0f + __expf(-x)); }
__device__ __forceinline__ float wave_sum(float v) {
#pragma unroll
    for (int o = 32; o >= 1; o >>= 1) v += __shfl_xor(v, o);
    return v; }
__device__ __forceinline__ void unpack8(const uint4 w, float (&f)[8]) { f[0] = bflo(w.x); f[1] = bfhi(w.x); f[2] = bflo(w.y); f[3] = bfhi(w.y); f[4] = bflo(w.z); f[5] = bfhi(w.z); f[6] = bflo(w.w); f[7] = bfhi(w.w); }
__device__ __forceinline__ uint4 pack8(const float (&f)[8]) { uint4 w; w.x = pack2(f[0], f[1]); w.y = pack2(f[2], f[3]); w.z = pack2(f[4], f[5]); w.w = pack2(f[6], f[7]); return w; }
__device__ __forceinline__ const float* xrow(const float* lat, const float* ctx, int r) { return r < NLAT ? lat + (size_t)r * D : ctx + (size_t)(r - NLAT) * D; }
__device__ __forceinline__ float* xrow_w(float* lat, float* ctx, int r) { return r < NLAT ? lat + (size_t)r * D : ctx + (size_t)(r - NLAT) * D; }
__device__ __forceinline__ f32x4 mfma16(bf16x8 a, bf16x8 b, f32x4 c) { return __builtin_amdgcn_mfma_f32_16x16x32_bf16(a, b, c, 0, 0, 0); }

__device__ __forceinline__ void tr_tile(const float* __restrict__ src, int ldsrc, int k0, int n0, bf16_t* __restrict__ dst, int lddst, int drow0, LAS unsigned* T) {
    const int tid = threadIdx.x, n4 = tid & 15, kq = tid >> 4;
    const float4 a = *(const float4*)(src + (size_t)(k0 + 2 * kq) * ldsrc + n0 + 4 * n4);
    const float4 b = *(const float4*)(src + (size_t)(k0 + 2 * kq + 1) * ldsrc + n0 + 4 * n4);
    T[(4 * n4 + 0) * 33 + kq] = pack2(a.x, b.x); T[(4 * n4 + 1) * 33 + kq] = pack2(a.y, b.y);
    T[(4 * n4 + 2) * 33 + kq] = pack2(a.z, b.z); T[(4 * n4 + 3) * 33 + kq] = pack2(a.w, b.w);
    __syncthreads();
    const int n = tid >> 3, pc = tid & 7;
    uint4 v; v.x = T[n * 33 + 4 * pc]; v.y = T[n * 33 + 4 * pc + 1]; v.z = T[n * 33 + 4 * pc + 2]; v.w = T[n * 33 + 4 * pc + 3];
    *(uint4*)(dst + (size_t)(drow0 + n) * lddst + k0 + 8 * pc) = v;
    __syncthreads();
}

__device__ __forceinline__ void tr_tile4(const float* __restrict__ src, int ldsrc, int k0, int n0, bf16_t* __restrict__ dst, int lddst, int drow0, LAS unsigned* T) {
    const int tid = threadIdx.x, n4 = tid & 15, kq = tid >> 4;
    float4 a[4], b[4];
#pragma unroll
    for (int t = 0; t < 4; ++t) { a[t] = *(const float4*)(src + (size_t)(k0 + 2 * kq) * ldsrc + n0 + 64 * t + 4 * n4); b[t] = *(const float4*)(src + (size_t)(k0 + 2 * kq + 1) * ldsrc + n0 + 64 * t + 4 * n4); }
#pragma unroll
    for (int t = 0; t < 4; ++t) { LAS unsigned* Tt = T + t * 64 * 33;
        Tt[(4 * n4 + 0) * 33 + kq] = pack2(a[t].x, b[t].x); Tt[(4 * n4 + 1) * 33 + kq] = pack2(a[t].y, b[t].y); Tt[(4 * n4 + 2) * 33 + kq] = pack2(a[t].z, b[t].z); Tt[(4 * n4 + 3) * 33 + kq] = pack2(a[t].w, b[t].w); }
    __syncthreads();
#pragma unroll
    for (int i = 0; i < 4; ++i) { const int idx = tid + NTHR * i, n = idx >> 3, pc = idx & 7;
        uint4 v; v.x = T[n * 33 + 4 * pc]; v.y = T[n * 33 + 4 * pc + 1]; v.z = T[n * 33 + 4 * pc + 2]; v.w = T[n * 33 + 4 * pc + 3];
        *(uint4*)(dst + (size_t)(drow0 + n) * lddst + k0 + 8 * pc) = v; }
    __syncthreads();
}
template <int NK, int DP, bool FP8> __device__ __forceinline__ void q8_strip(const float* __restrict__ src, int ldsrc, unsigned char* __restrict__ dst, float* __restrict__ scl, LAS unsigned char* lds) {
    LAS float* cmax = (LAS float*)lds;
    LAS unsigned char* T = lds + 8704;
    const int tid = threadIdx.x, n4 = tid & 15, kq = tid >> 4; constexpr float QMAX = FP8 ? 256.0f : 127.0f;
    float mx[4] = {0.f, 0.f, 0.f, 0.f};
#pragma unroll 8
    for (int i = 0; i < 2 * NK; ++i) { const float4 v = *(const float4*)(src + (size_t)(kq + 32 * i) * ldsrc + 4 * n4); mx[0] = fmaxf(mx[0], fabsf(v.x)); mx[1] = fmaxf(mx[1], fabsf(v.y)); mx[2] = fmaxf(mx[2], fabsf(v.z)); mx[3] = fmaxf(mx[3], fabsf(v.w)); }
    __syncthreads();
#pragma unroll
    for (int j = 0; j < 4; ++j) cmax[kq * 64 + 4 * n4 + j] = mx[j];
    __syncthreads();
    if (tid < 64) { float m = 0.f; for (int g = 0; g < 32; ++g) m = fmaxf(m, cmax[g * 64 + tid]); m = fmaxf(m, 1e-20f); scl[tid] = m * (1.0f / QMAX); cmax[32 * 64 + tid] = QMAX / m; }
    __syncthreads();
    float inv[4];
#pragma unroll
    for (int j = 0; j < 4; ++j) inv[j] = cmax[32 * 64 + 4 * n4 + j];
    for (int kg = 0; kg < NK / 4; ++kg) {
        float4 a[4], b[4];
#pragma unroll
        for (int t = 0; t < 4; ++t) { const int kb = (kg * 4 + t) * 64 + 2 * kq; a[t] = *(const float4*)(src + (size_t)kb * ldsrc + 4 * n4); b[t] = *(const float4*)(src + (size_t)(kb + 1) * ldsrc + 4 * n4); }
#pragma unroll
        for (int t = 0; t < 4; ++t) { const float av[4] = {a[t].x, a[t].y, a[t].z, a[t].w}, bv[4] = {b[t].x, b[t].y, b[t].z, b[t].w};
#pragma unroll
            for (int j = 0; j < 4; ++j) { unsigned short w;
                if (FP8) w = (unsigned short)(__builtin_amdgcn_cvt_pk_fp8_f32(av[j] * inv[j], bv[j] * inv[j], 0, false) & 0xffff);
                else { const int q0 = __float2int_rn(av[j] * inv[j]), q1 = __float2int_rn(bv[j] * inv[j]); w = (unsigned short)((q0 & 255) | ((q1 & 255) << 8)); }
                *(LAS unsigned short*)(T + (4 * n4 + j) * 272 + t * 64 + 2 * kq) = w; } }
        __syncthreads();
#pragma unroll
        for (int i = 0; i < 2; ++i) { const int idx = tid + NTHR * i, n = idx >> 4, pc = idx & 15; *(lu4*)(dst + (size_t)n * DP + kg * 256 + 16 * pc) = *(const LAS lu4*)(T + n * 272 + 16 * pc); }
        __syncthreads();
    }
}
__device__ __forceinline__ void q8r_strip(const float* __restrict__ src, int ldsrc, unsigned char* __restrict__ dst, float* __restrict__ scl, LAS unsigned char* lds) {
    LAS float* cmax = (LAS float*)lds;
    const int tid = threadIdx.x, n4 = tid & 15, rg = tid >> 4;
    const float* s0 = src + (size_t)(rg * 32) * ldsrc + 4 * n4;
    lf4 v[32];
#pragma unroll
    for (int i = 0; i < 32; ++i) v[i] = *(const lf4*)(s0 + (size_t)i * ldsrc);
    __builtin_amdgcn_sched_barrier(0);
    float mx[4] = {0.f, 0.f, 0.f, 0.f};
#pragma unroll
    for (int i = 0; i < 32; ++i) {
#pragma unroll
        for (int j = 0; j < 4; ++j) mx[j] = fmaxf(mx[j], fabsf(v[i][j])); }
    __syncthreads();
#pragma unroll
    for (int j = 0; j < 4; ++j) cmax[rg * 64 + 4 * n4 + j] = mx[j];
    __syncthreads();
    if (tid < 64) { float m = 0.f; for (int g = 0; g < 32; ++g) m = fmaxf(m, cmax[g * 64 + tid]); m = fmaxf(m, 1e-20f); scl[tid] = m * (1.0f / 127.0f); cmax[32 * 64 + tid] = 127.0f / m; }
    __syncthreads();
#pragma unroll
    for (int j = 0; j < 4; ++j) { const float inv = cmax[32 * 64 + 4 * n4 + j]; unsigned w[8];
#pragma unroll
        for (int g = 0; g < 8; ++g) { const int q0 = __float2int_rn(v[4 * g][j] * inv), q1 = __float2int_rn(v[4 * g + 1][j] * inv), q2 = __float2int_rn(v[4 * g + 2][j] * inv), q3 = __float2int_rn(v[4 * g + 3][j] * inv);
            w[g] = (unsigned)(q0 & 255) | ((unsigned)(q1 & 255) << 8) | ((unsigned)(q2 & 255) << 16) | ((unsigned)q3 << 24); }
        unsigned char* d = dst + (size_t)(4 * n4 + j) * 1024 + rg * 32;
        *(lu4*)d = (lu4){w[0], w[1], w[2], w[3]}; *(lu4*)(d + 16) = (lu4){w[4], w[5], w[6], w[7]}; }
}
__device__ __forceinline__ void q8d_strip(const float* __restrict__ src, unsigned char* __restrict__ dst, float* __restrict__ scl, LAS unsigned char* lds) {
    LAS float* cmax = (LAS float*)lds;
    const int tid = threadIdx.x, n8 = tid & 7, rg = tid >> 3; const bool v2 = rg < 48;
    unsigned pk[3][16][2]; float mx[4] = {0.f, 0.f, 0.f, 0.f}; lf4 bufA[8], bufB[8];
    auto ld = [&](lf4 (&b)[8], int hr) { const int r = hr >> 1, c = (r == 2 && !v2) ? rg + 64 : rg + 64 * r; const float* sp = src + (size_t)(c * 16 + (hr & 1) * 8) * 1024 + 4 * n8;
#pragma unroll
        for (int i = 0; i < 8; ++i) b[i] = *(const lf4*)(sp + (size_t)i * 1024); };
    auto use = [&](const lf4 (&b)[8], int hr) {
#pragma unroll
        for (int i = 0; i < 8; ++i) {
#pragma unroll
            for (int j = 0; j < 4; ++j) mx[j] = fmaxf(mx[j], fabsf(b[i][j]));
            pk[hr >> 1][(hr & 1) * 8 + i][0] = pack2(b[i][0], b[i][1]); pk[hr >> 1][(hr & 1) * 8 + i][1] = pack2(b[i][2], b[i][3]); } };
    ld(bufA, 0);
#pragma unroll
    for (int h2 = 0; h2 < 3; ++h2) {
        ld(bufB, 2 * h2 + 1); __builtin_amdgcn_sched_barrier(0); use(bufA, 2 * h2);
        if (h2 < 2) ld(bufA, 2 * h2 + 2);
        __builtin_amdgcn_sched_barrier(0); use(bufB, 2 * h2 + 1); }
    __syncthreads();
#pragma unroll
    for (int j = 0; j < 4; ++j) cmax[rg * 32 + 4 * n8 + j] = mx[j];
    __syncthreads();
    if (tid < 32) { float m = 0.f; for (int g = 0; g < 64; ++g) m = fmaxf(m, cmax[g * 32 + tid]); m = fmaxf(m, 1e-20f); scl[tid] = m * (1.0f / 256.0f); cmax[64 * 32 + tid] = 256.0f / m; }
    __syncthreads();
    float inv[4];
#pragma unroll
    for (int j = 0; j < 4; ++j) inv[j] = cmax[64 * 32 + 4 * n8 + j];
#pragma unroll
    for (int r = 0; r < 3; ++r) { if (r == 2 && !v2) continue;
        const int c = rg + 64 * r;
#pragma unroll
        for (int j = 0; j < 4; ++j) { unsigned w[4];
#pragma unroll
            for (int g = 0; g < 4; ++g) { float f[4];
#pragma unroll
                for (int x = 0; x < 4; ++x) { const unsigned u = pk[r][4 * g + x][j >> 1]; f[x] = ((j & 1) ? bfhi(u) : bflo(u)) * inv[j]; }
                unsigned t = (unsigned)__builtin_amdgcn_cvt_pk_fp8_f32(f[0], f[1], 0, false); t = (unsigned)__builtin_amdgcn_cvt_pk_fp8_f32(f[2], f[3], (int)t, true); w[g] = t; }
            *(lu4*)(dst + (size_t)(4 * n8 + j) * DE + c * 16) = (lu4){w[0], w[1], w[2], w[3]}; } }
}
__device__ __forceinline__ void gu_strip(const Params& p, int l, int item, LAS unsigned char* lds) {
    const int e = item / 88, rem = item % 88, up = rem / 44, nt = rem % 44, n0 = nt * 64, drow0 = (n0 >> 7) * 256 + (n0 & 127) + (up ? 128 : 0);
    q8r_strip(p.in[up ? 33 : 32] + (size_t)(l * 16 + e) * 1024 * DE + n0, DE, p.ws + WS_WGU + ((size_t)e * 5632 + drow0) * 1024, (float*)(p.ws + WS_SW8) + (size_t)e * 5632 + drow0, lds);
}
constexpr int CV_GU = 16 * 88, CV_D4 = 16 * 32, CV_WIN = 46, CV_PAD = 16, CV_WOUT4 = 16 * 4, CV_TOTAL = CV_GU + CV_D4 + CV_WIN + CV_PAD + CV_WOUT4;
__device__ __forceinline__ void convert_weights(const Params& p, int l, LAS unsigned char* lds, int vb, int nvb) {
    LAS unsigned* T = (LAS unsigned*)lds; bf16_t* WOUT = (bf16_t*)(p.ws + WS_WOUT);
    for (int it = vb; it < CV_TOTAL; it += nvb) {
        int j = it;
        if (j < CV_GU) { gu_strip(p, l, j, lds); continue; }
        j -= CV_GU;
        if (j < CV_D4) { const int e = j >> 5, nt = j & 31;
            q8d_strip(p.in[34] + (size_t)(l * 16 + e) * DE * 1024 + nt * 32, p.ws + WS_WD + ((size_t)e * 1024 + nt * 32) * DE, (float*)(p.ws + WS_SWD) + e * 1024 + nt * 32, lds); continue; }
        j -= CV_D4;
        if (j < CV_WIN) { q8r_strip(p.in[7] + (size_t)l * 1024 * NIN + j * 64, NIN, p.ws + WS_WIN + (size_t)j * 64 * 1024, (float*)(p.ws + WS_SWIN) + j * 64, lds); continue; }
        j -= CV_WIN;
        if (j < CV_PAD) { const size_t o = (size_t)NIN * 1024 + ((size_t)j * NTHR + threadIdx.x) * 16; *(uint4*)(p.ws + WS_WIN + o) = make_uint4(0u, 0u, 0u, 0u);
            if (j == 0 && threadIdx.x < 128) ((float*)(p.ws + WS_SWIN))[NIN + threadIdx.x] = 0.f; continue; }
        j -= CV_PAD;
        { const int kt = j >> 2, ng = j & 3; tr_tile4(p.in[8] + (size_t)l * 1024 * 1024, 1024, kt * 64, ng * 256, WOUT, 1024, ng * 256, T); }
    }
}

__device__ __forceinline__ void mod_item(const Params& p, int item, LAS unsigned char* lds) {
    LAS float* sc = (LAS float*)lds;
    LAS float* red = (LAS float*)(lds + 69632);
    const int tid = threadIdx.x, l = item / 96, cg = item % 96;
    for (int i = tid; i < 17 * 1024; i += NTHR) { const int b = i >> 10, k = i & 1023; const float c = b < 16 ? p.in[1][b * 1024 + k] : p.in[3][k]; sc[k * 17 + b] = c * sigm(c); }
    __syncthreads();
    const int col = cg * 64 + (tid & 63), kg = tid >> 6;
    float acc[17];
#pragma unroll
    for (int b = 0; b < 17; ++b) acc[b] = 0.f;
    const float* w = p.in[4] + ((size_t)l * 1024 + kg * 128) * 6144 + col;
#pragma unroll 4
    for (int kk = 0; kk < 128; ++kk) { const float wv = w[(size_t)kk * 6144]; const LAS float* s = sc + (kg * 128 + kk) * 17;
#pragma unroll
        for (int b = 0; b < 17; ++b) acc[b] += s[b] * wv; }
#pragma unroll
    for (int b = 0; b < 17; ++b) red[(kg * 17 + b) * 64 + (tid & 63)] = acc[b];
    __syncthreads();
    for (int i = tid; i < 17 * 64; i += NTHR) { const int b = i >> 6, c = i & 63; float s = 0.f;
#pragma unroll
        for (int g = 0; g < 8; ++g) s += red[(g * 17 + b) * 64 + c];
        ((float*)(p.ws + WS_MOD))[((size_t)l * 17 + b) * 6144 + cg * 64 + c] = s + p.in[5][l * 6144 + cg * 64 + c]; }
    __syncthreads();
}

__device__ __forceinline__ void s5mat_item(const Params& p, int item, LAS unsigned char* lds) {
    LAS lf2* pw = (LAS lf2*)lds;
    LAS lf2* bb = (LAS lf2*)(lds + 17408);
    LAS lf2* cc = (LAS lf2*)(lds + 17408 + 16384);
    LAS float* KT = (LAS float*)(lds + 17408 + 32768);
    const int tid = threadIdx.x, l = item >> 4, g = item & 15;
    for (int i = tid; i < 2 * 17 * 64; i += NTHR) { const int pp = i & 63, n = (i >> 6) % 17, d = i / (17 * 64);
        const int li = ((l * 2 + d) * 16 + g) * 64 + pp; const float lr = p.in[9][li], lim = p.in[10][li], dt = expf(p.in[11][(l * 2 + d) * 16 + g]);
        const float mag = expf((float)n * dt * lr); float s, c; sincosf((float)n * dt * lim, &s, &c); pw[i] = (lf2){mag * c, mag * s}; }
    for (int i = tid; i < 2 * 64 * 16; i += NTHR) { const int h = i & 15, pp = (i >> 4) & 63, d = i >> 10;
        const int li = ((l * 2 + d) * 16 + g) * 64 + pp; const float lr = p.in[9][li], lim = p.in[10][li], dt = expf(p.in[11][(l * 2 + d) * 16 + g]);
        const float mag = expf(dt * lr); float s, c; sincosf(dt * lim, &s, &c); const float x = mag * c - 1.0f, y = mag * s;
        const float den = 1.0f / (lr * lr + lim * lim); const float cr = (x * lr + y * lim) * den, ci = (y * lr - x * lim) * den;
        const int bi = ((l * 16 + g) * 64 + pp) * 16 + h; const float br = p.in[12][bi], bim = p.in[13][bi];
        bb[i] = (lf2){cr * br - ci * bim, cr * bim + ci * br}; }
    for (int i = tid; i < 2 * 16 * 64; i += NTHR) { const int pp = i & 63, h = (i >> 6) & 15, d = i >> 10;
        const int ci = (((l * 2 + d) * 16 + g) * 16 + h) * 64 + pp; cc[i] = (lf2){p.in[14][ci], p.in[15][ci]}; }
    __syncthreads();
    for (int i = tid; i < 2 * 16 * 256; i += NTHR) { const int h2 = i & 15, h = (i >> 4) & 15, tau = (i >> 8) & 15, d = i >> 12; float s = 0.f;
        for (int pp = 0; pp < 64; ++pp) { const lf2 c = cc[(d * 16 + h) * 64 + pp], w = pw[(d * 17 + tau) * 64 + pp], b = bb[(d * 64 + pp) * 16 + h2];
            const float tr = c.x * w.x - c.y * w.y, ti = c.x * w.y + c.y * w.x; s += tr * b.x - ti * b.y; }
        KT[i] = s; }
    __syncthreads();
    bf16_t* E = (bf16_t*)(p.ws + WS_SW + (size_t)l * SW_STRIDE + SW_S5E) + (size_t)g * 256 * 256;
    bf16_t* W2 = (bf16_t*)(p.ws + WS_SW + (size_t)l * SW_STRIDE + SW_S5W2) + (size_t)g * 256 * 512;
    for (int i = tid; i < 256 * 256; i += NTHR) { const int k = i & 255, n = i >> 8; const int s = k >> 4, h = k & 15, d = n >> 7, part = (n >> 6) & 1, pp = n & 63;
        const int e = d == 0 ? 15 - s : s; const lf2 w = pw[(d * 17 + e) * 64 + pp], b = bb[(d * 64 + pp) * 16 + h];
        E[i] = f2bf(part ? (w.x * b.y + w.y * b.x) : (w.x * b.x - w.y * b.y)); }
    for (int i = tid; i < 256 * 512; i += NTHR) { const int k = i & 511, n = i >> 9; const int t = n >> 4, h = n & 15; float v;
        if (k < 256) { const int s = k >> 4, h2 = k & 15; v = 0.f;
            if (t >= s) v += KT[((0 * 16 + (t - s)) * 16 + h) * 16 + h2];
            if (s >= t) v += KT[((1 * 16 + (s - t)) * 16 + h) * 16 + h2];
            if (s == t && h == h2) v += p.in[16][l * 256 + g * 16 + h]; }
        else { const int q = k - 256, d = q >> 7, part = (q >> 6) & 1, pp = q & 63; const int e = d == 0 ? t + 1 : 16 - t;
            const lf2 c = cc[(d * 16 + h) * 64 + pp], w = pw[(d * 17 + e) * 64 + pp];
            v = part ? -(c.x * w.y + c.y * w.x) : (c.x * w.x - c.y * w.y); }
        W2[i] = f2bf(v); }
    __syncthreads();
}

__device__ __forceinline__ void smallw_item(const Params& p, int item) {
    int i = item * NTHR + threadIdx.x; const int l = i / 212992; i %= 212992;
    unsigned char* sw = p.ws + WS_SW + (size_t)l * SW_STRIDE;
    if (i < 49152) { const int k = i & 63, n = (i >> 6) % 384, d = i / 24576; ((bf16_t*)(sw + SW_W2T))[i] = f2bf(p.in[22][((size_t)(l * 2 + d) * 64 + k) * 384 + n]); return; }
    i -= 49152;
    if (i < 49152) { const int k = i & 63, n = (i >> 6) % 384, d = i / 24576; ((bf16_t*)(sw + SW_A2T))[i] = f2bf(p.in[24][((size_t)(l * 2 + d) * 64 + k) * 384 + n]); return; }
    i -= 49152;
    if (i < 49152) { const int k = i & 127, n = i >> 7; ((bf16_t*)(sw + SW_G2T))[i] = f2bf(p.in[25][((size_t)l * 128 + k) * 384 + n]); return; }
    i -= 49152;
    { const int k = i & 255, n = i >> 8; ((bf16_t*)(sw + SW_GLUT))[i] = f2bf(p.in[17][((size_t)l * 256 + k) * 256 + n]); }
}

constexpr int PRO_MOD = 192, PRO_S5 = 32, PRO_SW = 832;
__device__ __forceinline__ void phase_prologue(const Params& p, LAS unsigned char* lds) {
    for (int it = blockIdx.x; it < PRO_MOD + PRO_S5 + PRO_SW; it += gridDim.x) {
        if (it < PRO_MOD) mod_item(p, it, lds);
        else if (it < PRO_MOD + PRO_S5) s5mat_item(p, it - PRO_MOD, lds);
        else smallw_item(p, it - PRO_MOD - PRO_S5);
    }
    convert_weights(p, 0, lds, (int)blockIdx.x, (int)gridDim.x);
}

__device__ __forceinline__ void hnorm_row(const float* g, const float* mb_sh, const float* mb_sc, unsigned char* dst, float* sdst, int lane, const float4 (&v)[4]) {
    float ss = 0.f;
#pragma unroll
    for (int i = 0; i < 4; ++i) ss += v[i].x * v[i].x + v[i].y * v[i].y + v[i].z * v[i].z + v[i].w * v[i].w;
    ss = wave_sum(ss); const float rs = rsqrtf(ss * (1.0f / 1024.0f) + 1e-6f);
    float hv[4][4]; float amax = 0.f;
#pragma unroll
    for (int i = 0; i < 4; ++i) { const int c = i * 256 + lane * 4; const float4 gg = *(const float4*)(g + c), sh = *(const float4*)(mb_sh + c), sc = *(const float4*)(mb_sc + c);
        hv[i][0] = v[i].x * rs * gg.x * (1.f + sc.x) + sh.x; hv[i][1] = v[i].y * rs * gg.y * (1.f + sc.y) + sh.y; hv[i][2] = v[i].z * rs * gg.z * (1.f + sc.z) + sh.z; hv[i][3] = v[i].w * rs * gg.w * (1.f + sc.w) + sh.w;
        amax = fmaxf(amax, fmaxf(fmaxf(fabsf(hv[i][0]), fabsf(hv[i][1])), fmaxf(fabsf(hv[i][2]), fabsf(hv[i][3])))); }
#pragma unroll
    for (int o = 32; o >= 1; o >>= 1) amax = fmaxf(amax, __shfl_xor(amax, o));
    amax = fmaxf(amax, 1e-20f); const float qs = 127.0f / amax;
    if (lane == 0) *sdst = amax * (1.0f / 127.0f);
#pragma unroll
    for (int i = 0; i < 4; ++i) { unsigned w = 0u;
#pragma unroll
        for (int k = 0; k < 4; ++k) w |= ((unsigned)__float2int_rn(hv[i][k] * qs) & 255u) << (8 * k);
        *(unsigned*)(dst + i * 256 + lane * 4) = w; }
}
__device__ __forceinline__ void phase_hnorm(const Params& p, int l, const float* xl, const float* xc) {
    const int lane = threadIdx.x & 63, wv = threadIdx.x >> 6;
    const float* mod = (const float*)(p.ws + WS_MOD) + (size_t)l * 17 * 6144; const float* g = p.in[6] + (l * 4 + 0) * 1024;
    unsigned char* A = p.ws + WS_ABUF; float* SH = (float*)(p.ws + WS_SH);
    for (int r = blockIdx.x * 8 + wv; r < NROW; r += gridDim.x * 8) {
        const float* src = xrow(xl, xc, r); const int b = r < NLAT ? (r >> 11) : 16; const float* mb = mod + (size_t)b * 6144;
        float4 v[4];
#pragma unroll
        for (int i = 0; i < 4; ++i) v[i] = *(const float4*)(src + i * 256 + lane * 4);
        hnorm_row(g, mb, mb + 1024, A + (size_t)r * 1024, SH + r, lane, v);
    }
}


__device__ __forceinline__ void phase_prep(const Params& p, int l, LAS unsigned char* lds) {
    LAS bf16_t* vt = (LAS bf16_t*)lds;
    LAS lf2* cs = (LAS lf2*)(lds + 50176);
    const int tid = threadIdx.x;
    for (int i = tid; i < 1024; i += NTHR) { const int pos = i >> 4, j = i & 15; const float invf = exp2f(-(float)j * (13.287712379549449f / 16.0f)); float s, c; sincosf((float)pos * invf, &s, &c); cs[i] = (lf2){c, s}; }
    __syncthreads();
    const bf16_t* P = (const bf16_t*)(p.ws + U_P);
    bf16_t* QR = (bf16_t*)(p.ws + U_QR); bf16_t* KR = (bf16_t*)(p.ws + U_KR);
    bf16_t* RS = (bf16_t*)(p.ws + U_RS); bf16_t* KS = (bf16_t*)(p.ws + U_KS); bf16_t* VS = (bf16_t*)(p.ws + U_VS); bf16_t* KK = (bf16_t*)(p.ws + U_KK); bf16_t* ALR = (bf16_t*)(p.ws + U_ALR);
    for (int ti = blockIdx.x; ti < NROW / 64; ti += gridDim.x) {
        const int r0 = ti * 64; const bool lat = r0 < NLAT; const int b = lat ? (r0 >> 11) : ((r0 - NLAT) >> 8), t0 = lat ? (r0 & 2047) : ((r0 - NLAT) & 255), slen = lat ? SEQ : CTXL;
#pragma unroll
        for (int i = 0; i < 6; ++i) { const int idx = tid + NTHR * i, tok = idx / 48, pc = idx % 48;
            *(LAS lu4*)(vt + tok * 392 + pc * 8) = *(const lu4*)(P + (size_t)(r0 + tok) * NINP + C_V + pc * 8); }
        __syncthreads();
        { bf16_t* vdst = lat ? (bf16_t*)(p.ws + U_VT) + (size_t)b * 384 * 2048 + t0 : (bf16_t*)(p.ws + U_VTC) + (size_t)b * 384 * 256 + t0;
#pragma unroll
          for (int i = 0; i < 6; ++i) { const int idx = tid + NTHR * i, hd = idx >> 3, pc = idx & 7; unsigned w[4];
#pragma unroll
              for (int j = 0; j < 4; ++j) w[j] = (unsigned)vt[(pc * 8 + 2 * j) * 392 + hd] | ((unsigned)vt[(pc * 8 + 2 * j + 1) * 392 + hd] << 16);
              *(uint4*)(vdst + (size_t)hd * slen + pc * 8) = make_uint4(w[0], w[1], w[2], w[3]); } }
#pragma unroll
        for (int i = 0; i < 4; ++i) { const int idx = tid + NTHR * i, tok = idx >> 5, pc = idx & 31;
            *(lu4*)((bf16_t*)(p.ws + U_U16) + (size_t)(r0 + tok) * 256 + pc * 8) = *(const lu4*)(P + (size_t)(r0 + tok) * NINP + pc * 8); }
        { lu4 rx[6][2]; int tq = threadIdx.x; asm volatile("" : "+v"(tq));
#pragma unroll
          for (int i = 0; i < 6; ++i) { const int idx = tq + NTHR * i, tok = idx / 48, rem = idx % 48, qk = rem / 24, rem2 = rem % 24, h = rem2 >> 2, pp = rem2 & 3;
              const int d1 = (pp >> 1) * 32 + (pp & 1) * 8; const size_t so = (size_t)(r0 + tok) * NINP + (qk ? C_K : C_Q) + h * 64 + d1;
              rx[i][0] = *(const lu4*)(P + so); rx[i][1] = *(const lu4*)(P + so + 16); }
#pragma unroll
          for (int i = 0; i < 6; ++i) { const int idx = tq + NTHR * i, tok = idx / 48, rem = idx % 48, qk = rem / 24, rem2 = rem % 24, h = rem2 >> 2, pp = rem2 & 3;
              const int d1 = (pp >> 1) * 32 + (pp & 1) * 8;
              float x1[8], x2[8], o1[8], o2[8]; unpack8(make_uint4(rx[i][0].x, rx[i][0].y, rx[i][0].z, rx[i][0].w), x1); unpack8(make_uint4(rx[i][1].x, rx[i][1].y, rx[i][1].z, rx[i][1].w), x2);
              const int t = t0 + tok, pos = (pp < 2) ? (t >> 6) : (t & 63), j0 = (pp & 1) * 8; const float scl = qk ? 1.0f : 0.125f;
#pragma unroll
              for (int j = 0; j < 8; ++j) { lf2 c = cs[pos * 16 + j0 + j]; if (!lat) c = (lf2){1.f, 0.f}; o1[j] = (x1[j] * c.x - x2[j] * c.y) * scl; o2[j] = (x1[j] * c.y + x2[j] * c.x) * scl; }
              bf16_t* dq = (qk ? KR : QR) + (size_t)(r0 + tok) * 384 + h * 64 + d1; *(uint4*)dq = pack8(o1); *(uint4*)(dq + 16) = pack8(o2); } }
#pragma unroll 1
        for (int ig = 0; ig < 6; ++ig) { lu4 zc[4], zq[4], zn[4]; int ts = threadIdx.x; asm volatile("" : "+v"(ts));
#pragma unroll
            for (int u = 0; u < 4; ++u) { const int idx = ts + NTHR * (ig * 4 + u), tok = idx / 192, pc = idx % 192, t = t0 + tok; const bf16_t* zp = P + (size_t)(r0 + tok) * NINP + C_Z + pc * 8;
                zc[u] = *(const lu4*)zp; zq[u] = t > 0 ? *(const lu4*)(zp - NINP) : (lu4){0u, 0u, 0u, 0u}; zn[u] = t < slen - 1 ? *(const lu4*)(zp + NINP) : (lu4){0u, 0u, 0u, 0u}; }
#pragma unroll
            for (int u = 0; u < 4; ++u) { const int idx = ts + NTHR * (ig * 4 + u), tok = idx / 192, pc = idx % 192, c0 = pc * 8, r = r0 + tok;
                float x[8], pv[8], nx[8], zs[8];
                unpack8(make_uint4(zc[u].x, zc[u].y, zc[u].z, zc[u].w), x); unpack8(make_uint4(zq[u].x, zq[u].y, zq[u].z, zq[u].w), pv); unpack8(make_uint4(zn[u].x, zn[u].y, zn[u].z, zn[u].w), nx);
                const float4 mu0 = *(const float4*)(p.in[20] + l * 1536 + c0), mu1 = *(const float4*)(p.in[20] + l * 1536 + c0 + 4); const float mu[8] = {mu0.x, mu0.y, mu0.z, mu0.w, mu1.x, mu1.y, mu1.z, mu1.w};
#pragma unroll
                for (int j = 0; j < 8; ++j) zs[j] = x[j] + (0.5f * (pv[j] + nx[j]) - x[j]) * mu[j];
                const bool isk = c0 >= 384 && c0 < 768; float kv[8]; float ss = 0.f;
                { const int kc = isk ? c0 - 384 : 0; const float4 k0 = *(const float4*)(p.in[26] + l * 384 + kc), k1 = *(const float4*)(p.in[26] + l * 384 + kc + 4); const float kkw[8] = {k0.x, k0.y, k0.z, k0.w, k1.x, k1.y, k1.z, k1.w};
#pragma unroll
                  for (int j = 0; j < 8; ++j) { kv[j] = zs[j] * kkw[j]; ss += kv[j] * kv[j]; } }
                ss += __shfl_xor(ss, 1); ss += __shfl_xor(ss, 2); ss += __shfl_xor(ss, 4);
                if (c0 < 384) *(uint4*)(RS + (size_t)r * 384 + c0) = pack8(zs);
                else if (c0 < 768) { *(uint4*)(KS + (size_t)r * 384 + c0 - 384) = pack8(zs); const float inv = 1.0f / fmaxf(sqrtf(ss), 1e-12f);
#pragma unroll
                    for (int j = 0; j < 8; ++j) kv[j] *= inv;
                    *(uint4*)(KK + (size_t)r * 384 + c0 - 384) = pack8(kv); }
                else if (c0 < 1152) *(uint4*)(VS + (size_t)r * 384 + c0 - 768) = pack8(zs);
                else { const int ac = c0 - 1152; float o[8];
#pragma unroll
                    for (int j = 0; j < 8; ++j) o[j] = ac < 128 ? 1.0f - 2.0f / (1.0f + __expf(2.0f * zs[j])) : (ac < 256 ? zs[j] : sigm(zs[j]));
                    *(uint4*)(ALR + (size_t)r * 384 + ac) = pack8(o); } }
        }
        __syncthreads();
    }
}

template <int KS, int MODE> __device__ __forceinline__ void lr_wave(const Params& p, int l, int row0, int kofs, const bf16_t* Bt, int d) {
    const int lane = threadIdx.x & 63, m = lane & 15, q = lane >> 4;
    const bf16_t* Ap = (const bf16_t*)(p.ws + U_ALR) + (size_t)(row0 + m) * 384 + kofs + q * 8;
    bf16x8 a[KS];
#pragma unroll
    for (int ks = 0; ks < KS; ++ks) a[ks] = *(const bf16x8*)(Ap + ks * 32);
    bf16_t* O = (bf16_t*)(p.ws + (MODE == 0 ? U_LD + (size_t)d * SZ384 : (MODE == 1 ? U_AG + (size_t)d * SZ384 : U_G))) + (size_t)(row0 + m) * 384;
    const float* bias = MODE == 0 ? p.in[21] + (l * 2 + d) * 384 : p.in[23] + (l * 2 + d) * 384;
    for (int nt = 0; nt < 24; ++nt) {
        f32x4 acc = (f32x4){0.f, 0.f, 0.f, 0.f};
#pragma unroll
        for (int ks = 0; ks < KS; ++ks) { const bf16x8 bfr = *(const bf16x8*)(Bt + (size_t)(nt * 16 + m) * (KS * 32) + ks * 32 + q * 8); acc = mfma16(bfr, a[ks], acc); }
        const int n = nt * 16 + q * 4; float o[4];
        if (MODE == 2) {
#pragma unroll
            for (int j = 0; j < 4; ++j) o[j] = acc[j];
        } else { const float4 bv = *(const float4*)(bias + n); const float bb[4] = {bv.x, bv.y, bv.z, bv.w};
#pragma unroll
            for (int j = 0; j < 4; ++j) { const float s = sigm(bb[j] + acc[j]); o[j] = MODE == 0 ? -0.6065306597f * s : s; } }
        u32x2 w; w.x = pack2(o[0], o[1]); w.y = pack2(o[2], o[3]); *(u32x2*)(O + n) = w;
    }
}
template <int KS, int MODE> __device__ __forceinline__ void lr_block(const Params& p, int l, const bf16_t* Bt, int kofs, int d, int bi, int nb, LAS unsigned char* lds) {
    constexpr int PITCH = KS * 32 + 8;
    LAS bf16_t* sB = (LAS bf16_t*)lds; LAS float* sbias = (LAS float*)(lds + 384 * PITCH * 2);
    const int tid = threadIdx.x, lane = tid & 63, m = lane & 15, q = lane >> 4, wv = tid >> 6;
    const float* bias = MODE == 0 ? p.in[21] + (l * 2 + d) * 384 : p.in[23] + (l * 2 + d) * 384;
    __syncthreads();
    for (int i = tid; i < 384 * KS * 4; i += NTHR) { const int n = i / (KS * 4), pc = i % (KS * 4); *(LAS lu4*)(sB + n * PITCH + pc * 8) = *(const lu4*)(Bt + (size_t)n * (KS * 32) + pc * 8); }
    if (MODE != 2) for (int i = tid; i < 384; i += NTHR) sbias[i] = bias[i];
    __syncthreads();
    bf16_t* Ob = (bf16_t*)(p.ws + (MODE == 0 ? U_LD + (size_t)d * SZ384 : (MODE == 1 ? U_AG + (size_t)d * SZ384 : U_G)));
    for (int rt = bi * 8 + wv; rt < 2304; rt += nb * 8) { const int row0 = rt * 16;
        const bf16_t* Ap = (const bf16_t*)(p.ws + U_ALR) + (size_t)(row0 + m) * 384 + kofs + q * 8;
        bf16x8 a[KS];
#pragma unroll
        for (int ks = 0; ks < KS; ++ks) a[ks] = *(const bf16x8*)(Ap + ks * 32);
        bf16_t* O = Ob + (size_t)(row0 + m) * 384;
#pragma unroll 4
        for (int nt = 0; nt < 24; ++nt) {
            f32x4 acc = (f32x4){0.f, 0.f, 0.f, 0.f};
#pragma unroll
            for (int ks = 0; ks < KS; ++ks) acc = mfma16(*(const LAS bf16x8*)(sB + (nt * 16 + m) * PITCH + ks * 32 + q * 8), a[ks], acc);
            const int n = nt * 16 + q * 4; float o[4];
            if (MODE == 2) {
#pragma unroll
                for (int j = 0; j < 4; ++j) o[j] = acc[j];
            } else { const lf4 bv = *(const LAS lf4*)(sbias + n); const float bb[4] = {bv.x, bv.y, bv.z, bv.w};
#pragma unroll
                for (int j = 0; j < 4; ++j) { const float sg = sigm(bb[j] + acc[j]); o[j] = MODE == 0 ? -0.6065306597f * sg : sg; } }
            u32x2 w; w.x = pack2(o[0], o[1]); w.y = pack2(o[2], o[3]); *(u32x2*)(O + n) = w;
        }
    }
    __syncthreads();
}
__device__ __forceinline__ void lowrank_items(const Params& p, int l, int wid, int nw, LAS unsigned char* lds) {
    const unsigned char* sw = p.ws + WS_SW + (size_t)l * SW_STRIDE; const int G = gridDim.x, bx = blockIdx.x;
    if (G >= 12) {
        const int sh = bx * 6 / G, mm = sh < 4 ? sh : 4; const int lo = (mm * G + 5) / 6, hi = mm < 4 ? ((mm + 1) * G + 5) / 6 : G, bi = bx - lo, nb = hi - lo;
        if (mm < 2) lr_block<2, 0>(p, l, (const bf16_t*)(sw + SW_W2T) + (size_t)mm * 384 * 64, mm * 64, mm, bi, nb, lds);
        else if (mm < 4) lr_block<2, 1>(p, l, (const bf16_t*)(sw + SW_A2T) + (size_t)(mm - 2) * 384 * 64, mm * 64, mm - 2, bi, nb, lds);
        else lr_block<4, 2>(p, l, (const bf16_t*)(sw + SW_G2T), 256, 0, bi, nb, lds);
        return; }
    for (int it = wid; it < 2304 * 5; it += nw) { const int rt = it / 5, m = it % 5, row0 = rt * 16;
        if (m < 2) lr_wave<2, 0>(p, l, row0, m * 64, (const bf16_t*)(sw + SW_W2T) + (size_t)m * 384 * 64, m);
        else if (m < 4) lr_wave<2, 1>(p, l, row0, m * 64, (const bf16_t*)(sw + SW_A2T) + (size_t)(m - 2) * 384 * 64, m - 2);
        else lr_wave<4, 2>(p, l, row0, 256, (const bf16_t*)(sw + SW_G2T), 0); }
}

__device__ __forceinline__ int s5_rowbase(int cr) { const int b = cr / 144, c = cr % 144; return c < 16 ? NLAT + b * 256 + c * 16 : b * 2048 + (c - 16) * 16; }
__device__ __forceinline__ void s5_pass1_items(const Params& p, int l, int wid, int nw) {
    const int lane = threadIdx.x & 63, m = lane & 15, q = lane >> 4;
    const bf16_t* P = (const bf16_t*)(p.ws + U_U16); float* SLOC = (float*)(p.ws + U_SLOC);
    for (int it = wid; it < 144 * 16; it += nw) { const int ct = it >> 4, g = it & 15, cr = ct * 16 + m, rb = s5_rowbase(cr);
        const bf16_t* E = (const bf16_t*)(p.ws + WS_SW + (size_t)l * SW_STRIDE + SW_S5E) + (size_t)g * 256 * 256;
        bf16x8 a[8];
#pragma unroll
        for (int ks = 0; ks < 8; ++ks) a[ks] = *(const bf16x8*)(P + (size_t)(rb + 2 * ks + (q >> 1)) * 256 + g * 16 + (q & 1) * 8);
        float* o = SLOC + ((size_t)cr * 16 + g) * 256 + q * 4;
#pragma unroll 2
        for (int nt = 0; nt < 16; ++nt) { f32x4 acc = (f32x4){0.f, 0.f, 0.f, 0.f}; const bf16_t* ep = E + (size_t)(nt * 16 + m) * 256 + q * 8;
#pragma unroll
            for (int ks = 0; ks < 8; ++ks) acc = mfma16(*(const bf16x8*)(ep + ks * 32), a[ks], acc);
            *(f32x4*)(o + nt * 16) = acc; }
    }
}
__device__ __forceinline__ void s5_pass1_block(const Params& p, int l, LAS unsigned char* lds) {
    constexpr int PITCH = 264;
    LAS bf16_t* sE = (LAS bf16_t*)lds;
    const int tid = threadIdx.x, lane = tid & 63, m = lane & 15, q = lane >> 4, wv = tid >> 6, G = gridDim.x, bx = blockIdx.x;
    const int combo = bx & 31, g = combo >> 1, half = combo & 1, bi = bx >> 5, nb = G >> 5;
    const bf16_t* E = (const bf16_t*)(p.ws + WS_SW + (size_t)l * SW_STRIDE + SW_S5E) + ((size_t)g * 256 + half * 128) * 256;
    const bf16_t* P = (const bf16_t*)(p.ws + U_U16); float* SLOC = (float*)(p.ws + U_SLOC);
    __syncthreads();
    for (int i = tid; i < 128 * 32; i += NTHR) { const int n = i >> 5, pc = i & 31; *(LAS lu4*)(sE + n * PITCH + pc * 8) = *(const lu4*)(E + (size_t)n * 256 + pc * 8); }
    __syncthreads();
    LAS unsigned char* eb = (LAS unsigned char*)(sE + m * PITCH + q * 8); asm volatile("" : "+v"(eb));
    for (int ct = bi * 8 + wv; ct < 144; ct += nb * 8) { const int cr = ct * 16 + m, rb = s5_rowbase(cr);
        bf16x8 a[8];
#pragma unroll
        for (int ks = 0; ks < 8; ++ks) a[ks] = *(const bf16x8*)(P + (size_t)(rb + 2 * ks + (q >> 1)) * 256 + g * 16 + (q & 1) * 8);
        float* o = SLOC + ((size_t)cr * 16 + g) * 256 + half * 128 + q * 4;
#pragma unroll 2
        for (int nt = 0; nt < 8; ++nt) { f32x4 acc = (f32x4){0.f, 0.f, 0.f, 0.f};
#pragma unroll
            for (int ks = 0; ks < 8; ++ks) acc = mfma16(*(const LAS bf16x8*)(eb + nt * 16 * PITCH * 2 + ks * 64), a[ks], acc);
            *(f32x4*)(o + nt * 16) = acc; } }
    __syncthreads();
}
__device__ __forceinline__ void s5_carry(const Params& p, int l) {
    const int gid = blockIdx.x * NTHR + threadIdx.x; if (gid >= 32768) return;
    const int pp = gid & 63, d = (gid >> 6) & 1, g = (gid >> 7) & 15, b = gid >> 11;
    const int li = ((l * 2 + d) * 16 + g) * 64 + pp; const float lr = p.in[9][li], lim = p.in[10][li], dt = expf(p.in[11][(l * 2 + d) * 16 + g]);
    const float mag = expf(16.0f * dt * lr); float sn, cn; sincosf(16.0f * dt * lim, &sn, &cn); const float ar = mag * cn, ai = mag * sn;
    const float* SLOC = (const float*)(p.ws + U_SLOC); bf16_t* SP = (bf16_t*)(p.ws + U_SPREV);
    float sr = 0.f, si = 0.f;
#pragma unroll 8
    for (int n = 0; n < 144; ++n) { const int c = d == 0 ? n : (n < 16 ? 15 - n : 159 - n); const size_t idx = ((size_t)(b * 144 + c) * 16 + g) * 256 + d * 128 + pp;
        SP[idx] = f2bf(sr); SP[idx + 64] = f2bf(si);
        const float xr = SLOC[idx], xi = SLOC[idx + 64]; const float nr = ar * sr - ai * si + xr, ni = ar * si + ai * sr + xi; sr = nr; si = ni; }
}
__device__ __forceinline__ void s5_pass2_items(const Params& p, int l, int wid, int nw) {
    const int lane = threadIdx.x & 63, m = lane & 15, q = lane >> 4;
    const bf16_t* P = (const bf16_t*)(p.ws + U_U16); const bf16_t* SP = (const bf16_t*)(p.ws + U_SPREV); bf16_t* YG = (bf16_t*)(p.ws + U_YG);
    for (int it = wid; it < 144 * 16; it += nw) { const int ct = it >> 4, g = it & 15; if (l == 1 && ct % 9 == 0) continue;
        const int cr = ct * 16 + m, rb = s5_rowbase(cr);
        const bf16_t* W2 = (const bf16_t*)(p.ws + WS_SW + (size_t)l * SW_STRIDE + SW_S5W2) + (size_t)g * 256 * 512;
        bf16x8 a[16];
#pragma unroll
        for (int ks = 0; ks < 8; ++ks) a[ks] = *(const bf16x8*)(P + (size_t)(rb + 2 * ks + (q >> 1)) * 256 + g * 16 + (q & 1) * 8);
#pragma unroll
        for (int ks = 8; ks < 16; ++ks) a[ks] = *(const bf16x8*)(SP + ((size_t)cr * 16 + g) * 256 + (ks - 8) * 32 + q * 8);
#pragma unroll 2
        for (int nt = 0; nt < 16; ++nt) { f32x4 acc = (f32x4){0.f, 0.f, 0.f, 0.f}; const bf16_t* wp = W2 + (size_t)(nt * 16 + m) * 512 + q * 8;
#pragma unroll
            for (int ks = 0; ks < 16; ++ks) acc = mfma16(*(const bf16x8*)(wp + ks * 32), a[ks], acc);
            float o[4];
#pragma unroll
            for (int j = 0; j < 4; ++j) { const float x = acc[j]; const float u = 0.7978845608f * (x + 0.044715f * x * x * x); const float th = 1.0f - 2.0f / (1.0f + __expf(2.0f * u)); o[j] = 0.5f * x * (1.0f + th); }
            u32x2 w; w.x = pack2(o[0], o[1]); w.y = pack2(o[2], o[3]); *(u32x2*)(YG + (size_t)(rb + nt) * 256 + g * 16 + q * 4) = w; }
    }
}
__device__ __forceinline__ void s5_pass2_block(const Params& p, int l, int vb, int nvb, LAS unsigned char* lds) {
    constexpr int PITCH = 520;
    LAS bf16_t* sW = (LAS bf16_t*)lds;
    const int tid = threadIdx.x, lane = tid & 63, m = lane & 15, q = lane >> 4, wv = tid >> 6;
    const bf16_t* P = (const bf16_t*)(p.ws + U_U16); const bf16_t* SP = (const bf16_t*)(p.ws + U_SPREV); bf16_t* YG = (bf16_t*)(p.ws + U_YG);
    if ((nvb & 63) != 0) { s5_pass2_items(p, l, vb * 8 + wv, nvb * 8); return; }
    { const int combo = vb & 63, g = combo >> 2, qd = combo & 3, bi = vb >> 6, nb = nvb >> 6;
        const bf16_t* W2 = (const bf16_t*)(p.ws + WS_SW + (size_t)l * SW_STRIDE + SW_S5W2) + ((size_t)g * 256 + qd * 64) * 512;
        __syncthreads();
        for (int i = tid; i < 64 * 64; i += NTHR) { const int n = i >> 6, pc = i & 63; *(LAS lu4*)(sW + n * PITCH + pc * 8) = *(const lu4*)(W2 + (size_t)n * 512 + pc * 8); }
        __syncthreads();
        LAS unsigned char* wb = (LAS unsigned char*)(sW + m * PITCH + q * 8); asm volatile("" : "+v"(wb));
        for (int ct = bi * 8 + wv; ct < 144; ct += nb * 8) { if (l == 1 && ct % 9 == 0) continue;
            const int cr = ct * 16 + m, rb = s5_rowbase(cr);
            bf16x8 a[16];
#pragma unroll
            for (int ks = 0; ks < 8; ++ks) a[ks] = *(const bf16x8*)(P + (size_t)(rb + 2 * ks + (q >> 1)) * 256 + g * 16 + (q & 1) * 8);
#pragma unroll
            for (int ks = 8; ks < 16; ++ks) a[ks] = *(const bf16x8*)(SP + ((size_t)cr * 16 + g) * 256 + (ks - 8) * 32 + q * 8);
#pragma unroll 1
            for (int nt = 0; nt < 4; ++nt) { f32x4 acc = (f32x4){0.f, 0.f, 0.f, 0.f};
#pragma unroll
                for (int ks = 0; ks < 16; ++ks) acc = mfma16(*(const LAS bf16x8*)(wb + nt * 16 * PITCH * 2 + ks * 64), a[ks], acc);
                float o[4];
#pragma unroll
                for (int j = 0; j < 4; ++j) { const float x = acc[j]; const float u = 0.7978845608f * (x + 0.044715f * x * x * x); const float th = 1.0f - 2.0f / (1.0f + __expf(2.0f * u)); o[j] = 0.5f * x * (1.0f + th); }
                u32x2 w; w.x = pack2(o[0], o[1]); w.y = pack2(o[2], o[3]); *(u32x2*)(YG + (size_t)(rb + qd * 4 + nt) * 256 + g * 16 + q * 4) = w; } }
    }
    __syncthreads();
}
__device__ __forceinline__ void s5_glu_items(const Params& p, int l, int wid, int nw) {
    const int lane = threadIdx.x & 63, m = lane & 15, q = lane >> 4;
    const bf16_t* YG = (const bf16_t*)(p.ws + U_YG); bf16_t* YC = (bf16_t*)(p.ws + WS_ABUF);
    const bf16_t* GT = (const bf16_t*)(p.ws + WS_SW + (size_t)l * SW_STRIDE + SW_GLUT);
    const int nrt = (l == 0 ? NROW : NLAT) / 16;
    for (int rt = wid; rt < nrt; rt += nw) { const int row = rt * 16 + m;
        bf16x8 a[8];
#pragma unroll
        for (int ks = 0; ks < 8; ++ks) a[ks] = *(const bf16x8*)(YG + (size_t)row * 256 + ks * 32 + q * 8);
#pragma unroll 2
        for (int nt = 0; nt < 16; ++nt) { f32x4 acc = (f32x4){0.f, 0.f, 0.f, 0.f}; const bf16_t* gp = GT + (size_t)(nt * 16 + m) * 256 + q * 8;
#pragma unroll
            for (int ks = 0; ks < 8; ++ks) acc = mfma16(*(const bf16x8*)(gp + ks * 32), a[ks], acc);
            const int n = nt * 16 + q * 4; const float4 bv = *(const float4*)(p.in[18] + l * 256 + n); const u32x2 yw = *(const u32x2*)(YG + (size_t)row * 256 + n);
            u32x2 w; w.x = pack2(bflo(yw.x) * sigm(acc[0] + bv.x), bfhi(yw.x) * sigm(acc[1] + bv.y)); w.y = pack2(bflo(yw.y) * sigm(acc[2] + bv.z), bfhi(yw.y) * sigm(acc[3] + bv.w));
            *(u32x2*)(YC + (size_t)row * 1024 + n) = w; }
    }
}

__device__ __forceinline__ void s5_glu_block(const Params& p, int l, int vb, int nvb, LAS unsigned char* lds) {
    constexpr int PITCH = 264;
    LAS bf16_t* sG = (LAS bf16_t*)lds;
    const int tid = threadIdx.x, lane = tid & 63, m = lane & 15, q = lane >> 4, wv = tid >> 6;
    if (nvb < 2 || (nvb & 1)) { s5_glu_items(p, l, vb * 8 + wv, nvb * 8); return; }
    const int half = vb & 1, bi = vb >> 1, nb = nvb >> 1;
    const bf16_t* YG = (const bf16_t*)(p.ws + U_YG); bf16_t* YC = (bf16_t*)(p.ws + WS_ABUF);
    const bf16_t* GT = (const bf16_t*)(p.ws + WS_SW + (size_t)l * SW_STRIDE + SW_GLUT) + (size_t)half * 128 * 256;
    __syncthreads();
    for (int i = tid; i < 128 * 32; i += NTHR) { const int n = i >> 5, pc = i & 31; *(LAS lu4*)(sG + n * PITCH + pc * 8) = *(const lu4*)(GT + (size_t)n * 256 + pc * 8); }
    __syncthreads();
    LAS unsigned char* gb = (LAS unsigned char*)(sG + m * PITCH + q * 8); asm volatile("" : "+v"(gb));
    const int nrt = (l == 0 ? NROW : NLAT) / 16;
    for (int rt = bi * 8 + wv; rt < nrt; rt += nb * 8) { const int row = rt * 16 + m;
        bf16x8 a[8];
#pragma unroll
        for (int ks = 0; ks < 8; ++ks) a[ks] = *(const bf16x8*)(YG + (size_t)row * 256 + ks * 32 + q * 8);
#pragma unroll 2
        for (int nt = 0; nt < 8; ++nt) { f32x4 acc = (f32x4){0.f, 0.f, 0.f, 0.f};
#pragma unroll
            for (int ks = 0; ks < 8; ++ks) acc = mfma16(*(const LAS bf16x8*)(gb + nt * 16 * PITCH * 2 + ks * 64), a[ks], acc);
            const int n = half * 128 + nt * 16 + q * 4; const float4 bv = *(const float4*)(p.in[18] + l * 256 + n); const u32x2 yw = *(const u32x2*)(YG + (size_t)row * 256 + n);
            u32x2 w; w.x = pack2(bflo(yw.x) * sigm(acc[0] + bv.x), bfhi(yw.x) * sigm(acc[1] + bv.y)); w.y = pack2(bflo(yw.y) * sigm(acc[2] + bv.z), bfhi(yw.y) * sigm(acc[3] + bv.w));
            *(u32x2*)(YC + (size_t)row * 1024 + n) = w; } }
    __syncthreads();
}

template <bool HASLAT> __device__ __forceinline__ void na_unit(const Params& p, const LAS float* rpb_l, int b, int h, int i, int n) {
    const int lane = threadIdx.x & 63, m = lane & 15, q = lane >> 4, kin = 8 * (m >> 2) + (m & 3);
    const bf16_t* QR = (const bf16_t*)(p.ws + U_QR); const bf16_t* KR = (const bf16_t*)(p.ws + U_KR);
    const bf16_t* VTL = (const bf16_t*)(p.ws + U_VT) + (size_t)(b * 6 + h) * 64 * 2048; const bf16_t* VTC = (const bf16_t*)(p.ws + U_VTC) + (size_t)(b * 6 + h) * 64 * 256;
    const int qrow = HASLAT ? b * 2048 + i * 64 + n * 16 + m : NLAT + b * 256 + n * 16 + m;
    bf16x8 qf[2];
#pragma unroll
    for (int ks = 0; ks < 2; ++ks) qf[ks] = *(const bf16x8*)(QR + (size_t)qrow * 384 + h * 64 + ks * 32 + q * 8);
    const int r0 = HASLAT ? min(max(i - 4, 0), 24) : 0, scol = HASLAT ? min(max(n * 16 - 8, 0), 32) : 0;
    f32x4 sl[HASLAT ? 16 : 1], sc[16];
    float mx = -3.0e38f;
    if (HASLAT) { const int qc = n * 16 + m, c0 = min(max(qc - 8, 0), 48); const LAS float* rpb = rpb_l + h * 15 * 31;
#pragma unroll
        for (int t = 0; t < 16; ++t) { const int kr = t >> 1, ch = t & 1; const bf16_t* kp = KR + (size_t)(b * 2048 + (r0 + kr) * 64 + scol + kin + 4 * ch) * 384 + h * 64 + q * 8;
            f32x4 acc = (f32x4){0.f, 0.f, 0.f, 0.f};
#pragma unroll
            for (int ks = 0; ks < 2; ++ks) acc = mfma16(*(const bf16x8*)(kp + ks * 32), qf[ks], acc);
            const int dr = r0 + kr - i + 7;
#pragma unroll
            for (int j = 0; j < 4; ++j) { const int kc = scol + 8 * q + 4 * ch + j; const bool valid = kc >= c0 && kc < c0 + 16; const int dc = min(max(kc - qc + 15, 0), 30);
                const float s = valid ? acc[j] + rpb[dr * 31 + dc] : -1.0e30f; acc[j] = s; mx = fmaxf(mx, s); }
            sl[t] = acc; if ((t & 7) == 7) __builtin_amdgcn_sched_barrier(0); } }
#pragma unroll
    for (int t = 0; t < 16; ++t) { const bf16_t* kp = KR + (size_t)(NLAT + b * 256 + (t >> 1) * 32 + kin + 4 * (t & 1)) * 384 + h * 64 + q * 8;
        f32x4 acc = (f32x4){0.f, 0.f, 0.f, 0.f};
#pragma unroll
        for (int ks = 0; ks < 2; ++ks) acc = mfma16(*(const bf16x8*)(kp + ks * 32), qf[ks], acc);
#pragma unroll
        for (int j = 0; j < 4; ++j) mx = fmaxf(mx, acc[j]);
        sc[t] = acc; }
    mx = fmaxf(mx, __shfl_xor(mx, 16)); mx = fmaxf(mx, __shfl_xor(mx, 32));
    float sum = 0.f;
    f32x4 o[4];
#pragma unroll
    for (int dt = 0; dt < 4; ++dt) o[dt] = (f32x4){0.f, 0.f, 0.f, 0.f};
    if (HASLAT) {
#pragma unroll
        for (int kr = 0; kr < 8; ++kr) { float e[8];
#pragma unroll
            for (int j = 0; j < 4; ++j) { e[j] = __expf(sl[2 * kr][j] - mx); e[4 + j] = __expf(sl[2 * kr + 1][j] - mx); }
#pragma unroll
            for (int j = 0; j < 8; ++j) sum += e[j];
            const uint4 pw = pack8(e); const bf16x8 pf = __builtin_bit_cast(bf16x8, pw);
            const int tok = (r0 + kr) * 64 + scol + q * 8;
#pragma unroll
            for (int dt = 0; dt < 4; ++dt) o[dt] = mfma16(*(const bf16x8*)(VTL + (size_t)(dt * 16 + m) * 2048 + tok), pf, o[dt]);
            if (kr & 1) __builtin_amdgcn_sched_barrier(0); } }
#pragma unroll
    for (int t2 = 0; t2 < 8; ++t2) { float e[8];
#pragma unroll
        for (int j = 0; j < 4; ++j) { e[j] = __expf(sc[2 * t2][j] - mx); e[4 + j] = __expf(sc[2 * t2 + 1][j] - mx); }
#pragma unroll
        for (int j = 0; j < 8; ++j) sum += e[j];
        const uint4 pw = pack8(e); const bf16x8 pf = __builtin_bit_cast(bf16x8, pw);
        const int tok = t2 * 32 + q * 8;
#pragma unroll
        for (int dt = 0; dt < 4; ++dt) o[dt] = mfma16(*(const bf16x8*)(VTC + (size_t)(dt * 16 + m) * 256 + tok), pf, o[dt]);
        if (t2 & 1) __builtin_amdgcn_sched_barrier(0); }
    sum += __shfl_xor(sum, 16); sum += __shfl_xor(sum, 32);
    const float inv = 1.0f / sum;
    bf16_t* yo = (bf16_t*)(p.ws + WS_ABUF) + (size_t)qrow * 1024 + 256 + h * 64 + q * 4;
#pragma unroll
    for (int dt = 0; dt < 4; ++dt) { u32x2 w; w.x = pack2(o[dt][0] * inv, o[dt][1] * inv); w.y = pack2(o[dt][2] * inv, o[dt][3] * inv); *(u32x2*)(yo + dt * 16) = w; }
}
template <bool HASLAT> __device__ __forceinline__ void na_block(const Params& p, int l, int b, int h, int sel, LAS unsigned char* lds) {
    LAS bf16_t* Ks = (LAS bf16_t*)lds;
    LAS bf16_t* Vs = (LAS bf16_t*)lds;
    LAS float* rp = (LAS float*)(lds + 120064);
    const int tid = threadIdx.x, lane = tid & 63, m = lane & 15, q = lane >> 4, w = tid >> 6, kin = 8 * (m >> 2) + (m & 3);
    const bf16_t* QR = (const bf16_t*)(p.ws + U_QR); const bf16_t* KR = (const bf16_t*)(p.ws + U_KR);
    const bf16_t* VTL = (const bf16_t*)(p.ws + U_VT) + (size_t)(b * 6 + h) * 64 * 2048; const bf16_t* VTC = (const bf16_t*)(p.ws + U_VTC) + (size_t)(b * 6 + h) * 64 * 256;
    const int i0 = HASLAT ? 2 * sel : 0, rlo = HASLAT ? min(max(i0 - 4, 0), 24) : 0;
    __syncthreads();
    int tk = threadIdx.x; asm volatile("" : "+v"(tk));
    if (HASLAT) {
#pragma unroll
        for (int j = 0; j < 9; ++j) { const int idx = tk + NTHR * j, key = idx >> 3, pc = idx & 7, tok = rlo * 64 + key;
            if (tok < 2048) *(LAS lu4*)(Ks + key * 72 + pc * 8) = *(const lu4*)(KR + (size_t)(b * 2048 + tok) * 384 + h * 64 + pc * 8); }
        for (int j = tk; j < 465; j += NTHR) rp[j] = p.in[19][(size_t)(l * 6 + h) * 465 + j]; }
#pragma unroll
    for (int j = 0; j < 4; ++j) { const int idx = tk + NTHR * j, key = idx >> 3, pc = idx & 7;
        *(LAS lu4*)(Ks + (576 + key) * 72 + pc * 8) = *(const lu4*)(KR + (size_t)(NLAT + b * 256 + key) * 384 + h * 64 + pc * 8); }
    const int i = HASLAT ? i0 + (w >> 2) : 0, n = HASLAT ? (w & 3) : sel * 8 + w;
    const int qrow = HASLAT ? b * 2048 + i * 64 + n * 16 + m : NLAT + b * 256 + n * 16 + m;
    bf16x8 qf[2];
#pragma unroll
    for (int ks = 0; ks < 2; ++ks) qf[ks] = *(const bf16x8*)(QR + (size_t)qrow * 384 + h * 64 + ks * 32 + q * 8);
    const int r0 = HASLAT ? min(max(i - 4, 0), 24) : 0, scol = HASLAT ? min(max(n * 16 - 8, 0), 32) : 0, kb = (r0 - rlo) * 64 + scol;
    LAS unsigned char* kbl = (LAS unsigned char*)(Ks + (kb + kin) * 72 + q * 8); LAS unsigned char* kbc = (LAS unsigned char*)(Ks + (576 + kin) * 72 + q * 8);
    LAS unsigned char* vb0 = (LAS unsigned char*)(Vs + (0 * 16 + m) * 840 + q * 8); LAS unsigned char* vb1 = (LAS unsigned char*)(Vs + (1 * 16 + m) * 840 + q * 8);
    LAS unsigned char* vb2 = (LAS unsigned char*)(Vs + (2 * 16 + m) * 840 + q * 8); LAS unsigned char* vb3 = (LAS unsigned char*)(Vs + (3 * 16 + m) * 840 + q * 8);
    asm volatile("" : "+v"(kbl), "+v"(kbc), "+v"(vb0), "+v"(vb1), "+v"(vb2), "+v"(vb3));
    __syncthreads();
    float mx1 = -3.0e38f, mx2 = -3.0e38f, sum1 = 0.f, sum2 = 0.f;
    bf16x8 pl[HASLAT ? 8 : 1], pcx[8];
    if (HASLAT) { const int qc = n * 16 + m, c0 = min(max(qc - 8, 0), 48); f32x4 sl[16];
#pragma unroll
        for (int t = 0; t < 16; ++t) { const int kr = t >> 1, ch = t & 1; const LAS bf16_t* kp = (const LAS bf16_t*)(kbl + (kr * 64 + 4 * ch) * 144);
            f32x4 acc = (f32x4){0.f, 0.f, 0.f, 0.f};
#pragma unroll
            for (int ks = 0; ks < 2; ++ks) acc = mfma16(*(const LAS bf16x8*)(kp + ks * 32), qf[ks], acc);
            const int dr = r0 + kr - i + 7;
#pragma unroll
            for (int j = 0; j < 4; ++j) { const int kc = scol + 8 * q + 4 * ch + j; const bool valid = kc >= c0 && kc < c0 + 16; const int dc = min(max(kc - qc + 15, 0), 30);
                const float sv = valid ? acc[j] + rp[dr * 31 + dc] : -1.0e30f; acc[j] = sv; mx1 = fmaxf(mx1, sv); }
            sl[t] = acc; if ((t & 3) == 3) __builtin_amdgcn_sched_barrier(0); }
        mx1 = fmaxf(mx1, __shfl_xor(mx1, 16)); mx1 = fmaxf(mx1, __shfl_xor(mx1, 32));
#pragma unroll
        for (int kr = 0; kr < 8; ++kr) { float e[8];
#pragma unroll
            for (int j = 0; j < 4; ++j) { e[j] = __expf(sl[2 * kr][j] - mx1); e[4 + j] = __expf(sl[2 * kr + 1][j] - mx1); }
#pragma unroll
            for (int j = 0; j < 8; ++j) sum1 += e[j];
            const uint4 pw = pack8(e); pl[kr] = __builtin_bit_cast(bf16x8, pw); }
        __builtin_amdgcn_sched_barrier(0); }
    { f32x4 sc[16];
#pragma unroll
      for (int t = 0; t < 16; ++t) { const LAS bf16_t* kp = (const LAS bf16_t*)(kbc + ((t >> 1) * 32 + 4 * (t & 1)) * 144);
          f32x4 acc = (f32x4){0.f, 0.f, 0.f, 0.f};
#pragma unroll
          for (int ks = 0; ks < 2; ++ks) acc = mfma16(*(const LAS bf16x8*)(kp + ks * 32), qf[ks], acc);
#pragma unroll
          for (int j = 0; j < 4; ++j) mx2 = fmaxf(mx2, acc[j]);
          sc[t] = acc; if ((t & 3) == 3) __builtin_amdgcn_sched_barrier(0); }
      mx2 = fmaxf(mx2, __shfl_xor(mx2, 16)); mx2 = fmaxf(mx2, __shfl_xor(mx2, 32));
#pragma unroll
      for (int t2 = 0; t2 < 8; ++t2) { float e[8];
#pragma unroll
          for (int j = 0; j < 4; ++j) { e[j] = __expf(sc[2 * t2][j] - mx2); e[4 + j] = __expf(sc[2 * t2 + 1][j] - mx2); }
#pragma unroll
          for (int j = 0; j < 8; ++j) sum2 += e[j];
          const uint4 pw = pack8(e); pcx[t2] = __builtin_bit_cast(bf16x8, pw); } }
    sum1 += __shfl_xor(sum1, 16); sum1 += __shfl_xor(sum1, 32); sum2 += __shfl_xor(sum2, 16); sum2 += __shfl_xor(sum2, 32);
    __builtin_amdgcn_sched_barrier(0);
    __syncthreads();
    int tv = threadIdx.x; asm volatile("" : "+v"(tv));
    if (HASLAT) {
#pragma unroll
        for (int j = 0; j < 9; ++j) { const int idx = tv + NTHR * j, dim = idx / 72, pc = idx % 72, tok = rlo * 64 + pc * 8;
            if (tok < 2048) *(LAS lu4*)(Vs + dim * 840 + pc * 8) = *(const lu4*)(VTL + (size_t)dim * 2048 + tok); } }
#pragma unroll
    for (int j = 0; j < 4; ++j) { const int idx = tv + NTHR * j, dim = idx >> 5, pc = idx & 31; *(LAS lu4*)(Vs + dim * 840 + 576 + pc * 8) = *(const lu4*)(VTC + (size_t)dim * 256 + pc * 8); }
    __syncthreads();
    const int kbv = kb * 2;
    f32x4 o1[4], o2[4];
#pragma unroll
    for (int dt = 0; dt < 4; ++dt) { o1[dt] = (f32x4){0.f, 0.f, 0.f, 0.f}; o2[dt] = (f32x4){0.f, 0.f, 0.f, 0.f}; }
    if (HASLAT) {
#pragma unroll
        for (int kr = 0; kr < 8; ++kr) {
#pragma unroll
            for (int dt = 0; dt < 4; ++dt) { LAS unsigned char* vb = dt == 0 ? vb0 : dt == 1 ? vb1 : dt == 2 ? vb2 : vb3; o1[dt] = mfma16(*(const LAS bf16x8*)(vb + kbv + kr * 128), pl[kr], o1[dt]); }
            if (kr & 1) __builtin_amdgcn_sched_barrier(0); } }
#pragma unroll
    for (int t2 = 0; t2 < 8; ++t2) {
#pragma unroll
        for (int dt = 0; dt < 4; ++dt) { LAS unsigned char* vb = dt == 0 ? vb0 : dt == 1 ? vb1 : dt == 2 ? vb2 : vb3; o2[dt] = mfma16(*(const LAS bf16x8*)(vb + 1152 + t2 * 64), pcx[t2], o2[dt]); }
        if (t2 & 1) __builtin_amdgcn_sched_barrier(0); }
    const float mxm = fmaxf(mx1, mx2), a1 = HASLAT ? __expf(mx1 - mxm) : 0.f, a2 = __expf(mx2 - mxm), inv = 1.0f / (a1 * sum1 + a2 * sum2), c1 = a1 * inv, c2 = a2 * inv;
    bf16_t* yo = (bf16_t*)(p.ws + WS_ABUF) + (size_t)qrow * 1024 + 256 + h * 64 + q * 4;
#pragma unroll
    for (int dt = 0; dt < 4; ++dt) { u32x2 wv2; wv2.x = pack2(o1[dt][0] * c1 + o2[dt][0] * c2, o1[dt][1] * c1 + o2[dt][1] * c2); wv2.y = pack2(o1[dt][2] * c1 + o2[dt][2] * c2, o1[dt][3] * c1 + o2[dt][3] * c2); *(u32x2*)(yo + dt * 16) = wv2; }
}
__device__ __forceinline__ void na_items(const Params& p, int l, int wid, int nw, LAS unsigned char* lds) {
    (void)wid; (void)nw;
    const int nlat = 16 * 6 * 16, nctx = (l == 0) ? 16 * 6 * 2 : 0;
    for (int it = blockIdx.x; it < nlat + nctx; it += gridDim.x) {
        if (it < nlat) { const int ip = it & 15, bh = it >> 4; na_block<true>(p, l, bh / 6, bh % 6, ip, lds); }
        else { const int j = it - nlat, half = j & 1, bh = j >> 1; na_block<false>(p, l, bh / 6, bh % 6, half, lds); }
    }
    __syncthreads();
}

typedef float f32x2 __attribute__((ext_vector_type(2)));
__device__ __forceinline__ int rk_row(int b, int d, int n) { return n < 256 ? NLAT + b * 256 + (d ? 255 - n : n) : b * 2048 + (d ? 2047 - (n - 256) : (n - 256)); }
template <int CTRL> __device__ __forceinline__ float dpp_f(float v) { return __builtin_bit_cast(float, __builtin_amdgcn_update_dpp(0, __builtin_bit_cast(int, v), CTRL, 0xF, 0xF, true)); }
constexpr int RKP_PITCH = 72, RKP_MAT = 16 * RKP_PITCH * 2, RKP_WAVE = 5 * RKP_MAT + 4 * 16 * 17 * 4;
__device__ __forceinline__ bf16x8 pack_frag(const float (&lo)[4], const float (&hi)[4]) { u32x4 w; w.x = pack2(lo[0], lo[1]); w.y = pack2(lo[2], lo[3]); w.z = pack2(hi[0], hi[1]); w.w = pack2(hi[2], hi[3]); return __builtin_bit_cast(bf16x8, w); }
__device__ __forceinline__ void rwkv_pre_items(const Params& p, int l, int wid, int nw, LAS unsigned char* lds) {
    const int lane = threadIdx.x & 63, m = lane & 15, q = lane >> 4, wv = threadIdx.x >> 6;
    LAS bf16_t* sAt = (LAS bf16_t*)(lds + wv * RKP_WAVE); LAS bf16_t* sBh = sAt + 16 * RKP_PITCH; LAS bf16_t* sKh = sBh + 16 * RKP_PITCH; LAS bf16_t* sRt = sKh + 16 * RKP_PITCH; LAS bf16_t* sV = sRt + 16 * RKP_PITCH;
    LAS float* sM = (LAS float*)(lds + wv * RKP_WAVE + 5 * RKP_MAT);
    const bf16_t* RS = (const bf16_t*)(p.ws + U_RS); const bf16_t* KS = (const bf16_t*)(p.ws + U_KS); const bf16_t* VS = (const bf16_t*)(p.ws + U_VS); const bf16_t* KK = (const bf16_t*)(p.ws + U_KK);
    for (int it = wid; it < NCHUNK; it += nw) { const int u = it / 144, c = it % 144, b = u / 12, h = (u % 12) >> 1, d = u & 1;
        const bf16_t* AG = (const bf16_t*)(p.ws + U_AG + (size_t)d * SZ384); const bf16_t* LD = (const bf16_t*)(p.ws + U_LD + (size_t)d * SZ384);
        const int rb = rk_row(b, d, c * 16), sgn = d ? -1 : 1;
#ifndef PRE_DUP
#define PRE_DUP 0
#endif
        for (int rp1 = 0; rp1 < (PRE_DUP == 1 ? 2 : 1); ++rp1) {
        { LAS bf16_t* sLd = (LAS bf16_t*)sM; lu4 raw[12];
#pragma unroll
          for (int k = 0; k < 12; ++k) { const int idx = lane + 64 * k, pair = idx >> 3, arr = pair >> 4, t = pair & 15, pc = idx & 7;
              const bf16_t* src = arr == 0 ? KK : arr == 1 ? AG : arr == 2 ? KS : arr == 3 ? RS : arr == 4 ? VS : LD;
              raw[k] = *(const lu4*)(src + (size_t)(rb + sgn * t) * 384 + h * 64 + pc * 8); }
          __builtin_amdgcn_sched_barrier(0);
#pragma unroll
          for (int k = 0; k < 12; ++k) { const int idx = lane + 64 * k, pair = idx >> 3, arr = pair >> 4, t = pair & 15, pc = idx & 7;
              LAS bf16_t* dst = arr == 0 ? sAt : arr == 1 ? sBh : arr == 2 ? sKh : arr == 3 ? sRt : arr == 4 ? sV : sLd;
              *(LAS lu4*)(dst + t * RKP_PITCH + pc * 8) = raw[k]; }
          const float ka = p.in[27][l * 384 + h * 64 + lane]; float L = 0.f;
#pragma unroll 4
          for (int t = 0; t < 16; ++t) { const int o = t * RKP_PITCH + lane;
              const float r_ = bf2f(sRt[o]), k_ = bf2f(sKh[o]), kk_ = bf2f(sAt[o]), ag_ = bf2f(sBh[o]), ld_ = bf2f(sLd[o]);
              const float e0 = __expf(L); L += ld_; const float e1 = __expf(L), ei = __expf(-L);
              sAt[o] = f2bf(-kk_ * e0); sBh[o] = f2bf(kk_ * ag_ * ei); sKh[o] = f2bf(k_ * (1.0f + (ag_ - 1.0f) * ka) * ei); sRt[o] = f2bf(r_ * e1); }
          ((bf16_t*)(p.ws + CH_GT))[(size_t)it * 64 + lane] = f2bf(L); }
        }
        for (int rp2 = 0; rp2 < (PRE_DUP == 2 ? 2 : 1); ++rp2) {
        { bf16x8 atf[2], rtf[2], bhf[2], khf[2];
#pragma unroll
          for (int ks = 0; ks < 2; ++ks) { atf[ks] = *(const LAS bf16x8*)(sAt + m * RKP_PITCH + ks * 32 + q * 8); rtf[ks] = *(const LAS bf16x8*)(sRt + m * RKP_PITCH + ks * 32 + q * 8);
              bhf[ks] = *(const LAS bf16x8*)(sBh + m * RKP_PITCH + ks * 32 + q * 8); khf[ks] = *(const LAS bf16x8*)(sKh + m * RKP_PITCH + ks * 32 + q * 8); }
          f32x4 mab = (f32x4){0.f, 0.f, 0.f, 0.f}, mak = mab, mrb = mab, mrk = mab;
#pragma unroll
          for (int ks = 0; ks < 2; ++ks) { mab = mfma16(atf[ks], bhf[ks], mab); mak = mfma16(atf[ks], khf[ks], mak); mrb = mfma16(rtf[ks], bhf[ks], mrb); mrk = mfma16(rtf[ks], khf[ks], mrk); }
#pragma unroll
          for (int r = 0; r < 4; ++r) { const int t = 4 * q + r; sM[(0 * 16 + t) * 17 + m] = m < t ? mab[r] : 0.f; sM[(1 * 16 + t) * 17 + m] = m < t ? mak[r] : 0.f;
              sM[(2 * 16 + t) * 17 + m] = m <= t ? mrb[r] : 0.f; sM[(3 * 16 + t) * 17 + m] = m <= t ? mrk[r] : 0.f; } }
        { float tv[16];
#pragma unroll
          for (int t = 0; t < 16; ++t) { float acc = (m == t) ? 1.0f : 0.0f;
#pragma unroll
              for (int s2 = 0; s2 < t; ++s2) acc += sM[t * 17 + s2] * tv[s2];
              tv[t] = acc; }
#pragma unroll
          for (int t = 0; t < 16; ++t) if (q == 0) sM[t * 17 + m] = tv[t]; }
        }
        bf16x8 tinvf, mrbf;
        { float lo[4], hi[4] = {0.f, 0.f, 0.f, 0.f};
#pragma unroll
          for (int j = 0; j < 4; ++j) lo[j] = sM[(0 * 16 + m) * 17 + 4 * q + j];
          tinvf = pack_frag(lo, hi);
#pragma unroll
          for (int j = 0; j < 4; ++j) lo[j] = sM[(2 * 16 + m) * 17 + 4 * q + j];
          mrbf = pack_frag(lo, hi);
#pragma unroll
          for (int j = 0; j < 4; ++j) hi[j] = sM[(3 * 16 + m) * 17 + 4 * q + j];
          *(bf16x8*)((bf16_t*)(p.ws + CH_MM) + ((size_t)it * 64 + lane) * 8) = pack_frag(lo, hi); }
        for (int rp3 = 0; rp3 < (PRE_DUP == 3 ? 2 : 1); ++rp3) {
        { bf16x8 makf; { float lo[4], hi[4];
#pragma unroll
            for (int j = 0; j < 4; ++j) { lo[j] = q < 2 ? sM[(1 * 16 + m) * 17 + 8 * q + j] : 0.f; hi[j] = q < 2 ? sM[(1 * 16 + m) * 17 + 8 * q + 4 + j] : 0.f; }
            makf = pack_frag(lo, hi); }
#pragma unroll
          for (int itile = 0; itile < 4; ++itile) { unsigned vw[4];
#pragma unroll
              for (int j = 0; j < 4; ++j) vw[j] = q < 2 ? ((unsigned)sV[(8 * q + 2 * j) * RKP_PITCH + 16 * itile + m] | ((unsigned)sV[(8 * q + 2 * j + 1) * RKP_PITCH + 16 * itile + m] << 16)) : 0u;
              const u32x4 vq = {vw[0], vw[1], vw[2], vw[3]};
              const f32x4 w1 = mfma16(makf, __builtin_bit_cast(bf16x8, vq), (f32x4){0.f, 0.f, 0.f, 0.f});
              const float lo[4] = {w1[0], w1[1], w1[2], w1[3]}, hi[4] = {0.f, 0.f, 0.f, 0.f};
              const f32x4 uu = mfma16(tinvf, pack_frag(lo, hi), (f32x4){0.f, 0.f, 0.f, 0.f});
              u32x2 o; o.x = pack2(uu[0], uu[1]); o.y = pack2(uu[2], uu[3]);
              *(u32x2*)((bf16_t*)(p.ws + CH_UL) + (((size_t)it * 4 + itile) * 64 + lane) * 4) = o; } }
        }
        f32x4 ap[4], rp[4];
        for (int rp4 = 0; rp4 < (PRE_DUP == 4 ? 2 : 1); ++rp4) {
#pragma unroll
        for (int jt = 0; jt < 4; ++jt) { float lo[4], hi[4] = {0.f, 0.f, 0.f, 0.f};
#pragma unroll
            for (int j = 0; j < 4; ++j) lo[j] = bf2f(sAt[(4 * q + j) * RKP_PITCH + 16 * jt + m]);
            ap[jt] = mfma16(tinvf, pack_frag(lo, hi), (f32x4){0.f, 0.f, 0.f, 0.f});
            const float al[4] = {ap[jt][0], ap[jt][1], ap[jt][2], ap[jt][3]};
            f32x4 rr = mfma16(mrbf, pack_frag(al, hi), (f32x4){0.f, 0.f, 0.f, 0.f});
#pragma unroll
            for (int r = 0; r < 4; ++r) rr[r] += bf2f(sRt[(4 * q + r) * RKP_PITCH + 16 * jt + m]);
            rp[jt] = rr;
            float bl[4], kl[4];
#pragma unroll
            for (int j = 0; j < 4; ++j) { bl[j] = bf2f(sBh[(4 * q + j) * RKP_PITCH + 16 * jt + m]); kl[j] = bf2f(sKh[(4 * q + j) * RKP_PITCH + 16 * jt + m]); }
            *(bf16x8*)((bf16_t*)(p.ws + CH_BK) + (((size_t)it * 4 + jt) * 64 + lane) * 8) = pack_frag(bl, kl); }
        }
        for (int rp5 = 0; rp5 < (PRE_DUP == 5 ? 2 : 1); ++rp5) {
#pragma unroll
        for (int jt = 0; jt < 4; ++jt)
#pragma unroll
            for (int r = 0; r < 4; ++r) { sAt[(4 * q + r) * RKP_PITCH + 16 * jt + m] = f2bf(ap[jt][r]); sRt[(4 * q + r) * RKP_PITCH + 16 * jt + m] = f2bf(rp[jt][r]); }
#pragma unroll
        for (int x = 0; x < 2; ++x)
#pragma unroll
            for (int ks = 0; ks < 2; ++ks) { const LAS bf16_t* src = (x ? sRt : sAt) + m * RKP_PITCH + 32 * ks + 4 * q;
                const u32x2 a0 = *(const LAS u32x2*)src, a1 = *(const LAS u32x2*)(src + 16); const u32x4 w = {a0.x, a0.y, a1.x, a1.y};
                *(u32x4*)((bf16_t*)(p.ws + CH_XP) + ((((size_t)it * 2 + x) * 2 + ks) * 64 + lane) * 8) = w; }
        }
    }
}
__device__ __forceinline__ void rwkv_seq_task(const Params& p, int l, int task, LAS unsigned char* lds) {
    const int lane = threadIdx.x & 63, m = lane & 15, q = lane >> 4;
    const int u = task >> 2, iw = task & 3, b = u / 12, h = (u % 12) >> 1, d = u & 1, sgn = d ? -1 : 1;
    const bf16_t* XP = (const bf16_t*)(p.ws + CH_XP); const bf16_t* BK = (const bf16_t*)(p.ws + CH_BK); const bf16_t* UL = (const bf16_t*)(p.ws + CH_UL); const bf16_t* MM = (const bf16_t*)(p.ws + CH_MM);
    const bf16_t* GT = (const bf16_t*)(p.ws + CH_GT); const bf16_t* VS = (const bf16_t*)(p.ws + U_VS) + h * 64 + 16 * iw;
    float* Yw = (float*)(p.ws + U_YRK) + (size_t)d * NROW * 384 + h * 64 + 16 * iw;
    LAS float* ybuf = (LAS float*)(lds + (threadIdx.x >> 6) * 12288);
    const int rc0 = NLAT + b * 256 + (d ? 255 : 0) + sgn * 4 * q, rdel = (b * 2048 + (d ? 2047 : 0)) - (NLAT + b * 256 + (d ? 255 : 0)) - sgn * 256;
    f32x4 acc[4];
#pragma unroll
    for (int jt = 0; jt < 4; ++jt) acc[jt] = (f32x4){0.f, 0.f, 0.f, 0.f};
    const unsigned vo16 = (unsigned)lane * 16u, vo8 = (unsigned)lane * 8u, vo8q = (unsigned)q * 8u;
    struct OpSet { u32x4 apf0, apf1, rpf0, rpf1, bkf0, bkf1, bkf2, bkf3, mmf; u32x2 gl0, gl1, gl2, gl3, uw; unsigned vr0, vr1, vr2, vr3; };
#define GLDS16(dst, voff, sbase, imm) asm volatile("global_load_dwordx4 %0, %1, %2 offset:" #imm : "=&v"(dst) : "v"(voff), "s"(sbase) : "memory")
#define GLDS8(dst, voff, sbase, imm) asm volatile("global_load_dwordx2 %0, %1, %2 offset:" #imm : "=&v"(dst) : "v"(voff), "s"(sbase) : "memory")
#define GLDS2(dst, voff, sbase) asm volatile("global_load_ushort %0, %1, %2" : "=&v"(dst) : "v"(voff), "s"(sbase) : "memory")
#define RKS_LOAD(X, c_) do { const size_t it_ = (size_t)u * 144 + (c_); const int rb_ = rc0 + sgn * 16 * (c_) + (int)((c_) >= 16) * rdel; \
        const bf16_t* xpb = XP + it_ * 2048; const bf16_t* bkb = BK + it_ * 2048; const bf16_t* mmb = MM + it_ * 512; const bf16_t* gtb = GT + it_ * 64; const bf16_t* ulb = UL + (it_ * 4 + iw) * 256; \
        GLDS16(X.apf0, vo16, xpb, 0); GLDS16(X.apf1, vo16, xpb, 1024); GLDS16(X.rpf0, vo16, xpb, 2048); GLDS16(X.rpf1, vo16, xpb, 3072); \
        GLDS16(X.bkf0, vo16, bkb, 0); GLDS16(X.bkf1, vo16, bkb, 1024); GLDS16(X.bkf2, vo16, bkb, 2048); GLDS16(X.bkf3, vo16, bkb, 3072); \
        GLDS8(X.gl0, vo8q, gtb, 0); GLDS8(X.gl1, vo8q, gtb, 32); GLDS8(X.gl2, vo8q, gtb, 64); GLDS8(X.gl3, vo8q, gtb, 96); \
        GLDS16(X.mmf, vo16, mmb, 0); GLDS8(X.uw, vo8, ulb, 0); \
        { const unsigned v0_ = (unsigned)(rb_) * 768u + 2u * m, v1_ = (unsigned)(rb_ + sgn) * 768u + 2u * m, v2_ = (unsigned)(rb_ + 2 * sgn) * 768u + 2u * m, v3_ = (unsigned)(rb_ + 3 * sgn) * 768u + 2u * m; \
          GLDS2(X.vr0, v0_, VS); GLDS2(X.vr1, v1_, VS); GLDS2(X.vr2, v2_, VS); GLDS2(X.vr3, v3_, VS); } } while (0)
#define RKS_WAIT(X) asm volatile("s_waitcnt vmcnt(36)" : "+v"(X.apf0), "+v"(X.apf1), "+v"(X.rpf0), "+v"(X.rpf1), "+v"(X.bkf0), "+v"(X.bkf1), "+v"(X.bkf2), "+v"(X.bkf3), "+v"(X.mmf), \
        "+v"(X.gl0), "+v"(X.gl1), "+v"(X.gl2), "+v"(X.gl3), "+v"(X.uw), "+v"(X.vr0), "+v"(X.vr1), "+v"(X.vr2), "+v"(X.vr3) :: "memory")
#define BF8(x) __builtin_bit_cast(bf16x8, x)
#define RKS_COMPUTE(X, c_) do { RKS_WAIT(X); \
        const float ul[4] = {bflo(X.uw.x), bfhi(X.uw.x), bflo(X.uw.y), bfhi(X.uw.y)}; const float vl[4] = {bflo(X.vr0), bflo(X.vr1), bflo(X.vr2), bflo(X.vr3)}; \
        f32x4 zp = (f32x4){0.f, 0.f, 0.f, 0.f}, yp = zp; \
        { const float lo[4] = {acc[0][0], acc[0][1], acc[0][2], acc[0][3]}, hi[4] = {acc[1][0], acc[1][1], acc[1][2], acc[1][3]}; const bf16x8 sf = pack_frag(lo, hi); zp = mfma16(BF8(X.apf0), sf, zp); yp = mfma16(BF8(X.rpf0), sf, yp); } \
        { const float lo[4] = {acc[2][0], acc[2][1], acc[2][2], acc[2][3]}, hi[4] = {acc[3][0], acc[3][1], acc[3][2], acc[3][3]}; const bf16x8 sf = pack_frag(lo, hi); zp = mfma16(BF8(X.apf1), sf, zp); yp = mfma16(BF8(X.rpf1), sf, yp); } \
        const float z[4] = {zp[0] + ul[0], zp[1] + ul[1], zp[2] + ul[2], zp[3] + ul[3]}; \
        yp = mfma16(BF8(X.mmf), pack_frag(ul, vl), yp); \
        const bf16x8 zvf = pack_frag(z, vl); \
        acc[0] = mfma16(BF8(X.bkf0), zvf, acc[0]); acc[1] = mfma16(BF8(X.bkf1), zvf, acc[1]); acc[2] = mfma16(BF8(X.bkf2), zvf, acc[2]); acc[3] = mfma16(BF8(X.bkf3), zvf, acc[3]); \
        { const f32x4 g4 = {__expf(bflo(X.gl0.x)), __expf(bfhi(X.gl0.x)), __expf(bflo(X.gl0.y)), __expf(bfhi(X.gl0.y))}; acc[0] *= g4; } \
        { const f32x4 g4 = {__expf(bflo(X.gl1.x)), __expf(bfhi(X.gl1.x)), __expf(bflo(X.gl1.y)), __expf(bfhi(X.gl1.y))}; acc[1] *= g4; } \
        { const f32x4 g4 = {__expf(bflo(X.gl2.x)), __expf(bfhi(X.gl2.x)), __expf(bflo(X.gl2.y)), __expf(bfhi(X.gl2.y))}; acc[2] *= g4; } \
        { const f32x4 g4 = {__expf(bflo(X.gl3.x)), __expf(bfhi(X.gl3.x)), __expf(bflo(X.gl3.y)), __expf(bfhi(X.gl3.y))}; acc[3] *= g4; } \
        _Pragma("unroll") for (int r = 0; r < 4; ++r) ybuf[((((c_) % 12) * 16) + 4 * q + r) * 16 + m] = yp[r]; } while (0)
    asm volatile("; SEQ_BEGIN");
    OpSet A, B, C;
    RKS_LOAD(A, 0); RKS_LOAD(B, 1);
    for (int c0 = 0; c0 < 144; c0 += 12) {
#pragma unroll
        for (int cc = 0; cc < 12; cc += 3) { const int c = c0 + cc;
            RKS_LOAD(C, c + 2); __builtin_amdgcn_sched_barrier(0);
            RKS_COMPUTE(A, c); __builtin_amdgcn_sched_barrier(0);
            { const int cn = c + 3 < 144 ? c + 3 : 143; RKS_LOAD(A, cn); } __builtin_amdgcn_sched_barrier(0);
            RKS_COMPUTE(B, c + 1); __builtin_amdgcn_sched_barrier(0);
            { const int cn = c + 4 < 144 ? c + 4 : 143; RKS_LOAD(B, cn); } __builtin_amdgcn_sched_barrier(0);
            RKS_COMPUTE(C, c + 2); __builtin_amdgcn_sched_barrier(0); }
#pragma unroll
        for (int k = 0; k < 12; ++k) { const int rr = (lane >> 2) + 16 * k, n = c0 * 16 + rr; const int grow = (rc0 - sgn * 4 * q) + sgn * n + (int)(n >= 256) * rdel;
            *(f32x4*)(Yw + (size_t)grow * 384 + (lane & 3) * 4) = *(const LAS f32x4*)(ybuf + rr * 16 + (lane & 3) * 4); }
    }
    asm volatile("; SEQ_END");
#undef RKS_LOAD
#undef RKS_COMPUTE
#undef RKS_WAIT
#undef GLDS16
#undef GLDS8
#undef GLDS2
#undef BF8
}

__device__ __forceinline__ void rwkv_seq_block(const Params& p, int l, int u, LAS unsigned char* lds) {
    (void)l;
    const int tid = threadIdx.x, lane = tid & 63, wv = __builtin_amdgcn_readfirstlane(tid >> 6), m = lane & 15, q = lane >> 4;
    const int b = u / 12, h = (u % 12) >> 1, d = u & 1, sgn = d ? -1 : 1;
    const unsigned char* XPb = p.ws + CH_XP + (size_t)u * 144 * 4096; const unsigned char* BKb = p.ws + CH_BK + (size_t)u * 144 * 4096;
    const unsigned char* MMb = p.ws + CH_MM + (size_t)u * 144 * 1024; const unsigned char* GTb = p.ws + CH_GT + (size_t)u * 144 * 128;
    LAS unsigned char* ring = lds + 49152;
#define SEQ_BAR() asm volatile("s_waitcnt lgkmcnt(0)\n\ts_barrier" ::: "memory")
    __syncthreads();
    if (wv >= 4) {
        const int lw = wv - 4; const bool hasmm = lw == 0, hasgt = (lw == 1) && lane < 8;
        lu4 xp[3], bk[3], mm[3], gt[3];
#define LDR_LOAD(k, c_) do { const int cc_ = (c_) < 144 ? (c_) : 143; xp[k] = *(const lu4*)(XPb + (size_t)cc_ * 4096 + lw * 1024 + lane * 16); bk[k] = *(const lu4*)(BKb + (size_t)cc_ * 4096 + lw * 1024 + lane * 16); \
            if (hasmm) mm[k] = *(const lu4*)(MMb + (size_t)cc_ * 1024 + lane * 16); if (hasgt) gt[k] = *(const lu4*)(GTb + (size_t)cc_ * 128 + lane * 16); } while (0)
#define LDR_STORE(k, c_) do { if ((c_) < 144) { LAS unsigned char* sl_ = ring + ((c_) % 3) * 9728; *(LAS lu4*)(sl_ + lw * 1024 + lane * 16) = xp[k]; *(LAS lu4*)(sl_ + 4096 + lw * 1024 + lane * 16) = bk[k]; \
            if (hasmm) *(LAS lu4*)(sl_ + 8192 + lane * 16) = mm[k]; if (hasgt) *(LAS lu4*)(sl_ + 9216 + lane * 16) = gt[k]; } } while (0)
        LDR_LOAD(0, 0); LDR_LOAD(1, 1); LDR_LOAD(2, 2);
        LDR_STORE(0, 0); LDR_LOAD(0, 3); LDR_STORE(1, 1); LDR_LOAD(1, 4);
        SEQ_BAR();
        for (int i0 = 0; i0 < 144; i0 += 3) {
            LDR_STORE(2, i0 + 2); LDR_LOAD(2, i0 + 5); SEQ_BAR();
            LDR_STORE(0, i0 + 3); LDR_LOAD(0, i0 + 6); SEQ_BAR();
            LDR_STORE(1, i0 + 4); LDR_LOAD(1, i0 + 7); SEQ_BAR(); }
#undef LDR_LOAD
#undef LDR_STORE
    } else {
        const int iw = wv;
        const bf16_t* UL = (const bf16_t*)(p.ws + CH_UL) + (size_t)u * 144 * 1024; const bf16_t* VS = (const bf16_t*)(p.ws + U_VS) + h * 64 + 16 * iw;
        float* Yw = (float*)(p.ws + U_YRK) + (size_t)d * NROW * 384 + h * 64 + 16 * iw;
        LAS float* ybuf = (LAS float*)(lds + wv * 12288);
        const int rc0 = NLAT + b * 256 + (d ? 255 : 0) + sgn * 4 * q, rdel = (b * 2048 + (d ? 2047 : 0)) - (NLAT + b * 256 + (d ? 255 : 0)) - sgn * 256;
        const unsigned vo8 = (unsigned)lane * 8u;
        f32x4 acc[4];
#pragma unroll
        for (int jt = 0; jt < 4; ++jt) acc[jt] = (f32x4){0.f, 0.f, 0.f, 0.f};
        struct Shared { bf16x8 apf0, apf1, rpf0, rpf1, bkf0, bkf1, bkf2, bkf3, mmf; u32x2 gl0, gl1, gl2, gl3; };
        struct Own { u32x2 uw; unsigned vr0, vr1, vr2, vr3; };
#define GLDS8(dst, voff, sbase) asm volatile("global_load_dwordx2 %0, %1, %2" : "=&v"(dst) : "v"(voff), "s"(sbase) : "memory")
#define GLDS2(dst, voff, sbase) asm volatile("global_load_ushort %0, %1, %2" : "=&v"(dst) : "v"(voff), "s"(sbase) : "memory")
#define OWN_LOAD(X, c_) do { const int cc_ = (c_) < 144 ? (c_) : 143; const int rb_ = rc0 + sgn * 16 * cc_ + (int)(cc_ >= 16) * rdel; const bf16_t* ulb = UL + ((size_t)cc_ * 4 + iw) * 256; \
            GLDS8(X.uw, vo8, ulb); const unsigned v0_ = (unsigned)(rb_) * 768u + 2u * m, v1_ = (unsigned)(rb_ + sgn) * 768u + 2u * m, v2_ = (unsigned)(rb_ + 2 * sgn) * 768u + 2u * m, v3_ = (unsigned)(rb_ + 3 * sgn) * 768u + 2u * m; \
            GLDS2(X.vr0, v0_, VS); GLDS2(X.vr1, v1_, VS); GLDS2(X.vr2, v2_, VS); GLDS2(X.vr3, v3_, VS); } while (0)
#define OWN_WAIT(X) asm volatile("s_waitcnt vmcnt(10)" : "+v"(X.uw), "+v"(X.vr0), "+v"(X.vr1), "+v"(X.vr2), "+v"(X.vr3) :: "memory")
#define SH_READ(S, c_) do { const int cc_ = (c_) < 144 ? (c_) : 143; const LAS unsigned char* sl_ = ring + (cc_ % 3) * 9728 + lane * 16; \
            S.apf0 = *(const LAS bf16x8*)(sl_); S.apf1 = *(const LAS bf16x8*)(sl_ + 1024); S.rpf0 = *(const LAS bf16x8*)(sl_ + 2048); S.rpf1 = *(const LAS bf16x8*)(sl_ + 3072); \
            S.bkf0 = *(const LAS bf16x8*)(sl_ + 4096); S.bkf1 = *(const LAS bf16x8*)(sl_ + 5120); S.bkf2 = *(const LAS bf16x8*)(sl_ + 6144); S.bkf3 = *(const LAS bf16x8*)(sl_ + 7168); S.mmf = *(const LAS bf16x8*)(sl_ + 8192); \
            const LAS unsigned char* gp_ = ring + (cc_ % 3) * 9728 + 9216 + q * 8; S.gl0 = *(const LAS u32x2*)(gp_); S.gl1 = *(const LAS u32x2*)(gp_ + 32); S.gl2 = *(const LAS u32x2*)(gp_ + 64); S.gl3 = *(const LAS u32x2*)(gp_ + 96); } while (0)
#define SEQ_COMPUTE(S, X, c_) do { OWN_WAIT(X); \
            const float ul[4] = {bflo(X.uw.x), bfhi(X.uw.x), bflo(X.uw.y), bfhi(X.uw.y)}; const float vl[4] = {bflo(X.vr0), bflo(X.vr1), bflo(X.vr2), bflo(X.vr3)}; \
            f32x4 zp = (f32x4){0.f, 0.f, 0.f, 0.f}, yp = zp; \
            { const float lo[4] = {acc[0][0], acc[0][1], acc[0][2], acc[0][3]}, hi[4] = {acc[1][0], acc[1][1], acc[1][2], acc[1][3]}; const bf16x8 sf = pack_frag(lo, hi); zp = mfma16(S.apf0, sf, zp); yp = mfma16(S.rpf0, sf, yp); } \
            { const float lo[4] = {acc[2][0], acc[2][1], acc[2][2], acc[2][3]}, hi[4] = {acc[3][0], acc[3][1], acc[3][2], acc[3][3]}; const bf16x8 sf = pack_frag(lo, hi); zp = mfma16(S.apf1, sf, zp); yp = mfma16(S.rpf1, sf, yp); } \
            const float z[4] = {zp[0] + ul[0], zp[1] + ul[1], zp[2] + ul[2], zp[3] + ul[3]}; \
            yp = mfma16(S.mmf, pack_frag(ul, vl), yp); \
            const bf16x8 zvf = pack_frag(z, vl); \
            acc[0] = mfma16(S.bkf0, zvf, acc[0]); acc[1] = mfma16(S.bkf1, zvf, acc[1]); acc[2] = mfma16(S.bkf2, zvf, acc[2]); acc[3] = mfma16(S.bkf3, zvf, acc[3]); \
            { const f32x4 g4 = {__expf(bflo(S.gl0.x)), __expf(bfhi(S.gl0.x)), __expf(bflo(S.gl0.y)), __expf(bfhi(S.gl0.y))}; acc[0] *= g4; } \
            { const f32x4 g4 = {__expf(bflo(S.gl1.x)), __expf(bfhi(S.gl1.x)), __expf(bflo(S.gl1.y)), __expf(bfhi(S.gl1.y))}; acc[1] *= g4; } \
            { const f32x4 g4 = {__expf(bflo(S.gl2.x)), __expf(bfhi(S.gl2.x)), __expf(bflo(S.gl2.y)), __expf(bfhi(S.gl2.y))}; acc[2] *= g4; } \
            { const f32x4 g4 = {__expf(bflo(S.gl3.x)), __expf(bfhi(S.gl3.x)), __expf(bflo(S.gl3.y)), __expf(bfhi(S.gl3.y))}; acc[3] *= g4; } \
            _Pragma("unroll") for (int r = 0; r < 4; ++r) ybuf[((((c_) % 12) * 16) + 4 * q + r) * 16 + m] = yp[r]; } while (0)
#define SEQ_STEP(SC, SN, XC, XN2, c_) do { SH_READ(SN, (c_) + 1); OWN_LOAD(XN2, (c_) + 2); __builtin_amdgcn_sched_barrier(0); SEQ_COMPUTE(SC, XC, c_); __builtin_amdgcn_sched_barrier(0); SEQ_BAR(); } while (0)
        Shared S0, S1; Own A, B, C;
        OWN_LOAD(A, 0); OWN_LOAD(B, 1);
        SEQ_BAR();
        SH_READ(S0, 0);
        for (int c0 = 0; c0 < 144; c0 += 12) {
#pragma unroll
            for (int cc = 0; cc < 12; cc += 6) { const int c = c0 + cc;
                SEQ_STEP(S0, S1, A, C, c); SEQ_STEP(S1, S0, B, A, c + 1); SEQ_STEP(S0, S1, C, B, c + 2);
                SEQ_STEP(S1, S0, A, C, c + 3); SEQ_STEP(S0, S1, B, A, c + 4); SEQ_STEP(S1, S0, C, B, c + 5); }
#pragma unroll
            for (int k = 0; k < 12; ++k) { const int rr = (lane >> 2) + 16 * k, n = c0 * 16 + rr; const int grow = (rc0 - sgn * 4 * q) + sgn * n + (int)(n >= 256) * rdel;
                *(f32x4*)(Yw + (size_t)grow * 384 + (lane & 3) * 4) = *(const LAS f32x4*)(ybuf + rr * 16 + (lane & 3) * 4); }
        }
#undef GLDS8
#undef GLDS2
#undef OWN_LOAD
#undef OWN_WAIT
#undef SH_READ
#undef SEQ_COMPUTE
#undef SEQ_STEP
    }
#undef SEQ_BAR
    __syncthreads();
}

__device__ __forceinline__ void rwkv_finish(const Params& p, int l) {
    const int sub = threadIdx.x & 7; const int npair = (l == 0 ? NROW : NLAT) * 6;
    const bf16_t* RS = (const bf16_t*)(p.ws + U_RS); const bf16_t* KS = (const bf16_t*)(p.ws + U_KS); const bf16_t* VS = (const bf16_t*)(p.ws + U_VS);
    const bf16_t* AG0 = (const bf16_t*)(p.ws + U_AG); const bf16_t* AG1 = (const bf16_t*)(p.ws + U_AG + SZ384); const bf16_t* G = (const bf16_t*)(p.ws + U_G);
    const float* Y0 = (const float*)(p.ws + U_YRK); const float* Y1 = Y0 + (size_t)NROW * 384; bf16_t* YC = (bf16_t*)(p.ws + WS_ABUF);
    for (int pr = (blockIdx.x * NTHR + threadIdx.x) >> 3; pr < npair; pr += (gridDim.x * NTHR) >> 3) { const int row = pr / 6, h = pr % 6, col = h * 64 + sub * 8; const size_t o = (size_t)row * 384 + col;
        float y[8]; { const float4 a0 = *(const float4*)(Y0 + o), a1 = *(const float4*)(Y0 + o + 4), c0 = *(const float4*)(Y1 + o), c1 = *(const float4*)(Y1 + o + 4);
            y[0] = a0.x + c0.x; y[1] = a0.y + c0.y; y[2] = a0.z + c0.z; y[3] = a0.w + c0.w; y[4] = a1.x + c1.x; y[5] = a1.y + c1.y; y[6] = a1.z + c1.z; y[7] = a1.w + c1.w; }
        float s = 0.f;
#pragma unroll
        for (int k = 0; k < 8; ++k) s += y[k];
        s += __shfl_xor(s, 1); s += __shfl_xor(s, 2); s += __shfl_xor(s, 4); const float mean = s * (1.0f / 64.0f);
        float v2 = 0.f;
#pragma unroll
        for (int k = 0; k < 8; ++k) { const float dd = y[k] - mean; v2 += dd * dd; }
        v2 += __shfl_xor(v2, 1); v2 += __shfl_xor(v2, 2); v2 += __shfl_xor(v2, 4); const float rstd = rsqrtf(v2 * (1.0f / 64.0f) + 64e-5f);
        float r[8], kx[8], vx[8], a0[8], a1[8], gx[8];
        unpack8(*(const uint4*)(RS + o), r); unpack8(*(const uint4*)(KS + o), kx); unpack8(*(const uint4*)(VS + o), vx); unpack8(*(const uint4*)(AG0 + o), a0); unpack8(*(const uint4*)(AG1 + o), a1); unpack8(*(const uint4*)(G + o), gx);
        const float* ka = p.in[27] + l * 384 + col; const float* rk = p.in[28] + l * 384 + col; const float* lw = p.in[29] + l * 384 + col; const float* lb = p.in[30] + l * 384 + col;
        float bs = 0.f;
#pragma unroll
        for (int k = 0; k < 8; ++k) { const float kd0 = kx[k] * (1.0f + (a0[k] - 1.0f) * ka[k]), kd1 = kx[k] * (1.0f + (a1[k] - 1.0f) * ka[k]); bs += r[k] * (kd0 + kd1) * rk[k]; }
        bs += __shfl_xor(bs, 1); bs += __shfl_xor(bs, 2); bs += __shfl_xor(bs, 4);
        float ov[8];
#pragma unroll
        for (int k = 0; k < 8; ++k) ov[k] = ((y[k] - mean) * rstd * lw[k] + lb[k] + bs * vx[k]) * gx[k];
        *(uint4*)(YC + (size_t)row * 1024 + 640 + col) = pack8(ov);
    }
}

__device__ __forceinline__ void phase_normrouter(const Params& p, int l, const float* xl, const float* xc, LAS unsigned char* lds) {
    LAS float* hrow = (LAS float*)lds;
    LAS float* part = (LAS float*)(lds + 32768);
    const int lane = threadIdx.x & 63, wv = threadIdx.x >> 6, e = lane & 15, cq = lane >> 4; const int ngrp = (l == 0 ? NROW : NLAT) / 8;
    const float* mod = (const float*)(p.ws + WS_MOD) + (size_t)l * 17 * 6144; const float* g1 = p.in[6] + (l * 4 + 1) * 1024; const float* g2 = p.in[6] + (l * 4 + 2) * 1024;
    const bf16_t* Y = (const bf16_t*)(p.ws + U_Y); unsigned char* A8 = p.ws + WS_ABUF; float* AFF = (float*)(p.ws + WS_AFF);
    float wr[32];
#pragma unroll
    for (int j = 0; j < 32; ++j) wr[j] = p.in[31][((size_t)l * 1024 + 128 * wv + 32 * cq + j) * 16 + e];
    for (int gi = blockIdx.x; gi < ngrp; gi += gridDim.x) { const int r = gi * 8 + wv; const int b = r < NLAT ? (r >> 11) : 16; const float* mb = mod + (size_t)b * 6144;
        const float* xs = xrow(xl, xc, r); float* xd = xrow_w(p.out, (float*)(p.ws + WS_CTXA), r);
        float4 y[4], x[4]; float ss = 0.f;
#pragma unroll
        for (int i = 0; i < 4; ++i) { { const u32x2 yw = *(const u32x2*)(Y + (size_t)r * 1024 + i * 256 + lane * 4); y[i] = make_float4(bflo(yw.x), bfhi(yw.x), bflo(yw.y), bfhi(yw.y)); } x[i] = *(const float4*)(xs + i * 256 + lane * 4); ss += y[i].x * y[i].x + y[i].y * y[i].y + y[i].z * y[i].z + y[i].w * y[i].w; }
        ss = wave_sum(ss); const float rs = rsqrtf(ss * (1.0f / 1024.0f) + 1e-6f);
        float s2 = 0.f;
#pragma unroll
        for (int i = 0; i < 4; ++i) { const int c = i * 256 + lane * 4; const float4 gg = *(const float4*)(g1 + c), gt = *(const float4*)(mb + 2048 + c);
            x[i].x += gt.x * (y[i].x * rs * gg.x); x[i].y += gt.y * (y[i].y * rs * gg.y); x[i].z += gt.z * (y[i].z * rs * gg.z); x[i].w += gt.w * (y[i].w * rs * gg.w);
            *(float4*)(xd + c) = x[i]; s2 += x[i].x * x[i].x + x[i].y * x[i].y + x[i].z * x[i].z + x[i].w * x[i].w; }
        s2 = wave_sum(s2); const float rs2 = rsqrtf(s2 * (1.0f / 1024.0f) + 1e-6f);
        float hv[4][4]; float amax = 0.f;
        __syncthreads();
#pragma unroll
        for (int i = 0; i < 4; ++i) { const int c = i * 256 + lane * 4; const float4 gg = *(const float4*)(g2 + c), sh = *(const float4*)(mb + 3072 + c), sc = *(const float4*)(mb + 4096 + c);
            hv[i][0] = x[i].x * rs2 * gg.x * (1.f + sc.x) + sh.x; hv[i][1] = x[i].y * rs2 * gg.y * (1.f + sc.y) + sh.y; hv[i][2] = x[i].z * rs2 * gg.z * (1.f + sc.z) + sh.z; hv[i][3] = x[i].w * rs2 * gg.w * (1.f + sc.w) + sh.w;
            *(LAS lf4*)(hrow + wv * 1024 + c) = (lf4){hv[i][0], hv[i][1], hv[i][2], hv[i][3]};
            amax = fmaxf(amax, fmaxf(fmaxf(fabsf(hv[i][0]), fabsf(hv[i][1])), fmaxf(fabsf(hv[i][2]), fabsf(hv[i][3])))); }
#pragma unroll
        for (int o = 32; o >= 1; o >>= 1) amax = fmaxf(amax, __shfl_xor(amax, o));
        amax = fmaxf(amax, 1e-20f); const float qs = 127.0f / amax;
        if (lane == 0) ((float*)(p.ws + WS_SX))[r] = amax * (1.0f / 127.0f);
#pragma unroll
        for (int i = 0; i < 4; ++i) { unsigned w = 0u;
#pragma unroll
            for (int k = 0; k < 4; ++k) w |= ((unsigned)__float2int_rn(hv[i][k] * qs) & 255u) << (8 * k);
            *(unsigned*)(A8 + (size_t)r * 1024 + i * 256 + lane * 4) = w; }
        __syncthreads();
#pragma unroll 2
        for (int rr = 0; rr < 8; ++rr) { const LAS float* hp = hrow + rr * 1024 + 128 * wv + 32 * cq; float acc = 0.f;
#pragma unroll
            for (int j4 = 0; j4 < 8; ++j4) { const lf4 h4 = *(const LAS lf4*)(hp + 4 * j4); acc += h4.x * wr[4 * j4] + h4.y * wr[4 * j4 + 1] + h4.z * wr[4 * j4 + 2] + h4.w * wr[4 * j4 + 3]; }
            acc += __shfl_xor(acc, 16); acc += __shfl_xor(acc, 32);
            if (cq == 0) part[(rr * 8 + wv) * 16 + e] = acc; }
        __syncthreads();
        if (lane < 16) { float lgt = 0.f;
#pragma unroll
            for (int w = 0; w < 8; ++w) lgt += part[(wv * 8 + w) * 16 + lane];
            float mxl = lgt;
#pragma unroll
            for (int o = 8; o >= 1; o >>= 1) mxl = fmaxf(mxl, __shfl_xor(mxl, o));
            const float ex = expf(lgt - mxl); float den = ex;
#pragma unroll
            for (int o = 8; o >= 1; o >>= 1) den += __shfl_xor(den, o);
            AFF[(size_t)r * 16 + lane] = ex / den; }
    }
}

__device__ __forceinline__ void phase_topk(const Params& p, int l, LAS unsigned char* lds) {
    LAS unsigned* keys = (LAS unsigned*)lds;
    LAS int* toks = (LAS int*)(lds + 8192);
    LAS unsigned* hist = (LAS unsigned*)(lds + 9216);
    LAS unsigned* wtot = (LAS unsigned*)(lds + 10240);
    LAS unsigned* sel = (LAS unsigned*)(lds + 10304);
    const int tid = threadIdx.x, lane = tid & 63, wv = tid >> 6, nitem = l == 0 ? 512 : 256;
    const float* AFF = (const float*)(p.ws + WS_AFF); int* SLOT = (int*)(p.ws + WS_SLOT); float* SELG = (float*)(p.ws + WS_SELG);
    const bf16_t* A = (const bf16_t*)(p.ws + WS_ABUF); bf16_t* XS = (bf16_t*)(p.ws + U_XSEL);
    for (int it = blockIdx.x; it < nitem; it += gridDim.x) { const bool lat = it < 256; const int be = it & 255, b = be >> 4, e = be & 15;
        const int n = lat ? SEQ : CTXL, cap = lat ? 256 : 32, rowbase = lat ? b * 2048 : NLAT + b * 256, xoff = lat ? b * 256 : 4096 + b * 32;
        const int per = n / NTHR > 0 ? n / NTHR : 1;
        const int t0 = tid * per; const bool act = t0 < n;
        unsigned kx[4];
        __syncthreads();
#pragma unroll
        for (int j = 0; j < 4; ++j) { kx[j] = 0u; if (act && j < per) { kx[j] = __float_as_uint(AFF[(size_t)(rowbase + t0 + j) * 16 + e]); keys[t0 + j] = kx[j]; } }
        unsigned prefix = 0u; int krem = cap;
        for (int pass = 0; pass < 4; ++pass) { const int shift = 24 - 8 * pass;
            if (tid < 256) hist[tid] = 0u;
            __syncthreads();
#pragma unroll
            for (int j = 0; j < 4; ++j) if (act && j < per) { const bool match = pass == 0 || (kx[j] >> (shift + 8)) == (prefix >> (shift + 8)); if (match) atomicAdd((unsigned*)&hist[(kx[j] >> shift) & 255u], 1u); }
            __syncthreads();
            if (tid < 256) { unsigned above = 0u; for (int bb = tid + 1; bb < 256; ++bb) above += hist[bb]; const unsigned mine = hist[tid];
                if (above < (unsigned)krem && above + mine >= (unsigned)krem) { sel[0] = (unsigned)tid; sel[1] = (unsigned)krem - above; } }
            __syncthreads();
            prefix |= sel[0] << shift; krem = (int)sel[1];
            __syncthreads();
        }
        unsigned loc = 0u, pre[4];
#pragma unroll
        for (int j = 0; j < 4; ++j) { pre[j] = loc; if (act && j < per) loc += (kx[j] > prefix ? 1u : 0u) + (kx[j] == prefix ? 65536u : 0u); }
        unsigned inc = loc;
#pragma unroll
        for (int o = 1; o < 64; o <<= 1) { const unsigned t = __shfl_up(inc, o); if (lane >= o) inc += t; }
        if (lane == 63) wtot[wv] = inc;
        __syncthreads();
        unsigned base = inc - loc;
        for (int w = 0; w < wv; ++w) base += wtot[w];
#pragma unroll
        for (int j = 0; j < 4; ++j) if (act && j < per) { const unsigned c = base + pre[j]; const int gtb = (int)(c & 0xffffu), eqb = (int)(c >> 16);
            const bool s = kx[j] > prefix || (kx[j] == prefix && eqb < krem); const int slot = gtb + (eqb < krem ? eqb : krem);
            if (s) { SELG[e * XROWS + xoff + slot] = __uint_as_float(kx[j]); toks[slot] = t0 + j; }
            SLOT[(size_t)(rowbase + t0 + j) * 16 + e] = s ? slot : -1; }
        __syncthreads();
        for (int s = wv; s < cap; s += 8) { const int row = rowbase + toks[s]; const lu4* src = (const lu4*)((const unsigned char*)A + (size_t)row * 1024); lu4* dst = (lu4*)((unsigned char*)XS + ((size_t)e * XROWS + xoff + s) * 1024);
            dst[lane] = src[lane]; if (lane == 0) ((float*)(p.ws + WS_SXS))[e * XROWS + xoff + s] = ((const float*)(p.ws + WS_SX))[row]; }
    }
}

struct GroupedOrder { int nMl, nNl, G, c, total;
    __device__ void init(int nMl_, int nNl_, int, int G_, int c_) { nMl = nMl_; nNl = nNl_; G = G_; c = c_; total = 16 * nMl_ * nNl_; }
    __device__ bool next(int i, pg8::Unit& u) const {
        int L;
        if ((G & 7) == 0 && (total & 7) == 0) { const int W = G >> 3, x = c & 7, r = c >> 3, t8 = total >> 3, k = i * W + r; if (k >= t8) return false; L = x * t8 + k; }
        else { const long LL = (long)i * G + c; if (LL >= total) return false; L = (int)LL; }
        const int per = nMl * nNl, e = L / per; int idx = L % per;
        const int mg = idx / (8 * nNl) < nMl / 8 ? idx / (8 * nNl) : nMl / 8, gm = (mg + 1) * 8 <= nMl ? 8 : nMl - mg * 8; idx -= mg * 8 * nNl;
        const int ng = idx / (gm * 4) < nNl / 4 ? idx / (gm * 4) : nNl / 4, gn = (ng + 1) * 4 <= nNl ? 4 : nNl - ng * 4; idx -= ng * gm * 4;
        u.pm = e * 18 + mg * 8 + idx / gn; u.pn = e * nNl + ng * 4 + idx % gn; return true; }
    __device__ __forceinline__ void a_ready(const pg8::Unit&) const {}
    __device__ __forceinline__ void done(const pg8::Unit&) const {}
};
struct EpiSwiGLU { static constexpr bool PERM = true, AFTER_DRAIN = false; unsigned char* H; const float* sx; const float* sw;
    __device__ __forceinline__ void operator()(const f32x4 (&acc)[2][2][4][2], const pg8::Unit& u, int wr, int wc, int fr, int fq) const {
        typedef int i32x4_ __attribute__((ext_vector_type(4)));
        const int e = u.pn / 22, pnl = u.pn - e * 22; const int row0 = u.pm * 256 + wr * 64 + fr, col0 = pnl * 128 + wc * 32 + 8 * fq;
        const float* swp = sw + (size_t)u.pn * 256 + wc * 32 + 8 * fq; const float4 g0 = *(const float4*)swp, g1 = *(const float4*)(swp + 4), u0 = *(const float4*)(swp + 128), u1 = *(const float4*)(swp + 132);
        const float swg[8] = {g0.x, g0.y, g0.z, g0.w, g1.x, g1.y, g1.z, g1.w}, swu[8] = {u0.x, u0.y, u0.z, u0.w, u1.x, u1.y, u1.z, u1.w};
#pragma unroll
        for (int ai = 0; ai < 2; ++ai)
#pragma unroll
            for (int m = 0; m < 4; ++m) { const int r = row0 + ai * 128 + m * 16; const float sr = sx[r]; unsigned char* rowp = H + (size_t)r * DE + col0; float o[8];
#pragma unroll
                for (int n = 0; n < 2; ++n) { const i32x4_ ig = __builtin_bit_cast(i32x4_, acc[ai][0][m][n]), iu = __builtin_bit_cast(i32x4_, acc[ai][1][m][n]);
#pragma unroll
                    for (int j = 0; j < 4; ++j) { const float g = (float)ig[j] * (sr * swg[n * 4 + j]), uu = (float)iu[j] * (sr * swu[n * 4 + j]); o[n * 4 + j] = g * sigm(g) * uu; } }
                u32x2 w8; { int t0 = 0, t1 = 0; t0 = __builtin_amdgcn_cvt_pk_fp8_f32(o[0], o[1], t0, false); t0 = __builtin_amdgcn_cvt_pk_fp8_f32(o[2], o[3], t0, true); t1 = __builtin_amdgcn_cvt_pk_fp8_f32(o[4], o[5], t1, false); t1 = __builtin_amdgcn_cvt_pk_fp8_f32(o[6], o[7], t1, true); w8.x = (unsigned)t0; w8.y = (unsigned)t1; }
                *(u32x2*)rowp = w8; }
    }
};
struct EpiScaleBf16 { static constexpr bool PERM = true, AFTER_DRAIN = false; bf16_t* O; int ldc; const float* sx; const float* sw;
    __device__ __forceinline__ void operator()(const f32x4 (&acc)[2][2][4][2], const pg8::Unit& u, int wr, int wc, int fr, int fq) const {
        typedef int i32x4_ __attribute__((ext_vector_type(4)));
        const int row0 = u.pm * 256 + wr * 64 + fr, col0 = u.pn * 256 + wc * 32 + 8 * fq;
        float swv[2][8];
#pragma unroll
        for (int bj = 0; bj < 2; ++bj) { const float4 a = *(const float4*)(sw + col0 + bj * 128), b = *(const float4*)(sw + col0 + bj * 128 + 4); swv[bj][0] = a.x; swv[bj][1] = a.y; swv[bj][2] = a.z; swv[bj][3] = a.w; swv[bj][4] = b.x; swv[bj][5] = b.y; swv[bj][6] = b.z; swv[bj][7] = b.w; }
#pragma unroll
        for (int ai = 0; ai < 2; ++ai)
#pragma unroll
            for (int m = 0; m < 4; ++m) { const int r = row0 + ai * 128 + m * 16; const float sr = sx[r]; bf16_t* rowp = O + (size_t)r * ldc + col0;
#pragma unroll
                for (int bj = 0; bj < 2; ++bj) { float o[8];
#pragma unroll
                    for (int n = 0; n < 2; ++n) { const i32x4_ iv = __builtin_bit_cast(i32x4_, acc[ai][bj][m][n]);
#pragma unroll
                        for (int j = 0; j < 4; ++j) o[n * 4 + j] = (float)iv[j] * (sr * swv[bj][n * 4 + j]); }
                    *(uint4*)(rowp + bj * 128) = pack8(o); } }
    }
};
struct EpiGate { static constexpr bool PERM = true, AFTER_DRAIN = false; bf16_t* O; const float* gate; const float* sw;
    __device__ __forceinline__ void operator()(const f32x4 (&acc)[2][2][4][2], const pg8::Unit& u, int wr, int wc, int fr, int fq) const {
        pg8::fp8_acc_settle();
        const int pnl = u.pn & 3; const int row0 = u.pm * 256 + wr * 64 + fr, col0 = pnl * 256 + wc * 32 + 8 * fq;
#pragma unroll
        for (int bj = 0; bj < 2; ++bj) { const float* sp = sw + (size_t)u.pn * 256 + wc * 32 + 8 * fq + bj * 128; const float4 sa = *(const float4*)sp, sb = *(const float4*)(sp + 4);
#pragma unroll
            for (int ai = 0; ai < 2; ++ai)
#pragma unroll
                for (int m = 0; m < 4; ++m) { const int r = row0 + ai * 128 + m * 16; const float gt = gate[r]; const f32x4 v0 = acc[ai][bj][m][0], v1 = acc[ai][bj][m][1];
                    u32x4 w; w.x = pack2(v0[0] * (gt * sa.x), v0[1] * (gt * sa.y)); w.y = pack2(v0[2] * (gt * sa.z), v0[3] * (gt * sa.w)); w.z = pack2(v1[0] * (gt * sb.x), v1[1] * (gt * sb.y)); w.w = pack2(v1[2] * (gt * sb.z), v1[3] * (gt * sb.w));
                    *(u32x4*)(O + (size_t)r * 1024 + col0 + bj * 128) = w; } }
    }
};

__device__ __forceinline__ void phase_combine(const Params& p, int l) {
    const int lane = threadIdx.x & 63, wv = threadIdx.x >> 6; const int nrow = l == 0 ? NROW : NLAT;
    const float* mod = (const float*)(p.ws + WS_MOD) + (size_t)l * 17 * 6144; const float* g3 = p.in[6] + (l * 4 + 3) * 1024;
    const int* SLOT = (const int*)(p.ws + WS_SLOT); const bf16_t* YE = (const bf16_t*)(p.ws + U_YEXP); bf16_t* A = (bf16_t*)(p.ws + WS_ABUF);
    const int rstep = gridDim.x * 8; int r = blockIdx.x * 8 + wv;
    int nslot = (r < nrow && lane < 16) ? SLOT[(size_t)r * 16 + lane] : -1; float4 nx1[4];
    if (r < nrow) { const float* x1p = xrow(p.out, (const float*)(p.ws + WS_CTXA), r);
#pragma unroll
        for (int i = 0; i < 4; ++i) nx1[i] = *(const float4*)(x1p + i * 256 + lane * 4); }
    for (; r < nrow; r += rstep) { const bool lat = r < NLAT; const int b = lat ? (r >> 11) : ((r - NLAT) >> 8), mbi = lat ? b : 16, xoff = lat ? b * 256 : 4096 + b * 32;
        const float* mb = mod + (size_t)mbi * 6144;
        const int myslot = nslot; float4 xc[4];
#pragma unroll
        for (int i = 0; i < 4; ++i) xc[i] = nx1[i];
        float f[16];
#pragma unroll
        for (int k = 0; k < 16; ++k) f[k] = 0.f;
        unsigned long long mask = __ballot(myslot >= 0);
        while (mask) { int ee[4], sl4[4]; u32x2 w[4][4];
#pragma unroll
            for (int k = 0; k < 4; ++k) { if (mask) { ee[k] = __builtin_ctzll(mask); mask &= mask - 1; sl4[k] = __shfl(myslot, ee[k]); } else { ee[k] = -1; sl4[k] = 0; } }
#pragma unroll
            for (int k = 0; k < 4; ++k) if (ee[k] >= 0) { const bf16_t* yr = YE + ((size_t)ee[k] * XROWS + xoff + sl4[k]) * 1024 + lane * 4;
#pragma unroll
                for (int i = 0; i < 4; ++i) w[k][i] = *(const u32x2*)(yr + i * 256); }
#pragma unroll
            for (int k = 0; k < 4; ++k) if (ee[k] >= 0) {
#pragma unroll
                for (int i = 0; i < 4; ++i) { f[i * 4] += bflo(w[k][i].x); f[i * 4 + 1] += bfhi(w[k][i].x); f[i * 4 + 2] += bflo(w[k][i].y); f[i * 4 + 3] += bfhi(w[k][i].y); } } }
        { const int rn = r + rstep; nslot = (rn < nrow && lane < 16) ? SLOT[(size_t)rn * 16 + lane] : -1;
          if (rn < nrow) { const float* x1p = xrow(p.out, (const float*)(p.ws + WS_CTXA), rn);
#pragma unroll
              for (int i = 0; i < 4; ++i) nx1[i] = *(const float4*)(x1p + i * 256 + lane * 4); } }
        float ss = 0.f;
#pragma unroll
        for (int k = 0; k < 16; ++k) ss += f[k] * f[k];
        ss = wave_sum(ss); const float rs = rsqrtf(ss * (1.0f / 1024.0f) + 1e-6f);
        float* x2 = l == 0 ? xrow_w((float*)(p.ws + WS_XB), (float*)(p.ws + WS_CTXB), r) : p.out + (size_t)r * D;
        float4 xv[4];
#pragma unroll
        for (int i = 0; i < 4; ++i) { const int c = i * 256 + lane * 4; const float4 gg = *(const float4*)(g3 + c), gt = *(const float4*)(mb + 5120 + c); float4 x = xc[i];
            x.x += gt.x * (f[i * 4] * rs * gg.x); x.y += gt.y * (f[i * 4 + 1] * rs * gg.y); x.z += gt.z * (f[i * 4 + 2] * rs * gg.z); x.w += gt.w * (f[i * 4 + 3] * rs * gg.w);
            *(float4*)(x2 + c) = x; xv[i] = x; }
        if (l == 0) { const float* mb1 = mod + (size_t)17 * 6144 + (size_t)mbi * 6144; hnorm_row(p.in[6] + 4 * 1024, mb1, mb1 + 1024, p.ws + WS_ABUF + (size_t)r * 1024, (float*)(p.ws + WS_SH) + r, lane, xv); }
    }
}


#ifndef MK_ONLY
#define MK_ONLY -1
#endif
#define EN(k) (MK_ONLY < 0 || MK_ONLY == (k))
#ifndef MK_DUP
#define MK_DUP 0
#endif
#define NREP(k) ((((MK_DUP) >> (k)) & 1) ? 2 : 1)
constexpr int PH_PER_LAYER = 14, N_PHASES = 1 + 2 * PH_PER_LAYER;
#define IN(k) (lo <= (k) && (k) < hi)
#define SEAM(k) do { if (p.use_bar && IN(k) && IN((k) + 1)) xcd_barrier(bar); } while (0)
template <int l> __device__ __forceinline__ void layer_phases(const Params& p, LAS unsigned char* lds, const XcdBarrier& bar, const int lo, const int hi) {
    const int wv = __builtin_amdgcn_readfirstlane(threadIdx.x >> 6), G = gridDim.x; const int wid = blockIdx.x * 8 + wv, nw = G * 8;
        const int pb = 1 + l * PH_PER_LAYER;
        const float* xl = l == 0 ? p.in[0] : (const float*)(p.ws + WS_XB);
        const float* xc = l == 0 ? p.in[2] : (const float*)(p.ws + WS_CTXB);
        if (EN(0) && IN(pb + 0)) { { if (l == 0) phase_hnorm(p, 0, xl, xc); }
            if ((NREP(0)) == 2) { if (l == 0) phase_hnorm(p, 0, xl, xc); } }
        SEAM(pb + 0);
        if (EN(1) && IN(pb + 1)) { { pg8::Gemm g{(const bf16_t*)(p.ws + WS_ABUF), (const bf16_t*)(p.ws + WS_WIN), NROW, NINP, D / 2}; pg8::StaticOrder S; S.init(NROW, NINP, G, (int)blockIdx.x);
            EpiScaleBf16 E{(bf16_t*)(p.ws + U_P), NINP, (const float*)(p.ws + WS_SH), (const float*)(p.ws + WS_SWIN)}; pg8::gemm_phase<EpiScaleBf16, pg8::StaticOrder, false, 1>(lds, g, S, E, nullptr); }
            if ((NREP(1)) == 2) { pg8::Gemm g{(const bf16_t*)(p.ws + WS_ABUF), (const bf16_t*)(p.ws + WS_WIN), NROW, NINP, D / 2}; pg8::StaticOrder S; S.init(NROW, NINP, G, (int)blockIdx.x);
            EpiScaleBf16 E{(bf16_t*)(p.ws + U_P), NINP, (const float*)(p.ws + WS_SH), (const float*)(p.ws + WS_SWIN)}; pg8::gemm_phase<EpiScaleBf16, pg8::StaticOrder, false, 1>(lds, g, S, E, nullptr); } }
        SEAM(pb + 1);
        if (EN(2) && IN(pb + 2)) { phase_prep(p, l, lds);
            if ((NREP(2)) == 2) phase_prep(p, l, lds); }
        SEAM(pb + 2);
        if (EN(3) && IN(pb + 3)) { { lowrank_items(p, l, wid, nw, lds); if ((G & 31) == 0) s5_pass1_block(p, l, lds); else s5_pass1_items(p, l, wid, nw); }
            if ((NREP(3)) == 2) { lowrank_items(p, l, wid, nw, lds); if ((G & 31) == 0) s5_pass1_block(p, l, lds); else s5_pass1_items(p, l, wid, nw); } }
        SEAM(pb + 3);
        if (EN(4) && IN(pb + 4)) { { s5_carry(p, l); na_items(p, l, wid, nw, lds); }
            if ((NREP(4)) == 2) { s5_carry(p, l); na_items(p, l, wid, nw, lds); } }
        SEAM(pb + 4);
        if (EN(5) && IN(pb + 5)) { { s5_pass2_block(p, l, (int)blockIdx.x, G, lds); if (PRE_DUP == 6) s5_pass2_block(p, l, (int)blockIdx.x, G, lds); rwkv_pre_items(p, l, wid, nw, lds); if (PRE_DUP == 7) rwkv_pre_items(p, l, wid, nw, lds); }
            if ((NREP(5)) == 2) { s5_pass2_block(p, l, (int)blockIdx.x, G, lds); rwkv_pre_items(p, l, wid, nw, lds); } }
        SEAM(pb + 5);
        if (EN(6) && IN(pb + 6)) {
            if (G > 192) { const int bx = (int)blockIdx.x;
                if (bx < 192) rwkv_seq_block(p, l, bx, lds); else s5_glu_block(p, l, bx - 192, G - 192, lds);
                if ((NREP(6)) == 2) { if (bx < 192) rwkv_seq_block(p, l, bx, lds); else s5_glu_block(p, l, bx - 192, G - 192, lds); } }
            else { for (int task = wid; task < 768; task += nw) rwkv_seq_task(p, l, task, lds); s5_glu_items(p, l, wid, nw); } }
        SEAM(pb + 6);
        if (EN(7) && IN(pb + 7)) { rwkv_finish(p, l);
            if ((NREP(7)) == 2) rwkv_finish(p, l); }
        SEAM(pb + 7);
        if (EN(8) && IN(pb + 8)) { { const int M = l == 0 ? NROW : NLAT; pg8::Gemm g{(const bf16_t*)(p.ws + WS_ABUF), (const bf16_t*)(p.ws + WS_WOUT), M, D, D}; pg8::StaticOrder S; S.init(M, D, G, (int)blockIdx.x);
            pg8::EpiBf16<0> E{(bf16_t*)(p.ws + U_Y), D, nullptr, 0, 0}; pg8::gemm_phase<pg8::EpiBf16<0>, pg8::StaticOrder, false>(lds, g, S, E, nullptr); }
            if ((NREP(8)) == 2) { const int M = l == 0 ? NROW : NLAT; pg8::Gemm g{(const bf16_t*)(p.ws + WS_ABUF), (const bf16_t*)(p.ws + WS_WOUT), M, D, D}; pg8::StaticOrder S; S.init(M, D, G, (int)blockIdx.x);
            pg8::EpiBf16<0> E{(bf16_t*)(p.ws + U_Y), D, nullptr, 0, 0}; pg8::gemm_phase<pg8::EpiBf16<0>, pg8::StaticOrder, false>(lds, g, S, E, nullptr); } }
        SEAM(pb + 8);
        if (EN(9) && IN(pb + 9)) { phase_normrouter(p, l, xl, xc, lds);
            if ((NREP(9)) == 2) phase_normrouter(p, l, xl, xc, lds); }
        SEAM(pb + 9);
        if (EN(10) && IN(pb + 10)) { phase_topk(p, l, lds);
            if ((NREP(10)) == 2) phase_topk(p, l, lds); }
        SEAM(pb + 10);
        if (EN(11) && IN(pb + 11)) { { pg8::Gemm g{(const bf16_t*)(p.ws + U_XSEL), (const bf16_t*)(p.ws + WS_WGU), 16 * XROWS, 16 * 5632, D / 2}; GroupedOrder S; S.init(l == 0 ? 18 : 16, 22, 2, G, (int)blockIdx.x);
            EpiSwiGLU E{p.ws + U_HID, (const float*)(p.ws + WS_SXS), (const float*)(p.ws + WS_SW8)}; pg8::gemm_phase<EpiSwiGLU, GroupedOrder, false, 1>(lds, g, S, E, nullptr); }
            if ((NREP(11)) == 2) { pg8::Gemm g{(const bf16_t*)(p.ws + U_XSEL), (const bf16_t*)(p.ws + WS_WGU), 16 * XROWS, 16 * 5632, D / 2}; GroupedOrder S; S.init(l == 0 ? 18 : 16, 22, 2, G, (int)blockIdx.x);
            EpiSwiGLU E{p.ws + U_HID, (const float*)(p.ws + WS_SXS), (const float*)(p.ws + WS_SW8)}; pg8::gemm_phase<EpiSwiGLU, GroupedOrder, false, 1>(lds, g, S, E, nullptr); } }
        SEAM(pb + 11);
        if (EN(12) && IN(pb + 12)) { { pg8::Gemm g{(const bf16_t*)(p.ws + U_HID), (const bf16_t*)(p.ws + WS_WD), 16 * XROWS, 16 * 1024, DE / 2}; GroupedOrder S; S.init(l == 0 ? 18 : 16, 4, 4, G, (int)blockIdx.x);
            EpiGate E{(bf16_t*)(p.ws + U_YEXP), (const float*)(p.ws + WS_SELG), (const float*)(p.ws + WS_SWD)}; pg8::gemm_phase<EpiGate, GroupedOrder, false, 2>(lds, g, S, E, nullptr); }
            if ((NREP(12)) == 2) { pg8::Gemm g{(const bf16_t*)(p.ws + U_HID), (const bf16_t*)(p.ws + WS_WD), 16 * XROWS, 16 * 1024, DE / 2}; GroupedOrder S; S.init(l == 0 ? 18 : 16, 4, 4, G, (int)blockIdx.x);
            EpiGate E{(bf16_t*)(p.ws + U_YEXP), (const float*)(p.ws + WS_SELG), (const float*)(p.ws + WS_SWD)}; pg8::gemm_phase<EpiGate, GroupedOrder, false, 2>(lds, g, S, E, nullptr); } }
        SEAM(pb + 12);
        if (EN(13) && IN(pb + 13)) { { phase_combine(p, l); if (l == 0) convert_weights(p, 1, lds, (int)blockIdx.x, G); }
            if (((l == 0 ? NREP(13) : 1)) == 2) { phase_combine(p, l); if (l == 0) convert_weights(p, 1, lds, (int)blockIdx.x, G); } }
        SEAM(pb + 13);
}
__global__ void __launch_bounds__(NTHR, 2) fwd(Params p) {
    extern __shared__ __attribute__((aligned(16))) unsigned char lds_raw[];
    LAS unsigned char* lds = (LAS unsigned char*)lds_raw;
    const int tid = threadIdx.x;
    if (tid < 4) ((LAS unsigned*)(lds + LDS_MISC))[tid] = 0u;
    __syncthreads();
    XcdBarrier bar; bar.bar = (unsigned*)(p.ws + WS_CTL); bar.x = 0; bar.st = (volatile LAS unsigned*)(lds + LDS_MISC);
    if (p.use_bar) bar = xcd_barrier_post((unsigned*)(p.ws + WS_CTL), (volatile LAS unsigned*)(lds + LDS_MISC));
    if (p.use_bar && tid == 0) { unsigned* xr = (unsigned*)(p.ws + WS_CTL + 32768); ((LAS unsigned*)(lds + LDS_MISC))[2] = xb_xcc_id(); ((LAS unsigned*)(lds + LDS_MISC))[3] = atomicAdd(xr + 64 * xb_xcc_id(), 1u); }
    __syncthreads();
    const int lo = p.ph_lo, hi = p.ph_hi;

    if (EN(100) && IN(0)) { { phase_prologue(p, lds); }
        if ((NREP(14)) == 2) { phase_prologue(p, lds); } }
    SEAM(0);
    layer_phases<0>(p, lds, bar, lo, hi);
    layer_phases<1>(p, lds, bar, lo, hi);
#undef IN
#undef SEAM
}
}

#ifndef MK_ONE_LAUNCH
#define MK_ONE_LAUNCH 1
#endif
extern "C" void kernel_launch(void* const* d_in, const int* in_sizes, int n_in, void* d_out, int out_size, void* d_ws, size_t ws_size, hipStream_t stream) {
    static int grid = 0;
    if (grid == 0) {
        if (n_in != 35 || out_size != mk::NLAT * mk::D || ws_size < mk::WS_END) { fprintf(stderr, "kernel_launch: unexpected problem (n_in %d, out %d, ws %zu < %zu)\n", n_in, out_size, ws_size, (size_t)mk::WS_END); grid = -1; return; }
        int dev = 0, cus = 0, per_cu = 0;
        if (hipGetDevice(&dev) != hipSuccess || hipDeviceGetAttribute(&cus, hipDeviceAttributeMultiprocessorCount, dev) != hipSuccess) { grid = -1; return; }
        if (hipFuncSetAttribute((const void*)mk::fwd, hipFuncAttributeMaxDynamicSharedMemorySize, mk::LDS_BYTES) != hipSuccess) { fprintf(stderr, "kernel_launch: hipFuncSetAttribute failed\n"); grid = -1; return; }
        if (hipOccupancyMaxActiveBlocksPerMultiprocessor(&per_cu, (const void*)mk::fwd, mk::NTHR, mk::LDS_BYTES) != hipSuccess || per_cu < 1) { fprintf(stderr, "kernel_launch: occupancy query says %d\n", per_cu); per_cu = 1; }
        (void)hipGetLastError();
        grid = cus;
    }
    if (grid < 0) return;
    (void)in_sizes;
    if (hipMemsetAsync(d_ws, 0, 65536, stream) != hipSuccess) return;
    mk::Params a{};
    for (int i = 0; i < 35; ++i) a.in[i] = (const float*)d_in[i];
    a.out = (float*)d_out; a.ws = (unsigned char*)d_ws;
#if MK_ONE_LAUNCH
    a.ph_lo = 0; a.ph_hi = mk::N_PHASES; a.use_bar = 1;
    hipLaunchKernelGGL(mk::fwd, dim3(grid), dim3(mk::NTHR), mk::LDS_BYTES, stream, a);
#else
    for (int ph = 0; ph < mk::N_PHASES; ++ph) { a.ph_lo = ph; a.ph_hi = ph + 1; a.use_bar = 0; hipLaunchKernelGGL(mk::fwd, dim3(grid), dim3(mk::NTHR), mk::LDS_BYTES, stream, a); }
#endif
}
```

```cpp
#include <hip/hip_runtime.h>
#include <cstdio>
#include <cstdint>
#define PRE_DUP 0
namespace pg8 {
#define PG8_LAS __attribute__((address_space(3)))
typedef unsigned short bf16_t;
typedef short bf16x8 __attribute__((ext_vector_type(8)));
typedef float f32x4 __attribute__((ext_vector_type(4)));
typedef unsigned u32x4 __attribute__((ext_vector_type(4)));
constexpr int BM = 256, BK = 64, HALF = 128, HTB = HALF * BK * 2  , STAGE_BYTES = 8 * HTB, NXCD = 8, WGM = 8;

__host__ __device__ __forceinline__ int lds_byte(int r, int c) { const int st = (r >> 4) * 2 + (c >> 5), rr = r & 15, cc = c & 31, ob = rr * 64 + cc * 2; return st * 1024 + (ob ^ (((ob >> 9) & 1) << 5)); }
__host__ __device__ __forceinline__ void stage_rc(int b, int& R, int& C) { const int st = b / 1024, sb = b % 1024, swz = sb ^ (((sb >> 9) & 1) << 5); R = (st >> 1) * 16 + swz / 64; C = (st & 1) * 32 + (swz % 64) / 2; }
__host__ __device__ __forceinline__ int perm32(int rho) { const int n = rho >> 4, i = rho & 15; return 8 * (i >> 2) + 4 * n + (i & 3); }

struct Unit { int pm, pn; };
struct Gemm { const bf16_t* A; const bf16_t* Bt; int M, N, K; };

struct StaticOrder {
    int nM, nN, nwg, G, c;
    __host__ __device__ void init(int M, int N, int G_, int c_) { nM = M / BM; nN = N / BM; nwg = nM * nN; G = G_; c = c_; }
    __host__ __device__ bool next(int i, Unit& u) const {
        const long L = (long)i * G + c; if (L >= nwg) return false;
        int wgid = (int)L; { const int q = nwg / NXCD, r = nwg % NXCD, xcd = wgid % NXCD, off = wgid / NXCD; wgid = (xcd < r ? xcd * (q + 1) : r * (q + 1) + (xcd - r) * q) + off; }
        const int nig = WGM * nN, gid = wgid / nig, fm = gid * WGM, gsz = (nM - fm) < WGM ? (nM - fm) : WGM;
        u.pm = fm + ((wgid % nig) % gsz); u.pn = (wgid % nig) / gsz; return true;
    }
    __device__ __forceinline__ void a_ready(const Unit&) const {}
    __device__ __forceinline__ void done(const Unit&) const {}
};
struct CountedOrder : StaticOrder {
    const unsigned* ready; unsigned need; unsigned* tmo;
    __device__ __forceinline__ void a_ready(const Unit& u) const {
        if (threadIdx.x < 64) {
            const unsigned long long t0 = __builtin_amdgcn_s_memrealtime(); unsigned polls = 0;
            while ((unsigned)__builtin_amdgcn_readfirstlane(__hip_atomic_load(ready + 64 * u.pm, __ATOMIC_RELAXED, __HIP_MEMORY_SCOPE_AGENT)) < need) {
                if ((++polls & 255u) == 0u && __builtin_amdgcn_readfirstlane(__hip_atomic_load(tmo, __ATOMIC_RELAXED, __HIP_MEMORY_SCOPE_AGENT)) != 0u) break;
                if (__builtin_amdgcn_s_memrealtime() - t0 > 2000000ull) {
                    if (threadIdx.x == 0) { unsigned expect = 0u; __hip_atomic_compare_exchange_strong(tmo + 1, &expect, 0x600u | (unsigned)(u.pm & 0xff), __ATOMIC_RELAXED, __ATOMIC_RELAXED, __HIP_MEMORY_SCOPE_AGENT); __hip_atomic_store(tmo, 1u, __ATOMIC_RELAXED, __HIP_MEMORY_SCOPE_AGENT); }
                    break; }
                __builtin_amdgcn_s_sleep(2); }
            __builtin_amdgcn_fence(__ATOMIC_ACQUIRE, "agent");
            asm volatile("s_waitcnt vmcnt(0)" ::: "memory");
        }
#if !defined(BROKEN_HOOK_NO_BARRIER)
        asm volatile("" ::: "memory"); __builtin_amdgcn_s_barrier(); asm volatile("" ::: "memory");
#endif
    }
};

__device__ __forceinline__ unsigned cvt_pk_bf16(float lo, float hi) { unsigned r; asm volatile("v_cvt_pk_bf16_f32 %0, %1, %2" : "=v"(r) : "v"(lo), "v"(hi)); return r; }
typedef float f32x2 __attribute__((ext_vector_type(2)));
__device__ __forceinline__ f32x2 gelu_pk(f32x2 v) {
    const f32x2 av = __builtin_elementwise_abs(v), d = av * 0.2316418882f + 1.0f;
    f32x2 t; t.x = __builtin_amdgcn_rcpf(d.x); t.y = __builtin_amdgcn_rcpf(d.y);
    f32x2 q = t * 0.5307027145f + (-0.7265760135f); q = q * t + 0.7107068705f; q = q * t + (-0.142248368f); q = q * t + 0.127414796f; q = q * t;
    const f32x2 s = (v * v) * (-0.72134752044f);
    f32x2 e; e.x = __builtin_amdgcn_exp2f(s.x); e.y = __builtin_amdgcn_exp2f(s.y);
    const f32x2 m = v * (q * e), r = v - m;
    f32x2 o; o.x = v.x < 0.f ? m.x : r.x; o.y = v.y < 0.f ? m.y : r.y; return o;
}

struct EpiF32 {
    static constexpr bool PERM = false, AFTER_DRAIN = false;
    float* C; int ldc; const float* bias;
    __device__ __forceinline__ void operator()(const f32x4 (&acc)[2][2][4][2], const Unit& u, int wr, int wc, int fr, int fq) const {
        const int row0 = u.pm * BM + wr * 64 + fr, col0 = u.pn * BM + wc * 32 + 4 * fq;
        f32x4 bv[2][2];
#pragma unroll
        for (int bj = 0; bj < 2; ++bj)
#pragma unroll
            for (int n = 0; n < 2; ++n) bv[bj][n] = bias ? *(const f32x4*)(bias + col0 + bj * HALF + n * 16) : (f32x4){0.f, 0.f, 0.f, 0.f};
#pragma unroll
        for (int ai = 0; ai < 2; ++ai)
#pragma unroll
            for (int m = 0; m < 4; ++m) { float* rowp = C + (size_t)(row0 + ai * HALF + m * 16) * ldc + col0;
#pragma unroll
                for (int bj = 0; bj < 2; ++bj)
#pragma unroll
                    for (int n = 0; n < 2; ++n) *(f32x4*)(rowp + bj * HALF + n * 16) = acc[ai][bj][m][n] + bv[bj][n]; }
    }
};
template <int ACT  > struct EpiBf16 {
    static constexpr bool PERM = true, AFTER_DRAIN = false;
    bf16_t* O; int ldc; const float* bias; int split_cols; size_t split_stride;
    __device__ __forceinline__ void operator()(const f32x4 (&acc)[2][2][4][2], const Unit& u, int wr, int wc, int fr, int fq) const {
        const int row0 = u.pm * BM + wr * 64 + fr; int colt = u.pn * BM; bf16_t* base = O;
        if (split_cols) { const int t = colt / split_cols; base += (size_t)t * split_stride; colt -= t * split_cols; }
        const int col0 = colt + wc * 32 + 8 * fq, bcol0 = u.pn * BM + wc * 32 + 8 * fq;
        f32x4 bv[2][2];
#pragma unroll
        for (int bj = 0; bj < 2; ++bj)
#pragma unroll
            for (int n = 0; n < 2; ++n) bv[bj][n] = bias ? *(const f32x4*)(bias + bcol0 + bj * HALF + 4 * n) : (f32x4){0.f, 0.f, 0.f, 0.f};
#pragma unroll
        for (int ai = 0; ai < 2; ++ai)
#pragma unroll
            for (int m = 0; m < 4; ++m) { bf16_t* rowp = base + (size_t)(row0 + ai * HALF + m * 16) * ldc + col0;
#pragma unroll
                for (int bj = 0; bj < 2; ++bj) { f32x4 v0 = acc[ai][bj][m][0] + bv[bj][0], v1 = acc[ai][bj][m][1] + bv[bj][1];
                    if (ACT == 1) { f32x2 a = gelu_pk((f32x2){v0[0], v0[1]}), b = gelu_pk((f32x2){v0[2], v0[3]}), c = gelu_pk((f32x2){v1[0], v1[1]}), d = gelu_pk((f32x2){v1[2], v1[3]});
                        v0 = (f32x4){a.x, a.y, b.x, b.y}; v1 = (f32x4){c.x, c.y, d.x, d.y}; }
                    if (ACT == 2) {
#pragma unroll
                        for (int j = 0; j < 4; ++j) { v0[j] = 0.5f * v0[j] * (1.0f + erff(v0[j] * 0.70710678f)); v1[j] = 0.5f * v1[j] * (1.0f + erff(v1[j] * 0.70710678f)); } }
                    u32x4 w; w.x = cvt_pk_bf16(v0[0], v0[1]); w.y = cvt_pk_bf16(v0[2], v0[3]); w.z = cvt_pk_bf16(v1[0], v1[1]); w.w = cvt_pk_bf16(v1[2], v1[3]);
                    *(u32x4*)(rowp + bj * HALF) = w; } }
    }
};

template <int MODE> __device__ __forceinline__ f32x4 pg8_mma(bf16x8 a, bf16x8 b, f32x4 c) {
    if constexpr (MODE == 1) { typedef int i32x4_ __attribute__((ext_vector_type(4))); return __builtin_bit_cast(f32x4, __builtin_amdgcn_mfma_i32_16x16x64_i8(__builtin_bit_cast(i32x4_, a), __builtin_bit_cast(i32x4_, b), __builtin_bit_cast(i32x4_, c), 0, 0, 0)); }
    else return __builtin_amdgcn_mfma_f32_16x16x32_bf16(a, b, c, 0, 0, 0); }
__device__ __forceinline__ f32x4 pg8_mma8(bf16x8 a0, bf16x8 a1, bf16x8 b0, bf16x8 b1, f32x4 c) {
    typedef int i32x4_ __attribute__((ext_vector_type(4))); typedef int i32x8_ __attribute__((ext_vector_type(8)));
    const i32x8_ A = __builtin_shufflevector(__builtin_bit_cast(i32x4_, a0), __builtin_bit_cast(i32x4_, a1), 0, 1, 2, 3, 4, 5, 6, 7), B = __builtin_shufflevector(__builtin_bit_cast(i32x4_, b0), __builtin_bit_cast(i32x4_, b1), 0, 1, 2, 3, 4, 5, 6, 7);
    const int one = 0x7f7f7f7f;
    asm volatile("v_mfma_scale_f32_16x16x128_f8f6f4 %0, %1, %2, %0, %3, %3 op_sel_hi:[0,0,0]" : "+v"(c) : "v"(A), "v"(B), "v"(one));
    return c; }
__device__ __forceinline__ void fp8_acc_settle() { asm volatile("s_nop 7\n\ts_nop 7\n\ts_nop 7" ::: "memory"); }
template <class Epi, class Sched, bool STAMP = false, int MODE = 0>
__device__ __forceinline__ void gemm_phase(PG8_LAS unsigned char* lds, const Gemm g, const Sched& S, const Epi& E, unsigned long long* stamps) {
    const int tid = threadIdx.x, wid = __builtin_amdgcn_readfirstlane(tid >> 6), lane = tid & 63, wr = wid >> 2, wc = wid & 3, fr = lane & 15, fq = lane >> 4;
    const int K = g.K, nt = K / BK;
    int ts_lo = 0, ts_hi = 0, nts = 0; const unsigned long long rt_entry = STAMP ? (unsigned long long)wall_clock64() : 0ull;
#define PG8_STAMP() do { if (STAMP && wid == 0 && nts < 64) { const unsigned long long _c = (unsigned long long)clock64(); \
        ts_lo = (lane == nts) ? (int)(unsigned)_c : ts_lo; ts_hi = (lane == nts) ? (int)(unsigned)(_c >> 32) : ts_hi; ++nts; } } while (0)
    PG8_STAMP();
    unsigned voffA[2], voffB[2];
#pragma unroll
    for (int i = 0; i < 2; ++i) { int R, C; stage_rc(tid * 16 + i * 8192, R, C); const int Rb = Epi::PERM ? ((R & ~31) + perm32(R & 31)) : R;
        voffA[i] = (unsigned)(R * K + C) * 2u; voffB[i] = (unsigned)(Rb * K + C) * 2u; }
    const size_t kstep = (size_t)(BK * 2);
    const size_t hstep = (size_t)HALF * K * 2;
    const size_t tstep = 2 * hstep;
    const unsigned ldsw = (unsigned)wid * 1024u;
    const int aoff = lds_byte(wr * 64 + fr, fq * 8), boff = lds_byte(wc * 32 + fr, fq * 8);
#define PG8_SA(b, h) (((b) * 2 + (h)) * HTB)
#define PG8_SB(b, h) ((4 + (b) * 2 + (h)) * HTB)
#define PG8_STAGE(bufoff, gbase, voff) do { _Pragma("unroll") for (int _i = 0; _i < 2; ++_i) \
        __builtin_amdgcn_global_load_lds((const unsigned*)((const char*)(gbase) + (voff)[_i]), (PG8_LAS unsigned*)(lds + (bufoff) + ldsw + _i * 8192), 16, 0, 0); } while (0)
#define PG8_LDA(dst, b, h) do { _Pragma("unroll") for (int m = 0; m < 4; ++m) _Pragma("unroll") for (int k = 0; k < 2; ++k) dst[m][k] = *(const PG8_LAS bf16x8*)(lds + PG8_SA(b, h) + aoff + m * 2048 + k * 1024); } while (0)
#define PG8_LDB(dst, b, h) do { _Pragma("unroll") for (int n = 0; n < 2; ++n) _Pragma("unroll") for (int k = 0; k < 2; ++k) dst[n][k] = *(const PG8_LAS bf16x8*)(lds + PG8_SB(b, h) + boff + n * 2048 + k * 1024); } while (0)
#define PG8_MMA(ai, bj, At, Bt) do { __builtin_amdgcn_s_setprio(1); _Pragma("unroll") for (int m = 0; m < 4; ++m) _Pragma("unroll") for (int n = 0; n < 2; ++n) { if constexpr (MODE == 2) acc[ai][bj][m][n] = pg8_mma8(Bt[n][0], Bt[n][1], At[m][0], At[m][1], acc[ai][bj][m][n]); else { _Pragma("unroll") for (int k = 0; k < 2; ++k) \
        acc[ai][bj][m][n] = pg8_mma<MODE>(Bt[n][k], At[m][k], acc[ai][bj][m][n]); } } __builtin_amdgcn_s_setprio(0); } while (0)
#define PG8_WAIT_V(n) asm volatile("s_waitcnt vmcnt(" #n ")" ::: "memory")
#define PG8_WAIT_L(n) asm volatile("s_waitcnt lgkmcnt(" #n ")" ::: "memory")
#define PG8_BAR __builtin_amdgcn_s_barrier()
#define PG8_SCHED __builtin_amdgcn_sched_barrier(0)
    Unit cur, nxt; int ui = 0;
    if (!S.next(0, cur)) return;
    f32x4 acc[2][2][4][2];
#pragma unroll
    for (int a = 0; a < 2; ++a)
#pragma unroll
        for (int b = 0; b < 2; ++b)
#pragma unroll
            for (int m = 0; m < 4; ++m)
#pragma unroll
                for (int n = 0; n < 2; ++n) acc[a][b][m][n] = (f32x4){0.f, 0.f, 0.f, 0.f};
    bf16x8 At[4][2], B0[2][2], B1[2][2];
    const char* cA = (const char*)g.A + (size_t)cur.pm * tstep; const char* cB = (const char*)g.Bt + (size_t)cur.pn * tstep;
    S.a_ready(cur);
    PG8_STAGE(PG8_SB(0, 0), cB, voffB); PG8_STAGE(PG8_SA(0, 0), cA, voffA); PG8_STAGE(PG8_SB(0, 1), cB + hstep, voffB); PG8_STAGE(PG8_SA(0, 1), cA + hstep, voffA);
    if (wr == 1) PG8_BAR;
    PG8_WAIT_V(4); PG8_BAR;
    PG8_STAGE(PG8_SB(1, 0), cB + kstep, voffB); PG8_STAGE(PG8_SA(1, 0), cA + kstep, voffA); PG8_STAGE(PG8_SB(1, 1), cB + hstep + kstep, voffB);
    PG8_WAIT_V(6); PG8_BAR;
    PG8_STAMP();
    for (;;) {
        const bool has_next = S.next(ui + 1, nxt);
        const char* nA = has_next ? (const char*)g.A + (size_t)nxt.pm * tstep : cA; const char* nB = has_next ? (const char*)g.Bt + (size_t)nxt.pn * tstep : cB;
        for (int t = 0; t < nt; t += 2) {
            const bool last = (t == nt - 2);
            const char* a1 = cA + (size_t)(t + 1) * kstep;
            const char* a2 = last ? nA : cA + (size_t)(t + 2) * kstep; const char* b2 = last ? nB : cB + (size_t)(t + 2) * kstep;
            const char* a3 = a2 + kstep; const char* b3 = b2 + kstep;
            if (last && has_next) S.a_ready(nxt);
            PG8_LDB(B0, 0, 0); PG8_SCHED; PG8_LDA(At, 0, 0); PG8_STAGE(PG8_SA(1, 1), a1 + hstep, voffA);
            PG8_WAIT_L(8); PG8_BAR; PG8_WAIT_L(0); PG8_MMA(0, 0, At, B0); PG8_BAR; PG8_SCHED;
            PG8_LDB(B1, 0, 1); PG8_STAGE(PG8_SB(0, 0), b2, voffB);
            PG8_BAR; PG8_WAIT_L(0); PG8_MMA(0, 1, At, B1); PG8_BAR;
            PG8_LDA(At, 0, 1); PG8_STAGE(PG8_SA(0, 0), a2, voffA);
            PG8_BAR; PG8_WAIT_L(0); PG8_MMA(1, 0, At, B0); PG8_BAR; PG8_SCHED;
            PG8_STAGE(PG8_SB(0, 1), b2 + hstep, voffB);
            PG8_WAIT_V(6); PG8_BAR; PG8_MMA(1, 1, At, B1); PG8_BAR;
            PG8_LDB(B0, 1, 0); PG8_SCHED; PG8_LDA(At, 1, 0); PG8_STAGE(PG8_SA(0, 1), a2 + hstep, voffA);
            PG8_WAIT_L(8); PG8_BAR; PG8_WAIT_L(0); PG8_MMA(0, 0, At, B0); PG8_BAR; PG8_SCHED;
            PG8_LDB(B1, 1, 1); PG8_STAGE(PG8_SB(1, 0), b3, voffB);
            PG8_BAR; PG8_WAIT_L(0); PG8_MMA(0, 1, At, B1); PG8_BAR;
            PG8_LDA(At, 1, 1); PG8_STAGE(PG8_SA(1, 0), a3, voffA);
            PG8_BAR; PG8_WAIT_L(0); PG8_MMA(1, 0, At, B0); PG8_BAR; PG8_SCHED;
            PG8_STAGE(PG8_SB(1, 1), b3 + hstep, voffB);
            PG8_WAIT_V(6); PG8_BAR; PG8_MMA(1, 1, At, B1); PG8_BAR;
        }
        PG8_STAMP();
        if constexpr (!Epi::AFTER_DRAIN) { E(acc, cur, wr, wc, fr, fq); S.done(cur); }
        PG8_STAMP();
        if (!has_next) break;
#pragma unroll
        for (int a = 0; a < 2; ++a)
#pragma unroll
            for (int b = 0; b < 2; ++b)
#pragma unroll
                for (int m = 0; m < 4; ++m)
#pragma unroll
                    for (int n = 0; n < 2; ++n) acc[a][b][m][n] = (f32x4){0.f, 0.f, 0.f, 0.f};
        cur = nxt; cA = nA; cB = nB; ++ui;
    }
    PG8_WAIT_V(0);
    if (wr == 0) PG8_BAR;
    PG8_BAR;
    if constexpr (Epi::AFTER_DRAIN) { E.fused(acc, cur, wr, wc, fr, fq, lds, wid, lane); S.done(cur); }
    PG8_STAMP();
    if (STAMP && wid == 0) { stamps[lane] = lane < nts ? (((unsigned long long)(unsigned)ts_hi << 32) | (unsigned)ts_lo) : 0ull;
        if (lane == 62) stamps[62] = rt_entry; if (lane == 63) stamps[63] = (unsigned long long)wall_clock64(); }
#undef PG8_STAMP
#undef PG8_SA
#undef PG8_SB
#undef PG8_STAGE
#undef PG8_LDA
#undef PG8_LDB
#undef PG8_MMA
#undef PG8_WAIT_V
#undef PG8_WAIT_L
#undef PG8_BAR
#undef PG8_SCHED
}
}
#define XB_TMO      128
#define XB_XCNT(j)  (256  + 64 * (j))
#define XB_XSUB(j)  (1280 + 64 * (j))
#define XB_XGEN(j)  (2304 + 64 * (j))
#define XB_TOP      3328
#define XB_TOPGEN   3392
#define XCD_BAR_WORDS 3456
#define XB_SPIN_CAP (1u << 18)
#define LAS __attribute__((address_space(3)))

__device__ __forceinline__ unsigned xb_ld(unsigned* p)              { return __hip_atomic_load(p, __ATOMIC_RELAXED, __HIP_MEMORY_SCOPE_AGENT); }
__device__ __forceinline__ unsigned xb_add(unsigned* p, unsigned v) { return __hip_atomic_fetch_add(p, v, __ATOMIC_RELAXED, __HIP_MEMORY_SCOPE_AGENT); }
__device__ __forceinline__ unsigned xb_xcc_id() { return (unsigned)__builtin_amdgcn_s_getreg((3 << 11) | 20) & 0xFu; }
#define XB_SPIN(cond, bar) do { unsigned _sp = 0; while (cond) { __builtin_amdgcn_s_sleep(1); \
    if ((++_sp & 255u) == 0u) { if (xb_ld(&(bar)[XB_TMO])) break; if (_sp > XB_SPIN_CAP) { atomicAdd(&(bar)[XB_TMO], 1u); break; } } } } while (0)

struct XcdBarrier {
    unsigned* bar; unsigned x;
    volatile LAS unsigned* st;
};

__device__ __forceinline__ XcdBarrier xcd_barrier_post(unsigned* bar, volatile LAS unsigned* st) {
    XcdBarrier b; b.bar = bar; b.x = xb_xcc_id(); b.st = st;
    if (threadIdx.x == 0) (void)xb_add(&bar[XB_XCNT(b.x)], 1u);
    return b;
}
__device__ __forceinline__ void xcd_barrier_complete(unsigned* bar, unsigned x, unsigned& nloc, unsigned& nx) {
    const unsigned G = gridDim.x * gridDim.y * gridDim.z;
    unsigned sum, cnt, mine, sp = 0u;
    for (;;) {
        sum = 0u; cnt = 0u; mine = 0u;
#pragma unroll
        for (unsigned j = 0; j < 16; ++j) { const unsigned c = xb_ld(&bar[XB_XCNT(j)]); sum += c; cnt += (c > 0u) ? 1u : 0u; mine = (j == x) ? c : mine; }
        if (sum == G) break;
        __builtin_amdgcn_s_sleep(1);
        if ((++sp & 255u) == 0u) { if (xb_ld(&bar[XB_TMO])) break; if (sp > XB_SPIN_CAP) { atomicAdd(&bar[XB_TMO], 1u); break; } }
    }
    nloc = mine > 0u ? mine : 1u; nx = cnt > 0u ? cnt : 1u;
}

__device__ __forceinline__ void xcd_barrier(const XcdBarrier& b) {
    asm volatile("s_waitcnt vmcnt(0)" ::: "memory");
    __syncthreads();
    if (threadIdx.x == 0) {
        unsigned* bar = b.bar;
        __builtin_amdgcn_s_waitcnt(0);
        unsigned nloc = b.st[0], nx = b.st[1];
        if (nloc == 0u) { xcd_barrier_complete(bar, b.x, nloc, nx); b.st[0] = nloc; b.st[1] = nx; }
        const unsigned old = xb_add(&bar[XB_XSUB(b.x)], 1u);
        const unsigned gen = old / nloc;
        if (old + 1u == (gen + 1u) * nloc) {
            __builtin_amdgcn_fence(__ATOMIC_RELEASE, "agent");
            asm volatile("s_waitcnt vmcnt(0)" ::: "memory");
            const unsigned og = xb_add(&bar[XB_TOP], 1u);
            const unsigned tg = og / nx;
            if (og + 1u == (tg + 1u) * nx) xb_add(&bar[XB_TOPGEN], 1u);
            else XB_SPIN(xb_ld(&bar[XB_TOPGEN]) == tg, bar);
            __builtin_amdgcn_fence(__ATOMIC_ACQUIRE, "agent");
            xb_add(&bar[XB_XGEN(b.x)], 1u);
            asm volatile("s_waitcnt vmcnt(0)" ::: "memory");
        } else {
            XB_SPIN(xb_ld(&bar[XB_XGEN(b.x)]) == gen, bar);
            __builtin_amdgcn_fence(__ATOMIC_ACQUIRE, "agent");
            asm volatile("s_waitcnt vmcnt(0)" ::: "memory");
        }
    }
    __syncthreads();
}

namespace mk {
using pg8::bf16_t; using pg8::bf16x8; using pg8::f32x4; using pg8::u32x4;
typedef unsigned u32x2 __attribute__((ext_vector_type(2)));
typedef short bf16x4 __attribute__((ext_vector_type(4)));
typedef float lf2 __attribute__((ext_vector_type(2)));
typedef float lf4 __attribute__((ext_vector_type(4)));
typedef unsigned lu4 __attribute__((ext_vector_type(4)));

constexpr int D = 1024, NBATCH = 16, SEQ = 2048, CTXL = 256;
constexpr int NLAT = NBATCH * SEQ, NCTX = NBATCH * CTXL, NROW = NLAT + NCTX;
constexpr int NINP = 3072, NIN = 2944;
constexpr int C_Q = 256, C_K = 640, C_V = 1024, C_Z = 1408;
constexpr int DE = 2816;
constexpr int XROWS = 4608;
constexpr int NTHR = 512;
constexpr int LDS_MISC = 131072, LDS_BYTES = 131072 + 256;

constexpr size_t al256(size_t x) { return (x + 255) & ~(size_t)255; }
constexpr size_t WS_CTL = 0;
constexpr size_t WS_MOD = 65536;
constexpr size_t WS_SW = al256(WS_MOD + (size_t)2 * 17 * 6144 * 4);
constexpr size_t SW_W2T = 0, SW_A2T = 98304, SW_G2T = 196608, SW_GLUT = 294912, SW_S5E = 425984, SW_S5W2 = 2523136, SW_STRIDE = 6717440;
constexpr size_t WS_WIN = al256(WS_SW + 2 * SW_STRIDE);
constexpr size_t WS_WOUT = WS_WIN + (size_t)3072 * 1024 * 2;
constexpr size_t WS_WGU = WS_WOUT + (size_t)1024 * 1024 * 2;
constexpr size_t WS_WD = WS_WGU + (size_t)16 * 5632 * 1024 * 2;
constexpr size_t WS_XB = WS_WD + (size_t)16 * 1024 * 2816 * 2;
constexpr size_t WS_CTXA = WS_XB + (size_t)NLAT * D * 4;
constexpr size_t WS_CTXB = WS_CTXA + (size_t)NCTX * D * 4;
constexpr size_t WS_ABUF = WS_CTXB + (size_t)NCTX * D * 4;
constexpr size_t WS_AFF = WS_ABUF + (size_t)NROW * D * 2;
constexpr size_t WS_SLOT = WS_AFF + (size_t)NROW * 16 * 4;
constexpr size_t WS_SELG = WS_SLOT + (size_t)NROW * 16 * 4;
constexpr size_t WS_SW8 = al256(WS_SELG + (size_t)16 * XROWS * 4);
constexpr size_t WS_SX = WS_SW8 + (size_t)16 * 5632 * 4;
constexpr size_t WS_SXS = WS_SX + (size_t)NROW * 4;
constexpr size_t WS_SWIN = WS_SXS + (size_t)16 * XROWS * 4;
constexpr size_t WS_SH = WS_SWIN + (size_t)3072 * 4;
constexpr size_t WS_SWD = WS_SH + (size_t)NROW * 4;
constexpr size_t WS_U = al256(WS_SWD + (size_t)16 * 1024 * 4);
constexpr size_t SZ384 = (size_t)NROW * 384 * 2;
constexpr size_t U_P = WS_U;
constexpr size_t U_QR = U_P + (size_t)NROW * NINP * 2;
constexpr size_t U_KR = U_QR + SZ384;
constexpr size_t U_VT = U_KR + SZ384;
constexpr size_t U_VTC = U_VT + (size_t)16 * 384 * 2048 * 2;
constexpr size_t U_RS = U_VT + SZ384;
constexpr size_t U_KS = U_RS + SZ384;
constexpr size_t U_VS = U_KS + SZ384;
constexpr size_t U_KK = U_VS + SZ384;
constexpr size_t U_ALR = U_KK + SZ384;
constexpr size_t U_LD = U_ALR + SZ384;
constexpr size_t U_AG = U_LD + 2 * SZ384;
constexpr size_t U_G = U_AG + 2 * SZ384;
constexpr size_t U_YRK = U_G + SZ384;
constexpr size_t U_SLOC = U_YRK + 2 * (size_t)NROW * 384 * 4;
constexpr size_t U_SPREV = U_SLOC + (size_t)2304 * 16 * 256 * 4;
constexpr size_t U_YG = U_SPREV + (size_t)2304 * 16 * 256 * 2;
constexpr size_t U_U16 = U_YG + (size_t)NROW * 256 * 2;
constexpr size_t U_MIX_END = U_U16 + (size_t)NROW * 256 * 2;
constexpr int NCHUNK = 192 * 144;
constexpr size_t CH_XP = U_P;
constexpr size_t CH_BK = CH_XP + (size_t)NCHUNK * 4096;
constexpr size_t CH_UL = CH_BK + (size_t)NCHUNK * 4096;
constexpr size_t CH_MM = U_SLOC;
constexpr size_t CH_GT = CH_MM + (size_t)NCHUNK * 1024;
static_assert(CH_UL + (size_t)NCHUNK * 2048 <= U_RS, "chunk buffers overlap live RWKV operands");
static_assert(CH_GT + (size_t)NCHUNK * 256 <= U_SPREV, "chunk buffers overlap S5 states");
constexpr size_t U_Y = WS_U;
constexpr size_t U_XSEL = U_Y + (size_t)NROW * D * 4;
constexpr size_t U_HID = U_XSEL + (size_t)16 * XROWS * 1024 * 2;
constexpr size_t U_YEXP = U_HID + (size_t)16 * XROWS * DE * 2;
constexpr size_t U_FFN_END = U_YEXP + (size_t)16 * XROWS * 1024 * 2;
constexpr size_t WS_END = U_MIX_END > U_FFN_END ? U_MIX_END : U_FFN_END;

struct Params { const float* in[35]; float* out; unsigned char* ws; int ph_lo, ph_hi, use_bar, pad; };

typedef __bf16 hwbf2 __attribute__((ext_vector_type(2)));
__device__ __forceinline__ unsigned pack2(float lo, float hi) { const lf2 v = {lo, hi}; return __builtin_bit_cast(unsigned, __builtin_convertvector(v, hwbf2)); }
__device__ __forceinline__ bf16_t f2bf(float f) { return (bf16_t)(pack2(f, 0.f) & 0xffffu); }
__device__ __forceinline__ float bflo(unsigned w) { return __uint_as_float(w << 16); }
__device__ __forceinline__ float bfhi(unsigned w) { return __uint_as_float(w & 0xffff0000u); }
__device__ __forceinline__ float bf2f(bf16_t b) { return __uint_as_float(((unsigned)b) << 16); }
__device__ __forceinline__ float sigm(float x) { return 1.0f / (1.0f + __expf(-x)); }
__device__ __forceinline__ float wave_sum(float v) {
#pragma unroll
    for (int o = 32; o >= 1; o >>= 1) v += __shfl_xor(v, o);
    return v; }
__device__ __forceinline__ void unpack8(const uint4 w, float (&f)[8]) { f[0] = bflo(w.x); f[1] = bfhi(w.x); f[2] = bflo(w.y); f[3] = bfhi(w.y); f[4] = bflo(w.z); f[5] = bfhi(w.z); f[6] = bflo(w.w); f[7] = bfhi(w.w); }
__device__ __forceinline__ uint4 pack8(const float (&f)[8]) { uint4 w; w.x = pack2(f[0], f[1]); w.y = pack2(f[2], f[3]); w.z = pack2(f[4], f[5]); w.w = pack2(f[6], f[7]); return w; }
__device__ __forceinline__ const float* xrow(const float* lat, const float* ctx, int r) { return r < NLAT ? lat + (size_t)r * D : ctx + (size_t)(r - NLAT) * D; }
__device__ __forceinline__ float* xrow_w(float* lat, float* ctx, int r) { return r < NLAT ? lat + (size_t)r * D : ctx + (size_t)(r - NLAT) * D; }
__device__ __forceinline__ f32x4 mfma16(bf16x8 a, bf16x8 b, f32x4 c) { return __builtin_amdgcn_mfma_f32_16x16x32_bf16(a, b, c, 0, 0, 0); }

__device__ __forceinline__ void tr_tile(const float* __restrict__ src, int ldsrc, int k0, int n0, bf16_t* __restrict__ dst, int lddst, int drow0, LAS unsigned* T) {
    const int tid = threadIdx.x, n4 = tid & 15, kq = tid >> 4;
    const float4 a = *(const float4*)(src + (size_t)(k0 + 2 * kq) * ldsrc + n0 + 4 * n4);
    const float4 b = *(const float4*)(src + (size_t)(k0 + 2 * kq + 1) * ldsrc + n0 + 4 * n4);
    T[(4 * n4 + 0) * 33 + kq] = pack2(a.x, b.x); T[(4 * n4 + 1) * 33 + kq] = pack2(a.y, b.y);
    T[(4 * n4 + 2) * 33 + kq] = pack2(a.z, b.z); T[(4 * n4 + 3) * 33 + kq] = pack2(a.w, b.w);
    __syncthreads();
    const int n = tid >> 3, pc = tid & 7;
    uint4 v; v.x = T[n * 33 + 4 * pc]; v.y = T[n * 33 + 4 * pc + 1]; v.z = T[n * 33 + 4 * pc + 2]; v.w = T[n * 33 + 4 * pc + 3];
    *(uint4*)(dst + (size_t)(drow0 + n) * lddst + k0 + 8 * pc) = v;
    __syncthreads();
}

__device__ __forceinline__ void tr_tile4(const float* __restrict__ src, int ldsrc, int k0, int n0, bf16_t* __restrict__ dst, int lddst, int drow0, LAS unsigned* T) {
    const int tid = threadIdx.x, n4 = tid & 15, kq = tid >> 4;
    float4 a[4], b[4];
#pragma unroll
    for (int t = 0; t < 4; ++t) { a[t] = *(const float4*)(src + (size_t)(k0 + 2 * kq) * ldsrc + n0 + 64 * t + 4 * n4); b[t] = *(const float4*)(src + (size_t)(k0 + 2 * kq + 1) * ldsrc + n0 + 64 * t + 4 * n4); }
#pragma unroll
    for (int t = 0; t < 4; ++t) { LAS unsigned* Tt = T + t * 64 * 33;
        Tt[(4 * n4 + 0) * 33 + kq] = pack2(a[t].x, b[t].x); Tt[(4 * n4 + 1) * 33 + kq] = pack2(a[t].y, b[t].y); Tt[(4 * n4 + 2) * 33 + kq] = pack2(a[t].z, b[t].z); Tt[(4 * n4 + 3) * 33 + kq] = pack2(a[t].w, b[t].w); }
    __syncthreads();
#pragma unroll
    for (int i = 0; i < 4; ++i) { const int idx = tid + NTHR * i, n = idx >> 3, pc = idx & 7;
        uint4 v; v.x = T[n * 33 + 4 * pc]; v.y = T[n * 33 + 4 * pc + 1]; v.z = T[n * 33 + 4 * pc + 2]; v.w = T[n * 33 + 4 * pc + 3];
        *(uint4*)(dst + (size_t)(drow0 + n) * lddst + k0 + 8 * pc) = v; }
    __syncthreads();
}
template <int NK, int DP, bool FP8> __device__ __forceinline__ void q8_strip(const float* __restrict__ src, int ldsrc, unsigned char* __restrict__ dst, float* __restrict__ scl, LAS unsigned char* lds) {
    LAS float* cmax = (LAS float*)lds;
    LAS unsigned char* T = lds + 8704;
    const int tid = threadIdx.x, n4 = tid & 15, kq = tid >> 4; constexpr float QMAX = FP8 ? 256.0f : 127.0f;
    float mx[4] = {0.f, 0.f, 0.f, 0.f};
#pragma unroll 8
    for (int i = 0; i < 2 * NK; ++i) { const float4 v = *(const float4*)(src + (size_t)(kq + 32 * i) * ldsrc + 4 * n4); mx[0] = fmaxf(mx[0], fabsf(v.x)); mx[1] = fmaxf(mx[1], fabsf(v.y)); mx[2] = fmaxf(mx[2], fabsf(v.z)); mx[3] = fmaxf(mx[3], fabsf(v.w)); }
    __syncthreads();
#pragma unroll
    for (int j = 0; j < 4; ++j) cmax[kq * 64 + 4 * n4 + j] = mx[j];
    __syncthreads();
    if (tid < 64) { float m = 0.f; for (int g = 0; g < 32; ++g) m = fmaxf(m, cmax[g * 64 + tid]); m = fmaxf(m, 1e-20f); scl[tid] = m * (1.0f / QMAX); cmax[32 * 64 + tid] = QMAX / m; }
    __syncthreads();
    float inv[4];
#pragma unroll
    for (int j = 0; j < 4; ++j) inv[j] = cmax[32 * 64 + 4 * n4 + j];
    for (int kg = 0; kg < NK / 4; ++kg) {
        float4 a[4], b[4];
#pragma unroll
        for (int t = 0; t < 4; ++t) { const int kb = (kg * 4 + t) * 64 + 2 * kq; a[t] = *(const float4*)(src + (size_t)kb * ldsrc + 4 * n4); b[t] = *(const float4*)(src + (size_t)(kb + 1) * ldsrc + 4 * n4); }
#pragma unroll
        for (int t = 0; t < 4; ++t) { const float av[4] = {a[t].x, a[t].y, a[t].z, a[t].w}, bv[4] = {b[t].x, b[t].y, b[t].z, b[t].w};
#pragma unroll
            for (int j = 0; j < 4; ++j) { unsigned short w;
                if (FP8) w = (unsigned short)(__builtin_amdgcn_cvt_pk_fp8_f32(av[j] * inv[j], bv[j] * inv[j], 0, false) & 0xffff);
                else { const int q0 = __float2int_rn(av[j] * inv[j]), q1 = __float2int_rn(bv[j] * inv[j]); w = (unsigned short)((q0 & 255) | ((q1 & 255) << 8)); }
                *(LAS unsigned short*)(T + (4 * n4 + j) * 272 + t * 64 + 2 * kq) = w; } }
        __syncthreads();
#pragma unroll
        for (int i = 0; i < 2; ++i) { const int idx = tid + NTHR * i, n = idx >> 4, pc = idx & 15; *(lu4*)(dst + (size_t)n * DP + kg * 256 + 16 * pc) = *(const LAS lu4*)(T + n * 272 + 16 * pc); }
        __syncthreads();
    }
}
__device__ __forceinline__ void q8r_strip(const float* __restrict__ src, int ldsrc, unsigned char* __restrict__ dst, float* __restrict__ scl, LAS unsigned char* lds) {
    LAS float* cmax = (LAS float*)lds;
    const int tid = threadIdx.x, n4 = tid & 15, rg = tid >> 4;
    const float* s0 = src + (size_t)(rg * 32) * ldsrc + 4 * n4;
    lf4 v[32];
#pragma unroll
    for (int i = 0; i < 32; ++i) v[i] = *(const lf4*)(s0 + (size_t)i * ldsrc);
    __builtin_amdgcn_sched_barrier(0);
    float mx[4] = {0.f, 0.f, 0.f, 0.f};
#pragma unroll
    for (int i = 0; i < 32; ++i) {
#pragma unroll
        for (int j = 0; j < 4; ++j) mx[j] = fmaxf(mx[j], fabsf(v[i][j])); }
    __syncthreads();
#pragma unroll
    for (int j = 0; j < 4; ++j) cmax[rg * 64 + 4 * n4 + j] = mx[j];
    __syncthreads();
    if (tid < 64) { float m = 0.f; for (int g = 0; g < 32; ++g) m = fmaxf(m, cmax[g * 64 + tid]); m = fmaxf(m, 1e-20f); scl[tid] = m * (1.0f / 127.0f); cmax[32 * 64 + tid] = 127.0f / m; }
    __syncthreads();
#pragma unroll
    for (int j = 0; j < 4; ++j) { const float inv = cmax[32 * 64 + 4 * n4 + j]; unsigned w[8];
#pragma unroll
        for (int g = 0; g < 8; ++g) { const int q0 = __float2int_rn(v[4 * g][j] * inv), q1 = __float2int_rn(v[4 * g + 1][j] * inv), q2 = __float2int_rn(v[4 * g + 2][j] * inv), q3 = __float2int_rn(v[4 * g + 3][j] * inv);
            w[g] = (unsigned)(q0 & 255) | ((unsigned)(q1 & 255) << 8) | ((unsigned)(q2 & 255) << 16) | ((unsigned)q3 << 24); }
        unsigned char* d = dst + (size_t)(4 * n4 + j) * 1024 + rg * 32;
        *(lu4*)d = (lu4){w[0], w[1], w[2], w[3]}; *(lu4*)(d + 16) = (lu4){w[4], w[5], w[6], w[7]}; }
}
__device__ __forceinline__ void q8d_strip(const float* __restrict__ src, unsigned char* __restrict__ dst, float* __restrict__ scl, LAS unsigned char* lds) {
    LAS float* cmax = (LAS float*)lds;
    const int tid = threadIdx.x, n8 = tid & 7, rg = tid >> 3; const bool v2 = rg < 48;
    unsigned pk[3][16][2]; float mx[4] = {0.f, 0.f, 0.f, 0.f}; lf4 bufA[8], bufB[8];
    auto ld = [&](lf4 (&b)[8], int hr) { const int r = hr >> 1, c = (r == 2 && !v2) ? rg + 64 : rg + 64 * r; const float* sp = src + (size_t)(c * 16 + (hr & 1) * 8) * 1024 + 4 * n8;
#pragma unroll
        for (int i = 0; i < 8; ++i) b[i] = *(const lf4*)(sp + (size_t)i * 1024); };
    auto use = [&](const lf4 (&b)[8], int hr) {
#pragma unroll
        for (int i = 0; i < 8; ++i) {
#pragma unroll
            for (int j = 0; j < 4; ++j) mx[j] = fmaxf(mx[j], fabsf(b[i][j]));
            pk[hr >> 1][(hr & 1) * 8 + i][0] = pack2(b[i][0], b[i][1]); pk[hr >> 1][(hr & 1) * 8 + i][1] = pack2(b[i][2], b[i][3]); } };
    ld(bufA, 0);
#pragma unroll
    for (int h2 = 0; h2 < 3; ++h2) {
        ld(bufB, 2 * h2 + 1); __builtin_amdgcn_sched_barrier(0); use(bufA, 2 * h2);
        if (h2 < 2) ld(bufA, 2 * h2 + 2);
        __builtin_amdgcn_sched_barrier(0); use(bufB, 2 * h2 + 1); }
    __syncthreads();
#pragma unroll
    for (int j = 0; j < 4; ++j) cmax[rg * 32 + 4 * n8 + j] = mx[j];
    __syncthreads();
    if (tid < 32) { float m = 0.f; for (int g = 0; g < 64; ++g) m = fmaxf(m, cmax[g * 32 + tid]); m = fmaxf(m, 1e-20f); scl[tid] = m * (1.0f / 256.0f); cmax[64 * 32 + tid] = 256.0f / m; }
    __syncthreads();
    float inv[4];
#pragma unroll
    for (int j = 0; j < 4; ++j) inv[j] = cmax[64 * 32 + 4 * n8 + j];
#pragma unroll
    for (int r = 0; r < 3; ++r) { if (r == 2 && !v2) continue;
        const int c = rg + 64 * r;
#pragma unroll
        for (int j = 0; j < 4; ++j) { unsigned w[4];
#pragma unroll
            for (int g = 0; g < 4; ++g) { float f[4];
#pragma unroll
                for (int x = 0; x < 4; ++x) { const unsigned u = pk[r][4 * g + x][j >> 1]; f[x] = ((j & 1) ? bfhi(u) : bflo(u)) * inv[j]; }
                unsigned t = (unsigned)__builtin_amdgcn_cvt_pk_fp8_f32(f[0], f[1], 0, false); t = (unsigned)__builtin_amdgcn_cvt_pk_fp8_f32(f[2], f[3], (int)t, true); w[g] = t; }
            *(lu4*)(dst + (size_t)(4 * n8 + j) * DE + c * 16) = (lu4){w[0], w[1], w[2], w[3]}; } }
}
__device__ __forceinline__ void gu_strip(const Params& p, int l, int item, LAS unsigned char* lds) {
    const int e = item / 88, rem = item % 88, up = rem / 44, nt = rem % 44, n0 = nt * 64, drow0 = (n0 >> 7) * 256 + (n0 & 127) + (up ? 128 : 0);
    q8r_strip(p.in[up ? 33 : 32] + (size_t)(l * 16 + e) * 1024 * DE + n0, DE, p.ws + WS_WGU + ((size_t)e * 5632 + drow0) * 1024, (float*)(p.ws + WS_SW8) + (size_t)e * 5632 + drow0, lds);
}
constexpr int CV_GU = 16 * 88, CV_D4 = 16 * 32, CV_WIN = 46, CV_PAD = 16, CV_WOUT4 = 16 * 4, CV_TOTAL = CV_GU + CV_D4 + CV_WIN + CV_PAD + CV_WOUT4;
__device__ __forceinline__ void convert_weights(const Params& p, int l, LAS unsigned char* lds, int vb, int nvb) {
    LAS unsigned* T = (LAS unsigned*)lds; bf16_t* WOUT = (bf16_t*)(p.ws + WS_WOUT);
    for (int it = vb; it < CV_TOTAL; it += nvb) {
        int j = it;
        if (j < CV_GU) { gu_strip(p, l, j, lds); continue; }
        j -= CV_GU;
        if (j < CV_D4) { const int e = j >> 5, nt = j & 31;
            q8d_strip(p.in[34] + (size_t)(l * 16 + e) * DE * 1024 + nt * 32, p.ws + WS_WD + ((size_t)e * 1024 + nt * 32) * DE, (float*)(p.ws + WS_SWD) + e * 1024 + nt * 32, lds); continue; }
        j -= CV_D4;
        if (j < CV_WIN) { q8r_strip(p.in[7] + (size_t)l * 1024 * NIN + j * 64, NIN, p.ws + WS_WIN + (size_t)j * 64 * 1024, (float*)(p.ws + WS_SWIN) + j * 64, lds); continue; }
        j -= CV_WIN;
        if (j < CV_PAD) { const size_t o = (size_t)NIN * 1024 + ((size_t)j * NTHR + threadIdx.x) * 16; *(uint4*)(p.ws + WS_WIN + o) = make_uint4(0u, 0u, 0u, 0u);
            if (j == 0 && threadIdx.x < 128) ((float*)(p.ws + WS_SWIN))[NIN + threadIdx.x] = 0.f; continue; }
        j -= CV_PAD;
        { const int kt = j >> 2, ng = j & 3; tr_tile4(p.in[8] + (size_t)l * 1024 * 1024, 1024, kt * 64, ng * 256, WOUT, 1024, ng * 256, T); }
    }
}

__device__ __forceinline__ void mod_item(const Params& p, int item, LAS unsigned char* lds) {
    LAS float* sc = (LAS float*)lds;
    LAS float* red = (LAS float*)(lds + 69632);
    const int tid = threadIdx.x, l = item / 96, cg = item % 96;
    for (int i = tid; i < 17 * 1024; i += NTHR) { const int b = i >> 10, k = i & 1023; const float c = b < 16 ? p.in[1][b * 1024 + k] : p.in[3][k]; sc[k * 17 + b] = c * sigm(c); }
    __syncthreads();
    const int col = cg * 64 + (tid & 63), kg = tid >> 6;
    float acc[17];
#pragma unroll
    for (int b = 0; b < 17; ++b) acc[b] = 0.f;
    const float* w = p.in[4] + ((size_t)l * 1024 + kg * 128) * 6144 + col;
#pragma unroll 4
    for (int kk = 0; kk < 128; ++kk) { const float wv = w[(size_t)kk * 6144]; const LAS float* s = sc + (kg * 128 + kk) * 17;
#pragma unroll
        for (int b = 0; b < 17; ++b) acc[b] += s[b] * wv; }
#pragma unroll
    for (int b = 0; b < 17; ++b) red[(kg * 17 + b) * 64 + (tid & 63)] = acc[b];
    __syncthreads();
    for (int i = tid; i < 17 * 64; i += NTHR) { const int b = i >> 6, c = i & 63; float s = 0.f;
#pragma unroll
        for (int g = 0; g < 8; ++g) s += red[(g * 17 + b) * 64 + c];
        ((float*)(p.ws + WS_MOD))[((size_t)l * 17 + b) * 6144 + cg * 64 + c] = s + p.in[5][l * 6144 + cg * 64 + c]; }
    __syncthreads();
}

__device__ __forceinline__ void s5mat_item(const Params& p, int item, LAS unsigned char* lds) {
    LAS lf2* pw = (LAS lf2*)lds;
    LAS lf2* bb = (LAS lf2*)(lds + 17408);
    LAS lf2* cc = (LAS lf2*)(lds + 17408 + 16384);
    LAS float* KT = (LAS float*)(lds + 17408 + 32768);
    const int tid = threadIdx.x, l = item >> 4, g = item & 15;
    for (int i = tid; i < 2 * 17 * 64; i += NTHR) { const int pp = i & 63, n = (i >> 6) % 17, d = i / (17 * 64);
        const int li = ((l * 2 + d) * 16 + g) * 64 + pp; const float lr = p.in[9][li], lim = p.in[10][li], dt = expf(p.in[11][(l * 2 + d) * 16 + g]);
        const float mag = expf((float)n * dt * lr); float s, c; sincosf((float)n * dt * lim, &s, &c); pw[i] = (lf2){mag * c, mag * s}; }
    for (int i = tid; i < 2 * 64 * 16; i += NTHR) { const int h = i & 15, pp = (i >> 4) & 63, d = i >> 10;
        const int li = ((l * 2 + d) * 16 + g) * 64 + pp; const float lr = p.in[9][li], lim = p.in[10][li], dt = expf(p.in[11][(l * 2 + d) * 16 + g]);
        const float mag = expf(dt * lr); float s, c; sincosf(dt * lim, &s, &c); const float x = mag * c - 1.0f, y = mag * s;
        const float den = 1.0f / (lr * lr + lim * lim); const float cr = (x * lr + y * lim) * den, ci = (y * lr - x * lim) * den;
        const int bi = ((l * 16 + g) * 64 + pp) * 16 + h; const float br = p.in[12][bi], bim = p.in[13][bi];
        bb[i] = (lf2){cr * br - ci * bim, cr * bim + ci * br}; }
    for (int i = tid; i < 2 * 16 * 64; i += NTHR) { const int pp = i & 63, h = (i >> 6) & 15, d = i >> 10;
        const int ci = (((l * 2 + d) * 16 + g) * 16 + h) * 64 + pp; cc[i] = (lf2){p.in[14][ci], p.in[15][ci]}; }
    __syncthreads();
    for (int i = tid; i < 2 * 16 * 256; i += NTHR) { const int h2 = i & 15, h = (i >> 4) & 15, tau = (i >> 8) & 15, d = i >> 12; float s = 0.f;
        for (int pp = 0; pp < 64; ++pp) { const lf2 c = cc[(d * 16 + h) * 64 + pp], w = pw[(d * 17 + tau) * 64 + pp], b = bb[(d * 64 + pp) * 16 + h2];
            const float tr = c.x * w.x - c.y * w.y, ti = c.x * w.y + c.y * w.x; s += tr * b.x - ti * b.y; }
        KT[i] = s; }
    __syncthreads();
    bf16_t* E = (bf16_t*)(p.ws + WS_SW + (size_t)l * SW_STRIDE + SW_S5E) + (size_t)g * 256 * 256;
    bf16_t* W2 = (bf16_t*)(p.ws + WS_SW + (size_t)l * SW_STRIDE + SW_S5W2) + (size_t)g * 256 * 512;
    for (int i = tid; i < 256 * 256; i += NTHR) { const int k = i & 255, n = i >> 8; const int s = k >> 4, h = k & 15, d = n >> 7, part = (n >> 6) & 1, pp = n & 63;
        const int e = d == 0 ? 15 - s : s; const lf2 w = pw[(d * 17 + e) * 64 + pp], b = bb[(d * 64 + pp) * 16 + h];
        E[i] = f2bf(part ? (w.x * b.y + w.y * b.x) : (w.x * b.x - w.y * b.y)); }
    for (int i = tid; i < 256 * 512; i += NTHR) { const int k = i & 511, n = i >> 9; const int t = n >> 4, h = n & 15; float v;
        if (k < 256) { const int s = k >> 4, h2 = k & 15; v = 0.f;
            if (t >= s) v += KT[((0 * 16 + (t - s)) * 16 + h) * 16 + h2];
            if (s >= t) v += KT[((1 * 16 + (s - t)) * 16 + h) * 16 + h2];
            if (s == t && h == h2) v += p.in[16][l * 256 + g * 16 + h]; }
        else { const int q = k - 256, d = q >> 7, part = (q >> 6) & 1, pp = q & 63; const int e = d == 0 ? t + 1 : 16 - t;
            const lf2 c = cc[(d * 16 + h) * 64 + pp], w = pw[(d * 17 + e) * 64 + pp];
            v = part ? -(c.x * w.y + c.y * w.x) : (c.x * w.x - c.y * w.y); }
        W2[i] = f2bf(v); }
    __syncthreads();
}

__device__ __forceinline__ void smallw_item(const Params& p, int item) {
    int i = item * NTHR + threadIdx.x; const int l = i / 212992; i %= 212992;
    unsigned char* sw = p.ws + WS_SW + (size_t)l * SW_STRIDE;
    if (i < 49152) { const int k = i & 63, n = (i >> 6) % 384, d = i / 24576; ((bf16_t*)(sw + SW_W2T))[i] = f2bf(p.in[22][((size_t)(l * 2 + d) * 64 + k) * 384 + n]); return; }
    i -= 49152;
    if (i < 49152) { const int k = i & 63, n = (i >> 6) % 384, d = i / 24576; ((bf16_t*)(sw + SW_A2T))[i] = f2bf(p.in[24][((size_t)(l * 2 + d) * 64 + k) * 384 + n]); return; }
    i -= 49152;
    if (i < 49152) { const int k = i & 127, n = i >> 7; ((bf16_t*)(sw + SW_G2T))[i] = f2bf(p.in[25][((size_t)l * 128 + k) * 384 + n]); return; }
    i -= 49152;
    { const int k = i & 255, n = i >> 8; ((bf16_t*)(sw + SW_GLUT))[i] = f2bf(p.in[17][((size_t)l * 256 + k) * 256 + n]); }
}

constexpr int PRO_MOD = 192, PRO_S5 = 32, PRO_SW = 832;
__device__ __forceinline__ void phase_prologue(const Params& p, LAS unsigned char* lds) {
    for (int it = blockIdx.x; it < PRO_MOD + PRO_S5 + PRO_SW; it += gridDim.x) {
        if (it < PRO_MOD) mod_item(p, it, lds);
        else if (it < PRO_MOD + PRO_S5) s5mat_item(p, it - PRO_MOD, lds);
        else smallw_item(p, it - PRO_MOD - PRO_S5);
    }
    convert_weights(p, 0, lds, (int)blockIdx.x, (int)gridDim.x);
}

__device__ __forceinline__ void hnorm_row(const float* g, const float* mb_sh, const float* mb_sc, unsigned char* dst, float* sdst, int lane, const float4 (&v)[4]) {
    float ss = 0.f;
#pragma unroll
    for (int i = 0; i < 4; ++i) ss += v[i].x * v[i].x + v[i].y * v[i].y + v[i].z * v[i].z + v[i].w * v[i].w;
    ss = wave_sum(ss); const float rs = rsqrtf(ss * (1.0f / 1024.0f) + 1e-6f);
    float hv[4][4]; float amax = 0.f;
#pragma unroll
    for (int i = 0; i < 4; ++i) { const int c = i * 256 + lane * 4; const float4 gg = *(const float4*)(g + c), sh = *(const float4*)(mb_sh + c), sc = *(const float4*)(mb_sc + c);
        hv[i][0] = v[i].x * rs * gg.x * (1.f + sc.x) + sh.x; hv[i][1] = v[i].y * rs * gg.y * (1.f + sc.y) + sh.y; hv[i][2] = v[i].z * rs * gg.z * (1.f + sc.z) + sh.z; hv[i][3] = v[i].w * rs * gg.w * (1.f + sc.w) + sh.w;
        amax = fmaxf(amax, fmaxf(fmaxf(fabsf(hv[i][0]), fabsf(hv[i][1])), fmaxf(fabsf(hv[i][2]), fabsf(hv[i][3])))); }
#pragma unroll
    for (int o = 32; o >= 1; o >>= 1) amax = fmaxf(amax, __shfl_xor(amax, o));
    amax = fmaxf(amax, 1e-20f); const float qs = 127.0f / amax;
    if (lane == 0) *sdst = amax * (1.0f / 127.0f);
#pragma unroll
    for (int i = 0; i < 4; ++i) { unsigned w = 0u;
#pragma unroll
        for (int k = 0; k < 4; ++k) w |= ((unsigned)__float2int_rn(hv[i][k] * qs) & 255u) << (8 * k);
        *(unsigned*)(dst + i * 256 + lane * 4) = w; }
}
__device__ __forceinline__ void phase_hnorm(const Params& p, int l, const float* xl, const float* xc) {
    const int lane = threadIdx.x & 63, wv = threadIdx.x >> 6;
    const float* mod = (const float*)(p.ws + WS_MOD) + (size_t)l * 17 * 6144; const float* g = p.in[6] + (l * 4 + 0) * 1024;
    unsigned char* A = p.ws + WS_ABUF; float* SH = (float*)(p.ws + WS_SH);
    for (int r = blockIdx.x * 8 + wv; r < NROW; r += gridDim.x * 8) {
        const float* src = xrow(xl, xc, r); const int b = r < NLAT ? (r >> 11) : 16; const float* mb = mod + (size_t)b * 6144;
        float4 v[4];
#pragma unroll
        for (int i = 0; i < 4; ++i) v[i] = *(const float4*)(src + i * 256 + lane * 4);
        hnorm_row(g, mb, mb + 1024, A + (size_t)r * 1024, SH + r, lane, v);
    }
}


__device__ __forceinline__ void phase_prep(const Params& p, int l, LAS unsigned char* lds) {
    LAS bf16_t* vt = (LAS bf16_t*)lds;
    LAS lf2* cs = (LAS lf2*)(lds + 50176);
    const int tid = threadIdx.x;
    for (int i = tid; i < 1024; i += NTHR) { const int pos = i >> 4, j = i & 15; const float invf = exp2f(-(float)j * (13.287712379549449f / 16.0f)); float s, c; sincosf((float)pos * invf, &s, &c); cs[i] = (lf2){c, s}; }
    __syncthreads();
    const bf16_t* P = (const bf16_t*)(p.ws + U_P);
    bf16_t* QR = (bf16_t*)(p.ws + U_QR); bf16_t* KR = (bf16_t*)(p.ws + U_KR);
    bf16_t* RS = (bf16_t*)(p.ws + U_RS); bf16_t* KS = (bf16_t*)(p.ws + U_KS); bf16_t* VS = (bf16_t*)(p.ws + U_VS); bf16_t* KK = (bf16_t*)(p.ws + U_KK); bf16_t* ALR = (bf16_t*)(p.ws + U_ALR);
    for (int ti = blockIdx.x; ti < NROW / 64; ti += gridDim.x) {
        const int r0 = ti * 64; const bool lat = r0 < NLAT; const int b = lat ? (r0 >> 11) : ((r0 - NLAT) >> 8), t0 = lat ? (r0 & 2047) : ((r0 - NLAT) & 255), slen = lat ? SEQ : CTXL;
#pragma unroll
        for (int i = 0; i < 6; ++i) { const int idx = tid + NTHR * i, tok = idx / 48, pc = idx % 48;
            *(LAS lu4*)(vt + tok * 392 + pc * 8) = *(const lu4*)(P + (size_t)(r0 + tok) * NINP + C_V + pc * 8); }
        __syncthreads();
        { bf16_t* vdst = lat ? (bf16_t*)(p.ws + U_VT) + (size_t)b * 384 * 2048 + t0 : (bf16_t*)(p.ws + U_VTC) + (size_t)b * 384 * 256 + t0;
#pragma unroll
          for (int i = 0; i < 6; ++i) { const int idx = tid + NTHR * i, hd = idx >> 3, pc = idx & 7; unsigned w[4];
#pragma unroll
              for (int j = 0; j < 4; ++j) w[j] = (unsigned)vt[(pc * 8 + 2 * j) * 392 + hd] | ((unsigned)vt[(pc * 8 + 2 * j + 1) * 392 + hd] << 16);
              *(uint4*)(vdst + (size_t)hd * slen + pc * 8) = make_uint4(w[0], w[1], w[2], w[3]); } }
#pragma unroll
        for (int i = 0; i < 4; ++i) { const int idx = tid + NTHR * i, tok = idx >> 5, pc = idx & 31;
            *(lu4*)((bf16_t*)(p.ws + U_U16) + (size_t)(r0 + tok) * 256 + pc * 8) = *(const lu4*)(P + (size_t)(r0 + tok) * NINP + pc * 8); }
        { lu4 rx[6][2]; int tq = threadIdx.x; asm volatile("" : "+v"(tq));
#pragma unroll
          for (int i = 0; i < 6; ++i) { const int idx = tq + NTHR * i, tok = idx / 48, rem = idx % 48, qk = rem / 24, rem2 = rem % 24, h = rem2 >> 2, pp = rem2 & 3;
              const int d1 = (pp >> 1) * 32 + (pp & 1) * 8; const size_t so = (size_t)(r0 + tok) * NINP + (qk ? C_K : C_Q) + h * 64 + d1;
              rx[i][0] = *(const lu4*)(P + so); rx[i][1] = *(const lu4*)(P + so + 16); }
#pragma unroll
          for (int i = 0; i < 6; ++i) { const int idx = tq + NTHR * i, tok = idx / 48, rem = idx % 48, qk = rem / 24, rem2 = rem % 24, h = rem2 >> 2, pp = rem2 & 3;
              const int d1 = (pp >> 1) * 32 + (pp & 1) * 8;
              float x1[8], x2[8], o1[8], o2[8]; unpack8(make_uint4(rx[i][0].x, rx[i][0].y, rx[i][0].z, rx[i][0].w), x1); unpack8(make_uint4(rx[i][1].x, rx[i][1].y, rx[i][1].z, rx[i][1].w), x2);
              const int t = t0 + tok, pos = (pp < 2) ? (t >> 6) : (t & 63), j0 = (pp & 1) * 8; const float scl = qk ? 1.0f : 0.125f;
#pragma unroll
              for (int j = 0; j < 8; ++j) { lf2 c = cs[pos * 16 + j0 + j]; if (!lat) c = (lf2){1.f, 0.f}; o1[j] = (x1[j] * c.x - x2[j] * c.y) * scl; o2[j] = (x1[j] * c.y + x2[j] * c.x) * scl; }
              bf16_t* dq = (qk ? KR : QR) + (size_t)(r0 + tok) * 384 + h * 64 + d1; *(uint4*)dq = pack8(o1); *(uint4*)(dq + 16) = pack8(o2); } }
#pragma unroll 1
        for (int ig = 0; ig < 6; ++ig) { lu4 zc[4], zq[4], zn[4]; int ts = threadIdx.x; asm volatile("" : "+v"(ts));
#pragma unroll
            for (int u = 0; u < 4; ++u) { const int idx = ts + NTHR * (ig * 4 + u), tok = idx / 192, pc = idx % 192, t = t0 + tok; const bf16_t* zp = P + (size_t)(r0 + tok) * NINP + C_Z + pc * 8;
                zc[u] = *(const lu4*)zp; zq[u] = t > 0 ? *(const lu4*)(zp - NINP) : (lu4){0u, 0u, 0u, 0u}; zn[u] = t < slen - 1 ? *(const lu4*)(zp + NINP) : (lu4){0u, 0u, 0u, 0u}; }
#pragma unroll
            for (int u = 0; u < 4; ++u) { const int idx = ts + NTHR * (ig * 4 + u), tok = idx / 192, pc = idx % 192, c0 = pc * 8, r = r0 + tok;
                float x[8], pv[8], nx[8], zs[8];
                unpack8(make_uint4(zc[u].x, zc[u].y, zc[u].z, zc[u].w), x); unpack8(make_uint4(zq[u].x, zq[u].y, zq[u].z, zq[u].w), pv); unpack8(make_uint4(zn[u].x, zn[u].y, zn[u].z, zn[u].w), nx);
                const float4 mu0 = *(const float4*)(p.in[20] + l * 1536 + c0), mu1 = *(const float4*)(p.in[20] + l * 1536 + c0 + 4); const float mu[8] = {mu0.x, mu0.y, mu0.z, mu0.w, mu1.x, mu1.y, mu1.z, mu1.w};
#pragma unroll
                for (int j = 0; j < 8; ++j) zs[j] = x[j] + (0.5f * (pv[j] + nx[j]) - x[j]) * mu[j];
                const bool isk = c0 >= 384 && c0 < 768; float kv[8]; float ss = 0.f;
                { const int kc = isk ? c0 - 384 : 0; const float4 k0 = *(const float4*)(p.in[26] + l * 384 + kc), k1 = *(const float4*)(p.in[26] + l * 384 + kc + 4); const float kkw[8] = {k0.x, k0.y, k0.z, k0.w, k1.x, k1.y, k1.z, k1.w};
#pragma unroll
                  for (int j = 0; j < 8; ++j) { kv[j] = zs[j] * kkw[j]; ss += kv[j] * kv[j]; } }
                ss += __shfl_xor(ss, 1); ss += __shfl_xor(ss, 2); ss += __shfl_xor(ss, 4);
                if (c0 < 384) *(uint4*)(RS + (size_t)r * 384 + c0) = pack8(zs);
                else if (c0 < 768) { *(uint4*)(KS + (size_t)r * 384 + c0 - 384) = pack8(zs); const float inv = 1.0f / fmaxf(sqrtf(ss), 1e-12f);
#pragma unroll
                    for (int j = 0; j < 8; ++j) kv[j] *= inv;
                    *(uint4*)(KK + (size_t)r * 384 + c0 - 384) = pack8(kv); }
                else if (c0 < 1152) *(uint4*)(VS + (size_t)r * 384 + c0 - 768) = pack8(zs);
                else { const int ac = c0 - 1152; float o[8];
#pragma unroll
                    for (int j = 0; j < 8; ++j) o[j] = ac < 128 ? 1.0f - 2.0f / (1.0f + __expf(2.0f * zs[j])) : (ac < 256 ? zs[j] : sigm(zs[j]));
                    *(uint4*)(ALR + (size_t)r * 384 + ac) = pack8(o); } }
        }
        __syncthreads();
    }
}

template <int KS, int MODE> __device__ __forceinline__ void lr_wave(const Params& p, int l, int row0, int kofs, const bf16_t* Bt, int d) {
    const int lane = threadIdx.x & 63, m = lane & 15, q = lane >> 4;
    const bf16_t* Ap = (const bf16_t*)(p.ws + U_ALR) + (size_t)(row0 + m) * 384 + kofs + q * 8;
    bf16x8 a[KS];
#pragma unroll
    for (int ks = 0; ks < KS; ++ks) a[ks] = *(const bf16x8*)(Ap + ks * 32);
    bf16_t* O = (bf16_t*)(p.ws + (MODE == 0 ? U_LD + (size_t)d * SZ384 : (MODE == 1 ? U_AG + (size_t)d * SZ384 : U_G))) + (size_t)(row0 + m) * 384;
    const float* bias = MODE == 0 ? p.in[21] + (l * 2 + d) * 384 : p.in[23] + (l * 2 + d) * 384;
    for (int nt = 0; nt < 24; ++nt) {
        f32x4 acc = (f32x4){0.f, 0.f, 0.f, 0.f};
#pragma unroll
        for (int ks = 0; ks < KS; ++ks) { const bf16x8 bfr = *(const bf16x8*)(Bt + (size_t)(nt * 16 + m) * (KS * 32) + ks * 32 + q * 8); acc = mfma16(bfr, a[ks], acc); }
        const int n = nt * 16 + q * 4; float o[4];
        if (MODE == 2) {
#pragma unroll
            for (int j = 0; j < 4; ++j) o[j] = acc[j];
        } else { const float4 bv = *(const float4*)(bias + n); const float bb[4] = {bv.x, bv.y, bv.z, bv.w};
#pragma unroll
            for (int j = 0; j < 4; ++j) { const float s = sigm(bb[j] + acc[j]); o[j] = MODE == 0 ? -0.6065306597f * s : s; } }
        u32x2 w; w.x = pack2(o[0], o[1]); w.y = pack2(o[2], o[3]); *(u32x2*)(O + n) = w;
    }
}
template <int KS, int MODE> __device__ __forceinline__ void lr_block(const Params& p, int l, const bf16_t* Bt, int kofs, int d, int bi, int nb, LAS unsigned char* lds) {
    constexpr int PITCH = KS * 32 + 8;
    LAS bf16_t* sB = (LAS bf16_t*)lds; LAS float* sbias = (LAS float*)(lds + 384 * PITCH * 2);
    const int tid = threadIdx.x, lane = tid & 63, m = lane & 15, q = lane >> 4, wv = tid >> 6;
    const float* bias = MODE == 0 ? p.in[21] + (l * 2 + d) * 384 : p.in[23] + (l * 2 + d) * 384;
    __syncthreads();
    for (int i = tid; i < 384 * KS * 4; i += NTHR) { const int n = i / (KS * 4), pc = i % (KS * 4); *(LAS lu4*)(sB + n * PITCH + pc * 8) = *(const lu4*)(Bt + (size_t)n * (KS * 32) + pc * 8); }
    if (MODE != 2) for (int i = tid; i < 384; i += NTHR) sbias[i] = bias[i];
    __syncthreads();
    bf16_t* Ob = (bf16_t*)(p.ws + (MODE == 0 ? U_LD + (size_t)d * SZ384 : (MODE == 1 ? U_AG + (size_t)d * SZ384 : U_G)));
    for (int rt = bi * 8 + wv; rt < 2304; rt += nb * 8) { const int row0 = rt * 16;
        const bf16_t* Ap = (const bf16_t*)(p.ws + U_ALR) + (size_t)(row0 + m) * 384 + kofs + q * 8;
        bf16x8 a[KS];
#pragma unroll
        for (int ks = 0; ks < KS; ++ks) a[ks] = *(const bf16x8*)(Ap + ks * 32);
        bf16_t* O = Ob + (size_t)(row0 + m) * 384;
#pragma unroll 4
        for (int nt = 0; nt < 24; ++nt) {
            f32x4 acc = (f32x4){0.f, 0.f, 0.f, 0.f};
#pragma unroll
            for (int ks = 0; ks < KS; ++ks) acc = mfma16(*(const LAS bf16x8*)(sB + (nt * 16 + m) * PITCH + ks * 32 + q * 8), a[ks], acc);
            const int n = nt * 16 + q * 4; float o[4];
            if (MODE == 2) {
#pragma unroll
                for (int j = 0; j < 4; ++j) o[j] = acc[j];
            } else { const lf4 bv = *(const LAS lf4*)(sbias + n); const float bb[4] = {bv.x, bv.y, bv.z, bv.w};
#pragma unroll
                for (int j = 0; j < 4; ++j) { const float sg = sigm(bb[j] + acc[j]); o[j] = MODE == 0 ? -0.6065306597f * sg : sg; } }
            u32x2 w; w.x = pack2(o[0], o[1]); w.y = pack2(o[2], o[3]); *(u32x2*)(O + n) = w;
        }
    }
    __syncthreads();
}
__device__ __forceinline__ void lowrank_items(const Params& p, int l, int wid, int nw, LAS unsigned char* lds) {
    const unsigned char* sw = p.ws + WS_SW + (size_t)l * SW_STRIDE; const int G = gridDim.x, bx = blockIdx.x;
    if (G >= 12) {
        const int sh = bx * 6 / G, mm = sh < 4 ? sh : 4; const int lo = (mm * G + 5) / 6, hi = mm < 4 ? ((mm + 1) * G + 5) / 6 : G, bi = bx - lo, nb = hi - lo;
        if (mm < 2) lr_block<2, 0>(p, l, (const bf16_t*)(sw + SW_W2T) + (size_t)mm * 384 * 64, mm * 64, mm, bi, nb, lds);
        else if (mm < 4) lr_block<2, 1>(p, l, (const bf16_t*)(sw + SW_A2T) + (size_t)(mm - 2) * 384 * 64, mm * 64, mm - 2, bi, nb, lds);
        else lr_block<4, 2>(p, l, (const bf16_t*)(sw + SW_G2T), 256, 0, bi, nb, lds);
        return; }
    for (int it = wid; it < 2304 * 5; it += nw) { const int rt = it / 5, m = it % 5, row0 = rt * 16;
        if (m < 2) lr_wave<2, 0>(p, l, row0, m * 64, (const bf16_t*)(sw + SW_W2T) + (size_t)m * 384 * 64, m);
        else if (m < 4) lr_wave<2, 1>(p, l, row0, m * 64, (const bf16_t*)(sw + SW_A2T) + (size_t)(m - 2) * 384 * 64, m - 2);
        else lr_wave<4, 2>(p, l, row0, 256, (const bf16_t*)(sw + SW_G2T), 0); }
}

__device__ __forceinline__ int s5_rowbase(int cr) { const int b = cr / 144, c = cr % 144; return c < 16 ? NLAT + b * 256 + c * 16 : b * 2048 + (c - 16) * 16; }
__device__ __forceinline__ void s5_pass1_items(const Params& p, int l, int wid, int nw) {
    const int lane = threadIdx.x & 63, m = lane & 15, q = lane >> 4;
    const bf16_t* P = (const bf16_t*)(p.ws + U_U16); float* SLOC = (float*)(p.ws + U_SLOC);
    for (int it = wid; it < 144 * 16; it += nw) { const int ct = it >> 4, g = it & 15, cr = ct * 16 + m, rb = s5_rowbase(cr);
        const bf16_t* E = (const bf16_t*)(p.ws + WS_SW + (size_t)l * SW_STRIDE + SW_S5E) + (size_t)g * 256 * 256;
        bf16x8 a[8];
#pragma unroll
        for (int ks = 0; ks < 8; ++ks) a[ks] = *(const bf16x8*)(P + (size_t)(rb + 2 * ks + (q >> 1)) * 256 + g * 16 + (q & 1) * 8);
        float* o = SLOC + ((size_t)cr * 16 + g) * 256 + q * 4;
#pragma unroll 2
        for (int nt = 0; nt < 16; ++nt) { f32x4 acc = (f32x4){0.f, 0.f, 0.f, 0.f}; const bf16_t* ep = E + (size_t)(nt * 16 + m) * 256 + q * 8;
#pragma unroll
            for (int ks = 0; ks < 8; ++ks) acc = mfma16(*(const bf16x8*)(ep + ks * 32), a[ks], acc);
            *(f32x4*)(o + nt * 16) = acc; }
    }
}
__device__ __forceinline__ void s5_pass1_block(const Params& p, int l, LAS unsigned char* lds) {
    constexpr int PITCH = 264;
    LAS bf16_t* sE = (LAS bf16_t*)lds;
    const int tid = threadIdx.x, lane = tid & 63, m = lane & 15, q = lane >> 4, wv = tid >> 6, G = gridDim.x, bx = blockIdx.x;
    const int combo = bx & 31, g = combo >> 1, half = combo & 1, bi = bx >> 5, nb = G >> 5;
    const bf16_t* E = (const bf16_t*)(p.ws + WS_SW + (size_t)l * SW_STRIDE + SW_S5E) + ((size_t)g * 256 + half * 128) * 256;
    const bf16_t* P = (const bf16_t*)(p.ws + U_U16); float* SLOC = (float*)(p.ws + U_SLOC);
    __syncthreads();
    for (int i = tid; i < 128 * 32; i += NTHR) { const int n = i >> 5, pc = i & 31; *(LAS lu4*)(sE + n * PITCH + pc * 8) = *(const lu4*)(E + (size_t)n * 256 + pc * 8); }
    __syncthreads();
    LAS unsigned char* eb = (LAS unsigned char*)(sE + m * PITCH + q * 8); asm volatile("" : "+v"(eb));
    for (int ct = bi * 8 + wv; ct < 144; ct += nb * 8) { const int cr = ct * 16 + m, rb = s5_rowbase(cr);
        bf16x8 a[8];
#pragma unroll
        for (int ks = 0; ks < 8; ++ks) a[ks] = *(const bf16x8*)(P + (size_t)(rb + 2 * ks + (q >> 1)) * 256 + g * 16 + (q & 1) * 8);
        float* o = SLOC + ((size_t)cr * 16 + g) * 256 + half * 128 + q * 4;
#pragma unroll 2
        for (int nt = 0; nt < 8; ++nt) { f32x4 acc = (f32x4){0.f, 0.f, 0.f, 0.f};
#pragma unroll
            for (int ks = 0; ks < 8; ++ks) acc = mfma16(*(const LAS bf16x8*)(eb + nt * 16 * PITCH * 2 + ks * 64), a[ks], acc);
            *(f32x4*)(o + nt * 16) = acc; } }
    __syncthreads();
}
__device__ __forceinline__ void s5_carry(const Params& p, int l) {
    const int gid = blockIdx.x * NTHR + threadIdx.x; if (gid >= 32768) return;
    const int pp = gid & 63, d = (gid >> 6) & 1, g = (gid >> 7) & 15, b = gid >> 11;
    const int li = ((l * 2 + d) * 16 + g) * 64 + pp; const float lr = p.in[9][li], lim = p.in[10][li], dt = expf(p.in[11][(l * 2 + d) * 16 + g]);
    const float mag = expf(16.0f * dt * lr); float sn, cn; sincosf(16.0f * dt * lim, &sn, &cn); const float ar = mag * cn, ai = mag * sn;
    const float* SLOC = (const float*)(p.ws + U_SLOC); bf16_t* SP = (bf16_t*)(p.ws + U_SPREV);
    float sr = 0.f, si = 0.f;
#pragma unroll 8
    for (int n = 0; n < 144; ++n) { const int c = d == 0 ? n : (n < 16 ? 15 - n : 159 - n); const size_t idx = ((size_t)(b * 144 + c) * 16 + g) * 256 + d * 128 + pp;
        SP[idx] = f2bf(sr); SP[idx + 64] = f2bf(si);
        const float xr = SLOC[idx], xi = SLOC[idx + 64]; const float nr = ar * sr - ai * si + xr, ni = ar * si + ai * sr + xi; sr = nr; si = ni; }
}
__device__ __forceinline__ void s5_pass2_items(const Params& p, int l, int wid, int nw) {
    const int lane = threadIdx.x & 63, m = lane & 15, q = lane >> 4;
    const bf16_t* P = (const bf16_t*)(p.ws + U_U16); const bf16_t* SP = (const bf16_t*)(p.ws + U_SPREV); bf16_t* YG = (bf16_t*)(p.ws + U_YG);
    for (int it = wid; it < 144 * 16; it += nw) { const int ct = it >> 4, g = it & 15; if (l == 1 && ct % 9 == 0) continue;
        const int cr = ct * 16 + m, rb = s5_rowbase(cr);
        const bf16_t* W2 = (const bf16_t*)(p.ws + WS_SW + (size_t)l * SW_STRIDE + SW_S5W2) + (size_t)g * 256 * 512;
        bf16x8 a[16];
#pragma unroll
        for (int ks = 0; ks < 8; ++ks) a[ks] = *(const bf16x8*)(P + (size_t)(rb + 2 * ks + (q >> 1)) * 256 + g * 16 + (q & 1) * 8);
#pragma unroll
        for (int ks = 8; ks < 16; ++ks) a[ks] = *(const bf16x8*)(SP + ((size_t)cr * 16 + g) * 256 + (ks - 8) * 32 + q * 8);
#pragma unroll 2
        for (int nt = 0; nt < 16; ++nt) { f32x4 acc = (f32x4){0.f, 0.f, 0.f, 0.f}; const bf16_t* wp = W2 + (size_t)(nt * 16 + m) * 512 + q * 8;
#pragma unroll
            for (int ks = 0; ks < 16; ++ks) acc = mfma16(*(const bf16x8*)(wp + ks * 32), a[ks], acc);
            float o[4];
#pragma unroll
            for (int j = 0; j < 4; ++j) { const float x = acc[j]; const float u = 0.7978845608f * (x + 0.044715f * x * x * x); const float th = 1.0f - 2.0f / (1.0f + __expf(2.0f * u)); o[j] = 0.5f * x * (1.0f + th); }
            u32x2 w; w.x = pack2(o[0], o[1]); w.y = pack2(o[2], o[3]); *(u32x2*)(YG + (size_t)(rb + nt) * 256 + g * 16 + q * 4) = w; }
    }
}
__device__ __forceinline__ void s5_pass2_block(const Params& p, int l, int vb, int nvb, LAS unsigned char* lds) {
    constexpr int PITCH = 520;
    LAS bf16_t* sW = (LAS bf16_t*)lds;
    const int tid = threadIdx.x, lane = tid & 63, m = lane & 15, q = lane >> 4, wv = tid >> 6;
    const bf16_t* P = (const bf16_t*)(p.ws + U_U16); const bf16_t* SP = (const bf16_t*)(p.ws + U_SPREV); bf16_t* YG = (bf16_t*)(p.ws + U_YG);
    if ((nvb & 63) != 0) { s5_pass2_items(p, l, vb * 8 + wv, nvb * 8); return; }
    { const int combo = vb & 63, g = combo >> 2, qd = combo & 3, bi = vb >> 6, nb = nvb >> 6;
        const bf16_t* W2 = (const bf16_t*)(p.ws + WS_SW + (size_t)l * SW_STRIDE + SW_S5W2) + ((size_t)g * 256 + qd * 64) * 512;
        __syncthreads();
        for (int i = tid; i < 64 * 64; i += NTHR) { const int n = i >> 6, pc = i & 63; *(LAS lu4*)(sW + n * PITCH + pc * 8) = *(const lu4*)(W2 + (size_t)n * 512 + pc * 8); }
        __syncthreads();
        LAS unsigned char* wb = (LAS unsigned char*)(sW + m * PITCH + q * 8); asm volatile("" : "+v"(wb));
        for (int ct = bi * 8 + wv; ct < 144; ct += nb * 8) { if (l == 1 && ct % 9 == 0) continue;
            const int cr = ct * 16 + m, rb = s5_rowbase(cr);
            bf16x8 a[16];
#pragma unroll
            for (int ks = 0; ks < 8; ++ks) a[ks] = *(const bf16x8*)(P + (size_t)(rb + 2 * ks + (q >> 1)) * 256 + g * 16 + (q & 1) * 8);
#pragma unroll
            for (int ks = 8; ks < 16; ++ks) a[ks] = *(const bf16x8*)(SP + ((size_t)cr * 16 + g) * 256 + (ks - 8) * 32 + q * 8);
#pragma unroll 1
            for (int nt = 0; nt < 4; ++nt) { f32x4 acc = (f32x4){0.f, 0.f, 0.f, 0.f};
#pragma unroll
                for (int ks = 0; ks < 16; ++ks) acc = mfma16(*(const LAS bf16x8*)(wb + nt * 16 * PITCH * 2 + ks * 64), a[ks], acc);
                float o[4];
#pragma unroll
                for (int j = 0; j < 4; ++j) { const float x = acc[j]; const float u = 0.7978845608f * (x + 0.044715f * x * x * x); const float th = 1.0f - 2.0f / (1.0f + __expf(2.0f * u)); o[j] = 0.5f * x * (1.0f + th); }
                u32x2 w; w.x = pack2(o[0], o[1]); w.y = pack2(o[2], o[3]); *(u32x2*)(YG + (size_t)(rb + qd * 4 + nt) * 256 + g * 16 + q * 4) = w; } }
    }
    __syncthreads();
}
__device__ __forceinline__ void s5_glu_items(const Params& p, int l, int wid, int nw) {
    const int lane = threadIdx.x & 63, m = lane & 15, q = lane >> 4;
    const bf16_t* YG = (const bf16_t*)(p.ws + U_YG); bf16_t* YC = (bf16_t*)(p.ws + WS_ABUF);
    const bf16_t* GT = (const bf16_t*)(p.ws + WS_SW + (size_t)l * SW_STRIDE + SW_GLUT);
    const int nrt = (l == 0 ? NROW : NLAT) / 16;
    for (int rt = wid; rt < nrt; rt += nw) { const int row = rt * 16 + m;
        bf16x8 a[8];
#pragma unroll
        for (int ks = 0; ks < 8; ++ks) a[ks] = *(const bf16x8*)(YG + (size_t)row * 256 + ks * 32 + q * 8);
#pragma unroll 2
        for (int nt = 0; nt < 16; ++nt) { f32x4 acc = (f32x4){0.f, 0.f, 0.f, 0.f}; const bf16_t* gp = GT + (size_t)(nt * 16 + m) * 256 + q * 8;
#pragma unroll
            for (int ks = 0; ks < 8; ++ks) acc = mfma16(*(const bf16x8*)(gp + ks * 32), a[ks], acc);
            const int n = nt * 16 + q * 4; const float4 bv = *(const float4*)(p.in[18] + l * 256 + n); const u32x2 yw = *(const u32x2*)(YG + (size_t)row * 256 + n);
            u32x2 w; w.x = pack2(bflo(yw.x) * sigm(acc[0] + bv.x), bfhi(yw.x) * sigm(acc[1] + bv.y)); w.y = pack2(bflo(yw.y) * sigm(acc[2] + bv.z), bfhi(yw.y) * sigm(acc[3] + bv.w));
            *(u32x2*)(YC + (size_t)row * 1024 + n) = w; }
    }
}

__device__ __forceinline__ void s5_glu_block(const Params& p, int l, int vb, int nvb, LAS unsigned char* lds) {
    constexpr int PITCH = 264;
    LAS bf16_t* sG = (LAS bf16_t*)lds;
    const int tid = threadIdx.x, lane = tid & 63, m = lane & 15, q = lane >> 4, wv = tid >> 6;
    if (nvb < 2 || (nvb & 1)) { s5_glu_items(p, l, vb * 8 + wv, nvb * 8); return; }
    const int half = vb & 1, bi = vb >> 1, nb = nvb >> 1;
    const bf16_t* YG = (const bf16_t*)(p.ws + U_YG); bf16_t* YC = (bf16_t*)(p.ws + WS_ABUF);
    const bf16_t* GT = (const bf16_t*)(p.ws + WS_SW + (size_t)l * SW_STRIDE + SW_GLUT) + (size_t)half * 128 * 256;
    __syncthreads();
    for (int i = tid; i < 128 * 32; i += NTHR) { const int n = i >> 5, pc = i & 31; *(LAS lu4*)(sG + n * PITCH + pc * 8) = *(const lu4*)(GT + (size_t)n * 256 + pc * 8); }
    __syncthreads();
    LAS unsigned char* gb = (LAS unsigned char*)(sG + m * PITCH + q * 8); asm volatile("" : "+v"(gb));
    const int nrt = (l == 0 ? NROW : NLAT) / 16;
    for (int rt = bi * 8 + wv; rt < nrt; rt += nb * 8) { const int row = rt * 16 + m;
        bf16x8 a[8];
#pragma unroll
        for (int ks = 0; ks < 8; ++ks) a[ks] = *(const bf16x8*)(YG + (size_t)row * 256 + ks * 32 + q * 8);
#pragma unroll 2
        for (int nt = 0; nt < 8; ++nt) { f32x4 acc = (f32x4){0.f, 0.f, 0.f, 0.f};
#pragma unroll
            for (int ks = 0; ks < 8; ++ks) acc = mfma16(*(const LAS bf16x8*)(gb + nt * 16 * PITCH * 2 + ks * 64), a[ks], acc);
            const int n = half * 128 + nt * 16 + q * 4; const float4 bv = *(const float4*)(p.in[18] + l * 256 + n); const u32x2 yw = *(const u32x2*)(YG + (size_t)row * 256 + n);
            u32x2 w; w.x = pack2(bflo(yw.x) * sigm(acc[0] + bv.x), bfhi(yw.x) * sigm(acc[1] + bv.y)); w.y = pack2(bflo(yw.y) * sigm(acc[2] + bv.z), bfhi(yw.y) * sigm(acc[3] + bv.w));
            *(u32x2*)(YC + (size_t)row * 1024 + n) = w; } }
    __syncthreads();
}

template <bool HASLAT> __device__ __forceinline__ void na_unit(const Params& p, const LAS float* rpb_l, int b, int h, int i, int n) {
    const int lane = threadIdx.x & 63, m = lane & 15, q = lane >> 4, kin = 8 * (m >> 2) + (m & 3);
    const bf16_t* QR = (const bf16_t*)(p.ws + U_QR); const bf16_t* KR = (const bf16_t*)(p.ws + U_KR);
    const bf16_t* VTL = (const bf16_t*)(p.ws + U_VT) + (size_t)(b * 6 + h) * 64 * 2048; const bf16_t* VTC = (const bf16_t*)(p.ws + U_VTC) + (size_t)(b * 6 + h) * 64 * 256;
    const int qrow = HASLAT ? b * 2048 + i * 64 + n * 16 + m : NLAT + b * 256 + n * 16 + m;
    bf16x8 qf[2];
#pragma unroll
    for (int ks = 0; ks < 2; ++ks) qf[ks] = *(const bf16x8*)(QR + (size_t)qrow * 384 + h * 64 + ks * 32 + q * 8);
    const int r0 = HASLAT ? min(max(i - 4, 0), 24) : 0, scol = HASLAT ? min(max(n * 16 - 8, 0), 32) : 0;
    f32x4 sl[HASLAT ? 16 : 1], sc[16];
    float mx = -3.0e38f;
    if (HASLAT) { const int qc = n * 16 + m, c0 = min(max(qc - 8, 0), 48); const LAS float* rpb = rpb_l + h * 15 * 31;
#pragma unroll
        for (int t = 0; t < 16; ++t) { const int kr = t >> 1, ch = t & 1; const bf16_t* kp = KR + (size_t)(b * 2048 + (r0 + kr) * 64 + scol + kin + 4 * ch) * 384 + h * 64 + q * 8;
            f32x4 acc = (f32x4){0.f, 0.f, 0.f, 0.f};
#pragma unroll
            for (int ks = 0; ks < 2; ++ks) acc = mfma16(*(const bf16x8*)(kp + ks * 32), qf[ks], acc);
            const int dr = r0 + kr - i + 7;
#pragma unroll
            for (int j = 0; j < 4; ++j) { const int kc = scol + 8 * q + 4 * ch + j; const bool valid = kc >= c0 && kc < c0 + 16; const int dc = min(max(kc - qc + 15, 0), 30);
                const float s = valid ? acc[j] + rpb[dr * 31 + dc] : -1.0e30f; acc[j] = s; mx = fmaxf(mx, s); }
            sl[t] = acc; if ((t & 7) == 7) __builtin_amdgcn_sched_barrier(0); } }
#pragma unroll
    for (int t = 0; t < 16; ++t) { const bf16_t* kp = KR + (size_t)(NLAT + b * 256 + (t >> 1) * 32 + kin + 4 * (t & 1)) * 384 + h * 64 + q * 8;
        f32x4 acc = (f32x4){0.f, 0.f, 0.f, 0.f};
#pragma unroll
        for (int ks = 0; ks < 2; ++ks) acc = mfma16(*(const bf16x8*)(kp + ks * 32), qf[ks], acc);
#pragma unroll
        for (int j = 0; j < 4; ++j) mx = fmaxf(mx, acc[j]);
        sc[t] = acc; }
    mx = fmaxf(mx, __shfl_xor(mx, 16)); mx = fmaxf(mx, __shfl_xor(mx, 32));
    float sum = 0.f;
    f32x4 o[4];
#pragma unroll
    for (int dt = 0; dt < 4; ++dt) o[dt] = (f32x4){0.f, 0.f, 0.f, 0.f};
    if (HASLAT) {
#pragma unroll
        for (int kr = 0; kr < 8; ++kr) { float e[8];
#pragma unroll
            for (int j = 0; j < 4; ++j) { e[j] = __expf(sl[2 * kr][j] - mx); e[4 + j] = __expf(sl[2 * kr + 1][j] - mx); }
#pragma unroll
            for (int j = 0; j < 8; ++j) sum += e[j];
            const uint4 pw = pack8(e); const bf16x8 pf = __builtin_bit_cast(bf16x8, pw);
            const int tok = (r0 + kr) * 64 + scol + q * 8;
#pragma unroll
            for (int dt = 0; dt < 4; ++dt) o[dt] = mfma16(*(const bf16x8*)(VTL + (size_t)(dt * 16 + m) * 2048 + tok), pf, o[dt]);
            if (kr & 1) __builtin_amdgcn_sched_barrier(0); } }
#pragma unroll
    for (int t2 = 0; t2 < 8; ++t2) { float e[8];
#pragma unroll
        for (int j = 0; j < 4; ++j) { e[j] = __expf(sc[2 * t2][j] - mx); e[4 + j] = __expf(sc[2 * t2 + 1][j] - mx); }
#pragma unroll
        for (int j = 0; j < 8; ++j) sum += e[j];
        const uint4 pw = pack8(e); const bf16x8 pf = __builtin_bit_cast(bf16x8, pw);
        const int tok = t2 * 32 + q * 8;
#pragma unroll
        for (int dt = 0; dt < 4; ++dt) o[dt] = mfma16(*(const bf16x8*)(VTC + (size_t)(dt * 16 + m) * 256 + tok), pf, o[dt]);
        if (t2 & 1) __builtin_amdgcn_sched_barrier(0); }
    sum += __shfl_xor(sum, 16); sum += __shfl_xor(sum, 32);
    const float inv = 1.0f / sum;
    bf16_t* yo = (bf16_t*)(p.ws + WS_ABUF) + (size_t)qrow * 1024 + 256 + h * 64 + q * 4;
#pragma unroll
    for (int dt = 0; dt < 4; ++dt) { u32x2 w; w.x = pack2(o[dt][0] * inv, o[dt][1] * inv); w.y = pack2(o[dt][2] * inv, o[dt][3] * inv); *(u32x2*)(yo + dt * 16) = w; }
}
template <bool HASLAT> __device__ __forceinline__ void na_block(const Params& p, int l, int b, int h, int sel, LAS unsigned char* lds) {
    LAS bf16_t* Ks = (LAS bf16_t*)lds;
    LAS bf16_t* Vs = (LAS bf16_t*)lds;
    LAS float* rp = (LAS float*)(lds + 120064);
    const int tid = threadIdx.x, lane = tid & 63, m = lane & 15, q = lane >> 4, w = tid >> 6, kin = 8 * (m >> 2) + (m & 3);
    const bf16_t* QR = (const bf16_t*)(p.ws + U_QR); const bf16_t* KR = (const bf16_t*)(p.ws + U_KR);
    const bf16_t* VTL = (const bf16_t*)(p.ws + U_VT) + (size_t)(b * 6 + h) * 64 * 2048; const bf16_t* VTC = (const bf16_t*)(p.ws + U_VTC) + (size_t)(b * 6 + h) * 64 * 256;
    const int i0 = HASLAT ? 2 * sel : 0, rlo = HASLAT ? min(max(i0 - 4, 0), 24) : 0;
    __syncthreads();
    int tk = threadIdx.x; asm volatile("" : "+v"(tk));
    if (HASLAT) {
#pragma unroll
        for (int j = 0; j < 9; ++j) { const int idx = tk + NTHR * j, key = idx >> 3, pc = idx & 7, tok = rlo * 64 + key;
            if (tok < 2048) *(LAS lu4*)(Ks + key * 72 + pc * 8) = *(const lu4*)(KR + (size_t)(b * 2048 + tok) * 384 + h * 64 + pc * 8); }
        for (int j = tk; j < 465; j += NTHR) rp[j] = p.in[19][(size_t)(l * 6 + h) * 465 + j]; }
#pragma unroll
    for (int j = 0; j < 4; ++j) { const int idx = tk + NTHR * j, key = idx >> 3, pc = idx & 7;
        *(LAS lu4*)(Ks + (576 + key) * 72 + pc * 8) = *(const lu4*)(KR + (size_t)(NLAT + b * 256 + key) * 384 + h * 64 + pc * 8); }
    const int i = HASLAT ? i0 + (w >> 2) : 0, n = HASLAT ? (w & 3) : sel * 8 + w;
    const int qrow = HASLAT ? b * 2048 + i * 64 + n * 16 + m : NLAT + b * 256 + n * 16 + m;
    bf16x8 qf[2];
#pragma unroll
    for (int ks = 0; ks < 2; ++ks) qf[ks] = *(const bf16x8*)(QR + (size_t)qrow * 384 + h * 64 + ks * 32 + q * 8);
    const int r0 = HASLAT ? min(max(i - 4, 0), 24) : 0, scol = HASLAT ? min(max(n * 16 - 8, 0), 32) : 0, kb = (r0 - rlo) * 64 + scol;
    LAS unsigned char* kbl = (LAS unsigned char*)(Ks + (kb + kin) * 72 + q * 8); LAS unsigned char* kbc = (LAS unsigned char*)(Ks + (576 + kin) * 72 + q * 8);
    LAS unsigned char* vb0 = (LAS unsigned char*)(Vs + (0 * 16 + m) * 840 + q * 8); LAS unsigned char* vb1 = (LAS unsigned char*)(Vs + (1 * 16 + m) * 840 + q * 8);
    LAS unsigned char* vb2 = (LAS unsigned char*)(Vs + (2 * 16 + m) * 840 + q * 8); LAS unsigned char* vb3 = (LAS unsigned char*)(Vs + (3 * 16 + m) * 840 + q * 8);
    asm volatile("" : "+v"(kbl), "+v"(kbc), "+v"(vb0), "+v"(vb1), "+v"(vb2), "+v"(vb3));
    __syncthreads();
    float mx1 = -3.0e38f, mx2 = -3.0e38f, sum1 = 0.f, sum2 = 0.f;
    bf16x8 pl[HASLAT ? 8 : 1], pcx[8];
    if (HASLAT) { const int qc = n * 16 + m, c0 = min(max(qc - 8, 0), 48); f32x4 sl[16];
#pragma unroll
        for (int t = 0; t < 16; ++t) { const int kr = t >> 1, ch = t & 1; const LAS bf16_t* kp = (const LAS bf16_t*)(kbl + (kr * 64 + 4 * ch) * 144);
            f32x4 acc = (f32x4){0.f, 0.f, 0.f, 0.f};
#pragma unroll
            for (int ks = 0; ks < 2; ++ks) acc = mfma16(*(const LAS bf16x8*)(kp + ks * 32), qf[ks], acc);
            const int dr = r0 + kr - i + 7;
#pragma unroll
            for (int j = 0; j < 4; ++j) { const int kc = scol + 8 * q + 4 * ch + j; const bool valid = kc >= c0 && kc < c0 + 16; const int dc = min(max(kc - qc + 15, 0), 30);
                const float sv = valid ? acc[j] + rp[dr * 31 + dc] : -1.0e30f; acc[j] = sv; mx1 = fmaxf(mx1, sv); }
            sl[t] = acc; if ((t & 3) == 3) __builtin_amdgcn_sched_barrier(0); }
        mx1 = fmaxf(mx1, __shfl_xor(mx1, 16)); mx1 = fmaxf(mx1, __shfl_xor(mx1, 32));
#pragma unroll
        for (int kr = 0; kr < 8; ++kr) { float e[8];
#pragma unroll
            for (int j = 0; j < 4; ++j) { e[j] = __expf(sl[2 * kr][j] - mx1); e[4 + j] = __expf(sl[2 * kr + 1][j] - mx1); }
#pragma unroll
            for (int j = 0; j < 8; ++j) sum1 += e[j];
            const uint4 pw = pack8(e); pl[kr] = __builtin_bit_cast(bf16x8, pw); }
        __builtin_amdgcn_sched_barrier(0); }
    { f32x4 sc[16];
#pragma unroll
      for (int t = 0; t < 16; ++t) { const LAS bf16_t* kp = (const LAS bf16_t*)(kbc + ((t >> 1) * 32 + 4 * (t & 1)) * 144);
          f32x4 acc = (f32x4){0.f, 0.f, 0.f, 0.f};
#pragma unroll
          for (int ks = 0; ks < 2; ++ks) acc = mfma16(*(const LAS bf16x8*)(kp + ks * 32), qf[ks], acc);
#pragma unroll
          for (int j = 0; j < 4; ++j) mx2 = fmaxf(mx2, acc[j]);
          sc[t] = acc; if ((t & 3) == 3) __builtin_amdgcn_sched_barrier(0); }
      mx2 = fmaxf(mx2, __shfl_xor(mx2, 16)); mx2 = fmaxf(mx2, __shfl_xor(mx2, 32));
#pragma unroll
      for (int t2 = 0; t2 < 8; ++t2) { float e[8];
#pragma unroll
          for (int j = 0; j < 4; ++j) { e[j] = __expf(sc[2 * t2][j] - mx2); e[4 + j] = __expf(sc[2 * t2 + 1][j] - mx2); }
#pragma unroll
          for (int j = 0; j < 8; ++j) sum2 += e[j];
          const uint4 pw = pack8(e); pcx[t2] = __builtin_bit_cast(bf16x8, pw); } }
    sum1 += __shfl_xor(sum1, 16); sum1 += __shfl_xor(sum1, 32); sum2 += __shfl_xor(sum2, 16); sum2 += __shfl_xor(sum2, 32);
    __builtin_amdgcn_sched_barrier(0);
    __syncthreads();
    int tv = threadIdx.x; asm volatile("" : "+v"(tv));
    if (HASLAT) {
#pragma unroll
        for (int j = 0; j < 9; ++j) { const int idx = tv + NTHR * j, dim = idx / 72, pc = idx % 72, tok = rlo * 64 + pc * 8;
            if (tok < 2048) *(LAS lu4*)(Vs + dim * 840 + pc * 8) = *(const lu4*)(VTL + (size_t)dim * 2048 + tok); } }
#pragma unroll
    for (int j = 0; j < 4; ++j) { const int idx = tv + NTHR * j, dim = idx >> 5, pc = idx & 31; *(LAS lu4*)(Vs + dim * 840 + 576 + pc * 8) = *(const lu4*)(VTC + (size_t)dim * 256 + pc * 8); }
    __syncthreads();
    const int kbv = kb * 2;
    f32x4 o1[4], o2[4];
#pragma unroll
    for (int dt = 0; dt < 4; ++dt) { o1[dt] = (f32x4){0.f, 0.f, 0.f, 0.f}; o2[dt] = (f32x4){0.f, 0.f, 0.f, 0.f}; }
    if (HASLAT) {
#pragma unroll
        for (int kr = 0; kr < 8; ++kr) {
#pragma unroll
            for (int dt = 0; dt < 4; ++dt) { LAS unsigned char* vb = dt == 0 ? vb0 : dt == 1 ? vb1 : dt == 2 ? vb2 : vb3; o1[dt] = mfma16(*(const LAS bf16x8*)(vb + kbv + kr * 128), pl[kr], o1[dt]); }
            if (kr & 1) __builtin_amdgcn_sched_barrier(0); } }
#pragma unroll
    for (int t2 = 0; t2 < 8; ++t2) {
#pragma unroll
        for (int dt = 0; dt < 4; ++dt) { LAS unsigned char* vb = dt == 0 ? vb0 : dt == 1 ? vb1 : dt == 2 ? vb2 : vb3; o2[dt] = mfma16(*(const LAS bf16x8*)(vb + 1152 + t2 * 64), pcx[t2], o2[dt]); }
        if (t2 & 1) __builtin_amdgcn_sched_barrier(0); }
    const float mxm = fmaxf(mx1, mx2), a1 = HASLAT ? __expf(mx1 - mxm) : 0.f, a2 = __expf(mx2 - mxm), inv = 1.0f / (a1 * sum1 + a2 * sum2), c1 = a1 * inv, c2 = a2 * inv;
    bf16_t* yo = (bf16_t*)(p.ws + WS_ABUF) + (size_t)qrow * 1024 + 256 + h * 64 + q * 4;
#pragma unroll
    for (int dt = 0; dt < 4; ++dt) { u32x2 wv2; wv2.x = pack2(o1[dt][0] * c1 + o2[dt][0] * c2, o1[dt][1] * c1 + o2[dt][1] * c2); wv2.y = pack2(o1[dt][2] * c1 + o2[dt][2] * c2, o1[dt][3] * c1 + o2[dt][3] * c2); *(u32x2*)(yo + dt * 16) = wv2; }
}
__device__ __forceinline__ void na_items(const Params& p, int l, int wid, int nw, LAS unsigned char* lds) {
    (void)wid; (void)nw;
    const int nlat = 16 * 6 * 16, nctx = (l == 0) ? 16 * 6 * 2 : 0;
    for (int it = blockIdx.x; it < nlat + nctx; it += gridDim.x) {
        if (it < nlat) { const int ip = it & 15, bh = it >> 4; na_block<true>(p, l, bh / 6, bh % 6, ip, lds); }
        else { const int j = it - nlat, half = j & 1, bh = j >> 1; na_block<false>(p, l, bh / 6, bh % 6, half, lds); }
    }
    __syncthreads();
}

typedef float f32x2 __attribute__((ext_vector_type(2)));
__device__ __forceinline__ int rk_row(int b, int d, int n) { return n < 256 ? NLAT + b * 256 + (d ? 255 - n : n) : b * 2048 + (d ? 2047 - (n - 256) : (n - 256)); }
template <int CTRL> __device__ __forceinline__ float dpp_f(float v) { return __builtin_bit_cast(float, __builtin_amdgcn_update_dpp(0, __builtin_bit_cast(int, v), CTRL, 0xF, 0xF, true)); }
constexpr int RKP_PITCH = 72, RKP_MAT = 16 * RKP_PITCH * 2, RKP_WAVE = 5 * RKP_MAT + 4 * 16 * 17 * 4;
__device__ __forceinline__ bf16x8 pack_frag(const float (&lo)[4], const float (&hi)[4]) { u32x4 w; w.x = pack2(lo[0], lo[1]); w.y = pack2(lo[2], lo[3]); w.z = pack2(hi[0], hi[1]); w.w = pack2(hi[2], hi[3]); return __builtin_bit_cast(bf16x8, w); }
__device__ __forceinline__ void rwkv_pre_items(const Params& p, int l, int wid, int nw, LAS unsigned char* lds) {
    const int lane = threadIdx.x & 63, m = lane & 15, q = lane >> 4, wv = threadIdx.x >> 6;
    LAS bf16_t* sAt = (LAS bf16_t*)(lds + wv * RKP_WAVE); LAS bf16_t* sBh = sAt + 16 * RKP_PITCH; LAS bf16_t* sKh = sBh + 16 * RKP_PITCH; LAS bf16_t* sRt = sKh + 16 * RKP_PITCH; LAS bf16_t* sV = sRt + 16 * RKP_PITCH;
    LAS float* sM = (LAS float*)(lds + wv * RKP_WAVE + 5 * RKP_MAT);
    const bf16_t* RS = (const bf16_t*)(p.ws + U_RS); const bf16_t* KS = (const bf16_t*)(p.ws + U_KS); const bf16_t* VS = (const bf16_t*)(p.ws + U_VS); const bf16_t* KK = (const bf16_t*)(p.ws + U_KK);
    for (int it = wid; it < NCHUNK; it += nw) { const int u = it / 144, c = it % 144, b = u / 12, h = (u % 12) >> 1, d = u & 1;
        const bf16_t* AG = (const bf16_t*)(p.ws + U_AG + (size_t)d * SZ384); const bf16_t* LD = (const bf16_t*)(p.ws + U_LD + (size_t)d * SZ384);
        const int rb = rk_row(b, d, c * 16), sgn = d ? -1 : 1;
#ifndef PRE_DUP
#define PRE_DUP 0
#endif
        for (int rp1 = 0; rp1 < (PRE_DUP == 1 ? 2 : 1); ++rp1) {
        { LAS bf16_t* sLd = (LAS bf16_t*)sM; lu4 raw[12];
#pragma unroll
          for (int k = 0; k < 12; ++k) { const int idx = lane + 64 * k, pair = idx >> 3, arr = pair >> 4, t = pair & 15, pc = idx & 7;
              const bf16_t* src = arr == 0 ? KK : arr == 1 ? AG : arr == 2 ? KS : arr == 3 ? RS : arr == 4 ? VS : LD;
              raw[k] = *(const lu4*)(src + (size_t)(rb + sgn * t) * 384 + h * 64 + pc * 8); }
          __builtin_amdgcn_sched_barrier(0);
#pragma unroll
          for (int k = 0; k < 12; ++k) { const int idx = lane + 64 * k, pair = idx >> 3, arr = pair >> 4, t = pair & 15, pc = idx & 7;
              LAS bf16_t* dst = arr == 0 ? sAt : arr == 1 ? sBh : arr == 2 ? sKh : arr == 3 ? sRt : arr == 4 ? sV : sLd;
              *(LAS lu4*)(dst + t * RKP_PITCH + pc * 8) = raw[k]; }
          const float ka = p.in[27][l * 384 + h * 64 + lane]; float L = 0.f;
#pragma unroll 4
          for (int t = 0; t < 16; ++t) { const int o = t * RKP_PITCH + lane;
              const float r_ = bf2f(sRt[o]), k_ = bf2f(sKh[o]), kk_ = bf2f(sAt[o]), ag_ = bf2f(sBh[o]), ld_ = bf2f(sLd[o]);
              const float e0 = __expf(L); L += ld_; const float e1 = __expf(L), ei = __expf(-L);
              sAt[o] = f2bf(-kk_ * e0); sBh[o] = f2bf(kk_ * ag_ * ei); sKh[o] = f2bf(k_ * (1.0f + (ag_ - 1.0f) * ka) * ei); sRt[o] = f2bf(r_ * e1); }
          ((bf16_t*)(p.ws + CH_GT))[(size_t)it * 64 + lane] = f2bf(L); }
        }
        for (int rp2 = 0; rp2 < (PRE_DUP == 2 ? 2 : 1); ++rp2) {
        { bf16x8 atf[2], rtf[2], bhf[2], khf[2];
#pragma unroll
          for (int ks = 0; ks < 2; ++ks) { atf[ks] = *(const LAS bf16x8*)(sAt + m * RKP_PITCH + ks * 32 + q * 8); rtf[ks] = *(const LAS bf16x8*)(sRt + m * RKP_PITCH + ks * 32 + q * 8);
              bhf[ks] = *(const LAS bf16x8*)(sBh + m * RKP_PITCH + ks * 32 + q * 8); khf[ks] = *(const LAS bf16x8*)(sKh + m * RKP_PITCH + ks * 32 + q * 8); }
          f32x4 mab = (f32x4){0.f, 0.f, 0.f, 0.f}, mak = mab, mrb = mab, mrk = mab;
#pragma unroll
          for (int ks = 0; ks < 2; ++ks) { mab = mfma16(atf[ks], bhf[ks], mab); mak = mfma16(atf[ks], khf[ks], mak); mrb = mfma16(rtf[ks], bhf[ks], mrb); mrk = mfma16(rtf[ks], khf[ks], mrk); }
#pragma unroll
          for (int r = 0; r < 4; ++r) { const int t = 4 * q + r; sM[(0 * 16 + t) * 17 + m] = m < t ? mab[r] : 0.f; sM[(1 * 16 + t) * 17 + m] = m < t ? mak[r] : 0.f;
              sM[(2 * 16 + t) * 17 + m] = m <= t ? mrb[r] : 0.f; sM[(3 * 16 + t) * 17 + m] = m <= t ? mrk[r] : 0.f; } }
        { float tv[16];
#pragma unroll
          for (int t = 0; t < 16; ++t) { float acc = (m == t) ? 1.0f : 0.0f;
#pragma unroll
              for (int s2 = 0; s2 < t; ++s2) acc += sM[t * 17 + s2] * tv[s2];
              tv[t] = acc; }
#pragma unroll
          for (int t = 0; t < 16; ++t) if (q == 0) sM[t * 17 + m] = tv[t]; }
        }
        bf16x8 tinvf, mrbf;
        { float lo[4], hi[4] = {0.f, 0.f, 0.f, 0.f};
#pragma unroll
          for (int j = 0; j < 4; ++j) lo[j] = sM[(0 * 16 + m) * 17 + 4 * q + j];
          tinvf = pack_frag(lo, hi);
#pragma unroll
          for (int j = 0; j < 4; ++j) lo[j] = sM[(2 * 16 + m) * 17 + 4 * q + j];
          mrbf = pack_frag(lo, hi);
#pragma unroll
          for (int j = 0; j < 4; ++j) hi[j] = sM[(3 * 16 + m) * 17 + 4 * q + j];
          *(bf16x8*)((bf16_t*)(p.ws + CH_MM) + ((size_t)it * 64 + lane) * 8) = pack_frag(lo, hi); }
        for (int rp3 = 0; rp3 < (PRE_DUP == 3 ? 2 : 1); ++rp3) {
        { bf16x8 makf; { float lo[4], hi[4];
#pragma unroll
            for (int j = 0; j < 4; ++j) { lo[j] = q < 2 ? sM[(1 * 16 + m) * 17 + 8 * q + j] : 0.f; hi[j] = q < 2 ? sM[(1 * 16 + m) * 17 + 8 * q + 4 + j] : 0.f; }
            makf = pack_frag(lo, hi); }
#pragma unroll
          for (int itile = 0; itile < 4; ++itile) { unsigned vw[4];
#pragma unroll
              for (int j = 0; j < 4; ++j) vw[j] = q < 2 ? ((unsigned)sV[(8 * q + 2 * j) * RKP_PITCH + 16 * itile + m] | ((unsigned)sV[(8 * q + 2 * j + 1) * RKP_PITCH + 16 * itile + m] << 16)) : 0u;
              const u32x4 vq = {vw[0], vw[1], vw[2], vw[3]};
              const f32x4 w1 = mfma16(makf, __builtin_bit_cast(bf16x8, vq), (f32x4){0.f, 0.f, 0.f, 0.f});
              const float lo[4] = {w1[0], w1[1], w1[2], w1[3]}, hi[4] = {0.f, 0.f, 0.f, 0.f};
              const f32x4 uu = mfma16(tinvf, pack_frag(lo, hi), (f32x4){0.f, 0.f, 0.f, 0.f});
              u32x2 o; o.x = pack2(uu[0], uu[1]); o.y = pack2(uu[2], uu[3]);
              *(u32x2*)((bf16_t*)(p.ws + CH_UL) + (((size_t)it * 4 + itile) * 64 + lane) * 4) = o; } }
        }
        f32x4 ap[4], rp[4];
        for (int rp4 = 0; rp4 < (PRE_DUP == 4 ? 2 : 1); ++rp4) {
#pragma unroll
        for (int jt = 0; jt < 4; ++jt) { float lo[4], hi[4] = {0.f, 0.f, 0.f, 0.f};
#pragma unroll
            for (int j = 0; j < 4; ++j) lo[j] = bf2f(sAt[(4 * q + j) * RKP_PITCH + 16 * jt + m]);
            ap[jt] = mfma16(tinvf, pack_frag(lo, hi), (f32x4){0.f, 0.f, 0.f, 0.f});
            const float al[4] = {ap[jt][0], ap[jt][1], ap[jt][2], ap[jt][3]};
            f32x4 rr = mfma16(mrbf, pack_frag(al, hi), (f32x4){0.f, 0.f, 0.f, 0.f});
#pragma unroll
            for (int r = 0; r < 4; ++r) rr[r] += bf2f(sRt[(4 * q + r) * RKP_PITCH + 16 * jt + m]);
            rp[jt] = rr;
            float bl[4], kl[4];
#pragma unroll
            for (int j = 0; j < 4; ++j) { bl[j] = bf2f(sBh[(4 * q + j) * RKP_PITCH + 16 * jt + m]); kl[j] = bf2f(sKh[(4 * q + j) * RKP_PITCH + 16 * jt + m]); }
            *(bf16x8*)((bf16_t*)(p.ws + CH_BK) + (((size_t)it * 4 + jt) * 64 + lane) * 8) = pack_frag(bl, kl); }
        }
        for (int rp5 = 0; rp5 < (PRE_DUP == 5 ? 2 : 1); ++rp5) {
#pragma unroll
        for (int jt = 0; jt < 4; ++jt)
#pragma unroll
            for (int r = 0; r < 4; ++r) { sAt[(4 * q + r) * RKP_PITCH + 16 * jt + m] = f2bf(ap[jt][r]); sRt[(4 * q + r) * RKP_PITCH + 16 * jt + m] = f2bf(rp[jt][r]); }
#pragma unroll
        for (int x = 0; x < 2; ++x)
#pragma unroll
            for (int ks = 0; ks < 2; ++ks) { const LAS bf16_t* src = (x ? sRt : sAt) + m * RKP_PITCH + 32 * ks + 4 * q;
                const u32x2 a0 = *(const LAS u32x2*)src, a1 = *(const LAS u32x2*)(src + 16); const u32x4 w = {a0.x, a0.y, a1.x, a1.y};
                *(u32x4*)((bf16_t*)(p.ws + CH_XP) + ((((size_t)it * 2 + x) * 2 + ks) * 64 + lane) * 8) = w; }
        }
    }
}
__device__ __forceinline__ void rwkv_seq_task(const Params& p, int l, int task, LAS unsigned char* lds) {
    const int lane = threadIdx.x & 63, m = lane & 15, q = lane >> 4;
    const int u = task >> 2, iw = task & 3, b = u / 12, h = (u % 12) >> 1, d = u & 1, sgn = d ? -1 : 1;
    const bf16_t* XP = (const bf16_t*)(p.ws + CH_XP); const bf16_t* BK = (const bf16_t*)(p.ws + CH_BK); const bf16_t* UL = (const bf16_t*)(p.ws + CH_UL); const bf16_t* MM = (const bf16_t*)(p.ws + CH_MM);
    const bf16_t* GT = (const bf16_t*)(p.ws + CH_GT); const bf16_t* VS = (const bf16_t*)(p.ws + U_VS) + h * 64 + 16 * iw;
    float* Yw = (float*)(p.ws + U_YRK) + (size_t)d * NROW * 384 + h * 64 + 16 * iw;
    LAS float* ybuf = (LAS float*)(lds + (threadIdx.x >> 6) * 12288);
    const int rc0 = NLAT + b * 256 + (d ? 255 : 0) + sgn * 4 * q, rdel = (b * 2048 + (d ? 2047 : 0)) - (NLAT + b * 256 + (d ? 255 : 0)) - sgn * 256;
    f32x4 acc[4];
#pragma unroll
    for (int jt = 0; jt < 4; ++jt) acc[jt] = (f32x4){0.f, 0.f, 0.f, 0.f};
    const unsigned vo16 = (unsigned)lane * 16u, vo8 = (unsigned)lane * 8u, vo8q = (unsigned)q * 8u;
    struct OpSet { u32x4 apf0, apf1, rpf0, rpf1, bkf0, bkf1, bkf2, bkf3, mmf; u32x2 gl0, gl1, gl2, gl3, uw; unsigned vr0, vr1, vr2, vr3; };
#define GLDS16(dst, voff, sbase, imm) asm volatile("global_load_dwordx4 %0, %1, %2 offset:" #imm : "=&v"(dst) : "v"(voff), "s"(sbase) : "memory")
#define GLDS8(dst, voff, sbase, imm) asm volatile("global_load_dwordx2 %0, %1, %2 offset:" #imm : "=&v"(dst) : "v"(voff), "s"(sbase) : "memory")
#define GLDS2(dst, voff, sbase) asm volatile("global_load_ushort %0, %1, %2" : "=&v"(dst) : "v"(voff), "s"(sbase) : "memory")
#define RKS_LOAD(X, c_) do { const size_t it_ = (size_t)u * 144 + (c_); const int rb_ = rc0 + sgn * 16 * (c_) + (int)((c_) >= 16) * rdel; \
        const bf16_t* xpb = XP + it_ * 2048; const bf16_t* bkb = BK + it_ * 2048; const bf16_t* mmb = MM + it_ * 512; const bf16_t* gtb = GT + it_ * 64; const bf16_t* ulb = UL + (it_ * 4 + iw) * 256; \
        GLDS16(X.apf0, vo16, xpb, 0); GLDS16(X.apf1, vo16, xpb, 1024); GLDS16(X.rpf0, vo16, xpb, 2048); GLDS16(X.rpf1, vo16, xpb, 3072); \
        GLDS16(X.bkf0, vo16, bkb, 0); GLDS16(X.bkf1, vo16, bkb, 1024); GLDS16(X.bkf2, vo16, bkb, 2048); GLDS16(X.bkf3, vo16, bkb, 3072); \
        GLDS8(X.gl0, vo8q, gtb, 0); GLDS8(X.gl1, vo8q, gtb, 32); GLDS8(X.gl2, vo8q, gtb, 64); GLDS8(X.gl3, vo8q, gtb, 96); \
        GLDS16(X.mmf, vo16, mmb, 0); GLDS8(X.uw, vo8, ulb, 0); \
        { const unsigned v0_ = (unsigned)(rb_) * 768u + 2u * m, v1_ = (unsigned)(rb_ + sgn) * 768u + 2u * m, v2_ = (unsigned)(rb_ + 2 * sgn) * 768u + 2u * m, v3_ = (unsigned)(rb_ + 3 * sgn) * 768u + 2u * m; \
          GLDS2(X.vr0, v0_, VS); GLDS2(X.vr1, v1_, VS); GLDS2(X.vr2, v2_, VS); GLDS2(X.vr3, v3_, VS); } } while (0)
#define RKS_WAIT(X) asm volatile("s_waitcnt vmcnt(36)" : "+v"(X.apf0), "+v"(X.apf1), "+v"(X.rpf0), "+v"(X.rpf1), "+v"(X.bkf0), "+v"(X.bkf1), "+v"(X.bkf2), "+v"(X.bkf3), "+v"(X.mmf), \
        "+v"(X.gl0), "+v"(X.gl1), "+v"(X.gl2), "+v"(X.gl3), "+v"(X.uw), "+v"(X.vr0), "+v"(X.vr1), "+v"(X.vr2), "+v"(X.vr3) :: "memory")
#define BF8(x) __builtin_bit_cast(bf16x8, x)
#define RKS_COMPUTE(X, c_) do { RKS_WAIT(X); \
        const float ul[4] = {bflo(X.uw.x), bfhi(X.uw.x), bflo(X.uw.y), bfhi(X.uw.y)}; const float vl[4] = {bflo(X.vr0), bflo(X.vr1), bflo(X.vr2), bflo(X.vr3)}; \
        f32x4 zp = (f32x4){0.f, 0.f, 0.f, 0.f}, yp = zp; \
        { const float lo[4] = {acc[0][0], acc[0][1], acc[0][2], acc[0][3]}, hi[4] = {acc[1][0], acc[1][1], acc[1][2], acc[1][3]}; const bf16x8 sf = pack_frag(lo, hi); zp = mfma16(BF8(X.apf0), sf, zp); yp = mfma16(BF8(X.rpf0), sf, yp); } \
        { const float lo[4] = {acc[2][0], acc[2][1], acc[2][2], acc[2][3]}, hi[4] = {acc[3][0], acc[3][1], acc[3][2], acc[3][3]}; const bf16x8 sf = pack_frag(lo, hi); zp = mfma16(BF8(X.apf1), sf, zp); yp = mfma16(BF8(X.rpf1), sf, yp); } \
        const float z[4] = {zp[0] + ul[0], zp[1] + ul[1], zp[2] + ul[2], zp[3] + ul[3]}; \
        yp = mfma16(BF8(X.mmf), pack_frag(ul, vl), yp); \
        const bf16x8 zvf = pack_frag(z, vl); \
        acc[0] = mfma16(BF8(X.bkf0), zvf, acc[0]); acc[1] = mfma16(BF8(X.bkf1), zvf, acc[1]); acc[2] = mfma16(BF8(X.bkf2), zvf, acc[2]); acc[3] = mfma16(BF8(X.bkf3), zvf, acc[3]); \
        { const f32x4 g4 = {__expf(bflo(X.gl0.x)), __expf(bfhi(X.gl0.x)), __expf(bflo(X.gl0.y)), __expf(bfhi(X.gl0.y))}; acc[0] *= g4; } \
        { const f32x4 g4 = {__expf(bflo(X.gl1.x)), __expf(bfhi(X.gl1.x)), __expf(bflo(X.gl1.y)), __expf(bfhi(X.gl1.y))}; acc[1] *= g4; } \
        { const f32x4 g4 = {__expf(bflo(X.gl2.x)), __expf(bfhi(X.gl2.x)), __expf(bflo(X.gl2.y)), __expf(bfhi(X.gl2.y))}; acc[2] *= g4; } \
        { const f32x4 g4 = {__expf(bflo(X.gl3.x)), __expf(bfhi(X.gl3.x)), __expf(bflo(X.gl3.y)), __expf(bfhi(X.gl3.y))}; acc[3] *= g4; } \
        _Pragma("unroll") for (int r = 0; r < 4; ++r) ybuf[((((c_) % 12) * 16) + 4 * q + r) * 16 + m] = yp[r]; } while (0)
    asm volatile("; SEQ_BEGIN");
    OpSet A, B, C;
    RKS_LOAD(A, 0); RKS_LOAD(B, 1);
    for (int c0 = 0; c0 < 144; c0 += 12) {
#pragma unroll
        for (int cc = 0; cc < 12; cc += 3) { const int c = c0 + cc;
            RKS_LOAD(C, c + 2); __builtin_amdgcn_sched_barrier(0);
            RKS_COMPUTE(A, c); __builtin_amdgcn_sched_barrier(0);
            { const int cn = c + 3 < 144 ? c + 3 : 143; RKS_LOAD(A, cn); } __builtin_amdgcn_sched_barrier(0);
            RKS_COMPUTE(B, c + 1); __builtin_amdgcn_sched_barrier(0);
            { const int cn = c + 4 < 144 ? c + 4 : 143; RKS_LOAD(B, cn); } __builtin_amdgcn_sched_barrier(0);
            RKS_COMPUTE(C, c + 2); __builtin_amdgcn_sched_barrier(0); }
#pragma unroll
        for (int k = 0; k < 12; ++k) { const int rr = (lane >> 2) + 16 * k, n = c0 * 16 + rr; const int grow = (rc0 - sgn * 4 * q) + sgn * n + (int)(n >= 256) * rdel;
            *(f32x4*)(Yw + (size_t)grow * 384 + (lane & 3) * 4) = *(const LAS f32x4*)(ybuf + rr * 16 + (lane & 3) * 4); }
    }
    asm volatile("; SEQ_END");
#undef RKS_LOAD
#undef RKS_COMPUTE
#undef RKS_WAIT
#undef GLDS16
#undef GLDS8
#undef GLDS2
#undef BF8
}

__device__ __forceinline__ void rwkv_seq_block(const Params& p, int l, int u, LAS unsigned char* lds) {
    (void)l;
    const int tid = threadIdx.x, lane = tid & 63, wv = __builtin_amdgcn_readfirstlane(tid >> 6), m = lane & 15, q = lane >> 4;
    const int b = u / 12, h = (u % 12) >> 1, d = u & 1, sgn = d ? -1 : 1;
    const unsigned char* XPb = p.ws + CH_XP + (size_t)u * 144 * 4096; const unsigned char* BKb = p.ws + CH_BK + (size_t)u * 144 * 4096;
    const unsigned char* MMb = p.ws + CH_MM + (size_t)u * 144 * 1024; const unsigned char* GTb = p.ws + CH_GT + (size_t)u * 144 * 128;
    LAS unsigned char* ring = lds + 49152;
#define SEQ_BAR() asm volatile("s_waitcnt lgkmcnt(0)\n\ts_barrier" ::: "memory")
    __syncthreads();
    if (wv >= 4) {
        const int lw = wv - 4; const bool hasmm = lw == 0, hasgt = (lw == 1) && lane < 8;
        lu4 xp[3], bk[3], mm[3], gt[3];
#define LDR_LOAD(k, c_) do { const int cc_ = (c_) < 144 ? (c_) : 143; xp[k] = *(const lu4*)(XPb + (size_t)cc_ * 4096 + lw * 1024 + lane * 16); bk[k] = *(const lu4*)(BKb + (size_t)cc_ * 4096 + lw * 1024 + lane * 16); \
            if (hasmm) mm[k] = *(const lu4*)(MMb + (size_t)cc_ * 1024 + lane * 16); if (hasgt) gt[k] = *(const lu4*)(GTb + (size_t)cc_ * 128 + lane * 16); } while (0)
#define LDR_STORE(k, c_) do { if ((c_) < 144) { LAS unsigned char* sl_ = ring + ((c_) % 3) * 9728; *(LAS lu4*)(sl_ + lw * 1024 + lane * 16) = xp[k]; *(LAS lu4*)(sl_ + 4096 + lw * 1024 + lane * 16) = bk[k]; \
            if (hasmm) *(LAS lu4*)(sl_ + 8192 + lane * 16) = mm[k]; if (hasgt) *(LAS lu4*)(sl_ + 9216 + lane * 16) = gt[k]; } } while (0)
        LDR_LOAD(0, 0); LDR_LOAD(1, 1); LDR_LOAD(2, 2);
        LDR_STORE(0, 0); LDR_LOAD(0, 3); LDR_STORE(1, 1); LDR_LOAD(1, 4);
        SEQ_BAR();
        for (int i0 = 0; i0 < 144; i0 += 3) {
            LDR_STORE(2, i0 + 2); LDR_LOAD(2, i0 + 5); SEQ_BAR();
            LDR_STORE(0, i0 + 3); LDR_LOAD(0, i0 + 6); SEQ_BAR();
            LDR_STORE(1, i0 + 4); LDR_LOAD(1, i0 + 7); SEQ_BAR(); }
#undef LDR_LOAD
#undef LDR_STORE
    } else {
        const int iw = wv;
        const bf16_t* UL = (const bf16_t*)(p.ws + CH_UL) + (size_t)u * 144 * 1024; const bf16_t* VS = (const bf16_t*)(p.ws + U_VS) + h * 64 + 16 * iw;
        float* Yw = (float*)(p.ws + U_YRK) + (size_t)d * NROW * 384 + h * 64 + 16 * iw;
        LAS float* ybuf = (LAS float*)(lds + wv * 12288);
        const int rc0 = NLAT + b * 256 + (d ? 255 : 0) + sgn * 4 * q, rdel = (b * 2048 + (d ? 2047 : 0)) - (NLAT + b * 256 + (d ? 255 : 0)) - sgn * 256;
        const unsigned vo8 = (unsigned)lane * 8u;
        f32x4 acc[4];
#pragma unroll
        for (int jt = 0; jt < 4; ++jt) acc[jt] = (f32x4){0.f, 0.f, 0.f, 0.f};
        struct Shared { bf16x8 apf0, apf1, rpf0, rpf1, bkf0, bkf1, bkf2, bkf3, mmf; u32x2 gl0, gl1, gl2, gl3; };
        struct Own { u32x2 uw; unsigned vr0, vr1, vr2, vr3; };
#define GLDS8(dst, voff, sbase) asm volatile("global_load_dwordx2 %0, %1, %2" : "=&v"(dst) : "v"(voff), "s"(sbase) : "memory")
#define GLDS2(dst, voff, sbase) asm volatile("global_load_ushort %0, %1, %2" : "=&v"(dst) : "v"(voff), "s"(sbase) : "memory")
#define OWN_LOAD(X, c_) do { const int cc_ = (c_) < 144 ? (c_) : 143; const int rb_ = rc0 + sgn * 16 * cc_ + (int)(cc_ >= 16) * rdel; const bf16_t* ulb = UL + ((size_t)cc_ * 4 + iw) * 256; \
            GLDS8(X.uw, vo8, ulb); const unsigned v0_ = (unsigned)(rb_) * 768u + 2u * m, v1_ = (unsigned)(rb_ + sgn) * 768u + 2u * m, v2_ = (unsigned)(rb_ + 2 * sgn) * 768u + 2u * m, v3_ = (unsigned)(rb_ + 3 * sgn) * 768u + 2u * m; \
            GLDS2(X.vr0, v0_, VS); GLDS2(X.vr1, v1_, VS); GLDS2(X.vr2, v2_, VS); GLDS2(X.vr3, v3_, VS); } while (0)
#define OWN_WAIT(X) asm volatile("s_waitcnt vmcnt(10)" : "+v"(X.uw), "+v"(X.vr0), "+v"(X.vr1), "+v"(X.vr2), "+v"(X.vr3) :: "memory")
#define SH_READ(S, c_) do { const int cc_ = (c_) < 144 ? (c_) : 143; const LAS unsigned char* sl_ = ring + (cc_ % 3) * 9728 + lane * 16; \
            S.apf0 = *(const LAS bf16x8*)(sl_); S.apf1 = *(const LAS bf16x8*)(sl_ + 1024); S.rpf0 = *(const LAS bf16x8*)(sl_ + 2048); S.rpf1 = *(const LAS bf16x8*)(sl_ + 3072); \
            S.bkf0 = *(const LAS bf16x8*)(sl_ + 4096); S.bkf1 = *(const LAS bf16x8*)(sl_ + 5120); S.bkf2 = *(const LAS bf16x8*)(sl_ + 6144); S.bkf3 = *(const LAS bf16x8*)(sl_ + 7168); S.mmf = *(const LAS bf16x8*)(sl_ + 8192); \
            const LAS unsigned char* gp_ = ring + (cc_ % 3) * 9728 + 9216 + q * 8; S.gl0 = *(const LAS u32x2*)(gp_); S.gl1 = *(const LAS u32x2*)(gp_ + 32); S.gl2 = *(const LAS u32x2*)(gp_ + 64); S.gl3 = *(const LAS u32x2*)(gp_ + 96); } while (0)
#define SEQ_COMPUTE(S, X, c_) do { OWN_WAIT(X); \
            const float ul[4] = {bflo(X.uw.x), bfhi(X.uw.x), bflo(X.uw.y), bfhi(X.uw.y)}; const float vl[4] = {bflo(X.vr0), bflo(X.vr1), bflo(X.vr2), bflo(X.vr3)}; \
            f32x4 zp = (f32x4){0.f, 0.f, 0.f, 0.f}, yp = zp; \
            { const float lo[4] = {acc[0][0], acc[0][1], acc[0][2], acc[0][3]}, hi[4] = {acc[1][0], acc[1][1], acc[1][2], acc[1][3]}; const bf16x8 sf = pack_frag(lo, hi); zp = mfma16(S.apf0, sf, zp); yp = mfma16(S.rpf0, sf, yp); } \
            { const float lo[4] = {acc[2][0], acc[2][1], acc[2][2], acc[2][3]}, hi[4] = {acc[3][0], acc[3][1], acc[3][2], acc[3][3]}; const bf16x8 sf = pack_frag(lo, hi); zp = mfma16(S.apf1, sf, zp); yp = mfma16(S.rpf1, sf, yp); } \
            const float z[4] = {zp[0] + ul[0], zp[1] + ul[1], zp[2] + ul[2], zp[3] + ul[3]}; \
            yp = mfma16(S.mmf, pack_frag(ul, vl), yp); \
            const bf16x8 zvf = pack_frag(z, vl); \
            acc[0] = mfma16(S.bkf0, zvf, acc[0]); acc[1] = mfma16(S.bkf1, zvf, acc[1]); acc[2] = mfma16(S.bkf2, zvf, acc[2]); acc[3] = mfma16(S.bkf3, zvf, acc[3]); \
            { const f32x4 g4 = {__expf(bflo(S.gl0.x)), __expf(bfhi(S.gl0.x)), __expf(bflo(S.gl0.y)), __expf(bfhi(S.gl0.y))}; acc[0] *= g4; } \
            { const f32x4 g4 = {__expf(bflo(S.gl1.x)), __expf(bfhi(S.gl1.x)), __expf(bflo(S.gl1.y)), __expf(bfhi(S.gl1.y))}; acc[1] *= g4; } \
            { const f32x4 g4 = {__expf(bflo(S.gl2.x)), __expf(bfhi(S.gl2.x)), __expf(bflo(S.gl2.y)), __expf(bfhi(S.gl2.y))}; acc[2] *= g4; } \
            { const f32x4 g4 = {__expf(bflo(S.gl3.x)), __expf(bfhi(S.gl3.x)), __expf(bflo(S.gl3.y)), __expf(bfhi(S.gl3.y))}; acc[3] *= g4; } \
            _Pragma("unroll") for (int r = 0; r < 4; ++r) ybuf[((((c_) % 12) * 16) + 4 * q + r) * 16 + m] = yp[r]; } while (0)
#define SEQ_STEP(SC, SN, XC, XN2, c_) do { SH_READ(SN, (c_) + 1); OWN_LOAD(XN2, (c_) + 2); __builtin_amdgcn_sched_barrier(0); SEQ_COMPUTE(SC, XC, c_); __builtin_amdgcn_sched_barrier(0); SEQ_BAR(); } while (0)
        Shared S0, S1; Own A, B, C;
        OWN_LOAD(A, 0); OWN_LOAD(B, 1);
        SEQ_BAR();
        SH_READ(S0, 0);
        for (int c0 = 0; c0 < 144; c0 += 12) {
#pragma unroll
            for (int cc = 0; cc < 12; cc += 6) { const int c = c0 + cc;
                SEQ_STEP(S0, S1, A, C, c); SEQ_STEP(S1, S0, B, A, c + 1); SEQ_STEP(S0, S1, C, B, c + 2);
                SEQ_STEP(S1, S0, A, C, c + 3); SEQ_STEP(S0, S1, B, A, c + 4); SEQ_STEP(S1, S0, C, B, c + 5); }
#pragma unroll
            for (int k = 0; k < 12; ++k) { const int rr = (lane >> 2) + 16 * k, n = c0 * 16 + rr; const int grow = (rc0 - sgn * 4 * q) + sgn * n + (int)(n >= 256) * rdel;
                *(f32x4*)(Yw + (size_t)grow * 384 + (lane & 3) * 4) = *(const LAS f32x4*)(ybuf + rr * 16 + (lane & 3) * 4); }
        }
#undef GLDS8
#undef GLDS2
#undef OWN_LOAD
#undef OWN_WAIT
#undef SH_READ
#undef SEQ_COMPUTE
#undef SEQ_STEP
    }
#undef SEQ_BAR
    __syncthreads();
}

__device__ __forceinline__ void rwkv_finish(const Params& p, int l) {
    const int sub = threadIdx.x & 7; const int npair = (l == 0 ? NROW : NLAT) * 6;
    const bf16_t* RS = (const bf16_t*)(p.ws + U_RS); const bf16_t* KS = (const bf16_t*)(p.ws + U_KS); const bf16_t* VS = (const bf16_t*)(p.ws + U_VS);
    const bf16_t* AG0 = (const bf16_t*)(p.ws + U_AG); const bf16_t* AG1 = (const bf16_t*)(p.ws + U_AG + SZ384); const bf16_t* G = (const bf16_t*)(p.ws + U_G);
    const float* Y0 = (const float*)(p.ws + U_YRK); const float* Y1 = Y0 + (size_t)NROW * 384; bf16_t* YC = (bf16_t*)(p.ws + WS_ABUF);
    for (int pr = (blockIdx.x * NTHR + threadIdx.x) >> 3; pr < npair; pr += (gridDim.x * NTHR) >> 3) { const int row = pr / 6, h = pr % 6, col = h * 64 + sub * 8; const size_t o = (size_t)row * 384 + col;
        float y[8]; { const float4 a0 = *(const float4*)(Y0 + o), a1 = *(const float4*)(Y0 + o + 4), c0 = *(const float4*)(Y1 + o), c1 = *(const float4*)(Y1 + o + 4);
            y[0] = a0.x + c0.x; y[1] = a0.y + c0.y; y[2] = a0.z + c0.z; y[3] = a0.w + c0.w; y[4] = a1.x + c1.x; y[5] = a1.y + c1.y; y[6] = a1.z + c1.z; y[7] = a1.w + c1.w; }
        float s = 0.f;
#pragma unroll
        for (int k = 0; k < 8; ++k) s += y[k];
        s += __shfl_xor(s, 1); s += __shfl_xor(s, 2); s += __shfl_xor(s, 4); const float mean = s * (1.0f / 64.0f);
        float v2 = 0.f;
#pragma unroll
        for (int k = 0; k < 8; ++k) { const float dd = y[k] - mean; v2 += dd * dd; }
        v2 += __shfl_xor(v2, 1); v2 += __shfl_xor(v2, 2); v2 += __shfl_xor(v2, 4); const float rstd = rsqrtf(v2 * (1.0f / 64.0f) + 64e-5f);
        float r[8], kx[8], vx[8], a0[8], a1[8], gx[8];
        unpack8(*(const uint4*)(RS + o), r); unpack8(*(const uint4*)(KS + o), kx); unpack8(*(const uint4*)(VS + o), vx); unpack8(*(const uint4*)(AG0 + o), a0); unpack8(*(const uint4*)(AG1 + o), a1); unpack8(*(const uint4*)(G + o), gx);
        const float* ka = p.in[27] + l * 384 + col; const float* rk = p.in[28] + l * 384 + col; const float* lw = p.in[29] + l * 384 + col; const float* lb = p.in[30] + l * 384 + col;
        float bs = 0.f;
#pragma unroll
        for (int k = 0; k < 8; ++k) { const float kd0 = kx[k] * (1.0f + (a0[k] - 1.0f) * ka[k]), kd1 = kx[k] * (1.0f + (a1[k] - 1.0f) * ka[k]); bs += r[k] * (kd0 + kd1) * rk[k]; }
        bs += __shfl_xor(bs, 1); bs += __shfl_xor(bs, 2); bs += __shfl_xor(bs, 4);
        float ov[8];
#pragma unroll
        for (int k = 0; k < 8; ++k) ov[k] = ((y[k] - mean) * rstd * lw[k] + lb[k] + bs * vx[k]) * gx[k];
        *(uint4*)(YC + (size_t)row * 1024 + 640 + col) = pack8(ov);
    }
}

__device__ __forceinline__ void phase_normrouter(const Params& p, int l, const float* xl, const float* xc, LAS unsigned char* lds) {
    LAS float* hrow = (LAS float*)lds;
    LAS float* part = (LAS float*)(lds + 65536);
    const int lane = threadIdx.x & 63, wv = threadIdx.x >> 6, e = lane & 15, cq = lane >> 4; const int ngrp = (l == 0 ? NROW : NLAT) / 16;
    const float* mod = (const float*)(p.ws + WS_MOD) + (size_t)l * 17 * 6144; const float* g1 = p.in[6] + (l * 4 + 1) * 1024; const float* g2 = p.in[6] + (l * 4 + 2) * 1024;
    const bf16_t* Y = (const bf16_t*)(p.ws + U_Y); unsigned char* A8 = p.ws + WS_ABUF; float* AFF = (float*)(p.ws + WS_AFF);
    float wr[32];
#pragma unroll
    for (int j = 0; j < 32; ++j) wr[j] = p.in[31][((size_t)l * 1024 + 128 * wv + 32 * cq + j) * 16 + e];
    for (int gi = blockIdx.x; gi < ngrp; gi += gridDim.x) { const int r0 = gi * 16 + wv; const int b = r0 < NLAT ? (r0 >> 11) : 16; const float* mb = mod + (size_t)b * 6144;
        const float* xs = xrow(xl, xc, r0); float* xd = xrow_w(p.out, (float*)(p.ws + WS_CTXA), r0);
        float4 y[2][4], x[2][4]; float ss[2] = {0.f, 0.f};
#pragma unroll
        for (int q = 0; q < 2; ++q)
#pragma unroll
            for (int i = 0; i < 4; ++i) { { const u32x2 yw = *(const u32x2*)(Y + (size_t)(r0 + 8 * q) * 1024 + i * 256 + lane * 4); y[q][i] = make_float4(bflo(yw.x), bfhi(yw.x), bflo(yw.y), bfhi(yw.y)); }
                x[q][i] = *(const float4*)(xs + (size_t)q * 8192 + i * 256 + lane * 4); }
#pragma unroll
        for (int q = 0; q < 2; ++q)
#pragma unroll
            for (int i = 0; i < 4; ++i) ss[q] += y[q][i].x * y[q][i].x + y[q][i].y * y[q][i].y + y[q][i].z * y[q][i].z + y[q][i].w * y[q][i].w;
        ss[0] = wave_sum(ss[0]); ss[1] = wave_sum(ss[1]); const float rs[2] = {rsqrtf(ss[0] * (1.0f / 1024.0f) + 1e-6f), rsqrtf(ss[1] * (1.0f / 1024.0f) + 1e-6f)};
        float s2[2] = {0.f, 0.f};
#pragma unroll
        for (int i = 0; i < 4; ++i) { const int c = i * 256 + lane * 4; const float4 gg = *(const float4*)(g1 + c), gt = *(const float4*)(mb + 2048 + c);
#pragma unroll
            for (int q = 0; q < 2; ++q) {
                x[q][i].x += gt.x * (y[q][i].x * rs[q] * gg.x); x[q][i].y += gt.y * (y[q][i].y * rs[q] * gg.y); x[q][i].z += gt.z * (y[q][i].z * rs[q] * gg.z); x[q][i].w += gt.w * (y[q][i].w * rs[q] * gg.w);
                *(float4*)(xd + (size_t)q * 8192 + c) = x[q][i]; s2[q] += x[q][i].x * x[q][i].x + x[q][i].y * x[q][i].y + x[q][i].z * x[q][i].z + x[q][i].w * x[q][i].w; } }
        s2[0] = wave_sum(s2[0]); s2[1] = wave_sum(s2[1]); const float rs2[2] = {rsqrtf(s2[0] * (1.0f / 1024.0f) + 1e-6f), rsqrtf(s2[1] * (1.0f / 1024.0f) + 1e-6f)};
        float hv[2][4][4]; float amax[2] = {0.f, 0.f};
        __syncthreads();
#pragma unroll
        for (int i = 0; i < 4; ++i) { const int c = i * 256 + lane * 4; const float4 gg = *(const float4*)(g2 + c), sh = *(const float4*)(mb + 3072 + c), sc = *(const float4*)(mb + 4096 + c);
#pragma unroll
            for (int q = 0; q < 2; ++q) {
                hv[q][i][0] = x[q][i].x * rs2[q] * gg.x * (1.f + sc.x) + sh.x; hv[q][i][1] = x[q][i].y * rs2[q] * gg.y * (1.f + sc.y) + sh.y; hv[q][i][2] = x[q][i].z * rs2[q] * gg.z * (1.f + sc.z) + sh.z; hv[q][i][3] = x[q][i].w * rs2[q] * gg.w * (1.f + sc.w) + sh.w;
                *(LAS lf4*)(hrow + (wv + 8 * q) * 1024 + c) = (lf4){hv[q][i][0], hv[q][i][1], hv[q][i][2], hv[q][i][3]};
                amax[q] = fmaxf(amax[q], fmaxf(fmaxf(fabsf(hv[q][i][0]), fabsf(hv[q][i][1])), fmaxf(fabsf(hv[q][i][2]), fabsf(hv[q][i][3])))); } }
#pragma unroll
        for (int o = 32; o >= 1; o >>= 1) { amax[0] = fmaxf(amax[0], __shfl_xor(amax[0], o)); amax[1] = fmaxf(amax[1], __shfl_xor(amax[1], o)); }
#pragma unroll
        for (int q = 0; q < 2; ++q) { const int r = r0 + 8 * q; const float am = fmaxf(amax[q], 1e-20f), qs = 127.0f / am;
            if (lane == 0) ((float*)(p.ws + WS_SX))[r] = am * (1.0f / 127.0f);
#pragma unroll
            for (int i = 0; i < 4; ++i) { unsigned w = 0u;
#pragma unroll
                for (int k = 0; k < 4; ++k) w |= ((unsigned)__float2int_rn(hv[q][i][k] * qs) & 255u) << (8 * k);
                *(unsigned*)(A8 + (size_t)r * 1024 + i * 256 + lane * 4) = w; } }
        __syncthreads();
#pragma unroll 2
        for (int rr = 0; rr < 16; ++rr) { const LAS float* hp = hrow + rr * 1024 + 128 * wv + 32 * cq; float acc = 0.f;
#pragma unroll
            for (int j4 = 0; j4 < 8; ++j4) { const lf4 h4 = *(const LAS lf4*)(hp + 4 * j4); acc += h4.x * wr[4 * j4] + h4.y * wr[4 * j4 + 1] + h4.z * wr[4 * j4 + 2] + h4.w * wr[4 * j4 + 3]; }
            acc += __shfl_xor(acc, 16); acc += __shfl_xor(acc, 32);
            if (cq == 0) part[(rr * 8 + wv) * 16 + e] = acc; }
        __syncthreads();
        if (lane < 32) { const int row = wv + 8 * cq; float lgt = 0.f;
#pragma unroll
            for (int w = 0; w < 8; ++w) lgt += part[(row * 8 + w) * 16 + e];
            float mxl = lgt;
#pragma unroll
            for (int o = 8; o >= 1; o >>= 1) mxl = fmaxf(mxl, __shfl_xor(mxl, o));
            const float ex = expf(lgt - mxl); float den = ex;
#pragma unroll
            for (int o = 8; o >= 1; o >>= 1) den += __shfl_xor(den, o);
            AFF[(size_t)(r0 + 8 * cq) * 16 + e] = ex / den; }
    }
}

__device__ __forceinline__ void phase_topk(const Params& p, int l, LAS unsigned char* lds) {
    LAS unsigned* keys = (LAS unsigned*)lds;
    LAS int* toks = (LAS int*)(lds + 8192);
    LAS unsigned* hist = (LAS unsigned*)(lds + 9216);
    LAS unsigned* wtot = (LAS unsigned*)(lds + 10240);
    LAS unsigned* sel = (LAS unsigned*)(lds + 10304);
    const int tid = threadIdx.x, lane = tid & 63, wv = tid >> 6, nitem = l == 0 ? 512 : 256;
    const float* AFF = (const float*)(p.ws + WS_AFF); int* SLOT = (int*)(p.ws + WS_SLOT); float* SELG = (float*)(p.ws + WS_SELG);
    const bf16_t* A = (const bf16_t*)(p.ws + WS_ABUF); bf16_t* XS = (bf16_t*)(p.ws + U_XSEL);
    for (int it = blockIdx.x; it < nitem; it += gridDim.x) { const bool lat = it < 256; const int be = it & 255, b = be >> 4, e = be & 15;
        const int n = lat ? SEQ : CTXL, cap = lat ? 256 : 32, rowbase = lat ? b * 2048 : NLAT + b * 256, xoff = lat ? b * 256 : 4096 + b * 32;
        const int per = n / NTHR > 0 ? n / NTHR : 1;
        const int t0 = tid * per; const bool act = t0 < n;
        unsigned kx[4];
        __syncthreads();
#pragma unroll
        for (int j = 0; j < 4; ++j) { kx[j] = 0u; if (act && j < per) { kx[j] = __float_as_uint(AFF[(size_t)(rowbase + t0 + j) * 16 + e]); keys[t0 + j] = kx[j]; } }
        unsigned prefix = 0u; int krem = cap;
        for (int pass = 0; pass < 4; ++pass) { const int shift = 24 - 8 * pass;
            if (tid < 256) hist[tid] = 0u;
            __syncthreads();
#pragma unroll
            for (int j = 0; j < 4; ++j) if (act && j < per) { const bool match = pass == 0 || (kx[j] >> (shift + 8)) == (prefix >> (shift + 8)); if (match) atomicAdd((unsigned*)&hist[(kx[j] >> shift) & 255u], 1u); }
            __syncthreads();
            if (tid < 256) { unsigned above = 0u; for (int bb = tid + 1; bb < 256; ++bb) above += hist[bb]; const unsigned mine = hist[tid];
                if (above < (unsigned)krem && above + mine >= (unsigned)krem) { sel[0] = (unsigned)tid; sel[1] = (unsigned)krem - above; } }
            __syncthreads();
            prefix |= sel[0] << shift; krem = (int)sel[1];
            __syncthreads();
        }
        unsigned loc = 0u, pre[4];
#pragma unroll
        for (int j = 0; j < 4; ++j) { pre[j] = loc; if (act && j < per) loc += (kx[j] > prefix ? 1u : 0u) + (kx[j] == prefix ? 65536u : 0u); }
        unsigned inc = loc;
#pragma unroll
        for (int o = 1; o < 64; o <<= 1) { const unsigned t = __shfl_up(inc, o); if (lane >= o) inc += t; }
        if (lane == 63) wtot[wv] = inc;
        __syncthreads();
        unsigned base = inc - loc;
        for (int w = 0; w < wv; ++w) base += wtot[w];
#pragma unroll
        for (int j = 0; j < 4; ++j) if (act && j < per) { const unsigned c = base + pre[j]; const int gtb = (int)(c & 0xffffu), eqb = (int)(c >> 16);
            const bool s = kx[j] > prefix || (kx[j] == prefix && eqb < krem); const int slot = gtb + (eqb < krem ? eqb : krem);
            if (s) { SELG[e * XROWS + xoff + slot] = __uint_as_float(kx[j]); toks[slot] = t0 + j; }
            SLOT[(size_t)(rowbase + t0 + j) * 16 + e] = s ? slot : -1; }
        __syncthreads();
        for (int s = wv; s < cap; s += 8) { const int row = rowbase + toks[s]; const lu4* src = (const lu4*)((const unsigned char*)A + (size_t)row * 1024); lu4* dst = (lu4*)((unsigned char*)XS + ((size_t)e * XROWS + xoff + s) * 1024);
            dst[lane] = src[lane]; if (lane == 0) ((float*)(p.ws + WS_SXS))[e * XROWS + xoff + s] = ((const float*)(p.ws + WS_SX))[row]; }
    }
}

struct GroupedOrder { int nMl, nNl, G, c, total;
    __device__ void init(int nMl_, int nNl_, int, int G_, int c_) { nMl = nMl_; nNl = nNl_; G = G_; c = c_; total = 16 * nMl_ * nNl_; }
    __device__ bool next(int i, pg8::Unit& u) const {
        int L;
        if ((G & 7) == 0 && (total & 7) == 0) { const int W = G >> 3, x = c & 7, r = c >> 3, t8 = total >> 3, k = i * W + r; if (k >= t8) return false; L = x * t8 + k; }
        else { const long LL = (long)i * G + c; if (LL >= total) return false; L = (int)LL; }
        const int per = nMl * nNl, e = L / per; int idx = L % per;
        const int mg = idx / (8 * nNl) < nMl / 8 ? idx / (8 * nNl) : nMl / 8, gm = (mg + 1) * 8 <= nMl ? 8 : nMl - mg * 8; idx -= mg * 8 * nNl;
        const int ng = idx / (gm * 4) < nNl / 4 ? idx / (gm * 4) : nNl / 4, gn = (ng + 1) * 4 <= nNl ? 4 : nNl - ng * 4; idx -= ng * gm * 4;
        u.pm = e * 18 + mg * 8 + idx / gn; u.pn = e * nNl + ng * 4 + idx % gn; return true; }
    __device__ __forceinline__ void a_ready(const pg8::Unit&) const {}
    __device__ __forceinline__ void done(const pg8::Unit&) const {}
};
struct EpiSwiGLU { static constexpr bool PERM = true, AFTER_DRAIN = false; unsigned char* H; const float* sx; const float* sw;
    __device__ __forceinline__ void operator()(const f32x4 (&acc)[2][2][4][2], const pg8::Unit& u, int wr, int wc, int fr, int fq) const {
        typedef int i32x4_ __attribute__((ext_vector_type(4)));
        const int e = u.pn / 22, pnl = u.pn - e * 22; const int row0 = u.pm * 256 + wr * 64 + fr, col0 = pnl * 128 + wc * 32 + 8 * fq;
        const float* swp = sw + (size_t)u.pn * 256 + wc * 32 + 8 * fq; const float4 g0 = *(const float4*)swp, g1 = *(const float4*)(swp + 4), u0 = *(const float4*)(swp + 128), u1 = *(const float4*)(swp + 132);
        const float swg[8] = {g0.x, g0.y, g0.z, g0.w, g1.x, g1.y, g1.z, g1.w}, swu[8] = {u0.x, u0.y, u0.z, u0.w, u1.x, u1.y, u1.z, u1.w};
#pragma unroll
        for (int ai = 0; ai < 2; ++ai)
#pragma unroll
            for (int m = 0; m < 4; ++m) { const int r = row0 + ai * 128 + m * 16; const float sr = sx[r]; unsigned char* rowp = H + (size_t)r * DE + col0; float o[8];
#pragma unroll
                for (int n = 0; n < 2; ++n) { const i32x4_ ig = __builtin_bit_cast(i32x4_, acc[ai][0][m][n]), iu = __builtin_bit_cast(i32x4_, acc[ai][1][m][n]);
#pragma unroll
                    for (int j = 0; j < 4; ++j) { const float g = (float)ig[j] * (sr * swg[n * 4 + j]), uu = (float)iu[j] * (sr * swu[n * 4 + j]); o[n * 4 + j] = g * sigm(g) * uu; } }
                u32x2 w8; { int t0 = 0, t1 = 0; t0 = __builtin_amdgcn_cvt_pk_fp8_f32(o[0], o[1], t0, false); t0 = __builtin_amdgcn_cvt_pk_fp8_f32(o[2], o[3], t0, true); t1 = __builtin_amdgcn_cvt_pk_fp8_f32(o[4], o[5], t1, false); t1 = __builtin_amdgcn_cvt_pk_fp8_f32(o[6], o[7], t1, true); w8.x = (unsigned)t0; w8.y = (unsigned)t1; }
                *(u32x2*)rowp = w8; }
    }
};
struct EpiScaleBf16 { static constexpr bool PERM = true, AFTER_DRAIN = false; bf16_t* O; int ldc; const float* sx; const float* sw;
    __device__ __forceinline__ void operator()(const f32x4 (&acc)[2][2][4][2], const pg8::Unit& u, int wr, int wc, int fr, int fq) const {
        typedef int i32x4_ __attribute__((ext_vector_type(4)));
        const int row0 = u.pm * 256 + wr * 64 + fr, col0 = u.pn * 256 + wc * 32 + 8 * fq;
        float swv[2][8];
#pragma unroll
        for (int bj = 0; bj < 2; ++bj) { const float4 a = *(const float4*)(sw + col0 + bj * 128), b = *(const float4*)(sw + col0 + bj * 128 + 4); swv[bj][0] = a.x; swv[bj][1] = a.y; swv[bj][2] = a.z; swv[bj][3] = a.w; swv[bj][4] = b.x; swv[bj][5] = b.y; swv[bj][6] = b.z; swv[bj][7] = b.w; }
#pragma unroll
        for (int ai = 0; ai < 2; ++ai)
#pragma unroll
            for (int m = 0; m < 4; ++m) { const int r = row0 + ai * 128 + m * 16; const float sr = sx[r]; bf16_t* rowp = O + (size_t)r * ldc + col0;
#pragma unroll
                for (int bj = 0; bj < 2; ++bj) { float o[8];
#pragma unroll
                    for (int n = 0; n < 2; ++n) { const i32x4_ iv = __builtin_bit_cast(i32x4_, acc[ai][bj][m][n]);
#pragma unroll
                        for (int j = 0; j < 4; ++j) o[n * 4 + j] = (float)iv[j] * (sr * swv[bj][n * 4 + j]); }
                    *(uint4*)(rowp + bj * 128) = pack8(o); } }
    }
};
struct EpiGate { static constexpr bool PERM = true, AFTER_DRAIN = false; bf16_t* O; const float* gate; const float* sw;
    __device__ __forceinline__ void operator()(const f32x4 (&acc)[2][2][4][2], const pg8::Unit& u, int wr, int wc, int fr, int fq) const {
        pg8::fp8_acc_settle();
        const int pnl = u.pn & 3; const int row0 = u.pm * 256 + wr * 64 + fr, col0 = pnl * 256 + wc * 32 + 8 * fq;
#pragma unroll
        for (int bj = 0; bj < 2; ++bj) { const float* sp = sw + (size_t)u.pn * 256 + wc * 32 + 8 * fq + bj * 128; const float4 sa = *(const float4*)sp, sb = *(const float4*)(sp + 4);
#pragma unroll
            for (int ai = 0; ai < 2; ++ai)
#pragma unroll
                for (int m = 0; m < 4; ++m) { const int r = row0 + ai * 128 + m * 16; const float gt = gate[r]; const f32x4 v0 = acc[ai][bj][m][0], v1 = acc[ai][bj][m][1];
                    u32x4 w; w.x = pack2(v0[0] * (gt * sa.x), v0[1] * (gt * sa.y)); w.y = pack2(v0[2] * (gt * sa.z), v0[3] * (gt * sa.w)); w.z = pack2(v1[0] * (gt * sb.x), v1[1] * (gt * sb.y)); w.w = pack2(v1[2] * (gt * sb.z), v1[3] * (gt * sb.w));
                    *(u32x4*)(O + (size_t)r * 1024 + col0 + bj * 128) = w; } }
    }
};

__device__ __forceinline__ void phase_combine(const Params& p, int l) {
    const int lane = threadIdx.x & 63, wv = threadIdx.x >> 6; const int nrow = l == 0 ? NROW : NLAT;
    const float* mod = (const float*)(p.ws + WS_MOD) + (size_t)l * 17 * 6144; const float* g3 = p.in[6] + (l * 4 + 3) * 1024;
    const int* SLOT = (const int*)(p.ws + WS_SLOT); const bf16_t* YE = (const bf16_t*)(p.ws + U_YEXP); bf16_t* A = (bf16_t*)(p.ws + WS_ABUF);
    const int rstep = gridDim.x * 8; int r = blockIdx.x * 8 + wv;
    int nslot = (r < nrow && lane < 16) ? SLOT[(size_t)r * 16 + lane] : -1; float4 nx1[4];
    if (r < nrow) { const float* x1p = xrow(p.out, (const float*)(p.ws + WS_CTXA), r);
#pragma unroll
        for (int i = 0; i < 4; ++i) nx1[i] = *(const float4*)(x1p + i * 256 + lane * 4); }
    for (; r < nrow; r += rstep) { const bool lat = r < NLAT; const int b = lat ? (r >> 11) : ((r - NLAT) >> 8), mbi = lat ? b : 16, xoff = lat ? b * 256 : 4096 + b * 32;
        const float* mb = mod + (size_t)mbi * 6144;
        const int myslot = nslot; float4 xc[4];
#pragma unroll
        for (int i = 0; i < 4; ++i) xc[i] = nx1[i];
        float f[16];
#pragma unroll
        for (int k = 0; k < 16; ++k) f[k] = 0.f;
        unsigned long long mask = __ballot(myslot >= 0);
        while (mask) { int ee[4], sl4[4]; u32x2 w[4][4];
#pragma unroll
            for (int k = 0; k < 4; ++k) { if (mask) { ee[k] = __builtin_ctzll(mask); mask &= mask - 1; sl4[k] = __shfl(myslot, ee[k]); } else { ee[k] = -1; sl4[k] = 0; } }
#pragma unroll
            for (int k = 0; k < 4; ++k) if (ee[k] >= 0) { const bf16_t* yr = YE + ((size_t)ee[k] * XROWS + xoff + sl4[k]) * 1024 + lane * 4;
#pragma unroll
                for (int i = 0; i < 4; ++i) w[k][i] = *(const u32x2*)(yr + i * 256); }
#pragma unroll
            for (int k = 0; k < 4; ++k) if (ee[k] >= 0) {
#pragma unroll
                for (int i = 0; i < 4; ++i) { f[i * 4] += bflo(w[k][i].x); f[i * 4 + 1] += bfhi(w[k][i].x); f[i * 4 + 2] += bflo(w[k][i].y); f[i * 4 + 3] += bfhi(w[k][i].y); } } }
        { const int rn = r + rstep; nslot = (rn < nrow && lane < 16) ? SLOT[(size_t)rn * 16 + lane] : -1;
          if (rn < nrow) { const float* x1p = xrow(p.out, (const float*)(p.ws + WS_CTXA), rn);
#pragma unroll
              for (int i = 0; i < 4; ++i) nx1[i] = *(const float4*)(x1p + i * 256 + lane * 4); } }
        float ss = 0.f;
#pragma unroll
        for (int k = 0; k < 16; ++k) ss += f[k] * f[k];
        ss = wave_sum(ss); const float rs = rsqrtf(ss * (1.0f / 1024.0f) + 1e-6f);
        float* x2 = l == 0 ? xrow_w((float*)(p.ws + WS_XB), (float*)(p.ws + WS_CTXB), r) : p.out + (size_t)r * D;
        float4 xv[4];
#pragma unroll
        for (int i = 0; i < 4; ++i) { const int c = i * 256 + lane * 4; const float4 gg = *(const float4*)(g3 + c), gt = *(const float4*)(mb + 5120 + c); float4 x = xc[i];
            x.x += gt.x * (f[i * 4] * rs * gg.x); x.y += gt.y * (f[i * 4 + 1] * rs * gg.y); x.z += gt.z * (f[i * 4 + 2] * rs * gg.z); x.w += gt.w * (f[i * 4 + 3] * rs * gg.w);
            *(float4*)(x2 + c) = x; xv[i] = x; }
        if (l == 0) { const float* mb1 = mod + (size_t)17 * 6144 + (size_t)mbi * 6144; hnorm_row(p.in[6] + 4 * 1024, mb1, mb1 + 1024, p.ws + WS_ABUF + (size_t)r * 1024, (float*)(p.ws + WS_SH) + r, lane, xv); }
    }
}


#ifndef MK_ONLY
#define MK_ONLY -1
#endif
#define EN(k) (MK_ONLY < 0 || MK_ONLY == (k))
#ifndef MK_DUP
#define MK_DUP 0
#endif
#define NREP(k) ((((MK_DUP) >> (k)) & 1) ? 2 : 1)
constexpr int PH_PER_LAYER = 14, N_PHASES = 1 + 2 * PH_PER_LAYER;
#define IN(k) (lo <= (k) && (k) < hi)
#define SEAM(k) do { if (p.use_bar && IN(k) && IN((k) + 1)) xcd_barrier(bar); } while (0)
template <int l> __device__ __forceinline__ void layer_phases(const Params& p, LAS unsigned char* lds, const XcdBarrier& bar, const int lo, const int hi) {
    const int wv = __builtin_amdgcn_readfirstlane(threadIdx.x >> 6), G = gridDim.x; const int wid = blockIdx.x * 8 + wv, nw = G * 8;
        const int pb = 1 + l * PH_PER_LAYER;
        const float* xl = l == 0 ? p.in[0] : (const float*)(p.ws + WS_XB);
        const float* xc = l == 0 ? p.in[2] : (const float*)(p.ws + WS_CTXB);
        if (EN(0) && IN(pb + 0)) { { if (l == 0) phase_hnorm(p, 0, xl, xc); }
            if ((NREP(0)) == 2) { if (l == 0) phase_hnorm(p, 0, xl, xc); } }
        SEAM(pb + 0);
        if (EN(1) && IN(pb + 1)) { { pg8::Gemm g{(const bf16_t*)(p.ws + WS_ABUF), (const bf16_t*)(p.ws + WS_WIN), NROW, NINP, D / 2}; pg8::StaticOrder S; S.init(NROW, NINP, G, (int)blockIdx.x);
            EpiScaleBf16 E{(bf16_t*)(p.ws + U_P), NINP, (const float*)(p.ws + WS_SH), (const float*)(p.ws + WS_SWIN)}; pg8::gemm_phase<EpiScaleBf16, pg8::StaticOrder, false, 1>(lds, g, S, E, nullptr); }
            if ((NREP(1)) == 2) { pg8::Gemm g{(const bf16_t*)(p.ws + WS_ABUF), (const bf16_t*)(p.ws + WS_WIN), NROW, NINP, D / 2}; pg8::StaticOrder S; S.init(NROW, NINP, G, (int)blockIdx.x);
            EpiScaleBf16 E{(bf16_t*)(p.ws + U_P), NINP, (const float*)(p.ws + WS_SH), (const float*)(p.ws + WS_SWIN)}; pg8::gemm_phase<EpiScaleBf16, pg8::StaticOrder, false, 1>(lds, g, S, E, nullptr); } }
        SEAM(pb + 1);
        if (EN(2) && IN(pb + 2)) { phase_prep(p, l, lds);
            if ((NREP(2)) == 2) phase_prep(p, l, lds); }
        SEAM(pb + 2);
        if (EN(3) && IN(pb + 3)) { { lowrank_items(p, l, wid, nw, lds); if ((G & 31) == 0) s5_pass1_block(p, l, lds); else s5_pass1_items(p, l, wid, nw); }
            if ((NREP(3)) == 2) { lowrank_items(p, l, wid, nw, lds); if ((G & 31) == 0) s5_pass1_block(p, l, lds); else s5_pass1_items(p, l, wid, nw); } }
        SEAM(pb + 3);
        if (EN(4) && IN(pb + 4)) { { s5_carry(p, l); na_items(p, l, wid, nw, lds); }
            if ((NREP(4)) == 2) { s5_carry(p, l); na_items(p, l, wid, nw, lds); } }
        SEAM(pb + 4);
        if (EN(5) && IN(pb + 5)) { { s5_pass2_block(p, l, (int)blockIdx.x, G, lds); if (PRE_DUP == 6) s5_pass2_block(p, l, (int)blockIdx.x, G, lds); rwkv_pre_items(p, l, wid, nw, lds); if (PRE_DUP == 7) rwkv_pre_items(p, l, wid, nw, lds); }
            if ((NREP(5)) == 2) { s5_pass2_block(p, l, (int)blockIdx.x, G, lds); rwkv_pre_items(p, l, wid, nw, lds); } }
        SEAM(pb + 5);
        if (EN(6) && IN(pb + 6)) {
            if (G > 192) { const int bx = (int)blockIdx.x;
                if (bx < 192) rwkv_seq_block(p, l, bx, lds); else s5_glu_block(p, l, bx - 192, G - 192, lds);
                if ((NREP(6)) == 2) { if (bx < 192) rwkv_seq_block(p, l, bx, lds); else s5_glu_block(p, l, bx - 192, G - 192, lds); } }
            else { for (int task = wid; task < 768; task += nw) rwkv_seq_task(p, l, task, lds); s5_glu_items(p, l, wid, nw); } }
        SEAM(pb + 6);
        if (EN(7) && IN(pb + 7)) { rwkv_finish(p, l);
            if ((NREP(7)) == 2) rwkv_finish(p, l); }
        SEAM(pb + 7);
        if (EN(8) && IN(pb + 8)) { { const int M = l == 0 ? NROW : NLAT; pg8::Gemm g{(const bf16_t*)(p.ws + WS_ABUF), (const bf16_t*)(p.ws + WS_WOUT), M, D, D}; pg8::StaticOrder S; S.init(M, D, G, (int)blockIdx.x);
            pg8::EpiBf16<0> E{(bf16_t*)(p.ws + U_Y), D, nullptr, 0, 0}; pg8::gemm_phase<pg8::EpiBf16<0>, pg8::StaticOrder, false>(lds, g, S, E, nullptr); }
            if ((NREP(8)) == 2) { const int M = l == 0 ? NROW : NLAT; pg8::Gemm g{(const bf16_t*)(p.ws + WS_ABUF), (const bf16_t*)(p.ws + WS_WOUT), M, D, D}; pg8::StaticOrder S; S.init(M, D, G, (int)blockIdx.x);
            pg8::EpiBf16<0> E{(bf16_t*)(p.ws + U_Y), D, nullptr, 0, 0}; pg8::gemm_phase<pg8::EpiBf16<0>, pg8::StaticOrder, false>(lds, g, S, E, nullptr); } }
        SEAM(pb + 8);
        if (EN(9) && IN(pb + 9)) { phase_normrouter(p, l, xl, xc, lds);
            if ((NREP(9)) == 2) phase_normrouter(p, l, xl, xc, lds); }
        SEAM(pb + 9);
        if (EN(10) && IN(pb + 10)) { phase_topk(p, l, lds);
            if ((NREP(10)) == 2) phase_topk(p, l, lds); }
        SEAM(pb + 10);
        if (EN(11) && IN(pb + 11)) { { pg8::Gemm g{(const bf16_t*)(p.ws + U_XSEL), (const bf16_t*)(p.ws + WS_WGU), 16 * XROWS, 16 * 5632, D / 2}; GroupedOrder S; S.init(l == 0 ? 18 : 16, 22, 2, G, (int)blockIdx.x);
            EpiSwiGLU E{p.ws + U_HID, (const float*)(p.ws + WS_SXS), (const float*)(p.ws + WS_SW8)}; pg8::gemm_phase<EpiSwiGLU, GroupedOrder, false, 1>(lds, g, S, E, nullptr); }
            if ((NREP(11)) == 2) { pg8::Gemm g{(const bf16_t*)(p.ws + U_XSEL), (const bf16_t*)(p.ws + WS_WGU), 16 * XROWS, 16 * 5632, D / 2}; GroupedOrder S; S.init(l == 0 ? 18 : 16, 22, 2, G, (int)blockIdx.x);
            EpiSwiGLU E{p.ws + U_HID, (const float*)(p.ws + WS_SXS), (const float*)(p.ws + WS_SW8)}; pg8::gemm_phase<EpiSwiGLU, GroupedOrder, false, 1>(lds, g, S, E, nullptr); } }
        SEAM(pb + 11);
        if (EN(12) && IN(pb + 12)) { { pg8::Gemm g{(const bf16_t*)(p.ws + U_HID), (const bf16_t*)(p.ws + WS_WD), 16 * XROWS, 16 * 1024, DE / 2}; GroupedOrder S; S.init(l == 0 ? 18 : 16, 4, 4, G, (int)blockIdx.x);
            EpiGate E{(bf16_t*)(p.ws + U_YEXP), (const float*)(p.ws + WS_SELG), (const float*)(p.ws + WS_SWD)}; pg8::gemm_phase<EpiGate, GroupedOrder, false, 2>(lds, g, S, E, nullptr); }
            if ((NREP(12)) == 2) { pg8::Gemm g{(const bf16_t*)(p.ws + U_HID), (const bf16_t*)(p.ws + WS_WD), 16 * XROWS, 16 * 1024, DE / 2}; GroupedOrder S; S.init(l == 0 ? 18 : 16, 4, 4, G, (int)blockIdx.x);
            EpiGate E{(bf16_t*)(p.ws + U_YEXP), (const float*)(p.ws + WS_SELG), (const float*)(p.ws + WS_SWD)}; pg8::gemm_phase<EpiGate, GroupedOrder, false, 2>(lds, g, S, E, nullptr); } }
        SEAM(pb + 12);
        if (EN(13) && IN(pb + 13)) { { phase_combine(p, l); if (l == 0) convert_weights(p, 1, lds, (int)blockIdx.x, G); }
            if (((l == 0 ? NREP(13) : 1)) == 2) { phase_combine(p, l); if (l == 0) convert_weights(p, 1, lds, (int)blockIdx.x, G); } }
        SEAM(pb + 13);
}
__global__ void __launch_bounds__(NTHR, 2) fwd(Params p) {
    extern __shared__ __attribute__((aligned(16))) unsigned char lds_raw[];
    LAS unsigned char* lds = (LAS unsigned char*)lds_raw;
    const int tid = threadIdx.x;
    if (tid < 4) ((LAS unsigned*)(lds + LDS_MISC))[tid] = 0u;
    __syncthreads();
    XcdBarrier bar; bar.bar = (unsigned*)(p.ws + WS_CTL); bar.x = 0; bar.st = (volatile LAS unsigned*)(lds + LDS_MISC);
    if (p.use_bar) bar = xcd_barrier_post((unsigned*)(p.ws + WS_CTL), (volatile LAS unsigned*)(lds + LDS_MISC));
    if (p.use_bar && tid == 0) { unsigned* xr = (unsigned*)(p.ws + WS_CTL + 32768); ((LAS unsigned*)(lds + LDS_MISC))[2] = xb_xcc_id(); ((LAS unsigned*)(lds + LDS_MISC))[3] = atomicAdd(xr + 64 * xb_xcc_id(), 1u); }
    __syncthreads();
    const int lo = p.ph_lo, hi = p.ph_hi;

    if (EN(100) && IN(0)) { { phase_prologue(p, lds); }
        if ((NREP(14)) == 2) { phase_prologue(p, lds); } }
    SEAM(0);
    layer_phases<0>(p, lds, bar, lo, hi);
    layer_phases<1>(p, lds, bar, lo, hi);
#undef IN
#undef SEAM
}
}

#ifndef MK_ONE_LAUNCH
#define MK_ONE_LAUNCH 1
#endif
extern "C" void kernel_launch(void* const* d_in, const int* in_sizes, int n_in, void* d_out, int out_size, void* d_ws, size_t ws_size, hipStream_t stream) {
    static int grid = 0;
    if (grid == 0) {
        if (n_in != 35 || out_size != mk::NLAT * mk::D || ws_size < mk::WS_END) { fprintf(stderr, "kernel_launch: unexpected problem (n_in %d, out %d, ws %zu < %zu)\n", n_in, out_size, ws_size, (size_t)mk::WS_END); grid = -1; return; }
        int dev = 0, cus = 0, per_cu = 0;
        if (hipGetDevice(&dev) != hipSuccess || hipDeviceGetAttribute(&cus, hipDeviceAttributeMultiprocessorCount, dev) != hipSuccess) { grid = -1; return; }
        if (hipFuncSetAttribute((const void*)mk::fwd, hipFuncAttributeMaxDynamicSharedMemorySize, mk::LDS_BYTES) != hipSuccess) { fprintf(stderr, "kernel_launch: hipFuncSetAttribute failed\n"); grid = -1; return; }
        if (hipOccupancyMaxActiveBlocksPerMultiprocessor(&per_cu, (const void*)mk::fwd, mk::NTHR, mk::LDS_BYTES) != hipSuccess || per_cu < 1) { fprintf(stderr, "kernel_launch: occupancy query says %d\n", per_cu); per_cu = 1; }
        (void)hipGetLastError();
        grid = cus;
    }
    if (grid < 0) return;
    (void)in_sizes;
    if (hipMemsetAsync(d_ws, 0, 65536, stream) != hipSuccess) return;
    mk::Params a{};
    for (int i = 0; i < 35; ++i) a.in[i] = (const float*)d_in[i];
    a.out = (float*)d_out; a.ws = (unsigned char*)d_ws;
#if MK_ONE_LAUNCH
    a.ph_lo = 0; a.ph_hi = mk::N_PHASES; a.use_bar = 1;
    hipLaunchKernelGGL(mk::fwd, dim3(grid), dim3(mk::NTHR), mk::LDS_BYTES, stream, a);
#else
    for (int ph = 0; ph < mk::N_PHASES; ++ph) { a.ph_lo = ph; a.ph_hi = ph + 1; a.use_bar = 0; hipLaunchKernelGGL(mk::fwd, dim3(grid), dim3(mk::NTHR), mk::LDS_BYTES, stream, a); }
#endif
}
```

```cpp
#include <hip/hip_runtime.h>
#include <cstdio>
#include <cstdint>
#define PRE_DUP 0
namespace pg8 {
#define PG8_LAS __attribute__((address_space(3)))
typedef unsigned short bf16_t;
typedef short bf16x8 __attribute__((ext_vector_type(8)));
typedef float f32x4 __attribute__((ext_vector_type(4)));
typedef unsigned u32x4 __attribute__((ext_vector_type(4)));
constexpr int BM = 256, BK = 64, HALF = 128, HTB = HALF * BK * 2  , STAGE_BYTES = 8 * HTB, NXCD = 8, WGM = 8;

__host__ __device__ __forceinline__ int lds_byte(int r, int c) { const int st = (r >> 4) * 2 + (c >> 5), rr = r & 15, cc = c & 31, ob = rr * 64 + cc * 2; return st * 1024 + (ob ^ (((ob >> 9) & 1) << 5)); }
__host__ __device__ __forceinline__ void stage_rc(int b, int& R, int& C) { const int st = b / 1024, sb = b % 1024, swz = sb ^ (((sb >> 9) & 1) << 5); R = (st >> 1) * 16 + swz / 64; C = (st & 1) * 32 + (swz % 64) / 2; }
__host__ __device__ __forceinline__ int perm32(int rho) { const int n = rho >> 4, i = rho & 15; return 8 * (i >> 2) + 4 * n + (i & 3); }

struct Unit { int pm, pn; };
struct Gemm { const bf16_t* A; const bf16_t* Bt; int M, N, K; };

struct StaticOrder {
    int nM, nN, nwg, G, c;
    __host__ __device__ void init(int M, int N, int G_, int c_) { nM = M / BM; nN = N / BM; nwg = nM * nN; G = G_; c = c_; }
    __host__ __device__ bool next(int i, Unit& u) const {
        const long L = (long)i * G + c; if (L >= nwg) return false;
        int wgid = (int)L; { const int q = nwg / NXCD, r = nwg % NXCD, xcd = wgid % NXCD, off = wgid / NXCD; wgid = (xcd < r ? xcd * (q + 1) : r * (q + 1) + (xcd - r) * q) + off; }
        const int nig = WGM * nN, gid = wgid / nig, fm = gid * WGM, gsz = (nM - fm) < WGM ? (nM - fm) : WGM;
        u.pm = fm + ((wgid % nig) % gsz); u.pn = (wgid % nig) / gsz; return true;
    }
    __device__ __forceinline__ void a_ready(const Unit&) const {}
    __device__ __forceinline__ void done(const Unit&) const {}
};
struct CountedOrder : StaticOrder {
    const unsigned* ready; unsigned need; unsigned* tmo;
    __device__ __forceinline__ void a_ready(const Unit& u) const {
        if (threadIdx.x < 64) {
            const unsigned long long t0 = __builtin_amdgcn_s_memrealtime(); unsigned polls = 0;
            while ((unsigned)__builtin_amdgcn_readfirstlane(__hip_atomic_load(ready + 64 * u.pm, __ATOMIC_RELAXED, __HIP_MEMORY_SCOPE_AGENT)) < need) {
                if ((++polls & 255u) == 0u && __builtin_amdgcn_readfirstlane(__hip_atomic_load(tmo, __ATOMIC_RELAXED, __HIP_MEMORY_SCOPE_AGENT)) != 0u) break;
                if (__builtin_amdgcn_s_memrealtime() - t0 > 2000000ull) {
                    if (threadIdx.x == 0) { unsigned expect = 0u; __hip_atomic_compare_exchange_strong(tmo + 1, &expect, 0x600u | (unsigned)(u.pm & 0xff), __ATOMIC_RELAXED, __ATOMIC_RELAXED, __HIP_MEMORY_SCOPE_AGENT); __hip_atomic_store(tmo, 1u, __ATOMIC_RELAXED, __HIP_MEMORY_SCOPE_AGENT); }
                    break; }
                __builtin_amdgcn_s_sleep(2); }
            __builtin_amdgcn_fence(__ATOMIC_ACQUIRE, "agent");
            asm volatile("s_waitcnt vmcnt(0)" ::: "memory");
        }
#if !defined(BROKEN_HOOK_NO_BARRIER)
        asm volatile("" ::: "memory"); __builtin_amdgcn_s_barrier(); asm volatile("" ::: "memory");
#endif
    }
};

__device__ __forceinline__ unsigned cvt_pk_bf16(float lo, float hi) { unsigned r; asm volatile("v_cvt_pk_bf16_f32 %0, %1, %2" : "=v"(r) : "v"(lo), "v"(hi)); return r; }
typedef float f32x2 __attribute__((ext_vector_type(2)));
__device__ __forceinline__ f32x2 gelu_pk(f32x2 v) {
    const f32x2 av = __builtin_elementwise_abs(v), d = av * 0.2316418882f + 1.0f;
    f32x2 t; t.x = __builtin_amdgcn_rcpf(d.x); t.y = __builtin_amdgcn_rcpf(d.y);
    f32x2 q = t * 0.5307027145f + (-0.7265760135f); q = q * t + 0.7107068705f; q = q * t + (-0.142248368f); q = q * t + 0.127414796f; q = q * t;
    const f32x2 s = (v * v) * (-0.72134752044f);
    f32x2 e; e.x = __builtin_amdgcn_exp2f(s.x); e.y = __builtin_amdgcn_exp2f(s.y);
    const f32x2 m = v * (q * e), r = v - m;
    f32x2 o; o.x = v.x < 0.f ? m.x : r.x; o.y = v.y < 0.f ? m.y : r.y; return o;
}

struct EpiF32 {
    static constexpr bool PERM = false, AFTER_DRAIN = false;
    float* C; int ldc; const float* bias;
    __device__ __forceinline__ void operator()(const f32x4 (&acc)[2][2][4][2], const Unit& u, int wr, int wc, int fr, int fq) const {
        const int row0 = u.pm * BM + wr * 64 + fr, col0 = u.pn * BM + wc * 32 + 4 * fq;
        f32x4 bv[2][2];
#pragma unroll
        for (int bj = 0; bj < 2; ++bj)
#pragma unroll
            for (int n = 0; n < 2; ++n) bv[bj][n] = bias ? *(const f32x4*)(bias + col0 + bj * HALF + n * 16) : (f32x4){0.f, 0.f, 0.f, 0.f};
#pragma unroll
        for (int ai = 0; ai < 2; ++ai)
#pragma unroll
            for (int m = 0; m < 4; ++m) { float* rowp = C + (size_t)(row0 + ai * HALF + m * 16) * ldc + col0;
#pragma unroll
                for (int bj = 0; bj < 2; ++bj)
#pragma unroll
                    for (int n = 0; n < 2; ++n) *(f32x4*)(rowp + bj * HALF + n * 16) = acc[ai][bj][m][n] + bv[bj][n]; }
    }
};
template <int ACT  > struct EpiBf16 {
    static constexpr bool PERM = true, AFTER_DRAIN = false;
    bf16_t* O; int ldc; const float* bias; int split_cols; size_t split_stride;
    __device__ __forceinline__ void operator()(const f32x4 (&acc)[2][2][4][2], const Unit& u, int wr, int wc, int fr, int fq) const {
        const int row0 = u.pm * BM + wr * 64 + fr; int colt = u.pn * BM; bf16_t* base = O;
        if (split_cols) { const int t = colt / split_cols; base += (size_t)t * split_stride; colt -= t * split_cols; }
        const int col0 = colt + wc * 32 + 8 * fq, bcol0 = u.pn * BM + wc * 32 + 8 * fq;
        f32x4 bv[2][2];
#pragma unroll
        for (int bj = 0; bj < 2; ++bj)
#pragma unroll
            for (int n = 0; n < 2; ++n) bv[bj][n] = bias ? *(const f32x4*)(bias + bcol0 + bj * HALF + 4 * n) : (f32x4){0.f, 0.f, 0.f, 0.f};
#pragma unroll
        for (int ai = 0; ai < 2; ++ai)
#pragma unroll
            for (int m = 0; m < 4; ++m) { bf16_t* rowp = base + (size_t)(row0 + ai * HALF + m * 16) * ldc + col0;
#pragma unroll
                for (int bj = 0; bj < 2; ++bj) { f32x4 v0 = acc[ai][bj][m][0] + bv[bj][0], v1 = acc[ai][bj][m][1] + bv[bj][1];
                    if (ACT == 1) { f32x2 a = gelu_pk((f32x2){v0[0], v0[1]}), b = gelu_pk((f32x2){v0[2], v0[3]}), c = gelu_pk((f32x2){v1[0], v1[1]}), d = gelu_pk((f32x2){v1[2], v1[3]});
                        v0 = (f32x4){a.x, a.y, b.x, b.y}; v1 = (f32x4){c.x, c.y, d.x, d.y}; }
                    if (ACT == 2) {
#pragma unroll
                        for (int j = 0; j < 4; ++j) { v0[j] = 0.5f * v0[j] * (1.0f + erff(v0[j] * 0.70710678f)); v1[j] = 0.5f * v1[j] * (1.0f + erff(v1[j] * 0.70710678f)); } }
                    u32x4 w; w.x = cvt_pk_bf16(v0[0], v0[1]); w.y = cvt_pk_bf16(v0[2], v0[3]); w.z = cvt_pk_bf16(v1[0], v1[1]); w.w = cvt_pk_bf16(v1[2], v1[3]);
                    *(u32x4*)(rowp + bj * HALF) = w; } }
    }
};

template <int MODE> __device__ __forceinline__ f32x4 pg8_mma(bf16x8 a, bf16x8 b, f32x4 c) {
    if constexpr (MODE == 1) { typedef int i32x4_ __attribute__((ext_vector_type(4))); return __builtin_bit_cast(f32x4, __builtin_amdgcn_mfma_i32_16x16x64_i8(__builtin_bit_cast(i32x4_, a), __builtin_bit_cast(i32x4_, b), __builtin_bit_cast(i32x4_, c), 0, 0, 0)); }
    else return __builtin_amdgcn_mfma_f32_16x16x32_bf16(a, b, c, 0, 0, 0); }
__device__ __forceinline__ f32x4 pg8_mma8(bf16x8 a0, bf16x8 a1, bf16x8 b0, bf16x8 b1, f32x4 c) {
    typedef int i32x4_ __attribute__((ext_vector_type(4))); typedef int i32x8_ __attribute__((ext_vector_type(8)));
    const i32x8_ A = __builtin_shufflevector(__builtin_bit_cast(i32x4_, a0), __builtin_bit_cast(i32x4_, a1), 0, 1, 2, 3, 4, 5, 6, 7), B = __builtin_shufflevector(__builtin_bit_cast(i32x4_, b0), __builtin_bit_cast(i32x4_, b1), 0, 1, 2, 3, 4, 5, 6, 7);
    const int one = 0x7f7f7f7f;
    asm volatile("v_mfma_scale_f32_16x16x128_f8f6f4 %0, %1, %2, %0, %3, %3 op_sel_hi:[0,0,0]" : "+v"(c) : "v"(A), "v"(B), "v"(one));
    return c; }
__device__ __forceinline__ void fp8_acc_settle() { asm volatile("s_nop 7\n\ts_nop 7\n\ts_nop 7" ::: "memory"); }
template <class Epi, class Sched, bool STAMP = false, int MODE = 0>
__device__ __forceinline__ void gemm_phase(PG8_LAS unsigned char* lds, const Gemm g, const Sched& S, const Epi& E, unsigned long long* stamps) {
    const int tid = threadIdx.x, wid = __builtin_amdgcn_readfirstlane(tid >> 6), lane = tid & 63, wr = wid >> 2, wc = wid & 3, fr = lane & 15, fq = lane >> 4;
    const int K = g.K, nt = K / BK;
    int ts_lo = 0, ts_hi = 0, nts = 0; const unsigned long long rt_entry = STAMP ? (unsigned long long)wall_clock64() : 0ull;
#define PG8_STAMP() do { if (STAMP && wid == 0 && nts < 64) { const unsigned long long _c = (unsigned long long)clock64(); \
        ts_lo = (lane == nts) ? (int)(unsigned)_c : ts_lo; ts_hi = (lane == nts) ? (int)(unsigned)(_c >> 32) : ts_hi; ++nts; } } while (0)
    PG8_STAMP();
    unsigned voffA[2], voffB[2];
#pragma unroll
    for (int i = 0; i < 2; ++i) { int R, C; stage_rc(tid * 16 + i * 8192, R, C); const int Rb = Epi::PERM ? ((R & ~31) + perm32(R & 31)) : R;
        voffA[i] = (unsigned)(R * K + C) * 2u; voffB[i] = (unsigned)(Rb * K + C) * 2u; }
    const size_t kstep = (size_t)(BK * 2);
    const size_t hstep = (size_t)HALF * K * 2;
    const size_t tstep = 2 * hstep;
    const unsigned ldsw = (unsigned)wid * 1024u;
    const int aoff = lds_byte(wr * 64 + fr, fq * 8), boff = lds_byte(wc * 32 + fr, fq * 8);
#define PG8_SA(b, h) (((b) * 2 + (h)) * HTB)
#define PG8_SB(b, h) ((4 + (b) * 2 + (h)) * HTB)
#define PG8_STAGE(bufoff, gbase, voff) do { _Pragma("unroll") for (int _i = 0; _i < 2; ++_i) \
        __builtin_amdgcn_global_load_lds((const unsigned*)((const char*)(gbase) + (voff)[_i]), (PG8_LAS unsigned*)(lds + (bufoff) + ldsw + _i * 8192), 16, 0, 0); } while (0)
#define PG8_LDA(dst, b, h) do { _Pragma("unroll") for (int m = 0; m < 4; ++m) _Pragma("unroll") for (int k = 0; k < 2; ++k) dst[m][k] = *(const PG8_LAS bf16x8*)(lds + PG8_SA(b, h) + aoff + m * 2048 + k * 1024); } while (0)
#define PG8_LDB(dst, b, h) do { _Pragma("unroll") for (int n = 0; n < 2; ++n) _Pragma("unroll") for (int k = 0; k < 2; ++k) dst[n][k] = *(const PG8_LAS bf16x8*)(lds + PG8_SB(b, h) + boff + n * 2048 + k * 1024); } while (0)
#define PG8_MMA(ai, bj, At, Bt) do { __builtin_amdgcn_s_setprio(1); _Pragma("unroll") for (int m = 0; m < 4; ++m) _Pragma("unroll") for (int n = 0; n < 2; ++n) { if constexpr (MODE == 2) acc[ai][bj][m][n] = pg8_mma8(Bt[n][0], Bt[n][1], At[m][0], At[m][1], acc[ai][bj][m][n]); else { _Pragma("unroll") for (int k = 0; k < 2; ++k) \
        acc[ai][bj][m][n] = pg8_mma<MODE>(Bt[n][k], At[m][k], acc[ai][bj][m][n]); } } __builtin_amdgcn_s_setprio(0); } while (0)
#define PG8_WAIT_V(n) asm volatile("s_waitcnt vmcnt(" #n ")" ::: "memory")
#define PG8_WAIT_L(n) asm volatile("s_waitcnt lgkmcnt(" #n ")" ::: "memory")
#define PG8_BAR __builtin_amdgcn_s_barrier()
#define PG8_SCHED __builtin_amdgcn_sched_barrier(0)
    Unit cur, nxt; int ui = 0;
    if (!S.next(0, cur)) return;
    f32x4 acc[2][2][4][2];
#pragma unroll
    for (int a = 0; a < 2; ++a)
#pragma unroll
        for (int b = 0; b < 2; ++b)
#pragma unroll
            for (int m = 0; m < 4; ++m)
#pragma unroll
                for (int n = 0; n < 2; ++n) acc[a][b][m][n] = (f32x4){0.f, 0.f, 0.f, 0.f};
    bf16x8 At[4][2], B0[2][2], B1[2][2];
    const char* cA = (const char*)g.A + (size_t)cur.pm * tstep; const char* cB = (const char*)g.Bt + (size_t)cur.pn * tstep;
    S.a_ready(cur);
    PG8_STAGE(PG8_SB(0, 0), cB, voffB); PG8_STAGE(PG8_SA(0, 0), cA, voffA); PG8_STAGE(PG8_SB(0, 1), cB + hstep, voffB); PG8_STAGE(PG8_SA(0, 1), cA + hstep, voffA);
    if (wr == 1) PG8_BAR;
    PG8_WAIT_V(4); PG8_BAR;
    PG8_STAGE(PG8_SB(1, 0), cB + kstep, voffB); PG8_STAGE(PG8_SA(1, 0), cA + kstep, voffA); PG8_STAGE(PG8_SB(1, 1), cB + hstep + kstep, voffB);
    PG8_WAIT_V(6); PG8_BAR;
    PG8_STAMP();
    for (;;) {
        const bool has_next = S.next(ui + 1, nxt);
        const char* nA = has_next ? (const char*)g.A + (size_t)nxt.pm * tstep : cA; const char* nB = has_next ? (const char*)g.Bt + (size_t)nxt.pn * tstep : cB;
        for (int t = 0; t < nt; t += 2) {
            const bool last = (t == nt - 2);
            const char* a1 = cA + (size_t)(t + 1) * kstep;
            const char* a2 = last ? nA : cA + (size_t)(t + 2) * kstep; const char* b2 = last ? nB : cB + (size_t)(t + 2) * kstep;
            const char* a3 = a2 + kstep; const char* b3 = b2 + kstep;
            if (last && has_next) S.a_ready(nxt);
            PG8_LDB(B0, 0, 0); PG8_SCHED; PG8_LDA(At, 0, 0); PG8_STAGE(PG8_SA(1, 1), a1 + hstep, voffA);
            PG8_WAIT_L(8); PG8_BAR; PG8_WAIT_L(0); PG8_MMA(0, 0, At, B0); PG8_BAR; PG8_SCHED;
            PG8_LDB(B1, 0, 1); PG8_STAGE(PG8_SB(0, 0), b2, voffB);
            PG8_BAR; PG8_WAIT_L(0); PG8_MMA(0, 1, At, B1); PG8_BAR;
            PG8_LDA(At, 0, 1); PG8_STAGE(PG8_SA(0, 0), a2, voffA);
            PG8_BAR; PG8_WAIT_L(0); PG8_MMA(1, 0, At, B0); PG8_BAR; PG8_SCHED;
            PG8_STAGE(PG8_SB(0, 1), b2 + hstep, voffB);
            PG8_WAIT_V(6); PG8_BAR; PG8_MMA(1, 1, At, B1); PG8_BAR;
            PG8_LDB(B0, 1, 0); PG8_SCHED; PG8_LDA(At, 1, 0); PG8_STAGE(PG8_SA(0, 1), a2 + hstep, voffA);
            PG8_WAIT_L(8); PG8_BAR; PG8_WAIT_L(0); PG8_MMA(0, 0, At, B0); PG8_BAR; PG8_SCHED;
            PG8_LDB(B1, 1, 1); PG8_STAGE(PG8_SB(1, 0), b3, voffB);
            PG8_BAR; PG8_WAIT_L(0); PG8_MMA(0, 1, At, B1); PG8_BAR;
            PG8_LDA(At, 1, 1); PG8_STAGE(PG8_SA(1, 0), a3, voffA);
            PG8_BAR; PG8_WAIT_L(0); PG8_MMA(1, 0, At, B0); PG8_BAR; PG8_SCHED;
            PG8_STAGE(PG8_SB(1, 1), b3 + hstep, voffB);
            PG8_WAIT_V(6); PG8_BAR; PG8_MMA(1, 1, At, B1); PG8_BAR;
        }
        PG8_STAMP();
        if constexpr (!Epi::AFTER_DRAIN) { E(acc, cur, wr, wc, fr, fq); S.done(cur); }
        PG8_STAMP();
        if (!has_next) break;
#pragma unroll
        for (int a = 0; a < 2; ++a)
#pragma unroll
            for (int b = 0; b < 2; ++b)
#pragma unroll
                for (int m = 0; m < 4; ++m)
#pragma unroll
                    for (int n = 0; n < 2; ++n) acc[a][b][m][n] = (f32x4){0.f, 0.f, 0.f, 0.f};
        cur = nxt; cA = nA; cB = nB; ++ui;
    }
    PG8_WAIT_V(0);
    if (wr == 0) PG8_BAR;
    PG8_BAR;
    if constexpr (Epi::AFTER_DRAIN) { E.fused(acc, cur, wr, wc, fr, fq, lds, wid, lane); S.done(cur); }
    PG8_STAMP();
    if (STAMP && wid == 0) { stamps[lane] = lane < nts ? (((unsigned long long)(unsigned)ts_hi << 32) | (unsigned)ts_lo) : 0ull;
        if (lane == 62) stamps[62] = rt_entry; if (lane == 63) stamps[63] = (unsigned long long)wall_clock64(); }
#undef PG8_STAMP
#undef PG8_SA
#undef PG8_SB
#undef PG8_STAGE
#undef PG8_LDA
#undef PG8_LDB
#undef PG8_MMA
#undef PG8_WAIT_V
#undef PG8_WAIT_L
#undef PG8_BAR
#undef PG8_SCHED
}
}
#define XB_TMO      128
#define XB_XCNT(j)  (256  + 64 * (j))
#define XB_XSUB(j)  (1280 + 64 * (j))
#define XB_XGEN(j)  (2304 + 64 * (j))
#define XB_TOP      3328
#define XB_TOPGEN   3392
#define XCD_BAR_WORDS 3456
#define XB_SPIN_CAP (1u << 18)
#define LAS __attribute__((address_space(3)))

__device__ __forceinline__ unsigned xb_ld(unsigned* p)              { return __hip_atomic_load(p, __ATOMIC_RELAXED, __HIP_MEMORY_SCOPE_AGENT); }
__device__ __forceinline__ unsigned xb_add(unsigned* p, unsigned v) { return __hip_atomic_fetch_add(p, v, __ATOMIC_RELAXED, __HIP_MEMORY_SCOPE_AGENT); }
__device__ __forceinline__ unsigned xb_xcc_id() { return (unsigned)__builtin_amdgcn_s_getreg((3 << 11) | 20) & 0xFu; }
#define XB_SPIN(cond, bar) do { unsigned _sp = 0; while (cond) { __builtin_amdgcn_s_sleep(1); \
    if ((++_sp & 255u) == 0u) { if (xb_ld(&(bar)[XB_TMO])) break; if (_sp > XB_SPIN_CAP) { atomicAdd(&(bar)[XB_TMO], 1u); break; } } } } while (0)

struct XcdBarrier {
    unsigned* bar; unsigned x;
    volatile LAS unsigned* st;
};

__device__ __forceinline__ XcdBarrier xcd_barrier_post(unsigned* bar, volatile LAS unsigned* st) {
    XcdBarrier b; b.bar = bar; b.x = xb_xcc_id(); b.st = st;
    if (threadIdx.x == 0) (void)xb_add(&bar[XB_XCNT(b.x)], 1u);
    return b;
}
__device__ __forceinline__ void xcd_barrier_complete(unsigned* bar, unsigned x, unsigned& nloc, unsigned& nx) {
    const unsigned G = gridDim.x * gridDim.y * gridDim.z;
    unsigned sum, cnt, mine, sp = 0u;
    for (;;) {
        sum = 0u; cnt = 0u; mine = 0u;
#pragma unroll
        for (unsigned j = 0; j < 16; ++j) { const unsigned c = xb_ld(&bar[XB_XCNT(j)]); sum += c; cnt += (c > 0u) ? 1u : 0u; mine = (j == x) ? c : mine; }
        if (sum == G) break;
        __builtin_amdgcn_s_sleep(1);
        if ((++sp & 255u) == 0u) { if (xb_ld(&bar[XB_TMO])) break; if (sp > XB_SPIN_CAP) { atomicAdd(&bar[XB_TMO], 1u); break; } }
    }
    nloc = mine > 0u ? mine : 1u; nx = cnt > 0u ? cnt : 1u;
}

__device__ __forceinline__ void xcd_barrier(const XcdBarrier& b) {
    asm volatile("s_waitcnt vmcnt(0)" ::: "memory");
    __syncthreads();
    if (threadIdx.x == 0) {
        unsigned* bar = b.bar;
        __builtin_amdgcn_s_waitcnt(0);
        unsigned nloc = b.st[0], nx = b.st[1];
        if (nloc == 0u) { xcd_barrier_complete(bar, b.x, nloc, nx); b.st[0] = nloc; b.st[1] = nx; }
        const unsigned old = xb_add(&bar[XB_XSUB(b.x)], 1u);
        const unsigned gen = old / nloc;
        if (old + 1u == (gen + 1u) * nloc) {
            __builtin_amdgcn_fence(__ATOMIC_RELEASE, "agent");
            asm volatile("s_waitcnt vmcnt(0)" ::: "memory");
            const unsigned og = xb_add(&bar[XB_TOP], 1u);
            const unsigned tg = og / nx;
            if (og + 1u == (tg + 1u) * nx) xb_add(&bar[XB_TOPGEN], 1u);
            else XB_SPIN(xb_ld(&bar[XB_TOPGEN]) == tg, bar);
            __builtin_amdgcn_fence(__ATOMIC_ACQUIRE, "agent");
            xb_add(&bar[XB_XGEN(b.x)], 1u);
            asm volatile("s_waitcnt vmcnt(0)" ::: "memory");
        } else {
            XB_SPIN(xb_ld(&bar[XB_XGEN(b.x)]) == gen, bar);
            __builtin_amdgcn_fence(__ATOMIC_ACQUIRE, "agent");
            asm volatile("s_waitcnt vmcnt(0)" ::: "memory");
        }
    }
    __syncthreads();
}

namespace mk {
using pg8::bf16_t; using pg8::bf16x8; using pg8::f32x4; using pg8::u32x4;
typedef unsigned u32x2 __attribute__((ext_vector_type(2)));
typedef short bf16x4 __attribute__((ext_vector_type(4)));
typedef float lf2 __attribute__((ext_vector_type(2)));
typedef float lf4 __attribute__((ext_vector_type(4)));
typedef unsigned lu4 __attribute__((ext_vector_type(4)));

constexpr int D = 1024, NBATCH = 16, SEQ = 2048, CTXL = 256;
constexpr int NLAT = NBATCH * SEQ, NCTX = NBATCH * CTXL, NROW = NLAT + NCTX;
constexpr int NINP = 3072, NIN = 2944;
constexpr int C_Q = 256, C_K = 640, C_V = 1024, C_Z = 1408;
constexpr int DE = 2816;
constexpr int XROWS = 4608;
constexpr int NTHR = 512;
constexpr int LDS_MISC = 131072, LDS_BYTES = 131072 + 256;

constexpr size_t al256(size_t x) { return (x + 255) & ~(size_t)255; }
constexpr size_t WS_CTL = 0;
constexpr size_t WS_MOD = 65536;
constexpr size_t WS_SW = al256(WS_MOD + (size_t)2 * 17 * 6144 * 4);
constexpr size_t SW_W2T = 0, SW_A2T = 98304, SW_G2T = 196608, SW_GLUT = 294912, SW_S5E = 425984, SW_S5W2 = 2523136, SW_STRIDE = 6717440;
constexpr size_t WS_WIN = al256(WS_SW + 2 * SW_STRIDE);
constexpr size_t WS_WOUT = WS_WIN + (size_t)3072 * 1024 * 2;
constexpr size_t WS_WGU = WS_WOUT + (size_t)1024 * 1024 * 2;
constexpr size_t WS_WD = WS_WGU + (size_t)16 * 5632 * 1024 * 2;
constexpr size_t WS_XB = WS_WD + (size_t)16 * 1024 * 2816 * 2;
constexpr size_t WS_CTXA = WS_XB + (size_t)NLAT * D * 4;
constexpr size_t WS_CTXB = WS_CTXA + (size_t)NCTX * D * 4;
constexpr size_t WS_ABUF = WS_CTXB + (size_t)NCTX * D * 4;
constexpr size_t WS_AFF = WS_ABUF + (size_t)NROW * D * 2;
constexpr size_t WS_SLOT = WS_AFF + (size_t)NROW * 16 * 4;
constexpr size_t WS_SELG = WS_SLOT + (size_t)NROW * 16 * 4;
constexpr size_t WS_SW8 = al256(WS_SELG + (size_t)16 * XROWS * 4);
constexpr size_t WS_SX = WS_SW8 + (size_t)16 * 5632 * 4;
constexpr size_t WS_SXS = WS_SX + (size_t)NROW * 4;
constexpr size_t WS_SWIN = WS_SXS + (size_t)16 * XROWS * 4;
constexpr size_t WS_SH = WS_SWIN + (size_t)3072 * 4;
constexpr size_t WS_SWD = WS_SH + (size_t)NROW * 4;
constexpr size_t WS_U = al256(WS_SWD + (size_t)16 * 1024 * 4);
constexpr size_t SZ384 = (size_t)NROW * 384 * 2;
constexpr size_t U_P = WS_U;
constexpr size_t U_QR = U_P + (size_t)NROW * NINP * 2;
constexpr size_t U_KR = U_QR + SZ384;
constexpr size_t U_VT = U_KR + SZ384;
constexpr size_t U_VTC = U_VT + (size_t)16 * 384 * 2048 * 2;
constexpr size_t U_RS = U_VT + SZ384;
constexpr size_t U_KS = U_RS + SZ384;
constexpr size_t U_VS = U_KS + SZ384;
constexpr size_t U_KK = U_VS + SZ384;
constexpr size_t U_ALR = U_KK + SZ384;
constexpr size_t U_LD = U_ALR + SZ384;
constexpr size_t U_AG = U_LD + 2 * SZ384;
constexpr size_t U_G = U_AG + 2 * SZ384;
constexpr size_t U_YRK = U_G + SZ384;
constexpr size_t U_SLOC = U_YRK + 2 * (size_t)NROW * 384 * 4;
constexpr size_t U_SPREV = U_SLOC + (size_t)2304 * 16 * 256 * 4;
constexpr size_t U_YG = U_SPREV + (size_t)2304 * 16 * 256 * 2;
constexpr size_t U_U16 = U_YG + (size_t)NROW * 256 * 2;
constexpr size_t U_MIX_END = U_U16 + (size_t)NROW * 256 * 2;
constexpr int NCHUNK = 192 * 144;
constexpr size_t CH_XP = U_P;
constexpr size_t CH_BK = CH_XP + (size_t)NCHUNK * 4096;
constexpr size_t CH_UL = CH_BK + (size_t)NCHUNK * 4096;
constexpr size_t CH_MM = U_SLOC;
constexpr size_t CH_GT = CH_MM + (size_t)NCHUNK * 1024;
static_assert(CH_UL + (size_t)NCHUNK * 2048 <= U_RS, "chunk buffers overlap live RWKV operands");
static_assert(CH_GT + (size_t)NCHUNK * 256 <= U_SPREV, "chunk buffers overlap S5 states");
constexpr size_t U_Y = WS_U;
constexpr size_t U_XSEL = U_Y + (size_t)NROW * D * 4;
constexpr size_t U_HID = U_XSEL + (size_t)16 * XROWS * 1024 * 2;
constexpr size_t U_YEXP = U_HID + (size_t)16 * XROWS * DE * 2;
constexpr size_t U_FFN_END = U_YEXP + (size_t)16 * XROWS * 1024 * 2;
constexpr size_t WS_END = U_MIX_END > U_FFN_END ? U_MIX_END : U_FFN_END;

struct Params { const float* in[35]; float* out; unsigned char* ws; int ph_lo, ph_hi, use_bar, pad; };

typedef __bf16 hwbf2 __attribute__((ext_vector_type(2)));
__device__ __forceinline__ unsigned pack2(float lo, float hi) { const lf2 v = {lo, hi}; return __builtin_bit_cast(unsigned, __builtin_convertvector(v, hwbf2)); }
__device__ __forceinline__ bf16_t f2bf(float f) { return (bf16_t)(pack2(f, 0.f) & 0xffffu); }
__device__ __forceinline__ float bflo(unsigned w) { return __uint_as_float(w << 16); }
__device__ __forceinline__ float bfhi(unsigned w) { return __uint_as_float(w & 0xffff0000u); }
__device__ __forceinline__ float bf2f(bf16_t b) { return __uint_as_float(((unsigned)b) << 16); }
__device__ __forceinline__ float sigm(float x) { return 1.0f / (1.0f + __expf(-x)); }
__device__ __forceinline__ float wave_sum(float v) {
#pragma unroll
    for (int o = 32; o >= 1; o >>= 1) v += __shfl_xor(v, o);
    return v; }
__device__ __forceinline__ void unpack8(const uint4 w, float (&f)[8]) { f[0] = bflo(w.x); f[1] = bfhi(w.x); f[2] = bflo(w.y); f[3] = bfhi(w.y); f[4] = bflo(w.z); f[5] = bfhi(w.z); f[6] = bflo(w.w); f[7] = bfhi(w.w); }
__device__ __forceinline__ uint4 pack8(const float (&f)[8]) { uint4 w; w.x = pack2(f[0], f[1]); w.y = pack2(f[2], f[3]); w.z = pack2(f[4], f[5]); w.w = pack2(f[6], f[7]); return w; }
__device__ __forceinline__ const float* xrow(const float* lat, const float* ctx, int r) { return r < NLAT ? lat + (size_t)r * D : ctx + (size_t)(r - NLAT) * D; }
__device__ __forceinline__ float* xrow_w(float* lat, float* ctx, int r) { return r < NLAT ? lat + (size_t)r * D : ctx + (size_t)(r - NLAT) * D; }
__device__ __forceinline__ f32x4 mfma16(bf16x8 a, bf16x8 b, f32x4 c) { return __builtin_amdgcn_mfma_f32_16x16x32_bf16(a, b, c, 0, 0, 0); }

__device__ __forceinline__ void tr_tile(const float* __restrict__ src, int ldsrc, int k0, int n0, bf16_t* __restrict__ dst, int lddst, int drow0, LAS unsigned* T) {
    const int tid = threadIdx.x, n4 = tid & 15, kq = tid >> 4;
    const float4 a = *(const float4*)(src + (size_t)(k0 + 2 * kq) * ldsrc + n0 + 4 * n4);
    const float4 b = *(const float4*)(src + (size_t)(k0 + 2 * kq + 1) * ldsrc + n0 + 4 * n4);
    T[(4 * n4 + 0) * 33 + kq] = pack2(a.x, b.x); T[(4 * n4 + 1) * 33 + kq] = pack2(a.y, b.y);
    T[(4 * n4 + 2) * 33 + kq] = pack2(a.z, b.z); T[(4 * n4 + 3) * 33 + kq] = pack2(a.w, b.w);
    __syncthreads();
    const int n = tid >> 3, pc = tid & 7;
    uint4 v; v.x = T[n * 33 + 4 * pc]; v.y = T[n * 33 + 4 * pc + 1]; v.z = T[n * 33 + 4 * pc + 2]; v.w = T[n * 33 + 4 * pc + 3];
    *(uint4*)(dst + (size_t)(drow0 + n) * lddst + k0 + 8 * pc) = v;
    __syncthreads();
}

__device__ __forceinline__ void tr_tile4(const float* __restrict__ src, int ldsrc, int k0, int n0, bf16_t* __restrict__ dst, int lddst, int drow0, LAS unsigned* T) {
    int tid = threadIdx.x; asm volatile("" : "+v"(tid)); const int n4 = tid & 15, kq = tid >> 4;
    float4 a[4], b[4];
#pragma unroll
    for (int t = 0; t < 4; ++t) { a[t] = *(const float4*)(src + (size_t)(k0 + 2 * kq) * ldsrc + n0 + 64 * t + 4 * n4); b[t] = *(const float4*)(src + (size_t)(k0 + 2 * kq + 1) * ldsrc + n0 + 64 * t + 4 * n4); }
#pragma unroll
    for (int t = 0; t < 4; ++t) { LAS unsigned* Tt = T + t * 64 * 33;
        Tt[(4 * n4 + 0) * 33 + kq] = pack2(a[t].x, b[t].x); Tt[(4 * n4 + 1) * 33 + kq] = pack2(a[t].y, b[t].y); Tt[(4 * n4 + 2) * 33 + kq] = pack2(a[t].z, b[t].z); Tt[(4 * n4 + 3) * 33 + kq] = pack2(a[t].w, b[t].w); }
    __syncthreads();
#pragma unroll
    for (int i = 0; i < 4; ++i) { const int idx = tid + NTHR * i, n = idx >> 3, pc = idx & 7;
        uint4 v; v.x = T[n * 33 + 4 * pc]; v.y = T[n * 33 + 4 * pc + 1]; v.z = T[n * 33 + 4 * pc + 2]; v.w = T[n * 33 + 4 * pc + 3];
        *(uint4*)(dst + (size_t)(drow0 + n) * lddst + k0 + 8 * pc) = v; }
    __syncthreads();
}
template <int NK, int DP, bool FP8> __device__ __forceinline__ void q8_strip(const float* __restrict__ src, int ldsrc, unsigned char* __restrict__ dst, float* __restrict__ scl, LAS unsigned char* lds) {
    LAS float* cmax = (LAS float*)lds;
    LAS unsigned char* T = lds + 8704;
    const int tid = threadIdx.x, n4 = tid & 15, kq = tid >> 4; constexpr float QMAX = FP8 ? 256.0f : 127.0f;
    float mx[4] = {0.f, 0.f, 0.f, 0.f};
#pragma unroll 8
    for (int i = 0; i < 2 * NK; ++i) { const float4 v = *(const float4*)(src + (size_t)(kq + 32 * i) * ldsrc + 4 * n4); mx[0] = fmaxf(mx[0], fabsf(v.x)); mx[1] = fmaxf(mx[1], fabsf(v.y)); mx[2] = fmaxf(mx[2], fabsf(v.z)); mx[3] = fmaxf(mx[3], fabsf(v.w)); }
    __syncthreads();
#pragma unroll
    for (int j = 0; j < 4; ++j) cmax[kq * 64 + 4 * n4 + j] = mx[j];
    __syncthreads();
    if (tid < 64) { float m = 0.f; for (int g = 0; g < 32; ++g) m = fmaxf(m, cmax[g * 64 + tid]); m = fmaxf(m, 1e-20f); scl[tid] = m * (1.0f / QMAX); cmax[32 * 64 + tid] = QMAX / m; }
    __syncthreads();
    float inv[4];
#pragma unroll
    for (int j = 0; j < 4; ++j) inv[j] = cmax[32 * 64 + 4 * n4 + j];
    for (int kg = 0; kg < NK / 4; ++kg) {
        float4 a[4], b[4];
#pragma unroll
        for (int t = 0; t < 4; ++t) { const int kb = (kg * 4 + t) * 64 + 2 * kq; a[t] = *(const float4*)(src + (size_t)kb * ldsrc + 4 * n4); b[t] = *(const float4*)(src + (size_t)(kb + 1) * ldsrc + 4 * n4); }
#pragma unroll
        for (int t = 0; t < 4; ++t) { const float av[4] = {a[t].x, a[t].y, a[t].z, a[t].w}, bv[4] = {b[t].x, b[t].y, b[t].z, b[t].w};
#pragma unroll
            for (int j = 0; j < 4; ++j) { unsigned short w;
                if (FP8) w = (unsigned short)(__builtin_amdgcn_cvt_pk_fp8_f32(av[j] * inv[j], bv[j] * inv[j], 0, false) & 0xffff);
                else { const int q0 = __float2int_rn(av[j] * inv[j]), q1 = __float2int_rn(bv[j] * inv[j]); w = (unsigned short)((q0 & 255) | ((q1 & 255) << 8)); }
                *(LAS unsigned short*)(T + (4 * n4 + j) * 272 + t * 64 + 2 * kq) = w; } }
        __syncthreads();
#pragma unroll
        for (int i = 0; i < 2; ++i) { const int idx = tid + NTHR * i, n = idx >> 4, pc = idx & 15; *(lu4*)(dst + (size_t)n * DP + kg * 256 + 16 * pc) = *(const LAS lu4*)(T + n * 272 + 16 * pc); }
        __syncthreads();
    }
}
__device__ __forceinline__ void q8r_strip(const float* __restrict__ src, int ldsrc, unsigned char* __restrict__ dst, float* __restrict__ scl, LAS unsigned char* lds) {
    LAS float* cmax = (LAS float*)lds;
    int tid = threadIdx.x; asm volatile("" : "+v"(tid)); const int n4 = tid & 15, rg = tid >> 4;
    const float* s0 = src + (size_t)(rg * 32) * ldsrc + 4 * n4;
    lf4 v[32];
#pragma unroll
    for (int i = 0; i < 32; ++i) v[i] = *(const lf4*)(s0 + (size_t)i * ldsrc);
    __builtin_amdgcn_sched_barrier(0);
    float mx[4] = {0.f, 0.f, 0.f, 0.f};
#pragma unroll
    for (int i = 0; i < 32; ++i) {
#pragma unroll
        for (int j = 0; j < 4; ++j) mx[j] = fmaxf(mx[j], fabsf(v[i][j])); }
    __syncthreads();
#pragma unroll
    for (int j = 0; j < 4; ++j) cmax[rg * 64 + 4 * n4 + j] = mx[j];
    __syncthreads();
    if (tid < 64) { float m = 0.f; for (int g = 0; g < 32; ++g) m = fmaxf(m, cmax[g * 64 + tid]); m = fmaxf(m, 1e-20f); scl[tid] = m * (1.0f / 127.0f); cmax[32 * 64 + tid] = 127.0f / m; }
    __syncthreads();
#pragma unroll
    for (int j = 0; j < 4; ++j) { const float inv = cmax[32 * 64 + 4 * n4 + j]; unsigned w[8];
#pragma unroll
        for (int g = 0; g < 8; ++g) { const int q0 = __float2int_rn(v[4 * g][j] * inv), q1 = __float2int_rn(v[4 * g + 1][j] * inv), q2 = __float2int_rn(v[4 * g + 2][j] * inv), q3 = __float2int_rn(v[4 * g + 3][j] * inv);
            w[g] = (unsigned)(q0 & 255) | ((unsigned)(q1 & 255) << 8) | ((unsigned)(q2 & 255) << 16) | ((unsigned)q3 << 24); }
        unsigned char* d = dst + (size_t)(4 * n4 + j) * 1024 + rg * 32;
        *(lu4*)d = (lu4){w[0], w[1], w[2], w[3]}; *(lu4*)(d + 16) = (lu4){w[4], w[5], w[6], w[7]}; }
}
__device__ __forceinline__ void q8d_strip(const float* __restrict__ src, unsigned char* __restrict__ dst, float* __restrict__ scl, LAS unsigned char* lds) {
    LAS float* cmax = (LAS float*)lds;
    int tid = threadIdx.x; asm volatile("" : "+v"(tid)); const int n8 = tid & 7, rg = tid >> 3; const bool v2 = rg < 48;
    unsigned pk[3][16][2]; float mx[4] = {0.f, 0.f, 0.f, 0.f}; lf4 bufA[8], bufB[8];
    auto ld = [&](lf4 (&b)[8], int hr) { const int r = hr >> 1, c = (r == 2 && !v2) ? rg + 64 : rg + 64 * r; const float* sp = src + (size_t)(c * 16 + (hr & 1) * 8) * 1024 + 4 * n8;
#pragma unroll
        for (int i = 0; i < 8; ++i) b[i] = *(const lf4*)(sp + (size_t)i * 1024); };
    auto use = [&](const lf4 (&b)[8], int hr) {
#pragma unroll
        for (int i = 0; i < 8; ++i) {
#pragma unroll
            for (int j = 0; j < 4; ++j) mx[j] = fmaxf(mx[j], fabsf(b[i][j]));
            pk[hr >> 1][(hr & 1) * 8 + i][0] = pack2(b[i][0], b[i][1]); pk[hr >> 1][(hr & 1) * 8 + i][1] = pack2(b[i][2], b[i][3]); } };
    ld(bufA, 0);
#pragma unroll
    for (int h2 = 0; h2 < 3; ++h2) {
        ld(bufB, 2 * h2 + 1); __builtin_amdgcn_sched_barrier(0); use(bufA, 2 * h2);
        if (h2 < 2) ld(bufA, 2 * h2 + 2);
        __builtin_amdgcn_sched_barrier(0); use(bufB, 2 * h2 + 1); }
    __syncthreads();
#pragma unroll
    for (int j = 0; j < 4; ++j) cmax[rg * 32 + 4 * n8 + j] = mx[j];
    __syncthreads();
    if (tid < 32) { float m = 0.f; for (int g = 0; g < 64; ++g) m = fmaxf(m, cmax[g * 32 + tid]); m = fmaxf(m, 1e-20f); scl[tid] = m * (1.0f / 256.0f); cmax[64 * 32 + tid] = 256.0f / m; }
    __syncthreads();
    float inv[4];
#pragma unroll
    for (int j = 0; j < 4; ++j) inv[j] = cmax[64 * 32 + 4 * n8 + j];
#pragma unroll
    for (int r = 0; r < 3; ++r) { if (r == 2 && !v2) continue;
        const int c = rg + 64 * r;
#pragma unroll
        for (int j = 0; j < 4; ++j) { unsigned w[4];
#pragma unroll
            for (int g = 0; g < 4; ++g) { float f[4];
#pragma unroll
                for (int x = 0; x < 4; ++x) { const unsigned u = pk[r][4 * g + x][j >> 1]; f[x] = ((j & 1) ? bfhi(u) : bflo(u)) * inv[j]; }
                unsigned t = (unsigned)__builtin_amdgcn_cvt_pk_fp8_f32(f[0], f[1], 0, false); t = (unsigned)__builtin_amdgcn_cvt_pk_fp8_f32(f[2], f[3], (int)t, true); w[g] = t; }
            *(lu4*)(dst + (size_t)(4 * n8 + j) * DE + c * 16) = (lu4){w[0], w[1], w[2], w[3]}; } }
}
__device__ __forceinline__ void gu_strip(const Params& p, int l, int item, LAS unsigned char* lds) {
    const int e = item / 88, rem = item % 88, up = rem / 44, nt = rem % 44, n0 = nt * 64, drow0 = (n0 >> 7) * 256 + (n0 & 127) + (up ? 128 : 0);
    q8r_strip(p.in[up ? 33 : 32] + (size_t)(l * 16 + e) * 1024 * DE + n0, DE, p.ws + WS_WGU + ((size_t)e * 5632 + drow0) * 1024, (float*)(p.ws + WS_SW8) + (size_t)e * 5632 + drow0, lds);
}
constexpr int CV_EARLY = 896;
constexpr int CV_GU = 16 * 88, CV_D4 = 16 * 32, CV_WIN = 46, CV_PAD = 16, CV_WOUT4 = 16 * 4, CV_TOTAL = CV_GU + CV_D4 + CV_WIN + CV_PAD + CV_WOUT4;
__device__ __forceinline__ void convert_weights(const Params& p, int l, LAS unsigned char* lds, int vb, int nvb, int lo = 0, int hi = CV_TOTAL) {
    LAS unsigned* T = (LAS unsigned*)lds; bf16_t* WOUT = (bf16_t*)(p.ws + WS_WOUT);
    for (int it = lo + vb; it < hi; it += nvb) {
        int j = it;
        if (j < CV_GU) { gu_strip(p, l, j, lds); continue; }
        j -= CV_GU;
        if (j < CV_D4) { const int e = j >> 5, nt = j & 31;
            q8d_strip(p.in[34] + (size_t)(l * 16 + e) * DE * 1024 + nt * 32, p.ws + WS_WD + ((size_t)e * 1024 + nt * 32) * DE, (float*)(p.ws + WS_SWD) + e * 1024 + nt * 32, lds); continue; }
        j -= CV_D4;
        if (j < CV_WIN) { q8r_strip(p.in[7] + (size_t)l * 1024 * NIN + j * 64, NIN, p.ws + WS_WIN + (size_t)j * 64 * 1024, (float*)(p.ws + WS_SWIN) + j * 64, lds); continue; }
        j -= CV_WIN;
        if (j < CV_PAD) { const size_t o = (size_t)NIN * 1024 + ((size_t)j * NTHR + threadIdx.x) * 16; *(uint4*)(p.ws + WS_WIN + o) = make_uint4(0u, 0u, 0u, 0u);
            if (j == 0 && threadIdx.x < 128) ((float*)(p.ws + WS_SWIN))[NIN + threadIdx.x] = 0.f; continue; }
        j -= CV_PAD;
        { const int kt = j >> 2, ng = j & 3; tr_tile4(p.in[8] + (size_t)l * 1024 * 1024, 1024, kt * 64, ng * 256, WOUT, 1024, ng * 256, T); }
    }
}

__device__ __forceinline__ void mod_item(const Params& p, int item, LAS unsigned char* lds) {
    LAS float* sc = (LAS float*)lds;
    LAS float* red = (LAS float*)(lds + 69632);
    const int tid = threadIdx.x, l = item / 96, cg = item % 96;
    for (int i = tid; i < 17 * 1024; i += NTHR) { const int b = i >> 10, k = i & 1023; const float c = b < 16 ? p.in[1][b * 1024 + k] : p.in[3][k]; sc[k * 17 + b] = c * sigm(c); }
    __syncthreads();
    const int col = cg * 64 + (tid & 63), kg = tid >> 6;
    float acc[17];
#pragma unroll
    for (int b = 0; b < 17; ++b) acc[b] = 0.f;
    const float* w = p.in[4] + ((size_t)l * 1024 + kg * 128) * 6144 + col;
#pragma unroll 4
    for (int kk = 0; kk < 128; ++kk) { const float wv = w[(size_t)kk * 6144]; const LAS float* s = sc + (kg * 128 + kk) * 17;
#pragma unroll
        for (int b = 0; b < 17; ++b) acc[b] += s[b] * wv; }
#pragma unroll
    for (int b = 0; b < 17; ++b) red[(kg * 17 + b) * 64 + (tid & 63)] = acc[b];
    __syncthreads();
    for (int i = tid; i < 17 * 64; i += NTHR) { const int b = i >> 6, c = i & 63; float s = 0.f;
#pragma unroll
        for (int g = 0; g < 8; ++g) s += red[(g * 17 + b) * 64 + c];
        ((float*)(p.ws + WS_MOD))[((size_t)l * 17 + b) * 6144 + cg * 64 + c] = s + p.in[5][l * 6144 + cg * 64 + c]; }
    __syncthreads();
}

__device__ __forceinline__ void s5mat_item(const Params& p, int item, LAS unsigned char* lds) {
    LAS lf2* pw = (LAS lf2*)lds;
    LAS lf2* bb = (LAS lf2*)(lds + 17408);
    LAS lf2* cc = (LAS lf2*)(lds + 17408 + 16384);
    LAS float* KT = (LAS float*)(lds + 17408 + 32768);
    const int tid = threadIdx.x, l = item >> 4, g = item & 15;
    for (int i = tid; i < 2 * 17 * 64; i += NTHR) { const int pp = i & 63, n = (i >> 6) % 17, d = i / (17 * 64);
        const int li = ((l * 2 + d) * 16 + g) * 64 + pp; const float lr = p.in[9][li], lim = p.in[10][li], dt = expf(p.in[11][(l * 2 + d) * 16 + g]);
        const float mag = expf((float)n * dt * lr); float s, c; sincosf((float)n * dt * lim, &s, &c); pw[i] = (lf2){mag * c, mag * s}; }
    for (int i = tid; i < 2 * 64 * 16; i += NTHR) { const int h = i & 15, pp = (i >> 4) & 63, d = i >> 10;
        const int li = ((l * 2 + d) * 16 + g) * 64 + pp; const float lr = p.in[9][li], lim = p.in[10][li], dt = expf(p.in[11][(l * 2 + d) * 16 + g]);
        const float mag = expf(dt * lr); float s, c; sincosf(dt * lim, &s, &c); const float x = mag * c - 1.0f, y = mag * s;
        const float den = 1.0f / (lr * lr + lim * lim); const float cr = (x * lr + y * lim) * den, ci = (y * lr - x * lim) * den;
        const int bi = ((l * 16 + g) * 64 + pp) * 16 + h; const float br = p.in[12][bi], bim = p.in[13][bi];
        bb[i] = (lf2){cr * br - ci * bim, cr * bim + ci * br}; }
    for (int i = tid; i < 2 * 16 * 64; i += NTHR) { const int pp = i & 63, h = (i >> 6) & 15, d = i >> 10;
        const int ci = (((l * 2 + d) * 16 + g) * 16 + h) * 64 + pp; cc[i] = (lf2){p.in[14][ci], p.in[15][ci]}; }
    __syncthreads();
    for (int i = tid; i < 2 * 16 * 256; i += NTHR) { const int h2 = i & 15, h = (i >> 4) & 15, tau = (i >> 8) & 15, d = i >> 12; float s = 0.f;
        for (int pp = 0; pp < 64; ++pp) { const lf2 c = cc[(d * 16 + h) * 64 + pp], w = pw[(d * 17 + tau) * 64 + pp], b = bb[(d * 64 + pp) * 16 + h2];
            const float tr = c.x * w.x - c.y * w.y, ti = c.x * w.y + c.y * w.x; s += tr * b.x - ti * b.y; }
        KT[i] = s; }
    __syncthreads();
    bf16_t* E = (bf16_t*)(p.ws + WS_SW + (size_t)l * SW_STRIDE + SW_S5E) + (size_t)g * 256 * 256;
    bf16_t* W2 = (bf16_t*)(p.ws + WS_SW + (size_t)l * SW_STRIDE + SW_S5W2) + (size_t)g * 256 * 512;
    for (int i = tid; i < 256 * 256; i += NTHR) { const int k = i & 255, n = i >> 8; const int s = k >> 4, h = k & 15, d = n >> 7, part = (n >> 6) & 1, pp = n & 63;
        const int e = d == 0 ? 15 - s : s; const lf2 w = pw[(d * 17 + e) * 64 + pp], b = bb[(d * 64 + pp) * 16 + h];
        E[i] = f2bf(part ? (w.x * b.y + w.y * b.x) : (w.x * b.x - w.y * b.y)); }
    for (int i = tid; i < 256 * 512; i += NTHR) { const int k = i & 511, n = i >> 9; const int t = n >> 4, h = n & 15; float v;
        if (k < 256) { const int s = k >> 4, h2 = k & 15; v = 0.f;
            if (t >= s) v += KT[((0 * 16 + (t - s)) * 16 + h) * 16 + h2];
            if (s >= t) v += KT[((1 * 16 + (s - t)) * 16 + h) * 16 + h2];
            if (s == t && h == h2) v += p.in[16][l * 256 + g * 16 + h]; }
        else { const int q = k - 256, d = q >> 7, part = (q >> 6) & 1, pp = q & 63; const int e = d == 0 ? t + 1 : 16 - t;
            const lf2 c = cc[(d * 16 + h) * 64 + pp], w = pw[(d * 17 + e) * 64 + pp];
            v = part ? -(c.x * w.y + c.y * w.x) : (c.x * w.x - c.y * w.y); }
        W2[i] = f2bf(v); }
    __syncthreads();
}

__device__ __forceinline__ void smallw_item(const Params& p, int item) {
    int i = item * NTHR + threadIdx.x; const int l = i / 212992; i %= 212992;
    unsigned char* sw = p.ws + WS_SW + (size_t)l * SW_STRIDE;
    if (i < 49152) { const int k = i & 63, n = (i >> 6) % 384, d = i / 24576; ((bf16_t*)(sw + SW_W2T))[i] = f2bf(p.in[22][((size_t)(l * 2 + d) * 64 + k) * 384 + n]); return; }
    i -= 49152;
    if (i < 49152) { const int k = i & 63, n = (i >> 6) % 384, d = i / 24576; ((bf16_t*)(sw + SW_A2T))[i] = f2bf(p.in[24][((size_t)(l * 2 + d) * 64 + k) * 384 + n]); return; }
    i -= 49152;
    if (i < 49152) { const int k = i & 127, n = i >> 7; ((bf16_t*)(sw + SW_G2T))[i] = f2bf(p.in[25][((size_t)l * 128 + k) * 384 + n]); return; }
    i -= 49152;
    { const int k = i & 255, n = i >> 8; ((bf16_t*)(sw + SW_GLUT))[i] = f2bf(p.in[17][((size_t)l * 256 + k) * 256 + n]); }
}

constexpr int PRO_MOD = 192, PRO_S5 = 32, PRO_SW = 832;
__device__ __forceinline__ void phase_prologue(const Params& p, LAS unsigned char* lds) {
    for (int it = blockIdx.x; it < PRO_MOD + PRO_S5 + PRO_SW; it += gridDim.x) {
        if (it < PRO_MOD) mod_item(p, it, lds);
        else if (it < PRO_MOD + PRO_S5) s5mat_item(p, it - PRO_MOD, lds);
        else smallw_item(p, it - PRO_MOD - PRO_S5);
    }
    convert_weights(p, 0, lds, (int)blockIdx.x, (int)gridDim.x);
}

__device__ __forceinline__ void hnorm_row(const float* g, const float* mb_sh, const float* mb_sc, unsigned char* dst, float* sdst, int lane, const float4 (&v)[4]) {
    float ss = 0.f;
#pragma unroll
    for (int i = 0; i < 4; ++i) ss += v[i].x * v[i].x + v[i].y * v[i].y + v[i].z * v[i].z + v[i].w * v[i].w;
    ss = wave_sum(ss); const float rs = rsqrtf(ss * (1.0f / 1024.0f) + 1e-6f);
    float hv[4][4]; float amax = 0.f;
#pragma unroll
    for (int i = 0; i < 4; ++i) { const int c = i * 256 + lane * 4; const float4 gg = *(const float4*)(g + c), sh = *(const float4*)(mb_sh + c), sc = *(const float4*)(mb_sc + c);
        hv[i][0] = v[i].x * rs * gg.x * (1.f + sc.x) + sh.x; hv[i][1] = v[i].y * rs * gg.y * (1.f + sc.y) + sh.y; hv[i][2] = v[i].z * rs * gg.z * (1.f + sc.z) + sh.z; hv[i][3] = v[i].w * rs * gg.w * (1.f + sc.w) + sh.w;
        amax = fmaxf(amax, fmaxf(fmaxf(fabsf(hv[i][0]), fabsf(hv[i][1])), fmaxf(fabsf(hv[i][2]), fabsf(hv[i][3])))); }
#pragma unroll
    for (int o = 32; o >= 1; o >>= 1) amax = fmaxf(amax, __shfl_xor(amax, o));
    amax = fmaxf(amax, 1e-20f); const float qs = 127.0f / amax;
    if (lane == 0) *sdst = amax * (1.0f / 127.0f);
#pragma unroll
    for (int i = 0; i < 4; ++i) { unsigned w = 0u;
#pragma unroll
        for (int k = 0; k < 4; ++k) w |= ((unsigned)__float2int_rn(hv[i][k] * qs) & 255u) << (8 * k);
        *(unsigned*)(dst + i * 256 + lane * 4) = w; }
}
__device__ __forceinline__ void phase_hnorm(const Params& p, int l, const float* xl, const float* xc) {
    const int lane = threadIdx.x & 63, wv = threadIdx.x >> 6;
    const float* mod = (const float*)(p.ws + WS_MOD) + (size_t)l * 17 * 6144; const float* g = p.in[6] + (l * 4 + 0) * 1024;
    unsigned char* A = p.ws + WS_ABUF; float* SH = (float*)(p.ws + WS_SH);
    for (int r = blockIdx.x * 8 + wv; r < NROW; r += gridDim.x * 8) {
        const float* src = xrow(xl, xc, r); const int b = r < NLAT ? (r >> 11) : 16; const float* mb = mod + (size_t)b * 6144;
        float4 v[4];
#pragma unroll
        for (int i = 0; i < 4; ++i) v[i] = *(const float4*)(src + i * 256 + lane * 4);
        hnorm_row(g, mb, mb + 1024, A + (size_t)r * 1024, SH + r, lane, v);
    }
}


__device__ __forceinline__ void phase_prep(const Params& p, int l, LAS unsigned char* lds) {
    LAS bf16_t* vt = (LAS bf16_t*)lds;
    LAS lf2* cs = (LAS lf2*)(lds + 50176);
    const int tid = threadIdx.x;
    for (int i = tid; i < 1024; i += NTHR) { const int pos = i >> 4, j = i & 15; const float invf = exp2f(-(float)j * (13.287712379549449f / 16.0f)); float s, c; sincosf((float)pos * invf, &s, &c); cs[i] = (lf2){c, s}; }
    __syncthreads();
    const bf16_t* P = (const bf16_t*)(p.ws + U_P);
    bf16_t* QR = (bf16_t*)(p.ws + U_QR); bf16_t* KR = (bf16_t*)(p.ws + U_KR);
    bf16_t* RS = (bf16_t*)(p.ws + U_RS); bf16_t* KS = (bf16_t*)(p.ws + U_KS); bf16_t* VS = (bf16_t*)(p.ws + U_VS); bf16_t* KK = (bf16_t*)(p.ws + U_KK); bf16_t* ALR = (bf16_t*)(p.ws + U_ALR);
    for (int ti = blockIdx.x; ti < NROW / 64; ti += gridDim.x) {
        const int r0 = ti * 64; const bool lat = r0 < NLAT; const int b = lat ? (r0 >> 11) : ((r0 - NLAT) >> 8), t0 = lat ? (r0 & 2047) : ((r0 - NLAT) & 255), slen = lat ? SEQ : CTXL;
#pragma unroll
        for (int i = 0; i < 6; ++i) { const int idx = tid + NTHR * i, tok = idx / 48, pc = idx % 48;
            *(LAS lu4*)(vt + tok * 392 + pc * 8) = *(const lu4*)(P + (size_t)(r0 + tok) * NINP + C_V + pc * 8); }
        __syncthreads();
        { bf16_t* vdst = lat ? (bf16_t*)(p.ws + U_VT) + (size_t)b * 384 * 2048 + t0 : (bf16_t*)(p.ws + U_VTC) + (size_t)b * 384 * 256 + t0;
#pragma unroll
          for (int i = 0; i < 6; ++i) { const int idx = tid + NTHR * i, hd = idx >> 3, pc = idx & 7; unsigned w[4];
#pragma unroll
              for (int j = 0; j < 4; ++j) w[j] = (unsigned)vt[(pc * 8 + 2 * j) * 392 + hd] | ((unsigned)vt[(pc * 8 + 2 * j + 1) * 392 + hd] << 16);
              *(uint4*)(vdst + (size_t)hd * slen + pc * 8) = make_uint4(w[0], w[1], w[2], w[3]); } }
#pragma unroll
        for (int i = 0; i < 4; ++i) { const int idx = tid + NTHR * i, tok = idx >> 5, pc = idx & 31;
            *(lu4*)((bf16_t*)(p.ws + U_U16) + (size_t)(r0 + tok) * 256 + pc * 8) = *(const lu4*)(P + (size_t)(r0 + tok) * NINP + pc * 8); }
        { lu4 rx[6][2]; int tq = threadIdx.x; asm volatile("" : "+v"(tq));
#pragma unroll
          for (int i = 0; i < 6; ++i) { const int idx = tq + NTHR * i, tok = idx / 48, rem = idx % 48, qk = rem / 24, rem2 = rem % 24, h = rem2 >> 2, pp = rem2 & 3;
              const int d1 = (pp >> 1) * 32 + (pp & 1) * 8; const size_t so = (size_t)(r0 + tok) * NINP + (qk ? C_K : C_Q) + h * 64 + d1;
              rx[i][0] = *(const lu4*)(P + so); rx[i][1] = *(const lu4*)(P + so + 16); }
#pragma unroll
          for (int i = 0; i < 6; ++i) { const int idx = tq + NTHR * i, tok = idx / 48, rem = idx % 48, qk = rem / 24, rem2 = rem % 24, h = rem2 >> 2, pp = rem2 & 3;
              const int d1 = (pp >> 1) * 32 + (pp & 1) * 8;
              float x1[8], x2[8], o1[8], o2[8]; unpack8(make_uint4(rx[i][0].x, rx[i][0].y, rx[i][0].z, rx[i][0].w), x1); unpack8(make_uint4(rx[i][1].x, rx[i][1].y, rx[i][1].z, rx[i][1].w), x2);
              const int t = t0 + tok, pos = (pp < 2) ? (t >> 6) : (t & 63), j0 = (pp & 1) * 8; const float scl = qk ? 1.0f : 0.125f;
#pragma unroll
              for (int j = 0; j < 8; ++j) { lf2 c = cs[pos * 16 + j0 + j]; if (!lat) c = (lf2){1.f, 0.f}; o1[j] = (x1[j] * c.x - x2[j] * c.y) * scl; o2[j] = (x1[j] * c.y + x2[j] * c.x) * scl; }
              bf16_t* dq = (qk ? KR : QR) + (size_t)(r0 + tok) * 384 + h * 64 + d1; *(uint4*)dq = pack8(o1); *(uint4*)(dq + 16) = pack8(o2); } }
#pragma unroll 1
        for (int ig = 0; ig < 6; ++ig) { lu4 zc[4], zq[4], zn[4]; int ts = threadIdx.x; asm volatile("" : "+v"(ts));
#pragma unroll
            for (int u = 0; u < 4; ++u) { const int idx = ts + NTHR * (ig * 4 + u), tok = idx / 192, pc = idx % 192, t = t0 + tok; const bf16_t* zp = P + (size_t)(r0 + tok) * NINP + C_Z + pc * 8;
                zc[u] = *(const lu4*)zp; zq[u] = t > 0 ? *(const lu4*)(zp - NINP) : (lu4){0u, 0u, 0u, 0u}; zn[u] = t < slen - 1 ? *(const lu4*)(zp + NINP) : (lu4){0u, 0u, 0u, 0u}; }
#pragma unroll
            for (int u = 0; u < 4; ++u) { const int idx = ts + NTHR * (ig * 4 + u), tok = idx / 192, pc = idx % 192, c0 = pc * 8, r = r0 + tok;
                float x[8], pv[8], nx[8], zs[8];
                unpack8(make_uint4(zc[u].x, zc[u].y, zc[u].z, zc[u].w), x); unpack8(make_uint4(zq[u].x, zq[u].y, zq[u].z, zq[u].w), pv); unpack8(make_uint4(zn[u].x, zn[u].y, zn[u].z, zn[u].w), nx);
                const float4 mu0 = *(const float4*)(p.in[20] + l * 1536 + c0), mu1 = *(const float4*)(p.in[20] + l * 1536 + c0 + 4); const float mu[8] = {mu0.x, mu0.y, mu0.z, mu0.w, mu1.x, mu1.y, mu1.z, mu1.w};
#pragma unroll
                for (int j = 0; j < 8; ++j) zs[j] = x[j] + (0.5f * (pv[j] + nx[j]) - x[j]) * mu[j];
                const bool isk = c0 >= 384 && c0 < 768; float kv[8]; float ss = 0.f;
                { const int kc = isk ? c0 - 384 : 0; const float4 k0 = *(const float4*)(p.in[26] + l * 384 + kc), k1 = *(const float4*)(p.in[26] + l * 384 + kc + 4); const float kkw[8] = {k0.x, k0.y, k0.z, k0.w, k1.x, k1.y, k1.z, k1.w};
#pragma unroll
                  for (int j = 0; j < 8; ++j) { kv[j] = zs[j] * kkw[j]; ss += kv[j] * kv[j]; } }
                ss += __shfl_xor(ss, 1); ss += __shfl_xor(ss, 2); ss += __shfl_xor(ss, 4);
                if (c0 < 384) *(uint4*)(RS + (size_t)r * 384 + c0) = pack8(zs);
                else if (c0 < 768) { *(uint4*)(KS + (size_t)r * 384 + c0 - 384) = pack8(zs); const float inv = 1.0f / fmaxf(sqrtf(ss), 1e-12f);
#pragma unroll
                    for (int j = 0; j < 8; ++j) kv[j] *= inv;
                    *(uint4*)(KK + (size_t)r * 384 + c0 - 384) = pack8(kv); }
                else if (c0 < 1152) *(uint4*)(VS + (size_t)r * 384 + c0 - 768) = pack8(zs);
                else { const int ac = c0 - 1152; float o[8];
#pragma unroll
                    for (int j = 0; j < 8; ++j) o[j] = ac < 128 ? 1.0f - 2.0f / (1.0f + __expf(2.0f * zs[j])) : (ac < 256 ? zs[j] : sigm(zs[j]));
                    *(uint4*)(ALR + (size_t)r * 384 + ac) = pack8(o); } }
        }
        __syncthreads();
    }
}

template <int KS, int MODE> __device__ __forceinline__ void lr_wave(const Params& p, int l, int row0, int kofs, const bf16_t* Bt, int d) {
    const int lane = threadIdx.x & 63, m = lane & 15, q = lane >> 4;
    const bf16_t* Ap = (const bf16_t*)(p.ws + U_ALR) + (size_t)(row0 + m) * 384 + kofs + q * 8;
    bf16x8 a[KS];
#pragma unroll
    for (int ks = 0; ks < KS; ++ks) a[ks] = *(const bf16x8*)(Ap + ks * 32);
    bf16_t* O = (bf16_t*)(p.ws + (MODE == 0 ? U_LD + (size_t)d * SZ384 : (MODE == 1 ? U_AG + (size_t)d * SZ384 : U_G))) + (size_t)(row0 + m) * 384;
    const float* bias = MODE == 0 ? p.in[21] + (l * 2 + d) * 384 : p.in[23] + (l * 2 + d) * 384;
    for (int nt = 0; nt < 24; ++nt) {
        f32x4 acc = (f32x4){0.f, 0.f, 0.f, 0.f};
#pragma unroll
        for (int ks = 0; ks < KS; ++ks) { const bf16x8 bfr = *(const bf16x8*)(Bt + (size_t)(nt * 16 + m) * (KS * 32) + ks * 32 + q * 8); acc = mfma16(bfr, a[ks], acc); }
        const int n = nt * 16 + q * 4; float o[4];
        if (MODE == 2) {
#pragma unroll
            for (int j = 0; j < 4; ++j) o[j] = acc[j];
        } else { const float4 bv = *(const float4*)(bias + n); const float bb[4] = {bv.x, bv.y, bv.z, bv.w};
#pragma unroll
            for (int j = 0; j < 4; ++j) { const float s = sigm(bb[j] + acc[j]); o[j] = MODE == 0 ? -0.6065306597f * s : s; } }
        u32x2 w; w.x = pack2(o[0], o[1]); w.y = pack2(o[2], o[3]); *(u32x2*)(O + n) = w;
    }
}
template <int KS, int MODE> __device__ __forceinline__ void lr_block(const Params& p, int l, const bf16_t* Bt, int kofs, int d, int bi, int nb, LAS unsigned char* lds) {
    constexpr int PITCH = KS * 32 + 8;
    LAS bf16_t* sB = (LAS bf16_t*)lds; LAS float* sbias = (LAS float*)(lds + 384 * PITCH * 2);
    const int tid = threadIdx.x, lane = tid & 63, m = lane & 15, q = lane >> 4, wv = tid >> 6;
    const float* bias = MODE == 0 ? p.in[21] + (l * 2 + d) * 384 : p.in[23] + (l * 2 + d) * 384;
    __syncthreads();
    for (int i = tid; i < 384 * KS * 4; i += NTHR) { const int n = i / (KS * 4), pc = i % (KS * 4); *(LAS lu4*)(sB + n * PITCH + pc * 8) = *(const lu4*)(Bt + (size_t)n * (KS * 32) + pc * 8); }
    if (MODE != 2) for (int i = tid; i < 384; i += NTHR) sbias[i] = bias[i];
    __syncthreads();
    bf16_t* Ob = (bf16_t*)(p.ws + (MODE == 0 ? U_LD + (size_t)d * SZ384 : (MODE == 1 ? U_AG + (size_t)d * SZ384 : U_G)));
    for (int rt = bi * 8 + wv; rt < 2304; rt += nb * 8) { const int row0 = rt * 16;
        const bf16_t* Ap = (const bf16_t*)(p.ws + U_ALR) + (size_t)(row0 + m) * 384 + kofs + q * 8;
        bf16x8 a[KS];
#pragma unroll
        for (int ks = 0; ks < KS; ++ks) a[ks] = *(const bf16x8*)(Ap + ks * 32);
        bf16_t* O = Ob + (size_t)(row0 + m) * 384;
#pragma unroll 4
        for (int nt = 0; nt < 24; ++nt) {
            f32x4 acc = (f32x4){0.f, 0.f, 0.f, 0.f};
#pragma unroll
            for (int ks = 0; ks < KS; ++ks) acc = mfma16(*(const LAS bf16x8*)(sB + (nt * 16 + m) * PITCH + ks * 32 + q * 8), a[ks], acc);
            const int n = nt * 16 + q * 4; float o[4];
            if (MODE == 2) {
#pragma unroll
                for (int j = 0; j < 4; ++j) o[j] = acc[j];
            } else { const lf4 bv = *(const LAS lf4*)(sbias + n); const float bb[4] = {bv.x, bv.y, bv.z, bv.w};
#pragma unroll
                for (int j = 0; j < 4; ++j) { const float sg = sigm(bb[j] + acc[j]); o[j] = MODE == 0 ? -0.6065306597f * sg : sg; } }
            u32x2 w; w.x = pack2(o[0], o[1]); w.y = pack2(o[2], o[3]); *(u32x2*)(O + n) = w;
        }
    }
    __syncthreads();
}
__device__ __forceinline__ void lowrank_items(const Params& p, int l, int wid, int nw, LAS unsigned char* lds) {
    const unsigned char* sw = p.ws + WS_SW + (size_t)l * SW_STRIDE; const int G = gridDim.x, bx = blockIdx.x;
    if (G >= 12) {
        const int sh = bx * 6 / G, mm = sh < 4 ? sh : 4; const int lo = (mm * G + 5) / 6, hi = mm < 4 ? ((mm + 1) * G + 5) / 6 : G, bi = bx - lo, nb = hi - lo;
        if (mm < 2) lr_block<2, 0>(p, l, (const bf16_t*)(sw + SW_W2T) + (size_t)mm * 384 * 64, mm * 64, mm, bi, nb, lds);
        else if (mm < 4) lr_block<2, 1>(p, l, (const bf16_t*)(sw + SW_A2T) + (size_t)(mm - 2) * 384 * 64, mm * 64, mm - 2, bi, nb, lds);
        else lr_block<4, 2>(p, l, (const bf16_t*)(sw + SW_G2T), 256, 0, bi, nb, lds);
        return; }
    for (int it = wid; it < 2304 * 5; it += nw) { const int rt = it / 5, m = it % 5, row0 = rt * 16;
        if (m < 2) lr_wave<2, 0>(p, l, row0, m * 64, (const bf16_t*)(sw + SW_W2T) + (size_t)m * 384 * 64, m);
        else if (m < 4) lr_wave<2, 1>(p, l, row0, m * 64, (const bf16_t*)(sw + SW_A2T) + (size_t)(m - 2) * 384 * 64, m - 2);
        else lr_wave<4, 2>(p, l, row0, 256, (const bf16_t*)(sw + SW_G2T), 0); }
}

__device__ __forceinline__ int s5_rowbase(int cr) { const int b = cr / 144, c = cr % 144; return c < 16 ? NLAT + b * 256 + c * 16 : b * 2048 + (c - 16) * 16; }
__device__ __forceinline__ void s5_pass1_items(const Params& p, int l, int wid, int nw) {
    const int lane = threadIdx.x & 63, m = lane & 15, q = lane >> 4;
    const bf16_t* P = (const bf16_t*)(p.ws + U_U16); float* SLOC = (float*)(p.ws + U_SLOC);
    for (int it = wid; it < 144 * 16; it += nw) { const int ct = it >> 4, g = it & 15, cr = ct * 16 + m, rb = s5_rowbase(cr);
        const bf16_t* E = (const bf16_t*)(p.ws + WS_SW + (size_t)l * SW_STRIDE + SW_S5E) + (size_t)g * 256 * 256;
        bf16x8 a[8];
#pragma unroll
        for (int ks = 0; ks < 8; ++ks) a[ks] = *(const bf16x8*)(P + (size_t)(rb + 2 * ks + (q >> 1)) * 256 + g * 16 + (q & 1) * 8);
        float* o = SLOC + ((size_t)cr * 16 + g) * 256 + q * 4;
#pragma unroll 2
        for (int nt = 0; nt < 16; ++nt) { f32x4 acc = (f32x4){0.f, 0.f, 0.f, 0.f}; const bf16_t* ep = E + (size_t)(nt * 16 + m) * 256 + q * 8;
#pragma unroll
            for (int ks = 0; ks < 8; ++ks) acc = mfma16(*(const bf16x8*)(ep + ks * 32), a[ks], acc);
            *(f32x4*)(o + nt * 16) = acc; }
    }
}
__device__ __forceinline__ void s5_pass1_block(const Params& p, int l, LAS unsigned char* lds) {
    constexpr int PITCH = 264;
    LAS bf16_t* sE = (LAS bf16_t*)lds;
    const int tid = threadIdx.x, lane = tid & 63, m = lane & 15, q = lane >> 4, wv = tid >> 6, G = gridDim.x, bx = blockIdx.x;
    const int combo = bx & 31, g = combo >> 1, half = combo & 1, bi = bx >> 5, nb = G >> 5;
    const bf16_t* E = (const bf16_t*)(p.ws + WS_SW + (size_t)l * SW_STRIDE + SW_S5E) + ((size_t)g * 256 + half * 128) * 256;
    const bf16_t* P = (const bf16_t*)(p.ws + U_U16); float* SLOC = (float*)(p.ws + U_SLOC);
    __syncthreads();
    for (int i = tid; i < 128 * 32; i += NTHR) { const int n = i >> 5, pc = i & 31; *(LAS lu4*)(sE + n * PITCH + pc * 8) = *(const lu4*)(E + (size_t)n * 256 + pc * 8); }
    __syncthreads();
    LAS unsigned char* eb = (LAS unsigned char*)(sE + m * PITCH + q * 8); asm volatile("" : "+v"(eb));
    for (int ct = bi * 8 + wv; ct < 144; ct += nb * 8) { const int cr = ct * 16 + m, rb = s5_rowbase(cr);
        bf16x8 a[8];
#pragma unroll
        for (int ks = 0; ks < 8; ++ks) a[ks] = *(const bf16x8*)(P + (size_t)(rb + 2 * ks + (q >> 1)) * 256 + g * 16 + (q & 1) * 8);
        float* o = SLOC + ((size_t)cr * 16 + g) * 256 + half * 128 + q * 4;
#pragma unroll 2
        for (int nt = 0; nt < 8; ++nt) { f32x4 acc = (f32x4){0.f, 0.f, 0.f, 0.f};
#pragma unroll
            for (int ks = 0; ks < 8; ++ks) acc = mfma16(*(const LAS bf16x8*)(eb + nt * 16 * PITCH * 2 + ks * 64), a[ks], acc);
            *(f32x4*)(o + nt * 16) = acc; } }
    __syncthreads();
}
__device__ __forceinline__ void s5_carry(const Params& p, int l) {
    const int gid = blockIdx.x * NTHR + threadIdx.x; if (gid >= 32768) return;
    const int pp = gid & 63, d = (gid >> 6) & 1, g = (gid >> 7) & 15, b = gid >> 11;
    const int li = ((l * 2 + d) * 16 + g) * 64 + pp; const float lr = p.in[9][li], lim = p.in[10][li], dt = expf(p.in[11][(l * 2 + d) * 16 + g]);
    const float mag = expf(16.0f * dt * lr); float sn, cn; sincosf(16.0f * dt * lim, &sn, &cn); const float ar = mag * cn, ai = mag * sn;
    const float* SLOC = (const float*)(p.ws + U_SLOC); bf16_t* SP = (bf16_t*)(p.ws + U_SPREV);
    float sr = 0.f, si = 0.f;
#pragma unroll 8
    for (int n = 0; n < 144; ++n) { const int c = d == 0 ? n : (n < 16 ? 15 - n : 159 - n); const size_t idx = ((size_t)(b * 144 + c) * 16 + g) * 256 + d * 128 + pp;
        SP[idx] = f2bf(sr); SP[idx + 64] = f2bf(si);
        const float xr = SLOC[idx], xi = SLOC[idx + 64]; const float nr = ar * sr - ai * si + xr, ni = ar * si + ai * sr + xi; sr = nr; si = ni; }
}
__device__ __forceinline__ void s5_pass2_items(const Params& p, int l, int wid, int nw) {
    const int lane = threadIdx.x & 63, m = lane & 15, q = lane >> 4;
    const bf16_t* P = (const bf16_t*)(p.ws + U_U16); const bf16_t* SP = (const bf16_t*)(p.ws + U_SPREV); bf16_t* YG = (bf16_t*)(p.ws + U_YG);
    for (int it = wid; it < 144 * 16; it += nw) { const int ct = it >> 4, g = it & 15; if (l == 1 && ct % 9 == 0) continue;
        const int cr = ct * 16 + m, rb = s5_rowbase(cr);
        const bf16_t* W2 = (const bf16_t*)(p.ws + WS_SW + (size_t)l * SW_STRIDE + SW_S5W2) + (size_t)g * 256 * 512;
        bf16x8 a[16];
#pragma unroll
        for (int ks = 0; ks < 8; ++ks) a[ks] = *(const bf16x8*)(P + (size_t)(rb + 2 * ks + (q >> 1)) * 256 + g * 16 + (q & 1) * 8);
#pragma unroll
        for (int ks = 8; ks < 16; ++ks) a[ks] = *(const bf16x8*)(SP + ((size_t)cr * 16 + g) * 256 + (ks - 8) * 32 + q * 8);
#pragma unroll 2
        for (int nt = 0; nt < 16; ++nt) { f32x4 acc = (f32x4){0.f, 0.f, 0.f, 0.f}; const bf16_t* wp = W2 + (size_t)(nt * 16 + m) * 512 + q * 8;
#pragma unroll
            for (int ks = 0; ks < 16; ++ks) acc = mfma16(*(const bf16x8*)(wp + ks * 32), a[ks], acc);
            float o[4];
#pragma unroll
            for (int j = 0; j < 4; ++j) { const float x = acc[j]; const float u = 0.7978845608f * (x + 0.044715f * x * x * x); const float th = 1.0f - 2.0f / (1.0f + __expf(2.0f * u)); o[j] = 0.5f * x * (1.0f + th); }
            u32x2 w; w.x = pack2(o[0], o[1]); w.y = pack2(o[2], o[3]); *(u32x2*)(YG + (size_t)(rb + nt) * 256 + g * 16 + q * 4) = w; }
    }
}
__device__ __forceinline__ void s5_pass2_block(const Params& p, int l, int vb, int nvb, LAS unsigned char* lds) {
    constexpr int PITCH = 520;
    LAS bf16_t* sW = (LAS bf16_t*)lds;
    const int tid = threadIdx.x, lane = tid & 63, m = lane & 15, q = lane >> 4, wv = tid >> 6;
    const bf16_t* P = (const bf16_t*)(p.ws + U_U16); const bf16_t* SP = (const bf16_t*)(p.ws + U_SPREV); bf16_t* YG = (bf16_t*)(p.ws + U_YG);
    if ((nvb & 63) != 0) { s5_pass2_items(p, l, vb * 8 + wv, nvb * 8); return; }
    { const int combo = vb & 63, g = combo >> 2, qd = combo & 3, bi = vb >> 6, nb = nvb >> 6;
        const bf16_t* W2 = (const bf16_t*)(p.ws + WS_SW + (size_t)l * SW_STRIDE + SW_S5W2) + ((size_t)g * 256 + qd * 64) * 512;
        __syncthreads();
        for (int i = tid; i < 64 * 64; i += NTHR) { const int n = i >> 6, pc = i & 63; *(LAS lu4*)(sW + n * PITCH + pc * 8) = *(const lu4*)(W2 + (size_t)n * 512 + pc * 8); }
        __syncthreads();
        LAS unsigned char* wb = (LAS unsigned char*)(sW + m * PITCH + q * 8); asm volatile("" : "+v"(wb));
        for (int ct = bi * 8 + wv; ct < 144; ct += nb * 8) { if (l == 1 && ct % 9 == 0) continue;
            const int cr = ct * 16 + m, rb = s5_rowbase(cr);
            bf16x8 a[16];
#pragma unroll
            for (int ks = 0; ks < 8; ++ks) a[ks] = *(const bf16x8*)(P + (size_t)(rb + 2 * ks + (q >> 1)) * 256 + g * 16 + (q & 1) * 8);
#pragma unroll
            for (int ks = 8; ks < 16; ++ks) a[ks] = *(const bf16x8*)(SP + ((size_t)cr * 16 + g) * 256 + (ks - 8) * 32 + q * 8);
#pragma unroll 1
            for (int nt = 0; nt < 4; ++nt) { f32x4 acc = (f32x4){0.f, 0.f, 0.f, 0.f};
#pragma unroll
                for (int ks = 0; ks < 16; ++ks) acc = mfma16(*(const LAS bf16x8*)(wb + nt * 16 * PITCH * 2 + ks * 64), a[ks], acc);
                float o[4];
#pragma unroll
                for (int j = 0; j < 4; ++j) { const float x = acc[j]; const float u = 0.7978845608f * (x + 0.044715f * x * x * x); const float th = 1.0f - 2.0f / (1.0f + __expf(2.0f * u)); o[j] = 0.5f * x * (1.0f + th); }
                u32x2 w; w.x = pack2(o[0], o[1]); w.y = pack2(o[2], o[3]); *(u32x2*)(YG + (size_t)(rb + qd * 4 + nt) * 256 + g * 16 + q * 4) = w; } }
    }
    __syncthreads();
}
__device__ __forceinline__ void s5_glu_items(const Params& p, int l, int wid, int nw) {
    const int lane = threadIdx.x & 63, m = lane & 15, q = lane >> 4;
    const bf16_t* YG = (const bf16_t*)(p.ws + U_YG); bf16_t* YC = (bf16_t*)(p.ws + WS_ABUF);
    const bf16_t* GT = (const bf16_t*)(p.ws + WS_SW + (size_t)l * SW_STRIDE + SW_GLUT);
    const int nrt = (l == 0 ? NROW : NLAT) / 16;
    for (int rt = wid; rt < nrt; rt += nw) { const int row = rt * 16 + m;
        bf16x8 a[8];
#pragma unroll
        for (int ks = 0; ks < 8; ++ks) a[ks] = *(const bf16x8*)(YG + (size_t)row * 256 + ks * 32 + q * 8);
#pragma unroll 2
        for (int nt = 0; nt < 16; ++nt) { f32x4 acc = (f32x4){0.f, 0.f, 0.f, 0.f}; const bf16_t* gp = GT + (size_t)(nt * 16 + m) * 256 + q * 8;
#pragma unroll
            for (int ks = 0; ks < 8; ++ks) acc = mfma16(*(const bf16x8*)(gp + ks * 32), a[ks], acc);
            const int n = nt * 16 + q * 4; const float4 bv = *(const float4*)(p.in[18] + l * 256 + n); const u32x2 yw = *(const u32x2*)(YG + (size_t)row * 256 + n);
            u32x2 w; w.x = pack2(bflo(yw.x) * sigm(acc[0] + bv.x), bfhi(yw.x) * sigm(acc[1] + bv.y)); w.y = pack2(bflo(yw.y) * sigm(acc[2] + bv.z), bfhi(yw.y) * sigm(acc[3] + bv.w));
            *(u32x2*)(YC + (size_t)row * 1024 + n) = w; }
    }
}

__device__ __forceinline__ void s5_glu_block(const Params& p, int l, int vb, int nvb, LAS unsigned char* lds) {
    constexpr int PITCH = 264;
    LAS bf16_t* sG = (LAS bf16_t*)lds;
    const int tid = threadIdx.x, lane = tid & 63, m = lane & 15, q = lane >> 4, wv = tid >> 6;
    if (nvb < 2 || (nvb & 1)) { s5_glu_items(p, l, vb * 8 + wv, nvb * 8); return; }
    const int half = vb & 1, bi = vb >> 1, nb = nvb >> 1;
    const bf16_t* YG = (const bf16_t*)(p.ws + U_YG); bf16_t* YC = (bf16_t*)(p.ws + WS_ABUF);
    const bf16_t* GT = (const bf16_t*)(p.ws + WS_SW + (size_t)l * SW_STRIDE + SW_GLUT) + (size_t)half * 128 * 256;
    __syncthreads();
    for (int i = tid; i < 128 * 32; i += NTHR) { const int n = i >> 5, pc = i & 31; *(LAS lu4*)(sG + n * PITCH + pc * 8) = *(const lu4*)(GT + (size_t)n * 256 + pc * 8); }
    __syncthreads();
    LAS unsigned char* gb = (LAS unsigned char*)(sG + m * PITCH + q * 8); asm volatile("" : "+v"(gb));
    const int nrt = (l == 0 ? NROW : NLAT) / 16;
    for (int rt = bi * 8 + wv; rt < nrt; rt += nb * 8) { const int row = rt * 16 + m;
        bf16x8 a[8];
#pragma unroll
        for (int ks = 0; ks < 8; ++ks) a[ks] = *(const bf16x8*)(YG + (size_t)row * 256 + ks * 32 + q * 8);
#pragma unroll 2
        for (int nt = 0; nt < 8; ++nt) { f32x4 acc = (f32x4){0.f, 0.f, 0.f, 0.f};
#pragma unroll
            for (int ks = 0; ks < 8; ++ks) acc = mfma16(*(const LAS bf16x8*)(gb + nt * 16 * PITCH * 2 + ks * 64), a[ks], acc);
            const int n = half * 128 + nt * 16 + q * 4; const float4 bv = *(const float4*)(p.in[18] + l * 256 + n); const u32x2 yw = *(const u32x2*)(YG + (size_t)row * 256 + n);
            u32x2 w; w.x = pack2(bflo(yw.x) * sigm(acc[0] + bv.x), bfhi(yw.x) * sigm(acc[1] + bv.y)); w.y = pack2(bflo(yw.y) * sigm(acc[2] + bv.z), bfhi(yw.y) * sigm(acc[3] + bv.w));
            *(u32x2*)(YC + (size_t)row * 1024 + n) = w; } }
    __syncthreads();
}

template <bool HASLAT> __device__ __forceinline__ void na_unit(const Params& p, const LAS float* rpb_l, int b, int h, int i, int n) {
    const int lane = threadIdx.x & 63, m = lane & 15, q = lane >> 4, kin = 8 * (m >> 2) + (m & 3);
    const bf16_t* QR = (const bf16_t*)(p.ws + U_QR); const bf16_t* KR = (const bf16_t*)(p.ws + U_KR);
    const bf16_t* VTL = (const bf16_t*)(p.ws + U_VT) + (size_t)(b * 6 + h) * 64 * 2048; const bf16_t* VTC = (const bf16_t*)(p.ws + U_VTC) + (size_t)(b * 6 + h) * 64 * 256;
    const int qrow = HASLAT ? b * 2048 + i * 64 + n * 16 + m : NLAT + b * 256 + n * 16 + m;
    bf16x8 qf[2];
#pragma unroll
    for (int ks = 0; ks < 2; ++ks) qf[ks] = *(const bf16x8*)(QR + (size_t)qrow * 384 + h * 64 + ks * 32 + q * 8);
    const int r0 = HASLAT ? min(max(i - 4, 0), 24) : 0, scol = HASLAT ? min(max(n * 16 - 8, 0), 32) : 0;
    f32x4 sl[HASLAT ? 16 : 1], sc[16];
    float mx = -3.0e38f;
    if (HASLAT) { const int qc = n * 16 + m, c0 = min(max(qc - 8, 0), 48); const LAS float* rpb = rpb_l + h * 15 * 31;
#pragma unroll
        for (int t = 0; t < 16; ++t) { const int kr = t >> 1, ch = t & 1; const bf16_t* kp = KR + (size_t)(b * 2048 + (r0 + kr) * 64 + scol + kin + 4 * ch) * 384 + h * 64 + q * 8;
            f32x4 acc = (f32x4){0.f, 0.f, 0.f, 0.f};
#pragma unroll
            for (int ks = 0; ks < 2; ++ks) acc = mfma16(*(const bf16x8*)(kp + ks * 32), qf[ks], acc);
            const int dr = r0 + kr - i + 7;
#pragma unroll
            for (int j = 0; j < 4; ++j) { const int kc = scol + 8 * q + 4 * ch + j; const bool valid = kc >= c0 && kc < c0 + 16; const int dc = min(max(kc - qc + 15, 0), 30);
                const float s = valid ? acc[j] + rpb[dr * 31 + dc] : -1.0e30f; acc[j] = s; mx = fmaxf(mx, s); }
            sl[t] = acc; if ((t & 7) == 7) __builtin_amdgcn_sched_barrier(0); } }
#pragma unroll
    for (int t = 0; t < 16; ++t) { const bf16_t* kp = KR + (size_t)(NLAT + b * 256 + (t >> 1) * 32 + kin + 4 * (t & 1)) * 384 + h * 64 + q * 8;
        f32x4 acc = (f32x4){0.f, 0.f, 0.f, 0.f};
#pragma unroll
        for (int ks = 0; ks < 2; ++ks) acc = mfma16(*(const bf16x8*)(kp + ks * 32), qf[ks], acc);
#pragma unroll
        for (int j = 0; j < 4; ++j) mx = fmaxf(mx, acc[j]);
        sc[t] = acc; }
    mx = fmaxf(mx, __shfl_xor(mx, 16)); mx = fmaxf(mx, __shfl_xor(mx, 32));
    float sum = 0.f;
    f32x4 o[4];
#pragma unroll
    for (int dt = 0; dt < 4; ++dt) o[dt] = (f32x4){0.f, 0.f, 0.f, 0.f};
    if (HASLAT) {
#pragma unroll
        for (int kr = 0; kr < 8; ++kr) { float e[8];
#pragma unroll
            for (int j = 0; j < 4; ++j) { e[j] = __expf(sl[2 * kr][j] - mx); e[4 + j] = __expf(sl[2 * kr + 1][j] - mx); }
#pragma unroll
            for (int j = 0; j < 8; ++j) sum += e[j];
            const uint4 pw = pack8(e); const bf16x8 pf = __builtin_bit_cast(bf16x8, pw);
            const int tok = (r0 + kr) * 64 + scol + q * 8;
#pragma unroll
            for (int dt = 0; dt < 4; ++dt) o[dt] = mfma16(*(const bf16x8*)(VTL + (size_t)(dt * 16 + m) * 2048 + tok), pf, o[dt]);
            if (kr & 1) __builtin_amdgcn_sched_barrier(0); } }
#pragma unroll
    for (int t2 = 0; t2 < 8; ++t2) { float e[8];
#pragma unroll
        for (int j = 0; j < 4; ++j) { e[j] = __expf(sc[2 * t2][j] - mx); e[4 + j] = __expf(sc[2 * t2 + 1][j] - mx); }
#pragma unroll
        for (int j = 0; j < 8; ++j) sum += e[j];
        const uint4 pw = pack8(e); const bf16x8 pf = __builtin_bit_cast(bf16x8, pw);
        const int tok = t2 * 32 + q * 8;
#pragma unroll
        for (int dt = 0; dt < 4; ++dt) o[dt] = mfma16(*(const bf16x8*)(VTC + (size_t)(dt * 16 + m) * 256 + tok), pf, o[dt]);
        if (t2 & 1) __builtin_amdgcn_sched_barrier(0); }
    sum += __shfl_xor(sum, 16); sum += __shfl_xor(sum, 32);
    const float inv = 1.0f / sum;
    bf16_t* yo = (bf16_t*)(p.ws + WS_ABUF) + (size_t)qrow * 1024 + 256 + h * 64 + q * 4;
#pragma unroll
    for (int dt = 0; dt < 4; ++dt) { u32x2 w; w.x = pack2(o[dt][0] * inv, o[dt][1] * inv); w.y = pack2(o[dt][2] * inv, o[dt][3] * inv); *(u32x2*)(yo + dt * 16) = w; }
}
#define NA_SHX(x, msk) __builtin_bit_cast(float, __builtin_amdgcn_ds_bpermute((lane ^ (msk)) << 2, __builtin_bit_cast(int, (x))))
template <bool HASLAT> __device__ __forceinline__ void na_block(const Params& p, int l, int b, int h, int sel, LAS unsigned char* lds) {
    LAS bf16_t* Ks = (LAS bf16_t*)lds;
    LAS bf16_t* Vs = (LAS bf16_t*)lds;
    LAS float* rp = (LAS float*)(lds + 120064);
    int tid = threadIdx.x; asm volatile("" : "+v"(tid));
    const int lane = tid & 63, m = lane & 15, q = lane >> 4, w = tid >> 6, kin = 8 * (m >> 2) + (m & 3);
    const bf16_t* QR = (const bf16_t*)(p.ws + U_QR); const bf16_t* KR = (const bf16_t*)(p.ws + U_KR);
    const bf16_t* VTL = (const bf16_t*)(p.ws + U_VT) + (size_t)(b * 6 + h) * 64 * 2048; const bf16_t* VTC = (const bf16_t*)(p.ws + U_VTC) + (size_t)(b * 6 + h) * 64 * 256;
    const int i0 = HASLAT ? 2 * sel : 0, rlo = HASLAT ? min(max(i0 - 4, 0), 24) : 0;
    __syncthreads();
    int tk = threadIdx.x; asm volatile("" : "+v"(tk));
    { lu4 kl[HASLAT ? 9 : 1], kc[4]; float rpv = 0.f;
      if (HASLAT) {
#pragma unroll
        for (int j = 0; j < 9; ++j) { const int idx = tk + NTHR * j, key = idx >> 3, pc = idx & 7, tok = min(rlo * 64 + key, 2047);
            kl[j] = *(const lu4*)(KR + (size_t)(b * 2048 + tok) * 384 + h * 64 + pc * 8); }
        rpv = p.in[19][(size_t)(l * 6 + h) * 465 + min(tk, 464)]; }
#pragma unroll
      for (int j = 0; j < 4; ++j) { const int idx = tk + NTHR * j, key = idx >> 3, pc = idx & 7; kc[j] = *(const lu4*)(KR + (size_t)(NLAT + b * 256 + key) * 384 + h * 64 + pc * 8); }
      __builtin_amdgcn_sched_barrier(0);
      if (HASLAT) {
#pragma unroll
        for (int j = 0; j < 9; ++j) { const int idx = tk + NTHR * j, key = idx >> 3, pc = idx & 7; *(LAS lu4*)(Ks + key * 72 + pc * 8) = kl[j]; }
        if (tk < 465) rp[tk] = rpv; }
#pragma unroll
      for (int j = 0; j < 4; ++j) { const int idx = tk + NTHR * j, key = idx >> 3, pc = idx & 7; *(LAS lu4*)(Ks + (576 + key) * 72 + pc * 8) = kc[j]; } }
    const int i = HASLAT ? i0 + (w >> 2) : 0, n = HASLAT ? (w & 3) : sel * 8 + w;
    const int qrow = HASLAT ? b * 2048 + i * 64 + n * 16 + m : NLAT + b * 256 + n * 16 + m;
    bf16x8 qf[2];
#pragma unroll
    for (int ks = 0; ks < 2; ++ks) qf[ks] = *(const bf16x8*)(QR + (size_t)qrow * 384 + h * 64 + ks * 32 + q * 8);
    const int r0 = HASLAT ? min(max(i - 4, 0), 24) : 0, scol = HASLAT ? min(max(n * 16 - 8, 0), 32) : 0, kb = (r0 - rlo) * 64 + scol;
    LAS unsigned char* kbl = (LAS unsigned char*)(Ks + (kb + kin) * 72 + q * 8); LAS unsigned char* kbc = (LAS unsigned char*)(Ks + (576 + kin) * 72 + q * 8);
    asm volatile("" : "+v"(kbl), "+v"(kbc));
    __syncthreads();
    float mx1 = -3.0e38f, mx2 = -3.0e38f, sum1 = 0.f, sum2 = 0.f;
    bf16x8 pl[HASLAT ? 8 : 1], pcx[8];
    if (HASLAT) { const int qc = n * 16 + m, c0 = min(max(qc - 8, 0), 48); f32x4 sl[16];
#pragma unroll
        for (int t = 0; t < 16; ++t) { const int kr = t >> 1, ch = t & 1; const LAS bf16_t* kp = (const LAS bf16_t*)(kbl + (kr * 64 + 4 * ch) * 144);
            f32x4 acc = (f32x4){0.f, 0.f, 0.f, 0.f};
#pragma unroll
            for (int ks = 0; ks < 2; ++ks) acc = mfma16(*(const LAS bf16x8*)(kp + ks * 32), qf[ks], acc);
            const int dr = r0 + kr - i + 7;
#pragma unroll
            for (int j = 0; j < 4; ++j) { const int kc = scol + 8 * q + 4 * ch + j; const bool valid = kc >= c0 && kc < c0 + 16; const int dc = min(max(kc - qc + 15, 0), 30);
                const float bias = rp[dr * 31 + dc]; const float sv = valid ? acc[j] + bias : -1.0e30f; acc[j] = sv; mx1 = fmaxf(mx1, sv); }
            sl[t] = acc; if ((t & 3) == 3) __builtin_amdgcn_sched_barrier(0); }
        mx1 = fmaxf(mx1, NA_SHX(mx1, 16)); mx1 = fmaxf(mx1, NA_SHX(mx1, 32));
#pragma unroll
        for (int kr = 0; kr < 8; ++kr) { float e[8];
#pragma unroll
            for (int j = 0; j < 4; ++j) { e[j] = __expf(sl[2 * kr][j] - mx1); e[4 + j] = __expf(sl[2 * kr + 1][j] - mx1); }
#pragma unroll
            for (int j = 0; j < 8; ++j) sum1 += e[j];
            const uint4 pw = pack8(e); pl[kr] = __builtin_bit_cast(bf16x8, pw); }
        __builtin_amdgcn_sched_barrier(0); }
    { f32x4 sc[16];
#pragma unroll
      for (int t = 0; t < 16; ++t) { const LAS bf16_t* kp = (const LAS bf16_t*)(kbc + ((t >> 1) * 32 + 4 * (t & 1)) * 144);
          f32x4 acc = (f32x4){0.f, 0.f, 0.f, 0.f};
#pragma unroll
          for (int ks = 0; ks < 2; ++ks) acc = mfma16(*(const LAS bf16x8*)(kp + ks * 32), qf[ks], acc);
#pragma unroll
          for (int j = 0; j < 4; ++j) mx2 = fmaxf(mx2, acc[j]);
          sc[t] = acc; if ((t & 3) == 3) __builtin_amdgcn_sched_barrier(0); }
      mx2 = fmaxf(mx2, NA_SHX(mx2, 16)); mx2 = fmaxf(mx2, NA_SHX(mx2, 32));
#pragma unroll
      for (int t2 = 0; t2 < 8; ++t2) { float e[8];
#pragma unroll
          for (int j = 0; j < 4; ++j) { e[j] = __expf(sc[2 * t2][j] - mx2); e[4 + j] = __expf(sc[2 * t2 + 1][j] - mx2); }
#pragma unroll
          for (int j = 0; j < 8; ++j) sum2 += e[j];
          const uint4 pw = pack8(e); pcx[t2] = __builtin_bit_cast(bf16x8, pw); } }
    sum1 += NA_SHX(sum1, 16); sum1 += NA_SHX(sum1, 32); sum2 += NA_SHX(sum2, 16); sum2 += NA_SHX(sum2, 32);
    __builtin_amdgcn_sched_barrier(0);
    __syncthreads();
    int tv = threadIdx.x; asm volatile("" : "+v"(tv));
    __builtin_amdgcn_sched_barrier(0);
    if (HASLAT) {
#pragma unroll
        for (int j = 0; j < 9; ++j) { const int idx = tv + NTHR * j, dim = idx / 72, pc = idx % 72, tok = rlo * 64 + pc * 8;
            if (tok < 2048) *(LAS lu4*)(Vs + dim * 840 + pc * 8) = *(const lu4*)(VTL + (size_t)dim * 2048 + tok); } }
#pragma unroll
    for (int j = 0; j < 4; ++j) { const int idx = tv + NTHR * j, dim = idx >> 5, pc = idx & 31; *(LAS lu4*)(Vs + dim * 840 + 576 + pc * 8) = *(const lu4*)(VTC + (size_t)dim * 256 + pc * 8); }
    __builtin_amdgcn_sched_barrier(0);
    __syncthreads();
    __builtin_amdgcn_sched_barrier(0);
    const int kbv = kb * 2;
    LAS unsigned char* vb0 = (LAS unsigned char*)(Vs + (0 * 16 + m) * 840 + q * 8); LAS unsigned char* vb1 = (LAS unsigned char*)(Vs + (1 * 16 + m) * 840 + q * 8);
    LAS unsigned char* vb2 = (LAS unsigned char*)(Vs + (2 * 16 + m) * 840 + q * 8); LAS unsigned char* vb3 = (LAS unsigned char*)(Vs + (3 * 16 + m) * 840 + q * 8);
    asm volatile("" : "+v"(vb0), "+v"(vb1), "+v"(vb2), "+v"(vb3));
    f32x4 o1[4], o2[4];
#pragma unroll
    for (int dt = 0; dt < 4; ++dt) { o1[dt] = (f32x4){0.f, 0.f, 0.f, 0.f}; o2[dt] = (f32x4){0.f, 0.f, 0.f, 0.f}; }
    if (HASLAT) {
#pragma unroll
        for (int kr = 0; kr < 8; ++kr) {
#pragma unroll
            for (int dt = 0; dt < 4; ++dt) { LAS unsigned char* vb = dt == 0 ? vb0 : dt == 1 ? vb1 : dt == 2 ? vb2 : vb3; o1[dt] = mfma16(*(const LAS bf16x8*)(vb + kbv + kr * 128), pl[kr], o1[dt]); }
            if (kr & 1) __builtin_amdgcn_sched_barrier(0); } }
#pragma unroll
    for (int t2 = 0; t2 < 8; ++t2) {
#pragma unroll
        for (int dt = 0; dt < 4; ++dt) { LAS unsigned char* vb = dt == 0 ? vb0 : dt == 1 ? vb1 : dt == 2 ? vb2 : vb3; o2[dt] = mfma16(*(const LAS bf16x8*)(vb + 1152 + t2 * 64), pcx[t2], o2[dt]); }
        if (t2 & 1) __builtin_amdgcn_sched_barrier(0); }
    const float mxm = fmaxf(mx1, mx2), a1 = HASLAT ? __expf(mx1 - mxm) : 0.f, a2 = __expf(mx2 - mxm), inv = 1.0f / (a1 * sum1 + a2 * sum2), c1 = a1 * inv, c2 = a2 * inv;
    bf16_t* yo = (bf16_t*)(p.ws + WS_ABUF) + (size_t)qrow * 1024 + 256 + h * 64 + q * 4;
#pragma unroll
    for (int dt = 0; dt < 4; ++dt) { u32x2 wv2; wv2.x = pack2(o1[dt][0] * c1 + o2[dt][0] * c2, o1[dt][1] * c1 + o2[dt][1] * c2); wv2.y = pack2(o1[dt][2] * c1 + o2[dt][2] * c2, o1[dt][3] * c1 + o2[dt][3] * c2); *(u32x2*)(yo + dt * 16) = wv2; }
}
#undef NA_SHX
__device__ __forceinline__ void na_items(const Params& p, int l, int wid, int nw, LAS unsigned char* lds) {
    (void)wid; (void)nw;
    const int nlat = 16 * 6 * 16, nctx = (l == 0) ? 16 * 6 * 2 : 0;
    for (int it = blockIdx.x; it < nlat + nctx; it += gridDim.x) {
        if (it < nlat) { const int ip = it & 15, bh = it >> 4; na_block<true>(p, l, bh / 6, bh % 6, ip, lds); }
        else { const int j = it - nlat, half = j & 1, bh = j >> 1; na_block<false>(p, l, bh / 6, bh % 6, half, lds); }
    }
    __syncthreads();
}

typedef float f32x2 __attribute__((ext_vector_type(2)));
__device__ __forceinline__ int rk_row(int b, int d, int n) { return n < 256 ? NLAT + b * 256 + (d ? 255 - n : n) : b * 2048 + (d ? 2047 - (n - 256) : (n - 256)); }
template <int CTRL> __device__ __forceinline__ float dpp_f(float v) { return __builtin_bit_cast(float, __builtin_amdgcn_update_dpp(0, __builtin_bit_cast(int, v), CTRL, 0xF, 0xF, true)); }
constexpr int RKP_WAVE = 4 * 16 * 17 * 4;
__device__ __forceinline__ bf16x8 pack_frag(const float (&lo)[4], const float (&hi)[4]) { u32x4 w; w.x = pack2(lo[0], lo[1]); w.y = pack2(lo[2], lo[3]); w.z = pack2(hi[0], hi[1]); w.w = pack2(hi[2], hi[3]); return __builtin_bit_cast(bf16x8, w); }
__device__ __forceinline__ bf16x8 pack_lo(const f32x4 v) { u32x4 w; w.x = pack2(v[0], v[1]); w.y = pack2(v[2], v[3]); w.z = 0u; w.w = 0u; return __builtin_bit_cast(bf16x8, w); }
__device__ __forceinline__ void rwkv_pre_items(const Params& p, int l, int wid, int nw, LAS unsigned char* lds) {
    const int lane = threadIdx.x & 63, m = lane & 15, q = lane >> 4, wv = threadIdx.x >> 6;
    LAS float* sM = (LAS float*)(lds + wv * RKP_WAVE);
    const bf16_t* RS = (const bf16_t*)(p.ws + U_RS); const bf16_t* KS = (const bf16_t*)(p.ws + U_KS); const bf16_t* VS = (const bf16_t*)(p.ws + U_VS); const bf16_t* KK = (const bf16_t*)(p.ws + U_KK);
    bf16x8 isel[2], idg;
    { const unsigned one = 0x3F80u << ((m & 1) * 16); const int wi = (m & 7) >> 1;
#pragma unroll
      for (int s2 = 0; s2 < 2; ++s2) { const unsigned v = (q == 2 * s2 + (m >> 3)) ? one : 0u; const u32x4 w = {wi == 0 ? v : 0u, wi == 1 ? v : 0u, wi == 2 ? v : 0u, wi == 3 ? v : 0u}; isel[s2] = __builtin_bit_cast(bf16x8, w); }
      const int jp = m & 3; const unsigned dv = (q == (m >> 2)) ? (0x3F80u << ((jp & 1) * 16)) : 0u; const u32x4 w = {0u, 0u, (jp >> 1) == 0 ? dv : 0u, (jp >> 1) == 1 ? dv : 0u}; idg = __builtin_bit_cast(bf16x8, w); }
    const f32x4 z4 = {0.f, 0.f, 0.f, 0.f};
    for (int it = wid; it < NCHUNK; it += nw) { const int u = it / 144, c = it % 144, b = u / 12, h = (u % 12) >> 1, d = u & 1;
        const bf16_t* AG = (const bf16_t*)(p.ws + U_AG + (size_t)d * SZ384); const bf16_t* LD = (const bf16_t*)(p.ws + U_LD + (size_t)d * SZ384);
        const int rb = rk_row(b, d, c * 16), sgn = d ? -1 : 1;
        const size_t ro = (size_t)(rb + sgn * m) * 384 + h * 64 + 8 * q;
        u32x4 raw[6][2]; float4 kaf[4];
#pragma unroll
        for (int ks = 0; ks < 2; ++ks) { raw[0][ks] = *(const u32x4*)(KK + ro + 32 * ks); raw[1][ks] = *(const u32x4*)(AG + ro + 32 * ks); raw[2][ks] = *(const u32x4*)(KS + ro + 32 * ks);
            raw[3][ks] = *(const u32x4*)(RS + ro + 32 * ks); raw[4][ks] = *(const u32x4*)(VS + ro + 32 * ks); raw[5][ks] = *(const u32x4*)(LD + ro + 32 * ks);
            kaf[2 * ks] = *(const float4*)(p.in[27] + l * 384 + h * 64 + 32 * ks + 8 * q); kaf[2 * ks + 1] = *(const float4*)(p.in[27] + l * 384 + h * 64 + 32 * ks + 8 * q + 4); }
        __builtin_amdgcn_sched_barrier(0);
        bf16x8 atf[2], rtf[2], bhf[2], khf[2], vf[2];
#pragma unroll
        for (int ks = 0; ks < 2; ++ks) { float at[8], bh[8], kh[8], rt[8], lk[8];
            const float ka[8] = {kaf[2 * ks].x, kaf[2 * ks].y, kaf[2 * ks].z, kaf[2 * ks].w, kaf[2 * ks + 1].x, kaf[2 * ks + 1].y, kaf[2 * ks + 1].z, kaf[2 * ks + 1].w};
#pragma unroll
            for (int w = 0; w < 4; ++w)
#pragma unroll
                for (int hh = 0; hh < 2; ++hh) { const int i = 2 * w + hh;
                    const float kk_ = hh ? bfhi(raw[0][ks][w]) : bflo(raw[0][ks][w]), ag_ = hh ? bfhi(raw[1][ks][w]) : bflo(raw[1][ks][w]), k_ = hh ? bfhi(raw[2][ks][w]) : bflo(raw[2][ks][w]);
                    const float r_ = hh ? bfhi(raw[3][ks][w]) : bflo(raw[3][ks][w]), ld2 = (hh ? bfhi(raw[5][ks][w]) : bflo(raw[5][ks][w])) * 1.4426950408889634f;
                    float L = ld2; L += dpp_f<0x111>(L); L += dpp_f<0x112>(L); L += dpp_f<0x114>(L); L += dpp_f<0x118>(L);
                    const float e1 = __builtin_amdgcn_exp2f(L), ei = __builtin_amdgcn_exp2f(-L), e0 = __builtin_amdgcn_exp2f(L - ld2);
                    at[i] = -kk_ * e0; bh[i] = kk_ * ag_ * ei; kh[i] = k_ * (1.0f + (ag_ - 1.0f) * ka[i]) * ei; rt[i] = r_ * e1; lk[i] = L * 0.6931471805599453f; }
            { const u32x4 w0 = {pack2(at[0], at[1]), pack2(at[2], at[3]), pack2(at[4], at[5]), pack2(at[6], at[7])}; atf[ks] = __builtin_bit_cast(bf16x8, w0);
              const u32x4 w1 = {pack2(bh[0], bh[1]), pack2(bh[2], bh[3]), pack2(bh[4], bh[5]), pack2(bh[6], bh[7])}; bhf[ks] = __builtin_bit_cast(bf16x8, w1);
              const u32x4 w2 = {pack2(kh[0], kh[1]), pack2(kh[2], kh[3]), pack2(kh[4], kh[5]), pack2(kh[6], kh[7])}; khf[ks] = __builtin_bit_cast(bf16x8, w2);
              const u32x4 w3 = {pack2(rt[0], rt[1]), pack2(rt[2], rt[3]), pack2(rt[4], rt[5]), pack2(rt[6], rt[7])}; rtf[ks] = __builtin_bit_cast(bf16x8, w3);
              vf[ks] = __builtin_bit_cast(bf16x8, raw[4][ks]);
              if (m == 15) { const u32x4 wl = {pack2(lk[0], lk[1]), pack2(lk[2], lk[3]), pack2(lk[4], lk[5]), pack2(lk[6], lk[7])};
                  *(u32x4*)((bf16_t*)(p.ws + CH_GT) + (size_t)it * 64 + 32 * ks + 8 * q) = wl; } } }
        { f32x4 mab = z4, mak = z4, mrb = z4, mrk = z4;
#pragma unroll
          for (int ks = 0; ks < 2; ++ks) { mab = mfma16(atf[ks], bhf[ks], mab); mak = mfma16(atf[ks], khf[ks], mak); mrb = mfma16(rtf[ks], bhf[ks], mrb); mrk = mfma16(rtf[ks], khf[ks], mrk); }
#pragma unroll
          for (int r = 0; r < 4; ++r) { const int t = 4 * q + r; sM[(0 * 16 + t) * 17 + m] = m < t ? mab[r] : 0.f; sM[(1 * 16 + t) * 17 + m] = m < t ? mak[r] : 0.f;
              sM[(2 * 16 + t) * 17 + m] = m <= t ? mrb[r] : 0.f; sM[(3 * 16 + t) * 17 + m] = m <= t ? mrk[r] : 0.f; } }
        { float tv[16];
#pragma unroll
          for (int t = 0; t < 16; ++t) { float acc = (m == t) ? 1.0f : 0.0f;
#pragma unroll
              for (int s2 = 0; s2 < t; ++s2) acc += sM[t * 17 + s2] * tv[s2];
              tv[t] = acc; }
#pragma unroll
          for (int t = 0; t < 16; ++t) if (q == 0) sM[t * 17 + m] = tv[t]; }
        bf16x8 tinvf, mrbf, makf;
        { float lo[4], hi[4] = {0.f, 0.f, 0.f, 0.f};
#pragma unroll
          for (int j = 0; j < 4; ++j) lo[j] = sM[(0 * 16 + m) * 17 + 4 * q + j];
          tinvf = pack_frag(lo, hi);
#pragma unroll
          for (int j = 0; j < 4; ++j) lo[j] = sM[(1 * 16 + m) * 17 + 4 * q + j];
          makf = pack_frag(lo, hi);
#pragma unroll
          for (int j = 0; j < 4; ++j) lo[j] = sM[(2 * 16 + m) * 17 + 4 * q + j];
          mrbf = pack_frag(lo, hi);
#pragma unroll
          for (int j = 0; j < 4; ++j) hi[j] = sM[(3 * 16 + m) * 17 + 4 * q + j];
          *(bf16x8*)((bf16_t*)(p.ws + CH_MM) + ((size_t)it * 64 + lane) * 8) = pack_frag(lo, hi); }
#pragma unroll
        for (int itile = 0; itile < 4; ++itile) { const f32x4 vt = mfma16(vf[itile >> 1], isel[itile & 1], z4);
            const f32x4 w1 = mfma16(makf, pack_lo(vt), z4);
            const f32x4 uu = mfma16(tinvf, pack_lo(w1), z4);
            u32x2 o; o.x = pack2(uu[0], uu[1]); o.y = pack2(uu[2], uu[3]);
            *(u32x2*)((bf16_t*)(p.ws + CH_UL) + (((size_t)it * 4 + itile) * 64 + lane) * 4) = o; }
        const u32x4 mrbw = __builtin_bit_cast(u32x4, mrbf), idgw = __builtin_bit_cast(u32x4, idg); const u32x4 rpbw = {mrbw.x, mrbw.y, idgw.z, idgw.w}; const bf16x8 rpb = __builtin_bit_cast(bf16x8, rpbw);
        u32x2 xa = {0u, 0u}, xr = {0u, 0u};
#pragma unroll
        for (int jt = 0; jt < 4; ++jt) { const int ks = jt >> 1;
            const bf16x8 att = pack_lo(mfma16(atf[ks], isel[jt & 1], z4));
            const f32x4 ap = mfma16(tinvf, att, z4);
            const f32x4 apT = mfma16(att, tinvf, z4);
            const f32x4 rtt = mfma16(rtf[ks], isel[jt & 1], z4);
            u32x4 aw = __builtin_bit_cast(u32x4, pack_lo(ap)); aw.z = pack2(rtt[0], rtt[1]); aw.w = pack2(rtt[2], rtt[3]);
            const f32x4 rpT = mfma16(__builtin_bit_cast(bf16x8, aw), rpb, z4);
            const f32x4 bht = mfma16(bhf[ks], isel[jt & 1], z4), kht = mfma16(khf[ks], isel[jt & 1], z4);
            { u32x4 w; w.x = pack2(bht[0], bht[1]); w.y = pack2(bht[2], bht[3]); w.z = pack2(kht[0], kht[1]); w.w = pack2(kht[2], kht[3]);
              *(u32x4*)((bf16_t*)(p.ws + CH_BK) + (((size_t)it * 4 + jt) * 64 + lane) * 8) = w; }
            if ((jt & 1) == 0) { xa.x = pack2(apT[0], apT[1]); xa.y = pack2(apT[2], apT[3]); xr.x = pack2(rpT[0], rpT[1]); xr.y = pack2(rpT[2], rpT[3]); }
            else { const u32x4 wa = {xa.x, xa.y, pack2(apT[0], apT[1]), pack2(apT[2], apT[3])}, wr2 = {xr.x, xr.y, pack2(rpT[0], rpT[1]), pack2(rpT[2], rpT[3])};
                *(u32x4*)((bf16_t*)(p.ws + CH_XP) + ((((size_t)it * 2 + 0) * 2 + ks) * 64 + lane) * 8) = wa;
                *(u32x4*)((bf16_t*)(p.ws + CH_XP) + ((((size_t)it * 2 + 1) * 2 + ks) * 64 + lane) * 8) = wr2; } }
    }
}
__device__ __forceinline__ void rwkv_seq_task(const Params& p, int l, int task, LAS unsigned char* lds) {
    const int lane = threadIdx.x & 63, m = lane & 15, q = lane >> 4;
    const int u = task >> 2, iw = task & 3, b = u / 12, h = (u % 12) >> 1, d = u & 1, sgn = d ? -1 : 1;
    const bf16_t* XP = (const bf16_t*)(p.ws + CH_XP); const bf16_t* BK = (const bf16_t*)(p.ws + CH_BK); const bf16_t* UL = (const bf16_t*)(p.ws + CH_UL); const bf16_t* MM = (const bf16_t*)(p.ws + CH_MM);
    const bf16_t* GT = (const bf16_t*)(p.ws + CH_GT); const bf16_t* VS = (const bf16_t*)(p.ws + U_VS) + h * 64 + 16 * iw;
    float* Yw = (float*)(p.ws + U_YRK) + (size_t)d * NROW * 384 + h * 64 + 16 * iw;
    LAS float* ybuf = (LAS float*)(lds + (threadIdx.x >> 6) * 12288);
    const int rc0 = NLAT + b * 256 + (d ? 255 : 0) + sgn * 4 * q, rdel = (b * 2048 + (d ? 2047 : 0)) - (NLAT + b * 256 + (d ? 255 : 0)) - sgn * 256;
    f32x4 acc[4];
#pragma unroll
    for (int jt = 0; jt < 4; ++jt) acc[jt] = (f32x4){0.f, 0.f, 0.f, 0.f};
    const unsigned vo16 = (unsigned)lane * 16u, vo8 = (unsigned)lane * 8u, vo8q = (unsigned)q * 8u;
    struct OpSet { u32x4 apf0, apf1, rpf0, rpf1, bkf0, bkf1, bkf2, bkf3, mmf; u32x2 gl0, gl1, gl2, gl3, uw; unsigned vr0, vr1, vr2, vr3; };
#define GLDS16(dst, voff, sbase, imm) asm volatile("global_load_dwordx4 %0, %1, %2 offset:" #imm : "=&v"(dst) : "v"(voff), "s"(sbase) : "memory")
#define GLDS8(dst, voff, sbase, imm) asm volatile("global_load_dwordx2 %0, %1, %2 offset:" #imm : "=&v"(dst) : "v"(voff), "s"(sbase) : "memory")
#define GLDS2(dst, voff, sbase) asm volatile("global_load_ushort %0, %1, %2" : "=&v"(dst) : "v"(voff), "s"(sbase) : "memory")
#define RKS_LOAD(X, c_) do { const size_t it_ = (size_t)u * 144 + (c_); const int rb_ = rc0 + sgn * 16 * (c_) + (int)((c_) >= 16) * rdel; \
        const bf16_t* xpb = XP + it_ * 2048; const bf16_t* bkb = BK + it_ * 2048; const bf16_t* mmb = MM + it_ * 512; const bf16_t* gtb = GT + it_ * 64; const bf16_t* ulb = UL + (it_ * 4 + iw) * 256; \
        GLDS16(X.apf0, vo16, xpb, 0); GLDS16(X.apf1, vo16, xpb, 1024); GLDS16(X.rpf0, vo16, xpb, 2048); GLDS16(X.rpf1, vo16, xpb, 3072); \
        GLDS16(X.bkf0, vo16, bkb, 0); GLDS16(X.bkf1, vo16, bkb, 1024); GLDS16(X.bkf2, vo16, bkb, 2048); GLDS16(X.bkf3, vo16, bkb, 3072); \
        GLDS8(X.gl0, vo8q, gtb, 0); GLDS8(X.gl1, vo8q, gtb, 32); GLDS8(X.gl2, vo8q, gtb, 64); GLDS8(X.gl3, vo8q, gtb, 96); \
        GLDS16(X.mmf, vo16, mmb, 0); GLDS8(X.uw, vo8, ulb, 0); \
        { const unsigned v0_ = (unsigned)(rb_) * 768u + 2u * m, v1_ = (unsigned)(rb_ + sgn) * 768u + 2u * m, v2_ = (unsigned)(rb_ + 2 * sgn) * 768u + 2u * m, v3_ = (unsigned)(rb_ + 3 * sgn) * 768u + 2u * m; \
          GLDS2(X.vr0, v0_, VS); GLDS2(X.vr1, v1_, VS); GLDS2(X.vr2, v2_, VS); GLDS2(X.vr3, v3_, VS); } } while (0)
#define RKS_WAIT(X) asm volatile("s_waitcnt vmcnt(36)" : "+v"(X.apf0), "+v"(X.apf1), "+v"(X.rpf0), "+v"(X.rpf1), "+v"(X.bkf0), "+v"(X.bkf1), "+v"(X.bkf2), "+v"(X.bkf3), "+v"(X.mmf), \
        "+v"(X.gl0), "+v"(X.gl1), "+v"(X.gl2), "+v"(X.gl3), "+v"(X.uw), "+v"(X.vr0), "+v"(X.vr1), "+v"(X.vr2), "+v"(X.vr3) :: "memory")
#define BF8(x) __builtin_bit_cast(bf16x8, x)
#define RKS_COMPUTE(X, c_) do { RKS_WAIT(X); \
        const float ul[4] = {bflo(X.uw.x), bfhi(X.uw.x), bflo(X.uw.y), bfhi(X.uw.y)}; const float vl[4] = {bflo(X.vr0), bflo(X.vr1), bflo(X.vr2), bflo(X.vr3)}; \
        f32x4 zp = (f32x4){0.f, 0.f, 0.f, 0.f}, yp = zp; \
        { const float lo[4] = {acc[0][0], acc[0][1], acc[0][2], acc[0][3]}, hi[4] = {acc[1][0], acc[1][1], acc[1][2], acc[1][3]}; const bf16x8 sf = pack_frag(lo, hi); zp = mfma16(BF8(X.apf0), sf, zp); yp = mfma16(BF8(X.rpf0), sf, yp); } \
        { const float lo[4] = {acc[2][0], acc[2][1], acc[2][2], acc[2][3]}, hi[4] = {acc[3][0], acc[3][1], acc[3][2], acc[3][3]}; const bf16x8 sf = pack_frag(lo, hi); zp = mfma16(BF8(X.apf1), sf, zp); yp = mfma16(BF8(X.rpf1), sf, yp); } \
        const float z[4] = {zp[0] + ul[0], zp[1] + ul[1], zp[2] + ul[2], zp[3] + ul[3]}; \
        yp = mfma16(BF8(X.mmf), pack_frag(ul, vl), yp); \
        const bf16x8 zvf = pack_frag(z, vl); \
        acc[0] = mfma16(BF8(X.bkf0), zvf, acc[0]); acc[1] = mfma16(BF8(X.bkf1), zvf, acc[1]); acc[2] = mfma16(BF8(X.bkf2), zvf, acc[2]); acc[3] = mfma16(BF8(X.bkf3), zvf, acc[3]); \
        { const f32x4 g4 = {__expf(bflo(X.gl0.x)), __expf(bfhi(X.gl0.x)), __expf(bflo(X.gl0.y)), __expf(bfhi(X.gl0.y))}; acc[0] *= g4; } \
        { const f32x4 g4 = {__expf(bflo(X.gl1.x)), __expf(bfhi(X.gl1.x)), __expf(bflo(X.gl1.y)), __expf(bfhi(X.gl1.y))}; acc[1] *= g4; } \
        { const f32x4 g4 = {__expf(bflo(X.gl2.x)), __expf(bfhi(X.gl2.x)), __expf(bflo(X.gl2.y)), __expf(bfhi(X.gl2.y))}; acc[2] *= g4; } \
        { const f32x4 g4 = {__expf(bflo(X.gl3.x)), __expf(bfhi(X.gl3.x)), __expf(bflo(X.gl3.y)), __expf(bfhi(X.gl3.y))}; acc[3] *= g4; } \
        _Pragma("unroll") for (int r = 0; r < 4; ++r) ybuf[((((c_) % 12) * 16) + 4 * q + r) * 16 + m] = yp[r]; } while (0)
    asm volatile("; SEQ_BEGIN");
    OpSet A, B, C;
    RKS_LOAD(A, 0); RKS_LOAD(B, 1);
    for (int c0 = 0; c0 < 144; c0 += 12) {
#pragma unroll
        for (int cc = 0; cc < 12; cc += 3) { const int c = c0 + cc;
            RKS_LOAD(C, c + 2); __builtin_amdgcn_sched_barrier(0);
            RKS_COMPUTE(A, c); __builtin_amdgcn_sched_barrier(0);
            { const int cn = c + 3 < 144 ? c + 3 : 143; RKS_LOAD(A, cn); } __builtin_amdgcn_sched_barrier(0);
            RKS_COMPUTE(B, c + 1); __builtin_amdgcn_sched_barrier(0);
            { const int cn = c + 4 < 144 ? c + 4 : 143; RKS_LOAD(B, cn); } __builtin_amdgcn_sched_barrier(0);
            RKS_COMPUTE(C, c + 2); __builtin_amdgcn_sched_barrier(0); }
#pragma unroll
        for (int k = 0; k < 12; ++k) { const int rr = (lane >> 2) + 16 * k, n = c0 * 16 + rr; const int grow = (rc0 - sgn * 4 * q) + sgn * n + (int)(n >= 256) * rdel;
            *(f32x4*)(Yw + (size_t)grow * 384 + (lane & 3) * 4) = *(const LAS f32x4*)(ybuf + rr * 16 + (lane & 3) * 4); }
    }
    asm volatile("; SEQ_END");
#undef RKS_LOAD
#undef RKS_COMPUTE
#undef RKS_WAIT
#undef GLDS16
#undef GLDS8
#undef GLDS2
#undef BF8
}

__device__ __forceinline__ void rwkv_seq_block(const Params& p, int l, int u, LAS unsigned char* lds) {
    (void)l;
    const int tid = threadIdx.x, lane = tid & 63, wv = __builtin_amdgcn_readfirstlane(tid >> 6), m = lane & 15, q = lane >> 4;
    const int b = u / 12, h = (u % 12) >> 1, d = u & 1, sgn = d ? -1 : 1;
    const unsigned char* XPb = p.ws + CH_XP + (size_t)u * 144 * 4096; const unsigned char* BKb = p.ws + CH_BK + (size_t)u * 144 * 4096;
    const unsigned char* MMb = p.ws + CH_MM + (size_t)u * 144 * 1024; const unsigned char* GTb = p.ws + CH_GT + (size_t)u * 144 * 128;
    LAS unsigned char* ring = lds + 49152;
#define SEQ_BAR() asm volatile("s_waitcnt lgkmcnt(0)\n\ts_barrier" ::: "memory")
    __syncthreads();
    if (wv >= 4) {
        const int lw = wv - 4; const bool hasmm = lw == 0, hasgt = (lw == 1) && lane < 8;
        lu4 xp[3], bk[3], mm[3], gt[3];
#define LDR_LOAD(k, c_) do { const int cc_ = (c_) < 144 ? (c_) : 143; xp[k] = *(const lu4*)(XPb + (size_t)cc_ * 4096 + lw * 1024 + lane * 16); bk[k] = *(const lu4*)(BKb + (size_t)cc_ * 4096 + lw * 1024 + lane * 16); \
            if (hasmm) mm[k] = *(const lu4*)(MMb + (size_t)cc_ * 1024 + lane * 16); if (hasgt) gt[k] = *(const lu4*)(GTb + (size_t)cc_ * 128 + lane * 16); } while (0)
#define LDR_STORE(k, c_) do { if ((c_) < 144) { LAS unsigned char* sl_ = ring + ((c_) % 3) * 9728; *(LAS lu4*)(sl_ + lw * 1024 + lane * 16) = xp[k]; *(LAS lu4*)(sl_ + 4096 + lw * 1024 + lane * 16) = bk[k]; \
            if (hasmm) *(LAS lu4*)(sl_ + 8192 + lane * 16) = mm[k]; if (hasgt) *(LAS lu4*)(sl_ + 9216 + lane * 16) = gt[k]; } } while (0)
        LDR_LOAD(0, 0); LDR_LOAD(1, 1); LDR_LOAD(2, 2);
        LDR_STORE(0, 0); LDR_LOAD(0, 3); LDR_STORE(1, 1); LDR_LOAD(1, 4);
        SEQ_BAR();
        for (int i0 = 0; i0 < 144; i0 += 3) {
            LDR_STORE(2, i0 + 2); LDR_LOAD(2, i0 + 5); SEQ_BAR();
            LDR_STORE(0, i0 + 3); LDR_LOAD(0, i0 + 6); SEQ_BAR();
            LDR_STORE(1, i0 + 4); LDR_LOAD(1, i0 + 7); SEQ_BAR(); }
#undef LDR_LOAD
#undef LDR_STORE
    } else {
        const int iw = wv;
        const bf16_t* UL = (const bf16_t*)(p.ws + CH_UL) + (size_t)u * 144 * 1024; const bf16_t* VS = (const bf16_t*)(p.ws + U_VS) + h * 64 + 16 * iw;
        float* Yw = (float*)(p.ws + U_YRK) + (size_t)d * NROW * 384 + h * 64 + 16 * iw;
        LAS float* ybuf = (LAS float*)(lds + wv * 12288);
        const int rc0 = NLAT + b * 256 + (d ? 255 : 0) + sgn * 4 * q, rdel = (b * 2048 + (d ? 2047 : 0)) - (NLAT + b * 256 + (d ? 255 : 0)) - sgn * 256;
        const unsigned vo8 = (unsigned)lane * 8u;
        f32x4 acc[4];
#pragma unroll
        for (int jt = 0; jt < 4; ++jt) acc[jt] = (f32x4){0.f, 0.f, 0.f, 0.f};
        struct Shared { bf16x8 apf0, apf1, rpf0, rpf1, bkf0, bkf1, bkf2, bkf3, mmf; u32x2 gl0, gl1, gl2, gl3; };
        struct Own { u32x2 uw; unsigned vr0, vr1, vr2, vr3; };
#define GLDS8(dst, voff, sbase) asm volatile("global_load_dwordx2 %0, %1, %2" : "=&v"(dst) : "v"(voff), "s"(sbase) : "memory")
#define GLDS2(dst, voff, sbase) asm volatile("global_load_ushort %0, %1, %2" : "=&v"(dst) : "v"(voff), "s"(sbase) : "memory")
#define OWN_LOAD(X, c_) do { const int cc_ = (c_) < 144 ? (c_) : 143; const int rb_ = rc0 + sgn * 16 * cc_ + (int)(cc_ >= 16) * rdel; const bf16_t* ulb = UL + ((size_t)cc_ * 4 + iw) * 256; \
            GLDS8(X.uw, vo8, ulb); const unsigned v0_ = (unsigned)(rb_) * 768u + 2u * m, v1_ = (unsigned)(rb_ + sgn) * 768u + 2u * m, v2_ = (unsigned)(rb_ + 2 * sgn) * 768u + 2u * m, v3_ = (unsigned)(rb_ + 3 * sgn) * 768u + 2u * m; \
            GLDS2(X.vr0, v0_, VS); GLDS2(X.vr1, v1_, VS); GLDS2(X.vr2, v2_, VS); GLDS2(X.vr3, v3_, VS); } while (0)
#define OWN_WAIT(X) asm volatile("s_waitcnt vmcnt(10)" : "+v"(X.uw), "+v"(X.vr0), "+v"(X.vr1), "+v"(X.vr2), "+v"(X.vr3) :: "memory")
#define SH_READ(S, c_) do { const int cc_ = (c_) < 144 ? (c_) : 143; const LAS unsigned char* sl_ = ring + (cc_ % 3) * 9728 + lane * 16; \
            S.apf0 = *(const LAS bf16x8*)(sl_); S.apf1 = *(const LAS bf16x8*)(sl_ + 1024); S.rpf0 = *(const LAS bf16x8*)(sl_ + 2048); S.rpf1 = *(const LAS bf16x8*)(sl_ + 3072); \
            S.bkf0 = *(const LAS bf16x8*)(sl_ + 4096); S.bkf1 = *(const LAS bf16x8*)(sl_ + 5120); S.bkf2 = *(const LAS bf16x8*)(sl_ + 6144); S.bkf3 = *(const LAS bf16x8*)(sl_ + 7168); S.mmf = *(const LAS bf16x8*)(sl_ + 8192); \
            const LAS unsigned char* gp_ = ring + (cc_ % 3) * 9728 + 9216 + q * 8; S.gl0 = *(const LAS u32x2*)(gp_); S.gl1 = *(const LAS u32x2*)(gp_ + 32); S.gl2 = *(const LAS u32x2*)(gp_ + 64); S.gl3 = *(const LAS u32x2*)(gp_ + 96); } while (0)
#define SEQ_COMPUTE(S, X, c_) do { OWN_WAIT(X); \
            const float ul[4] = {bflo(X.uw.x), bfhi(X.uw.x), bflo(X.uw.y), bfhi(X.uw.y)}; const float vl[4] = {bflo(X.vr0), bflo(X.vr1), bflo(X.vr2), bflo(X.vr3)}; \
            f32x4 zp = (f32x4){0.f, 0.f, 0.f, 0.f}, yp = zp; \
            { const float lo[4] = {acc[0][0], acc[0][1], acc[0][2], acc[0][3]}, hi[4] = {acc[1][0], acc[1][1], acc[1][2], acc[1][3]}; const bf16x8 sf = pack_frag(lo, hi); zp = mfma16(S.apf0, sf, zp); yp = mfma16(S.rpf0, sf, yp); } \
            { const float lo[4] = {acc[2][0], acc[2][1], acc[2][2], acc[2][3]}, hi[4] = {acc[3][0], acc[3][1], acc[3][2], acc[3][3]}; const bf16x8 sf = pack_frag(lo, hi); zp = mfma16(S.apf1, sf, zp); yp = mfma16(S.rpf1, sf, yp); } \
            const float z[4] = {zp[0] + ul[0], zp[1] + ul[1], zp[2] + ul[2], zp[3] + ul[3]}; \
            yp = mfma16(S.mmf, pack_frag(ul, vl), yp); \
            const bf16x8 zvf = pack_frag(z, vl); \
            acc[0] = mfma16(S.bkf0, zvf, acc[0]); acc[1] = mfma16(S.bkf1, zvf, acc[1]); acc[2] = mfma16(S.bkf2, zvf, acc[2]); acc[3] = mfma16(S.bkf3, zvf, acc[3]); \
            { const f32x4 g4 = {__expf(bflo(S.gl0.x)), __expf(bfhi(S.gl0.x)), __expf(bflo(S.gl0.y)), __expf(bfhi(S.gl0.y))}; acc[0] *= g4; } \
            { const f32x4 g4 = {__expf(bflo(S.gl1.x)), __expf(bfhi(S.gl1.x)), __expf(bflo(S.gl1.y)), __expf(bfhi(S.gl1.y))}; acc[1] *= g4; } \
            { const f32x4 g4 = {__expf(bflo(S.gl2.x)), __expf(bfhi(S.gl2.x)), __expf(bflo(S.gl2.y)), __expf(bfhi(S.gl2.y))}; acc[2] *= g4; } \
            { const f32x4 g4 = {__expf(bflo(S.gl3.x)), __expf(bfhi(S.gl3.x)), __expf(bflo(S.gl3.y)), __expf(bfhi(S.gl3.y))}; acc[3] *= g4; } \
            _Pragma("unroll") for (int r = 0; r < 4; ++r) ybuf[((((c_) % 12) * 16) + 4 * q + r) * 16 + m] = yp[r]; } while (0)
#define SEQ_STEP(SC, SN, XC, XN2, c_) do { SH_READ(SN, (c_) + 1); OWN_LOAD(XN2, (c_) + 2); __builtin_amdgcn_sched_barrier(0); SEQ_COMPUTE(SC, XC, c_); __builtin_amdgcn_sched_barrier(0); SEQ_BAR(); } while (0)
        Shared S0, S1; Own A, B, C;
        OWN_LOAD(A, 0); OWN_LOAD(B, 1);
        SEQ_BAR();
        SH_READ(S0, 0);
        for (int c0 = 0; c0 < 144; c0 += 12) {
#pragma unroll
            for (int cc = 0; cc < 12; cc += 6) { const int c = c0 + cc;
                SEQ_STEP(S0, S1, A, C, c); SEQ_STEP(S1, S0, B, A, c + 1); SEQ_STEP(S0, S1, C, B, c + 2);
                SEQ_STEP(S1, S0, A, C, c + 3); SEQ_STEP(S0, S1, B, A, c + 4); SEQ_STEP(S1, S0, C, B, c + 5); }
#pragma unroll
            for (int k = 0; k < 12; ++k) { const int rr = (lane >> 2) + 16 * k, n = c0 * 16 + rr; const int grow = (rc0 - sgn * 4 * q) + sgn * n + (int)(n >= 256) * rdel;
                *(f32x4*)(Yw + (size_t)grow * 384 + (lane & 3) * 4) = *(const LAS f32x4*)(ybuf + rr * 16 + (lane & 3) * 4); }
        }
#undef GLDS8
#undef GLDS2
#undef OWN_LOAD
#undef OWN_WAIT
#undef SH_READ
#undef SEQ_COMPUTE
#undef SEQ_STEP
    }
#undef SEQ_BAR
    __syncthreads();
}

__device__ __forceinline__ void rwkv_finish(const Params& p, int l) {
    const int sub = threadIdx.x & 7; const int npair = (l == 0 ? NROW : NLAT) * 6;
    const bf16_t* RS = (const bf16_t*)(p.ws + U_RS); const bf16_t* KS = (const bf16_t*)(p.ws + U_KS); const bf16_t* VS = (const bf16_t*)(p.ws + U_VS);
    const bf16_t* AG0 = (const bf16_t*)(p.ws + U_AG); const bf16_t* AG1 = (const bf16_t*)(p.ws + U_AG + SZ384); const bf16_t* G = (const bf16_t*)(p.ws + U_G);
    const float* Y0 = (const float*)(p.ws + U_YRK); const float* Y1 = Y0 + (size_t)NROW * 384; bf16_t* YC = (bf16_t*)(p.ws + WS_ABUF);
    for (int pr = (blockIdx.x * NTHR + threadIdx.x) >> 3; pr < npair; pr += (gridDim.x * NTHR) >> 3) { const int row = pr / 6, h = pr % 6, col = h * 64 + sub * 8; const size_t o = (size_t)row * 384 + col;
        float y[8]; { const float4 a0 = *(const float4*)(Y0 + o), a1 = *(const float4*)(Y0 + o + 4), c0 = *(const float4*)(Y1 + o), c1 = *(const float4*)(Y1 + o + 4);
            y[0] = a0.x + c0.x; y[1] = a0.y + c0.y; y[2] = a0.z + c0.z; y[3] = a0.w + c0.w; y[4] = a1.x + c1.x; y[5] = a1.y + c1.y; y[6] = a1.z + c1.z; y[7] = a1.w + c1.w; }
        float s = 0.f;
#pragma unroll
        for (int k = 0; k < 8; ++k) s += y[k];
        s += __shfl_xor(s, 1); s += __shfl_xor(s, 2); s += __shfl_xor(s, 4); const float mean = s * (1.0f / 64.0f);
        float v2 = 0.f;
#pragma unroll
        for (int k = 0; k < 8; ++k) { const float dd = y[k] - mean; v2 += dd * dd; }
        v2 += __shfl_xor(v2, 1); v2 += __shfl_xor(v2, 2); v2 += __shfl_xor(v2, 4); const float rstd = rsqrtf(v2 * (1.0f / 64.0f) + 64e-5f);
        float r[8], kx[8], vx[8], a0[8], a1[8], gx[8];
        unpack8(*(const uint4*)(RS + o), r); unpack8(*(const uint4*)(KS + o), kx); unpack8(*(const uint4*)(VS + o), vx); unpack8(*(const uint4*)(AG0 + o), a0); unpack8(*(const uint4*)(AG1 + o), a1); unpack8(*(const uint4*)(G + o), gx);
        const float* ka = p.in[27] + l * 384 + col; const float* rk = p.in[28] + l * 384 + col; const float* lw = p.in[29] + l * 384 + col; const float* lb = p.in[30] + l * 384 + col;
        float bs = 0.f;
#pragma unroll
        for (int k = 0; k < 8; ++k) { const float kd0 = kx[k] * (1.0f + (a0[k] - 1.0f) * ka[k]), kd1 = kx[k] * (1.0f + (a1[k] - 1.0f) * ka[k]); bs += r[k] * (kd0 + kd1) * rk[k]; }
        bs += __shfl_xor(bs, 1); bs += __shfl_xor(bs, 2); bs += __shfl_xor(bs, 4);
        float ov[8];
#pragma unroll
        for (int k = 0; k < 8; ++k) ov[k] = ((y[k] - mean) * rstd * lw[k] + lb[k] + bs * vx[k]) * gx[k];
        *(uint4*)(YC + (size_t)row * 1024 + 640 + col) = pack8(ov);
    }
}

__device__ __forceinline__ void phase_normrouter(const Params& p, int l, const float* xl, const float* xc, LAS unsigned char* lds) {
    LAS float* hrow = (LAS float*)lds;
    LAS float* part = (LAS float*)(lds + 65536);
    const int lane = threadIdx.x & 63, wv = threadIdx.x >> 6, e = lane & 15, cq = lane >> 4; const int ngrp = (l == 0 ? NROW : NLAT) / 16;
    const float* mod = (const float*)(p.ws + WS_MOD) + (size_t)l * 17 * 6144; const float* g1 = p.in[6] + (l * 4 + 1) * 1024; const float* g2 = p.in[6] + (l * 4 + 2) * 1024;
    const bf16_t* Y = (const bf16_t*)(p.ws + U_Y); unsigned char* A8 = p.ws + WS_ABUF; float* AFF = (float*)(p.ws + WS_AFF);
    float wr[32];
#pragma unroll
    for (int j = 0; j < 32; ++j) wr[j] = p.in[31][((size_t)l * 1024 + 128 * wv + 32 * cq + j) * 16 + e];
    for (int gi = blockIdx.x; gi < ngrp; gi += gridDim.x) { const int r0 = gi * 16 + wv; const int b = r0 < NLAT ? (r0 >> 11) : 16; const float* mb = mod + (size_t)b * 6144;
        const float* xs = xrow(xl, xc, r0); float* xd = xrow_w(p.out, (float*)(p.ws + WS_CTXA), r0);
        float4 y[2][4], x[2][4]; float ss[2] = {0.f, 0.f};
#pragma unroll
        for (int q = 0; q < 2; ++q)
#pragma unroll
            for (int i = 0; i < 4; ++i) { { const u32x2 yw = *(const u32x2*)(Y + (size_t)(r0 + 8 * q) * 1024 + i * 256 + lane * 4); y[q][i] = make_float4(bflo(yw.x), bfhi(yw.x), bflo(yw.y), bfhi(yw.y)); }
                x[q][i] = *(const float4*)(xs + (size_t)q * 8192 + i * 256 + lane * 4); }
#pragma unroll
        for (int q = 0; q < 2; ++q)
#pragma unroll
            for (int i = 0; i < 4; ++i) ss[q] += y[q][i].x * y[q][i].x + y[q][i].y * y[q][i].y + y[q][i].z * y[q][i].z + y[q][i].w * y[q][i].w;
        ss[0] = wave_sum(ss[0]); ss[1] = wave_sum(ss[1]); const float rs[2] = {rsqrtf(ss[0] * (1.0f / 1024.0f) + 1e-6f), rsqrtf(ss[1] * (1.0f / 1024.0f) + 1e-6f)};
        float s2[2] = {0.f, 0.f};
#pragma unroll
        for (int i = 0; i < 4; ++i) { const int c = i * 256 + lane * 4; const float4 gg = *(const float4*)(g1 + c), gt = *(const float4*)(mb + 2048 + c);
#pragma unroll
            for (int q = 0; q < 2; ++q) {
                x[q][i].x += gt.x * (y[q][i].x * rs[q] * gg.x); x[q][i].y += gt.y * (y[q][i].y * rs[q] * gg.y); x[q][i].z += gt.z * (y[q][i].z * rs[q] * gg.z); x[q][i].w += gt.w * (y[q][i].w * rs[q] * gg.w);
                *(float4*)(xd + (size_t)q * 8192 + c) = x[q][i]; s2[q] += x[q][i].x * x[q][i].x + x[q][i].y * x[q][i].y + x[q][i].z * x[q][i].z + x[q][i].w * x[q][i].w; } }
        s2[0] = wave_sum(s2[0]); s2[1] = wave_sum(s2[1]); const float rs2[2] = {rsqrtf(s2[0] * (1.0f / 1024.0f) + 1e-6f), rsqrtf(s2[1] * (1.0f / 1024.0f) + 1e-6f)};
        float hv[2][4][4]; float amax[2] = {0.f, 0.f};
        __syncthreads();
#pragma unroll
        for (int i = 0; i < 4; ++i) { const int c = i * 256 + lane * 4; const float4 gg = *(const float4*)(g2 + c), sh = *(const float4*)(mb + 3072 + c), sc = *(const float4*)(mb + 4096 + c);
#pragma unroll
            for (int q = 0; q < 2; ++q) {
                hv[q][i][0] = x[q][i].x * rs2[q] * gg.x * (1.f + sc.x) + sh.x; hv[q][i][1] = x[q][i].y * rs2[q] * gg.y * (1.f + sc.y) + sh.y; hv[q][i][2] = x[q][i].z * rs2[q] * gg.z * (1.f + sc.z) + sh.z; hv[q][i][3] = x[q][i].w * rs2[q] * gg.w * (1.f + sc.w) + sh.w;
                *(LAS lf4*)(hrow + (wv + 8 * q) * 1024 + c) = (lf4){hv[q][i][0], hv[q][i][1], hv[q][i][2], hv[q][i][3]};
                amax[q] = fmaxf(amax[q], fmaxf(fmaxf(fabsf(hv[q][i][0]), fabsf(hv[q][i][1])), fmaxf(fabsf(hv[q][i][2]), fabsf(hv[q][i][3])))); } }
#pragma unroll
        for (int o = 32; o >= 1; o >>= 1) { amax[0] = fmaxf(amax[0], __shfl_xor(amax[0], o)); amax[1] = fmaxf(amax[1], __shfl_xor(amax[1], o)); }
#pragma unroll
        for (int q = 0; q < 2; ++q) { const int r = r0 + 8 * q; const float am = fmaxf(amax[q], 1e-20f), qs = 127.0f / am;
            if (lane == 0) ((float*)(p.ws + WS_SX))[r] = am * (1.0f / 127.0f);
#pragma unroll
            for (int i = 0; i < 4; ++i) { unsigned w = 0u;
#pragma unroll
                for (int k = 0; k < 4; ++k) w |= ((unsigned)__float2int_rn(hv[q][i][k] * qs) & 255u) << (8 * k);
                *(unsigned*)(A8 + (size_t)r * 1024 + i * 256 + lane * 4) = w; } }
        __syncthreads();
#pragma unroll 2
        for (int rr = 0; rr < 16; ++rr) { const LAS float* hp = hrow + rr * 1024 + 128 * wv + 32 * cq; float acc = 0.f;
#pragma unroll
            for (int j4 = 0; j4 < 8; ++j4) { const lf4 h4 = *(const LAS lf4*)(hp + 4 * j4); acc += h4.x * wr[4 * j4] + h4.y * wr[4 * j4 + 1] + h4.z * wr[4 * j4 + 2] + h4.w * wr[4 * j4 + 3]; }
            acc += __shfl_xor(acc, 16); acc += __shfl_xor(acc, 32);
            if (cq == 0) part[(rr * 8 + wv) * 16 + e] = acc; }
        __syncthreads();
        if (lane < 32) { const int row = wv + 8 * cq; float lgt = 0.f;
#pragma unroll
            for (int w = 0; w < 8; ++w) lgt += part[(row * 8 + w) * 16 + e];
            float mxl = lgt;
#pragma unroll
            for (int o = 8; o >= 1; o >>= 1) mxl = fmaxf(mxl, __shfl_xor(mxl, o));
            const float ex = expf(lgt - mxl); float den = ex;
#pragma unroll
            for (int o = 8; o >= 1; o >>= 1) den += __shfl_xor(den, o);
            AFF[(size_t)(r0 + 8 * cq) * 16 + e] = ex / den; }
    }
}

__device__ __forceinline__ void phase_topk(const Params& p, int l, LAS unsigned char* lds) {
    LAS unsigned* keys = (LAS unsigned*)lds;
    LAS int* toks = (LAS int*)(lds + 8192);
    LAS unsigned* hist = (LAS unsigned*)(lds + 9216);
    LAS unsigned* wtot = (LAS unsigned*)(lds + 10240);
    LAS unsigned* sel = (LAS unsigned*)(lds + 10304);
    const int tid = threadIdx.x, lane = tid & 63, wv = tid >> 6, nitem = l == 0 ? 512 : 256;
    const float* AFF = (const float*)(p.ws + WS_AFF); int* SLOT = (int*)(p.ws + WS_SLOT); float* SELG = (float*)(p.ws + WS_SELG);
    const bf16_t* A = (const bf16_t*)(p.ws + WS_ABUF); bf16_t* XS = (bf16_t*)(p.ws + U_XSEL);
    for (int it = blockIdx.x; it < nitem; it += gridDim.x) { const bool lat = it < 256; const int be = it & 255, b = be >> 4, e = be & 15;
        const int n = lat ? SEQ : CTXL, cap = lat ? 256 : 32, rowbase = lat ? b * 2048 : NLAT + b * 256, xoff = lat ? b * 256 : 4096 + b * 32;
        const int per = n / NTHR > 0 ? n / NTHR : 1;
        const int t0 = tid * per; const bool act = t0 < n;
        unsigned kx[4];
        __syncthreads();
#pragma unroll
        for (int j = 0; j < 4; ++j) { kx[j] = 0u; if (act && j < per) { kx[j] = __float_as_uint(AFF[(size_t)(rowbase + t0 + j) * 16 + e]); keys[t0 + j] = kx[j]; } }
        unsigned prefix = 0u; int krem = cap;
        for (int pass = 0; pass < 4; ++pass) { const int shift = 24 - 8 * pass;
            if (tid < 256) hist[tid] = 0u;
            __syncthreads();
#pragma unroll
            for (int j = 0; j < 4; ++j) if (act && j < per) { const bool match = pass == 0 || (kx[j] >> (shift + 8)) == (prefix >> (shift + 8)); if (match) atomicAdd((unsigned*)&hist[(kx[j] >> shift) & 255u], 1u); }
            __syncthreads();
            if (tid < 256) { unsigned above = 0u; for (int bb = tid + 1; bb < 256; ++bb) above += hist[bb]; const unsigned mine = hist[tid];
                if (above < (unsigned)krem && above + mine >= (unsigned)krem) { sel[0] = (unsigned)tid; sel[1] = (unsigned)krem - above; } }
            __syncthreads();
            prefix |= sel[0] << shift; krem = (int)sel[1];
            __syncthreads();
        }
        unsigned loc = 0u, pre[4];
#pragma unroll
        for (int j = 0; j < 4; ++j) { pre[j] = loc; if (act && j < per) loc += (kx[j] > prefix ? 1u : 0u) + (kx[j] == prefix ? 65536u : 0u); }
        unsigned inc = loc;
#pragma unroll
        for (int o = 1; o < 64; o <<= 1) { const unsigned t = __shfl_up(inc, o); if (lane >= o) inc += t; }
        if (lane == 63) wtot[wv] = inc;
        __syncthreads();
        unsigned base = inc - loc;
        for (int w = 0; w < wv; ++w) base += wtot[w];
#pragma unroll
        for (int j = 0; j < 4; ++j) if (act && j < per) { const unsigned c = base + pre[j]; const int gtb = (int)(c & 0xffffu), eqb = (int)(c >> 16);
            const bool s = kx[j] > prefix || (kx[j] == prefix && eqb < krem); const int slot = gtb + (eqb < krem ? eqb : krem);
            if (s) { SELG[e * XROWS + xoff + slot] = __uint_as_float(kx[j]); toks[slot] = t0 + j; }
            SLOT[(size_t)(rowbase + t0 + j) * 16 + e] = s ? slot : -1; }
        __syncthreads();
        for (int s = wv; s < cap; s += 8) { const int row = rowbase + toks[s]; const lu4* src = (const lu4*)((const unsigned char*)A + (size_t)row * 1024); lu4* dst = (lu4*)((unsigned char*)XS + ((size_t)e * XROWS + xoff + s) * 1024);
            dst[lane] = src[lane]; if (lane == 0) ((float*)(p.ws + WS_SXS))[e * XROWS + xoff + s] = ((const float*)(p.ws + WS_SX))[row]; }
    }
}

struct GroupedOrder { int nMl, nNl, G, c, total;
    __device__ void init(int nMl_, int nNl_, int, int G_, int c_) { nMl = nMl_; nNl = nNl_; G = G_; c = c_; total = 16 * nMl_ * nNl_; }
    __device__ bool next(int i, pg8::Unit& u) const {
        int L;
        if ((G & 7) == 0 && (total & 7) == 0) { const int W = G >> 3, x = c & 7, r = c >> 3, t8 = total >> 3, k = i * W + r; if (k >= t8) return false; L = x * t8 + k; }
        else { const long LL = (long)i * G + c; if (LL >= total) return false; L = (int)LL; }
        const int per = nMl * nNl, e = L / per; int idx = L % per;
        const int mg = idx / (8 * nNl) < nMl / 8 ? idx / (8 * nNl) : nMl / 8, gm = (mg + 1) * 8 <= nMl ? 8 : nMl - mg * 8; idx -= mg * 8 * nNl;
        const int ng = idx / (gm * 4) < nNl / 4 ? idx / (gm * 4) : nNl / 4, gn = (ng + 1) * 4 <= nNl ? 4 : nNl - ng * 4; idx -= ng * gm * 4;
        u.pm = e * 18 + mg * 8 + idx / gn; u.pn = e * nNl + ng * 4 + idx % gn; return true; }
    __device__ __forceinline__ void a_ready(const pg8::Unit&) const {}
    __device__ __forceinline__ void done(const pg8::Unit&) const {}
};
struct EpiSwiGLU { static constexpr bool PERM = true, AFTER_DRAIN = false; unsigned char* H; const float* sx; const float* sw;
    __device__ __forceinline__ void operator()(const f32x4 (&acc)[2][2][4][2], const pg8::Unit& u, int wr, int wc, int fr, int fq) const {
        typedef int i32x4_ __attribute__((ext_vector_type(4)));
        const int e = u.pn / 22, pnl = u.pn - e * 22; const int row0 = u.pm * 256 + wr * 64 + fr, col0 = pnl * 128 + wc * 32 + 8 * fq;
        const float* swp = sw + (size_t)u.pn * 256 + wc * 32 + 8 * fq; const float4 g0 = *(const float4*)swp, g1 = *(const float4*)(swp + 4), u0 = *(const float4*)(swp + 128), u1 = *(const float4*)(swp + 132);
        const float swg[8] = {g0.x, g0.y, g0.z, g0.w, g1.x, g1.y, g1.z, g1.w}, swu[8] = {u0.x, u0.y, u0.z, u0.w, u1.x, u1.y, u1.z, u1.w};
#pragma unroll
        for (int ai = 0; ai < 2; ++ai)
#pragma unroll
            for (int m = 0; m < 4; ++m) { const int r = row0 + ai * 128 + m * 16; const float sr = sx[r]; unsigned char* rowp = H + (size_t)r * DE + col0; float o[8];
#pragma unroll
                for (int n = 0; n < 2; ++n) { const i32x4_ ig = __builtin_bit_cast(i32x4_, acc[ai][0][m][n]), iu = __builtin_bit_cast(i32x4_, acc[ai][1][m][n]);
#pragma unroll
                    for (int j = 0; j < 4; ++j) { const float g = (float)ig[j] * (sr * swg[n * 4 + j]), uu = (float)iu[j] * (sr * swu[n * 4 + j]); o[n * 4 + j] = g * sigm(g) * uu; } }
                u32x2 w8; { int t0 = 0, t1 = 0; t0 = __builtin_amdgcn_cvt_pk_fp8_f32(o[0], o[1], t0, false); t0 = __builtin_amdgcn_cvt_pk_fp8_f32(o[2], o[3], t0, true); t1 = __builtin_amdgcn_cvt_pk_fp8_f32(o[4], o[5], t1, false); t1 = __builtin_amdgcn_cvt_pk_fp8_f32(o[6], o[7], t1, true); w8.x = (unsigned)t0; w8.y = (unsigned)t1; }
                *(u32x2*)rowp = w8; }
    }
};
struct EpiScaleBf16 { static constexpr bool PERM = true, AFTER_DRAIN = false; bf16_t* O; int ldc; const float* sx; const float* sw;
    __device__ __forceinline__ void operator()(const f32x4 (&acc)[2][2][4][2], const pg8::Unit& u, int wr, int wc, int fr, int fq) const {
        typedef int i32x4_ __attribute__((ext_vector_type(4)));
        const int row0 = u.pm * 256 + wr * 64 + fr, col0 = u.pn * 256 + wc * 32 + 8 * fq;
        float swv[2][8];
#pragma unroll
        for (int bj = 0; bj < 2; ++bj) { const float4 a = *(const float4*)(sw + col0 + bj * 128), b = *(const float4*)(sw + col0 + bj * 128 + 4); swv[bj][0] = a.x; swv[bj][1] = a.y; swv[bj][2] = a.z; swv[bj][3] = a.w; swv[bj][4] = b.x; swv[bj][5] = b.y; swv[bj][6] = b.z; swv[bj][7] = b.w; }
#pragma unroll
        for (int ai = 0; ai < 2; ++ai)
#pragma unroll
            for (int m = 0; m < 4; ++m) { const int r = row0 + ai * 128 + m * 16; const float sr = sx[r]; bf16_t* rowp = O + (size_t)r * ldc + col0;
#pragma unroll
                for (int bj = 0; bj < 2; ++bj) { float o[8];
#pragma unroll
                    for (int n = 0; n < 2; ++n) { const i32x4_ iv = __builtin_bit_cast(i32x4_, acc[ai][bj][m][n]);
#pragma unroll
                        for (int j = 0; j < 4; ++j) o[n * 4 + j] = (float)iv[j] * (sr * swv[bj][n * 4 + j]); }
                    *(uint4*)(rowp + bj * 128) = pack8(o); } }
    }
};
struct EpiGate { static constexpr bool PERM = true, AFTER_DRAIN = false; bf16_t* O; const float* gate; const float* sw;
    __device__ __forceinline__ void operator()(const f32x4 (&acc)[2][2][4][2], const pg8::Unit& u, int wr, int wc, int fr, int fq) const {
        pg8::fp8_acc_settle();
        const int pnl = u.pn & 3; const int row0 = u.pm * 256 + wr * 64 + fr, col0 = pnl * 256 + wc * 32 + 8 * fq;
#pragma unroll
        for (int bj = 0; bj < 2; ++bj) { const float* sp = sw + (size_t)u.pn * 256 + wc * 32 + 8 * fq + bj * 128; const float4 sa = *(const float4*)sp, sb = *(const float4*)(sp + 4);
#pragma unroll
            for (int ai = 0; ai < 2; ++ai)
#pragma unroll
                for (int m = 0; m < 4; ++m) { const int r = row0 + ai * 128 + m * 16; const float gt = gate[r]; const f32x4 v0 = acc[ai][bj][m][0], v1 = acc[ai][bj][m][1];
                    u32x4 w; w.x = pack2(v0[0] * (gt * sa.x), v0[1] * (gt * sa.y)); w.y = pack2(v0[2] * (gt * sa.z), v0[3] * (gt * sa.w)); w.z = pack2(v1[0] * (gt * sb.x), v1[1] * (gt * sb.y)); w.w = pack2(v1[2] * (gt * sb.z), v1[3] * (gt * sb.w));
                    *(u32x4*)(O + (size_t)r * 1024 + col0 + bj * 128) = w; } }
    }
};

__device__ __forceinline__ void phase_combine(const Params& p, int l) {
    const int lane = threadIdx.x & 63, wv = threadIdx.x >> 6; const int nrow = l == 0 ? NROW : NLAT;
    const float* mod = (const float*)(p.ws + WS_MOD) + (size_t)l * 17 * 6144; const float* g3 = p.in[6] + (l * 4 + 3) * 1024;
    const int* SLOT = (const int*)(p.ws + WS_SLOT); const bf16_t* YE = (const bf16_t*)(p.ws + U_YEXP); bf16_t* A = (bf16_t*)(p.ws + WS_ABUF);
    const int rstep = gridDim.x * 8; int r = blockIdx.x * 8 + wv;
    int nslot = (r < nrow && lane < 16) ? SLOT[(size_t)r * 16 + lane] : -1; float4 nx1[4];
    if (r < nrow) { const float* x1p = xrow(p.out, (const float*)(p.ws + WS_CTXA), r);
#pragma unroll
        for (int i = 0; i < 4; ++i) nx1[i] = *(const float4*)(x1p + i * 256 + lane * 4); }
    for (; r < nrow; r += rstep) { const bool lat = r < NLAT; const int b = lat ? (r >> 11) : ((r - NLAT) >> 8), mbi = lat ? b : 16, xoff = lat ? b * 256 : 4096 + b * 32;
        const float* mb = mod + (size_t)mbi * 6144;
        const int myslot = nslot; float4 xc[4];
#pragma unroll
        for (int i = 0; i < 4; ++i) xc[i] = nx1[i];
        float f[16];
#pragma unroll
        for (int k = 0; k < 16; ++k) f[k] = 0.f;
        unsigned long long mask = __ballot(myslot >= 0);
        while (mask) { int ee[4], sl4[4]; u32x2 w[4][4];
#pragma unroll
            for (int k = 0; k < 4; ++k) { if (mask) { ee[k] = __builtin_ctzll(mask); mask &= mask - 1; sl4[k] = __shfl(myslot, ee[k]); } else { ee[k] = -1; sl4[k] = 0; } }
#pragma unroll
            for (int k = 0; k < 4; ++k) if (ee[k] >= 0) { const bf16_t* yr = YE + ((size_t)ee[k] * XROWS + xoff + sl4[k]) * 1024 + lane * 4;
#pragma unroll
                for (int i = 0; i < 4; ++i) w[k][i] = *(const u32x2*)(yr + i * 256); }
#pragma unroll
            for (int k = 0; k < 4; ++k) if (ee[k] >= 0) {
#pragma unroll
                for (int i = 0; i < 4; ++i) { f[i * 4] += bflo(w[k][i].x); f[i * 4 + 1] += bfhi(w[k][i].x); f[i * 4 + 2] += bflo(w[k][i].y); f[i * 4 + 3] += bfhi(w[k][i].y); } } }
        { const int rn = r + rstep; nslot = (rn < nrow && lane < 16) ? SLOT[(size_t)rn * 16 + lane] : -1;
          if (rn < nrow) { const float* x1p = xrow(p.out, (const float*)(p.ws + WS_CTXA), rn);
#pragma unroll
              for (int i = 0; i < 4; ++i) nx1[i] = *(const float4*)(x1p + i * 256 + lane * 4); } }
        float ss = 0.f;
#pragma unroll
        for (int k = 0; k < 16; ++k) ss += f[k] * f[k];
        ss = wave_sum(ss); const float rs = rsqrtf(ss * (1.0f / 1024.0f) + 1e-6f);
        float* x2 = l == 0 ? xrow_w((float*)(p.ws + WS_XB), (float*)(p.ws + WS_CTXB), r) : p.out + (size_t)r * D;
        float4 xv[4];
#pragma unroll
        for (int i = 0; i < 4; ++i) { const int c = i * 256 + lane * 4; const float4 gg = *(const float4*)(g3 + c), gt = *(const float4*)(mb + 5120 + c); float4 x = xc[i];
            x.x += gt.x * (f[i * 4] * rs * gg.x); x.y += gt.y * (f[i * 4 + 1] * rs * gg.y); x.z += gt.z * (f[i * 4 + 2] * rs * gg.z); x.w += gt.w * (f[i * 4 + 3] * rs * gg.w);
            *(float4*)(x2 + c) = x; xv[i] = x; }
        if (l == 0) { const float* mb1 = mod + (size_t)17 * 6144 + (size_t)mbi * 6144; hnorm_row(p.in[6] + 4 * 1024, mb1, mb1 + 1024, p.ws + WS_ABUF + (size_t)r * 1024, (float*)(p.ws + WS_SH) + r, lane, xv); }
    }
}


#ifndef MK_ONLY
#define MK_ONLY -1
#endif
#define EN(k) (MK_ONLY < 0 || MK_ONLY == (k))
#ifndef MK_DUP
#define MK_DUP 0
#endif
#define NREP(k) ((((MK_DUP) >> (k)) & 1) ? 2 : 1)
constexpr int PH_PER_LAYER = 14, N_PHASES = 1 + 2 * PH_PER_LAYER;
#define IN(k) (lo <= (k) && (k) < hi)
#define SEAM(k) do { if (p.use_bar && IN(k) && IN((k) + 1)) xcd_barrier(bar); } while (0)
template <int l> __device__ __forceinline__ void layer_phases(const Params& p, LAS unsigned char* lds, const XcdBarrier& bar, const int lo, const int hi) {
    const int wv = __builtin_amdgcn_readfirstlane(threadIdx.x >> 6), G = gridDim.x; const int wid = blockIdx.x * 8 + wv, nw = G * 8;
        const int pb = 1 + l * PH_PER_LAYER;
        const float* xl = l == 0 ? p.in[0] : (const float*)(p.ws + WS_XB);
        const float* xc = l == 0 ? p.in[2] : (const float*)(p.ws + WS_CTXB);
        if (EN(0) && IN(pb + 0)) { { if (l == 0) phase_hnorm(p, 0, xl, xc); }
            if ((NREP(0)) == 2) { if (l == 0) phase_hnorm(p, 0, xl, xc); } }
        SEAM(pb + 0);
        if (EN(1) && IN(pb + 1)) { { pg8::Gemm g{(const bf16_t*)(p.ws + WS_ABUF), (const bf16_t*)(p.ws + WS_WIN), NROW, NINP, D / 2}; pg8::StaticOrder S; S.init(NROW, NINP, G, (int)blockIdx.x);
            EpiScaleBf16 E{(bf16_t*)(p.ws + U_P), NINP, (const float*)(p.ws + WS_SH), (const float*)(p.ws + WS_SWIN)}; pg8::gemm_phase<EpiScaleBf16, pg8::StaticOrder, false, 1>(lds, g, S, E, nullptr); }
            if ((NREP(1)) == 2) { pg8::Gemm g{(const bf16_t*)(p.ws + WS_ABUF), (const bf16_t*)(p.ws + WS_WIN), NROW, NINP, D / 2}; pg8::StaticOrder S; S.init(NROW, NINP, G, (int)blockIdx.x);
            EpiScaleBf16 E{(bf16_t*)(p.ws + U_P), NINP, (const float*)(p.ws + WS_SH), (const float*)(p.ws + WS_SWIN)}; pg8::gemm_phase<EpiScaleBf16, pg8::StaticOrder, false, 1>(lds, g, S, E, nullptr); } }
        SEAM(pb + 1);
        if (EN(2) && IN(pb + 2)) { phase_prep(p, l, lds);
            if ((NREP(2)) == 2) phase_prep(p, l, lds); }
        SEAM(pb + 2);
        if (EN(3) && IN(pb + 3)) { { lowrank_items(p, l, wid, nw, lds); if ((G & 31) == 0) s5_pass1_block(p, l, lds); else s5_pass1_items(p, l, wid, nw); }
            if ((NREP(3)) == 2) { lowrank_items(p, l, wid, nw, lds); if ((G & 31) == 0) s5_pass1_block(p, l, lds); else s5_pass1_items(p, l, wid, nw); } }
        SEAM(pb + 3);
        if (EN(4) && IN(pb + 4)) { { s5_carry(p, l); na_items(p, l, wid, nw, lds); }
            if ((NREP(4)) == 2) { s5_carry(p, l); na_items(p, l, wid, nw, lds); } }
        SEAM(pb + 4);
        if (EN(5) && IN(pb + 5)) { { s5_pass2_block(p, l, (int)blockIdx.x, G, lds); if (PRE_DUP == 6) s5_pass2_block(p, l, (int)blockIdx.x, G, lds); rwkv_pre_items(p, l, wid, nw, lds); if (PRE_DUP == 7) rwkv_pre_items(p, l, wid, nw, lds); }
            if ((NREP(5)) == 2) { s5_pass2_block(p, l, (int)blockIdx.x, G, lds); rwkv_pre_items(p, l, wid, nw, lds); } }
        SEAM(pb + 5);
        if (EN(6) && IN(pb + 6)) {
            if (G > 192) { const int bx = (int)blockIdx.x;
                if (bx < 192) rwkv_seq_block(p, l, bx, lds); else s5_glu_block(p, l, bx - 192, G - 192, lds);
                if ((NREP(6)) == 2) { if (bx < 192) rwkv_seq_block(p, l, bx, lds); else s5_glu_block(p, l, bx - 192, G - 192, lds); } }
            else { for (int task = wid; task < 768; task += nw) rwkv_seq_task(p, l, task, lds); s5_glu_items(p, l, wid, nw); } }
        SEAM(pb + 6);
        if (EN(7) && IN(pb + 7)) { rwkv_finish(p, l);
            if ((NREP(7)) == 2) rwkv_finish(p, l); }
        SEAM(pb + 7);
        if (EN(8) && IN(pb + 8)) { { const int M = l == 0 ? NROW : NLAT; pg8::Gemm g{(const bf16_t*)(p.ws + WS_ABUF), (const bf16_t*)(p.ws + WS_WOUT), M, D, D}; pg8::StaticOrder S; S.init(M, D, G, (int)blockIdx.x);
            pg8::EpiBf16<0> E{(bf16_t*)(p.ws + U_Y), D, nullptr, 0, 0}; pg8::gemm_phase<pg8::EpiBf16<0>, pg8::StaticOrder, false>(lds, g, S, E, nullptr); }
            if ((NREP(8)) == 2) { const int M = l == 0 ? NROW : NLAT; pg8::Gemm g{(const bf16_t*)(p.ws + WS_ABUF), (const bf16_t*)(p.ws + WS_WOUT), M, D, D}; pg8::StaticOrder S; S.init(M, D, G, (int)blockIdx.x);
            pg8::EpiBf16<0> E{(bf16_t*)(p.ws + U_Y), D, nullptr, 0, 0}; pg8::gemm_phase<pg8::EpiBf16<0>, pg8::StaticOrder, false>(lds, g, S, E, nullptr); } }
        SEAM(pb + 8);
        if (EN(9) && IN(pb + 9)) { phase_normrouter(p, l, xl, xc, lds);
            if ((NREP(9)) == 2) phase_normrouter(p, l, xl, xc, lds); }
        SEAM(pb + 9);
        if (EN(10) && IN(pb + 10)) { phase_topk(p, l, lds);
            if ((NREP(10)) == 2) phase_topk(p, l, lds); }
        SEAM(pb + 10);
        if (EN(11) && IN(pb + 11)) { { pg8::Gemm g{(const bf16_t*)(p.ws + U_XSEL), (const bf16_t*)(p.ws + WS_WGU), 16 * XROWS, 16 * 5632, D / 2}; GroupedOrder S; S.init(l == 0 ? 18 : 16, 22, 2, G, (int)blockIdx.x);
            EpiSwiGLU E{p.ws + U_HID, (const float*)(p.ws + WS_SXS), (const float*)(p.ws + WS_SW8)}; pg8::gemm_phase<EpiSwiGLU, GroupedOrder, false, 1>(lds, g, S, E, nullptr); }
            if ((NREP(11)) == 2) { pg8::Gemm g{(const bf16_t*)(p.ws + U_XSEL), (const bf16_t*)(p.ws + WS_WGU), 16 * XROWS, 16 * 5632, D / 2}; GroupedOrder S; S.init(l == 0 ? 18 : 16, 22, 2, G, (int)blockIdx.x);
            EpiSwiGLU E{p.ws + U_HID, (const float*)(p.ws + WS_SXS), (const float*)(p.ws + WS_SW8)}; pg8::gemm_phase<EpiSwiGLU, GroupedOrder, false, 1>(lds, g, S, E, nullptr); } }
        SEAM(pb + 11);
        if (EN(12) && IN(pb + 12)) { { pg8::Gemm g{(const bf16_t*)(p.ws + U_HID), (const bf16_t*)(p.ws + WS_WD), 16 * XROWS, 16 * 1024, DE / 2}; GroupedOrder S; S.init(l == 0 ? 18 : 16, 4, 4, G, (int)blockIdx.x);
            EpiGate E{(bf16_t*)(p.ws + U_YEXP), (const float*)(p.ws + WS_SELG), (const float*)(p.ws + WS_SWD)}; pg8::gemm_phase<EpiGate, GroupedOrder, false, 2>(lds, g, S, E, nullptr);
            if (l == 0 && G == 256 && blockIdx.x >= 128) convert_weights(p, 1, lds, (int)blockIdx.x - 128, 128, 0, CV_EARLY); }
            if ((NREP(12)) == 2) { pg8::Gemm g{(const bf16_t*)(p.ws + U_HID), (const bf16_t*)(p.ws + WS_WD), 16 * XROWS, 16 * 1024, DE / 2}; GroupedOrder S; S.init(l == 0 ? 18 : 16, 4, 4, G, (int)blockIdx.x);
            EpiGate E{(bf16_t*)(p.ws + U_YEXP), (const float*)(p.ws + WS_SELG), (const float*)(p.ws + WS_SWD)}; pg8::gemm_phase<EpiGate, GroupedOrder, false, 2>(lds, g, S, E, nullptr); } }
        SEAM(pb + 12);
        if (EN(13) && IN(pb + 13)) { { phase_combine(p, l); if (l == 0) convert_weights(p, 1, lds, (int)blockIdx.x, G, G == 256 ? CV_EARLY : 0, CV_TOTAL); }
            if (((l == 0 ? NREP(13) : 1)) == 2) { phase_combine(p, l); if (l == 0) convert_weights(p, 1, lds, (int)blockIdx.x, G); } }
        SEAM(pb + 13);
}
__global__ void __launch_bounds__(NTHR, 2) fwd(Params p) {
    extern __shared__ __attribute__((aligned(16))) unsigned char lds_raw[];
    LAS unsigned char* lds = (LAS unsigned char*)lds_raw;
    const int tid = threadIdx.x;
    if (tid < 4) ((LAS unsigned*)(lds + LDS_MISC))[tid] = 0u;
    __syncthreads();
    XcdBarrier bar; bar.bar = (unsigned*)(p.ws + WS_CTL); bar.x = 0; bar.st = (volatile LAS unsigned*)(lds + LDS_MISC);
    if (p.use_bar) bar = xcd_barrier_post((unsigned*)(p.ws + WS_CTL), (volatile LAS unsigned*)(lds + LDS_MISC));
    if (p.use_bar && tid == 0) { unsigned* xr = (unsigned*)(p.ws + WS_CTL + 32768); ((LAS unsigned*)(lds + LDS_MISC))[2] = xb_xcc_id(); ((LAS unsigned*)(lds + LDS_MISC))[3] = atomicAdd(xr + 64 * xb_xcc_id(), 1u); }
    __syncthreads();
    const int lo = p.ph_lo, hi = p.ph_hi;

    if (EN(100) && IN(0)) { { phase_prologue(p, lds); }
        if ((NREP(14)) == 2) { phase_prologue(p, lds); } }
    SEAM(0);
    layer_phases<0>(p, lds, bar, lo, hi);
    layer_phases<1>(p, lds, bar, lo, hi);
#undef IN
#undef SEAM
}
}

#ifndef MK_ONE_LAUNCH
#define MK_ONE_LAUNCH 1
#endif
extern "C" void kernel_launch(void* const* d_in, const int* in_sizes, int n_in, void* d_out, int out_size, void* d_ws, size_t ws_size, hipStream_t stream) {
    static int grid = 0;
    if (grid == 0) {
        if (n_in != 35 || out_size != mk::NLAT * mk::D || ws_size < mk::WS_END) { fprintf(stderr, "kernel_launch: unexpected problem (n_in %d, out %d, ws %zu < %zu)\n", n_in, out_size, ws_size, (size_t)mk::WS_END); grid = -1; return; }
        int dev = 0, cus = 0, per_cu = 0;
        if (hipGetDevice(&dev) != hipSuccess || hipDeviceGetAttribute(&cus, hipDeviceAttributeMultiprocessorCount, dev) != hipSuccess) { grid = -1; return; }
        if (hipFuncSetAttribute((const void*)mk::fwd, hipFuncAttributeMaxDynamicSharedMemorySize, mk::LDS_BYTES) != hipSuccess) { fprintf(stderr, "kernel_launch: hipFuncSetAttribute failed\n"); grid = -1; return; }
        if (hipOccupancyMaxActiveBlocksPerMultiprocessor(&per_cu, (const void*)mk::fwd, mk::NTHR, mk::LDS_BYTES) != hipSuccess || per_cu < 1) { fprintf(stderr, "kernel_launch: occupancy query says %d\n", per_cu); per_cu = 1; }
        (void)hipGetLastError();
        grid = cus;
    }
    if (grid < 0) return;
    (void)in_sizes;
    if (hipMemsetAsync(d_ws, 0, 65536, stream) != hipSuccess) return;
    mk::Params a{};
    for (int i = 0; i < 35; ++i) a.in[i] = (const float*)d_in[i];
    a.out = (float*)d_out; a.ws = (unsigned char*)d_ws;
#if MK_ONE_LAUNCH
    a.ph_lo = 0; a.ph_hi = mk::N_PHASES; a.use_bar = 1;
    hipLaunchKernelGGL(mk::fwd, dim3(grid), dim3(mk::NTHR), mk::LDS_BYTES, stream, a);
#else
    for (int ph = 0; ph < mk::N_PHASES; ++ph) { a.ph_lo = ph; a.ph_hi = ph + 1; a.use_bar = 0; hipLaunchKernelGGL(mk::fwd, dim3(grid), dim3(mk::NTHR), mk::LDS_BYTES, stream, a); }
#endif
}
```

```cpp
#include <hip/hip_runtime.h>
#include <cstdio>
#include <cstdint>
#define PRE_DUP 0
namespace pg8 {
#define PG8_LAS __attribute__((address_space(3)))
typedef unsigned short bf16_t;
typedef short bf16x8 __attribute__((ext_vector_type(8)));
typedef float f32x4 __attribute__((ext_vector_type(4)));
typedef unsigned u32x4 __attribute__((ext_vector_type(4)));
constexpr int BM = 256, BK = 64, HALF = 128, HTB = HALF * BK * 2  , STAGE_BYTES = 8 * HTB, NXCD = 8, WGM = 8;

__host__ __device__ __forceinline__ int lds_byte(int r, int c) { const int st = (r >> 4) * 2 + (c >> 5), rr = r & 15, cc = c & 31, ob = rr * 64 + cc * 2; return st * 1024 + (ob ^ (((ob >> 9) & 1) << 5)); }
__host__ __device__ __forceinline__ void stage_rc(int b, int& R, int& C) { const int st = b / 1024, sb = b % 1024, swz = sb ^ (((sb >> 9) & 1) << 5); R = (st >> 1) * 16 + swz / 64; C = (st & 1) * 32 + (swz % 64) / 2; }
__host__ __device__ __forceinline__ int perm32(int rho) { const int n = rho >> 4, i = rho & 15; return 8 * (i >> 2) + 4 * n + (i & 3); }

struct Unit { int pm, pn; };
struct Gemm { const bf16_t* A; const bf16_t* Bt; int M, N, K; };

struct StaticOrder {
    int nM, nN, nwg, G, c;
    __host__ __device__ void init(int M, int N, int G_, int c_) { nM = M / BM; nN = N / BM; nwg = nM * nN; G = G_; c = c_; }
    __host__ __device__ bool next(int i, Unit& u) const {
        const long L = (long)i * G + c; if (L >= nwg) return false;
        int wgid = (int)L; { const int q = nwg / NXCD, r = nwg % NXCD, xcd = wgid % NXCD, off = wgid / NXCD; wgid = (xcd < r ? xcd * (q + 1) : r * (q + 1) + (xcd - r) * q) + off; }
        const int nig = WGM * nN, gid = wgid / nig, fm = gid * WGM, gsz = (nM - fm) < WGM ? (nM - fm) : WGM;
        u.pm = fm + ((wgid % nig) % gsz); u.pn = (wgid % nig) / gsz; return true;
    }
    __device__ __forceinline__ void a_ready(const Unit&) const {}
    __device__ __forceinline__ void done(const Unit&) const {}
};
struct CountedOrder : StaticOrder {
    const unsigned* ready; unsigned need; unsigned* tmo;
    __device__ __forceinline__ void a_ready(const Unit& u) const {
        if (threadIdx.x < 64) {
            const unsigned long long t0 = __builtin_amdgcn_s_memrealtime(); unsigned polls = 0;
            while ((unsigned)__builtin_amdgcn_readfirstlane(__hip_atomic_load(ready + 64 * u.pm, __ATOMIC_RELAXED, __HIP_MEMORY_SCOPE_AGENT)) < need) {
                if ((++polls & 255u) == 0u && __builtin_amdgcn_readfirstlane(__hip_atomic_load(tmo, __ATOMIC_RELAXED, __HIP_MEMORY_SCOPE_AGENT)) != 0u) break;
                if (__builtin_amdgcn_s_memrealtime() - t0 > 2000000ull) {
                    if (threadIdx.x == 0) { unsigned expect = 0u; __hip_atomic_compare_exchange_strong(tmo + 1, &expect, 0x600u | (unsigned)(u.pm & 0xff), __ATOMIC_RELAXED, __ATOMIC_RELAXED, __HIP_MEMORY_SCOPE_AGENT); __hip_atomic_store(tmo, 1u, __ATOMIC_RELAXED, __HIP_MEMORY_SCOPE_AGENT); }
                    break; }
                __builtin_amdgcn_s_sleep(2); }
            __builtin_amdgcn_fence(__ATOMIC_ACQUIRE, "agent");
            asm volatile("s_waitcnt vmcnt(0)" ::: "memory");
        }
#if !defined(BROKEN_HOOK_NO_BARRIER)
        asm volatile("" ::: "memory"); __builtin_amdgcn_s_barrier(); asm volatile("" ::: "memory");
#endif
    }
};

__device__ __forceinline__ unsigned cvt_pk_bf16(float lo, float hi) { unsigned r; asm volatile("v_cvt_pk_bf16_f32 %0, %1, %2" : "=v"(r) : "v"(lo), "v"(hi)); return r; }
typedef float f32x2 __attribute__((ext_vector_type(2)));
__device__ __forceinline__ f32x2 gelu_pk(f32x2 v) {
    const f32x2 av = __builtin_elementwise_abs(v), d = av * 0.2316418882f + 1.0f;
    f32x2 t; t.x = __builtin_amdgcn_rcpf(d.x); t.y = __builtin_amdgcn_rcpf(d.y);
    f32x2 q = t * 0.5307027145f + (-0.7265760135f); q = q * t + 0.7107068705f; q = q * t + (-0.142248368f); q = q * t + 0.127414796f; q = q * t;
    const f32x2 s = (v * v) * (-0.72134752044f);
    f32x2 e; e.x = __builtin_amdgcn_exp2f(s.x); e.y = __builtin_amdgcn_exp2f(s.y);
    const f32x2 m = v * (q * e), r = v - m;
    f32x2 o; o.x = v.x < 0.f ? m.x : r.x; o.y = v.y < 0.f ? m.y : r.y; return o;
}

struct EpiF32 {
    static constexpr bool PERM = false, AFTER_DRAIN = false;
    float* C; int ldc; const float* bias;
    __device__ __forceinline__ void operator()(const f32x4 (&acc)[2][2][4][2], const Unit& u, int wr, int wc, int fr, int fq) const {
        const int row0 = u.pm * BM + wr * 64 + fr, col0 = u.pn * BM + wc * 32 + 4 * fq;
        f32x4 bv[2][2];
#pragma unroll
        for (int bj = 0; bj < 2; ++bj)
#pragma unroll
            for (int n = 0; n < 2; ++n) bv[bj][n] = bias ? *(const f32x4*)(bias + col0 + bj * HALF + n * 16) : (f32x4){0.f, 0.f, 0.f, 0.f};
#pragma unroll
        for (int ai = 0; ai < 2; ++ai)
#pragma unroll
            for (int m = 0; m < 4; ++m) { float* rowp = C + (size_t)(row0 + ai * HALF + m * 16) * ldc + col0;
#pragma unroll
                for (int bj = 0; bj < 2; ++bj)
#pragma unroll
                    for (int n = 0; n < 2; ++n) *(f32x4*)(rowp + bj * HALF + n * 16) = acc[ai][bj][m][n] + bv[bj][n]; }
    }
};
template <int ACT  > struct EpiBf16 {
    static constexpr bool PERM = true, AFTER_DRAIN = false;
    bf16_t* O; int ldc; const float* bias; int split_cols; size_t split_stride;
    __device__ __forceinline__ void operator()(const f32x4 (&acc)[2][2][4][2], const Unit& u, int wr, int wc, int fr, int fq) const {
        const int row0 = u.pm * BM + wr * 64 + fr; int colt = u.pn * BM; bf16_t* base = O;
        if (split_cols) { const int t = colt / split_cols; base += (size_t)t * split_stride; colt -= t * split_cols; }
        const int col0 = colt + wc * 32 + 8 * fq, bcol0 = u.pn * BM + wc * 32 + 8 * fq;
        f32x4 bv[2][2];
#pragma unroll
        for (int bj = 0; bj < 2; ++bj)
#pragma unroll
            for (int n = 0; n < 2; ++n) bv[bj][n] = bias ? *(const f32x4*)(bias + bcol0 + bj * HALF + 4 * n) : (f32x4){0.f, 0.f, 0.f, 0.f};
#pragma unroll
        for (int ai = 0; ai < 2; ++ai)
#pragma unroll
            for (int m = 0; m < 4; ++m) { bf16_t* rowp = base + (size_t)(row0 + ai * HALF + m * 16) * ldc + col0;
#pragma unroll
                for (int bj = 0; bj < 2; ++bj) { f32x4 v0 = acc[ai][bj][m][0] + bv[bj][0], v1 = acc[ai][bj][m][1] + bv[bj][1];
                    if (ACT == 1) { f32x2 a = gelu_pk((f32x2){v0[0], v0[1]}), b = gelu_pk((f32x2){v0[2], v0[3]}), c = gelu_pk((f32x2){v1[0], v1[1]}), d = gelu_pk((f32x2){v1[2], v1[3]});
                        v0 = (f32x4){a.x, a.y, b.x, b.y}; v1 = (f32x4){c.x, c.y, d.x, d.y}; }
                    if (ACT == 2) {
#pragma unroll
                        for (int j = 0; j < 4; ++j) { v0[j] = 0.5f * v0[j] * (1.0f + erff(v0[j] * 0.70710678f)); v1[j] = 0.5f * v1[j] * (1.0f + erff(v1[j] * 0.70710678f)); } }
                    u32x4 w; w.x = cvt_pk_bf16(v0[0], v0[1]); w.y = cvt_pk_bf16(v0[2], v0[3]); w.z = cvt_pk_bf16(v1[0], v1[1]); w.w = cvt_pk_bf16(v1[2], v1[3]);
                    *(u32x4*)(rowp + bj * HALF) = w; } }
    }
};

template <int MODE> __device__ __forceinline__ f32x4 pg8_mma(bf16x8 a, bf16x8 b, f32x4 c) {
    if constexpr (MODE == 1) { typedef int i32x4_ __attribute__((ext_vector_type(4))); return __builtin_bit_cast(f32x4, __builtin_amdgcn_mfma_i32_16x16x64_i8(__builtin_bit_cast(i32x4_, a), __builtin_bit_cast(i32x4_, b), __builtin_bit_cast(i32x4_, c), 0, 0, 0)); }
    else return __builtin_amdgcn_mfma_f32_16x16x32_bf16(a, b, c, 0, 0, 0); }
__device__ __forceinline__ f32x4 pg8_mma8(bf16x8 a0, bf16x8 a1, bf16x8 b0, bf16x8 b1, f32x4 c) {
    typedef int i32x4_ __attribute__((ext_vector_type(4))); typedef int i32x8_ __attribute__((ext_vector_type(8)));
    const i32x8_ A = __builtin_shufflevector(__builtin_bit_cast(i32x4_, a0), __builtin_bit_cast(i32x4_, a1), 0, 1, 2, 3, 4, 5, 6, 7), B = __builtin_shufflevector(__builtin_bit_cast(i32x4_, b0), __builtin_bit_cast(i32x4_, b1), 0, 1, 2, 3, 4, 5, 6, 7);
    const int one = 0x7f7f7f7f;
    asm volatile("v_mfma_scale_f32_16x16x128_f8f6f4 %0, %1, %2, %0, %3, %3 op_sel_hi:[0,0,0]" : "+v"(c) : "v"(A), "v"(B), "v"(one));
    return c; }
__device__ __forceinline__ void fp8_acc_settle() { asm volatile("s_nop 7\n\ts_nop 7\n\ts_nop 7" ::: "memory"); }
template <class Epi, class Sched, bool STAMP = false, int MODE = 0>
__device__ __forceinline__ void gemm_phase(PG8_LAS unsigned char* lds, const Gemm g, const Sched& S, const Epi& E, unsigned long long* stamps) {
    const int tid = threadIdx.x, wid = __builtin_amdgcn_readfirstlane(tid >> 6), lane = tid & 63, wr = wid >> 2, wc = wid & 3, fr = lane & 15, fq = lane >> 4;
    const int K = g.K, nt = K / BK;
    int ts_lo = 0, ts_hi = 0, nts = 0; const unsigned long long rt_entry = STAMP ? (unsigned long long)wall_clock64() : 0ull;
#define PG8_STAMP() do { if (STAMP && wid == 0 && nts < 64) { const unsigned long long _c = (unsigned long long)clock64(); \
        ts_lo = (lane == nts) ? (int)(unsigned)_c : ts_lo; ts_hi = (lane == nts) ? (int)(unsigned)(_c >> 32) : ts_hi; ++nts; } } while (0)
    PG8_STAMP();
    unsigned voffA[2], voffB[2];
#pragma unroll
    for (int i = 0; i < 2; ++i) { int R, C; stage_rc(tid * 16 + i * 8192, R, C); const int Rb = Epi::PERM ? ((R & ~31) + perm32(R & 31)) : R;
        voffA[i] = (unsigned)(R * K + C) * 2u; voffB[i] = (unsigned)(Rb * K + C) * 2u; }
    const size_t kstep = (size_t)(BK * 2);
    const size_t hstep = (size_t)HALF * K * 2;
    const size_t tstep = 2 * hstep;
    const unsigned ldsw = (unsigned)wid * 1024u;
    const int aoff = lds_byte(wr * 64 + fr, fq * 8), boff = lds_byte(wc * 32 + fr, fq * 8);
#define PG8_SA(b, h) (((b) * 2 + (h)) * HTB)
#define PG8_SB(b, h) ((4 + (b) * 2 + (h)) * HTB)
#define PG8_STAGE(bufoff, gbase, voff) do { _Pragma("unroll") for (int _i = 0; _i < 2; ++_i) \
        __builtin_amdgcn_global_load_lds((const unsigned*)((const char*)(gbase) + (voff)[_i]), (PG8_LAS unsigned*)(lds + (bufoff) + ldsw + _i * 8192), 16, 0, 0); } while (0)
#define PG8_LDA(dst, b, h) do { _Pragma("unroll") for (int m = 0; m < 4; ++m) _Pragma("unroll") for (int k = 0; k < 2; ++k) dst[m][k] = *(const PG8_LAS bf16x8*)(lds + PG8_SA(b, h) + aoff + m * 2048 + k * 1024); } while (0)
#define PG8_LDB(dst, b, h) do { _Pragma("unroll") for (int n = 0; n < 2; ++n) _Pragma("unroll") for (int k = 0; k < 2; ++k) dst[n][k] = *(const PG8_LAS bf16x8*)(lds + PG8_SB(b, h) + boff + n * 2048 + k * 1024); } while (0)
#define PG8_MMA(ai, bj, At, Bt) do { __builtin_amdgcn_s_setprio(1); _Pragma("unroll") for (int m = 0; m < 4; ++m) _Pragma("unroll") for (int n = 0; n < 2; ++n) { if constexpr (MODE == 2) acc[ai][bj][m][n] = pg8_mma8(Bt[n][0], Bt[n][1], At[m][0], At[m][1], acc[ai][bj][m][n]); else { _Pragma("unroll") for (int k = 0; k < 2; ++k) \
        acc[ai][bj][m][n] = pg8_mma<MODE>(Bt[n][k], At[m][k], acc[ai][bj][m][n]); } } __builtin_amdgcn_s_setprio(0); } while (0)
#define PG8_WAIT_V(n) asm volatile("s_waitcnt vmcnt(" #n ")" ::: "memory")
#define PG8_WAIT_L(n) asm volatile("s_waitcnt lgkmcnt(" #n ")" ::: "memory")
#define PG8_BAR __builtin_amdgcn_s_barrier()
#define PG8_SCHED __builtin_amdgcn_sched_barrier(0)
    Unit cur, nxt; int ui = 0;
    if (!S.next(0, cur)) return;
    f32x4 acc[2][2][4][2];
#pragma unroll
    for (int a = 0; a < 2; ++a)
#pragma unroll
        for (int b = 0; b < 2; ++b)
#pragma unroll
            for (int m = 0; m < 4; ++m)
#pragma unroll
                for (int n = 0; n < 2; ++n) acc[a][b][m][n] = (f32x4){0.f, 0.f, 0.f, 0.f};
    bf16x8 At[4][2], B0[2][2], B1[2][2];
    const char* cA = (const char*)g.A + (size_t)cur.pm * tstep; const char* cB = (const char*)g.Bt + (size_t)cur.pn * tstep;
    S.a_ready(cur);
    PG8_STAGE(PG8_SB(0, 0), cB, voffB); PG8_STAGE(PG8_SA(0, 0), cA, voffA); PG8_STAGE(PG8_SB(0, 1), cB + hstep, voffB); PG8_STAGE(PG8_SA(0, 1), cA + hstep, voffA);
    if (wr == 1) PG8_BAR;
    PG8_WAIT_V(4); PG8_BAR;
    PG8_STAGE(PG8_SB(1, 0), cB + kstep, voffB); PG8_STAGE(PG8_SA(1, 0), cA + kstep, voffA); PG8_STAGE(PG8_SB(1, 1), cB + hstep + kstep, voffB);
    PG8_WAIT_V(6); PG8_BAR;
    PG8_STAMP();
    for (;;) {
        const bool has_next = S.next(ui + 1, nxt);
        const char* nA = has_next ? (const char*)g.A + (size_t)nxt.pm * tstep : cA; const char* nB = has_next ? (const char*)g.Bt + (size_t)nxt.pn * tstep : cB;
        for (int t = 0; t < nt; t += 2) {
            const bool last = (t == nt - 2);
            const char* a1 = cA + (size_t)(t + 1) * kstep;
            const char* a2 = last ? nA : cA + (size_t)(t + 2) * kstep; const char* b2 = last ? nB : cB + (size_t)(t + 2) * kstep;
            const char* a3 = a2 + kstep; const char* b3 = b2 + kstep;
            if (last && has_next) S.a_ready(nxt);
            PG8_LDB(B0, 0, 0); PG8_SCHED; PG8_LDA(At, 0, 0); PG8_STAGE(PG8_SA(1, 1), a1 + hstep, voffA);
            PG8_WAIT_L(8); PG8_BAR; PG8_WAIT_L(0); PG8_MMA(0, 0, At, B0); PG8_BAR; PG8_SCHED;
            PG8_LDB(B1, 0, 1); PG8_STAGE(PG8_SB(0, 0), b2, voffB);
            PG8_BAR; PG8_WAIT_L(0); PG8_MMA(0, 1, At, B1); PG8_BAR;
            PG8_LDA(At, 0, 1); PG8_STAGE(PG8_SA(0, 0), a2, voffA);
            PG8_BAR; PG8_WAIT_L(0); PG8_MMA(1, 0, At, B0); PG8_BAR; PG8_SCHED;
            PG8_STAGE(PG8_SB(0, 1), b2 + hstep, voffB);
            PG8_WAIT_V(6); PG8_BAR; PG8_MMA(1, 1, At, B1); PG8_BAR;
            PG8_LDB(B0, 1, 0); PG8_SCHED; PG8_LDA(At, 1, 0); PG8_STAGE(PG8_SA(0, 1), a2 + hstep, voffA);
            PG8_WAIT_L(8); PG8_BAR; PG8_WAIT_L(0); PG8_MMA(0, 0, At, B0); PG8_BAR; PG8_SCHED;
            PG8_LDB(B1, 1, 1); PG8_STAGE(PG8_SB(1, 0), b3, voffB);
            PG8_BAR; PG8_WAIT_L(0); PG8_MMA(0, 1, At, B1); PG8_BAR;
            PG8_LDA(At, 1, 1); PG8_STAGE(PG8_SA(1, 0), a3, voffA);
            PG8_BAR; PG8_WAIT_L(0); PG8_MMA(1, 0, At, B0); PG8_BAR; PG8_SCHED;
            PG8_STAGE(PG8_SB(1, 1), b3 + hstep, voffB);
            PG8_WAIT_V(6); PG8_BAR; PG8_MMA(1, 1, At, B1); PG8_BAR;
        }
        PG8_STAMP();
        if constexpr (!Epi::AFTER_DRAIN) { E(acc, cur, wr, wc, fr, fq); S.done(cur); }
        PG8_STAMP();
        if (!has_next) break;
#pragma unroll
        for (int a = 0; a < 2; ++a)
#pragma unroll
            for (int b = 0; b < 2; ++b)
#pragma unroll
                for (int m = 0; m < 4; ++m)
#pragma unroll
                    for (int n = 0; n < 2; ++n) acc[a][b][m][n] = (f32x4){0.f, 0.f, 0.f, 0.f};
        cur = nxt; cA = nA; cB = nB; ++ui;
    }
    PG8_WAIT_V(0);
    if (wr == 0) PG8_BAR;
    PG8_BAR;
    if constexpr (Epi::AFTER_DRAIN) { E.fused(acc, cur, wr, wc, fr, fq, lds, wid, lane); S.done(cur); }
    PG8_STAMP();
    if (STAMP && wid == 0) { stamps[lane] = lane < nts ? (((unsigned long long)(unsigned)ts_hi << 32) | (unsigned)ts_lo) : 0ull;
        if (lane == 62) stamps[62] = rt_entry; if (lane == 63) stamps[63] = (unsigned long long)wall_clock64(); }
#undef PG8_STAMP
#undef PG8_SA
#undef PG8_SB
#undef PG8_STAGE
#undef PG8_LDA
#undef PG8_LDB
#undef PG8_MMA
#undef PG8_WAIT_V
#undef PG8_WAIT_L
#undef PG8_BAR
#undef PG8_SCHED
}
}
#define XB_TMO      128
#define XB_XCNT(j)  (256  + 64 * (j))
#define XB_XSUB(j)  (1280 + 64 * (j))
#define XB_XGEN(j)  (2304 + 64 * (j))
#define XB_TOP      3328
#define XB_TOPGEN   3392
#define XCD_BAR_WORDS 3456
#define XB_SPIN_CAP (1u << 18)
#define LAS __attribute__((address_space(3)))

__device__ __forceinline__ unsigned xb_ld(unsigned* p)              { return __hip_atomic_load(p, __ATOMIC_RELAXED, __HIP_MEMORY_SCOPE_AGENT); }
__device__ __forceinline__ unsigned xb_add(unsigned* p, unsigned v) { return __hip_atomic_fetch_add(p, v, __ATOMIC_RELAXED, __HIP_MEMORY_SCOPE_AGENT); }
__device__ __forceinline__ unsigned xb_xcc_id() { return (unsigned)__builtin_amdgcn_s_getreg((3 << 11) | 20) & 0xFu; }
#define XB_SPIN(cond, bar) do { unsigned _sp = 0; while (cond) { __builtin_amdgcn_s_sleep(1); \
    if ((++_sp & 255u) == 0u) { if (xb_ld(&(bar)[XB_TMO])) break; if (_sp > XB_SPIN_CAP) { atomicAdd(&(bar)[XB_TMO], 1u); break; } } } } while (0)

struct XcdBarrier {
    unsigned* bar; unsigned x;
    volatile LAS unsigned* st;
};

__device__ __forceinline__ XcdBarrier xcd_barrier_post(unsigned* bar, volatile LAS unsigned* st) {
    XcdBarrier b; b.bar = bar; b.x = xb_xcc_id(); b.st = st;
    if (threadIdx.x == 0) (void)xb_add(&bar[XB_XCNT(b.x)], 1u);
    return b;
}
__device__ __forceinline__ void xcd_barrier_complete(unsigned* bar, unsigned x, unsigned& nloc, unsigned& nx) {
    const unsigned G = gridDim.x * gridDim.y * gridDim.z;
    unsigned sum, cnt, mine, sp = 0u;
    for (;;) {
        sum = 0u; cnt = 0u; mine = 0u;
#pragma unroll
        for (unsigned j = 0; j < 16; ++j) { const unsigned c = xb_ld(&bar[XB_XCNT(j)]); sum += c; cnt += (c > 0u) ? 1u : 0u; mine = (j == x) ? c : mine; }
        if (sum == G) break;
        __builtin_amdgcn_s_sleep(1);
        if ((++sp & 255u) == 0u) { if (xb_ld(&bar[XB_TMO])) break; if (sp > XB_SPIN_CAP) { atomicAdd(&bar[XB_TMO], 1u); break; } }
    }
    nloc = mine > 0u ? mine : 1u; nx = cnt > 0u ? cnt : 1u;
}

__device__ __forceinline__ void xcd_barrier(const XcdBarrier& b) {
    asm volatile("s_waitcnt vmcnt(0)" ::: "memory");
    __syncthreads();
    if (threadIdx.x == 0) {
        unsigned* bar = b.bar;
        __builtin_amdgcn_s_waitcnt(0);
        unsigned nloc = b.st[0], nx = b.st[1];
        if (nloc == 0u) { xcd_barrier_complete(bar, b.x, nloc, nx); b.st[0] = nloc; b.st[1] = nx; }
        const unsigned old = xb_add(&bar[XB_XSUB(b.x)], 1u);
        const unsigned gen = old / nloc;
        if (old + 1u == (gen + 1u) * nloc) {
            __builtin_amdgcn_fence(__ATOMIC_RELEASE, "agent");
            asm volatile("s_waitcnt vmcnt(0)" ::: "memory");
            const unsigned og = xb_add(&bar[XB_TOP], 1u);
            const unsigned tg = og / nx;
            if (og + 1u == (tg + 1u) * nx) xb_add(&bar[XB_TOPGEN], 1u);
            else XB_SPIN(xb_ld(&bar[XB_TOPGEN]) == tg, bar);
            __builtin_amdgcn_fence(__ATOMIC_ACQUIRE, "agent");
            xb_add(&bar[XB_XGEN(b.x)], 1u);
            asm volatile("s_waitcnt vmcnt(0)" ::: "memory");
        } else {
            XB_SPIN(xb_ld(&bar[XB_XGEN(b.x)]) == gen, bar);
            __builtin_amdgcn_fence(__ATOMIC_ACQUIRE, "agent");
            asm volatile("s_waitcnt vmcnt(0)" ::: "memory");
        }
    }
    __syncthreads();
}

namespace mk {
using pg8::bf16_t; using pg8::bf16x8; using pg8::f32x4; using pg8::u32x4;
typedef unsigned u32x2 __attribute__((ext_vector_type(2)));
typedef short bf16x4 __attribute__((ext_vector_type(4)));
typedef float lf2 __attribute__((ext_vector_type(2)));
typedef float lf4 __attribute__((ext_vector_type(4)));
typedef unsigned lu4 __attribute__((ext_vector_type(4)));

constexpr int D = 1024, NBATCH = 16, SEQ = 2048, CTXL = 256;
constexpr int NLAT = NBATCH * SEQ, NCTX = NBATCH * CTXL, NROW = NLAT + NCTX;
constexpr int NINP = 3072, NIN = 2944;
constexpr int C_Q = 256, C_K = 640, C_V = 1024, C_Z = 1408;
constexpr int DE = 2816;
constexpr int XROWS = 4608;
constexpr int NTHR = 512;
constexpr int LDS_MISC = 131072, LDS_BYTES = 131072 + 256;

constexpr size_t al256(size_t x) { return (x + 255) & ~(size_t)255; }
constexpr size_t WS_CTL = 0;
constexpr size_t WS_MOD = 65536;
constexpr size_t WS_SW = al256(WS_MOD + (size_t)2 * 17 * 6144 * 4);
constexpr size_t SW_W2T = 0, SW_A2T = 98304, SW_G2T = 196608, SW_GLUT = 294912, SW_S5E = 425984, SW_S5W2 = 2523136, SW_STRIDE = 6717440;
constexpr size_t WS_WIN = al256(WS_SW + 2 * SW_STRIDE);
constexpr size_t WS_WOUT = WS_WIN + (size_t)3072 * 1024 * 2;
constexpr size_t WS_WGU = WS_WOUT + (size_t)1024 * 1024 * 2;
constexpr size_t WS_WD = WS_WGU + (size_t)16 * 5632 * 1024 * 2;
constexpr size_t WS_XB = WS_WD + (size_t)16 * 1024 * 2816 * 2;
constexpr size_t WS_CTXA = WS_XB + (size_t)NLAT * D * 4;
constexpr size_t WS_CTXB = WS_CTXA + (size_t)NCTX * D * 4;
constexpr size_t WS_ABUF = WS_CTXB + (size_t)NCTX * D * 4;
constexpr size_t WS_AFF = WS_ABUF + (size_t)NROW * D * 2;
constexpr size_t WS_SLOT = WS_AFF + (size_t)NROW * 16 * 4;
constexpr size_t WS_SELG = WS_SLOT + (size_t)NROW * 16 * 4;
constexpr size_t WS_SW8 = al256(WS_SELG + (size_t)16 * XROWS * 4);
constexpr size_t WS_SX = WS_SW8 + (size_t)16 * 5632 * 4;
constexpr size_t WS_SXS = WS_SX + (size_t)NROW * 4;
constexpr size_t WS_SWIN = WS_SXS + (size_t)16 * XROWS * 4;
constexpr size_t WS_SH = WS_SWIN + (size_t)3072 * 4;
constexpr size_t WS_SWD = WS_SH + (size_t)NROW * 4;
constexpr size_t WS_U = al256(WS_SWD + (size_t)16 * 1024 * 4);
constexpr size_t SZ384 = (size_t)NROW * 384 * 2;
constexpr size_t U_P = WS_U;
constexpr size_t U_QR = U_P + (size_t)NROW * NINP * 2;
constexpr size_t U_KR = U_QR + SZ384;
constexpr size_t U_VT = U_KR + SZ384;
constexpr size_t U_VTC = U_VT + (size_t)16 * 384 * 2048 * 2;
constexpr size_t U_RS = U_VT + SZ384;
constexpr size_t U_KS = U_RS + SZ384;
constexpr size_t U_VS = U_KS + SZ384;
constexpr size_t U_KK = U_VS + SZ384;
constexpr size_t U_ALR = U_KK + SZ384;
constexpr size_t U_LD = U_ALR + SZ384;
constexpr size_t U_AG = U_LD + 2 * SZ384;
constexpr size_t U_G = U_AG + 2 * SZ384;
constexpr size_t U_YRK = U_G + SZ384;
constexpr size_t U_SLOC = U_YRK + 2 * (size_t)NROW * 384 * 4;
constexpr size_t U_SPREV = U_SLOC + (size_t)2304 * 16 * 256 * 4;
constexpr size_t U_YG = U_SPREV + (size_t)2304 * 16 * 256 * 2;
constexpr size_t U_U16 = U_YG + (size_t)NROW * 256 * 2;
constexpr size_t U_MIX_END = U_U16 + (size_t)NROW * 256 * 2;
constexpr int NCHUNK = 192 * 144;
constexpr size_t CH_XP = U_P;
constexpr size_t CH_BK = CH_XP + (size_t)NCHUNK * 4096;
constexpr size_t CH_UL = CH_BK + (size_t)NCHUNK * 4096;
constexpr size_t CH_MM = U_SLOC;
constexpr size_t CH_GT = CH_MM + (size_t)NCHUNK * 1024;
static_assert(CH_UL + (size_t)NCHUNK * 2048 <= U_RS, "chunk buffers overlap live RWKV operands");
static_assert(CH_GT + (size_t)NCHUNK * 256 <= U_SPREV, "chunk buffers overlap S5 states");
constexpr size_t U_Y = WS_U;
constexpr size_t U_XSEL = U_Y + (size_t)NROW * D * 4;
constexpr size_t U_HID = U_XSEL + (size_t)16 * XROWS * 1024 * 2;
constexpr size_t U_YEXP = U_HID + (size_t)16 * XROWS * DE * 2;
constexpr size_t U_FFN_END = U_YEXP + (size_t)16 * XROWS * 1024 * 2;
constexpr size_t WS_END = U_MIX_END > U_FFN_END ? U_MIX_END : U_FFN_END;

struct Params { const float* in[35]; float* out; unsigned char* ws; int ph_lo, ph_hi, use_bar, pad; };

typedef __bf16 hwbf2 __attribute__((ext_vector_type(2)));
__device__ __forceinline__ unsigned pack2(float lo, float hi) { const lf2 v = {lo, hi}; return __builtin_bit_cast(unsigned, __builtin_convertvector(v, hwbf2)); }
__device__ __forceinline__ bf16_t f2bf(float f) { return (bf16_t)(pack2(f, 0.f) & 0xffffu); }
__device__ __forceinline__ float bflo(unsigned w) { return __uint_as_float(w << 16); }
__device__ __forceinline__ float bfhi(unsigned w) { return __uint_as_float(w & 0xffff0000u); }
__device__ __forceinline__ float bf2f(bf16_t b) { return __uint_as_float(((unsigned)b) << 16); }
__device__ __forceinline__ float sigm(float x) { return 1.0f / (1.0f + __expf(-x)); }
__device__ __forceinline__ float wave_sum(float v) {
#pragma unroll
    for (int o = 32; o >= 1; o >>= 1) v += __shfl_xor(v, o);
    return v; }
__device__ __forceinline__ void unpack8(const uint4 w, float (&f)[8]) { f[0] = bflo(w.x); f[1] = bfhi(w.x); f[2] = bflo(w.y); f[3] = bfhi(w.y); f[4] = bflo(w.z); f[5] = bfhi(w.z); f[6] = bflo(w.w); f[7] = bfhi(w.w); }
__device__ __forceinline__ uint4 pack8(const float (&f)[8]) { uint4 w; w.x = pack2(f[0], f[1]); w.y = pack2(f[2], f[3]); w.z = pack2(f[4], f[5]); w.w = pack2(f[6], f[7]); return w; }
__device__ __forceinline__ const float* xrow(const float* lat, const float* ctx, int r) { return r < NLAT ? lat + (size_t)r * D : ctx + (size_t)(r - NLAT) * D; }
__device__ __forceinline__ float* xrow_w(float* lat, float* ctx, int r) { return r < NLAT ? lat + (size_t)r * D : ctx + (size_t)(r - NLAT) * D; }
__device__ __forceinline__ f32x4 mfma16(bf16x8 a, bf16x8 b, f32x4 c) { return __builtin_amdgcn_mfma_f32_16x16x32_bf16(a, b, c, 0, 0, 0); }

__device__ __forceinline__ void tr_tile(const float* __restrict__ src, int ldsrc, int k0, int n0, bf16_t* __restrict__ dst, int lddst, int drow0, LAS unsigned* T) {
    const int tid = threadIdx.x, n4 = tid & 15, kq = tid >> 4;
    const float4 a = *(const float4*)(src + (size_t)(k0 + 2 * kq) * ldsrc + n0 + 4 * n4);
    const float4 b = *(const float4*)(src + (size_t)(k0 + 2 * kq + 1) * ldsrc + n0 + 4 * n4);
    T[(4 * n4 + 0) * 33 + kq] = pack2(a.x, b.x); T[(4 * n4 + 1) * 33 + kq] = pack2(a.y, b.y);
    T[(4 * n4 + 2) * 33 + kq] = pack2(a.z, b.z); T[(4 * n4 + 3) * 33 + kq] = pack2(a.w, b.w);
    __syncthreads();
    const int n = tid >> 3, pc = tid & 7;
    uint4 v; v.x = T[n * 33 + 4 * pc]; v.y = T[n * 33 + 4 * pc + 1]; v.z = T[n * 33 + 4 * pc + 2]; v.w = T[n * 33 + 4 * pc + 3];
    *(uint4*)(dst + (size_t)(drow0 + n) * lddst + k0 + 8 * pc) = v;
    __syncthreads();
}

__device__ __forceinline__ void tr_tile4(const float* __restrict__ src, int ldsrc, int k0, int n0, bf16_t* __restrict__ dst, int lddst, int drow0, LAS unsigned* T) {
    int tid = threadIdx.x; asm volatile("" : "+v"(tid)); const int n4 = tid & 15, kq = tid >> 4;
    float4 a[4], b[4];
#pragma unroll
    for (int t = 0; t < 4; ++t) { a[t] = *(const float4*)(src + (size_t)(k0 + 2 * kq) * ldsrc + n0 + 64 * t + 4 * n4); b[t] = *(const float4*)(src + (size_t)(k0 + 2 * kq + 1) * ldsrc + n0 + 64 * t + 4 * n4); }
#pragma unroll
    for (int t = 0; t < 4; ++t) { LAS unsigned* Tt = T + t * 64 * 33;
        Tt[(4 * n4 + 0) * 33 + kq] = pack2(a[t].x, b[t].x); Tt[(4 * n4 + 1) * 33 + kq] = pack2(a[t].y, b[t].y); Tt[(4 * n4 + 2) * 33 + kq] = pack2(a[t].z, b[t].z); Tt[(4 * n4 + 3) * 33 + kq] = pack2(a[t].w, b[t].w); }
    __syncthreads();
#pragma unroll
    for (int i = 0; i < 4; ++i) { const int idx = tid + NTHR * i, n = idx >> 3, pc = idx & 7;
        uint4 v; v.x = T[n * 33 + 4 * pc]; v.y = T[n * 33 + 4 * pc + 1]; v.z = T[n * 33 + 4 * pc + 2]; v.w = T[n * 33 + 4 * pc + 3];
        *(uint4*)(dst + (size_t)(drow0 + n) * lddst + k0 + 8 * pc) = v; }
    __syncthreads();
}
template <int NK, int DP, bool FP8> __device__ __forceinline__ void q8_strip(const float* __restrict__ src, int ldsrc, unsigned char* __restrict__ dst, float* __restrict__ scl, LAS unsigned char* lds) {
    LAS float* cmax = (LAS float*)lds;
    LAS unsigned char* T = lds + 8704;
    const int tid = threadIdx.x, n4 = tid & 15, kq = tid >> 4; constexpr float QMAX = FP8 ? 256.0f : 127.0f;
    float mx[4] = {0.f, 0.f, 0.f, 0.f};
#pragma unroll 8
    for (int i = 0; i < 2 * NK; ++i) { const float4 v = *(const float4*)(src + (size_t)(kq + 32 * i) * ldsrc + 4 * n4); mx[0] = fmaxf(mx[0], fabsf(v.x)); mx[1] = fmaxf(mx[1], fabsf(v.y)); mx[2] = fmaxf(mx[2], fabsf(v.z)); mx[3] = fmaxf(mx[3], fabsf(v.w)); }
    __syncthreads();
#pragma unroll
    for (int j = 0; j < 4; ++j) cmax[kq * 64 + 4 * n4 + j] = mx[j];
    __syncthreads();
    if (tid < 64) { float m = 0.f; for (int g = 0; g < 32; ++g) m = fmaxf(m, cmax[g * 64 + tid]); m = fmaxf(m, 1e-20f); scl[tid] = m * (1.0f / QMAX); cmax[32 * 64 + tid] = QMAX / m; }
    __syncthreads();
    float inv[4];
#pragma unroll
    for (int j = 0; j < 4; ++j) inv[j] = cmax[32 * 64 + 4 * n4 + j];
    for (int kg = 0; kg < NK / 4; ++kg) {
        float4 a[4], b[4];
#pragma unroll
        for (int t = 0; t < 4; ++t) { const int kb = (kg * 4 + t) * 64 + 2 * kq; a[t] = *(const float4*)(src + (size_t)kb * ldsrc + 4 * n4); b[t] = *(const float4*)(src + (size_t)(kb + 1) * ldsrc + 4 * n4); }
#pragma unroll
        for (int t = 0; t < 4; ++t) { const float av[4] = {a[t].x, a[t].y, a[t].z, a[t].w}, bv[4] = {b[t].x, b[t].y, b[t].z, b[t].w};
#pragma unroll
            for (int j = 0; j < 4; ++j) { unsigned short w;
                if (FP8) w = (unsigned short)(__builtin_amdgcn_cvt_pk_fp8_f32(av[j] * inv[j], bv[j] * inv[j], 0, false) & 0xffff);
                else { const int q0 = __float2int_rn(av[j] * inv[j]), q1 = __float2int_rn(bv[j] * inv[j]); w = (unsigned short)((q0 & 255) | ((q1 & 255) << 8)); }
                *(LAS unsigned short*)(T + (4 * n4 + j) * 272 + t * 64 + 2 * kq) = w; } }
        __syncthreads();
#pragma unroll
        for (int i = 0; i < 2; ++i) { const int idx = tid + NTHR * i, n = idx >> 4, pc = idx & 15; *(lu4*)(dst + (size_t)n * DP + kg * 256 + 16 * pc) = *(const LAS lu4*)(T + n * 272 + 16 * pc); }
        __syncthreads();
    }
}
__device__ __forceinline__ void q8r_strip(const float* __restrict__ src, int ldsrc, unsigned char* __restrict__ dst, float* __restrict__ scl, LAS unsigned char* lds) {
    LAS float* cmax = (LAS float*)lds;
    int tid = threadIdx.x; asm volatile("" : "+v"(tid)); const int n4 = tid & 15, rg = tid >> 4;
    const float* s0 = src + (size_t)(rg * 32) * ldsrc + 4 * n4;
    lf4 v[32];
#pragma unroll
    for (int i = 0; i < 32; ++i) v[i] = *(const lf4*)(s0 + (size_t)i * ldsrc);
    __builtin_amdgcn_sched_barrier(0);
    float mx[4] = {0.f, 0.f, 0.f, 0.f};
#pragma unroll
    for (int i = 0; i < 32; ++i) {
#pragma unroll
        for (int j = 0; j < 4; ++j) mx[j] = fmaxf(mx[j], fabsf(v[i][j])); }
    __syncthreads();
#pragma unroll
    for (int j = 0; j < 4; ++j) cmax[rg * 64 + 4 * n4 + j] = mx[j];
    __syncthreads();
    if (tid < 64) { float m = 0.f; for (int g = 0; g < 32; ++g) m = fmaxf(m, cmax[g * 64 + tid]); m = fmaxf(m, 1e-20f); scl[tid] = m * (1.0f / 127.0f); cmax[32 * 64 + tid] = 127.0f / m; }
    __syncthreads();
#pragma unroll
    for (int j = 0; j < 4; ++j) { const float inv = cmax[32 * 64 + 4 * n4 + j]; unsigned w[8];
#pragma unroll
        for (int g = 0; g < 8; ++g) { const int q0 = __float2int_rn(v[4 * g][j] * inv), q1 = __float2int_rn(v[4 * g + 1][j] * inv), q2 = __float2int_rn(v[4 * g + 2][j] * inv), q3 = __float2int_rn(v[4 * g + 3][j] * inv);
            w[g] = (unsigned)(q0 & 255) | ((unsigned)(q1 & 255) << 8) | ((unsigned)(q2 & 255) << 16) | ((unsigned)q3 << 24); }
        unsigned char* d = dst + (size_t)(4 * n4 + j) * 1024 + rg * 32;
        *(lu4*)d = (lu4){w[0], w[1], w[2], w[3]}; *(lu4*)(d + 16) = (lu4){w[4], w[5], w[6], w[7]}; }
}
__device__ __forceinline__ void q8d_strip(const float* __restrict__ src, unsigned char* __restrict__ dst, float* __restrict__ scl, LAS unsigned char* lds) {
    LAS float* cmax = (LAS float*)lds;
    int tid = threadIdx.x; asm volatile("" : "+v"(tid)); const int n8 = tid & 7, rg = tid >> 3; const bool v2 = rg < 48;
    unsigned pk[3][16][2]; float mx[4] = {0.f, 0.f, 0.f, 0.f}; lf4 bufA[8], bufB[8];
    auto ld = [&](lf4 (&b)[8], int hr) { const int r = hr >> 1, c = (r == 2 && !v2) ? rg + 64 : rg + 64 * r; const float* sp = src + (size_t)(c * 16 + (hr & 1) * 8) * 1024 + 4 * n8;
#pragma unroll
        for (int i = 0; i < 8; ++i) b[i] = *(const lf4*)(sp + (size_t)i * 1024); };
    auto use = [&](const lf4 (&b)[8], int hr) {
#pragma unroll
        for (int i = 0; i < 8; ++i) {
#pragma unroll
            for (int j = 0; j < 4; ++j) mx[j] = fmaxf(mx[j], fabsf(b[i][j]));
            pk[hr >> 1][(hr & 1) * 8 + i][0] = pack2(b[i][0], b[i][1]); pk[hr >> 1][(hr & 1) * 8 + i][1] = pack2(b[i][2], b[i][3]); } };
    ld(bufA, 0);
#pragma unroll
    for (int h2 = 0; h2 < 3; ++h2) {
        ld(bufB, 2 * h2 + 1); __builtin_amdgcn_sched_barrier(0); use(bufA, 2 * h2);
        if (h2 < 2) ld(bufA, 2 * h2 + 2);
        __builtin_amdgcn_sched_barrier(0); use(bufB, 2 * h2 + 1); }
    __syncthreads();
#pragma unroll
    for (int j = 0; j < 4; ++j) cmax[rg * 32 + 4 * n8 + j] = mx[j];
    __syncthreads();
    if (tid < 32) { float m = 0.f; for (int g = 0; g < 64; ++g) m = fmaxf(m, cmax[g * 32 + tid]); m = fmaxf(m, 1e-20f); scl[tid] = m * (1.0f / 256.0f); cmax[64 * 32 + tid] = 256.0f / m; }
    __syncthreads();
    float inv[4];
#pragma unroll
    for (int j = 0; j < 4; ++j) inv[j] = cmax[64 * 32 + 4 * n8 + j];
#pragma unroll
    for (int r = 0; r < 3; ++r) { if (r == 2 && !v2) continue;
        const int c = rg + 64 * r;
#pragma unroll
        for (int j = 0; j < 4; ++j) { unsigned w[4];
#pragma unroll
            for (int g = 0; g < 4; ++g) { float f[4];
#pragma unroll
                for (int x = 0; x < 4; ++x) { const unsigned u = pk[r][4 * g + x][j >> 1]; f[x] = ((j & 1) ? bfhi(u) : bflo(u)) * inv[j]; }
                unsigned t = (unsigned)__builtin_amdgcn_cvt_pk_fp8_f32(f[0], f[1], 0, false); t = (unsigned)__builtin_amdgcn_cvt_pk_fp8_f32(f[2], f[3], (int)t, true); w[g] = t; }
            *(lu4*)(dst + (size_t)(4 * n8 + j) * DE + c * 16) = (lu4){w[0], w[1], w[2], w[3]}; } }
}
__device__ __forceinline__ void gu_strip(const Params& p, int l, int item, LAS unsigned char* lds) {
    const int e = item / 88, rem = item % 88, up = rem / 44, nt = rem % 44, n0 = nt * 64, drow0 = (n0 >> 7) * 256 + (n0 & 127) + (up ? 128 : 0);
    q8r_strip(p.in[up ? 33 : 32] + (size_t)(l * 16 + e) * 1024 * DE + n0, DE, p.ws + WS_WGU + ((size_t)e * 5632 + drow0) * 1024, (float*)(p.ws + WS_SW8) + (size_t)e * 5632 + drow0, lds);
}
constexpr int CV_EARLY = 1024;
constexpr int CV_GU = 16 * 88, CV_D4 = 16 * 32, CV_WIN = 46, CV_PAD = 16, CV_WOUT4 = 16 * 4, CV_TOTAL = CV_GU + CV_D4 + CV_WIN + CV_PAD + CV_WOUT4;
__device__ __forceinline__ void convert_weights(const Params& p, int l, LAS unsigned char* lds, int vb, int nvb, int lo = 0, int hi = CV_TOTAL) {
    LAS unsigned* T = (LAS unsigned*)lds; bf16_t* WOUT = (bf16_t*)(p.ws + WS_WOUT);
    for (int it = lo + vb; it < hi; it += nvb) {
        int j = it;
        if (j < CV_GU) { gu_strip(p, l, j, lds); continue; }
        j -= CV_GU;
        if (j < CV_D4) { const int e = j >> 5, nt = j & 31;
            q8d_strip(p.in[34] + (size_t)(l * 16 + e) * DE * 1024 + nt * 32, p.ws + WS_WD + ((size_t)e * 1024 + nt * 32) * DE, (float*)(p.ws + WS_SWD) + e * 1024 + nt * 32, lds); continue; }
        j -= CV_D4;
        if (j < CV_WIN) { q8r_strip(p.in[7] + (size_t)l * 1024 * NIN + j * 64, NIN, p.ws + WS_WIN + (size_t)j * 64 * 1024, (float*)(p.ws + WS_SWIN) + j * 64, lds); continue; }
        j -= CV_WIN;
        if (j < CV_PAD) { const size_t o = (size_t)NIN * 1024 + ((size_t)j * NTHR + threadIdx.x) * 16; *(uint4*)(p.ws + WS_WIN + o) = make_uint4(0u, 0u, 0u, 0u);
            if (j == 0 && threadIdx.x < 128) ((float*)(p.ws + WS_SWIN))[NIN + threadIdx.x] = 0.f; continue; }
        j -= CV_PAD;
        { const int kt = j >> 2, ng = j & 3; tr_tile4(p.in[8] + (size_t)l * 1024 * 1024, 1024, kt * 64, ng * 256, WOUT, 1024, ng * 256, T); }
    }
}

__device__ __forceinline__ void mod_item(const Params& p, int item, LAS unsigned char* lds) {
    LAS float* sc = (LAS float*)lds;
    LAS float* red = (LAS float*)(lds + 69632);
    const int tid = threadIdx.x, l = item / 96, cg = item % 96;
    for (int i = tid; i < 17 * 1024; i += NTHR) { const int b = i >> 10, k = i & 1023; const float c = b < 16 ? p.in[1][b * 1024 + k] : p.in[3][k]; sc[k * 17 + b] = c * sigm(c); }
    __syncthreads();
    const int col = cg * 64 + (tid & 63), kg = tid >> 6;
    float acc[17];
#pragma unroll
    for (int b = 0; b < 17; ++b) acc[b] = 0.f;
    const float* w = p.in[4] + ((size_t)l * 1024 + kg * 128) * 6144 + col;
#pragma unroll 4
    for (int kk = 0; kk < 128; ++kk) { const float wv = w[(size_t)kk * 6144]; const LAS float* s = sc + (kg * 128 + kk) * 17;
#pragma unroll
        for (int b = 0; b < 17; ++b) acc[b] += s[b] * wv; }
#pragma unroll
    for (int b = 0; b < 17; ++b) red[(kg * 17 + b) * 64 + (tid & 63)] = acc[b];
    __syncthreads();
    for (int i = tid; i < 17 * 64; i += NTHR) { const int b = i >> 6, c = i & 63; float s = 0.f;
#pragma unroll
        for (int g = 0; g < 8; ++g) s += red[(g * 17 + b) * 64 + c];
        ((float*)(p.ws + WS_MOD))[((size_t)l * 17 + b) * 6144 + cg * 64 + c] = s + p.in[5][l * 6144 + cg * 64 + c]; }
    __syncthreads();
}

__device__ __forceinline__ void s5mat_item(const Params& p, int item, LAS unsigned char* lds) {
    LAS lf2* pw = (LAS lf2*)lds;
    LAS lf2* bb = (LAS lf2*)(lds + 17408);
    LAS lf2* cc = (LAS lf2*)(lds + 17408 + 16384);
    LAS float* KT = (LAS float*)(lds + 17408 + 32768);
    const int tid = threadIdx.x, l = item >> 4, g = item & 15;
    for (int i = tid; i < 2 * 17 * 64; i += NTHR) { const int pp = i & 63, n = (i >> 6) % 17, d = i / (17 * 64);
        const int li = ((l * 2 + d) * 16 + g) * 64 + pp; const float lr = p.in[9][li], lim = p.in[10][li], dt = expf(p.in[11][(l * 2 + d) * 16 + g]);
        const float mag = expf((float)n * dt * lr); float s, c; sincosf((float)n * dt * lim, &s, &c); pw[i] = (lf2){mag * c, mag * s}; }
    for (int i = tid; i < 2 * 64 * 16; i += NTHR) { const int h = i & 15, pp = (i >> 4) & 63, d = i >> 10;
        const int li = ((l * 2 + d) * 16 + g) * 64 + pp; const float lr = p.in[9][li], lim = p.in[10][li], dt = expf(p.in[11][(l * 2 + d) * 16 + g]);
        const float mag = expf(dt * lr); float s, c; sincosf(dt * lim, &s, &c); const float x = mag * c - 1.0f, y = mag * s;
        const float den = 1.0f / (lr * lr + lim * lim); const float cr = (x * lr + y * lim) * den, ci = (y * lr - x * lim) * den;
        const int bi = ((l * 16 + g) * 64 + pp) * 16 + h; const float br = p.in[12][bi], bim = p.in[13][bi];
        bb[i] = (lf2){cr * br - ci * bim, cr * bim + ci * br}; }
    for (int i = tid; i < 2 * 16 * 64; i += NTHR) { const int pp = i & 63, h = (i >> 6) & 15, d = i >> 10;
        const int ci = (((l * 2 + d) * 16 + g) * 16 + h) * 64 + pp; cc[i] = (lf2){p.in[14][ci], p.in[15][ci]}; }
    __syncthreads();
    for (int i = tid; i < 2 * 16 * 256; i += NTHR) { const int h2 = i & 15, h = (i >> 4) & 15, tau = (i >> 8) & 15, d = i >> 12; float s = 0.f;
        for (int pp = 0; pp < 64; ++pp) { const lf2 c = cc[(d * 16 + h) * 64 + pp], w = pw[(d * 17 + tau) * 64 + pp], b = bb[(d * 64 + pp) * 16 + h2];
            const float tr = c.x * w.x - c.y * w.y, ti = c.x * w.y + c.y * w.x; s += tr * b.x - ti * b.y; }
        KT[i] = s; }
    __syncthreads();
    bf16_t* E = (bf16_t*)(p.ws + WS_SW + (size_t)l * SW_STRIDE + SW_S5E) + (size_t)g * 256 * 256;
    bf16_t* W2 = (bf16_t*)(p.ws + WS_SW + (size_t)l * SW_STRIDE + SW_S5W2) + (size_t)g * 256 * 512;
    for (int i = tid; i < 256 * 256; i += NTHR) { const int k = i & 255, n = i >> 8; const int s = k >> 4, h = k & 15, d = n >> 7, part = (n >> 6) & 1, pp = n & 63;
        const int e = d == 0 ? 15 - s : s; const lf2 w = pw[(d * 17 + e) * 64 + pp], b = bb[(d * 64 + pp) * 16 + h];
        E[i] = f2bf(part ? (w.x * b.y + w.y * b.x) : (w.x * b.x - w.y * b.y)); }
    for (int i = tid; i < 256 * 512; i += NTHR) { const int k = i & 511, n = i >> 9; const int t = n >> 4, h = n & 15; float v;
        if (k < 256) { const int s = k >> 4, h2 = k & 15; v = 0.f;
            if (t >= s) v += KT[((0 * 16 + (t - s)) * 16 + h) * 16 + h2];
            if (s >= t) v += KT[((1 * 16 + (s - t)) * 16 + h) * 16 + h2];
            if (s == t && h == h2) v += p.in[16][l * 256 + g * 16 + h]; }
        else { const int q = k - 256, d = q >> 7, part = (q >> 6) & 1, pp = q & 63; const int e = d == 0 ? t + 1 : 16 - t;
            const lf2 c = cc[(d * 16 + h) * 64 + pp], w = pw[(d * 17 + e) * 64 + pp];
            v = part ? -(c.x * w.y + c.y * w.x) : (c.x * w.x - c.y * w.y); }
        W2[i] = f2bf(v); }
    __syncthreads();
}

__device__ __forceinline__ void smallw_item(const Params& p, int item) {
    int i = item * NTHR + threadIdx.x; const int l = i / 212992; i %= 212992;
    unsigned char* sw = p.ws + WS_SW + (size_t)l * SW_STRIDE;
    if (i < 49152) { const int k = i & 63, n = (i >> 6) % 384, d = i / 24576; ((bf16_t*)(sw + SW_W2T))[i] = f2bf(p.in[22][((size_t)(l * 2 + d) * 64 + k) * 384 + n]); return; }
    i -= 49152;
    if (i < 49152) { const int k = i & 63, n = (i >> 6) % 384, d = i / 24576; ((bf16_t*)(sw + SW_A2T))[i] = f2bf(p.in[24][((size_t)(l * 2 + d) * 64 + k) * 384 + n]); return; }
    i -= 49152;
    if (i < 49152) { const int k = i & 127, n = i >> 7; ((bf16_t*)(sw + SW_G2T))[i] = f2bf(p.in[25][((size_t)l * 128 + k) * 384 + n]); return; }
    i -= 49152;
    { const int k = i & 255, n = i >> 8; ((bf16_t*)(sw + SW_GLUT))[i] = f2bf(p.in[17][((size_t)l * 256 + k) * 256 + n]); }
}

constexpr int PRO_MOD = 192, PRO_S5 = 32, PRO_SW = 832;
__device__ __forceinline__ void phase_prologue(const Params& p, LAS unsigned char* lds) {
    for (int it = blockIdx.x; it < PRO_MOD + PRO_S5 + PRO_SW; it += gridDim.x) {
        if (it < PRO_MOD) mod_item(p, it, lds);
        else if (it < PRO_MOD + PRO_S5) s5mat_item(p, it - PRO_MOD, lds);
        else smallw_item(p, it - PRO_MOD - PRO_S5);
    }
    convert_weights(p, 0, lds, (int)blockIdx.x, (int)gridDim.x);
}

__device__ __forceinline__ void hnorm_row(const float* g, const float* mb_sh, const float* mb_sc, unsigned char* dst, float* sdst, int lane, const float4 (&v)[4]) {
    float ss = 0.f;
#pragma unroll
    for (int i = 0; i < 4; ++i) ss += v[i].x * v[i].x + v[i].y * v[i].y + v[i].z * v[i].z + v[i].w * v[i].w;
    ss = wave_sum(ss); const float rs = rsqrtf(ss * (1.0f / 1024.0f) + 1e-6f);
    float hv[4][4]; float amax = 0.f;
#pragma unroll
    for (int i = 0; i < 4; ++i) { const int c = i * 256 + lane * 4; const float4 gg = *(const float4*)(g + c), sh = *(const float4*)(mb_sh + c), sc = *(const float4*)(mb_sc + c);
        hv[i][0] = v[i].x * rs * gg.x * (1.f + sc.x) + sh.x; hv[i][1] = v[i].y * rs * gg.y * (1.f + sc.y) + sh.y; hv[i][2] = v[i].z * rs * gg.z * (1.f + sc.z) + sh.z; hv[i][3] = v[i].w * rs * gg.w * (1.f + sc.w) + sh.w;
        amax = fmaxf(amax, fmaxf(fmaxf(fabsf(hv[i][0]), fabsf(hv[i][1])), fmaxf(fabsf(hv[i][2]), fabsf(hv[i][3])))); }
#pragma unroll
    for (int o = 32; o >= 1; o >>= 1) amax = fmaxf(amax, __shfl_xor(amax, o));
    amax = fmaxf(amax, 1e-20f); const float qs = 127.0f / amax;
    if (lane == 0) *sdst = amax * (1.0f / 127.0f);
#pragma unroll
    for (int i = 0; i < 4; ++i) { unsigned w = 0u;
#pragma unroll
        for (int k = 0; k < 4; ++k) w |= ((unsigned)__float2int_rn(hv[i][k] * qs) & 255u) << (8 * k);
        *(unsigned*)(dst + i * 256 + lane * 4) = w; }
}
__device__ __forceinline__ void phase_hnorm(const Params& p, int l, const float* xl, const float* xc) {
    const int lane = threadIdx.x & 63, wv = threadIdx.x >> 6;
    const float* mod = (const float*)(p.ws + WS_MOD) + (size_t)l * 17 * 6144; const float* g = p.in[6] + (l * 4 + 0) * 1024;
    unsigned char* A = p.ws + WS_ABUF; float* SH = (float*)(p.ws + WS_SH);
    for (int r = blockIdx.x * 8 + wv; r < NROW; r += gridDim.x * 8) {
        const float* src = xrow(xl, xc, r); const int b = r < NLAT ? (r >> 11) : 16; const float* mb = mod + (size_t)b * 6144;
        float4 v[4];
#pragma unroll
        for (int i = 0; i < 4; ++i) v[i] = *(const float4*)(src + i * 256 + lane * 4);
        hnorm_row(g, mb, mb + 1024, A + (size_t)r * 1024, SH + r, lane, v);
    }
}


__device__ __forceinline__ void phase_prep(const Params& p, int l, LAS unsigned char* lds) {
    LAS bf16_t* vt = (LAS bf16_t*)lds;
    LAS lf2* cs = (LAS lf2*)(lds + 50176);
    const int tid = threadIdx.x;
    for (int i = tid; i < 1024; i += NTHR) { const int pos = i >> 4, j = i & 15; const float invf = exp2f(-(float)j * (13.287712379549449f / 16.0f)); float s, c; sincosf((float)pos * invf, &s, &c); cs[i] = (lf2){c, s}; }
    __syncthreads();
    const bf16_t* P = (const bf16_t*)(p.ws + U_P);
    bf16_t* QR = (bf16_t*)(p.ws + U_QR); bf16_t* KR = (bf16_t*)(p.ws + U_KR);
    bf16_t* RS = (bf16_t*)(p.ws + U_RS); bf16_t* KS = (bf16_t*)(p.ws + U_KS); bf16_t* VS = (bf16_t*)(p.ws + U_VS); bf16_t* KK = (bf16_t*)(p.ws + U_KK); bf16_t* ALR = (bf16_t*)(p.ws + U_ALR);
    for (int ti = blockIdx.x; ti < NROW / 64; ti += gridDim.x) {
        const int r0 = ti * 64; const bool lat = r0 < NLAT; const int b = lat ? (r0 >> 11) : ((r0 - NLAT) >> 8), t0 = lat ? (r0 & 2047) : ((r0 - NLAT) & 255), slen = lat ? SEQ : CTXL;
#pragma unroll
        for (int i = 0; i < 6; ++i) { const int idx = tid + NTHR * i, tok = idx / 48, pc = idx % 48;
            *(LAS lu4*)(vt + tok * 392 + pc * 8) = *(const lu4*)(P + (size_t)(r0 + tok) * NINP + C_V + pc * 8); }
        __syncthreads();
        { bf16_t* vdst = lat ? (bf16_t*)(p.ws + U_VT) + (size_t)b * 384 * 2048 + t0 : (bf16_t*)(p.ws + U_VTC) + (size_t)b * 384 * 256 + t0;
#pragma unroll
          for (int i = 0; i < 6; ++i) { const int idx = tid + NTHR * i, hd = idx >> 3, pc = idx & 7; unsigned w[4];
#pragma unroll
              for (int j = 0; j < 4; ++j) w[j] = (unsigned)vt[(pc * 8 + 2 * j) * 392 + hd] | ((unsigned)vt[(pc * 8 + 2 * j + 1) * 392 + hd] << 16);
              *(uint4*)(vdst + (size_t)hd * slen + pc * 8) = make_uint4(w[0], w[1], w[2], w[3]); } }
#pragma unroll
        for (int i = 0; i < 4; ++i) { const int idx = tid + NTHR * i, tok = idx >> 5, pc = idx & 31;
            *(lu4*)((bf16_t*)(p.ws + U_U16) + (size_t)(r0 + tok) * 256 + pc * 8) = *(const lu4*)(P + (size_t)(r0 + tok) * NINP + pc * 8); }
        { lu4 rx[6][2]; int tq = threadIdx.x; asm volatile("" : "+v"(tq));
#pragma unroll
          for (int i = 0; i < 6; ++i) { const int idx = tq + NTHR * i, tok = idx / 48, rem = idx % 48, qk = rem / 24, rem2 = rem % 24, h = rem2 >> 2, pp = rem2 & 3;
              const int d1 = (pp >> 1) * 32 + (pp & 1) * 8; const size_t so = (size_t)(r0 + tok) * NINP + (qk ? C_K : C_Q) + h * 64 + d1;
              rx[i][0] = *(const lu4*)(P + so); rx[i][1] = *(const lu4*)(P + so + 16); }
#pragma unroll
          for (int i = 0; i < 6; ++i) { const int idx = tq + NTHR * i, tok = idx / 48, rem = idx % 48, qk = rem / 24, rem2 = rem % 24, h = rem2 >> 2, pp = rem2 & 3;
              const int d1 = (pp >> 1) * 32 + (pp & 1) * 8;
              float x1[8], x2[8], o1[8], o2[8]; unpack8(make_uint4(rx[i][0].x, rx[i][0].y, rx[i][0].z, rx[i][0].w), x1); unpack8(make_uint4(rx[i][1].x, rx[i][1].y, rx[i][1].z, rx[i][1].w), x2);
              const int t = t0 + tok, pos = (pp < 2) ? (t >> 6) : (t & 63), j0 = (pp & 1) * 8; const float scl = qk ? 1.0f : 0.125f;
#pragma unroll
              for (int j = 0; j < 8; ++j) { lf2 c = cs[pos * 16 + j0 + j]; if (!lat) c = (lf2){1.f, 0.f}; o1[j] = (x1[j] * c.x - x2[j] * c.y) * scl; o2[j] = (x1[j] * c.y + x2[j] * c.x) * scl; }
              bf16_t* dq = (qk ? KR : QR) + (size_t)(r0 + tok) * 384 + h * 64 + d1; *(uint4*)dq = pack8(o1); *(uint4*)(dq + 16) = pack8(o2); } }
#pragma unroll 1
        for (int ig = 0; ig < 6; ++ig) { lu4 zc[4], zq[4], zn[4]; int ts = threadIdx.x; asm volatile("" : "+v"(ts));
#pragma unroll
            for (int u = 0; u < 4; ++u) { const int idx = ts + NTHR * (ig * 4 + u), tok = idx / 192, pc = idx % 192, t = t0 + tok; const bf16_t* zp = P + (size_t)(r0 + tok) * NINP + C_Z + pc * 8;
                zc[u] = *(const lu4*)zp; zq[u] = t > 0 ? *(const lu4*)(zp - NINP) : (lu4){0u, 0u, 0u, 0u}; zn[u] = t < slen - 1 ? *(const lu4*)(zp + NINP) : (lu4){0u, 0u, 0u, 0u}; }
#pragma unroll
            for (int u = 0; u < 4; ++u) { const int idx = ts + NTHR * (ig * 4 + u), tok = idx / 192, pc = idx % 192, c0 = pc * 8, r = r0 + tok;
                float x[8], pv[8], nx[8], zs[8];
                unpack8(make_uint4(zc[u].x, zc[u].y, zc[u].z, zc[u].w), x); unpack8(make_uint4(zq[u].x, zq[u].y, zq[u].z, zq[u].w), pv); unpack8(make_uint4(zn[u].x, zn[u].y, zn[u].z, zn[u].w), nx);
                const float4 mu0 = *(const float4*)(p.in[20] + l * 1536 + c0), mu1 = *(const float4*)(p.in[20] + l * 1536 + c0 + 4); const float mu[8] = {mu0.x, mu0.y, mu0.z, mu0.w, mu1.x, mu1.y, mu1.z, mu1.w};
#pragma unroll
                for (int j = 0; j < 8; ++j) zs[j] = x[j] + (0.5f * (pv[j] + nx[j]) - x[j]) * mu[j];
                const bool isk = c0 >= 384 && c0 < 768; float kv[8]; float ss = 0.f;
                { const int kc = isk ? c0 - 384 : 0; const float4 k0 = *(const float4*)(p.in[26] + l * 384 + kc), k1 = *(const float4*)(p.in[26] + l * 384 + kc + 4); const float kkw[8] = {k0.x, k0.y, k0.z, k0.w, k1.x, k1.y, k1.z, k1.w};
#pragma unroll
                  for (int j = 0; j < 8; ++j) { kv[j] = zs[j] * kkw[j]; ss += kv[j] * kv[j]; } }
                ss += __shfl_xor(ss, 1); ss += __shfl_xor(ss, 2); ss += __shfl_xor(ss, 4);
                if (c0 < 384) *(uint4*)(RS + (size_t)r * 384 + c0) = pack8(zs);
                else if (c0 < 768) { *(uint4*)(KS + (size_t)r * 384 + c0 - 384) = pack8(zs); const float inv = 1.0f / fmaxf(sqrtf(ss), 1e-12f);
#pragma unroll
                    for (int j = 0; j < 8; ++j) kv[j] *= inv;
                    *(uint4*)(KK + (size_t)r * 384 + c0 - 384) = pack8(kv); }
                else if (c0 < 1152) *(uint4*)(VS + (size_t)r * 384 + c0 - 768) = pack8(zs);
                else { const int ac = c0 - 1152; float o[8];
#pragma unroll
                    for (int j = 0; j < 8; ++j) o[j] = ac < 128 ? 1.0f - 2.0f / (1.0f + __expf(2.0f * zs[j])) : (ac < 256 ? zs[j] : sigm(zs[j]));
                    *(uint4*)(ALR + (size_t)r * 384 + ac) = pack8(o); } }
        }
        __syncthreads();
    }
}

template <int KS, int MODE> __device__ __forceinline__ void lr_wave(const Params& p, int l, int row0, int kofs, const bf16_t* Bt, int d) {
    const int lane = threadIdx.x & 63, m = lane & 15, q = lane >> 4;
    const bf16_t* Ap = (const bf16_t*)(p.ws + U_ALR) + (size_t)(row0 + m) * 384 + kofs + q * 8;
    bf16x8 a[KS];
#pragma unroll
    for (int ks = 0; ks < KS; ++ks) a[ks] = *(const bf16x8*)(Ap + ks * 32);
    bf16_t* O = (bf16_t*)(p.ws + (MODE == 0 ? U_LD + (size_t)d * SZ384 : (MODE == 1 ? U_AG + (size_t)d * SZ384 : U_G))) + (size_t)(row0 + m) * 384;
    const float* bias = MODE == 0 ? p.in[21] + (l * 2 + d) * 384 : p.in[23] + (l * 2 + d) * 384;
    for (int nt = 0; nt < 24; ++nt) {
        f32x4 acc = (f32x4){0.f, 0.f, 0.f, 0.f};
#pragma unroll
        for (int ks = 0; ks < KS; ++ks) { const bf16x8 bfr = *(const bf16x8*)(Bt + (size_t)(nt * 16 + m) * (KS * 32) + ks * 32 + q * 8); acc = mfma16(bfr, a[ks], acc); }
        const int n = nt * 16 + q * 4; float o[4];
        if (MODE == 2) {
#pragma unroll
            for (int j = 0; j < 4; ++j) o[j] = acc[j];
        } else { const float4 bv = *(const float4*)(bias + n); const float bb[4] = {bv.x, bv.y, bv.z, bv.w};
#pragma unroll
            for (int j = 0; j < 4; ++j) { const float s = sigm(bb[j] + acc[j]); o[j] = MODE == 0 ? -0.6065306597f * s : s; } }
        u32x2 w; w.x = pack2(o[0], o[1]); w.y = pack2(o[2], o[3]); *(u32x2*)(O + n) = w;
    }
}
template <int KS, int MODE> __device__ __forceinline__ void lr_block(const Params& p, int l, const bf16_t* Bt, int kofs, int d, int bi, int nb, LAS unsigned char* lds) {
    constexpr int PITCH = KS * 32 + 8;
    LAS bf16_t* sB = (LAS bf16_t*)lds; LAS float* sbias = (LAS float*)(lds + 384 * PITCH * 2);
    const int tid = threadIdx.x, lane = tid & 63, m = lane & 15, q = lane >> 4, wv = tid >> 6;
    const float* bias = MODE == 0 ? p.in[21] + (l * 2 + d) * 384 : p.in[23] + (l * 2 + d) * 384;
    __syncthreads();
    { lu4 st_[3 * KS];
#pragma unroll
      for (int j = 0; j < 3 * KS; ++j) { const int i = tid + NTHR * j, n = i / (KS * 4), pc = i % (KS * 4); st_[j] = *(const lu4*)(Bt + (size_t)n * (KS * 32) + pc * 8); }
      __builtin_amdgcn_sched_barrier(0);
#pragma unroll
      for (int j = 0; j < 3 * KS; ++j) { const int i = tid + NTHR * j, n = i / (KS * 4), pc = i % (KS * 4); *(LAS lu4*)(sB + n * PITCH + pc * 8) = st_[j]; } }
    if (MODE != 2) for (int i = tid; i < 384; i += NTHR) sbias[i] = bias[i];
    __syncthreads();
    bf16_t* Ob = (bf16_t*)(p.ws + (MODE == 0 ? U_LD + (size_t)d * SZ384 : (MODE == 1 ? U_AG + (size_t)d * SZ384 : U_G)));
    for (int rt = bi * 8 + wv; rt < 2304; rt += nb * 8) { const int row0 = rt * 16;
        const bf16_t* Ap = (const bf16_t*)(p.ws + U_ALR) + (size_t)(row0 + m) * 384 + kofs + q * 8;
        bf16x8 a[KS];
#pragma unroll
        for (int ks = 0; ks < KS; ++ks) a[ks] = *(const bf16x8*)(Ap + ks * 32);
        bf16_t* O = Ob + (size_t)(row0 + m) * 384;
#pragma unroll 4
        for (int nt = 0; nt < 24; ++nt) {
            f32x4 acc = (f32x4){0.f, 0.f, 0.f, 0.f};
#pragma unroll
            for (int ks = 0; ks < KS; ++ks) acc = mfma16(*(const LAS bf16x8*)(sB + (nt * 16 + m) * PITCH + ks * 32 + q * 8), a[ks], acc);
            const int n = nt * 16 + q * 4; float o[4];
            if (MODE == 2) {
#pragma unroll
                for (int j = 0; j < 4; ++j) o[j] = acc[j];
            } else { const lf4 bv = *(const LAS lf4*)(sbias + n); const float bb[4] = {bv.x, bv.y, bv.z, bv.w};
#pragma unroll
                for (int j = 0; j < 4; ++j) { const float sg = sigm(bb[j] + acc[j]); o[j] = MODE == 0 ? -0.6065306597f * sg : sg; } }
            u32x2 w; w.x = pack2(o[0], o[1]); w.y = pack2(o[2], o[3]); *(u32x2*)(O + n) = w;
        }
    }
    __syncthreads();
}
__device__ __forceinline__ void lowrank_items(const Params& p, int l, int wid, int nw, LAS unsigned char* lds) {
    const unsigned char* sw = p.ws + WS_SW + (size_t)l * SW_STRIDE; const int G = gridDim.x, bx = blockIdx.x;
    if (G >= 12) {
        const int sh = bx * 6 / G, mm = sh < 4 ? sh : 4; const int lo = (mm * G + 5) / 6, hi = mm < 4 ? ((mm + 1) * G + 5) / 6 : G, bi = bx - lo, nb = hi - lo;
        if (mm < 2) lr_block<2, 0>(p, l, (const bf16_t*)(sw + SW_W2T) + (size_t)mm * 384 * 64, mm * 64, mm, bi, nb, lds);
        else if (mm < 4) lr_block<2, 1>(p, l, (const bf16_t*)(sw + SW_A2T) + (size_t)(mm - 2) * 384 * 64, mm * 64, mm - 2, bi, nb, lds);
        else lr_block<4, 2>(p, l, (const bf16_t*)(sw + SW_G2T), 256, 0, bi, nb, lds);
        return; }
    for (int it = wid; it < 2304 * 5; it += nw) { const int rt = it / 5, m = it % 5, row0 = rt * 16;
        if (m < 2) lr_wave<2, 0>(p, l, row0, m * 64, (const bf16_t*)(sw + SW_W2T) + (size_t)m * 384 * 64, m);
        else if (m < 4) lr_wave<2, 1>(p, l, row0, m * 64, (const bf16_t*)(sw + SW_A2T) + (size_t)(m - 2) * 384 * 64, m - 2);
        else lr_wave<4, 2>(p, l, row0, 256, (const bf16_t*)(sw + SW_G2T), 0); }
}

__device__ __forceinline__ int s5_rowbase(int cr) { const int b = cr / 144, c = cr % 144; return c < 16 ? NLAT + b * 256 + c * 16 : b * 2048 + (c - 16) * 16; }
__device__ __forceinline__ void s5_pass1_items(const Params& p, int l, int wid, int nw) {
    const int lane = threadIdx.x & 63, m = lane & 15, q = lane >> 4;
    const bf16_t* P = (const bf16_t*)(p.ws + U_U16); float* SLOC = (float*)(p.ws + U_SLOC);
    for (int it = wid; it < 144 * 16; it += nw) { const int ct = it >> 4, g = it & 15, cr = ct * 16 + m, rb = s5_rowbase(cr);
        const bf16_t* E = (const bf16_t*)(p.ws + WS_SW + (size_t)l * SW_STRIDE + SW_S5E) + (size_t)g * 256 * 256;
        bf16x8 a[8];
#pragma unroll
        for (int ks = 0; ks < 8; ++ks) a[ks] = *(const bf16x8*)(P + (size_t)(rb + 2 * ks + (q >> 1)) * 256 + g * 16 + (q & 1) * 8);
        float* o = SLOC + ((size_t)cr * 16 + g) * 256 + q * 4;
#pragma unroll 2
        for (int nt = 0; nt < 16; ++nt) { f32x4 acc = (f32x4){0.f, 0.f, 0.f, 0.f}; const bf16_t* ep = E + (size_t)(nt * 16 + m) * 256 + q * 8;
#pragma unroll
            for (int ks = 0; ks < 8; ++ks) acc = mfma16(*(const bf16x8*)(ep + ks * 32), a[ks], acc);
            *(f32x4*)(o + nt * 16) = acc; }
    }
}
__device__ __forceinline__ void s5_pass1_block(const Params& p, int l, LAS unsigned char* lds) {
    constexpr int PITCH = 264;
    LAS bf16_t* sE = (LAS bf16_t*)lds;
    const int tid = threadIdx.x, lane = tid & 63, m = lane & 15, q = lane >> 4, wv = tid >> 6, G = gridDim.x, bx = blockIdx.x;
    const int combo = bx & 31, g = combo >> 1, half = combo & 1, bi = bx >> 5, nb = G >> 5;
    const bf16_t* E = (const bf16_t*)(p.ws + WS_SW + (size_t)l * SW_STRIDE + SW_S5E) + ((size_t)g * 256 + half * 128) * 256;
    const bf16_t* P = (const bf16_t*)(p.ws + U_U16); float* SLOC = (float*)(p.ws + U_SLOC);
    __syncthreads();
    { lu4 st_[8];
#pragma unroll
      for (int j = 0; j < 8; ++j) { const int i = tid + NTHR * j, n = i >> 5, pc = i & 31; st_[j] = *(const lu4*)(E + (size_t)n * 256 + pc * 8); }
      __builtin_amdgcn_sched_barrier(0);
#pragma unroll
      for (int j = 0; j < 8; ++j) { const int i = tid + NTHR * j, n = i >> 5, pc = i & 31; *(LAS lu4*)(sE + n * PITCH + pc * 8) = st_[j]; } }
    __syncthreads();
    LAS unsigned char* eb = (LAS unsigned char*)(sE + m * PITCH + q * 8); asm volatile("" : "+v"(eb));
    for (int ct = bi * 8 + wv; ct < 144; ct += nb * 8) { const int cr = ct * 16 + m, rb = s5_rowbase(cr);
        bf16x8 a[8];
#pragma unroll
        for (int ks = 0; ks < 8; ++ks) a[ks] = *(const bf16x8*)(P + (size_t)(rb + 2 * ks + (q >> 1)) * 256 + g * 16 + (q & 1) * 8);
        float* o = SLOC + ((size_t)cr * 16 + g) * 256 + half * 128 + q * 4;
#pragma unroll 2
        for (int nt = 0; nt < 8; ++nt) { f32x4 acc = (f32x4){0.f, 0.f, 0.f, 0.f};
#pragma unroll
            for (int ks = 0; ks < 8; ++ks) acc = mfma16(*(const LAS bf16x8*)(eb + nt * 16 * PITCH * 2 + ks * 64), a[ks], acc);
            *(f32x4*)(o + nt * 16) = acc; } }
    __syncthreads();
}
__device__ __forceinline__ void s5_carry(const Params& p, int l) {
    const int gid = blockIdx.x * NTHR + threadIdx.x; if (gid >= 32768) return;
    const int pp = gid & 63, d = (gid >> 6) & 1, g = (gid >> 7) & 15, b = gid >> 11;
    const int li = ((l * 2 + d) * 16 + g) * 64 + pp; const float lr = p.in[9][li], lim = p.in[10][li], dt = expf(p.in[11][(l * 2 + d) * 16 + g]);
    const float mag = expf(16.0f * dt * lr); float sn, cn; sincosf(16.0f * dt * lim, &sn, &cn); const float ar = mag * cn, ai = mag * sn;
    const float* SLOC = (const float*)(p.ws + U_SLOC); bf16_t* SP = (bf16_t*)(p.ws + U_SPREV);
    float sr = 0.f, si = 0.f;
#pragma unroll 8
    for (int n = 0; n < 144; ++n) { const int c = d == 0 ? n : (n < 16 ? 15 - n : 159 - n); const size_t idx = ((size_t)(b * 144 + c) * 16 + g) * 256 + d * 128 + pp;
        SP[idx] = f2bf(sr); SP[idx + 64] = f2bf(si);
        const float xr = SLOC[idx], xi = SLOC[idx + 64]; const float nr = ar * sr - ai * si + xr, ni = ar * si + ai * sr + xi; sr = nr; si = ni; }
}
__device__ __forceinline__ void s5_pass2_items(const Params& p, int l, int wid, int nw) {
    const int lane = threadIdx.x & 63, m = lane & 15, q = lane >> 4;
    const bf16_t* P = (const bf16_t*)(p.ws + U_U16); const bf16_t* SP = (const bf16_t*)(p.ws + U_SPREV); bf16_t* YG = (bf16_t*)(p.ws + U_YG);
    for (int it = wid; it < 144 * 16; it += nw) { const int ct = it >> 4, g = it & 15; if (l == 1 && ct % 9 == 0) continue;
        const int cr = ct * 16 + m, rb = s5_rowbase(cr);
        const bf16_t* W2 = (const bf16_t*)(p.ws + WS_SW + (size_t)l * SW_STRIDE + SW_S5W2) + (size_t)g * 256 * 512;
        bf16x8 a[16];
#pragma unroll
        for (int ks = 0; ks < 8; ++ks) a[ks] = *(const bf16x8*)(P + (size_t)(rb + 2 * ks + (q >> 1)) * 256 + g * 16 + (q & 1) * 8);
#pragma unroll
        for (int ks = 8; ks < 16; ++ks) a[ks] = *(const bf16x8*)(SP + ((size_t)cr * 16 + g) * 256 + (ks - 8) * 32 + q * 8);
#pragma unroll 2
        for (int nt = 0; nt < 16; ++nt) { f32x4 acc = (f32x4){0.f, 0.f, 0.f, 0.f}; const bf16_t* wp = W2 + (size_t)(nt * 16 + m) * 512 + q * 8;
#pragma unroll
            for (int ks = 0; ks < 16; ++ks) acc = mfma16(*(const bf16x8*)(wp + ks * 32), a[ks], acc);
            float o[4];
#pragma unroll
            for (int j = 0; j < 4; ++j) { const float x = acc[j]; const float u = 0.7978845608f * (x + 0.044715f * x * x * x); const float th = 1.0f - 2.0f / (1.0f + __expf(2.0f * u)); o[j] = 0.5f * x * (1.0f + th); }
            u32x2 w; w.x = pack2(o[0], o[1]); w.y = pack2(o[2], o[3]); *(u32x2*)(YG + (size_t)(rb + nt) * 256 + g * 16 + q * 4) = w; }
    }
}
__device__ __forceinline__ void s5_pass2_block(const Params& p, int l, int vb, int nvb, LAS unsigned char* lds) {
    constexpr int PITCH = 520;
    LAS bf16_t* sW = (LAS bf16_t*)lds;
    const int tid = threadIdx.x, lane = tid & 63, m = lane & 15, q = lane >> 4, wv = tid >> 6;
    const bf16_t* P = (const bf16_t*)(p.ws + U_U16); const bf16_t* SP = (const bf16_t*)(p.ws + U_SPREV); bf16_t* YG = (bf16_t*)(p.ws + U_YG);
    if ((nvb & 63) != 0) { s5_pass2_items(p, l, vb * 8 + wv, nvb * 8); return; }
    { const int combo = vb & 63, g = combo >> 2, qd = combo & 3, bi = vb >> 6, nb = nvb >> 6;
        const bf16_t* W2 = (const bf16_t*)(p.ws + WS_SW + (size_t)l * SW_STRIDE + SW_S5W2) + ((size_t)g * 256 + qd * 64) * 512;
        __syncthreads();
        { lu4 st_[8];
#pragma unroll
          for (int j = 0; j < 8; ++j) { const int i = tid + NTHR * j, n = i >> 6, pc = i & 63; st_[j] = *(const lu4*)(W2 + (size_t)n * 512 + pc * 8); }
          __builtin_amdgcn_sched_barrier(0);
#pragma unroll
          for (int j = 0; j < 8; ++j) { const int i = tid + NTHR * j, n = i >> 6, pc = i & 63; *(LAS lu4*)(sW + n * PITCH + pc * 8) = st_[j]; } }
        __syncthreads();
        LAS unsigned char* wb = (LAS unsigned char*)(sW + m * PITCH + q * 8); asm volatile("" : "+v"(wb));
        for (int ct = bi * 8 + wv; ct < 144; ct += nb * 8) { if (l == 1 && ct % 9 == 0) continue;
            const int cr = ct * 16 + m, rb = s5_rowbase(cr);
            bf16x8 a[16];
#pragma unroll
            for (int ks = 0; ks < 8; ++ks) a[ks] = *(const bf16x8*)(P + (size_t)(rb + 2 * ks + (q >> 1)) * 256 + g * 16 + (q & 1) * 8);
#pragma unroll
            for (int ks = 8; ks < 16; ++ks) a[ks] = *(const bf16x8*)(SP + ((size_t)cr * 16 + g) * 256 + (ks - 8) * 32 + q * 8);
#pragma unroll 1
            for (int nt = 0; nt < 4; ++nt) { f32x4 acc = (f32x4){0.f, 0.f, 0.f, 0.f};
#pragma unroll
                for (int ks = 0; ks < 16; ++ks) acc = mfma16(*(const LAS bf16x8*)(wb + nt * 16 * PITCH * 2 + ks * 64), a[ks], acc);
                float o[4];
#pragma unroll
                for (int j = 0; j < 4; ++j) { const float x = acc[j]; const float u = 0.7978845608f * (x + 0.044715f * x * x * x); const float th = 1.0f - 2.0f / (1.0f + __expf(2.0f * u)); o[j] = 0.5f * x * (1.0f + th); }
                u32x2 w; w.x = pack2(o[0], o[1]); w.y = pack2(o[2], o[3]); *(u32x2*)(YG + (size_t)(rb + qd * 4 + nt) * 256 + g * 16 + q * 4) = w; } }
    }
    __syncthreads();
}
__device__ __forceinline__ void s5_glu_items(const Params& p, int l, int wid, int nw) {
    const int lane = threadIdx.x & 63, m = lane & 15, q = lane >> 4;
    const bf16_t* YG = (const bf16_t*)(p.ws + U_YG); bf16_t* YC = (bf16_t*)(p.ws + WS_ABUF);
    const bf16_t* GT = (const bf16_t*)(p.ws + WS_SW + (size_t)l * SW_STRIDE + SW_GLUT);
    const int nrt = (l == 0 ? NROW : NLAT) / 16;
    for (int rt = wid; rt < nrt; rt += nw) { const int row = rt * 16 + m;
        bf16x8 a[8];
#pragma unroll
        for (int ks = 0; ks < 8; ++ks) a[ks] = *(const bf16x8*)(YG + (size_t)row * 256 + ks * 32 + q * 8);
#pragma unroll 2
        for (int nt = 0; nt < 16; ++nt) { f32x4 acc = (f32x4){0.f, 0.f, 0.f, 0.f}; const bf16_t* gp = GT + (size_t)(nt * 16 + m) * 256 + q * 8;
#pragma unroll
            for (int ks = 0; ks < 8; ++ks) acc = mfma16(*(const bf16x8*)(gp + ks * 32), a[ks], acc);
            const int n = nt * 16 + q * 4; const float4 bv = *(const float4*)(p.in[18] + l * 256 + n); const u32x2 yw = *(const u32x2*)(YG + (size_t)row * 256 + n);
            u32x2 w; w.x = pack2(bflo(yw.x) * sigm(acc[0] + bv.x), bfhi(yw.x) * sigm(acc[1] + bv.y)); w.y = pack2(bflo(yw.y) * sigm(acc[2] + bv.z), bfhi(yw.y) * sigm(acc[3] + bv.w));
            *(u32x2*)(YC + (size_t)row * 1024 + n) = w; }
    }
}

__device__ __forceinline__ void s5_glu_block(const Params& p, int l, int vb, int nvb, LAS unsigned char* lds) {
    constexpr int PITCH = 264;
    LAS bf16_t* sG = (LAS bf16_t*)lds;
    const int tid = threadIdx.x, lane = tid & 63, m = lane & 15, q = lane >> 4, wv = tid >> 6;
    if (nvb < 2 || (nvb & 1)) { s5_glu_items(p, l, vb * 8 + wv, nvb * 8); return; }
    const int half = vb & 1, bi = vb >> 1, nb = nvb >> 1;
    const bf16_t* YG = (const bf16_t*)(p.ws + U_YG); bf16_t* YC = (bf16_t*)(p.ws + WS_ABUF);
    const bf16_t* GT = (const bf16_t*)(p.ws + WS_SW + (size_t)l * SW_STRIDE + SW_GLUT) + (size_t)half * 128 * 256;
    __syncthreads();
    { lu4 st_[8];
#pragma unroll
      for (int j = 0; j < 8; ++j) { const int i = tid + NTHR * j, n = i >> 5, pc = i & 31; st_[j] = *(const lu4*)(GT + (size_t)n * 256 + pc * 8); }
      __builtin_amdgcn_sched_barrier(0);
#pragma unroll
      for (int j = 0; j < 8; ++j) { const int i = tid + NTHR * j, n = i >> 5, pc = i & 31; *(LAS lu4*)(sG + n * PITCH + pc * 8) = st_[j]; } }
    __syncthreads();
    LAS unsigned char* gb = (LAS unsigned char*)(sG + m * PITCH + q * 8); asm volatile("" : "+v"(gb));
    const int nrt = (l == 0 ? NROW : NLAT) / 16;
    for (int rt = bi * 8 + wv; rt < nrt; rt += nb * 8) { const int row = rt * 16 + m;
        bf16x8 a[8];
#pragma unroll
        for (int ks = 0; ks < 8; ++ks) a[ks] = *(const bf16x8*)(YG + (size_t)row * 256 + ks * 32 + q * 8);
#pragma unroll 2
        for (int nt = 0; nt < 8; ++nt) { f32x4 acc = (f32x4){0.f, 0.f, 0.f, 0.f};
#pragma unroll
            for (int ks = 0; ks < 8; ++ks) acc = mfma16(*(const LAS bf16x8*)(gb + nt * 16 * PITCH * 2 + ks * 64), a[ks], acc);
            const int n = half * 128 + nt * 16 + q * 4; const float4 bv = *(const float4*)(p.in[18] + l * 256 + n); const u32x2 yw = *(const u32x2*)(YG + (size_t)row * 256 + n);
            u32x2 w; w.x = pack2(bflo(yw.x) * sigm(acc[0] + bv.x), bfhi(yw.x) * sigm(acc[1] + bv.y)); w.y = pack2(bflo(yw.y) * sigm(acc[2] + bv.z), bfhi(yw.y) * sigm(acc[3] + bv.w));
            *(u32x2*)(YC + (size_t)row * 1024 + n) = w; } }
    __syncthreads();
}

template <bool HASLAT> __device__ __forceinline__ void na_unit(const Params& p, const LAS float* rpb_l, int b, int h, int i, int n) {
    const int lane = threadIdx.x & 63, m = lane & 15, q = lane >> 4, kin = 8 * (m >> 2) + (m & 3);
    const bf16_t* QR = (const bf16_t*)(p.ws + U_QR); const bf16_t* KR = (const bf16_t*)(p.ws + U_KR);
    const bf16_t* VTL = (const bf16_t*)(p.ws + U_VT) + (size_t)(b * 6 + h) * 64 * 2048; const bf16_t* VTC = (const bf16_t*)(p.ws + U_VTC) + (size_t)(b * 6 + h) * 64 * 256;
    const int qrow = HASLAT ? b * 2048 + i * 64 + n * 16 + m : NLAT + b * 256 + n * 16 + m;
    bf16x8 qf[2];
#pragma unroll
    for (int ks = 0; ks < 2; ++ks) qf[ks] = *(const bf16x8*)(QR + (size_t)qrow * 384 + h * 64 + ks * 32 + q * 8);
    const int r0 = HASLAT ? min(max(i - 4, 0), 24) : 0, scol = HASLAT ? min(max(n * 16 - 8, 0), 32) : 0;
    f32x4 sl[HASLAT ? 16 : 1], sc[16];
    float mx = -3.0e38f;
    if (HASLAT) { const int qc = n * 16 + m, c0 = min(max(qc - 8, 0), 48); const LAS float* rpb = rpb_l + h * 15 * 31;
#pragma unroll
        for (int t = 0; t < 16; ++t) { const int kr = t >> 1, ch = t & 1; const bf16_t* kp = KR + (size_t)(b * 2048 + (r0 + kr) * 64 + scol + kin + 4 * ch) * 384 + h * 64 + q * 8;
            f32x4 acc = (f32x4){0.f, 0.f, 0.f, 0.f};
#pragma unroll
            for (int ks = 0; ks < 2; ++ks) acc = mfma16(*(const bf16x8*)(kp + ks * 32), qf[ks], acc);
            const int dr = r0 + kr - i + 7;
#pragma unroll
            for (int j = 0; j < 4; ++j) { const int kc = scol + 8 * q + 4 * ch + j; const bool valid = kc >= c0 && kc < c0 + 16; const int dc = min(max(kc - qc + 15, 0), 30);
                const float s = valid ? acc[j] + rpb[dr * 31 + dc] : -1.0e30f; acc[j] = s; mx = fmaxf(mx, s); }
            sl[t] = acc; if ((t & 7) == 7) __builtin_amdgcn_sched_barrier(0); } }
#pragma unroll
    for (int t = 0; t < 16; ++t) { const bf16_t* kp = KR + (size_t)(NLAT + b * 256 + (t >> 1) * 32 + kin + 4 * (t & 1)) * 384 + h * 64 + q * 8;
        f32x4 acc = (f32x4){0.f, 0.f, 0.f, 0.f};
#pragma unroll
        for (int ks = 0; ks < 2; ++ks) acc = mfma16(*(const bf16x8*)(kp + ks * 32), qf[ks], acc);
#pragma unroll
        for (int j = 0; j < 4; ++j) mx = fmaxf(mx, acc[j]);
        sc[t] = acc; }
    mx = fmaxf(mx, __shfl_xor(mx, 16)); mx = fmaxf(mx, __shfl_xor(mx, 32));
    float sum = 0.f;
    f32x4 o[4];
#pragma unroll
    for (int dt = 0; dt < 4; ++dt) o[dt] = (f32x4){0.f, 0.f, 0.f, 0.f};
    if (HASLAT) {
#pragma unroll
        for (int kr = 0; kr < 8; ++kr) { float e[8];
#pragma unroll
            for (int j = 0; j < 4; ++j) { e[j] = __expf(sl[2 * kr][j] - mx); e[4 + j] = __expf(sl[2 * kr + 1][j] - mx); }
#pragma unroll
            for (int j = 0; j < 8; ++j) sum += e[j];
            const uint4 pw = pack8(e); const bf16x8 pf = __builtin_bit_cast(bf16x8, pw);
            const int tok = (r0 + kr) * 64 + scol + q * 8;
#pragma unroll
            for (int dt = 0; dt < 4; ++dt) o[dt] = mfma16(*(const bf16x8*)(VTL + (size_t)(dt * 16 + m) * 2048 + tok), pf, o[dt]);
            if (kr & 1) __builtin_amdgcn_sched_barrier(0); } }
#pragma unroll
    for (int t2 = 0; t2 < 8; ++t2) { float e[8];
#pragma unroll
        for (int j = 0; j < 4; ++j) { e[j] = __expf(sc[2 * t2][j] - mx); e[4 + j] = __expf(sc[2 * t2 + 1][j] - mx); }
#pragma unroll
        for (int j = 0; j < 8; ++j) sum += e[j];
        const uint4 pw = pack8(e); const bf16x8 pf = __builtin_bit_cast(bf16x8, pw);
        const int tok = t2 * 32 + q * 8;
#pragma unroll
        for (int dt = 0; dt < 4; ++dt) o[dt] = mfma16(*(const bf16x8*)(VTC + (size_t)(dt * 16 + m) * 256 + tok), pf, o[dt]);
        if (t2 & 1) __builtin_amdgcn_sched_barrier(0); }
    sum += __shfl_xor(sum, 16); sum += __shfl_xor(sum, 32);
    const float inv = 1.0f / sum;
    bf16_t* yo = (bf16_t*)(p.ws + WS_ABUF) + (size_t)qrow * 1024 + 256 + h * 64 + q * 4;
#pragma unroll
    for (int dt = 0; dt < 4; ++dt) { u32x2 w; w.x = pack2(o[dt][0] * inv, o[dt][1] * inv); w.y = pack2(o[dt][2] * inv, o[dt][3] * inv); *(u32x2*)(yo + dt * 16) = w; }
}
#define NA_SHX(x, msk) __builtin_bit_cast(float, __builtin_amdgcn_ds_bpermute((lane ^ (msk)) << 2, __builtin_bit_cast(int, (x))))
template <bool HASLAT> __device__ __forceinline__ void na_block(const Params& p, int l, int b, int h, int sel, LAS unsigned char* lds) {
    LAS bf16_t* Ks = (LAS bf16_t*)lds;
    LAS bf16_t* Vs = (LAS bf16_t*)lds;
    LAS float* rp = (LAS float*)(lds + 120064);
    int tid = threadIdx.x; asm volatile("" : "+v"(tid));
    const int lane = tid & 63, m = lane & 15, q = lane >> 4, w = tid >> 6, kin = 8 * (m >> 2) + (m & 3);
    const bf16_t* QR = (const bf16_t*)(p.ws + U_QR); const bf16_t* KR = (const bf16_t*)(p.ws + U_KR);
    const bf16_t* VTL = (const bf16_t*)(p.ws + U_VT) + (size_t)(b * 6 + h) * 64 * 2048; const bf16_t* VTC = (const bf16_t*)(p.ws + U_VTC) + (size_t)(b * 6 + h) * 64 * 256;
    const int i0 = HASLAT ? 2 * sel : 0, rlo = HASLAT ? min(max(i0 - 4, 0), 24) : 0;
    __syncthreads();
    int tk = threadIdx.x; asm volatile("" : "+v"(tk));
    { lu4 kl[HASLAT ? 9 : 1], kc[4]; float rpv = 0.f;
      if (HASLAT) {
#pragma unroll
        for (int j = 0; j < 9; ++j) { const int idx = tk + NTHR * j, key = idx >> 3, pc = idx & 7, tok = min(rlo * 64 + key, 2047);
            kl[j] = *(const lu4*)(KR + (size_t)(b * 2048 + tok) * 384 + h * 64 + pc * 8); }
        rpv = p.in[19][(size_t)(l * 6 + h) * 465 + min(tk, 464)]; }
#pragma unroll
      for (int j = 0; j < 4; ++j) { const int idx = tk + NTHR * j, key = idx >> 3, pc = idx & 7; kc[j] = *(const lu4*)(KR + (size_t)(NLAT + b * 256 + key) * 384 + h * 64 + pc * 8); }
      __builtin_amdgcn_sched_barrier(0);
      if (HASLAT) {
#pragma unroll
        for (int j = 0; j < 9; ++j) { const int idx = tk + NTHR * j, key = idx >> 3, pc = idx & 7; *(LAS lu4*)(Ks + key * 72 + pc * 8) = kl[j]; }
        if (tk < 465) rp[tk] = rpv; }
#pragma unroll
      for (int j = 0; j < 4; ++j) { const int idx = tk + NTHR * j, key = idx >> 3, pc = idx & 7; *(LAS lu4*)(Ks + (576 + key) * 72 + pc * 8) = kc[j]; } }
    const int i = HASLAT ? i0 + (w >> 2) : 0, n = HASLAT ? (w & 3) : sel * 8 + w;
    const int qrow = HASLAT ? b * 2048 + i * 64 + n * 16 + m : NLAT + b * 256 + n * 16 + m;
    bf16x8 qf[2];
#pragma unroll
    for (int ks = 0; ks < 2; ++ks) qf[ks] = *(const bf16x8*)(QR + (size_t)qrow * 384 + h * 64 + ks * 32 + q * 8);
    const int r0 = HASLAT ? min(max(i - 4, 0), 24) : 0, scol = HASLAT ? min(max(n * 16 - 8, 0), 32) : 0, kb = (r0 - rlo) * 64 + scol;
    LAS unsigned char* kbl = (LAS unsigned char*)(Ks + (kb + kin) * 72 + q * 8); LAS unsigned char* kbc = (LAS unsigned char*)(Ks + (576 + kin) * 72 + q * 8);
    asm volatile("" : "+v"(kbl), "+v"(kbc));
    __syncthreads();
    float mx1 = -3.0e38f, mx2 = -3.0e38f, sum1 = 0.f, sum2 = 0.f;
    bf16x8 pl[HASLAT ? 8 : 1], pcx[8];
    if (HASLAT) { const int qc = n * 16 + m, c0 = min(max(qc - 8, 0), 48); f32x4 sl[16];
#pragma unroll
        for (int t = 0; t < 16; ++t) { const int kr = t >> 1, ch = t & 1; const LAS bf16_t* kp = (const LAS bf16_t*)(kbl + (kr * 64 + 4 * ch) * 144);
            f32x4 acc = (f32x4){0.f, 0.f, 0.f, 0.f};
#pragma unroll
            for (int ks = 0; ks < 2; ++ks) acc = mfma16(*(const LAS bf16x8*)(kp + ks * 32), qf[ks], acc);
            const int dr = r0 + kr - i + 7;
#pragma unroll
            for (int j = 0; j < 4; ++j) { const int kc = scol + 8 * q + 4 * ch + j; const bool valid = kc >= c0 && kc < c0 + 16; const int dc = min(max(kc - qc + 15, 0), 30);
                const float bias = rp[dr * 31 + dc]; const float sv = valid ? acc[j] + bias : -1.0e30f; acc[j] = sv; mx1 = fmaxf(mx1, sv); }
            sl[t] = acc; if ((t & 3) == 3) __builtin_amdgcn_sched_barrier(0); }
        mx1 = fmaxf(mx1, NA_SHX(mx1, 16)); mx1 = fmaxf(mx1, NA_SHX(mx1, 32));
#pragma unroll
        for (int kr = 0; kr < 8; ++kr) { float e[8];
#pragma unroll
            for (int j = 0; j < 4; ++j) { e[j] = __expf(sl[2 * kr][j] - mx1); e[4 + j] = __expf(sl[2 * kr + 1][j] - mx1); }
#pragma unroll
            for (int j = 0; j < 8; ++j) sum1 += e[j];
            const uint4 pw = pack8(e); pl[kr] = __builtin_bit_cast(bf16x8, pw); }
        __builtin_amdgcn_sched_barrier(0); }
    { f32x4 sc[16];
#pragma unroll
      for (int t = 0; t < 16; ++t) { const LAS bf16_t* kp = (const LAS bf16_t*)(kbc + ((t >> 1) * 32 + 4 * (t & 1)) * 144);
          f32x4 acc = (f32x4){0.f, 0.f, 0.f, 0.f};
#pragma unroll
          for (int ks = 0; ks < 2; ++ks) acc = mfma16(*(const LAS bf16x8*)(kp + ks * 32), qf[ks], acc);
#pragma unroll
          for (int j = 0; j < 4; ++j) mx2 = fmaxf(mx2, acc[j]);
          sc[t] = acc; if ((t & 3) == 3) __builtin_amdgcn_sched_barrier(0); }
      mx2 = fmaxf(mx2, NA_SHX(mx2, 16)); mx2 = fmaxf(mx2, NA_SHX(mx2, 32));
#pragma unroll
      for (int t2 = 0; t2 < 8; ++t2) { float e[8];
#pragma unroll
          for (int j = 0; j < 4; ++j) { e[j] = __expf(sc[2 * t2][j] - mx2); e[4 + j] = __expf(sc[2 * t2 + 1][j] - mx2); }
#pragma unroll
          for (int j = 0; j < 8; ++j) sum2 += e[j];
          const uint4 pw = pack8(e); pcx[t2] = __builtin_bit_cast(bf16x8, pw); } }
    sum1 += NA_SHX(sum1, 16); sum1 += NA_SHX(sum1, 32); sum2 += NA_SHX(sum2, 16); sum2 += NA_SHX(sum2, 32);
    __builtin_amdgcn_sched_barrier(0);
    __syncthreads();
    int tv = threadIdx.x; asm volatile("" : "+v"(tv));
    __builtin_amdgcn_sched_barrier(0);
    if (HASLAT) {
#pragma unroll
        for (int j = 0; j < 9; ++j) { const int idx = tv + NTHR * j, dim = idx / 72, pc = idx % 72, tok = rlo * 64 + pc * 8;
            if (tok < 2048) *(LAS lu4*)(Vs + dim * 840 + pc * 8) = *(const lu4*)(VTL + (size_t)dim * 2048 + tok); } }
#pragma unroll
    for (int j = 0; j < 4; ++j) { const int idx = tv + NTHR * j, dim = idx >> 5, pc = idx & 31; *(LAS lu4*)(Vs + dim * 840 + 576 + pc * 8) = *(const lu4*)(VTC + (size_t)dim * 256 + pc * 8); }
    __builtin_amdgcn_sched_barrier(0);
    __syncthreads();
    __builtin_amdgcn_sched_barrier(0);
    const int kbv = kb * 2;
    LAS unsigned char* vb0 = (LAS unsigned char*)(Vs + (0 * 16 + m) * 840 + q * 8); LAS unsigned char* vb1 = (LAS unsigned char*)(Vs + (1 * 16 + m) * 840 + q * 8);
    LAS unsigned char* vb2 = (LAS unsigned char*)(Vs + (2 * 16 + m) * 840 + q * 8); LAS unsigned char* vb3 = (LAS unsigned char*)(Vs + (3 * 16 + m) * 840 + q * 8);
    asm volatile("" : "+v"(vb0), "+v"(vb1), "+v"(vb2), "+v"(vb3));
    f32x4 o1[4], o2[4];
#pragma unroll
    for (int dt = 0; dt < 4; ++dt) { o1[dt] = (f32x4){0.f, 0.f, 0.f, 0.f}; o2[dt] = (f32x4){0.f, 0.f, 0.f, 0.f}; }
    if (HASLAT) {
#pragma unroll
        for (int kr = 0; kr < 8; ++kr) {
#pragma unroll
            for (int dt = 0; dt < 4; ++dt) { LAS unsigned char* vb = dt == 0 ? vb0 : dt == 1 ? vb1 : dt == 2 ? vb2 : vb3; o1[dt] = mfma16(*(const LAS bf16x8*)(vb + kbv + kr * 128), pl[kr], o1[dt]); }
            if (kr & 1) __builtin_amdgcn_sched_barrier(0); } }
#pragma unroll
    for (int t2 = 0; t2 < 8; ++t2) {
#pragma unroll
        for (int dt = 0; dt < 4; ++dt) { LAS unsigned char* vb = dt == 0 ? vb0 : dt == 1 ? vb1 : dt == 2 ? vb2 : vb3; o2[dt] = mfma16(*(const LAS bf16x8*)(vb + 1152 + t2 * 64), pcx[t2], o2[dt]); }
        if (t2 & 1) __builtin_amdgcn_sched_barrier(0); }
    const float mxm = fmaxf(mx1, mx2), a1 = HASLAT ? __expf(mx1 - mxm) : 0.f, a2 = __expf(mx2 - mxm), inv = 1.0f / (a1 * sum1 + a2 * sum2), c1 = a1 * inv, c2 = a2 * inv;
    bf16_t* yo = (bf16_t*)(p.ws + WS_ABUF) + (size_t)qrow * 1024 + 256 + h * 64 + q * 4;
#pragma unroll
    for (int dt = 0; dt < 4; ++dt) { u32x2 wv2; wv2.x = pack2(o1[dt][0] * c1 + o2[dt][0] * c2, o1[dt][1] * c1 + o2[dt][1] * c2); wv2.y = pack2(o1[dt][2] * c1 + o2[dt][2] * c2, o1[dt][3] * c1 + o2[dt][3] * c2); *(u32x2*)(yo + dt * 16) = wv2; }
}
#undef NA_SHX
__device__ __forceinline__ void na_items(const Params& p, int l, int wid, int nw, LAS unsigned char* lds) {
    (void)wid; (void)nw;
    const int nlat = 16 * 6 * 16, nctx = (l == 0) ? 16 * 6 * 2 : 0;
    for (int it = blockIdx.x; it < nlat + nctx; it += gridDim.x) {
        if (it < nlat) { const int ip = it & 15, bh = it >> 4; na_block<true>(p, l, bh / 6, bh % 6, ip, lds); }
        else { const int j = it - nlat, half = j & 1, bh = j >> 1; na_block<false>(p, l, bh / 6, bh % 6, half, lds); }
    }
    __syncthreads();
}

typedef float f32x2 __attribute__((ext_vector_type(2)));
__device__ __forceinline__ int rk_row(int b, int d, int n) { return n < 256 ? NLAT + b * 256 + (d ? 255 - n : n) : b * 2048 + (d ? 2047 - (n - 256) : (n - 256)); }
template <int CTRL> __device__ __forceinline__ float dpp_f(float v) { return __builtin_bit_cast(float, __builtin_amdgcn_update_dpp(0, __builtin_bit_cast(int, v), CTRL, 0xF, 0xF, true)); }
constexpr int RKP_WAVE = 4 * 16 * 17 * 4;
__device__ __forceinline__ bf16x8 pack_frag(const float (&lo)[4], const float (&hi)[4]) { u32x4 w; w.x = pack2(lo[0], lo[1]); w.y = pack2(lo[2], lo[3]); w.z = pack2(hi[0], hi[1]); w.w = pack2(hi[2], hi[3]); return __builtin_bit_cast(bf16x8, w); }
__device__ __forceinline__ bf16x8 pack_lo(const f32x4 v) { u32x4 w; w.x = pack2(v[0], v[1]); w.y = pack2(v[2], v[3]); w.z = 0u; w.w = 0u; return __builtin_bit_cast(bf16x8, w); }
__device__ __forceinline__ void rwkv_pre_items(const Params& p, int l, int wid, int nw, LAS unsigned char* lds) {
    const int lane = threadIdx.x & 63, m = lane & 15, q = lane >> 4, wv = threadIdx.x >> 6;
    LAS float* sM = (LAS float*)(lds + wv * RKP_WAVE);
    const bf16_t* RS = (const bf16_t*)(p.ws + U_RS); const bf16_t* KS = (const bf16_t*)(p.ws + U_KS); const bf16_t* VS = (const bf16_t*)(p.ws + U_VS); const bf16_t* KK = (const bf16_t*)(p.ws + U_KK);
    bf16x8 isel[2], idg;
    { const unsigned one = 0x3F80u << ((m & 1) * 16); const int wi = (m & 7) >> 1;
#pragma unroll
      for (int s2 = 0; s2 < 2; ++s2) { const unsigned v = (q == 2 * s2 + (m >> 3)) ? one : 0u; const u32x4 w = {wi == 0 ? v : 0u, wi == 1 ? v : 0u, wi == 2 ? v : 0u, wi == 3 ? v : 0u}; isel[s2] = __builtin_bit_cast(bf16x8, w); }
      const int jp = m & 3; const unsigned dv = (q == (m >> 2)) ? (0x3F80u << ((jp & 1) * 16)) : 0u; const u32x4 w = {0u, 0u, (jp >> 1) == 0 ? dv : 0u, (jp >> 1) == 1 ? dv : 0u}; idg = __builtin_bit_cast(bf16x8, w); }
    const f32x4 z4 = {0.f, 0.f, 0.f, 0.f};
    for (int it = wid; it < NCHUNK; it += nw) { const int u = it / 144, c = it % 144, b = u / 12, h = (u % 12) >> 1, d = u & 1;
        const bf16_t* AG = (const bf16_t*)(p.ws + U_AG + (size_t)d * SZ384); const bf16_t* LD = (const bf16_t*)(p.ws + U_LD + (size_t)d * SZ384);
        const int rb = rk_row(b, d, c * 16), sgn = d ? -1 : 1;
        const size_t ro = (size_t)(rb + sgn * m) * 384 + h * 64 + 8 * q;
        u32x4 raw[6][2]; float4 kaf[4];
#pragma unroll
        for (int ks = 0; ks < 2; ++ks) { raw[0][ks] = *(const u32x4*)(KK + ro + 32 * ks); raw[1][ks] = *(const u32x4*)(AG + ro + 32 * ks); raw[2][ks] = *(const u32x4*)(KS + ro + 32 * ks);
            raw[3][ks] = *(const u32x4*)(RS + ro + 32 * ks); raw[4][ks] = *(const u32x4*)(VS + ro + 32 * ks); raw[5][ks] = *(const u32x4*)(LD + ro + 32 * ks);
            kaf[2 * ks] = *(const float4*)(p.in[27] + l * 384 + h * 64 + 32 * ks + 8 * q); kaf[2 * ks + 1] = *(const float4*)(p.in[27] + l * 384 + h * 64 + 32 * ks + 8 * q + 4); }
        __builtin_amdgcn_sched_barrier(0);
        bf16x8 atf[2], rtf[2], bhf[2], khf[2], vf[2];
#pragma unroll
        for (int ks = 0; ks < 2; ++ks) { float at[8], bh[8], kh[8], rt[8], lk[8];
            const float ka[8] = {kaf[2 * ks].x, kaf[2 * ks].y, kaf[2 * ks].z, kaf[2 * ks].w, kaf[2 * ks + 1].x, kaf[2 * ks + 1].y, kaf[2 * ks + 1].z, kaf[2 * ks + 1].w};
#pragma unroll
            for (int w = 0; w < 4; ++w)
#pragma unroll
                for (int hh = 0; hh < 2; ++hh) { const int i = 2 * w + hh;
                    const float kk_ = hh ? bfhi(raw[0][ks][w]) : bflo(raw[0][ks][w]), ag_ = hh ? bfhi(raw[1][ks][w]) : bflo(raw[1][ks][w]), k_ = hh ? bfhi(raw[2][ks][w]) : bflo(raw[2][ks][w]);
                    const float r_ = hh ? bfhi(raw[3][ks][w]) : bflo(raw[3][ks][w]), ld2 = (hh ? bfhi(raw[5][ks][w]) : bflo(raw[5][ks][w])) * 1.4426950408889634f;
                    float L = ld2; L += dpp_f<0x111>(L); L += dpp_f<0x112>(L); L += dpp_f<0x114>(L); L += dpp_f<0x118>(L);
                    const float e1 = __builtin_amdgcn_exp2f(L), ei = __builtin_amdgcn_exp2f(-L), e0 = __builtin_amdgcn_exp2f(L - ld2);
                    at[i] = -kk_ * e0; bh[i] = kk_ * ag_ * ei; kh[i] = k_ * (1.0f + (ag_ - 1.0f) * ka[i]) * ei; rt[i] = r_ * e1; lk[i] = L * 0.6931471805599453f; }
            { const u32x4 w0 = {pack2(at[0], at[1]), pack2(at[2], at[3]), pack2(at[4], at[5]), pack2(at[6], at[7])}; atf[ks] = __builtin_bit_cast(bf16x8, w0);
              const u32x4 w1 = {pack2(bh[0], bh[1]), pack2(bh[2], bh[3]), pack2(bh[4], bh[5]), pack2(bh[6], bh[7])}; bhf[ks] = __builtin_bit_cast(bf16x8, w1);
              const u32x4 w2 = {pack2(kh[0], kh[1]), pack2(kh[2], kh[3]), pack2(kh[4], kh[5]), pack2(kh[6], kh[7])}; khf[ks] = __builtin_bit_cast(bf16x8, w2);
              const u32x4 w3 = {pack2(rt[0], rt[1]), pack2(rt[2], rt[3]), pack2(rt[4], rt[5]), pack2(rt[6], rt[7])}; rtf[ks] = __builtin_bit_cast(bf16x8, w3);
              vf[ks] = __builtin_bit_cast(bf16x8, raw[4][ks]);
              if (m == 15) { const u32x4 wl = {pack2(lk[0], lk[1]), pack2(lk[2], lk[3]), pack2(lk[4], lk[5]), pack2(lk[6], lk[7])};
                  *(u32x4*)((bf16_t*)(p.ws + CH_GT) + (size_t)it * 64 + 32 * ks + 8 * q) = wl; } } }
        { f32x4 mab = z4, mak = z4, mrb = z4, mrk = z4;
#pragma unroll
          for (int ks = 0; ks < 2; ++ks) { mab = mfma16(atf[ks], bhf[ks], mab); mak = mfma16(atf[ks], khf[ks], mak); mrb = mfma16(rtf[ks], bhf[ks], mrb); mrk = mfma16(rtf[ks], khf[ks], mrk); }
#pragma unroll
          for (int r = 0; r < 4; ++r) { const int t = 4 * q + r; sM[(0 * 16 + t) * 17 + m] = m < t ? mab[r] : 0.f; sM[(1 * 16 + t) * 17 + m] = m < t ? mak[r] : 0.f;
              sM[(2 * 16 + t) * 17 + m] = m <= t ? mrb[r] : 0.f; sM[(3 * 16 + t) * 17 + m] = m <= t ? mrk[r] : 0.f; } }
        { float tv[16];
#pragma unroll
          for (int t = 0; t < 16; ++t) { float acc = (m == t) ? 1.0f : 0.0f;
#pragma unroll
              for (int s2 = 0; s2 < t; ++s2) acc += sM[t * 17 + s2] * tv[s2];
              tv[t] = acc; }
#pragma unroll
          for (int t = 0; t < 16; ++t) if (q == 0) sM[t * 17 + m] = tv[t]; }
        bf16x8 tinvf, mrbf, makf;
        { float lo[4], hi[4] = {0.f, 0.f, 0.f, 0.f};
#pragma unroll
          for (int j = 0; j < 4; ++j) lo[j] = sM[(0 * 16 + m) * 17 + 4 * q + j];
          tinvf = pack_frag(lo, hi);
#pragma unroll
          for (int j = 0; j < 4; ++j) lo[j] = sM[(1 * 16 + m) * 17 + 4 * q + j];
          makf = pack_frag(lo, hi);
#pragma unroll
          for (int j = 0; j < 4; ++j) lo[j] = sM[(2 * 16 + m) * 17 + 4 * q + j];
          mrbf = pack_frag(lo, hi);
#pragma unroll
          for (int j = 0; j < 4; ++j) hi[j] = sM[(3 * 16 + m) * 17 + 4 * q + j];
          *(bf16x8*)((bf16_t*)(p.ws + CH_MM) + ((size_t)it * 64 + lane) * 8) = pack_frag(lo, hi); }
#pragma unroll
        for (int itile = 0; itile < 4; ++itile) { const f32x4 vt = mfma16(vf[itile >> 1], isel[itile & 1], z4);
            const f32x4 w1 = mfma16(makf, pack_lo(vt), z4);
            const f32x4 uu = mfma16(tinvf, pack_lo(w1), z4);
            u32x2 o; o.x = pack2(uu[0], uu[1]); o.y = pack2(uu[2], uu[3]);
            *(u32x2*)((bf16_t*)(p.ws + CH_UL) + (((size_t)it * 4 + itile) * 64 + lane) * 4) = o; }
        const u32x4 mrbw = __builtin_bit_cast(u32x4, mrbf), idgw = __builtin_bit_cast(u32x4, idg); const u32x4 rpbw = {mrbw.x, mrbw.y, idgw.z, idgw.w}; const bf16x8 rpb = __builtin_bit_cast(bf16x8, rpbw);
        u32x2 xa = {0u, 0u}, xr = {0u, 0u};
#pragma unroll
        for (int jt = 0; jt < 4; ++jt) { const int ks = jt >> 1;
            const bf16x8 att = pack_lo(mfma16(atf[ks], isel[jt & 1], z4));
            const f32x4 ap = mfma16(tinvf, att, z4);
            const f32x4 apT = mfma16(att, tinvf, z4);
            const f32x4 rtt = mfma16(rtf[ks], isel[jt & 1], z4);
            u32x4 aw = __builtin_bit_cast(u32x4, pack_lo(ap)); aw.z = pack2(rtt[0], rtt[1]); aw.w = pack2(rtt[2], rtt[3]);
            const f32x4 rpT = mfma16(__builtin_bit_cast(bf16x8, aw), rpb, z4);
            const f32x4 bht = mfma16(bhf[ks], isel[jt & 1], z4), kht = mfma16(khf[ks], isel[jt & 1], z4);
            { u32x4 w; w.x = pack2(bht[0], bht[1]); w.y = pack2(bht[2], bht[3]); w.z = pack2(kht[0], kht[1]); w.w = pack2(kht[2], kht[3]);
              *(u32x4*)((bf16_t*)(p.ws + CH_BK) + (((size_t)it * 4 + jt) * 64 + lane) * 8) = w; }
            if ((jt & 1) == 0) { xa.x = pack2(apT[0], apT[1]); xa.y = pack2(apT[2], apT[3]); xr.x = pack2(rpT[0], rpT[1]); xr.y = pack2(rpT[2], rpT[3]); }
            else { const u32x4 wa = {xa.x, xa.y, pack2(apT[0], apT[1]), pack2(apT[2], apT[3])}, wr2 = {xr.x, xr.y, pack2(rpT[0], rpT[1]), pack2(rpT[2], rpT[3])};
                *(u32x4*)((bf16_t*)(p.ws + CH_XP) + ((((size_t)it * 2 + 0) * 2 + ks) * 64 + lane) * 8) = wa;
                *(u32x4*)((bf16_t*)(p.ws + CH_XP) + ((((size_t)it * 2 + 1) * 2 + ks) * 64 + lane) * 8) = wr2; } }
    }
}
__device__ __forceinline__ void rwkv_seq_task(const Params& p, int l, int task, LAS unsigned char* lds) {
    const int lane = threadIdx.x & 63, m = lane & 15, q = lane >> 4;
    const int u = task >> 2, iw = task & 3, b = u / 12, h = (u % 12) >> 1, d = u & 1, sgn = d ? -1 : 1;
    const bf16_t* XP = (const bf16_t*)(p.ws + CH_XP); const bf16_t* BK = (const bf16_t*)(p.ws + CH_BK); const bf16_t* UL = (const bf16_t*)(p.ws + CH_UL); const bf16_t* MM = (const bf16_t*)(p.ws + CH_MM);
    const bf16_t* GT = (const bf16_t*)(p.ws + CH_GT); const bf16_t* VS = (const bf16_t*)(p.ws + U_VS) + h * 64 + 16 * iw;
    float* Yw = (float*)(p.ws + U_YRK) + (size_t)d * NROW * 384 + h * 64 + 16 * iw;
    LAS float* ybuf = (LAS float*)(lds + (threadIdx.x >> 6) * 12288);
    const int rc0 = NLAT + b * 256 + (d ? 255 : 0) + sgn * 4 * q, rdel = (b * 2048 + (d ? 2047 : 0)) - (NLAT + b * 256 + (d ? 255 : 0)) - sgn * 256;
    f32x4 acc[4];
#pragma unroll
    for (int jt = 0; jt < 4; ++jt) acc[jt] = (f32x4){0.f, 0.f, 0.f, 0.f};
    const unsigned vo16 = (unsigned)lane * 16u, vo8 = (unsigned)lane * 8u, vo8q = (unsigned)q * 8u;
    struct OpSet { u32x4 apf0, apf1, rpf0, rpf1, bkf0, bkf1, bkf2, bkf3, mmf; u32x2 gl0, gl1, gl2, gl3, uw; unsigned vr0, vr1, vr2, vr3; };
#define GLDS16(dst, voff, sbase, imm) asm volatile("global_load_dwordx4 %0, %1, %2 offset:" #imm : "=&v"(dst) : "v"(voff), "s"(sbase) : "memory")
#define GLDS8(dst, voff, sbase, imm) asm volatile("global_load_dwordx2 %0, %1, %2 offset:" #imm : "=&v"(dst) : "v"(voff), "s"(sbase) : "memory")
#define GLDS2(dst, voff, sbase) asm volatile("global_load_ushort %0, %1, %2" : "=&v"(dst) : "v"(voff), "s"(sbase) : "memory")
#define RKS_LOAD(X, c_) do { const size_t it_ = (size_t)u * 144 + (c_); const int rb_ = rc0 + sgn * 16 * (c_) + (int)((c_) >= 16) * rdel; \
        const bf16_t* xpb = XP + it_ * 2048; const bf16_t* bkb = BK + it_ * 2048; const bf16_t* mmb = MM + it_ * 512; const bf16_t* gtb = GT + it_ * 64; const bf16_t* ulb = UL + (it_ * 4 + iw) * 256; \
        GLDS16(X.apf0, vo16, xpb, 0); GLDS16(X.apf1, vo16, xpb, 1024); GLDS16(X.rpf0, vo16, xpb, 2048); GLDS16(X.rpf1, vo16, xpb, 3072); \
        GLDS16(X.bkf0, vo16, bkb, 0); GLDS16(X.bkf1, vo16, bkb, 1024); GLDS16(X.bkf2, vo16, bkb, 2048); GLDS16(X.bkf3, vo16, bkb, 3072); \
        GLDS8(X.gl0, vo8q, gtb, 0); GLDS8(X.gl1, vo8q, gtb, 32); GLDS8(X.gl2, vo8q, gtb, 64); GLDS8(X.gl3, vo8q, gtb, 96); \
        GLDS16(X.mmf, vo16, mmb, 0); GLDS8(X.uw, vo8, ulb, 0); \
        { const unsigned v0_ = (unsigned)(rb_) * 768u + 2u * m, v1_ = (unsigned)(rb_ + sgn) * 768u + 2u * m, v2_ = (unsigned)(rb_ + 2 * sgn) * 768u + 2u * m, v3_ = (unsigned)(rb_ + 3 * sgn) * 768u + 2u * m; \
          GLDS2(X.vr0, v0_, VS); GLDS2(X.vr1, v1_, VS); GLDS2(X.vr2, v2_, VS); GLDS2(X.vr3, v3_, VS); } } while (0)
#define RKS_WAIT(X) asm volatile("s_waitcnt vmcnt(36)" : "+v"(X.apf0), "+v"(X.apf1), "+v"(X.rpf0), "+v"(X.rpf1), "+v"(X.bkf0), "+v"(X.bkf1), "+v"(X.bkf2), "+v"(X.bkf3), "+v"(X.mmf), \
        "+v"(X.gl0), "+v"(X.gl1), "+v"(X.gl2), "+v"(X.gl3), "+v"(X.uw), "+v"(X.vr0), "+v"(X.vr1), "+v"(X.vr2), "+v"(X.vr3) :: "memory")
#define BF8(x) __builtin_bit_cast(bf16x8, x)
#define RKS_COMPUTE(X, c_) do { RKS_WAIT(X); \
        const float ul[4] = {bflo(X.uw.x), bfhi(X.uw.x), bflo(X.uw.y), bfhi(X.uw.y)}; const float vl[4] = {bflo(X.vr0), bflo(X.vr1), bflo(X.vr2), bflo(X.vr3)}; \
        f32x4 zp = (f32x4){0.f, 0.f, 0.f, 0.f}, yp = zp; \
        { const float lo[4] = {acc[0][0], acc[0][1], acc[0][2], acc[0][3]}, hi[4] = {acc[1][0], acc[1][1], acc[1][2], acc[1][3]}; const bf16x8 sf = pack_frag(lo, hi); zp = mfma16(BF8(X.apf0), sf, zp); yp = mfma16(BF8(X.rpf0), sf, yp); } \
        { const float lo[4] = {acc[2][0], acc[2][1], acc[2][2], acc[2][3]}, hi[4] = {acc[3][0], acc[3][1], acc[3][2], acc[3][3]}; const bf16x8 sf = pack_frag(lo, hi); zp = mfma16(BF8(X.apf1), sf, zp); yp = mfma16(BF8(X.rpf1), sf, yp); } \
        const float z[4] = {zp[0] + ul[0], zp[1] + ul[1], zp[2] + ul[2], zp[3] + ul[3]}; \
        yp = mfma16(BF8(X.mmf), pack_frag(ul, vl), yp); \
        const bf16x8 zvf = pack_frag(z, vl); \
        acc[0] = mfma16(BF8(X.bkf0), zvf, acc[0]); acc[1] = mfma16(BF8(X.bkf1), zvf, acc[1]); acc[2] = mfma16(BF8(X.bkf2), zvf, acc[2]); acc[3] = mfma16(BF8(X.bkf3), zvf, acc[3]); \
        { const f32x4 g4 = {__expf(bflo(X.gl0.x)), __expf(bfhi(X.gl0.x)), __expf(bflo(X.gl0.y)), __expf(bfhi(X.gl0.y))}; acc[0] *= g4; } \
        { const f32x4 g4 = {__expf(bflo(X.gl1.x)), __expf(bfhi(X.gl1.x)), __expf(bflo(X.gl1.y)), __expf(bfhi(X.gl1.y))}; acc[1] *= g4; } \
        { const f32x4 g4 = {__expf(bflo(X.gl2.x)), __expf(bfhi(X.gl2.x)), __expf(bflo(X.gl2.y)), __expf(bfhi(X.gl2.y))}; acc[2] *= g4; } \
        { const f32x4 g4 = {__expf(bflo(X.gl3.x)), __expf(bfhi(X.gl3.x)), __expf(bflo(X.gl3.y)), __expf(bfhi(X.gl3.y))}; acc[3] *= g4; } \
        _Pragma("unroll") for (int r = 0; r < 4; ++r) ybuf[((((c_) % 12) * 16) + 4 * q + r) * 16 + m] = yp[r]; } while (0)
    asm volatile("; SEQ_BEGIN");
    OpSet A, B, C;
    RKS_LOAD(A, 0); RKS_LOAD(B, 1);
    for (int c0 = 0; c0 < 144; c0 += 12) {
#pragma unroll
        for (int cc = 0; cc < 12; cc += 3) { const int c = c0 + cc;
            RKS_LOAD(C, c + 2); __builtin_amdgcn_sched_barrier(0);
            RKS_COMPUTE(A, c); __builtin_amdgcn_sched_barrier(0);
            { const int cn = c + 3 < 144 ? c + 3 : 143; RKS_LOAD(A, cn); } __builtin_amdgcn_sched_barrier(0);
            RKS_COMPUTE(B, c + 1); __builtin_amdgcn_sched_barrier(0);
            { const int cn = c + 4 < 144 ? c + 4 : 143; RKS_LOAD(B, cn); } __builtin_amdgcn_sched_barrier(0);
            RKS_COMPUTE(C, c + 2); __builtin_amdgcn_sched_barrier(0); }
#pragma unroll
        for (int k = 0; k < 12; ++k) { const int rr = (lane >> 2) + 16 * k, n = c0 * 16 + rr; const int grow = (rc0 - sgn * 4 * q) + sgn * n + (int)(n >= 256) * rdel;
            *(f32x4*)(Yw + (size_t)grow * 384 + (lane & 3) * 4) = *(const LAS f32x4*)(ybuf + rr * 16 + (lane & 3) * 4); }
    }
    asm volatile("; SEQ_END");
#undef RKS_LOAD
#undef RKS_COMPUTE
#undef RKS_WAIT
#undef GLDS16
#undef GLDS8
#undef GLDS2
#undef BF8
}

__device__ __forceinline__ void rwkv_seq_block(const Params& p, int l, int u, LAS unsigned char* lds) {
    (void)l;
    const int tid = threadIdx.x, lane = tid & 63, wv = __builtin_amdgcn_readfirstlane(tid >> 6), m = lane & 15, q = lane >> 4;
    const int b = u / 12, h = (u % 12) >> 1, d = u & 1, sgn = d ? -1 : 1;
    const unsigned char* XPb = p.ws + CH_XP + (size_t)u * 144 * 4096; const unsigned char* BKb = p.ws + CH_BK + (size_t)u * 144 * 4096;
    const unsigned char* MMb = p.ws + CH_MM + (size_t)u * 144 * 1024; const unsigned char* GTb = p.ws + CH_GT + (size_t)u * 144 * 128;
    LAS unsigned char* ring = lds + 49152;
#define SEQ_BAR() asm volatile("s_waitcnt lgkmcnt(0)\n\ts_barrier" ::: "memory")
    __syncthreads();
    if (wv >= 4) {
        const int lw = wv - 4; const bool hasmm = lw == 0, hasgt = (lw == 1) && lane < 8;
        lu4 xp[3], bk[3], mm[3], gt[3];
#define LDR_LOAD(k, c_) do { const int cc_ = (c_) < 144 ? (c_) : 143; xp[k] = *(const lu4*)(XPb + (size_t)cc_ * 4096 + lw * 1024 + lane * 16); bk[k] = *(const lu4*)(BKb + (size_t)cc_ * 4096 + lw * 1024 + lane * 16); \
            if (hasmm) mm[k] = *(const lu4*)(MMb + (size_t)cc_ * 1024 + lane * 16); if (hasgt) gt[k] = *(const lu4*)(GTb + (size_t)cc_ * 128 + lane * 16); } while (0)
#define LDR_STORE(k, c_) do { if ((c_) < 144) { LAS unsigned char* sl_ = ring + ((c_) % 3) * 9728; *(LAS lu4*)(sl_ + lw * 1024 + lane * 16) = xp[k]; *(LAS lu4*)(sl_ + 4096 + lw * 1024 + lane * 16) = bk[k]; \
            if (hasmm) *(LAS lu4*)(sl_ + 8192 + lane * 16) = mm[k]; if (hasgt) *(LAS lu4*)(sl_ + 9216 + lane * 16) = gt[k]; } } while (0)
        LDR_LOAD(0, 0); LDR_LOAD(1, 1); LDR_LOAD(2, 2);
        LDR_STORE(0, 0); LDR_LOAD(0, 3); LDR_STORE(1, 1); LDR_LOAD(1, 4);
        SEQ_BAR();
        for (int i0 = 0; i0 < 144; i0 += 3) {
            LDR_STORE(2, i0 + 2); LDR_LOAD(2, i0 + 5); SEQ_BAR();
            LDR_STORE(0, i0 + 3); LDR_LOAD(0, i0 + 6); SEQ_BAR();
            LDR_STORE(1, i0 + 4); LDR_LOAD(1, i0 + 7); SEQ_BAR(); }
#undef LDR_LOAD
#undef LDR_STORE
    } else {
        const int iw = wv;
        const bf16_t* UL = (const bf16_t*)(p.ws + CH_UL) + (size_t)u * 144 * 1024; const bf16_t* VS = (const bf16_t*)(p.ws + U_VS) + h * 64 + 16 * iw;
        float* Yw = (float*)(p.ws + U_YRK) + (size_t)d * NROW * 384 + h * 64 + 16 * iw;
        LAS float* ybuf = (LAS float*)(lds + wv * 12288);
        const int rc0 = NLAT + b * 256 + (d ? 255 : 0) + sgn * 4 * q, rdel = (b * 2048 + (d ? 2047 : 0)) - (NLAT + b * 256 + (d ? 255 : 0)) - sgn * 256;
        const unsigned vo8 = (unsigned)lane * 8u;
        f32x4 acc[4];
#pragma unroll
        for (int jt = 0; jt < 4; ++jt) acc[jt] = (f32x4){0.f, 0.f, 0.f, 0.f};
        struct Shared { bf16x8 apf0, apf1, rpf0, rpf1, bkf0, bkf1, bkf2, bkf3, mmf; u32x2 gl0, gl1, gl2, gl3; };
        struct Own { u32x2 uw; unsigned vr0, vr1, vr2, vr3; };
#define GLDS8(dst, voff, sbase) asm volatile("global_load_dwordx2 %0, %1, %2" : "=&v"(dst) : "v"(voff), "s"(sbase) : "memory")
#define GLDS2(dst, voff, sbase) asm volatile("global_load_ushort %0, %1, %2" : "=&v"(dst) : "v"(voff), "s"(sbase) : "memory")
#define OWN_LOAD(X, c_) do { const int cc_ = (c_) < 144 ? (c_) : 143; const int rb_ = rc0 + sgn * 16 * cc_ + (int)(cc_ >= 16) * rdel; const bf16_t* ulb = UL + ((size_t)cc_ * 4 + iw) * 256; \
            GLDS8(X.uw, vo8, ulb); const unsigned v0_ = (unsigned)(rb_) * 768u + 2u * m, v1_ = (unsigned)(rb_ + sgn) * 768u + 2u * m, v2_ = (unsigned)(rb_ + 2 * sgn) * 768u + 2u * m, v3_ = (unsigned)(rb_ + 3 * sgn) * 768u + 2u * m; \
            GLDS2(X.vr0, v0_, VS); GLDS2(X.vr1, v1_, VS); GLDS2(X.vr2, v2_, VS); GLDS2(X.vr3, v3_, VS); } while (0)
#define OWN_WAIT(X) asm volatile("s_waitcnt vmcnt(10)" : "+v"(X.uw), "+v"(X.vr0), "+v"(X.vr1), "+v"(X.vr2), "+v"(X.vr3) :: "memory")
#define SH_READ(S, c_) do { const int cc_ = (c_) < 144 ? (c_) : 143; const LAS unsigned char* sl_ = ring + (cc_ % 3) * 9728 + lane * 16; \
            S.apf0 = *(const LAS bf16x8*)(sl_); S.apf1 = *(const LAS bf16x8*)(sl_ + 1024); S.rpf0 = *(const LAS bf16x8*)(sl_ + 2048); S.rpf1 = *(const LAS bf16x8*)(sl_ + 3072); \
            S.bkf0 = *(const LAS bf16x8*)(sl_ + 4096); S.bkf1 = *(const LAS bf16x8*)(sl_ + 5120); S.bkf2 = *(const LAS bf16x8*)(sl_ + 6144); S.bkf3 = *(const LAS bf16x8*)(sl_ + 7168); S.mmf = *(const LAS bf16x8*)(sl_ + 8192); \
            const LAS unsigned char* gp_ = ring + (cc_ % 3) * 9728 + 9216 + q * 8; S.gl0 = *(const LAS u32x2*)(gp_); S.gl1 = *(const LAS u32x2*)(gp_ + 32); S.gl2 = *(const LAS u32x2*)(gp_ + 64); S.gl3 = *(const LAS u32x2*)(gp_ + 96); } while (0)
#define SEQ_COMPUTE(S, X, c_) do { OWN_WAIT(X); \
            const float ul[4] = {bflo(X.uw.x), bfhi(X.uw.x), bflo(X.uw.y), bfhi(X.uw.y)}; const float vl[4] = {bflo(X.vr0), bflo(X.vr1), bflo(X.vr2), bflo(X.vr3)}; \
            f32x4 zp = (f32x4){0.f, 0.f, 0.f, 0.f}, yp = zp; \
            { const float lo[4] = {acc[0][0], acc[0][1], acc[0][2], acc[0][3]}, hi[4] = {acc[1][0], acc[1][1], acc[1][2], acc[1][3]}; const bf16x8 sf = pack_frag(lo, hi); zp = mfma16(S.apf0, sf, zp); yp = mfma16(S.rpf0, sf, yp); } \
            { const float lo[4] = {acc[2][0], acc[2][1], acc[2][2], acc[2][3]}, hi[4] = {acc[3][0], acc[3][1], acc[3][2], acc[3][3]}; const bf16x8 sf = pack_frag(lo, hi); zp = mfma16(S.apf1, sf, zp); yp = mfma16(S.rpf1, sf, yp); } \
            const float z[4] = {zp[0] + ul[0], zp[1] + ul[1], zp[2] + ul[2], zp[3] + ul[3]}; \
            yp = mfma16(S.mmf, pack_frag(ul, vl), yp); \
            const bf16x8 zvf = pack_frag(z, vl); \
            acc[0] = mfma16(S.bkf0, zvf, acc[0]); acc[1] = mfma16(S.bkf1, zvf, acc[1]); acc[2] = mfma16(S.bkf2, zvf, acc[2]); acc[3] = mfma16(S.bkf3, zvf, acc[3]); \
            { const f32x4 g4 = {__expf(bflo(S.gl0.x)), __expf(bfhi(S.gl0.x)), __expf(bflo(S.gl0.y)), __expf(bfhi(S.gl0.y))}; acc[0] *= g4; } \
            { const f32x4 g4 = {__expf(bflo(S.gl1.x)), __expf(bfhi(S.gl1.x)), __expf(bflo(S.gl1.y)), __expf(bfhi(S.gl1.y))}; acc[1] *= g4; } \
            { const f32x4 g4 = {__expf(bflo(S.gl2.x)), __expf(bfhi(S.gl2.x)), __expf(bflo(S.gl2.y)), __expf(bfhi(S.gl2.y))}; acc[2] *= g4; } \
            { const f32x4 g4 = {__expf(bflo(S.gl3.x)), __expf(bfhi(S.gl3.x)), __expf(bflo(S.gl3.y)), __expf(bfhi(S.gl3.y))}; acc[3] *= g4; } \
            _Pragma("unroll") for (int r = 0; r < 4; ++r) ybuf[((((c_) % 12) * 16) + 4 * q + r) * 16 + m] = yp[r]; } while (0)
#define SEQ_STEP(SC, SN, XC, XN2, c_) do { SH_READ(SN, (c_) + 1); OWN_LOAD(XN2, (c_) + 2); __builtin_amdgcn_sched_barrier(0); SEQ_COMPUTE(SC, XC, c_); __builtin_amdgcn_sched_barrier(0); SEQ_BAR(); } while (0)
        Shared S0, S1; Own A, B, C;
        OWN_LOAD(A, 0); OWN_LOAD(B, 1);
        SEQ_BAR();
        SH_READ(S0, 0);
        for (int c0 = 0; c0 < 144; c0 += 12) {
#pragma unroll
            for (int cc = 0; cc < 12; cc += 6) { const int c = c0 + cc;
                SEQ_STEP(S0, S1, A, C, c); SEQ_STEP(S1, S0, B, A, c + 1); SEQ_STEP(S0, S1, C, B, c + 2);
                SEQ_STEP(S1, S0, A, C, c + 3); SEQ_STEP(S0, S1, B, A, c + 4); SEQ_STEP(S1, S0, C, B, c + 5); }
#pragma unroll
            for (int k = 0; k < 12; ++k) { const int rr = (lane >> 2) + 16 * k, n = c0 * 16 + rr; const int grow = (rc0 - sgn * 4 * q) + sgn * n + (int)(n >= 256) * rdel;
                *(f32x4*)(Yw + (size_t)grow * 384 + (lane & 3) * 4) = *(const LAS f32x4*)(ybuf + rr * 16 + (lane & 3) * 4); }
        }
#undef GLDS8
#undef GLDS2
#undef OWN_LOAD
#undef OWN_WAIT
#undef SH_READ
#undef SEQ_COMPUTE
#undef SEQ_STEP
    }
#undef SEQ_BAR
    __syncthreads();
}

__device__ __forceinline__ void rwkv_finish(const Params& p, int l) {
    const int sub = threadIdx.x & 7; const int npair = (l == 0 ? NROW : NLAT) * 6;
    const bf16_t* RS = (const bf16_t*)(p.ws + U_RS); const bf16_t* KS = (const bf16_t*)(p.ws + U_KS); const bf16_t* VS = (const bf16_t*)(p.ws + U_VS);
    const bf16_t* AG0 = (const bf16_t*)(p.ws + U_AG); const bf16_t* AG1 = (const bf16_t*)(p.ws + U_AG + SZ384); const bf16_t* G = (const bf16_t*)(p.ws + U_G);
    const float* Y0 = (const float*)(p.ws + U_YRK); const float* Y1 = Y0 + (size_t)NROW * 384; bf16_t* YC = (bf16_t*)(p.ws + WS_ABUF);
    for (int pr = (blockIdx.x * NTHR + threadIdx.x) >> 3; pr < npair; pr += (gridDim.x * NTHR) >> 3) { const int row = pr / 6, h = pr % 6, col = h * 64 + sub * 8; const size_t o = (size_t)row * 384 + col;
        float y[8]; { const float4 a0 = *(const float4*)(Y0 + o), a1 = *(const float4*)(Y0 + o + 4), c0 = *(const float4*)(Y1 + o), c1 = *(const float4*)(Y1 + o + 4);
            y[0] = a0.x + c0.x; y[1] = a0.y + c0.y; y[2] = a0.z + c0.z; y[3] = a0.w + c0.w; y[4] = a1.x + c1.x; y[5] = a1.y + c1.y; y[6] = a1.z + c1.z; y[7] = a1.w + c1.w; }
        float s = 0.f;
#pragma unroll
        for (int k = 0; k < 8; ++k) s += y[k];
        s += __shfl_xor(s, 1); s += __shfl_xor(s, 2); s += __shfl_xor(s, 4); const float mean = s * (1.0f / 64.0f);
        float v2 = 0.f;
#pragma unroll
        for (int k = 0; k < 8; ++k) { const float dd = y[k] - mean; v2 += dd * dd; }
        v2 += __shfl_xor(v2, 1); v2 += __shfl_xor(v2, 2); v2 += __shfl_xor(v2, 4); const float rstd = rsqrtf(v2 * (1.0f / 64.0f) + 64e-5f);
        float r[8], kx[8], vx[8], a0[8], a1[8], gx[8];
        unpack8(*(const uint4*)(RS + o), r); unpack8(*(const uint4*)(KS + o), kx); unpack8(*(const uint4*)(VS + o), vx); unpack8(*(const uint4*)(AG0 + o), a0); unpack8(*(const uint4*)(AG1 + o), a1); unpack8(*(const uint4*)(G + o), gx);
        const float* ka = p.in[27] + l * 384 + col; const float* rk = p.in[28] + l * 384 + col; const float* lw = p.in[29] + l * 384 + col; const float* lb = p.in[30] + l * 384 + col;
        float bs = 0.f;
#pragma unroll
        for (int k = 0; k < 8; ++k) { const float kd0 = kx[k] * (1.0f + (a0[k] - 1.0f) * ka[k]), kd1 = kx[k] * (1.0f + (a1[k] - 1.0f) * ka[k]); bs += r[k] * (kd0 + kd1) * rk[k]; }
        bs += __shfl_xor(bs, 1); bs += __shfl_xor(bs, 2); bs += __shfl_xor(bs, 4);
        float ov[8];
#pragma unroll
        for (int k = 0; k < 8; ++k) ov[k] = ((y[k] - mean) * rstd * lw[k] + lb[k] + bs * vx[k]) * gx[k];
        *(uint4*)(YC + (size_t)row * 1024 + 640 + col) = pack8(ov);
    }
}

__device__ __forceinline__ void phase_normrouter(const Params& p, int l, const float* xl, const float* xc, LAS unsigned char* lds) {
    LAS float* hrow = (LAS float*)lds;
    LAS float* part = (LAS float*)(lds + 65536);
    const int lane = threadIdx.x & 63, wv = threadIdx.x >> 6, e = lane & 15, cq = lane >> 4; const int ngrp = (l == 0 ? NROW : NLAT) / 16;
    const float* mod = (const float*)(p.ws + WS_MOD) + (size_t)l * 17 * 6144; const float* g1 = p.in[6] + (l * 4 + 1) * 1024; const float* g2 = p.in[6] + (l * 4 + 2) * 1024;
    const bf16_t* Y = (const bf16_t*)(p.ws + U_Y); unsigned char* A8 = p.ws + WS_ABUF; float* AFF = (float*)(p.ws + WS_AFF);
    float wr[32];
#pragma unroll
    for (int j = 0; j < 32; ++j) wr[j] = p.in[31][((size_t)l * 1024 + 128 * wv + 32 * cq + j) * 16 + e];
    for (int gi = blockIdx.x; gi < ngrp; gi += gridDim.x) { const int r0 = gi * 16 + wv; const int b = r0 < NLAT ? (r0 >> 11) : 16; const float* mb = mod + (size_t)b * 6144;
        const float* xs = xrow(xl, xc, r0); float* xd = xrow_w(p.out, (float*)(p.ws + WS_CTXA), r0);
        float4 y[2][4], x[2][4]; float ss[2] = {0.f, 0.f};
#pragma unroll
        for (int q = 0; q < 2; ++q)
#pragma unroll
            for (int i = 0; i < 4; ++i) { { const u32x2 yw = *(const u32x2*)(Y + (size_t)(r0 + 8 * q) * 1024 + i * 256 + lane * 4); y[q][i] = make_float4(bflo(yw.x), bfhi(yw.x), bflo(yw.y), bfhi(yw.y)); }
                x[q][i] = *(const float4*)(xs + (size_t)q * 8192 + i * 256 + lane * 4); }
#pragma unroll
        for (int q = 0; q < 2; ++q)
#pragma unroll
            for (int i = 0; i < 4; ++i) ss[q] += y[q][i].x * y[q][i].x + y[q][i].y * y[q][i].y + y[q][i].z * y[q][i].z + y[q][i].w * y[q][i].w;
        ss[0] = wave_sum(ss[0]); ss[1] = wave_sum(ss[1]); const float rs[2] = {rsqrtf(ss[0] * (1.0f / 1024.0f) + 1e-6f), rsqrtf(ss[1] * (1.0f / 1024.0f) + 1e-6f)};
        float s2[2] = {0.f, 0.f};
#pragma unroll
        for (int i = 0; i < 4; ++i) { const int c = i * 256 + lane * 4; const float4 gg = *(const float4*)(g1 + c), gt = *(const float4*)(mb + 2048 + c);
#pragma unroll
            for (int q = 0; q < 2; ++q) {
                x[q][i].x += gt.x * (y[q][i].x * rs[q] * gg.x); x[q][i].y += gt.y * (y[q][i].y * rs[q] * gg.y); x[q][i].z += gt.z * (y[q][i].z * rs[q] * gg.z); x[q][i].w += gt.w * (y[q][i].w * rs[q] * gg.w);
                *(float4*)(xd + (size_t)q * 8192 + c) = x[q][i]; s2[q] += x[q][i].x * x[q][i].x + x[q][i].y * x[q][i].y + x[q][i].z * x[q][i].z + x[q][i].w * x[q][i].w; } }
        s2[0] = wave_sum(s2[0]); s2[1] = wave_sum(s2[1]); const float rs2[2] = {rsqrtf(s2[0] * (1.0f / 1024.0f) + 1e-6f), rsqrtf(s2[1] * (1.0f / 1024.0f) + 1e-6f)};
        float hv[2][4][4]; float amax[2] = {0.f, 0.f};
        __syncthreads();
#pragma unroll
        for (int i = 0; i < 4; ++i) { const int c = i * 256 + lane * 4; const float4 gg = *(const float4*)(g2 + c), sh = *(const float4*)(mb + 3072 + c), sc = *(const float4*)(mb + 4096 + c);
#pragma unroll
            for (int q = 0; q < 2; ++q) {
                hv[q][i][0] = x[q][i].x * rs2[q] * gg.x * (1.f + sc.x) + sh.x; hv[q][i][1] = x[q][i].y * rs2[q] * gg.y * (1.f + sc.y) + sh.y; hv[q][i][2] = x[q][i].z * rs2[q] * gg.z * (1.f + sc.z) + sh.z; hv[q][i][3] = x[q][i].w * rs2[q] * gg.w * (1.f + sc.w) + sh.w;
                *(LAS lf4*)(hrow + (wv + 8 * q) * 1024 + c) = (lf4){hv[q][i][0], hv[q][i][1], hv[q][i][2], hv[q][i][3]};
                amax[q] = fmaxf(amax[q], fmaxf(fmaxf(fabsf(hv[q][i][0]), fabsf(hv[q][i][1])), fmaxf(fabsf(hv[q][i][2]), fabsf(hv[q][i][3])))); } }
#pragma unroll
        for (int o = 32; o >= 1; o >>= 1) { amax[0] = fmaxf(amax[0], __shfl_xor(amax[0], o)); amax[1] = fmaxf(amax[1], __shfl_xor(amax[1], o)); }
#pragma unroll
        for (int q = 0; q < 2; ++q) { const int r = r0 + 8 * q; const float am = fmaxf(amax[q], 1e-20f), qs = 127.0f / am;
            if (lane == 0) ((float*)(p.ws + WS_SX))[r] = am * (1.0f / 127.0f);
#pragma unroll
            for (int i = 0; i < 4; ++i) { unsigned w = 0u;
#pragma unroll
                for (int k = 0; k < 4; ++k) w |= ((unsigned)__float2int_rn(hv[q][i][k] * qs) & 255u) << (8 * k);
                *(unsigned*)(A8 + (size_t)r * 1024 + i * 256 + lane * 4) = w; } }
        __syncthreads();
#pragma unroll 2
        for (int rr = 0; rr < 16; ++rr) { const LAS float* hp = hrow + rr * 1024 + 128 * wv + 32 * cq; float acc = 0.f;
#pragma unroll
            for (int j4 = 0; j4 < 8; ++j4) { const lf4 h4 = *(const LAS lf4*)(hp + 4 * j4); acc += h4.x * wr[4 * j4] + h4.y * wr[4 * j4 + 1] + h4.z * wr[4 * j4 + 2] + h4.w * wr[4 * j4 + 3]; }
            acc += __shfl_xor(acc, 16); acc += __shfl_xor(acc, 32);
            if (cq == 0) part[(rr * 8 + wv) * 16 + e] = acc; }
        __syncthreads();
        if (lane < 32) { const int row = wv + 8 * cq; float lgt = 0.f;
#pragma unroll
            for (int w = 0; w < 8; ++w) lgt += part[(row * 8 + w) * 16 + e];
            float mxl = lgt;
#pragma unroll
            for (int o = 8; o >= 1; o >>= 1) mxl = fmaxf(mxl, __shfl_xor(mxl, o));
            const float ex = expf(lgt - mxl); float den = ex;
#pragma unroll
            for (int o = 8; o >= 1; o >>= 1) den += __shfl_xor(den, o);
            AFF[(size_t)(r0 + 8 * cq) * 16 + e] = ex / den; }
    }
}

__device__ __forceinline__ void phase_topk(const Params& p, int l, LAS unsigned char* lds) {
    LAS unsigned* keys = (LAS unsigned*)lds;
    LAS int* toks = (LAS int*)(lds + 8192);
    LAS unsigned* hist = (LAS unsigned*)(lds + 9216);
    LAS unsigned* wtot = (LAS unsigned*)(lds + 10240);
    LAS unsigned* sel = (LAS unsigned*)(lds + 10304);
    const int tid = threadIdx.x, lane = tid & 63, wv = tid >> 6, nitem = l == 0 ? 512 : 256;
    const float* AFF = (const float*)(p.ws + WS_AFF); int* SLOT = (int*)(p.ws + WS_SLOT); float* SELG = (float*)(p.ws + WS_SELG);
    const bf16_t* A = (const bf16_t*)(p.ws + WS_ABUF); bf16_t* XS = (bf16_t*)(p.ws + U_XSEL);
    for (int it = blockIdx.x; it < nitem; it += gridDim.x) { const bool lat = it < 256; const int be = it & 255, b = be >> 4, e = be & 15;
        const int n = lat ? SEQ : CTXL, cap = lat ? 256 : 32, rowbase = lat ? b * 2048 : NLAT + b * 256, xoff = lat ? b * 256 : 4096 + b * 32;
        const int per = n / NTHR > 0 ? n / NTHR : 1;
        const int t0 = tid * per; const bool act = t0 < n;
        unsigned kx[4];
        __syncthreads();
#pragma unroll
        for (int j = 0; j < 4; ++j) { kx[j] = 0u; if (act && j < per) { kx[j] = __float_as_uint(AFF[(size_t)(rowbase + t0 + j) * 16 + e]); keys[t0 + j] = kx[j]; } }
        unsigned prefix = 0u; int krem = cap;
        for (int pass = 0; pass < 4; ++pass) { const int shift = 24 - 8 * pass;
            if (tid < 256) hist[tid] = 0u;
            __syncthreads();
#pragma unroll
            for (int j = 0; j < 4; ++j) if (act && j < per) { const bool match = pass == 0 || (kx[j] >> (shift + 8)) == (prefix >> (shift + 8)); if (match) atomicAdd((unsigned*)&hist[(kx[j] >> shift) & 255u], 1u); }
            __syncthreads();
            if (tid < 256) { unsigned above = 0u; for (int bb = tid + 1; bb < 256; ++bb) above += hist[bb]; const unsigned mine = hist[tid];
                if (above < (unsigned)krem && above + mine >= (unsigned)krem) { sel[0] = (unsigned)tid; sel[1] = (unsigned)krem - above; } }
            __syncthreads();
            prefix |= sel[0] << shift; krem = (int)sel[1];
            __syncthreads();
        }
        unsigned loc = 0u, pre[4];
#pragma unroll
        for (int j = 0; j < 4; ++j) { pre[j] = loc; if (act && j < per) loc += (kx[j] > prefix ? 1u : 0u) + (kx[j] == prefix ? 65536u : 0u); }
        unsigned inc = loc;
#pragma unroll
        for (int o = 1; o < 64; o <<= 1) { const unsigned t = __shfl_up(inc, o); if (lane >= o) inc += t; }
        if (lane == 63) wtot[wv] = inc;
        __syncthreads();
        unsigned base = inc - loc;
        for (int w = 0; w < wv; ++w) base += wtot[w];
#pragma unroll
        for (int j = 0; j < 4; ++j) if (act && j < per) { const unsigned c = base + pre[j]; const int gtb = (int)(c & 0xffffu), eqb = (int)(c >> 16);
            const bool s = kx[j] > prefix || (kx[j] == prefix && eqb < krem); const int slot = gtb + (eqb < krem ? eqb : krem);
            if (s) { SELG[e * XROWS + xoff + slot] = __uint_as_float(kx[j]); toks[slot] = t0 + j; }
            SLOT[(size_t)(rowbase + t0 + j) * 16 + e] = s ? slot : -1; }
        __syncthreads();
        for (int s = wv; s < cap; s += 8) { const int row = rowbase + toks[s]; const lu4* src = (const lu4*)((const unsigned char*)A + (size_t)row * 1024); lu4* dst = (lu4*)((unsigned char*)XS + ((size_t)e * XROWS + xoff + s) * 1024);
            dst[lane] = src[lane]; if (lane == 0) ((float*)(p.ws + WS_SXS))[e * XROWS + xoff + s] = ((const float*)(p.ws + WS_SX))[row]; }
    }
}

struct GroupedOrder { int nMl, nNl, G, c, total;
    __device__ void init(int nMl_, int nNl_, int, int G_, int c_) { nMl = nMl_; nNl = nNl_; G = G_; c = c_; total = 16 * nMl_ * nNl_; }
    __device__ bool next(int i, pg8::Unit& u) const {
        int L;
        if ((G & 7) == 0 && (total & 7) == 0) { const int W = G >> 3, x = c & 7, r = c >> 3, t8 = total >> 3, k = i * W + r; if (k >= t8) return false; L = x * t8 + k; }
        else { const long LL = (long)i * G + c; if (LL >= total) return false; L = (int)LL; }
        const int per = nMl * nNl, e = L / per; int idx = L % per;
        const int mg = idx / (8 * nNl) < nMl / 8 ? idx / (8 * nNl) : nMl / 8, gm = (mg + 1) * 8 <= nMl ? 8 : nMl - mg * 8; idx -= mg * 8 * nNl;
        const int ng = idx / (gm * 4) < nNl / 4 ? idx / (gm * 4) : nNl / 4, gn = (ng + 1) * 4 <= nNl ? 4 : nNl - ng * 4; idx -= ng * gm * 4;
        u.pm = e * 18 + mg * 8 + idx / gn; u.pn = e * nNl + ng * 4 + idx % gn; return true; }
    __device__ __forceinline__ void a_ready(const pg8::Unit&) const {}
    __device__ __forceinline__ void done(const pg8::Unit&) const {}
};
struct EpiSwiGLU { static constexpr bool PERM = true, AFTER_DRAIN = false; unsigned char* H; const float* sx; const float* sw;
    __device__ __forceinline__ void operator()(const f32x4 (&acc)[2][2][4][2], const pg8::Unit& u, int wr, int wc, int fr, int fq) const {
        typedef int i32x4_ __attribute__((ext_vector_type(4)));
        const int e = u.pn / 22, pnl = u.pn - e * 22; const int row0 = u.pm * 256 + wr * 64 + fr, col0 = pnl * 128 + wc * 32 + 8 * fq;
        const float* swp = sw + (size_t)u.pn * 256 + wc * 32 + 8 * fq; const float4 g0 = *(const float4*)swp, g1 = *(const float4*)(swp + 4), u0 = *(const float4*)(swp + 128), u1 = *(const float4*)(swp + 132);
        const float swg[8] = {g0.x, g0.y, g0.z, g0.w, g1.x, g1.y, g1.z, g1.w}, swu[8] = {u0.x, u0.y, u0.z, u0.w, u1.x, u1.y, u1.z, u1.w};
#pragma unroll
        for (int ai = 0; ai < 2; ++ai)
#pragma unroll
            for (int m = 0; m < 4; ++m) { const int r = row0 + ai * 128 + m * 16; const float sr = sx[r]; unsigned char* rowp = H + (size_t)r * DE + col0; float o[8];
#pragma unroll
                for (int n = 0; n < 2; ++n) { const i32x4_ ig = __builtin_bit_cast(i32x4_, acc[ai][0][m][n]), iu = __builtin_bit_cast(i32x4_, acc[ai][1][m][n]);
#pragma unroll
                    for (int j = 0; j < 4; ++j) { const float g = (float)ig[j] * (sr * swg[n * 4 + j]), uu = (float)iu[j] * (sr * swu[n * 4 + j]); o[n * 4 + j] = g * sigm(g) * uu; } }
                u32x2 w8; { int t0 = 0, t1 = 0; t0 = __builtin_amdgcn_cvt_pk_fp8_f32(o[0], o[1], t0, false); t0 = __builtin_amdgcn_cvt_pk_fp8_f32(o[2], o[3], t0, true); t1 = __builtin_amdgcn_cvt_pk_fp8_f32(o[4], o[5], t1, false); t1 = __builtin_amdgcn_cvt_pk_fp8_f32(o[6], o[7], t1, true); w8.x = (unsigned)t0; w8.y = (unsigned)t1; }
                *(u32x2*)rowp = w8; }
    }
};
struct EpiScaleBf16 { static constexpr bool PERM = true, AFTER_DRAIN = false; bf16_t* O; int ldc; const float* sx; const float* sw;
    __device__ __forceinline__ void operator()(const f32x4 (&acc)[2][2][4][2], const pg8::Unit& u, int wr, int wc, int fr, int fq) const {
        typedef int i32x4_ __attribute__((ext_vector_type(4)));
        const int row0 = u.pm * 256 + wr * 64 + fr, col0 = u.pn * 256 + wc * 32 + 8 * fq;
        float swv[2][8];
#pragma unroll
        for (int bj = 0; bj < 2; ++bj) { const float4 a = *(const float4*)(sw + col0 + bj * 128), b = *(const float4*)(sw + col0 + bj * 128 + 4); swv[bj][0] = a.x; swv[bj][1] = a.y; swv[bj][2] = a.z; swv[bj][3] = a.w; swv[bj][4] = b.x; swv[bj][5] = b.y; swv[bj][6] = b.z; swv[bj][7] = b.w; }
#pragma unroll
        for (int ai = 0; ai < 2; ++ai)
#pragma unroll
            for (int m = 0; m < 4; ++m) { const int r = row0 + ai * 128 + m * 16; const float sr = sx[r]; bf16_t* rowp = O + (size_t)r * ldc + col0;
#pragma unroll
                for (int bj = 0; bj < 2; ++bj) { float o[8];
#pragma unroll
                    for (int n = 0; n < 2; ++n) { const i32x4_ iv = __builtin_bit_cast(i32x4_, acc[ai][bj][m][n]);
#pragma unroll
                        for (int j = 0; j < 4; ++j) o[n * 4 + j] = (float)iv[j] * (sr * swv[bj][n * 4 + j]); }
                    *(uint4*)(rowp + bj * 128) = pack8(o); } }
    }
};
struct EpiGate { static constexpr bool PERM = true, AFTER_DRAIN = false; bf16_t* O; const float* gate; const float* sw;
    __device__ __forceinline__ void operator()(const f32x4 (&acc)[2][2][4][2], const pg8::Unit& u, int wr, int wc, int fr, int fq) const {
        pg8::fp8_acc_settle();
        const int pnl = u.pn & 3; const int row0 = u.pm * 256 + wr * 64 + fr, col0 = pnl * 256 + wc * 32 + 8 * fq;
#pragma unroll
        for (int bj = 0; bj < 2; ++bj) { const float* sp = sw + (size_t)u.pn * 256 + wc * 32 + 8 * fq + bj * 128; const float4 sa = *(const float4*)sp, sb = *(const float4*)(sp + 4);
#pragma unroll
            for (int ai = 0; ai < 2; ++ai)
#pragma unroll
                for (int m = 0; m < 4; ++m) { const int r = row0 + ai * 128 + m * 16; const float gt = gate[r]; const f32x4 v0 = acc[ai][bj][m][0], v1 = acc[ai][bj][m][1];
                    u32x4 w; w.x = pack2(v0[0] * (gt * sa.x), v0[1] * (gt * sa.y)); w.y = pack2(v0[2] * (gt * sa.z), v0[3] * (gt * sa.w)); w.z = pack2(v1[0] * (gt * sb.x), v1[1] * (gt * sb.y)); w.w = pack2(v1[2] * (gt * sb.z), v1[3] * (gt * sb.w));
                    *(u32x4*)(O + (size_t)r * 1024 + col0 + bj * 128) = w; } }
    }
};

__device__ __forceinline__ void phase_combine(const Params& p, int l) {
    const int lane = threadIdx.x & 63, wv = threadIdx.x >> 6; const int nrow = l == 0 ? NROW : NLAT;
    const float* mod = (const float*)(p.ws + WS_MOD) + (size_t)l * 17 * 6144; const float* g3 = p.in[6] + (l * 4 + 3) * 1024;
    const int* SLOT = (const int*)(p.ws + WS_SLOT); const bf16_t* YE = (const bf16_t*)(p.ws + U_YEXP); bf16_t* A = (bf16_t*)(p.ws + WS_ABUF);
    const int rstep = gridDim.x * 8; int r = blockIdx.x * 8 + wv;
    int nslot = (r < nrow && lane < 16) ? SLOT[(size_t)r * 16 + lane] : -1; float4 nx1[4];
    if (r < nrow) { const float* x1p = xrow(p.out, (const float*)(p.ws + WS_CTXA), r);
#pragma unroll
        for (int i = 0; i < 4; ++i) nx1[i] = *(const float4*)(x1p + i * 256 + lane * 4); }
    for (; r < nrow; r += rstep) { const bool lat = r < NLAT; const int b = lat ? (r >> 11) : ((r - NLAT) >> 8), mbi = lat ? b : 16, xoff = lat ? b * 256 : 4096 + b * 32;
        const float* mb = mod + (size_t)mbi * 6144;
        const int myslot = nslot; float4 xc[4];
#pragma unroll
        for (int i = 0; i < 4; ++i) xc[i] = nx1[i];
        float f[16];
#pragma unroll
        for (int k = 0; k < 16; ++k) f[k] = 0.f;
        unsigned long long mask = __ballot(myslot >= 0);
        while (mask) { int ee[4], sl4[4]; u32x2 w[4][4];
#pragma unroll
            for (int k = 0; k < 4; ++k) { if (mask) { ee[k] = __builtin_ctzll(mask); mask &= mask - 1; sl4[k] = __shfl(myslot, ee[k]); } else { ee[k] = -1; sl4[k] = 0; } }
#pragma unroll
            for (int k = 0; k < 4; ++k) if (ee[k] >= 0) { const bf16_t* yr = YE + ((size_t)ee[k] * XROWS + xoff + sl4[k]) * 1024 + lane * 4;
#pragma unroll
                for (int i = 0; i < 4; ++i) w[k][i] = *(const u32x2*)(yr + i * 256); }
#pragma unroll
            for (int k = 0; k < 4; ++k) if (ee[k] >= 0) {
#pragma unroll
                for (int i = 0; i < 4; ++i) { f[i * 4] += bflo(w[k][i].x); f[i * 4 + 1] += bfhi(w[k][i].x); f[i * 4 + 2] += bflo(w[k][i].y); f[i * 4 + 3] += bfhi(w[k][i].y); } } }
        { const int rn = r + rstep; nslot = (rn < nrow && lane < 16) ? SLOT[(size_t)rn * 16 + lane] : -1;
          if (rn < nrow) { const float* x1p = xrow(p.out, (const float*)(p.ws + WS_CTXA), rn);
#pragma unroll
              for (int i = 0; i < 4; ++i) nx1[i] = *(const float4*)(x1p + i * 256 + lane * 4); } }
        float ss = 0.f;
#pragma unroll
        for (int k = 0; k < 16; ++k) ss += f[k] * f[k];
        ss = wave_sum(ss); const float rs = rsqrtf(ss * (1.0f / 1024.0f) + 1e-6f);
        float* x2 = l == 0 ? xrow_w((float*)(p.ws + WS_XB), (float*)(p.ws + WS_CTXB), r) : p.out + (size_t)r * D;
        float4 xv[4];
#pragma unroll
        for (int i = 0; i < 4; ++i) { const int c = i * 256 + lane * 4; const float4 gg = *(const float4*)(g3 + c), gt = *(const float4*)(mb + 5120 + c); float4 x = xc[i];
            x.x += gt.x * (f[i * 4] * rs * gg.x); x.y += gt.y * (f[i * 4 + 1] * rs * gg.y); x.z += gt.z * (f[i * 4 + 2] * rs * gg.z); x.w += gt.w * (f[i * 4 + 3] * rs * gg.w);
            *(float4*)(x2 + c) = x; xv[i] = x; }
        if (l == 0) { const float* mb1 = mod + (size_t)17 * 6144 + (size_t)mbi * 6144; hnorm_row(p.in[6] + 4 * 1024, mb1, mb1 + 1024, p.ws + WS_ABUF + (size_t)r * 1024, (float*)(p.ws + WS_SH) + r, lane, xv); }
    }
}


#ifndef MK_ONLY
#define MK_ONLY -1
#endif
#define EN(k) (MK_ONLY < 0 || MK_ONLY == (k))
#ifndef MK_DUP
#define MK_DUP 0
#endif
#define NREP(k) ((((MK_DUP) >> (k)) & 1) ? 2 : 1)
constexpr int PH_PER_LAYER = 14, N_PHASES = 1 + 2 * PH_PER_LAYER;
#define IN(k) (lo <= (k) && (k) < hi)
#define SEAM(k) do { if (p.use_bar && IN(k) && IN((k) + 1)) xcd_barrier(bar); } while (0)
template <int l> __device__ __forceinline__ void layer_phases(const Params& p, LAS unsigned char* lds, const XcdBarrier& bar, const int lo, const int hi) {
    const int wv = __builtin_amdgcn_readfirstlane(threadIdx.x >> 6), G = gridDim.x; const int wid = blockIdx.x * 8 + wv, nw = G * 8;
        const int pb = 1 + l * PH_PER_LAYER;
        const float* xl = l == 0 ? p.in[0] : (const float*)(p.ws + WS_XB);
        const float* xc = l == 0 ? p.in[2] : (const float*)(p.ws + WS_CTXB);
        if (EN(0) && IN(pb + 0)) { { if (l == 0) phase_hnorm(p, 0, xl, xc); }
            if ((NREP(0)) == 2) { if (l == 0) phase_hnorm(p, 0, xl, xc); } }
        SEAM(pb + 0);
        if (EN(1) && IN(pb + 1)) { { pg8::Gemm g{(const bf16_t*)(p.ws + WS_ABUF), (const bf16_t*)(p.ws + WS_WIN), NROW, NINP, D / 2}; pg8::StaticOrder S; S.init(NROW, NINP, G, (int)blockIdx.x);
            EpiScaleBf16 E{(bf16_t*)(p.ws + U_P), NINP, (const float*)(p.ws + WS_SH), (const float*)(p.ws + WS_SWIN)}; pg8::gemm_phase<EpiScaleBf16, pg8::StaticOrder, false, 1>(lds, g, S, E, nullptr); }
            if ((NREP(1)) == 2) { pg8::Gemm g{(const bf16_t*)(p.ws + WS_ABUF), (const bf16_t*)(p.ws + WS_WIN), NROW, NINP, D / 2}; pg8::StaticOrder S; S.init(NROW, NINP, G, (int)blockIdx.x);
            EpiScaleBf16 E{(bf16_t*)(p.ws + U_P), NINP, (const float*)(p.ws + WS_SH), (const float*)(p.ws + WS_SWIN)}; pg8::gemm_phase<EpiScaleBf16, pg8::StaticOrder, false, 1>(lds, g, S, E, nullptr); } }
        SEAM(pb + 1);
        if (EN(2) && IN(pb + 2)) { phase_prep(p, l, lds);
            if ((NREP(2)) == 2) phase_prep(p, l, lds); }
        SEAM(pb + 2);
        if (EN(3) && IN(pb + 3)) { { lowrank_items(p, l, wid, nw, lds); if ((G & 31) == 0) s5_pass1_block(p, l, lds); else s5_pass1_items(p, l, wid, nw); }
            if ((NREP(3)) == 2) { lowrank_items(p, l, wid, nw, lds); if ((G & 31) == 0) s5_pass1_block(p, l, lds); else s5_pass1_items(p, l, wid, nw); } }
        SEAM(pb + 3);
        if (EN(4) && IN(pb + 4)) { { s5_carry(p, l); na_items(p, l, wid, nw, lds); }
            if ((NREP(4)) == 2) { s5_carry(p, l); na_items(p, l, wid, nw, lds); } }
        SEAM(pb + 4);
        if (EN(5) && IN(pb + 5)) { { s5_pass2_block(p, l, (int)blockIdx.x, G, lds); if (PRE_DUP == 6) s5_pass2_block(p, l, (int)blockIdx.x, G, lds); rwkv_pre_items(p, l, wid, nw, lds); if (PRE_DUP == 7) rwkv_pre_items(p, l, wid, nw, lds); }
            if ((NREP(5)) == 2) { s5_pass2_block(p, l, (int)blockIdx.x, G, lds); rwkv_pre_items(p, l, wid, nw, lds); } }
        SEAM(pb + 5);
        if (EN(6) && IN(pb + 6)) {
            if (G > 192) { const int bx = (int)blockIdx.x;
                if (bx < 192) rwkv_seq_block(p, l, bx, lds); else s5_glu_block(p, l, bx - 192, G - 192, lds);
                if ((NREP(6)) == 2) { if (bx < 192) rwkv_seq_block(p, l, bx, lds); else s5_glu_block(p, l, bx - 192, G - 192, lds); } }
            else { for (int task = wid; task < 768; task += nw) rwkv_seq_task(p, l, task, lds); s5_glu_items(p, l, wid, nw); } }
        SEAM(pb + 6);
        if (EN(7) && IN(pb + 7)) { rwkv_finish(p, l);
            if ((NREP(7)) == 2) rwkv_finish(p, l); }
        SEAM(pb + 7);
        if (EN(8) && IN(pb + 8)) { { const int M = l == 0 ? NROW : NLAT; pg8::Gemm g{(const bf16_t*)(p.ws + WS_ABUF), (const bf16_t*)(p.ws + WS_WOUT), M, D, D}; pg8::StaticOrder S; S.init(M, D, G, (int)blockIdx.x);
            pg8::EpiBf16<0> E{(bf16_t*)(p.ws + U_Y), D, nullptr, 0, 0}; pg8::gemm_phase<pg8::EpiBf16<0>, pg8::StaticOrder, false>(lds, g, S, E, nullptr); }
            if ((NREP(8)) == 2) { const int M = l == 0 ? NROW : NLAT; pg8::Gemm g{(const bf16_t*)(p.ws + WS_ABUF), (const bf16_t*)(p.ws + WS_WOUT), M, D, D}; pg8::StaticOrder S; S.init(M, D, G, (int)blockIdx.x);
            pg8::EpiBf16<0> E{(bf16_t*)(p.ws + U_Y), D, nullptr, 0, 0}; pg8::gemm_phase<pg8::EpiBf16<0>, pg8::StaticOrder, false>(lds, g, S, E, nullptr); } }
        SEAM(pb + 8);
        if (EN(9) && IN(pb + 9)) { phase_normrouter(p, l, xl, xc, lds);
            if ((NREP(9)) == 2) phase_normrouter(p, l, xl, xc, lds); }
        SEAM(pb + 9);
        if (EN(10) && IN(pb + 10)) { phase_topk(p, l, lds);
            if ((NREP(10)) == 2) phase_topk(p, l, lds); }
        SEAM(pb + 10);
        if (EN(11) && IN(pb + 11)) { { pg8::Gemm g{(const bf16_t*)(p.ws + U_XSEL), (const bf16_t*)(p.ws + WS_WGU), 16 * XROWS, 16 * 5632, D / 2}; GroupedOrder S; S.init(l == 0 ? 18 : 16, 22, 2, G, (int)blockIdx.x);
            EpiSwiGLU E{p.ws + U_HID, (const float*)(p.ws + WS_SXS), (const float*)(p.ws + WS_SW8)}; pg8::gemm_phase<EpiSwiGLU, GroupedOrder, false, 1>(lds, g, S, E, nullptr); }
            if ((NREP(11)) == 2) { pg8::Gemm g{(const bf16_t*)(p.ws + U_XSEL), (const bf16_t*)(p.ws + WS_WGU), 16 * XROWS, 16 * 5632, D / 2}; GroupedOrder S; S.init(l == 0 ? 18 : 16, 22, 2, G, (int)blockIdx.x);
            EpiSwiGLU E{p.ws + U_HID, (const float*)(p.ws + WS_SXS), (const float*)(p.ws + WS_SW8)}; pg8::gemm_phase<EpiSwiGLU, GroupedOrder, false, 1>(lds, g, S, E, nullptr); } }
        SEAM(pb + 11);
        if (EN(12) && IN(pb + 12)) { { pg8::Gemm g{(const bf16_t*)(p.ws + U_HID), (const bf16_t*)(p.ws + WS_WD), 16 * XROWS, 16 * 1024, DE / 2}; GroupedOrder S; S.init(l == 0 ? 18 : 16, 4, 4, G, (int)blockIdx.x);
            EpiGate E{(bf16_t*)(p.ws + U_YEXP), (const float*)(p.ws + WS_SELG), (const float*)(p.ws + WS_SWD)}; pg8::gemm_phase<EpiGate, GroupedOrder, false, 2>(lds, g, S, E, nullptr);
            if (l == 0 && G == 256 && blockIdx.x >= 128) convert_weights(p, 1, lds, (int)blockIdx.x - 128, 128, 0, CV_EARLY); }
            if ((NREP(12)) == 2) { pg8::Gemm g{(const bf16_t*)(p.ws + U_HID), (const bf16_t*)(p.ws + WS_WD), 16 * XROWS, 16 * 1024, DE / 2}; GroupedOrder S; S.init(l == 0 ? 18 : 16, 4, 4, G, (int)blockIdx.x);
            EpiGate E{(bf16_t*)(p.ws + U_YEXP), (const float*)(p.ws + WS_SELG), (const float*)(p.ws + WS_SWD)}; pg8::gemm_phase<EpiGate, GroupedOrder, false, 2>(lds, g, S, E, nullptr); } }
        SEAM(pb + 12);
        if (EN(13) && IN(pb + 13)) { { phase_combine(p, l); if (l == 0) convert_weights(p, 1, lds, (int)blockIdx.x, G, G == 256 ? CV_EARLY : 0, CV_TOTAL); }
            if (((l == 0 ? NREP(13) : 1)) == 2) { phase_combine(p, l); if (l == 0) convert_weights(p, 1, lds, (int)blockIdx.x, G); } }
        SEAM(pb + 13);
}
__global__ void __launch_bounds__(NTHR, 2) fwd(Params p) {
    extern __shared__ __attribute__((aligned(16))) unsigned char lds_raw[];
    LAS unsigned char* lds = (LAS unsigned char*)lds_raw;
    const int tid = threadIdx.x;
    if (tid < 4) ((LAS unsigned*)(lds + LDS_MISC))[tid] = 0u;
    __syncthreads();
    XcdBarrier bar; bar.bar = (unsigned*)(p.ws + WS_CTL); bar.x = 0; bar.st = (volatile LAS unsigned*)(lds + LDS_MISC);
    if (p.use_bar) bar = xcd_barrier_post((unsigned*)(p.ws + WS_CTL), (volatile LAS unsigned*)(lds + LDS_MISC));
    if (p.use_bar && tid == 0) { unsigned* xr = (unsigned*)(p.ws + WS_CTL + 32768); ((LAS unsigned*)(lds + LDS_MISC))[2] = xb_xcc_id(); ((LAS unsigned*)(lds + LDS_MISC))[3] = atomicAdd(xr + 64 * xb_xcc_id(), 1u); }
    __syncthreads();
    const int lo = p.ph_lo, hi = p.ph_hi;

    if (EN(100) && IN(0)) { { phase_prologue(p, lds); }
        if ((NREP(14)) == 2) { phase_prologue(p, lds); } }
    SEAM(0);
    layer_phases<0>(p, lds, bar, lo, hi);
    layer_phases<1>(p, lds, bar, lo, hi);
#undef IN
#undef SEAM
}
}

#ifndef MK_ONE_LAUNCH
#define MK_ONE_LAUNCH 1
#endif
extern "C" void kernel_launch(void* const* d_in, const int* in_sizes, int n_in, void* d_out, int out_size, void* d_ws, size_t ws_size, hipStream_t stream) {
    static int grid = 0;
    if (grid == 0) {
        if (n_in != 35 || out_size != mk::NLAT * mk::D || ws_size < mk::WS_END) { fprintf(stderr, "kernel_launch: unexpected problem (n_in %d, out %d, ws %zu < %zu)\n", n_in, out_size, ws_size, (size_t)mk::WS_END); grid = -1; return; }
        int dev = 0, cus = 0, per_cu = 0;
        if (hipGetDevice(&dev) != hipSuccess || hipDeviceGetAttribute(&cus, hipDeviceAttributeMultiprocessorCount, dev) != hipSuccess) { grid = -1; return; }
        if (hipFuncSetAttribute((const void*)mk::fwd, hipFuncAttributeMaxDynamicSharedMemorySize, mk::LDS_BYTES) != hipSuccess) { fprintf(stderr, "kernel_launch: hipFuncSetAttribute failed\n"); grid = -1; return; }
        if (hipOccupancyMaxActiveBlocksPerMultiprocessor(&per_cu, (const void*)mk::fwd, mk::NTHR, mk::LDS_BYTES) != hipSuccess || per_cu < 1) { fprintf(stderr, "kernel_launch: occupancy query says %d\n", per_cu); per_cu = 1; }
        (void)hipGetLastError();
        grid = cus;
    }
    if (grid < 0) return;
    (void)in_sizes;
    if (hipMemsetAsync(d_ws, 0, 65536, stream) != hipSuccess) return;
    mk::Params a{};
    for (int i = 0; i < 35; ++i) a.in[i] = (const float*)d_in[i];
    a.out = (float*)d_out; a.ws = (unsigned char*)d_ws;
#if MK_ONE_LAUNCH
    a.ph_lo = 0; a.ph_hi = mk::N_PHASES; a.use_bar = 1;
    hipLaunchKernelGGL(mk::fwd, dim3(grid), dim3(mk::NTHR), mk::LDS_BYTES, stream, a);
#else
    for (int ph = 0; ph < mk::N_PHASES; ++ph) { a.ph_lo = ph; a.ph_hi = ph + 1; a.use_bar = 0; hipLaunchKernelGGL(mk::fwd, dim3(grid), dim3(mk::NTHR), mk::LDS_BYTES, stream, a); }
#endif
}
```

```cpp
#include <hip/hip_runtime.h>
#include <cstdio>
#include <cstdint>
#define PRE_DUP 0
namespace pg8 {
#define PG8_LAS __attribute__((address_space(3)))
typedef unsigned short bf16_t;
typedef short bf16x8 __attribute__((ext_vector_type(8)));
typedef float f32x4 __attribute__((ext_vector_type(4)));
typedef unsigned u32x4 __attribute__((ext_vector_type(4)));
constexpr int BM = 256, BK = 64, HALF = 128, HTB = HALF * BK * 2  , STAGE_BYTES = 8 * HTB, NXCD = 8, WGM = 8;

__host__ __device__ __forceinline__ int lds_byte(int r, int c) { const int st = (r >> 4) * 2 + (c >> 5), rr = r & 15, cc = c & 31, ob = rr * 64 + cc * 2; return st * 1024 + (ob ^ (((ob >> 9) & 1) << 5)); }
__host__ __device__ __forceinline__ void stage_rc(int b, int& R, int& C) { const int st = b / 1024, sb = b % 1024, swz = sb ^ (((sb >> 9) & 1) << 5); R = (st >> 1) * 16 + swz / 64; C = (st & 1) * 32 + (swz % 64) / 2; }
__host__ __device__ __forceinline__ int perm32(int rho) { const int n = rho >> 4, i = rho & 15; return 8 * (i >> 2) + 4 * n + (i & 3); }

struct Unit { int pm, pn; };
struct Gemm { const bf16_t* A; const bf16_t* Bt; int M, N, K; };

struct StaticOrder {
    int nM, nN, nwg, G, c;
    __host__ __device__ void init(int M, int N, int G_, int c_) { nM = M / BM; nN = N / BM; nwg = nM * nN; G = G_; c = c_; }
    __host__ __device__ bool next(int i, Unit& u) const {
        const long L = (long)i * G + c; if (L >= nwg) return false;
        int wgid = (int)L; { const int q = nwg / NXCD, r = nwg % NXCD, xcd = wgid % NXCD, off = wgid / NXCD; wgid = (xcd < r ? xcd * (q + 1) : r * (q + 1) + (xcd - r) * q) + off; }
        const int nig = WGM * nN, gid = wgid / nig, fm = gid * WGM, gsz = (nM - fm) < WGM ? (nM - fm) : WGM;
        u.pm = fm + ((wgid % nig) % gsz); u.pn = (wgid % nig) / gsz; return true;
    }
    __device__ __forceinline__ void a_ready(const Unit&) const {}
    __device__ __forceinline__ void done(const Unit&) const {}
};
struct CountedOrder : StaticOrder {
    const unsigned* ready; unsigned need; unsigned* tmo;
    __device__ __forceinline__ void a_ready(const Unit& u) const {
        if (threadIdx.x < 64) {
            const unsigned long long t0 = __builtin_amdgcn_s_memrealtime(); unsigned polls = 0;
            while ((unsigned)__builtin_amdgcn_readfirstlane(__hip_atomic_load(ready + 64 * u.pm, __ATOMIC_RELAXED, __HIP_MEMORY_SCOPE_AGENT)) < need) {
                if ((++polls & 255u) == 0u && __builtin_amdgcn_readfirstlane(__hip_atomic_load(tmo, __ATOMIC_RELAXED, __HIP_MEMORY_SCOPE_AGENT)) != 0u) break;
                if (__builtin_amdgcn_s_memrealtime() - t0 > 2000000ull) {
                    if (threadIdx.x == 0) { unsigned expect = 0u; __hip_atomic_compare_exchange_strong(tmo + 1, &expect, 0x600u | (unsigned)(u.pm & 0xff), __ATOMIC_RELAXED, __ATOMIC_RELAXED, __HIP_MEMORY_SCOPE_AGENT); __hip_atomic_store(tmo, 1u, __ATOMIC_RELAXED, __HIP_MEMORY_SCOPE_AGENT); }
                    break; }
                __builtin_amdgcn_s_sleep(2); }
            __builtin_amdgcn_fence(__ATOMIC_ACQUIRE, "agent");
            asm volatile("s_waitcnt vmcnt(0)" ::: "memory");
        }
#if !defined(BROKEN_HOOK_NO_BARRIER)
        asm volatile("" ::: "memory"); __builtin_amdgcn_s_barrier(); asm volatile("" ::: "memory");
#endif
    }
};

__device__ __forceinline__ unsigned cvt_pk_bf16(float lo, float hi) { unsigned r; asm volatile("v_cvt_pk_bf16_f32 %0, %1, %2" : "=v"(r) : "v"(lo), "v"(hi)); return r; }
typedef float f32x2 __attribute__((ext_vector_type(2)));
__device__ __forceinline__ f32x2 gelu_pk(f32x2 v) {
    const f32x2 av = __builtin_elementwise_abs(v), d = av * 0.2316418882f + 1.0f;
    f32x2 t; t.x = __builtin_amdgcn_rcpf(d.x); t.y = __builtin_amdgcn_rcpf(d.y);
    f32x2 q = t * 0.5307027145f + (-0.7265760135f); q = q * t + 0.7107068705f; q = q * t + (-0.142248368f); q = q * t + 0.127414796f; q = q * t;
    const f32x2 s = (v * v) * (-0.72134752044f);
    f32x2 e; e.x = __builtin_amdgcn_exp2f(s.x); e.y = __builtin_amdgcn_exp2f(s.y);
    const f32x2 m = v * (q * e), r = v - m;
    f32x2 o; o.x = v.x < 0.f ? m.x : r.x; o.y = v.y < 0.f ? m.y : r.y; return o;
}

struct EpiF32 {
    static constexpr bool PERM = false, AFTER_DRAIN = false;
    float* C; int ldc; const float* bias;
    __device__ __forceinline__ void operator()(const f32x4 (&acc)[2][2][4][2], const Unit& u, int wr, int wc, int fr, int fq) const {
        const int row0 = u.pm * BM + wr * 64 + fr, col0 = u.pn * BM + wc * 32 + 4 * fq;
        f32x4 bv[2][2];
#pragma unroll
        for (int bj = 0; bj < 2; ++bj)
#pragma unroll
            for (int n = 0; n < 2; ++n) bv[bj][n] = bias ? *(const f32x4*)(bias + col0 + bj * HALF + n * 16) : (f32x4){0.f, 0.f, 0.f, 0.f};
#pragma unroll
        for (int ai = 0; ai < 2; ++ai)
#pragma unroll
            for (int m = 0; m < 4; ++m) { float* rowp = C + (size_t)(row0 + ai * HALF + m * 16) * ldc + col0;
#pragma unroll
                for (int bj = 0; bj < 2; ++bj)
#pragma unroll
                    for (int n = 0; n < 2; ++n) *(f32x4*)(rowp + bj * HALF + n * 16) = acc[ai][bj][m][n] + bv[bj][n]; }
    }
};
template <int ACT  > struct EpiBf16 {
    static constexpr bool PERM = true, AFTER_DRAIN = false;
    bf16_t* O; int ldc; const float* bias; int split_cols; size_t split_stride;
    __device__ __forceinline__ void operator()(const f32x4 (&acc)[2][2][4][2], const Unit& u, int wr, int wc, int fr, int fq) const {
        const int row0 = u.pm * BM + wr * 64 + fr; int colt = u.pn * BM; bf16_t* base = O;
        if (split_cols) { const int t = colt / split_cols; base += (size_t)t * split_stride; colt -= t * split_cols; }
        const int col0 = colt + wc * 32 + 8 * fq, bcol0 = u.pn * BM + wc * 32 + 8 * fq;
        f32x4 bv[2][2];
#pragma unroll
        for (int bj = 0; bj < 2; ++bj)
#pragma unroll
            for (int n = 0; n < 2; ++n) bv[bj][n] = bias ? *(const f32x4*)(bias + bcol0 + bj * HALF + 4 * n) : (f32x4){0.f, 0.f, 0.f, 0.f};
#pragma unroll
        for (int ai = 0; ai < 2; ++ai)
#pragma unroll
            for (int m = 0; m < 4; ++m) { bf16_t* rowp = base + (size_t)(row0 + ai * HALF + m * 16) * ldc + col0;
#pragma unroll
                for (int bj = 0; bj < 2; ++bj) { f32x4 v0 = acc[ai][bj][m][0] + bv[bj][0], v1 = acc[ai][bj][m][1] + bv[bj][1];
                    if (ACT == 1) { f32x2 a = gelu_pk((f32x2){v0[0], v0[1]}), b = gelu_pk((f32x2){v0[2], v0[3]}), c = gelu_pk((f32x2){v1[0], v1[1]}), d = gelu_pk((f32x2){v1[2], v1[3]});
                        v0 = (f32x4){a.x, a.y, b.x, b.y}; v1 = (f32x4){c.x, c.y, d.x, d.y}; }
                    if (ACT == 2) {
#pragma unroll
                        for (int j = 0; j < 4; ++j) { v0[j] = 0.5f * v0[j] * (1.0f + erff(v0[j] * 0.70710678f)); v1[j] = 0.5f * v1[j] * (1.0f + erff(v1[j] * 0.70710678f)); } }
                    u32x4 w; w.x = cvt_pk_bf16(v0[0], v0[1]); w.y = cvt_pk_bf16(v0[2], v0[3]); w.z = cvt_pk_bf16(v1[0], v1[1]); w.w = cvt_pk_bf16(v1[2], v1[3]);
                    *(u32x4*)(rowp + bj * HALF) = w; } }
    }
};

template <int MODE> __device__ __forceinline__ f32x4 pg8_mma(bf16x8 a, bf16x8 b, f32x4 c) {
    if constexpr (MODE == 1) { typedef int i32x4_ __attribute__((ext_vector_type(4))); return __builtin_bit_cast(f32x4, __builtin_amdgcn_mfma_i32_16x16x64_i8(__builtin_bit_cast(i32x4_, a), __builtin_bit_cast(i32x4_, b), __builtin_bit_cast(i32x4_, c), 0, 0, 0)); }
    else return __builtin_amdgcn_mfma_f32_16x16x32_bf16(a, b, c, 0, 0, 0); }
__device__ __forceinline__ f32x4 pg8_mma8(bf16x8 a0, bf16x8 a1, bf16x8 b0, bf16x8 b1, f32x4 c) {
    typedef int i32x4_ __attribute__((ext_vector_type(4))); typedef int i32x8_ __attribute__((ext_vector_type(8)));
    const i32x8_ A = __builtin_shufflevector(__builtin_bit_cast(i32x4_, a0), __builtin_bit_cast(i32x4_, a1), 0, 1, 2, 3, 4, 5, 6, 7), B = __builtin_shufflevector(__builtin_bit_cast(i32x4_, b0), __builtin_bit_cast(i32x4_, b1), 0, 1, 2, 3, 4, 5, 6, 7);
    const int one = 0x7f7f7f7f;
    asm volatile("v_mfma_scale_f32_16x16x128_f8f6f4 %0, %1, %2, %0, %3, %3 op_sel_hi:[0,0,0]" : "+v"(c) : "v"(A), "v"(B), "v"(one));
    return c; }
__device__ __forceinline__ void fp8_acc_settle() { asm volatile("s_nop 7\n\ts_nop 7\n\ts_nop 7" ::: "memory"); }
template <class Epi, class Sched, bool STAMP = false, int MODE = 0>
__device__ __forceinline__ void gemm_phase(PG8_LAS unsigned char* lds, const Gemm g, const Sched& S, const Epi& E, unsigned long long* stamps) {
    const int tid = threadIdx.x, wid = __builtin_amdgcn_readfirstlane(tid >> 6), lane = tid & 63, wr = wid >> 2, wc = wid & 3, fr = lane & 15, fq = lane >> 4;
    const int K = g.K, nt = K / BK;
    int ts_lo = 0, ts_hi = 0, nts = 0; const unsigned long long rt_entry = STAMP ? (unsigned long long)wall_clock64() : 0ull;
#define PG8_STAMP() do { if (STAMP && wid == 0 && nts < 64) { const unsigned long long _c = (unsigned long long)clock64(); \
        ts_lo = (lane == nts) ? (int)(unsigned)_c : ts_lo; ts_hi = (lane == nts) ? (int)(unsigned)(_c >> 32) : ts_hi; ++nts; } } while (0)
    PG8_STAMP();
    unsigned voffA[2], voffB[2];
#pragma unroll
    for (int i = 0; i < 2; ++i) { int R, C; stage_rc(tid * 16 + i * 8192, R, C); const int Rb = Epi::PERM ? ((R & ~31) + perm32(R & 31)) : R;
        voffA[i] = (unsigned)(R * K + C) * 2u; voffB[i] = (unsigned)(Rb * K + C) * 2u; }
    const size_t kstep = (size_t)(BK * 2);
    const size_t hstep = (size_t)HALF * K * 2;
    const size_t tstep = 2 * hstep;
    const unsigned ldsw = (unsigned)wid * 1024u;
    const int aoff = lds_byte(wr * 64 + fr, fq * 8), boff = lds_byte(wc * 32 + fr, fq * 8);
#define PG8_SA(b, h) (((b) * 2 + (h)) * HTB)
#define PG8_SB(b, h) ((4 + (b) * 2 + (h)) * HTB)
#define PG8_STAGE(bufoff, gbase, voff) do { _Pragma("unroll") for (int _i = 0; _i < 2; ++_i) \
        __builtin_amdgcn_global_load_lds((const unsigned*)((const char*)(gbase) + (voff)[_i]), (PG8_LAS unsigned*)(lds + (bufoff) + ldsw + _i * 8192), 16, 0, 0); } while (0)
#define PG8_LDA(dst, b, h) do { _Pragma("unroll") for (int m = 0; m < 4; ++m) _Pragma("unroll") for (int k = 0; k < 2; ++k) dst[m][k] = *(const PG8_LAS bf16x8*)(lds + PG8_SA(b, h) + aoff + m * 2048 + k * 1024); } while (0)
#define PG8_LDB(dst, b, h) do { _Pragma("unroll") for (int n = 0; n < 2; ++n) _Pragma("unroll") for (int k = 0; k < 2; ++k) dst[n][k] = *(const PG8_LAS bf16x8*)(lds + PG8_SB(b, h) + boff + n * 2048 + k * 1024); } while (0)
#define PG8_MMA(ai, bj, At, Bt) do { __builtin_amdgcn_s_setprio(1); _Pragma("unroll") for (int m = 0; m < 4; ++m) _Pragma("unroll") for (int n = 0; n < 2; ++n) { if constexpr (MODE == 2) acc[ai][bj][m][n] = pg8_mma8(Bt[n][0], Bt[n][1], At[m][0], At[m][1], acc[ai][bj][m][n]); else { _Pragma("unroll") for (int k = 0; k < 2; ++k) \
        acc[ai][bj][m][n] = pg8_mma<MODE>(Bt[n][k], At[m][k], acc[ai][bj][m][n]); } } __builtin_amdgcn_s_setprio(0); } while (0)
#define PG8_WAIT_V(n) asm volatile("s_waitcnt vmcnt(" #n ")" ::: "memory")
#define PG8_WAIT_L(n) asm volatile("s_waitcnt lgkmcnt(" #n ")" ::: "memory")
#define PG8_BAR __builtin_amdgcn_s_barrier()
#define PG8_SCHED __builtin_amdgcn_sched_barrier(0)
    Unit cur, nxt; int ui = 0;
    if (!S.next(0, cur)) return;
    f32x4 acc[2][2][4][2];
#pragma unroll
    for (int a = 0; a < 2; ++a)
#pragma unroll
        for (int b = 0; b < 2; ++b)
#pragma unroll
            for (int m = 0; m < 4; ++m)
#pragma unroll
                for (int n = 0; n < 2; ++n) acc[a][b][m][n] = (f32x4){0.f, 0.f, 0.f, 0.f};
    bf16x8 At[4][2], B0[2][2], B1[2][2];
    const char* cA = (const char*)g.A + (size_t)cur.pm * tstep; const char* cB = (const char*)g.Bt + (size_t)cur.pn * tstep;
    S.a_ready(cur);
    PG8_STAGE(PG8_SB(0, 0), cB, voffB); PG8_STAGE(PG8_SA(0, 0), cA, voffA); PG8_STAGE(PG8_SB(0, 1), cB + hstep, voffB); PG8_STAGE(PG8_SA(0, 1), cA + hstep, voffA);
    if (wr == 1) PG8_BAR;
    PG8_WAIT_V(4); PG8_BAR;
    PG8_STAGE(PG8_SB(1, 0), cB + kstep, voffB); PG8_STAGE(PG8_SA(1, 0), cA + kstep, voffA); PG8_STAGE(PG8_SB(1, 1), cB + hstep + kstep, voffB);
    PG8_WAIT_V(6); PG8_BAR;
    PG8_STAMP();
    for (;;) {
        const bool has_next = S.next(ui + 1, nxt);
        const char* nA = has_next ? (const char*)g.A + (size_t)nxt.pm * tstep : cA; const char* nB = has_next ? (const char*)g.Bt + (size_t)nxt.pn * tstep : cB;
        for (int t = 0; t < nt; t += 2) {
            const bool last = (t == nt - 2);
            const char* a1 = cA + (size_t)(t + 1) * kstep;
            const char* a2 = last ? nA : cA + (size_t)(t + 2) * kstep; const char* b2 = last ? nB : cB + (size_t)(t + 2) * kstep;
            const char* a3 = a2 + kstep; const char* b3 = b2 + kstep;
            if (last && has_next) S.a_ready(nxt);
            PG8_LDB(B0, 0, 0); PG8_SCHED; PG8_LDA(At, 0, 0); PG8_STAGE(PG8_SA(1, 1), a1 + hstep, voffA);
            PG8_WAIT_L(8); PG8_BAR; PG8_WAIT_L(0); PG8_MMA(0, 0, At, B0); PG8_BAR; PG8_SCHED;
            PG8_LDB(B1, 0, 1); PG8_STAGE(PG8_SB(0, 0), b2, voffB);
            PG8_BAR; PG8_WAIT_L(0); PG8_MMA(0, 1, At, B1); PG8_BAR;
            PG8_LDA(At, 0, 1); PG8_STAGE(PG8_SA(0, 0), a2, voffA);
            PG8_BAR; PG8_WAIT_L(0); PG8_MMA(1, 0, At, B0); PG8_BAR; PG8_SCHED;
            PG8_STAGE(PG8_SB(0, 1), b2 + hstep, voffB);
            PG8_WAIT_V(6); PG8_BAR; PG8_MMA(1, 1, At, B1); PG8_BAR;
            PG8_LDB(B0, 1, 0); PG8_SCHED; PG8_LDA(At, 1, 0); PG8_STAGE(PG8_SA(0, 1), a2 + hstep, voffA);
            PG8_WAIT_L(8); PG8_BAR; PG8_WAIT_L(0); PG8_MMA(0, 0, At, B0); PG8_BAR; PG8_SCHED;
            PG8_LDB(B1, 1, 1); PG8_STAGE(PG8_SB(1, 0), b3, voffB);
            PG8_BAR; PG8_WAIT_L(0); PG8_MMA(0, 1, At, B1); PG8_BAR;
            PG8_LDA(At, 1, 1); PG8_STAGE(PG8_SA(1, 0), a3, voffA);
            PG8_BAR; PG8_WAIT_L(0); PG8_MMA(1, 0, At, B0); PG8_BAR; PG8_SCHED;
            PG8_STAGE(PG8_SB(1, 1), b3 + hstep, voffB);
            PG8_WAIT_V(6); PG8_BAR; PG8_MMA(1, 1, At, B1); PG8_BAR;
        }
        PG8_STAMP();
        if constexpr (!Epi::AFTER_DRAIN) { E(acc, cur, wr, wc, fr, fq); S.done(cur); }
        PG8_STAMP();
        if (!has_next) break;
#pragma unroll
        for (int a = 0; a < 2; ++a)
#pragma unroll
            for (int b = 0; b < 2; ++b)
#pragma unroll
                for (int m = 0; m < 4; ++m)
#pragma unroll
                    for (int n = 0; n < 2; ++n) acc[a][b][m][n] = (f32x4){0.f, 0.f, 0.f, 0.f};
        cur = nxt; cA = nA; cB = nB; ++ui;
    }
    PG8_WAIT_V(0);
    if (wr == 0) PG8_BAR;
    PG8_BAR;
    if constexpr (Epi::AFTER_DRAIN) { E.fused(acc, cur, wr, wc, fr, fq, lds, wid, lane); S.done(cur); }
    PG8_STAMP();
    if (STAMP && wid == 0) { stamps[lane] = lane < nts ? (((unsigned long long)(unsigned)ts_hi << 32) | (unsigned)ts_lo) : 0ull;
        if (lane == 62) stamps[62] = rt_entry; if (lane == 63) stamps[63] = (unsigned long long)wall_clock64(); }
#undef PG8_STAMP
#undef PG8_SA
#undef PG8_SB
#undef PG8_STAGE
#undef PG8_LDA
#undef PG8_LDB
#undef PG8_MMA
#undef PG8_WAIT_V
#undef PG8_WAIT_L
#undef PG8_BAR
#undef PG8_SCHED
}
}
#define XB_TMO      128
#define XB_XCNT(j)  (256  + 64 * (j))
#define XB_XSUB(j)  (1280 + 64 * (j))
#define XB_XGEN(j)  (2304 + 64 * (j))
#define XB_TOP      3328
#define XB_TOPGEN   3392
#define XCD_BAR_WORDS 3456
#define XB_SPIN_CAP (1u << 18)
#define LAS __attribute__((address_space(3)))

__device__ __forceinline__ unsigned xb_ld(unsigned* p)              { return __hip_atomic_load(p, __ATOMIC_RELAXED, __HIP_MEMORY_SCOPE_AGENT); }
__device__ __forceinline__ unsigned xb_add(unsigned* p, unsigned v) { return __hip_atomic_fetch_add(p, v, __ATOMIC_RELAXED, __HIP_MEMORY_SCOPE_AGENT); }
__device__ __forceinline__ unsigned xb_xcc_id() { return (unsigned)__builtin_amdgcn_s_getreg((3 << 11) | 20) & 0xFu; }
#define XB_SPIN(cond, bar) do { unsigned _sp = 0; while (cond) { __builtin_amdgcn_s_sleep(1); \
    if ((++_sp & 255u) == 0u) { if (xb_ld(&(bar)[XB_TMO])) break; if (_sp > XB_SPIN_CAP) { atomicAdd(&(bar)[XB_TMO], 1u); break; } } } } while (0)

struct XcdBarrier {
    unsigned* bar; unsigned x;
    volatile LAS unsigned* st;
};

__device__ __forceinline__ XcdBarrier xcd_barrier_post(unsigned* bar, volatile LAS unsigned* st) {
    XcdBarrier b; b.bar = bar; b.x = xb_xcc_id(); b.st = st;
    if (threadIdx.x == 0) (void)xb_add(&bar[XB_XCNT(b.x)], 1u);
    return b;
}
__device__ __forceinline__ void xcd_barrier_complete(unsigned* bar, unsigned x, unsigned& nloc, unsigned& nx) {
    const unsigned G = gridDim.x * gridDim.y * gridDim.z;
    unsigned sum, cnt, mine, sp = 0u;
    for (;;) {
        sum = 0u; cnt = 0u; mine = 0u;
#pragma unroll
        for (unsigned j = 0; j < 16; ++j) { const unsigned c = xb_ld(&bar[XB_XCNT(j)]); sum += c; cnt += (c > 0u) ? 1u : 0u; mine = (j == x) ? c : mine; }
        if (sum == G) break;
        __builtin_amdgcn_s_sleep(1);
        if ((++sp & 255u) == 0u) { if (xb_ld(&bar[XB_TMO])) break; if (sp > XB_SPIN_CAP) { atomicAdd(&bar[XB_TMO], 1u); break; } }
    }
    nloc = mine > 0u ? mine : 1u; nx = cnt > 0u ? cnt : 1u;
}

__device__ __forceinline__ void xcd_barrier(const XcdBarrier& b) {
    asm volatile("s_waitcnt vmcnt(0)" ::: "memory");
    __syncthreads();
    if (threadIdx.x == 0) {
        unsigned* bar = b.bar;
        __builtin_amdgcn_s_waitcnt(0);
        unsigned nloc = b.st[0], nx = b.st[1];
        if (nloc == 0u) { xcd_barrier_complete(bar, b.x, nloc, nx); b.st[0] = nloc; b.st[1] = nx; }
        const unsigned old = xb_add(&bar[XB_XSUB(b.x)], 1u);
        const unsigned gen = old / nloc;
        if (old + 1u == (gen + 1u) * nloc) {
            __builtin_amdgcn_fence(__ATOMIC_RELEASE, "agent");
            asm volatile("s_waitcnt vmcnt(0)" ::: "memory");
            const unsigned og = xb_add(&bar[XB_TOP], 1u);
            const unsigned tg = og / nx;
            if (og + 1u == (tg + 1u) * nx) xb_add(&bar[XB_TOPGEN], 1u);
            else XB_SPIN(xb_ld(&bar[XB_TOPGEN]) == tg, bar);
            __builtin_amdgcn_fence(__ATOMIC_ACQUIRE, "agent");
            xb_add(&bar[XB_XGEN(b.x)], 1u);
            asm volatile("s_waitcnt vmcnt(0)" ::: "memory");
        } else {
            XB_SPIN(xb_ld(&bar[XB_XGEN(b.x)]) == gen, bar);
            __builtin_amdgcn_fence(__ATOMIC_ACQUIRE, "agent");
            asm volatile("s_waitcnt vmcnt(0)" ::: "memory");
        }
    }
    __syncthreads();
}

namespace mk {
using pg8::bf16_t; using pg8::bf16x8; using pg8::f32x4; using pg8::u32x4;
typedef unsigned u32x2 __attribute__((ext_vector_type(2)));
typedef short bf16x4 __attribute__((ext_vector_type(4)));
typedef float lf2 __attribute__((ext_vector_type(2)));
typedef float lf4 __attribute__((ext_vector_type(4)));
typedef unsigned lu4 __attribute__((ext_vector_type(4)));

constexpr int D = 1024, NBATCH = 16, SEQ = 2048, CTXL = 256;
constexpr int NLAT = NBATCH * SEQ, NCTX = NBATCH * CTXL, NROW = NLAT + NCTX;
constexpr int NINP = 3072, NIN = 2944;
constexpr int C_Q = 256, C_K = 640, C_V = 1024, C_Z = 1408;
constexpr int DE = 2816;
constexpr int XROWS = 4608;
constexpr int NTHR = 512;
constexpr int LDS_MISC = 131072, LDS_BYTES = 131072 + 256;

constexpr size_t al256(size_t x) { return (x + 255) & ~(size_t)255; }
constexpr size_t WS_CTL = 0;
constexpr size_t WS_MOD = 65536;
constexpr size_t WS_SW = al256(WS_MOD + (size_t)2 * 17 * 6144 * 4);
constexpr size_t SW_W2T = 0, SW_A2T = 98304, SW_G2T = 196608, SW_GLUT = 294912, SW_S5E = 425984, SW_S5W2 = 2523136, SW_STRIDE = 6717440;
constexpr size_t WS_WIN = al256(WS_SW + 2 * SW_STRIDE);
constexpr size_t WS_WOUT = WS_WIN + (size_t)3072 * 1024 * 2;
constexpr size_t WS_WGU = WS_WOUT + (size_t)1024 * 1024 * 2;
constexpr size_t WS_WD = WS_WGU + (size_t)16 * 5632 * 1024 * 2;
constexpr size_t WS_XB = WS_WD + (size_t)16 * 1024 * 2816 * 2;
constexpr size_t WS_CTXA = WS_XB + (size_t)NLAT * D * 4;
constexpr size_t WS_CTXB = WS_CTXA + (size_t)NCTX * D * 4;
constexpr size_t WS_ABUF = WS_CTXB + (size_t)NCTX * D * 4;
constexpr size_t WS_AFF = WS_ABUF + (size_t)NROW * D * 2;
constexpr size_t WS_SLOT = WS_AFF + (size_t)NROW * 16 * 4;
constexpr size_t WS_SELG = WS_SLOT + (size_t)NROW * 16 * 4;
constexpr size_t WS_SW8 = al256(WS_SELG + (size_t)16 * XROWS * 4);
constexpr size_t WS_SX = WS_SW8 + (size_t)16 * 5632 * 4;
constexpr size_t WS_SXS = WS_SX + (size_t)NROW * 4;
constexpr size_t WS_SWIN = WS_SXS + (size_t)16 * XROWS * 4;
constexpr size_t WS_SH = WS_SWIN + (size_t)3072 * 4;
constexpr size_t WS_SWD = WS_SH + (size_t)NROW * 4;
constexpr size_t WS_U = al256(WS_SWD + (size_t)16 * 1024 * 4);
constexpr size_t SZ384 = (size_t)NROW * 384 * 2;
constexpr size_t U_P = WS_U;
constexpr size_t U_QR = U_P + (size_t)NROW * NINP * 2;
constexpr size_t U_KR = U_QR + SZ384;
constexpr size_t U_VT = U_KR + SZ384;
constexpr size_t U_VTC = U_VT + (size_t)16 * 384 * 2048 * 2;
constexpr size_t U_RS = U_VT + SZ384;
constexpr size_t U_KS = U_RS + SZ384;
constexpr size_t U_VS = U_KS + SZ384;
constexpr size_t U_KK = U_VS + SZ384;
constexpr size_t U_ALR = U_KK + SZ384;
constexpr size_t U_LD = U_ALR + SZ384;
constexpr size_t U_AG = U_LD + 2 * SZ384;
constexpr size_t U_G = U_AG + 2 * SZ384;
constexpr size_t U_YRK = U_G + SZ384;
constexpr size_t U_SLOC = U_YRK + 2 * (size_t)NROW * 384 * 4;
constexpr size_t U_SPREV = U_SLOC + (size_t)2304 * 16 * 256 * 4;
constexpr size_t U_YG = U_SPREV + (size_t)2304 * 16 * 256 * 2;
constexpr size_t U_U16 = U_YG + (size_t)NROW * 256 * 2;
constexpr size_t U_MIX_END = U_U16 + (size_t)NROW * 256 * 2;
constexpr int NCHUNK = 192 * 144;
constexpr size_t CH_XP = U_P;
constexpr size_t CH_BK = CH_XP + (size_t)NCHUNK * 4096;
constexpr size_t CH_UL = CH_BK + (size_t)NCHUNK * 4096;
constexpr size_t CH_MM = U_SLOC;
constexpr size_t CH_GT = CH_MM + (size_t)NCHUNK * 1024;
static_assert(CH_UL + (size_t)NCHUNK * 2048 <= U_RS, "chunk buffers overlap live RWKV operands");
static_assert(CH_GT + (size_t)NCHUNK * 256 <= U_SPREV, "chunk buffers overlap S5 states");
constexpr size_t U_Y = WS_U;
constexpr size_t U_XSEL = U_Y + (size_t)NROW * D * 4;
constexpr size_t U_HID = U_XSEL + (size_t)16 * XROWS * 1024 * 2;
constexpr size_t U_YEXP = U_HID + (size_t)16 * XROWS * DE * 2;
constexpr size_t U_FFN_END = U_YEXP + (size_t)16 * XROWS * 1024 * 2;
constexpr size_t WS_END = U_MIX_END > U_FFN_END ? U_MIX_END : U_FFN_END;

struct Params { const float* in[35]; float* out; unsigned char* ws; int ph_lo, ph_hi, use_bar, pad; };

typedef __bf16 hwbf2 __attribute__((ext_vector_type(2)));
__device__ __forceinline__ unsigned pack2(float lo, float hi) { const lf2 v = {lo, hi}; return __builtin_bit_cast(unsigned, __builtin_convertvector(v, hwbf2)); }
__device__ __forceinline__ bf16_t f2bf(float f) { return (bf16_t)(pack2(f, 0.f) & 0xffffu); }
__device__ __forceinline__ float bflo(unsigned w) { return __uint_as_float(w << 16); }
__device__ __forceinline__ float bfhi(unsigned w) { return __uint_as_float(w & 0xffff0000u); }
__device__ __forceinline__ float bf2f(bf16_t b) { return __uint_as_float(((unsigned)b) << 16); }
__device__ __forceinline__ float sigm(float x) { return 1.0f / (1.0f + __expf(-x)); }
__device__ __forceinline__ float wave_sum(float v) {
#pragma unroll
    for (int o = 32; o >= 1; o >>= 1) v += __shfl_xor(v, o);
    return v; }
__device__ __forceinline__ void unpack8(const uint4 w, float (&f)[8]) { f[0] = bflo(w.x); f[1] = bfhi(w.x); f[2] = bflo(w.y); f[3] = bfhi(w.y); f[4] = bflo(w.z); f[5] = bfhi(w.z); f[6] = bflo(w.w); f[7] = bfhi(w.w); }
__device__ __forceinline__ uint4 pack8(const float (&f)[8]) { uint4 w; w.x = pack2(f[0], f[1]); w.y = pack2(f[2], f[3]); w.z = pack2(f[4], f[5]); w.w = pack2(f[6], f[7]); return w; }
__device__ __forceinline__ const float* xrow(const float* lat, const float* ctx, int r) { return r < NLAT ? lat + (size_t)r * D : ctx + (size_t)(r - NLAT) * D; }
__device__ __forceinline__ float* xrow_w(float* lat, float* ctx, int r) { return r < NLAT ? lat + (size_t)r * D : ctx + (size_t)(r - NLAT) * D; }
__device__ __forceinline__ f32x4 mfma16(bf16x8 a, bf16x8 b, f32x4 c) { return __builtin_amdgcn_mfma_f32_16x16x32_bf16(a, b, c, 0, 0, 0); }

__device__ __forceinline__ void tr_tile(const float* __restrict__ src, int ldsrc, int k0, int n0, bf16_t* __restrict__ dst, int lddst, int drow0, LAS unsigned* T) {
    const int tid = threadIdx.x, n4 = tid & 15, kq = tid >> 4;
    const float4 a = *(const float4*)(src + (size_t)(k0 + 2 * kq) * ldsrc + n0 + 4 * n4);
    const float4 b = *(const float4*)(src + (size_t)(k0 + 2 * kq + 1) * ldsrc + n0 + 4 * n4);
    T[(4 * n4 + 0) * 33 + kq] = pack2(a.x, b.x); T[(4 * n4 + 1) * 33 + kq] = pack2(a.y, b.y);
    T[(4 * n4 + 2) * 33 + kq] = pack2(a.z, b.z); T[(4 * n4 + 3) * 33 + kq] = pack2(a.w, b.w);
    __syncthreads();
    const int n = tid >> 3, pc = tid & 7;
    uint4 v; v.x = T[n * 33 + 4 * pc]; v.y = T[n * 33 + 4 * pc + 1]; v.z = T[n * 33 + 4 * pc + 2]; v.w = T[n * 33 + 4 * pc + 3];
    *(uint4*)(dst + (size_t)(drow0 + n) * lddst + k0 + 8 * pc) = v;
    __syncthreads();
}

__device__ __forceinline__ void tr_tile4(const float* __restrict__ src, int ldsrc, int k0, int n0, bf16_t* __restrict__ dst, int lddst, int drow0, LAS unsigned* T) {
    int tid = threadIdx.x; asm volatile("" : "+v"(tid)); const int n4 = tid & 15, kq = tid >> 4;
    float4 a[4], b[4];
#pragma unroll
    for (int t = 0; t < 4; ++t) { a[t] = *(const float4*)(src + (size_t)(k0 + 2 * kq) * ldsrc + n0 + 64 * t + 4 * n4); b[t] = *(const float4*)(src + (size_t)(k0 + 2 * kq + 1) * ldsrc + n0 + 64 * t + 4 * n4); }
#pragma unroll
    for (int t = 0; t < 4; ++t) { LAS unsigned* Tt = T + t * 64 * 33;
        Tt[(4 * n4 + 0) * 33 + kq] = pack2(a[t].x, b[t].x); Tt[(4 * n4 + 1) * 33 + kq] = pack2(a[t].y, b[t].y); Tt[(4 * n4 + 2) * 33 + kq] = pack2(a[t].z, b[t].z); Tt[(4 * n4 + 3) * 33 + kq] = pack2(a[t].w, b[t].w); }
    __syncthreads();
#pragma unroll
    for (int i = 0; i < 4; ++i) { const int idx = tid + NTHR * i, n = idx >> 3, pc = idx & 7;
        uint4 v; v.x = T[n * 33 + 4 * pc]; v.y = T[n * 33 + 4 * pc + 1]; v.z = T[n * 33 + 4 * pc + 2]; v.w = T[n * 33 + 4 * pc + 3];
        *(uint4*)(dst + (size_t)(drow0 + n) * lddst + k0 + 8 * pc) = v; }
    __syncthreads();
}
template <int NK, int DP, bool FP8> __device__ __forceinline__ void q8_strip(const float* __restrict__ src, int ldsrc, unsigned char* __restrict__ dst, float* __restrict__ scl, LAS unsigned char* lds) {
    LAS float* cmax = (LAS float*)lds;
    LAS unsigned char* T = lds + 8704;
    const int tid = threadIdx.x, n4 = tid & 15, kq = tid >> 4; constexpr float QMAX = FP8 ? 256.0f : 127.0f;
    float mx[4] = {0.f, 0.f, 0.f, 0.f};
#pragma unroll 8
    for (int i = 0; i < 2 * NK; ++i) { const float4 v = *(const float4*)(src + (size_t)(kq + 32 * i) * ldsrc + 4 * n4); mx[0] = fmaxf(mx[0], fabsf(v.x)); mx[1] = fmaxf(mx[1], fabsf(v.y)); mx[2] = fmaxf(mx[2], fabsf(v.z)); mx[3] = fmaxf(mx[3], fabsf(v.w)); }
    __syncthreads();
#pragma unroll
    for (int j = 0; j < 4; ++j) cmax[kq * 64 + 4 * n4 + j] = mx[j];
    __syncthreads();
    if (tid < 64) { float m = 0.f; for (int g = 0; g < 32; ++g) m = fmaxf(m, cmax[g * 64 + tid]); m = fmaxf(m, 1e-20f); scl[tid] = m * (1.0f / QMAX); cmax[32 * 64 + tid] = QMAX / m; }
    __syncthreads();
    float inv[4];
#pragma unroll
    for (int j = 0; j < 4; ++j) inv[j] = cmax[32 * 64 + 4 * n4 + j];
    for (int kg = 0; kg < NK / 4; ++kg) {
        float4 a[4], b[4];
#pragma unroll
        for (int t = 0; t < 4; ++t) { const int kb = (kg * 4 + t) * 64 + 2 * kq; a[t] = *(const float4*)(src + (size_t)kb * ldsrc + 4 * n4); b[t] = *(const float4*)(src + (size_t)(kb + 1) * ldsrc + 4 * n4); }
#pragma unroll
        for (int t = 0; t < 4; ++t) { const float av[4] = {a[t].x, a[t].y, a[t].z, a[t].w}, bv[4] = {b[t].x, b[t].y, b[t].z, b[t].w};
#pragma unroll
            for (int j = 0; j < 4; ++j) { unsigned short w;
                if (FP8) w = (unsigned short)(__builtin_amdgcn_cvt_pk_fp8_f32(av[j] * inv[j], bv[j] * inv[j], 0, false) & 0xffff);
                else { const int q0 = __float2int_rn(av[j] * inv[j]), q1 = __float2int_rn(bv[j] * inv[j]); w = (unsigned short)((q0 & 255) | ((q1 & 255) << 8)); }
                *(LAS unsigned short*)(T + (4 * n4 + j) * 272 + t * 64 + 2 * kq) = w; } }
        __syncthreads();
#pragma unroll
        for (int i = 0; i < 2; ++i) { const int idx = tid + NTHR * i, n = idx >> 4, pc = idx & 15; *(lu4*)(dst + (size_t)n * DP + kg * 256 + 16 * pc) = *(const LAS lu4*)(T + n * 272 + 16 * pc); }
        __syncthreads();
    }
}
__device__ __forceinline__ void q8r_strip(const float* __restrict__ src, int ldsrc, unsigned char* __restrict__ dst, float* __restrict__ scl, LAS unsigned char* lds) {
    LAS float* cmax = (LAS float*)lds;
    int tid = threadIdx.x; asm volatile("" : "+v"(tid)); const int n4 = tid & 15, rg = tid >> 4;
    const float* s0 = src + (size_t)(rg * 32) * ldsrc + 4 * n4;
    lf4 v[32];
#pragma unroll
    for (int i = 0; i < 32; ++i) v[i] = *(const lf4*)(s0 + (size_t)i * ldsrc);
    __builtin_amdgcn_sched_barrier(0);
    float mx[4] = {0.f, 0.f, 0.f, 0.f};
#pragma unroll
    for (int i = 0; i < 32; ++i) {
#pragma unroll
        for (int j = 0; j < 4; ++j) mx[j] = fmaxf(mx[j], fabsf(v[i][j])); }
    __syncthreads();
#pragma unroll
    for (int j = 0; j < 4; ++j) cmax[rg * 64 + 4 * n4 + j] = mx[j];
    __syncthreads();
    if (tid < 64) { float m = 0.f; for (int g = 0; g < 32; ++g) m = fmaxf(m, cmax[g * 64 + tid]); m = fmaxf(m, 1e-20f); scl[tid] = m * (1.0f / 127.0f); cmax[32 * 64 + tid] = 127.0f / m; }
    __syncthreads();
#pragma unroll
    for (int j = 0; j < 4; ++j) { const float inv = cmax[32 * 64 + 4 * n4 + j]; unsigned w[8];
#pragma unroll
        for (int g = 0; g < 8; ++g) { const int q0 = __float2int_rn(v[4 * g][j] * inv), q1 = __float2int_rn(v[4 * g + 1][j] * inv), q2 = __float2int_rn(v[4 * g + 2][j] * inv), q3 = __float2int_rn(v[4 * g + 3][j] * inv);
            w[g] = (unsigned)(q0 & 255) | ((unsigned)(q1 & 255) << 8) | ((unsigned)(q2 & 255) << 16) | ((unsigned)q3 << 24); }
        unsigned char* d = dst + (size_t)(4 * n4 + j) * 1024 + rg * 32;
        *(lu4*)d = (lu4){w[0], w[1], w[2], w[3]}; *(lu4*)(d + 16) = (lu4){w[4], w[5], w[6], w[7]}; }
}
__device__ __forceinline__ void q8d_strip(const float* __restrict__ src, unsigned char* __restrict__ dst, float* __restrict__ scl, LAS unsigned char* lds) {
    LAS float* cmax = (LAS float*)lds;
    int tid = threadIdx.x; asm volatile("" : "+v"(tid)); const int n8 = tid & 7, rg = tid >> 3; const bool v2 = rg < 48;
    unsigned pk[3][16][2]; float mx[4] = {0.f, 0.f, 0.f, 0.f}; lf4 bufA[8], bufB[8];
    auto ld = [&](lf4 (&b)[8], int hr) { const int r = hr >> 1, c = (r == 2 && !v2) ? rg + 64 : rg + 64 * r; const float* sp = src + (size_t)(c * 16 + (hr & 1) * 8) * 1024 + 4 * n8;
#pragma unroll
        for (int i = 0; i < 8; ++i) b[i] = *(const lf4*)(sp + (size_t)i * 1024); };
    auto use = [&](const lf4 (&b)[8], int hr) {
#pragma unroll
        for (int i = 0; i < 8; ++i) {
#pragma unroll
            for (int j = 0; j < 4; ++j) mx[j] = fmaxf(mx[j], fabsf(b[i][j]));
            pk[hr >> 1][(hr & 1) * 8 + i][0] = pack2(b[i][0], b[i][1]); pk[hr >> 1][(hr & 1) * 8 + i][1] = pack2(b[i][2], b[i][3]); } };
    ld(bufA, 0);
#pragma unroll
    for (int h2 = 0; h2 < 3; ++h2) {
        ld(bufB, 2 * h2 + 1); __builtin_amdgcn_sched_barrier(0); use(bufA, 2 * h2);
        if (h2 < 2) ld(bufA, 2 * h2 + 2);
        __builtin_amdgcn_sched_barrier(0); use(bufB, 2 * h2 + 1); }
    __syncthreads();
#pragma unroll
    for (int j = 0; j < 4; ++j) cmax[rg * 32 + 4 * n8 + j] = mx[j];
    __syncthreads();
    if (tid < 32) { float m = 0.f; for (int g = 0; g < 64; ++g) m = fmaxf(m, cmax[g * 32 + tid]); m = fmaxf(m, 1e-20f); scl[tid] = m * (1.0f / 256.0f); cmax[64 * 32 + tid] = 256.0f / m; }
    __syncthreads();
    float inv[4];
#pragma unroll
    for (int j = 0; j < 4; ++j) inv[j] = cmax[64 * 32 + 4 * n8 + j];
#pragma unroll
    for (int r = 0; r < 3; ++r) { if (r == 2 && !v2) continue;
        const int c = rg + 64 * r;
#pragma unroll
        for (int j = 0; j < 4; ++j) { unsigned w[4];
#pragma unroll
            for (int g = 0; g < 4; ++g) { float f[4];
#pragma unroll
                for (int x = 0; x < 4; ++x) { const unsigned u = pk[r][4 * g + x][j >> 1]; f[x] = ((j & 1) ? bfhi(u) : bflo(u)) * inv[j]; }
                unsigned t = (unsigned)__builtin_amdgcn_cvt_pk_fp8_f32(f[0], f[1], 0, false); t = (unsigned)__builtin_amdgcn_cvt_pk_fp8_f32(f[2], f[3], (int)t, true); w[g] = t; }
            *(lu4*)(dst + (size_t)(4 * n8 + j) * DE + c * 16) = (lu4){w[0], w[1], w[2], w[3]}; } }
}
__device__ __forceinline__ void gu_strip(const Params& p, int l, int item, LAS unsigned char* lds) {
    const int e = item / 88, rem = item % 88, up = rem / 44, nt = rem % 44, n0 = nt * 64, drow0 = (n0 >> 7) * 256 + (n0 & 127) + (up ? 128 : 0);
    q8r_strip(p.in[up ? 33 : 32] + (size_t)(l * 16 + e) * 1024 * DE + n0, DE, p.ws + WS_WGU + ((size_t)e * 5632 + drow0) * 1024, (float*)(p.ws + WS_SW8) + (size_t)e * 5632 + drow0, lds);
}
constexpr int CV_EARLY = 1024;
constexpr int CV_GU = 16 * 88, CV_D4 = 16 * 32, CV_WIN = 46, CV_PAD = 16, CV_WOUT4 = 16 * 4, CV_TOTAL = CV_GU + CV_D4 + CV_WIN + CV_PAD + CV_WOUT4;
__device__ __forceinline__ void convert_item(const Params& p, int l, LAS unsigned char* lds, int it) {
    LAS unsigned* T = (LAS unsigned*)lds; bf16_t* WOUT = (bf16_t*)(p.ws + WS_WOUT);
    for (int once = 0; once < 1; ++once) {
        int j = it;
        if (j < CV_GU) { gu_strip(p, l, j, lds); continue; }
        j -= CV_GU;
        if (j < CV_D4) { const int e = j >> 5, nt = j & 31;
            q8d_strip(p.in[34] + (size_t)(l * 16 + e) * DE * 1024 + nt * 32, p.ws + WS_WD + ((size_t)e * 1024 + nt * 32) * DE, (float*)(p.ws + WS_SWD) + e * 1024 + nt * 32, lds); continue; }
        j -= CV_D4;
        if (j < CV_WIN) { q8r_strip(p.in[7] + (size_t)l * 1024 * NIN + j * 64, NIN, p.ws + WS_WIN + (size_t)j * 64 * 1024, (float*)(p.ws + WS_SWIN) + j * 64, lds); continue; }
        j -= CV_WIN;
        if (j < CV_PAD) { const size_t o = (size_t)NIN * 1024 + ((size_t)j * NTHR + threadIdx.x) * 16; *(uint4*)(p.ws + WS_WIN + o) = make_uint4(0u, 0u, 0u, 0u);
            if (j == 0 && threadIdx.x < 128) ((float*)(p.ws + WS_SWIN))[NIN + threadIdx.x] = 0.f; continue; }
        j -= CV_PAD;
        { const int kt = j >> 2, ng = j & 3; tr_tile4(p.in[8] + (size_t)l * 1024 * 1024, 1024, kt * 64, ng * 256, WOUT, 1024, ng * 256, T); }
    }
}
__device__ __forceinline__ void convert_weights(const Params& p, int l, LAS unsigned char* lds, int vb, int nvb, int lo = 0, int hi = CV_TOTAL) {
    for (int it = lo + vb; it < hi; it += nvb) convert_item(p, l, lds, it);
}
__device__ __forceinline__ void convert_weights_dyn(const Params& p, int l, LAS unsigned char* lds, unsigned* ctr, int lo, int hi) {
    LAS int* slot = (LAS int*)(lds + LDS_MISC + 32);
    for (;;) {
        __syncthreads();
        if (threadIdx.x == 0) *slot = lo + (int)atomicAdd(ctr, 1u);
        __syncthreads();
        const int it = *slot;
        if (it >= hi) break;
        convert_item(p, l, lds, it);
    }
}

__device__ __forceinline__ void mod_item(const Params& p, int item, LAS unsigned char* lds) {
    LAS float* sc = (LAS float*)lds;
    LAS float* red = (LAS float*)(lds + 69632);
    const int tid = threadIdx.x, l = item / 96, cg = item % 96;
    for (int i = tid; i < 17 * 1024; i += NTHR) { const int b = i >> 10, k = i & 1023; const float c = b < 16 ? p.in[1][b * 1024 + k] : p.in[3][k]; sc[k * 17 + b] = c * sigm(c); }
    __syncthreads();
    const int col = cg * 64 + (tid & 63), kg = tid >> 6;
    float acc[17];
#pragma unroll
    for (int b = 0; b < 17; ++b) acc[b] = 0.f;
    const float* w = p.in[4] + ((size_t)l * 1024 + kg * 128) * 6144 + col;
    for (int k0 = 0; k0 < 128; k0 += 32) { float wv[32];
#pragma unroll
        for (int j = 0; j < 32; ++j) wv[j] = w[(size_t)(k0 + j) * 6144];
        __builtin_amdgcn_sched_barrier(0);
#pragma unroll
        for (int j = 0; j < 32; ++j) { const LAS float* s = sc + (kg * 128 + k0 + j) * 17;
#pragma unroll
            for (int b = 0; b < 17; ++b) acc[b] += s[b] * wv[j]; } }
#pragma unroll
    for (int b = 0; b < 17; ++b) red[(kg * 17 + b) * 64 + (tid & 63)] = acc[b];
    __syncthreads();
    for (int i = tid; i < 17 * 64; i += NTHR) { const int b = i >> 6, c = i & 63; float s = 0.f;
#pragma unroll
        for (int g = 0; g < 8; ++g) s += red[(g * 17 + b) * 64 + c];
        ((float*)(p.ws + WS_MOD))[((size_t)l * 17 + b) * 6144 + cg * 64 + c] = s + p.in[5][l * 6144 + cg * 64 + c]; }
    __syncthreads();
}

__device__ __forceinline__ void s5mat_item(const Params& p, int item, LAS unsigned char* lds) {
    LAS lf2* pw = (LAS lf2*)lds;
    LAS lf2* bb = (LAS lf2*)(lds + 17408);
    LAS lf2* cc = (LAS lf2*)(lds + 17408 + 16384);
    LAS float* KT = (LAS float*)(lds + 17408 + 32768);
    const int tid = threadIdx.x, l = item >> 4, g = item & 15;
    for (int i = tid; i < 2 * 17 * 64; i += NTHR) { const int pp = i & 63, n = (i >> 6) % 17, d = i / (17 * 64);
        const int li = ((l * 2 + d) * 16 + g) * 64 + pp; const float lr = p.in[9][li], lim = p.in[10][li], dt = expf(p.in[11][(l * 2 + d) * 16 + g]);
        const float mag = expf((float)n * dt * lr); float s, c; sincosf((float)n * dt * lim, &s, &c); pw[i] = (lf2){mag * c, mag * s}; }
    for (int i = tid; i < 2 * 64 * 16; i += NTHR) { const int h = i & 15, pp = (i >> 4) & 63, d = i >> 10;
        const int li = ((l * 2 + d) * 16 + g) * 64 + pp; const float lr = p.in[9][li], lim = p.in[10][li], dt = expf(p.in[11][(l * 2 + d) * 16 + g]);
        const float mag = expf(dt * lr); float s, c; sincosf(dt * lim, &s, &c); const float x = mag * c - 1.0f, y = mag * s;
        const float den = 1.0f / (lr * lr + lim * lim); const float cr = (x * lr + y * lim) * den, ci = (y * lr - x * lim) * den;
        const int bi = ((l * 16 + g) * 64 + pp) * 16 + h; const float br = p.in[12][bi], bim = p.in[13][bi];
        bb[i] = (lf2){cr * br - ci * bim, cr * bim + ci * br}; }
    for (int i = tid; i < 2 * 16 * 64; i += NTHR) { const int pp = i & 63, h = (i >> 6) & 15, d = i >> 10;
        const int ci = (((l * 2 + d) * 16 + g) * 16 + h) * 64 + pp; cc[i] = (lf2){p.in[14][ci], p.in[15][ci]}; }
    __syncthreads();
    for (int i = tid; i < 2 * 16 * 256; i += NTHR) { const int h2 = i & 15, h = (i >> 4) & 15, tau = (i >> 8) & 15, d = i >> 12; float s = 0.f;
        for (int pp = 0; pp < 64; ++pp) { const lf2 c = cc[(d * 16 + h) * 64 + pp], w = pw[(d * 17 + tau) * 64 + pp], b = bb[(d * 64 + pp) * 16 + h2];
            const float tr = c.x * w.x - c.y * w.y, ti = c.x * w.y + c.y * w.x; s += tr * b.x - ti * b.y; }
        KT[i] = s; }
    __syncthreads();
    bf16_t* E = (bf16_t*)(p.ws + WS_SW + (size_t)l * SW_STRIDE + SW_S5E) + (size_t)g * 256 * 256;
    bf16_t* W2 = (bf16_t*)(p.ws + WS_SW + (size_t)l * SW_STRIDE + SW_S5W2) + (size_t)g * 256 * 512;
    for (int i = tid; i < 256 * 256; i += NTHR) { const int k = i & 255, n = i >> 8; const int s = k >> 4, h = k & 15, d = n >> 7, part = (n >> 6) & 1, pp = n & 63;
        const int e = d == 0 ? 15 - s : s; const lf2 w = pw[(d * 17 + e) * 64 + pp], b = bb[(d * 64 + pp) * 16 + h];
        E[i] = f2bf(part ? (w.x * b.y + w.y * b.x) : (w.x * b.x - w.y * b.y)); }
    for (int i = tid; i < 256 * 512; i += NTHR) { const int k = i & 511, n = i >> 9; const int t = n >> 4, h = n & 15; float v;
        if (k < 256) { const int s = k >> 4, h2 = k & 15; v = 0.f;
            if (t >= s) v += KT[((0 * 16 + (t - s)) * 16 + h) * 16 + h2];
            if (s >= t) v += KT[((1 * 16 + (s - t)) * 16 + h) * 16 + h2];
            if (s == t && h == h2) v += p.in[16][l * 256 + g * 16 + h]; }
        else { const int q = k - 256, d = q >> 7, part = (q >> 6) & 1, pp = q & 63; const int e = d == 0 ? t + 1 : 16 - t;
            const lf2 c = cc[(d * 16 + h) * 64 + pp], w = pw[(d * 17 + e) * 64 + pp];
            v = part ? -(c.x * w.y + c.y * w.x) : (c.x * w.x - c.y * w.y); }
        W2[i] = f2bf(v); }
    __syncthreads();
}

__device__ __forceinline__ void smallw_item(const Params& p, int item) {
    int i = item * NTHR + threadIdx.x; const int l = i / 212992; i %= 212992;
    unsigned char* sw = p.ws + WS_SW + (size_t)l * SW_STRIDE;
    if (i < 49152) { const int k = i & 63, n = (i >> 6) % 384, d = i / 24576; ((bf16_t*)(sw + SW_W2T))[i] = f2bf(p.in[22][((size_t)(l * 2 + d) * 64 + k) * 384 + n]); return; }
    i -= 49152;
    if (i < 49152) { const int k = i & 63, n = (i >> 6) % 384, d = i / 24576; ((bf16_t*)(sw + SW_A2T))[i] = f2bf(p.in[24][((size_t)(l * 2 + d) * 64 + k) * 384 + n]); return; }
    i -= 49152;
    if (i < 49152) { const int k = i & 127, n = i >> 7; ((bf16_t*)(sw + SW_G2T))[i] = f2bf(p.in[25][((size_t)l * 128 + k) * 384 + n]); return; }
    i -= 49152;
    { const int k = i & 255, n = i >> 8; ((bf16_t*)(sw + SW_GLUT))[i] = f2bf(p.in[17][((size_t)l * 256 + k) * 256 + n]); }
}

constexpr int PRO_MOD = 192, PRO_S5 = 32, PRO_SW = 832;
__device__ __forceinline__ void phase_prologue(const Params& p, LAS unsigned char* lds) {
    for (int it = blockIdx.x; it < PRO_MOD + PRO_S5 + PRO_SW; it += gridDim.x) {
        if (it < PRO_MOD) mod_item(p, it, lds);
        else if (it < PRO_MOD + PRO_S5) s5mat_item(p, it - PRO_MOD, lds);
        else smallw_item(p, it - PRO_MOD - PRO_S5);
    }
    convert_weights_dyn(p, 0, lds, (unsigned*)(p.ws + WS_CTL + 49152), 0, CV_TOTAL);
}

__device__ __forceinline__ void hnorm_row(const float* g, const float* mb_sh, const float* mb_sc, unsigned char* dst, float* sdst, int lane, const float4 (&v)[4]) {
    float ss = 0.f;
#pragma unroll
    for (int i = 0; i < 4; ++i) ss += v[i].x * v[i].x + v[i].y * v[i].y + v[i].z * v[i].z + v[i].w * v[i].w;
    ss = wave_sum(ss); const float rs = rsqrtf(ss * (1.0f / 1024.0f) + 1e-6f);
    float hv[4][4]; float amax = 0.f;
#pragma unroll
    for (int i = 0; i < 4; ++i) { const int c = i * 256 + lane * 4; const float4 gg = *(const float4*)(g + c), sh = *(const float4*)(mb_sh + c), sc = *(const float4*)(mb_sc + c);
        hv[i][0] = v[i].x * rs * gg.x * (1.f + sc.x) + sh.x; hv[i][1] = v[i].y * rs * gg.y * (1.f + sc.y) + sh.y; hv[i][2] = v[i].z * rs * gg.z * (1.f + sc.z) + sh.z; hv[i][3] = v[i].w * rs * gg.w * (1.f + sc.w) + sh.w;
        amax = fmaxf(amax, fmaxf(fmaxf(fabsf(hv[i][0]), fabsf(hv[i][1])), fmaxf(fabsf(hv[i][2]), fabsf(hv[i][3])))); }
#pragma unroll
    for (int o = 32; o >= 1; o >>= 1) amax = fmaxf(amax, __shfl_xor(amax, o));
    amax = fmaxf(amax, 1e-20f); const float qs = 127.0f / amax;
    if (lane == 0) *sdst = amax * (1.0f / 127.0f);
#pragma unroll
    for (int i = 0; i < 4; ++i) { unsigned w = 0u;
#pragma unroll
        for (int k = 0; k < 4; ++k) w |= ((unsigned)__float2int_rn(hv[i][k] * qs) & 255u) << (8 * k);
        *(unsigned*)(dst + i * 256 + lane * 4) = w; }
}
__device__ __forceinline__ void phase_hnorm(const Params& p, int l, const float* xl, const float* xc) {
    const int lane = threadIdx.x & 63, wv = threadIdx.x >> 6;
    const float* mod = (const float*)(p.ws + WS_MOD) + (size_t)l * 17 * 6144; const float* g = p.in[6] + (l * 4 + 0) * 1024;
    unsigned char* A = p.ws + WS_ABUF; float* SH = (float*)(p.ws + WS_SH);
    for (int r = blockIdx.x * 8 + wv; r < NROW; r += gridDim.x * 8) {
        const float* src = xrow(xl, xc, r); const int b = r < NLAT ? (r >> 11) : 16; const float* mb = mod + (size_t)b * 6144;
        float4 v[4];
#pragma unroll
        for (int i = 0; i < 4; ++i) v[i] = *(const float4*)(src + i * 256 + lane * 4);
        hnorm_row(g, mb, mb + 1024, A + (size_t)r * 1024, SH + r, lane, v);
    }
}


__device__ __forceinline__ void phase_prep(const Params& p, int l, LAS unsigned char* lds) {
    LAS bf16_t* vt = (LAS bf16_t*)lds;
    LAS lf2* cs = (LAS lf2*)(lds + 50176);
    const int tid = threadIdx.x;
    for (int i = tid; i < 1024; i += NTHR) { const int pos = i >> 4, j = i & 15; const float invf = exp2f(-(float)j * (13.287712379549449f / 16.0f)); float s, c; sincosf((float)pos * invf, &s, &c); cs[i] = (lf2){c, s}; }
    __syncthreads();
    const bf16_t* P = (const bf16_t*)(p.ws + U_P);
    bf16_t* QR = (bf16_t*)(p.ws + U_QR); bf16_t* KR = (bf16_t*)(p.ws + U_KR);
    bf16_t* RS = (bf16_t*)(p.ws + U_RS); bf16_t* KS = (bf16_t*)(p.ws + U_KS); bf16_t* VS = (bf16_t*)(p.ws + U_VS); bf16_t* KK = (bf16_t*)(p.ws + U_KK); bf16_t* ALR = (bf16_t*)(p.ws + U_ALR);
    for (int ti = blockIdx.x; ti < NROW / 64; ti += gridDim.x) {
        const int r0 = ti * 64; const bool lat = r0 < NLAT; const int b = lat ? (r0 >> 11) : ((r0 - NLAT) >> 8), t0 = lat ? (r0 & 2047) : ((r0 - NLAT) & 255), slen = lat ? SEQ : CTXL;
#pragma unroll
        for (int i = 0; i < 6; ++i) { const int idx = tid + NTHR * i, tok = idx / 48, pc = idx % 48;
            *(LAS lu4*)(vt + tok * 392 + pc * 8) = *(const lu4*)(P + (size_t)(r0 + tok) * NINP + C_V + pc * 8); }
        __syncthreads();
        { bf16_t* vdst = lat ? (bf16_t*)(p.ws + U_VT) + (size_t)b * 384 * 2048 + t0 : (bf16_t*)(p.ws + U_VTC) + (size_t)b * 384 * 256 + t0;
#pragma unroll
          for (int i = 0; i < 6; ++i) { const int idx = tid + NTHR * i, hd = idx >> 3, pc = idx & 7; unsigned w[4];
#pragma unroll
              for (int j = 0; j < 4; ++j) w[j] = (unsigned)vt[(pc * 8 + 2 * j) * 392 + hd] | ((unsigned)vt[(pc * 8 + 2 * j + 1) * 392 + hd] << 16);
              *(uint4*)(vdst + (size_t)hd * slen + pc * 8) = make_uint4(w[0], w[1], w[2], w[3]); } }
#pragma unroll
        for (int i = 0; i < 4; ++i) { const int idx = tid + NTHR * i, tok = idx >> 5, pc = idx & 31;
            *(lu4*)((bf16_t*)(p.ws + U_U16) + (size_t)(r0 + tok) * 256 + pc * 8) = *(const lu4*)(P + (size_t)(r0 + tok) * NINP + pc * 8); }
        { lu4 rx[6][2]; int tq = threadIdx.x; asm volatile("" : "+v"(tq));
#pragma unroll
          for (int i = 0; i < 6; ++i) { const int idx = tq + NTHR * i, tok = idx / 48, rem = idx % 48, qk = rem / 24, rem2 = rem % 24, h = rem2 >> 2, pp = rem2 & 3;
              const int d1 = (pp >> 1) * 32 + (pp & 1) * 8; const size_t so = (size_t)(r0 + tok) * NINP + (qk ? C_K : C_Q) + h * 64 + d1;
              rx[i][0] = *(const lu4*)(P + so); rx[i][1] = *(const lu4*)(P + so + 16); }
#pragma unroll
          for (int i = 0; i < 6; ++i) { const int idx = tq + NTHR * i, tok = idx / 48, rem = idx % 48, qk = rem / 24, rem2 = rem % 24, h = rem2 >> 2, pp = rem2 & 3;
              const int d1 = (pp >> 1) * 32 + (pp & 1) * 8;
              float x1[8], x2[8], o1[8], o2[8]; unpack8(make_uint4(rx[i][0].x, rx[i][0].y, rx[i][0].z, rx[i][0].w), x1); unpack8(make_uint4(rx[i][1].x, rx[i][1].y, rx[i][1].z, rx[i][1].w), x2);
              const int t = t0 + tok, pos = (pp < 2) ? (t >> 6) : (t & 63), j0 = (pp & 1) * 8; const float scl = qk ? 1.0f : 0.125f;
#pragma unroll
              for (int j = 0; j < 8; ++j) { lf2 c = cs[pos * 16 + j0 + j]; if (!lat) c = (lf2){1.f, 0.f}; o1[j] = (x1[j] * c.x - x2[j] * c.y) * scl; o2[j] = (x1[j] * c.y + x2[j] * c.x) * scl; }
              bf16_t* dq = (qk ? KR : QR) + (size_t)(r0 + tok) * 384 + h * 64 + d1; *(uint4*)dq = pack8(o1); *(uint4*)(dq + 16) = pack8(o2); } }
#pragma unroll 1
        for (int ig = 0; ig < 6; ++ig) { lu4 zc[4], zq[4], zn[4]; int ts = threadIdx.x; asm volatile("" : "+v"(ts));
#pragma unroll
            for (int u = 0; u < 4; ++u) { const int idx = ts + NTHR * (ig * 4 + u), tok = idx / 192, pc = idx % 192, t = t0 + tok; const bf16_t* zp = P + (size_t)(r0 + tok) * NINP + C_Z + pc * 8;
                zc[u] = *(const lu4*)zp; zq[u] = t > 0 ? *(const lu4*)(zp - NINP) : (lu4){0u, 0u, 0u, 0u}; zn[u] = t < slen - 1 ? *(const lu4*)(zp + NINP) : (lu4){0u, 0u, 0u, 0u}; }
#pragma unroll
            for (int u = 0; u < 4; ++u) { const int idx = ts + NTHR * (ig * 4 + u), tok = idx / 192, pc = idx % 192, c0 = pc * 8, r = r0 + tok;
                float x[8], pv[8], nx[8], zs[8];
                unpack8(make_uint4(zc[u].x, zc[u].y, zc[u].z, zc[u].w), x); unpack8(make_uint4(zq[u].x, zq[u].y, zq[u].z, zq[u].w), pv); unpack8(make_uint4(zn[u].x, zn[u].y, zn[u].z, zn[u].w), nx);
                const float4 mu0 = *(const float4*)(p.in[20] + l * 1536 + c0), mu1 = *(const float4*)(p.in[20] + l * 1536 + c0 + 4); const float mu[8] = {mu0.x, mu0.y, mu0.z, mu0.w, mu1.x, mu1.y, mu1.z, mu1.w};
#pragma unroll
                for (int j = 0; j < 8; ++j) zs[j] = x[j] + (0.5f * (pv[j] + nx[j]) - x[j]) * mu[j];
                const bool isk = c0 >= 384 && c0 < 768; float kv[8]; float ss = 0.f;
                { const int kc = isk ? c0 - 384 : 0; const float4 k0 = *(const float4*)(p.in[26] + l * 384 + kc), k1 = *(const float4*)(p.in[26] + l * 384 + kc + 4); const float kkw[8] = {k0.x, k0.y, k0.z, k0.w, k1.x, k1.y, k1.z, k1.w};
#pragma unroll
                  for (int j = 0; j < 8; ++j) { kv[j] = zs[j] * kkw[j]; ss += kv[j] * kv[j]; } }
                ss += __shfl_xor(ss, 1); ss += __shfl_xor(ss, 2); ss += __shfl_xor(ss, 4);
                if (c0 < 384) *(uint4*)(RS + (size_t)r * 384 + c0) = pack8(zs);
                else if (c0 < 768) { *(uint4*)(KS + (size_t)r * 384 + c0 - 384) = pack8(zs); const float inv = 1.0f / fmaxf(sqrtf(ss), 1e-12f);
#pragma unroll
                    for (int j = 0; j < 8; ++j) kv[j] *= inv;
                    *(uint4*)(KK + (size_t)r * 384 + c0 - 384) = pack8(kv); }
                else if (c0 < 1152) *(uint4*)(VS + (size_t)r * 384 + c0 - 768) = pack8(zs);
                else { const int ac = c0 - 1152; float o[8];
#pragma unroll
                    for (int j = 0; j < 8; ++j) o[j] = ac < 128 ? 1.0f - 2.0f / (1.0f + __expf(2.0f * zs[j])) : (ac < 256 ? zs[j] : sigm(zs[j]));
                    *(uint4*)(ALR + (size_t)r * 384 + ac) = pack8(o); } }
        }
        __syncthreads();
    }
}

template <int KS, int MODE> __device__ __forceinline__ void lr_wave(const Params& p, int l, int row0, int kofs, const bf16_t* Bt, int d) {
    const int lane = threadIdx.x & 63, m = lane & 15, q = lane >> 4;
    const bf16_t* Ap = (const bf16_t*)(p.ws + U_ALR) + (size_t)(row0 + m) * 384 + kofs + q * 8;
    bf16x8 a[KS];
#pragma unroll
    for (int ks = 0; ks < KS; ++ks) a[ks] = *(const bf16x8*)(Ap + ks * 32);
    bf16_t* O = (bf16_t*)(p.ws + (MODE == 0 ? U_LD + (size_t)d * SZ384 : (MODE == 1 ? U_AG + (size_t)d * SZ384 : U_G))) + (size_t)(row0 + m) * 384;
    const float* bias = MODE == 0 ? p.in[21] + (l * 2 + d) * 384 : p.in[23] + (l * 2 + d) * 384;
    for (int nt = 0; nt < 24; ++nt) {
        f32x4 acc = (f32x4){0.f, 0.f, 0.f, 0.f};
#pragma unroll
        for (int ks = 0; ks < KS; ++ks) { const bf16x8 bfr = *(const bf16x8*)(Bt + (size_t)(nt * 16 + m) * (KS * 32) + ks * 32 + q * 8); acc = mfma16(bfr, a[ks], acc); }
        const int n = nt * 16 + q * 4; float o[4];
        if (MODE == 2) {
#pragma unroll
            for (int j = 0; j < 4; ++j) o[j] = acc[j];
        } else { const float4 bv = *(const float4*)(bias + n); const float bb[4] = {bv.x, bv.y, bv.z, bv.w};
#pragma unroll
            for (int j = 0; j < 4; ++j) { const float s = sigm(bb[j] + acc[j]); o[j] = MODE == 0 ? -0.6065306597f * s : s; } }
        u32x2 w; w.x = pack2(o[0], o[1]); w.y = pack2(o[2], o[3]); *(u32x2*)(O + n) = w;
    }
}
template <int KS, int MODE> __device__ __forceinline__ void lr_block(const Params& p, int l, const bf16_t* Bt, int kofs, int d, int bi, int nb, LAS unsigned char* lds) {
    constexpr int PITCH = KS * 32 + 8;
    LAS bf16_t* sB = (LAS bf16_t*)lds; LAS float* sbias = (LAS float*)(lds + 384 * PITCH * 2);
    const int tid = threadIdx.x, lane = tid & 63, m = lane & 15, q = lane >> 4, wv = tid >> 6;
    const float* bias = MODE == 0 ? p.in[21] + (l * 2 + d) * 384 : p.in[23] + (l * 2 + d) * 384;
    __syncthreads();
    { lu4 st_[3 * KS];
#pragma unroll
      for (int j = 0; j < 3 * KS; ++j) { const int i = tid + NTHR * j, n = i / (KS * 4), pc = i % (KS * 4); st_[j] = *(const lu4*)(Bt + (size_t)n * (KS * 32) + pc * 8); }
      __builtin_amdgcn_sched_barrier(0);
#pragma unroll
      for (int j = 0; j < 3 * KS; ++j) { const int i = tid + NTHR * j, n = i / (KS * 4), pc = i % (KS * 4); *(LAS lu4*)(sB + n * PITCH + pc * 8) = st_[j]; } }
    if (MODE != 2) for (int i = tid; i < 384; i += NTHR) sbias[i] = bias[i];
    __syncthreads();
    bf16_t* Ob = (bf16_t*)(p.ws + (MODE == 0 ? U_LD + (size_t)d * SZ384 : (MODE == 1 ? U_AG + (size_t)d * SZ384 : U_G)));
    for (int rt = bi * 8 + wv; rt < 2304; rt += nb * 8) { const int row0 = rt * 16;
        const bf16_t* Ap = (const bf16_t*)(p.ws + U_ALR) + (size_t)(row0 + m) * 384 + kofs + q * 8;
        bf16x8 a[KS];
#pragma unroll
        for (int ks = 0; ks < KS; ++ks) a[ks] = *(const bf16x8*)(Ap + ks * 32);
        bf16_t* O = Ob + (size_t)(row0 + m) * 384;
#pragma unroll 4
        for (int nt = 0; nt < 24; ++nt) {
            f32x4 acc = (f32x4){0.f, 0.f, 0.f, 0.f};
#pragma unroll
            for (int ks = 0; ks < KS; ++ks) acc = mfma16(*(const LAS bf16x8*)(sB + (nt * 16 + m) * PITCH + ks * 32 + q * 8), a[ks], acc);
            const int n = nt * 16 + q * 4; float o[4];
            if (MODE == 2) {
#pragma unroll
                for (int j = 0; j < 4; ++j) o[j] = acc[j];
            } else { const lf4 bv = *(const LAS lf4*)(sbias + n); const float bb[4] = {bv.x, bv.y, bv.z, bv.w};
#pragma unroll
                for (int j = 0; j < 4; ++j) { const float sg = sigm(bb[j] + acc[j]); o[j] = MODE == 0 ? -0.6065306597f * sg : sg; } }
            u32x2 w; w.x = pack2(o[0], o[1]); w.y = pack2(o[2], o[3]); *(u32x2*)(O + n) = w;
        }
    }
    __syncthreads();
}
__device__ __forceinline__ void lowrank_items(const Params& p, int l, int wid, int nw, LAS unsigned char* lds) {
    const unsigned char* sw = p.ws + WS_SW + (size_t)l * SW_STRIDE; const int G = gridDim.x, bx = blockIdx.x;
    if (G >= 12) {
        const int sh = bx * 6 / G, mm = sh < 4 ? sh : 4; const int lo = (mm * G + 5) / 6, hi = mm < 4 ? ((mm + 1) * G + 5) / 6 : G, bi = bx - lo, nb = hi - lo;
        if (mm < 2) lr_block<2, 0>(p, l, (const bf16_t*)(sw + SW_W2T) + (size_t)mm * 384 * 64, mm * 64, mm, bi, nb, lds);
        else if (mm < 4) lr_block<2, 1>(p, l, (const bf16_t*)(sw + SW_A2T) + (size_t)(mm - 2) * 384 * 64, mm * 64, mm - 2, bi, nb, lds);
        else lr_block<4, 2>(p, l, (const bf16_t*)(sw + SW_G2T), 256, 0, bi, nb, lds);
        return; }
    for (int it = wid; it < 2304 * 5; it += nw) { const int rt = it / 5, m = it % 5, row0 = rt * 16;
        if (m < 2) lr_wave<2, 0>(p, l, row0, m * 64, (const bf16_t*)(sw + SW_W2T) + (size_t)m * 384 * 64, m);
        else if (m < 4) lr_wave<2, 1>(p, l, row0, m * 64, (const bf16_t*)(sw + SW_A2T) + (size_t)(m - 2) * 384 * 64, m - 2);
        else lr_wave<4, 2>(p, l, row0, 256, (const bf16_t*)(sw + SW_G2T), 0); }
}

__device__ __forceinline__ int s5_rowbase(int cr) { const int b = cr / 144, c = cr % 144; return c < 16 ? NLAT + b * 256 + c * 16 : b * 2048 + (c - 16) * 16; }
__device__ __forceinline__ void s5_pass1_items(const Params& p, int l, int wid, int nw) {
    const int lane = threadIdx.x & 63, m = lane & 15, q = lane >> 4;
    const bf16_t* P = (const bf16_t*)(p.ws + U_U16); float* SLOC = (float*)(p.ws + U_SLOC);
    for (int it = wid; it < 144 * 16; it += nw) { const int ct = it >> 4, g = it & 15, cr = ct * 16 + m, rb = s5_rowbase(cr);
        const bf16_t* E = (const bf16_t*)(p.ws + WS_SW + (size_t)l * SW_STRIDE + SW_S5E) + (size_t)g * 256 * 256;
        bf16x8 a[8];
#pragma unroll
        for (int ks = 0; ks < 8; ++ks) a[ks] = *(const bf16x8*)(P + (size_t)(rb + 2 * ks + (q >> 1)) * 256 + g * 16 + (q & 1) * 8);
        float* o = SLOC + ((size_t)cr * 16 + g) * 256 + q * 4;
#pragma unroll 2
        for (int nt = 0; nt < 16; ++nt) { f32x4 acc = (f32x4){0.f, 0.f, 0.f, 0.f}; const bf16_t* ep = E + (size_t)(nt * 16 + m) * 256 + q * 8;
#pragma unroll
            for (int ks = 0; ks < 8; ++ks) acc = mfma16(*(const bf16x8*)(ep + ks * 32), a[ks], acc);
            *(f32x4*)(o + nt * 16) = acc; }
    }
}
__device__ __forceinline__ void s5_pass1_block(const Params& p, int l, LAS unsigned char* lds) {
    constexpr int PITCH = 264;
    LAS bf16_t* sE = (LAS bf16_t*)lds;
    const int tid = threadIdx.x, lane = tid & 63, m = lane & 15, q = lane >> 4, wv = tid >> 6, G = gridDim.x, bx = blockIdx.x;
    const int combo = bx & 31, g = combo >> 1, half = combo & 1, bi = bx >> 5, nb = G >> 5;
    const bf16_t* E = (const bf16_t*)(p.ws + WS_SW + (size_t)l * SW_STRIDE + SW_S5E) + ((size_t)g * 256 + half * 128) * 256;
    const bf16_t* P = (const bf16_t*)(p.ws + U_U16); float* SLOC = (float*)(p.ws + U_SLOC);
    __syncthreads();
    { lu4 st_[8];
#pragma unroll
      for (int j = 0; j < 8; ++j) { const int i = tid + NTHR * j, n = i >> 5, pc = i & 31; st_[j] = *(const lu4*)(E + (size_t)n * 256 + pc * 8); }
      __builtin_amdgcn_sched_barrier(0);
#pragma unroll
      for (int j = 0; j < 8; ++j) { const int i = tid + NTHR * j, n = i >> 5, pc = i & 31; *(LAS lu4*)(sE + n * PITCH + pc * 8) = st_[j]; } }
    __syncthreads();
    LAS unsigned char* eb = (LAS unsigned char*)(sE + m * PITCH + q * 8); asm volatile("" : "+v"(eb));
    for (int ct = bi * 8 + wv; ct < 144; ct += nb * 8) { const int cr = ct * 16 + m, rb = s5_rowbase(cr);
        bf16x8 a[8];
#pragma unroll
        for (int ks = 0; ks < 8; ++ks) a[ks] = *(const bf16x8*)(P + (size_t)(rb + 2 * ks + (q >> 1)) * 256 + g * 16 + (q & 1) * 8);
        float* o = SLOC + ((size_t)cr * 16 + g) * 256 + half * 128 + q * 4;
#pragma unroll 2
        for (int nt = 0; nt < 8; ++nt) { f32x4 acc = (f32x4){0.f, 0.f, 0.f, 0.f};
#pragma unroll
            for (int ks = 0; ks < 8; ++ks) acc = mfma16(*(const LAS bf16x8*)(eb + nt * 16 * PITCH * 2 + ks * 64), a[ks], acc);
            *(f32x4*)(o + nt * 16) = acc; } }
    __syncthreads();
}
__device__ __forceinline__ void s5_carry(const Params& p, int l) {
    const int gid = blockIdx.x * NTHR + threadIdx.x; if (gid >= 32768) return;
    const int pp = gid & 63, d = (gid >> 6) & 1, g = (gid >> 7) & 15, b = gid >> 11;
    const int li = ((l * 2 + d) * 16 + g) * 64 + pp; const float lr = p.in[9][li], lim = p.in[10][li], dt = expf(p.in[11][(l * 2 + d) * 16 + g]);
    const float mag = expf(16.0f * dt * lr); float sn, cn; sincosf(16.0f * dt * lim, &sn, &cn); const float ar = mag * cn, ai = mag * sn;
    const float* SLOC = (const float*)(p.ws + U_SLOC); bf16_t* SP = (bf16_t*)(p.ws + U_SPREV);
    float sr = 0.f, si = 0.f;
#pragma unroll 8
    for (int n = 0; n < 144; ++n) { const int c = d == 0 ? n : (n < 16 ? 15 - n : 159 - n); const size_t idx = ((size_t)(b * 144 + c) * 16 + g) * 256 + d * 128 + pp;
        SP[idx] = f2bf(sr); SP[idx + 64] = f2bf(si);
        const float xr = SLOC[idx], xi = SLOC[idx + 64]; const float nr = ar * sr - ai * si + xr, ni = ar * si + ai * sr + xi; sr = nr; si = ni; }
}
__device__ __forceinline__ void s5_pass2_items(const Params& p, int l, int wid, int nw) {
    const int lane = threadIdx.x & 63, m = lane & 15, q = lane >> 4;
    const bf16_t* P = (const bf16_t*)(p.ws + U_U16); const bf16_t* SP = (const bf16_t*)(p.ws + U_SPREV); bf16_t* YG = (bf16_t*)(p.ws + U_YG);
    for (int it = wid; it < 144 * 16; it += nw) { const int ct = it >> 4, g = it & 15; if (l == 1 && ct % 9 == 0) continue;
        const int cr = ct * 16 + m, rb = s5_rowbase(cr);
        const bf16_t* W2 = (const bf16_t*)(p.ws + WS_SW + (size_t)l * SW_STRIDE + SW_S5W2) + (size_t)g * 256 * 512;
        bf16x8 a[16];
#pragma unroll
        for (int ks = 0; ks < 8; ++ks) a[ks] = *(const bf16x8*)(P + (size_t)(rb + 2 * ks + (q >> 1)) * 256 + g * 16 + (q & 1) * 8);
#pragma unroll
        for (int ks = 8; ks < 16; ++ks) a[ks] = *(const bf16x8*)(SP + ((size_t)cr * 16 + g) * 256 + (ks - 8) * 32 + q * 8);
#pragma unroll 2
        for (int nt = 0; nt < 16; ++nt) { f32x4 acc = (f32x4){0.f, 0.f, 0.f, 0.f}; const bf16_t* wp = W2 + (size_t)(nt * 16 + m) * 512 + q * 8;
#pragma unroll
            for (int ks = 0; ks < 16; ++ks) acc = mfma16(*(const bf16x8*)(wp + ks * 32), a[ks], acc);
            float o[4];
#pragma unroll
            for (int j = 0; j < 4; ++j) { const float x = acc[j]; const float u = 0.7978845608f * (x + 0.044715f * x * x * x); const float th = 1.0f - 2.0f / (1.0f + __expf(2.0f * u)); o[j] = 0.5f * x * (1.0f + th); }
            u32x2 w; w.x = pack2(o[0], o[1]); w.y = pack2(o[2], o[3]); *(u32x2*)(YG + (size_t)(rb + nt) * 256 + g * 16 + q * 4) = w; }
    }
}
__device__ __forceinline__ void s5_pass2_block(const Params& p, int l, int vb, int nvb, LAS unsigned char* lds) {
    constexpr int PITCH = 520;
    LAS bf16_t* sW = (LAS bf16_t*)lds;
    const int tid = threadIdx.x, lane = tid & 63, m = lane & 15, q = lane >> 4, wv = tid >> 6;
    const bf16_t* P = (const bf16_t*)(p.ws + U_U16); const bf16_t* SP = (const bf16_t*)(p.ws + U_SPREV); bf16_t* YG = (bf16_t*)(p.ws + U_YG);
    if ((nvb & 63) != 0) { s5_pass2_items(p, l, vb * 8 + wv, nvb * 8); return; }
    { const int combo = vb & 63, g = combo >> 2, qd = combo & 3, bi = vb >> 6, nb = nvb >> 6;
        const bf16_t* W2 = (const bf16_t*)(p.ws + WS_SW + (size_t)l * SW_STRIDE + SW_S5W2) + ((size_t)g * 256 + qd * 64) * 512;
        __syncthreads();
        { lu4 st_[8];
#pragma unroll
          for (int j = 0; j < 8; ++j) { const int i = tid + NTHR * j, n = i >> 6, pc = i & 63; st_[j] = *(const lu4*)(W2 + (size_t)n * 512 + pc * 8); }
          __builtin_amdgcn_sched_barrier(0);
#pragma unroll
          for (int j = 0; j < 8; ++j) { const int i = tid + NTHR * j, n = i >> 6, pc = i & 63; *(LAS lu4*)(sW + n * PITCH + pc * 8) = st_[j]; } }
        __syncthreads();
        LAS unsigned char* wb = (LAS unsigned char*)(sW + m * PITCH + q * 8); asm volatile("" : "+v"(wb));
        for (int ct = bi * 8 + wv; ct < 144; ct += nb * 8) { if (l == 1 && ct % 9 == 0) continue;
            const int cr = ct * 16 + m, rb = s5_rowbase(cr);
            bf16x8 a[16];
#pragma unroll
            for (int ks = 0; ks < 8; ++ks) a[ks] = *(const bf16x8*)(P + (size_t)(rb + 2 * ks + (q >> 1)) * 256 + g * 16 + (q & 1) * 8);
#pragma unroll
            for (int ks = 8; ks < 16; ++ks) a[ks] = *(const bf16x8*)(SP + ((size_t)cr * 16 + g) * 256 + (ks - 8) * 32 + q * 8);
#pragma unroll 1
            for (int nt = 0; nt < 4; ++nt) { f32x4 acc = (f32x4){0.f, 0.f, 0.f, 0.f};
#pragma unroll
                for (int ks = 0; ks < 16; ++ks) acc = mfma16(*(const LAS bf16x8*)(wb + nt * 16 * PITCH * 2 + ks * 64), a[ks], acc);
                float o[4];
#pragma unroll
                for (int j = 0; j < 4; ++j) { const float x = acc[j]; const float u = 0.7978845608f * (x + 0.044715f * x * x * x); const float th = 1.0f - 2.0f / (1.0f + __expf(2.0f * u)); o[j] = 0.5f * x * (1.0f + th); }
                u32x2 w; w.x = pack2(o[0], o[1]); w.y = pack2(o[2], o[3]); *(u32x2*)(YG + (size_t)(rb + qd * 4 + nt) * 256 + g * 16 + q * 4) = w; } }
    }
    __syncthreads();
}
__device__ __forceinline__ void s5_glu_items(const Params& p, int l, int wid, int nw) {
    const int lane = threadIdx.x & 63, m = lane & 15, q = lane >> 4;
    const bf16_t* YG = (const bf16_t*)(p.ws + U_YG); bf16_t* YC = (bf16_t*)(p.ws + WS_ABUF);
    const bf16_t* GT = (const bf16_t*)(p.ws + WS_SW + (size_t)l * SW_STRIDE + SW_GLUT);
    const int nrt = (l == 0 ? NROW : NLAT) / 16;
    for (int rt = wid; rt < nrt; rt += nw) { const int row = rt * 16 + m;
        bf16x8 a[8];
#pragma unroll
        for (int ks = 0; ks < 8; ++ks) a[ks] = *(const bf16x8*)(YG + (size_t)row * 256 + ks * 32 + q * 8);
#pragma unroll 2
        for (int nt = 0; nt < 16; ++nt) { f32x4 acc = (f32x4){0.f, 0.f, 0.f, 0.f}; const bf16_t* gp = GT + (size_t)(nt * 16 + m) * 256 + q * 8;
#pragma unroll
            for (int ks = 0; ks < 8; ++ks) acc = mfma16(*(const bf16x8*)(gp + ks * 32), a[ks], acc);
            const int n = nt * 16 + q * 4; const float4 bv = *(const float4*)(p.in[18] + l * 256 + n); const u32x2 yw = *(const u32x2*)(YG + (size_t)row * 256 + n);
            u32x2 w; w.x = pack2(bflo(yw.x) * sigm(acc[0] + bv.x), bfhi(yw.x) * sigm(acc[1] + bv.y)); w.y = pack2(bflo(yw.y) * sigm(acc[2] + bv.z), bfhi(yw.y) * sigm(acc[3] + bv.w));
            *(u32x2*)(YC + (size_t)row * 1024 + n) = w; }
    }
}

__device__ __forceinline__ void s5_glu_block(const Params& p, int l, int vb, int nvb, LAS unsigned char* lds) {
    constexpr int PITCH = 264;
    LAS bf16_t* sG = (LAS bf16_t*)lds;
    const int tid = threadIdx.x, lane = tid & 63, m = lane & 15, q = lane >> 4, wv = tid >> 6;
    if (nvb < 2 || (nvb & 1)) { s5_glu_items(p, l, vb * 8 + wv, nvb * 8); return; }
    const int half = vb & 1, bi = vb >> 1, nb = nvb >> 1;
    const bf16_t* YG = (const bf16_t*)(p.ws + U_YG); bf16_t* YC = (bf16_t*)(p.ws + WS_ABUF);
    const bf16_t* GT = (const bf16_t*)(p.ws + WS_SW + (size_t)l * SW_STRIDE + SW_GLUT) + (size_t)half * 128 * 256;
    __syncthreads();
    { lu4 st_[8];
#pragma unroll
      for (int j = 0; j < 8; ++j) { const int i = tid + NTHR * j, n = i >> 5, pc = i & 31; st_[j] = *(const lu4*)(GT + (size_t)n * 256 + pc * 8); }
      __builtin_amdgcn_sched_barrier(0);
#pragma unroll
      for (int j = 0; j < 8; ++j) { const int i = tid + NTHR * j, n = i >> 5, pc = i & 31; *(LAS lu4*)(sG + n * PITCH + pc * 8) = st_[j]; } }
    __syncthreads();
    LAS unsigned char* gb = (LAS unsigned char*)(sG + m * PITCH + q * 8); asm volatile("" : "+v"(gb));
    const int nrt = (l == 0 ? NROW : NLAT) / 16;
    for (int rt = bi * 8 + wv; rt < nrt; rt += nb * 8) { const int row = rt * 16 + m;
        bf16x8 a[8];
#pragma unroll
        for (int ks = 0; ks < 8; ++ks) a[ks] = *(const bf16x8*)(YG + (size_t)row * 256 + ks * 32 + q * 8);
#pragma unroll 2
        for (int nt = 0; nt < 8; ++nt) { f32x4 acc = (f32x4){0.f, 0.f, 0.f, 0.f};
#pragma unroll
            for (int ks = 0; ks < 8; ++ks) acc = mfma16(*(const LAS bf16x8*)(gb + nt * 16 * PITCH * 2 + ks * 64), a[ks], acc);
            const int n = half * 128 + nt * 16 + q * 4; const float4 bv = *(const float4*)(p.in[18] + l * 256 + n); const u32x2 yw = *(const u32x2*)(YG + (size_t)row * 256 + n);
            u32x2 w; w.x = pack2(bflo(yw.x) * sigm(acc[0] + bv.x), bfhi(yw.x) * sigm(acc[1] + bv.y)); w.y = pack2(bflo(yw.y) * sigm(acc[2] + bv.z), bfhi(yw.y) * sigm(acc[3] + bv.w));
            *(u32x2*)(YC + (size_t)row * 1024 + n) = w; } }
    __syncthreads();
}

template <bool HASLAT> __device__ __forceinline__ void na_unit(const Params& p, const LAS float* rpb_l, int b, int h, int i, int n) {
    const int lane = threadIdx.x & 63, m = lane & 15, q = lane >> 4, kin = 8 * (m >> 2) + (m & 3);
    const bf16_t* QR = (const bf16_t*)(p.ws + U_QR); const bf16_t* KR = (const bf16_t*)(p.ws + U_KR);
    const bf16_t* VTL = (const bf16_t*)(p.ws + U_VT) + (size_t)(b * 6 + h) * 64 * 2048; const bf16_t* VTC = (const bf16_t*)(p.ws + U_VTC) + (size_t)(b * 6 + h) * 64 * 256;
    const int qrow = HASLAT ? b * 2048 + i * 64 + n * 16 + m : NLAT + b * 256 + n * 16 + m;
    bf16x8 qf[2];
#pragma unroll
    for (int ks = 0; ks < 2; ++ks) qf[ks] = *(const bf16x8*)(QR + (size_t)qrow * 384 + h * 64 + ks * 32 + q * 8);
    const int r0 = HASLAT ? min(max(i - 4, 0), 24) : 0, scol = HASLAT ? min(max(n * 16 - 8, 0), 32) : 0;
    f32x4 sl[HASLAT ? 16 : 1], sc[16];
    float mx = -3.0e38f;
    if (HASLAT) { const int qc = n * 16 + m, c0 = min(max(qc - 8, 0), 48); const LAS float* rpb = rpb_l + h * 15 * 31;
#pragma unroll
        for (int t = 0; t < 16; ++t) { const int kr = t >> 1, ch = t & 1; const bf16_t* kp = KR + (size_t)(b * 2048 + (r0 + kr) * 64 + scol + kin + 4 * ch) * 384 + h * 64 + q * 8;
            f32x4 acc = (f32x4){0.f, 0.f, 0.f, 0.f};
#pragma unroll
            for (int ks = 0; ks < 2; ++ks) acc = mfma16(*(const bf16x8*)(kp + ks * 32), qf[ks], acc);
            const int dr = r0 + kr - i + 7;
#pragma unroll
            for (int j = 0; j < 4; ++j) { const int kc = scol + 8 * q + 4 * ch + j; const bool valid = kc >= c0 && kc < c0 + 16; const int dc = min(max(kc - qc + 15, 0), 30);
                const float s = valid ? acc[j] + rpb[dr * 31 + dc] : -1.0e30f; acc[j] = s; mx = fmaxf(mx, s); }
            sl[t] = acc; if ((t & 7) == 7) __builtin_amdgcn_sched_barrier(0); } }
#pragma unroll
    for (int t = 0; t < 16; ++t) { const bf16_t* kp = KR + (size_t)(NLAT + b * 256 + (t >> 1) * 32 + kin + 4 * (t & 1)) * 384 + h * 64 + q * 8;
        f32x4 acc = (f32x4){0.f, 0.f, 0.f, 0.f};
#pragma unroll
        for (int ks = 0; ks < 2; ++ks) acc = mfma16(*(const bf16x8*)(kp + ks * 32), qf[ks], acc);
#pragma unroll
        for (int j = 0; j < 4; ++j) mx = fmaxf(mx, acc[j]);
        sc[t] = acc; }
    mx = fmaxf(mx, __shfl_xor(mx, 16)); mx = fmaxf(mx, __shfl_xor(mx, 32));
    float sum = 0.f;
    f32x4 o[4];
#pragma unroll
    for (int dt = 0; dt < 4; ++dt) o[dt] = (f32x4){0.f, 0.f, 0.f, 0.f};
    if (HASLAT) {
#pragma unroll
        for (int kr = 0; kr < 8; ++kr) { float e[8];
#pragma unroll
            for (int j = 0; j < 4; ++j) { e[j] = __expf(sl[2 * kr][j] - mx); e[4 + j] = __expf(sl[2 * kr + 1][j] - mx); }
#pragma unroll
            for (int j = 0; j < 8; ++j) sum += e[j];
            const uint4 pw = pack8(e); const bf16x8 pf = __builtin_bit_cast(bf16x8, pw);
            const int tok = (r0 + kr) * 64 + scol + q * 8;
#pragma unroll
            for (int dt = 0; dt < 4; ++dt) o[dt] = mfma16(*(const bf16x8*)(VTL + (size_t)(dt * 16 + m) * 2048 + tok), pf, o[dt]);
            if (kr & 1) __builtin_amdgcn_sched_barrier(0); } }
#pragma unroll
    for (int t2 = 0; t2 < 8; ++t2) { float e[8];
#pragma unroll
        for (int j = 0; j < 4; ++j) { e[j] = __expf(sc[2 * t2][j] - mx); e[4 + j] = __expf(sc[2 * t2 + 1][j] - mx); }
#pragma unroll
        for (int j = 0; j < 8; ++j) sum += e[j];
        const uint4 pw = pack8(e); const bf16x8 pf = __builtin_bit_cast(bf16x8, pw);
        const int tok = t2 * 32 + q * 8;
#pragma unroll
        for (int dt = 0; dt < 4; ++dt) o[dt] = mfma16(*(const bf16x8*)(VTC + (size_t)(dt * 16 + m) * 256 + tok), pf, o[dt]);
        if (t2 & 1) __builtin_amdgcn_sched_barrier(0); }
    sum += __shfl_xor(sum, 16); sum += __shfl_xor(sum, 32);
    const float inv = 1.0f / sum;
    bf16_t* yo = (bf16_t*)(p.ws + WS_ABUF) + (size_t)qrow * 1024 + 256 + h * 64 + q * 4;
#pragma unroll
    for (int dt = 0; dt < 4; ++dt) { u32x2 w; w.x = pack2(o[dt][0] * inv, o[dt][1] * inv); w.y = pack2(o[dt][2] * inv, o[dt][3] * inv); *(u32x2*)(yo + dt * 16) = w; }
}
#define NA_SHX(x, msk) __builtin_bit_cast(float, __builtin_amdgcn_ds_bpermute((lane ^ (msk)) << 2, __builtin_bit_cast(int, (x))))
template <bool HASLAT> __device__ __forceinline__ void na_block(const Params& p, int l, int b, int h, int sel, LAS unsigned char* lds) {
    LAS bf16_t* Ks = (LAS bf16_t*)lds;
    LAS bf16_t* Vs = (LAS bf16_t*)lds;
    LAS float* rp = (LAS float*)(lds + 120064);
    int tid = threadIdx.x; asm volatile("" : "+v"(tid));
    const int lane = tid & 63, m = lane & 15, q = lane >> 4, w = tid >> 6, kin = 8 * (m >> 2) + (m & 3);
    const bf16_t* QR = (const bf16_t*)(p.ws + U_QR); const bf16_t* KR = (const bf16_t*)(p.ws + U_KR);
    const bf16_t* VTL = (const bf16_t*)(p.ws + U_VT) + (size_t)(b * 6 + h) * 64 * 2048; const bf16_t* VTC = (const bf16_t*)(p.ws + U_VTC) + (size_t)(b * 6 + h) * 64 * 256;
    const int i0 = HASLAT ? 2 * sel : 0, rlo = HASLAT ? min(max(i0 - 4, 0), 24) : 0;
    __syncthreads();
    int tk = threadIdx.x; asm volatile("" : "+v"(tk));
    { lu4 kl[HASLAT ? 9 : 1], kc[4]; float rpv = 0.f;
      if (HASLAT) {
#pragma unroll
        for (int j = 0; j < 9; ++j) { const int idx = tk + NTHR * j, key = idx >> 3, pc = idx & 7, tok = min(rlo * 64 + key, 2047);
            kl[j] = *(const lu4*)(KR + (size_t)(b * 2048 + tok) * 384 + h * 64 + pc * 8); }
        rpv = p.in[19][(size_t)(l * 6 + h) * 465 + min(tk, 464)]; }
#pragma unroll
      for (int j = 0; j < 4; ++j) { const int idx = tk + NTHR * j, key = idx >> 3, pc = idx & 7; kc[j] = *(const lu4*)(KR + (size_t)(NLAT + b * 256 + key) * 384 + h * 64 + pc * 8); }
      __builtin_amdgcn_sched_barrier(0);
      if (HASLAT) {
#pragma unroll
        for (int j = 0; j < 9; ++j) { const int idx = tk + NTHR * j, key = idx >> 3, pc = idx & 7; *(LAS lu4*)(Ks + key * 72 + pc * 8) = kl[j]; }
        if (tk < 465) rp[tk] = rpv; }
#pragma unroll
      for (int j = 0; j < 4; ++j) { const int idx = tk + NTHR * j, key = idx >> 3, pc = idx & 7; *(LAS lu4*)(Ks + (576 + key) * 72 + pc * 8) = kc[j]; } }
    const int i = HASLAT ? i0 + (w >> 2) : 0, n = HASLAT ? (w & 3) : sel * 8 + w;
    const int qrow = HASLAT ? b * 2048 + i * 64 + n * 16 + m : NLAT + b * 256 + n * 16 + m;
    bf16x8 qf[2];
#pragma unroll
    for (int ks = 0; ks < 2; ++ks) qf[ks] = *(const bf16x8*)(QR + (size_t)qrow * 384 + h * 64 + ks * 32 + q * 8);
    const int r0 = HASLAT ? min(max(i - 4, 0), 24) : 0, scol = HASLAT ? min(max(n * 16 - 8, 0), 32) : 0, kb = (r0 - rlo) * 64 + scol;
    LAS unsigned char* kbl = (LAS unsigned char*)(Ks + (kb + kin) * 72 + q * 8); LAS unsigned char* kbc = (LAS unsigned char*)(Ks + (576 + kin) * 72 + q * 8);
    asm volatile("" : "+v"(kbl), "+v"(kbc));
    __syncthreads();
    float mx1 = -3.0e38f, mx2 = -3.0e38f, sum1 = 0.f, sum2 = 0.f;
    bf16x8 pl[HASLAT ? 8 : 1], pcx[8];
    if (HASLAT) { const int qc = n * 16 + m, c0 = min(max(qc - 8, 0), 48); f32x4 sl[16];
#pragma unroll
        for (int t = 0; t < 16; ++t) { const int kr = t >> 1, ch = t & 1; const LAS bf16_t* kp = (const LAS bf16_t*)(kbl + (kr * 64 + 4 * ch) * 144);
            f32x4 acc = (f32x4){0.f, 0.f, 0.f, 0.f};
#pragma unroll
            for (int ks = 0; ks < 2; ++ks) acc = mfma16(*(const LAS bf16x8*)(kp + ks * 32), qf[ks], acc);
            const int dr = r0 + kr - i + 7;
#pragma unroll
            for (int j = 0; j < 4; ++j) { const int kc = scol + 8 * q + 4 * ch + j; const bool valid = kc >= c0 && kc < c0 + 16; const int dc = min(max(kc - qc + 15, 0), 30);
                float bias = rp[dr * 31 + dc]; asm("" : "+v"(bias));
                const float sv = valid ? acc[j] + bias : -1.0e30f; acc[j] = sv; mx1 = fmaxf(mx1, sv); }
            sl[t] = acc; if ((t & 3) == 3) __builtin_amdgcn_sched_barrier(0); }
        mx1 = fmaxf(mx1, NA_SHX(mx1, 16)); mx1 = fmaxf(mx1, NA_SHX(mx1, 32));
#pragma unroll
        for (int kr = 0; kr < 8; ++kr) { float e[8];
#pragma unroll
            for (int j = 0; j < 4; ++j) { e[j] = __expf(sl[2 * kr][j] - mx1); e[4 + j] = __expf(sl[2 * kr + 1][j] - mx1); }
#pragma unroll
            for (int j = 0; j < 8; ++j) sum1 += e[j];
            const uint4 pw = pack8(e); pl[kr] = __builtin_bit_cast(bf16x8, pw); }
        __builtin_amdgcn_sched_barrier(0); }
    { f32x4 sc[16];
#pragma unroll
      for (int t = 0; t < 16; ++t) { const LAS bf16_t* kp = (const LAS bf16_t*)(kbc + ((t >> 1) * 32 + 4 * (t & 1)) * 144);
          f32x4 acc = (f32x4){0.f, 0.f, 0.f, 0.f};
#pragma unroll
          for (int ks = 0; ks < 2; ++ks) acc = mfma16(*(const LAS bf16x8*)(kp + ks * 32), qf[ks], acc);
#pragma unroll
          for (int j = 0; j < 4; ++j) mx2 = fmaxf(mx2, acc[j]);
          sc[t] = acc; if ((t & 3) == 3) __builtin_amdgcn_sched_barrier(0); }
      mx2 = fmaxf(mx2, NA_SHX(mx2, 16)); mx2 = fmaxf(mx2, NA_SHX(mx2, 32));
#pragma unroll
      for (int t2 = 0; t2 < 8; ++t2) { float e[8];
#pragma unroll
          for (int j = 0; j < 4; ++j) { e[j] = __expf(sc[2 * t2][j] - mx2); e[4 + j] = __expf(sc[2 * t2 + 1][j] - mx2); }
#pragma unroll
          for (int j = 0; j < 8; ++j) sum2 += e[j];
          const uint4 pw = pack8(e); pcx[t2] = __builtin_bit_cast(bf16x8, pw); } }
    sum1 += NA_SHX(sum1, 16); sum1 += NA_SHX(sum1, 32); sum2 += NA_SHX(sum2, 16); sum2 += NA_SHX(sum2, 32);
    __builtin_amdgcn_sched_barrier(0);
    __syncthreads();
    int tv = threadIdx.x; asm volatile("" : "+v"(tv));
    __builtin_amdgcn_sched_barrier(0);
    if (HASLAT) {
#pragma unroll
        for (int j = 0; j < 9; ++j) { const int idx = tv + NTHR * j, dim = idx / 72, pc = idx % 72, tok = rlo * 64 + pc * 8;
            if (tok < 2048) *(LAS lu4*)(Vs + dim * 840 + pc * 8) = *(const lu4*)(VTL + (size_t)dim * 2048 + tok); } }
#pragma unroll
    for (int j = 0; j < 4; ++j) { const int idx = tv + NTHR * j, dim = idx >> 5, pc = idx & 31; *(LAS lu4*)(Vs + dim * 840 + 576 + pc * 8) = *(const lu4*)(VTC + (size_t)dim * 256 + pc * 8); }
    __builtin_amdgcn_sched_barrier(0);
    __syncthreads();
    __builtin_amdgcn_sched_barrier(0);
    const int kbv = kb * 2;
    LAS unsigned char* vb0 = (LAS unsigned char*)(Vs + (0 * 16 + m) * 840 + q * 8); LAS unsigned char* vb1 = (LAS unsigned char*)(Vs + (1 * 16 + m) * 840 + q * 8);
    LAS unsigned char* vb2 = (LAS unsigned char*)(Vs + (2 * 16 + m) * 840 + q * 8); LAS unsigned char* vb3 = (LAS unsigned char*)(Vs + (3 * 16 + m) * 840 + q * 8);
    asm volatile("" : "+v"(vb0), "+v"(vb1), "+v"(vb2), "+v"(vb3));
    f32x4 o1[4], o2[4];
#pragma unroll
    for (int dt = 0; dt < 4; ++dt) { o1[dt] = (f32x4){0.f, 0.f, 0.f, 0.f}; o2[dt] = (f32x4){0.f, 0.f, 0.f, 0.f}; }
    if (HASLAT) {
#pragma unroll
        for (int kr = 0; kr < 8; ++kr) {
#pragma unroll
            for (int dt = 0; dt < 4; ++dt) { LAS unsigned char* vb = dt == 0 ? vb0 : dt == 1 ? vb1 : dt == 2 ? vb2 : vb3; o1[dt] = mfma16(*(const LAS bf16x8*)(vb + kbv + kr * 128), pl[kr], o1[dt]); }
            if (kr & 1) __builtin_amdgcn_sched_barrier(0); } }
#pragma unroll
    for (int t2 = 0; t2 < 8; ++t2) {
#pragma unroll
        for (int dt = 0; dt < 4; ++dt) { LAS unsigned char* vb = dt == 0 ? vb0 : dt == 1 ? vb1 : dt == 2 ? vb2 : vb3; o2[dt] = mfma16(*(const LAS bf16x8*)(vb + 1152 + t2 * 64), pcx[t2], o2[dt]); }
        if (t2 & 1) __builtin_amdgcn_sched_barrier(0); }
    const float mxm = fmaxf(mx1, mx2), a1 = HASLAT ? __expf(mx1 - mxm) : 0.f, a2 = __expf(mx2 - mxm), inv = 1.0f / (a1 * sum1 + a2 * sum2), c1 = a1 * inv, c2 = a2 * inv;
    bf16_t* yo = (bf16_t*)(p.ws + WS_ABUF) + (size_t)qrow * 1024 + 256 + h * 64 + q * 4;
#pragma unroll
    for (int dt = 0; dt < 4; ++dt) { u32x2 wv2; wv2.x = pack2(o1[dt][0] * c1 + o2[dt][0] * c2, o1[dt][1] * c1 + o2[dt][1] * c2); wv2.y = pack2(o1[dt][2] * c1 + o2[dt][2] * c2, o1[dt][3] * c1 + o2[dt][3] * c2); *(u32x2*)(yo + dt * 16) = wv2; }
}
#undef NA_SHX
__device__ __forceinline__ void na_items(const Params& p, int l, int wid, int nw, LAS unsigned char* lds) {
    (void)wid; (void)nw;
    const int nlat = 16 * 6 * 16, nctx = (l == 0) ? 16 * 6 * 2 : 0;
    for (int it = blockIdx.x; it < nlat + nctx; it += gridDim.x) {
        if (it < nlat) { const int ip = it & 15, bh = it >> 4; na_block<true>(p, l, bh / 6, bh % 6, ip, lds); }
        else { const int j = it - nlat, half = j & 1, bh = j >> 1; na_block<false>(p, l, bh / 6, bh % 6, half, lds); }
    }
    __syncthreads();
}

typedef float f32x2 __attribute__((ext_vector_type(2)));
__device__ __forceinline__ int rk_row(int b, int d, int n) { return n < 256 ? NLAT + b * 256 + (d ? 255 - n : n) : b * 2048 + (d ? 2047 - (n - 256) : (n - 256)); }
template <int CTRL> __device__ __forceinline__ float dpp_f(float v) { return __builtin_bit_cast(float, __builtin_amdgcn_update_dpp(0, __builtin_bit_cast(int, v), CTRL, 0xF, 0xF, true)); }
constexpr int RKP_WAVE = 4 * 16 * 17 * 4;
__device__ __forceinline__ bf16x8 pack_frag(const float (&lo)[4], const float (&hi)[4]) { u32x4 w; w.x = pack2(lo[0], lo[1]); w.y = pack2(lo[2], lo[3]); w.z = pack2(hi[0], hi[1]); w.w = pack2(hi[2], hi[3]); return __builtin_bit_cast(bf16x8, w); }
__device__ __forceinline__ bf16x8 pack_lo(const f32x4 v) { u32x4 w; w.x = pack2(v[0], v[1]); w.y = pack2(v[2], v[3]); w.z = 0u; w.w = 0u; return __builtin_bit_cast(bf16x8, w); }
__device__ __forceinline__ void rwkv_pre_items(const Params& p, int l, int wid, int nw, LAS unsigned char* lds) {
    const int lane = threadIdx.x & 63, m = lane & 15, q = lane >> 4, wv = threadIdx.x >> 6;
    LAS float* sM = (LAS float*)(lds + wv * RKP_WAVE);
    const bf16_t* RS = (const bf16_t*)(p.ws + U_RS); const bf16_t* KS = (const bf16_t*)(p.ws + U_KS); const bf16_t* VS = (const bf16_t*)(p.ws + U_VS); const bf16_t* KK = (const bf16_t*)(p.ws + U_KK);
    bf16x8 isel[2], idg;
    { const unsigned one = 0x3F80u << ((m & 1) * 16); const int wi = (m & 7) >> 1;
#pragma unroll
      for (int s2 = 0; s2 < 2; ++s2) { const unsigned v = (q == 2 * s2 + (m >> 3)) ? one : 0u; const u32x4 w = {wi == 0 ? v : 0u, wi == 1 ? v : 0u, wi == 2 ? v : 0u, wi == 3 ? v : 0u}; isel[s2] = __builtin_bit_cast(bf16x8, w); }
      const int jp = m & 3; const unsigned dv = (q == (m >> 2)) ? (0x3F80u << ((jp & 1) * 16)) : 0u; const u32x4 w = {0u, 0u, (jp >> 1) == 0 ? dv : 0u, (jp >> 1) == 1 ? dv : 0u}; idg = __builtin_bit_cast(bf16x8, w); }
    const f32x4 z4 = {0.f, 0.f, 0.f, 0.f};
    for (int it = wid; it < NCHUNK; it += nw) { const int u = it / 144, c = it % 144, b = u / 12, h = (u % 12) >> 1, d = u & 1;
        const bf16_t* AG = (const bf16_t*)(p.ws + U_AG + (size_t)d * SZ384); const bf16_t* LD = (const bf16_t*)(p.ws + U_LD + (size_t)d * SZ384);
        const int rb = rk_row(b, d, c * 16), sgn = d ? -1 : 1;
        const size_t ro = (size_t)(rb + sgn * m) * 384 + h * 64 + 8 * q;
        u32x4 raw[6][2]; float4 kaf[4];
#pragma unroll
        for (int ks = 0; ks < 2; ++ks) { raw[0][ks] = *(const u32x4*)(KK + ro + 32 * ks); raw[1][ks] = *(const u32x4*)(AG + ro + 32 * ks); raw[2][ks] = *(const u32x4*)(KS + ro + 32 * ks);
            raw[3][ks] = *(const u32x4*)(RS + ro + 32 * ks); raw[4][ks] = *(const u32x4*)(VS + ro + 32 * ks); raw[5][ks] = *(const u32x4*)(LD + ro + 32 * ks);
            kaf[2 * ks] = *(const float4*)(p.in[27] + l * 384 + h * 64 + 32 * ks + 8 * q); kaf[2 * ks + 1] = *(const float4*)(p.in[27] + l * 384 + h * 64 + 32 * ks + 8 * q + 4); }
        __builtin_amdgcn_sched_barrier(0);
        bf16x8 atf[2], rtf[2], bhf[2], khf[2], vf[2];
#pragma unroll
        for (int ks = 0; ks < 2; ++ks) { float at[8], bh[8], kh[8], rt[8], lk[8];
            const float ka[8] = {kaf[2 * ks].x, kaf[2 * ks].y, kaf[2 * ks].z, kaf[2 * ks].w, kaf[2 * ks + 1].x, kaf[2 * ks + 1].y, kaf[2 * ks + 1].z, kaf[2 * ks + 1].w};
#pragma unroll
            for (int w = 0; w < 4; ++w)
#pragma unroll
                for (int hh = 0; hh < 2; ++hh) { const int i = 2 * w + hh;
                    const float kk_ = hh ? bfhi(raw[0][ks][w]) : bflo(raw[0][ks][w]), ag_ = hh ? bfhi(raw[1][ks][w]) : bflo(raw[1][ks][w]), k_ = hh ? bfhi(raw[2][ks][w]) : bflo(raw[2][ks][w]);
                    const float r_ = hh ? bfhi(raw[3][ks][w]) : bflo(raw[3][ks][w]), ld2 = (hh ? bfhi(raw[5][ks][w]) : bflo(raw[5][ks][w])) * 1.4426950408889634f;
                    float L = ld2; L += dpp_f<0x111>(L); L += dpp_f<0x112>(L); L += dpp_f<0x114>(L); L += dpp_f<0x118>(L);
                    const float e1 = __builtin_amdgcn_exp2f(L), ei = __builtin_amdgcn_exp2f(-L), e0 = __builtin_amdgcn_exp2f(L - ld2);
                    at[i] = -kk_ * e0; bh[i] = kk_ * ag_ * ei; kh[i] = k_ * (1.0f + (ag_ - 1.0f) * ka[i]) * ei; rt[i] = r_ * e1; lk[i] = L * 0.6931471805599453f; }
            { const u32x4 w0 = {pack2(at[0], at[1]), pack2(at[2], at[3]), pack2(at[4], at[5]), pack2(at[6], at[7])}; atf[ks] = __builtin_bit_cast(bf16x8, w0);
              const u32x4 w1 = {pack2(bh[0], bh[1]), pack2(bh[2], bh[3]), pack2(bh[4], bh[5]), pack2(bh[6], bh[7])}; bhf[ks] = __builtin_bit_cast(bf16x8, w1);
              const u32x4 w2 = {pack2(kh[0], kh[1]), pack2(kh[2], kh[3]), pack2(kh[4], kh[5]), pack2(kh[6], kh[7])}; khf[ks] = __builtin_bit_cast(bf16x8, w2);
              const u32x4 w3 = {pack2(rt[0], rt[1]), pack2(rt[2], rt[3]), pack2(rt[4], rt[5]), pack2(rt[6], rt[7])}; rtf[ks] = __builtin_bit_cast(bf16x8, w3);
              vf[ks] = __builtin_bit_cast(bf16x8, raw[4][ks]);
              if (m == 15) { const u32x4 wl = {pack2(lk[0], lk[1]), pack2(lk[2], lk[3]), pack2(lk[4], lk[5]), pack2(lk[6], lk[7])};
                  *(u32x4*)((bf16_t*)(p.ws + CH_GT) + (size_t)it * 64 + 32 * ks + 8 * q) = wl; } } }
        { f32x4 mab = z4, mak = z4, mrb = z4, mrk = z4;
#pragma unroll
          for (int ks = 0; ks < 2; ++ks) { mab = mfma16(atf[ks], bhf[ks], mab); mak = mfma16(atf[ks], khf[ks], mak); mrb = mfma16(rtf[ks], bhf[ks], mrb); mrk = mfma16(rtf[ks], khf[ks], mrk); }
#pragma unroll
          for (int r = 0; r < 4; ++r) { const int t = 4 * q + r; sM[(0 * 16 + t) * 17 + m] = m < t ? mab[r] : 0.f; sM[(1 * 16 + t) * 17 + m] = m < t ? mak[r] : 0.f;
              sM[(2 * 16 + t) * 17 + m] = m <= t ? mrb[r] : 0.f; sM[(3 * 16 + t) * 17 + m] = m <= t ? mrk[r] : 0.f; } }
        { float tv[16];
#pragma unroll
          for (int t = 0; t < 16; ++t) { float acc = (m == t) ? 1.0f : 0.0f;
#pragma unroll
              for (int s2 = 0; s2 < t; ++s2) acc += sM[t * 17 + s2] * tv[s2];
              tv[t] = acc; }
#pragma unroll
          for (int t = 0; t < 16; ++t) if (q == 0) sM[t * 17 + m] = tv[t]; }
        bf16x8 tinvf, mrbf, makf;
        { float lo[4], hi[4] = {0.f, 0.f, 0.f, 0.f};
#pragma unroll
          for (int j = 0; j < 4; ++j) lo[j] = sM[(0 * 16 + m) * 17 + 4 * q + j];
          tinvf = pack_frag(lo, hi);
#pragma unroll
          for (int j = 0; j < 4; ++j) lo[j] = sM[(1 * 16 + m) * 17 + 4 * q + j];
          makf = pack_frag(lo, hi);
#pragma unroll
          for (int j = 0; j < 4; ++j) lo[j] = sM[(2 * 16 + m) * 17 + 4 * q + j];
          mrbf = pack_frag(lo, hi);
#pragma unroll
          for (int j = 0; j < 4; ++j) hi[j] = sM[(3 * 16 + m) * 17 + 4 * q + j];
          *(bf16x8*)((bf16_t*)(p.ws + CH_MM) + ((size_t)it * 64 + lane) * 8) = pack_frag(lo, hi); }
#pragma unroll
        for (int itile = 0; itile < 4; ++itile) { const f32x4 vt = mfma16(vf[itile >> 1], isel[itile & 1], z4);
            const f32x4 w1 = mfma16(makf, pack_lo(vt), z4);
            const f32x4 uu = mfma16(tinvf, pack_lo(w1), z4);
            u32x2 o; o.x = pack2(uu[0], uu[1]); o.y = pack2(uu[2], uu[3]);
            *(u32x2*)((bf16_t*)(p.ws + CH_UL) + (((size_t)it * 4 + itile) * 64 + lane) * 4) = o; }
        const u32x4 mrbw = __builtin_bit_cast(u32x4, mrbf), idgw = __builtin_bit_cast(u32x4, idg); const u32x4 rpbw = {mrbw.x, mrbw.y, idgw.z, idgw.w}; const bf16x8 rpb = __builtin_bit_cast(bf16x8, rpbw);
        u32x2 xa = {0u, 0u}, xr = {0u, 0u};
#pragma unroll
        for (int jt = 0; jt < 4; ++jt) { const int ks = jt >> 1;
            const bf16x8 att = pack_lo(mfma16(atf[ks], isel[jt & 1], z4));
            const f32x4 ap = mfma16(tinvf, att, z4);
            const f32x4 apT = mfma16(att, tinvf, z4);
            const f32x4 rtt = mfma16(rtf[ks], isel[jt & 1], z4);
            u32x4 aw = __builtin_bit_cast(u32x4, pack_lo(ap)); aw.z = pack2(rtt[0], rtt[1]); aw.w = pack2(rtt[2], rtt[3]);
            const f32x4 rpT = mfma16(__builtin_bit_cast(bf16x8, aw), rpb, z4);
            const f32x4 bht = mfma16(bhf[ks], isel[jt & 1], z4), kht = mfma16(khf[ks], isel[jt & 1], z4);
            { u32x4 w; w.x = pack2(bht[0], bht[1]); w.y = pack2(bht[2], bht[3]); w.z = pack2(kht[0], kht[1]); w.w = pack2(kht[2], kht[3]);
              *(u32x4*)((bf16_t*)(p.ws + CH_BK) + (((size_t)it * 4 + jt) * 64 + lane) * 8) = w; }
            if ((jt & 1) == 0) { xa.x = pack2(apT[0], apT[1]); xa.y = pack2(apT[2], apT[3]); xr.x = pack2(rpT[0], rpT[1]); xr.y = pack2(rpT[2], rpT[3]); }
            else { const u32x4 wa = {xa.x, xa.y, pack2(apT[0], apT[1]), pack2(apT[2], apT[3])}, wr2 = {xr.x, xr.y, pack2(rpT[0], rpT[1]), pack2(rpT[2], rpT[3])};
                *(u32x4*)((bf16_t*)(p.ws + CH_XP) + ((((size_t)it * 2 + 0) * 2 + ks) * 64 + lane) * 8) = wa;
                *(u32x4*)((bf16_t*)(p.ws + CH_XP) + ((((size_t)it * 2 + 1) * 2 + ks) * 64 + lane) * 8) = wr2; } }
    }
}
__device__ __forceinline__ void rwkv_seq_task(const Params& p, int l, int task, LAS unsigned char* lds) {
    const int lane = threadIdx.x & 63, m = lane & 15, q = lane >> 4;
    const int u = task >> 2, iw = task & 3, b = u / 12, h = (u % 12) >> 1, d = u & 1, sgn = d ? -1 : 1;
    const bf16_t* XP = (const bf16_t*)(p.ws + CH_XP); const bf16_t* BK = (const bf16_t*)(p.ws + CH_BK); const bf16_t* UL = (const bf16_t*)(p.ws + CH_UL); const bf16_t* MM = (const bf16_t*)(p.ws + CH_MM);
    const bf16_t* GT = (const bf16_t*)(p.ws + CH_GT); const bf16_t* VS = (const bf16_t*)(p.ws + U_VS) + h * 64 + 16 * iw;
    float* Yw = (float*)(p.ws + U_YRK) + (size_t)d * NROW * 384 + h * 64 + 16 * iw;
    LAS float* ybuf = (LAS float*)(lds + (threadIdx.x >> 6) * 12288);
    const int rc0 = NLAT + b * 256 + (d ? 255 : 0) + sgn * 4 * q, rdel = (b * 2048 + (d ? 2047 : 0)) - (NLAT + b * 256 + (d ? 255 : 0)) - sgn * 256;
    f32x4 acc[4];
#pragma unroll
    for (int jt = 0; jt < 4; ++jt) acc[jt] = (f32x4){0.f, 0.f, 0.f, 0.f};
    const unsigned vo16 = (unsigned)lane * 16u, vo8 = (unsigned)lane * 8u, vo8q = (unsigned)q * 8u;
    struct OpSet { u32x4 apf0, apf1, rpf0, rpf1, bkf0, bkf1, bkf2, bkf3, mmf; u32x2 gl0, gl1, gl2, gl3, uw; unsigned vr0, vr1, vr2, vr3; };
#define GLDS16(dst, voff, sbase, imm) asm volatile("global_load_dwordx4 %0, %1, %2 offset:" #imm : "=&v"(dst) : "v"(voff), "s"(sbase) : "memory")
#define GLDS8(dst, voff, sbase, imm) asm volatile("global_load_dwordx2 %0, %1, %2 offset:" #imm : "=&v"(dst) : "v"(voff), "s"(sbase) : "memory")
#define GLDS2(dst, voff, sbase) asm volatile("global_load_ushort %0, %1, %2" : "=&v"(dst) : "v"(voff), "s"(sbase) : "memory")
#define RKS_LOAD(X, c_) do { const size_t it_ = (size_t)u * 144 + (c_); const int rb_ = rc0 + sgn * 16 * (c_) + (int)((c_) >= 16) * rdel; \
        const bf16_t* xpb = XP + it_ * 2048; const bf16_t* bkb = BK + it_ * 2048; const bf16_t* mmb = MM + it_ * 512; const bf16_t* gtb = GT + it_ * 64; const bf16_t* ulb = UL + (it_ * 4 + iw) * 256; \
        GLDS16(X.apf0, vo16, xpb, 0); GLDS16(X.apf1, vo16, xpb, 1024); GLDS16(X.rpf0, vo16, xpb, 2048); GLDS16(X.rpf1, vo16, xpb, 3072); \
        GLDS16(X.bkf0, vo16, bkb, 0); GLDS16(X.bkf1, vo16, bkb, 1024); GLDS16(X.bkf2, vo16, bkb, 2048); GLDS16(X.bkf3, vo16, bkb, 3072); \
        GLDS8(X.gl0, vo8q, gtb, 0); GLDS8(X.gl1, vo8q, gtb, 32); GLDS8(X.gl2, vo8q, gtb, 64); GLDS8(X.gl3, vo8q, gtb, 96); \
        GLDS16(X.mmf, vo16, mmb, 0); GLDS8(X.uw, vo8, ulb, 0); \
        { const unsigned v0_ = (unsigned)(rb_) * 768u + 2u * m, v1_ = (unsigned)(rb_ + sgn) * 768u + 2u * m, v2_ = (unsigned)(rb_ + 2 * sgn) * 768u + 2u * m, v3_ = (unsigned)(rb_ + 3 * sgn) * 768u + 2u * m; \
          GLDS2(X.vr0, v0_, VS); GLDS2(X.vr1, v1_, VS); GLDS2(X.vr2, v2_, VS); GLDS2(X.vr3, v3_, VS); } } while (0)
#define RKS_WAIT(X) asm volatile("s_waitcnt vmcnt(36)" : "+v"(X.apf0), "+v"(X.apf1), "+v"(X.rpf0), "+v"(X.rpf1), "+v"(X.bkf0), "+v"(X.bkf1), "+v"(X.bkf2), "+v"(X.bkf3), "+v"(X.mmf), \
        "+v"(X.gl0), "+v"(X.gl1), "+v"(X.gl2), "+v"(X.gl3), "+v"(X.uw), "+v"(X.vr0), "+v"(X.vr1), "+v"(X.vr2), "+v"(X.vr3) :: "memory")
#define BF8(x) __builtin_bit_cast(bf16x8, x)
#define RKS_COMPUTE(X, c_) do { RKS_WAIT(X); \
        const float ul[4] = {bflo(X.uw.x), bfhi(X.uw.x), bflo(X.uw.y), bfhi(X.uw.y)}; const float vl[4] = {bflo(X.vr0), bflo(X.vr1), bflo(X.vr2), bflo(X.vr3)}; \
        f32x4 zp = (f32x4){0.f, 0.f, 0.f, 0.f}, yp = zp; \
        { const float lo[4] = {acc[0][0], acc[0][1], acc[0][2], acc[0][3]}, hi[4] = {acc[1][0], acc[1][1], acc[1][2], acc[1][3]}; const bf16x8 sf = pack_frag(lo, hi); zp = mfma16(BF8(X.apf0), sf, zp); yp = mfma16(BF8(X.rpf0), sf, yp); } \
        { const float lo[4] = {acc[2][0], acc[2][1], acc[2][2], acc[2][3]}, hi[4] = {acc[3][0], acc[3][1], acc[3][2], acc[3][3]}; const bf16x8 sf = pack_frag(lo, hi); zp = mfma16(BF8(X.apf1), sf, zp); yp = mfma16(BF8(X.rpf1), sf, yp); } \
        const float z[4] = {zp[0] + ul[0], zp[1] + ul[1], zp[2] + ul[2], zp[3] + ul[3]}; \
        yp = mfma16(BF8(X.mmf), pack_frag(ul, vl), yp); \
        const bf16x8 zvf = pack_frag(z, vl); \
        acc[0] = mfma16(BF8(X.bkf0), zvf, acc[0]); acc[1] = mfma16(BF8(X.bkf1), zvf, acc[1]); acc[2] = mfma16(BF8(X.bkf2), zvf, acc[2]); acc[3] = mfma16(BF8(X.bkf3), zvf, acc[3]); \
        { const f32x4 g4 = {__expf(bflo(X.gl0.x)), __expf(bfhi(X.gl0.x)), __expf(bflo(X.gl0.y)), __expf(bfhi(X.gl0.y))}; acc[0] *= g4; } \
        { const f32x4 g4 = {__expf(bflo(X.gl1.x)), __expf(bfhi(X.gl1.x)), __expf(bflo(X.gl1.y)), __expf(bfhi(X.gl1.y))}; acc[1] *= g4; } \
        { const f32x4 g4 = {__expf(bflo(X.gl2.x)), __expf(bfhi(X.gl2.x)), __expf(bflo(X.gl2.y)), __expf(bfhi(X.gl2.y))}; acc[2] *= g4; } \
        { const f32x4 g4 = {__expf(bflo(X.gl3.x)), __expf(bfhi(X.gl3.x)), __expf(bflo(X.gl3.y)), __expf(bfhi(X.gl3.y))}; acc[3] *= g4; } \
        _Pragma("unroll") for (int r = 0; r < 4; ++r) ybuf[((((c_) % 12) * 16) + 4 * q + r) * 16 + m] = yp[r]; } while (0)
    asm volatile("; SEQ_BEGIN");
    OpSet A, B, C;
    RKS_LOAD(A, 0); RKS_LOAD(B, 1);
    for (int c0 = 0; c0 < 144; c0 += 12) {
#pragma unroll
        for (int cc = 0; cc < 12; cc += 3) { const int c = c0 + cc;
            RKS_LOAD(C, c + 2); __builtin_amdgcn_sched_barrier(0);
            RKS_COMPUTE(A, c); __builtin_amdgcn_sched_barrier(0);
            { const int cn = c + 3 < 144 ? c + 3 : 143; RKS_LOAD(A, cn); } __builtin_amdgcn_sched_barrier(0);
            RKS_COMPUTE(B, c + 1); __builtin_amdgcn_sched_barrier(0);
            { const int cn = c + 4 < 144 ? c + 4 : 143; RKS_LOAD(B, cn); } __builtin_amdgcn_sched_barrier(0);
            RKS_COMPUTE(C, c + 2); __builtin_amdgcn_sched_barrier(0); }
#pragma unroll
        for (int k = 0; k < 12; ++k) { const int rr = (lane >> 2) + 16 * k, n = c0 * 16 + rr; const int grow = (rc0 - sgn * 4 * q) + sgn * n + (int)(n >= 256) * rdel;
            *(f32x4*)(Yw + (size_t)grow * 384 + (lane & 3) * 4) = *(const LAS f32x4*)(ybuf + rr * 16 + (lane & 3) * 4); }
    }
    asm volatile("; SEQ_END");
#undef RKS_LOAD
#undef RKS_COMPUTE
#undef RKS_WAIT
#undef GLDS16
#undef GLDS8
#undef GLDS2
#undef BF8
}

__device__ __forceinline__ void rwkv_seq_block(const Params& p, int l, int u, LAS unsigned char* lds) {
    (void)l;
    const int tid = threadIdx.x, lane = tid & 63, wv = __builtin_amdgcn_readfirstlane(tid >> 6), m = lane & 15, q = lane >> 4;
    const int b = u / 12, h = (u % 12) >> 1, d = u & 1, sgn = d ? -1 : 1;
    const unsigned char* XPb = p.ws + CH_XP + (size_t)u * 144 * 4096; const unsigned char* BKb = p.ws + CH_BK + (size_t)u * 144 * 4096;
    const unsigned char* MMb = p.ws + CH_MM + (size_t)u * 144 * 1024; const unsigned char* GTb = p.ws + CH_GT + (size_t)u * 144 * 128;
    LAS unsigned char* ring = lds + 49152;
#define SEQ_BAR() asm volatile("s_waitcnt lgkmcnt(0)\n\ts_barrier" ::: "memory")
    __syncthreads();
    if (wv >= 4) {
        const int lw = wv - 4; const bool hasmm = lw == 0, hasgt = (lw == 1) && lane < 8;
        lu4 xp[3], bk[3], mm[3], gt[3];
#define LDR_LOAD(k, c_) do { const int cc_ = (c_) < 144 ? (c_) : 143; xp[k] = *(const lu4*)(XPb + (size_t)cc_ * 4096 + lw * 1024 + lane * 16); bk[k] = *(const lu4*)(BKb + (size_t)cc_ * 4096 + lw * 1024 + lane * 16); \
            if (hasmm) mm[k] = *(const lu4*)(MMb + (size_t)cc_ * 1024 + lane * 16); if (hasgt) gt[k] = *(const lu4*)(GTb + (size_t)cc_ * 128 + lane * 16); } while (0)
#define LDR_STORE(k, c_) do { if ((c_) < 144) { LAS unsigned char* sl_ = ring + ((c_) % 3) * 9728; *(LAS lu4*)(sl_ + lw * 1024 + lane * 16) = xp[k]; *(LAS lu4*)(sl_ + 4096 + lw * 1024 + lane * 16) = bk[k]; \
            if (hasmm) *(LAS lu4*)(sl_ + 8192 + lane * 16) = mm[k]; if (hasgt) *(LAS lu4*)(sl_ + 9216 + lane * 16) = gt[k]; } } while (0)
        LDR_LOAD(0, 0); LDR_LOAD(1, 1); LDR_LOAD(2, 2);
        LDR_STORE(0, 0); LDR_LOAD(0, 3); LDR_STORE(1, 1); LDR_LOAD(1, 4);
        SEQ_BAR();
        for (int i0 = 0; i0 < 144; i0 += 3) {
            LDR_STORE(2, i0 + 2); LDR_LOAD(2, i0 + 5); SEQ_BAR();
            LDR_STORE(0, i0 + 3); LDR_LOAD(0, i0 + 6); SEQ_BAR();
            LDR_STORE(1, i0 + 4); LDR_LOAD(1, i0 + 7); SEQ_BAR(); }
#undef LDR_LOAD
#undef LDR_STORE
    } else {
        const int iw = wv;
        const bf16_t* UL = (const bf16_t*)(p.ws + CH_UL) + (size_t)u * 144 * 1024; const bf16_t* VS = (const bf16_t*)(p.ws + U_VS) + h * 64 + 16 * iw;
        float* Yw = (float*)(p.ws + U_YRK) + (size_t)d * NROW * 384 + h * 64 + 16 * iw;
        LAS float* ybuf = (LAS float*)(lds + wv * 12288);
        const int rc0 = NLAT + b * 256 + (d ? 255 : 0) + sgn * 4 * q, rdel = (b * 2048 + (d ? 2047 : 0)) - (NLAT + b * 256 + (d ? 255 : 0)) - sgn * 256;
        const unsigned vo8 = (unsigned)lane * 8u;
        f32x4 acc[4];
#pragma unroll
        for (int jt = 0; jt < 4; ++jt) acc[jt] = (f32x4){0.f, 0.f, 0.f, 0.f};
        struct Shared { bf16x8 apf0, apf1, rpf0, rpf1, bkf0, bkf1, bkf2, bkf3, mmf; u32x2 gl0, gl1, gl2, gl3; };
        struct Own { u32x2 uw; unsigned vr0, vr1, vr2, vr3; };
#define GLDS8(dst, voff, sbase) asm volatile("global_load_dwordx2 %0, %1, %2" : "=&v"(dst) : "v"(voff), "s"(sbase) : "memory")
#define GLDS2(dst, voff, sbase) asm volatile("global_load_ushort %0, %1, %2" : "=&v"(dst) : "v"(voff), "s"(sbase) : "memory")
#define OWN_LOAD(X, c_) do { const int cc_ = (c_) < 144 ? (c_) : 143; const int rb_ = rc0 + sgn * 16 * cc_ + (int)(cc_ >= 16) * rdel; const bf16_t* ulb = UL + ((size_t)cc_ * 4 + iw) * 256; \
            GLDS8(X.uw, vo8, ulb); const unsigned v0_ = (unsigned)(rb_) * 768u + 2u * m, v1_ = (unsigned)(rb_ + sgn) * 768u + 2u * m, v2_ = (unsigned)(rb_ + 2 * sgn) * 768u + 2u * m, v3_ = (unsigned)(rb_ + 3 * sgn) * 768u + 2u * m; \
            GLDS2(X.vr0, v0_, VS); GLDS2(X.vr1, v1_, VS); GLDS2(X.vr2, v2_, VS); GLDS2(X.vr3, v3_, VS); } while (0)
#define OWN_WAIT(X) asm volatile("s_waitcnt vmcnt(10)" : "+v"(X.uw), "+v"(X.vr0), "+v"(X.vr1), "+v"(X.vr2), "+v"(X.vr3) :: "memory")
#define SH_READ(S, c_) do { const int cc_ = (c_) < 144 ? (c_) : 143; const LAS unsigned char* sl_ = ring + (cc_ % 3) * 9728 + lane * 16; \
            S.apf0 = *(const LAS bf16x8*)(sl_); S.apf1 = *(const LAS bf16x8*)(sl_ + 1024); S.rpf0 = *(const LAS bf16x8*)(sl_ + 2048); S.rpf1 = *(const LAS bf16x8*)(sl_ + 3072); \
            S.bkf0 = *(const LAS bf16x8*)(sl_ + 4096); S.bkf1 = *(const LAS bf16x8*)(sl_ + 5120); S.bkf2 = *(const LAS bf16x8*)(sl_ + 6144); S.bkf3 = *(const LAS bf16x8*)(sl_ + 7168); S.mmf = *(const LAS bf16x8*)(sl_ + 8192); \
            const LAS unsigned char* gp_ = ring + (cc_ % 3) * 9728 + 9216 + q * 8; S.gl0 = *(const LAS u32x2*)(gp_); S.gl1 = *(const LAS u32x2*)(gp_ + 32); S.gl2 = *(const LAS u32x2*)(gp_ + 64); S.gl3 = *(const LAS u32x2*)(gp_ + 96); } while (0)
#define SEQ_COMPUTE(S, X, c_) do { OWN_WAIT(X); \
            const float ul[4] = {bflo(X.uw.x), bfhi(X.uw.x), bflo(X.uw.y), bfhi(X.uw.y)}; const float vl[4] = {bflo(X.vr0), bflo(X.vr1), bflo(X.vr2), bflo(X.vr3)}; \
            f32x4 zp = (f32x4){0.f, 0.f, 0.f, 0.f}, yp = zp; \
            { const float lo[4] = {acc[0][0], acc[0][1], acc[0][2], acc[0][3]}, hi[4] = {acc[1][0], acc[1][1], acc[1][2], acc[1][3]}; const bf16x8 sf = pack_frag(lo, hi); zp = mfma16(S.apf0, sf, zp); yp = mfma16(S.rpf0, sf, yp); } \
            { const float lo[4] = {acc[2][0], acc[2][1], acc[2][2], acc[2][3]}, hi[4] = {acc[3][0], acc[3][1], acc[3][2], acc[3][3]}; const bf16x8 sf = pack_frag(lo, hi); zp = mfma16(S.apf1, sf, zp); yp = mfma16(S.rpf1, sf, yp); } \
            const float z[4] = {zp[0] + ul[0], zp[1] + ul[1], zp[2] + ul[2], zp[3] + ul[3]}; \
            yp = mfma16(S.mmf, pack_frag(ul, vl), yp); \
            const bf16x8 zvf = pack_frag(z, vl); \
            acc[0] = mfma16(S.bkf0, zvf, acc[0]); acc[1] = mfma16(S.bkf1, zvf, acc[1]); acc[2] = mfma16(S.bkf2, zvf, acc[2]); acc[3] = mfma16(S.bkf3, zvf, acc[3]); \
            { const f32x4 g4 = {__expf(bflo(S.gl0.x)), __expf(bfhi(S.gl0.x)), __expf(bflo(S.gl0.y)), __expf(bfhi(S.gl0.y))}; acc[0] *= g4; } \
            { const f32x4 g4 = {__expf(bflo(S.gl1.x)), __expf(bfhi(S.gl1.x)), __expf(bflo(S.gl1.y)), __expf(bfhi(S.gl1.y))}; acc[1] *= g4; } \
            { const f32x4 g4 = {__expf(bflo(S.gl2.x)), __expf(bfhi(S.gl2.x)), __expf(bflo(S.gl2.y)), __expf(bfhi(S.gl2.y))}; acc[2] *= g4; } \
            { const f32x4 g4 = {__expf(bflo(S.gl3.x)), __expf(bfhi(S.gl3.x)), __expf(bflo(S.gl3.y)), __expf(bfhi(S.gl3.y))}; acc[3] *= g4; } \
            _Pragma("unroll") for (int r = 0; r < 4; ++r) ybuf[((((c_) % 12) * 16) + 4 * q + r) * 16 + m] = yp[r]; } while (0)
#define SEQ_STEP(SC, SN, XC, XN2, c_) do { SH_READ(SN, (c_) + 1); OWN_LOAD(XN2, (c_) + 2); __builtin_amdgcn_sched_barrier(0); SEQ_COMPUTE(SC, XC, c_); __builtin_amdgcn_sched_barrier(0); SEQ_BAR(); } while (0)
        Shared S0, S1; Own A, B, C;
        OWN_LOAD(A, 0); OWN_LOAD(B, 1);
        SEQ_BAR();
        SH_READ(S0, 0);
        for (int c0 = 0; c0 < 144; c0 += 12) {
#pragma unroll
            for (int cc = 0; cc < 12; cc += 6) { const int c = c0 + cc;
                SEQ_STEP(S0, S1, A, C, c); SEQ_STEP(S1, S0, B, A, c + 1); SEQ_STEP(S0, S1, C, B, c + 2);
                SEQ_STEP(S1, S0, A, C, c + 3); SEQ_STEP(S0, S1, B, A, c + 4); SEQ_STEP(S1, S0, C, B, c + 5); }
#pragma unroll
            for (int k = 0; k < 12; ++k) { const int rr = (lane >> 2) + 16 * k, n = c0 * 16 + rr; const int grow = (rc0 - sgn * 4 * q) + sgn * n + (int)(n >= 256) * rdel;
                *(f32x4*)(Yw + (size_t)grow * 384 + (lane & 3) * 4) = *(const LAS f32x4*)(ybuf + rr * 16 + (lane & 3) * 4); }
        }
#undef GLDS8
#undef GLDS2
#undef OWN_LOAD
#undef OWN_WAIT
#undef SH_READ
#undef SEQ_COMPUTE
#undef SEQ_STEP
    }
#undef SEQ_BAR
    __syncthreads();
}

__device__ __forceinline__ void rwkv_finish(const Params& p, int l) {
    const int sub = threadIdx.x & 7; const int npair = (l == 0 ? NROW : NLAT) * 6;
    const bf16_t* RS = (const bf16_t*)(p.ws + U_RS); const bf16_t* KS = (const bf16_t*)(p.ws + U_KS); const bf16_t* VS = (const bf16_t*)(p.ws + U_VS);
    const bf16_t* AG0 = (const bf16_t*)(p.ws + U_AG); const bf16_t* AG1 = (const bf16_t*)(p.ws + U_AG + SZ384); const bf16_t* G = (const bf16_t*)(p.ws + U_G);
    const float* Y0 = (const float*)(p.ws + U_YRK); const float* Y1 = Y0 + (size_t)NROW * 384; bf16_t* YC = (bf16_t*)(p.ws + WS_ABUF);
    for (int pr = (blockIdx.x * NTHR + threadIdx.x) >> 3; pr < npair; pr += (gridDim.x * NTHR) >> 3) { const int row = pr / 6, h = pr % 6, col = h * 64 + sub * 8; const size_t o = (size_t)row * 384 + col;
        float y[8]; { const float4 a0 = *(const float4*)(Y0 + o), a1 = *(const float4*)(Y0 + o + 4), c0 = *(const float4*)(Y1 + o), c1 = *(const float4*)(Y1 + o + 4);
            y[0] = a0.x + c0.x; y[1] = a0.y + c0.y; y[2] = a0.z + c0.z; y[3] = a0.w + c0.w; y[4] = a1.x + c1.x; y[5] = a1.y + c1.y; y[6] = a1.z + c1.z; y[7] = a1.w + c1.w; }
        float s = 0.f;
#pragma unroll
        for (int k = 0; k < 8; ++k) s += y[k];
        s += __shfl_xor(s, 1); s += __shfl_xor(s, 2); s += __shfl_xor(s, 4); const float mean = s * (1.0f / 64.0f);
        float v2 = 0.f;
#pragma unroll
        for (int k = 0; k < 8; ++k) { const float dd = y[k] - mean; v2 += dd * dd; }
        v2 += __shfl_xor(v2, 1); v2 += __shfl_xor(v2, 2); v2 += __shfl_xor(v2, 4); const float rstd = rsqrtf(v2 * (1.0f / 64.0f) + 64e-5f);
        float r[8], kx[8], vx[8], a0[8], a1[8], gx[8];
        unpack8(*(const uint4*)(RS + o), r); unpack8(*(const uint4*)(KS + o), kx); unpack8(*(const uint4*)(VS + o), vx); unpack8(*(const uint4*)(AG0 + o), a0); unpack8(*(const uint4*)(AG1 + o), a1); unpack8(*(const uint4*)(G + o), gx);
        const float* ka = p.in[27] + l * 384 + col; const float* rk = p.in[28] + l * 384 + col; const float* lw = p.in[29] + l * 384 + col; const float* lb = p.in[30] + l * 384 + col;
        float bs = 0.f;
#pragma unroll
        for (int k = 0; k < 8; ++k) { const float kd0 = kx[k] * (1.0f + (a0[k] - 1.0f) * ka[k]), kd1 = kx[k] * (1.0f + (a1[k] - 1.0f) * ka[k]); bs += r[k] * (kd0 + kd1) * rk[k]; }
        bs += __shfl_xor(bs, 1); bs += __shfl_xor(bs, 2); bs += __shfl_xor(bs, 4);
        float ov[8];
#pragma unroll
        for (int k = 0; k < 8; ++k) ov[k] = ((y[k] - mean) * rstd * lw[k] + lb[k] + bs * vx[k]) * gx[k];
        *(uint4*)(YC + (size_t)row * 1024 + 640 + col) = pack8(ov);
    }
}

__device__ __forceinline__ void phase_normrouter(const Params& p, int l, const float* xl, const float* xc, LAS unsigned char* lds) {
    LAS float* hrow = (LAS float*)lds;
    LAS float* part = (LAS float*)(lds + 65536);
    const int lane = threadIdx.x & 63, wv = threadIdx.x >> 6, e = lane & 15, cq = lane >> 4; const int ngrp = (l == 0 ? NROW : NLAT) / 16;
    const float* mod = (const float*)(p.ws + WS_MOD) + (size_t)l * 17 * 6144; const float* g1 = p.in[6] + (l * 4 + 1) * 1024; const float* g2 = p.in[6] + (l * 4 + 2) * 1024;
    const bf16_t* Y = (const bf16_t*)(p.ws + U_Y); unsigned char* A8 = p.ws + WS_ABUF; float* AFF = (float*)(p.ws + WS_AFF);
    float wr[32];
#pragma unroll
    for (int j = 0; j < 32; ++j) wr[j] = p.in[31][((size_t)l * 1024 + 128 * wv + 32 * cq + j) * 16 + e];
    for (int gi = blockIdx.x; gi < ngrp; gi += gridDim.x) { const int r0 = gi * 16 + wv; const int b = r0 < NLAT ? (r0 >> 11) : 16; const float* mb = mod + (size_t)b * 6144;
        const float* xs = xrow(xl, xc, r0); float* xd = xrow_w(p.out, (float*)(p.ws + WS_CTXA), r0);
        float4 y[2][4], x[2][4]; float ss[2] = {0.f, 0.f};
#pragma unroll
        for (int q = 0; q < 2; ++q)
#pragma unroll
            for (int i = 0; i < 4; ++i) { { const u32x2 yw = *(const u32x2*)(Y + (size_t)(r0 + 8 * q) * 1024 + i * 256 + lane * 4); y[q][i] = make_float4(bflo(yw.x), bfhi(yw.x), bflo(yw.y), bfhi(yw.y)); }
                x[q][i] = *(const float4*)(xs + (size_t)q * 8192 + i * 256 + lane * 4); }
#pragma unroll
        for (int q = 0; q < 2; ++q)
#pragma unroll
            for (int i = 0; i < 4; ++i) ss[q] += y[q][i].x * y[q][i].x + y[q][i].y * y[q][i].y + y[q][i].z * y[q][i].z + y[q][i].w * y[q][i].w;
        ss[0] = wave_sum(ss[0]); ss[1] = wave_sum(ss[1]); const float rs[2] = {rsqrtf(ss[0] * (1.0f / 1024.0f) + 1e-6f), rsqrtf(ss[1] * (1.0f / 1024.0f) + 1e-6f)};
        float s2[2] = {0.f, 0.f};
#pragma unroll
        for (int i = 0; i < 4; ++i) { const int c = i * 256 + lane * 4; const float4 gg = *(const float4*)(g1 + c), gt = *(const float4*)(mb + 2048 + c);
#pragma unroll
            for (int q = 0; q < 2; ++q) {
                x[q][i].x += gt.x * (y[q][i].x * rs[q] * gg.x); x[q][i].y += gt.y * (y[q][i].y * rs[q] * gg.y); x[q][i].z += gt.z * (y[q][i].z * rs[q] * gg.z); x[q][i].w += gt.w * (y[q][i].w * rs[q] * gg.w);
                *(float4*)(xd + (size_t)q * 8192 + c) = x[q][i]; s2[q] += x[q][i].x * x[q][i].x + x[q][i].y * x[q][i].y + x[q][i].z * x[q][i].z + x[q][i].w * x[q][i].w; } }
        s2[0] = wave_sum(s2[0]); s2[1] = wave_sum(s2[1]); const float rs2[2] = {rsqrtf(s2[0] * (1.0f / 1024.0f) + 1e-6f), rsqrtf(s2[1] * (1.0f / 1024.0f) + 1e-6f)};
        float hv[2][4][4]; float amax[2] = {0.f, 0.f};
        __syncthreads();
#pragma unroll
        for (int i = 0; i < 4; ++i) { const int c = i * 256 + lane * 4; const float4 gg = *(const float4*)(g2 + c), sh = *(const float4*)(mb + 3072 + c), sc = *(const float4*)(mb + 4096 + c);
#pragma unroll
            for (int q = 0; q < 2; ++q) {
                hv[q][i][0] = x[q][i].x * rs2[q] * gg.x * (1.f + sc.x) + sh.x; hv[q][i][1] = x[q][i].y * rs2[q] * gg.y * (1.f + sc.y) + sh.y; hv[q][i][2] = x[q][i].z * rs2[q] * gg.z * (1.f + sc.z) + sh.z; hv[q][i][3] = x[q][i].w * rs2[q] * gg.w * (1.f + sc.w) + sh.w;
                *(LAS lf4*)(hrow + (wv + 8 * q) * 1024 + c) = (lf4){hv[q][i][0], hv[q][i][1], hv[q][i][2], hv[q][i][3]};
                amax[q] = fmaxf(amax[q], fmaxf(fmaxf(fabsf(hv[q][i][0]), fabsf(hv[q][i][1])), fmaxf(fabsf(hv[q][i][2]), fabsf(hv[q][i][3])))); } }
#pragma unroll
        for (int o = 32; o >= 1; o >>= 1) { amax[0] = fmaxf(amax[0], __shfl_xor(amax[0], o)); amax[1] = fmaxf(amax[1], __shfl_xor(amax[1], o)); }
#pragma unroll
        for (int q = 0; q < 2; ++q) { const int r = r0 + 8 * q; const float am = fmaxf(amax[q], 1e-20f), qs = 127.0f / am;
            if (lane == 0) ((float*)(p.ws + WS_SX))[r] = am * (1.0f / 127.0f);
#pragma unroll
            for (int i = 0; i < 4; ++i) { unsigned w = 0u;
#pragma unroll
                for (int k = 0; k < 4; ++k) w |= ((unsigned)__float2int_rn(hv[q][i][k] * qs) & 255u) << (8 * k);
                *(unsigned*)(A8 + (size_t)r * 1024 + i * 256 + lane * 4) = w; } }
        __syncthreads();
#pragma unroll 2
        for (int rr = 0; rr < 16; ++rr) { const LAS float* hp = hrow + rr * 1024 + 128 * wv + 32 * cq; float acc = 0.f;
#pragma unroll
            for (int j4 = 0; j4 < 8; ++j4) { const lf4 h4 = *(const LAS lf4*)(hp + 4 * j4); acc += h4.x * wr[4 * j4] + h4.y * wr[4 * j4 + 1] + h4.z * wr[4 * j4 + 2] + h4.w * wr[4 * j4 + 3]; }
            acc += __shfl_xor(acc, 16); acc += __shfl_xor(acc, 32);
            if (cq == 0) part[(rr * 8 + wv) * 16 + e] = acc; }
        __syncthreads();
        if (lane < 32) { const int row = wv + 8 * cq; float lgt = 0.f;
#pragma unroll
            for (int w = 0; w < 8; ++w) lgt += part[(row * 8 + w) * 16 + e];
            float mxl = lgt;
#pragma unroll
            for (int o = 8; o >= 1; o >>= 1) mxl = fmaxf(mxl, __shfl_xor(mxl, o));
            const float ex = expf(lgt - mxl); float den = ex;
#pragma unroll
            for (int o = 8; o >= 1; o >>= 1) den += __shfl_xor(den, o);
            AFF[(size_t)(r0 + 8 * cq) * 16 + e] = ex / den; }
    }
}

__device__ __forceinline__ void phase_topk(const Params& p, int l, LAS unsigned char* lds) {
    LAS unsigned* keys = (LAS unsigned*)lds;
    LAS int* toks = (LAS int*)(lds + 8192);
    LAS unsigned* hist = (LAS unsigned*)(lds + 9216);
    LAS unsigned* wtot = (LAS unsigned*)(lds + 10240);
    LAS unsigned* sel = (LAS unsigned*)(lds + 10304);
    const int tid = threadIdx.x, lane = tid & 63, wv = tid >> 6, nitem = l == 0 ? 512 : 256;
    const float* AFF = (const float*)(p.ws + WS_AFF); int* SLOT = (int*)(p.ws + WS_SLOT); float* SELG = (float*)(p.ws + WS_SELG);
    const bf16_t* A = (const bf16_t*)(p.ws + WS_ABUF); bf16_t* XS = (bf16_t*)(p.ws + U_XSEL);
    for (int it = blockIdx.x; it < nitem; it += gridDim.x) { const bool lat = it < 256; const int be = it & 255, b = be >> 4, e = be & 15;
        const int n = lat ? SEQ : CTXL, cap = lat ? 256 : 32, rowbase = lat ? b * 2048 : NLAT + b * 256, xoff = lat ? b * 256 : 4096 + b * 32;
        const int per = n / NTHR > 0 ? n / NTHR : 1;
        const int t0 = tid * per; const bool act = t0 < n;
        unsigned kx[4];
        __syncthreads();
#pragma unroll
        for (int j = 0; j < 4; ++j) { kx[j] = 0u; if (act && j < per) { kx[j] = __float_as_uint(AFF[(size_t)(rowbase + t0 + j) * 16 + e]); keys[t0 + j] = kx[j]; } }
        unsigned prefix = 0u; int krem = cap;
        for (int pass = 0; pass < 4; ++pass) { const int shift = 24 - 8 * pass;
            if (tid < 256) hist[tid] = 0u;
            __syncthreads();
#pragma unroll
            for (int j = 0; j < 4; ++j) if (act && j < per) { const bool match = pass == 0 || (kx[j] >> (shift + 8)) == (prefix >> (shift + 8)); if (match) atomicAdd((unsigned*)&hist[(kx[j] >> shift) & 255u], 1u); }
            __syncthreads();
            if (tid < 256) { unsigned above = 0u; for (int bb = tid + 1; bb < 256; ++bb) above += hist[bb]; const unsigned mine = hist[tid];
                if (above < (unsigned)krem && above + mine >= (unsigned)krem) { sel[0] = (unsigned)tid; sel[1] = (unsigned)krem - above; } }
            __syncthreads();
            prefix |= sel[0] << shift; krem = (int)sel[1];
            __syncthreads();
        }
        unsigned loc = 0u, pre[4];
#pragma unroll
        for (int j = 0; j < 4; ++j) { pre[j] = loc; if (act && j < per) loc += (kx[j] > prefix ? 1u : 0u) + (kx[j] == prefix ? 65536u : 0u); }
        unsigned inc = loc;
#pragma unroll
        for (int o = 1; o < 64; o <<= 1) { const unsigned t = __shfl_up(inc, o); if (lane >= o) inc += t; }
        if (lane == 63) wtot[wv] = inc;
        __syncthreads();
        unsigned base = inc - loc;
        for (int w = 0; w < wv; ++w) base += wtot[w];
#pragma unroll
        for (int j = 0; j < 4; ++j) if (act && j < per) { const unsigned c = base + pre[j]; const int gtb = (int)(c & 0xffffu), eqb = (int)(c >> 16);
            const bool s = kx[j] > prefix || (kx[j] == prefix && eqb < krem); const int slot = gtb + (eqb < krem ? eqb : krem);
            if (s) { SELG[e * XROWS + xoff + slot] = __uint_as_float(kx[j]); toks[slot] = t0 + j; }
            SLOT[(size_t)(rowbase + t0 + j) * 16 + e] = s ? slot : -1; }
        __syncthreads();
        for (int s = wv; s < cap; s += 8) { const int row = rowbase + toks[s]; const lu4* src = (const lu4*)((const unsigned char*)A + (size_t)row * 1024); lu4* dst = (lu4*)((unsigned char*)XS + ((size_t)e * XROWS + xoff + s) * 1024);
            dst[lane] = src[lane]; if (lane == 0) ((float*)(p.ws + WS_SXS))[e * XROWS + xoff + s] = ((const float*)(p.ws + WS_SX))[row]; }
    }
}

struct GroupedOrder { int nMl, nNl, G, c, total;
    __device__ void init(int nMl_, int nNl_, int, int G_, int c_) { nMl = nMl_; nNl = nNl_; G = G_; c = c_; total = 16 * nMl_ * nNl_; }
    __device__ bool next(int i, pg8::Unit& u) const {
        int L;
        if ((G & 7) == 0 && (total & 7) == 0) { const int W = G >> 3, x = c & 7, r = c >> 3, t8 = total >> 3, k = i * W + r; if (k >= t8) return false; L = x * t8 + k; }
        else { const long LL = (long)i * G + c; if (LL >= total) return false; L = (int)LL; }
        const int per = nMl * nNl, e = L / per; int idx = L % per;
        const int mg = idx / (8 * nNl) < nMl / 8 ? idx / (8 * nNl) : nMl / 8, gm = (mg + 1) * 8 <= nMl ? 8 : nMl - mg * 8; idx -= mg * 8 * nNl;
        const int ng = idx / (gm * 4) < nNl / 4 ? idx / (gm * 4) : nNl / 4, gn = (ng + 1) * 4 <= nNl ? 4 : nNl - ng * 4; idx -= ng * gm * 4;
        u.pm = e * 18 + mg * 8 + idx / gn; u.pn = e * nNl + ng * 4 + idx % gn; return true; }
    __device__ __forceinline__ void a_ready(const pg8::Unit&) const {}
    __device__ __forceinline__ void done(const pg8::Unit&) const {}
};
struct EpiSwiGLU { static constexpr bool PERM = true, AFTER_DRAIN = false; unsigned char* H; const float* sx; const float* sw;
    __device__ __forceinline__ void operator()(const f32x4 (&acc)[2][2][4][2], const pg8::Unit& u, int wr, int wc, int fr, int fq) const {
        typedef int i32x4_ __attribute__((ext_vector_type(4)));
        const int e = u.pn / 22, pnl = u.pn - e * 22; const int row0 = u.pm * 256 + wr * 64 + fr, col0 = pnl * 128 + wc * 32 + 8 * fq;
        const float* swp = sw + (size_t)u.pn * 256 + wc * 32 + 8 * fq; const float4 g0 = *(const float4*)swp, g1 = *(const float4*)(swp + 4), u0 = *(const float4*)(swp + 128), u1 = *(const float4*)(swp + 132);
        const float swg[8] = {g0.x, g0.y, g0.z, g0.w, g1.x, g1.y, g1.z, g1.w}, swu[8] = {u0.x, u0.y, u0.z, u0.w, u1.x, u1.y, u1.z, u1.w};
#pragma unroll
        for (int ai = 0; ai < 2; ++ai)
#pragma unroll
            for (int m = 0; m < 4; ++m) { const int r = row0 + ai * 128 + m * 16; const float sr = sx[r]; unsigned char* rowp = H + (size_t)r * DE + col0; float o[8];
#pragma unroll
                for (int n = 0; n < 2; ++n) { const i32x4_ ig = __builtin_bit_cast(i32x4_, acc[ai][0][m][n]), iu = __builtin_bit_cast(i32x4_, acc[ai][1][m][n]);
#pragma unroll
                    for (int j = 0; j < 4; ++j) { const float g = (float)ig[j] * (sr * swg[n * 4 + j]), uu = (float)iu[j] * (sr * swu[n * 4 + j]); o[n * 4 + j] = g * sigm(g) * uu; } }
                u32x2 w8; { int t0 = 0, t1 = 0; t0 = __builtin_amdgcn_cvt_pk_fp8_f32(o[0], o[1], t0, false); t0 = __builtin_amdgcn_cvt_pk_fp8_f32(o[2], o[3], t0, true); t1 = __builtin_amdgcn_cvt_pk_fp8_f32(o[4], o[5], t1, false); t1 = __builtin_amdgcn_cvt_pk_fp8_f32(o[6], o[7], t1, true); w8.x = (unsigned)t0; w8.y = (unsigned)t1; }
                *(u32x2*)rowp = w8; }
    }
};
struct EpiScaleBf16 { static constexpr bool PERM = true, AFTER_DRAIN = false; bf16_t* O; int ldc; const float* sx; const float* sw;
    __device__ __forceinline__ void operator()(const f32x4 (&acc)[2][2][4][2], const pg8::Unit& u, int wr, int wc, int fr, int fq) const {
        typedef int i32x4_ __attribute__((ext_vector_type(4)));
        const int row0 = u.pm * 256 + wr * 64 + fr, col0 = u.pn * 256 + wc * 32 + 8 * fq;
        float swv[2][8];
#pragma unroll
        for (int bj = 0; bj < 2; ++bj) { const float4 a = *(const float4*)(sw + col0 + bj * 128), b = *(const float4*)(sw + col0 + bj * 128 + 4); swv[bj][0] = a.x; swv[bj][1] = a.y; swv[bj][2] = a.z; swv[bj][3] = a.w; swv[bj][4] = b.x; swv[bj][5] = b.y; swv[bj][6] = b.z; swv[bj][7] = b.w; }
#pragma unroll
        for (int ai = 0; ai < 2; ++ai)
#pragma unroll
            for (int m = 0; m < 4; ++m) { const int r = row0 + ai * 128 + m * 16; const float sr = sx[r]; bf16_t* rowp = O + (size_t)r * ldc + col0;
#pragma unroll
                for (int bj = 0; bj < 2; ++bj) { float o[8];
#pragma unroll
                    for (int n = 0; n < 2; ++n) { const i32x4_ iv = __builtin_bit_cast(i32x4_, acc[ai][bj][m][n]);
#pragma unroll
                        for (int j = 0; j < 4; ++j) o[n * 4 + j] = (float)iv[j] * (sr * swv[bj][n * 4 + j]); }
                    *(uint4*)(rowp + bj * 128) = pack8(o); } }
    }
};
struct EpiGate { static constexpr bool PERM = true, AFTER_DRAIN = false; bf16_t* O; const float* gate; const float* sw;
    __device__ __forceinline__ void operator()(const f32x4 (&acc)[2][2][4][2], const pg8::Unit& u, int wr, int wc, int fr, int fq) const {
        pg8::fp8_acc_settle();
        const int pnl = u.pn & 3; const int row0 = u.pm * 256 + wr * 64 + fr, col0 = pnl * 256 + wc * 32 + 8 * fq;
#pragma unroll
        for (int bj = 0; bj < 2; ++bj) { const float* sp = sw + (size_t)u.pn * 256 + wc * 32 + 8 * fq + bj * 128; const float4 sa = *(const float4*)sp, sb = *(const float4*)(sp + 4);
#pragma unroll
            for (int ai = 0; ai < 2; ++ai)
#pragma unroll
                for (int m = 0; m < 4; ++m) { const int r = row0 + ai * 128 + m * 16; const float gt = gate[r]; const f32x4 v0 = acc[ai][bj][m][0], v1 = acc[ai][bj][m][1];
                    u32x4 w; w.x = pack2(v0[0] * (gt * sa.x), v0[1] * (gt * sa.y)); w.y = pack2(v0[2] * (gt * sa.z), v0[3] * (gt * sa.w)); w.z = pack2(v1[0] * (gt * sb.x), v1[1] * (gt * sb.y)); w.w = pack2(v1[2] * (gt * sb.z), v1[3] * (gt * sb.w));
                    *(u32x4*)(O + (size_t)r * 1024 + col0 + bj * 128) = w; } }
    }
};

__device__ __forceinline__ void phase_combine(const Params& p, int l) {
    const int lane = threadIdx.x & 63, wv = threadIdx.x >> 6; const int nrow = l == 0 ? NROW : NLAT;
    const float* mod = (const float*)(p.ws + WS_MOD) + (size_t)l * 17 * 6144; const float* g3 = p.in[6] + (l * 4 + 3) * 1024;
    const int* SLOT = (const int*)(p.ws + WS_SLOT); const bf16_t* YE = (const bf16_t*)(p.ws + U_YEXP); bf16_t* A = (bf16_t*)(p.ws + WS_ABUF);
    const int rstep = gridDim.x * 8; int r = blockIdx.x * 8 + wv;
    int nslot = (r < nrow && lane < 16) ? SLOT[(size_t)r * 16 + lane] : -1; float4 nx1[4];
    if (r < nrow) { const float* x1p = xrow(p.out, (const float*)(p.ws + WS_CTXA), r);
#pragma unroll
        for (int i = 0; i < 4; ++i) nx1[i] = *(const float4*)(x1p + i * 256 + lane * 4); }
    for (; r < nrow; r += rstep) { const bool lat = r < NLAT; const int b = lat ? (r >> 11) : ((r - NLAT) >> 8), mbi = lat ? b : 16, xoff = lat ? b * 256 : 4096 + b * 32;
        const float* mb = mod + (size_t)mbi * 6144;
        const int myslot = nslot; float4 xc[4];
#pragma unroll
        for (int i = 0; i < 4; ++i) xc[i] = nx1[i];
        float f[16];
#pragma unroll
        for (int k = 0; k < 16; ++k) f[k] = 0.f;
        unsigned long long mask = __ballot(myslot >= 0);
        while (mask) { int ee[4], sl4[4]; u32x2 w[4][4];
#pragma unroll
            for (int k = 0; k < 4; ++k) { if (mask) { ee[k] = __builtin_ctzll(mask); mask &= mask - 1; sl4[k] = __shfl(myslot, ee[k]); } else { ee[k] = -1; sl4[k] = 0; } }
#pragma unroll
            for (int k = 0; k < 4; ++k) if (ee[k] >= 0) { const bf16_t* yr = YE + ((size_t)ee[k] * XROWS + xoff + sl4[k]) * 1024 + lane * 4;
#pragma unroll
                for (int i = 0; i < 4; ++i) w[k][i] = *(const u32x2*)(yr + i * 256); }
#pragma unroll
            for (int k = 0; k < 4; ++k) if (ee[k] >= 0) {
#pragma unroll
                for (int i = 0; i < 4; ++i) { f[i * 4] += bflo(w[k][i].x); f[i * 4 + 1] += bfhi(w[k][i].x); f[i * 4 + 2] += bflo(w[k][i].y); f[i * 4 + 3] += bfhi(w[k][i].y); } } }
        { const int rn = r + rstep; nslot = (rn < nrow && lane < 16) ? SLOT[(size_t)rn * 16 + lane] : -1;
          if (rn < nrow) { const float* x1p = xrow(p.out, (const float*)(p.ws + WS_CTXA), rn);
#pragma unroll
              for (int i = 0; i < 4; ++i) nx1[i] = *(const float4*)(x1p + i * 256 + lane * 4); } }
        float ss = 0.f;
#pragma unroll
        for (int k = 0; k < 16; ++k) ss += f[k] * f[k];
        ss = wave_sum(ss); const float rs = rsqrtf(ss * (1.0f / 1024.0f) + 1e-6f);
        float* x2 = l == 0 ? xrow_w((float*)(p.ws + WS_XB), (float*)(p.ws + WS_CTXB), r) : p.out + (size_t)r * D;
        float4 xv[4];
#pragma unroll
        for (int i = 0; i < 4; ++i) { const int c = i * 256 + lane * 4; const float4 gg = *(const float4*)(g3 + c), gt = *(const float4*)(mb + 5120 + c); float4 x = xc[i];
            x.x += gt.x * (f[i * 4] * rs * gg.x); x.y += gt.y * (f[i * 4 + 1] * rs * gg.y); x.z += gt.z * (f[i * 4 + 2] * rs * gg.z); x.w += gt.w * (f[i * 4 + 3] * rs * gg.w);
            *(float4*)(x2 + c) = x; xv[i] = x; }
        if (l == 0) { const float* mb1 = mod + (size_t)17 * 6144 + (size_t)mbi * 6144; hnorm_row(p.in[6] + 4 * 1024, mb1, mb1 + 1024, p.ws + WS_ABUF + (size_t)r * 1024, (float*)(p.ws + WS_SH) + r, lane, xv); }
    }
}


#ifndef MK_ONLY
#define MK_ONLY -1
#endif
#define EN(k) (MK_ONLY < 0 || MK_ONLY == (k))
#ifndef MK_DUP
#define MK_DUP 0
#endif
#define NREP(k) ((((MK_DUP) >> (k)) & 1) ? 2 : 1)
constexpr int PH_PER_LAYER = 14, N_PHASES = 1 + 2 * PH_PER_LAYER;
#define IN(k) (lo <= (k) && (k) < hi)
#define SEAM(k) do { if (p.use_bar && IN(k) && IN((k) + 1)) xcd_barrier(bar); } while (0)
template <int l> __device__ __forceinline__ void layer_phases(const Params& p, LAS unsigned char* lds, const XcdBarrier& bar, const int lo, const int hi) {
    const int wv = __builtin_amdgcn_readfirstlane(threadIdx.x >> 6), G = gridDim.x; const int wid = blockIdx.x * 8 + wv, nw = G * 8;
        const int pb = 1 + l * PH_PER_LAYER;
        const float* xl = l == 0 ? p.in[0] : (const float*)(p.ws + WS_XB);
        const float* xc = l == 0 ? p.in[2] : (const float*)(p.ws + WS_CTXB);
        if (EN(0) && IN(pb + 0)) { { if (l == 0) phase_hnorm(p, 0, xl, xc); }
            if ((NREP(0)) == 2) { if (l == 0) phase_hnorm(p, 0, xl, xc); } }
        SEAM(pb + 0);
        if (EN(1) && IN(pb + 1)) { { pg8::Gemm g{(const bf16_t*)(p.ws + WS_ABUF), (const bf16_t*)(p.ws + WS_WIN), NROW, NINP, D / 2}; pg8::StaticOrder S; S.init(NROW, NINP, G, (int)blockIdx.x);
            EpiScaleBf16 E{(bf16_t*)(p.ws + U_P), NINP, (const float*)(p.ws + WS_SH), (const float*)(p.ws + WS_SWIN)}; pg8::gemm_phase<EpiScaleBf16, pg8::StaticOrder, false, 1>(lds, g, S, E, nullptr); }
            if ((NREP(1)) == 2) { pg8::Gemm g{(const bf16_t*)(p.ws + WS_ABUF), (const bf16_t*)(p.ws + WS_WIN), NROW, NINP, D / 2}; pg8::StaticOrder S; S.init(NROW, NINP, G, (int)blockIdx.x);
            EpiScaleBf16 E{(bf16_t*)(p.ws + U_P), NINP, (const float*)(p.ws + WS_SH), (const float*)(p.ws + WS_SWIN)}; pg8::gemm_phase<EpiScaleBf16, pg8::StaticOrder, false, 1>(lds, g, S, E, nullptr); } }
        SEAM(pb + 1);
        if (EN(2) && IN(pb + 2)) { phase_prep(p, l, lds);
            if ((NREP(2)) == 2) phase_prep(p, l, lds); }
        SEAM(pb + 2);
        if (EN(3) && IN(pb + 3)) { { lowrank_items(p, l, wid, nw, lds); if ((G & 31) == 0) s5_pass1_block(p, l, lds); else s5_pass1_items(p, l, wid, nw); }
            if ((NREP(3)) == 2) { lowrank_items(p, l, wid, nw, lds); if ((G & 31) == 0) s5_pass1_block(p, l, lds); else s5_pass1_items(p, l, wid, nw); } }
        SEAM(pb + 3);
        if (EN(4) && IN(pb + 4)) { { s5_carry(p, l); na_items(p, l, wid, nw, lds); }
            if ((NREP(4)) == 2) { s5_carry(p, l); na_items(p, l, wid, nw, lds); } }
        SEAM(pb + 4);
        if (EN(5) && IN(pb + 5)) { { s5_pass2_block(p, l, (int)blockIdx.x, G, lds); if (PRE_DUP == 6) s5_pass2_block(p, l, (int)blockIdx.x, G, lds); rwkv_pre_items(p, l, wid, nw, lds); if (PRE_DUP == 7) rwkv_pre_items(p, l, wid, nw, lds); }
            if ((NREP(5)) == 2) { s5_pass2_block(p, l, (int)blockIdx.x, G, lds); rwkv_pre_items(p, l, wid, nw, lds); } }
        SEAM(pb + 5);
        if (EN(6) && IN(pb + 6)) {
            if (G > 192) { const int bx = (int)blockIdx.x;
                if (bx < 192) rwkv_seq_block(p, l, bx, lds); else s5_glu_block(p, l, bx - 192, G - 192, lds);
                if ((NREP(6)) == 2) { if (bx < 192) rwkv_seq_block(p, l, bx, lds); else s5_glu_block(p, l, bx - 192, G - 192, lds); } }
            else { for (int task = wid; task < 768; task += nw) rwkv_seq_task(p, l, task, lds); s5_glu_items(p, l, wid, nw); } }
        SEAM(pb + 6);
        if (EN(7) && IN(pb + 7)) { rwkv_finish(p, l);
            if ((NREP(7)) == 2) rwkv_finish(p, l); }
        SEAM(pb + 7);
        if (EN(8) && IN(pb + 8)) { { const int M = l == 0 ? NROW : NLAT; pg8::Gemm g{(const bf16_t*)(p.ws + WS_ABUF), (const bf16_t*)(p.ws + WS_WOUT), M, D, D}; pg8::StaticOrder S; S.init(M, D, G, (int)blockIdx.x);
            pg8::EpiBf16<0> E{(bf16_t*)(p.ws + U_Y), D, nullptr, 0, 0}; pg8::gemm_phase<pg8::EpiBf16<0>, pg8::StaticOrder, false>(lds, g, S, E, nullptr); }
            if ((NREP(8)) == 2) { const int M = l == 0 ? NROW : NLAT; pg8::Gemm g{(const bf16_t*)(p.ws + WS_ABUF), (const bf16_t*)(p.ws + WS_WOUT), M, D, D}; pg8::StaticOrder S; S.init(M, D, G, (int)blockIdx.x);
            pg8::EpiBf16<0> E{(bf16_t*)(p.ws + U_Y), D, nullptr, 0, 0}; pg8::gemm_phase<pg8::EpiBf16<0>, pg8::StaticOrder, false>(lds, g, S, E, nullptr); } }
        SEAM(pb + 8);
        if (EN(9) && IN(pb + 9)) { phase_normrouter(p, l, xl, xc, lds);
            if ((NREP(9)) == 2) phase_normrouter(p, l, xl, xc, lds); }
        SEAM(pb + 9);
        if (EN(10) && IN(pb + 10)) { phase_topk(p, l, lds);
            if ((NREP(10)) == 2) phase_topk(p, l, lds); }
        SEAM(pb + 10);
        if (EN(11) && IN(pb + 11)) { { pg8::Gemm g{(const bf16_t*)(p.ws + U_XSEL), (const bf16_t*)(p.ws + WS_WGU), 16 * XROWS, 16 * 5632, D / 2}; GroupedOrder S; S.init(l == 0 ? 18 : 16, 22, 2, G, (int)blockIdx.x);
            EpiSwiGLU E{p.ws + U_HID, (const float*)(p.ws + WS_SXS), (const float*)(p.ws + WS_SW8)}; pg8::gemm_phase<EpiSwiGLU, GroupedOrder, false, 1>(lds, g, S, E, nullptr); }
            if ((NREP(11)) == 2) { pg8::Gemm g{(const bf16_t*)(p.ws + U_XSEL), (const bf16_t*)(p.ws + WS_WGU), 16 * XROWS, 16 * 5632, D / 2}; GroupedOrder S; S.init(l == 0 ? 18 : 16, 22, 2, G, (int)blockIdx.x);
            EpiSwiGLU E{p.ws + U_HID, (const float*)(p.ws + WS_SXS), (const float*)(p.ws + WS_SW8)}; pg8::gemm_phase<EpiSwiGLU, GroupedOrder, false, 1>(lds, g, S, E, nullptr); } }
        SEAM(pb + 11);
        if (EN(12) && IN(pb + 12)) { { pg8::Gemm g{(const bf16_t*)(p.ws + U_HID), (const bf16_t*)(p.ws + WS_WD), 16 * XROWS, 16 * 1024, DE / 2}; GroupedOrder S; S.init(l == 0 ? 18 : 16, 4, 4, G, (int)blockIdx.x);
            EpiGate E{(bf16_t*)(p.ws + U_YEXP), (const float*)(p.ws + WS_SELG), (const float*)(p.ws + WS_SWD)}; pg8::gemm_phase<EpiGate, GroupedOrder, false, 2>(lds, g, S, E, nullptr);
            if (l == 0 && G == 256 && blockIdx.x >= 128) convert_weights(p, 1, lds, (int)blockIdx.x - 128, 128, 0, CV_EARLY); }
            if ((NREP(12)) == 2) { pg8::Gemm g{(const bf16_t*)(p.ws + U_HID), (const bf16_t*)(p.ws + WS_WD), 16 * XROWS, 16 * 1024, DE / 2}; GroupedOrder S; S.init(l == 0 ? 18 : 16, 4, 4, G, (int)blockIdx.x);
            EpiGate E{(bf16_t*)(p.ws + U_YEXP), (const float*)(p.ws + WS_SELG), (const float*)(p.ws + WS_SWD)}; pg8::gemm_phase<EpiGate, GroupedOrder, false, 2>(lds, g, S, E, nullptr); } }
        SEAM(pb + 12);
        if (EN(13) && IN(pb + 13)) { { phase_combine(p, l); if (l == 0) convert_weights(p, 1, lds, (int)blockIdx.x, G, G == 256 ? CV_EARLY : 0, CV_TOTAL); }
            if (((l == 0 ? NREP(13) : 1)) == 2) { phase_combine(p, l); if (l == 0) convert_weights(p, 1, lds, (int)blockIdx.x, G); } }
        SEAM(pb + 13);
}
__global__ void __launch_bounds__(NTHR, 2) fwd(Params p) {
    extern __shared__ __attribute__((aligned(16))) unsigned char lds_raw[];
    LAS unsigned char* lds = (LAS unsigned char*)lds_raw;
    const int tid = threadIdx.x;
    if (tid < 4) ((LAS unsigned*)(lds + LDS_MISC))[tid] = 0u;
    __syncthreads();
    XcdBarrier bar; bar.bar = (unsigned*)(p.ws + WS_CTL); bar.x = 0; bar.st = (volatile LAS unsigned*)(lds + LDS_MISC);
    if (p.use_bar) bar = xcd_barrier_post((unsigned*)(p.ws + WS_CTL), (volatile LAS unsigned*)(lds + LDS_MISC));
    if (p.use_bar && tid == 0) { unsigned* xr = (unsigned*)(p.ws + WS_CTL + 32768); ((LAS unsigned*)(lds + LDS_MISC))[2] = xb_xcc_id(); ((LAS unsigned*)(lds + LDS_MISC))[3] = atomicAdd(xr + 64 * xb_xcc_id(), 1u); }
    __syncthreads();
    const int lo = p.ph_lo, hi = p.ph_hi;

    if (EN(100) && IN(0)) { { phase_prologue(p, lds); }
        if ((NREP(14)) == 2) { phase_prologue(p, lds); } }
    SEAM(0);
    layer_phases<0>(p, lds, bar, lo, hi);
    layer_phases<1>(p, lds, bar, lo, hi);
#undef IN
#undef SEAM
}
}

#ifndef MK_ONE_LAUNCH
#define MK_ONE_LAUNCH 1
#endif
extern "C" void kernel_launch(void* const* d_in, const int* in_sizes, int n_in, void* d_out, int out_size, void* d_ws, size_t ws_size, hipStream_t stream) {
    static int grid = 0;
    if (grid == 0) {
        if (n_in != 35 || out_size != mk::NLAT * mk::D || ws_size < mk::WS_END) { fprintf(stderr, "kernel_launch: unexpected problem (n_in %d, out %d, ws %zu < %zu)\n", n_in, out_size, ws_size, (size_t)mk::WS_END); grid = -1; return; }
        int dev = 0, cus = 0, per_cu = 0;
        if (hipGetDevice(&dev) != hipSuccess || hipDeviceGetAttribute(&cus, hipDeviceAttributeMultiprocessorCount, dev) != hipSuccess) { grid = -1; return; }
        if (hipFuncSetAttribute((const void*)mk::fwd, hipFuncAttributeMaxDynamicSharedMemorySize, mk::LDS_BYTES) != hipSuccess) { fprintf(stderr, "kernel_launch: hipFuncSetAttribute failed\n"); grid = -1; return; }
        if (hipOccupancyMaxActiveBlocksPerMultiprocessor(&per_cu, (const void*)mk::fwd, mk::NTHR, mk::LDS_BYTES) != hipSuccess || per_cu < 1) { fprintf(stderr, "kernel_launch: occupancy query says %d\n", per_cu); per_cu = 1; }
        (void)hipGetLastError();
        grid = cus;
    }
    if (grid < 0) return;
    (void)in_sizes;
    if (hipMemsetAsync(d_ws, 0, 65536, stream) != hipSuccess) return;
    mk::Params a{};
    for (int i = 0; i < 35; ++i) a.in[i] = (const float*)d_in[i];
    a.out = (float*)d_out; a.ws = (unsigned char*)d_ws;
#if MK_ONE_LAUNCH
    a.ph_lo = 0; a.ph_hi = mk::N_PHASES; a.use_bar = 1;
    hipLaunchKernelGGL(mk::fwd, dim3(grid), dim3(mk::NTHR), mk::LDS_BYTES, stream, a);
#else
    for (int ph = 0; ph < mk::N_PHASES; ++ph) { a.ph_lo = ph; a.ph_hi = ph + 1; a.use_bar = 0; hipLaunchKernelGGL(mk::fwd, dim3(grid), dim3(mk::NTHR), mk::LDS_BYTES, stream, a); }
#endif
}
```

```cpp
#include <hip/hip_runtime.h>
#include <cstdio>
#include <cstdint>
#define PRE_DUP 0
namespace pg8 {
#define PG8_LAS __attribute__((address_space(3)))
typedef unsigned short bf16_t;
typedef short bf16x8 __attribute__((ext_vector_type(8)));
typedef float f32x4 __attribute__((ext_vector_type(4)));
typedef unsigned u32x4 __attribute__((ext_vector_type(4)));
constexpr int BM = 256, BK = 64, HALF = 128, HTB = HALF * BK * 2  , STAGE_BYTES = 8 * HTB, NXCD = 8, WGM = 8;

__host__ __device__ __forceinline__ int lds_byte(int r, int c) { const int st = (r >> 4) * 2 + (c >> 5), rr = r & 15, cc = c & 31, ob = rr * 64 + cc * 2; return st * 1024 + (ob ^ (((ob >> 9) & 1) << 5)); }
__host__ __device__ __forceinline__ void stage_rc(int b, int& R, int& C) { const int st = b / 1024, sb = b % 1024, swz = sb ^ (((sb >> 9) & 1) << 5); R = (st >> 1) * 16 + swz / 64; C = (st & 1) * 32 + (swz % 64) / 2; }
__host__ __device__ __forceinline__ int perm32(int rho) { const int n = rho >> 4, i = rho & 15; return 8 * (i >> 2) + 4 * n + (i & 3); }

struct Unit { int pm, pn; };
struct Gemm { const bf16_t* A; const bf16_t* Bt; int M, N, K; };

struct StaticOrder {
    int nM, nN, nwg, G, c;
    __host__ __device__ void init(int M, int N, int G_, int c_) { nM = M / BM; nN = N / BM; nwg = nM * nN; G = G_; c = c_; }
    __host__ __device__ bool next(int i, Unit& u) const {
        const long L = (long)i * G + c; if (L >= nwg) return false;
        int wgid = (int)L; { const int q = nwg / NXCD, r = nwg % NXCD, xcd = wgid % NXCD, off = wgid / NXCD; wgid = (xcd < r ? xcd * (q + 1) : r * (q + 1) + (xcd - r) * q) + off; }
        const int nig = WGM * nN, gid = wgid / nig, fm = gid * WGM, gsz = (nM - fm) < WGM ? (nM - fm) : WGM;
        u.pm = fm + ((wgid % nig) % gsz); u.pn = (wgid % nig) / gsz; return true;
    }
    __device__ __forceinline__ void a_ready(const Unit&) const {}
    __device__ __forceinline__ void done(const Unit&) const {}
};
struct CountedOrder : StaticOrder {
    const unsigned* ready; unsigned need; unsigned* tmo;
    __device__ __forceinline__ void a_ready(const Unit& u) const {
        if (threadIdx.x < 64) {
            const unsigned long long t0 = __builtin_amdgcn_s_memrealtime(); unsigned polls = 0;
            while ((unsigned)__builtin_amdgcn_readfirstlane(__hip_atomic_load(ready + 64 * u.pm, __ATOMIC_RELAXED, __HIP_MEMORY_SCOPE_AGENT)) < need) {
                if ((++polls & 255u) == 0u && __builtin_amdgcn_readfirstlane(__hip_atomic_load(tmo, __ATOMIC_RELAXED, __HIP_MEMORY_SCOPE_AGENT)) != 0u) break;
                if (__builtin_amdgcn_s_memrealtime() - t0 > 2000000ull) {
                    if (threadIdx.x == 0) { unsigned expect = 0u; __hip_atomic_compare_exchange_strong(tmo + 1, &expect, 0x600u | (unsigned)(u.pm & 0xff), __ATOMIC_RELAXED, __ATOMIC_RELAXED, __HIP_MEMORY_SCOPE_AGENT); __hip_atomic_store(tmo, 1u, __ATOMIC_RELAXED, __HIP_MEMORY_SCOPE_AGENT); }
                    break; }
                __builtin_amdgcn_s_sleep(2); }
            __builtin_amdgcn_fence(__ATOMIC_ACQUIRE, "agent");
            asm volatile("s_waitcnt vmcnt(0)" ::: "memory");
        }
#if !defined(BROKEN_HOOK_NO_BARRIER)
        asm volatile("" ::: "memory"); __builtin_amdgcn_s_barrier(); asm volatile("" ::: "memory");
#endif
    }
};

__device__ __forceinline__ unsigned cvt_pk_bf16(float lo, float hi) { unsigned r; asm volatile("v_cvt_pk_bf16_f32 %0, %1, %2" : "=v"(r) : "v"(lo), "v"(hi)); return r; }
typedef float f32x2 __attribute__((ext_vector_type(2)));
__device__ __forceinline__ f32x2 gelu_pk(f32x2 v) {
    const f32x2 av = __builtin_elementwise_abs(v), d = av * 0.2316418882f + 1.0f;
    f32x2 t; t.x = __builtin_amdgcn_rcpf(d.x); t.y = __builtin_amdgcn_rcpf(d.y);
    f32x2 q = t * 0.5307027145f + (-0.7265760135f); q = q * t + 0.7107068705f; q = q * t + (-0.142248368f); q = q * t + 0.127414796f; q = q * t;
    const f32x2 s = (v * v) * (-0.72134752044f);
    f32x2 e; e.x = __builtin_amdgcn_exp2f(s.x); e.y = __builtin_amdgcn_exp2f(s.y);
    const f32x2 m = v * (q * e), r = v - m;
    f32x2 o; o.x = v.x < 0.f ? m.x : r.x; o.y = v.y < 0.f ? m.y : r.y; return o;
}

struct EpiF32 {
    static constexpr bool PERM = false, AFTER_DRAIN = false;
    float* C; int ldc; const float* bias;
    __device__ __forceinline__ void operator()(const f32x4 (&acc)[2][2][4][2], const Unit& u, int wr, int wc, int fr, int fq) const {
        const int row0 = u.pm * BM + wr * 64 + fr, col0 = u.pn * BM + wc * 32 + 4 * fq;
        f32x4 bv[2][2];
#pragma unroll
        for (int bj = 0; bj < 2; ++bj)
#pragma unroll
            for (int n = 0; n < 2; ++n) bv[bj][n] = bias ? *(const f32x4*)(bias + col0 + bj * HALF + n * 16) : (f32x4){0.f, 0.f, 0.f, 0.f};
#pragma unroll
        for (int ai = 0; ai < 2; ++ai)
#pragma unroll
            for (int m = 0; m < 4; ++m) { float* rowp = C + (size_t)(row0 + ai * HALF + m * 16) * ldc + col0;
#pragma unroll
                for (int bj = 0; bj < 2; ++bj)
#pragma unroll
                    for (int n = 0; n < 2; ++n) *(f32x4*)(rowp + bj * HALF + n * 16) = acc[ai][bj][m][n] + bv[bj][n]; }
    }
};
template <int ACT  > struct EpiBf16 {
    static constexpr bool PERM = true, AFTER_DRAIN = false;
    bf16_t* O; int ldc; const float* bias; int split_cols; size_t split_stride;
    __device__ __forceinline__ void operator()(const f32x4 (&acc)[2][2][4][2], const Unit& u, int wr, int wc, int fr, int fq) const {
        const int row0 = u.pm * BM + wr * 64 + fr; int colt = u.pn * BM; bf16_t* base = O;
        if (split_cols) { const int t = colt / split_cols; base += (size_t)t * split_stride; colt -= t * split_cols; }
        const int col0 = colt + wc * 32 + 8 * fq, bcol0 = u.pn * BM + wc * 32 + 8 * fq;
        f32x4 bv[2][2];
#pragma unroll
        for (int bj = 0; bj < 2; ++bj)
#pragma unroll
            for (int n = 0; n < 2; ++n) bv[bj][n] = bias ? *(const f32x4*)(bias + bcol0 + bj * HALF + 4 * n) : (f32x4){0.f, 0.f, 0.f, 0.f};
#pragma unroll
        for (int ai = 0; ai < 2; ++ai)
#pragma unroll
            for (int m = 0; m < 4; ++m) { bf16_t* rowp = base + (size_t)(row0 + ai * HALF + m * 16) * ldc + col0;
#pragma unroll
                for (int bj = 0; bj < 2; ++bj) { f32x4 v0 = acc[ai][bj][m][0] + bv[bj][0], v1 = acc[ai][bj][m][1] + bv[bj][1];
                    if (ACT == 1) { f32x2 a = gelu_pk((f32x2){v0[0], v0[1]}), b = gelu_pk((f32x2){v0[2], v0[3]}), c = gelu_pk((f32x2){v1[0], v1[1]}), d = gelu_pk((f32x2){v1[2], v1[3]});
                        v0 = (f32x4){a.x, a.y, b.x, b.y}; v1 = (f32x4){c.x, c.y, d.x, d.y}; }
                    if (ACT == 2) {
#pragma unroll
                        for (int j = 0; j < 4; ++j) { v0[j] = 0.5f * v0[j] * (1.0f + erff(v0[j] * 0.70710678f)); v1[j] = 0.5f * v1[j] * (1.0f + erff(v1[j] * 0.70710678f)); } }
                    u32x4 w; w.x = cvt_pk_bf16(v0[0], v0[1]); w.y = cvt_pk_bf16(v0[2], v0[3]); w.z = cvt_pk_bf16(v1[0], v1[1]); w.w = cvt_pk_bf16(v1[2], v1[3]);
                    *(u32x4*)(rowp + bj * HALF) = w; } }
    }
};

template <int MODE> __device__ __forceinline__ f32x4 pg8_mma(bf16x8 a, bf16x8 b, f32x4 c) {
    if constexpr (MODE == 1) { typedef int i32x4_ __attribute__((ext_vector_type(4))); return __builtin_bit_cast(f32x4, __builtin_amdgcn_mfma_i32_16x16x64_i8(__builtin_bit_cast(i32x4_, a), __builtin_bit_cast(i32x4_, b), __builtin_bit_cast(i32x4_, c), 0, 0, 0)); }
    else return __builtin_amdgcn_mfma_f32_16x16x32_bf16(a, b, c, 0, 0, 0); }
__device__ __forceinline__ f32x4 pg8_mma8(bf16x8 a0, bf16x8 a1, bf16x8 b0, bf16x8 b1, f32x4 c) {
    typedef int i32x4_ __attribute__((ext_vector_type(4))); typedef int i32x8_ __attribute__((ext_vector_type(8)));
    const i32x8_ A = __builtin_shufflevector(__builtin_bit_cast(i32x4_, a0), __builtin_bit_cast(i32x4_, a1), 0, 1, 2, 3, 4, 5, 6, 7), B = __builtin_shufflevector(__builtin_bit_cast(i32x4_, b0), __builtin_bit_cast(i32x4_, b1), 0, 1, 2, 3, 4, 5, 6, 7);
    const int one = 0x7f7f7f7f;
    asm volatile("v_mfma_scale_f32_16x16x128_f8f6f4 %0, %1, %2, %0, %3, %3 op_sel_hi:[0,0,0]" : "+v"(c) : "v"(A), "v"(B), "v"(one));
    return c; }
__device__ __forceinline__ void fp8_acc_settle() { asm volatile("s_nop 7\n\ts_nop 7\n\ts_nop 7" ::: "memory"); }
template <class Epi, class Sched, bool STAMP = false, int MODE = 0>
__device__ __forceinline__ void gemm_phase(PG8_LAS unsigned char* lds, const Gemm g, const Sched& S, const Epi& E, unsigned long long* stamps) {
    const int tid = threadIdx.x, wid = __builtin_amdgcn_readfirstlane(tid >> 6), lane = tid & 63, wr = wid >> 2, wc = wid & 3, fr = lane & 15, fq = lane >> 4;
    const int K = g.K, nt = K / BK;
    int ts_lo = 0, ts_hi = 0, nts = 0; const unsigned long long rt_entry = STAMP ? (unsigned long long)wall_clock64() : 0ull;
#define PG8_STAMP() do { if (STAMP && wid == 0 && nts < 64) { const unsigned long long _c = (unsigned long long)clock64(); \
        ts_lo = (lane == nts) ? (int)(unsigned)_c : ts_lo; ts_hi = (lane == nts) ? (int)(unsigned)(_c >> 32) : ts_hi; ++nts; } } while (0)
    PG8_STAMP();
    unsigned voffA[2], voffB[2];
#pragma unroll
    for (int i = 0; i < 2; ++i) { int R, C; stage_rc(tid * 16 + i * 8192, R, C); const int Rb = Epi::PERM ? ((R & ~31) + perm32(R & 31)) : R;
        voffA[i] = (unsigned)(R * K + C) * 2u; voffB[i] = (unsigned)(Rb * K + C) * 2u; }
    const size_t kstep = (size_t)(BK * 2);
    const size_t hstep = (size_t)HALF * K * 2;
    const size_t tstep = 2 * hstep;
    const unsigned ldsw = (unsigned)wid * 1024u;
    const int aoff = lds_byte(wr * 64 + fr, fq * 8), boff = lds_byte(wc * 32 + fr, fq * 8);
#define PG8_SA(b, h) (((b) * 2 + (h)) * HTB)
#define PG8_SB(b, h) ((4 + (b) * 2 + (h)) * HTB)
#define PG8_STAGE(bufoff, gbase, voff) do { _Pragma("unroll") for (int _i = 0; _i < 2; ++_i) \
        __builtin_amdgcn_global_load_lds((const unsigned*)((const char*)(gbase) + (voff)[_i]), (PG8_LAS unsigned*)(lds + (bufoff) + ldsw + _i * 8192), 16, 0, 0); } while (0)
#define PG8_LDA(dst, b, h) do { _Pragma("unroll") for (int m = 0; m < 4; ++m) _Pragma("unroll") for (int k = 0; k < 2; ++k) dst[m][k] = *(const PG8_LAS bf16x8*)(lds + PG8_SA(b, h) + aoff + m * 2048 + k * 1024); } while (0)
#define PG8_LDB(dst, b, h) do { _Pragma("unroll") for (int n = 0; n < 2; ++n) _Pragma("unroll") for (int k = 0; k < 2; ++k) dst[n][k] = *(const PG8_LAS bf16x8*)(lds + PG8_SB(b, h) + boff + n * 2048 + k * 1024); } while (0)
#define PG8_MMA(ai, bj, At, Bt) do { __builtin_amdgcn_s_setprio(1); _Pragma("unroll") for (int m = 0; m < 4; ++m) _Pragma("unroll") for (int n = 0; n < 2; ++n) { if constexpr (MODE == 2) acc[ai][bj][m][n] = pg8_mma8(Bt[n][0], Bt[n][1], At[m][0], At[m][1], acc[ai][bj][m][n]); else { _Pragma("unroll") for (int k = 0; k < 2; ++k) \
        acc[ai][bj][m][n] = pg8_mma<MODE>(Bt[n][k], At[m][k], acc[ai][bj][m][n]); } } __builtin_amdgcn_s_setprio(0); } while (0)
#define PG8_WAIT_V(n) asm volatile("s_waitcnt vmcnt(" #n ")" ::: "memory")
#define PG8_WAIT_L(n) asm volatile("s_waitcnt lgkmcnt(" #n ")" ::: "memory")
#define PG8_BAR __builtin_amdgcn_s_barrier()
#define PG8_SCHED __builtin_amdgcn_sched_barrier(0)
    Unit cur, nxt; int ui = 0;
    if (!S.next(0, cur)) return;
    f32x4 acc[2][2][4][2];
#pragma unroll
    for (int a = 0; a < 2; ++a)
#pragma unroll
        for (int b = 0; b < 2; ++b)
#pragma unroll
            for (int m = 0; m < 4; ++m)
#pragma unroll
                for (int n = 0; n < 2; ++n) acc[a][b][m][n] = (f32x4){0.f, 0.f, 0.f, 0.f};
    bf16x8 At[4][2], B0[2][2], B1[2][2];
    const char* cA = (const char*)g.A + (size_t)cur.pm * tstep; const char* cB = (const char*)g.Bt + (size_t)cur.pn * tstep;
    S.a_ready(cur);
    PG8_STAGE(PG8_SB(0, 0), cB, voffB); PG8_STAGE(PG8_SA(0, 0), cA, voffA); PG8_STAGE(PG8_SB(0, 1), cB + hstep, voffB); PG8_STAGE(PG8_SA(0, 1), cA + hstep, voffA);
    if (wr == 1) PG8_BAR;
    PG8_WAIT_V(4); PG8_BAR;
    PG8_STAGE(PG8_SB(1, 0), cB + kstep, voffB); PG8_STAGE(PG8_SA(1, 0), cA + kstep, voffA); PG8_STAGE(PG8_SB(1, 1), cB + hstep + kstep, voffB);
    PG8_WAIT_V(6); PG8_BAR;
    PG8_STAMP();
    for (;;) {
        const bool has_next = S.next(ui + 1, nxt);
        const char* nA = has_next ? (const char*)g.A + (size_t)nxt.pm * tstep : cA; const char* nB = has_next ? (const char*)g.Bt + (size_t)nxt.pn * tstep : cB;
        for (int t = 0; t < nt; t += 2) {
            const bool last = (t == nt - 2);
            const char* a1 = cA + (size_t)(t + 1) * kstep;
            const char* a2 = last ? nA : cA + (size_t)(t + 2) * kstep; const char* b2 = last ? nB : cB + (size_t)(t + 2) * kstep;
            const char* a3 = a2 + kstep; const char* b3 = b2 + kstep;
            if (last && has_next) S.a_ready(nxt);
            PG8_LDB(B0, 0, 0); PG8_SCHED; PG8_LDA(At, 0, 0); PG8_STAGE(PG8_SA(1, 1), a1 + hstep, voffA);
            PG8_WAIT_L(8); PG8_BAR; PG8_WAIT_L(0); PG8_MMA(0, 0, At, B0); PG8_BAR; PG8_SCHED;
            PG8_LDB(B1, 0, 1); PG8_STAGE(PG8_SB(0, 0), b2, voffB);
            PG8_BAR; PG8_WAIT_L(0); PG8_MMA(0, 1, At, B1); PG8_BAR;
            PG8_LDA(At, 0, 1); PG8_STAGE(PG8_SA(0, 0), a2, voffA);
            PG8_BAR; PG8_WAIT_L(0); PG8_MMA(1, 0, At, B0); PG8_BAR; PG8_SCHED;
            PG8_STAGE(PG8_SB(0, 1), b2 + hstep, voffB);
            PG8_WAIT_V(6); PG8_BAR; PG8_MMA(1, 1, At, B1); PG8_BAR;
            PG8_LDB(B0, 1, 0); PG8_SCHED; PG8_LDA(At, 1, 0); PG8_STAGE(PG8_SA(0, 1), a2 + hstep, voffA);
            PG8_WAIT_L(8); PG8_BAR; PG8_WAIT_L(0); PG8_MMA(0, 0, At, B0); PG8_BAR; PG8_SCHED;
            PG8_LDB(B1, 1, 1); PG8_STAGE(PG8_SB(1, 0), b3, voffB);
            PG8_BAR; PG8_WAIT_L(0); PG8_MMA(0, 1, At, B1); PG8_BAR;
            PG8_LDA(At, 1, 1); PG8_STAGE(PG8_SA(1, 0), a3, voffA);
            PG8_BAR; PG8_WAIT_L(0); PG8_MMA(1, 0, At, B0); PG8_BAR; PG8_SCHED;
            PG8_STAGE(PG8_SB(1, 1), b3 + hstep, voffB);
            PG8_WAIT_V(6); PG8_BAR; PG8_MMA(1, 1, At, B1); PG8_BAR;
        }
        PG8_STAMP();
        if constexpr (!Epi::AFTER_DRAIN) { E(acc, cur, wr, wc, fr, fq); S.done(cur); }
        PG8_STAMP();
        if (!has_next) break;
#pragma unroll
        for (int a = 0; a < 2; ++a)
#pragma unroll
            for (int b = 0; b < 2; ++b)
#pragma unroll
                for (int m = 0; m < 4; ++m)
#pragma unroll
                    for (int n = 0; n < 2; ++n) acc[a][b][m][n] = (f32x4){0.f, 0.f, 0.f, 0.f};
        cur = nxt; cA = nA; cB = nB; ++ui;
    }
    PG8_WAIT_V(0);
    if (wr == 0) PG8_BAR;
    PG8_BAR;
    if constexpr (Epi::AFTER_DRAIN) { E.fused(acc, cur, wr, wc, fr, fq, lds, wid, lane); S.done(cur); }
    PG8_STAMP();
    if (STAMP && wid == 0) { stamps[lane] = lane < nts ? (((unsigned long long)(unsigned)ts_hi << 32) | (unsigned)ts_lo) : 0ull;
        if (lane == 62) stamps[62] = rt_entry; if (lane == 63) stamps[63] = (unsigned long long)wall_clock64(); }
#undef PG8_STAMP
#undef PG8_SA
#undef PG8_SB
#undef PG8_STAGE
#undef PG8_LDA
#undef PG8_LDB
#undef PG8_MMA
#undef PG8_WAIT_V
#undef PG8_WAIT_L
#undef PG8_BAR
#undef PG8_SCHED
}
}
#define XB_TMO      128
#define XB_XCNT(j)  (256  + 64 * (j))
#define XB_XSUB(j)  (1280 + 64 * (j))
#define XB_XGEN(j)  (2304 + 64 * (j))
#define XB_TOP      3328
#define XB_TOPGEN   3392
#define XCD_BAR_WORDS 3456
#define XB_SPIN_CAP (1u << 18)
#define LAS __attribute__((address_space(3)))

__device__ __forceinline__ unsigned xb_ld(unsigned* p)              { return __hip_atomic_load(p, __ATOMIC_RELAXED, __HIP_MEMORY_SCOPE_AGENT); }
__device__ __forceinline__ unsigned xb_add(unsigned* p, unsigned v) { return __hip_atomic_fetch_add(p, v, __ATOMIC_RELAXED, __HIP_MEMORY_SCOPE_AGENT); }
__device__ __forceinline__ unsigned xb_xcc_id() { return (unsigned)__builtin_amdgcn_s_getreg((3 << 11) | 20) & 0xFu; }
#define XB_SPIN(cond, bar) do { unsigned _sp = 0; while (cond) { __builtin_amdgcn_s_sleep(1); \
    if ((++_sp & 255u) == 0u) { if (xb_ld(&(bar)[XB_TMO])) break; if (_sp > XB_SPIN_CAP) { atomicAdd(&(bar)[XB_TMO], 1u); break; } } } } while (0)

struct XcdBarrier {
    unsigned* bar; unsigned x;
    volatile LAS unsigned* st;
};

__device__ __forceinline__ XcdBarrier xcd_barrier_post(unsigned* bar, volatile LAS unsigned* st) {
    XcdBarrier b; b.bar = bar; b.x = xb_xcc_id(); b.st = st;
    if (threadIdx.x == 0) (void)xb_add(&bar[XB_XCNT(b.x)], 1u);
    return b;
}
__device__ __forceinline__ void xcd_barrier_complete(unsigned* bar, unsigned x, unsigned& nloc, unsigned& nx) {
    const unsigned G = gridDim.x * gridDim.y * gridDim.z;
    unsigned sum, cnt, mine, sp = 0u;
    for (;;) {
        sum = 0u; cnt = 0u; mine = 0u;
#pragma unroll
        for (unsigned j = 0; j < 16; ++j) { const unsigned c = xb_ld(&bar[XB_XCNT(j)]); sum += c; cnt += (c > 0u) ? 1u : 0u; mine = (j == x) ? c : mine; }
        if (sum == G) break;
        __builtin_amdgcn_s_sleep(1);
        if ((++sp & 255u) == 0u) { if (xb_ld(&bar[XB_TMO])) break; if (sp > XB_SPIN_CAP) { atomicAdd(&bar[XB_TMO], 1u); break; } }
    }
    nloc = mine > 0u ? mine : 1u; nx = cnt > 0u ? cnt : 1u;
}

__device__ __forceinline__ void xcd_barrier(const XcdBarrier& b) {
    asm volatile("s_waitcnt vmcnt(0)" ::: "memory");
    __syncthreads();
    if (threadIdx.x == 0) {
        unsigned* bar = b.bar;
        __builtin_amdgcn_s_waitcnt(0);
        unsigned nloc = b.st[0], nx = b.st[1];
        if (nloc == 0u) { xcd_barrier_complete(bar, b.x, nloc, nx); b.st[0] = nloc; b.st[1] = nx; }
        const unsigned old = xb_add(&bar[XB_XSUB(b.x)], 1u);
        const unsigned gen = old / nloc;
        if (old + 1u == (gen + 1u) * nloc) {
            __builtin_amdgcn_fence(__ATOMIC_RELEASE, "agent");
            asm volatile("s_waitcnt vmcnt(0)" ::: "memory");
            const unsigned og = xb_add(&bar[XB_TOP], 1u);
            const unsigned tg = og / nx;
            if (og + 1u == (tg + 1u) * nx) xb_add(&bar[XB_TOPGEN], 1u);
            else XB_SPIN(xb_ld(&bar[XB_TOPGEN]) == tg, bar);
            __builtin_amdgcn_fence(__ATOMIC_ACQUIRE, "agent");
            xb_add(&bar[XB_XGEN(b.x)], 1u);
            asm volatile("s_waitcnt vmcnt(0)" ::: "memory");
        } else {
            XB_SPIN(xb_ld(&bar[XB_XGEN(b.x)]) == gen, bar);
            __builtin_amdgcn_fence(__ATOMIC_ACQUIRE, "agent");
            asm volatile("s_waitcnt vmcnt(0)" ::: "memory");
        }
    }
    __syncthreads();
}

namespace mk {
using pg8::bf16_t; using pg8::bf16x8; using pg8::f32x4; using pg8::u32x4;
typedef unsigned u32x2 __attribute__((ext_vector_type(2)));
typedef short bf16x4 __attribute__((ext_vector_type(4)));
typedef float lf2 __attribute__((ext_vector_type(2)));
typedef float lf4 __attribute__((ext_vector_type(4)));
typedef unsigned lu4 __attribute__((ext_vector_type(4)));

constexpr int D = 1024, NBATCH = 16, SEQ = 2048, CTXL = 256;
constexpr int NLAT = NBATCH * SEQ, NCTX = NBATCH * CTXL, NROW = NLAT + NCTX;
constexpr int NINP = 3072, NIN = 2944;
constexpr int C_Q = 256, C_K = 640, C_V = 1024, C_Z = 1408;
constexpr int DE = 2816;
constexpr int XROWS = 4608;
constexpr int NTHR = 512;
constexpr int LDS_MISC = 131072, LDS_BYTES = 131072 + 256;

constexpr size_t al256(size_t x) { return (x + 255) & ~(size_t)255; }
constexpr size_t WS_CTL = 0;
constexpr size_t WS_MOD = 65536;
constexpr size_t WS_SW = al256(WS_MOD + (size_t)2 * 17 * 6144 * 4);
constexpr size_t SW_W2T = 0, SW_A2T = 98304, SW_G2T = 196608, SW_GLUT = 294912, SW_S5E = 425984, SW_S5W2 = 2523136, SW_STRIDE = 6717440;
constexpr size_t WS_WIN = al256(WS_SW + 2 * SW_STRIDE);
constexpr size_t WS_WOUT = WS_WIN + (size_t)3072 * 1024 * 2;
constexpr size_t WS_WGU = WS_WOUT + (size_t)1024 * 1024 * 2;
constexpr size_t WS_WD = WS_WGU + (size_t)16 * 5632 * 1024 * 2;
constexpr size_t WS_XB = WS_WD + (size_t)16 * 1024 * 2816 * 2;
constexpr size_t WS_CTXA = WS_XB + (size_t)NLAT * D * 4;
constexpr size_t WS_CTXB = WS_CTXA + (size_t)NCTX * D * 4;
constexpr size_t WS_ABUF = WS_CTXB + (size_t)NCTX * D * 4;
constexpr size_t WS_AFF = WS_ABUF + (size_t)NROW * D * 2;
constexpr size_t WS_SLOT = WS_AFF + (size_t)NROW * 16 * 4;
constexpr size_t WS_SELG = WS_SLOT + (size_t)NROW * 16 * 4;
constexpr size_t WS_SW8 = al256(WS_SELG + (size_t)16 * XROWS * 4);
constexpr size_t WS_SX = WS_SW8 + (size_t)16 * 5632 * 4;
constexpr size_t WS_SXS = WS_SX + (size_t)NROW * 4;
constexpr size_t WS_SWIN = WS_SXS + (size_t)16 * XROWS * 4;
constexpr size_t WS_SH = WS_SWIN + (size_t)3072 * 4;
constexpr size_t WS_SWD = WS_SH + (size_t)NROW * 4;
constexpr size_t WS_U = al256(WS_SWD + (size_t)16 * 1024 * 4);
constexpr size_t SZ384 = (size_t)NROW * 384 * 2;
constexpr size_t U_P = WS_U;
constexpr size_t U_QR = U_P + (size_t)NROW * NINP * 2;
constexpr size_t U_KR = U_QR + SZ384;
constexpr size_t U_VT = U_KR + SZ384;
constexpr size_t U_VTC = U_VT + (size_t)16 * 384 * 2048 * 2;
constexpr size_t U_RS = U_VT + SZ384;
constexpr size_t U_KS = U_RS + SZ384;
constexpr size_t U_VS = U_KS + SZ384;
constexpr size_t U_KK = U_VS + SZ384;
constexpr size_t U_ALR = U_KK + SZ384;
constexpr size_t U_LD = U_ALR + SZ384;
constexpr size_t U_AG = U_LD + 2 * SZ384;
constexpr size_t U_G = U_AG + 2 * SZ384;
constexpr size_t U_YRK = U_G + SZ384;
constexpr size_t U_SLOC = U_YRK + 2 * (size_t)NROW * 384 * 4;
constexpr size_t U_SPREV = U_SLOC + (size_t)2304 * 16 * 256 * 4;
constexpr size_t U_YG = U_SPREV + (size_t)2304 * 16 * 256 * 2;
constexpr size_t U_U16 = U_YG + (size_t)NROW * 256 * 2;
constexpr size_t U_MIX_END = U_U16 + (size_t)NROW * 256 * 2;
constexpr int NCHUNK = 192 * 144;
constexpr size_t CH_XP = U_P;
constexpr size_t CH_BK = CH_XP + (size_t)NCHUNK * 4096;
constexpr size_t CH_UL = CH_BK + (size_t)NCHUNK * 4096;
constexpr size_t CH_MM = U_SLOC;
constexpr size_t CH_GT = CH_MM + (size_t)NCHUNK * 1024;
static_assert(CH_UL + (size_t)NCHUNK * 2048 <= U_RS, "chunk buffers overlap live RWKV operands");
static_assert(CH_GT + (size_t)NCHUNK * 256 <= U_SPREV, "chunk buffers overlap S5 states");
constexpr size_t U_Y = WS_U;
constexpr size_t U_XSEL = U_Y + (size_t)NROW * D * 4;
constexpr size_t U_HID = U_XSEL + (size_t)16 * XROWS * 1024 * 2;
constexpr size_t U_YEXP = U_HID + (size_t)16 * XROWS * DE * 2;
constexpr size_t U_FFN_END = U_YEXP + (size_t)16 * XROWS * 1024 * 2;
constexpr size_t WS_END = U_MIX_END > U_FFN_END ? U_MIX_END : U_FFN_END;

struct Params { const float* in[35]; float* out; unsigned char* ws; int ph_lo, ph_hi, use_bar, pad; };

typedef __bf16 hwbf2 __attribute__((ext_vector_type(2)));
__device__ __forceinline__ unsigned pack2(float lo, float hi) { const lf2 v = {lo, hi}; return __builtin_bit_cast(unsigned, __builtin_convertvector(v, hwbf2)); }
__device__ __forceinline__ bf16_t f2bf(float f) { return (bf16_t)(pack2(f, 0.f) & 0xffffu); }
__device__ __forceinline__ float bflo(unsigned w) { return __uint_as_float(w << 16); }
__device__ __forceinline__ float bfhi(unsigned w) { return __uint_as_float(w & 0xffff0000u); }
__device__ __forceinline__ float bf2f(bf16_t b) { return __uint_as_float(((unsigned)b) << 16); }
__device__ __forceinline__ float frcp(float x) { return __builtin_amdgcn_rcpf(x); }
__device__ __forceinline__ float sigm(float x) { return frcp(1.0f + __expf(-x)); }
__device__ __forceinline__ float wave_sum(float v) {
#pragma unroll
    for (int o = 32; o >= 1; o >>= 1) v += __shfl_xor(v, o);
    return v; }
__device__ __forceinline__ void unpack8(const uint4 w, float (&f)[8]) { f[0] = bflo(w.x); f[1] = bfhi(w.x); f[2] = bflo(w.y); f[3] = bfhi(w.y); f[4] = bflo(w.z); f[5] = bfhi(w.z); f[6] = bflo(w.w); f[7] = bfhi(w.w); }
__device__ __forceinline__ uint4 pack8(const float (&f)[8]) { uint4 w; w.x = pack2(f[0], f[1]); w.y = pack2(f[2], f[3]); w.z = pack2(f[4], f[5]); w.w = pack2(f[6], f[7]); return w; }
__device__ __forceinline__ const float* xrow(const float* lat, const float* ctx, int r) { return r < NLAT ? lat + (size_t)r * D : ctx + (size_t)(r - NLAT) * D; }
__device__ __forceinline__ float* xrow_w(float* lat, float* ctx, int r) { return r < NLAT ? lat + (size_t)r * D : ctx + (size_t)(r - NLAT) * D; }
__device__ __forceinline__ f32x4 mfma16(bf16x8 a, bf16x8 b, f32x4 c) { return __builtin_amdgcn_mfma_f32_16x16x32_bf16(a, b, c, 0, 0, 0); }

__device__ __forceinline__ void tr_tile(const float* __restrict__ src, int ldsrc, int k0, int n0, bf16_t* __restrict__ dst, int lddst, int drow0, LAS unsigned* T) {
    const int tid = threadIdx.x, n4 = tid & 15, kq = tid >> 4;
    const float4 a = *(const float4*)(src + (size_t)(k0 + 2 * kq) * ldsrc + n0 + 4 * n4);
    const float4 b = *(const float4*)(src + (size_t)(k0 + 2 * kq + 1) * ldsrc + n0 + 4 * n4);
    T[(4 * n4 + 0) * 33 + kq] = pack2(a.x, b.x); T[(4 * n4 + 1) * 33 + kq] = pack2(a.y, b.y);
    T[(4 * n4 + 2) * 33 + kq] = pack2(a.z, b.z); T[(4 * n4 + 3) * 33 + kq] = pack2(a.w, b.w);
    __syncthreads();
    const int n = tid >> 3, pc = tid & 7;
    uint4 v; v.x = T[n * 33 + 4 * pc]; v.y = T[n * 33 + 4 * pc + 1]; v.z = T[n * 33 + 4 * pc + 2]; v.w = T[n * 33 + 4 * pc + 3];
    *(uint4*)(dst + (size_t)(drow0 + n) * lddst + k0 + 8 * pc) = v;
    __syncthreads();
}

__device__ __forceinline__ void tr_tile4(const float* __restrict__ src, int ldsrc, int k0, int n0, bf16_t* __restrict__ dst, int lddst, int drow0, LAS unsigned* T) {
    int tid = threadIdx.x; asm volatile("" : "+v"(tid)); const int n4 = tid & 15, kq = tid >> 4;
    float4 a[4], b[4];
#pragma unroll
    for (int t = 0; t < 4; ++t) { a[t] = *(const float4*)(src + (size_t)(k0 + 2 * kq) * ldsrc + n0 + 64 * t + 4 * n4); b[t] = *(const float4*)(src + (size_t)(k0 + 2 * kq + 1) * ldsrc + n0 + 64 * t + 4 * n4); }
#pragma unroll
    for (int t = 0; t < 4; ++t) { LAS unsigned* Tt = T + t * 64 * 33;
        Tt[(4 * n4 + 0) * 33 + kq] = pack2(a[t].x, b[t].x); Tt[(4 * n4 + 1) * 33 + kq] = pack2(a[t].y, b[t].y); Tt[(4 * n4 + 2) * 33 + kq] = pack2(a[t].z, b[t].z); Tt[(4 * n4 + 3) * 33 + kq] = pack2(a[t].w, b[t].w); }
    __syncthreads();
#pragma unroll
    for (int i = 0; i < 4; ++i) { const int idx = tid + NTHR * i, n = idx >> 3, pc = idx & 7;
        uint4 v; v.x = T[n * 33 + 4 * pc]; v.y = T[n * 33 + 4 * pc + 1]; v.z = T[n * 33 + 4 * pc + 2]; v.w = T[n * 33 + 4 * pc + 3];
        *(uint4*)(dst + (size_t)(drow0 + n) * lddst + k0 + 8 * pc) = v; }
    __syncthreads();
}
template <int NK, int DP, bool FP8> __device__ __forceinline__ void q8_strip(const float* __restrict__ src, int ldsrc, unsigned char* __restrict__ dst, float* __restrict__ scl, LAS unsigned char* lds) {
    LAS float* cmax = (LAS float*)lds;
    LAS unsigned char* T = lds + 8704;
    const int tid = threadIdx.x, n4 = tid & 15, kq = tid >> 4; constexpr float QMAX = FP8 ? 256.0f : 127.0f;
    float mx[4] = {0.f, 0.f, 0.f, 0.f};
#pragma unroll 8
    for (int i = 0; i < 2 * NK; ++i) { const float4 v = *(const float4*)(src + (size_t)(kq + 32 * i) * ldsrc + 4 * n4); mx[0] = fmaxf(mx[0], fabsf(v.x)); mx[1] = fmaxf(mx[1], fabsf(v.y)); mx[2] = fmaxf(mx[2], fabsf(v.z)); mx[3] = fmaxf(mx[3], fabsf(v.w)); }
    __syncthreads();
#pragma unroll
    for (int j = 0; j < 4; ++j) cmax[kq * 64 + 4 * n4 + j] = mx[j];
    __syncthreads();
    if (tid < 64) { float m = 0.f; for (int g = 0; g < 32; ++g) m = fmaxf(m, cmax[g * 64 + tid]); m = fmaxf(m, 1e-20f); scl[tid] = m * (1.0f / QMAX); cmax[32 * 64 + tid] = QMAX / m; }
    __syncthreads();
    float inv[4];
#pragma unroll
    for (int j = 0; j < 4; ++j) inv[j] = cmax[32 * 64 + 4 * n4 + j];
    for (int kg = 0; kg < NK / 4; ++kg) {
        float4 a[4], b[4];
#pragma unroll
        for (int t = 0; t < 4; ++t) { const int kb = (kg * 4 + t) * 64 + 2 * kq; a[t] = *(const float4*)(src + (size_t)kb * ldsrc + 4 * n4); b[t] = *(const float4*)(src + (size_t)(kb + 1) * ldsrc + 4 * n4); }
#pragma unroll
        for (int t = 0; t < 4; ++t) { const float av[4] = {a[t].x, a[t].y, a[t].z, a[t].w}, bv[4] = {b[t].x, b[t].y, b[t].z, b[t].w};
#pragma unroll
            for (int j = 0; j < 4; ++j) { unsigned short w;
                if (FP8) w = (unsigned short)(__builtin_amdgcn_cvt_pk_fp8_f32(av[j] * inv[j], bv[j] * inv[j], 0, false) & 0xffff);
                else { const int q0 = __float2int_rn(av[j] * inv[j]), q1 = __float2int_rn(bv[j] * inv[j]); w = (unsigned short)((q0 & 255) | ((q1 & 255) << 8)); }
                *(LAS unsigned short*)(T + (4 * n4 + j) * 272 + t * 64 + 2 * kq) = w; } }
        __syncthreads();
#pragma unroll
        for (int i = 0; i < 2; ++i) { const int idx = tid + NTHR * i, n = idx >> 4, pc = idx & 15; *(lu4*)(dst + (size_t)n * DP + kg * 256 + 16 * pc) = *(const LAS lu4*)(T + n * 272 + 16 * pc); }
        __syncthreads();
    }
}
__device__ __forceinline__ void q8r_strip(const float* __restrict__ src, int ldsrc, unsigned char* __restrict__ dst, float* __restrict__ scl, LAS unsigned char* lds) {
    LAS float* cmax = (LAS float*)lds;
    int tid = threadIdx.x; asm volatile("" : "+v"(tid)); const int n4 = tid & 15, rg = tid >> 4;
    const float* s0 = src + (size_t)(rg * 32) * ldsrc + 4 * n4;
    lf4 v[32];
#pragma unroll
    for (int i = 0; i < 16; ++i) v[i] = *(const lf4*)(s0 + (size_t)i * ldsrc);
    __builtin_amdgcn_sched_barrier(0);
    asm volatile("s_waitcnt vmcnt(4)" ::: "memory");
#pragma unroll
    for (int i = 16; i < 32; ++i) v[i] = *(const lf4*)(s0 + (size_t)i * ldsrc);
    __builtin_amdgcn_sched_barrier(0);
    float mx[4] = {0.f, 0.f, 0.f, 0.f};
#pragma unroll
    for (int i = 0; i < 32; ++i) {
#pragma unroll
        for (int j = 0; j < 4; ++j) mx[j] = fmaxf(mx[j], fabsf(v[i][j])); }
    __syncthreads();
#pragma unroll
    for (int j = 0; j < 4; ++j) cmax[rg * 64 + 4 * n4 + j] = mx[j];
    __syncthreads();
    if (tid < 64) { float m = 0.f; for (int g = 0; g < 32; ++g) m = fmaxf(m, cmax[g * 64 + tid]); m = fmaxf(m, 1e-20f); scl[tid] = m * (1.0f / 127.0f); cmax[32 * 64 + tid] = 127.0f / m; }
    __syncthreads();
#pragma unroll
    for (int j = 0; j < 4; ++j) { const float inv = cmax[32 * 64 + 4 * n4 + j]; unsigned w[8];
#pragma unroll
        for (int g = 0; g < 8; ++g) { const int q0 = __float2int_rn(v[4 * g][j] * inv), q1 = __float2int_rn(v[4 * g + 1][j] * inv), q2 = __float2int_rn(v[4 * g + 2][j] * inv), q3 = __float2int_rn(v[4 * g + 3][j] * inv);
            w[g] = (unsigned)(q0 & 255) | ((unsigned)(q1 & 255) << 8) | ((unsigned)(q2 & 255) << 16) | ((unsigned)q3 << 24); }
        unsigned char* d = dst + (size_t)(4 * n4 + j) * 1024 + rg * 32;
        *(lu4*)d = (lu4){w[0], w[1], w[2], w[3]}; *(lu4*)(d + 16) = (lu4){w[4], w[5], w[6], w[7]}; }
}
__device__ __forceinline__ void q8d_strip(const float* __restrict__ src, unsigned char* __restrict__ dst, float* __restrict__ scl, LAS unsigned char* lds) {
    LAS float* cmax = (LAS float*)lds;
    int tid = threadIdx.x; asm volatile("" : "+v"(tid)); const int n8 = tid & 7, rg = tid >> 3; const bool v2 = rg < 48;
    unsigned pk[3][16][2]; float mx[4] = {0.f, 0.f, 0.f, 0.f}; lf4 bufA[8], bufB[8];
    auto ld = [&](lf4 (&b)[8], int hr) { const int r = hr >> 1, c = (r == 2 && !v2) ? rg + 64 : rg + 64 * r; const float* sp = src + (size_t)(c * 16 + (hr & 1) * 8) * 1024 + 4 * n8;
#pragma unroll
        for (int i = 0; i < 8; ++i) b[i] = *(const lf4*)(sp + (size_t)i * 1024); };
    auto use = [&](const lf4 (&b)[8], int hr) {
#pragma unroll
        for (int i = 0; i < 8; ++i) {
#pragma unroll
            for (int j = 0; j < 4; ++j) mx[j] = fmaxf(mx[j], fabsf(b[i][j]));
            pk[hr >> 1][(hr & 1) * 8 + i][0] = pack2(b[i][0], b[i][1]); pk[hr >> 1][(hr & 1) * 8 + i][1] = pack2(b[i][2], b[i][3]); } };
    ld(bufA, 0);
#pragma unroll
    for (int h2 = 0; h2 < 3; ++h2) {
        ld(bufB, 2 * h2 + 1); __builtin_amdgcn_sched_barrier(0); use(bufA, 2 * h2);
        if (h2 < 2) ld(bufA, 2 * h2 + 2);
        __builtin_amdgcn_sched_barrier(0); use(bufB, 2 * h2 + 1); }
    __syncthreads();
#pragma unroll
    for (int j = 0; j < 4; ++j) cmax[rg * 32 + 4 * n8 + j] = mx[j];
    __syncthreads();
    if (tid < 32) { float m = 0.f; for (int g = 0; g < 64; ++g) m = fmaxf(m, cmax[g * 32 + tid]); m = fmaxf(m, 1e-20f); scl[tid] = m * (1.0f / 256.0f); cmax[64 * 32 + tid] = 256.0f / m; }
    __syncthreads();
    float inv[4];
#pragma unroll
    for (int j = 0; j < 4; ++j) inv[j] = cmax[64 * 32 + 4 * n8 + j];
#pragma unroll
    for (int r = 0; r < 3; ++r) { if (r == 2 && !v2) continue;
        const int c = rg + 64 * r;
#pragma unroll
        for (int j = 0; j < 4; ++j) { unsigned w[4];
#pragma unroll
            for (int g = 0; g < 4; ++g) { float f[4];
#pragma unroll
                for (int x = 0; x < 4; ++x) { const unsigned u = pk[r][4 * g + x][j >> 1]; f[x] = ((j & 1) ? bfhi(u) : bflo(u)) * inv[j]; }
                unsigned t = (unsigned)__builtin_amdgcn_cvt_pk_fp8_f32(f[0], f[1], 0, false); t = (unsigned)__builtin_amdgcn_cvt_pk_fp8_f32(f[2], f[3], (int)t, true); w[g] = t; }
            *(lu4*)(dst + (size_t)(4 * n8 + j) * DE + c * 16) = (lu4){w[0], w[1], w[2], w[3]}; } }
}
__device__ __forceinline__ void gu_strip(const Params& p, int l, int item, LAS unsigned char* lds) {
    const int e = item / 88, rem = item % 88, up = rem / 44, nt = rem % 44, n0 = nt * 64, drow0 = (n0 >> 7) * 256 + (n0 & 127) + (up ? 128 : 0);
    q8r_strip(p.in[up ? 33 : 32] + (size_t)(l * 16 + e) * 1024 * DE + n0, DE, p.ws + WS_WGU + ((size_t)e * 5632 + drow0) * 1024, (float*)(p.ws + WS_SW8) + (size_t)e * 5632 + drow0, lds);
}
constexpr int CV_EARLY = 1024;
constexpr int CV_GU = 16 * 88, CV_D4 = 16 * 32, CV_WIN = 46, CV_PAD = 16, CV_WOUT4 = 16 * 4, CV_TOTAL = CV_GU + CV_D4 + CV_WIN + CV_PAD + CV_WOUT4;
__device__ __forceinline__ void convert_item(const Params& p, int l, LAS unsigned char* lds, int it) {
    LAS unsigned* T = (LAS unsigned*)lds; bf16_t* WOUT = (bf16_t*)(p.ws + WS_WOUT);
    for (int once = 0; once < 1; ++once) {
        int j = it;
        if (j < CV_GU) { gu_strip(p, l, j, lds); continue; }
        j -= CV_GU;
        if (j < CV_D4) { const int e = j >> 5, nt = j & 31;
            q8d_strip(p.in[34] + (size_t)(l * 16 + e) * DE * 1024 + nt * 32, p.ws + WS_WD + ((size_t)e * 1024 + nt * 32) * DE, (float*)(p.ws + WS_SWD) + e * 1024 + nt * 32, lds); continue; }
        j -= CV_D4;
        if (j < CV_WIN) { q8r_strip(p.in[7] + (size_t)l * 1024 * NIN + j * 64, NIN, p.ws + WS_WIN + (size_t)j * 64 * 1024, (float*)(p.ws + WS_SWIN) + j * 64, lds); continue; }
        j -= CV_WIN;
        if (j < CV_PAD) { const size_t o = (size_t)NIN * 1024 + ((size_t)j * NTHR + threadIdx.x) * 16; *(uint4*)(p.ws + WS_WIN + o) = make_uint4(0u, 0u, 0u, 0u);
            if (j == 0 && threadIdx.x < 128) ((float*)(p.ws + WS_SWIN))[NIN + threadIdx.x] = 0.f; continue; }
        j -= CV_PAD;
        { const int kt = j >> 2, ng = j & 3; tr_tile4(p.in[8] + (size_t)l * 1024 * 1024, 1024, kt * 64, ng * 256, WOUT, 1024, ng * 256, T); }
    }
}
__device__ __forceinline__ void convert_weights(const Params& p, int l, LAS unsigned char* lds, int vb, int nvb, int lo = 0, int hi = CV_TOTAL) {
    for (int it = lo + vb; it < hi; it += nvb) convert_item(p, l, lds, it);
}
__device__ __forceinline__ void convert_weights_dyn(const Params& p, int l, LAS unsigned char* lds, unsigned* ctr, int lo, int hi) {
    LAS int* slot = (LAS int*)(lds + LDS_MISC + 32);
    for (;;) {
        __syncthreads();
        if (threadIdx.x == 0) *slot = lo + (int)atomicAdd(ctr, 1u);
        __syncthreads();
        const int it = *slot;
        if (it >= hi) break;
        convert_item(p, l, lds, it);
    }
}

__device__ __forceinline__ void mod_item(const Params& p, int item, LAS unsigned char* lds) {
    LAS float* sc = (LAS float*)lds;
    LAS float* red = (LAS float*)(lds + 69632);
    int tid = threadIdx.x; asm volatile("" : "+v"(tid)); const int l = item / 96, cg = item % 96;
    for (int i = tid; i < 17 * 1024; i += NTHR) { const int b = i >> 10, k = i & 1023; const float c = b < 16 ? p.in[1][b * 1024 + k] : p.in[3][k]; sc[k * 17 + b] = c * sigm(c); }
    __syncthreads();
    const int col = cg * 64 + (tid & 63), kg = tid >> 6;
    float acc[17];
#pragma unroll
    for (int b = 0; b < 17; ++b) acc[b] = 0.f;
    const float* w = p.in[4] + ((size_t)l * 1024 + kg * 128) * 6144 + col;
    for (int k0 = 0; k0 < 128; k0 += 32) { float wv[32];
#pragma unroll
        for (int j = 0; j < 32; ++j) wv[j] = w[(size_t)(k0 + j) * 6144];
        __builtin_amdgcn_sched_barrier(0);
#pragma unroll
        for (int j = 0; j < 32; ++j) { const LAS float* s = sc + (kg * 128 + k0 + j) * 17;
#pragma unroll
            for (int b = 0; b < 17; ++b) acc[b] += s[b] * wv[j]; } }
#pragma unroll
    for (int b = 0; b < 17; ++b) red[(kg * 17 + b) * 64 + (tid & 63)] = acc[b];
    __syncthreads();
    for (int i = tid; i < 17 * 64; i += NTHR) { const int b = i >> 6, c = i & 63; float s = 0.f;
#pragma unroll
        for (int g = 0; g < 8; ++g) s += red[(g * 17 + b) * 64 + c];
        ((float*)(p.ws + WS_MOD))[((size_t)l * 17 + b) * 6144 + cg * 64 + c] = s + p.in[5][l * 6144 + cg * 64 + c]; }
    __syncthreads();
}

__device__ __forceinline__ void s5mat_item(const Params& p, int item, LAS unsigned char* lds) {
    LAS lf2* pw = (LAS lf2*)lds;
    LAS lf2* bb = (LAS lf2*)(lds + 17408);
    LAS lf2* cc = (LAS lf2*)(lds + 17408 + 16384);
    LAS float* KT = (LAS float*)(lds + 17408 + 32768);
    int tid = threadIdx.x; asm volatile("" : "+v"(tid)); const int l = item >> 4, g = item & 15;
    for (int i = tid; i < 2 * 17 * 64; i += NTHR) { const int pp = i & 63, n = (i >> 6) % 17, d = i / (17 * 64);
        const int li = ((l * 2 + d) * 16 + g) * 64 + pp; const float lr = p.in[9][li], lim = p.in[10][li], dt = expf(p.in[11][(l * 2 + d) * 16 + g]);
        const float mag = expf((float)n * dt * lr); float s, c; sincosf((float)n * dt * lim, &s, &c); pw[i] = (lf2){mag * c, mag * s}; }
    for (int i = tid; i < 2 * 64 * 16; i += NTHR) { const int h = i & 15, pp = (i >> 4) & 63, d = i >> 10;
        const int li = ((l * 2 + d) * 16 + g) * 64 + pp; const float lr = p.in[9][li], lim = p.in[10][li], dt = expf(p.in[11][(l * 2 + d) * 16 + g]);
        const float mag = expf(dt * lr); float s, c; sincosf(dt * lim, &s, &c); const float x = mag * c - 1.0f, y = mag * s;
        const float den = 1.0f / (lr * lr + lim * lim); const float cr = (x * lr + y * lim) * den, ci = (y * lr - x * lim) * den;
        const int bi = ((l * 16 + g) * 64 + pp) * 16 + h; const float br = p.in[12][bi], bim = p.in[13][bi];
        bb[i] = (lf2){cr * br - ci * bim, cr * bim + ci * br}; }
    for (int i = tid; i < 2 * 16 * 64; i += NTHR) { const int pp = i & 63, h = (i >> 6) & 15, d = i >> 10;
        const int ci = (((l * 2 + d) * 16 + g) * 16 + h) * 64 + pp; cc[i] = (lf2){p.in[14][ci], p.in[15][ci]}; }
    __syncthreads();
    for (int i = tid; i < 2 * 16 * 256; i += NTHR) { const int h2 = i & 15, h = (i >> 4) & 15, tau = (i >> 8) & 15, d = i >> 12; float s = 0.f;
        for (int pp = 0; pp < 64; ++pp) { const lf2 c = cc[(d * 16 + h) * 64 + pp], w = pw[(d * 17 + tau) * 64 + pp], b = bb[(d * 64 + pp) * 16 + h2];
            const float tr = c.x * w.x - c.y * w.y, ti = c.x * w.y + c.y * w.x; s += tr * b.x - ti * b.y; }
        KT[i] = s; }
    __syncthreads();
    bf16_t* E = (bf16_t*)(p.ws + WS_SW + (size_t)l * SW_STRIDE + SW_S5E) + (size_t)g * 256 * 256;
    bf16_t* W2 = (bf16_t*)(p.ws + WS_SW + (size_t)l * SW_STRIDE + SW_S5W2) + (size_t)g * 256 * 512;
    for (int i = tid; i < 256 * 256; i += NTHR) { const int k = i & 255, n = i >> 8; const int s = k >> 4, h = k & 15, d = n >> 7, part = (n >> 6) & 1, pp = n & 63;
        const int e = d == 0 ? 15 - s : s; const lf2 w = pw[(d * 17 + e) * 64 + pp], b = bb[(d * 64 + pp) * 16 + h];
        E[i] = f2bf(part ? (w.x * b.y + w.y * b.x) : (w.x * b.x - w.y * b.y)); }
    for (int i = tid; i < 256 * 512; i += NTHR) { const int k = i & 511, n = i >> 9; const int t = n >> 4, h = n & 15; float v;
        if (k < 256) { const int s = k >> 4, h2 = k & 15; v = 0.f;
            if (t >= s) v += KT[((0 * 16 + (t - s)) * 16 + h) * 16 + h2];
            if (s >= t) v += KT[((1 * 16 + (s - t)) * 16 + h) * 16 + h2];
            if (s == t && h == h2) v += p.in[16][l * 256 + g * 16 + h]; }
        else { const int q = k - 256, d = q >> 7, part = (q >> 6) & 1, pp = q & 63; const int e = d == 0 ? t + 1 : 16 - t;
            const lf2 c = cc[(d * 16 + h) * 64 + pp], w = pw[(d * 17 + e) * 64 + pp];
            v = part ? -(c.x * w.y + c.y * w.x) : (c.x * w.x - c.y * w.y); }
        W2[i] = f2bf(v); }
    __syncthreads();
}

__device__ __forceinline__ void smallw_item(const Params& p, int item) {
    int tid = threadIdx.x; asm volatile("" : "+v"(tid)); int i = item * NTHR + tid; const int l = i / 212992; i %= 212992;
    unsigned char* sw = p.ws + WS_SW + (size_t)l * SW_STRIDE;
    if (i < 49152) { const int k = i & 63, n = (i >> 6) % 384, d = i / 24576; ((bf16_t*)(sw + SW_W2T))[i] = f2bf(p.in[22][((size_t)(l * 2 + d) * 64 + k) * 384 + n]); return; }
    i -= 49152;
    if (i < 49152) { const int k = i & 63, n = (i >> 6) % 384, d = i / 24576; ((bf16_t*)(sw + SW_A2T))[i] = f2bf(p.in[24][((size_t)(l * 2 + d) * 64 + k) * 384 + n]); return; }
    i -= 49152;
    if (i < 49152) { const int k = i & 127, n = i >> 7; ((bf16_t*)(sw + SW_G2T))[i] = f2bf(p.in[25][((size_t)l * 128 + k) * 384 + n]); return; }
    i -= 49152;
    { const int k = i & 255, n = i >> 8; ((bf16_t*)(sw + SW_GLUT))[i] = f2bf(p.in[17][((size_t)l * 256 + k) * 256 + n]); }
}

constexpr int PRO_MOD = 192, PRO_S5 = 32, PRO_SW = 832, PRO_SMALL = PRO_MOD + PRO_S5 + PRO_SW;
__device__ __forceinline__ void phase_prologue(const Params& p, LAS unsigned char* lds) {
    unsigned* ctr = (unsigned*)(p.ws + WS_CTL + 49152); LAS int* slot = (LAS int*)(lds + LDS_MISC + 32);
    for (;;) {
        __syncthreads();
        if (threadIdx.x == 0) *slot = (int)atomicAdd(ctr, 1u);
        __syncthreads();
        const int s = *slot;
        if (s >= 3 * PRO_SMALL) break;
        const int g = s / 3, r = s - 3 * g;
        if (r == 2) { if (g < PRO_S5) s5mat_item(p, g, lds); else if (g < PRO_S5 + PRO_MOD) mod_item(p, g - PRO_S5, lds); else smallw_item(p, g - PRO_S5 - PRO_MOD); }
        else { const int it = 2 * g + r; if (it < CV_TOTAL) convert_item(p, 0, lds, it); }
    }
}

__device__ __forceinline__ void hnorm_row(const float* g, const float* mb_sh, const float* mb_sc, unsigned char* dst, float* sdst, int lane, const float4 (&v)[4]) {
    float ss = 0.f;
#pragma unroll
    for (int i = 0; i < 4; ++i) ss += v[i].x * v[i].x + v[i].y * v[i].y + v[i].z * v[i].z + v[i].w * v[i].w;
    ss = wave_sum(ss); const float rs = rsqrtf(ss * (1.0f / 1024.0f) + 1e-6f);
    float hv[4][4]; float amax = 0.f;
#pragma unroll
    for (int i = 0; i < 4; ++i) { const int c = i * 256 + lane * 4; const float4 gg = *(const float4*)(g + c), sh = *(const float4*)(mb_sh + c), sc = *(const float4*)(mb_sc + c);
        hv[i][0] = v[i].x * rs * gg.x * (1.f + sc.x) + sh.x; hv[i][1] = v[i].y * rs * gg.y * (1.f + sc.y) + sh.y; hv[i][2] = v[i].z * rs * gg.z * (1.f + sc.z) + sh.z; hv[i][3] = v[i].w * rs * gg.w * (1.f + sc.w) + sh.w;
        amax = fmaxf(amax, fmaxf(fmaxf(fabsf(hv[i][0]), fabsf(hv[i][1])), fmaxf(fabsf(hv[i][2]), fabsf(hv[i][3])))); }
#pragma unroll
    for (int o = 32; o >= 1; o >>= 1) amax = fmaxf(amax, __shfl_xor(amax, o));
    amax = fmaxf(amax, 1e-20f); const float qs = 127.0f / amax;
    if (lane == 0) *sdst = amax * (1.0f / 127.0f);
#pragma unroll
    for (int i = 0; i < 4; ++i) { unsigned w = 0u;
#pragma unroll
        for (int k = 0; k < 4; ++k) w |= ((unsigned)__float2int_rn(hv[i][k] * qs) & 255u) << (8 * k);
        *(unsigned*)(dst + i * 256 + lane * 4) = w; }
}
__device__ __forceinline__ void phase_hnorm(const Params& p, int l, const float* xl, const float* xc) {
    const int lane = threadIdx.x & 63, wv = threadIdx.x >> 6;
    const float* mod = (const float*)(p.ws + WS_MOD) + (size_t)l * 17 * 6144; const float* g = p.in[6] + (l * 4 + 0) * 1024;
    unsigned char* A = p.ws + WS_ABUF; float* SH = (float*)(p.ws + WS_SH);
    for (int r = blockIdx.x * 8 + wv; r < NROW; r += gridDim.x * 8) {
        const float* src = xrow(xl, xc, r); const int b = r < NLAT ? (r >> 11) : 16; const float* mb = mod + (size_t)b * 6144;
        float4 v[4];
#pragma unroll
        for (int i = 0; i < 4; ++i) v[i] = *(const float4*)(src + i * 256 + lane * 4);
        hnorm_row(g, mb, mb + 1024, A + (size_t)r * 1024, SH + r, lane, v);
    }
}


__device__ __forceinline__ void phase_prep(const Params& p, int l, LAS unsigned char* lds) {
    LAS bf16_t* vt = (LAS bf16_t*)lds;
    LAS lf2* cs = (LAS lf2*)(lds + 50176);
    const int tid = threadIdx.x;
    for (int i = tid; i < 1024; i += NTHR) { const int pos = i >> 4, j = i & 15; const float invf = exp2f(-(float)j * (13.287712379549449f / 16.0f)); float s, c; sincosf((float)pos * invf, &s, &c); cs[i] = (lf2){c, s}; }
    __syncthreads();
    const bf16_t* P = (const bf16_t*)(p.ws + U_P);
    bf16_t* QR = (bf16_t*)(p.ws + U_QR); bf16_t* KR = (bf16_t*)(p.ws + U_KR);
    bf16_t* RS = (bf16_t*)(p.ws + U_RS); bf16_t* KS = (bf16_t*)(p.ws + U_KS); bf16_t* VS = (bf16_t*)(p.ws + U_VS); bf16_t* KK = (bf16_t*)(p.ws + U_KK); bf16_t* ALR = (bf16_t*)(p.ws + U_ALR);
    for (int ti = blockIdx.x; ti < NROW / 64; ti += gridDim.x) {
        const int r0 = ti * 64; const bool lat = r0 < NLAT; const int b = lat ? (r0 >> 11) : ((r0 - NLAT) >> 8), t0 = lat ? (r0 & 2047) : ((r0 - NLAT) & 255), slen = lat ? SEQ : CTXL;
#pragma unroll
        for (int i = 0; i < 6; ++i) { const int idx = tid + NTHR * i, tok = idx / 48, pc = idx % 48;
            *(LAS lu4*)(vt + tok * 392 + pc * 8) = *(const lu4*)(P + (size_t)(r0 + tok) * NINP + C_V + pc * 8); }
        __syncthreads();
        { bf16_t* vdst = lat ? (bf16_t*)(p.ws + U_VT) + (size_t)b * 384 * 2048 + t0 : (bf16_t*)(p.ws + U_VTC) + (size_t)b * 384 * 256 + t0;
#pragma unroll
          for (int i = 0; i < 6; ++i) { const int idx = tid + NTHR * i, hd = idx >> 3, pc = idx & 7; unsigned w[4];
#pragma unroll
              for (int j = 0; j < 4; ++j) w[j] = (unsigned)vt[(pc * 8 + 2 * j) * 392 + hd] | ((unsigned)vt[(pc * 8 + 2 * j + 1) * 392 + hd] << 16);
              *(uint4*)(vdst + (size_t)hd * slen + pc * 8) = make_uint4(w[0], w[1], w[2], w[3]); } }
#pragma unroll
        for (int i = 0; i < 4; ++i) { const int idx = tid + NTHR * i, tok = idx >> 5, pc = idx & 31;
            *(lu4*)((bf16_t*)(p.ws + U_U16) + (size_t)(r0 + tok) * 256 + pc * 8) = *(const lu4*)(P + (size_t)(r0 + tok) * NINP + pc * 8); }
        { lu4 rx[6][2]; int tq = threadIdx.x; asm volatile("" : "+v"(tq));
#pragma unroll
          for (int i = 0; i < 6; ++i) { const int idx = tq + NTHR * i, tok = idx / 48, rem = idx % 48, qk = rem / 24, rem2 = rem % 24, h = rem2 >> 2, pp = rem2 & 3;
              const int d1 = (pp >> 1) * 32 + (pp & 1) * 8; const size_t so = (size_t)(r0 + tok) * NINP + (qk ? C_K : C_Q) + h * 64 + d1;
              rx[i][0] = *(const lu4*)(P + so); rx[i][1] = *(const lu4*)(P + so + 16); }
#pragma unroll
          for (int i = 0; i < 6; ++i) { const int idx = tq + NTHR * i, tok = idx / 48, rem = idx % 48, qk = rem / 24, rem2 = rem % 24, h = rem2 >> 2, pp = rem2 & 3;
              const int d1 = (pp >> 1) * 32 + (pp & 1) * 8;
              float x1[8], x2[8], o1[8], o2[8]; unpack8(make_uint4(rx[i][0].x, rx[i][0].y, rx[i][0].z, rx[i][0].w), x1); unpack8(make_uint4(rx[i][1].x, rx[i][1].y, rx[i][1].z, rx[i][1].w), x2);
              const int t = t0 + tok, pos = (pp < 2) ? (t >> 6) : (t & 63), j0 = (pp & 1) * 8; const float scl = qk ? 1.0f : 0.125f;
#pragma unroll
              for (int j = 0; j < 8; ++j) { lf2 c = cs[pos * 16 + j0 + j]; if (!lat) c = (lf2){1.f, 0.f}; o1[j] = (x1[j] * c.x - x2[j] * c.y) * scl; o2[j] = (x1[j] * c.y + x2[j] * c.x) * scl; }
              bf16_t* dq = (qk ? KR : QR) + (size_t)(r0 + tok) * 384 + h * 64 + d1; *(uint4*)dq = pack8(o1); *(uint4*)(dq + 16) = pack8(o2); } }
#pragma unroll 1
        for (int ig = 0; ig < 6; ++ig) { lu4 zc[4], zq[4], zn[4]; int ts = threadIdx.x; asm volatile("" : "+v"(ts));
#pragma unroll
            for (int u = 0; u < 4; ++u) { const int idx = ts + NTHR * (ig * 4 + u), tok = idx / 192, pc = idx % 192, t = t0 + tok; const bf16_t* zp = P + (size_t)(r0 + tok) * NINP + C_Z + pc * 8;
                zc[u] = *(const lu4*)zp; zq[u] = t > 0 ? *(const lu4*)(zp - NINP) : (lu4){0u, 0u, 0u, 0u}; zn[u] = t < slen - 1 ? *(const lu4*)(zp + NINP) : (lu4){0u, 0u, 0u, 0u}; }
#pragma unroll
            for (int u = 0; u < 4; ++u) { const int idx = ts + NTHR * (ig * 4 + u), tok = idx / 192, pc = idx % 192, c0 = pc * 8, r = r0 + tok;
                float x[8], pv[8], nx[8], zs[8];
                unpack8(make_uint4(zc[u].x, zc[u].y, zc[u].z, zc[u].w), x); unpack8(make_uint4(zq[u].x, zq[u].y, zq[u].z, zq[u].w), pv); unpack8(make_uint4(zn[u].x, zn[u].y, zn[u].z, zn[u].w), nx);
                const float4 mu0 = *(const float4*)(p.in[20] + l * 1536 + c0), mu1 = *(const float4*)(p.in[20] + l * 1536 + c0 + 4); const float mu[8] = {mu0.x, mu0.y, mu0.z, mu0.w, mu1.x, mu1.y, mu1.z, mu1.w};
#pragma unroll
                for (int j = 0; j < 8; ++j) zs[j] = x[j] + (0.5f * (pv[j] + nx[j]) - x[j]) * mu[j];
                const bool isk = c0 >= 384 && c0 < 768; float kv[8]; float ss = 0.f;
                { const int kc = isk ? c0 - 384 : 0; const float4 k0 = *(const float4*)(p.in[26] + l * 384 + kc), k1 = *(const float4*)(p.in[26] + l * 384 + kc + 4); const float kkw[8] = {k0.x, k0.y, k0.z, k0.w, k1.x, k1.y, k1.z, k1.w};
#pragma unroll
                  for (int j = 0; j < 8; ++j) { kv[j] = zs[j] * kkw[j]; ss += kv[j] * kv[j]; } }
                ss += __shfl_xor(ss, 1); ss += __shfl_xor(ss, 2); ss += __shfl_xor(ss, 4);
                if (c0 < 384) *(uint4*)(RS + (size_t)r * 384 + c0) = pack8(zs);
                else if (c0 < 768) { *(uint4*)(KS + (size_t)r * 384 + c0 - 384) = pack8(zs); const float inv = 1.0f / fmaxf(sqrtf(ss), 1e-12f);
#pragma unroll
                    for (int j = 0; j < 8; ++j) kv[j] *= inv;
                    *(uint4*)(KK + (size_t)r * 384 + c0 - 384) = pack8(kv); }
                else if (c0 < 1152) *(uint4*)(VS + (size_t)r * 384 + c0 - 768) = pack8(zs);
                else { const int ac = c0 - 1152; float o[8];
#pragma unroll
                    for (int j = 0; j < 8; ++j) o[j] = ac < 128 ? 1.0f - 2.0f * frcp(1.0f + __expf(2.0f * zs[j])) : (ac < 256 ? zs[j] : sigm(zs[j]));
                    *(uint4*)(ALR + (size_t)r * 384 + ac) = pack8(o); } }
        }
        __syncthreads();
    }
}

template <int KS, int MODE> __device__ __forceinline__ void lr_wave(const Params& p, int l, int row0, int kofs, const bf16_t* Bt, int d) {
    const int lane = threadIdx.x & 63, m = lane & 15, q = lane >> 4;
    const bf16_t* Ap = (const bf16_t*)(p.ws + U_ALR) + (size_t)(row0 + m) * 384 + kofs + q * 8;
    bf16x8 a[KS];
#pragma unroll
    for (int ks = 0; ks < KS; ++ks) a[ks] = *(const bf16x8*)(Ap + ks * 32);
    bf16_t* O = (bf16_t*)(p.ws + (MODE == 0 ? U_LD + (size_t)d * SZ384 : (MODE == 1 ? U_AG + (size_t)d * SZ384 : U_G))) + (size_t)(row0 + m) * 384;
    const float* bias = MODE == 0 ? p.in[21] + (l * 2 + d) * 384 : p.in[23] + (l * 2 + d) * 384;
    for (int nt = 0; nt < 24; ++nt) {
        f32x4 acc = (f32x4){0.f, 0.f, 0.f, 0.f};
#pragma unroll
        for (int ks = 0; ks < KS; ++ks) { const bf16x8 bfr = *(const bf16x8*)(Bt + (size_t)(nt * 16 + m) * (KS * 32) + ks * 32 + q * 8); acc = mfma16(bfr, a[ks], acc); }
        const int n = nt * 16 + q * 4; float o[4];
        if (MODE == 2) {
#pragma unroll
            for (int j = 0; j < 4; ++j) o[j] = acc[j];
        } else { const float4 bv = *(const float4*)(bias + n); const float bb[4] = {bv.x, bv.y, bv.z, bv.w};
#pragma unroll
            for (int j = 0; j < 4; ++j) { const float s = sigm(bb[j] + acc[j]); o[j] = MODE == 0 ? -0.6065306597f * s : s; } }
        u32x2 w; w.x = pack2(o[0], o[1]); w.y = pack2(o[2], o[3]); *(u32x2*)(O + n) = w;
    }
}
template <int KS, int MODE> __device__ __forceinline__ void lr_block(const Params& p, int l, const bf16_t* Bt, int kofs, int d, int bi, int nb, LAS unsigned char* lds) {
    constexpr int PITCH = KS * 32 + 8;
    LAS bf16_t* sB = (LAS bf16_t*)lds; LAS float* sbias = (LAS float*)(lds + 384 * PITCH * 2);
    const int tid = threadIdx.x, lane = tid & 63, m = lane & 15, q = lane >> 4, wv = tid >> 6;
    const float* bias = MODE == 0 ? p.in[21] + (l * 2 + d) * 384 : p.in[23] + (l * 2 + d) * 384;
    __syncthreads();
    { lu4 st_[3 * KS];
#pragma unroll
      for (int j = 0; j < 3 * KS; ++j) { const int i = tid + NTHR * j, n = i / (KS * 4), pc = i % (KS * 4); st_[j] = *(const lu4*)(Bt + (size_t)n * (KS * 32) + pc * 8); }
      __builtin_amdgcn_sched_barrier(0);
#pragma unroll
      for (int j = 0; j < 3 * KS; ++j) { const int i = tid + NTHR * j, n = i / (KS * 4), pc = i % (KS * 4); *(LAS lu4*)(sB + n * PITCH + pc * 8) = st_[j]; } }
    if (MODE != 2) for (int i = tid; i < 384; i += NTHR) sbias[i] = bias[i];
    __syncthreads();
    bf16_t* Ob = (bf16_t*)(p.ws + (MODE == 0 ? U_LD + (size_t)d * SZ384 : (MODE == 1 ? U_AG + (size_t)d * SZ384 : U_G)));
    for (int rt = bi * 8 + wv; rt < 2304; rt += nb * 8) { const int row0 = rt * 16;
        const bf16_t* Ap = (const bf16_t*)(p.ws + U_ALR) + (size_t)(row0 + m) * 384 + kofs + q * 8;
        bf16x8 a[KS];
#pragma unroll
        for (int ks = 0; ks < KS; ++ks) a[ks] = *(const bf16x8*)(Ap + ks * 32);
        bf16_t* O = Ob + (size_t)(row0 + m) * 384;
#pragma unroll 4
        for (int nt = 0; nt < 24; ++nt) {
            f32x4 acc = (f32x4){0.f, 0.f, 0.f, 0.f};
#pragma unroll
            for (int ks = 0; ks < KS; ++ks) acc = mfma16(*(const LAS bf16x8*)(sB + (nt * 16 + m) * PITCH + ks * 32 + q * 8), a[ks], acc);
            const int n = nt * 16 + q * 4; float o[4];
            if (MODE == 2) {
#pragma unroll
                for (int j = 0; j < 4; ++j) o[j] = acc[j];
            } else { const lf4 bv = *(const LAS lf4*)(sbias + n); const float bb[4] = {bv.x, bv.y, bv.z, bv.w};
#pragma unroll
                for (int j = 0; j < 4; ++j) { const float sg = sigm(bb[j] + acc[j]); o[j] = MODE == 0 ? -0.6065306597f * sg : sg; } }
            u32x2 w; w.x = pack2(o[0], o[1]); w.y = pack2(o[2], o[3]); *(u32x2*)(O + n) = w;
        }
    }
    __syncthreads();
}
__device__ __forceinline__ void lowrank_items(const Params& p, int l, int wid, int nw, LAS unsigned char* lds) {
    const unsigned char* sw = p.ws + WS_SW + (size_t)l * SW_STRIDE; const int G = gridDim.x, bx = blockIdx.x;
    if (G >= 12) {
        const int sh = bx * 6 / G, mm = sh < 4 ? sh : 4; const int lo = (mm * G + 5) / 6, hi = mm < 4 ? ((mm + 1) * G + 5) / 6 : G, bi = bx - lo, nb = hi - lo;
        if (mm < 2) lr_block<2, 0>(p, l, (const bf16_t*)(sw + SW_W2T) + (size_t)mm * 384 * 64, mm * 64, mm, bi, nb, lds);
        else if (mm < 4) lr_block<2, 1>(p, l, (const bf16_t*)(sw + SW_A2T) + (size_t)(mm - 2) * 384 * 64, mm * 64, mm - 2, bi, nb, lds);
        else lr_block<4, 2>(p, l, (const bf16_t*)(sw + SW_G2T), 256, 0, bi, nb, lds);
        return; }
    for (int it = wid; it < 2304 * 5; it += nw) { const int rt = it / 5, m = it % 5, row0 = rt * 16;
        if (m < 2) lr_wave<2, 0>(p, l, row0, m * 64, (const bf16_t*)(sw + SW_W2T) + (size_t)m * 384 * 64, m);
        else if (m < 4) lr_wave<2, 1>(p, l, row0, m * 64, (const bf16_t*)(sw + SW_A2T) + (size_t)(m - 2) * 384 * 64, m - 2);
        else lr_wave<4, 2>(p, l, row0, 256, (const bf16_t*)(sw + SW_G2T), 0); }
}

__device__ __forceinline__ int s5_rowbase(int cr) { const int b = cr / 144, c = cr % 144; return c < 16 ? NLAT + b * 256 + c * 16 : b * 2048 + (c - 16) * 16; }
__device__ __forceinline__ void s5_pass1_items(const Params& p, int l, int wid, int nw) {
    const int lane = threadIdx.x & 63, m = lane & 15, q = lane >> 4;
    const bf16_t* P = (const bf16_t*)(p.ws + U_U16); float* SLOC = (float*)(p.ws + U_SLOC);
    for (int it = wid; it < 144 * 16; it += nw) { const int ct = it >> 4, g = it & 15, cr = ct * 16 + m, rb = s5_rowbase(cr);
        const bf16_t* E = (const bf16_t*)(p.ws + WS_SW + (size_t)l * SW_STRIDE + SW_S5E) + (size_t)g * 256 * 256;
        bf16x8 a[8];
#pragma unroll
        for (int ks = 0; ks < 8; ++ks) a[ks] = *(const bf16x8*)(P + (size_t)(rb + 2 * ks + (q >> 1)) * 256 + g * 16 + (q & 1) * 8);
        float* o = SLOC + ((size_t)cr * 16 + g) * 256 + q * 4;
#pragma unroll 2
        for (int nt = 0; nt < 16; ++nt) { f32x4 acc = (f32x4){0.f, 0.f, 0.f, 0.f}; const bf16_t* ep = E + (size_t)(nt * 16 + m) * 256 + q * 8;
#pragma unroll
            for (int ks = 0; ks < 8; ++ks) acc = mfma16(*(const bf16x8*)(ep + ks * 32), a[ks], acc);
            *(f32x4*)(o + nt * 16) = acc; }
    }
}
__device__ __forceinline__ void s5_pass1_block(const Params& p, int l, LAS unsigned char* lds) {
    constexpr int PITCH = 264;
    LAS bf16_t* sE = (LAS bf16_t*)lds;
    const int tid = threadIdx.x, lane = tid & 63, m = lane & 15, q = lane >> 4, wv = tid >> 6, G = gridDim.x, bx = blockIdx.x;
    const int combo = bx & 31, g = combo >> 1, half = combo & 1, bi = bx >> 5, nb = G >> 5;
    const bf16_t* E = (const bf16_t*)(p.ws + WS_SW + (size_t)l * SW_STRIDE + SW_S5E) + ((size_t)g * 256 + half * 128) * 256;
    const bf16_t* P = (const bf16_t*)(p.ws + U_U16); float* SLOC = (float*)(p.ws + U_SLOC);
    __syncthreads();
    { lu4 st_[8];
#pragma unroll
      for (int j = 0; j < 8; ++j) { const int i = tid + NTHR * j, n = i >> 5, pc = i & 31; st_[j] = *(const lu4*)(E + (size_t)n * 256 + pc * 8); }
      __builtin_amdgcn_sched_barrier(0);
#pragma unroll
      for (int j = 0; j < 8; ++j) { const int i = tid + NTHR * j, n = i >> 5, pc = i & 31; *(LAS lu4*)(sE + n * PITCH + pc * 8) = st_[j]; } }
    __syncthreads();
    LAS unsigned char* eb = (LAS unsigned char*)(sE + m * PITCH + q * 8); asm volatile("" : "+v"(eb));
    for (int ct = bi * 8 + wv; ct < 144; ct += nb * 8) { const int cr = ct * 16 + m, rb = s5_rowbase(cr);
        bf16x8 a[8];
#pragma unroll
        for (int ks = 0; ks < 8; ++ks) a[ks] = *(const bf16x8*)(P + (size_t)(rb + 2 * ks + (q >> 1)) * 256 + g * 16 + (q & 1) * 8);
        float* o = SLOC + ((size_t)cr * 16 + g) * 256 + half * 128 + q * 4;
#pragma unroll 2
        for (int nt = 0; nt < 8; ++nt) { f32x4 acc = (f32x4){0.f, 0.f, 0.f, 0.f};
#pragma unroll
            for (int ks = 0; ks < 8; ++ks) acc = mfma16(*(const LAS bf16x8*)(eb + nt * 16 * PITCH * 2 + ks * 64), a[ks], acc);
            *(f32x4*)(o + nt * 16) = acc; } }
    __syncthreads();
}
__device__ __forceinline__ void s5_carry(const Params& p, int l) {
    const int gid = blockIdx.x * NTHR + threadIdx.x; if (gid >= 32768) return;
    const int pp = gid & 63, d = (gid >> 6) & 1, g = (gid >> 7) & 15, b = gid >> 11;
    const int li = ((l * 2 + d) * 16 + g) * 64 + pp; const float lr = p.in[9][li], lim = p.in[10][li], dt = expf(p.in[11][(l * 2 + d) * 16 + g]);
    const float mag = expf(16.0f * dt * lr); float sn, cn; sincosf(16.0f * dt * lim, &sn, &cn); const float ar = mag * cn, ai = mag * sn;
    const float* SLOC = (const float*)(p.ws + U_SLOC); bf16_t* SP = (bf16_t*)(p.ws + U_SPREV);
    float sr = 0.f, si = 0.f;
    float xa[16], xb[16];
#define S5C_IDX(n_) (((size_t)(b * 144 + (d == 0 ? (n_) : ((n_) < 16 ? 15 - (n_) : 159 - (n_)))) * 16 + g) * 256 + d * 128 + pp)
#define S5C_LOAD(buf, n0_) do { _Pragma("unroll") for (int j = 0; j < 8; ++j) { const size_t ix_ = S5C_IDX((n0_) + j); buf[2 * j] = SLOC[ix_]; buf[2 * j + 1] = SLOC[ix_ + 64]; } } while (0)
#define S5C_RUN(buf, n0_) do { _Pragma("unroll") for (int j = 0; j < 8; ++j) { const size_t ix_ = S5C_IDX((n0_) + j); SP[ix_] = f2bf(sr); SP[ix_ + 64] = f2bf(si); \
        const float nr = ar * sr - ai * si + buf[2 * j], ni = ar * si + ai * sr + buf[2 * j + 1]; sr = nr; si = ni; } } while (0)
    S5C_LOAD(xa, 0);
    for (int n0 = 0; n0 < 144; n0 += 16) {
        S5C_LOAD(xb, n0 + 8); __builtin_amdgcn_sched_barrier(0);
        S5C_RUN(xa, n0); __builtin_amdgcn_sched_barrier(0);
        if (n0 + 16 < 144) S5C_LOAD(xa, n0 + 16);
        __builtin_amdgcn_sched_barrier(0);
        S5C_RUN(xb, n0 + 8); __builtin_amdgcn_sched_barrier(0); }
#undef S5C_IDX
#undef S5C_LOAD
#undef S5C_RUN
}
__device__ __forceinline__ void s5_pass2_items(const Params& p, int l, int wid, int nw) {
    const int lane = threadIdx.x & 63, m = lane & 15, q = lane >> 4;
    const bf16_t* P = (const bf16_t*)(p.ws + U_U16); const bf16_t* SP = (const bf16_t*)(p.ws + U_SPREV); bf16_t* YG = (bf16_t*)(p.ws + U_YG);
    for (int it = wid; it < 144 * 16; it += nw) { const int ct = it >> 4, g = it & 15; if (l == 1 && ct % 9 == 0) continue;
        const int cr = ct * 16 + m, rb = s5_rowbase(cr);
        const bf16_t* W2 = (const bf16_t*)(p.ws + WS_SW + (size_t)l * SW_STRIDE + SW_S5W2) + (size_t)g * 256 * 512;
        bf16x8 a[16];
#pragma unroll
        for (int ks = 0; ks < 8; ++ks) a[ks] = *(const bf16x8*)(P + (size_t)(rb + 2 * ks + (q >> 1)) * 256 + g * 16 + (q & 1) * 8);
#pragma unroll
        for (int ks = 8; ks < 16; ++ks) a[ks] = *(const bf16x8*)(SP + ((size_t)cr * 16 + g) * 256 + (ks - 8) * 32 + q * 8);
#pragma unroll 2
        for (int nt = 0; nt < 16; ++nt) { f32x4 acc = (f32x4){0.f, 0.f, 0.f, 0.f}; const bf16_t* wp = W2 + (size_t)(nt * 16 + m) * 512 + q * 8;
#pragma unroll
            for (int ks = 0; ks < 16; ++ks) acc = mfma16(*(const bf16x8*)(wp + ks * 32), a[ks], acc);
            float o[4];
#pragma unroll
            for (int j = 0; j < 4; ++j) { const float x = acc[j]; const float u = 0.7978845608f * (x + 0.044715f * x * x * x); const float th = 1.0f - 2.0f * frcp(1.0f + __expf(2.0f * u)); o[j] = 0.5f * x * (1.0f + th); }
            u32x2 w; w.x = pack2(o[0], o[1]); w.y = pack2(o[2], o[3]); *(u32x2*)(YG + (size_t)(rb + nt) * 256 + g * 16 + q * 4) = w; }
    }
}
__device__ __forceinline__ void s5_pass2_block(const Params& p, int l, int vb, int nvb, LAS unsigned char* lds) {
    constexpr int PITCH = 520;
    LAS bf16_t* sW = (LAS bf16_t*)lds;
    const int tid = threadIdx.x, lane = tid & 63, m = lane & 15, q = lane >> 4, wv = tid >> 6;
    const bf16_t* P = (const bf16_t*)(p.ws + U_U16); const bf16_t* SP = (const bf16_t*)(p.ws + U_SPREV); bf16_t* YG = (bf16_t*)(p.ws + U_YG);
    if ((nvb & 63) != 0) { s5_pass2_items(p, l, vb * 8 + wv, nvb * 8); return; }
    { const int combo = vb & 63, g = combo >> 2, qd = combo & 3, bi = vb >> 6, nb = nvb >> 6;
        const bf16_t* W2 = (const bf16_t*)(p.ws + WS_SW + (size_t)l * SW_STRIDE + SW_S5W2) + ((size_t)g * 256 + qd * 64) * 512;
        __syncthreads();
        { lu4 st_[8];
#pragma unroll
          for (int j = 0; j < 8; ++j) { const int i = tid + NTHR * j, n = i >> 6, pc = i & 63; st_[j] = *(const lu4*)(W2 + (size_t)n * 512 + pc * 8); }
          __builtin_amdgcn_sched_barrier(0);
#pragma unroll
          for (int j = 0; j < 8; ++j) { const int i = tid + NTHR * j, n = i >> 6, pc = i & 63; *(LAS lu4*)(sW + n * PITCH + pc * 8) = st_[j]; } }
        __syncthreads();
        LAS unsigned char* wb = (LAS unsigned char*)(sW + m * PITCH + q * 8); asm volatile("" : "+v"(wb));
        for (int ct = bi * 8 + wv; ct < 144; ct += nb * 8) { if (l == 1 && ct % 9 == 0) continue;
            const int cr = ct * 16 + m, rb = s5_rowbase(cr);
            bf16x8 a[16];
#pragma unroll
            for (int ks = 0; ks < 8; ++ks) a[ks] = *(const bf16x8*)(P + (size_t)(rb + 2 * ks + (q >> 1)) * 256 + g * 16 + (q & 1) * 8);
#pragma unroll
            for (int ks = 8; ks < 16; ++ks) a[ks] = *(const bf16x8*)(SP + ((size_t)cr * 16 + g) * 256 + (ks - 8) * 32 + q * 8);
#pragma unroll 1
            for (int nt = 0; nt < 4; ++nt) { f32x4 acc = (f32x4){0.f, 0.f, 0.f, 0.f};
#pragma unroll
                for (int ks = 0; ks < 16; ++ks) acc = mfma16(*(const LAS bf16x8*)(wb + nt * 16 * PITCH * 2 + ks * 64), a[ks], acc);
                float o[4];
#pragma unroll
                for (int j = 0; j < 4; ++j) { const float x = acc[j]; const float u = 0.7978845608f * (x + 0.044715f * x * x * x); const float th = 1.0f - 2.0f * frcp(1.0f + __expf(2.0f * u)); o[j] = 0.5f * x * (1.0f + th); }
                u32x2 w; w.x = pack2(o[0], o[1]); w.y = pack2(o[2], o[3]); *(u32x2*)(YG + (size_t)(rb + qd * 4 + nt) * 256 + g * 16 + q * 4) = w; } }
    }
    __syncthreads();
}
__device__ __forceinline__ void s5_glu_items(const Params& p, int l, int wid, int nw) {
    const int lane = threadIdx.x & 63, m = lane & 15, q = lane >> 4;
    const bf16_t* YG = (const bf16_t*)(p.ws + U_YG); bf16_t* YC = (bf16_t*)(p.ws + WS_ABUF);
    const bf16_t* GT = (const bf16_t*)(p.ws + WS_SW + (size_t)l * SW_STRIDE + SW_GLUT);
    const int nrt = (l == 0 ? NROW : NLAT) / 16;
    for (int rt = wid; rt < nrt; rt += nw) { const int row = rt * 16 + m;
        bf16x8 a[8];
#pragma unroll
        for (int ks = 0; ks < 8; ++ks) a[ks] = *(const bf16x8*)(YG + (size_t)row * 256 + ks * 32 + q * 8);
#pragma unroll 2
        for (int nt = 0; nt < 16; ++nt) { f32x4 acc = (f32x4){0.f, 0.f, 0.f, 0.f}; const bf16_t* gp = GT + (size_t)(nt * 16 + m) * 256 + q * 8;
#pragma unroll
            for (int ks = 0; ks < 8; ++ks) acc = mfma16(*(const bf16x8*)(gp + ks * 32), a[ks], acc);
            const int n = nt * 16 + q * 4; const float4 bv = *(const float4*)(p.in[18] + l * 256 + n); const u32x2 yw = *(const u32x2*)(YG + (size_t)row * 256 + n);
            u32x2 w; w.x = pack2(bflo(yw.x) * sigm(acc[0] + bv.x), bfhi(yw.x) * sigm(acc[1] + bv.y)); w.y = pack2(bflo(yw.y) * sigm(acc[2] + bv.z), bfhi(yw.y) * sigm(acc[3] + bv.w));
            *(u32x2*)(YC + (size_t)row * 1024 + n) = w; }
    }
}

__device__ __forceinline__ void s5_glu_block(const Params& p, int l, int vb, int nvb, LAS unsigned char* lds) {
    constexpr int PITCH = 264;
    LAS bf16_t* sG = (LAS bf16_t*)lds;
    const int tid = threadIdx.x, lane = tid & 63, m = lane & 15, q = lane >> 4, wv = tid >> 6;
    if (nvb < 2 || (nvb & 1)) { s5_glu_items(p, l, vb * 8 + wv, nvb * 8); return; }
    const int half = vb & 1, bi = vb >> 1, nb = nvb >> 1;
    const bf16_t* YG = (const bf16_t*)(p.ws + U_YG); bf16_t* YC = (bf16_t*)(p.ws + WS_ABUF);
    const bf16_t* GT = (const bf16_t*)(p.ws + WS_SW + (size_t)l * SW_STRIDE + SW_GLUT) + (size_t)half * 128 * 256;
    __syncthreads();
    { lu4 st_[8];
#pragma unroll
      for (int j = 0; j < 8; ++j) { const int i = tid + NTHR * j, n = i >> 5, pc = i & 31; st_[j] = *(const lu4*)(GT + (size_t)n * 256 + pc * 8); }
      __builtin_amdgcn_sched_barrier(0);
#pragma unroll
      for (int j = 0; j < 8; ++j) { const int i = tid + NTHR * j, n = i >> 5, pc = i & 31; *(LAS lu4*)(sG + n * PITCH + pc * 8) = st_[j]; } }
    __syncthreads();
    LAS unsigned char* gb = (LAS unsigned char*)(sG + m * PITCH + q * 8); asm volatile("" : "+v"(gb));
    const int nrt = (l == 0 ? NROW : NLAT) / 16;
    for (int rt = bi * 8 + wv; rt < nrt; rt += nb * 8) { const int row = rt * 16 + m;
        bf16x8 a[8];
#pragma unroll
        for (int ks = 0; ks < 8; ++ks) a[ks] = *(const bf16x8*)(YG + (size_t)row * 256 + ks * 32 + q * 8);
#pragma unroll 2
        for (int nt = 0; nt < 8; ++nt) { f32x4 acc = (f32x4){0.f, 0.f, 0.f, 0.f};
#pragma unroll
            for (int ks = 0; ks < 8; ++ks) acc = mfma16(*(const LAS bf16x8*)(gb + nt * 16 * PITCH * 2 + ks * 64), a[ks], acc);
            const int n = half * 128 + nt * 16 + q * 4; const float4 bv = *(const float4*)(p.in[18] + l * 256 + n); const u32x2 yw = *(const u32x2*)(YG + (size_t)row * 256 + n);
            u32x2 w; w.x = pack2(bflo(yw.x) * sigm(acc[0] + bv.x), bfhi(yw.x) * sigm(acc[1] + bv.y)); w.y = pack2(bflo(yw.y) * sigm(acc[2] + bv.z), bfhi(yw.y) * sigm(acc[3] + bv.w));
            *(u32x2*)(YC + (size_t)row * 1024 + n) = w; } }
    __syncthreads();
}

template <bool HASLAT> __device__ __forceinline__ void na_unit(const Params& p, const LAS float* rpb_l, int b, int h, int i, int n) {
    const int lane = threadIdx.x & 63, m = lane & 15, q = lane >> 4, kin = 8 * (m >> 2) + (m & 3);
    const bf16_t* QR = (const bf16_t*)(p.ws + U_QR); const bf16_t* KR = (const bf16_t*)(p.ws + U_KR);
    const bf16_t* VTL = (const bf16_t*)(p.ws + U_VT) + (size_t)(b * 6 + h) * 64 * 2048; const bf16_t* VTC = (const bf16_t*)(p.ws + U_VTC) + (size_t)(b * 6 + h) * 64 * 256;
    const int qrow = HASLAT ? b * 2048 + i * 64 + n * 16 + m : NLAT + b * 256 + n * 16 + m;
    bf16x8 qf[2];
#pragma unroll
    for (int ks = 0; ks < 2; ++ks) qf[ks] = *(const bf16x8*)(QR + (size_t)qrow * 384 + h * 64 + ks * 32 + q * 8);
    const int r0 = HASLAT ? min(max(i - 4, 0), 24) : 0, scol = HASLAT ? min(max(n * 16 - 8, 0), 32) : 0;
    f32x4 sl[HASLAT ? 16 : 1], sc[16];
    float mx = -3.0e38f;
    if (HASLAT) { const int qc = n * 16 + m, c0 = min(max(qc - 8, 0), 48); const LAS float* rpb = rpb_l + h * 15 * 31;
#pragma unroll
        for (int t = 0; t < 16; ++t) { const int kr = t >> 1, ch = t & 1; const bf16_t* kp = KR + (size_t)(b * 2048 + (r0 + kr) * 64 + scol + kin + 4 * ch) * 384 + h * 64 + q * 8;
            f32x4 acc = (f32x4){0.f, 0.f, 0.f, 0.f};
#pragma unroll
            for (int ks = 0; ks < 2; ++ks) acc = mfma16(*(const bf16x8*)(kp + ks * 32), qf[ks], acc);
            const int dr = r0 + kr - i + 7;
#pragma unroll
            for (int j = 0; j < 4; ++j) { const int kc = scol + 8 * q + 4 * ch + j; const bool valid = kc >= c0 && kc < c0 + 16; const int dc = min(max(kc - qc + 15, 0), 30);
                const float s = valid ? acc[j] + rpb[dr * 31 + dc] : -1.0e30f; acc[j] = s; mx = fmaxf(mx, s); }
            sl[t] = acc; if ((t & 7) == 7) __builtin_amdgcn_sched_barrier(0); } }
#pragma unroll
    for (int t = 0; t < 16; ++t) { const bf16_t* kp = KR + (size_t)(NLAT + b * 256 + (t >> 1) * 32 + kin + 4 * (t & 1)) * 384 + h * 64 + q * 8;
        f32x4 acc = (f32x4){0.f, 0.f, 0.f, 0.f};
#pragma unroll
        for (int ks = 0; ks < 2; ++ks) acc = mfma16(*(const bf16x8*)(kp + ks * 32), qf[ks], acc);
#pragma unroll
        for (int j = 0; j < 4; ++j) mx = fmaxf(mx, acc[j]);
        sc[t] = acc; }
    mx = fmaxf(mx, __shfl_xor(mx, 16)); mx = fmaxf(mx, __shfl_xor(mx, 32));
    float sum = 0.f;
    f32x4 o[4];
#pragma unroll
    for (int dt = 0; dt < 4; ++dt) o[dt] = (f32x4){0.f, 0.f, 0.f, 0.f};
    if (HASLAT) {
#pragma unroll
        for (int kr = 0; kr < 8; ++kr) { float e[8];
#pragma unroll
            for (int j = 0; j < 4; ++j) { e[j] = __expf(sl[2 * kr][j] - mx); e[4 + j] = __expf(sl[2 * kr + 1][j] - mx); }
#pragma unroll
            for (int j = 0; j < 8; ++j) sum += e[j];
            const uint4 pw = pack8(e); const bf16x8 pf = __builtin_bit_cast(bf16x8, pw);
            const int tok = (r0 + kr) * 64 + scol + q * 8;
#pragma unroll
            for (int dt = 0; dt < 4; ++dt) o[dt] = mfma16(*(const bf16x8*)(VTL + (size_t)(dt * 16 + m) * 2048 + tok), pf, o[dt]);
            if (kr & 1) __builtin_amdgcn_sched_barrier(0); } }
#pragma unroll
    for (int t2 = 0; t2 < 8; ++t2) { float e[8];
#pragma unroll
        for (int j = 0; j < 4; ++j) { e[j] = __expf(sc[2 * t2][j] - mx); e[4 + j] = __expf(sc[2 * t2 + 1][j] - mx); }
#pragma unroll
        for (int j = 0; j < 8; ++j) sum += e[j];
        const uint4 pw = pack8(e); const bf16x8 pf = __builtin_bit_cast(bf16x8, pw);
        const int tok = t2 * 32 + q * 8;
#pragma unroll
        for (int dt = 0; dt < 4; ++dt) o[dt] = mfma16(*(const bf16x8*)(VTC + (size_t)(dt * 16 + m) * 256 + tok), pf, o[dt]);
        if (t2 & 1) __builtin_amdgcn_sched_barrier(0); }
    sum += __shfl_xor(sum, 16); sum += __shfl_xor(sum, 32);
    const float inv = 1.0f / sum;
    bf16_t* yo = (bf16_t*)(p.ws + WS_ABUF) + (size_t)qrow * 1024 + 256 + h * 64 + q * 4;
#pragma unroll
    for (int dt = 0; dt < 4; ++dt) { u32x2 w; w.x = pack2(o[dt][0] * inv, o[dt][1] * inv); w.y = pack2(o[dt][2] * inv, o[dt][3] * inv); *(u32x2*)(yo + dt * 16) = w; }
}
#define NA_SHX(x, msk) __builtin_bit_cast(float, __builtin_amdgcn_ds_bpermute((lane ^ (msk)) << 2, __builtin_bit_cast(int, (x))))
template <bool HASLAT> __device__ __forceinline__ void na_block(const Params& p, int l, int b, int h, int sel, LAS unsigned char* lds) {
    LAS bf16_t* Ks = (LAS bf16_t*)lds;
    LAS bf16_t* Vs = (LAS bf16_t*)lds;
    LAS float* rp = (LAS float*)(lds + 120064);
    int tid = threadIdx.x; asm volatile("" : "+v"(tid));
    const int lane = tid & 63, m = lane & 15, q = lane >> 4, w = tid >> 6, kin = 8 * (m >> 2) + (m & 3);
    const bf16_t* QR = (const bf16_t*)(p.ws + U_QR); const bf16_t* KR = (const bf16_t*)(p.ws + U_KR);
    const bf16_t* VTL = (const bf16_t*)(p.ws + U_VT) + (size_t)(b * 6 + h) * 64 * 2048; const bf16_t* VTC = (const bf16_t*)(p.ws + U_VTC) + (size_t)(b * 6 + h) * 64 * 256;
    const int i0 = HASLAT ? 2 * sel : 0, rlo = HASLAT ? min(max(i0 - 4, 0), 24) : 0;
    __syncthreads();
    int tk = threadIdx.x; asm volatile("" : "+v"(tk));
    { lu4 kl[HASLAT ? 9 : 1], kc[4]; float rpv = 0.f;
      if (HASLAT) {
#pragma unroll
        for (int j = 0; j < 9; ++j) { const int idx = tk + NTHR * j, key = idx >> 3, pc = idx & 7, tok = min(rlo * 64 + key, 2047);
            kl[j] = *(const lu4*)(KR + (size_t)(b * 2048 + tok) * 384 + h * 64 + pc * 8); }
        rpv = p.in[19][(size_t)(l * 6 + h) * 465 + min(tk, 464)]; }
#pragma unroll
      for (int j = 0; j < 4; ++j) { const int idx = tk + NTHR * j, key = idx >> 3, pc = idx & 7; kc[j] = *(const lu4*)(KR + (size_t)(NLAT + b * 256 + key) * 384 + h * 64 + pc * 8); }
      __builtin_amdgcn_sched_barrier(0);
      if (HASLAT) {
#pragma unroll
        for (int j = 0; j < 9; ++j) { const int idx = tk + NTHR * j, key = idx >> 3, pc = idx & 7; *(LAS lu4*)(Ks + key * 72 + pc * 8) = kl[j]; }
        if (tk < 465) rp[tk] = rpv; }
#pragma unroll
      for (int j = 0; j < 4; ++j) { const int idx = tk + NTHR * j, key = idx >> 3, pc = idx & 7; *(LAS lu4*)(Ks + (576 + key) * 72 + pc * 8) = kc[j]; } }
    const int i = HASLAT ? i0 + (w >> 2) : 0, n = HASLAT ? (w & 3) : sel * 8 + w;
    const int qrow = HASLAT ? b * 2048 + i * 64 + n * 16 + m : NLAT + b * 256 + n * 16 + m;
    bf16x8 qf[2];
#pragma unroll
    for (int ks = 0; ks < 2; ++ks) qf[ks] = *(const bf16x8*)(QR + (size_t)qrow * 384 + h * 64 + ks * 32 + q * 8);
    const int r0 = HASLAT ? min(max(i - 4, 0), 24) : 0, scol = HASLAT ? min(max(n * 16 - 8, 0), 32) : 0, kb = (r0 - rlo) * 64 + scol;
    LAS unsigned char* kbl = (LAS unsigned char*)(Ks + (kb + kin) * 72 + q * 8); LAS unsigned char* kbc = (LAS unsigned char*)(Ks + (576 + kin) * 72 + q * 8);
    asm volatile("" : "+v"(kbl), "+v"(kbc));
    __syncthreads();
    float mx1 = -3.0e38f, mx2 = -3.0e38f, sum1 = 0.f, sum2 = 0.f;
    bf16x8 pl[HASLAT ? 8 : 1], pcx[8];
    if (HASLAT) { const int qc = n * 16 + m, c0 = min(max(qc - 8, 0), 48); f32x4 sl[16];
#pragma unroll
        for (int t = 0; t < 16; ++t) { const int kr = t >> 1, ch = t & 1; const LAS bf16_t* kp = (const LAS bf16_t*)(kbl + (kr * 64 + 4 * ch) * 144);
            f32x4 acc = (f32x4){0.f, 0.f, 0.f, 0.f};
#pragma unroll
            for (int ks = 0; ks < 2; ++ks) acc = mfma16(*(const LAS bf16x8*)(kp + ks * 32), qf[ks], acc);
            const int dr = r0 + kr - i + 7;
#pragma unroll
            for (int j = 0; j < 4; ++j) { const int kc = scol + 8 * q + 4 * ch + j; const bool valid = kc >= c0 && kc < c0 + 16; const int dc = min(max(kc - qc + 15, 0), 30);
                float bias = rp[dr * 31 + dc]; asm("" : "+v"(bias));
                const float sv = valid ? acc[j] + bias : -1.0e30f; acc[j] = sv; mx1 = fmaxf(mx1, sv); }
            sl[t] = acc; if ((t & 3) == 3) __builtin_amdgcn_sched_barrier(0); }
        mx1 = fmaxf(mx1, NA_SHX(mx1, 16)); mx1 = fmaxf(mx1, NA_SHX(mx1, 32)); const float nm1 = -mx1 * 1.4426950408889634f;
#pragma unroll
        for (int kr = 0; kr < 8; ++kr) { float e[8];
#pragma unroll
            for (int j = 0; j < 4; ++j) { e[j] = __builtin_amdgcn_exp2f(fmaf(sl[2 * kr][j], 1.4426950408889634f, nm1)); e[4 + j] = __builtin_amdgcn_exp2f(fmaf(sl[2 * kr + 1][j], 1.4426950408889634f, nm1)); }
#pragma unroll
            for (int j = 0; j < 8; ++j) sum1 += e[j];
            const uint4 pw = pack8(e); pl[kr] = __builtin_bit_cast(bf16x8, pw); }
        __builtin_amdgcn_sched_barrier(0); }
    { f32x4 sc[16];
#pragma unroll
      for (int t = 0; t < 16; ++t) { const LAS bf16_t* kp = (const LAS bf16_t*)(kbc + ((t >> 1) * 32 + 4 * (t & 1)) * 144);
          f32x4 acc = (f32x4){0.f, 0.f, 0.f, 0.f};
#pragma unroll
          for (int ks = 0; ks < 2; ++ks) acc = mfma16(*(const LAS bf16x8*)(kp + ks * 32), qf[ks], acc);
#pragma unroll
          for (int j = 0; j < 4; ++j) mx2 = fmaxf(mx2, acc[j]);
          sc[t] = acc; if ((t & 3) == 3) __builtin_amdgcn_sched_barrier(0); }
      mx2 = fmaxf(mx2, NA_SHX(mx2, 16)); mx2 = fmaxf(mx2, NA_SHX(mx2, 32)); const float nm2 = -mx2 * 1.4426950408889634f;
#pragma unroll
      for (int t2 = 0; t2 < 8; ++t2) { float e[8];
#pragma unroll
          for (int j = 0; j < 4; ++j) { e[j] = __builtin_amdgcn_exp2f(fmaf(sc[2 * t2][j], 1.4426950408889634f, nm2)); e[4 + j] = __builtin_amdgcn_exp2f(fmaf(sc[2 * t2 + 1][j], 1.4426950408889634f, nm2)); }
#pragma unroll
          for (int j = 0; j < 8; ++j) sum2 += e[j];
          const uint4 pw = pack8(e); pcx[t2] = __builtin_bit_cast(bf16x8, pw); } }
    sum1 += NA_SHX(sum1, 16); sum1 += NA_SHX(sum1, 32); sum2 += NA_SHX(sum2, 16); sum2 += NA_SHX(sum2, 32);
    __builtin_amdgcn_sched_barrier(0);
    __syncthreads();
    int tv = threadIdx.x; asm volatile("" : "+v"(tv));
    __builtin_amdgcn_sched_barrier(0);
    if (HASLAT) {
#pragma unroll
        for (int j = 0; j < 9; ++j) { const int idx = tv + NTHR * j, dim = idx / 72, pc = idx % 72, tok = rlo * 64 + pc * 8;
            if (tok < 2048) *(LAS lu4*)(Vs + dim * 840 + pc * 8) = *(const lu4*)(VTL + (size_t)dim * 2048 + tok); } }
#pragma unroll
    for (int j = 0; j < 4; ++j) { const int idx = tv + NTHR * j, dim = idx >> 5, pc = idx & 31; *(LAS lu4*)(Vs + dim * 840 + 576 + pc * 8) = *(const lu4*)(VTC + (size_t)dim * 256 + pc * 8); }
    __builtin_amdgcn_sched_barrier(0);
    __syncthreads();
    __builtin_amdgcn_sched_barrier(0);
    const int kbv = kb * 2;
    LAS unsigned char* vb0 = (LAS unsigned char*)(Vs + (0 * 16 + m) * 840 + q * 8); LAS unsigned char* vb1 = (LAS unsigned char*)(Vs + (1 * 16 + m) * 840 + q * 8);
    LAS unsigned char* vb2 = (LAS unsigned char*)(Vs + (2 * 16 + m) * 840 + q * 8); LAS unsigned char* vb3 = (LAS unsigned char*)(Vs + (3 * 16 + m) * 840 + q * 8);
    asm volatile("" : "+v"(vb0), "+v"(vb1), "+v"(vb2), "+v"(vb3));
    f32x4 o1[4], o2[4];
#pragma unroll
    for (int dt = 0; dt < 4; ++dt) { o1[dt] = (f32x4){0.f, 0.f, 0.f, 0.f}; o2[dt] = (f32x4){0.f, 0.f, 0.f, 0.f}; }
    if (HASLAT) {
#pragma unroll
        for (int kr = 0; kr < 8; ++kr) {
#pragma unroll
            for (int dt = 0; dt < 4; ++dt) { LAS unsigned char* vb = dt == 0 ? vb0 : dt == 1 ? vb1 : dt == 2 ? vb2 : vb3; o1[dt] = mfma16(*(const LAS bf16x8*)(vb + kbv + kr * 128), pl[kr], o1[dt]); }
            if (kr & 1) __builtin_amdgcn_sched_barrier(0); } }
#pragma unroll
    for (int t2 = 0; t2 < 8; ++t2) {
#pragma unroll
        for (int dt = 0; dt < 4; ++dt) { LAS unsigned char* vb = dt == 0 ? vb0 : dt == 1 ? vb1 : dt == 2 ? vb2 : vb3; o2[dt] = mfma16(*(const LAS bf16x8*)(vb + 1152 + t2 * 64), pcx[t2], o2[dt]); }
        if (t2 & 1) __builtin_amdgcn_sched_barrier(0); }
    const float mxm = fmaxf(mx1, mx2), a1 = HASLAT ? __expf(mx1 - mxm) : 0.f, a2 = __expf(mx2 - mxm), inv = 1.0f / (a1 * sum1 + a2 * sum2), c1 = a1 * inv, c2 = a2 * inv;
    bf16_t* yo = (bf16_t*)(p.ws + WS_ABUF) + (size_t)qrow * 1024 + 256 + h * 64 + q * 4;
#pragma unroll
    for (int dt = 0; dt < 4; ++dt) { u32x2 wv2; wv2.x = pack2(o1[dt][0] * c1 + o2[dt][0] * c2, o1[dt][1] * c1 + o2[dt][1] * c2); wv2.y = pack2(o1[dt][2] * c1 + o2[dt][2] * c2, o1[dt][3] * c1 + o2[dt][3] * c2); *(u32x2*)(yo + dt * 16) = wv2; }
}
#undef NA_SHX
__device__ __forceinline__ void na_items(const Params& p, int l, int wid, int nw, LAS unsigned char* lds) {
    (void)wid; (void)nw;
    const int nlat = 16 * 6 * 16, nctx = (l == 0) ? 16 * 6 * 2 : 0;
    unsigned* ctr = (unsigned*)(p.ws + WS_CTL + 49152) + 1 + l; LAS int* slot = (LAS int*)(lds + LDS_MISC + 32);
    __syncthreads();
    if (threadIdx.x == 0) *slot = (int)atomicAdd(ctr, 1u);
    __syncthreads();
    int it = __builtin_amdgcn_readfirstlane(*slot);
    while (it < nlat + nctx) {
        int nxt = 0; if (threadIdx.x == 0) nxt = (int)atomicAdd(ctr, 1u);
        if (it < nlat) { const int ip = it & 15, bh = it >> 4; na_block<true>(p, l, bh / 6, bh % 6, ip, lds); }
        else { const int j = it - nlat, half = j & 1, bh = j >> 1; na_block<false>(p, l, bh / 6, bh % 6, half, lds); }
        __syncthreads();
        if (threadIdx.x == 0) *slot = nxt;
        __syncthreads();
        it = __builtin_amdgcn_readfirstlane(*slot);
    }
    __syncthreads();
}

typedef float f32x2 __attribute__((ext_vector_type(2)));
__device__ __forceinline__ int rk_row(int b, int d, int n) { return n < 256 ? NLAT + b * 256 + (d ? 255 - n : n) : b * 2048 + (d ? 2047 - (n - 256) : (n - 256)); }
template <int CTRL> __device__ __forceinline__ float dpp_f(float v) { return __builtin_bit_cast(float, __builtin_amdgcn_update_dpp(0, __builtin_bit_cast(int, v), CTRL, 0xF, 0xF, true)); }
constexpr int RKP_WAVE = 4 * 16 * 17 * 4;
__device__ __forceinline__ bf16x8 pack_frag(const float (&lo)[4], const float (&hi)[4]) { u32x4 w; w.x = pack2(lo[0], lo[1]); w.y = pack2(lo[2], lo[3]); w.z = pack2(hi[0], hi[1]); w.w = pack2(hi[2], hi[3]); return __builtin_bit_cast(bf16x8, w); }
__device__ __forceinline__ bf16x8 pack_lo(const f32x4 v) { u32x4 w; w.x = pack2(v[0], v[1]); w.y = pack2(v[2], v[3]); w.z = 0u; w.w = 0u; return __builtin_bit_cast(bf16x8, w); }
__device__ __forceinline__ void rwkv_pre_items(const Params& p, int l, int wid, int nw, LAS unsigned char* lds) {
    const int lane = threadIdx.x & 63, m = lane & 15, q = lane >> 4, wv = threadIdx.x >> 6;
    LAS float* sM = (LAS float*)(lds + wv * RKP_WAVE);
    const bf16_t* RS = (const bf16_t*)(p.ws + U_RS); const bf16_t* KS = (const bf16_t*)(p.ws + U_KS); const bf16_t* VS = (const bf16_t*)(p.ws + U_VS); const bf16_t* KK = (const bf16_t*)(p.ws + U_KK);
    bf16x8 isel[2], idg;
    { const unsigned one = 0x3F80u << ((m & 1) * 16); const int wi = (m & 7) >> 1;
#pragma unroll
      for (int s2 = 0; s2 < 2; ++s2) { const unsigned v = (q == 2 * s2 + (m >> 3)) ? one : 0u; const u32x4 w = {wi == 0 ? v : 0u, wi == 1 ? v : 0u, wi == 2 ? v : 0u, wi == 3 ? v : 0u}; isel[s2] = __builtin_bit_cast(bf16x8, w); }
      const int jp = m & 3; const unsigned dv = (q == (m >> 2)) ? (0x3F80u << ((jp & 1) * 16)) : 0u; const u32x4 w = {0u, 0u, (jp >> 1) == 0 ? dv : 0u, (jp >> 1) == 1 ? dv : 0u}; idg = __builtin_bit_cast(bf16x8, w); }
    const f32x4 z4 = {0.f, 0.f, 0.f, 0.f};
    for (int it = wid; it < NCHUNK; it += nw) { const int u = it / 144, c = it % 144, b = u / 12, h = (u % 12) >> 1, d = u & 1;
        const bf16_t* AG = (const bf16_t*)(p.ws + U_AG + (size_t)d * SZ384); const bf16_t* LD = (const bf16_t*)(p.ws + U_LD + (size_t)d * SZ384);
        const int rb = rk_row(b, d, c * 16), sgn = d ? -1 : 1;
        const size_t ro = (size_t)(rb + sgn * m) * 384 + h * 64 + 8 * q;
        u32x4 raw[6][2]; float4 kaf[4];
#pragma unroll
        for (int ks = 0; ks < 2; ++ks) { raw[0][ks] = *(const u32x4*)(KK + ro + 32 * ks); raw[1][ks] = *(const u32x4*)(AG + ro + 32 * ks); raw[2][ks] = *(const u32x4*)(KS + ro + 32 * ks);
            raw[3][ks] = *(const u32x4*)(RS + ro + 32 * ks); raw[4][ks] = *(const u32x4*)(VS + ro + 32 * ks); raw[5][ks] = *(const u32x4*)(LD + ro + 32 * ks);
            kaf[2 * ks] = *(const float4*)(p.in[27] + l * 384 + h * 64 + 32 * ks + 8 * q); kaf[2 * ks + 1] = *(const float4*)(p.in[27] + l * 384 + h * 64 + 32 * ks + 8 * q + 4); }
        __builtin_amdgcn_sched_barrier(0);
        bf16x8 atf[2], rtf[2], bhf[2], khf[2], vf[2];
#pragma unroll
        for (int ks = 0; ks < 2; ++ks) { float at[8], bh[8], kh[8], rt[8], lk[8];
            const float ka[8] = {kaf[2 * ks].x, kaf[2 * ks].y, kaf[2 * ks].z, kaf[2 * ks].w, kaf[2 * ks + 1].x, kaf[2 * ks + 1].y, kaf[2 * ks + 1].z, kaf[2 * ks + 1].w};
#pragma unroll
            for (int w = 0; w < 4; ++w)
#pragma unroll
                for (int hh = 0; hh < 2; ++hh) { const int i = 2 * w + hh;
                    const float kk_ = hh ? bfhi(raw[0][ks][w]) : bflo(raw[0][ks][w]), ag_ = hh ? bfhi(raw[1][ks][w]) : bflo(raw[1][ks][w]), k_ = hh ? bfhi(raw[2][ks][w]) : bflo(raw[2][ks][w]);
                    const float r_ = hh ? bfhi(raw[3][ks][w]) : bflo(raw[3][ks][w]), ld2 = (hh ? bfhi(raw[5][ks][w]) : bflo(raw[5][ks][w])) * 1.4426950408889634f;
                    float L = ld2; L += dpp_f<0x111>(L); L += dpp_f<0x112>(L); L += dpp_f<0x114>(L); L += dpp_f<0x118>(L);
                    const float e1 = __builtin_amdgcn_exp2f(L), ei = __builtin_amdgcn_exp2f(-L), e0 = __builtin_amdgcn_exp2f(L - ld2);
                    at[i] = -kk_ * e0; bh[i] = kk_ * ag_ * ei; kh[i] = k_ * (1.0f + (ag_ - 1.0f) * ka[i]) * ei; rt[i] = r_ * e1; lk[i] = L * 0.6931471805599453f; }
            { const u32x4 w0 = {pack2(at[0], at[1]), pack2(at[2], at[3]), pack2(at[4], at[5]), pack2(at[6], at[7])}; atf[ks] = __builtin_bit_cast(bf16x8, w0);
              const u32x4 w1 = {pack2(bh[0], bh[1]), pack2(bh[2], bh[3]), pack2(bh[4], bh[5]), pack2(bh[6], bh[7])}; bhf[ks] = __builtin_bit_cast(bf16x8, w1);
              const u32x4 w2 = {pack2(kh[0], kh[1]), pack2(kh[2], kh[3]), pack2(kh[4], kh[5]), pack2(kh[6], kh[7])}; khf[ks] = __builtin_bit_cast(bf16x8, w2);
              const u32x4 w3 = {pack2(rt[0], rt[1]), pack2(rt[2], rt[3]), pack2(rt[4], rt[5]), pack2(rt[6], rt[7])}; rtf[ks] = __builtin_bit_cast(bf16x8, w3);
              vf[ks] = __builtin_bit_cast(bf16x8, raw[4][ks]);
              if (m == 15) { const u32x4 wl = {pack2(lk[0], lk[1]), pack2(lk[2], lk[3]), pack2(lk[4], lk[5]), pack2(lk[6], lk[7])};
                  *(u32x4*)((bf16_t*)(p.ws + CH_GT) + (size_t)it * 64 + 32 * ks + 8 * q) = wl; } } }
        { f32x4 mab = z4, mak = z4, mrb = z4, mrk = z4;
#pragma unroll
          for (int ks = 0; ks < 2; ++ks) { mab = mfma16(atf[ks], bhf[ks], mab); mak = mfma16(atf[ks], khf[ks], mak); mrb = mfma16(rtf[ks], bhf[ks], mrb); mrk = mfma16(rtf[ks], khf[ks], mrk); }
#pragma unroll
          for (int r = 0; r < 4; ++r) { const int t = 4 * q + r; sM[(0 * 16 + t) * 17 + m] = m < t ? mab[r] : 0.f; sM[(1 * 16 + t) * 17 + m] = m < t ? mak[r] : 0.f;
              sM[(2 * 16 + t) * 17 + m] = m <= t ? mrb[r] : 0.f; sM[(3 * 16 + t) * 17 + m] = m <= t ? mrk[r] : 0.f; } }
        { float tv[16];
#pragma unroll
          for (int t = 0; t < 16; ++t) { float acc = (m == t) ? 1.0f : 0.0f;
#pragma unroll
              for (int s2 = 0; s2 < t; ++s2) acc += sM[t * 17 + s2] * tv[s2];
              tv[t] = acc; }
#pragma unroll
          for (int t = 0; t < 16; ++t) if (q == 0) sM[t * 17 + m] = tv[t]; }
        bf16x8 tinvf, mrbf, makf;
        { float lo[4], hi[4] = {0.f, 0.f, 0.f, 0.f};
#pragma unroll
          for (int j = 0; j < 4; ++j) lo[j] = sM[(0 * 16 + m) * 17 + 4 * q + j];
          tinvf = pack_frag(lo, hi);
#pragma unroll
          for (int j = 0; j < 4; ++j) lo[j] = sM[(1 * 16 + m) * 17 + 4 * q + j];
          makf = pack_frag(lo, hi);
#pragma unroll
          for (int j = 0; j < 4; ++j) lo[j] = sM[(2 * 16 + m) * 17 + 4 * q + j];
          mrbf = pack_frag(lo, hi);
#pragma unroll
          for (int j = 0; j < 4; ++j) hi[j] = sM[(3 * 16 + m) * 17 + 4 * q + j];
          *(bf16x8*)((bf16_t*)(p.ws + CH_MM) + ((size_t)it * 64 + lane) * 8) = pack_frag(lo, hi); }
#pragma unroll
        for (int itile = 0; itile < 4; ++itile) { const f32x4 vt = mfma16(vf[itile >> 1], isel[itile & 1], z4);
            const f32x4 w1 = mfma16(makf, pack_lo(vt), z4);
            const f32x4 uu = mfma16(tinvf, pack_lo(w1), z4);
            u32x2 o; o.x = pack2(uu[0], uu[1]); o.y = pack2(uu[2], uu[3]);
            *(u32x2*)((bf16_t*)(p.ws + CH_UL) + (((size_t)it * 4 + itile) * 64 + lane) * 4) = o; }
        const u32x4 mrbw = __builtin_bit_cast(u32x4, mrbf), idgw = __builtin_bit_cast(u32x4, idg); const u32x4 rpbw = {mrbw.x, mrbw.y, idgw.z, idgw.w}; const bf16x8 rpb = __builtin_bit_cast(bf16x8, rpbw);
        u32x2 xa = {0u, 0u}, xr = {0u, 0u};
#pragma unroll
        for (int jt = 0; jt < 4; ++jt) { const int ks = jt >> 1;
            const bf16x8 att = pack_lo(mfma16(atf[ks], isel[jt & 1], z4));
            const f32x4 ap = mfma16(tinvf, att, z4);
            const f32x4 apT = mfma16(att, tinvf, z4);
            const f32x4 rtt = mfma16(rtf[ks], isel[jt & 1], z4);
            u32x4 aw = __builtin_bit_cast(u32x4, pack_lo(ap)); aw.z = pack2(rtt[0], rtt[1]); aw.w = pack2(rtt[2], rtt[3]);
            const f32x4 rpT = mfma16(__builtin_bit_cast(bf16x8, aw), rpb, z4);
            const f32x4 bht = mfma16(bhf[ks], isel[jt & 1], z4), kht = mfma16(khf[ks], isel[jt & 1], z4);
            { u32x4 w; w.x = pack2(bht[0], bht[1]); w.y = pack2(bht[2], bht[3]); w.z = pack2(kht[0], kht[1]); w.w = pack2(kht[2], kht[3]);
              *(u32x4*)((bf16_t*)(p.ws + CH_BK) + (((size_t)it * 4 + jt) * 64 + lane) * 8) = w; }
            if ((jt & 1) == 0) { xa.x = pack2(apT[0], apT[1]); xa.y = pack2(apT[2], apT[3]); xr.x = pack2(rpT[0], rpT[1]); xr.y = pack2(rpT[2], rpT[3]); }
            else { const u32x4 wa = {xa.x, xa.y, pack2(apT[0], apT[1]), pack2(apT[2], apT[3])}, wr2 = {xr.x, xr.y, pack2(rpT[0], rpT[1]), pack2(rpT[2], rpT[3])};
                *(u32x4*)((bf16_t*)(p.ws + CH_XP) + ((((size_t)it * 2 + 0) * 2 + ks) * 64 + lane) * 8) = wa;
                *(u32x4*)((bf16_t*)(p.ws + CH_XP) + ((((size_t)it * 2 + 1) * 2 + ks) * 64 + lane) * 8) = wr2; } }
    }
}
__device__ __forceinline__ void rwkv_seq_task(const Params& p, int l, int task, LAS unsigned char* lds) {
    const int lane = threadIdx.x & 63, m = lane & 15, q = lane >> 4;
    const int u = task >> 2, iw = task & 3, b = u / 12, h = (u % 12) >> 1, d = u & 1, sgn = d ? -1 : 1;
    const bf16_t* XP = (const bf16_t*)(p.ws + CH_XP); const bf16_t* BK = (const bf16_t*)(p.ws + CH_BK); const bf16_t* UL = (const bf16_t*)(p.ws + CH_UL); const bf16_t* MM = (const bf16_t*)(p.ws + CH_MM);
    const bf16_t* GT = (const bf16_t*)(p.ws + CH_GT); const bf16_t* VS = (const bf16_t*)(p.ws + U_VS) + h * 64 + 16 * iw;
    float* Yw = (float*)(p.ws + U_YRK) + (size_t)d * NROW * 384 + h * 64 + 16 * iw;
    LAS float* ybuf = (LAS float*)(lds + (threadIdx.x >> 6) * 12288);
    const int rc0 = NLAT + b * 256 + (d ? 255 : 0) + sgn * 4 * q, rdel = (b * 2048 + (d ? 2047 : 0)) - (NLAT + b * 256 + (d ? 255 : 0)) - sgn * 256;
    f32x4 acc[4];
#pragma unroll
    for (int jt = 0; jt < 4; ++jt) acc[jt] = (f32x4){0.f, 0.f, 0.f, 0.f};
    const unsigned vo16 = (unsigned)lane * 16u, vo8 = (unsigned)lane * 8u, vo8q = (unsigned)q * 8u;
    struct OpSet { u32x4 apf0, apf1, rpf0, rpf1, bkf0, bkf1, bkf2, bkf3, mmf; u32x2 gl0, gl1, gl2, gl3, uw; unsigned vr0, vr1, vr2, vr3; };
#define GLDS16(dst, voff, sbase, imm) asm volatile("global_load_dwordx4 %0, %1, %2 offset:" #imm : "=&v"(dst) : "v"(voff), "s"(sbase) : "memory")
#define GLDS8(dst, voff, sbase, imm) asm volatile("global_load_dwordx2 %0, %1, %2 offset:" #imm : "=&v"(dst) : "v"(voff), "s"(sbase) : "memory")
#define GLDS2(dst, voff, sbase) asm volatile("global_load_ushort %0, %1, %2" : "=&v"(dst) : "v"(voff), "s"(sbase) : "memory")
#define RKS_LOAD(X, c_) do { const size_t it_ = (size_t)u * 144 + (c_); const int rb_ = rc0 + sgn * 16 * (c_) + (int)((c_) >= 16) * rdel; \
        const bf16_t* xpb = XP + it_ * 2048; const bf16_t* bkb = BK + it_ * 2048; const bf16_t* mmb = MM + it_ * 512; const bf16_t* gtb = GT + it_ * 64; const bf16_t* ulb = UL + (it_ * 4 + iw) * 256; \
        GLDS16(X.apf0, vo16, xpb, 0); GLDS16(X.apf1, vo16, xpb, 1024); GLDS16(X.rpf0, vo16, xpb, 2048); GLDS16(X.rpf1, vo16, xpb, 3072); \
        GLDS16(X.bkf0, vo16, bkb, 0); GLDS16(X.bkf1, vo16, bkb, 1024); GLDS16(X.bkf2, vo16, bkb, 2048); GLDS16(X.bkf3, vo16, bkb, 3072); \
        GLDS8(X.gl0, vo8q, gtb, 0); GLDS8(X.gl1, vo8q, gtb, 32); GLDS8(X.gl2, vo8q, gtb, 64); GLDS8(X.gl3, vo8q, gtb, 96); \
        GLDS16(X.mmf, vo16, mmb, 0); GLDS8(X.uw, vo8, ulb, 0); \
        { const unsigned v0_ = (unsigned)(rb_) * 768u + 2u * m, v1_ = (unsigned)(rb_ + sgn) * 768u + 2u * m, v2_ = (unsigned)(rb_ + 2 * sgn) * 768u + 2u * m, v3_ = (unsigned)(rb_ + 3 * sgn) * 768u + 2u * m; \
          GLDS2(X.vr0, v0_, VS); GLDS2(X.vr1, v1_, VS); GLDS2(X.vr2, v2_, VS); GLDS2(X.vr3, v3_, VS); } } while (0)
#define RKS_WAIT(X) asm volatile("s_waitcnt vmcnt(36)" : "+v"(X.apf0), "+v"(X.apf1), "+v"(X.rpf0), "+v"(X.rpf1), "+v"(X.bkf0), "+v"(X.bkf1), "+v"(X.bkf2), "+v"(X.bkf3), "+v"(X.mmf), \
        "+v"(X.gl0), "+v"(X.gl1), "+v"(X.gl2), "+v"(X.gl3), "+v"(X.uw), "+v"(X.vr0), "+v"(X.vr1), "+v"(X.vr2), "+v"(X.vr3) :: "memory")
#define BF8(x) __builtin_bit_cast(bf16x8, x)
#define RKS_COMPUTE(X, c_) do { RKS_WAIT(X); \
        const float ul[4] = {bflo(X.uw.x), bfhi(X.uw.x), bflo(X.uw.y), bfhi(X.uw.y)}; const float vl[4] = {bflo(X.vr0), bflo(X.vr1), bflo(X.vr2), bflo(X.vr3)}; \
        f32x4 zp = (f32x4){0.f, 0.f, 0.f, 0.f}, yp = zp; \
        { const float lo[4] = {acc[0][0], acc[0][1], acc[0][2], acc[0][3]}, hi[4] = {acc[1][0], acc[1][1], acc[1][2], acc[1][3]}; const bf16x8 sf = pack_frag(lo, hi); zp = mfma16(BF8(X.apf0), sf, zp); yp = mfma16(BF8(X.rpf0), sf, yp); } \
        { const float lo[4] = {acc[2][0], acc[2][1], acc[2][2], acc[2][3]}, hi[4] = {acc[3][0], acc[3][1], acc[3][2], acc[3][3]}; const bf16x8 sf = pack_frag(lo, hi); zp = mfma16(BF8(X.apf1), sf, zp); yp = mfma16(BF8(X.rpf1), sf, yp); } \
        const float z[4] = {zp[0] + ul[0], zp[1] + ul[1], zp[2] + ul[2], zp[3] + ul[3]}; \
        yp = mfma16(BF8(X.mmf), pack_frag(ul, vl), yp); \
        const bf16x8 zvf = pack_frag(z, vl); \
        acc[0] = mfma16(BF8(X.bkf0), zvf, acc[0]); acc[1] = mfma16(BF8(X.bkf1), zvf, acc[1]); acc[2] = mfma16(BF8(X.bkf2), zvf, acc[2]); acc[3] = mfma16(BF8(X.bkf3), zvf, acc[3]); \
        { const f32x4 g4 = {__expf(bflo(X.gl0.x)), __expf(bfhi(X.gl0.x)), __expf(bflo(X.gl0.y)), __expf(bfhi(X.gl0.y))}; acc[0] *= g4; } \
        { const f32x4 g4 = {__expf(bflo(X.gl1.x)), __expf(bfhi(X.gl1.x)), __expf(bflo(X.gl1.y)), __expf(bfhi(X.gl1.y))}; acc[1] *= g4; } \
        { const f32x4 g4 = {__expf(bflo(X.gl2.x)), __expf(bfhi(X.gl2.x)), __expf(bflo(X.gl2.y)), __expf(bfhi(X.gl2.y))}; acc[2] *= g4; } \
        { const f32x4 g4 = {__expf(bflo(X.gl3.x)), __expf(bfhi(X.gl3.x)), __expf(bflo(X.gl3.y)), __expf(bfhi(X.gl3.y))}; acc[3] *= g4; } \
        _Pragma("unroll") for (int r = 0; r < 4; ++r) ybuf[((((c_) % 12) * 16) + 4 * q + r) * 16 + m] = yp[r]; } while (0)
    asm volatile("; SEQ_BEGIN");
    OpSet A, B, C;
    RKS_LOAD(A, 0); RKS_LOAD(B, 1);
    for (int c0 = 0; c0 < 144; c0 += 12) {
#pragma unroll
        for (int cc = 0; cc < 12; cc += 3) { const int c = c0 + cc;
            RKS_LOAD(C, c + 2); __builtin_amdgcn_sched_barrier(0);
            RKS_COMPUTE(A, c); __builtin_amdgcn_sched_barrier(0);
            { const int cn = c + 3 < 144 ? c + 3 : 143; RKS_LOAD(A, cn); } __builtin_amdgcn_sched_barrier(0);
            RKS_COMPUTE(B, c + 1); __builtin_amdgcn_sched_barrier(0);
            { const int cn = c + 4 < 144 ? c + 4 : 143; RKS_LOAD(B, cn); } __builtin_amdgcn_sched_barrier(0);
            RKS_COMPUTE(C, c + 2); __builtin_amdgcn_sched_barrier(0); }
#pragma unroll
        for (int k = 0; k < 12; ++k) { const int rr = (lane >> 2) + 16 * k, n = c0 * 16 + rr; const int grow = (rc0 - sgn * 4 * q) + sgn * n + (int)(n >= 256) * rdel;
            *(f32x4*)(Yw + (size_t)grow * 384 + (lane & 3) * 4) = *(const LAS f32x4*)(ybuf + rr * 16 + (lane & 3) * 4); }
    }
    asm volatile("; SEQ_END");
#undef RKS_LOAD
#undef RKS_COMPUTE
#undef RKS_WAIT
#undef GLDS16
#undef GLDS8
#undef GLDS2
#undef BF8
}

__device__ __forceinline__ void rwkv_seq_block(const Params& p, int l, int u, LAS unsigned char* lds) {
    (void)l;
    const int tid = threadIdx.x, lane = tid & 63, wv = __builtin_amdgcn_readfirstlane(tid >> 6), m = lane & 15, q = lane >> 4;
    const int b = u / 12, h = (u % 12) >> 1, d = u & 1, sgn = d ? -1 : 1;
    const unsigned char* XPb = p.ws + CH_XP + (size_t)u * 144 * 4096; const unsigned char* BKb = p.ws + CH_BK + (size_t)u * 144 * 4096;
    const unsigned char* MMb = p.ws + CH_MM + (size_t)u * 144 * 1024; const unsigned char* GTb = p.ws + CH_GT + (size_t)u * 144 * 128;
    LAS unsigned char* ring = lds + 49152;
#define SEQ_BAR() asm volatile("s_waitcnt lgkmcnt(0)\n\ts_barrier" ::: "memory")
    __syncthreads();
    if (wv >= 4) {
        const int lw = wv - 4; const bool hasmm = lw == 0, hasgt = (lw == 1) && lane < 8;
        lu4 xp[3], bk[3], mm[3], gt[3];
#define LDR_LOAD(k, c_) do { const int cc_ = (c_) < 144 ? (c_) : 143; xp[k] = *(const lu4*)(XPb + (size_t)cc_ * 4096 + lw * 1024 + lane * 16); bk[k] = *(const lu4*)(BKb + (size_t)cc_ * 4096 + lw * 1024 + lane * 16); \
            if (hasmm) mm[k] = *(const lu4*)(MMb + (size_t)cc_ * 1024 + lane * 16); if (hasgt) gt[k] = *(const lu4*)(GTb + (size_t)cc_ * 128 + lane * 16); } while (0)
#define LDR_STORE(k, c_) do { if ((c_) < 144) { LAS unsigned char* sl_ = ring + ((c_) % 3) * 9728; *(LAS lu4*)(sl_ + lw * 1024 + lane * 16) = xp[k]; *(LAS lu4*)(sl_ + 4096 + lw * 1024 + lane * 16) = bk[k]; \
            if (hasmm) *(LAS lu4*)(sl_ + 8192 + lane * 16) = mm[k]; if (hasgt) *(LAS lu4*)(sl_ + 9216 + lane * 16) = gt[k]; } } while (0)
        LDR_LOAD(0, 0); LDR_LOAD(1, 1); LDR_LOAD(2, 2);
        LDR_STORE(0, 0); LDR_LOAD(0, 3); LDR_STORE(1, 1); LDR_LOAD(1, 4);
        SEQ_BAR();
        for (int i0 = 0; i0 < 144; i0 += 3) {
            LDR_STORE(2, i0 + 2); LDR_LOAD(2, i0 + 5); SEQ_BAR();
            LDR_STORE(0, i0 + 3); LDR_LOAD(0, i0 + 6); SEQ_BAR();
            LDR_STORE(1, i0 + 4); LDR_LOAD(1, i0 + 7); SEQ_BAR(); }
#undef LDR_LOAD
#undef LDR_STORE
    } else {
        const int iw = wv;
        const bf16_t* UL = (const bf16_t*)(p.ws + CH_UL) + (size_t)u * 144 * 1024; const bf16_t* VS = (const bf16_t*)(p.ws + U_VS) + h * 64 + 16 * iw;
        float* Yw = (float*)(p.ws + U_YRK) + (size_t)d * NROW * 384 + h * 64 + 16 * iw;
        LAS float* ybuf = (LAS float*)(lds + wv * 12288);
        const int rc0 = NLAT + b * 256 + (d ? 255 : 0) + sgn * 4 * q, rdel = (b * 2048 + (d ? 2047 : 0)) - (NLAT + b * 256 + (d ? 255 : 0)) - sgn * 256;
        const unsigned vo8 = (unsigned)lane * 8u;
        const int rcu = NLAT + b * 256 + (d ? 255 : 0), s768 = sgn * 768, loff = sgn * 4 * q * 768 + 2 * m;
        f32x4 acc[4];
#pragma unroll
        for (int jt = 0; jt < 4; ++jt) acc[jt] = (f32x4){0.f, 0.f, 0.f, 0.f};
        struct Shared { bf16x8 apf0, apf1, rpf0, rpf1, bkf0, bkf1, bkf2, bkf3, mmf; u32x2 gl0, gl1, gl2, gl3; };
        struct Own { u32x2 uw; unsigned vr0, vr1, vr2, vr3; };
#define GLDS8(dst, voff, sbase) asm volatile("global_load_dwordx2 %0, %1, %2" : "=&v"(dst) : "v"(voff), "s"(sbase) : "memory")
#define GLDS2(dst, voff, sbase) asm volatile("global_load_ushort %0, %1, %2" : "=&v"(dst) : "v"(voff), "s"(sbase) : "memory")
#define OWN_LOAD(X, c_) do { const int cc_ = (c_) < 144 ? (c_) : 143; const int ub_ = (rcu + sgn * 16 * cc_ + (int)(cc_ >= 16) * rdel) * 768; const bf16_t* ulb = UL + ((size_t)cc_ * 4 + iw) * 256; \
            GLDS8(X.uw, vo8, ulb); const unsigned v0_ = (unsigned)(ub_ + loff), v1_ = v0_ + (unsigned)s768, v2_ = v0_ + (unsigned)(2 * s768), v3_ = v0_ + (unsigned)(3 * s768); \
            GLDS2(X.vr0, v0_, VS); GLDS2(X.vr1, v1_, VS); GLDS2(X.vr2, v2_, VS); GLDS2(X.vr3, v3_, VS); } while (0)
#define OWN_WAIT(X) asm volatile("s_waitcnt vmcnt(10)" : "+v"(X.uw), "+v"(X.vr0), "+v"(X.vr1), "+v"(X.vr2), "+v"(X.vr3) :: "memory")
#define SH_READ(S, c_) do { const int cc_ = (c_) < 144 ? (c_) : 143; const LAS unsigned char* sl_ = ring + (cc_ % 3) * 9728 + lane * 16; \
            S.apf0 = *(const LAS bf16x8*)(sl_); S.apf1 = *(const LAS bf16x8*)(sl_ + 1024); S.rpf0 = *(const LAS bf16x8*)(sl_ + 2048); S.rpf1 = *(const LAS bf16x8*)(sl_ + 3072); \
            S.bkf0 = *(const LAS bf16x8*)(sl_ + 4096); S.bkf1 = *(const LAS bf16x8*)(sl_ + 5120); S.bkf2 = *(const LAS bf16x8*)(sl_ + 6144); S.bkf3 = *(const LAS bf16x8*)(sl_ + 7168); S.mmf = *(const LAS bf16x8*)(sl_ + 8192); \
            const LAS unsigned char* gp_ = ring + (cc_ % 3) * 9728 + 9216 + q * 8; S.gl0 = *(const LAS u32x2*)(gp_); S.gl1 = *(const LAS u32x2*)(gp_ + 32); S.gl2 = *(const LAS u32x2*)(gp_ + 64); S.gl3 = *(const LAS u32x2*)(gp_ + 96); } while (0)
#define SEQ_COMPUTE(S, X, c_) do { OWN_WAIT(X); \
            const float ul[4] = {bflo(X.uw.x), bfhi(X.uw.x), bflo(X.uw.y), bfhi(X.uw.y)}; const float vl[4] = {bflo(X.vr0), bflo(X.vr1), bflo(X.vr2), bflo(X.vr3)}; \
            f32x4 zp = (f32x4){0.f, 0.f, 0.f, 0.f}, yp = zp; \
            { const float lo[4] = {acc[0][0], acc[0][1], acc[0][2], acc[0][3]}, hi[4] = {acc[1][0], acc[1][1], acc[1][2], acc[1][3]}; const bf16x8 sf = pack_frag(lo, hi); zp = mfma16(S.apf0, sf, zp); yp = mfma16(S.rpf0, sf, yp); } \
            { const float lo[4] = {acc[2][0], acc[2][1], acc[2][2], acc[2][3]}, hi[4] = {acc[3][0], acc[3][1], acc[3][2], acc[3][3]}; const bf16x8 sf = pack_frag(lo, hi); zp = mfma16(S.apf1, sf, zp); yp = mfma16(S.rpf1, sf, yp); } \
            const float z[4] = {zp[0] + ul[0], zp[1] + ul[1], zp[2] + ul[2], zp[3] + ul[3]}; \
            yp = mfma16(S.mmf, pack_frag(ul, vl), yp); \
            const bf16x8 zvf = pack_frag(z, vl); \
            acc[0] = mfma16(S.bkf0, zvf, acc[0]); acc[1] = mfma16(S.bkf1, zvf, acc[1]); acc[2] = mfma16(S.bkf2, zvf, acc[2]); acc[3] = mfma16(S.bkf3, zvf, acc[3]); \
            { const f32x4 g4 = {__expf(bflo(S.gl0.x)), __expf(bfhi(S.gl0.x)), __expf(bflo(S.gl0.y)), __expf(bfhi(S.gl0.y))}; acc[0] *= g4; } \
            { const f32x4 g4 = {__expf(bflo(S.gl1.x)), __expf(bfhi(S.gl1.x)), __expf(bflo(S.gl1.y)), __expf(bfhi(S.gl1.y))}; acc[1] *= g4; } \
            { const f32x4 g4 = {__expf(bflo(S.gl2.x)), __expf(bfhi(S.gl2.x)), __expf(bflo(S.gl2.y)), __expf(bfhi(S.gl2.y))}; acc[2] *= g4; } \
            { const f32x4 g4 = {__expf(bflo(S.gl3.x)), __expf(bfhi(S.gl3.x)), __expf(bflo(S.gl3.y)), __expf(bfhi(S.gl3.y))}; acc[3] *= g4; } \
            _Pragma("unroll") for (int r = 0; r < 4; ++r) ybuf[((((c_) % 12) * 16) + 4 * q + r) * 16 + m] = yp[r]; } while (0)
#define SEQ_STEP(SC, SN, XC, XN2, c_) do { SH_READ(SN, (c_) + 1); OWN_LOAD(XN2, (c_) + 2); __builtin_amdgcn_sched_barrier(0); SEQ_COMPUTE(SC, XC, c_); __builtin_amdgcn_sched_barrier(0); SEQ_BAR(); } while (0)
        Shared S0, S1; Own A, B, C;
        OWN_LOAD(A, 0); OWN_LOAD(B, 1);
        SEQ_BAR();
        SH_READ(S0, 0);
        for (int c0 = 0; c0 < 144; c0 += 12) {
#pragma unroll
            for (int cc = 0; cc < 12; cc += 6) { const int c = c0 + cc;
                SEQ_STEP(S0, S1, A, C, c); SEQ_STEP(S1, S0, B, A, c + 1); SEQ_STEP(S0, S1, C, B, c + 2);
                SEQ_STEP(S1, S0, A, C, c + 3); SEQ_STEP(S0, S1, B, A, c + 4); SEQ_STEP(S1, S0, C, B, c + 5); }
#pragma unroll
            for (int k = 0; k < 12; ++k) { const int rr = (lane >> 2) + 16 * k, n = c0 * 16 + rr; const int grow = (rc0 - sgn * 4 * q) + sgn * n + (int)(n >= 256) * rdel;
                *(f32x4*)(Yw + (size_t)grow * 384 + (lane & 3) * 4) = *(const LAS f32x4*)(ybuf + rr * 16 + (lane & 3) * 4); }
        }
#undef GLDS8
#undef GLDS2
#undef OWN_LOAD
#undef OWN_WAIT
#undef SH_READ
#undef SEQ_COMPUTE
#undef SEQ_STEP
    }
#undef SEQ_BAR
    __syncthreads();
}

__device__ __forceinline__ void rwkv_finish(const Params& p, int l) {
    const int sub = threadIdx.x & 7; const int npair = (l == 0 ? NROW : NLAT) * 6;
    const bf16_t* RS = (const bf16_t*)(p.ws + U_RS); const bf16_t* KS = (const bf16_t*)(p.ws + U_KS); const bf16_t* VS = (const bf16_t*)(p.ws + U_VS);
    const bf16_t* AG0 = (const bf16_t*)(p.ws + U_AG); const bf16_t* AG1 = (const bf16_t*)(p.ws + U_AG + SZ384); const bf16_t* G = (const bf16_t*)(p.ws + U_G);
    const float* Y0 = (const float*)(p.ws + U_YRK); const float* Y1 = Y0 + (size_t)NROW * 384; bf16_t* YC = (bf16_t*)(p.ws + WS_ABUF);
    for (int pr = (blockIdx.x * NTHR + threadIdx.x) >> 3; pr < npair; pr += (gridDim.x * NTHR) >> 3) { const int row = pr / 6, h = pr % 6, col = h * 64 + sub * 8; const size_t o = (size_t)row * 384 + col;
        float y[8]; { const float4 a0 = *(const float4*)(Y0 + o), a1 = *(const float4*)(Y0 + o + 4), c0 = *(const float4*)(Y1 + o), c1 = *(const float4*)(Y1 + o + 4);
            y[0] = a0.x + c0.x; y[1] = a0.y + c0.y; y[2] = a0.z + c0.z; y[3] = a0.w + c0.w; y[4] = a1.x + c1.x; y[5] = a1.y + c1.y; y[6] = a1.z + c1.z; y[7] = a1.w + c1.w; }
        float s = 0.f;
#pragma unroll
        for (int k = 0; k < 8; ++k) s += y[k];
        s += __shfl_xor(s, 1); s += __shfl_xor(s, 2); s += __shfl_xor(s, 4); const float mean = s * (1.0f / 64.0f);
        float v2 = 0.f;
#pragma unroll
        for (int k = 0; k < 8; ++k) { const float dd = y[k] - mean; v2 += dd * dd; }
        v2 += __shfl_xor(v2, 1); v2 += __shfl_xor(v2, 2); v2 += __shfl_xor(v2, 4); const float rstd = rsqrtf(v2 * (1.0f / 64.0f) + 64e-5f);
        float r[8], kx[8], vx[8], a0[8], a1[8], gx[8];
        unpack8(*(const uint4*)(RS + o), r); unpack8(*(const uint4*)(KS + o), kx); unpack8(*(const uint4*)(VS + o), vx); unpack8(*(const uint4*)(AG0 + o), a0); unpack8(*(const uint4*)(AG1 + o), a1); unpack8(*(const uint4*)(G + o), gx);
        const float* ka = p.in[27] + l * 384 + col; const float* rk = p.in[28] + l * 384 + col; const float* lw = p.in[29] + l * 384 + col; const float* lb = p.in[30] + l * 384 + col;
        float bs = 0.f;
#pragma unroll
        for (int k = 0; k < 8; ++k) { const float kd0 = kx[k] * (1.0f + (a0[k] - 1.0f) * ka[k]), kd1 = kx[k] * (1.0f + (a1[k] - 1.0f) * ka[k]); bs += r[k] * (kd0 + kd1) * rk[k]; }
        bs += __shfl_xor(bs, 1); bs += __shfl_xor(bs, 2); bs += __shfl_xor(bs, 4);
        float ov[8];
#pragma unroll
        for (int k = 0; k < 8; ++k) ov[k] = ((y[k] - mean) * rstd * lw[k] + lb[k] + bs * vx[k]) * gx[k];
        *(uint4*)(YC + (size_t)row * 1024 + 640 + col) = pack8(ov);
    }
}

__device__ __forceinline__ void phase_normrouter(const Params& p, int l, const float* xl, const float* xc, LAS unsigned char* lds) {
    LAS float* hrow = (LAS float*)lds;
    LAS float* part = (LAS float*)(lds + 65536);
    const int lane = threadIdx.x & 63, wv = threadIdx.x >> 6, e = lane & 15, cq = lane >> 4; const int ngrp = (l == 0 ? NROW : NLAT) / 16;
    const float* mod = (const float*)(p.ws + WS_MOD) + (size_t)l * 17 * 6144; const float* g1 = p.in[6] + (l * 4 + 1) * 1024; const float* g2 = p.in[6] + (l * 4 + 2) * 1024;
    const bf16_t* Y = (const bf16_t*)(p.ws + U_Y); unsigned char* A8 = p.ws + WS_ABUF; float* AFF = (float*)(p.ws + WS_AFF);
    float wr[32];
#pragma unroll
    for (int j = 0; j < 32; ++j) wr[j] = p.in[31][((size_t)l * 1024 + 128 * wv + 32 * cq + j) * 16 + e];
    for (int gi = blockIdx.x; gi < ngrp; gi += gridDim.x) { const int r0 = gi * 16 + wv; const int b = r0 < NLAT ? (r0 >> 11) : 16; const float* mb = mod + (size_t)b * 6144;
        const float* xs = xrow(xl, xc, r0); float* xd = xrow_w(p.out, (float*)(p.ws + WS_CTXA), r0);
        float4 y[2][4], x[2][4]; float ss[2] = {0.f, 0.f};
#pragma unroll
        for (int q = 0; q < 2; ++q)
#pragma unroll
            for (int i = 0; i < 4; ++i) { { const u32x2 yw = *(const u32x2*)(Y + (size_t)(r0 + 8 * q) * 1024 + i * 256 + lane * 4); y[q][i] = make_float4(bflo(yw.x), bfhi(yw.x), bflo(yw.y), bfhi(yw.y)); }
                x[q][i] = *(const float4*)(xs + (size_t)q * 8192 + i * 256 + lane * 4); }
#pragma unroll
        for (int q = 0; q < 2; ++q)
#pragma unroll
            for (int i = 0; i < 4; ++i) ss[q] += y[q][i].x * y[q][i].x + y[q][i].y * y[q][i].y + y[q][i].z * y[q][i].z + y[q][i].w * y[q][i].w;
        ss[0] = wave_sum(ss[0]); ss[1] = wave_sum(ss[1]); const float rs[2] = {rsqrtf(ss[0] * (1.0f / 1024.0f) + 1e-6f), rsqrtf(ss[1] * (1.0f / 1024.0f) + 1e-6f)};
        float s2[2] = {0.f, 0.f};
#pragma unroll
        for (int i = 0; i < 4; ++i) { const int c = i * 256 + lane * 4; const float4 gg = *(const float4*)(g1 + c), gt = *(const float4*)(mb + 2048 + c);
#pragma unroll
            for (int q = 0; q < 2; ++q) {
                x[q][i].x += gt.x * (y[q][i].x * rs[q] * gg.x); x[q][i].y += gt.y * (y[q][i].y * rs[q] * gg.y); x[q][i].z += gt.z * (y[q][i].z * rs[q] * gg.z); x[q][i].w += gt.w * (y[q][i].w * rs[q] * gg.w);
                *(float4*)(xd + (size_t)q * 8192 + c) = x[q][i]; s2[q] += x[q][i].x * x[q][i].x + x[q][i].y * x[q][i].y + x[q][i].z * x[q][i].z + x[q][i].w * x[q][i].w; } }
        s2[0] = wave_sum(s2[0]); s2[1] = wave_sum(s2[1]); const float rs2[2] = {rsqrtf(s2[0] * (1.0f / 1024.0f) + 1e-6f), rsqrtf(s2[1] * (1.0f / 1024.0f) + 1e-6f)};
        float hv[2][4][4]; float amax[2] = {0.f, 0.f};
        __syncthreads();
#pragma unroll
        for (int i = 0; i < 4; ++i) { const int c = i * 256 + lane * 4; const float4 gg = *(const float4*)(g2 + c), sh = *(const float4*)(mb + 3072 + c), sc = *(const float4*)(mb + 4096 + c);
#pragma unroll
            for (int q = 0; q < 2; ++q) {
                hv[q][i][0] = x[q][i].x * rs2[q] * gg.x * (1.f + sc.x) + sh.x; hv[q][i][1] = x[q][i].y * rs2[q] * gg.y * (1.f + sc.y) + sh.y; hv[q][i][2] = x[q][i].z * rs2[q] * gg.z * (1.f + sc.z) + sh.z; hv[q][i][3] = x[q][i].w * rs2[q] * gg.w * (1.f + sc.w) + sh.w;
                *(LAS lf4*)(hrow + (wv + 8 * q) * 1024 + c) = (lf4){hv[q][i][0], hv[q][i][1], hv[q][i][2], hv[q][i][3]};
                amax[q] = fmaxf(amax[q], fmaxf(fmaxf(fabsf(hv[q][i][0]), fabsf(hv[q][i][1])), fmaxf(fabsf(hv[q][i][2]), fabsf(hv[q][i][3])))); } }
#pragma unroll
        for (int o = 32; o >= 1; o >>= 1) { amax[0] = fmaxf(amax[0], __shfl_xor(amax[0], o)); amax[1] = fmaxf(amax[1], __shfl_xor(amax[1], o)); }
#pragma unroll
        for (int q = 0; q < 2; ++q) { const int r = r0 + 8 * q; const float am = fmaxf(amax[q], 1e-20f), qs = 127.0f / am;
            if (lane == 0) ((float*)(p.ws + WS_SX))[r] = am * (1.0f / 127.0f);
#pragma unroll
            for (int i = 0; i < 4; ++i) { unsigned w = 0u;
#pragma unroll
                for (int k = 0; k < 4; ++k) w |= ((unsigned)__float2int_rn(hv[q][i][k] * qs) & 255u) << (8 * k);
                *(unsigned*)(A8 + (size_t)r * 1024 + i * 256 + lane * 4) = w; } }
        __syncthreads();
#pragma unroll 2
        for (int rr = 0; rr < 16; ++rr) { const LAS float* hp = hrow + rr * 1024 + 128 * wv + 32 * cq; float acc = 0.f;
#pragma unroll
            for (int j4 = 0; j4 < 8; ++j4) { const lf4 h4 = *(const LAS lf4*)(hp + 4 * j4); acc += h4.x * wr[4 * j4] + h4.y * wr[4 * j4 + 1] + h4.z * wr[4 * j4 + 2] + h4.w * wr[4 * j4 + 3]; }
            acc += __shfl_xor(acc, 16); acc += __shfl_xor(acc, 32);
            if (cq == 0) part[(rr * 8 + wv) * 16 + e] = acc; }
        __syncthreads();
        if (lane < 32) { const int row = wv + 8 * cq; float lgt = 0.f;
#pragma unroll
            for (int w = 0; w < 8; ++w) lgt += part[(row * 8 + w) * 16 + e];
            float mxl = lgt;
#pragma unroll
            for (int o = 8; o >= 1; o >>= 1) mxl = fmaxf(mxl, __shfl_xor(mxl, o));
            const float ex = expf(lgt - mxl); float den = ex;
#pragma unroll
            for (int o = 8; o >= 1; o >>= 1) den += __shfl_xor(den, o);
            AFF[(size_t)(r0 + 8 * cq) * 16 + e] = ex / den; }
    }
}

__device__ __forceinline__ void phase_topk(const Params& p, int l, LAS unsigned char* lds) {
    LAS unsigned* keys = (LAS unsigned*)lds;
    LAS int* toks = (LAS int*)(lds + 8192);
    LAS unsigned* hist = (LAS unsigned*)(lds + 9216);
    LAS unsigned* wtot = (LAS unsigned*)(lds + 10240);
    LAS unsigned* sel = (LAS unsigned*)(lds + 10304);
    const int tid = threadIdx.x, lane = tid & 63, wv = tid >> 6, nitem = l == 0 ? 512 : 256;
    const float* AFF = (const float*)(p.ws + WS_AFF); int* SLOT = (int*)(p.ws + WS_SLOT); float* SELG = (float*)(p.ws + WS_SELG);
    const bf16_t* A = (const bf16_t*)(p.ws + WS_ABUF); bf16_t* XS = (bf16_t*)(p.ws + U_XSEL);
    for (int it = blockIdx.x; it < nitem; it += gridDim.x) { const bool lat = it < 256; const int be = it & 255, b = be >> 4, e = be & 15;
        const int n = lat ? SEQ : CTXL, cap = lat ? 256 : 32, rowbase = lat ? b * 2048 : NLAT + b * 256, xoff = lat ? b * 256 : 4096 + b * 32;
        const int per = n / NTHR > 0 ? n / NTHR : 1;
        const int t0 = tid * per; const bool act = t0 < n;
        unsigned kx[4];
        __syncthreads();
#pragma unroll
        for (int j = 0; j < 4; ++j) { kx[j] = 0u; if (act && j < per) { kx[j] = __float_as_uint(AFF[(size_t)(rowbase + t0 + j) * 16 + e]); keys[t0 + j] = kx[j]; } }
        unsigned prefix = 0u; int krem = cap;
        for (int pass = 0; pass < 4; ++pass) { const int shift = 24 - 8 * pass;
            if (tid < 256) hist[tid] = 0u;
            __syncthreads();
#pragma unroll
            for (int j = 0; j < 4; ++j) if (act && j < per) { const bool match = pass == 0 || (kx[j] >> (shift + 8)) == (prefix >> (shift + 8)); if (match) atomicAdd((unsigned*)&hist[(kx[j] >> shift) & 255u], 1u); }
            __syncthreads();
            if (tid < 256) { unsigned above = 0u; for (int bb = tid + 1; bb < 256; ++bb) above += hist[bb]; const unsigned mine = hist[tid];
                if (above < (unsigned)krem && above + mine >= (unsigned)krem) { sel[0] = (unsigned)tid; sel[1] = (unsigned)krem - above; } }
            __syncthreads();
            prefix |= sel[0] << shift; krem = (int)sel[1];
            __syncthreads();
        }
        unsigned loc = 0u, pre[4];
#pragma unroll
        for (int j = 0; j < 4; ++j) { pre[j] = loc; if (act && j < per) loc += (kx[j] > prefix ? 1u : 0u) + (kx[j] == prefix ? 65536u : 0u); }
        unsigned inc = loc;
#pragma unroll
        for (int o = 1; o < 64; o <<= 1) { const unsigned t = __shfl_up(inc, o); if (lane >= o) inc += t; }
        if (lane == 63) wtot[wv] = inc;
        __syncthreads();
        unsigned base = inc - loc;
        for (int w = 0; w < wv; ++w) base += wtot[w];
#pragma unroll
        for (int j = 0; j < 4; ++j) if (act && j < per) { const unsigned c = base + pre[j]; const int gtb = (int)(c & 0xffffu), eqb = (int)(c >> 16);
            const bool s = kx[j] > prefix || (kx[j] == prefix && eqb < krem); const int slot = gtb + (eqb < krem ? eqb : krem);
            if (s) { SELG[e * XROWS + xoff + slot] = __uint_as_float(kx[j]); toks[slot] = t0 + j; }
            SLOT[(size_t)(rowbase + t0 + j) * 16 + e] = s ? slot : -1; }
        __syncthreads();
        for (int s = wv; s < cap; s += 8) { const int row = rowbase + toks[s]; const lu4* src = (const lu4*)((const unsigned char*)A + (size_t)row * 1024); lu4* dst = (lu4*)((unsigned char*)XS + ((size_t)e * XROWS + xoff + s) * 1024);
            dst[lane] = src[lane]; if (lane == 0) ((float*)(p.ws + WS_SXS))[e * XROWS + xoff + s] = ((const float*)(p.ws + WS_SX))[row]; }
    }
}

struct GroupedOrder { int nMl, nNl, G, c, total;
    __device__ void init(int nMl_, int nNl_, int, int G_, int c_) { nMl = nMl_; nNl = nNl_; G = G_; c = c_; total = 16 * nMl_ * nNl_; }
    __device__ bool next(int i, pg8::Unit& u) const {
        int L;
        if ((G & 7) == 0 && (total & 7) == 0) { const int W = G >> 3, x = c & 7, r = c >> 3, t8 = total >> 3, k = i * W + r; if (k >= t8) return false; L = x * t8 + k; }
        else { const long LL = (long)i * G + c; if (LL >= total) return false; L = (int)LL; }
        const int per = nMl * nNl, e = L / per; int idx = L % per;
        const int mg = idx / (8 * nNl) < nMl / 8 ? idx / (8 * nNl) : nMl / 8, gm = (mg + 1) * 8 <= nMl ? 8 : nMl - mg * 8; idx -= mg * 8 * nNl;
        const int ng = idx / (gm * 4) < nNl / 4 ? idx / (gm * 4) : nNl / 4, gn = (ng + 1) * 4 <= nNl ? 4 : nNl - ng * 4; idx -= ng * gm * 4;
        u.pm = e * 18 + mg * 8 + idx / gn; u.pn = e * nNl + ng * 4 + idx % gn; return true; }
    __device__ __forceinline__ void a_ready(const pg8::Unit&) const {}
    __device__ __forceinline__ void done(const pg8::Unit&) const {}
};
struct EpiSwiGLU { static constexpr bool PERM = true, AFTER_DRAIN = false; unsigned char* H; const float* sx; const float* sw;
    __device__ __forceinline__ void operator()(const f32x4 (&acc)[2][2][4][2], const pg8::Unit& u, int wr, int wc, int fr, int fq) const {
        typedef int i32x4_ __attribute__((ext_vector_type(4)));
        const int e = u.pn / 22, pnl = u.pn - e * 22; const int row0 = u.pm * 256 + wr * 64 + fr, col0 = pnl * 128 + wc * 32 + 8 * fq;
        const float* swp = sw + (size_t)u.pn * 256 + wc * 32 + 8 * fq; const float4 g0 = *(const float4*)swp, g1 = *(const float4*)(swp + 4), u0 = *(const float4*)(swp + 128), u1 = *(const float4*)(swp + 132);
        const float swg[8] = {g0.x, g0.y, g0.z, g0.w, g1.x, g1.y, g1.z, g1.w}, swu[8] = {u0.x, u0.y, u0.z, u0.w, u1.x, u1.y, u1.z, u1.w};
#pragma unroll
        for (int ai = 0; ai < 2; ++ai)
#pragma unroll
            for (int m = 0; m < 4; ++m) { const int r = row0 + ai * 128 + m * 16; const float sr = sx[r]; unsigned char* rowp = H + (size_t)r * DE + col0; float o[8];
#pragma unroll
                for (int n = 0; n < 2; ++n) { const i32x4_ ig = __builtin_bit_cast(i32x4_, acc[ai][0][m][n]), iu = __builtin_bit_cast(i32x4_, acc[ai][1][m][n]);
#pragma unroll
                    for (int j = 0; j < 4; ++j) { const float g = (float)ig[j] * (sr * swg[n * 4 + j]), uu = (float)iu[j] * (sr * swu[n * 4 + j]); o[n * 4 + j] = g * sigm(g) * uu; } }
                u32x2 w8; { int t0 = 0, t1 = 0; t0 = __builtin_amdgcn_cvt_pk_fp8_f32(o[0], o[1], t0, false); t0 = __builtin_amdgcn_cvt_pk_fp8_f32(o[2], o[3], t0, true); t1 = __builtin_amdgcn_cvt_pk_fp8_f32(o[4], o[5], t1, false); t1 = __builtin_amdgcn_cvt_pk_fp8_f32(o[6], o[7], t1, true); w8.x = (unsigned)t0; w8.y = (unsigned)t1; }
                *(u32x2*)rowp = w8; }
    }
};
struct EpiScaleBf16 { static constexpr bool PERM = true, AFTER_DRAIN = false; bf16_t* O; int ldc; const float* sx; const float* sw;
    __device__ __forceinline__ void operator()(const f32x4 (&acc)[2][2][4][2], const pg8::Unit& u, int wr, int wc, int fr, int fq) const {
        typedef int i32x4_ __attribute__((ext_vector_type(4)));
        const int row0 = u.pm * 256 + wr * 64 + fr, col0 = u.pn * 256 + wc * 32 + 8 * fq;
        float swv[2][8];
#pragma unroll
        for (int bj = 0; bj < 2; ++bj) { const float4 a = *(const float4*)(sw + col0 + bj * 128), b = *(const float4*)(sw + col0 + bj * 128 + 4); swv[bj][0] = a.x; swv[bj][1] = a.y; swv[bj][2] = a.z; swv[bj][3] = a.w; swv[bj][4] = b.x; swv[bj][5] = b.y; swv[bj][6] = b.z; swv[bj][7] = b.w; }
#pragma unroll
        for (int ai = 0; ai < 2; ++ai)
#pragma unroll
            for (int m = 0; m < 4; ++m) { const int r = row0 + ai * 128 + m * 16; const float sr = sx[r]; bf16_t* rowp = O + (size_t)r * ldc + col0;
#pragma unroll
                for (int bj = 0; bj < 2; ++bj) { float o[8];
#pragma unroll
                    for (int n = 0; n < 2; ++n) { const i32x4_ iv = __builtin_bit_cast(i32x4_, acc[ai][bj][m][n]);
#pragma unroll
                        for (int j = 0; j < 4; ++j) o[n * 4 + j] = (float)iv[j] * (sr * swv[bj][n * 4 + j]); }
                    *(uint4*)(rowp + bj * 128) = pack8(o); } }
    }
};
struct EpiGate { static constexpr bool PERM = true, AFTER_DRAIN = false; bf16_t* O; const float* gate; const float* sw;
    __device__ __forceinline__ void operator()(const f32x4 (&acc)[2][2][4][2], const pg8::Unit& u, int wr, int wc, int fr, int fq) const {
        pg8::fp8_acc_settle();
        const int pnl = u.pn & 3; const int row0 = u.pm * 256 + wr * 64 + fr, col0 = pnl * 256 + wc * 32 + 8 * fq;
#pragma unroll
        for (int bj = 0; bj < 2; ++bj) { const float* sp = sw + (size_t)u.pn * 256 + wc * 32 + 8 * fq + bj * 128; const float4 sa = *(const float4*)sp, sb = *(const float4*)(sp + 4);
#pragma unroll
            for (int ai = 0; ai < 2; ++ai)
#pragma unroll
                for (int m = 0; m < 4; ++m) { const int r = row0 + ai * 128 + m * 16; const float gt = gate[r]; const f32x4 v0 = acc[ai][bj][m][0], v1 = acc[ai][bj][m][1];
                    u32x4 w; w.x = pack2(v0[0] * (gt * sa.x), v0[1] * (gt * sa.y)); w.y = pack2(v0[2] * (gt * sa.z), v0[3] * (gt * sa.w)); w.z = pack2(v1[0] * (gt * sb.x), v1[1] * (gt * sb.y)); w.w = pack2(v1[2] * (gt * sb.z), v1[3] * (gt * sb.w));
                    *(u32x4*)(O + (size_t)r * 1024 + col0 + bj * 128) = w; } }
    }
};

__device__ __forceinline__ void phase_combine(const Params& p, int l) {
    const int lane = threadIdx.x & 63, wv = threadIdx.x >> 6; const int nrow = l == 0 ? NROW : NLAT;
    const float* mod = (const float*)(p.ws + WS_MOD) + (size_t)l * 17 * 6144; const float* g3 = p.in[6] + (l * 4 + 3) * 1024;
    const int* SLOT = (const int*)(p.ws + WS_SLOT); const bf16_t* YE = (const bf16_t*)(p.ws + U_YEXP); bf16_t* A = (bf16_t*)(p.ws + WS_ABUF);
    const int rstep = gridDim.x * 8; int r = blockIdx.x * 8 + wv;
    int nslot = (r < nrow && lane < 16) ? SLOT[(size_t)r * 16 + lane] : -1; float4 nx1[4];
    if (r < nrow) { const float* x1p = xrow(p.out, (const float*)(p.ws + WS_CTXA), r);
#pragma unroll
        for (int i = 0; i < 4; ++i) nx1[i] = *(const float4*)(x1p + i * 256 + lane * 4); }
    for (; r < nrow; r += rstep) { const bool lat = r < NLAT; const int b = lat ? (r >> 11) : ((r - NLAT) >> 8), mbi = lat ? b : 16, xoff = lat ? b * 256 : 4096 + b * 32;
        const float* mb = mod + (size_t)mbi * 6144;
        const int myslot = nslot; float4 xc[4];
#pragma unroll
        for (int i = 0; i < 4; ++i) xc[i] = nx1[i];
        float f[16];
#pragma unroll
        for (int k = 0; k < 16; ++k) f[k] = 0.f;
        unsigned long long mask = __ballot(myslot >= 0);
        while (mask) { int ee[4], sl4[4]; u32x2 w[4][4];
#pragma unroll
            for (int k = 0; k < 4; ++k) { if (mask) { ee[k] = __builtin_ctzll(mask); mask &= mask - 1; sl4[k] = __shfl(myslot, ee[k]); } else { ee[k] = -1; sl4[k] = 0; } }
#pragma unroll
            for (int k = 0; k < 4; ++k) if (ee[k] >= 0) { const bf16_t* yr = YE + ((size_t)ee[k] * XROWS + xoff + sl4[k]) * 1024 + lane * 4;
#pragma unroll
                for (int i = 0; i < 4; ++i) w[k][i] = *(const u32x2*)(yr + i * 256); }
#pragma unroll
            for (int k = 0; k < 4; ++k) if (ee[k] >= 0) {
#pragma unroll
                for (int i = 0; i < 4; ++i) { f[i * 4] += bflo(w[k][i].x); f[i * 4 + 1] += bfhi(w[k][i].x); f[i * 4 + 2] += bflo(w[k][i].y); f[i * 4 + 3] += bfhi(w[k][i].y); } } }
        { const int rn = r + rstep; nslot = (rn < nrow && lane < 16) ? SLOT[(size_t)rn * 16 + lane] : -1;
          if (rn < nrow) { const float* x1p = xrow(p.out, (const float*)(p.ws + WS_CTXA), rn);
#pragma unroll
              for (int i = 0; i < 4; ++i) nx1[i] = *(const float4*)(x1p + i * 256 + lane * 4); } }
        float ss = 0.f;
#pragma unroll
        for (int k = 0; k < 16; ++k) ss += f[k] * f[k];
        ss = wave_sum(ss); const float rs = rsqrtf(ss * (1.0f / 1024.0f) + 1e-6f);
        float* x2 = l == 0 ? xrow_w((float*)(p.ws + WS_XB), (float*)(p.ws + WS_CTXB), r) : p.out + (size_t)r * D;
        float4 xv[4];
#pragma unroll
        for (int i = 0; i < 4; ++i) { const int c = i * 256 + lane * 4; const float4 gg = *(const float4*)(g3 + c), gt = *(const float4*)(mb + 5120 + c); float4 x = xc[i];
            x.x += gt.x * (f[i * 4] * rs * gg.x); x.y += gt.y * (f[i * 4 + 1] * rs * gg.y); x.z += gt.z * (f[i * 4 + 2] * rs * gg.z); x.w += gt.w * (f[i * 4 + 3] * rs * gg.w);
            *(float4*)(x2 + c) = x; xv[i] = x; }
        if (l == 0) { const float* mb1 = mod + (size_t)17 * 6144 + (size_t)mbi * 6144; hnorm_row(p.in[6] + 4 * 1024, mb1, mb1 + 1024, p.ws + WS_ABUF + (size_t)r * 1024, (float*)(p.ws + WS_SH) + r, lane, xv); }
    }
}


#ifndef MK_ONLY
#define MK_ONLY -1
#endif
#define EN(k) (MK_ONLY < 0 || MK_ONLY == (k))
#ifndef MK_DUP
#define MK_DUP 0
#endif
#define NREP(k) ((((MK_DUP) >> (k)) & 1) ? 2 : 1)
constexpr int PH_PER_LAYER = 14, N_PHASES = 1 + 2 * PH_PER_LAYER;
#define IN(k) (lo <= (k) && (k) < hi)
#define SEAM(k) do { if (p.use_bar && IN(k) && IN((k) + 1)) xcd_barrier(bar); } while (0)
template <int l> __device__ __forceinline__ void layer_phases(const Params& p, LAS unsigned char* lds, const XcdBarrier& bar, const int lo, const int hi) {
    const int wv = __builtin_amdgcn_readfirstlane(threadIdx.x >> 6), G = gridDim.x; const int wid = blockIdx.x * 8 + wv, nw = G * 8;
        const int pb = 1 + l * PH_PER_LAYER;
        const float* xl = l == 0 ? p.in[0] : (const float*)(p.ws + WS_XB);
        const float* xc = l == 0 ? p.in[2] : (const float*)(p.ws + WS_CTXB);
        if (EN(0) && IN(pb + 0)) { { if (l == 0) phase_hnorm(p, 0, xl, xc); }
            if ((NREP(0)) == 2) { if (l == 0) phase_hnorm(p, 0, xl, xc); } }
        SEAM(pb + 0);
        if (EN(1) && IN(pb + 1)) { { pg8::Gemm g{(const bf16_t*)(p.ws + WS_ABUF), (const bf16_t*)(p.ws + WS_WIN), NROW, NINP, D / 2}; pg8::StaticOrder S; S.init(NROW, NINP, G, (int)blockIdx.x);
            EpiScaleBf16 E{(bf16_t*)(p.ws + U_P), NINP, (const float*)(p.ws + WS_SH), (const float*)(p.ws + WS_SWIN)}; pg8::gemm_phase<EpiScaleBf16, pg8::StaticOrder, false, 1>(lds, g, S, E, nullptr); }
            if ((NREP(1)) == 2) { pg8::Gemm g{(const bf16_t*)(p.ws + WS_ABUF), (const bf16_t*)(p.ws + WS_WIN), NROW, NINP, D / 2}; pg8::StaticOrder S; S.init(NROW, NINP, G, (int)blockIdx.x);
            EpiScaleBf16 E{(bf16_t*)(p.ws + U_P), NINP, (const float*)(p.ws + WS_SH), (const float*)(p.ws + WS_SWIN)}; pg8::gemm_phase<EpiScaleBf16, pg8::StaticOrder, false, 1>(lds, g, S, E, nullptr); } }
        SEAM(pb + 1);
        if (EN(2) && IN(pb + 2)) { phase_prep(p, l, lds);
            if ((NREP(2)) == 2) phase_prep(p, l, lds); }
        SEAM(pb + 2);
        if (EN(3) && IN(pb + 3)) { { lowrank_items(p, l, wid, nw, lds); if ((G & 31) == 0) s5_pass1_block(p, l, lds); else s5_pass1_items(p, l, wid, nw); }
            if ((NREP(3)) == 2) { lowrank_items(p, l, wid, nw, lds); if ((G & 31) == 0) s5_pass1_block(p, l, lds); else s5_pass1_items(p, l, wid, nw); } }
        SEAM(pb + 3);
        if (EN(4) && IN(pb + 4)) { { s5_carry(p, l); na_items(p, l, wid, nw, lds); }
            if ((NREP(4)) == 2) { s5_carry(p, l); na_items(p, l, wid, nw, lds); } }
        SEAM(pb + 4);
        if (EN(5) && IN(pb + 5)) { { s5_pass2_block(p, l, (int)blockIdx.x, G, lds); if (PRE_DUP == 6) s5_pass2_block(p, l, (int)blockIdx.x, G, lds); rwkv_pre_items(p, l, wid, nw, lds); if (PRE_DUP == 7) rwkv_pre_items(p, l, wid, nw, lds); }
            if ((NREP(5)) == 2) { s5_pass2_block(p, l, (int)blockIdx.x, G, lds); rwkv_pre_items(p, l, wid, nw, lds); } }
        SEAM(pb + 5);
        if (EN(6) && IN(pb + 6)) {
            if (G > 192) { const int bx = (int)blockIdx.x;
                if (bx < 192) rwkv_seq_block(p, l, bx, lds); else s5_glu_block(p, l, bx - 192, G - 192, lds);
                if ((NREP(6)) == 2) { if (bx < 192) rwkv_seq_block(p, l, bx, lds); else s5_glu_block(p, l, bx - 192, G - 192, lds); } }
            else { for (int task = wid; task < 768; task += nw) rwkv_seq_task(p, l, task, lds); s5_glu_items(p, l, wid, nw); } }
        SEAM(pb + 6);
        if (EN(7) && IN(pb + 7)) { rwkv_finish(p, l);
            if ((NREP(7)) == 2) rwkv_finish(p, l); }
        SEAM(pb + 7);
        if (EN(8) && IN(pb + 8)) { { const int M = l == 0 ? NROW : NLAT; pg8::Gemm g{(const bf16_t*)(p.ws + WS_ABUF), (const bf16_t*)(p.ws + WS_WOUT), M, D, D}; pg8::StaticOrder S; S.init(M, D, G, (int)blockIdx.x);
            pg8::EpiBf16<0> E{(bf16_t*)(p.ws + U_Y), D, nullptr, 0, 0}; pg8::gemm_phase<pg8::EpiBf16<0>, pg8::StaticOrder, false>(lds, g, S, E, nullptr); }
            if ((NREP(8)) == 2) { const int M = l == 0 ? NROW : NLAT; pg8::Gemm g{(const bf16_t*)(p.ws + WS_ABUF), (const bf16_t*)(p.ws + WS_WOUT), M, D, D}; pg8::StaticOrder S; S.init(M, D, G, (int)blockIdx.x);
            pg8::EpiBf16<0> E{(bf16_t*)(p.ws + U_Y), D, nullptr, 0, 0}; pg8::gemm_phase<pg8::EpiBf16<0>, pg8::StaticOrder, false>(lds, g, S, E, nullptr); } }
        SEAM(pb + 8);
        if (EN(9) && IN(pb + 9)) { phase_normrouter(p, l, xl, xc, lds);
            if ((NREP(9)) == 2) phase_normrouter(p, l, xl, xc, lds); }
        SEAM(pb + 9);
        if (EN(10) && IN(pb + 10)) { phase_topk(p, l, lds);
            if ((NREP(10)) == 2) phase_topk(p, l, lds); }
        SEAM(pb + 10);
        if (EN(11) && IN(pb + 11)) { { pg8::Gemm g{(const bf16_t*)(p.ws + U_XSEL), (const bf16_t*)(p.ws + WS_WGU), 16 * XROWS, 16 * 5632, D / 2}; GroupedOrder S; S.init(l == 0 ? 18 : 16, 22, 2, G, (int)blockIdx.x);
            EpiSwiGLU E{p.ws + U_HID, (const float*)(p.ws + WS_SXS), (const float*)(p.ws + WS_SW8)}; pg8::gemm_phase<EpiSwiGLU, GroupedOrder, false, 1>(lds, g, S, E, nullptr); }
            if ((NREP(11)) == 2) { pg8::Gemm g{(const bf16_t*)(p.ws + U_XSEL), (const bf16_t*)(p.ws + WS_WGU), 16 * XROWS, 16 * 5632, D / 2}; GroupedOrder S; S.init(l == 0 ? 18 : 16, 22, 2, G, (int)blockIdx.x);
            EpiSwiGLU E{p.ws + U_HID, (const float*)(p.ws + WS_SXS), (const float*)(p.ws + WS_SW8)}; pg8::gemm_phase<EpiSwiGLU, GroupedOrder, false, 1>(lds, g, S, E, nullptr); } }
        SEAM(pb + 11);
        if (EN(12) && IN(pb + 12)) { { pg8::Gemm g{(const bf16_t*)(p.ws + U_HID), (const bf16_t*)(p.ws + WS_WD), 16 * XROWS, 16 * 1024, DE / 2}; GroupedOrder S; S.init(l == 0 ? 18 : 16, 4, 4, G, (int)blockIdx.x);
            EpiGate E{(bf16_t*)(p.ws + U_YEXP), (const float*)(p.ws + WS_SELG), (const float*)(p.ws + WS_SWD)}; pg8::gemm_phase<EpiGate, GroupedOrder, false, 2>(lds, g, S, E, nullptr);
            if (l == 0 && G == 256 && blockIdx.x >= 128) convert_weights(p, 1, lds, (int)blockIdx.x - 128, 128, 0, CV_EARLY); }
            if ((NREP(12)) == 2) { pg8::Gemm g{(const bf16_t*)(p.ws + U_HID), (const bf16_t*)(p.ws + WS_WD), 16 * XROWS, 16 * 1024, DE / 2}; GroupedOrder S; S.init(l == 0 ? 18 : 16, 4, 4, G, (int)blockIdx.x);
            EpiGate E{(bf16_t*)(p.ws + U_YEXP), (const float*)(p.ws + WS_SELG), (const float*)(p.ws + WS_SWD)}; pg8::gemm_phase<EpiGate, GroupedOrder, false, 2>(lds, g, S, E, nullptr); } }
        SEAM(pb + 12);
        if (EN(13) && IN(pb + 13)) { { phase_combine(p, l); if (l == 0) convert_weights(p, 1, lds, (int)blockIdx.x, G, G == 256 ? CV_EARLY : 0, CV_TOTAL); }
            if (((l == 0 ? NREP(13) : 1)) == 2) { phase_combine(p, l); if (l == 0) convert_weights(p, 1, lds, (int)blockIdx.x, G); } }
        SEAM(pb + 13);
}
__global__ void __launch_bounds__(NTHR, 2) fwd(Params p) {
    extern __shared__ __attribute__((aligned(16))) unsigned char lds_raw[];
    LAS unsigned char* lds = (LAS unsigned char*)lds_raw;
    const int tid = threadIdx.x;
    if (tid < 4) ((LAS unsigned*)(lds + LDS_MISC))[tid] = 0u;
    __syncthreads();
    XcdBarrier bar; bar.bar = (unsigned*)(p.ws + WS_CTL); bar.x = 0; bar.st = (volatile LAS unsigned*)(lds + LDS_MISC);
    if (p.use_bar) bar = xcd_barrier_post((unsigned*)(p.ws + WS_CTL), (volatile LAS unsigned*)(lds + LDS_MISC));
    if (p.use_bar && tid == 0) { unsigned* xr = (unsigned*)(p.ws + WS_CTL + 32768); ((LAS unsigned*)(lds + LDS_MISC))[2] = xb_xcc_id(); ((LAS unsigned*)(lds + LDS_MISC))[3] = atomicAdd(xr + 64 * xb_xcc_id(), 1u); }
    __syncthreads();
    const int lo = p.ph_lo, hi = p.ph_hi;

    if (EN(100) && IN(0)) { { phase_prologue(p, lds); }
        if ((NREP(14)) == 2) { phase_prologue(p, lds); } }
    SEAM(0);
    layer_phases<0>(p, lds, bar, lo, hi);
    layer_phases<1>(p, lds, bar, lo, hi);
#undef IN
#undef SEAM
}
}

#ifndef MK_ONE_LAUNCH
#define MK_ONE_LAUNCH 1
#endif
extern "C" void kernel_launch(void* const* d_in, const int* in_sizes, int n_in, void* d_out, int out_size, void* d_ws, size_t ws_size, hipStream_t stream) {
    static int grid = 0;
    if (grid == 0) {
        if (n_in != 35 || out_size != mk::NLAT * mk::D || ws_size < mk::WS_END) { fprintf(stderr, "kernel_launch: unexpected problem (n_in %d, out %d, ws %zu < %zu)\n", n_in, out_size, ws_size, (size_t)mk::WS_END); grid = -1; return; }
        int dev = 0, cus = 0, per_cu = 0;
        if (hipGetDevice(&dev) != hipSuccess || hipDeviceGetAttribute(&cus, hipDeviceAttributeMultiprocessorCount, dev) != hipSuccess) { grid = -1; return; }
        if (hipFuncSetAttribute((const void*)mk::fwd, hipFuncAttributeMaxDynamicSharedMemorySize, mk::LDS_BYTES) != hipSuccess) { fprintf(stderr, "kernel_launch: hipFuncSetAttribute failed\n"); grid = -1; return; }
        if (hipOccupancyMaxActiveBlocksPerMultiprocessor(&per_cu, (const void*)mk::fwd, mk::NTHR, mk::LDS_BYTES) != hipSuccess || per_cu < 1) { fprintf(stderr, "kernel_launch: occupancy query says %d\n", per_cu); per_cu = 1; }
        (void)hipGetLastError();
        grid = cus;
    }
    if (grid < 0) return;
    (void)in_sizes;
    if (hipMemsetAsync(d_ws, 0, 65536, stream) != hipSuccess) return;
    mk::Params a{};
    for (int i = 0; i < 35; ++i) a.in[i] = (const float*)d_in[i];
    a.out = (float*)d_out; a.ws = (unsigned char*)d_ws;
#if MK_ONE_LAUNCH
    a.ph_lo = 0; a.ph_hi = mk::N_PHASES; a.use_bar = 1;
    hipLaunchKernelGGL(mk::fwd, dim3(grid), dim3(mk::NTHR), mk::LDS_BYTES, stream, a);
#else
    for (int ph = 0; ph < mk::N_PHASES; ++ph) { a.ph_lo = ph; a.ph_hi = ph + 1; a.use_bar = 0; hipLaunchKernelGGL(mk::fwd, dim3(grid), dim3(mk::NTHR), mk::LDS_BYTES, stream, a); }
#endif
}
```
